# Optimizing an MI355X kernel written in HIP

```python
import math
import jax
import jax.numpy as jnp
from jax import lax
import numpy as np

D_MODEL = 2048
BATCH = 8
SEQ = 2048
DEPTH = 1

ALPHA = (2.0 * DEPTH) ** 0.25
BETA = (8.0 * DEPTH) ** -0.25
LN_EPS = 1e-5
RMS_EPS = 1e-6
HG_DK = 128
HG_DV = 128
HG_HEADS = D_MODEL // 128
HG_WIDTH = HG_HEADS * HG_DK
HG_CHUNK = 64
AT_DH = 128
AT_HEADS = D_MODEL // 128
AT_WIDTH = AT_HEADS * AT_DH
KV_RANK = D_MODEL // 8
IDX_HEADS = 16
IDX_DIM = 128
TOPK_MAX = 256
Q_BLOCK = 128
REL_BUCKETS = 32
REL_MAX_DIST = 128
MEM_LEN = 256
MEM_HEADS = 4
MEM_DH = D_MODEL // MEM_HEADS
PEER_HEADS = 8
PEER_NKEYS = 128
PEER_N = PEER_NKEYS * PEER_NKEYS
PEER_DKEY = 256
PEER_TOPK = 16
PEER_BLOCK = 128
IN_SIZES = (HG_WIDTH, HG_WIDTH, HG_WIDTH, HG_WIDTH, AT_WIDTH, KV_RANK, IDX_HEADS * IDX_DIM, IDX_DIM, IDX_HEADS, D_MODEL, D_MODEL)
IN_COLS = sum(IN_SIZES)

kernel_name = 'hgrn2_dsa_peer_gated_hybrid'


def layer_norm(x, g, b):
    xf = x.astype(jnp.float32)
    mu = jnp.mean(xf, axis=-1, keepdims=True)
    var = jnp.mean(jnp.square(xf - mu), axis=-1, keepdims=True)
    return ((xf - mu) * lax.rsqrt(var + LN_EPS) * g + b).astype(x.dtype)


def rms_norm(x, g):
    xf = x.astype(jnp.float32)
    return (xf * lax.rsqrt(jnp.mean(xf * xf, axis=-1, keepdims=True) + RMS_EPS) * g).astype(x.dtype)


def split_columns(t, sizes):
    idx, acc = [], 0
    for s in sizes[:-1]:
        acc += s
        idx.append(acc)
    return jnp.split(t, idx, axis=-1)


def t5_bucket(dist):
    max_exact = REL_BUCKETS // 2
    d = jnp.maximum(dist, 0)
    large = max_exact + (jnp.log(jnp.maximum(d, 1).astype(jnp.float32) / max_exact)
                         / math.log(REL_MAX_DIST / max_exact) * (REL_BUCKETS - max_exact)).astype(jnp.int32)
    large = jnp.minimum(large, REL_BUCKETS - 1)
    return jnp.where(d < max_exact, d, large)


def hgrn2_branch(q, f_raw, i, g_out, lb, norm_g):
    B, S, _ = q.shape
    C = HG_CHUNK
    N = S // C
    f = lb + (1.0 - lb) * jax.nn.sigmoid(f_raw.astype(jnp.float32))
    log_f = jnp.log(f)
    k = 1.0 - f

    def heads(t, d):
        return t.astype(jnp.float32).reshape(B, N, C, HG_HEADS, d).transpose(0, 3, 1, 2, 4)

    qh, kh, vh, gl = heads(q, HG_DK), heads(k, HG_DK), heads(i, HG_DV), heads(log_f, HG_DK)
    G = jnp.cumsum(gl, axis=3)
    G_last = G[:, :, :, -1:, :]
    G_ref = G[:, :, :, C // 2 - 1:C // 2, :]
    a = jnp.einsum('bhnik,bhnjk->bhnij', qh * jnp.exp(G - G_ref), kh * jnp.exp(G_ref - G))
    a = jnp.where(jnp.tril(jnp.ones((C, C), dtype=bool)), a, 0.0)
    o_intra = jnp.einsum('bhnij,bhnjv->bhniv', a, vh)
    q_dec = qh * jnp.exp(G)
    k_dec = kh * jnp.exp(G_last - G)
    chunk_decay = jnp.exp(G_last[:, :, :, 0, :])

    def step(state, xs):
        qd, kd, vc, dec = xs
        o = jnp.einsum('bhik,bhkv->bhiv', qd, state)
        state = dec[..., None] * state + jnp.einsum('bhjk,bhjv->bhkv', kd, vc)
        return state, o

    s0 = jnp.zeros((B, HG_HEADS, HG_DK, HG_DV), jnp.float32)
    mv = lambda t: jnp.moveaxis(t, 2, 0)
    _, o_inter = lax.scan(step, s0, (mv(q_dec), mv(k_dec), mv(vh), mv(chunk_decay)))
    o = o_intra + jnp.moveaxis(o_inter, 0, 2)
    o = o.transpose(0, 2, 3, 1, 4).reshape(B, S, HG_HEADS, HG_DV)
    o = rms_norm(o, norm_g.reshape(HG_HEADS, HG_DV).astype(jnp.float32))
    o = o.reshape(B, S, HG_WIDTH) * jax.nn.silu(g_out.astype(jnp.float32))
    return o.astype(q.dtype)


def dsa_branch(q, ckv, iq, ik, iw, kv_norm_g, ik_norm_g, ik_norm_b, w_uk, w_uv, rel_bias):
    B, S, _ = q.shape
    K = min(TOPK_MAX, S // 4)
    nb = S // Q_BLOCK
    ckv = rms_norm(ckv, kv_norm_g)
    ik = layer_norm(ik, ik_norm_g, ik_norm_b)
    q = q.reshape(B, S, AT_HEADS, AT_DH)
    q_lat = jnp.einsum('bshd,hrd->bshr', q, w_uk) * AT_DH ** -0.5
    iq = iq.reshape(B, S, IDX_HEADS, IDX_DIM)
    iw = iw * IDX_HEADS ** -0.5
    key_pos = jnp.arange(S, dtype=jnp.int32)

    def blocks(t):
        return jnp.moveaxis(t.reshape(B, nb, Q_BLOCK, *t.shape[2:]), 1, 0)

    def one_block(args):
        q_lat_b, iq_b, iw_b, start = args
        t_pos = start + jnp.arange(Q_BLOCK, dtype=jnp.int32)
        s_idx = jnp.einsum('bqhd,bsd->bqhs', iq_b, ik) * IDX_DIM ** -0.5
        score = jnp.einsum('bqhs,bqh->bqs', jax.nn.relu(s_idx), iw_b).astype(jnp.float32)
        score = jnp.where(key_pos[None, :] <= t_pos[:, None], score, -jnp.inf)
        _, sel = lax.top_k(score, K)
        valid = sel <= t_pos[None, :, None]
        c_sel = jax.vmap(lambda c, idx: c[idx])(ckv, sel)
        logits = jnp.einsum('bqhr,bqkr->bqhk', q_lat_b, c_sel).astype(jnp.float32)
        bias = rel_bias[t5_bucket(t_pos[None, :, None] - sel)]
        logits = logits + jnp.moveaxis(bias, -1, 2).astype(jnp.float32)
        logits = jnp.where(valid[:, :, None, :], logits, -jnp.inf)
        p = jax.nn.softmax(logits, axis=-1).astype(c_sel.dtype)
        o_lat = jnp.einsum('bqhk,bqkr->bqhr', p, c_sel)
        return jnp.einsum('bqhr,hrd->bqhd', o_lat, w_uv)

    starts = jnp.arange(nb, dtype=jnp.int32) * Q_BLOCK
    o = lax.map(one_block, (blocks(q_lat), blocks(iq), blocks(iw), starts))
    return jnp.moveaxis(o, 0, 1).reshape(B, S, AT_WIDTH)


def memory_cross_attention(x, mem, w_q, w_k, w_v, w_o):
    B, S, D = x.shape
    M = mem.shape[1]
    q = (x @ w_q).reshape(B, S, MEM_HEADS, MEM_DH)
    k = (mem @ w_k).reshape(B, M, MEM_HEADS, MEM_DH)
    v = (mem @ w_v).reshape(B, M, MEM_HEADS, MEM_DH)
    logits = jnp.einsum('bshd,bmhd->bhsm', q, k).astype(jnp.float32) * MEM_DH ** -0.5
    p = jax.nn.softmax(logits, axis=-1).astype(v.dtype)
    o = jnp.einsum('bhsm,bmhd->bshd', p, v).reshape(B, S, D)
    return o @ w_o


def peer_ffn(x, w_query, sub_keys, expert_u, expert_v):
    B, S, D = x.shape
    T = B * S
    xt = x.reshape(T, D)
    q = (xt @ w_query).reshape(T, PEER_HEADS, 2, PEER_DKEY // 2)
    s = jnp.einsum('thpd,hpnd->thpn', q, sub_keys).astype(jnp.float32)
    v_half, i_half = lax.top_k(s, PEER_TOPK)
    cand = v_half[:, :, 0, :, None] + v_half[:, :, 1, None, :]
    cand_idx = i_half[:, :, 0, :, None] * PEER_NKEYS + i_half[:, :, 1, None, :]
    top_s, top_pos = lax.top_k(cand.reshape(T, PEER_HEADS, -1), PEER_TOPK)
    experts = jnp.take_along_axis(cand_idx.reshape(T, PEER_HEADS, -1), top_pos, axis=-1)
    gate = jax.nn.softmax(top_s, axis=-1).astype(x.dtype)
    E = PEER_HEADS * PEER_TOPK
    nb = T // PEER_BLOCK

    def one_block(args):
        xb, eb, gb = args
        h = jax.nn.gelu(jnp.einsum('td,ted->te', xb, expert_u[eb]), approximate=False)
        return jnp.einsum('te,ted->td', gb * h, expert_v[eb])

    y = lax.map(one_block, (xt.reshape(nb, PEER_BLOCK, D), experts.reshape(nb, PEER_BLOCK, E),
                            gate.reshape(nb, PEER_BLOCK, E)))
    return y.reshape(B, S, D)


def setup_inputs(seed: int = 0) -> dict:
    key = jax.random.key(seed)
    ks = jax.random.split(key, 32)
    L, D = DEPTH, D_MODEL
    nrm = lambda k, shape, s: jax.random.normal(k, shape, jnp.float32) * s
    return {
        'x': nrm(ks[0], (BATCH, SEQ, D), 1.0),
        'mem': nrm(ks[1], (BATCH, MEM_LEN, D), 1.0),
        'w_in': nrm(ks[2], (L, D, IN_COLS), D ** -0.5),
        'lb_logits': nrm(ks[3], (L + 1, HG_WIDTH), 0.1),
        'hg_norm_g': 1.0 + nrm(ks[4], (L, HG_WIDTH), 0.02),
        'kv_norm_g': 1.0 + nrm(ks[5], (L, KV_RANK), 0.02),
        'ik_norm_g': 1.0 + nrm(ks[6], (L, IDX_DIM), 0.02),
        'ik_norm_b': nrm(ks[7], (L, IDX_DIM), 0.02),
        'w_uk': nrm(ks[8], (L, AT_HEADS, KV_RANK, AT_DH), KV_RANK ** -0.5),
        'w_uv': nrm(ks[9], (L, AT_HEADS, KV_RANK, AT_DH), KV_RANK ** -0.5 * BETA),
        'rel_bias': nrm(ks[10], (REL_BUCKETS, AT_HEADS), 0.5),
        'w_branch_a': nrm(ks[11], (L, HG_WIDTH, D), HG_WIDTH ** -0.5 * BETA),
        'w_branch_b': nrm(ks[12], (L, AT_WIDTH, D), AT_WIDTH ** -0.5 * BETA),
        'w_mix_out': nrm(ks[13], (L, D, D), D ** -0.5 * BETA),
        'ln1_g': 1.0 + nrm(ks[14], (L, D), 0.02),
        'ln1_b': nrm(ks[15], (L, D), 0.02),
        'w_cq': nrm(ks[16], (L, D, D), D ** -0.5),
        'w_ck': nrm(ks[17], (L, D, D), D ** -0.5),
        'w_cv': nrm(ks[18], (L, D, D), D ** -0.5 * BETA),
        'w_co': nrm(ks[19], (L, D, D), D ** -0.5 * BETA),
        'ln2_g': 1.0 + nrm(ks[20], (L, D), 0.02),
        'ln2_b': nrm(ks[21], (L, D), 0.02),
        'w_pq': nrm(ks[22], (L, D, PEER_HEADS * PEER_DKEY), D ** -0.5),
        'peer_keys': nrm(ks[23], (L, PEER_HEADS, 2, PEER_NKEYS, PEER_DKEY // 2), (PEER_DKEY // 2) ** -0.5),
        'peer_u': nrm(ks[24], (L, PEER_N, D), D ** -0.5),
        'peer_v': nrm(ks[25], (L, PEER_N, D), BETA),
        'ln3_g': 1.0 + nrm(ks[26], (L, D), 0.02),
        'ln3_b': nrm(ks[27], (L, D), 0.02),
    }


def reference(x, mem, w_in, lb_logits, hg_norm_g, kv_norm_g, ik_norm_g, ik_norm_b, w_uk, w_uv,
              rel_bias, w_branch_a, w_branch_b, w_mix_out, ln1_g, ln1_b, w_cq, w_ck, w_cv, w_co,
              ln2_g, ln2_b, w_pq, peer_keys, peer_u, peer_v, ln3_g, ln3_b):
    lower_bounds = jnp.cumsum(jax.nn.softmax(lb_logits.astype(jnp.float32), axis=0), axis=0)
    h = x
    for l in range(DEPTH):
        proj = h @ w_in[l]
        hq, hf, hi, hg, aq, ackv, aiq, aik, aiw, gate_a, gate_b = split_columns(proj, IN_SIZES)
        ya = hgrn2_branch(hq, hf, hi, hg, lower_bounds[l], hg_norm_g[l]) @ w_branch_a[l]
        yb = dsa_branch(aq, ackv, aiq, aik, aiw, kv_norm_g[l], ik_norm_g[l], ik_norm_b[l],
                        w_uk[l], w_uv[l], rel_bias) @ w_branch_b[l]
        mix = (jax.nn.sigmoid(gate_a) * ya + jax.nn.sigmoid(gate_b) * yb) @ w_mix_out[l]
        h = layer_norm(ALPHA * h + mix, ln1_g[l], ln1_b[l])
        ca = memory_cross_attention(h, mem, w_cq[l], w_ck[l], w_cv[l], w_co[l])
        h = layer_norm(ALPHA * h + ca, ln2_g[l], ln2_b[l])
        ff = peer_ffn(h, w_pq[l], peer_keys[l], peer_u[l], peer_v[l])
        h = layer_norm(ALPHA * h + ff, ln3_g[l], ln3_b[l])
    return h
```

```cpp
#include <hip/hip_runtime.h>
#include <hip/hip_cooperative_groups.h>
#include <cstdint>
#include <cmath>
#include <cstdio>
namespace cg = cooperative_groups;

#ifndef ONE_LAUNCH
#define ONE_LAUNCH 0
#endif

typedef unsigned short bf16;
typedef short bf16x8 __attribute__((ext_vector_type(8)));
typedef float f32x4 __attribute__((ext_vector_type(4)));
typedef float f32x16 __attribute__((ext_vector_type(16)));
typedef unsigned u32x4 __attribute__((ext_vector_type(4)));
typedef unsigned u32x2 __attribute__((ext_vector_type(2)));

constexpr int T = 16384, D = 2048, SEQ = 2048, NB = 8;
constexpr int NCOLS = 16896;
constexpr float ALPHA = 1.189207115002721f;
constexpr int NPH = 17;

constexpr size_t MiB = 1u << 20;
constexpr size_t WS_CTL = 0, WS_MEMB = 1 * MiB, WS_WKV = 9 * MiB, WS_LB = 11 * MiB, WS_MASK = 12 * MiB, WS_WIN = 17 * MiB,
                 WS_SLOT = 83 * MiB, SLOT_BYTES = 64 * MiB, WS_CKV = 595 * MiB, WS_IKW = 603 * MiB, WS_END = 611 * MiB;
constexpr int LDS_BYTES = 147456;

struct Args {
    const float* in[28];
    float* out;
    unsigned char* ws;
    int ph_lo, ph_hi;
};

#define WAVE_SYNC() asm volatile("s_waitcnt lgkmcnt(0)" ::: "memory")

__device__ __forceinline__ unsigned f2bf(float f) { unsigned u = __float_as_uint(f); return (u + 0x7fffu + ((u >> 16) & 1u)) >> 16; }
__device__ __forceinline__ unsigned pk2(float lo, float hi) { return f2bf(lo) | (f2bf(hi) << 16); }
__device__ __forceinline__ float bf2f(unsigned h) { return __uint_as_float(h << 16); }
__device__ __forceinline__ float bflo(unsigned w) { return __uint_as_float(w << 16); }
__device__ __forceinline__ float bfhi(unsigned w) { return __uint_as_float(w & 0xffff0000u); }
__device__ __forceinline__ float wave_sum(float v) {
#pragma unroll
    for (int o = 32; o >= 1; o >>= 1) v += __shfl_xor(v, o);
    return v;
}
__device__ __forceinline__ float wave_max(float v) {
#pragma unroll
    for (int o = 32; o >= 1; o >>= 1) v = fmaxf(v, __shfl_xor(v, o));
    return v;
}
__device__ __forceinline__ float sigm(float x) { return 1.0f / (1.0f + expf(-x)); }
__device__ __forceinline__ void unpack8(u32x4 w, float* f) {
    f[0] = bflo(w.x); f[1] = bfhi(w.x); f[2] = bflo(w.y); f[3] = bfhi(w.y); f[4] = bflo(w.z); f[5] = bfhi(w.z); f[6] = bflo(w.w); f[7] = bfhi(w.w);
}

struct Frame {
    unsigned char* lds;
    int tid, lane, wave, bid, G;
    const Args* a;
    unsigned char* ws;
    __device__ __forceinline__ bf16* slot(int i) const { return (bf16*)(ws + WS_SLOT + (size_t)i * SLOT_BYTES); }
};

template <class Epi>
__device__ __forceinline__ void gemm_simple(const Frame& F, const bf16* A, int lda, const bf16* Bt, int ldb, int M, int N, int K, const Epi& epi) {
    const int ntn = N / 128, nunits = (M / 256) * ntn;
    const int wm = F.wave >> 1, wn = F.wave & 1, l31 = F.lane & 31, hi = F.lane >> 5;
    for (int unit = F.bid; unit < nunits; unit += F.G) {
        const int tm = unit / ntn, tn = unit % ntn;
        const int row0 = tm * 256 + wm * 64, col0 = tn * 128 + wn * 64;
        f32x16 acc[2][2];
#pragma unroll
        for (int i = 0; i < 2; ++i)
#pragma unroll
            for (int j = 0; j < 2; ++j)
#pragma unroll
                for (int r = 0; r < 16; ++r) acc[i][j][r] = 0.f;
        const bf16* ap0 = A + (size_t)(row0 + l31) * lda + 8 * hi;
        const bf16* ap1 = ap0 + (size_t)32 * lda;
        const bf16* bp0 = Bt + (size_t)(col0 + l31) * ldb + 8 * hi;
        const bf16* bp1 = bp0 + (size_t)32 * ldb;
#pragma unroll 2
        for (int k0 = 0; k0 < K; k0 += 16) {
            const bf16x8 a0 = *(const bf16x8*)(ap0 + k0), a1 = *(const bf16x8*)(ap1 + k0);
            const bf16x8 b0 = *(const bf16x8*)(bp0 + k0), b1 = *(const bf16x8*)(bp1 + k0);
            acc[0][0] = __builtin_amdgcn_mfma_f32_32x32x16_bf16(a0, b0, acc[0][0], 0, 0, 0);
            acc[0][1] = __builtin_amdgcn_mfma_f32_32x32x16_bf16(a0, b1, acc[0][1], 0, 0, 0);
            acc[1][0] = __builtin_amdgcn_mfma_f32_32x32x16_bf16(a1, b0, acc[1][0], 0, 0, 0);
            acc[1][1] = __builtin_amdgcn_mfma_f32_32x32x16_bf16(a1, b1, acc[1][1], 0, 0, 0);
        }
#pragma unroll
        for (int i = 0; i < 2; ++i)
#pragma unroll
            for (int j = 0; j < 2; ++j)
#pragma unroll
                for (int r = 0; r < 16; ++r) {
                    const int row = row0 + 32 * i + (r & 3) + 8 * (r >> 2) + 4 * hi, col = col0 + 32 * j + l31;
                    epi(row, col, acc[i][j][r]);
                }
    }
}

struct EpiProj { unsigned char* ws;
    __device__ __forceinline__ void operator()(int row, int col, float v) const {
        if (col < 16384) { bf16* s = (bf16*)(ws + WS_SLOT + (size_t)(col >> 11) * SLOT_BYTES); s[(size_t)row * 2048 + (col & 2047)] = (bf16)f2bf(v); }
        else if (col < 16640) ((bf16*)(ws + WS_CKV))[(size_t)row * 256 + (col - 16384)] = (bf16)f2bf(v);
        else ((bf16*)(ws + WS_IKW))[(size_t)row * 256 + (col - 16640)] = (bf16)f2bf(v);
    } };
struct EpiBf16 { bf16* o; int ld;
    __device__ __forceinline__ void operator()(int row, int col, float v) const { o[(size_t)row * ld + col] = (bf16)f2bf(v); } };
struct EpiF32 { float* o; int ld;
    __device__ __forceinline__ void operator()(int row, int col, float v) const { o[(size_t)row * ld + col] = v; } };
struct EpiYA { bf16* ga;
    __device__ __forceinline__ void operator()(int row, int col, float v) const { bf16* p = ga + (size_t)row * 2048 + col; *p = (bf16)f2bf(sigm(bf2f(*p)) * v); } };
struct EpiKV { bf16* kh; bf16* vh;
    __device__ __forceinline__ void operator()(int row, int col, float v) const { if (col < 2048) kh[(size_t)row * 2048 + col] = (bf16)f2bf(v); else vh[(size_t)row * 2048 + col - 2048] = (bf16)f2bf(v); } };
struct EpiYB { bf16* ga; const bf16* gb;
    __device__ __forceinline__ void operator()(int row, int col, float v) const { const size_t i = (size_t)row * 2048 + col; ga[i] = (bf16)f2bf(bf2f(ga[i]) + sigm(bf2f(gb[i])) * v); } };
struct EpiMix { const float* x; float* z;
    __device__ __forceinline__ void operator()(int row, int col, float v) const { const size_t i = (size_t)row * 2048 + col; z[i] = ALPHA * x[i] + v; } };
struct EpiRes { float* z;
    __device__ __forceinline__ void operator()(int row, int col, float v) const { const size_t i = (size_t)row * 2048 + col; z[i] = ALPHA * z[i] + v; } };

template <class CM>
__device__ __forceinline__ void transpose_item(const float* W, size_t ldw, bf16* WT, size_t ldwt, int row_off, int nblk, int item, float* scr, int lane, const CM& cm) {
    const int kb = item / nblk, nb = item % nblk, k0 = 64 * kb, n0 = 32 * nb;
    const int c = cm(n0 + (lane & 31));
#pragma unroll 8
    for (int i = 0; i < 32; ++i) { const int kk = 2 * i + (lane >> 5); scr[kk * 33 + (lane & 31)] = (c >= 0) ? W[(size_t)(k0 + kk) * ldw + c] : 0.f; }
    WAVE_SYNC();
    const int c8 = lane & 7;
#pragma unroll
    for (int j = 0; j < 4; ++j) { const int n = (lane >> 3) + 8 * j; const float* s = scr + (8 * c8) * 33 + n;
        u32x4 o; o.x = pk2(s[0 * 33], s[1 * 33]); o.y = pk2(s[2 * 33], s[3 * 33]); o.z = pk2(s[4 * 33], s[5 * 33]); o.w = pk2(s[6 * 33], s[7 * 33]);
        *(u32x4*)(WT + (size_t)(row_off + n0 + n) * ldwt + k0 + 8 * c8) = o; }
    WAVE_SYNC();
}
struct CmIdent { __device__ __forceinline__ int operator()(int n) const { return n; } };
struct CmWin { __device__ __forceinline__ int operator()(int n) const {
    if (n < 10240) return n;
    if (n < 12288) return 10496 + (n - 10240);
    if (n < 14336) return 12688 + (n - 12288);
    if (n < 16384) return 14736 + (n - 14336);
    if (n < 16640) return 10240 + (n - 16384);
    if (n < 16768) return 12544 + (n - 16640);
    if (n < 16784) return 12672 + (n - 16768);
    return -1; } };

__device__ __forceinline__ void cvt_bf16_stream(const Frame& F, const float* src, bf16* dst, size_t n8) {
    const size_t gt = (size_t)F.bid * 512 + F.tid, NT = (size_t)F.G * 512;
    for (size_t i = gt; i < n8; i += NT) { const f32x4 a = ((const f32x4*)src)[2 * i], b = ((const f32x4*)src)[2 * i + 1];
        u32x4 o; o.x = pk2(a.x, a.y); o.y = pk2(a.z, a.w); o.z = pk2(b.x, b.y); o.w = pk2(b.z, b.w); ((u32x4*)dst)[i] = o; }
}

__device__ __forceinline__ void ph0_prologue(const Frame& F) {
    const Args& a = *F.a;
    cvt_bf16_stream(F, a.in[0], (bf16*)a.out, (size_t)T * D / 8);
    cvt_bf16_stream(F, a.in[1], (bf16*)(F.ws + WS_MEMB), (size_t)2048 * 2048 / 8);
    float* scr = (float*)(F.lds + F.wave * 16384);
    const int gw = F.bid * 8 + F.wave, NGW = F.G * 8;
    {
        const int nblk = NCOLS / 32, nitems = (2048 / 64) * nblk;
        for (int it = gw; it < nitems; it += NGW) transpose_item(a.in[2], 16784, (bf16*)(F.ws + WS_WIN), 2048, 0, nblk, it, scr, F.lane, CmWin());
    }
    {
        for (int it = gw; it < 32 * 16; it += NGW) { const int mat = it >> 4, which = mat >> 4, h = mat & 15;
            transpose_item(a.in[which ? 9 : 8] + (size_t)h * 256 * 128, 128, (bf16*)(F.ws + WS_WKV), 256, which * 2048 + h * 128, 4, it & 15, scr, F.lane, CmIdent()); }
    }
    {
        const int gt = F.bid * 512 + F.tid;
        if (gt < 2048) { const float l0 = a.in[3][gt], l1 = a.in[3][2048 + gt]; ((float*)(F.ws + WS_LB))[gt] = 1.0f / (1.0f + expf(l1 - l0)); }
    }
}

__device__ __forceinline__ void hgrn_naive(const Frame& F, int unit) {
    const int b = unit >> 4, h = unit & 15, tid = F.tid;
    float* qs = (float*)F.lds; float* fs = qs + 128; float* ks = fs + 128; float* part = ks + 128;
    const bf16* HQ = F.slot(0); const bf16* HF = F.slot(1); const bf16* HI = F.slot(2);
    float* oraw = F.a->out;
    const int dv = tid & 127, kq = tid >> 7;
    float S[32];
#pragma unroll
    for (int j = 0; j < 32; ++j) S[j] = 0.f;
    const float lb = ((const float*)(F.ws + WS_LB))[h * 128 + dv];
    const size_t base = (size_t)b * 2048 * 2048 + h * 128;
    unsigned short qn = HQ[base + dv], fn = HF[base + dv], vn = HI[base + dv];
    for (int t = 0; t < 2048; ++t) {
        const size_t off = base + (size_t)t * 2048;
        if (tid < 128) { const float f = lb + (1.0f - lb) * sigm(bf2f(fn)); qs[tid] = bf2f(qn); fs[tid] = f; ks[tid] = 1.0f - f; }
        const float v = bf2f(vn);
        if (t + 1 < 2048) { qn = HQ[off + 2048 + dv]; fn = HF[off + 2048 + dv]; vn = HI[off + 2048 + dv]; }
        __syncthreads();
        float acc = 0.f;
#pragma unroll
        for (int j = 0; j < 32; ++j) { const int dk = kq * 32 + j; S[j] = fs[dk] * S[j] + ks[dk] * v; acc += qs[dk] * S[j]; }
        part[kq * 128 + dv] = acc;
        __syncthreads();
        if (tid < 128) oraw[off + tid] = (part[tid] + part[128 + tid]) + (part[256 + tid] + part[384 + tid]);
    }
    __syncthreads();
}

__device__ __forceinline__ void ph2_side(const Frame& F, int sid, int nside) {
    const Args& a = *F.a;
    const int gw = sid * 8 + F.wave, NGW = nside * 8, lane = F.lane;
    bf16* CKV = (bf16*)(F.ws + WS_CKV); bf16* IKW = (bf16*)(F.ws + WS_IKW);
    for (int row = gw; row < T; row += NGW) {
        {   u32x2 w = *(u32x2*)(CKV + (size_t)row * 256 + 4 * lane);
            float x0 = bflo(w.x), x1 = bfhi(w.x), x2 = bflo(w.y), x3 = bfhi(w.y);
            const float ss = wave_sum(x0 * x0 + x1 * x1 + x2 * x2 + x3 * x3);
            const float r = rsqrtf(ss * (1.0f / 256.0f) + 1e-6f);
            const f32x4 g = *(const f32x4*)(a.in[5] + 4 * lane);
            w.x = pk2(x0 * r * g.x, x1 * r * g.y); w.y = pk2(x2 * r * g.z, x3 * r * g.w);
            *(u32x2*)(CKV + (size_t)row * 256 + 4 * lane) = w; }
        {   unsigned w = *(unsigned*)(IKW + (size_t)row * 256 + 2 * lane);
            float x0 = bflo(w), x1 = bfhi(w);
            const float mu = wave_sum(x0 + x1) * (1.0f / 128.0f);
            x0 -= mu; x1 -= mu;
            const float var = wave_sum(x0 * x0 + x1 * x1) * (1.0f / 128.0f);
            const float r = rsqrtf(var + 1e-5f);
            const float g0 = a.in[6][2 * lane], g1 = a.in[6][2 * lane + 1], b0 = a.in[7][2 * lane], b1 = a.in[7][2 * lane + 1];
            *(unsigned*)(IKW + (size_t)row * 256 + 2 * lane) = pk2(x0 * r * g0 + b0, x1 * r * g1 + b1); }
    }
    float* scr = (float*)(F.lds + F.wave * 16384);
    for (int it = gw; it < 8 * 2048; it += NGW) { const int m = it >> 11;
        const float* wsrc = m == 0 ? a.in[11] : m == 1 ? a.in[12] : m == 2 ? a.in[13] : m == 3 ? a.in[16] : m == 4 ? a.in[17] : m == 5 ? a.in[18] : m == 6 ? a.in[19] : a.in[22];
        transpose_item(wsrc, 2048, (bf16*)(F.ws + WS_WIN + (size_t)m * 8 * MiB), 2048, 0, 64, it & 2047, scr, lane, CmIdent()); }
}

__device__ __forceinline__ void ph3_hgnorm(const Frame& F) {
    const Args& a = *F.a;
    const int gw = F.bid * 8 + F.wave, NGW = F.G * 8, lane = F.lane;
    const float* oraw = a.out; const bf16* HG = F.slot(3); bf16* HO = F.slot(0);
    for (int u = gw; u < T * 16; u += NGW) {
        const size_t off = (size_t)(u >> 4) * 2048 + (u & 15) * 128 + 2 * lane;
        const float o0 = oraw[off], o1 = oraw[off + 1];
        const float r = rsqrtf(wave_sum(o0 * o0 + o1 * o1) * (1.0f / 128.0f) + 1e-6f);
        const unsigned gw2 = *(const unsigned*)(HG + off);
        const float g0 = bflo(gw2), g1 = bfhi(gw2);
        const int c = (u & 15) * 128 + 2 * lane;
        *(unsigned*)(HO + off) = pk2(o0 * r * a.in[4][c] * (g0 * sigm(g0)), o1 * r * a.in[4][c + 1] * (g1 * sigm(g1)));
    }
}

__device__ __forceinline__ unsigned fkey(float f) { const unsigned u = __float_as_uint(f); return (u & 0x80000000u) ? ~u : (u | 0x80000000u); }
__device__ __forceinline__ void ph5_select(const Frame& F) {
    const int gw = F.bid * 8 + F.wave, NGW = F.G * 8, lane = F.lane;
    float* iq = (float*)(F.lds + F.wave * 16384);
    float* scl = iq + 2048;
    const bf16* AIQ = F.slot(5); const bf16* IKW = (const bf16*)(F.ws + WS_IKW);
    unsigned* MASK = (unsigned*)(F.ws + WS_MASK);
    for (int idx = gw; idx < T; idx += NGW) {
        const int b = idx >> 11, tt = idx & 2047, t = (b & 1) ? 2047 - tt : tt;
        const size_t row = (size_t)b * 2048 + t;
        {
#pragma unroll
            for (int i = 0; i < 4; ++i) { const u32x4 w = *(const u32x4*)(AIQ + row * 2048 + 512 * i + 8 * lane); float f[8]; unpack8(w, f);
#pragma unroll
                for (int j = 0; j < 8; ++j) iq[512 * i + 8 * lane + j] = f[j]; }
        }
        float wv = 0.f;
        if (lane < 16) wv = bf2f(IKW[row * 256 + 128 + lane]) * (0.25f * 0.08838834764831845f);
        WAVE_SYNC();
        const int nj = (t >> 6) + 1;
        for (int j = 0; j < nj; ++j) {
            const int s = lane + 64 * j, sc = s <= t ? s : t;
            const bf16* kr = IKW + ((size_t)b * 2048 + sc) * 256;
            float dot[16];
#pragma unroll
            for (int h = 0; h < 16; ++h) dot[h] = 0.f;
            for (int c = 0; c < 16; ++c) {
                float kf[8]; unpack8(*(const u32x4*)(kr + 8 * c), kf);
#pragma unroll
                for (int h = 0; h < 16; ++h) { const f32x4 q0 = *(const f32x4*)(iq + h * 128 + 8 * c), q1 = *(const f32x4*)(iq + h * 128 + 8 * c + 4);
                    dot[h] += kf[0] * q0.x + kf[1] * q0.y + kf[2] * q0.z + kf[3] * q0.w + kf[4] * q1.x + kf[5] * q1.y + kf[6] * q1.z + kf[7] * q1.w; }
            }
            float score = 0.f;
#pragma unroll
            for (int h = 0; h < 16; ++h) score += fmaxf(dot[h], 0.f) * __shfl(wv, h);
            scl[s] = score;
        }
        WAVE_SYNC();
        unsigned key[32];
#pragma unroll
        for (int j = 0; j < 32; ++j) { const int s = lane + 64 * j; key[j] = (s <= t) ? fkey(scl[s]) : 0u; }
        unsigned thr = 0u;
        if (t + 1 > 256) {
            for (int bit = 31; bit >= 0; --bit) {
                const unsigned cand = thr | (1u << bit);
                int cnt = 0;
#pragma unroll
                for (int j = 0; j < 32; ++j) cnt += __popcll(__ballot(key[j] >= cand));
                if (cnt >= 256) thr = cand;
            }
        }
        unsigned w = 0u;
#pragma unroll
        for (int j = 0; j < 32; ++j) { const int s = lane + 64 * j; const unsigned long long m = __ballot(s <= t && key[j] >= thr);
            if (lane == 2 * j) w = (unsigned)m; if (lane == 2 * j + 1) w = (unsigned)(m >> 32); }
        MASK[row * 64 + lane] = w;
        WAVE_SYNC();
    }
}

__device__ __forceinline__ int t5_bucket(int d) {
    if (d < 16) return d;
    return 16 + (d >= 19) + (d >= 21) + (d >= 24) + (d >= 27) + (d >= 31) + (d >= 35) + (d >= 40) + (d >= 46) + (d >= 52) + (d >= 59) + (d >= 67) + (d >= 77) + (d >= 87) + (d >= 99) + (d >= 113);
}
__device__ __forceinline__ void ph6_attn(const Frame& F) {
    const Args& a = *F.a;
    const int gw = F.bid * 8 + F.wave, NGW = F.G * 8, lane = F.lane;
    float* q = (float*)(F.lds + F.wave * 16384);
    float* pl = q + 2048;
    unsigned short* list = (unsigned short*)(pl + 512);
    const bf16* AQ = F.slot(4); const bf16* KH = F.slot(1); const bf16* VH = F.slot(2); bf16* AO = F.slot(3);
    const unsigned* MASK = (const unsigned*)(F.ws + WS_MASK);
    const float* relb = a.in[10];
    for (int idx = gw; idx < T; idx += NGW) {
        const int b = idx >> 11, tt = idx & 2047, t = (b & 1) ? 2047 - tt : tt;
        const size_t row = (size_t)b * 2048 + t;
        unsigned w = MASK[row * 64 + lane];
        const int cnt = __popc(w);
        int incl = cnt;
#pragma unroll
        for (int o = 1; o < 64; o <<= 1) { const int n = __shfl_up(incl, o); if (lane >= o) incl += n; }
        const int total = __shfl(incl, 63);
        int pos = incl - cnt;
        while (w) { const int bit = __ffs(w) - 1; w &= w - 1; if (pos < 512) list[pos] = (unsigned short)(32 * lane + bit); ++pos; }
        const int nsel = total < 512 ? total : 512;
#pragma unroll
        for (int i = 0; i < 4; ++i) { const u32x4 ww = *(const u32x4*)(AQ + row * 2048 + 512 * i + 8 * lane); float f[8]; unpack8(ww, f);
#pragma unroll
            for (int j = 0; j < 8; ++j) q[512 * i + 8 * lane + j] = f[j]; }
        WAVE_SYNC();
        for (int h = 0; h < 16; ++h) {
            float lmax = -INFINITY;
            for (int e = lane; e < nsel; e += 64) {
                const int s = list[e];
                const bf16* kr = KH + ((size_t)b * 2048 + s) * 2048 + h * 128;
                float dot = 0.f;
#pragma unroll 4
                for (int c = 0; c < 16; ++c) { float kf[8]; unpack8(*(const u32x4*)(kr + 8 * c), kf);
                    const f32x4 q0 = *(const f32x4*)(q + h * 128 + 8 * c), q1 = *(const f32x4*)(q + h * 128 + 8 * c + 4);
                    dot += kf[0] * q0.x + kf[1] * q0.y + kf[2] * q0.z + kf[3] * q0.w + kf[4] * q1.x + kf[5] * q1.y + kf[6] * q1.z + kf[7] * q1.w; }
                const float lg = dot * 0.08838834764831845f + relb[t5_bucket(t - s) * 16 + h];
                pl[e] = lg; lmax = fmaxf(lmax, lg);
            }
            lmax = wave_max(lmax);
            float lsum = 0.f;
            for (int e = lane; e < nsel; e += 64) { const float p = expf(pl[e] - lmax); pl[e] = p; lsum += p; }
            lsum = wave_sum(lsum);
            WAVE_SYNC();
            float o0 = 0.f, o1 = 0.f;
            for (int e = 0; e < nsel; ++e) { const int s = list[e]; const float p = pl[e];
                const unsigned vv = *(const unsigned*)(VH + ((size_t)b * 2048 + s) * 2048 + h * 128 + 2 * lane);
                o0 += p * bflo(vv); o1 += p * bfhi(vv); }
            const float inv = 1.0f / lsum;
            *(unsigned*)(AO + row * 2048 + h * 128 + 2 * lane) = pk2(o0 * inv, o1 * inv);
            WAVE_SYNC();
        }
    }
}

__device__ __forceinline__ void ln_row(float* zrow, const float* g, const float* bta, bf16* brow, int lane) {
    f32x4 v[8]; float s = 0.f;
#pragma unroll
    for (int i = 0; i < 8; ++i) { v[i] = *(const f32x4*)(zrow + 256 * i + 4 * lane); s += (v[i].x + v[i].y) + (v[i].z + v[i].w); }
    const float mu = wave_sum(s) * (1.0f / 2048.0f); float s2 = 0.f;
#pragma unroll
    for (int i = 0; i < 8; ++i) { v[i] = v[i] - mu; s2 += (v[i].x * v[i].x + v[i].y * v[i].y) + (v[i].z * v[i].z + v[i].w * v[i].w); }
    const float r = rsqrtf(wave_sum(s2) * (1.0f / 2048.0f) + 1e-5f);
#pragma unroll
    for (int i = 0; i < 8; ++i) { const f32x4 gg = *(const f32x4*)(g + 256 * i + 4 * lane), bb = *(const f32x4*)(bta + 256 * i + 4 * lane);
        const f32x4 o = v[i] * r * gg + bb; *(f32x4*)(zrow + 256 * i + 4 * lane) = o;
        if (brow) { u32x2 w; w.x = pk2(o.x, o.y); w.y = pk2(o.z, o.w); *(u32x2*)(brow + 256 * i + 4 * lane) = w; } }
}
__device__ __forceinline__ void ph_ln(const Frame& F, const float* g, const float* bta, bf16* bout) {
    const int gw = F.bid * 8 + F.wave, NGW = F.G * 8;
    for (int row = gw; row < T; row += NGW) ln_row(F.a->out + (size_t)row * 2048, g, bta, bout + (size_t)row * 2048, F.lane);
}

__device__ __forceinline__ void ph11_xattn(const Frame& F) {
    const int gw = F.bid * 8 + F.wave, NGW = F.G * 8, lane = F.lane;
    float* q = (float*)(F.lds + F.wave * 16384);
    float* pl = q + 512;
    const bf16* CQ = F.slot(1); const bf16* CK = (const bf16*)(F.ws + WS_CKV); const bf16* CV = (const bf16*)(F.ws + WS_IKW); bf16* CO = F.slot(4);
    for (int u = gw; u < T * 4; u += NGW) {
        const int row = u >> 2, h = u & 3, b = row >> 11;
        { float f[8]; unpack8(*(const u32x4*)(CQ + (size_t)row * 2048 + h * 512 + 8 * lane), f);
#pragma unroll
          for (int j = 0; j < 8; ++j) q[8 * lane + j] = f[j]; }
        WAVE_SYNC();
        float lg[4]; float lmax = -INFINITY;
#pragma unroll
        for (int i = 0; i < 4; ++i) { const int s = lane + 64 * i; const bf16* kr = CK + ((size_t)b * 256 + s) * 2048 + h * 512; float dot = 0.f;
#pragma unroll 4
            for (int c = 0; c < 64; ++c) { float kf[8]; unpack8(*(const u32x4*)(kr + 8 * c), kf);
                const f32x4 q0 = *(const f32x4*)(q + 8 * c), q1 = *(const f32x4*)(q + 8 * c + 4);
                dot += kf[0] * q0.x + kf[1] * q0.y + kf[2] * q0.z + kf[3] * q0.w + kf[4] * q1.x + kf[5] * q1.y + kf[6] * q1.z + kf[7] * q1.w; }
            lg[i] = dot * 0.04419417382415922f; lmax = fmaxf(lmax, lg[i]); }
        lmax = wave_max(lmax);
        float lsum = 0.f;
#pragma unroll
        for (int i = 0; i < 4; ++i) { const float p = expf(lg[i] - lmax); pl[lane + 64 * i] = p; lsum += p; }
        lsum = wave_sum(lsum);
        WAVE_SYNC();
        float o[8];
#pragma unroll
        for (int j = 0; j < 8; ++j) o[j] = 0.f;
        for (int s = 0; s < 256; ++s) { const float p = pl[s]; float vf[8]; unpack8(*(const u32x4*)(CV + ((size_t)b * 256 + s) * 2048 + h * 512 + 8 * lane), vf);
#pragma unroll
            for (int j = 0; j < 8; ++j) o[j] += p * vf[j]; }
        const float inv = 1.0f / lsum;
        u32x4 w; w.x = pk2(o[0] * inv, o[1] * inv); w.y = pk2(o[2] * inv, o[3] * inv); w.z = pk2(o[4] * inv, o[5] * inv); w.w = pk2(o[6] * inv, o[7] * inv);
        *(u32x4*)(CO + (size_t)row * 2048 + h * 512 + 8 * lane) = w;
        WAVE_SYNC();
    }
}

__device__ __forceinline__ void ph15_peer_select(const Frame& F) {
    const Args& a = *F.a;
    const int gw = F.bid * 8 + F.wave, NGW = F.G * 8, lane = F.lane;
    float* q = (float*)(F.lds + F.wave * 16384);
    const float* PQ = (const float*)F.slot(1);
    const float* keys = a.in[23];
    int* EIDX = (int*)(F.ws + WS_CKV); float* EG = (float*)(F.ws + WS_IKW);
    for (int t = gw; t < T; t += NGW) {
#pragma unroll
        for (int i = 0; i < 8; ++i) *(f32x4*)(q + 256 * i + 4 * lane) = *(const f32x4*)(PQ + (size_t)t * 2048 + 256 * i + 4 * lane);
        WAVE_SYNC();
        for (int h = 0; h < 8; ++h) {
            float tv[2]; int ti[2];
#pragma unroll
            for (int p = 0; p < 2; ++p) {
                const float* qq = q + h * 256 + p * 128;
                const float* k0 = keys + ((size_t)(h * 2 + p) * 128 + lane) * 128; const float* k1 = k0 + 64 * 128;
                float v0 = 0.f, v1 = 0.f;
#pragma unroll 4
                for (int d = 0; d < 128; d += 4) { const f32x4 qv = *(const f32x4*)(qq + d), a0 = *(const f32x4*)(k0 + d), a1 = *(const f32x4*)(k1 + d);
                    v0 += qv.x * a0.x + qv.y * a0.y + qv.z * a0.z + qv.w * a0.w; v1 += qv.x * a1.x + qv.y * a1.y + qv.z * a1.z + qv.w * a1.w; }
                float mv = 0.f; int mi = 0;
                for (int k = 0; k < 16; ++k) {
                    const float m = wave_max(fmaxf(v0, v1));
                    const unsigned long long b0 = __ballot(v0 == m);
                    int nidx;
                    if (b0) { const int src = __ffsll((long long)b0) - 1; nidx = src; if (lane == src) v0 = -INFINITY; }
                    else { const unsigned long long b1 = __ballot(v1 == m); const int src = __ffsll((long long)b1) - 1; nidx = src + 64; if (lane == src) v1 = -INFINITY; }
                    if (lane == k) { mv = m; mi = nidx; }
                }
                tv[p] = mv; ti[p] = mi;
            }
            float cand[4];
#pragma unroll
            for (int m4 = 0; m4 < 4; ++m4) { const int c = lane + 64 * m4; cand[m4] = __shfl(tv[0], c >> 4) + __shfl(tv[1], c & 15); }
            float sv = -INFINITY; int sc = 0;
            for (int k = 0; k < 16; ++k) {
                const float m = wave_max(fmaxf(fmaxf(cand[0], cand[1]), fmaxf(cand[2], cand[3])));
                int c = -1;
#pragma unroll
                for (int m4 = 0; m4 < 4; ++m4) { if (c < 0) { const unsigned long long bm = __ballot(cand[m4] == m); if (bm) { const int src = __ffsll((long long)bm) - 1; c = src + 64 * m4; if (lane == src) cand[m4] = -INFINITY; } } }
                if (lane == k) { sv = m; sc = c; }
            }
            const float mx = __shfl(sv, 0);
            const float e = lane < 16 ? expf(sv - mx) : 0.f;
            const float den = wave_sum(e);
            const int i1 = __shfl(ti[0], sc >> 4), i2 = __shfl(ti[1], sc & 15);
            if (lane < 16) { EIDX[(size_t)t * 128 + h * 16 + lane] = i1 * 128 + i2; EG[(size_t)t * 128 + h * 16 + lane] = e / den; }
        }
        WAVE_SYNC();
    }
}

__device__ __forceinline__ void ph16_experts(const Frame& F) {
    const Args& a = *F.a;
    const int gw = F.bid * 8 + F.wave, NGW = F.G * 8, lane = F.lane;
    const int* EIDX = (const int*)(F.ws + WS_CKV); const float* EG = (const float*)(F.ws + WS_IKW);
    const float* PU = a.in[24]; const float* PV = a.in[25];
    for (int t = gw; t < T; t += NGW) {
        float* xrow = a.out + (size_t)t * 2048;
        f32x4 x[8];
#pragma unroll
        for (int i = 0; i < 8; ++i) x[i] = *(const f32x4*)(xrow + 256 * i + 4 * lane);
        const int id0 = EIDX[(size_t)t * 128 + lane], id1 = EIDX[(size_t)t * 128 + 64 + lane];
        const float g0 = EG[(size_t)t * 128 + lane], g1 = EG[(size_t)t * 128 + 64 + lane];
        float c0 = 0.f, c1 = 0.f;
        for (int e = 0; e < 128; ++e) {
            const int id = (e < 64) ? __builtin_amdgcn_readlane(id0, e & 63) : __builtin_amdgcn_readlane(id1, e & 63);
            const float* ur = PU + (size_t)id * 2048;
            float d = 0.f;
#pragma unroll
            for (int i = 0; i < 8; ++i) { const f32x4 u = *(const f32x4*)(ur + 256 * i + 4 * lane); d += (x[i].x * u.x + x[i].y * u.y) + (x[i].z * u.z + x[i].w * u.w); }
            d = wave_sum(d);
            const float hv = 0.5f * d * (1.0f + erff(d * 0.7071067811865476f));
            if (e < 64) { if (lane == e) c0 = g0 * hv; } else { if (lane == e - 64) c1 = g1 * hv; }
        }
        f32x4 y[8];
#pragma unroll
        for (int i = 0; i < 8; ++i) y[i] = (f32x4){0.f, 0.f, 0.f, 0.f};
        for (int e = 0; e < 128; ++e) {
            const int id = (e < 64) ? __builtin_amdgcn_readlane(id0, e & 63) : __builtin_amdgcn_readlane(id1, e & 63);
            const float c = __int_as_float((e < 64) ? __builtin_amdgcn_readlane(__float_as_int(c0), e & 63) : __builtin_amdgcn_readlane(__float_as_int(c1), e & 63));
            const float* vr = PV + (size_t)id * 2048;
#pragma unroll
            for (int i = 0; i < 8; ++i) { const f32x4 v = *(const f32x4*)(vr + 256 * i + 4 * lane); y[i] = y[i] + c * v; }
        }
#pragma unroll
        for (int i = 0; i < 8; ++i) *(f32x4*)(xrow + 256 * i + 4 * lane) = ALPHA * x[i] + y[i];
        ln_row(xrow, a.in[26], a.in[27], nullptr, lane);
    }
}

__global__ void __launch_bounds__(512, 2) mega(Args args) {
    extern __shared__ __attribute__((aligned(16))) unsigned char lds[];
    cg::grid_group grid = cg::this_grid();
    Frame F;
    F.lds = lds; F.tid = threadIdx.x; F.lane = F.tid & 63; F.wave = __builtin_amdgcn_readfirstlane(F.tid >> 6); F.bid = blockIdx.x; F.G = gridDim.x;
    F.a = &args; F.ws = args.ws;
    const int lo = args.ph_lo, hi = args.ph_hi;
    bf16* W8 = (bf16*)(F.ws + WS_WIN);
#define IN(k) (lo <= (k) && (k) < hi)
#define SEAM(k) do { if (IN(k) && IN((k) + 1)) grid.sync(); } while (0)
    if (IN(0)) { ph0_prologue(F); } SEAM(0);
    if (IN(1)) { gemm_simple(F, (const bf16*)args.out, 2048, (const bf16*)(F.ws + WS_WIN), 2048, T, NCOLS, 2048, EpiProj{F.ws}); } SEAM(1);
    if (IN(2)) {
        for (int u = F.bid; u < 128; u += F.G) hgrn_naive(F, u);
        if (F.G > 128) { if (F.bid >= 128) ph2_side(F, F.bid - 128, F.G - 128); } else ph2_side(F, F.bid, F.G);
    } SEAM(2);
    if (IN(3)) { ph3_hgnorm(F); } SEAM(3);
    if (IN(4)) {
        gemm_simple(F, F.slot(0), 2048, W8, 2048, T, 2048, 2048, EpiYA{F.slot(6)});
        gemm_simple(F, (const bf16*)(F.ws + WS_CKV), 256, (const bf16*)(F.ws + WS_WKV), 256, T, 4096, 256, EpiKV{F.slot(1), F.slot(2)});
    } SEAM(4);
    if (IN(5)) { ph5_select(F); } SEAM(5);
    if (IN(6)) { ph6_attn(F); } SEAM(6);
    if (IN(7)) { gemm_simple(F, F.slot(3), 2048, W8 + (size_t)1 * 2048 * 2048, 2048, T, 2048, 2048, EpiYB{F.slot(6), F.slot(7)}); } SEAM(7);
    if (IN(8)) { gemm_simple(F, F.slot(6), 2048, W8 + (size_t)2 * 2048 * 2048, 2048, T, 2048, 2048, EpiMix{args.in[0], args.out}); } SEAM(8);
    if (IN(9)) { ph_ln(F, args.in[14], args.in[15], F.slot(0)); } SEAM(9);
    if (IN(10)) {
        gemm_simple(F, F.slot(0), 2048, W8 + (size_t)3 * 2048 * 2048, 2048, T, 2048, 2048, EpiBf16{F.slot(1), 2048});
        gemm_simple(F, (const bf16*)(F.ws + WS_MEMB), 2048, W8 + (size_t)4 * 2048 * 2048, 2048, 2048, 2048, 2048, EpiBf16{(bf16*)(F.ws + WS_CKV), 2048});
        gemm_simple(F, (const bf16*)(F.ws + WS_MEMB), 2048, W8 + (size_t)5 * 2048 * 2048, 2048, 2048, 2048, 2048, EpiBf16{(bf16*)(F.ws + WS_IKW), 2048});
    } SEAM(10);
    if (IN(11)) { ph11_xattn(F); } SEAM(11);
    if (IN(12)) { gemm_simple(F, F.slot(4), 2048, W8 + (size_t)6 * 2048 * 2048, 2048, T, 2048, 2048, EpiRes{args.out}); } SEAM(12);
    if (IN(13)) { ph_ln(F, args.in[20], args.in[21], F.slot(0)); } SEAM(13);
    if (IN(14)) { gemm_simple(F, F.slot(0), 2048, W8 + (size_t)7 * 2048 * 2048, 2048, T, 2048, 2048, EpiF32{(float*)F.slot(1), 2048}); } SEAM(14);
    if (IN(15)) { ph15_peer_select(F); } SEAM(15);
    if (IN(16)) { ph16_experts(F); }
#undef IN
#undef SEAM
}

extern "C" void kernel_launch(void* const* d_in, const int* in_sizes, int n_in, void* d_out, int out_size, void* d_ws, size_t ws_size, hipStream_t stream) {
    static int grid = 0;
    if (grid == 0) {
        if (n_in != 28 || out_size != T * D || ws_size < WS_END) { fprintf(stderr, "kernel_launch: unexpected shapes (n_in %d out %d ws %zu)\n", n_in, out_size, ws_size); grid = -1; return; }
        int dev = 0, cus = 0, per_cu = 0;
        hipGetDevice(&dev); hipDeviceGetAttribute(&cus, hipDeviceAttributeMultiprocessorCount, dev);
        hipFuncSetAttribute((const void*)mega, hipFuncAttributeMaxDynamicSharedMemorySize, LDS_BYTES);
        hipOccupancyMaxActiveBlocksPerMultiprocessor(&per_cu, (const void*)mega, 512, LDS_BYTES);
        if (per_cu < 1) { fprintf(stderr, "kernel_launch: occupancy query says %d blocks per CU\n", per_cu); per_cu = 1; }
        (void)hipGetLastError();
        grid = cus;
    }
    if (grid < 0) return;
    Args a{};
    for (int i = 0; i < 28; ++i) a.in[i] = (const float*)d_in[i];
    a.out = (float*)d_out; a.ws = (unsigned char*)d_ws;
#if ONE_LAUNCH
    a.ph_lo = 0; a.ph_hi = NPH;
    void* params[] = {&a};
    hipError_t e = hipLaunchCooperativeKernel((const void*)mega, dim3(grid), dim3(512), params, LDS_BYTES, stream);
    if (e != hipSuccess) fprintf(stderr, "cooperative launch failed: %s\n", hipGetErrorString(e));
#else
    for (int ph = 0; ph < NPH; ++ph) {
        a.ph_lo = ph; a.ph_hi = ph + 1;
        void* params[] = {&a};
        hipError_t e = hipLaunchCooperativeKernel((const void*)mega, dim3(grid), dim3(512), params, LDS_BYTES, stream);
        if (e != hipSuccess) { fprintf(stderr, "launch %d failed: %s\n", ph, hipGetErrorString(e)); break; }
    }
#endif
}
```

```cpp
#include <hip/hip_runtime.h>
#include <hip/hip_cooperative_groups.h>
#include <cstdint>
#include <cmath>
#include <cstdio>
namespace cg = cooperative_groups;

#ifndef ONE_LAUNCH
#define ONE_LAUNCH 1
#endif

typedef unsigned short bf16;
typedef short bf16x8 __attribute__((ext_vector_type(8)));
typedef float f32x4 __attribute__((ext_vector_type(4)));
typedef float f32x16 __attribute__((ext_vector_type(16)));
typedef unsigned u32x4 __attribute__((ext_vector_type(4)));
typedef unsigned u32x2 __attribute__((ext_vector_type(2)));

constexpr int T = 16384, D = 2048, SEQ = 2048, NB = 8;
constexpr int NCOLS = 16896;
constexpr float ALPHA = 1.189207115002721f;
constexpr int NPH = 17;

constexpr size_t MiB = 1u << 20;
constexpr size_t WS_CTL = 0, WS_MEMB = 1 * MiB, WS_WKV = 9 * MiB, WS_LB = 11 * MiB, WS_MASK = 12 * MiB, WS_WIN = 17 * MiB,
                 WS_SLOT = 83 * MiB, SLOT_BYTES = 64 * MiB, WS_CKV = 595 * MiB, WS_IKW = 603 * MiB, WS_END = 611 * MiB;
constexpr int LDS_BYTES = 147456;

struct Args {
    const float* in[28];
    float* out;
    unsigned char* ws;
    int ph_lo, ph_hi;
};

#define WAVE_SYNC() asm volatile("s_waitcnt lgkmcnt(0)" ::: "memory")

__device__ __forceinline__ unsigned f2bf(float f) { unsigned u = __float_as_uint(f); return (u + 0x7fffu + ((u >> 16) & 1u)) >> 16; }
__device__ __forceinline__ unsigned pk2(float lo, float hi) { return f2bf(lo) | (f2bf(hi) << 16); }
__device__ __forceinline__ float bf2f(unsigned h) { return __uint_as_float(h << 16); }
__device__ __forceinline__ float bflo(unsigned w) { return __uint_as_float(w << 16); }
__device__ __forceinline__ float bfhi(unsigned w) { return __uint_as_float(w & 0xffff0000u); }
__device__ __forceinline__ float wave_sum(float v) {
#pragma unroll
    for (int o = 32; o >= 1; o >>= 1) v += __shfl_xor(v, o);
    return v;
}
__device__ __forceinline__ float wave_max(float v) {
#pragma unroll
    for (int o = 32; o >= 1; o >>= 1) v = fmaxf(v, __shfl_xor(v, o));
    return v;
}
__device__ __forceinline__ float sigm(float x) { return 1.0f / (1.0f + expf(-x)); }
__device__ __forceinline__ void unpack8(u32x4 w, float* f) {
    f[0] = bflo(w.x); f[1] = bfhi(w.x); f[2] = bflo(w.y); f[3] = bfhi(w.y); f[4] = bflo(w.z); f[5] = bfhi(w.z); f[6] = bflo(w.w); f[7] = bfhi(w.w);
}

struct Frame {
    unsigned char* lds;
    int tid, lane, wave, bid, G;
    const Args* a;
    unsigned char* ws;
    __device__ __forceinline__ bf16* slot(int i) const { return (bf16*)(ws + WS_SLOT + (size_t)i * SLOT_BYTES); }
};

template <class Epi>
__device__ __forceinline__ void gemm_simple(const Frame& F, const bf16* A, int lda, const bf16* Bt, int ldb, int M, int N, int K, const Epi& epi) {
    const int ntn = N / 128, nunits = (M / 256) * ntn;
    const int wm = F.wave >> 1, wn = F.wave & 1, l31 = F.lane & 31, hi = F.lane >> 5;
    for (int unit = F.bid; unit < nunits; unit += F.G) {
        const int tm = unit / ntn, tn = unit % ntn;
        const int row0 = tm * 256 + wm * 64, col0 = tn * 128 + wn * 64;
        f32x16 acc[2][2];
#pragma unroll
        for (int i = 0; i < 2; ++i)
#pragma unroll
            for (int j = 0; j < 2; ++j)
#pragma unroll
                for (int r = 0; r < 16; ++r) acc[i][j][r] = 0.f;
        const bf16* ap0 = A + (size_t)(row0 + l31) * lda + 8 * hi;
        const bf16* ap1 = ap0 + (size_t)32 * lda;
        const bf16* bp0 = Bt + (size_t)(col0 + l31) * ldb + 8 * hi;
        const bf16* bp1 = bp0 + (size_t)32 * ldb;
#pragma unroll 2
        for (int k0 = 0; k0 < K; k0 += 16) {
            const bf16x8 a0 = *(const bf16x8*)(ap0 + k0), a1 = *(const bf16x8*)(ap1 + k0);
            const bf16x8 b0 = *(const bf16x8*)(bp0 + k0), b1 = *(const bf16x8*)(bp1 + k0);
            acc[0][0] = __builtin_amdgcn_mfma_f32_32x32x16_bf16(a0, b0, acc[0][0], 0, 0, 0);
            acc[0][1] = __builtin_amdgcn_mfma_f32_32x32x16_bf16(a0, b1, acc[0][1], 0, 0, 0);
            acc[1][0] = __builtin_amdgcn_mfma_f32_32x32x16_bf16(a1, b0, acc[1][0], 0, 0, 0);
            acc[1][1] = __builtin_amdgcn_mfma_f32_32x32x16_bf16(a1, b1, acc[1][1], 0, 0, 0);
        }
#pragma unroll
        for (int i = 0; i < 2; ++i)
#pragma unroll
            for (int j = 0; j < 2; ++j)
#pragma unroll
                for (int r = 0; r < 16; ++r) {
                    const int row = row0 + 32 * i + (r & 3) + 8 * (r >> 2) + 4 * hi, col = col0 + 32 * j + l31;
                    epi(row, col, acc[i][j][r]);
                }
    }
}

struct EpiProj { unsigned char* ws;
    __device__ __forceinline__ void operator()(int row, int col, float v) const {
        if (col < 16384) { bf16* s = (bf16*)(ws + WS_SLOT + (size_t)(col >> 11) * SLOT_BYTES); s[(size_t)row * 2048 + (col & 2047)] = (bf16)f2bf(v); }
        else if (col < 16640) ((bf16*)(ws + WS_CKV))[(size_t)row * 256 + (col - 16384)] = (bf16)f2bf(v);
        else ((bf16*)(ws + WS_IKW))[(size_t)row * 256 + (col - 16640)] = (bf16)f2bf(v);
    } };
struct EpiBf16 { bf16* o; int ld;
    __device__ __forceinline__ void operator()(int row, int col, float v) const { o[(size_t)row * ld + col] = (bf16)f2bf(v); } };
struct EpiF32 { float* o; int ld;
    __device__ __forceinline__ void operator()(int row, int col, float v) const { o[(size_t)row * ld + col] = v; } };
struct EpiYA { bf16* ga;
    __device__ __forceinline__ void operator()(int row, int col, float v) const { bf16* p = ga + (size_t)row * 2048 + col; *p = (bf16)f2bf(sigm(bf2f(*p)) * v); } };
struct EpiKV { bf16* kh; bf16* vh;
    __device__ __forceinline__ void operator()(int row, int col, float v) const { if (col < 2048) kh[(size_t)row * 2048 + col] = (bf16)f2bf(v); else vh[(size_t)row * 2048 + col - 2048] = (bf16)f2bf(v); } };
struct EpiYB { bf16* ga; const bf16* gb;
    __device__ __forceinline__ void operator()(int row, int col, float v) const { const size_t i = (size_t)row * 2048 + col; ga[i] = (bf16)f2bf(bf2f(ga[i]) + sigm(bf2f(gb[i])) * v); } };
struct EpiMix { const float* x; float* z;
    __device__ __forceinline__ void operator()(int row, int col, float v) const { const size_t i = (size_t)row * 2048 + col; z[i] = ALPHA * x[i] + v; } };
struct EpiRes { float* z;
    __device__ __forceinline__ void operator()(int row, int col, float v) const { const size_t i = (size_t)row * 2048 + col; z[i] = ALPHA * z[i] + v; } };

template <class CM>
__device__ __forceinline__ void transpose_item(const float* W, size_t ldw, bf16* WT, size_t ldwt, int row_off, int nblk, int item, float* scr, int lane, const CM& cm) {
    const int kb = item / nblk, nb = item % nblk, k0 = 64 * kb, n0 = 32 * nb;
    const int c = cm(n0 + (lane & 31));
#pragma unroll 8
    for (int i = 0; i < 32; ++i) { const int kk = 2 * i + (lane >> 5); scr[kk * 33 + (lane & 31)] = (c >= 0) ? W[(size_t)(k0 + kk) * ldw + c] : 0.f; }
    WAVE_SYNC();
    const int c8 = lane & 7;
#pragma unroll
    for (int j = 0; j < 4; ++j) { const int n = (lane >> 3) + 8 * j; const float* s = scr + (8 * c8) * 33 + n;
        u32x4 o; o.x = pk2(s[0 * 33], s[1 * 33]); o.y = pk2(s[2 * 33], s[3 * 33]); o.z = pk2(s[4 * 33], s[5 * 33]); o.w = pk2(s[6 * 33], s[7 * 33]);
        *(u32x4*)(WT + (size_t)(row_off + n0 + n) * ldwt + k0 + 8 * c8) = o; }
    WAVE_SYNC();
}
struct CmIdent { __device__ __forceinline__ int operator()(int n) const { return n; } };
struct CmWin { __device__ __forceinline__ int operator()(int n) const {
    if (n < 10240) return n;
    if (n < 12288) return 10496 + (n - 10240);
    if (n < 14336) return 12688 + (n - 12288);
    if (n < 16384) return 14736 + (n - 14336);
    if (n < 16640) return 10240 + (n - 16384);
    if (n < 16768) return 12544 + (n - 16640);
    if (n < 16784) return 12672 + (n - 16768);
    return -1; } };

__device__ __forceinline__ void cvt_bf16_stream(const Frame& F, const float* src, bf16* dst, size_t n8) {
    const size_t gt = (size_t)F.bid * 512 + F.tid, NT = (size_t)F.G * 512;
    for (size_t i = gt; i < n8; i += NT) { const f32x4 a = ((const f32x4*)src)[2 * i], b = ((const f32x4*)src)[2 * i + 1];
        u32x4 o; o.x = pk2(a.x, a.y); o.y = pk2(a.z, a.w); o.z = pk2(b.x, b.y); o.w = pk2(b.z, b.w); ((u32x4*)dst)[i] = o; }
}

__device__ __forceinline__ void ph0_prologue(const Frame& F) {
    const Args& a = *F.a;
    cvt_bf16_stream(F, a.in[0], (bf16*)a.out, (size_t)T * D / 8);
    cvt_bf16_stream(F, a.in[1], (bf16*)(F.ws + WS_MEMB), (size_t)2048 * 2048 / 8);
    float* scr = (float*)(F.lds + F.wave * 16384);
    const int gw = F.bid * 8 + F.wave, NGW = F.G * 8;
    {
        const int nblk = NCOLS / 32, nitems = (2048 / 64) * nblk;
        for (int it = gw; it < nitems; it += NGW) transpose_item(a.in[2], 16784, (bf16*)(F.ws + WS_WIN), 2048, 0, nblk, it, scr, F.lane, CmWin());
    }
    {
        for (int it = gw; it < 32 * 16; it += NGW) { const int mat = it >> 4, which = mat >> 4, h = mat & 15;
            transpose_item(a.in[which ? 9 : 8] + (size_t)h * 256 * 128, 128, (bf16*)(F.ws + WS_WKV), 256, which * 2048 + h * 128, 4, it & 15, scr, F.lane, CmIdent()); }
    }
    {
        const int gt = F.bid * 512 + F.tid;
        if (gt < 2048) { const float l0 = a.in[3][gt], l1 = a.in[3][2048 + gt]; ((float*)(F.ws + WS_LB))[gt] = 1.0f / (1.0f + expf(l1 - l0)); }
    }
}

__device__ __forceinline__ void hgrn_naive(const Frame& F, int unit) {
    const int b = unit >> 4, h = unit & 15, tid = F.tid;
    float* qs = (float*)F.lds; float* fs = qs + 128; float* ks = fs + 128; float* part = ks + 128;
    const bf16* HQ = F.slot(0); const bf16* HF = F.slot(1); const bf16* HI = F.slot(2);
    float* oraw = F.a->out;
    const int dv = tid & 127, kq = tid >> 7;
    float S[32];
#pragma unroll
    for (int j = 0; j < 32; ++j) S[j] = 0.f;
    const float lb = ((const float*)(F.ws + WS_LB))[h * 128 + dv];
    const size_t base = (size_t)b * 2048 * 2048 + h * 128;
    unsigned short qn = HQ[base + dv], fn = HF[base + dv], vn = HI[base + dv];
    for (int t = 0; t < 2048; ++t) {
        const size_t off = base + (size_t)t * 2048;
        if (tid < 128) { const float f = lb + (1.0f - lb) * sigm(bf2f(fn)); qs[tid] = bf2f(qn); fs[tid] = f; ks[tid] = 1.0f - f; }
        const float v = bf2f(vn);
        if (t + 1 < 2048) { qn = HQ[off + 2048 + dv]; fn = HF[off + 2048 + dv]; vn = HI[off + 2048 + dv]; }
        __syncthreads();
        float acc = 0.f;
#pragma unroll
        for (int j = 0; j < 32; ++j) { const int dk = kq * 32 + j; S[j] = fs[dk] * S[j] + ks[dk] * v; acc += qs[dk] * S[j]; }
        part[kq * 128 + dv] = acc;
        __syncthreads();
        if (tid < 128) oraw[off + tid] = (part[tid] + part[128 + tid]) + (part[256 + tid] + part[384 + tid]);
    }
    __syncthreads();
}

__device__ __forceinline__ void ph2_side(const Frame& F, int sid, int nside) {
    const Args& a = *F.a;
    const int gw = sid * 8 + F.wave, NGW = nside * 8, lane = F.lane;
    bf16* CKV = (bf16*)(F.ws + WS_CKV); bf16* IKW = (bf16*)(F.ws + WS_IKW);
    for (int row = gw; row < T; row += NGW) {
        {   u32x2 w = *(u32x2*)(CKV + (size_t)row * 256 + 4 * lane);
            float x0 = bflo(w.x), x1 = bfhi(w.x), x2 = bflo(w.y), x3 = bfhi(w.y);
            const float ss = wave_sum(x0 * x0 + x1 * x1 + x2 * x2 + x3 * x3);
            const float r = rsqrtf(ss * (1.0f / 256.0f) + 1e-6f);
            const f32x4 g = *(const f32x4*)(a.in[5] + 4 * lane);
            w.x = pk2(x0 * r * g.x, x1 * r * g.y); w.y = pk2(x2 * r * g.z, x3 * r * g.w);
            *(u32x2*)(CKV + (size_t)row * 256 + 4 * lane) = w; }
        {   unsigned w = *(unsigned*)(IKW + (size_t)row * 256 + 2 * lane);
            float x0 = bflo(w), x1 = bfhi(w);
            const float mu = wave_sum(x0 + x1) * (1.0f / 128.0f);
            x0 -= mu; x1 -= mu;
            const float var = wave_sum(x0 * x0 + x1 * x1) * (1.0f / 128.0f);
            const float r = rsqrtf(var + 1e-5f);
            const float g0 = a.in[6][2 * lane], g1 = a.in[6][2 * lane + 1], b0 = a.in[7][2 * lane], b1 = a.in[7][2 * lane + 1];
            *(unsigned*)(IKW + (size_t)row * 256 + 2 * lane) = pk2(x0 * r * g0 + b0, x1 * r * g1 + b1); }
    }
    float* scr = (float*)(F.lds + F.wave * 16384);
    for (int it = gw; it < 8 * 2048; it += NGW) { const int m = it >> 11;
        const float* wsrc = m == 0 ? a.in[11] : m == 1 ? a.in[12] : m == 2 ? a.in[13] : m == 3 ? a.in[16] : m == 4 ? a.in[17] : m == 5 ? a.in[18] : m == 6 ? a.in[19] : a.in[22];
        transpose_item(wsrc, 2048, (bf16*)(F.ws + WS_WIN + (size_t)m * 8 * MiB), 2048, 0, 64, it & 2047, scr, lane, CmIdent()); }
}

__device__ __forceinline__ void ph3_hgnorm(const Frame& F) {
    const Args& a = *F.a;
    const int gw = F.bid * 8 + F.wave, NGW = F.G * 8, lane = F.lane;
    const float* oraw = a.out; const bf16* HG = F.slot(3); bf16* HO = F.slot(0);
    for (int u = gw; u < T * 16; u += NGW) {
        const size_t off = (size_t)(u >> 4) * 2048 + (u & 15) * 128 + 2 * lane;
        const float o0 = oraw[off], o1 = oraw[off + 1];
        const float r = rsqrtf(wave_sum(o0 * o0 + o1 * o1) * (1.0f / 128.0f) + 1e-6f);
        const unsigned gw2 = *(const unsigned*)(HG + off);
        const float g0 = bflo(gw2), g1 = bfhi(gw2);
        const int c = (u & 15) * 128 + 2 * lane;
        *(unsigned*)(HO + off) = pk2(o0 * r * a.in[4][c] * (g0 * sigm(g0)), o1 * r * a.in[4][c + 1] * (g1 * sigm(g1)));
    }
}

__device__ __forceinline__ unsigned fkey(float f) { const unsigned u = __float_as_uint(f); return (u & 0x80000000u) ? ~u : (u | 0x80000000u); }
__device__ __forceinline__ void ph5_select(const Frame& F) {
    const int gw = F.bid * 8 + F.wave, NGW = F.G * 8, lane = F.lane;
    float* iq = (float*)(F.lds + F.wave * 16384);
    float* scl = iq + 2048;
    const bf16* AIQ = F.slot(5); const bf16* IKW = (const bf16*)(F.ws + WS_IKW);
    unsigned* MASK = (unsigned*)(F.ws + WS_MASK);
    for (int idx = gw; idx < T; idx += NGW) {
        const int b = idx >> 11, tt = idx & 2047, t = (b & 1) ? 2047 - tt : tt;
        const size_t row = (size_t)b * 2048 + t;
        {
#pragma unroll
            for (int i = 0; i < 4; ++i) { const u32x4 w = *(const u32x4*)(AIQ + row * 2048 + 512 * i + 8 * lane); float f[8]; unpack8(w, f);
#pragma unroll
                for (int j = 0; j < 8; ++j) iq[512 * i + 8 * lane + j] = f[j]; }
        }
        float wv = 0.f;
        if (lane < 16) wv = bf2f(IKW[row * 256 + 128 + lane]) * (0.25f * 0.08838834764831845f);
        WAVE_SYNC();
        const int nj = (t >> 6) + 1;
        for (int j = 0; j < nj; ++j) {
            const int s = lane + 64 * j, sc = s <= t ? s : t;
            const bf16* kr = IKW + ((size_t)b * 2048 + sc) * 256;
            float dot[16];
#pragma unroll
            for (int h = 0; h < 16; ++h) dot[h] = 0.f;
            for (int c = 0; c < 16; ++c) {
                float kf[8]; unpack8(*(const u32x4*)(kr + 8 * c), kf);
#pragma unroll
                for (int h = 0; h < 16; ++h) { const f32x4 q0 = *(const f32x4*)(iq + h * 128 + 8 * c), q1 = *(const f32x4*)(iq + h * 128 + 8 * c + 4);
                    dot[h] += kf[0] * q0.x + kf[1] * q0.y + kf[2] * q0.z + kf[3] * q0.w + kf[4] * q1.x + kf[5] * q1.y + kf[6] * q1.z + kf[7] * q1.w; }
            }
            float score = 0.f;
#pragma unroll
            for (int h = 0; h < 16; ++h) score += fmaxf(dot[h], 0.f) * __shfl(wv, h);
            scl[s] = score;
        }
        WAVE_SYNC();
        unsigned key[32];
#pragma unroll
        for (int j = 0; j < 32; ++j) { const int s = lane + 64 * j; key[j] = (s <= t) ? fkey(scl[s]) : 0u; }
        unsigned thr = 0u;
        if (t + 1 > 256) {
            for (int bit = 31; bit >= 0; --bit) {
                const unsigned cand = thr | (1u << bit);
                int cnt = 0;
#pragma unroll
                for (int j = 0; j < 32; ++j) cnt += __popcll(__ballot(key[j] >= cand));
                if (cnt >= 256) thr = cand;
            }
        }
        unsigned w = 0u;
#pragma unroll
        for (int j = 0; j < 32; ++j) { const int s = lane + 64 * j; const unsigned long long m = __ballot(s <= t && key[j] >= thr);
            if (lane == 2 * j) w = (unsigned)m; if (lane == 2 * j + 1) w = (unsigned)(m >> 32); }
        MASK[row * 64 + lane] = w;
        WAVE_SYNC();
    }
}

__device__ __forceinline__ int t5_bucket(int d) {
    if (d < 16) return d;
    return 16 + (d >= 19) + (d >= 21) + (d >= 24) + (d >= 27) + (d >= 31) + (d >= 35) + (d >= 40) + (d >= 46) + (d >= 52) + (d >= 59) + (d >= 67) + (d >= 77) + (d >= 87) + (d >= 99) + (d >= 113);
}
__device__ __forceinline__ void ph6_attn(const Frame& F) {
    const Args& a = *F.a;
    const int gw = F.bid * 8 + F.wave, NGW = F.G * 8, lane = F.lane;
    float* q = (float*)(F.lds + F.wave * 16384);
    float* pl = q + 2048;
    unsigned short* list = (unsigned short*)(pl + 512);
    const bf16* AQ = F.slot(4); const bf16* KH = F.slot(1); const bf16* VH = F.slot(2); bf16* AO = F.slot(3);
    const unsigned* MASK = (const unsigned*)(F.ws + WS_MASK);
    const float* relb = a.in[10];
    for (int idx = gw; idx < T; idx += NGW) {
        const int b = idx >> 11, tt = idx & 2047, t = (b & 1) ? 2047 - tt : tt;
        const size_t row = (size_t)b * 2048 + t;
        unsigned w = MASK[row * 64 + lane];
        const int cnt = __popc(w);
        int incl = cnt;
#pragma unroll
        for (int o = 1; o < 64; o <<= 1) { const int n = __shfl_up(incl, o); if (lane >= o) incl += n; }
        const int total = __shfl(incl, 63);
        int pos = incl - cnt;
        while (w) { const int bit = __ffs(w) - 1; w &= w - 1; if (pos < 512) list[pos] = (unsigned short)(32 * lane + bit); ++pos; }
        const int nsel = total < 512 ? total : 512;
#pragma unroll
        for (int i = 0; i < 4; ++i) { const u32x4 ww = *(const u32x4*)(AQ + row * 2048 + 512 * i + 8 * lane); float f[8]; unpack8(ww, f);
#pragma unroll
            for (int j = 0; j < 8; ++j) q[512 * i + 8 * lane + j] = f[j]; }
        WAVE_SYNC();
        for (int h = 0; h < 16; ++h) {
            float lmax = -INFINITY;
            for (int e = lane; e < nsel; e += 64) {
                const int s = list[e];
                const bf16* kr = KH + ((size_t)b * 2048 + s) * 2048 + h * 128;
                float dot = 0.f;
#pragma unroll 4
                for (int c = 0; c < 16; ++c) { float kf[8]; unpack8(*(const u32x4*)(kr + 8 * c), kf);
                    const f32x4 q0 = *(const f32x4*)(q + h * 128 + 8 * c), q1 = *(const f32x4*)(q + h * 128 + 8 * c + 4);
                    dot += kf[0] * q0.x + kf[1] * q0.y + kf[2] * q0.z + kf[3] * q0.w + kf[4] * q1.x + kf[5] * q1.y + kf[6] * q1.z + kf[7] * q1.w; }
                const float lg = dot * 0.08838834764831845f + relb[t5_bucket(t - s) * 16 + h];
                pl[e] = lg; lmax = fmaxf(lmax, lg);
            }
            lmax = wave_max(lmax);
            float lsum = 0.f;
            for (int e = lane; e < nsel; e += 64) { const float p = expf(pl[e] - lmax); pl[e] = p; lsum += p; }
            lsum = wave_sum(lsum);
            WAVE_SYNC();
            float o0 = 0.f, o1 = 0.f;
            for (int e = 0; e < nsel; ++e) { const int s = list[e]; const float p = pl[e];
                const unsigned vv = *(const unsigned*)(VH + ((size_t)b * 2048 + s) * 2048 + h * 128 + 2 * lane);
                o0 += p * bflo(vv); o1 += p * bfhi(vv); }
            const float inv = 1.0f / lsum;
            *(unsigned*)(AO + row * 2048 + h * 128 + 2 * lane) = pk2(o0 * inv, o1 * inv);
            WAVE_SYNC();
        }
    }
}

__device__ __forceinline__ void ln_row(float* zrow, const float* g, const float* bta, bf16* brow, int lane) {
    f32x4 v[8]; float s = 0.f;
#pragma unroll
    for (int i = 0; i < 8; ++i) { v[i] = *(const f32x4*)(zrow + 256 * i + 4 * lane); s += (v[i].x + v[i].y) + (v[i].z + v[i].w); }
    const float mu = wave_sum(s) * (1.0f / 2048.0f); float s2 = 0.f;
#pragma unroll
    for (int i = 0; i < 8; ++i) { v[i] = v[i] - mu; s2 += (v[i].x * v[i].x + v[i].y * v[i].y) + (v[i].z * v[i].z + v[i].w * v[i].w); }
    const float r = rsqrtf(wave_sum(s2) * (1.0f / 2048.0f) + 1e-5f);
#pragma unroll
    for (int i = 0; i < 8; ++i) { const f32x4 gg = *(const f32x4*)(g + 256 * i + 4 * lane), bb = *(const f32x4*)(bta + 256 * i + 4 * lane);
        const f32x4 o = v[i] * r * gg + bb; *(f32x4*)(zrow + 256 * i + 4 * lane) = o;
        if (brow) { u32x2 w; w.x = pk2(o.x, o.y); w.y = pk2(o.z, o.w); *(u32x2*)(brow + 256 * i + 4 * lane) = w; } }
}
__device__ __forceinline__ void ph_ln(const Frame& F, const float* g, const float* bta, bf16* bout) {
    const int gw = F.bid * 8 + F.wave, NGW = F.G * 8;
    for (int row = gw; row < T; row += NGW) ln_row(F.a->out + (size_t)row * 2048, g, bta, bout + (size_t)row * 2048, F.lane);
}

__device__ __forceinline__ void ph11_xattn(const Frame& F) {
    const int gw = F.bid * 8 + F.wave, NGW = F.G * 8, lane = F.lane;
    float* q = (float*)(F.lds + F.wave * 16384);
    float* pl = q + 512;
    const bf16* CQ = F.slot(1); const bf16* CK = (const bf16*)(F.ws + WS_CKV); const bf16* CV = (const bf16*)(F.ws + WS_IKW); bf16* CO = F.slot(4);
    for (int u = gw; u < T * 4; u += NGW) {
        const int row = u >> 2, h = u & 3, b = row >> 11;
        { float f[8]; unpack8(*(const u32x4*)(CQ + (size_t)row * 2048 + h * 512 + 8 * lane), f);
#pragma unroll
          for (int j = 0; j < 8; ++j) q[8 * lane + j] = f[j]; }
        WAVE_SYNC();
        float lg[4]; float lmax = -INFINITY;
#pragma unroll
        for (int i = 0; i < 4; ++i) { const int s = lane + 64 * i; const bf16* kr = CK + ((size_t)b * 256 + s) * 2048 + h * 512; float dot = 0.f;
#pragma unroll 4
            for (int c = 0; c < 64; ++c) { float kf[8]; unpack8(*(const u32x4*)(kr + 8 * c), kf);
                const f32x4 q0 = *(const f32x4*)(q + 8 * c), q1 = *(const f32x4*)(q + 8 * c + 4);
                dot += kf[0] * q0.x + kf[1] * q0.y + kf[2] * q0.z + kf[3] * q0.w + kf[4] * q1.x + kf[5] * q1.y + kf[6] * q1.z + kf[7] * q1.w; }
            lg[i] = dot * 0.04419417382415922f; lmax = fmaxf(lmax, lg[i]); }
        lmax = wave_max(lmax);
        float lsum = 0.f;
#pragma unroll
        for (int i = 0; i < 4; ++i) { const float p = expf(lg[i] - lmax); pl[lane + 64 * i] = p; lsum += p; }
        lsum = wave_sum(lsum);
        WAVE_SYNC();
        float o[8];
#pragma unroll
        for (int j = 0; j < 8; ++j) o[j] = 0.f;
        for (int s = 0; s < 256; ++s) { const float p = pl[s]; float vf[8]; unpack8(*(const u32x4*)(CV + ((size_t)b * 256 + s) * 2048 + h * 512 + 8 * lane), vf);
#pragma unroll
            for (int j = 0; j < 8; ++j) o[j] += p * vf[j]; }
        const float inv = 1.0f / lsum;
        u32x4 w; w.x = pk2(o[0] * inv, o[1] * inv); w.y = pk2(o[2] * inv, o[3] * inv); w.z = pk2(o[4] * inv, o[5] * inv); w.w = pk2(o[6] * inv, o[7] * inv);
        *(u32x4*)(CO + (size_t)row * 2048 + h * 512 + 8 * lane) = w;
        WAVE_SYNC();
    }
}

__device__ __forceinline__ void ph15_peer_select(const Frame& F) {
    const Args& a = *F.a;
    const int gw = F.bid * 8 + F.wave, NGW = F.G * 8, lane = F.lane;
    float* q = (float*)(F.lds + F.wave * 16384);
    const float* PQ = (const float*)F.slot(1);
    const float* keys = a.in[23];
    int* EIDX = (int*)(F.ws + WS_CKV); float* EG = (float*)(F.ws + WS_IKW);
    for (int t = gw; t < T; t += NGW) {
#pragma unroll
        for (int i = 0; i < 8; ++i) *(f32x4*)(q + 256 * i + 4 * lane) = *(const f32x4*)(PQ + (size_t)t * 2048 + 256 * i + 4 * lane);
        WAVE_SYNC();
        for (int h = 0; h < 8; ++h) {
            float tv[2]; int ti[2];
#pragma unroll
            for (int p = 0; p < 2; ++p) {
                const float* qq = q + h * 256 + p * 128;
                const float* k0 = keys + ((size_t)(h * 2 + p) * 128 + lane) * 128; const float* k1 = k0 + 64 * 128;
                float v0 = 0.f, v1 = 0.f;
#pragma unroll 4
                for (int d = 0; d < 128; d += 4) { const f32x4 qv = *(const f32x4*)(qq + d), a0 = *(const f32x4*)(k0 + d), a1 = *(const f32x4*)(k1 + d);
                    v0 += qv.x * a0.x + qv.y * a0.y + qv.z * a0.z + qv.w * a0.w; v1 += qv.x * a1.x + qv.y * a1.y + qv.z * a1.z + qv.w * a1.w; }
                float mv = 0.f; int mi = 0;
                for (int k = 0; k < 16; ++k) {
                    const float m = wave_max(fmaxf(v0, v1));
                    const unsigned long long b0 = __ballot(v0 == m);
                    int nidx;
                    if (b0) { const int src = __ffsll((long long)b0) - 1; nidx = src; if (lane == src) v0 = -INFINITY; }
                    else { const unsigned long long b1 = __ballot(v1 == m); const int src = __ffsll((long long)b1) - 1; nidx = src + 64; if (lane == src) v1 = -INFINITY; }
                    if (lane == k) { mv = m; mi = nidx; }
                }
                tv[p] = mv; ti[p] = mi;
            }
            float cand[4];
#pragma unroll
            for (int m4 = 0; m4 < 4; ++m4) { const int c = lane + 64 * m4; cand[m4] = __shfl(tv[0], c >> 4) + __shfl(tv[1], c & 15); }
            float sv = -INFINITY; int sc = 0;
            for (int k = 0; k < 16; ++k) {
                const float m = wave_max(fmaxf(fmaxf(cand[0], cand[1]), fmaxf(cand[2], cand[3])));
                int c = -1;
#pragma unroll
                for (int m4 = 0; m4 < 4; ++m4) { if (c < 0) { const unsigned long long bm = __ballot(cand[m4] == m); if (bm) { const int src = __ffsll((long long)bm) - 1; c = src + 64 * m4; if (lane == src) cand[m4] = -INFINITY; } } }
                if (lane == k) { sv = m; sc = c; }
            }
            const float mx = __shfl(sv, 0);
            const float e = lane < 16 ? expf(sv - mx) : 0.f;
            const float den = wave_sum(e);
            const int i1 = __shfl(ti[0], sc >> 4), i2 = __shfl(ti[1], sc & 15);
            if (lane < 16) { EIDX[(size_t)t * 128 + h * 16 + lane] = i1 * 128 + i2; EG[(size_t)t * 128 + h * 16 + lane] = e / den; }
        }
        WAVE_SYNC();
    }
}

__device__ __forceinline__ void ph16_experts(const Frame& F) {
    const Args& a = *F.a;
    const int gw = F.bid * 8 + F.wave, NGW = F.G * 8, lane = F.lane;
    const int* EIDX = (const int*)(F.ws + WS_CKV); const float* EG = (const float*)(F.ws + WS_IKW);
    const float* PU = a.in[24]; const float* PV = a.in[25];
    for (int t = gw; t < T; t += NGW) {
        float* xrow = a.out + (size_t)t * 2048;
        f32x4 x[8];
#pragma unroll
        for (int i = 0; i < 8; ++i) x[i] = *(const f32x4*)(xrow + 256 * i + 4 * lane);
        const int id0 = EIDX[(size_t)t * 128 + lane], id1 = EIDX[(size_t)t * 128 + 64 + lane];
        const float g0 = EG[(size_t)t * 128 + lane], g1 = EG[(size_t)t * 128 + 64 + lane];
        float c0 = 0.f, c1 = 0.f;
        for (int e = 0; e < 128; ++e) {
            const int id = (e < 64) ? __builtin_amdgcn_readlane(id0, e & 63) : __builtin_amdgcn_readlane(id1, e & 63);
            const float* ur = PU + (size_t)id * 2048;
            float d = 0.f;
#pragma unroll
            for (int i = 0; i < 8; ++i) { const f32x4 u = *(const f32x4*)(ur + 256 * i + 4 * lane); d += (x[i].x * u.x + x[i].y * u.y) + (x[i].z * u.z + x[i].w * u.w); }
            d = wave_sum(d);
            const float hv = 0.5f * d * (1.0f + erff(d * 0.7071067811865476f));
            if (e < 64) { if (lane == e) c0 = g0 * hv; } else { if (lane == e - 64) c1 = g1 * hv; }
        }
        f32x4 y[8];
#pragma unroll
        for (int i = 0; i < 8; ++i) y[i] = (f32x4){0.f, 0.f, 0.f, 0.f};
        for (int e = 0; e < 128; ++e) {
            const int id = (e < 64) ? __builtin_amdgcn_readlane(id0, e & 63) : __builtin_amdgcn_readlane(id1, e & 63);
            const float c = __int_as_float((e < 64) ? __builtin_amdgcn_readlane(__float_as_int(c0), e & 63) : __builtin_amdgcn_readlane(__float_as_int(c1), e & 63));
            const float* vr = PV + (size_t)id * 2048;
#pragma unroll
            for (int i = 0; i < 8; ++i) { const f32x4 v = *(const f32x4*)(vr + 256 * i + 4 * lane); y[i] = y[i] + c * v; }
        }
#pragma unroll
        for (int i = 0; i < 8; ++i) *(f32x4*)(xrow + 256 * i + 4 * lane) = ALPHA * x[i] + y[i];
        ln_row(xrow, a.in[26], a.in[27], nullptr, lane);
    }
}

__global__ void __launch_bounds__(512, 2) mega(Args args) {
    extern __shared__ __attribute__((aligned(16))) unsigned char lds[];
    cg::grid_group grid = cg::this_grid();
    Frame F;
    F.lds = lds; F.tid = threadIdx.x; F.lane = F.tid & 63; F.wave = __builtin_amdgcn_readfirstlane(F.tid >> 6); F.bid = blockIdx.x; F.G = gridDim.x;
    F.a = &args; F.ws = args.ws;
    const int lo = args.ph_lo, hi = args.ph_hi;
    bf16* W8 = (bf16*)(F.ws + WS_WIN);
#define IN(k) (lo <= (k) && (k) < hi)
#define SEAM(k) do { if (IN(k) && IN((k) + 1)) grid.sync(); } while (0)
    if (IN(0)) { ph0_prologue(F); } SEAM(0);
    if (IN(1)) { gemm_simple(F, (const bf16*)args.out, 2048, (const bf16*)(F.ws + WS_WIN), 2048, T, NCOLS, 2048, EpiProj{F.ws}); } SEAM(1);
    if (IN(2)) {
        for (int u = F.bid; u < 128; u += F.G) hgrn_naive(F, u);
        if (F.G > 128) { if (F.bid >= 128) ph2_side(F, F.bid - 128, F.G - 128); } else ph2_side(F, F.bid, F.G);
    } SEAM(2);
    if (IN(3)) { ph3_hgnorm(F); } SEAM(3);
    if (IN(4)) {
        gemm_simple(F, F.slot(0), 2048, W8, 2048, T, 2048, 2048, EpiYA{F.slot(6)});
        gemm_simple(F, (const bf16*)(F.ws + WS_CKV), 256, (const bf16*)(F.ws + WS_WKV), 256, T, 4096, 256, EpiKV{F.slot(1), F.slot(2)});
    } SEAM(4);
    if (IN(5)) { ph5_select(F); } SEAM(5);
    if (IN(6)) { ph6_attn(F); } SEAM(6);
    if (IN(7)) { gemm_simple(F, F.slot(3), 2048, W8 + (size_t)1 * 2048 * 2048, 2048, T, 2048, 2048, EpiYB{F.slot(6), F.slot(7)}); } SEAM(7);
    if (IN(8)) { gemm_simple(F, F.slot(6), 2048, W8 + (size_t)2 * 2048 * 2048, 2048, T, 2048, 2048, EpiMix{args.in[0], args.out}); } SEAM(8);
    if (IN(9)) { ph_ln(F, args.in[14], args.in[15], F.slot(0)); } SEAM(9);
    if (IN(10)) {
        gemm_simple(F, F.slot(0), 2048, W8 + (size_t)3 * 2048 * 2048, 2048, T, 2048, 2048, EpiBf16{F.slot(1), 2048});
        gemm_simple(F, (const bf16*)(F.ws + WS_MEMB), 2048, W8 + (size_t)4 * 2048 * 2048, 2048, 2048, 2048, 2048, EpiBf16{(bf16*)(F.ws + WS_CKV), 2048});
        gemm_simple(F, (const bf16*)(F.ws + WS_MEMB), 2048, W8 + (size_t)5 * 2048 * 2048, 2048, 2048, 2048, 2048, EpiBf16{(bf16*)(F.ws + WS_IKW), 2048});
    } SEAM(10);
    if (IN(11)) { ph11_xattn(F); } SEAM(11);
    if (IN(12)) { gemm_simple(F, F.slot(4), 2048, W8 + (size_t)6 * 2048 * 2048, 2048, T, 2048, 2048, EpiRes{args.out}); } SEAM(12);
    if (IN(13)) { ph_ln(F, args.in[20], args.in[21], F.slot(0)); } SEAM(13);
    if (IN(14)) { gemm_simple(F, F.slot(0), 2048, W8 + (size_t)7 * 2048 * 2048, 2048, T, 2048, 2048, EpiF32{(float*)F.slot(1), 2048}); } SEAM(14);
    if (IN(15)) { ph15_peer_select(F); } SEAM(15);
    if (IN(16)) { ph16_experts(F); }
#undef IN
#undef SEAM
}

extern "C" void kernel_launch(void* const* d_in, const int* in_sizes, int n_in, void* d_out, int out_size, void* d_ws, size_t ws_size, hipStream_t stream) {
    static int grid = 0;
    if (grid == 0) {
        if (n_in != 28 || out_size != T * D || ws_size < WS_END) { fprintf(stderr, "kernel_launch: unexpected shapes (n_in %d out %d ws %zu)\n", n_in, out_size, ws_size); grid = -1; return; }
        int dev = 0, cus = 0, per_cu = 0;
        hipGetDevice(&dev); hipDeviceGetAttribute(&cus, hipDeviceAttributeMultiprocessorCount, dev);
        hipFuncSetAttribute((const void*)mega, hipFuncAttributeMaxDynamicSharedMemorySize, LDS_BYTES);
        hipOccupancyMaxActiveBlocksPerMultiprocessor(&per_cu, (const void*)mega, 512, LDS_BYTES);
        if (per_cu < 1) { fprintf(stderr, "kernel_launch: occupancy query says %d blocks per CU\n", per_cu); per_cu = 1; }
        (void)hipGetLastError();
        grid = cus;
    }
    if (grid < 0) return;
    Args a{};
    for (int i = 0; i < 28; ++i) a.in[i] = (const float*)d_in[i];
    a.out = (float*)d_out; a.ws = (unsigned char*)d_ws;
#if ONE_LAUNCH
    a.ph_lo = 0; a.ph_hi = NPH;
    void* params[] = {&a};
    hipError_t e = hipLaunchCooperativeKernel((const void*)mega, dim3(grid), dim3(512), params, LDS_BYTES, stream);
    if (e != hipSuccess) fprintf(stderr, "cooperative launch failed: %s\n", hipGetErrorString(e));
#else
    for (int ph = 0; ph < NPH; ++ph) {
        a.ph_lo = ph; a.ph_hi = ph + 1;
        void* params[] = {&a};
        hipError_t e = hipLaunchCooperativeKernel((const void*)mega, dim3(grid), dim3(512), params, LDS_BYTES, stream);
        if (e != hipSuccess) { fprintf(stderr, "launch %d failed: %s\n", ph, hipGetErrorString(e)); break; }
    }
#endif
}
```

```cpp
#include <hip/hip_runtime.h>
#include <hip/hip_cooperative_groups.h>
#include <cstdint>
#include <cmath>
#include <cstdio>
namespace cg = cooperative_groups;

#ifndef ONE_LAUNCH
#define ONE_LAUNCH 1
#endif

typedef unsigned short bf16;
typedef short bf16x8 __attribute__((ext_vector_type(8)));
typedef float f32x4 __attribute__((ext_vector_type(4)));
typedef float f32x16 __attribute__((ext_vector_type(16)));
typedef unsigned u32x4 __attribute__((ext_vector_type(4)));
typedef unsigned u32x2 __attribute__((ext_vector_type(2)));

constexpr int T = 16384, D = 2048, SEQ = 2048, NB = 8;
constexpr int NCOLS = 16896;
constexpr float ALPHA = 1.189207115002721f;
constexpr int NPH = 17;

constexpr size_t MiB = 1u << 20;
constexpr size_t WS_CTL = 0, WS_MEMB = 1 * MiB, WS_WKV = 9 * MiB, WS_LB = 11 * MiB, WS_MASK = 12 * MiB, WS_WIN = 17 * MiB,
                 WS_SLOT = 83 * MiB, SLOT_BYTES = 64 * MiB, WS_CKV = 595 * MiB, WS_IKW = 603 * MiB, WS_END = 611 * MiB;
constexpr int LDS_BYTES = 147456;

struct Args {
    const float* in[28];
    float* out;
    unsigned char* ws;
    int ph_lo, ph_hi;
};

#define WAVE_SYNC() asm volatile("s_waitcnt lgkmcnt(0)" ::: "memory")

__device__ __forceinline__ unsigned f2bf(float f) { unsigned u = __float_as_uint(f); return (u + 0x7fffu + ((u >> 16) & 1u)) >> 16; }
__device__ __forceinline__ unsigned pk2(float lo, float hi) { return f2bf(lo) | (f2bf(hi) << 16); }
__device__ __forceinline__ float bf2f(unsigned h) { return __uint_as_float(h << 16); }
__device__ __forceinline__ float bflo(unsigned w) { return __uint_as_float(w << 16); }
__device__ __forceinline__ float bfhi(unsigned w) { return __uint_as_float(w & 0xffff0000u); }
__device__ __forceinline__ float wave_sum(float v) {
#pragma unroll
    for (int o = 32; o >= 1; o >>= 1) v += __shfl_xor(v, o);
    return v;
}
__device__ __forceinline__ float wave_max(float v) {
#pragma unroll
    for (int o = 32; o >= 1; o >>= 1) v = fmaxf(v, __shfl_xor(v, o));
    return v;
}
__device__ __forceinline__ float sigm(float x) { return 1.0f / (1.0f + expf(-x)); }
__device__ __forceinline__ void unpack8(u32x4 w, float* f) {
    f[0] = bflo(w.x); f[1] = bfhi(w.x); f[2] = bflo(w.y); f[3] = bfhi(w.y); f[4] = bflo(w.z); f[5] = bfhi(w.z); f[6] = bflo(w.w); f[7] = bfhi(w.w);
}

struct Frame {
    unsigned char* lds;
    int tid, lane, wave, bid, G;
    const Args* a;
    unsigned char* ws;
    __device__ __forceinline__ bf16* slot(int i) const { return (bf16*)(ws + WS_SLOT + (size_t)i * SLOT_BYTES); }
};

namespace pg8 {
#define PG8_LAS __attribute__((address_space(3)))
constexpr int BM = 256, BK = 64, HALF = 128, HTB = HALF * BK * 2, STAGE_BYTES = 8 * HTB, NXCD = 8, WGM = 8;
__host__ __device__ __forceinline__ int lds_byte(int r, int c) { const int st = (r >> 4) * 2 + (c >> 5), rr = r & 15, cc = c & 31, ob = rr * 64 + cc * 2; return st * 1024 + (ob ^ (((ob >> 9) & 1) << 5)); }
__host__ __device__ __forceinline__ void stage_rc(int b, int& R, int& C) { const int st = b / 1024, sb = b % 1024, swz = sb ^ (((sb >> 9) & 1) << 5); R = (st >> 1) * 16 + swz / 64; C = (st & 1) * 32 + (swz % 64) / 2; }
__host__ __device__ __forceinline__ int perm32(int rho) { const int n = rho >> 4, i = rho & 15; return 8 * (i >> 2) + 4 * n + (i & 3); }
struct Unit { int pm, pn; };
struct Gemm { const bf16* A; const bf16* Bt; int lda, ldb, M, N, K; };
struct StaticOrder {
    int nM, nN, nwg, G, c;
    __device__ void init(int M, int N, int G_, int c_) { nM = M / BM; nN = N / BM; nwg = nM * nN; G = G_; c = c_; }
    __device__ bool next(int i, Unit& u) const {
        const long L = (long)i * G + c; if (L >= nwg) return false;
        int wgid = (int)L; { const int q = nwg / NXCD, r = nwg % NXCD, xcd = wgid % NXCD, off = wgid / NXCD; wgid = (xcd < r ? xcd * (q + 1) : r * (q + 1) + (xcd - r) * q) + off; }
        const int nig = WGM * nN, gid = wgid / nig, fm = gid * WGM, gsz = (nM - fm) < WGM ? (nM - fm) : WGM;
        u.pm = fm + ((wgid % nig) % gsz); u.pn = (wgid % nig) / gsz; return true;
    }
};
__device__ __forceinline__ unsigned cvt_pk_bf16(float lo, float hi) { unsigned r; asm volatile("v_cvt_pk_bf16_f32 %0, %1, %2" : "=v"(r) : "v"(lo), "v"(hi)); return r; }

template <class Op> struct Epi8 {
    static constexpr bool PERM = true;
    Op op;
    __device__ __forceinline__ void operator()(const f32x4 (&acc)[2][2][4][2], const Unit& u, int wr, int wc, int fr, int fq) const {
        const int row0 = u.pm * BM + wr * 64 + fr, col0 = u.pn * BM + wc * 32 + 8 * fq;
#pragma unroll
        for (int ai = 0; ai < 2; ++ai)
#pragma unroll
            for (int m = 0; m < 4; ++m)
#pragma unroll
                for (int bj = 0; bj < 2; ++bj) op(row0 + ai * HALF + m * 16, col0 + bj * HALF, acc[ai][bj][m][0], acc[ai][bj][m][1]);
    }
};

template <class Epi, class Sched, bool ALIGN_EPI>
__device__ __forceinline__ void gemm_phase(PG8_LAS unsigned char* lds, const Gemm g, const Sched& S, const Epi& E) {
    const int tid = threadIdx.x, wid = __builtin_amdgcn_readfirstlane(tid >> 6), lane = tid & 63, wr = wid >> 2, wc = wid & 3, fr = lane & 15, fq = lane >> 4;
    const int K = g.K, nt = K / BK;
    unsigned voffA[2], voffB[2];
#pragma unroll
    for (int i = 0; i < 2; ++i) { int R, C; stage_rc(tid * 16 + i * 8192, R, C); const int Rb = Epi::PERM ? ((R & ~31) + perm32(R & 31)) : R;
        voffA[i] = (unsigned)(R * g.lda + C) * 2u; voffB[i] = (unsigned)(Rb * g.ldb + C) * 2u; }
    const size_t kstep = (size_t)(BK * 2);
    const size_t hstepA = (size_t)HALF * g.lda * 2, hstepB = (size_t)HALF * g.ldb * 2;
    const size_t tstepA = 2 * hstepA, tstepB = 2 * hstepB;
    const unsigned ldsw = (unsigned)wid * 1024u;
    const int aoff = lds_byte(wr * 64 + fr, fq * 8), boff = lds_byte(wc * 32 + fr, fq * 8);
#define PG8_SA(b, h) (((b) * 2 + (h)) * HTB)
#define PG8_SB(b, h) ((4 + (b) * 2 + (h)) * HTB)
#define PG8_STAGE(bufoff, gbase, voff) do { _Pragma("unroll") for (int _i = 0; _i < 2; ++_i) \
        __builtin_amdgcn_global_load_lds((const unsigned*)((const char*)(gbase) + (voff)[_i]), (PG8_LAS unsigned*)(lds + (bufoff) + ldsw + _i * 8192), 16, 0, 0); } while (0)
#define PG8_LDA(dst, b, h) do { _Pragma("unroll") for (int m = 0; m < 4; ++m) _Pragma("unroll") for (int k = 0; k < 2; ++k) dst[m][k] = *(const PG8_LAS bf16x8*)(lds + PG8_SA(b, h) + aoff + m * 2048 + k * 1024); } while (0)
#define PG8_LDB(dst, b, h) do { _Pragma("unroll") for (int n = 0; n < 2; ++n) _Pragma("unroll") for (int k = 0; k < 2; ++k) dst[n][k] = *(const PG8_LAS bf16x8*)(lds + PG8_SB(b, h) + boff + n * 2048 + k * 1024); } while (0)
#define PG8_MMA(ai, bj, At, Bt) do { __builtin_amdgcn_s_setprio(1); _Pragma("unroll") for (int m = 0; m < 4; ++m) _Pragma("unroll") for (int n = 0; n < 2; ++n) _Pragma("unroll") for (int k = 0; k < 2; ++k) \
        acc[ai][bj][m][n] = __builtin_amdgcn_mfma_f32_16x16x32_bf16(Bt[n][k], At[m][k], acc[ai][bj][m][n], 0, 0, 0); __builtin_amdgcn_s_setprio(0); } while (0)
#define PG8_WAIT_V(n) asm volatile("s_waitcnt vmcnt(" #n ")" ::: "memory")
#define PG8_WAIT_L(n) asm volatile("s_waitcnt lgkmcnt(" #n ")" ::: "memory")
#define PG8_BAR __builtin_amdgcn_s_barrier()
#define PG8_SCHED __builtin_amdgcn_sched_barrier(0)
    Unit cur, nxt; int ui = 0;
    if (!S.next(0, cur)) return;
    f32x4 acc[2][2][4][2];
#pragma unroll
    for (int a = 0; a < 2; ++a)
#pragma unroll
        for (int b = 0; b < 2; ++b)
#pragma unroll
            for (int m = 0; m < 4; ++m)
#pragma unroll
                for (int n = 0; n < 2; ++n) acc[a][b][m][n] = (f32x4){0.f, 0.f, 0.f, 0.f};
    bf16x8 At[4][2], B0[2][2], B1[2][2];
    const char* cA = (const char*)g.A + (size_t)cur.pm * tstepA; const char* cB = (const char*)g.Bt + (size_t)cur.pn * tstepB;
    PG8_STAGE(PG8_SB(0, 0), cB, voffB); PG8_STAGE(PG8_SB(0, 1), cB + hstepB, voffB); PG8_STAGE(PG8_SA(0, 0), cA, voffA); PG8_STAGE(PG8_SA(0, 1), cA + hstepA, voffA);
    if (wr == 1) PG8_BAR;
    PG8_WAIT_V(2); PG8_BAR;
    PG8_STAGE(PG8_SB(1, 0), cB + kstep, voffB); PG8_STAGE(PG8_SA(1, 0), cA + kstep, voffA); PG8_STAGE(PG8_SB(1, 1), cB + hstepB + kstep, voffB);
    PG8_WAIT_V(6); PG8_BAR;
    for (;;) {
        const bool has_next = S.next(ui + 1, nxt);
        const char* nA = has_next ? (const char*)g.A + (size_t)nxt.pm * tstepA : cA; const char* nB = has_next ? (const char*)g.Bt + (size_t)nxt.pn * tstepB : cB;
        for (int t = 0; t < nt; t += 2) {
            const bool last = (t == nt - 2);
            const char* a1 = cA + (size_t)(t + 1) * kstep;
            const char* a2 = last ? nA : cA + (size_t)(t + 2) * kstep; const char* b2 = last ? nB : cB + (size_t)(t + 2) * kstep;
            const char* a3 = a2 + kstep; const char* b3 = b2 + kstep;
            PG8_LDB(B0, 0, 0); PG8_LDB(B1, 0, 1); PG8_SCHED; PG8_LDA(At, 0, 0); PG8_STAGE(PG8_SA(1, 1), a1 + hstepA, voffA);
            PG8_WAIT_V(8); PG8_WAIT_L(0); PG8_BAR; PG8_MMA(0, 0, At, B0); PG8_MMA(0, 1, At, B1); PG8_BAR; PG8_SCHED;
            PG8_LDA(At, 0, 1); PG8_STAGE(PG8_SB(0, 0), b2, voffB); PG8_STAGE(PG8_SB(0, 1), b2 + hstepB, voffB); PG8_STAGE(PG8_SA(0, 0), a2, voffA);
            PG8_WAIT_V(8); PG8_WAIT_L(0); PG8_BAR; PG8_MMA(1, 0, At, B0); PG8_MMA(1, 1, At, B1); PG8_BAR; PG8_SCHED;
            PG8_LDB(B0, 1, 0); PG8_LDB(B1, 1, 1); PG8_SCHED; PG8_LDA(At, 1, 0); PG8_STAGE(PG8_SA(0, 1), a2 + hstepA, voffA);
            PG8_WAIT_V(8); PG8_WAIT_L(0); PG8_BAR; PG8_MMA(0, 0, At, B0); PG8_MMA(0, 1, At, B1); PG8_BAR; PG8_SCHED;
            PG8_LDA(At, 1, 1); PG8_STAGE(PG8_SB(1, 0), b3, voffB); PG8_STAGE(PG8_SB(1, 1), b3 + hstepB, voffB); PG8_STAGE(PG8_SA(1, 0), a3, voffA);
            PG8_WAIT_V(8); PG8_WAIT_L(0); PG8_BAR; PG8_MMA(1, 0, At, B0); PG8_MMA(1, 1, At, B1); PG8_BAR; PG8_SCHED;
        }
        if constexpr (ALIGN_EPI) { if (wr == 0) PG8_BAR; }
        E(acc, cur, wr, wc, fr, fq);
        if (!has_next) break;
#pragma unroll
        for (int a = 0; a < 2; ++a)
#pragma unroll
            for (int b = 0; b < 2; ++b)
#pragma unroll
                for (int m = 0; m < 4; ++m)
#pragma unroll
                    for (int n = 0; n < 2; ++n) acc[a][b][m][n] = (f32x4){0.f, 0.f, 0.f, 0.f};
        cur = nxt; cA = nA; cB = nB; ++ui;
        if constexpr (ALIGN_EPI) { if (wr == 1) PG8_BAR; }
    }
    PG8_WAIT_V(0);
    if constexpr (!ALIGN_EPI) { if (wr == 0) PG8_BAR; }
    PG8_BAR;
#undef PG8_SA
#undef PG8_SB
#undef PG8_STAGE
#undef PG8_LDA
#undef PG8_LDB
#undef PG8_MMA
#undef PG8_WAIT_V
#undef PG8_WAIT_L
#undef PG8_BAR
#undef PG8_SCHED
}
}

__device__ __forceinline__ u32x4 pack8(f32x4 a, f32x4 b) { u32x4 w; w.x = pg8::cvt_pk_bf16(a.x, a.y); w.y = pg8::cvt_pk_bf16(a.z, a.w); w.z = pg8::cvt_pk_bf16(b.x, b.y); w.w = pg8::cvt_pk_bf16(b.z, b.w); return w; }
__device__ __forceinline__ void unpack8v(u32x4 w, f32x4& a, f32x4& b) { a.x = bflo(w.x); a.y = bfhi(w.x); a.z = bflo(w.y); a.w = bfhi(w.y); b.x = bflo(w.z); b.y = bfhi(w.z); b.z = bflo(w.w); b.w = bfhi(w.w); }
__device__ __forceinline__ f32x4 sigm4(f32x4 v) { f32x4 r; r.x = sigm(v.x); r.y = sigm(v.y); r.z = sigm(v.z); r.w = sigm(v.w); return r; }

struct OpProj { unsigned char* ws;
    __device__ __forceinline__ void operator()(int row, int col, f32x4 a, f32x4 b) const {
        bf16* p;
        if (col < 16384) p = (bf16*)(ws + WS_SLOT + (size_t)(col >> 11) * SLOT_BYTES) + (size_t)row * 2048 + (col & 2047);
        else if (col < 16640) p = (bf16*)(ws + WS_CKV) + (size_t)row * 256 + (col - 16384);
        else p = (bf16*)(ws + WS_IKW) + (size_t)row * 256 + (col - 16640);
        *(u32x4*)p = pack8(a, b);
    } };
struct OpBf16 { bf16* o; int ld;
    __device__ __forceinline__ void operator()(int row, int col, f32x4 a, f32x4 b) const { *(u32x4*)(o + (size_t)row * ld + col) = pack8(a, b); } };
struct OpSplit2 { bf16* o0; bf16* o1;
    __device__ __forceinline__ void operator()(int row, int col, f32x4 a, f32x4 b) const { bf16* p = (col < 2048 ? o0 : o1) + (size_t)row * 2048 + (col & 2047); *(u32x4*)p = pack8(a, b); } };
struct OpF32 { float* o; int ld;
    __device__ __forceinline__ void operator()(int row, int col, f32x4 a, f32x4 b) const { float* p = o + (size_t)row * ld + col; *(f32x4*)p = a; *(f32x4*)(p + 4) = b; } };
struct OpYA { bf16* ga;
    __device__ __forceinline__ void operator()(int row, int col, f32x4 a, f32x4 b) const { bf16* p = ga + (size_t)row * 2048 + col; f32x4 g0, g1; unpack8v(*(const u32x4*)p, g0, g1);
        *(u32x4*)p = pack8(sigm4(g0) * a, sigm4(g1) * b); } };
struct OpYB { bf16* ga; const bf16* gb;
    __device__ __forceinline__ void operator()(int row, int col, f32x4 a, f32x4 b) const { const size_t i = (size_t)row * 2048 + col; f32x4 m0, m1, g0, g1; unpack8v(*(const u32x4*)(ga + i), m0, m1); unpack8v(*(const u32x4*)(gb + i), g0, g1);
        *(u32x4*)(ga + i) = pack8(m0 + sigm4(g0) * a, m1 + sigm4(g1) * b); } };
struct OpMix { const float* x; float* z;
    __device__ __forceinline__ void operator()(int row, int col, f32x4 a, f32x4 b) const { const size_t i = (size_t)row * 2048 + col; const f32x4 x0 = *(const f32x4*)(x + i), x1 = *(const f32x4*)(x + i + 4);
        *(f32x4*)(z + i) = ALPHA * x0 + a; *(f32x4*)(z + i + 4) = ALPHA * x1 + b; } };
struct OpRes { float* z;
    __device__ __forceinline__ void operator()(int row, int col, f32x4 a, f32x4 b) const { const size_t i = (size_t)row * 2048 + col; const f32x4 x0 = *(const f32x4*)(z + i), x1 = *(const f32x4*)(z + i + 4);
        *(f32x4*)(z + i) = ALPHA * x0 + a; *(f32x4*)(z + i + 4) = ALPHA * x1 + b; } };

template <class Op>
__device__ __forceinline__ void gemm(const Frame& F, const bf16* A, int lda, const bf16* Bt, int ldb, int M, int N, int K, const Op& op) {
    pg8::Gemm g{A, Bt, lda, ldb, M, N, K}; pg8::StaticOrder S; S.init(M, N, F.G, F.bid);
    pg8::Epi8<Op> E{op};
    pg8::gemm_phase<pg8::Epi8<Op>, pg8::StaticOrder, true>((PG8_LAS unsigned char*)F.lds, g, S, E);
}

template <class CM>
__device__ __forceinline__ void transpose_item(const float* W, size_t ldw, bf16* WT, size_t ldwt, int row_off, int nblk, int item, float* scr, int lane, const CM& cm) {
    const int kb = item / nblk, nb = item % nblk, k0 = 64 * kb, n0 = 32 * nb;
    const int c = cm(n0 + (lane & 31));
#pragma unroll 8
    for (int i = 0; i < 32; ++i) { const int kk = 2 * i + (lane >> 5); scr[kk * 33 + (lane & 31)] = (c >= 0) ? W[(size_t)(k0 + kk) * ldw + c] : 0.f; }
    WAVE_SYNC();
    const int c8 = lane & 7;
#pragma unroll
    for (int j = 0; j < 4; ++j) { const int n = (lane >> 3) + 8 * j; const float* s = scr + (8 * c8) * 33 + n;
        u32x4 o; o.x = pk2(s[0 * 33], s[1 * 33]); o.y = pk2(s[2 * 33], s[3 * 33]); o.z = pk2(s[4 * 33], s[5 * 33]); o.w = pk2(s[6 * 33], s[7 * 33]);
        *(u32x4*)(WT + (size_t)(row_off + n0 + n) * ldwt + k0 + 8 * c8) = o; }
    WAVE_SYNC();
}
struct CmIdent { __device__ __forceinline__ int operator()(int n) const { return n; } };
struct CmWin { __device__ __forceinline__ int operator()(int n) const {
    if (n < 10240) return n;
    if (n < 12288) return 10496 + (n - 10240);
    if (n < 14336) return 12688 + (n - 12288);
    if (n < 16384) return 14736 + (n - 14336);
    if (n < 16640) return 10240 + (n - 16384);
    if (n < 16768) return 12544 + (n - 16640);
    if (n < 16784) return 12672 + (n - 16768);
    return -1; } };

__device__ __forceinline__ void cvt_bf16_stream(const Frame& F, const float* src, bf16* dst, size_t n8) {
    const size_t gt = (size_t)F.bid * 512 + F.tid, NT = (size_t)F.G * 512;
    for (size_t i = gt; i < n8; i += NT) { const f32x4 a = ((const f32x4*)src)[2 * i], b = ((const f32x4*)src)[2 * i + 1];
        u32x4 o; o.x = pk2(a.x, a.y); o.y = pk2(a.z, a.w); o.z = pk2(b.x, b.y); o.w = pk2(b.z, b.w); ((u32x4*)dst)[i] = o; }
}

__device__ __forceinline__ void ph0_prologue(const Frame& F) {
    const Args& a = *F.a;
    cvt_bf16_stream(F, a.in[0], (bf16*)a.out, (size_t)T * D / 8);
    cvt_bf16_stream(F, a.in[1], (bf16*)(F.ws + WS_MEMB), (size_t)2048 * 2048 / 8);
    float* scr = (float*)(F.lds + F.wave * 16384);
    const int gw = F.bid * 8 + F.wave, NGW = F.G * 8;
    {
        const int nblk = NCOLS / 32, nitems = (2048 / 64) * nblk;
        for (int it = gw; it < nitems; it += NGW) transpose_item(a.in[2], 16784, (bf16*)(F.ws + WS_WIN), 2048, 0, nblk, it, scr, F.lane, CmWin());
    }
    {
        for (int it = gw; it < 32 * 16; it += NGW) { const int mat = it >> 4, which = mat >> 4, h = mat & 15;
            transpose_item(a.in[which ? 9 : 8] + (size_t)h * 256 * 128, 128, (bf16*)(F.ws + WS_WKV), 256, which * 2048 + h * 128, 4, it & 15, scr, F.lane, CmIdent()); }
    }
    {
        const int gt = F.bid * 512 + F.tid;
        if (gt < 2048) { const float l0 = a.in[3][gt], l1 = a.in[3][2048 + gt]; ((float*)(F.ws + WS_LB))[gt] = 1.0f / (1.0f + expf(l1 - l0)); }
    }
}

__device__ __forceinline__ void hgrn_naive(const Frame& F, int unit) {
    const int b = unit >> 4, h = unit & 15, tid = F.tid;
    float* qs = (float*)F.lds; float* fs = qs + 128; float* ks = fs + 128; float* part = ks + 128;
    const bf16* HQ = F.slot(0); const bf16* HF = F.slot(1); const bf16* HI = F.slot(2);
    float* oraw = F.a->out;
    const int dv = tid & 127, kq = tid >> 7;
    float S[32];
#pragma unroll
    for (int j = 0; j < 32; ++j) S[j] = 0.f;
    const float lb = ((const float*)(F.ws + WS_LB))[h * 128 + dv];
    const size_t base = (size_t)b * 2048 * 2048 + h * 128;
    unsigned short qn = HQ[base + dv], fn = HF[base + dv], vn = HI[base + dv];
    for (int t = 0; t < 2048; ++t) {
        const size_t off = base + (size_t)t * 2048;
        if (tid < 128) { const float f = lb + (1.0f - lb) * sigm(bf2f(fn)); qs[tid] = bf2f(qn); fs[tid] = f; ks[tid] = 1.0f - f; }
        const float v = bf2f(vn);
        if (t + 1 < 2048) { qn = HQ[off + 2048 + dv]; fn = HF[off + 2048 + dv]; vn = HI[off + 2048 + dv]; }
        __syncthreads();
        float acc = 0.f;
#pragma unroll
        for (int j = 0; j < 32; ++j) { const int dk = kq * 32 + j; S[j] = fs[dk] * S[j] + ks[dk] * v; acc += qs[dk] * S[j]; }
        part[kq * 128 + dv] = acc;
        __syncthreads();
        if (tid < 128) oraw[off + tid] = (part[tid] + part[128 + tid]) + (part[256 + tid] + part[384 + tid]);
    }
    __syncthreads();
}

__device__ __forceinline__ void ph2_side(const Frame& F, int sid, int nside) {
    const Args& a = *F.a;
    const int gw = sid * 8 + F.wave, NGW = nside * 8, lane = F.lane;
    bf16* CKV = (bf16*)(F.ws + WS_CKV); bf16* IKW = (bf16*)(F.ws + WS_IKW);
    for (int row = gw; row < T; row += NGW) {
        {   u32x2 w = *(u32x2*)(CKV + (size_t)row * 256 + 4 * lane);
            float x0 = bflo(w.x), x1 = bfhi(w.x), x2 = bflo(w.y), x3 = bfhi(w.y);
            const float ss = wave_sum(x0 * x0 + x1 * x1 + x2 * x2 + x3 * x3);
            const float r = rsqrtf(ss * (1.0f / 256.0f) + 1e-6f);
            const f32x4 g = *(const f32x4*)(a.in[5] + 4 * lane);
            w.x = pk2(x0 * r * g.x, x1 * r * g.y); w.y = pk2(x2 * r * g.z, x3 * r * g.w);
            *(u32x2*)(CKV + (size_t)row * 256 + 4 * lane) = w; }
        {   unsigned w = *(unsigned*)(IKW + (size_t)row * 256 + 2 * lane);
            float x0 = bflo(w), x1 = bfhi(w);
            const float mu = wave_sum(x0 + x1) * (1.0f / 128.0f);
            x0 -= mu; x1 -= mu;
            const float var = wave_sum(x0 * x0 + x1 * x1) * (1.0f / 128.0f);
            const float r = rsqrtf(var + 1e-5f);
            const float g0 = a.in[6][2 * lane], g1 = a.in[6][2 * lane + 1], b0 = a.in[7][2 * lane], b1 = a.in[7][2 * lane + 1];
            *(unsigned*)(IKW + (size_t)row * 256 + 2 * lane) = pk2(x0 * r * g0 + b0, x1 * r * g1 + b1); }
    }
    float* scr = (float*)(F.lds + F.wave * 16384);
    for (int it = gw; it < 8 * 2048; it += NGW) { const int m = it >> 11;
        const float* wsrc = m == 0 ? a.in[11] : m == 1 ? a.in[12] : m == 2 ? a.in[13] : m == 3 ? a.in[16] : m == 4 ? a.in[17] : m == 5 ? a.in[18] : m == 6 ? a.in[19] : a.in[22];
        transpose_item(wsrc, 2048, (bf16*)(F.ws + WS_WIN + (size_t)m * 8 * MiB), 2048, 0, 64, it & 2047, scr, lane, CmIdent()); }
}

__device__ __forceinline__ void ph3_hgnorm(const Frame& F) {
    const Args& a = *F.a;
    const int gw = F.bid * 8 + F.wave, NGW = F.G * 8, lane = F.lane;
    const float* oraw = a.out; const bf16* HG = F.slot(3); bf16* HO = F.slot(0);
    for (int u = gw; u < T * 16; u += NGW) {
        const size_t off = (size_t)(u >> 4) * 2048 + (u & 15) * 128 + 2 * lane;
        const float o0 = oraw[off], o1 = oraw[off + 1];
        const float r = rsqrtf(wave_sum(o0 * o0 + o1 * o1) * (1.0f / 128.0f) + 1e-6f);
        const unsigned gw2 = *(const unsigned*)(HG + off);
        const float g0 = bflo(gw2), g1 = bfhi(gw2);
        const int c = (u & 15) * 128 + 2 * lane;
        *(unsigned*)(HO + off) = pk2(o0 * r * a.in[4][c] * (g0 * sigm(g0)), o1 * r * a.in[4][c + 1] * (g1 * sigm(g1)));
    }
}

__device__ __forceinline__ unsigned fkey(float f) { const unsigned u = __float_as_uint(f); return (u & 0x80000000u) ? ~u : (u | 0x80000000u); }
__device__ __forceinline__ void ph5_select(const Frame& F) {
    const int gw = F.bid * 8 + F.wave, NGW = F.G * 8, lane = F.lane;
    float* iq = (float*)(F.lds + F.wave * 16384);
    float* scl = iq + 2048;
    const bf16* AIQ = F.slot(5); const bf16* IKW = (const bf16*)(F.ws + WS_IKW);
    unsigned* MASK = (unsigned*)(F.ws + WS_MASK);
    for (int idx = gw; idx < T; idx += NGW) {
        const int b = idx >> 11, tt = idx & 2047, t = (b & 1) ? 2047 - tt : tt;
        const size_t row = (size_t)b * 2048 + t;
        {
#pragma unroll
            for (int i = 0; i < 4; ++i) { const u32x4 w = *(const u32x4*)(AIQ + row * 2048 + 512 * i + 8 * lane); float f[8]; unpack8(w, f);
#pragma unroll
                for (int j = 0; j < 8; ++j) iq[512 * i + 8 * lane + j] = f[j]; }
        }
        float wv = 0.f;
        if (lane < 16) wv = bf2f(IKW[row * 256 + 128 + lane]) * (0.25f * 0.08838834764831845f);
        WAVE_SYNC();
        const int nj = (t >> 6) + 1;
        for (int j = 0; j < nj; ++j) {
            const int s = lane + 64 * j, sc = s <= t ? s : t;
            const bf16* kr = IKW + ((size_t)b * 2048 + sc) * 256;
            float dot[16];
#pragma unroll
            for (int h = 0; h < 16; ++h) dot[h] = 0.f;
            for (int c = 0; c < 16; ++c) {
                float kf[8]; unpack8(*(const u32x4*)(kr + 8 * c), kf);
#pragma unroll
                for (int h = 0; h < 16; ++h) { const f32x4 q0 = *(const f32x4*)(iq + h * 128 + 8 * c), q1 = *(const f32x4*)(iq + h * 128 + 8 * c + 4);
                    dot[h] += kf[0] * q0.x + kf[1] * q0.y + kf[2] * q0.z + kf[3] * q0.w + kf[4] * q1.x + kf[5] * q1.y + kf[6] * q1.z + kf[7] * q1.w; }
            }
            float score = 0.f;
#pragma unroll
            for (int h = 0; h < 16; ++h) score += fmaxf(dot[h], 0.f) * __shfl(wv, h);
            scl[s] = score;
        }
        WAVE_SYNC();
        unsigned key[32];
#pragma unroll
        for (int j = 0; j < 32; ++j) { const int s = lane + 64 * j; key[j] = (s <= t) ? fkey(scl[s]) : 0u; }
        unsigned thr = 0u;
        if (t + 1 > 256) {
            for (int bit = 31; bit >= 0; --bit) {
                const unsigned cand = thr | (1u << bit);
                int cnt = 0;
#pragma unroll
                for (int j = 0; j < 32; ++j) cnt += __popcll(__ballot(key[j] >= cand));
                if (cnt >= 256) thr = cand;
            }
        }
        unsigned w = 0u;
#pragma unroll
        for (int j = 0; j < 32; ++j) { const int s = lane + 64 * j; const unsigned long long m = __ballot(s <= t && key[j] >= thr);
            if (lane == 2 * j) w = (unsigned)m; if (lane == 2 * j + 1) w = (unsigned)(m >> 32); }
        MASK[row * 64 + lane] = w;
        WAVE_SYNC();
    }
}

__device__ __forceinline__ int t5_bucket(int d) {
    if (d < 16) return d;
    return 16 + (d >= 19) + (d >= 21) + (d >= 24) + (d >= 27) + (d >= 31) + (d >= 35) + (d >= 40) + (d >= 46) + (d >= 52) + (d >= 59) + (d >= 67) + (d >= 77) + (d >= 87) + (d >= 99) + (d >= 113);
}
__device__ __forceinline__ void ph6_attn(const Frame& F) {
    const Args& a = *F.a;
    const int gw = F.bid * 8 + F.wave, NGW = F.G * 8, lane = F.lane;
    float* q = (float*)(F.lds + F.wave * 16384);
    float* pl = q + 2048;
    unsigned short* list = (unsigned short*)(pl + 512);
    const bf16* AQ = F.slot(4); const bf16* KH = F.slot(1); const bf16* VH = F.slot(2); bf16* AO = F.slot(3);
    const unsigned* MASK = (const unsigned*)(F.ws + WS_MASK);
    const float* relb = a.in[10];
    for (int idx = gw; idx < T; idx += NGW) {
        const int b = idx >> 11, tt = idx & 2047, t = (b & 1) ? 2047 - tt : tt;
        const size_t row = (size_t)b * 2048 + t;
        unsigned w = MASK[row * 64 + lane];
        const int cnt = __popc(w);
        int incl = cnt;
#pragma unroll
        for (int o = 1; o < 64; o <<= 1) { const int n = __shfl_up(incl, o); if (lane >= o) incl += n; }
        const int total = __shfl(incl, 63);
        int pos = incl - cnt;
        while (w) { const int bit = __ffs(w) - 1; w &= w - 1; if (pos < 512) list[pos] = (unsigned short)(32 * lane + bit); ++pos; }
        const int nsel = total < 512 ? total : 512;
#pragma unroll
        for (int i = 0; i < 4; ++i) { const u32x4 ww = *(const u32x4*)(AQ + row * 2048 + 512 * i + 8 * lane); float f[8]; unpack8(ww, f);
#pragma unroll
            for (int j = 0; j < 8; ++j) q[512 * i + 8 * lane + j] = f[j]; }
        WAVE_SYNC();
        for (int h = 0; h < 16; ++h) {
            float lmax = -INFINITY;
            for (int e = lane; e < nsel; e += 64) {
                const int s = list[e];
                const bf16* kr = KH + ((size_t)b * 2048 + s) * 2048 + h * 128;
                float dot = 0.f;
#pragma unroll 4
                for (int c = 0; c < 16; ++c) { float kf[8]; unpack8(*(const u32x4*)(kr + 8 * c), kf);
                    const f32x4 q0 = *(const f32x4*)(q + h * 128 + 8 * c), q1 = *(const f32x4*)(q + h * 128 + 8 * c + 4);
                    dot += kf[0] * q0.x + kf[1] * q0.y + kf[2] * q0.z + kf[3] * q0.w + kf[4] * q1.x + kf[5] * q1.y + kf[6] * q1.z + kf[7] * q1.w; }
                const float lg = dot * 0.08838834764831845f + relb[t5_bucket(t - s) * 16 + h];
                pl[e] = lg; lmax = fmaxf(lmax, lg);
            }
            lmax = wave_max(lmax);
            float lsum = 0.f;
            for (int e = lane; e < nsel; e += 64) { const float p = expf(pl[e] - lmax); pl[e] = p; lsum += p; }
            lsum = wave_sum(lsum);
            WAVE_SYNC();
            float o0 = 0.f, o1 = 0.f;
            for (int e = 0; e < nsel; ++e) { const int s = list[e]; const float p = pl[e];
                const unsigned vv = *(const unsigned*)(VH + ((size_t)b * 2048 + s) * 2048 + h * 128 + 2 * lane);
                o0 += p * bflo(vv); o1 += p * bfhi(vv); }
            const float inv = 1.0f / lsum;
            *(unsigned*)(AO + row * 2048 + h * 128 + 2 * lane) = pk2(o0 * inv, o1 * inv);
            WAVE_SYNC();
        }
    }
}

__device__ __forceinline__ void ln_row(float* zrow, const float* g, const float* bta, bf16* brow, int lane) {
    f32x4 v[8]; float s = 0.f;
#pragma unroll
    for (int i = 0; i < 8; ++i) { v[i] = *(const f32x4*)(zrow + 256 * i + 4 * lane); s += (v[i].x + v[i].y) + (v[i].z + v[i].w); }
    const float mu = wave_sum(s) * (1.0f / 2048.0f); float s2 = 0.f;
#pragma unroll
    for (int i = 0; i < 8; ++i) { v[i] = v[i] - mu; s2 += (v[i].x * v[i].x + v[i].y * v[i].y) + (v[i].z * v[i].z + v[i].w * v[i].w); }
    const float r = rsqrtf(wave_sum(s2) * (1.0f / 2048.0f) + 1e-5f);
#pragma unroll
    for (int i = 0; i < 8; ++i) { const f32x4 gg = *(const f32x4*)(g + 256 * i + 4 * lane), bb = *(const f32x4*)(bta + 256 * i + 4 * lane);
        const f32x4 o = v[i] * r * gg + bb; *(f32x4*)(zrow + 256 * i + 4 * lane) = o;
        if (brow) { u32x2 w; w.x = pk2(o.x, o.y); w.y = pk2(o.z, o.w); *(u32x2*)(brow + 256 * i + 4 * lane) = w; } }
}
__device__ __forceinline__ void ph_ln(const Frame& F, const float* g, const float* bta, bf16* bout) {
    const int gw = F.bid * 8 + F.wave, NGW = F.G * 8;
    for (int row = gw; row < T; row += NGW) ln_row(F.a->out + (size_t)row * 2048, g, bta, bout + (size_t)row * 2048, F.lane);
}

__device__ __forceinline__ void ph11_xattn(const Frame& F) {
    const int gw = F.bid * 8 + F.wave, NGW = F.G * 8, lane = F.lane;
    float* q = (float*)(F.lds + F.wave * 16384);
    float* pl = q + 512;
    const bf16* CQ = F.slot(1); const bf16* CK = (const bf16*)(F.ws + WS_CKV); const bf16* CV = (const bf16*)(F.ws + WS_IKW); bf16* CO = F.slot(4);
    for (int u = gw; u < T * 4; u += NGW) {
        const int row = u >> 2, h = u & 3, b = row >> 11;
        { float f[8]; unpack8(*(const u32x4*)(CQ + (size_t)row * 2048 + h * 512 + 8 * lane), f);
#pragma unroll
          for (int j = 0; j < 8; ++j) q[8 * lane + j] = f[j]; }
        WAVE_SYNC();
        float lg[4]; float lmax = -INFINITY;
#pragma unroll
        for (int i = 0; i < 4; ++i) { const int s = lane + 64 * i; const bf16* kr = CK + ((size_t)b * 256 + s) * 2048 + h * 512; float dot = 0.f;
#pragma unroll 4
            for (int c = 0; c < 64; ++c) { float kf[8]; unpack8(*(const u32x4*)(kr + 8 * c), kf);
                const f32x4 q0 = *(const f32x4*)(q + 8 * c), q1 = *(const f32x4*)(q + 8 * c + 4);
                dot += kf[0] * q0.x + kf[1] * q0.y + kf[2] * q0.z + kf[3] * q0.w + kf[4] * q1.x + kf[5] * q1.y + kf[6] * q1.z + kf[7] * q1.w; }
            lg[i] = dot * 0.04419417382415922f; lmax = fmaxf(lmax, lg[i]); }
        lmax = wave_max(lmax);
        float lsum = 0.f;
#pragma unroll
        for (int i = 0; i < 4; ++i) { const float p = expf(lg[i] - lmax); pl[lane + 64 * i] = p; lsum += p; }
        lsum = wave_sum(lsum);
        WAVE_SYNC();
        float o[8];
#pragma unroll
        for (int j = 0; j < 8; ++j) o[j] = 0.f;
        for (int s = 0; s < 256; ++s) { const float p = pl[s]; float vf[8]; unpack8(*(const u32x4*)(CV + ((size_t)b * 256 + s) * 2048 + h * 512 + 8 * lane), vf);
#pragma unroll
            for (int j = 0; j < 8; ++j) o[j] += p * vf[j]; }
        const float inv = 1.0f / lsum;
        u32x4 w; w.x = pk2(o[0] * inv, o[1] * inv); w.y = pk2(o[2] * inv, o[3] * inv); w.z = pk2(o[4] * inv, o[5] * inv); w.w = pk2(o[6] * inv, o[7] * inv);
        *(u32x4*)(CO + (size_t)row * 2048 + h * 512 + 8 * lane) = w;
        WAVE_SYNC();
    }
}

__device__ __forceinline__ void ph15_peer_select(const Frame& F) {
    const Args& a = *F.a;
    const int gw = F.bid * 8 + F.wave, NGW = F.G * 8, lane = F.lane;
    float* q = (float*)(F.lds + F.wave * 16384);
    const float* PQ = (const float*)F.slot(1);
    const float* keys = a.in[23];
    int* EIDX = (int*)(F.ws + WS_CKV); float* EG = (float*)(F.ws + WS_IKW);
    for (int t = gw; t < T; t += NGW) {
#pragma unroll
        for (int i = 0; i < 8; ++i) *(f32x4*)(q + 256 * i + 4 * lane) = *(const f32x4*)(PQ + (size_t)t * 2048 + 256 * i + 4 * lane);
        WAVE_SYNC();
        for (int h = 0; h < 8; ++h) {
            float tv[2]; int ti[2];
#pragma unroll
            for (int p = 0; p < 2; ++p) {
                const float* qq = q + h * 256 + p * 128;
                const float* k0 = keys + ((size_t)(h * 2 + p) * 128 + lane) * 128; const float* k1 = k0 + 64 * 128;
                float v0 = 0.f, v1 = 0.f;
#pragma unroll 4
                for (int d = 0; d < 128; d += 4) { const f32x4 qv = *(const f32x4*)(qq + d), a0 = *(const f32x4*)(k0 + d), a1 = *(const f32x4*)(k1 + d);
                    v0 += qv.x * a0.x + qv.y * a0.y + qv.z * a0.z + qv.w * a0.w; v1 += qv.x * a1.x + qv.y * a1.y + qv.z * a1.z + qv.w * a1.w; }
                float mv = 0.f; int mi = 0;
                for (int k = 0; k < 16; ++k) {
                    const float m = wave_max(fmaxf(v0, v1));
                    const unsigned long long b0 = __ballot(v0 == m);
                    int nidx;
                    if (b0) { const int src = __ffsll((long long)b0) - 1; nidx = src; if (lane == src) v0 = -INFINITY; }
                    else { const unsigned long long b1 = __ballot(v1 == m); const int src = __ffsll((long long)b1) - 1; nidx = src + 64; if (lane == src) v1 = -INFINITY; }
                    if (lane == k) { mv = m; mi = nidx; }
                }
                tv[p] = mv; ti[p] = mi;
            }
            float cand[4];
#pragma unroll
            for (int m4 = 0; m4 < 4; ++m4) { const int c = lane + 64 * m4; cand[m4] = __shfl(tv[0], c >> 4) + __shfl(tv[1], c & 15); }
            float sv = -INFINITY; int sc = 0;
            for (int k = 0; k < 16; ++k) {
                const float m = wave_max(fmaxf(fmaxf(cand[0], cand[1]), fmaxf(cand[2], cand[3])));
                int c = -1;
#pragma unroll
                for (int m4 = 0; m4 < 4; ++m4) { if (c < 0) { const unsigned long long bm = __ballot(cand[m4] == m); if (bm) { const int src = __ffsll((long long)bm) - 1; c = src + 64 * m4; if (lane == src) cand[m4] = -INFINITY; } } }
                if (lane == k) { sv = m; sc = c; }
            }
            const float mx = __shfl(sv, 0);
            const float e = lane < 16 ? expf(sv - mx) : 0.f;
            const float den = wave_sum(e);
            const int i1 = __shfl(ti[0], sc >> 4), i2 = __shfl(ti[1], sc & 15);
            if (lane < 16) { EIDX[(size_t)t * 128 + h * 16 + lane] = i1 * 128 + i2; EG[(size_t)t * 128 + h * 16 + lane] = e / den; }
        }
        WAVE_SYNC();
    }
}

__device__ __forceinline__ void ph16_experts(const Frame& F) {
    const Args& a = *F.a;
    const int gw = F.bid * 8 + F.wave, NGW = F.G * 8, lane = F.lane;
    const int* EIDX = (const int*)(F.ws + WS_CKV); const float* EG = (const float*)(F.ws + WS_IKW);
    const float* PU = a.in[24]; const float* PV = a.in[25];
    for (int t = gw; t < T; t += NGW) {
        float* xrow = a.out + (size_t)t * 2048;
        f32x4 x[8];
#pragma unroll
        for (int i = 0; i < 8; ++i) x[i] = *(const f32x4*)(xrow + 256 * i + 4 * lane);
        const int id0 = EIDX[(size_t)t * 128 + lane], id1 = EIDX[(size_t)t * 128 + 64 + lane];
        const float g0 = EG[(size_t)t * 128 + lane], g1 = EG[(size_t)t * 128 + 64 + lane];
        float c0 = 0.f, c1 = 0.f;
        for (int e = 0; e < 128; ++e) {
            const int id = (e < 64) ? __builtin_amdgcn_readlane(id0, e & 63) : __builtin_amdgcn_readlane(id1, e & 63);
            const float* ur = PU + (size_t)id * 2048;
            float d = 0.f;
#pragma unroll
            for (int i = 0; i < 8; ++i) { const f32x4 u = *(const f32x4*)(ur + 256 * i + 4 * lane); d += (x[i].x * u.x + x[i].y * u.y) + (x[i].z * u.z + x[i].w * u.w); }
            d = wave_sum(d);
            const float hv = 0.5f * d * (1.0f + erff(d * 0.7071067811865476f));
            if (e < 64) { if (lane == e) c0 = g0 * hv; } else { if (lane == e - 64) c1 = g1 * hv; }
        }
        f32x4 y[8];
#pragma unroll
        for (int i = 0; i < 8; ++i) y[i] = (f32x4){0.f, 0.f, 0.f, 0.f};
        for (int e = 0; e < 128; ++e) {
            const int id = (e < 64) ? __builtin_amdgcn_readlane(id0, e & 63) : __builtin_amdgcn_readlane(id1, e & 63);
            const float c = __int_as_float((e < 64) ? __builtin_amdgcn_readlane(__float_as_int(c0), e & 63) : __builtin_amdgcn_readlane(__float_as_int(c1), e & 63));
            const float* vr = PV + (size_t)id * 2048;
#pragma unroll
            for (int i = 0; i < 8; ++i) { const f32x4 v = *(const f32x4*)(vr + 256 * i + 4 * lane); y[i] = y[i] + c * v; }
        }
#pragma unroll
        for (int i = 0; i < 8; ++i) *(f32x4*)(xrow + 256 * i + 4 * lane) = ALPHA * x[i] + y[i];
        ln_row(xrow, a.in[26], a.in[27], nullptr, lane);
    }
}

__global__ void __launch_bounds__(512, 2) mega(Args args) {
    extern __shared__ __attribute__((aligned(16))) unsigned char lds[];
    cg::grid_group grid = cg::this_grid();
    Frame F;
    F.lds = lds; F.tid = threadIdx.x; F.lane = F.tid & 63; F.wave = __builtin_amdgcn_readfirstlane(F.tid >> 6); F.bid = blockIdx.x; F.G = gridDim.x;
    F.a = &args; F.ws = args.ws;
    const int lo = args.ph_lo, hi = args.ph_hi;
    bf16* W8 = (bf16*)(F.ws + WS_WIN);
#define IN(k) (lo <= (k) && (k) < hi)
#define SEAM(k) do { if (IN(k) && IN((k) + 1)) grid.sync(); } while (0)
    if (IN(0)) { ph0_prologue(F); } SEAM(0);
    if (IN(1)) { gemm(F, (const bf16*)args.out, 2048, (const bf16*)(F.ws + WS_WIN), 2048, T, NCOLS, 2048, OpProj{F.ws}); } SEAM(1);
    if (IN(2)) {
        for (int u = F.bid; u < 128; u += F.G) hgrn_naive(F, u);
        if (F.G > 128) { if (F.bid >= 128) ph2_side(F, F.bid - 128, F.G - 128); } else ph2_side(F, F.bid, F.G);
    } SEAM(2);
    if (IN(3)) { ph3_hgnorm(F); } SEAM(3);
    if (IN(4)) {
        gemm(F, F.slot(0), 2048, W8, 2048, T, 2048, 2048, OpYA{F.slot(6)});
        gemm(F, (const bf16*)(F.ws + WS_CKV), 256, (const bf16*)(F.ws + WS_WKV), 256, T, 4096, 256, OpSplit2{F.slot(1), F.slot(2)});
    } SEAM(4);
    if (IN(5)) { ph5_select(F); } SEAM(5);
    if (IN(6)) { ph6_attn(F); } SEAM(6);
    if (IN(7)) { gemm(F, F.slot(3), 2048, W8 + (size_t)1 * 2048 * 2048, 2048, T, 2048, 2048, OpYB{F.slot(6), F.slot(7)}); } SEAM(7);
    if (IN(8)) { gemm(F, F.slot(6), 2048, W8 + (size_t)2 * 2048 * 2048, 2048, T, 2048, 2048, OpMix{args.in[0], args.out}); } SEAM(8);
    if (IN(9)) { ph_ln(F, args.in[14], args.in[15], F.slot(0)); } SEAM(9);
    if (IN(10)) {
        gemm(F, F.slot(0), 2048, W8 + (size_t)3 * 2048 * 2048, 2048, T, 2048, 2048, OpBf16{F.slot(1), 2048});
        gemm(F, (const bf16*)(F.ws + WS_MEMB), 2048, W8 + (size_t)4 * 2048 * 2048, 2048, 2048, 4096, 2048, OpSplit2{(bf16*)(F.ws + WS_CKV), (bf16*)(F.ws + WS_IKW)});
    } SEAM(10);
    if (IN(11)) { ph11_xattn(F); } SEAM(11);
    if (IN(12)) { gemm(F, F.slot(4), 2048, W8 + (size_t)6 * 2048 * 2048, 2048, T, 2048, 2048, OpRes{args.out}); } SEAM(12);
    if (IN(13)) { ph_ln(F, args.in[20], args.in[21], F.slot(0)); } SEAM(13);
    if (IN(14)) { gemm(F, F.slot(0), 2048, W8 + (size_t)7 * 2048 * 2048, 2048, T, 2048, 2048, OpF32{(float*)F.slot(1), 2048}); } SEAM(14);
    if (IN(15)) { ph15_peer_select(F); } SEAM(15);
    if (IN(16)) { ph16_experts(F); }
#undef IN
#undef SEAM
}

extern "C" void kernel_launch(void* const* d_in, const int* in_sizes, int n_in, void* d_out, int out_size, void* d_ws, size_t ws_size, hipStream_t stream) {
    static int grid = 0;
    if (grid == 0) {
        if (n_in != 28 || out_size != T * D || ws_size < WS_END) { fprintf(stderr, "kernel_launch: unexpected shapes (n_in %d out %d ws %zu)\n", n_in, out_size, ws_size); grid = -1; return; }
        int dev = 0, cus = 0, per_cu = 0;
        hipGetDevice(&dev); hipDeviceGetAttribute(&cus, hipDeviceAttributeMultiprocessorCount, dev);
        hipFuncSetAttribute((const void*)mega, hipFuncAttributeMaxDynamicSharedMemorySize, LDS_BYTES);
        hipOccupancyMaxActiveBlocksPerMultiprocessor(&per_cu, (const void*)mega, 512, LDS_BYTES);
        if (per_cu < 1) { fprintf(stderr, "kernel_launch: occupancy query says %d blocks per CU\n", per_cu); per_cu = 1; }
        (void)hipGetLastError();
        grid = cus;
    }
    if (grid < 0) return;
    Args a{};
    for (int i = 0; i < 28; ++i) a.in[i] = (const float*)d_in[i];
    a.out = (float*)d_out; a.ws = (unsigned char*)d_ws;
#if ONE_LAUNCH
    a.ph_lo = 0; a.ph_hi = NPH;
    void* params[] = {&a};
    hipError_t e = hipLaunchCooperativeKernel((const void*)mega, dim3(grid), dim3(512), params, LDS_BYTES, stream);
    if (e != hipSuccess) fprintf(stderr, "cooperative launch failed: %s\n", hipGetErrorString(e));
#else
    for (int ph = 0; ph < NPH; ++ph) {
        a.ph_lo = ph; a.ph_hi = ph + 1;
        void* params[] = {&a};
        hipError_t e = hipLaunchCooperativeKernel((const void*)mega, dim3(grid), dim3(512), params, LDS_BYTES, stream);
        if (e != hipSuccess) { fprintf(stderr, "launch %d failed: %s\n", ph, hipGetErrorString(e)); break; }
    }
#endif
}
```

```cpp
#include <hip/hip_runtime.h>
#include <hip/hip_cooperative_groups.h>
#include <cstdint>
#include <cmath>
#include <cstdio>
namespace cg = cooperative_groups;

#ifndef ONE_LAUNCH
#define ONE_LAUNCH 1
#endif
#ifndef PROBE_MASK
#define PROBE_MASK 0u
#endif

typedef unsigned short bf16;
typedef short bf16x8 __attribute__((ext_vector_type(8)));
typedef float f32x4 __attribute__((ext_vector_type(4)));
typedef float f32x16 __attribute__((ext_vector_type(16)));
typedef unsigned u32x4 __attribute__((ext_vector_type(4)));
typedef unsigned u32x2 __attribute__((ext_vector_type(2)));

constexpr int T = 16384, D = 2048, SEQ = 2048, NB = 8;
constexpr int NCOLS = 16896;
constexpr float ALPHA = 1.189207115002721f;
constexpr int NPH = 17;

constexpr size_t MiB = 1u << 20;
constexpr size_t WS_CTL = 0, WS_MEMB = 1 * MiB, WS_WKV = 9 * MiB, WS_LB = 11 * MiB, WS_MASK = 12 * MiB, WS_WIN = 17 * MiB,
                 WS_SLOT = 83 * MiB, SLOT_BYTES = 64 * MiB, WS_CKV = 595 * MiB, WS_IKW = 603 * MiB, WS_END = 611 * MiB;
constexpr int LDS_BYTES = 147456;

struct Args {
    const float* in[28];
    float* out;
    unsigned char* ws;
    int ph_lo, ph_hi;
};

#define WAVE_SYNC() asm volatile("s_waitcnt lgkmcnt(0)" ::: "memory")

__device__ __forceinline__ unsigned f2bf(float f) { unsigned u = __float_as_uint(f); return (u + 0x7fffu + ((u >> 16) & 1u)) >> 16; }
__device__ __forceinline__ unsigned pk2(float lo, float hi) { return f2bf(lo) | (f2bf(hi) << 16); }
__device__ __forceinline__ float bf2f(unsigned h) { return __uint_as_float(h << 16); }
__device__ __forceinline__ float bflo(unsigned w) { return __uint_as_float(w << 16); }
__device__ __forceinline__ float bfhi(unsigned w) { return __uint_as_float(w & 0xffff0000u); }
__device__ __forceinline__ float wave_sum(float v) {
#pragma unroll
    for (int o = 32; o >= 1; o >>= 1) v += __shfl_xor(v, o);
    return v;
}
__device__ __forceinline__ float wave_max(float v) {
#pragma unroll
    for (int o = 32; o >= 1; o >>= 1) v = fmaxf(v, __shfl_xor(v, o));
    return v;
}
__device__ __forceinline__ float sigm(float x) { return 1.0f / (1.0f + expf(-x)); }
__device__ __forceinline__ void unpack8(u32x4 w, float* f) {
    f[0] = bflo(w.x); f[1] = bfhi(w.x); f[2] = bflo(w.y); f[3] = bfhi(w.y); f[4] = bflo(w.z); f[5] = bfhi(w.z); f[6] = bflo(w.w); f[7] = bfhi(w.w);
}

__device__ __forceinline__ int fresh_lane() { int l; asm volatile("v_mbcnt_lo_u32_b32 %0, -1, 0\n\tv_mbcnt_hi_u32_b32 %0, -1, %0" : "=v"(l)); return l; }
struct Frame {
    unsigned char* lds;
    int wave, bid, G;
    __device__ __forceinline__ int lane() const { return fresh_lane(); }
    const Args* a;
    unsigned char* ws;
    __device__ __forceinline__ bf16* slot(int i) const { return (bf16*)(ws + WS_SLOT + (size_t)i * SLOT_BYTES); }
};

namespace pg8 {
#define PG8_LAS __attribute__((address_space(3)))
constexpr int BM = 256, BK = 64, HALF = 128, HTB = HALF * BK * 2, STAGE_BYTES = 8 * HTB, NXCD = 8, WGM = 8;
__host__ __device__ __forceinline__ int lds_byte(int r, int c) { const int st = (r >> 4) * 2 + (c >> 5), rr = r & 15, cc = c & 31, ob = rr * 64 + cc * 2; return st * 1024 + (ob ^ (((ob >> 9) & 1) << 5)); }
__host__ __device__ __forceinline__ void stage_rc(int b, int& R, int& C) { const int st = b / 1024, sb = b % 1024, swz = sb ^ (((sb >> 9) & 1) << 5); R = (st >> 1) * 16 + swz / 64; C = (st & 1) * 32 + (swz % 64) / 2; }
__host__ __device__ __forceinline__ int perm32(int rho) { const int n = rho >> 4, i = rho & 15; return 8 * (i >> 2) + 4 * n + (i & 3); }
struct Unit { int pm, pn; };
struct Gemm { const bf16* A; const bf16* Bt; int lda, ldb, M, N, K; };
struct StaticOrder {
    int nM, nN, nwg, G, c;
    __device__ void init(int M, int N, int G_, int c_) { nM = M / BM; nN = N / BM; nwg = nM * nN; G = G_; c = c_; }
    __device__ bool next(int i, Unit& u) const {
        const long L = (long)i * G + c; if (L >= nwg) return false;
        int wgid = (int)L; { const int q = nwg / NXCD, r = nwg % NXCD, xcd = wgid % NXCD, off = wgid / NXCD; wgid = (xcd < r ? xcd * (q + 1) : r * (q + 1) + (xcd - r) * q) + off; }
        const int nig = WGM * nN, gid = wgid / nig, fm = gid * WGM, gsz = (nM - fm) < WGM ? (nM - fm) : WGM;
        u.pm = fm + ((wgid % nig) % gsz); u.pn = (wgid % nig) / gsz; return true;
    }
};
__device__ __forceinline__ unsigned cvt_pk_bf16(float lo, float hi) { unsigned r; asm volatile("v_cvt_pk_bf16_f32 %0, %1, %2" : "=v"(r) : "v"(lo), "v"(hi)); return r; }

template <class Op> struct Epi8 {
    static constexpr bool PERM = true;
    Op op;
    __device__ __forceinline__ void operator()(const f32x4 (&acc)[2][2][4][2], const Unit& u, int wr, int wc, int fr, int fq) const {
        const int row0 = u.pm * BM + wr * 64 + fr, col0 = u.pn * BM + wc * 32 + 8 * fq;
#pragma unroll
        for (int ai = 0; ai < 2; ++ai)
#pragma unroll
            for (int m = 0; m < 4; ++m)
#pragma unroll
                for (int bj = 0; bj < 2; ++bj) op(row0 + ai * HALF + m * 16, col0 + bj * HALF, acc[ai][bj][m][0], acc[ai][bj][m][1]);
    }
};

template <class Epi, class Sched, bool ALIGN_EPI>
__device__ __forceinline__ void gemm_phase(PG8_LAS unsigned char* lds, const Gemm g, const Sched& S, const Epi& E, int wid, int lane) {
    const int tid = wid * 64 + lane, wr = wid >> 2, wc = wid & 3, fr = lane & 15, fq = lane >> 4;
    const int K = g.K, nt = K / BK;
    unsigned voffA[2], voffB[2];
#pragma unroll
    for (int i = 0; i < 2; ++i) { int R, C; stage_rc(tid * 16 + i * 8192, R, C); const int Rb = Epi::PERM ? ((R & ~31) + perm32(R & 31)) : R;
        voffA[i] = (unsigned)(R * g.lda + C) * 2u; voffB[i] = (unsigned)(Rb * g.ldb + C) * 2u; }
    const size_t kstep = (size_t)(BK * 2);
    const size_t hstepA = (size_t)HALF * g.lda * 2, hstepB = (size_t)HALF * g.ldb * 2;
    const size_t tstepA = 2 * hstepA, tstepB = 2 * hstepB;
    const unsigned ldsw = (unsigned)wid * 1024u;
    const int aoff = lds_byte(wr * 64 + fr, fq * 8), boff = lds_byte(wc * 32 + fr, fq * 8);
#define PG8_SA(b, h) (((b) * 2 + (h)) * HTB)
#define PG8_SB(b, h) ((4 + (b) * 2 + (h)) * HTB)
#define PG8_STAGE(bufoff, gbase, voff) do { _Pragma("unroll") for (int _i = 0; _i < 2; ++_i) \
        __builtin_amdgcn_global_load_lds((const unsigned*)((const char*)(gbase) + (voff)[_i]), (PG8_LAS unsigned*)(lds + (bufoff) + ldsw + _i * 8192), 16, 0, 0); } while (0)
#define PG8_LDA(dst, b, h) do { _Pragma("unroll") for (int m = 0; m < 4; ++m) _Pragma("unroll") for (int k = 0; k < 2; ++k) dst[m][k] = *(const PG8_LAS bf16x8*)(lds + PG8_SA(b, h) + aoff + m * 2048 + k * 1024); } while (0)
#define PG8_LDB(dst, b, h) do { _Pragma("unroll") for (int n = 0; n < 2; ++n) _Pragma("unroll") for (int k = 0; k < 2; ++k) dst[n][k] = *(const PG8_LAS bf16x8*)(lds + PG8_SB(b, h) + boff + n * 2048 + k * 1024); } while (0)
#define PG8_MMA(ai, bj, At, Bt) do { __builtin_amdgcn_s_setprio(1); _Pragma("unroll") for (int m = 0; m < 4; ++m) _Pragma("unroll") for (int n = 0; n < 2; ++n) _Pragma("unroll") for (int k = 0; k < 2; ++k) \
        acc[ai][bj][m][n] = __builtin_amdgcn_mfma_f32_16x16x32_bf16(Bt[n][k], At[m][k], acc[ai][bj][m][n], 0, 0, 0); __builtin_amdgcn_s_setprio(0); } while (0)
#define PG8_WAIT_V(n) asm volatile("s_waitcnt vmcnt(" #n ")" ::: "memory")
#define PG8_WAIT_L(n) asm volatile("s_waitcnt lgkmcnt(" #n ")" ::: "memory")
#define PG8_BAR __builtin_amdgcn_s_barrier()
#define PG8_SCHED __builtin_amdgcn_sched_barrier(0)
    Unit cur, nxt; int ui = 0;
    if (!S.next(0, cur)) return;
    f32x4 acc[2][2][4][2];
#pragma unroll
    for (int a = 0; a < 2; ++a)
#pragma unroll
        for (int b = 0; b < 2; ++b)
#pragma unroll
            for (int m = 0; m < 4; ++m)
#pragma unroll
                for (int n = 0; n < 2; ++n) acc[a][b][m][n] = (f32x4){0.f, 0.f, 0.f, 0.f};
    bf16x8 At[4][2], B0[2][2], B1[2][2];
    const char* cA = (const char*)g.A + (size_t)cur.pm * tstepA; const char* cB = (const char*)g.Bt + (size_t)cur.pn * tstepB;
    PG8_STAGE(PG8_SB(0, 0), cB, voffB); PG8_STAGE(PG8_SB(0, 1), cB + hstepB, voffB); PG8_STAGE(PG8_SA(0, 0), cA, voffA); PG8_STAGE(PG8_SA(0, 1), cA + hstepA, voffA);
    if (wr == 1) PG8_BAR;
    PG8_WAIT_V(2); PG8_BAR;
    PG8_STAGE(PG8_SB(1, 0), cB + kstep, voffB); PG8_STAGE(PG8_SA(1, 0), cA + kstep, voffA); PG8_STAGE(PG8_SB(1, 1), cB + hstepB + kstep, voffB);
    PG8_WAIT_V(6); PG8_BAR;
    for (;;) {
        const bool has_next = S.next(ui + 1, nxt);
        const char* nA = has_next ? (const char*)g.A + (size_t)nxt.pm * tstepA : cA; const char* nB = has_next ? (const char*)g.Bt + (size_t)nxt.pn * tstepB : cB;
        for (int t = 0; t < nt; t += 2) {
            const bool last = (t == nt - 2);
            const char* a1 = cA + (size_t)(t + 1) * kstep;
            const char* a2 = last ? nA : cA + (size_t)(t + 2) * kstep; const char* b2 = last ? nB : cB + (size_t)(t + 2) * kstep;
            const char* a3 = a2 + kstep; const char* b3 = b2 + kstep;
            PG8_LDB(B0, 0, 0); PG8_LDB(B1, 0, 1); PG8_SCHED; PG8_LDA(At, 0, 0); PG8_STAGE(PG8_SA(1, 1), a1 + hstepA, voffA);
            PG8_WAIT_V(8); PG8_WAIT_L(0); PG8_BAR; PG8_MMA(0, 0, At, B0); PG8_MMA(0, 1, At, B1); PG8_BAR; PG8_SCHED;
            PG8_LDA(At, 0, 1); PG8_STAGE(PG8_SB(0, 0), b2, voffB); PG8_STAGE(PG8_SB(0, 1), b2 + hstepB, voffB); PG8_STAGE(PG8_SA(0, 0), a2, voffA);
            PG8_WAIT_V(8); PG8_WAIT_L(0); PG8_BAR; PG8_MMA(1, 0, At, B0); PG8_MMA(1, 1, At, B1); PG8_BAR; PG8_SCHED;
            PG8_LDB(B0, 1, 0); PG8_LDB(B1, 1, 1); PG8_SCHED; PG8_LDA(At, 1, 0); PG8_STAGE(PG8_SA(0, 1), a2 + hstepA, voffA);
            PG8_WAIT_V(8); PG8_WAIT_L(0); PG8_BAR; PG8_MMA(0, 0, At, B0); PG8_MMA(0, 1, At, B1); PG8_BAR; PG8_SCHED;
            PG8_LDA(At, 1, 1); PG8_STAGE(PG8_SB(1, 0), b3, voffB); PG8_STAGE(PG8_SB(1, 1), b3 + hstepB, voffB); PG8_STAGE(PG8_SA(1, 0), a3, voffA);
            PG8_WAIT_V(8); PG8_WAIT_L(0); PG8_BAR; PG8_MMA(1, 0, At, B0); PG8_MMA(1, 1, At, B1); PG8_BAR; PG8_SCHED;
        }
        if constexpr (ALIGN_EPI) { if (wr == 0) PG8_BAR; }
        E(acc, cur, wr, wc, fr, fq);
        if (!has_next) break;
#pragma unroll
        for (int a = 0; a < 2; ++a)
#pragma unroll
            for (int b = 0; b < 2; ++b)
#pragma unroll
                for (int m = 0; m < 4; ++m)
#pragma unroll
                    for (int n = 0; n < 2; ++n) acc[a][b][m][n] = (f32x4){0.f, 0.f, 0.f, 0.f};
        cur = nxt; cA = nA; cB = nB; ++ui;
        if constexpr (ALIGN_EPI) { if (wr == 1) PG8_BAR; }
    }
    PG8_WAIT_V(0);
    if constexpr (!ALIGN_EPI) { if (wr == 0) PG8_BAR; }
    PG8_BAR;
#undef PG8_SA
#undef PG8_SB
#undef PG8_STAGE
#undef PG8_LDA
#undef PG8_LDB
#undef PG8_MMA
#undef PG8_WAIT_V
#undef PG8_WAIT_L
#undef PG8_BAR
#undef PG8_SCHED
}
}

__device__ __forceinline__ u32x4 pack8(f32x4 a, f32x4 b) { u32x4 w; w.x = pg8::cvt_pk_bf16(a.x, a.y); w.y = pg8::cvt_pk_bf16(a.z, a.w); w.z = pg8::cvt_pk_bf16(b.x, b.y); w.w = pg8::cvt_pk_bf16(b.z, b.w); return w; }
__device__ __forceinline__ void unpack8v(u32x4 w, f32x4& a, f32x4& b) { a.x = bflo(w.x); a.y = bfhi(w.x); a.z = bflo(w.y); a.w = bfhi(w.y); b.x = bflo(w.z); b.y = bfhi(w.z); b.z = bflo(w.w); b.w = bfhi(w.w); }
__device__ __forceinline__ f32x4 sigm4(f32x4 v) { f32x4 r; r.x = sigm(v.x); r.y = sigm(v.y); r.z = sigm(v.z); r.w = sigm(v.w); return r; }

struct OpProj { unsigned char* ws;
    __device__ __forceinline__ void operator()(int row, int col, f32x4 a, f32x4 b) const {
        bf16* p;
        if (col < 16384) p = (bf16*)(ws + WS_SLOT + (size_t)(col >> 11) * SLOT_BYTES) + (size_t)row * 2048 + (col & 2047);
        else if (col < 16640) p = (bf16*)(ws + WS_CKV) + (size_t)row * 256 + (col - 16384);
        else p = (bf16*)(ws + WS_IKW) + (size_t)row * 256 + (col - 16640);
        *(u32x4*)p = pack8(a, b);
    } };
struct OpBf16 { bf16* o; int ld;
    __device__ __forceinline__ void operator()(int row, int col, f32x4 a, f32x4 b) const { *(u32x4*)(o + (size_t)row * ld + col) = pack8(a, b); } };
struct OpSplit2 { bf16* o0; bf16* o1;
    __device__ __forceinline__ void operator()(int row, int col, f32x4 a, f32x4 b) const { bf16* p = (col < 2048 ? o0 : o1) + (size_t)row * 2048 + (col & 2047); *(u32x4*)p = pack8(a, b); } };
struct OpF32 { float* o; int ld;
    __device__ __forceinline__ void operator()(int row, int col, f32x4 a, f32x4 b) const { float* p = o + (size_t)row * ld + col; *(f32x4*)p = a; *(f32x4*)(p + 4) = b; } };
struct OpYA { bf16* ga;
    __device__ __forceinline__ void operator()(int row, int col, f32x4 a, f32x4 b) const { bf16* p = ga + (size_t)row * 2048 + col; f32x4 g0, g1; unpack8v(*(const u32x4*)p, g0, g1);
        *(u32x4*)p = pack8(sigm4(g0) * a, sigm4(g1) * b); } };
struct OpYB { bf16* ga; const bf16* gb;
    __device__ __forceinline__ void operator()(int row, int col, f32x4 a, f32x4 b) const { const size_t i = (size_t)row * 2048 + col; f32x4 m0, m1, g0, g1; unpack8v(*(const u32x4*)(ga + i), m0, m1); unpack8v(*(const u32x4*)(gb + i), g0, g1);
        *(u32x4*)(ga + i) = pack8(m0 + sigm4(g0) * a, m1 + sigm4(g1) * b); } };
struct OpMix { const float* x; float* z;
    __device__ __forceinline__ void operator()(int row, int col, f32x4 a, f32x4 b) const { const size_t i = (size_t)row * 2048 + col; const f32x4 x0 = *(const f32x4*)(x + i), x1 = *(const f32x4*)(x + i + 4);
        *(f32x4*)(z + i) = ALPHA * x0 + a; *(f32x4*)(z + i + 4) = ALPHA * x1 + b; } };
struct OpRes { float* z;
    __device__ __forceinline__ void operator()(int row, int col, f32x4 a, f32x4 b) const { const size_t i = (size_t)row * 2048 + col; const f32x4 x0 = *(const f32x4*)(z + i), x1 = *(const f32x4*)(z + i + 4);
        *(f32x4*)(z + i) = ALPHA * x0 + a; *(f32x4*)(z + i + 4) = ALPHA * x1 + b; } };

template <class Op>
__device__ __forceinline__ void gemm(const Frame& F, const bf16* A, int lda, const bf16* Bt, int ldb, int M, int N, int K, const Op& op) {
    pg8::Gemm g{A, Bt, lda, ldb, M, N, K}; pg8::StaticOrder S; S.init(M, N, F.G, F.bid);
    pg8::Epi8<Op> E{op};
    pg8::gemm_phase<pg8::Epi8<Op>, pg8::StaticOrder, true>((PG8_LAS unsigned char*)F.lds, g, S, E, F.wave, F.lane());
}

template <class CM>
__device__ __forceinline__ void transpose_item(const float* W, size_t ldw, bf16* WT, size_t ldwt, int row_off, int nblk, int item, float* scr, int lane, const CM& cm) {
    const int kb = item / nblk, nb = item % nblk, k0 = 64 * kb, n0 = 32 * nb;
    const int c = cm(n0 + (lane & 31));
#pragma unroll 8
    for (int i = 0; i < 32; ++i) { const int kk = 2 * i + (lane >> 5); scr[kk * 33 + (lane & 31)] = (c >= 0) ? W[(size_t)(k0 + kk) * ldw + c] : 0.f; }
    WAVE_SYNC();
    const int c8 = lane & 7;
#pragma unroll
    for (int j = 0; j < 4; ++j) { const int n = (lane >> 3) + 8 * j; const float* s = scr + (8 * c8) * 33 + n;
        u32x4 o; o.x = pk2(s[0 * 33], s[1 * 33]); o.y = pk2(s[2 * 33], s[3 * 33]); o.z = pk2(s[4 * 33], s[5 * 33]); o.w = pk2(s[6 * 33], s[7 * 33]);
        *(u32x4*)(WT + (size_t)(row_off + n0 + n) * ldwt + k0 + 8 * c8) = o; }
    WAVE_SYNC();
}
struct CmIdent { __device__ __forceinline__ int operator()(int n) const { return n; } };
struct CmWin { __device__ __forceinline__ int operator()(int n) const {
    if (n < 10240) return n;
    if (n < 12288) return 10496 + (n - 10240);
    if (n < 14336) return 12688 + (n - 12288);
    if (n < 16384) return 14736 + (n - 14336);
    if (n < 16640) return 10240 + (n - 16384);
    if (n < 16768) return 12544 + (n - 16640);
    if (n < 16784) return 12672 + (n - 16768);
    return -1; } };

__device__ __forceinline__ void cvt_bf16_stream(const Frame& F, const float* src, bf16* dst, size_t n8) {
    const size_t gt = (size_t)F.bid * 512 + F.wave * 64 + F.lane(), NT = (size_t)F.G * 512;
    for (size_t i = gt; i < n8; i += NT) { const f32x4 a = ((const f32x4*)src)[2 * i], b = ((const f32x4*)src)[2 * i + 1];
        u32x4 o; o.x = pk2(a.x, a.y); o.y = pk2(a.z, a.w); o.z = pk2(b.x, b.y); o.w = pk2(b.z, b.w); ((u32x4*)dst)[i] = o; }
}

__device__ __forceinline__ void ph0_prologue(const Frame& F) {
    const Args& a = *F.a;
    cvt_bf16_stream(F, a.in[0], (bf16*)a.out, (size_t)T * D / 8);
    cvt_bf16_stream(F, a.in[1], (bf16*)(F.ws + WS_MEMB), (size_t)2048 * 2048 / 8);
    float* scr = (float*)(F.lds + F.wave * 16384);
    const int gw = F.bid * 8 + F.wave, NGW = F.G * 8, lane = F.lane();
    {
        const int nblk = NCOLS / 32, nitems = (2048 / 64) * nblk;
        for (int it = gw; it < nitems; it += NGW) transpose_item(a.in[2], 16784, (bf16*)(F.ws + WS_WIN), 2048, 0, nblk, it, scr, lane, CmWin());
    }
    {
        for (int it = gw; it < 32 * 16; it += NGW) { const int mat = it >> 4, which = mat >> 4, h = mat & 15;
            transpose_item(a.in[which ? 9 : 8] + (size_t)h * 256 * 128, 128, (bf16*)(F.ws + WS_WKV), 256, which * 2048 + h * 128, 4, it & 15, scr, lane, CmIdent()); }
    }
    {
        const int gt = F.bid * 512 + F.wave * 64 + lane;
        if (gt < 2048) { const float l0 = a.in[3][gt], l1 = a.in[3][2048 + gt]; ((float*)(F.ws + WS_LB))[gt] = 1.0f / (1.0f + expf(l1 - l0)); }
    }
}

__device__ __forceinline__ void hgrn_naive(const Frame& F, int unit) {
    const int b = unit >> 4, h = unit & 15, tid = F.wave * 64 + F.lane();
    float* qs = (float*)F.lds; float* fs = qs + 128; float* ks = fs + 128; float* part = ks + 128;
    const bf16* HQ = F.slot(0); const bf16* HF = F.slot(1); const bf16* HI = F.slot(2);
    float* oraw = F.a->out;
    const int dv = tid & 127, kq = tid >> 7;
    float S[32];
#pragma unroll
    for (int j = 0; j < 32; ++j) S[j] = 0.f;
    const float lb = ((const float*)(F.ws + WS_LB))[h * 128 + dv];
    const size_t base = (size_t)b * 2048 * 2048 + h * 128;
    unsigned short qn = HQ[base + dv], fn = HF[base + dv], vn = HI[base + dv];
    for (int t = 0; t < 2048; ++t) {
        const size_t off = base + (size_t)t * 2048;
        if (tid < 128) { const float f = lb + (1.0f - lb) * sigm(bf2f(fn)); qs[tid] = bf2f(qn); fs[tid] = f; ks[tid] = 1.0f - f; }
        const float v = bf2f(vn);
        if (t + 1 < 2048) { qn = HQ[off + 2048 + dv]; fn = HF[off + 2048 + dv]; vn = HI[off + 2048 + dv]; }
        __syncthreads();
        float acc = 0.f;
#pragma unroll
        for (int j = 0; j < 32; ++j) { const int dk = kq * 32 + j; S[j] = fs[dk] * S[j] + ks[dk] * v; acc += qs[dk] * S[j]; }
        part[kq * 128 + dv] = acc;
        __syncthreads();
        if (tid < 128) oraw[off + tid] = (part[tid] + part[128 + tid]) + (part[256 + tid] + part[384 + tid]);
    }
    __syncthreads();
}

__device__ __forceinline__ void ph2_side(const Frame& F, int sid, int nside) {
    const Args& a = *F.a;
    const int gw = sid * 8 + F.wave, NGW = nside * 8, lane = F.lane();
    bf16* CKV = (bf16*)(F.ws + WS_CKV); bf16* IKW = (bf16*)(F.ws + WS_IKW);
    for (int row = gw; row < T; row += NGW) {
        {   u32x2 w = *(u32x2*)(CKV + (size_t)row * 256 + 4 * lane);
            float x0 = bflo(w.x), x1 = bfhi(w.x), x2 = bflo(w.y), x3 = bfhi(w.y);
            const float ss = wave_sum(x0 * x0 + x1 * x1 + x2 * x2 + x3 * x3);
            const float r = rsqrtf(ss * (1.0f / 256.0f) + 1e-6f);
            const f32x4 g = *(const f32x4*)(a.in[5] + 4 * lane);
            w.x = pk2(x0 * r * g.x, x1 * r * g.y); w.y = pk2(x2 * r * g.z, x3 * r * g.w);
            *(u32x2*)(CKV + (size_t)row * 256 + 4 * lane) = w; }
        {   unsigned w = *(unsigned*)(IKW + (size_t)row * 256 + 2 * lane);
            float x0 = bflo(w), x1 = bfhi(w);
            const float mu = wave_sum(x0 + x1) * (1.0f / 128.0f);
            x0 -= mu; x1 -= mu;
            const float var = wave_sum(x0 * x0 + x1 * x1) * (1.0f / 128.0f);
            const float r = rsqrtf(var + 1e-5f);
            const float g0 = a.in[6][2 * lane], g1 = a.in[6][2 * lane + 1], b0 = a.in[7][2 * lane], b1 = a.in[7][2 * lane + 1];
            *(unsigned*)(IKW + (size_t)row * 256 + 2 * lane) = pk2(x0 * r * g0 + b0, x1 * r * g1 + b1); }
    }
    float* scr = (float*)(F.lds + F.wave * 16384);
    for (int it = gw; it < 8 * 2048; it += NGW) { const int m = it >> 11;
        const float* wsrc = m == 0 ? a.in[11] : m == 1 ? a.in[12] : m == 2 ? a.in[13] : m == 3 ? a.in[16] : m == 4 ? a.in[17] : m == 5 ? a.in[18] : m == 6 ? a.in[19] : a.in[22];
        transpose_item(wsrc, 2048, (bf16*)(F.ws + WS_WIN + (size_t)m * 8 * MiB), 2048, 0, 64, it & 2047, scr, lane, CmIdent()); }
}

__device__ __forceinline__ void ph3_hgnorm(const Frame& F) {
    const Args& a = *F.a;
    const int gw = F.bid * 8 + F.wave, NGW = F.G * 8, lane = F.lane();
    const float* oraw = a.out; const bf16* HG = F.slot(3); bf16* HO = F.slot(0);
    for (int u = gw; u < T * 16; u += NGW) {
        const size_t off = (size_t)(u >> 4) * 2048 + (u & 15) * 128 + 2 * lane;
        const float o0 = oraw[off], o1 = oraw[off + 1];
        const float r = rsqrtf(wave_sum(o0 * o0 + o1 * o1) * (1.0f / 128.0f) + 1e-6f);
        const unsigned gw2 = *(const unsigned*)(HG + off);
        const float g0 = bflo(gw2), g1 = bfhi(gw2);
        const int c = (u & 15) * 128 + 2 * lane;
        *(unsigned*)(HO + off) = pk2(o0 * r * a.in[4][c] * (g0 * sigm(g0)), o1 * r * a.in[4][c + 1] * (g1 * sigm(g1)));
    }
}

__device__ __forceinline__ unsigned fkey(float f) { const unsigned u = __float_as_uint(f); return (u & 0x80000000u) ? ~u : (u | 0x80000000u); }
__device__ __forceinline__ void ph5_select(const Frame& F) {
    const int gw = F.bid * 8 + F.wave, NGW = F.G * 8, lane = F.lane();
    float* iq = (float*)(F.lds + F.wave * 16384);
    float* scl = iq + 2048;
    const bf16* AIQ = F.slot(5); const bf16* IKW = (const bf16*)(F.ws + WS_IKW);
    unsigned* MASK = (unsigned*)(F.ws + WS_MASK);
    for (int idx = gw; idx < T; idx += NGW) {
        const int b = idx >> 11, tt = idx & 2047, t = (b & 1) ? 2047 - tt : tt;
        const size_t row = (size_t)b * 2048 + t;
        {
#pragma unroll
            for (int i = 0; i < 4; ++i) { const u32x4 w = *(const u32x4*)(AIQ + row * 2048 + 512 * i + 8 * lane); float f[8]; unpack8(w, f);
#pragma unroll
                for (int j = 0; j < 8; ++j) iq[512 * i + 8 * lane + j] = f[j]; }
        }
        float wv = 0.f;
        if (lane < 16) wv = bf2f(IKW[row * 256 + 128 + lane]) * (0.25f * 0.08838834764831845f);
        WAVE_SYNC();
        const int nj = (t >> 6) + 1;
        for (int j = 0; j < nj; ++j) {
            const int s = lane + 64 * j, sc = s <= t ? s : t;
            const bf16* kr = IKW + ((size_t)b * 2048 + sc) * 256;
            float dot[16];
#pragma unroll
            for (int h = 0; h < 16; ++h) dot[h] = 0.f;
            for (int c = 0; c < 16; ++c) {
                float kf[8]; unpack8(*(const u32x4*)(kr + 8 * c), kf);
#pragma unroll
                for (int h = 0; h < 16; ++h) { const f32x4 q0 = *(const f32x4*)(iq + h * 128 + 8 * c), q1 = *(const f32x4*)(iq + h * 128 + 8 * c + 4);
                    dot[h] += kf[0] * q0.x + kf[1] * q0.y + kf[2] * q0.z + kf[3] * q0.w + kf[4] * q1.x + kf[5] * q1.y + kf[6] * q1.z + kf[7] * q1.w; }
            }
            float score = 0.f;
#pragma unroll
            for (int h = 0; h < 16; ++h) score += fmaxf(dot[h], 0.f) * __shfl(wv, h);
            scl[s] = score;
        }
        WAVE_SYNC();
        unsigned key[32];
#pragma unroll
        for (int j = 0; j < 32; ++j) { const int s = lane + 64 * j; key[j] = (s <= t) ? fkey(scl[s]) : 0u; }
        unsigned thr = 0u;
        if (t + 1 > 256) {
            for (int bit = 31; bit >= 0; --bit) {
                const unsigned cand = thr | (1u << bit);
                int cnt = 0;
#pragma unroll
                for (int j = 0; j < 32; ++j) cnt += __popcll(__ballot(key[j] >= cand));
                if (cnt >= 256) thr = cand;
            }
        }
        unsigned w = 0u;
#pragma unroll
        for (int j = 0; j < 32; ++j) { const int s = lane + 64 * j; const unsigned long long m = __ballot(s <= t && key[j] >= thr);
            if (lane == 2 * j) w = (unsigned)m; if (lane == 2 * j + 1) w = (unsigned)(m >> 32); }
        MASK[row * 64 + lane] = w;
        WAVE_SYNC();
    }
}

__device__ __forceinline__ int t5_bucket(int d) {
    if (d < 16) return d;
    return 16 + (d >= 19) + (d >= 21) + (d >= 24) + (d >= 27) + (d >= 31) + (d >= 35) + (d >= 40) + (d >= 46) + (d >= 52) + (d >= 59) + (d >= 67) + (d >= 77) + (d >= 87) + (d >= 99) + (d >= 113);
}
namespace dsa {
constexpr float SCALE = 0.08838834764831845f;
constexpr int NW = 8, QBLK = 32, KVBLK = 64, QB = NW * QBLK, DH = 128, LD = 2048;
constexpr int SHM_V = KVBLK * DH * 2, SHM_K = KVBLK * DH * 2;
constexpr int OFF_WS = 2 * SHM_V + 2 * SHM_K, OFF_BIAS = OFF_WS + NW * 64 * 4, LDS_TOTAL = OFF_BIAS + 16 * 128 * 4;
constexpr float THR = 8.f;
typedef short s16x4 __attribute__((ext_vector_type(4)));
#define KSWZ(row, colB) ((row) * 256 + ((colB) ^ (((row) & 7) << 4)))
#define SBAR() __builtin_amdgcn_sched_barrier(0)
__device__ __forceinline__ int v_st(int k, int c) { const int kk = (k & ~0xC) | ((k & 4) << 1) | ((k & 8) >> 1); return ((kk >> 3) * 4 + (c >> 5)) * 512 + ((kk & 7) * 32 + (c & 31)) * 2; }
__device__ __forceinline__ int v_rd_base(int lane) { return ((lane & 3) << 3) | (((lane >> 2) & 3) << 6) | (((lane >> 4) & 1) << 5) | (((lane >> 5) & 1) << 8); }
constexpr int v_rd_off(int d0, int ks, int half) { return d0 * 512 + ks * 4096 + half * 2048; }
__device__ __forceinline__ int crow(int r, int hi) { return (r & 3) + 8 * (r >> 2) + 4 * hi; }
__device__ __forceinline__ unsigned cvtpk(float lo, float hi) { unsigned r; asm volatile("v_cvt_pk_bf16_f32 %0, %1, %2" : "=v"(r) : "v"(lo), "v"(hi)); return r; }
__device__ __forceinline__ bf16x8 load8(const bf16* p) { return *reinterpret_cast<const bf16x8*>(p); }
template <bool NEAR>
__device__ __forceinline__ void init_scores(f32x16& p0, f32x16& p1, unsigned w0, unsigned w1, int hi, int dq, const float* bl) {
    w0 >>= 4 * hi; w1 >>= 4 * hi;
#pragma unroll
    for (int r = 0; r < 16; ++r) { const int c = (r & 3) + 8 * (r >> 2);
        const int x0 = __builtin_amdgcn_sbfe(w0, c, 1), x1 = __builtin_amdgcn_sbfe(w1, c, 1);
        unsigned b0 = 0u, b1 = 0u;
        if (NEAR) { int d0 = dq - c, d1 = dq - c - 32; d0 = d0 < 0 ? 0 : (d0 > 127 ? 127 : d0); d1 = d1 < 0 ? 0 : (d1 > 127 ? 127 : d1);
            b0 = __float_as_uint(bl[d0]); b1 = __float_as_uint(bl[d1]); }
        p0[r] = __uint_as_float((b0 & (unsigned)x0) | (0xFF800000u & ~(unsigned)x0));
        p1[r] = __uint_as_float((b1 & (unsigned)x1) | (0xFF800000u & ~(unsigned)x1)); }
}
__device__ __forceinline__ void partialSM(f32x16& p0, f32x16& p1, float& m_reg, float& mn, float& alpha) {
    float pmax = p0[0];
#pragma unroll
    for (int r = 1; r < 16; ++r) pmax = fmaxf(pmax, p0[r]);
#pragma unroll
    for (int r = 0; r < 16; ++r) pmax = fmaxf(pmax, p1[r]);
    { auto rr = __builtin_amdgcn_permlane32_swap(__float_as_uint(pmax), __float_as_uint(pmax), false, false);
      pmax = fmaxf(__uint_as_float(rr[0]), __uint_as_float(rr[1])); }
    constexpr float C2 = 1.4426950408889634f * SCALE;
    if (__builtin_expect(__all((pmax - m_reg) * SCALE <= THR), 1)) { mn = m_reg; alpha = 1.f; }
    else { mn = fmaxf(m_reg, pmax); alpha = __builtin_amdgcn_exp2f((m_reg - mn) * C2); m_reg = mn; }
    const float mnL = -mn * C2;
#pragma unroll
    for (int r = 0; r < 16; ++r) p0[r] = fmaf(p0[r], C2, mnL);
#pragma unroll
    for (int r = 0; r < 16; ++r) p1[r] = fmaf(p1[r], C2, mnL);
#pragma unroll
    for (int r = 0; r < 16; ++r) p0[r] = __builtin_amdgcn_exp2f(p0[r]);
}
__device__ __forceinline__ void finishSM(f32x16& p0, f32x16& p1, float alpha, float& l_reg, bf16x8& pa0, bf16x8& pa1, bf16x8& pa2, bf16x8& pa3) {
#pragma unroll
    for (int r = 0; r < 16; ++r) p1[r] = __builtin_amdgcn_exp2f(p1[r]);
    float ps = 0;
#pragma unroll
    for (int r = 0; r < 16; ++r) ps += p0[r];
#pragma unroll
    for (int r = 0; r < 16; ++r) ps += p1[r];
    { auto rr = __builtin_amdgcn_permlane32_swap(__float_as_uint(ps), __float_as_uint(ps), false, false);
      ps = __uint_as_float(rr[0]) + __uint_as_float(rr[1]); }
    l_reg = l_reg * alpha + ps;
#define PK4(P, B_, OUT) do { unsigned a0 = cvtpk(P[B_+0], P[B_+1]), a1 = cvtpk(P[B_+2], P[B_+3]);                          \
        unsigned b0 = cvtpk(P[B_+4], P[B_+5]), b1 = cvtpk(P[B_+6], P[B_+7]);                                             \
        auto r0 = __builtin_amdgcn_permlane32_swap(a0, b0, false, false); auto r1 = __builtin_amdgcn_permlane32_swap(a1, b1, false, false); \
        u32x4 w = {r0[0], r1[0], r0[1], r1[1]}; OUT = *reinterpret_cast<bf16x8*>(&w); } while (0)
    PK4(p0, 0, pa0); PK4(p0, 8, pa1); PK4(p1, 0, pa2); PK4(p1, 8, pa3);
#undef PK4
}
template <int KB>
__device__ __forceinline__ void qkt(f32x16& p0, f32x16& p1, const char* K_lds, int r32, int hi, const bf16x8* qr) {
    const char* kb[4];
#pragma unroll
    for (int dd = 0; dd < 4; ++dd) kb[dd] = K_lds + KB * SHM_K + KSWZ(r32, (dd * 16 + hi * 8) * 2);
#pragma unroll
    for (int d0 = 0; d0 < 8; ++d0) { const char* a = kb[d0 & 3] + (d0 >> 2) * 128;
        bf16x8 b0 = *reinterpret_cast<const bf16x8*>(a);
        bf16x8 b1 = *reinterpret_cast<const bf16x8*>(a + 32 * 256);
        p0 = __builtin_amdgcn_mfma_f32_32x32x16_bf16(b0, qr[d0], p0, 0, 0, 0);
        p1 = __builtin_amdgcn_mfma_f32_32x32x16_bf16(b1, qr[d0], p1, 0, 0, 0); }
}
template <int VB>
__device__ __forceinline__ void pv_tile(f32x16* o, int vb0, bf16x8 pa0, bf16x8 pa1, bf16x8 pa2, bf16x8 pa3) {
#define TRRD(dst, off) asm volatile("ds_read_b64_tr_b16 %0, %1 offset:%2" : "=&v"(dst) : "v"(vb0), "i"(off) : "memory")
#define PV_D0(d0) do { s16x4 l0, l1, l2, l3, h0, h1, h2, h3; constexpr int b_ = VB * SHM_V + v_rd_off(d0, 0, 0); \
        TRRD(l0, b_); TRRD(h0, b_ + 2048); TRRD(l1, b_ + 4096); TRRD(h1, b_ + 6144); TRRD(l2, b_ + 8192); TRRD(h2, b_ + 10240); TRRD(l3, b_ + 12288); TRRD(h3, b_ + 14336); \
        asm volatile("s_waitcnt lgkmcnt(0)" ::: "memory"); SBAR();   \
        o[d0] = __builtin_amdgcn_mfma_f32_32x32x16_bf16(pa0, (bf16x8){l0[0], l0[1], l0[2], l0[3], h0[0], h0[1], h0[2], h0[3]}, o[d0], 0, 0, 0);   \
        o[d0] = __builtin_amdgcn_mfma_f32_32x32x16_bf16(pa1, (bf16x8){l1[0], l1[1], l1[2], l1[3], h1[0], h1[1], h1[2], h1[3]}, o[d0], 0, 0, 0);   \
        o[d0] = __builtin_amdgcn_mfma_f32_32x32x16_bf16(pa2, (bf16x8){l2[0], l2[1], l2[2], l2[3], h2[0], h2[1], h2[2], h2[3]}, o[d0], 0, 0, 0);   \
        o[d0] = __builtin_amdgcn_mfma_f32_32x32x16_bf16(pa3, (bf16x8){l3[0], l3[1], l3[2], l3[3], h3[0], h3[1], h3[2], h3[3]}, o[d0], 0, 0, 0); } while (0)
    PV_D0(0); PV_D0(1); PV_D0(2); PV_D0(3);
#undef PV_D0
#undef TRRD
}
struct BlockRef { const bf16* Q; const bf16* K; const bf16* V; bf16* O; const unsigned* M; int P0; int h; };
struct Seam { bf16x8 qr[8]; bf16x8 st_v0, st_v1, st_k0, st_k1; };
#define ROWU(p, k0) ((p) + (size_t)(k0) * LD)
#define VMW() asm volatile("s_waitcnt vmcnt(0)" ::: "memory")
#define VMWN(n) asm volatile("s_waitcnt vmcnt(%0)" :: "i"(n) : "memory")
#define SLOAD_H(Kp, Vp, k0) do { S.st_v0 = load8(ROWU(Vp, k0) + sofs); S.st_v1 = load8(ROWU(Vp, (k0) + 32) + sofs);              \
                         S.st_k0 = load8(ROWU(Kp, k0) + sofs); S.st_k1 = load8(ROWU(Kp, (k0) + 32) + sofs); } while (0)
#define SWRITE_HK(bf) do { *(bf16x8*)(K_lds + (bf) * SHM_K + kws) = S.st_k0; *(bf16x8*)(K_lds + (bf) * SHM_K + kws + 32 * 256) = S.st_k1; } while (0)
#define SWRITE_HV(bf) do { *(bf16x8*)(V_lds + (bf) * SHM_V + vst0) = S.st_v0; *(bf16x8*)(V_lds + (bf) * SHM_V + vst1) = S.st_v1; } while (0)
#define SWRITE_H(bf) do { SWRITE_HV(bf); SWRITE_HK(bf); } while (0)
__device__ __forceinline__ void prime(const BlockRef& cur, char* lds, Seam& S, int wid) {
    const int lane = fresh_lane(), tid = wid * 64 + lane, r32 = lane & 31, hi = lane >> 5;
    const int sr = tid >> 4, sc = (tid & 15) * 8, kws = KSWZ(sr, sc * 2); char* K_lds = lds + 2 * SHM_V; const unsigned sofs = (unsigned)(sr * LD + sc);
    const unsigned qofs = (unsigned)((wid * QBLK + r32) * LD + hi * 8);
#pragma unroll
    for (int d0 = 0; d0 < 8; ++d0) S.qr[d0] = load8(cur.Q + qofs + d0 * 16);
    SLOAD_H(cur.K, cur.V, 0); VMW(); SWRITE_HK(0);
    __syncthreads();
}
__device__ __forceinline__ void block(const BlockRef& cur, const BlockRef& nxt, char* lds, Seam& S, int wid) {
    const int lane = fresh_lane(), tid = wid * 64 + lane,
               r32 = lane & 31, hi = lane >> 5;
    const int NT = (cur.P0 + QB - 1) / KVBLK + 1;
    const int qlo = cur.P0 + wid * QBLK, qm = qlo + r32 - 4 * hi;
    char* V_lds = lds; char* K_lds = lds + 2 * SHM_V;
    float* ws = (float*)(lds + OFF_WS) + wid * 64; float* li_l = ws, * al_l = ws + 32;
    const float* bl = (const float*)(lds + OFF_BIAS) + cur.h * 128;
    const unsigned mofs = (unsigned)((wid * QBLK + r32) * 64);
    float m_reg = -1e30f, l_reg = 0; f32x16 o[4] = {};
    const int sr = tid >> 4, sc = (tid & 15) * 8, vst0 = v_st(sr, sc), vst1 = v_st(32 + sr, sc), kws = KSWZ(sr, sc * 2); const unsigned sofs = (unsigned)(sr * LD + sc);
    const int vb0 = (int)(uintptr_t)V_lds + v_rd_base(lane);
    const bf16* Kh = cur.K; const bf16* Vh = cur.V;
#define RESC(a) do { if (__any((a) < 1.f)) { if (hi == 0) al_l[r32] = (a); asm volatile("s_waitcnt lgkmcnt(0)" ::: "memory");              \
                     for (int d_ = 0; d_ < 4; ++d_) for (int r = 0; r < 16; ++r) o[d_][r] *= al_l[crow(r, hi)]; } } while (0)
#define KBASE(t) ((t) * KVBLK)
#define LDMASK(t) (*(const u32x2*)(cur.M + 2 * ((t) < 31 ? (t) : 31) + mofs))
#define INIT(P0_, P1_, t) do { const int kb_ = KBASE(t); if (qlo - kb_ - 63 < 113) init_scores<true>(P0_, P1_, mw.x, mw.y, hi, qm - kb_, bl); else init_scores<false>(P0_, P1_, mw.x, mw.y, hi, 0, bl); } while (0)
#define SEAM_K0() do { VMWN(8); SWRITE_HK(0); SBAR(); } while (0)
    f32x16 pA0, pA1, pB0, pB1; float mnA, mnB, alA, alB; bf16x8 pa0, pa1, pa2, pa3; u32x2 mw;
    SWRITE_HV(0); SBAR();
    if (NT > 1) { SLOAD_H(Kh, Vh, KBASE(1)); }
    mw = LDMASK(0); INIT(pA0, pA1, 0); mw = LDMASK(1);
    SBAR(); qkt<0>(pA0, pA1, K_lds, r32, hi, S.qr);
    partialSM(pA0, pA1, m_reg, mnA, alA);
    if (NT > 1) { VMW(); SWRITE_H(1); }
    __syncthreads();
#define HALF_STEP(PX0, PX1, mnX, alX, PY0, PY1, alY, t, KB, VB, SB) do {                                                      \
        INIT(PX0, PX1, (t)); mw = LDMASK((t) + 1);                                                                           \
        SBAR(); qkt<KB>(PX0, PX1, K_lds, r32, hi, S.qr);                                                                      \
        finishSM(PY0, PY1, alY, l_reg, pa0, pa1, pa2, pa3); SBAR();                                                           \
        if ((t) + 1 < NT) { SLOAD_H(Kh, Vh, KBASE((t) + 1)); SBAR(); }                                                        \
        pv_tile<VB>(o, vb0, pa0, pa1, pa2, pa3); partialSM(PX0, PX1, m_reg, mnX, alX);              \
        __syncthreads();                                                                                                      \
        if ((t) + 1 < NT) { VMW(); SWRITE_H(SB); }                                                                            \
        RESC(alX); __syncthreads(); } while (0)
    for (int t = 1; t + 1 < NT; t += 2) {
        HALF_STEP(pB0, pB1, mnB, alB, pA0, pA1, alA, t, 1, 0, 0);
        HALF_STEP(pA0, pA1, mnA, alA, pB0, pB1, alB, t + 1, 0, 1, 1);
    }
    const bool even = (NT & 1) == 0;
    if (even) { INIT(pB0, pB1, NT - 1); SBAR(); qkt<1>(pB0, pB1, K_lds, r32, hi, S.qr); SBAR(); }
    SLOAD_H(nxt.K, nxt.V, 0); SBAR();
#pragma unroll
    for (int d0 = 0; d0 < 8; ++d0) S.qr[d0] = load8(nxt.Q + (unsigned)((wid * QBLK + r32) * LD + hi * 8) + d0 * 16);
    SBAR();
    finishSM(pA0, pA1, alA, l_reg, pa0, pa1, pa2, pa3); SBAR();
    pv_tile<0>(o, vb0, pa0, pa1, pa2, pa3);
    if (even) { partialSM(pB0, pB1, m_reg, mnB, alB); __syncthreads(); RESC(alB);
        finishSM(pB0, pB1, alB, l_reg, pa0, pa1, pa2, pa3); SBAR(); pv_tile<1>(o, vb0, pa0, pa1, pa2, pa3); }
    SBAR(); SEAM_K0();
    if (hi == 0) li_l[r32] = l_reg; asm volatile("s_waitcnt lgkmcnt(0)" ::: "memory");
    float rli[16];
#pragma unroll
    for (int r = 0; r < 16; ++r) rli[r] = __builtin_amdgcn_rcpf(li_l[crow(r, hi)]);
    int lofs = 4 * hi * LD + r32; asm volatile("" : "+v"(lofs));
    bf16* Ow = cur.O + (size_t)(wid * QBLK) * LD + lofs;
#pragma unroll
    for (int r = 0; r < 16; ++r) { const int orow = (r & 3) + 8 * (r >> 2);
#pragma unroll
        for (int d0 = 0; d0 < 4; ++d0) { const float v = o[d0][r] * rli[r];
            const float vn = __shfl_xor(v, 1);
            if ((r32 & 1) == 0) *(unsigned*)(Ow + orow * LD + d0 * 32) = cvtpk(v, vn); } }
    __syncthreads();
#undef RESC
#undef KBASE
#undef LDMASK
#undef INIT
#undef SEAM_K0
#undef HALF_STEP
}
#undef ROWU
#undef VMW
#undef VMWN
#undef SLOAD_H
#undef SWRITE_HK
#undef SWRITE_HV
#undef SWRITE_H
#undef KSWZ
#undef SBAR
}

__device__ __forceinline__ dsa::BlockRef dsa_ref(const Frame& F, int bh, int qb) {
    const int b = bh >> 4, h = bh & 15;
    dsa::BlockRef r;
    r.Q = F.slot(4) + ((size_t)b * 2048 + (size_t)qb * 256) * 2048 + h * 128;
    r.O = F.slot(3) + ((size_t)b * 2048 + (size_t)qb * 256) * 2048 + h * 128;
    r.K = F.slot(1) + (size_t)b * 2048 * 2048 + h * 128; r.V = F.slot(2) + (size_t)b * 2048 * 2048 + h * 128;
    r.M = (const unsigned*)(F.ws + WS_MASK) + ((size_t)b * 2048 + (size_t)qb * 256) * 64;
    r.P0 = qb * 256; r.h = h;
    return r;
}
__device__ __forceinline__ void ph6_attn(const Frame& F) {
    const Args& a = *F.a;
    char* lds = (char*)F.lds;
    {
        float* bt = (float*)(lds + dsa::OFF_BIAS);
        for (int i = F.wave * 64 + F.lane(); i < 16 * 128; i += 512) { const int h = i >> 7, d = i & 127; bt[i] = (a.in[10][t5_bucket(d) * 16 + h] - a.in[10][31 * 16 + h]) * (1.0f / dsa::SCALE); }
    }
    __syncthreads();
    const int total = 4 * 128;
    int L = F.bid; if (L >= total) return;
    int pass = 0;
    dsa::BlockRef cur = dsa_ref(F, L >> 2, L & 3);
    dsa::Seam S;
    dsa::prime(cur, lds, S, F.wave);
    for (;;) {
        const bool more_pass = pass == 0, more_item = L + F.G < total, last = !more_pass && !more_item;
        int passn = pass + 1, Ln = L;
        if (!more_pass) { passn = 0; Ln = more_item ? L + F.G : L; }
        const dsa::BlockRef nxt = last ? cur : dsa_ref(F, Ln >> 2, passn ? 7 - (Ln & 3) : (Ln & 3));
        dsa::block(cur, nxt, lds, S, F.wave);
        if (last) break;
        cur = nxt; pass = passn; L = Ln;
    }
}

__device__ __forceinline__ void ln_row(float* zrow, const float* g, const float* bta, bf16* brow, int lane) {
    f32x4 v[8]; float s = 0.f;
#pragma unroll
    for (int i = 0; i < 8; ++i) { v[i] = *(const f32x4*)(zrow + 256 * i + 4 * lane); s += (v[i].x + v[i].y) + (v[i].z + v[i].w); }
    const float mu = wave_sum(s) * (1.0f / 2048.0f); float s2 = 0.f;
#pragma unroll
    for (int i = 0; i < 8; ++i) { v[i] = v[i] - mu; s2 += (v[i].x * v[i].x + v[i].y * v[i].y) + (v[i].z * v[i].z + v[i].w * v[i].w); }
    const float r = rsqrtf(wave_sum(s2) * (1.0f / 2048.0f) + 1e-5f);
#pragma unroll
    for (int i = 0; i < 8; ++i) { const f32x4 gg = *(const f32x4*)(g + 256 * i + 4 * lane), bb = *(const f32x4*)(bta + 256 * i + 4 * lane);
        const f32x4 o = v[i] * r * gg + bb; *(f32x4*)(zrow + 256 * i + 4 * lane) = o;
        if (brow) { u32x2 w; w.x = pk2(o.x, o.y); w.y = pk2(o.z, o.w); *(u32x2*)(brow + 256 * i + 4 * lane) = w; } }
}
__device__ __forceinline__ void ph_ln(const Frame& F, const float* g, const float* bta, bf16* bout) {
    const int gw = F.bid * 8 + F.wave, NGW = F.G * 8, lane = F.lane();
    for (int row = gw; row < T; row += NGW) ln_row(F.a->out + (size_t)row * 2048, g, bta, bout + (size_t)row * 2048, lane);
}

__device__ __forceinline__ void ph11_xattn(const Frame& F) {
    const int gw = F.bid * 8 + F.wave, NGW = F.G * 8, lane = F.lane();
    float* q = (float*)(F.lds + F.wave * 16384);
    float* pl = q + 512;
    const bf16* CQ = F.slot(1); const bf16* CK = (const bf16*)(F.ws + WS_CKV); const bf16* CV = (const bf16*)(F.ws + WS_IKW); bf16* CO = F.slot(4);
    for (int u = gw; u < T * 4; u += NGW) {
        const int row = u >> 2, h = u & 3, b = row >> 11;
        { float f[8]; unpack8(*(const u32x4*)(CQ + (size_t)row * 2048 + h * 512 + 8 * lane), f);
#pragma unroll
          for (int j = 0; j < 8; ++j) q[8 * lane + j] = f[j]; }
        WAVE_SYNC();
        float lg[4]; float lmax = -INFINITY;
#pragma unroll
        for (int i = 0; i < 4; ++i) { const int s = lane + 64 * i; const bf16* kr = CK + ((size_t)b * 256 + s) * 2048 + h * 512; float dot = 0.f;
#pragma unroll 4
            for (int c = 0; c < 64; ++c) { float kf[8]; unpack8(*(const u32x4*)(kr + 8 * c), kf);
                const f32x4 q0 = *(const f32x4*)(q + 8 * c), q1 = *(const f32x4*)(q + 8 * c + 4);
                dot += kf[0] * q0.x + kf[1] * q0.y + kf[2] * q0.z + kf[3] * q0.w + kf[4] * q1.x + kf[5] * q1.y + kf[6] * q1.z + kf[7] * q1.w; }
            lg[i] = dot * 0.04419417382415922f; lmax = fmaxf(lmax, lg[i]); }
        lmax = wave_max(lmax);
        float lsum = 0.f;
#pragma unroll
        for (int i = 0; i < 4; ++i) { const float p = expf(lg[i] - lmax); pl[lane + 64 * i] = p; lsum += p; }
        lsum = wave_sum(lsum);
        WAVE_SYNC();
        float o[8];
#pragma unroll
        for (int j = 0; j < 8; ++j) o[j] = 0.f;
        for (int s = 0; s < 256; ++s) { const float p = pl[s]; float vf[8]; unpack8(*(const u32x4*)(CV + ((size_t)b * 256 + s) * 2048 + h * 512 + 8 * lane), vf);
#pragma unroll
            for (int j = 0; j < 8; ++j) o[j] += p * vf[j]; }
        const float inv = 1.0f / lsum;
        u32x4 w; w.x = pk2(o[0] * inv, o[1] * inv); w.y = pk2(o[2] * inv, o[3] * inv); w.z = pk2(o[4] * inv, o[5] * inv); w.w = pk2(o[6] * inv, o[7] * inv);
        *(u32x4*)(CO + (size_t)row * 2048 + h * 512 + 8 * lane) = w;
        WAVE_SYNC();
    }
}

__device__ __forceinline__ void ph15_peer_select(const Frame& F) {
    const Args& a = *F.a;
    const int gw = F.bid * 8 + F.wave, NGW = F.G * 8, lane = F.lane();
    float* q = (float*)(F.lds + F.wave * 16384);
    const float* PQ = (const float*)F.slot(1);
    const float* keys = a.in[23];
    int* EIDX = (int*)(F.ws + WS_CKV); float* EG = (float*)(F.ws + WS_IKW);
    for (int t = gw; t < T; t += NGW) {
#pragma unroll
        for (int i = 0; i < 8; ++i) *(f32x4*)(q + 256 * i + 4 * lane) = *(const f32x4*)(PQ + (size_t)t * 2048 + 256 * i + 4 * lane);
        WAVE_SYNC();
        for (int h = 0; h < 8; ++h) {
            float tv[2]; int ti[2];
#pragma unroll
            for (int p = 0; p < 2; ++p) {
                const float* qq = q + h * 256 + p * 128;
                const float* k0 = keys + ((size_t)(h * 2 + p) * 128 + lane) * 128; const float* k1 = k0 + 64 * 128;
                float v0 = 0.f, v1 = 0.f;
#pragma unroll 4
                for (int d = 0; d < 128; d += 4) { const f32x4 qv = *(const f32x4*)(qq + d), a0 = *(const f32x4*)(k0 + d), a1 = *(const f32x4*)(k1 + d);
                    v0 += qv.x * a0.x + qv.y * a0.y + qv.z * a0.z + qv.w * a0.w; v1 += qv.x * a1.x + qv.y * a1.y + qv.z * a1.z + qv.w * a1.w; }
                float mv = 0.f; int mi = 0;
                for (int k = 0; k < 16; ++k) {
                    const float m = wave_max(fmaxf(v0, v1));
                    const unsigned long long b0 = __ballot(v0 == m);
                    int nidx;
                    if (b0) { const int src = __ffsll((long long)b0) - 1; nidx = src; if (lane == src) v0 = -INFINITY; }
                    else { const unsigned long long b1 = __ballot(v1 == m); const int src = __ffsll((long long)b1) - 1; nidx = src + 64; if (lane == src) v1 = -INFINITY; }
                    if (lane == k) { mv = m; mi = nidx; }
                }
                tv[p] = mv; ti[p] = mi;
            }
            float cand[4];
#pragma unroll
            for (int m4 = 0; m4 < 4; ++m4) { const int c = lane + 64 * m4; cand[m4] = __shfl(tv[0], c >> 4) + __shfl(tv[1], c & 15); }
            float sv = -INFINITY; int sc = 0;
            for (int k = 0; k < 16; ++k) {
                const float m = wave_max(fmaxf(fmaxf(cand[0], cand[1]), fmaxf(cand[2], cand[3])));
                int c = -1;
#pragma unroll
                for (int m4 = 0; m4 < 4; ++m4) { if (c < 0) { const unsigned long long bm = __ballot(cand[m4] == m); if (bm) { const int src = __ffsll((long long)bm) - 1; c = src + 64 * m4; if (lane == src) cand[m4] = -INFINITY; } } }
                if (lane == k) { sv = m; sc = c; }
            }
            const float mx = __shfl(sv, 0);
            const float e = lane < 16 ? expf(sv - mx) : 0.f;
            const float den = wave_sum(e);
            const int i1 = __shfl(ti[0], sc >> 4), i2 = __shfl(ti[1], sc & 15);
            if (lane < 16) { EIDX[(size_t)t * 128 + h * 16 + lane] = i1 * 128 + i2; EG[(size_t)t * 128 + h * 16 + lane] = e / den; }
        }
        WAVE_SYNC();
    }
}

typedef __bf16 bf16x2_t __attribute__((ext_vector_type(2)));
__device__ __forceinline__ float dot2bf(unsigned a, unsigned b, float c) { return __builtin_amdgcn_fdot2_f32_bf16(__builtin_bit_cast(bf16x2_t, a), __builtin_bit_cast(bf16x2_t, b), c, false); }
#define RL(v, l) __builtin_amdgcn_readlane((v), (l))
#define EXR 2
#define EX_LOAD(buf, tab, idv, e) do { _Pragma("unroll") for (int r_ = 0; r_ < EXR; ++r_) { const bf16* rp_ = (tab) + (size_t)RL(idv, ((e) & 63) + r_) * 2048 + 8 * lane; \
        _Pragma("unroll") for (int c_ = 0; c_ < 4; ++c_) buf[r_][c_] = *(const u32x4*)(rp_ + 512 * c_); } } while (0)
#define EX_DOT(buf, e) do { float d_[EXR]; _Pragma("unroll") for (int r_ = 0; r_ < EXR; ++r_) { float a_ = 0.f, b_ = 0.f; \
        _Pragma("unroll") for (int c_ = 0; c_ < 4; ++c_) { a_ = dot2bf(buf[r_][c_].x, xb[c_].x, a_); b_ = dot2bf(buf[r_][c_].y, xb[c_].y, b_); a_ = dot2bf(buf[r_][c_].z, xb[c_].z, a_); b_ = dot2bf(buf[r_][c_].w, xb[c_].w, b_); } d_[r_] = a_ + b_; } \
        _Pragma("unroll") for (int o_ = 32; o_ >= 1; o_ >>= 1) { _Pragma("unroll") for (int r_ = 0; r_ < EXR; ++r_) d_[r_] += __shfl_xor(d_[r_], o_); } \
        _Pragma("unroll") for (int r_ = 0; r_ < EXR; ++r_) { const float hv_ = 0.5f * d_[r_] * (1.0f + erff(d_[r_] * 0.7071067811865476f)); if (lane == (((e) & 63) + r_)) { if ((e) < 64) c0 = g0 * hv_; else c1 = g1 * hv_; } } } while (0)
#define EX_AXPY(buf, e) do { const float cv_ = (e) < 64 ? c0 : c1; _Pragma("unroll") for (int r_ = 0; r_ < EXR; ++r_) { const float cf_ = __int_as_float(RL(__float_as_int(cv_), ((e) & 63) + r_)); \
        _Pragma("unroll") for (int c_ = 0; c_ < 4; ++c_) { y[c_][0] += cf_ * bflo(buf[r_][c_].x); y[c_][1] += cf_ * bfhi(buf[r_][c_].x); y[c_][2] += cf_ * bflo(buf[r_][c_].y); y[c_][3] += cf_ * bfhi(buf[r_][c_].y); \
            y[c_][4] += cf_ * bflo(buf[r_][c_].z); y[c_][5] += cf_ * bfhi(buf[r_][c_].z); y[c_][6] += cf_ * bflo(buf[r_][c_].w); y[c_][7] += cf_ * bfhi(buf[r_][c_].w); } } } while (0)
__device__ __forceinline__ void ph16_experts(const Frame& F) {
    const Args& a = *F.a;
    const int gw = F.bid * 8 + F.wave, NGW = F.G * 8, lane = F.lane();
    const int* EIDX = (const int*)(F.ws + WS_CKV); const float* EG = (const float*)(F.ws + WS_IKW);
    const bf16* PU = F.slot(5); const bf16* PV = F.slot(6); const bf16* XB = F.slot(0);
    for (int t = gw; t < T; t += NGW) {
        u32x4 xb[4];
#pragma unroll
        for (int c = 0; c < 4; ++c) xb[c] = *(const u32x4*)(XB + (size_t)t * 2048 + 512 * c + 8 * lane);
        const int id0 = EIDX[(size_t)t * 128 + lane], id1 = EIDX[(size_t)t * 128 + 64 + lane];
        const float g0 = EG[(size_t)t * 128 + lane], g1 = EG[(size_t)t * 128 + 64 + lane];
        float c0 = 0.f, c1 = 0.f;
        u32x4 bA[EXR][4], bB[EXR][4];
        EX_LOAD(bA, PU, id0, 0);
        for (int e = 0; e < 128; e += 2 * EXR) {
            const int idv = e < 64 ? id0 : id1;
            EX_LOAD(bB, PU, idv, e + EXR);
            EX_DOT(bA, e);
            if (e + 2 * EXR < 128) { const int idn = (e + 2 * EXR) < 64 ? id0 : id1; EX_LOAD(bA, PU, idn, e + 2 * EXR); }
            EX_DOT(bB, e + EXR);
        }
        float y[4][8];
#pragma unroll
        for (int c = 0; c < 4; ++c)
#pragma unroll
            for (int j = 0; j < 8; ++j) y[c][j] = 0.f;
        EX_LOAD(bA, PV, id0, 0);
        for (int e = 0; e < 128; e += 2 * EXR) {
            const int idv = e < 64 ? id0 : id1;
            EX_LOAD(bB, PV, idv, e + EXR);
            EX_AXPY(bA, e);
            if (e + 2 * EXR < 128) { const int idn = (e + 2 * EXR) < 64 ? id0 : id1; EX_LOAD(bA, PV, idn, e + 2 * EXR); }
            EX_AXPY(bB, e + EXR);
        }
        float* xrow = a.out + (size_t)t * 2048;
        float s = 0.f;
#pragma unroll
        for (int c = 0; c < 4; ++c) { const f32x4 x0 = *(const f32x4*)(xrow + 512 * c + 8 * lane), x1 = *(const f32x4*)(xrow + 512 * c + 8 * lane + 4);
            y[c][0] += ALPHA * x0.x; y[c][1] += ALPHA * x0.y; y[c][2] += ALPHA * x0.z; y[c][3] += ALPHA * x0.w; y[c][4] += ALPHA * x1.x; y[c][5] += ALPHA * x1.y; y[c][6] += ALPHA * x1.z; y[c][7] += ALPHA * x1.w;
#pragma unroll
            for (int j = 0; j < 8; ++j) s += y[c][j]; }
        const float mu = wave_sum(s) * (1.0f / 2048.0f); float s2 = 0.f;
#pragma unroll
        for (int c = 0; c < 4; ++c)
#pragma unroll
            for (int j = 0; j < 8; ++j) { y[c][j] -= mu; s2 += y[c][j] * y[c][j]; }
        const float rs = rsqrtf(wave_sum(s2) * (1.0f / 2048.0f) + 1e-5f);
#pragma unroll
        for (int c = 0; c < 4; ++c) { const int col = 512 * c + 8 * lane;
            const f32x4 ga = *(const f32x4*)(a.in[26] + col), gb = *(const f32x4*)(a.in[26] + col + 4), ba = *(const f32x4*)(a.in[27] + col), bb = *(const f32x4*)(a.in[27] + col + 4);
            f32x4 o0, o1; o0.x = y[c][0] * rs * ga.x + ba.x; o0.y = y[c][1] * rs * ga.y + ba.y; o0.z = y[c][2] * rs * ga.z + ba.z; o0.w = y[c][3] * rs * ga.w + ba.w;
            o1.x = y[c][4] * rs * gb.x + bb.x; o1.y = y[c][5] * rs * gb.y + bb.y; o1.z = y[c][6] * rs * gb.z + bb.z; o1.w = y[c][7] * rs * gb.w + bb.w;
            *(f32x4*)(xrow + col) = o0; *(f32x4*)(xrow + col + 4) = o1; }
    }
}

__global__ void __launch_bounds__(512, 2) mega(Args args) {
    extern __shared__ __attribute__((aligned(16))) unsigned char lds[];
    cg::grid_group grid = cg::this_grid();
    Frame F;
    F.lds = lds; F.wave = __builtin_amdgcn_readfirstlane(threadIdx.x >> 6); F.bid = blockIdx.x; F.G = gridDim.x;
    F.a = &args; F.ws = args.ws;
    const int lo = args.ph_lo, hi = args.ph_hi;
    bf16* W8 = (bf16*)(F.ws + WS_WIN);
#define IN(k) (lo <= (k) && (k) < hi)
#if PROBE_MASK
    unsigned long long pr_acc = 0ull, pr_t0 = __builtin_amdgcn_s_memrealtime();
#define SEAM(k) do { if (IN(k) && IN((k) + 1)) grid.sync(); { const unsigned long long t1_ = __builtin_amdgcn_s_memrealtime(); if ((PROBE_MASK >> (k)) & 1u) pr_acc += t1_ - pr_t0; pr_t0 = t1_; } } while (0)
#else
#define SEAM(k) do { if (IN(k) && IN((k) + 1)) grid.sync(); } while (0)
#endif
    if (IN(0)) { ph0_prologue(F); } SEAM(0);
    if (IN(1)) { gemm(F, (const bf16*)args.out, 2048, (const bf16*)(F.ws + WS_WIN), 2048, T, NCOLS, 2048, OpProj{F.ws}); } SEAM(1);
    if (IN(2)) {
        for (int u = F.bid; u < 128; u += F.G) hgrn_naive(F, u);
        if (F.G > 128) { if (F.bid >= 128) ph2_side(F, F.bid - 128, F.G - 128); } else ph2_side(F, F.bid, F.G);
    } SEAM(2);
    if (IN(3)) { ph3_hgnorm(F); } SEAM(3);
    if (IN(4)) {
        gemm(F, F.slot(0), 2048, W8, 2048, T, 2048, 2048, OpYA{F.slot(6)});
        gemm(F, (const bf16*)(F.ws + WS_CKV), 256, (const bf16*)(F.ws + WS_WKV), 256, T, 4096, 256, OpSplit2{F.slot(1), F.slot(2)});
    } SEAM(4);
    if (IN(5)) { ph5_select(F); } SEAM(5);
    if (IN(6)) { ph6_attn(F); } SEAM(6);
    if (IN(7)) { gemm(F, F.slot(3), 2048, W8 + (size_t)1 * 2048 * 2048, 2048, T, 2048, 2048, OpYB{F.slot(6), F.slot(7)}); } SEAM(7);
    if (IN(8)) { gemm(F, F.slot(6), 2048, W8 + (size_t)2 * 2048 * 2048, 2048, T, 2048, 2048, OpMix{args.in[0], args.out}); } SEAM(8);
    if (IN(9)) { ph_ln(F, args.in[14], args.in[15], F.slot(0)); } SEAM(9);
    if (IN(10)) {
        gemm(F, F.slot(0), 2048, W8 + (size_t)3 * 2048 * 2048, 2048, T, 2048, 2048, OpBf16{F.slot(1), 2048});
        gemm(F, (const bf16*)(F.ws + WS_MEMB), 2048, W8 + (size_t)4 * 2048 * 2048, 2048, 2048, 4096, 2048, OpSplit2{(bf16*)(F.ws + WS_CKV), (bf16*)(F.ws + WS_IKW)});
    } SEAM(10);
    if (IN(11)) { ph11_xattn(F); } SEAM(11);
    if (IN(12)) { gemm(F, F.slot(4), 2048, W8 + (size_t)6 * 2048 * 2048, 2048, T, 2048, 2048, OpRes{args.out}); } SEAM(12);
    if (IN(13)) { ph_ln(F, args.in[20], args.in[21], F.slot(0));
        cvt_bf16_stream(F, args.in[24], F.slot(5), (size_t)16384 * 2048 / 8); cvt_bf16_stream(F, args.in[25], F.slot(6), (size_t)16384 * 2048 / 8); } SEAM(13);
    if (IN(14)) { gemm(F, F.slot(0), 2048, W8 + (size_t)7 * 2048 * 2048, 2048, T, 2048, 2048, OpF32{(float*)F.slot(1), 2048}); } SEAM(14);
    if (IN(15)) { ph15_peer_select(F); } SEAM(15);
    if (IN(16)) { ph16_experts(F); }
#if PROBE_MASK
    { const unsigned long long t1_ = __builtin_amdgcn_s_memrealtime(); if ((PROBE_MASK >> 16) & 1u) pr_acc += t1_ - pr_t0;
      if (F.bid == 0 && threadIdx.x == 0) { const unsigned long long ts_ = __builtin_amdgcn_s_memrealtime(); while (__builtin_amdgcn_s_memrealtime() - ts_ < pr_acc) __builtin_amdgcn_s_sleep(8); } }
#endif
#undef IN
#undef SEAM
}

extern "C" void kernel_launch(void* const* d_in, const int* in_sizes, int n_in, void* d_out, int out_size, void* d_ws, size_t ws_size, hipStream_t stream) {
    static int grid = 0;
    if (grid == 0) {
        if (n_in != 28 || out_size != T * D || ws_size < WS_END) { fprintf(stderr, "kernel_launch: unexpected shapes (n_in %d out %d ws %zu)\n", n_in, out_size, ws_size); grid = -1; return; }
        int dev = 0, cus = 0, per_cu = 0;
        hipGetDevice(&dev); hipDeviceGetAttribute(&cus, hipDeviceAttributeMultiprocessorCount, dev);
        hipFuncSetAttribute((const void*)mega, hipFuncAttributeMaxDynamicSharedMemorySize, LDS_BYTES);
        hipOccupancyMaxActiveBlocksPerMultiprocessor(&per_cu, (const void*)mega, 512, LDS_BYTES);
        if (per_cu < 1) { fprintf(stderr, "kernel_launch: occupancy query says %d blocks per CU\n", per_cu); per_cu = 1; }
        (void)hipGetLastError();
        grid = cus;
    }
    if (grid < 0) return;
    Args a{};
    for (int i = 0; i < 28; ++i) a.in[i] = (const float*)d_in[i];
    a.out = (float*)d_out; a.ws = (unsigned char*)d_ws;
#if ONE_LAUNCH
    a.ph_lo = 0; a.ph_hi = NPH;
    void* params[] = {&a};
    hipError_t e = hipLaunchCooperativeKernel((const void*)mega, dim3(grid), dim3(512), params, LDS_BYTES, stream);
    if (e != hipSuccess) fprintf(stderr, "cooperative launch failed: %s\n", hipGetErrorString(e));
#else
    for (int ph = 0; ph < NPH; ++ph) {
        a.ph_lo = ph; a.ph_hi = ph + 1;
        void* params[] = {&a};
        hipError_t e = hipLaunchCooperativeKernel((const void*)mega, dim3(grid), dim3(512), params, LDS_BYTES, stream);
        if (e != hipSuccess) { fprintf(stderr, "launch %d failed: %s\n", ph, hipGetErrorString(e)); break; }
    }
#endif
}
```

```cpp
#include <hip/hip_runtime.h>
#include <hip/hip_cooperative_groups.h>
#include <cstdint>
#include <cmath>
#include <cstdio>
namespace cg = cooperative_groups;

#ifndef ONE_LAUNCH
#define ONE_LAUNCH 1
#endif
#ifndef PROBE_MASK
#define PROBE_MASK 0u
#endif

typedef unsigned short bf16;
typedef short bf16x8 __attribute__((ext_vector_type(8)));
typedef float f32x4 __attribute__((ext_vector_type(4)));
typedef float f32x16 __attribute__((ext_vector_type(16)));
typedef unsigned u32x4 __attribute__((ext_vector_type(4)));
typedef unsigned u32x2 __attribute__((ext_vector_type(2)));

constexpr int T = 16384, D = 2048, SEQ = 2048, NB = 8;
constexpr int NCOLS = 16896;
constexpr float ALPHA = 1.189207115002721f;
constexpr int NPH = 19;

constexpr size_t MiB = 1u << 20;
constexpr size_t WS_CTL = 0, WS_MEMB = 1 * MiB, WS_WKV = 9 * MiB, WS_LB = 11 * MiB, WS_MASK = 12 * MiB, WS_WIN = 17 * MiB,
                 WS_SLOT = 83 * MiB, SLOT_BYTES = 64 * MiB, WS_CKV = 595 * MiB, WS_IKW = 603 * MiB, WS_END = 611 * MiB;
constexpr int LDS_BYTES = 147456;

struct Args {
    const float* in[28];
    float* out;
    unsigned char* ws;
    int ph_lo, ph_hi;
};

#define WAVE_SYNC() asm volatile("s_waitcnt lgkmcnt(0)" ::: "memory")

__device__ __forceinline__ unsigned f2bf(float f) { unsigned u = __float_as_uint(f); return (u + 0x7fffu + ((u >> 16) & 1u)) >> 16; }
__device__ __forceinline__ unsigned pk2(float lo, float hi) { return f2bf(lo) | (f2bf(hi) << 16); }
__device__ __forceinline__ float bf2f(unsigned h) { return __uint_as_float(h << 16); }
__device__ __forceinline__ float bflo(unsigned w) { return __uint_as_float(w << 16); }
__device__ __forceinline__ float bfhi(unsigned w) { return __uint_as_float(w & 0xffff0000u); }
__device__ __forceinline__ float wave_sum(float v) {
#pragma unroll
    for (int o = 32; o >= 1; o >>= 1) v += __shfl_xor(v, o);
    return v;
}
__device__ __forceinline__ float wave_max(float v) {
#pragma unroll
    for (int o = 32; o >= 1; o >>= 1) v = fmaxf(v, __shfl_xor(v, o));
    return v;
}
__device__ __forceinline__ float sigm(float x) { return 1.0f / (1.0f + expf(-x)); }
__device__ __forceinline__ void unpack8(u32x4 w, float* f) {
    f[0] = bflo(w.x); f[1] = bfhi(w.x); f[2] = bflo(w.y); f[3] = bfhi(w.y); f[4] = bflo(w.z); f[5] = bfhi(w.z); f[6] = bflo(w.w); f[7] = bfhi(w.w);
}

__device__ __forceinline__ int fresh_lane() { int l; asm volatile("v_mbcnt_lo_u32_b32 %0, -1, 0\n\tv_mbcnt_hi_u32_b32 %0, -1, %0" : "=v"(l)); return l; }
struct Frame {
    unsigned char* lds;
    int wave, bid, G;
    __device__ __forceinline__ int lane() const { return fresh_lane(); }
    const Args* a;
    unsigned char* ws;
    __device__ __forceinline__ bf16* slot(int i) const { return (bf16*)(ws + WS_SLOT + (size_t)i * SLOT_BYTES); }
};

namespace pg8 {
#define PG8_LAS __attribute__((address_space(3)))
constexpr int BM = 256, BK = 64, HALF = 128, HTB = HALF * BK * 2, STAGE_BYTES = 8 * HTB, NXCD = 8, WGM = 8;
__host__ __device__ __forceinline__ int lds_byte(int r, int c) { const int st = (r >> 4) * 2 + (c >> 5), rr = r & 15, cc = c & 31, ob = rr * 64 + cc * 2; return st * 1024 + (ob ^ (((ob >> 9) & 1) << 5)); }
__host__ __device__ __forceinline__ void stage_rc(int b, int& R, int& C) { const int st = b / 1024, sb = b % 1024, swz = sb ^ (((sb >> 9) & 1) << 5); R = (st >> 1) * 16 + swz / 64; C = (st & 1) * 32 + (swz % 64) / 2; }
__host__ __device__ __forceinline__ int perm32(int rho) { const int n = rho >> 4, i = rho & 15; return 8 * (i >> 2) + 4 * n + (i & 3); }
struct Unit { int pm, pn, z; const char* a; const char* b; };
struct Gemm { int lda, ldb, K; };
__device__ __forceinline__ void tile_of(int wgid, int nM, int nN, int& pm, int& pn) {
    const int nwg = nM * nN; { const int q = nwg / NXCD, r = nwg % NXCD, xcd = wgid % NXCD, off = wgid / NXCD; wgid = (xcd < r ? xcd * (q + 1) : r * (q + 1) + (xcd - r) * q) + off; }
    const int nig = WGM * nN, gid = wgid / nig, fm = gid * WGM, gsz = (nM - fm) < WGM ? (nM - fm) : WGM;
    pm = fm + ((wgid % nig) % gsz); pn = (wgid % nig) / gsz;
}
struct Sub { const bf16* A; const bf16* Bt; int nM, nN; };
template <int NS> struct MultiOrder {
    Sub s[NS]; int lda, ldb, G, c;
    __device__ __forceinline__ bool next(int i, Unit& u) const {
        int L = i * G + c;
#pragma unroll
        for (int k = 0; k < NS; ++k) { const int n = s[k].nM * s[k].nN;
            if (L < n) { tile_of(L, s[k].nM, s[k].nN, u.pm, u.pn); u.z = k; u.a = (const char*)(s[k].A + (size_t)u.pm * BM * lda); u.b = (const char*)(s[k].Bt + (size_t)u.pn * BM * ldb); return true; }
            L -= n; }
        return false;
    }
};
template <class Off> struct BatchOrder {
    const bf16* A; const bf16* Bt; int nM, nN, nz, lda, ldb, G, c; Off off;
    __device__ __forceinline__ bool next(int i, Unit& u) const {
        const int L = i * G + c, per = nM * nN; if (L >= per * nz) return false;
        u.z = L / per; const int r = L % per; u.pn = r / nM; u.pm = r % nM;
        u.a = (const char*)(A + off.a(u.z) + (size_t)u.pm * BM * lda); u.b = (const char*)(Bt + off.b(u.z) + (size_t)u.pn * BM * ldb); return true;
    }
};
__device__ __forceinline__ unsigned cvt_pk_bf16(float lo, float hi) { unsigned r; asm volatile("v_cvt_pk_bf16_f32 %0, %1, %2" : "=v"(r) : "v"(lo), "v"(hi)); return r; }

template <class Op> struct Epi8 {
    static constexpr bool PERM = true;
    Op op;
    __device__ __forceinline__ void operator()(const f32x4 (&acc)[2][2][4][2], const Unit& u, int wr, int wc, int fr, int fq) const {
        const int row0 = u.pm * BM + wr * 64 + fr, col0 = u.pn * BM + wc * 32 + 8 * fq;
#pragma unroll
        for (int ai = 0; ai < 2; ++ai)
#pragma unroll
            for (int m = 0; m < 4; ++m)
#pragma unroll
                for (int bj = 0; bj < 2; ++bj) op(u.z, row0 + ai * HALF + m * 16, col0 + bj * HALF, acc[ai][bj][m][0], acc[ai][bj][m][1]);
    }
};

template <class Epi, class Sched, bool ALIGN_EPI>
__device__ __forceinline__ void gemm_phase(PG8_LAS unsigned char* lds, const Gemm g, const Sched& S, const Epi& E, int wid, int lane) {
    const int tid = wid * 64 + lane, wr = wid >> 2, wc = wid & 3, fr = lane & 15, fq = lane >> 4;
    const int K = g.K, nt = K / BK;
    unsigned voffA[2], voffB[2];
#pragma unroll
    for (int i = 0; i < 2; ++i) { int R, C; stage_rc(tid * 16 + i * 8192, R, C); const int Rb = Epi::PERM ? ((R & ~31) + perm32(R & 31)) : R;
        voffA[i] = (unsigned)(R * g.lda + C) * 2u; voffB[i] = (unsigned)(Rb * g.ldb + C) * 2u; }
    const size_t kstep = (size_t)(BK * 2);
    const size_t hstepA = (size_t)HALF * g.lda * 2, hstepB = (size_t)HALF * g.ldb * 2;
    const unsigned ldsw = (unsigned)wid * 1024u;
    const int aoff = lds_byte(wr * 64 + fr, fq * 8), boff = lds_byte(wc * 32 + fr, fq * 8);
#define PG8_SA(b, h) (((b) * 2 + (h)) * HTB)
#define PG8_SB(b, h) ((4 + (b) * 2 + (h)) * HTB)
#define PG8_STAGE(bufoff, gbase, voff) do { _Pragma("unroll") for (int _i = 0; _i < 2; ++_i) \
        __builtin_amdgcn_global_load_lds((const unsigned*)((const char*)(gbase) + (voff)[_i]), (PG8_LAS unsigned*)(lds + (bufoff) + ldsw + _i * 8192), 16, 0, 0); } while (0)
#define PG8_LDA(dst, b, h) do { _Pragma("unroll") for (int m = 0; m < 4; ++m) _Pragma("unroll") for (int k = 0; k < 2; ++k) dst[m][k] = *(const PG8_LAS bf16x8*)(lds + PG8_SA(b, h) + aoff + m * 2048 + k * 1024); } while (0)
#define PG8_LDB(dst, b, h) do { _Pragma("unroll") for (int n = 0; n < 2; ++n) _Pragma("unroll") for (int k = 0; k < 2; ++k) dst[n][k] = *(const PG8_LAS bf16x8*)(lds + PG8_SB(b, h) + boff + n * 2048 + k * 1024); } while (0)
#define PG8_MMA(ai, bj, At, Bt) do { __builtin_amdgcn_s_setprio(1); _Pragma("unroll") for (int m = 0; m < 4; ++m) _Pragma("unroll") for (int n = 0; n < 2; ++n) _Pragma("unroll") for (int k = 0; k < 2; ++k) \
        acc[ai][bj][m][n] = __builtin_amdgcn_mfma_f32_16x16x32_bf16(Bt[n][k], At[m][k], acc[ai][bj][m][n], 0, 0, 0); __builtin_amdgcn_s_setprio(0); } while (0)
#define PG8_WAIT_V(n) asm volatile("s_waitcnt vmcnt(" #n ")" ::: "memory")
#define PG8_WAIT_L(n) asm volatile("s_waitcnt lgkmcnt(" #n ")" ::: "memory")
#define PG8_BAR __builtin_amdgcn_s_barrier()
#define PG8_SCHED __builtin_amdgcn_sched_barrier(0)
    Unit cur, nxt; int ui = 0;
    if (!S.next(0, cur)) return;
    f32x4 acc[2][2][4][2];
#pragma unroll
    for (int a = 0; a < 2; ++a)
#pragma unroll
        for (int b = 0; b < 2; ++b)
#pragma unroll
            for (int m = 0; m < 4; ++m)
#pragma unroll
                for (int n = 0; n < 2; ++n) acc[a][b][m][n] = (f32x4){0.f, 0.f, 0.f, 0.f};
    bf16x8 At[4][2], B0[2][2], B1[2][2];
    const char* cA = cur.a; const char* cB = cur.b;
    PG8_STAGE(PG8_SB(0, 0), cB, voffB); PG8_STAGE(PG8_SB(0, 1), cB + hstepB, voffB); PG8_STAGE(PG8_SA(0, 0), cA, voffA); PG8_STAGE(PG8_SA(0, 1), cA + hstepA, voffA);
    if (wr == 1) PG8_BAR;
    PG8_WAIT_V(2); PG8_BAR;
    PG8_STAGE(PG8_SB(1, 0), cB + kstep, voffB); PG8_STAGE(PG8_SA(1, 0), cA + kstep, voffA); PG8_STAGE(PG8_SB(1, 1), cB + hstepB + kstep, voffB);
    PG8_WAIT_V(6); PG8_BAR;
    for (;;) {
        const bool has_next = S.next(ui + 1, nxt);
        const char* nA = has_next ? nxt.a : cA; const char* nB = has_next ? nxt.b : cB;
#pragma unroll 1
        for (int t = 0; t < nt; t += 2) {
            const bool last = (t == nt - 2);
            const char* a1 = cA + (size_t)(t + 1) * kstep;
            const char* a2 = last ? nA : cA + (size_t)(t + 2) * kstep; const char* b2 = last ? nB : cB + (size_t)(t + 2) * kstep;
            const char* a3 = a2 + kstep; const char* b3 = b2 + kstep;
            PG8_LDB(B0, 0, 0); PG8_LDB(B1, 0, 1); PG8_SCHED; PG8_LDA(At, 0, 0); PG8_STAGE(PG8_SA(1, 1), a1 + hstepA, voffA);
            PG8_WAIT_V(8); PG8_WAIT_L(0); PG8_BAR; PG8_MMA(0, 0, At, B0); PG8_MMA(0, 1, At, B1); PG8_BAR; PG8_SCHED;
            PG8_LDA(At, 0, 1); PG8_STAGE(PG8_SB(0, 0), b2, voffB); PG8_STAGE(PG8_SB(0, 1), b2 + hstepB, voffB); PG8_STAGE(PG8_SA(0, 0), a2, voffA);
            PG8_WAIT_V(8); PG8_WAIT_L(0); PG8_BAR; PG8_MMA(1, 0, At, B0); PG8_MMA(1, 1, At, B1); PG8_BAR; PG8_SCHED;
            PG8_LDB(B0, 1, 0); PG8_LDB(B1, 1, 1); PG8_SCHED; PG8_LDA(At, 1, 0); PG8_STAGE(PG8_SA(0, 1), a2 + hstepA, voffA);
            PG8_WAIT_V(8); PG8_WAIT_L(0); PG8_BAR; PG8_MMA(0, 0, At, B0); PG8_MMA(0, 1, At, B1); PG8_BAR; PG8_SCHED;
            PG8_LDA(At, 1, 1); PG8_STAGE(PG8_SB(1, 0), b3, voffB); PG8_STAGE(PG8_SB(1, 1), b3 + hstepB, voffB); PG8_STAGE(PG8_SA(1, 0), a3, voffA);
            PG8_WAIT_V(8); PG8_WAIT_L(0); PG8_BAR; PG8_MMA(1, 0, At, B0); PG8_MMA(1, 1, At, B1); PG8_BAR; PG8_SCHED;
        }
        if constexpr (ALIGN_EPI) { if (wr == 0) PG8_BAR; }
        E(acc, cur, wr, wc, fr, fq);
        if (!has_next) break;
#pragma unroll
        for (int a = 0; a < 2; ++a)
#pragma unroll
            for (int b = 0; b < 2; ++b)
#pragma unroll
                for (int m = 0; m < 4; ++m)
#pragma unroll
                    for (int n = 0; n < 2; ++n) acc[a][b][m][n] = (f32x4){0.f, 0.f, 0.f, 0.f};
        cur = nxt; cA = nA; cB = nB; ++ui;
        if constexpr (ALIGN_EPI) { if (wr == 1) PG8_BAR; }
    }
    PG8_WAIT_V(0);
    if constexpr (!ALIGN_EPI) { if (wr == 0) PG8_BAR; }
    PG8_BAR;
#undef PG8_SA
#undef PG8_SB
#undef PG8_STAGE
#undef PG8_LDA
#undef PG8_LDB
#undef PG8_MMA
#undef PG8_WAIT_V
#undef PG8_WAIT_L
#undef PG8_BAR
#undef PG8_SCHED
}
}

__device__ __forceinline__ u32x4 pack8(f32x4 a, f32x4 b) { u32x4 w; w.x = pg8::cvt_pk_bf16(a.x, a.y); w.y = pg8::cvt_pk_bf16(a.z, a.w); w.z = pg8::cvt_pk_bf16(b.x, b.y); w.w = pg8::cvt_pk_bf16(b.z, b.w); return w; }
__device__ __forceinline__ void unpack8v(u32x4 w, f32x4& a, f32x4& b) { a.x = bflo(w.x); a.y = bfhi(w.x); a.z = bflo(w.y); a.w = bfhi(w.y); b.x = bflo(w.z); b.y = bfhi(w.z); b.z = bflo(w.w); b.w = bfhi(w.w); }
__device__ __forceinline__ f32x4 sigm4(f32x4 v) { f32x4 r; r.x = sigm(v.x); r.y = sigm(v.y); r.z = sigm(v.z); r.w = sigm(v.w); return r; }

struct OpProj { unsigned char* ws;
    __device__ __forceinline__ void operator()(int z, int row, int col, f32x4 a, f32x4 b) const {
        bf16* p;
        if (col < 16384) p = (bf16*)(ws + WS_SLOT + (size_t)(col >> 11) * SLOT_BYTES) + (size_t)row * 2048 + (col & 2047);
        else if (col < 16640) p = (bf16*)(ws + WS_CKV) + (size_t)row * 256 + (col - 16384);
        else p = (bf16*)(ws + WS_IKW) + (size_t)row * 256 + (col - 16640);
        *(u32x4*)p = pack8(a, b);
    } };
struct OpBf16 { bf16* o; int ld;
    __device__ __forceinline__ void operator()(int z, int row, int col, f32x4 a, f32x4 b) const { *(u32x4*)(o + (size_t)row * ld + col) = pack8(a, b); } };
struct OpSplit2 { bf16* o0; bf16* o1;
    __device__ __forceinline__ void operator()(int z, int row, int col, f32x4 a, f32x4 b) const { bf16* p = (col < 2048 ? o0 : o1) + (size_t)row * 2048 + (col & 2047); *(u32x4*)p = pack8(a, b); } };
struct OpF32 { float* o; int ld;
    __device__ __forceinline__ void operator()(int z, int row, int col, f32x4 a, f32x4 b) const { float* p = o + (size_t)row * ld + col; *(f32x4*)p = a; *(f32x4*)(p + 4) = b; } };
struct OpYA { bf16* ga;
    __device__ __forceinline__ void operator()(int z, int row, int col, f32x4 a, f32x4 b) const { bf16* p = ga + (size_t)row * 2048 + col; f32x4 g0, g1; unpack8v(*(const u32x4*)p, g0, g1);
        *(u32x4*)p = pack8(sigm4(g0) * a, sigm4(g1) * b); } };
struct OpYB { bf16* ga; const bf16* gb;
    __device__ __forceinline__ void operator()(int z, int row, int col, f32x4 a, f32x4 b) const { const size_t i = (size_t)row * 2048 + col; f32x4 m0, m1, g0, g1; unpack8v(*(const u32x4*)(ga + i), m0, m1); unpack8v(*(const u32x4*)(gb + i), g0, g1);
        *(u32x4*)(ga + i) = pack8(m0 + sigm4(g0) * a, m1 + sigm4(g1) * b); } };
struct OpMix { const float* x; float* z;
    __device__ __forceinline__ void operator()(int zi, int row, int col, f32x4 a, f32x4 b) const { const size_t i = (size_t)row * 2048 + col; const f32x4 x0 = *(const f32x4*)(x + i), x1 = *(const f32x4*)(x + i + 4);
        *(f32x4*)(z + i) = ALPHA * x0 + a; *(f32x4*)(z + i + 4) = ALPHA * x1 + b; } };
struct OpRes { float* z;
    __device__ __forceinline__ void operator()(int zi, int row, int col, f32x4 a, f32x4 b) const { const size_t i = (size_t)row * 2048 + col; const f32x4 x0 = *(const f32x4*)(z + i), x1 = *(const f32x4*)(z + i + 4);
        *(f32x4*)(z + i) = ALPHA * x0 + a; *(f32x4*)(z + i + 4) = ALPHA * x1 + b; } };

template <class Op>
__device__ __forceinline__ void gemm(const Frame& F, const bf16* A, int lda, const bf16* Bt, int ldb, int M, int N, int K, const Op& op) {
    pg8::Gemm g{lda, ldb, K}; pg8::MultiOrder<1> S; S.s[0] = pg8::Sub{A, Bt, M / 256, N / 256}; S.lda = lda; S.ldb = ldb; S.G = F.G; S.c = F.bid;
    pg8::Epi8<Op> E{op};
    pg8::gemm_phase<pg8::Epi8<Op>, pg8::MultiOrder<1>, true>((PG8_LAS unsigned char*)F.lds, g, S, E, F.wave, F.lane());
}
template <int NS, class Op>
__device__ __forceinline__ void gemm_multi(const Frame& F, const pg8::MultiOrder<NS>& S, int K, const Op& op) {
    pg8::Gemm g{S.lda, S.ldb, K}; pg8::Epi8<Op> E{op};
    pg8::gemm_phase<pg8::Epi8<Op>, pg8::MultiOrder<NS>, true>((PG8_LAS unsigned char*)F.lds, g, S, E, F.wave, F.lane());
}
template <class Off, class Op>
__device__ __forceinline__ void gemm_batch(const Frame& F, const pg8::BatchOrder<Off>& S, int K, const Op& op) {
    pg8::Gemm g{S.lda, S.ldb, K}; pg8::Epi8<Op> E{op};
    pg8::gemm_phase<pg8::Epi8<Op>, pg8::BatchOrder<Off>, true>((PG8_LAS unsigned char*)F.lds, g, S, E, F.wave, F.lane());
}
struct OffS { __device__ __forceinline__ size_t a(int z) const { return (size_t)(z >> 2) * 2048 * 2048 + (z & 3) * 512; } __device__ __forceinline__ size_t b(int z) const { return (size_t)(z >> 2) * 256 * 2048 + (z & 3) * 512; } };
struct OffPV { __device__ __forceinline__ size_t a(int z) const { return (size_t)(z >> 2) * 2048 * 1024 + (z & 3) * 256; } __device__ __forceinline__ size_t b(int z) const { return (size_t)(z & 3) * 512 * 2048 + (z >> 2) * 256; } };
struct OpLogit { float* lg;
    __device__ __forceinline__ void operator()(int z, int row, int col, f32x4 a, f32x4 b) const { float* p = lg + ((size_t)(z >> 2) * 2048 + row) * 1024 + (z & 3) * 256 + col; *(f32x4*)p = a * 0.04419417382415922f; *(f32x4*)(p + 4) = b * 0.04419417382415922f; } };
struct OpCO { bf16* co;
    __device__ __forceinline__ void operator()(int z, int row, int col, f32x4 a, f32x4 b) const { *(u32x4*)(co + ((size_t)(z >> 2) * 2048 + row) * 2048 + (z & 3) * 512 + col) = pack8(a, b); } };
struct OpCQKV { bf16* cq; bf16* ck; bf16* vt;
    __device__ __forceinline__ void operator()(int z, int row, int col, f32x4 a, f32x4 b) const { bf16* o = z == 0 ? cq : (z == 1 ? ck : vt); *(u32x4*)(o + (size_t)row * 2048 + col) = pack8(a, b); } };
__device__ __forceinline__ void ph_xsoftmax(const Frame& F, const float* lg, bf16* P) {
    const int gw = F.bid * 8 + F.wave, NGW = F.G * 8, lane = F.lane();
    for (int u = gw; u < T * 4; u += NGW) {
        const f32x4 v = *(const f32x4*)(lg + (size_t)u * 256 + 4 * lane);
        const float m = wave_max(fmaxf(fmaxf(v.x, v.y), fmaxf(v.z, v.w)));
        const float e0 = expf(v.x - m), e1 = expf(v.y - m), e2 = expf(v.z - m), e3 = expf(v.w - m);
        const float inv = 1.0f / wave_sum((e0 + e1) + (e2 + e3));
        u32x2 w; w.x = pk2(e0 * inv, e1 * inv); w.y = pk2(e2 * inv, e3 * inv);
        *(u32x2*)(P + (size_t)u * 256 + 4 * lane) = w;
    }
}

template <class CM>
__device__ __forceinline__ void transpose_item(const float* W, size_t ldw, bf16* WT, size_t ldwt, int row_off, int nblk, int item, float* scr, int lane, const CM& cm) {
    const int kb = item / nblk, nb = item % nblk, k0 = 64 * kb, n0 = 32 * nb;
    const int c = cm(n0 + (lane & 31));
#pragma unroll 8
    for (int i = 0; i < 32; ++i) { const int kk = 2 * i + (lane >> 5); scr[kk * 33 + (lane & 31)] = (c >= 0) ? W[(size_t)(k0 + kk) * ldw + c] : 0.f; }
    WAVE_SYNC();
    const int c8 = lane & 7;
#pragma unroll
    for (int j = 0; j < 4; ++j) { const int n = (lane >> 3) + 8 * j; const float* s = scr + (8 * c8) * 33 + n;
        u32x4 o; o.x = pk2(s[0 * 33], s[1 * 33]); o.y = pk2(s[2 * 33], s[3 * 33]); o.z = pk2(s[4 * 33], s[5 * 33]); o.w = pk2(s[6 * 33], s[7 * 33]);
        *(u32x4*)(WT + (size_t)(row_off + n0 + n) * ldwt + k0 + 8 * c8) = o; }
    WAVE_SYNC();
}
struct CmIdent { __device__ __forceinline__ int operator()(int n) const { return n; } };
struct CmWin { __device__ __forceinline__ int operator()(int n) const {
    if (n < 10240) return n;
    if (n < 12288) return 10496 + (n - 10240);
    if (n < 14336) return 12688 + (n - 12288);
    if (n < 16384) return 14736 + (n - 14336);
    if (n < 16640) return 10240 + (n - 16384);
    if (n < 16768) return 12544 + (n - 16640);
    if (n < 16784) return 12672 + (n - 16768);
    return -1; } };

__device__ __forceinline__ void cvt_bf16_stream(const Frame& F, const float* src, bf16* dst, size_t n8) {
    const size_t gt = (size_t)F.bid * 512 + F.wave * 64 + F.lane(), NT = (size_t)F.G * 512;
    for (size_t i = gt; i < n8; i += NT) { const f32x4 a = ((const f32x4*)src)[2 * i], b = ((const f32x4*)src)[2 * i + 1];
        u32x4 o; o.x = pk2(a.x, a.y); o.y = pk2(a.z, a.w); o.z = pk2(b.x, b.y); o.w = pk2(b.z, b.w); ((u32x4*)dst)[i] = o; }
}

__device__ __forceinline__ void ph0_prologue(const Frame& F) {
    const Args& a = *F.a;
    cvt_bf16_stream(F, a.in[0], (bf16*)a.out, (size_t)T * D / 8);
    cvt_bf16_stream(F, a.in[1], (bf16*)(F.ws + WS_MEMB), (size_t)2048 * 2048 / 8);
    float* scr = (float*)(F.lds + F.wave * 16384);
    const int gw = F.bid * 8 + F.wave, NGW = F.G * 8, lane = F.lane();
    {
        const int nblk = NCOLS / 32, nitems = (2048 / 64) * nblk;
        for (int it = gw; it < nitems; it += NGW) transpose_item(a.in[2], 16784, (bf16*)(F.ws + WS_WIN), 2048, 0, nblk, it, scr, lane, CmWin());
    }
    {
        for (int it = gw; it < 32 * 16; it += NGW) { const int mat = it >> 4, which = mat >> 4, h = mat & 15;
            transpose_item(a.in[which ? 9 : 8] + (size_t)h * 256 * 128, 128, (bf16*)(F.ws + WS_WKV), 256, which * 2048 + h * 128, 4, it & 15, scr, lane, CmIdent()); }
    }
    {
        const int gt = F.bid * 512 + F.wave * 64 + lane;
        if (gt < 2048) { const float l0 = a.in[3][gt], l1 = a.in[3][2048 + gt]; ((float*)(F.ws + WS_LB))[gt] = 1.0f / (1.0f + expf(l1 - l0)); }
    }
}

__device__ __forceinline__ void hgrn_naive(const Frame& F, int unit) {
    const int b = unit >> 4, h = unit & 15, tid = F.wave * 64 + F.lane();
    float* qs = (float*)F.lds; float* fs = qs + 128; float* ks = fs + 128; float* part = ks + 128;
    const bf16* HQ = F.slot(0); const bf16* HF = F.slot(1); const bf16* HI = F.slot(2);
    float* oraw = F.a->out;
    const int dv = tid & 127, kq = tid >> 7;
    float S[32];
#pragma unroll
    for (int j = 0; j < 32; ++j) S[j] = 0.f;
    const float lb = ((const float*)(F.ws + WS_LB))[h * 128 + dv];
    const size_t base = (size_t)b * 2048 * 2048 + h * 128;
    unsigned short qn = HQ[base + dv], fn = HF[base + dv], vn = HI[base + dv];
    for (int t = 0; t < 2048; ++t) {
        const size_t off = base + (size_t)t * 2048;
        if (tid < 128) { const float f = lb + (1.0f - lb) * sigm(bf2f(fn)); qs[tid] = bf2f(qn); fs[tid] = f; ks[tid] = 1.0f - f; }
        const float v = bf2f(vn);
        if (t + 1 < 2048) { qn = HQ[off + 2048 + dv]; fn = HF[off + 2048 + dv]; vn = HI[off + 2048 + dv]; }
        __syncthreads();
        float acc = 0.f;
#pragma unroll
        for (int j = 0; j < 32; ++j) { const int dk = kq * 32 + j; S[j] = fs[dk] * S[j] + ks[dk] * v; acc += qs[dk] * S[j]; }
        part[kq * 128 + dv] = acc;
        __syncthreads();
        if (tid < 128) oraw[off + tid] = (part[tid] + part[128 + tid]) + (part[256 + tid] + part[384 + tid]);
    }
    __syncthreads();
}

__device__ __forceinline__ void ph2_side(const Frame& F, int sid, int nside) {
    const Args& a = *F.a;
    const int gw = sid * 8 + F.wave, NGW = nside * 8, lane = F.lane();
    bf16* CKV = (bf16*)(F.ws + WS_CKV); bf16* IKW = (bf16*)(F.ws + WS_IKW);
    for (int row = gw; row < T; row += NGW) {
        {   u32x2 w = *(u32x2*)(CKV + (size_t)row * 256 + 4 * lane);
            float x0 = bflo(w.x), x1 = bfhi(w.x), x2 = bflo(w.y), x3 = bfhi(w.y);
            const float ss = wave_sum(x0 * x0 + x1 * x1 + x2 * x2 + x3 * x3);
            const float r = rsqrtf(ss * (1.0f / 256.0f) + 1e-6f);
            const f32x4 g = *(const f32x4*)(a.in[5] + 4 * lane);
            w.x = pk2(x0 * r * g.x, x1 * r * g.y); w.y = pk2(x2 * r * g.z, x3 * r * g.w);
            *(u32x2*)(CKV + (size_t)row * 256 + 4 * lane) = w; }
        {   unsigned w = *(unsigned*)(IKW + (size_t)row * 256 + 2 * lane);
            float x0 = bflo(w), x1 = bfhi(w);
            const float mu = wave_sum(x0 + x1) * (1.0f / 128.0f);
            x0 -= mu; x1 -= mu;
            const float var = wave_sum(x0 * x0 + x1 * x1) * (1.0f / 128.0f);
            const float r = rsqrtf(var + 1e-5f);
            const float g0 = a.in[6][2 * lane], g1 = a.in[6][2 * lane + 1], b0 = a.in[7][2 * lane], b1 = a.in[7][2 * lane + 1];
            *(unsigned*)(IKW + (size_t)row * 256 + 2 * lane) = pk2(x0 * r * g0 + b0, x1 * r * g1 + b1); }
    }
    float* scr = (float*)(F.lds + F.wave * 16384);
    for (int it = gw; it < 8 * 2048; it += NGW) { const int m = it >> 11;
        const float* wsrc = m == 0 ? a.in[11] : m == 1 ? a.in[12] : m == 2 ? a.in[13] : m == 3 ? a.in[16] : m == 4 ? a.in[17] : m == 5 ? a.in[18] : m == 6 ? a.in[19] : a.in[22];
        transpose_item(wsrc, 2048, (bf16*)(F.ws + WS_WIN + (size_t)m * 8 * MiB), 2048, 0, 64, it & 2047, scr, lane, CmIdent()); }
}

__device__ __forceinline__ void ph3_hgnorm(const Frame& F) {
    const Args& a = *F.a;
    const int gw = F.bid * 8 + F.wave, NGW = F.G * 8, lane = F.lane();
    const float* oraw = a.out; const bf16* HG = F.slot(3); bf16* HO = F.slot(0);
    for (int u = gw; u < T * 16; u += NGW) {
        const size_t off = (size_t)(u >> 4) * 2048 + (u & 15) * 128 + 2 * lane;
        const float o0 = oraw[off], o1 = oraw[off + 1];
        const float r = rsqrtf(wave_sum(o0 * o0 + o1 * o1) * (1.0f / 128.0f) + 1e-6f);
        const unsigned gw2 = *(const unsigned*)(HG + off);
        const float g0 = bflo(gw2), g1 = bfhi(gw2);
        const int c = (u & 15) * 128 + 2 * lane;
        *(unsigned*)(HO + off) = pk2(o0 * r * a.in[4][c] * (g0 * sigm(g0)), o1 * r * a.in[4][c + 1] * (g1 * sigm(g1)));
    }
}

__device__ __forceinline__ unsigned fkey(float f) { const unsigned u = __float_as_uint(f); return (u & 0x80000000u) ? ~u : (u | 0x80000000u); }
__device__ __forceinline__ void ph5_select(const Frame& F) {
    const int gw = F.bid * 8 + F.wave, NGW = F.G * 8, lane = F.lane();
    float* iq = (float*)(F.lds + F.wave * 16384);
    float* scl = iq + 2048;
    const bf16* AIQ = F.slot(5); const bf16* IKW = (const bf16*)(F.ws + WS_IKW);
    unsigned* MASK = (unsigned*)(F.ws + WS_MASK);
    for (int idx = gw; idx < T; idx += NGW) {
        const int b = idx >> 11, tt = idx & 2047, t = (b & 1) ? 2047 - tt : tt;
        const size_t row = (size_t)b * 2048 + t;
        {
#pragma unroll
            for (int i = 0; i < 4; ++i) { const u32x4 w = *(const u32x4*)(AIQ + row * 2048 + 512 * i + 8 * lane); float f[8]; unpack8(w, f);
#pragma unroll
                for (int j = 0; j < 8; ++j) iq[512 * i + 8 * lane + j] = f[j]; }
        }
        float wv = 0.f;
        if (lane < 16) wv = bf2f(IKW[row * 256 + 128 + lane]) * (0.25f * 0.08838834764831845f);
        WAVE_SYNC();
        const int nj = (t >> 6) + 1;
        for (int j = 0; j < nj; ++j) {
            const int s = lane + 64 * j, sc = s <= t ? s : t;
            const bf16* kr = IKW + ((size_t)b * 2048 + sc) * 256;
            float dot[16];
#pragma unroll
            for (int h = 0; h < 16; ++h) dot[h] = 0.f;
            for (int c = 0; c < 16; ++c) {
                float kf[8]; unpack8(*(const u32x4*)(kr + 8 * c), kf);
#pragma unroll
                for (int h = 0; h < 16; ++h) { const f32x4 q0 = *(const f32x4*)(iq + h * 128 + 8 * c), q1 = *(const f32x4*)(iq + h * 128 + 8 * c + 4);
                    dot[h] += kf[0] * q0.x + kf[1] * q0.y + kf[2] * q0.z + kf[3] * q0.w + kf[4] * q1.x + kf[5] * q1.y + kf[6] * q1.z + kf[7] * q1.w; }
            }
            float score = 0.f;
#pragma unroll
            for (int h = 0; h < 16; ++h) score += fmaxf(dot[h], 0.f) * __shfl(wv, h);
            scl[s] = score;
        }
        WAVE_SYNC();
        unsigned key[32];
#pragma unroll
        for (int j = 0; j < 32; ++j) { const int s = lane + 64 * j; key[j] = (s <= t) ? fkey(scl[s]) : 0u; }
        unsigned thr = 0u;
        if (t + 1 > 256) {
            for (int bit = 31; bit >= 0; --bit) {
                const unsigned cand = thr | (1u << bit);
                int cnt = 0;
#pragma unroll
                for (int j = 0; j < 32; ++j) cnt += __popcll(__ballot(key[j] >= cand));
                if (cnt >= 256) thr = cand;
            }
        }
        unsigned w = 0u;
#pragma unroll
        for (int j = 0; j < 32; ++j) { const int s = lane + 64 * j; const unsigned long long m = __ballot(s <= t && key[j] >= thr);
            if (lane == 2 * j) w = (unsigned)m; if (lane == 2 * j + 1) w = (unsigned)(m >> 32); }
        MASK[row * 64 + lane] = w;
        WAVE_SYNC();
    }
}

__device__ __forceinline__ int t5_bucket(int d) {
    if (d < 16) return d;
    return 16 + (d >= 19) + (d >= 21) + (d >= 24) + (d >= 27) + (d >= 31) + (d >= 35) + (d >= 40) + (d >= 46) + (d >= 52) + (d >= 59) + (d >= 67) + (d >= 77) + (d >= 87) + (d >= 99) + (d >= 113);
}
namespace dsa {
constexpr float SCALE = 0.08838834764831845f;
constexpr int NW = 8, QBLK = 32, KVBLK = 64, QB = NW * QBLK, DH = 128, LD = 2048;
constexpr int SHM_V = KVBLK * DH * 2, SHM_K = KVBLK * DH * 2;
constexpr int OFF_WS = 2 * SHM_V + 2 * SHM_K, OFF_BIAS = OFF_WS + NW * 64 * 4, LDS_TOTAL = OFF_BIAS + 16 * 128 * 4;
constexpr float THR = 8.f;
typedef short s16x4 __attribute__((ext_vector_type(4)));
#define KSWZ(row, colB) ((row) * 256 + ((colB) ^ (((row) & 7) << 4)))
#define SBAR() __builtin_amdgcn_sched_barrier(0)
__device__ __forceinline__ int v_st(int k, int c) { const int kk = (k & ~0xC) | ((k & 4) << 1) | ((k & 8) >> 1); return ((kk >> 3) * 4 + (c >> 5)) * 512 + ((kk & 7) * 32 + (c & 31)) * 2; }
__device__ __forceinline__ int v_rd_base(int lane) { return ((lane & 3) << 3) | (((lane >> 2) & 3) << 6) | (((lane >> 4) & 1) << 5) | (((lane >> 5) & 1) << 8); }
constexpr int v_rd_off(int d0, int ks, int half) { return d0 * 512 + ks * 4096 + half * 2048; }
__device__ __forceinline__ int crow(int r, int hi) { return (r & 3) + 8 * (r >> 2) + 4 * hi; }
__device__ __forceinline__ unsigned cvtpk(float lo, float hi) { unsigned r; asm volatile("v_cvt_pk_bf16_f32 %0, %1, %2" : "=v"(r) : "v"(lo), "v"(hi)); return r; }
__device__ __forceinline__ bf16x8 load8(const bf16* p) { return *reinterpret_cast<const bf16x8*>(p); }
template <bool NEAR>
__device__ __forceinline__ void init_scores(f32x16& p0, f32x16& p1, unsigned w0, unsigned w1, int hi, int dq, const float* bl) {
    w0 >>= 4 * hi; w1 >>= 4 * hi;
#pragma unroll
    for (int r = 0; r < 16; ++r) { const int c = (r & 3) + 8 * (r >> 2);
        const int x0 = __builtin_amdgcn_sbfe(w0, c, 1), x1 = __builtin_amdgcn_sbfe(w1, c, 1);
        unsigned b0 = 0u, b1 = 0u;
        if (NEAR) { int d0 = dq - c, d1 = dq - c - 32; d0 = d0 < 0 ? 0 : (d0 > 127 ? 127 : d0); d1 = d1 < 0 ? 0 : (d1 > 127 ? 127 : d1);
            b0 = __float_as_uint(bl[d0]); b1 = __float_as_uint(bl[d1]); }
        p0[r] = __uint_as_float((b0 & (unsigned)x0) | (0xFF800000u & ~(unsigned)x0));
        p1[r] = __uint_as_float((b1 & (unsigned)x1) | (0xFF800000u & ~(unsigned)x1)); }
}
__device__ __forceinline__ void partialSM(f32x16& p0, f32x16& p1, float& m_reg, float& mn, float& alpha) {
    float pmax = p0[0];
#pragma unroll
    for (int r = 1; r < 16; ++r) pmax = fmaxf(pmax, p0[r]);
#pragma unroll
    for (int r = 0; r < 16; ++r) pmax = fmaxf(pmax, p1[r]);
    { auto rr = __builtin_amdgcn_permlane32_swap(__float_as_uint(pmax), __float_as_uint(pmax), false, false);
      pmax = fmaxf(__uint_as_float(rr[0]), __uint_as_float(rr[1])); }
    constexpr float C2 = 1.4426950408889634f * SCALE;
    if (__builtin_expect(__all((pmax - m_reg) * SCALE <= THR), 1)) { mn = m_reg; alpha = 1.f; }
    else { mn = fmaxf(m_reg, pmax); alpha = __builtin_amdgcn_exp2f((m_reg - mn) * C2); m_reg = mn; }
    const float mnL = -mn * C2;
#pragma unroll
    for (int r = 0; r < 16; ++r) p0[r] = fmaf(p0[r], C2, mnL);
#pragma unroll
    for (int r = 0; r < 16; ++r) p1[r] = fmaf(p1[r], C2, mnL);
#pragma unroll
    for (int r = 0; r < 16; ++r) p0[r] = __builtin_amdgcn_exp2f(p0[r]);
}
__device__ __forceinline__ void finishSM(f32x16& p0, f32x16& p1, float alpha, float& l_reg, bf16x8& pa0, bf16x8& pa1, bf16x8& pa2, bf16x8& pa3) {
#pragma unroll
    for (int r = 0; r < 16; ++r) p1[r] = __builtin_amdgcn_exp2f(p1[r]);
    float ps = 0;
#pragma unroll
    for (int r = 0; r < 16; ++r) ps += p0[r];
#pragma unroll
    for (int r = 0; r < 16; ++r) ps += p1[r];
    { auto rr = __builtin_amdgcn_permlane32_swap(__float_as_uint(ps), __float_as_uint(ps), false, false);
      ps = __uint_as_float(rr[0]) + __uint_as_float(rr[1]); }
    l_reg = l_reg * alpha + ps;
#define PK4(P, B_, OUT) do { unsigned a0 = cvtpk(P[B_+0], P[B_+1]), a1 = cvtpk(P[B_+2], P[B_+3]);                          \
        unsigned b0 = cvtpk(P[B_+4], P[B_+5]), b1 = cvtpk(P[B_+6], P[B_+7]);                                             \
        auto r0 = __builtin_amdgcn_permlane32_swap(a0, b0, false, false); auto r1 = __builtin_amdgcn_permlane32_swap(a1, b1, false, false); \
        u32x4 w = {r0[0], r1[0], r0[1], r1[1]}; OUT = *reinterpret_cast<bf16x8*>(&w); } while (0)
    PK4(p0, 0, pa0); PK4(p0, 8, pa1); PK4(p1, 0, pa2); PK4(p1, 8, pa3);
#undef PK4
}
template <int KB>
__device__ __forceinline__ void qkt(f32x16& p0, f32x16& p1, const char* K_lds, int r32, int hi, const bf16x8* qr) {
    const char* kb[4];
#pragma unroll
    for (int dd = 0; dd < 4; ++dd) kb[dd] = K_lds + KB * SHM_K + KSWZ(r32, (dd * 16 + hi * 8) * 2);
#pragma unroll
    for (int d0 = 0; d0 < 8; ++d0) { const char* a = kb[d0 & 3] + (d0 >> 2) * 128;
        bf16x8 b0 = *reinterpret_cast<const bf16x8*>(a);
        bf16x8 b1 = *reinterpret_cast<const bf16x8*>(a + 32 * 256);
        p0 = __builtin_amdgcn_mfma_f32_32x32x16_bf16(b0, qr[d0], p0, 0, 0, 0);
        p1 = __builtin_amdgcn_mfma_f32_32x32x16_bf16(b1, qr[d0], p1, 0, 0, 0); }
}
template <int VB>
__device__ __forceinline__ void pv_tile(f32x16* o, int vb0, bf16x8 pa0, bf16x8 pa1, bf16x8 pa2, bf16x8 pa3) {
#define TRRD(dst, off) asm volatile("ds_read_b64_tr_b16 %0, %1 offset:%2" : "=&v"(dst) : "v"(vb0), "i"(off) : "memory")
#define PV_D0(d0) do { s16x4 l0, l1, l2, l3, h0, h1, h2, h3; constexpr int b_ = VB * SHM_V + v_rd_off(d0, 0, 0); \
        TRRD(l0, b_); TRRD(h0, b_ + 2048); TRRD(l1, b_ + 4096); TRRD(h1, b_ + 6144); TRRD(l2, b_ + 8192); TRRD(h2, b_ + 10240); TRRD(l3, b_ + 12288); TRRD(h3, b_ + 14336); \
        asm volatile("s_waitcnt lgkmcnt(0)" ::: "memory"); SBAR();   \
        o[d0] = __builtin_amdgcn_mfma_f32_32x32x16_bf16(pa0, (bf16x8){l0[0], l0[1], l0[2], l0[3], h0[0], h0[1], h0[2], h0[3]}, o[d0], 0, 0, 0);   \
        o[d0] = __builtin_amdgcn_mfma_f32_32x32x16_bf16(pa1, (bf16x8){l1[0], l1[1], l1[2], l1[3], h1[0], h1[1], h1[2], h1[3]}, o[d0], 0, 0, 0);   \
        o[d0] = __builtin_amdgcn_mfma_f32_32x32x16_bf16(pa2, (bf16x8){l2[0], l2[1], l2[2], l2[3], h2[0], h2[1], h2[2], h2[3]}, o[d0], 0, 0, 0);   \
        o[d0] = __builtin_amdgcn_mfma_f32_32x32x16_bf16(pa3, (bf16x8){l3[0], l3[1], l3[2], l3[3], h3[0], h3[1], h3[2], h3[3]}, o[d0], 0, 0, 0); } while (0)
    PV_D0(0); PV_D0(1); PV_D0(2); PV_D0(3);
#undef PV_D0
#undef TRRD
}
struct BlockRef { const bf16* Q; const bf16* K; const bf16* V; bf16* O; const unsigned* M; int P0; int h; };
struct Seam { bf16x8 qr[8]; bf16x8 st_v0, st_v1, st_k0, st_k1; };
#define ROWU(p, k0) ((p) + (size_t)(k0) * LD)
#define VMW() asm volatile("s_waitcnt vmcnt(0)" ::: "memory")
#define VMWN(n) asm volatile("s_waitcnt vmcnt(%0)" :: "i"(n) : "memory")
#define SLOAD_H(Kp, Vp, k0) do { S.st_v0 = load8(ROWU(Vp, k0) + sofs); S.st_v1 = load8(ROWU(Vp, (k0) + 32) + sofs);              \
                         S.st_k0 = load8(ROWU(Kp, k0) + sofs); S.st_k1 = load8(ROWU(Kp, (k0) + 32) + sofs); } while (0)
#define SWRITE_HK(bf) do { *(bf16x8*)(K_lds + (bf) * SHM_K + kws) = S.st_k0; *(bf16x8*)(K_lds + (bf) * SHM_K + kws + 32 * 256) = S.st_k1; } while (0)
#define SWRITE_HV(bf) do { *(bf16x8*)(V_lds + (bf) * SHM_V + vst0) = S.st_v0; *(bf16x8*)(V_lds + (bf) * SHM_V + vst1) = S.st_v1; } while (0)
#define SWRITE_H(bf) do { SWRITE_HV(bf); SWRITE_HK(bf); } while (0)
__device__ __forceinline__ void prime(const BlockRef& cur, char* lds, Seam& S, int wid) {
    const int lane = fresh_lane(), tid = wid * 64 + lane, r32 = lane & 31, hi = lane >> 5;
    const int sr = tid >> 4, sc = (tid & 15) * 8, kws = KSWZ(sr, sc * 2); char* K_lds = lds + 2 * SHM_V; const unsigned sofs = (unsigned)(sr * LD + sc);
    const unsigned qofs = (unsigned)((wid * QBLK + r32) * LD + hi * 8);
#pragma unroll
    for (int d0 = 0; d0 < 8; ++d0) S.qr[d0] = load8(cur.Q + qofs + d0 * 16);
    SLOAD_H(cur.K, cur.V, 0); VMW(); SWRITE_HK(0);
    __syncthreads();
}
__device__ __forceinline__ void block(const BlockRef& cur, const BlockRef& nxt, char* lds, Seam& S, int wid) {
    const int lane = fresh_lane(), tid = wid * 64 + lane,
               r32 = lane & 31, hi = lane >> 5;
    const int NT = (cur.P0 + QB - 1) / KVBLK + 1;
    const int qlo = cur.P0 + wid * QBLK, qm = qlo + r32 - 4 * hi;
    char* V_lds = lds; char* K_lds = lds + 2 * SHM_V;
    float* ws = (float*)(lds + OFF_WS) + wid * 64; float* li_l = ws, * al_l = ws + 32;
    const float* bl = (const float*)(lds + OFF_BIAS) + cur.h * 128;
    const unsigned mofs = (unsigned)((wid * QBLK + r32) * 64);
    float m_reg = -1e30f, l_reg = 0; f32x16 o[4] = {};
    const int sr = tid >> 4, sc = (tid & 15) * 8, vst0 = v_st(sr, sc), vst1 = v_st(32 + sr, sc), kws = KSWZ(sr, sc * 2); const unsigned sofs = (unsigned)(sr * LD + sc);
    const int vb0 = (int)(uintptr_t)V_lds + v_rd_base(lane);
    const bf16* Kh = cur.K; const bf16* Vh = cur.V;
#define RESC(a) do { if (__any((a) < 1.f)) { if (hi == 0) al_l[r32] = (a); asm volatile("s_waitcnt lgkmcnt(0)" ::: "memory");              \
                     for (int d_ = 0; d_ < 4; ++d_) for (int r = 0; r < 16; ++r) o[d_][r] *= al_l[crow(r, hi)]; } } while (0)
#define KBASE(t) ((t) * KVBLK)
#define LDMASK(t) (*(const u32x2*)(cur.M + 2 * ((t) < 31 ? (t) : 31) + mofs))
#define INIT(P0_, P1_, t) do { const int kb_ = KBASE(t); if (qlo - kb_ - 63 < 113) init_scores<true>(P0_, P1_, mw.x, mw.y, hi, qm - kb_, bl); else init_scores<false>(P0_, P1_, mw.x, mw.y, hi, 0, bl); } while (0)
#define SEAM_K0() do { VMWN(8); SWRITE_HK(0); SBAR(); } while (0)
    f32x16 pA0, pA1, pB0, pB1; float mnA, mnB, alA, alB; bf16x8 pa0, pa1, pa2, pa3; u32x2 mw;
    SWRITE_HV(0); SBAR();
    if (NT > 1) { SLOAD_H(Kh, Vh, KBASE(1)); }
    mw = LDMASK(0); INIT(pA0, pA1, 0); mw = LDMASK(1);
    SBAR(); qkt<0>(pA0, pA1, K_lds, r32, hi, S.qr);
    partialSM(pA0, pA1, m_reg, mnA, alA);
    if (NT > 1) { VMW(); SWRITE_H(1); }
    __syncthreads();
#define HALF_STEP(PX0, PX1, mnX, alX, PY0, PY1, alY, t, KB, VB, SB) do {                                                      \
        INIT(PX0, PX1, (t)); mw = LDMASK((t) + 1);                                                                           \
        SBAR(); qkt<KB>(PX0, PX1, K_lds, r32, hi, S.qr);                                                                      \
        finishSM(PY0, PY1, alY, l_reg, pa0, pa1, pa2, pa3); SBAR();                                                           \
        if ((t) + 1 < NT) { SLOAD_H(Kh, Vh, KBASE((t) + 1)); SBAR(); }                                                        \
        pv_tile<VB>(o, vb0, pa0, pa1, pa2, pa3); partialSM(PX0, PX1, m_reg, mnX, alX);              \
        __syncthreads();                                                                                                      \
        if ((t) + 1 < NT) { VMW(); SWRITE_H(SB); }                                                                            \
        RESC(alX); __syncthreads(); } while (0)
    for (int t = 1; t + 1 < NT; t += 2) {
        HALF_STEP(pB0, pB1, mnB, alB, pA0, pA1, alA, t, 1, 0, 0);
        HALF_STEP(pA0, pA1, mnA, alA, pB0, pB1, alB, t + 1, 0, 1, 1);
    }
    const bool even = (NT & 1) == 0;
    if (even) { INIT(pB0, pB1, NT - 1); SBAR(); qkt<1>(pB0, pB1, K_lds, r32, hi, S.qr); SBAR(); }
    SLOAD_H(nxt.K, nxt.V, 0); SBAR();
#pragma unroll
    for (int d0 = 0; d0 < 8; ++d0) S.qr[d0] = load8(nxt.Q + (unsigned)((wid * QBLK + r32) * LD + hi * 8) + d0 * 16);
    SBAR();
    finishSM(pA0, pA1, alA, l_reg, pa0, pa1, pa2, pa3); SBAR();
    pv_tile<0>(o, vb0, pa0, pa1, pa2, pa3);
    if (even) { partialSM(pB0, pB1, m_reg, mnB, alB); __syncthreads(); RESC(alB);
        finishSM(pB0, pB1, alB, l_reg, pa0, pa1, pa2, pa3); SBAR(); pv_tile<1>(o, vb0, pa0, pa1, pa2, pa3); }
    SBAR(); SEAM_K0();
    if (hi == 0) li_l[r32] = l_reg; asm volatile("s_waitcnt lgkmcnt(0)" ::: "memory");
    float rli[16];
#pragma unroll
    for (int r = 0; r < 16; ++r) rli[r] = __builtin_amdgcn_rcpf(li_l[crow(r, hi)]);
    int lofs = 4 * hi * LD + r32; asm volatile("" : "+v"(lofs));
    bf16* Ow = cur.O + (size_t)(wid * QBLK) * LD + lofs;
#pragma unroll
    for (int r = 0; r < 16; ++r) { const int orow = (r & 3) + 8 * (r >> 2);
#pragma unroll
        for (int d0 = 0; d0 < 4; ++d0) { const float v = o[d0][r] * rli[r];
            const float vn = __shfl_xor(v, 1);
            if ((r32 & 1) == 0) *(unsigned*)(Ow + orow * LD + d0 * 32) = cvtpk(v, vn); } }
    __syncthreads();
#undef RESC
#undef KBASE
#undef LDMASK
#undef INIT
#undef SEAM_K0
#undef HALF_STEP
}
#undef ROWU
#undef VMW
#undef VMWN
#undef SLOAD_H
#undef SWRITE_HK
#undef SWRITE_HV
#undef SWRITE_H
#undef KSWZ
#undef SBAR
}

__device__ __forceinline__ dsa::BlockRef dsa_ref(const Frame& F, int bh, int qb) {
    const int b = bh >> 4, h = bh & 15;
    dsa::BlockRef r;
    r.Q = F.slot(4) + ((size_t)b * 2048 + (size_t)qb * 256) * 2048 + h * 128;
    r.O = F.slot(3) + ((size_t)b * 2048 + (size_t)qb * 256) * 2048 + h * 128;
    r.K = F.slot(1) + (size_t)b * 2048 * 2048 + h * 128; r.V = F.slot(2) + (size_t)b * 2048 * 2048 + h * 128;
    r.M = (const unsigned*)(F.ws + WS_MASK) + ((size_t)b * 2048 + (size_t)qb * 256) * 64;
    r.P0 = qb * 256; r.h = h;
    return r;
}
__device__ __forceinline__ void ph6_attn(const Frame& F) {
    const Args& a = *F.a;
    char* lds = (char*)F.lds;
    {
        float* bt = (float*)(lds + dsa::OFF_BIAS);
        for (int i = F.wave * 64 + F.lane(); i < 16 * 128; i += 512) { const int h = i >> 7, d = i & 127; bt[i] = (a.in[10][t5_bucket(d) * 16 + h] - a.in[10][31 * 16 + h]) * (1.0f / dsa::SCALE); }
    }
    __syncthreads();
    const int total = 4 * 128;
    int L = F.bid; if (L >= total) return;
    int pass = 0;
    dsa::BlockRef cur = dsa_ref(F, L >> 2, L & 3);
    dsa::Seam S;
    dsa::prime(cur, lds, S, F.wave);
    for (;;) {
        const bool more_pass = pass == 0, more_item = L + F.G < total, last = !more_pass && !more_item;
        int passn = pass + 1, Ln = L;
        if (!more_pass) { passn = 0; Ln = more_item ? L + F.G : L; }
        const dsa::BlockRef nxt = last ? cur : dsa_ref(F, Ln >> 2, passn ? 7 - (Ln & 3) : (Ln & 3));
        dsa::block(cur, nxt, lds, S, F.wave);
        if (last) break;
        cur = nxt; pass = passn; L = Ln;
    }
}

__device__ __forceinline__ void ln_row(float* zrow, const float* g, const float* bta, bf16* brow, int lane) {
    f32x4 v[8]; float s = 0.f;
#pragma unroll
    for (int i = 0; i < 8; ++i) { v[i] = *(const f32x4*)(zrow + 256 * i + 4 * lane); s += (v[i].x + v[i].y) + (v[i].z + v[i].w); }
    const float mu = wave_sum(s) * (1.0f / 2048.0f); float s2 = 0.f;
#pragma unroll
    for (int i = 0; i < 8; ++i) { v[i] = v[i] - mu; s2 += (v[i].x * v[i].x + v[i].y * v[i].y) + (v[i].z * v[i].z + v[i].w * v[i].w); }
    const float r = rsqrtf(wave_sum(s2) * (1.0f / 2048.0f) + 1e-5f);
#pragma unroll
    for (int i = 0; i < 8; ++i) { const f32x4 gg = *(const f32x4*)(g + 256 * i + 4 * lane), bb = *(const f32x4*)(bta + 256 * i + 4 * lane);
        const f32x4 o = v[i] * r * gg + bb; *(f32x4*)(zrow + 256 * i + 4 * lane) = o;
        if (brow) { u32x2 w; w.x = pk2(o.x, o.y); w.y = pk2(o.z, o.w); *(u32x2*)(brow + 256 * i + 4 * lane) = w; } }
}
__device__ __forceinline__ void ph_ln(const Frame& F, const float* g, const float* bta, bf16* bout) {
    const int gw = F.bid * 8 + F.wave, NGW = F.G * 8, lane = F.lane();
    for (int row = gw; row < T; row += NGW) ln_row(F.a->out + (size_t)row * 2048, g, bta, bout + (size_t)row * 2048, lane);
}

__device__ __forceinline__ void ph15_peer_select(const Frame& F) {
    const Args& a = *F.a;
    const int gw = F.bid * 8 + F.wave, NGW = F.G * 8, lane = F.lane();
    float* q = (float*)(F.lds + F.wave * 16384);
    const float* PQ = (const float*)F.slot(1);
    const float* keys = a.in[23];
    int* EIDX = (int*)(F.ws + WS_CKV); float* EG = (float*)(F.ws + WS_IKW);
    for (int t = gw; t < T; t += NGW) {
#pragma unroll
        for (int i = 0; i < 8; ++i) *(f32x4*)(q + 256 * i + 4 * lane) = *(const f32x4*)(PQ + (size_t)t * 2048 + 256 * i + 4 * lane);
        WAVE_SYNC();
        for (int h = 0; h < 8; ++h) {
            float tv[2]; int ti[2];
#pragma unroll
            for (int p = 0; p < 2; ++p) {
                const float* qq = q + h * 256 + p * 128;
                const float* k0 = keys + ((size_t)(h * 2 + p) * 128 + lane) * 128; const float* k1 = k0 + 64 * 128;
                float v0 = 0.f, v1 = 0.f;
#pragma unroll 4
                for (int d = 0; d < 128; d += 4) { const f32x4 qv = *(const f32x4*)(qq + d), a0 = *(const f32x4*)(k0 + d), a1 = *(const f32x4*)(k1 + d);
                    v0 += qv.x * a0.x + qv.y * a0.y + qv.z * a0.z + qv.w * a0.w; v1 += qv.x * a1.x + qv.y * a1.y + qv.z * a1.z + qv.w * a1.w; }
                float mv = 0.f; int mi = 0;
                for (int k = 0; k < 16; ++k) {
                    const float m = wave_max(fmaxf(v0, v1));
                    const unsigned long long b0 = __ballot(v0 == m);
                    int nidx;
                    if (b0) { const int src = __ffsll((long long)b0) - 1; nidx = src; if (lane == src) v0 = -INFINITY; }
                    else { const unsigned long long b1 = __ballot(v1 == m); const int src = __ffsll((long long)b1) - 1; nidx = src + 64; if (lane == src) v1 = -INFINITY; }
                    if (lane == k) { mv = m; mi = nidx; }
                }
                tv[p] = mv; ti[p] = mi;
            }
            float cand[4];
#pragma unroll
            for (int m4 = 0; m4 < 4; ++m4) { const int c = lane + 64 * m4; cand[m4] = __shfl(tv[0], c >> 4) + __shfl(tv[1], c & 15); }
            float sv = -INFINITY; int sc = 0;
            for (int k = 0; k < 16; ++k) {
                const float m = wave_max(fmaxf(fmaxf(cand[0], cand[1]), fmaxf(cand[2], cand[3])));
                int c = -1;
#pragma unroll
                for (int m4 = 0; m4 < 4; ++m4) { if (c < 0) { const unsigned long long bm = __ballot(cand[m4] == m); if (bm) { const int src = __ffsll((long long)bm) - 1; c = src + 64 * m4; if (lane == src) cand[m4] = -INFINITY; } } }
                if (lane == k) { sv = m; sc = c; }
            }
            const float mx = __shfl(sv, 0);
            const float e = lane < 16 ? expf(sv - mx) : 0.f;
            const float den = wave_sum(e);
            const int i1 = __shfl(ti[0], sc >> 4), i2 = __shfl(ti[1], sc & 15);
            if (lane < 16) { EIDX[(size_t)t * 128 + h * 16 + lane] = i1 * 128 + i2; EG[(size_t)t * 128 + h * 16 + lane] = e / den; }
        }
        WAVE_SYNC();
    }
}

typedef __bf16 bf16x2_t __attribute__((ext_vector_type(2)));
__device__ __forceinline__ float dot2bf(unsigned a, unsigned b, float c) { return __builtin_amdgcn_fdot2_f32_bf16(__builtin_bit_cast(bf16x2_t, a), __builtin_bit_cast(bf16x2_t, b), c, false); }
#define RL(v, l) __builtin_amdgcn_readlane((v), (l))
#define EXR 2
#define EX_LOAD(buf, tab, idv, e) do { _Pragma("unroll") for (int r_ = 0; r_ < EXR; ++r_) { const bf16* rp_ = (tab) + (size_t)RL(idv, ((e) & 63) + r_) * 2048 + 8 * lane; \
        _Pragma("unroll") for (int c_ = 0; c_ < 4; ++c_) buf[r_][c_] = *(const u32x4*)(rp_ + 512 * c_); } } while (0)
#define EX_DOT(buf, e) do { float d_[EXR]; _Pragma("unroll") for (int r_ = 0; r_ < EXR; ++r_) { float a_ = 0.f, b_ = 0.f; \
        _Pragma("unroll") for (int c_ = 0; c_ < 4; ++c_) { a_ = dot2bf(buf[r_][c_].x, xb[c_].x, a_); b_ = dot2bf(buf[r_][c_].y, xb[c_].y, b_); a_ = dot2bf(buf[r_][c_].z, xb[c_].z, a_); b_ = dot2bf(buf[r_][c_].w, xb[c_].w, b_); } d_[r_] = a_ + b_; } \
        _Pragma("unroll") for (int o_ = 32; o_ >= 1; o_ >>= 1) { _Pragma("unroll") for (int r_ = 0; r_ < EXR; ++r_) d_[r_] += __shfl_xor(d_[r_], o_); } \
        _Pragma("unroll") for (int r_ = 0; r_ < EXR; ++r_) { const float hv_ = 0.5f * d_[r_] * (1.0f + erff(d_[r_] * 0.7071067811865476f)); if (lane == (((e) & 63) + r_)) { if ((e) < 64) c0 = g0 * hv_; else c1 = g1 * hv_; } } } while (0)
#define EX_AXPY(buf, e) do { const float cv_ = (e) < 64 ? c0 : c1; _Pragma("unroll") for (int r_ = 0; r_ < EXR; ++r_) { const float cf_ = __int_as_float(RL(__float_as_int(cv_), ((e) & 63) + r_)); \
        _Pragma("unroll") for (int c_ = 0; c_ < 4; ++c_) { y[c_][0] += cf_ * bflo(buf[r_][c_].x); y[c_][1] += cf_ * bfhi(buf[r_][c_].x); y[c_][2] += cf_ * bflo(buf[r_][c_].y); y[c_][3] += cf_ * bfhi(buf[r_][c_].y); \
            y[c_][4] += cf_ * bflo(buf[r_][c_].z); y[c_][5] += cf_ * bfhi(buf[r_][c_].z); y[c_][6] += cf_ * bflo(buf[r_][c_].w); y[c_][7] += cf_ * bfhi(buf[r_][c_].w); } } } while (0)
__device__ __forceinline__ void ph16_experts(const Frame& F) {
    const Args& a = *F.a;
    const int gw = F.bid * 8 + F.wave, NGW = F.G * 8, lane = F.lane();
    const int* EIDX = (const int*)(F.ws + WS_CKV); const float* EG = (const float*)(F.ws + WS_IKW);
    const bf16* PU = F.slot(5); const bf16* PV = F.slot(6); const bf16* XB = F.slot(0);
    for (int t = gw; t < T; t += NGW) {
        u32x4 xb[4];
#pragma unroll
        for (int c = 0; c < 4; ++c) xb[c] = *(const u32x4*)(XB + (size_t)t * 2048 + 512 * c + 8 * lane);
        const int id0 = EIDX[(size_t)t * 128 + lane], id1 = EIDX[(size_t)t * 128 + 64 + lane];
        const float g0 = EG[(size_t)t * 128 + lane], g1 = EG[(size_t)t * 128 + 64 + lane];
        float c0 = 0.f, c1 = 0.f;
        u32x4 bA[EXR][4], bB[EXR][4];
        EX_LOAD(bA, PU, id0, 0);
        for (int e = 0; e < 128; e += 2 * EXR) {
            const int idv = e < 64 ? id0 : id1;
            EX_LOAD(bB, PU, idv, e + EXR);
            EX_DOT(bA, e);
            if (e + 2 * EXR < 128) { const int idn = (e + 2 * EXR) < 64 ? id0 : id1; EX_LOAD(bA, PU, idn, e + 2 * EXR); }
            EX_DOT(bB, e + EXR);
        }
        float y[4][8];
#pragma unroll
        for (int c = 0; c < 4; ++c)
#pragma unroll
            for (int j = 0; j < 8; ++j) y[c][j] = 0.f;
        EX_LOAD(bA, PV, id0, 0);
        for (int e = 0; e < 128; e += 2 * EXR) {
            const int idv = e < 64 ? id0 : id1;
            EX_LOAD(bB, PV, idv, e + EXR);
            EX_AXPY(bA, e);
            if (e + 2 * EXR < 128) { const int idn = (e + 2 * EXR) < 64 ? id0 : id1; EX_LOAD(bA, PV, idn, e + 2 * EXR); }
            EX_AXPY(bB, e + EXR);
        }
        float* xrow = a.out + (size_t)t * 2048;
        float s = 0.f;
#pragma unroll
        for (int c = 0; c < 4; ++c) { const f32x4 x0 = *(const f32x4*)(xrow + 512 * c + 8 * lane), x1 = *(const f32x4*)(xrow + 512 * c + 8 * lane + 4);
            y[c][0] += ALPHA * x0.x; y[c][1] += ALPHA * x0.y; y[c][2] += ALPHA * x0.z; y[c][3] += ALPHA * x0.w; y[c][4] += ALPHA * x1.x; y[c][5] += ALPHA * x1.y; y[c][6] += ALPHA * x1.z; y[c][7] += ALPHA * x1.w;
#pragma unroll
            for (int j = 0; j < 8; ++j) s += y[c][j]; }
        const float mu = wave_sum(s) * (1.0f / 2048.0f); float s2 = 0.f;
#pragma unroll
        for (int c = 0; c < 4; ++c)
#pragma unroll
            for (int j = 0; j < 8; ++j) { y[c][j] -= mu; s2 += y[c][j] * y[c][j]; }
        const float rs = rsqrtf(wave_sum(s2) * (1.0f / 2048.0f) + 1e-5f);
#pragma unroll
        for (int c = 0; c < 4; ++c) { const int col = 512 * c + 8 * lane;
            const f32x4 ga = *(const f32x4*)(a.in[26] + col), gb = *(const f32x4*)(a.in[26] + col + 4), ba = *(const f32x4*)(a.in[27] + col), bb = *(const f32x4*)(a.in[27] + col + 4);
            f32x4 o0, o1; o0.x = y[c][0] * rs * ga.x + ba.x; o0.y = y[c][1] * rs * ga.y + ba.y; o0.z = y[c][2] * rs * ga.z + ba.z; o0.w = y[c][3] * rs * ga.w + ba.w;
            o1.x = y[c][4] * rs * gb.x + bb.x; o1.y = y[c][5] * rs * gb.y + bb.y; o1.z = y[c][6] * rs * gb.z + bb.z; o1.w = y[c][7] * rs * gb.w + bb.w;
            *(f32x4*)(xrow + col) = o0; *(f32x4*)(xrow + col + 4) = o1; }
    }
}

#define XB_TMO      128
#define XB_XCNT(j)  (256  + 64 * (j))
#define XB_XSUB(j)  (1280 + 64 * (j))
#define XB_XGEN(j)  (2304 + 64 * (j))
#define XB_TOP      3328
#define XB_TOPGEN   3392
#define XCD_BAR_WORDS 3456
#define XB_SPIN_CAP (1u << 22)
__device__ __forceinline__ unsigned xb_ld(unsigned* p)              { return __hip_atomic_load(p, __ATOMIC_RELAXED, __HIP_MEMORY_SCOPE_AGENT); }
__device__ __forceinline__ unsigned xb_add(unsigned* p, unsigned v) { return __hip_atomic_fetch_add(p, v, __ATOMIC_RELAXED, __HIP_MEMORY_SCOPE_AGENT); }
__device__ __forceinline__ unsigned xb_xcc_id() { return (unsigned)__builtin_amdgcn_s_getreg((3 << 11) | 20) & 0xFu; }
#define XB_SPIN(cond, bar) do { unsigned _sp = 0; while (cond) { __builtin_amdgcn_s_sleep(1); \
    if ((++_sp & 255u) == 0u) { if (xb_ld(&(bar)[XB_TMO])) break; if (_sp > XB_SPIN_CAP) { atomicAdd(&(bar)[XB_TMO], 1u); break; } } } } while (0)
struct XcdBarrier { unsigned* bar; unsigned x; volatile unsigned* st; };
__device__ __forceinline__ void xcd_barrier_complete(unsigned* bar, unsigned x, unsigned G, unsigned& nloc, unsigned& nx) {
    unsigned sum, cnt, mine, sp = 0u;
    for (;;) {
        sum = 0u; cnt = 0u; mine = 0u;
#pragma unroll
        for (unsigned j = 0; j < 16; ++j) { const unsigned c = xb_ld(&bar[XB_XCNT(j)]); sum += c; cnt += (c > 0u) ? 1u : 0u; mine = (j == x) ? c : mine; }
        if (sum == G) break;
        __builtin_amdgcn_s_sleep(1);
        if ((++sp & 255u) == 0u) { if (xb_ld(&bar[XB_TMO])) break; if (sp > XB_SPIN_CAP) { atomicAdd(&bar[XB_TMO], 1u); break; } }
    }
    nloc = mine > 0u ? mine : 1u; nx = cnt > 0u ? cnt : 1u;
}
__device__ __forceinline__ void xcd_barrier(const XcdBarrier& b, bool leader, unsigned G) {
    asm volatile("s_waitcnt vmcnt(0)" ::: "memory");
    __syncthreads();
    if (leader) {
        unsigned* bar = b.bar;
        __builtin_amdgcn_s_waitcnt(0);
        unsigned nloc = b.st[0], nx = b.st[1];
        if (nloc == 0u) { xcd_barrier_complete(bar, b.x, G, nloc, nx); b.st[0] = nloc; b.st[1] = nx; }
        const unsigned old = xb_add(&bar[XB_XSUB(b.x)], 1u);
        const unsigned gen = old / nloc;
        if (old + 1u == (gen + 1u) * nloc) {
            __builtin_amdgcn_fence(__ATOMIC_RELEASE, "agent");
            asm volatile("s_waitcnt vmcnt(0)" ::: "memory");
            const unsigned og = xb_add(&bar[XB_TOP], 1u);
            const unsigned tg = og / nx;
            if (og + 1u == (tg + 1u) * nx) xb_add(&bar[XB_TOPGEN], 1u);
            else XB_SPIN(xb_ld(&bar[XB_TOPGEN]) == tg, bar);
            __builtin_amdgcn_fence(__ATOMIC_ACQUIRE, "agent");
            xb_add(&bar[XB_XGEN(b.x)], 1u);
            asm volatile("s_waitcnt vmcnt(0)" ::: "memory");
        } else {
            XB_SPIN(xb_ld(&bar[XB_XGEN(b.x)]) == gen, bar);
            __builtin_amdgcn_fence(__ATOMIC_ACQUIRE, "agent");
            asm volatile("s_waitcnt vmcnt(0)" ::: "memory");
        }
    }
    __syncthreads();
}

__global__ void __launch_bounds__(512, 2) mega(Args args) {
    extern __shared__ __attribute__((aligned(16))) unsigned char lds[];
    cg::grid_group grid = cg::this_grid();
    Frame F;
    F.lds = lds; F.wave = __builtin_amdgcn_readfirstlane(threadIdx.x >> 6); F.bid = blockIdx.x; F.G = gridDim.x;
    F.a = &args; F.ws = args.ws;
    const int lo = args.ph_lo, hi = args.ph_hi;
    volatile unsigned* xst = (volatile unsigned*)(lds + LDS_BYTES - 64);
    const bool leader = (F.wave == 0) && (fresh_lane() == 0);
    if (leader) { xst[0] = 0u; xst[1] = 0u; }
    XcdBarrier xbar; xbar.bar = (unsigned*)(F.ws + WS_CTL) + 4096; xbar.x = xb_xcc_id(); xbar.st = xst;
    if (leader) (void)xb_add(&xbar.bar[XB_XCNT(xbar.x)], 1u);
    __syncthreads();
    bf16* W8 = (bf16*)(F.ws + WS_WIN);
#define IN(k) (lo <= (k) && (k) < hi)
#if PROBE_MASK
    unsigned long long pr_acc = 0ull, pr_t0 = __builtin_amdgcn_s_memrealtime();
#define SEAM(k) do { if (IN(k) && IN((k) + 1)) { if ((k) == 0) grid.sync(); else xcd_barrier(xbar, (F.wave == 0) && (fresh_lane() == 0), (unsigned)F.G); } { const unsigned long long t1_ = __builtin_amdgcn_s_memrealtime(); if ((PROBE_MASK >> (k)) & 1u) pr_acc += t1_ - pr_t0; pr_t0 = t1_; } } while (0)
#else
#define SEAM(k) do { if (IN(k) && IN((k) + 1)) { if ((k) == 0) grid.sync(); else xcd_barrier(xbar, (F.wave == 0) && (fresh_lane() == 0), (unsigned)F.G); } } while (0)
#endif
    if (IN(0)) { ph0_prologue(F); } SEAM(0);
    if (IN(1)) { gemm(F, (const bf16*)args.out, 2048, (const bf16*)(F.ws + WS_WIN), 2048, T, NCOLS, 2048, OpProj{F.ws}); } SEAM(1);
    if (IN(2)) {
        for (int u = F.bid; u < 128; u += F.G) hgrn_naive(F, u);
        if (F.G > 128) { if (F.bid >= 128) ph2_side(F, F.bid - 128, F.G - 128); } else ph2_side(F, F.bid, F.G);
    } SEAM(2);
    if (IN(3)) { ph3_hgnorm(F); } SEAM(3);
    if (IN(4)) {
        gemm(F, F.slot(0), 2048, W8, 2048, T, 2048, 2048, OpYA{F.slot(6)});
        gemm(F, (const bf16*)(F.ws + WS_CKV), 256, (const bf16*)(F.ws + WS_WKV), 256, T, 4096, 256, OpSplit2{F.slot(1), F.slot(2)});
    } SEAM(4);
    if (IN(5)) { ph5_select(F); } SEAM(5);
    if (IN(6)) { ph6_attn(F); } SEAM(6);
    if (IN(7)) { gemm(F, F.slot(3), 2048, W8 + (size_t)1 * 2048 * 2048, 2048, T, 2048, 2048, OpYB{F.slot(6), F.slot(7)}); } SEAM(7);
    if (IN(8)) { gemm(F, F.slot(6), 2048, W8 + (size_t)2 * 2048 * 2048, 2048, T, 2048, 2048, OpMix{args.in[0], args.out}); } SEAM(8);
    if (IN(9)) { ph_ln(F, args.in[14], args.in[15], F.slot(0)); } SEAM(9);
    if (IN(10)) {
        pg8::MultiOrder<3> S; S.lda = 2048; S.ldb = 2048; S.G = F.G; S.c = F.bid;
        S.s[0] = pg8::Sub{F.slot(0), W8 + (size_t)3 * 2048 * 2048, 64, 8};
        S.s[1] = pg8::Sub{(const bf16*)(F.ws + WS_MEMB), W8 + (size_t)4 * 2048 * 2048, 8, 8};
        S.s[2] = pg8::Sub{W8 + (size_t)5 * 2048 * 2048, (const bf16*)(F.ws + WS_MEMB), 8, 8};
        gemm_multi<3>(F, S, 2048, OpCQKV{F.slot(1), (bf16*)(F.ws + WS_CKV), (bf16*)(F.ws + WS_IKW)});
    } SEAM(10);
    if (IN(11)) {
        pg8::BatchOrder<OffS> S{F.slot(1), (const bf16*)(F.ws + WS_CKV), 8, 1, 32, 2048, 2048, F.G, F.bid, OffS()};
        gemm_batch(F, S, 512, OpLogit{(float*)F.slot(2)});
    } SEAM(11);
    if (IN(12)) { ph_xsoftmax(F, (const float*)F.slot(2), F.slot(3)); } SEAM(12);
    if (IN(13)) {
        pg8::BatchOrder<OffPV> S{F.slot(3), (const bf16*)(F.ws + WS_IKW), 8, 2, 32, 1024, 2048, F.G, F.bid, OffPV()};
        gemm_batch(F, S, 256, OpCO{F.slot(4)});
    } SEAM(13);
    if (IN(14)) { gemm(F, F.slot(4), 2048, W8 + (size_t)6 * 2048 * 2048, 2048, T, 2048, 2048, OpRes{args.out}); } SEAM(14);
    if (IN(15)) { ph_ln(F, args.in[20], args.in[21], F.slot(0));
        cvt_bf16_stream(F, args.in[24], F.slot(5), (size_t)16384 * 2048 / 8); cvt_bf16_stream(F, args.in[25], F.slot(6), (size_t)16384 * 2048 / 8); } SEAM(15);
    if (IN(16)) { gemm(F, F.slot(0), 2048, W8 + (size_t)7 * 2048 * 2048, 2048, T, 2048, 2048, OpF32{(float*)F.slot(1), 2048}); } SEAM(16);
    if (IN(17)) { ph15_peer_select(F); } SEAM(17);
    if (IN(18)) { ph16_experts(F); }
#if PROBE_MASK
    { const unsigned long long t1_ = __builtin_amdgcn_s_memrealtime(); if ((PROBE_MASK >> 18) & 1u) pr_acc += t1_ - pr_t0;
      if (F.bid == 0 && threadIdx.x == 0) { const unsigned long long ts_ = __builtin_amdgcn_s_memrealtime(); while (__builtin_amdgcn_s_memrealtime() - ts_ < pr_acc) __builtin_amdgcn_s_sleep(8); } }
#endif
#undef IN
#undef SEAM
}

extern "C" void kernel_launch(void* const* d_in, const int* in_sizes, int n_in, void* d_out, int out_size, void* d_ws, size_t ws_size, hipStream_t stream) {
    static int grid = 0;
    if (grid == 0) {
        if (n_in != 28 || out_size != T * D || ws_size < WS_END) { fprintf(stderr, "kernel_launch: unexpected shapes (n_in %d out %d ws %zu)\n", n_in, out_size, ws_size); grid = -1; return; }
        int dev = 0, cus = 0, per_cu = 0;
        hipGetDevice(&dev); hipDeviceGetAttribute(&cus, hipDeviceAttributeMultiprocessorCount, dev);
        hipFuncSetAttribute((const void*)mega, hipFuncAttributeMaxDynamicSharedMemorySize, LDS_BYTES);
        hipOccupancyMaxActiveBlocksPerMultiprocessor(&per_cu, (const void*)mega, 512, LDS_BYTES);
        if (per_cu < 1) { fprintf(stderr, "kernel_launch: occupancy query says %d blocks per CU\n", per_cu); per_cu = 1; }
        (void)hipGetLastError();
        grid = cus;
    }
    if (grid < 0) return;
    (void)hipMemsetAsync((char*)d_ws + WS_CTL, 0, 65536, stream);
    Args a{};
    for (int i = 0; i < 28; ++i) a.in[i] = (const float*)d_in[i];
    a.out = (float*)d_out; a.ws = (unsigned char*)d_ws;
#if ONE_LAUNCH
    a.ph_lo = 0; a.ph_hi = NPH;
    void* params[] = {&a};
    hipError_t e = hipLaunchCooperativeKernel((const void*)mega, dim3(grid), dim3(512), params, LDS_BYTES, stream);
    if (e != hipSuccess) fprintf(stderr, "cooperative launch failed: %s\n", hipGetErrorString(e));
#else
    for (int ph = 0; ph < NPH; ++ph) {
        a.ph_lo = ph; a.ph_hi = ph + 1;
        void* params[] = {&a};
        hipError_t e = hipLaunchCooperativeKernel((const void*)mega, dim3(grid), dim3(512), params, LDS_BYTES, stream);
        if (e != hipSuccess) { fprintf(stderr, "launch %d failed: %s\n", ph, hipGetErrorString(e)); break; }
    }
#endif
}
```

```cpp
#include <hip/hip_runtime.h>
#include <hip/hip_cooperative_groups.h>
#include <cstdint>
#include <cmath>
#include <cstdio>
namespace cg = cooperative_groups;

#ifndef ONE_LAUNCH
#define ONE_LAUNCH 1
#endif
#ifndef PROBE_MASK
#define PROBE_MASK 0u
#endif

typedef unsigned short bf16;
typedef short bf16x8 __attribute__((ext_vector_type(8)));
typedef float f32x4 __attribute__((ext_vector_type(4)));
typedef float f32x16 __attribute__((ext_vector_type(16)));
typedef unsigned u32x4 __attribute__((ext_vector_type(4)));
typedef unsigned u32x2 __attribute__((ext_vector_type(2)));

constexpr int T = 16384, D = 2048, SEQ = 2048, NB = 8;
constexpr int NCOLS = 16896;
constexpr float ALPHA = 1.189207115002721f;
constexpr int NPH = 19;

constexpr size_t MiB = 1u << 20;
constexpr size_t WS_CTL = 0, WS_MEMB = 1 * MiB, WS_WKV = 9 * MiB, WS_LB = 11 * MiB, WS_MASK = 12 * MiB, WS_WIN = 17 * MiB,
                 WS_SLOT = 83 * MiB, SLOT_BYTES = 64 * MiB, WS_CKV = 595 * MiB, WS_IKW = 603 * MiB, WS_END = 611 * MiB;
constexpr int LDS_BYTES = 147456;

struct Args {
    const float* in[28];
    float* out;
    unsigned char* ws;
    int ph_lo, ph_hi;
};

#define WAVE_SYNC() asm volatile("s_waitcnt lgkmcnt(0)" ::: "memory")

__device__ __forceinline__ unsigned f2bf(float f) { unsigned u = __float_as_uint(f); return (u + 0x7fffu + ((u >> 16) & 1u)) >> 16; }
__device__ __forceinline__ unsigned pk2(float lo, float hi) { return f2bf(lo) | (f2bf(hi) << 16); }
__device__ __forceinline__ float bf2f(unsigned h) { return __uint_as_float(h << 16); }
__device__ __forceinline__ float bflo(unsigned w) { return __uint_as_float(w << 16); }
__device__ __forceinline__ float bfhi(unsigned w) { return __uint_as_float(w & 0xffff0000u); }
__device__ __forceinline__ float wave_sum(float v) {
#pragma unroll
    for (int o = 32; o >= 1; o >>= 1) v += __shfl_xor(v, o);
    return v;
}
__device__ __forceinline__ float wave_max(float v) {
#pragma unroll
    for (int o = 32; o >= 1; o >>= 1) v = fmaxf(v, __shfl_xor(v, o));
    return v;
}
__device__ __forceinline__ float sigm(float x) { return 1.0f / (1.0f + expf(-x)); }
__device__ __forceinline__ void unpack8(u32x4 w, float* f) {
    f[0] = bflo(w.x); f[1] = bfhi(w.x); f[2] = bflo(w.y); f[3] = bfhi(w.y); f[4] = bflo(w.z); f[5] = bfhi(w.z); f[6] = bflo(w.w); f[7] = bfhi(w.w);
}

__device__ __forceinline__ int fresh_lane() { int l; asm volatile("v_mbcnt_lo_u32_b32 %0, -1, 0\n\tv_mbcnt_hi_u32_b32 %0, -1, %0" : "=v"(l)); return l; }
struct Frame {
    unsigned char* lds;
    int wave, bid, G;
    __device__ __forceinline__ int lane() const { return fresh_lane(); }
    const Args* a;
    unsigned char* ws;
    __device__ __forceinline__ bf16* slot(int i) const { return (bf16*)(ws + WS_SLOT + (size_t)i * SLOT_BYTES); }
};

namespace pg8 {
#define PG8_LAS __attribute__((address_space(3)))
constexpr int BM = 256, BK = 64, HALF = 128, HTB = HALF * BK * 2, STAGE_BYTES = 8 * HTB, NXCD = 8, WGM = 8;
__host__ __device__ __forceinline__ int lds_byte(int r, int c) { const int st = (r >> 4) * 2 + (c >> 5), rr = r & 15, cc = c & 31, ob = rr * 64 + cc * 2; return st * 1024 + (ob ^ (((ob >> 9) & 1) << 5)); }
__host__ __device__ __forceinline__ void stage_rc(int b, int& R, int& C) { const int st = b / 1024, sb = b % 1024, swz = sb ^ (((sb >> 9) & 1) << 5); R = (st >> 1) * 16 + swz / 64; C = (st & 1) * 32 + (swz % 64) / 2; }
__host__ __device__ __forceinline__ int perm32(int rho) { const int n = rho >> 4, i = rho & 15; return 8 * (i >> 2) + 4 * n + (i & 3); }
struct Unit { int pm, pn, z; const char* a; const char* b; };
struct Gemm { int lda, ldb, K; };
__device__ __forceinline__ void tile_of(int wgid, int nM, int nN, int& pm, int& pn) {
    const int nwg = nM * nN; { const int q = nwg / NXCD, r = nwg % NXCD, xcd = wgid % NXCD, off = wgid / NXCD; wgid = (xcd < r ? xcd * (q + 1) : r * (q + 1) + (xcd - r) * q) + off; }
    const int nig = WGM * nN, gid = wgid / nig, fm = gid * WGM, gsz = (nM - fm) < WGM ? (nM - fm) : WGM;
    pm = fm + ((wgid % nig) % gsz); pn = (wgid % nig) / gsz;
}
struct Sub { const bf16* A; const bf16* Bt; int nM, nN; };
template <int NS> struct MultiOrder {
    Sub s[NS]; int lda, ldb, G, c;
    __device__ __forceinline__ bool next(int i, Unit& u) const {
        int L = i * G + c;
#pragma unroll
        for (int k = 0; k < NS; ++k) { const int n = s[k].nM * s[k].nN;
            if (L < n) { tile_of(L, s[k].nM, s[k].nN, u.pm, u.pn); u.z = k; u.a = (const char*)(s[k].A + (size_t)u.pm * BM * lda); u.b = (const char*)(s[k].Bt + (size_t)u.pn * BM * ldb); return true; }
            L -= n; }
        return false;
    }
};
template <class Off> struct BatchOrder {
    const bf16* A; const bf16* Bt; int nM, nN, nz, lda, ldb, G, c; Off off;
    __device__ __forceinline__ bool next(int i, Unit& u) const {
        const int L = i * G + c, per = nM * nN; if (L >= per * nz) return false;
        u.z = L / per; const int r = L % per; u.pn = r / nM; u.pm = r % nM;
        u.a = (const char*)(A + off.a(u.z) + (size_t)u.pm * BM * lda); u.b = (const char*)(Bt + off.b(u.z) + (size_t)u.pn * BM * ldb); return true;
    }
};
__device__ __forceinline__ unsigned cvt_pk_bf16(float lo, float hi) { unsigned r; asm volatile("v_cvt_pk_bf16_f32 %0, %1, %2" : "=v"(r) : "v"(lo), "v"(hi)); return r; }

template <class Op> struct Epi8 {
    static constexpr bool PERM = true;
    Op op;
    __device__ __forceinline__ void operator()(const f32x4 (&acc)[2][2][4][2], const Unit& u, int wr, int wc, int fr, int fq) const {
        const int row0 = u.pm * BM + wr * 64 + fr, col0 = u.pn * BM + wc * 32 + 8 * fq;
#pragma unroll
        for (int ai = 0; ai < 2; ++ai)
#pragma unroll
            for (int m = 0; m < 4; ++m)
#pragma unroll
                for (int bj = 0; bj < 2; ++bj) op(u.z, row0 + ai * HALF + m * 16, col0 + bj * HALF, acc[ai][bj][m][0], acc[ai][bj][m][1]);
    }
};

template <class Epi, class Sched, bool ALIGN_EPI>
__device__ __forceinline__ void gemm_phase(PG8_LAS unsigned char* lds, const Gemm g, const Sched& S, const Epi& E, int wid, int lane) {
    const int tid = wid * 64 + lane, wr = wid >> 2, wc = wid & 3, fr = lane & 15, fq = lane >> 4;
    const int K = g.K, nt = K / BK;
    unsigned voffA[2], voffB[2];
#pragma unroll
    for (int i = 0; i < 2; ++i) { int R, C; stage_rc(tid * 16 + i * 8192, R, C); const int Rb = Epi::PERM ? ((R & ~31) + perm32(R & 31)) : R;
        voffA[i] = (unsigned)(R * g.lda + C) * 2u; voffB[i] = (unsigned)(Rb * g.ldb + C) * 2u; }
    const size_t kstep = (size_t)(BK * 2);
    const size_t hstepA = (size_t)HALF * g.lda * 2, hstepB = (size_t)HALF * g.ldb * 2;
    const unsigned ldsw = (unsigned)wid * 1024u;
    const int aoff = lds_byte(wr * 64 + fr, fq * 8), boff = lds_byte(wc * 32 + fr, fq * 8);
#define PG8_SA(b, h) (((b) * 2 + (h)) * HTB)
#define PG8_SB(b, h) ((4 + (b) * 2 + (h)) * HTB)
#define PG8_STAGE(bufoff, gbase, voff) do { _Pragma("unroll") for (int _i = 0; _i < 2; ++_i) \
        __builtin_amdgcn_global_load_lds((const unsigned*)((const char*)(gbase) + (voff)[_i]), (PG8_LAS unsigned*)(lds + (bufoff) + ldsw + _i * 8192), 16, 0, 0); } while (0)
#define PG8_LDA(dst, b, h) do { _Pragma("unroll") for (int m = 0; m < 4; ++m) _Pragma("unroll") for (int k = 0; k < 2; ++k) dst[m][k] = *(const PG8_LAS bf16x8*)(lds + PG8_SA(b, h) + aoff + m * 2048 + k * 1024); } while (0)
#define PG8_LDB(dst, b, h) do { _Pragma("unroll") for (int n = 0; n < 2; ++n) _Pragma("unroll") for (int k = 0; k < 2; ++k) dst[n][k] = *(const PG8_LAS bf16x8*)(lds + PG8_SB(b, h) + boff + n * 2048 + k * 1024); } while (0)
#define PG8_MMA(ai, bj, At, Bt) do { __builtin_amdgcn_s_setprio(1); _Pragma("unroll") for (int m = 0; m < 4; ++m) _Pragma("unroll") for (int n = 0; n < 2; ++n) _Pragma("unroll") for (int k = 0; k < 2; ++k) \
        acc[ai][bj][m][n] = __builtin_amdgcn_mfma_f32_16x16x32_bf16(Bt[n][k], At[m][k], acc[ai][bj][m][n], 0, 0, 0); __builtin_amdgcn_s_setprio(0); } while (0)
#define PG8_WAIT_V(n) asm volatile("s_waitcnt vmcnt(" #n ")" ::: "memory")
#define PG8_WAIT_L(n) asm volatile("s_waitcnt lgkmcnt(" #n ")" ::: "memory")
#define PG8_BAR __builtin_amdgcn_s_barrier()
#define PG8_SCHED __builtin_amdgcn_sched_barrier(0)
    Unit cur, nxt; int ui = 0;
    if (!S.next(0, cur)) return;
    f32x4 acc[2][2][4][2];
#pragma unroll
    for (int a = 0; a < 2; ++a)
#pragma unroll
        for (int b = 0; b < 2; ++b)
#pragma unroll
            for (int m = 0; m < 4; ++m)
#pragma unroll
                for (int n = 0; n < 2; ++n) acc[a][b][m][n] = (f32x4){0.f, 0.f, 0.f, 0.f};
    bf16x8 At[4][2], B0[2][2], B1[2][2];
    const char* cA = cur.a; const char* cB = cur.b;
    PG8_STAGE(PG8_SB(0, 0), cB, voffB); PG8_STAGE(PG8_SB(0, 1), cB + hstepB, voffB); PG8_STAGE(PG8_SA(0, 0), cA, voffA); PG8_STAGE(PG8_SA(0, 1), cA + hstepA, voffA);
    if (wr == 1) PG8_BAR;
    PG8_WAIT_V(2); PG8_BAR;
    PG8_STAGE(PG8_SB(1, 0), cB + kstep, voffB); PG8_STAGE(PG8_SA(1, 0), cA + kstep, voffA); PG8_STAGE(PG8_SB(1, 1), cB + hstepB + kstep, voffB);
    PG8_WAIT_V(6); PG8_BAR;
    for (;;) {
        const bool has_next = S.next(ui + 1, nxt);
        const char* nA = has_next ? nxt.a : cA; const char* nB = has_next ? nxt.b : cB;
#pragma unroll 1
        for (int t = 0; t < nt; t += 2) {
            const bool last = (t == nt - 2);
            const char* a1 = cA + (size_t)(t + 1) * kstep;
            const char* a2 = last ? nA : cA + (size_t)(t + 2) * kstep; const char* b2 = last ? nB : cB + (size_t)(t + 2) * kstep;
            const char* a3 = a2 + kstep; const char* b3 = b2 + kstep;
            PG8_LDB(B0, 0, 0); PG8_LDB(B1, 0, 1); PG8_SCHED; PG8_LDA(At, 0, 0); PG8_STAGE(PG8_SA(1, 1), a1 + hstepA, voffA);
            PG8_WAIT_V(8); PG8_WAIT_L(0); PG8_BAR; PG8_MMA(0, 0, At, B0); PG8_MMA(0, 1, At, B1); PG8_BAR; PG8_SCHED;
            PG8_LDA(At, 0, 1); PG8_STAGE(PG8_SB(0, 0), b2, voffB); PG8_STAGE(PG8_SB(0, 1), b2 + hstepB, voffB); PG8_STAGE(PG8_SA(0, 0), a2, voffA);
            PG8_WAIT_V(8); PG8_WAIT_L(0); PG8_BAR; PG8_MMA(1, 0, At, B0); PG8_MMA(1, 1, At, B1); PG8_BAR; PG8_SCHED;
            PG8_LDB(B0, 1, 0); PG8_LDB(B1, 1, 1); PG8_SCHED; PG8_LDA(At, 1, 0); PG8_STAGE(PG8_SA(0, 1), a2 + hstepA, voffA);
            PG8_WAIT_V(8); PG8_WAIT_L(0); PG8_BAR; PG8_MMA(0, 0, At, B0); PG8_MMA(0, 1, At, B1); PG8_BAR; PG8_SCHED;
            PG8_LDA(At, 1, 1); PG8_STAGE(PG8_SB(1, 0), b3, voffB); PG8_STAGE(PG8_SB(1, 1), b3 + hstepB, voffB); PG8_STAGE(PG8_SA(1, 0), a3, voffA);
            PG8_WAIT_V(8); PG8_WAIT_L(0); PG8_BAR; PG8_MMA(1, 0, At, B0); PG8_MMA(1, 1, At, B1); PG8_BAR; PG8_SCHED;
        }
        if constexpr (ALIGN_EPI) { if (wr == 0) PG8_BAR; }
        E(acc, cur, wr, wc, fr, fq);
        if (!has_next) break;
#pragma unroll
        for (int a = 0; a < 2; ++a)
#pragma unroll
            for (int b = 0; b < 2; ++b)
#pragma unroll
                for (int m = 0; m < 4; ++m)
#pragma unroll
                    for (int n = 0; n < 2; ++n) acc[a][b][m][n] = (f32x4){0.f, 0.f, 0.f, 0.f};
        cur = nxt; cA = nA; cB = nB; ++ui;
        if constexpr (ALIGN_EPI) { if (wr == 1) PG8_BAR; }
    }
    PG8_WAIT_V(0);
    if constexpr (!ALIGN_EPI) { if (wr == 0) PG8_BAR; }
    PG8_BAR;
#undef PG8_SA
#undef PG8_SB
#undef PG8_STAGE
#undef PG8_LDA
#undef PG8_LDB
#undef PG8_MMA
#undef PG8_WAIT_V
#undef PG8_WAIT_L
#undef PG8_BAR
#undef PG8_SCHED
}
}

__device__ __forceinline__ u32x4 pack8(f32x4 a, f32x4 b) { u32x4 w; w.x = pg8::cvt_pk_bf16(a.x, a.y); w.y = pg8::cvt_pk_bf16(a.z, a.w); w.z = pg8::cvt_pk_bf16(b.x, b.y); w.w = pg8::cvt_pk_bf16(b.z, b.w); return w; }
__device__ __forceinline__ void unpack8v(u32x4 w, f32x4& a, f32x4& b) { a.x = bflo(w.x); a.y = bfhi(w.x); a.z = bflo(w.y); a.w = bfhi(w.y); b.x = bflo(w.z); b.y = bfhi(w.z); b.z = bflo(w.w); b.w = bfhi(w.w); }
__device__ __forceinline__ f32x4 sigm4(f32x4 v) { f32x4 r; r.x = sigm(v.x); r.y = sigm(v.y); r.z = sigm(v.z); r.w = sigm(v.w); return r; }

struct OpProj { unsigned char* ws;
    __device__ __forceinline__ void operator()(int z, int row, int col, f32x4 a, f32x4 b) const {
        bf16* p;
        if (col < 16384) p = (bf16*)(ws + WS_SLOT + (size_t)(col >> 11) * SLOT_BYTES) + (size_t)row * 2048 + (col & 2047);
        else if (col < 16640) p = (bf16*)(ws + WS_CKV) + (size_t)row * 256 + (col - 16384);
        else p = (bf16*)(ws + WS_IKW) + (size_t)row * 256 + (col - 16640);
        *(u32x4*)p = pack8(a, b);
    } };
struct OpBf16 { bf16* o; int ld;
    __device__ __forceinline__ void operator()(int z, int row, int col, f32x4 a, f32x4 b) const { *(u32x4*)(o + (size_t)row * ld + col) = pack8(a, b); } };
struct OpSplit2 { bf16* o0; bf16* o1;
    __device__ __forceinline__ void operator()(int z, int row, int col, f32x4 a, f32x4 b) const { bf16* p = (col < 2048 ? o0 : o1) + (size_t)row * 2048 + (col & 2047); *(u32x4*)p = pack8(a, b); } };
struct OpF32 { float* o; int ld;
    __device__ __forceinline__ void operator()(int z, int row, int col, f32x4 a, f32x4 b) const { float* p = o + (size_t)row * ld + col; *(f32x4*)p = a; *(f32x4*)(p + 4) = b; } };
struct OpYA { bf16* ga;
    __device__ __forceinline__ void operator()(int z, int row, int col, f32x4 a, f32x4 b) const { bf16* p = ga + (size_t)row * 2048 + col; f32x4 g0, g1; unpack8v(*(const u32x4*)p, g0, g1);
        *(u32x4*)p = pack8(sigm4(g0) * a, sigm4(g1) * b); } };
struct OpYB { bf16* ga; const bf16* gb;
    __device__ __forceinline__ void operator()(int z, int row, int col, f32x4 a, f32x4 b) const { const size_t i = (size_t)row * 2048 + col; f32x4 m0, m1, g0, g1; unpack8v(*(const u32x4*)(ga + i), m0, m1); unpack8v(*(const u32x4*)(gb + i), g0, g1);
        *(u32x4*)(ga + i) = pack8(m0 + sigm4(g0) * a, m1 + sigm4(g1) * b); } };
struct OpMix { const float* x; float* z;
    __device__ __forceinline__ void operator()(int zi, int row, int col, f32x4 a, f32x4 b) const { const size_t i = (size_t)row * 2048 + col; const f32x4 x0 = *(const f32x4*)(x + i), x1 = *(const f32x4*)(x + i + 4);
        *(f32x4*)(z + i) = ALPHA * x0 + a; *(f32x4*)(z + i + 4) = ALPHA * x1 + b; } };
struct OpRes { float* z;
    __device__ __forceinline__ void operator()(int zi, int row, int col, f32x4 a, f32x4 b) const { const size_t i = (size_t)row * 2048 + col; const f32x4 x0 = *(const f32x4*)(z + i), x1 = *(const f32x4*)(z + i + 4);
        *(f32x4*)(z + i) = ALPHA * x0 + a; *(f32x4*)(z + i + 4) = ALPHA * x1 + b; } };

template <class Op>
__device__ __forceinline__ void gemm(const Frame& F, const bf16* A, int lda, const bf16* Bt, int ldb, int M, int N, int K, const Op& op) {
    pg8::Gemm g{lda, ldb, K}; pg8::MultiOrder<1> S; S.s[0] = pg8::Sub{A, Bt, M / 256, N / 256}; S.lda = lda; S.ldb = ldb; S.G = F.G; S.c = F.bid;
    pg8::Epi8<Op> E{op};
    pg8::gemm_phase<pg8::Epi8<Op>, pg8::MultiOrder<1>, true>((PG8_LAS unsigned char*)F.lds, g, S, E, F.wave, F.lane());
}
template <int NS, class Op>
__device__ __forceinline__ void gemm_multi(const Frame& F, const pg8::MultiOrder<NS>& S, int K, const Op& op) {
    pg8::Gemm g{S.lda, S.ldb, K}; pg8::Epi8<Op> E{op};
    pg8::gemm_phase<pg8::Epi8<Op>, pg8::MultiOrder<NS>, true>((PG8_LAS unsigned char*)F.lds, g, S, E, F.wave, F.lane());
}
template <class Off, class Op>
__device__ __forceinline__ void gemm_batch(const Frame& F, const pg8::BatchOrder<Off>& S, int K, const Op& op) {
    pg8::Gemm g{S.lda, S.ldb, K}; pg8::Epi8<Op> E{op};
    pg8::gemm_phase<pg8::Epi8<Op>, pg8::BatchOrder<Off>, true>((PG8_LAS unsigned char*)F.lds, g, S, E, F.wave, F.lane());
}
struct OffS { __device__ __forceinline__ size_t a(int z) const { return (size_t)(z >> 2) * 2048 * 2048 + (z & 3) * 512; } __device__ __forceinline__ size_t b(int z) const { return (size_t)(z >> 2) * 256 * 2048 + (z & 3) * 512; } };
struct OffPV { __device__ __forceinline__ size_t a(int z) const { return (size_t)(z >> 2) * 2048 * 1024 + (z & 3) * 256; } __device__ __forceinline__ size_t b(int z) const { return (size_t)(z & 3) * 512 * 2048 + (z >> 2) * 256; } };
struct OpLogit { float* lg;
    __device__ __forceinline__ void operator()(int z, int row, int col, f32x4 a, f32x4 b) const { float* p = lg + ((size_t)(z >> 2) * 2048 + row) * 1024 + (z & 3) * 256 + col; *(f32x4*)p = a * 0.04419417382415922f; *(f32x4*)(p + 4) = b * 0.04419417382415922f; } };
struct OpCO { bf16* co;
    __device__ __forceinline__ void operator()(int z, int row, int col, f32x4 a, f32x4 b) const { *(u32x4*)(co + ((size_t)(z >> 2) * 2048 + row) * 2048 + (z & 3) * 512 + col) = pack8(a, b); } };
struct OpCQKV { bf16* cq; bf16* ck; bf16* vt;
    __device__ __forceinline__ void operator()(int z, int row, int col, f32x4 a, f32x4 b) const { bf16* o = z == 0 ? cq : (z == 1 ? ck : vt); *(u32x4*)(o + (size_t)row * 2048 + col) = pack8(a, b); } };
__device__ __forceinline__ void ph_xsoftmax(const Frame& F, const float* lg, bf16* P) {
    const int gw = F.bid * 8 + F.wave, NGW = F.G * 8, lane = F.lane();
    for (int u = gw; u < T * 4; u += NGW) {
        const f32x4 v = *(const f32x4*)(lg + (size_t)u * 256 + 4 * lane);
        const float m = wave_max(fmaxf(fmaxf(v.x, v.y), fmaxf(v.z, v.w)));
        const float e0 = expf(v.x - m), e1 = expf(v.y - m), e2 = expf(v.z - m), e3 = expf(v.w - m);
        const float inv = 1.0f / wave_sum((e0 + e1) + (e2 + e3));
        u32x2 w; w.x = pk2(e0 * inv, e1 * inv); w.y = pk2(e2 * inv, e3 * inv);
        *(u32x2*)(P + (size_t)u * 256 + 4 * lane) = w;
    }
}

template <class CM>
__device__ __forceinline__ void transpose_item(const float* W, size_t ldw, bf16* WT, size_t ldwt, int row_off, int nblk, int item, float* scr, int lane, const CM& cm) {
    const int kb = item / nblk, nb = item % nblk, k0 = 64 * kb, n0 = 32 * nb;
    const int c = cm(n0 + (lane & 31));
#pragma unroll 8
    for (int i = 0; i < 32; ++i) { const int kk = 2 * i + (lane >> 5); scr[kk * 33 + (lane & 31)] = (c >= 0) ? W[(size_t)(k0 + kk) * ldw + c] : 0.f; }
    WAVE_SYNC();
    const int c8 = lane & 7;
#pragma unroll
    for (int j = 0; j < 4; ++j) { const int n = (lane >> 3) + 8 * j; const float* s = scr + (8 * c8) * 33 + n;
        u32x4 o; o.x = pk2(s[0 * 33], s[1 * 33]); o.y = pk2(s[2 * 33], s[3 * 33]); o.z = pk2(s[4 * 33], s[5 * 33]); o.w = pk2(s[6 * 33], s[7 * 33]);
        *(u32x4*)(WT + (size_t)(row_off + n0 + n) * ldwt + k0 + 8 * c8) = o; }
    WAVE_SYNC();
}
struct CmIdent { __device__ __forceinline__ int operator()(int n) const { return n; } };
struct CmWin { __device__ __forceinline__ int operator()(int n) const {
    if (n < 10240) return n;
    if (n < 12288) return 10496 + (n - 10240);
    if (n < 14336) return 12688 + (n - 12288);
    if (n < 16384) return 14736 + (n - 14336);
    if (n < 16640) return 10240 + (n - 16384);
    if (n < 16768) return 12544 + (n - 16640);
    if (n < 16784) return 12672 + (n - 16768);
    return -1; } };

__device__ __forceinline__ void cvt_bf16_stream(const Frame& F, const float* src, bf16* dst, size_t n8) {
    const size_t gt = (size_t)F.bid * 512 + F.wave * 64 + F.lane(), NT = (size_t)F.G * 512;
    for (size_t i = gt; i < n8; i += NT) { const f32x4 a = ((const f32x4*)src)[2 * i], b = ((const f32x4*)src)[2 * i + 1];
        u32x4 o; o.x = pk2(a.x, a.y); o.y = pk2(a.z, a.w); o.z = pk2(b.x, b.y); o.w = pk2(b.z, b.w); ((u32x4*)dst)[i] = o; }
}

__device__ __forceinline__ void ph0_prologue(const Frame& F) {
    const Args& a = *F.a;
    cvt_bf16_stream(F, a.in[0], (bf16*)a.out, (size_t)T * D / 8);
    cvt_bf16_stream(F, a.in[1], (bf16*)(F.ws + WS_MEMB), (size_t)2048 * 2048 / 8);
    float* scr = (float*)(F.lds + F.wave * 16384);
    const int gw = F.bid * 8 + F.wave, NGW = F.G * 8, lane = F.lane();
    {
        const int nblk = NCOLS / 32, nitems = (2048 / 64) * nblk;
        for (int it = gw; it < nitems; it += NGW) transpose_item(a.in[2], 16784, (bf16*)(F.ws + WS_WIN), 2048, 0, nblk, it, scr, lane, CmWin());
    }
    {
        for (int it = gw; it < 32 * 16; it += NGW) { const int mat = it >> 4, which = mat >> 4, h = mat & 15;
            transpose_item(a.in[which ? 9 : 8] + (size_t)h * 256 * 128, 128, (bf16*)(F.ws + WS_WKV), 256, which * 2048 + h * 128, 4, it & 15, scr, lane, CmIdent()); }
    }
    {
        const int gt = F.bid * 512 + F.wave * 64 + lane;
        if (gt < 2048) { const float l0 = a.in[3][gt], l1 = a.in[3][2048 + gt]; ((float*)(F.ws + WS_LB))[gt] = 1.0f / (1.0f + expf(l1 - l0)); }
    }
}

__device__ __forceinline__ void hgrn_naive(const Frame& F, int unit) {
    const int b = unit >> 4, h = unit & 15, tid = F.wave * 64 + F.lane();
    float* qs = (float*)F.lds; float* fs = qs + 128; float* ks = fs + 128; float* part = ks + 128;
    const bf16* HQ = F.slot(0); const bf16* HF = F.slot(1); const bf16* HI = F.slot(2);
    float* oraw = F.a->out;
    const int dv = tid & 127, kq = tid >> 7;
    float S[32];
#pragma unroll
    for (int j = 0; j < 32; ++j) S[j] = 0.f;
    const float lb = ((const float*)(F.ws + WS_LB))[h * 128 + dv];
    const size_t base = (size_t)b * 2048 * 2048 + h * 128;
    unsigned short qn = HQ[base + dv], fn = HF[base + dv], vn = HI[base + dv];
    for (int t = 0; t < 2048; ++t) {
        const size_t off = base + (size_t)t * 2048;
        if (tid < 128) { const float f = lb + (1.0f - lb) * sigm(bf2f(fn)); qs[tid] = bf2f(qn); fs[tid] = f; ks[tid] = 1.0f - f; }
        const float v = bf2f(vn);
        if (t + 1 < 2048) { qn = HQ[off + 2048 + dv]; fn = HF[off + 2048 + dv]; vn = HI[off + 2048 + dv]; }
        __syncthreads();
        float acc = 0.f;
#pragma unroll
        for (int j = 0; j < 32; ++j) { const int dk = kq * 32 + j; S[j] = fs[dk] * S[j] + ks[dk] * v; acc += qs[dk] * S[j]; }
        part[kq * 128 + dv] = acc;
        __syncthreads();
        if (tid < 128) oraw[off + tid] = (part[tid] + part[128 + tid]) + (part[256 + tid] + part[384 + tid]);
    }
    __syncthreads();
}

__device__ __forceinline__ void ph2_side(const Frame& F, int sid, int nside) {
    const Args& a = *F.a;
    const int gw = sid * 8 + F.wave, NGW = nside * 8, lane = F.lane();
    bf16* CKV = (bf16*)(F.ws + WS_CKV); bf16* IKW = (bf16*)(F.ws + WS_IKW);
    for (int row = gw; row < T; row += NGW) {
        {   u32x2 w = *(u32x2*)(CKV + (size_t)row * 256 + 4 * lane);
            float x0 = bflo(w.x), x1 = bfhi(w.x), x2 = bflo(w.y), x3 = bfhi(w.y);
            const float ss = wave_sum(x0 * x0 + x1 * x1 + x2 * x2 + x3 * x3);
            const float r = rsqrtf(ss * (1.0f / 256.0f) + 1e-6f);
            const f32x4 g = *(const f32x4*)(a.in[5] + 4 * lane);
            w.x = pk2(x0 * r * g.x, x1 * r * g.y); w.y = pk2(x2 * r * g.z, x3 * r * g.w);
            *(u32x2*)(CKV + (size_t)row * 256 + 4 * lane) = w; }
        {   unsigned w = *(unsigned*)(IKW + (size_t)row * 256 + 2 * lane);
            float x0 = bflo(w), x1 = bfhi(w);
            const float mu = wave_sum(x0 + x1) * (1.0f / 128.0f);
            x0 -= mu; x1 -= mu;
            const float var = wave_sum(x0 * x0 + x1 * x1) * (1.0f / 128.0f);
            const float r = rsqrtf(var + 1e-5f);
            const float g0 = a.in[6][2 * lane], g1 = a.in[6][2 * lane + 1], b0 = a.in[7][2 * lane], b1 = a.in[7][2 * lane + 1];
            *(unsigned*)(IKW + (size_t)row * 256 + 2 * lane) = pk2(x0 * r * g0 + b0, x1 * r * g1 + b1); }
    }
    float* scr = (float*)(F.lds + F.wave * 16384);
    for (int it = gw; it < 8 * 2048; it += NGW) { const int m = it >> 11;
        const float* wsrc = m == 0 ? a.in[11] : m == 1 ? a.in[12] : m == 2 ? a.in[13] : m == 3 ? a.in[16] : m == 4 ? a.in[17] : m == 5 ? a.in[18] : m == 6 ? a.in[19] : a.in[22];
        transpose_item(wsrc, 2048, (bf16*)(F.ws + WS_WIN + (size_t)m * 8 * MiB), 2048, 0, 64, it & 2047, scr, lane, CmIdent()); }
}

__device__ __forceinline__ void ph3_hgnorm(const Frame& F) {
    const Args& a = *F.a;
    const int gw = F.bid * 8 + F.wave, NGW = F.G * 8, lane = F.lane();
    const float* oraw = a.out; const bf16* HG = F.slot(3); bf16* HO = F.slot(0);
    for (int u = gw; u < T * 16; u += NGW) {
        const size_t off = (size_t)(u >> 4) * 2048 + (u & 15) * 128 + 2 * lane;
        const float o0 = oraw[off], o1 = oraw[off + 1];
        const float r = rsqrtf(wave_sum(o0 * o0 + o1 * o1) * (1.0f / 128.0f) + 1e-6f);
        const unsigned gw2 = *(const unsigned*)(HG + off);
        const float g0 = bflo(gw2), g1 = bfhi(gw2);
        const int c = (u & 15) * 128 + 2 * lane;
        *(unsigned*)(HO + off) = pk2(o0 * r * a.in[4][c] * (g0 * sigm(g0)), o1 * r * a.in[4][c + 1] * (g1 * sigm(g1)));
    }
}

__device__ __forceinline__ unsigned fkey(float f) { const unsigned u = __float_as_uint(f); return (u & 0x80000000u) ? ~u : (u | 0x80000000u); }
__device__ __forceinline__ void ph5_select(const Frame& F) {
    const int lane = F.lane(), l31 = lane & 31, half = lane >> 5, w = F.wave;
    float* scl = (float*)F.lds;
    const bf16* AIQ = F.slot(5); const bf16* IKW = (const bf16*)(F.ws + WS_IKW);
    unsigned* MASK = (unsigned*)(F.ws + WS_MASK);
    for (int i = F.bid; i < 1024; i += F.G) {
        const int r4 = i >> 8, c = i & 255, j = c & 127, b = 2 * r4 + (c >> 7), qt = (r4 & 1) ? 127 - j : j, t0 = qt * 16;
        bf16x8 Af[8];
        { const size_t rowA = (size_t)b * 2048 + t0 + 2 * w + ((l31 >> 2) & 1); const int headA = (l31 & 3) + 4 * (l31 >> 3);
#pragma unroll
          for (int ks = 0; ks < 8; ++ks) Af[ks] = *(const bf16x8*)(AIQ + rowA * 2048 + headA * 128 + 16 * ks + 8 * half); }
        float wr[16];
        { const bf16* wp = IKW + ((size_t)b * 2048 + t0 + 2 * w + half) * 256 + 128;
#pragma unroll
          for (int r = 0; r < 16; ++r) wr[r] = bf2f(wp[(r & 3) + 4 * (r >> 2)]) * (0.25f * 0.08838834764831845f); }
        const int nkt = (t0 + 15) / 32 + 1;
        const bf16* kbase = IKW + ((size_t)b * 2048 + l31) * 256 + 8 * half;
        bf16x8 Bf[8];
#pragma unroll
        for (int ks = 0; ks < 8; ++ks) Bf[ks] = *(const bf16x8*)(kbase + 16 * ks);
        for (int kt = 0; kt < nkt; ++kt) {
            f32x16 acc;
#pragma unroll
            for (int r = 0; r < 16; ++r) acc[r] = 0.f;
#pragma unroll
            for (int ks = 0; ks < 8; ++ks) acc = __builtin_amdgcn_mfma_f32_32x32x16_bf16(Af[ks], Bf[ks], acc, 0, 0, 0);
            if (kt + 1 < nkt) {
#pragma unroll
                for (int ks = 0; ks < 8; ++ks) Bf[ks] = *(const bf16x8*)(kbase + (size_t)(kt + 1) * 32 * 256 + 16 * ks); }
            float sc = 0.f;
#pragma unroll
            for (int r = 0; r < 16; ++r) sc += fmaxf(acc[r], 0.f) * wr[r];
            scl[(2 * w + half) * 2048 + kt * 32 + l31] = sc;
        }
        WAVE_SYNC();
#pragma unroll 1
        for (int qi = 0; qi < 2; ++qi) {
            const int t = t0 + 2 * w + qi; const float* row = scl + (2 * w + qi) * 2048;
            unsigned key[32];
#pragma unroll
            for (int jj = 0; jj < 32; ++jj) { const int s2 = lane + 64 * jj; key[jj] = (s2 <= t) ? fkey(row[s2]) : 0u; }
            unsigned thr = 0u;
            if (t + 1 > 256) {
                for (int bit = 31; bit >= 0; --bit) {
                    const unsigned cand = thr | (1u << bit);
                    int cnt = 0;
#pragma unroll
                    for (int jj = 0; jj < 32; ++jj) cnt += __popcll(__ballot(key[jj] >= cand));
                    if (cnt >= 256) { thr = cand; if (cnt == 256) break; }
                }
            }
            unsigned wd = 0u;
#pragma unroll
            for (int jj = 0; jj < 32; ++jj) { const int s2 = lane + 64 * jj; const unsigned long long m = __ballot(s2 <= t && key[jj] >= thr);
                if (lane == 2 * jj) wd = (unsigned)m; if (lane == 2 * jj + 1) wd = (unsigned)(m >> 32); }
            MASK[((size_t)b * 2048 + t) * 64 + lane] = wd;
        }
        WAVE_SYNC();
    }
}

__device__ __forceinline__ int t5_bucket(int d) {
    if (d < 16) return d;
    return 16 + (d >= 19) + (d >= 21) + (d >= 24) + (d >= 27) + (d >= 31) + (d >= 35) + (d >= 40) + (d >= 46) + (d >= 52) + (d >= 59) + (d >= 67) + (d >= 77) + (d >= 87) + (d >= 99) + (d >= 113);
}
namespace dsa {
constexpr float SCALE = 0.08838834764831845f;
constexpr int NW = 8, QBLK = 32, KVBLK = 64, QB = NW * QBLK, DH = 128, LD = 2048;
constexpr int SHM_V = KVBLK * DH * 2, SHM_K = KVBLK * DH * 2;
constexpr int OFF_WS = 2 * SHM_V + 2 * SHM_K, OFF_BIAS = OFF_WS + NW * 64 * 4, LDS_TOTAL = OFF_BIAS + 16 * 128 * 4;
constexpr float THR = 8.f;
typedef short s16x4 __attribute__((ext_vector_type(4)));
#define KSWZ(row, colB) ((row) * 256 + ((colB) ^ (((row) & 7) << 4)))
#define SBAR() __builtin_amdgcn_sched_barrier(0)
__device__ __forceinline__ int v_st(int k, int c) { const int kk = (k & ~0xC) | ((k & 4) << 1) | ((k & 8) >> 1); return ((kk >> 3) * 4 + (c >> 5)) * 512 + ((kk & 7) * 32 + (c & 31)) * 2; }
__device__ __forceinline__ int v_rd_base(int lane) { return ((lane & 3) << 3) | (((lane >> 2) & 3) << 6) | (((lane >> 4) & 1) << 5) | (((lane >> 5) & 1) << 8); }
constexpr int v_rd_off(int d0, int ks, int half) { return d0 * 512 + ks * 4096 + half * 2048; }
__device__ __forceinline__ int crow(int r, int hi) { return (r & 3) + 8 * (r >> 2) + 4 * hi; }
__device__ __forceinline__ unsigned cvtpk(float lo, float hi) { unsigned r; asm volatile("v_cvt_pk_bf16_f32 %0, %1, %2" : "=v"(r) : "v"(lo), "v"(hi)); return r; }
__device__ __forceinline__ bf16x8 load8(const bf16* p) { return *reinterpret_cast<const bf16x8*>(p); }
template <bool NEAR>
__device__ __forceinline__ void init_scores(f32x16& p0, f32x16& p1, unsigned w0, unsigned w1, int hi, int dq, const float* bl) {
    w0 >>= 4 * hi; w1 >>= 4 * hi;
#pragma unroll
    for (int r = 0; r < 16; ++r) { const int c = (r & 3) + 8 * (r >> 2);
        const int x0 = __builtin_amdgcn_sbfe(w0, c, 1), x1 = __builtin_amdgcn_sbfe(w1, c, 1);
        unsigned b0 = 0u, b1 = 0u;
        if (NEAR) { int d0 = dq - c, d1 = dq - c - 32; d0 = d0 < 0 ? 0 : (d0 > 127 ? 127 : d0); d1 = d1 < 0 ? 0 : (d1 > 127 ? 127 : d1);
            b0 = __float_as_uint(bl[d0]); b1 = __float_as_uint(bl[d1]); }
        p0[r] = __uint_as_float((b0 & (unsigned)x0) | (0xFF800000u & ~(unsigned)x0));
        p1[r] = __uint_as_float((b1 & (unsigned)x1) | (0xFF800000u & ~(unsigned)x1)); }
}
__device__ __forceinline__ void partialSM(f32x16& p0, f32x16& p1, float& m_reg, float& mn, float& alpha) {
    float pmax = p0[0];
#pragma unroll
    for (int r = 1; r < 16; ++r) pmax = fmaxf(pmax, p0[r]);
#pragma unroll
    for (int r = 0; r < 16; ++r) pmax = fmaxf(pmax, p1[r]);
    { auto rr = __builtin_amdgcn_permlane32_swap(__float_as_uint(pmax), __float_as_uint(pmax), false, false);
      pmax = fmaxf(__uint_as_float(rr[0]), __uint_as_float(rr[1])); }
    constexpr float C2 = 1.4426950408889634f * SCALE;
    if (__builtin_expect(__all((pmax - m_reg) * SCALE <= THR), 1)) { mn = m_reg; alpha = 1.f; }
    else { mn = fmaxf(m_reg, pmax); alpha = __builtin_amdgcn_exp2f((m_reg - mn) * C2); m_reg = mn; }
    const float mnL = -mn * C2;
#pragma unroll
    for (int r = 0; r < 16; ++r) p0[r] = fmaf(p0[r], C2, mnL);
#pragma unroll
    for (int r = 0; r < 16; ++r) p1[r] = fmaf(p1[r], C2, mnL);
#pragma unroll
    for (int r = 0; r < 16; ++r) p0[r] = __builtin_amdgcn_exp2f(p0[r]);
}
__device__ __forceinline__ void finishSM(f32x16& p0, f32x16& p1, float alpha, float& l_reg, bf16x8& pa0, bf16x8& pa1, bf16x8& pa2, bf16x8& pa3) {
#pragma unroll
    for (int r = 0; r < 16; ++r) p1[r] = __builtin_amdgcn_exp2f(p1[r]);
    float ps = 0;
#pragma unroll
    for (int r = 0; r < 16; ++r) ps += p0[r];
#pragma unroll
    for (int r = 0; r < 16; ++r) ps += p1[r];
    { auto rr = __builtin_amdgcn_permlane32_swap(__float_as_uint(ps), __float_as_uint(ps), false, false);
      ps = __uint_as_float(rr[0]) + __uint_as_float(rr[1]); }
    l_reg = l_reg * alpha + ps;
#define PK4(P, B_, OUT) do { unsigned a0 = cvtpk(P[B_+0], P[B_+1]), a1 = cvtpk(P[B_+2], P[B_+3]);                          \
        unsigned b0 = cvtpk(P[B_+4], P[B_+5]), b1 = cvtpk(P[B_+6], P[B_+7]);                                             \
        auto r0 = __builtin_amdgcn_permlane32_swap(a0, b0, false, false); auto r1 = __builtin_amdgcn_permlane32_swap(a1, b1, false, false); \
        u32x4 w = {r0[0], r1[0], r0[1], r1[1]}; OUT = *reinterpret_cast<bf16x8*>(&w); } while (0)
    PK4(p0, 0, pa0); PK4(p0, 8, pa1); PK4(p1, 0, pa2); PK4(p1, 8, pa3);
#undef PK4
}
template <int KB>
__device__ __forceinline__ void qkt(f32x16& p0, f32x16& p1, const char* K_lds, int r32, int hi, const bf16x8* qr) {
    const char* kb[4];
#pragma unroll
    for (int dd = 0; dd < 4; ++dd) kb[dd] = K_lds + KB * SHM_K + KSWZ(r32, (dd * 16 + hi * 8) * 2);
#pragma unroll
    for (int d0 = 0; d0 < 8; ++d0) { const char* a = kb[d0 & 3] + (d0 >> 2) * 128;
        bf16x8 b0 = *reinterpret_cast<const bf16x8*>(a);
        bf16x8 b1 = *reinterpret_cast<const bf16x8*>(a + 32 * 256);
        p0 = __builtin_amdgcn_mfma_f32_32x32x16_bf16(b0, qr[d0], p0, 0, 0, 0);
        p1 = __builtin_amdgcn_mfma_f32_32x32x16_bf16(b1, qr[d0], p1, 0, 0, 0); }
}
template <int VB>
__device__ __forceinline__ void pv_tile(f32x16* o, int vb0, bf16x8 pa0, bf16x8 pa1, bf16x8 pa2, bf16x8 pa3) {
#define TRRD(dst, off) asm volatile("ds_read_b64_tr_b16 %0, %1 offset:%2" : "=&v"(dst) : "v"(vb0), "i"(off) : "memory")
#define PV_D0(d0) do { s16x4 l0, l1, l2, l3, h0, h1, h2, h3; constexpr int b_ = VB * SHM_V + v_rd_off(d0, 0, 0); \
        TRRD(l0, b_); TRRD(h0, b_ + 2048); TRRD(l1, b_ + 4096); TRRD(h1, b_ + 6144); TRRD(l2, b_ + 8192); TRRD(h2, b_ + 10240); TRRD(l3, b_ + 12288); TRRD(h3, b_ + 14336); \
        asm volatile("s_waitcnt lgkmcnt(0)" ::: "memory"); SBAR();   \
        o[d0] = __builtin_amdgcn_mfma_f32_32x32x16_bf16(pa0, (bf16x8){l0[0], l0[1], l0[2], l0[3], h0[0], h0[1], h0[2], h0[3]}, o[d0], 0, 0, 0);   \
        o[d0] = __builtin_amdgcn_mfma_f32_32x32x16_bf16(pa1, (bf16x8){l1[0], l1[1], l1[2], l1[3], h1[0], h1[1], h1[2], h1[3]}, o[d0], 0, 0, 0);   \
        o[d0] = __builtin_amdgcn_mfma_f32_32x32x16_bf16(pa2, (bf16x8){l2[0], l2[1], l2[2], l2[3], h2[0], h2[1], h2[2], h2[3]}, o[d0], 0, 0, 0);   \
        o[d0] = __builtin_amdgcn_mfma_f32_32x32x16_bf16(pa3, (bf16x8){l3[0], l3[1], l3[2], l3[3], h3[0], h3[1], h3[2], h3[3]}, o[d0], 0, 0, 0); } while (0)
    PV_D0(0); PV_D0(1); PV_D0(2); PV_D0(3);
#undef PV_D0
#undef TRRD
}
struct BlockRef { const bf16* Q; const bf16* K; const bf16* V; bf16* O; const unsigned* M; int P0; int h; };
struct Seam { bf16x8 qr[8]; bf16x8 st_v0, st_v1, st_k0, st_k1; };
#define ROWU(p, k0) ((p) + (size_t)(k0) * LD)
#define VMW() asm volatile("s_waitcnt vmcnt(0)" ::: "memory")
#define VMWN(n) asm volatile("s_waitcnt vmcnt(%0)" :: "i"(n) : "memory")
#define SLOAD_H(Kp, Vp, k0) do { S.st_v0 = load8(ROWU(Vp, k0) + sofs); S.st_v1 = load8(ROWU(Vp, (k0) + 32) + sofs);              \
                         S.st_k0 = load8(ROWU(Kp, k0) + sofs); S.st_k1 = load8(ROWU(Kp, (k0) + 32) + sofs); } while (0)
#define SWRITE_HK(bf) do { *(bf16x8*)(K_lds + (bf) * SHM_K + kws) = S.st_k0; *(bf16x8*)(K_lds + (bf) * SHM_K + kws + 32 * 256) = S.st_k1; } while (0)
#define SWRITE_HV(bf) do { *(bf16x8*)(V_lds + (bf) * SHM_V + vst0) = S.st_v0; *(bf16x8*)(V_lds + (bf) * SHM_V + vst1) = S.st_v1; } while (0)
#define SWRITE_H(bf) do { SWRITE_HV(bf); SWRITE_HK(bf); } while (0)
__device__ __forceinline__ void prime(const BlockRef& cur, char* lds, Seam& S, int wid) {
    const int lane = fresh_lane(), tid = wid * 64 + lane, r32 = lane & 31, hi = lane >> 5;
    const int sr = tid >> 4, sc = (tid & 15) * 8, kws = KSWZ(sr, sc * 2); char* K_lds = lds + 2 * SHM_V; const unsigned sofs = (unsigned)(sr * LD + sc);
    const unsigned qofs = (unsigned)((wid * QBLK + r32) * LD + hi * 8);
#pragma unroll
    for (int d0 = 0; d0 < 8; ++d0) S.qr[d0] = load8(cur.Q + qofs + d0 * 16);
    SLOAD_H(cur.K, cur.V, 0); VMW(); SWRITE_HK(0);
    __syncthreads();
}
__device__ __forceinline__ void block(const BlockRef& cur, const BlockRef& nxt, char* lds, Seam& S, int wid) {
    const int lane = fresh_lane(), tid = wid * 64 + lane,
               r32 = lane & 31, hi = lane >> 5;
    const int NT = (cur.P0 + QB - 1) / KVBLK + 1;
    const int qlo = cur.P0 + wid * QBLK, qm = qlo + r32 - 4 * hi;
    char* V_lds = lds; char* K_lds = lds + 2 * SHM_V;
    float* ws = (float*)(lds + OFF_WS) + wid * 64; float* li_l = ws, * al_l = ws + 32;
    const float* bl = (const float*)(lds + OFF_BIAS) + cur.h * 128;
    const unsigned mofs = (unsigned)((wid * QBLK + r32) * 64);
    float m_reg = -1e30f, l_reg = 0; f32x16 o[4] = {};
    const int sr = tid >> 4, sc = (tid & 15) * 8, vst0 = v_st(sr, sc), vst1 = v_st(32 + sr, sc), kws = KSWZ(sr, sc * 2); const unsigned sofs = (unsigned)(sr * LD + sc);
    const int vb0 = (int)(uintptr_t)V_lds + v_rd_base(lane);
    const bf16* Kh = cur.K; const bf16* Vh = cur.V;
#define RESC(a) do { if (__any((a) < 1.f)) { if (hi == 0) al_l[r32] = (a); asm volatile("s_waitcnt lgkmcnt(0)" ::: "memory");              \
                     for (int d_ = 0; d_ < 4; ++d_) for (int r = 0; r < 16; ++r) o[d_][r] *= al_l[crow(r, hi)]; } } while (0)
#define KBASE(t) ((t) * KVBLK)
#define LDMASK(t) (*(const u32x2*)(cur.M + 2 * ((t) < 31 ? (t) : 31) + mofs))
#define INIT(P0_, P1_, t) do { const int kb_ = KBASE(t); if (qlo - kb_ - 63 < 113) init_scores<true>(P0_, P1_, mw.x, mw.y, hi, qm - kb_, bl); else init_scores<false>(P0_, P1_, mw.x, mw.y, hi, 0, bl); } while (0)
#define SEAM_K0() do { VMWN(8); SWRITE_HK(0); SBAR(); } while (0)
    f32x16 pA0, pA1, pB0, pB1; float mnA, mnB, alA, alB; bf16x8 pa0, pa1, pa2, pa3; u32x2 mw;
    SWRITE_HV(0); SBAR();
    if (NT > 1) { SLOAD_H(Kh, Vh, KBASE(1)); }
    mw = LDMASK(0); INIT(pA0, pA1, 0); mw = LDMASK(1);
    SBAR(); qkt<0>(pA0, pA1, K_lds, r32, hi, S.qr);
    partialSM(pA0, pA1, m_reg, mnA, alA);
    if (NT > 1) { VMW(); SWRITE_H(1); }
    __syncthreads();
#define HALF_STEP(PX0, PX1, mnX, alX, PY0, PY1, alY, t, KB, VB, SB) do {                                                      \
        INIT(PX0, PX1, (t)); mw = LDMASK((t) + 1);                                                                           \
        SBAR(); qkt<KB>(PX0, PX1, K_lds, r32, hi, S.qr);                                                                      \
        finishSM(PY0, PY1, alY, l_reg, pa0, pa1, pa2, pa3); SBAR();                                                           \
        if ((t) + 1 < NT) { SLOAD_H(Kh, Vh, KBASE((t) + 1)); SBAR(); }                                                        \
        pv_tile<VB>(o, vb0, pa0, pa1, pa2, pa3); partialSM(PX0, PX1, m_reg, mnX, alX);              \
        __syncthreads();                                                                                                      \
        if ((t) + 1 < NT) { VMW(); SWRITE_H(SB); }                                                                            \
        RESC(alX); __syncthreads(); } while (0)
    for (int t = 1; t + 1 < NT; t += 2) {
        HALF_STEP(pB0, pB1, mnB, alB, pA0, pA1, alA, t, 1, 0, 0);
        HALF_STEP(pA0, pA1, mnA, alA, pB0, pB1, alB, t + 1, 0, 1, 1);
    }
    const bool even = (NT & 1) == 0;
    if (even) { INIT(pB0, pB1, NT - 1); SBAR(); qkt<1>(pB0, pB1, K_lds, r32, hi, S.qr); SBAR(); }
    SLOAD_H(nxt.K, nxt.V, 0); SBAR();
#pragma unroll
    for (int d0 = 0; d0 < 8; ++d0) S.qr[d0] = load8(nxt.Q + (unsigned)((wid * QBLK + r32) * LD + hi * 8) + d0 * 16);
    SBAR();
    finishSM(pA0, pA1, alA, l_reg, pa0, pa1, pa2, pa3); SBAR();
    pv_tile<0>(o, vb0, pa0, pa1, pa2, pa3);
    if (even) { partialSM(pB0, pB1, m_reg, mnB, alB); __syncthreads(); RESC(alB);
        finishSM(pB0, pB1, alB, l_reg, pa0, pa1, pa2, pa3); SBAR(); pv_tile<1>(o, vb0, pa0, pa1, pa2, pa3); }
    SBAR(); SEAM_K0();
    if (hi == 0) li_l[r32] = l_reg; asm volatile("s_waitcnt lgkmcnt(0)" ::: "memory");
    float rli[16];
#pragma unroll
    for (int r = 0; r < 16; ++r) rli[r] = __builtin_amdgcn_rcpf(li_l[crow(r, hi)]);
    int lofs = 4 * hi * LD + r32; asm volatile("" : "+v"(lofs));
    bf16* Ow = cur.O + (size_t)(wid * QBLK) * LD + lofs;
#pragma unroll
    for (int r = 0; r < 16; ++r) { const int orow = (r & 3) + 8 * (r >> 2);
#pragma unroll
        for (int d0 = 0; d0 < 4; ++d0) { const float v = o[d0][r] * rli[r];
            const float vn = __shfl_xor(v, 1);
            if ((r32 & 1) == 0) *(unsigned*)(Ow + orow * LD + d0 * 32) = cvtpk(v, vn); } }
    __syncthreads();
#undef RESC
#undef KBASE
#undef LDMASK
#undef INIT
#undef SEAM_K0
#undef HALF_STEP
}
#undef ROWU
#undef VMW
#undef VMWN
#undef SLOAD_H
#undef SWRITE_HK
#undef SWRITE_HV
#undef SWRITE_H
#undef KSWZ
#undef SBAR
}

__device__ __forceinline__ dsa::BlockRef dsa_ref(const Frame& F, int bh, int qb) {
    const int b = bh >> 4, h = bh & 15;
    dsa::BlockRef r;
    r.Q = F.slot(4) + ((size_t)b * 2048 + (size_t)qb * 256) * 2048 + h * 128;
    r.O = F.slot(3) + ((size_t)b * 2048 + (size_t)qb * 256) * 2048 + h * 128;
    r.K = F.slot(1) + (size_t)b * 2048 * 2048 + h * 128; r.V = F.slot(2) + (size_t)b * 2048 * 2048 + h * 128;
    r.M = (const unsigned*)(F.ws + WS_MASK) + ((size_t)b * 2048 + (size_t)qb * 256) * 64;
    r.P0 = qb * 256; r.h = h;
    return r;
}
__device__ __forceinline__ void ph6_attn(const Frame& F) {
    const Args& a = *F.a;
    char* lds = (char*)F.lds;
    {
        float* bt = (float*)(lds + dsa::OFF_BIAS);
        for (int i = F.wave * 64 + F.lane(); i < 16 * 128; i += 512) { const int h = i >> 7, d = i & 127; bt[i] = (a.in[10][t5_bucket(d) * 16 + h] - a.in[10][31 * 16 + h]) * (1.0f / dsa::SCALE); }
    }
    __syncthreads();
    const int total = 4 * 128;
    int L = F.bid; if (L >= total) return;
    int pass = 0;
    dsa::BlockRef cur = dsa_ref(F, L >> 2, L & 3);
    dsa::Seam S;
    dsa::prime(cur, lds, S, F.wave);
    for (;;) {
        const bool more_pass = pass == 0, more_item = L + F.G < total, last = !more_pass && !more_item;
        int passn = pass + 1, Ln = L;
        if (!more_pass) { passn = 0; Ln = more_item ? L + F.G : L; }
        const dsa::BlockRef nxt = last ? cur : dsa_ref(F, Ln >> 2, passn ? 7 - (Ln & 3) : (Ln & 3));
        dsa::block(cur, nxt, lds, S, F.wave);
        if (last) break;
        cur = nxt; pass = passn; L = Ln;
    }
}

__device__ __forceinline__ void ln_row(float* zrow, const float* g, const float* bta, bf16* brow, int lane) {
    f32x4 v[8]; float s = 0.f;
#pragma unroll
    for (int i = 0; i < 8; ++i) { v[i] = *(const f32x4*)(zrow + 256 * i + 4 * lane); s += (v[i].x + v[i].y) + (v[i].z + v[i].w); }
    const float mu = wave_sum(s) * (1.0f / 2048.0f); float s2 = 0.f;
#pragma unroll
    for (int i = 0; i < 8; ++i) { v[i] = v[i] - mu; s2 += (v[i].x * v[i].x + v[i].y * v[i].y) + (v[i].z * v[i].z + v[i].w * v[i].w); }
    const float r = rsqrtf(wave_sum(s2) * (1.0f / 2048.0f) + 1e-5f);
#pragma unroll
    for (int i = 0; i < 8; ++i) { const f32x4 gg = *(const f32x4*)(g + 256 * i + 4 * lane), bb = *(const f32x4*)(bta + 256 * i + 4 * lane);
        const f32x4 o = v[i] * r * gg + bb; *(f32x4*)(zrow + 256 * i + 4 * lane) = o;
        if (brow) { u32x2 w; w.x = pk2(o.x, o.y); w.y = pk2(o.z, o.w); *(u32x2*)(brow + 256 * i + 4 * lane) = w; } }
}
__device__ __forceinline__ void ph_ln(const Frame& F, const float* g, const float* bta, bf16* bout) {
    const int gw = F.bid * 8 + F.wave, NGW = F.G * 8, lane = F.lane();
    for (int row = gw; row < T; row += NGW) ln_row(F.a->out + (size_t)row * 2048, g, bta, bout + (size_t)row * 2048, lane);
}

__device__ __forceinline__ float pk_idx(float v, unsigned code, unsigned mask) { return __uint_as_float((__float_as_uint(v) & ~mask) | code); }
__device__ __forceinline__ void ph_peer_select(const Frame& F) {
    const Args& a = *F.a;
    const int lane = F.lane(), l31 = lane & 31, half = lane >> 5;
    const float* PQ = (const float*)F.slot(1); const float* keys = a.in[23];
    int* EIDX = (int*)(F.ws + WS_CKV); float* EG = (float*)(F.ws + WS_IKW);
    const float NEG = -__builtin_inff();
    for (int tile = F.bid; tile < T / 32; tile += F.G) {
        const int h = F.wave, t = tile * 32 + l31;
        float tv[2][16];
#pragma unroll
        for (int p = 0; p < 2; ++p) {
            const int g = 2 * h + p;
            float qv[64];
            { const float* qp = PQ + (size_t)t * 2048 + g * 128 + 64 * half;
#pragma unroll
              for (int j = 0; j < 16; ++j) { const f32x4 v = *(const f32x4*)(qp + 4 * j); qv[4 * j] = v.x; qv[4 * j + 1] = v.y; qv[4 * j + 2] = v.z; qv[4 * j + 3] = v.w; } }
            f32x16 acc[4];
#pragma unroll
            for (int mt = 0; mt < 4; ++mt) {
#pragma unroll
                for (int r = 0; r < 16; ++r) acc[mt][r] = 0.f;
                const float* kp = keys + ((size_t)(g * 128 + mt * 32 + l31) * 128 + 64 * half);
#pragma unroll
                for (int j = 0; j < 16; ++j) { const f32x4 kv = *(const f32x4*)(kp + 4 * j);
                    acc[mt] = __builtin_amdgcn_mfma_f32_32x32x2f32(kv.x, qv[4 * j], acc[mt], 0, 0, 0); acc[mt] = __builtin_amdgcn_mfma_f32_32x32x2f32(kv.y, qv[4 * j + 1], acc[mt], 0, 0, 0);
                    acc[mt] = __builtin_amdgcn_mfma_f32_32x32x2f32(kv.z, qv[4 * j + 2], acc[mt], 0, 0, 0); acc[mt] = __builtin_amdgcn_mfma_f32_32x32x2f32(kv.w, qv[4 * j + 3], acc[mt], 0, 0, 0);
                    if ((j & 3) == 3) __builtin_amdgcn_sched_barrier(0); }
            }
            unsigned hmask = ~(4u * (unsigned)half); asm volatile("" : "+v"(hmask));
#pragma unroll
            for (int mt = 0; mt < 4; ++mt)
#pragma unroll
                for (int r = 0; r < 16; ++r) acc[mt][r] = __uint_as_float(((__float_as_uint(acc[mt][r]) & ~127u) | (unsigned)(127 - (32 * mt + (r & 3) + 8 * (r >> 2)))) & hmask);
#pragma unroll
            for (int k = 0; k < 16; ++k) {
                float m = acc[0][0];
#pragma unroll
                for (int mt = 0; mt < 4; ++mt)
#pragma unroll
                    for (int r = 0; r < 16; ++r) m = fmaxf(m, acc[mt][r]);
                m = fmaxf(m, __shfl_xor(m, 32));
                tv[p][k] = m;
#pragma unroll
                for (int mt = 0; mt < 4; ++mt)
#pragma unroll
                    for (int r = 0; r < 16; ++r) acc[mt][r] = (acc[mt][r] == m) ? NEG : acc[mt][r];
            }
        }
        float cand[25]; int cid[25];
        unsigned hc = 25u * (unsigned)half; asm volatile("" : "+v"(hc));
        { const float ai = half ? tv[0][2] : tv[0][0], bj = half ? tv[1][1] : tv[1][0];
          cand[0] = pk_idx(ai + bj, (unsigned)(63 - 0) - hc, 63u); cid[0] = (int)((127u - (__float_as_uint(ai) & 127u)) * 128u + (127u - (__float_as_uint(bj) & 127u))); }
        { const float ai = half ? tv[0][2] : tv[0][0], bj = half ? tv[1][2] : tv[1][1];
          cand[1] = pk_idx(ai + bj, (unsigned)(63 - 1) - hc, 63u); cid[1] = (int)((127u - (__float_as_uint(ai) & 127u)) * 128u + (127u - (__float_as_uint(bj) & 127u))); }
        { const float ai = half ? tv[0][2] : tv[0][0], bj = half ? tv[1][3] : tv[1][2];
          cand[2] = pk_idx(ai + bj, (unsigned)(63 - 2) - hc, 63u); cid[2] = (int)((127u - (__float_as_uint(ai) & 127u)) * 128u + (127u - (__float_as_uint(bj) & 127u))); }
        { const float ai = half ? tv[0][2] : tv[0][0], bj = half ? tv[1][4] : tv[1][3];
          cand[3] = pk_idx(ai + bj, (unsigned)(63 - 3) - hc, 63u); cid[3] = (int)((127u - (__float_as_uint(ai) & 127u)) * 128u + (127u - (__float_as_uint(bj) & 127u))); }
        { const float ai = half ? tv[0][3] : tv[0][0], bj = half ? tv[1][0] : tv[1][4];
          cand[4] = pk_idx(ai + bj, (unsigned)(63 - 4) - hc, 63u); cid[4] = (int)((127u - (__float_as_uint(ai) & 127u)) * 128u + (127u - (__float_as_uint(bj) & 127u))); }
        { const float ai = half ? tv[0][3] : tv[0][0], bj = half ? tv[1][1] : tv[1][5];
          cand[5] = pk_idx(ai + bj, (unsigned)(63 - 5) - hc, 63u); cid[5] = (int)((127u - (__float_as_uint(ai) & 127u)) * 128u + (127u - (__float_as_uint(bj) & 127u))); }
        { const float ai = half ? tv[0][3] : tv[0][0], bj = half ? tv[1][2] : tv[1][6];
          cand[6] = pk_idx(ai + bj, (unsigned)(63 - 6) - hc, 63u); cid[6] = (int)((127u - (__float_as_uint(ai) & 127u)) * 128u + (127u - (__float_as_uint(bj) & 127u))); }
        { const float ai = half ? tv[0][3] : tv[0][0], bj = half ? tv[1][3] : tv[1][7];
          cand[7] = pk_idx(ai + bj, (unsigned)(63 - 7) - hc, 63u); cid[7] = (int)((127u - (__float_as_uint(ai) & 127u)) * 128u + (127u - (__float_as_uint(bj) & 127u))); }
        { const float ai = half ? tv[0][4] : tv[0][0], bj = half ? tv[1][0] : tv[1][8];
          cand[8] = pk_idx(ai + bj, (unsigned)(63 - 8) - hc, 63u); cid[8] = (int)((127u - (__float_as_uint(ai) & 127u)) * 128u + (127u - (__float_as_uint(bj) & 127u))); }
        { const float ai = half ? tv[0][4] : tv[0][0], bj = half ? tv[1][1] : tv[1][9];
          cand[9] = pk_idx(ai + bj, (unsigned)(63 - 9) - hc, 63u); cid[9] = (int)((127u - (__float_as_uint(ai) & 127u)) * 128u + (127u - (__float_as_uint(bj) & 127u))); }
        { const float ai = half ? tv[0][4] : tv[0][0], bj = half ? tv[1][2] : tv[1][10];
          cand[10] = pk_idx(ai + bj, (unsigned)(63 - 10) - hc, 63u); cid[10] = (int)((127u - (__float_as_uint(ai) & 127u)) * 128u + (127u - (__float_as_uint(bj) & 127u))); }
        { const float ai = half ? tv[0][5] : tv[0][0], bj = half ? tv[1][0] : tv[1][11];
          cand[11] = pk_idx(ai + bj, (unsigned)(63 - 11) - hc, 63u); cid[11] = (int)((127u - (__float_as_uint(ai) & 127u)) * 128u + (127u - (__float_as_uint(bj) & 127u))); }
        { const float ai = half ? tv[0][5] : tv[0][0], bj = half ? tv[1][1] : tv[1][12];
          cand[12] = pk_idx(ai + bj, (unsigned)(63 - 12) - hc, 63u); cid[12] = (int)((127u - (__float_as_uint(ai) & 127u)) * 128u + (127u - (__float_as_uint(bj) & 127u))); }
        { const float ai = half ? tv[0][6] : tv[0][0], bj = half ? tv[1][0] : tv[1][13];
          cand[13] = pk_idx(ai + bj, (unsigned)(63 - 13) - hc, 63u); cid[13] = (int)((127u - (__float_as_uint(ai) & 127u)) * 128u + (127u - (__float_as_uint(bj) & 127u))); }
        { const float ai = half ? tv[0][6] : tv[0][0], bj = half ? tv[1][1] : tv[1][14];
          cand[14] = pk_idx(ai + bj, (unsigned)(63 - 14) - hc, 63u); cid[14] = (int)((127u - (__float_as_uint(ai) & 127u)) * 128u + (127u - (__float_as_uint(bj) & 127u))); }
        { const float ai = half ? tv[0][7] : tv[0][0], bj = half ? tv[1][0] : tv[1][15];
          cand[15] = pk_idx(ai + bj, (unsigned)(63 - 15) - hc, 63u); cid[15] = (int)((127u - (__float_as_uint(ai) & 127u)) * 128u + (127u - (__float_as_uint(bj) & 127u))); }
        { const float ai = half ? tv[0][7] : tv[0][1], bj = half ? tv[1][1] : tv[1][0];
          cand[16] = pk_idx(ai + bj, (unsigned)(63 - 16) - hc, 63u); cid[16] = (int)((127u - (__float_as_uint(ai) & 127u)) * 128u + (127u - (__float_as_uint(bj) & 127u))); }
        { const float ai = half ? tv[0][8] : tv[0][1], bj = half ? tv[1][0] : tv[1][1];
          cand[17] = pk_idx(ai + bj, (unsigned)(63 - 17) - hc, 63u); cid[17] = (int)((127u - (__float_as_uint(ai) & 127u)) * 128u + (127u - (__float_as_uint(bj) & 127u))); }
        { const float ai = half ? tv[0][9] : tv[0][1], bj = half ? tv[1][0] : tv[1][2];
          cand[18] = pk_idx(ai + bj, (unsigned)(63 - 18) - hc, 63u); cid[18] = (int)((127u - (__float_as_uint(ai) & 127u)) * 128u + (127u - (__float_as_uint(bj) & 127u))); }
        { const float ai = half ? tv[0][10] : tv[0][1], bj = half ? tv[1][0] : tv[1][3];
          cand[19] = pk_idx(ai + bj, (unsigned)(63 - 19) - hc, 63u); cid[19] = (int)((127u - (__float_as_uint(ai) & 127u)) * 128u + (127u - (__float_as_uint(bj) & 127u))); }
        { const float ai = half ? tv[0][11] : tv[0][1], bj = half ? tv[1][0] : tv[1][4];
          cand[20] = pk_idx(ai + bj, (unsigned)(63 - 20) - hc, 63u); cid[20] = (int)((127u - (__float_as_uint(ai) & 127u)) * 128u + (127u - (__float_as_uint(bj) & 127u))); }
        { const float ai = half ? tv[0][12] : tv[0][1], bj = half ? tv[1][0] : tv[1][5];
          cand[21] = pk_idx(ai + bj, (unsigned)(63 - 21) - hc, 63u); cid[21] = (int)((127u - (__float_as_uint(ai) & 127u)) * 128u + (127u - (__float_as_uint(bj) & 127u))); }
        { const float ai = half ? tv[0][13] : tv[0][1], bj = half ? tv[1][0] : tv[1][6];
          cand[22] = pk_idx(ai + bj, (unsigned)(63 - 22) - hc, 63u); cid[22] = (int)((127u - (__float_as_uint(ai) & 127u)) * 128u + (127u - (__float_as_uint(bj) & 127u))); }
        { const float ai = half ? tv[0][14] : tv[0][1], bj = half ? tv[1][0] : tv[1][7];
          cand[23] = pk_idx(ai + bj, (unsigned)(63 - 23) - hc, 63u); cid[23] = (int)((127u - (__float_as_uint(ai) & 127u)) * 128u + (127u - (__float_as_uint(bj) & 127u))); }
        { const float ai = half ? tv[0][15] : tv[0][2], bj = half ? tv[1][0] : tv[1][0];
          cand[24] = pk_idx(ai + bj, (unsigned)(63 - 24) - hc, 63u); cid[24] = (int)((127u - (__float_as_uint(ai) & 127u)) * 128u + (127u - (__float_as_uint(bj) & 127u))); }
        float sv[16]; int sid[16];
#pragma unroll
        for (int k = 0; k < 16; ++k) {
            float m = cand[0];
#pragma unroll
            for (int c = 1; c < 25; ++c) m = fmaxf(m, cand[c]);
            const float mo = __shfl_xor(m, 32);
            const bool mine = (m > mo) || (m == mo && half == 0);
            const float mm = fmaxf(m, mo);
            int id = -1;
#pragma unroll
            for (int c = 0; c < 25; ++c) { const bool hit = mine && (cand[c] == mm); id = hit ? cid[c] : id; cand[c] = hit ? NEG : cand[c]; }
            const int ido = __shfl_xor(id, 32);
            sv[k] = mm; sid[k] = id > ido ? id : ido;
        }
        float den = 0.f; float ev[16];
#pragma unroll
        for (int k = 0; k < 16; ++k) { ev[k] = expf(sv[k] - sv[0]); den += ev[k]; }
        const float inv = 1.0f / den;
        if (half == 0) { int* ep = EIDX + (size_t)t * 128 + h * 16;
#pragma unroll
            for (int k = 0; k < 16; k += 4) *(u32x4*)(ep + k) = (u32x4){(unsigned)sid[k], (unsigned)sid[k + 1], (unsigned)sid[k + 2], (unsigned)sid[k + 3]}; }
        else { float* gp = EG + (size_t)t * 128 + h * 16;
#pragma unroll
            for (int k = 0; k < 16; k += 4) *(f32x4*)(gp + k) = (f32x4){ev[k] * inv, ev[k + 1] * inv, ev[k + 2] * inv, ev[k + 3] * inv}; }
    }
}

typedef __bf16 bf16x2_t __attribute__((ext_vector_type(2)));
__device__ __forceinline__ float dot2bf(unsigned a, unsigned b, float c) { return __builtin_amdgcn_fdot2_f32_bf16(__builtin_bit_cast(bf16x2_t, a), __builtin_bit_cast(bf16x2_t, b), c, false); }
#define RL(v, l) __builtin_amdgcn_readlane((v), (l))
#define EXR 2
#define EX_LOAD(buf, tab, idv, e) do { _Pragma("unroll") for (int r_ = 0; r_ < EXR; ++r_) { const bf16* rp_ = (tab) + (size_t)RL(idv, ((e) & 63) + r_) * 2048 + 8 * lane; \
        _Pragma("unroll") for (int c_ = 0; c_ < 4; ++c_) buf[r_][c_] = *(const u32x4*)(rp_ + 512 * c_); } } while (0)
#define EX_DOT(buf, e) do { float d_[EXR]; _Pragma("unroll") for (int r_ = 0; r_ < EXR; ++r_) { float a_ = 0.f, b_ = 0.f; \
        _Pragma("unroll") for (int c_ = 0; c_ < 4; ++c_) { a_ = dot2bf(buf[r_][c_].x, xb[c_].x, a_); b_ = dot2bf(buf[r_][c_].y, xb[c_].y, b_); a_ = dot2bf(buf[r_][c_].z, xb[c_].z, a_); b_ = dot2bf(buf[r_][c_].w, xb[c_].w, b_); } d_[r_] = a_ + b_; } \
        _Pragma("unroll") for (int o_ = 32; o_ >= 1; o_ >>= 1) { _Pragma("unroll") for (int r_ = 0; r_ < EXR; ++r_) d_[r_] += __shfl_xor(d_[r_], o_); } \
        _Pragma("unroll") for (int r_ = 0; r_ < EXR; ++r_) { const float hv_ = 0.5f * d_[r_] * (1.0f + erff(d_[r_] * 0.7071067811865476f)); if (lane == (((e) & 63) + r_)) { if ((e) < 64) c0 = g0 * hv_; else c1 = g1 * hv_; } } } while (0)
#define EX_AXPY(buf, e) do { const float cv_ = (e) < 64 ? c0 : c1; _Pragma("unroll") for (int r_ = 0; r_ < EXR; ++r_) { const float cf_ = __int_as_float(RL(__float_as_int(cv_), ((e) & 63) + r_)); \
        _Pragma("unroll") for (int c_ = 0; c_ < 4; ++c_) { y[c_][0] += cf_ * bflo(buf[r_][c_].x); y[c_][1] += cf_ * bfhi(buf[r_][c_].x); y[c_][2] += cf_ * bflo(buf[r_][c_].y); y[c_][3] += cf_ * bfhi(buf[r_][c_].y); \
            y[c_][4] += cf_ * bflo(buf[r_][c_].z); y[c_][5] += cf_ * bfhi(buf[r_][c_].z); y[c_][6] += cf_ * bflo(buf[r_][c_].w); y[c_][7] += cf_ * bfhi(buf[r_][c_].w); } } } while (0)
__device__ __forceinline__ void ph16_experts(const Frame& F) {
    const Args& a = *F.a;
    const int gw = F.bid * 8 + F.wave, NGW = F.G * 8, lane = F.lane();
    const int* EIDX = (const int*)(F.ws + WS_CKV); const float* EG = (const float*)(F.ws + WS_IKW);
    const bf16* PU = F.slot(5); const bf16* PV = F.slot(6); const bf16* XB = F.slot(0);
    for (int t = gw; t < T; t += NGW) {
        u32x4 xb[4];
#pragma unroll
        for (int c = 0; c < 4; ++c) xb[c] = *(const u32x4*)(XB + (size_t)t * 2048 + 512 * c + 8 * lane);
        const int id0 = EIDX[(size_t)t * 128 + lane], id1 = EIDX[(size_t)t * 128 + 64 + lane];
        const float g0 = EG[(size_t)t * 128 + lane], g1 = EG[(size_t)t * 128 + 64 + lane];
        float c0 = 0.f, c1 = 0.f;
        u32x4 bA[EXR][4], bB[EXR][4];
        EX_LOAD(bA, PU, id0, 0);
        for (int e = 0; e < 128; e += 2 * EXR) {
            const int idv = e < 64 ? id0 : id1;
            EX_LOAD(bB, PU, idv, e + EXR);
            EX_DOT(bA, e);
            if (e + 2 * EXR < 128) { const int idn = (e + 2 * EXR) < 64 ? id0 : id1; EX_LOAD(bA, PU, idn, e + 2 * EXR); }
            EX_DOT(bB, e + EXR);
        }
        float y[4][8];
#pragma unroll
        for (int c = 0; c < 4; ++c)
#pragma unroll
            for (int j = 0; j < 8; ++j) y[c][j] = 0.f;
        EX_LOAD(bA, PV, id0, 0);
        for (int e = 0; e < 128; e += 2 * EXR) {
            const int idv = e < 64 ? id0 : id1;
            EX_LOAD(bB, PV, idv, e + EXR);
            EX_AXPY(bA, e);
            if (e + 2 * EXR < 128) { const int idn = (e + 2 * EXR) < 64 ? id0 : id1; EX_LOAD(bA, PV, idn, e + 2 * EXR); }
            EX_AXPY(bB, e + EXR);
        }
        float* xrow = a.out + (size_t)t * 2048;
        float s = 0.f;
#pragma unroll
        for (int c = 0; c < 4; ++c) { const f32x4 x0 = *(const f32x4*)(xrow + 512 * c + 8 * lane), x1 = *(const f32x4*)(xrow + 512 * c + 8 * lane + 4);
            y[c][0] += ALPHA * x0.x; y[c][1] += ALPHA * x0.y; y[c][2] += ALPHA * x0.z; y[c][3] += ALPHA * x0.w; y[c][4] += ALPHA * x1.x; y[c][5] += ALPHA * x1.y; y[c][6] += ALPHA * x1.z; y[c][7] += ALPHA * x1.w;
#pragma unroll
            for (int j = 0; j < 8; ++j) s += y[c][j]; }
        const float mu = wave_sum(s) * (1.0f / 2048.0f); float s2 = 0.f;
#pragma unroll
        for (int c = 0; c < 4; ++c)
#pragma unroll
            for (int j = 0; j < 8; ++j) { y[c][j] -= mu; s2 += y[c][j] * y[c][j]; }
        const float rs = rsqrtf(wave_sum(s2) * (1.0f / 2048.0f) + 1e-5f);
#pragma unroll
        for (int c = 0; c < 4; ++c) { const int col = 512 * c + 8 * lane;
            const f32x4 ga = *(const f32x4*)(a.in[26] + col), gb = *(const f32x4*)(a.in[26] + col + 4), ba = *(const f32x4*)(a.in[27] + col), bb = *(const f32x4*)(a.in[27] + col + 4);
            f32x4 o0, o1; o0.x = y[c][0] * rs * ga.x + ba.x; o0.y = y[c][1] * rs * ga.y + ba.y; o0.z = y[c][2] * rs * ga.z + ba.z; o0.w = y[c][3] * rs * ga.w + ba.w;
            o1.x = y[c][4] * rs * gb.x + bb.x; o1.y = y[c][5] * rs * gb.y + bb.y; o1.z = y[c][6] * rs * gb.z + bb.z; o1.w = y[c][7] * rs * gb.w + bb.w;
            *(f32x4*)(xrow + col) = o0; *(f32x4*)(xrow + col + 4) = o1; }
    }
}

#define XB_TMO      128
#define XB_XCNT(j)  (256  + 64 * (j))
#define XB_XSUB(j)  (1280 + 64 * (j))
#define XB_XGEN(j)  (2304 + 64 * (j))
#define XB_TOP      3328
#define XB_TOPGEN   3392
#define XCD_BAR_WORDS 3456
#define XB_SPIN_CAP (1u << 22)
__device__ __forceinline__ unsigned xb_ld(unsigned* p)              { return __hip_atomic_load(p, __ATOMIC_RELAXED, __HIP_MEMORY_SCOPE_AGENT); }
__device__ __forceinline__ unsigned xb_add(unsigned* p, unsigned v) { return __hip_atomic_fetch_add(p, v, __ATOMIC_RELAXED, __HIP_MEMORY_SCOPE_AGENT); }
__device__ __forceinline__ unsigned xb_xcc_id() { return (unsigned)__builtin_amdgcn_s_getreg((3 << 11) | 20) & 0xFu; }
#define XB_SPIN(cond, bar) do { unsigned _sp = 0; while (cond) { __builtin_amdgcn_s_sleep(1); \
    if ((++_sp & 255u) == 0u) { if (xb_ld(&(bar)[XB_TMO])) break; if (_sp > XB_SPIN_CAP) { atomicAdd(&(bar)[XB_TMO], 1u); break; } } } } while (0)
struct XcdBarrier { unsigned* bar; unsigned x; volatile unsigned* st; };
__device__ __forceinline__ void xcd_barrier_complete(unsigned* bar, unsigned x, unsigned G, unsigned& nloc, unsigned& nx) {
    unsigned sum, cnt, mine, sp = 0u;
    for (;;) {
        sum = 0u; cnt = 0u; mine = 0u;
#pragma unroll
        for (unsigned j = 0; j < 16; ++j) { const unsigned c = xb_ld(&bar[XB_XCNT(j)]); sum += c; cnt += (c > 0u) ? 1u : 0u; mine = (j == x) ? c : mine; }
        if (sum == G) break;
        __builtin_amdgcn_s_sleep(1);
        if ((++sp & 255u) == 0u) { if (xb_ld(&bar[XB_TMO])) break; if (sp > XB_SPIN_CAP) { atomicAdd(&bar[XB_TMO], 1u); break; } }
    }
    nloc = mine > 0u ? mine : 1u; nx = cnt > 0u ? cnt : 1u;
}
__device__ __forceinline__ void xcd_barrier(const XcdBarrier& b, bool leader, unsigned G) {
    asm volatile("s_waitcnt vmcnt(0)" ::: "memory");
    __syncthreads();
    if (leader) {
        unsigned* bar = b.bar;
        __builtin_amdgcn_s_waitcnt(0);
        unsigned nloc = b.st[0], nx = b.st[1];
        if (nloc == 0u) { xcd_barrier_complete(bar, b.x, G, nloc, nx); b.st[0] = nloc; b.st[1] = nx; }
        const unsigned old = xb_add(&bar[XB_XSUB(b.x)], 1u);
        const unsigned gen = old / nloc;
        if (old + 1u == (gen + 1u) * nloc) {
            __builtin_amdgcn_fence(__ATOMIC_RELEASE, "agent");
            asm volatile("s_waitcnt vmcnt(0)" ::: "memory");
            const unsigned og = xb_add(&bar[XB_TOP], 1u);
            const unsigned tg = og / nx;
            if (og + 1u == (tg + 1u) * nx) xb_add(&bar[XB_TOPGEN], 1u);
            else XB_SPIN(xb_ld(&bar[XB_TOPGEN]) == tg, bar);
            __builtin_amdgcn_fence(__ATOMIC_ACQUIRE, "agent");
            xb_add(&bar[XB_XGEN(b.x)], 1u);
            asm volatile("s_waitcnt vmcnt(0)" ::: "memory");
        } else {
            XB_SPIN(xb_ld(&bar[XB_XGEN(b.x)]) == gen, bar);
            __builtin_amdgcn_fence(__ATOMIC_ACQUIRE, "agent");
            asm volatile("s_waitcnt vmcnt(0)" ::: "memory");
        }
    }
    __syncthreads();
}

__global__ void __launch_bounds__(512, 2) mega(Args args) {
    extern __shared__ __attribute__((aligned(16))) unsigned char lds[];
    cg::grid_group grid = cg::this_grid();
    Frame F;
    F.lds = lds; F.wave = __builtin_amdgcn_readfirstlane(threadIdx.x >> 6); F.bid = blockIdx.x; F.G = gridDim.x;
    F.a = &args; F.ws = args.ws;
    const int lo = args.ph_lo, hi = args.ph_hi;
    volatile unsigned* xst = (volatile unsigned*)(lds + LDS_BYTES - 64);
    const bool leader = (F.wave == 0) && (fresh_lane() == 0);
    if (leader) { xst[0] = 0u; xst[1] = 0u; }
    XcdBarrier xbar; xbar.bar = (unsigned*)(F.ws + WS_CTL) + 4096; xbar.x = xb_xcc_id(); xbar.st = xst;
    if (leader) (void)xb_add(&xbar.bar[XB_XCNT(xbar.x)], 1u);
    __syncthreads();
    bf16* W8 = (bf16*)(F.ws + WS_WIN);
#define IN(k) (lo <= (k) && (k) < hi)
#if PROBE_MASK
    unsigned long long pr_acc = 0ull, pr_t0 = __builtin_amdgcn_s_memrealtime();
#define SEAM(k) do { if (IN(k) && IN((k) + 1)) { if ((k) == 0) grid.sync(); else xcd_barrier(xbar, (F.wave == 0) && (fresh_lane() == 0), (unsigned)F.G); } { const unsigned long long t1_ = __builtin_amdgcn_s_memrealtime(); if ((PROBE_MASK >> (k)) & 1u) pr_acc += t1_ - pr_t0; pr_t0 = t1_; } } while (0)
#else
#define SEAM(k) do { if (IN(k) && IN((k) + 1)) { if ((k) == 0) grid.sync(); else xcd_barrier(xbar, (F.wave == 0) && (fresh_lane() == 0), (unsigned)F.G); } } while (0)
#endif
    if (IN(0)) { ph0_prologue(F); } SEAM(0);
    if (IN(1)) { gemm(F, (const bf16*)args.out, 2048, (const bf16*)(F.ws + WS_WIN), 2048, T, NCOLS, 2048, OpProj{F.ws}); } SEAM(1);
    if (IN(2)) {
        for (int u = F.bid; u < 128; u += F.G) hgrn_naive(F, u);
        if (F.G > 128) { if (F.bid >= 128) ph2_side(F, F.bid - 128, F.G - 128); } else ph2_side(F, F.bid, F.G);
    } SEAM(2);
    if (IN(3)) { ph3_hgnorm(F); } SEAM(3);
    if (IN(4)) {
        gemm(F, F.slot(0), 2048, W8, 2048, T, 2048, 2048, OpYA{F.slot(6)});
        gemm(F, (const bf16*)(F.ws + WS_CKV), 256, (const bf16*)(F.ws + WS_WKV), 256, T, 4096, 256, OpSplit2{F.slot(1), F.slot(2)});
    } SEAM(4);
    if (IN(5)) { ph5_select(F); } SEAM(5);
    if (IN(6)) { ph6_attn(F); } SEAM(6);
    if (IN(7)) { gemm(F, F.slot(3), 2048, W8 + (size_t)1 * 2048 * 2048, 2048, T, 2048, 2048, OpYB{F.slot(6), F.slot(7)}); } SEAM(7);
    if (IN(8)) { gemm(F, F.slot(6), 2048, W8 + (size_t)2 * 2048 * 2048, 2048, T, 2048, 2048, OpMix{args.in[0], args.out}); } SEAM(8);
    if (IN(9)) { ph_ln(F, args.in[14], args.in[15], F.slot(0)); } SEAM(9);
    if (IN(10)) {
        pg8::MultiOrder<3> S; S.lda = 2048; S.ldb = 2048; S.G = F.G; S.c = F.bid;
        S.s[0] = pg8::Sub{F.slot(0), W8 + (size_t)3 * 2048 * 2048, 64, 8};
        S.s[1] = pg8::Sub{(const bf16*)(F.ws + WS_MEMB), W8 + (size_t)4 * 2048 * 2048, 8, 8};
        S.s[2] = pg8::Sub{W8 + (size_t)5 * 2048 * 2048, (const bf16*)(F.ws + WS_MEMB), 8, 8};
        gemm_multi<3>(F, S, 2048, OpCQKV{F.slot(1), (bf16*)(F.ws + WS_CKV), (bf16*)(F.ws + WS_IKW)});
    } SEAM(10);
    if (IN(11)) {
        pg8::BatchOrder<OffS> S{F.slot(1), (const bf16*)(F.ws + WS_CKV), 8, 1, 32, 2048, 2048, F.G, F.bid, OffS()};
        gemm_batch(F, S, 512, OpLogit{(float*)F.slot(2)});
    } SEAM(11);
    if (IN(12)) { ph_xsoftmax(F, (const float*)F.slot(2), F.slot(3)); } SEAM(12);
    if (IN(13)) {
        pg8::BatchOrder<OffPV> S{F.slot(3), (const bf16*)(F.ws + WS_IKW), 8, 2, 32, 1024, 2048, F.G, F.bid, OffPV()};
        gemm_batch(F, S, 256, OpCO{F.slot(4)});
    } SEAM(13);
    if (IN(14)) { gemm(F, F.slot(4), 2048, W8 + (size_t)6 * 2048 * 2048, 2048, T, 2048, 2048, OpRes{args.out}); } SEAM(14);
    if (IN(15)) { ph_ln(F, args.in[20], args.in[21], F.slot(0));
        cvt_bf16_stream(F, args.in[24], F.slot(5), (size_t)16384 * 2048 / 8); cvt_bf16_stream(F, args.in[25], F.slot(6), (size_t)16384 * 2048 / 8); } SEAM(15);
    if (IN(16)) { gemm(F, F.slot(0), 2048, W8 + (size_t)7 * 2048 * 2048, 2048, T, 2048, 2048, OpF32{(float*)F.slot(1), 2048}); } SEAM(16);
    if (IN(17)) { ph_peer_select(F); } SEAM(17);
    if (IN(18)) { ph16_experts(F); }
#if PROBE_MASK
    { const unsigned long long t1_ = __builtin_amdgcn_s_memrealtime(); if ((PROBE_MASK >> 18) & 1u) pr_acc += t1_ - pr_t0;
      if (F.bid == 0 && threadIdx.x == 0) { const unsigned long long ts_ = __builtin_amdgcn_s_memrealtime(); while (__builtin_amdgcn_s_memrealtime() - ts_ < pr_acc) __builtin_amdgcn_s_sleep(8); } }
#endif
#undef IN
#undef SEAM
}

extern "C" void kernel_launch(void* const* d_in, const int* in_sizes, int n_in, void* d_out, int out_size, void* d_ws, size_t ws_size, hipStream_t stream) {
    static int grid = 0;
    if (grid == 0) {
        if (n_in != 28 || out_size != T * D || ws_size < WS_END) { fprintf(stderr, "kernel_launch: unexpected shapes (n_in %d out %d ws %zu)\n", n_in, out_size, ws_size); grid = -1; return; }
        int dev = 0, cus = 0, per_cu = 0;
        hipGetDevice(&dev); hipDeviceGetAttribute(&cus, hipDeviceAttributeMultiprocessorCount, dev);
        hipFuncSetAttribute((const void*)mega, hipFuncAttributeMaxDynamicSharedMemorySize, LDS_BYTES);
        hipOccupancyMaxActiveBlocksPerMultiprocessor(&per_cu, (const void*)mega, 512, LDS_BYTES);
        if (per_cu < 1) { fprintf(stderr, "kernel_launch: occupancy query says %d blocks per CU\n", per_cu); per_cu = 1; }
        (void)hipGetLastError();
        grid = cus;
    }
    if (grid < 0) return;
    (void)hipMemsetAsync((char*)d_ws + WS_CTL, 0, 65536, stream);
    Args a{};
    for (int i = 0; i < 28; ++i) a.in[i] = (const float*)d_in[i];
    a.out = (float*)d_out; a.ws = (unsigned char*)d_ws;
#if ONE_LAUNCH
    a.ph_lo = 0; a.ph_hi = NPH;
    void* params[] = {&a};
    hipError_t e = hipLaunchCooperativeKernel((const void*)mega, dim3(grid), dim3(512), params, LDS_BYTES, stream);
    if (e != hipSuccess) fprintf(stderr, "cooperative launch failed: %s\n", hipGetErrorString(e));
#else
    for (int ph = 0; ph < NPH; ++ph) {
        a.ph_lo = ph; a.ph_hi = ph + 1;
        void* params[] = {&a};
        hipError_t e = hipLaunchCooperativeKernel((const void*)mega, dim3(grid), dim3(512), params, LDS_BYTES, stream);
        if (e != hipSuccess) { fprintf(stderr, "launch %d failed: %s\n", ph, hipGetErrorString(e)); break; }
    }
#endif
}
```

```cpp
#include <hip/hip_runtime.h>
#include <hip/hip_cooperative_groups.h>
#include <cstdint>
#include <cmath>
#include <cstdio>
namespace cg = cooperative_groups;

#ifndef ONE_LAUNCH
#define ONE_LAUNCH 1
#endif
#ifndef PROBE_MASK
#define PROBE_MASK 0u
#endif

typedef unsigned short bf16;
typedef short bf16x8 __attribute__((ext_vector_type(8)));
typedef float f32x4 __attribute__((ext_vector_type(4)));
typedef float f32x16 __attribute__((ext_vector_type(16)));
typedef unsigned u32x4 __attribute__((ext_vector_type(4)));
typedef unsigned u32x2 __attribute__((ext_vector_type(2)));

constexpr int T = 16384, D = 2048, SEQ = 2048, NB = 8;
constexpr int NCOLS = 16896;
constexpr float ALPHA = 1.189207115002721f;
constexpr int NPH = 19;

constexpr size_t MiB = 1u << 20;
constexpr size_t WS_CTL = 0, WS_MEMB = 1 * MiB, WS_WKV = 9 * MiB, WS_LB = 11 * MiB, WS_MASK = 12 * MiB, WS_WIN = 17 * MiB,
                 WS_SLOT = 83 * MiB, SLOT_BYTES = 64 * MiB, WS_CKV = 595 * MiB, WS_IKW = 603 * MiB, WS_END = 611 * MiB;
constexpr int LDS_BYTES = 147456;

struct Args {
    const float* in[28];
    float* out;
    unsigned char* ws;
    int ph_lo, ph_hi;
};

#define WAVE_SYNC() asm volatile("s_waitcnt lgkmcnt(0)" ::: "memory")

__device__ __forceinline__ unsigned f2bf(float f) { unsigned u = __float_as_uint(f); return (u + 0x7fffu + ((u >> 16) & 1u)) >> 16; }
__device__ __forceinline__ unsigned pk2(float lo, float hi) { return f2bf(lo) | (f2bf(hi) << 16); }
__device__ __forceinline__ float bf2f(unsigned h) { return __uint_as_float(h << 16); }
__device__ __forceinline__ float bflo(unsigned w) { return __uint_as_float(w << 16); }
__device__ __forceinline__ float bfhi(unsigned w) { return __uint_as_float(w & 0xffff0000u); }
__device__ __forceinline__ float wave_sum(float v) {
#pragma unroll
    for (int o = 32; o >= 1; o >>= 1) v += __shfl_xor(v, o);
    return v;
}
__device__ __forceinline__ float wave_max(float v) {
#pragma unroll
    for (int o = 32; o >= 1; o >>= 1) v = fmaxf(v, __shfl_xor(v, o));
    return v;
}
__device__ __forceinline__ float sigm(float x) { return 1.0f / (1.0f + expf(-x)); }
__device__ __forceinline__ void unpack8(u32x4 w, float* f) {
    f[0] = bflo(w.x); f[1] = bfhi(w.x); f[2] = bflo(w.y); f[3] = bfhi(w.y); f[4] = bflo(w.z); f[5] = bfhi(w.z); f[6] = bflo(w.w); f[7] = bfhi(w.w);
}

__device__ __forceinline__ int fresh_lane() { int l; asm volatile("v_mbcnt_lo_u32_b32 %0, -1, 0\n\tv_mbcnt_hi_u32_b32 %0, -1, %0" : "=v"(l)); return l; }
struct Frame {
    unsigned char* lds;
    int wave, bid, G;
    __device__ __forceinline__ int lane() const { return fresh_lane(); }
    const Args* a;
    unsigned char* ws;
    __device__ __forceinline__ bf16* slot(int i) const { return (bf16*)(ws + WS_SLOT + (size_t)i * SLOT_BYTES); }
};

namespace pg8 {
#define PG8_LAS __attribute__((address_space(3)))
constexpr int BM = 256, BK = 64, HALF = 128, HTB = HALF * BK * 2, STAGE_BYTES = 8 * HTB, NXCD = 8, WGM = 8;
__host__ __device__ __forceinline__ int lds_byte(int r, int c) { const int st = (r >> 4) * 2 + (c >> 5), rr = r & 15, cc = c & 31, ob = rr * 64 + cc * 2; return st * 1024 + (ob ^ (((ob >> 9) & 1) << 5)); }
__host__ __device__ __forceinline__ void stage_rc(int b, int& R, int& C) { const int st = b / 1024, sb = b % 1024, swz = sb ^ (((sb >> 9) & 1) << 5); R = (st >> 1) * 16 + swz / 64; C = (st & 1) * 32 + (swz % 64) / 2; }
__host__ __device__ __forceinline__ int perm32(int rho) { const int n = rho >> 4, i = rho & 15; return 8 * (i >> 2) + 4 * n + (i & 3); }
struct Unit { int pm, pn, z; const char* a; const char* b; };
struct Gemm { int lda, ldb, K; };
__device__ __forceinline__ void tile_of(int wgid, int nM, int nN, int& pm, int& pn) {
    const int nwg = nM * nN; { const int q = nwg / NXCD, r = nwg % NXCD, xcd = wgid % NXCD, off = wgid / NXCD; wgid = (xcd < r ? xcd * (q + 1) : r * (q + 1) + (xcd - r) * q) + off; }
    const int nig = WGM * nN, gid = wgid / nig, fm = gid * WGM, gsz = (nM - fm) < WGM ? (nM - fm) : WGM;
    pm = fm + ((wgid % nig) % gsz); pn = (wgid % nig) / gsz;
}
struct Sub { const bf16* A; const bf16* Bt; int nM, nN; };
template <int NS> struct MultiOrder {
    Sub s[NS]; int lda, ldb, G, c;
    __device__ __forceinline__ bool next(int i, Unit& u) const {
        int L = i * G + c;
#pragma unroll
        for (int k = 0; k < NS; ++k) { const int n = s[k].nM * s[k].nN;
            if (L < n) { tile_of(L, s[k].nM, s[k].nN, u.pm, u.pn); u.z = k; u.a = (const char*)(s[k].A + (size_t)u.pm * BM * lda); u.b = (const char*)(s[k].Bt + (size_t)u.pn * BM * ldb); return true; }
            L -= n; }
        return false;
    }
};
template <class Off> struct BatchOrder {
    const bf16* A; const bf16* Bt; int nM, nN, nz, lda, ldb, G, c; Off off;
    __device__ __forceinline__ bool next(int i, Unit& u) const {
        const int L = i * G + c, per = nM * nN; if (L >= per * nz) return false;
        u.z = L / per; const int r = L % per; u.pn = r / nM; u.pm = r % nM;
        u.a = (const char*)(A + off.a(u.z) + (size_t)u.pm * BM * lda); u.b = (const char*)(Bt + off.b(u.z) + (size_t)u.pn * BM * ldb); return true;
    }
};
__device__ __forceinline__ unsigned cvt_pk_bf16(float lo, float hi) { unsigned r; asm volatile("v_cvt_pk_bf16_f32 %0, %1, %2" : "=v"(r) : "v"(lo), "v"(hi)); return r; }

template <class Op> struct Epi8 {
    static constexpr bool PERM = true;
    Op op;
    __device__ __forceinline__ void operator()(const f32x4 (&acc)[2][2][4][2], const Unit& u, int wr, int wc, int fr, int fq) const {
        const int row0 = u.pm * BM + wr * 64 + fr, col0 = u.pn * BM + wc * 32 + 8 * fq;
#pragma unroll
        for (int ai = 0; ai < 2; ++ai)
#pragma unroll
            for (int m = 0; m < 4; ++m)
#pragma unroll
                for (int bj = 0; bj < 2; ++bj) op(u.z, row0 + ai * HALF + m * 16, col0 + bj * HALF, acc[ai][bj][m][0], acc[ai][bj][m][1]);
    }
};

template <class Epi, class Sched, bool ALIGN_EPI>
__device__ __forceinline__ void gemm_phase(PG8_LAS unsigned char* lds, const Gemm g, const Sched& S, const Epi& E, int wid, int lane) {
    const int tid = wid * 64 + lane, wr = wid >> 2, wc = wid & 3, fr = lane & 15, fq = lane >> 4;
    const int K = g.K, nt = K / BK;
    unsigned voffA[2], voffB[2];
#pragma unroll
    for (int i = 0; i < 2; ++i) { int R, C; stage_rc(tid * 16 + i * 8192, R, C); const int Rb = Epi::PERM ? ((R & ~31) + perm32(R & 31)) : R;
        voffA[i] = (unsigned)(R * g.lda + C) * 2u; voffB[i] = (unsigned)(Rb * g.ldb + C) * 2u; }
    const size_t kstep = (size_t)(BK * 2);
    const size_t hstepA = (size_t)HALF * g.lda * 2, hstepB = (size_t)HALF * g.ldb * 2;
    const unsigned ldsw = (unsigned)wid * 1024u;
    const int aoff = lds_byte(wr * 64 + fr, fq * 8), boff = lds_byte(wc * 32 + fr, fq * 8);
#define PG8_SA(b, h) (((b) * 2 + (h)) * HTB)
#define PG8_SB(b, h) ((4 + (b) * 2 + (h)) * HTB)
#define PG8_STAGE(bufoff, gbase, voff) do { _Pragma("unroll") for (int _i = 0; _i < 2; ++_i) \
        __builtin_amdgcn_global_load_lds((const unsigned*)((const char*)(gbase) + (voff)[_i]), (PG8_LAS unsigned*)(lds + (bufoff) + ldsw + _i * 8192), 16, 0, 0); } while (0)
#define PG8_LDA(dst, b, h) do { _Pragma("unroll") for (int m = 0; m < 4; ++m) _Pragma("unroll") for (int k = 0; k < 2; ++k) dst[m][k] = *(const PG8_LAS bf16x8*)(lds + PG8_SA(b, h) + aoff + m * 2048 + k * 1024); } while (0)
#define PG8_LDB(dst, b, h) do { _Pragma("unroll") for (int n = 0; n < 2; ++n) _Pragma("unroll") for (int k = 0; k < 2; ++k) dst[n][k] = *(const PG8_LAS bf16x8*)(lds + PG8_SB(b, h) + boff + n * 2048 + k * 1024); } while (0)
#define PG8_MMA(ai, bj, At, Bt) do { __builtin_amdgcn_s_setprio(1); _Pragma("unroll") for (int m = 0; m < 4; ++m) _Pragma("unroll") for (int n = 0; n < 2; ++n) _Pragma("unroll") for (int k = 0; k < 2; ++k) \
        acc[ai][bj][m][n] = __builtin_amdgcn_mfma_f32_16x16x32_bf16(Bt[n][k], At[m][k], acc[ai][bj][m][n], 0, 0, 0); __builtin_amdgcn_s_setprio(0); } while (0)
#define PG8_WAIT_V(n) asm volatile("s_waitcnt vmcnt(" #n ")" ::: "memory")
#define PG8_WAIT_L(n) asm volatile("s_waitcnt lgkmcnt(" #n ")" ::: "memory")
#define PG8_BAR __builtin_amdgcn_s_barrier()
#define PG8_SCHED __builtin_amdgcn_sched_barrier(0)
    Unit cur, nxt; int ui = 0;
    if (!S.next(0, cur)) return;
    f32x4 acc[2][2][4][2];
#pragma unroll
    for (int a = 0; a < 2; ++a)
#pragma unroll
        for (int b = 0; b < 2; ++b)
#pragma unroll
            for (int m = 0; m < 4; ++m)
#pragma unroll
                for (int n = 0; n < 2; ++n) acc[a][b][m][n] = (f32x4){0.f, 0.f, 0.f, 0.f};
    bf16x8 At[4][2], B0[2][2], B1[2][2];
    const char* cA = cur.a; const char* cB = cur.b;
    PG8_STAGE(PG8_SB(0, 0), cB, voffB); PG8_STAGE(PG8_SB(0, 1), cB + hstepB, voffB); PG8_STAGE(PG8_SA(0, 0), cA, voffA); PG8_STAGE(PG8_SA(0, 1), cA + hstepA, voffA);
    if (wr == 1) PG8_BAR;
    PG8_WAIT_V(2); PG8_BAR;
    PG8_STAGE(PG8_SB(1, 0), cB + kstep, voffB); PG8_STAGE(PG8_SA(1, 0), cA + kstep, voffA); PG8_STAGE(PG8_SB(1, 1), cB + hstepB + kstep, voffB);
    PG8_WAIT_V(6); PG8_BAR;
    for (;;) {
        const bool has_next = S.next(ui + 1, nxt);
        const char* nA = has_next ? nxt.a : cA; const char* nB = has_next ? nxt.b : cB;
#pragma unroll 1
        for (int t = 0; t < nt; t += 2) {
            const bool last = (t == nt - 2);
            const char* a1 = cA + (size_t)(t + 1) * kstep;
            const char* a2 = last ? nA : cA + (size_t)(t + 2) * kstep; const char* b2 = last ? nB : cB + (size_t)(t + 2) * kstep;
            const char* a3 = a2 + kstep; const char* b3 = b2 + kstep;
            PG8_LDB(B0, 0, 0); PG8_LDB(B1, 0, 1); PG8_SCHED; PG8_LDA(At, 0, 0); PG8_STAGE(PG8_SA(1, 1), a1 + hstepA, voffA);
            PG8_WAIT_V(8); PG8_WAIT_L(0); PG8_BAR; PG8_MMA(0, 0, At, B0); PG8_MMA(0, 1, At, B1); PG8_BAR; PG8_SCHED;
            PG8_LDA(At, 0, 1); PG8_STAGE(PG8_SB(0, 0), b2, voffB); PG8_STAGE(PG8_SB(0, 1), b2 + hstepB, voffB); PG8_STAGE(PG8_SA(0, 0), a2, voffA);
            PG8_WAIT_V(8); PG8_WAIT_L(0); PG8_BAR; PG8_MMA(1, 0, At, B0); PG8_MMA(1, 1, At, B1); PG8_BAR; PG8_SCHED;
            PG8_LDB(B0, 1, 0); PG8_LDB(B1, 1, 1); PG8_SCHED; PG8_LDA(At, 1, 0); PG8_STAGE(PG8_SA(0, 1), a2 + hstepA, voffA);
            PG8_WAIT_V(8); PG8_WAIT_L(0); PG8_BAR; PG8_MMA(0, 0, At, B0); PG8_MMA(0, 1, At, B1); PG8_BAR; PG8_SCHED;
            PG8_LDA(At, 1, 1); PG8_STAGE(PG8_SB(1, 0), b3, voffB); PG8_STAGE(PG8_SB(1, 1), b3 + hstepB, voffB); PG8_STAGE(PG8_SA(1, 0), a3, voffA);
            PG8_WAIT_V(8); PG8_WAIT_L(0); PG8_BAR; PG8_MMA(1, 0, At, B0); PG8_MMA(1, 1, At, B1); PG8_BAR; PG8_SCHED;
        }
        if constexpr (ALIGN_EPI) { if (wr == 0) PG8_BAR; }
        E(acc, cur, wr, wc, fr, fq);
        if (!has_next) break;
#pragma unroll
        for (int a = 0; a < 2; ++a)
#pragma unroll
            for (int b = 0; b < 2; ++b)
#pragma unroll
                for (int m = 0; m < 4; ++m)
#pragma unroll
                    for (int n = 0; n < 2; ++n) acc[a][b][m][n] = (f32x4){0.f, 0.f, 0.f, 0.f};
        cur = nxt; cA = nA; cB = nB; ++ui;
        if constexpr (ALIGN_EPI) { if (wr == 1) PG8_BAR; }
    }
    PG8_WAIT_V(0);
    if constexpr (!ALIGN_EPI) { if (wr == 0) PG8_BAR; }
    PG8_BAR;
#undef PG8_SA
#undef PG8_SB
#undef PG8_STAGE
#undef PG8_LDA
#undef PG8_LDB
#undef PG8_MMA
#undef PG8_WAIT_V
#undef PG8_WAIT_L
#undef PG8_BAR
#undef PG8_SCHED
}
}

__device__ __forceinline__ u32x4 pack8(f32x4 a, f32x4 b) { u32x4 w; w.x = pg8::cvt_pk_bf16(a.x, a.y); w.y = pg8::cvt_pk_bf16(a.z, a.w); w.z = pg8::cvt_pk_bf16(b.x, b.y); w.w = pg8::cvt_pk_bf16(b.z, b.w); return w; }
__device__ __forceinline__ void unpack8v(u32x4 w, f32x4& a, f32x4& b) { a.x = bflo(w.x); a.y = bfhi(w.x); a.z = bflo(w.y); a.w = bfhi(w.y); b.x = bflo(w.z); b.y = bfhi(w.z); b.z = bflo(w.w); b.w = bfhi(w.w); }
__device__ __forceinline__ f32x4 sigm4(f32x4 v) { f32x4 r; r.x = sigm(v.x); r.y = sigm(v.y); r.z = sigm(v.z); r.w = sigm(v.w); return r; }

struct OpProj { unsigned char* ws;
    __device__ __forceinline__ void operator()(int z, int row, int col, f32x4 a, f32x4 b) const {
        bf16* p;
        if (col < 16384) p = (bf16*)(ws + WS_SLOT + (size_t)(col >> 11) * SLOT_BYTES) + (size_t)row * 2048 + (col & 2047);
        else if (col < 16640) p = (bf16*)(ws + WS_CKV) + (size_t)row * 256 + (col - 16384);
        else p = (bf16*)(ws + WS_IKW) + (size_t)row * 256 + (col - 16640);
        *(u32x4*)p = pack8(a, b);
    } };
struct OpBf16 { bf16* o; int ld;
    __device__ __forceinline__ void operator()(int z, int row, int col, f32x4 a, f32x4 b) const { *(u32x4*)(o + (size_t)row * ld + col) = pack8(a, b); } };
struct OpSplit2 { bf16* o0; bf16* o1;
    __device__ __forceinline__ void operator()(int z, int row, int col, f32x4 a, f32x4 b) const { bf16* p = (col < 2048 ? o0 : o1) + (size_t)row * 2048 + (col & 2047); *(u32x4*)p = pack8(a, b); } };
struct OpF32 { float* o; int ld;
    __device__ __forceinline__ void operator()(int z, int row, int col, f32x4 a, f32x4 b) const { float* p = o + (size_t)row * ld + col; *(f32x4*)p = a; *(f32x4*)(p + 4) = b; } };
struct OpYA { bf16* ga;
    __device__ __forceinline__ void operator()(int z, int row, int col, f32x4 a, f32x4 b) const { bf16* p = ga + (size_t)row * 2048 + col; f32x4 g0, g1; unpack8v(*(const u32x4*)p, g0, g1);
        *(u32x4*)p = pack8(sigm4(g0) * a, sigm4(g1) * b); } };
struct OpYB { bf16* ga; const bf16* gb;
    __device__ __forceinline__ void operator()(int z, int row, int col, f32x4 a, f32x4 b) const { const size_t i = (size_t)row * 2048 + col; f32x4 m0, m1, g0, g1; unpack8v(*(const u32x4*)(ga + i), m0, m1); unpack8v(*(const u32x4*)(gb + i), g0, g1);
        *(u32x4*)(ga + i) = pack8(m0 + sigm4(g0) * a, m1 + sigm4(g1) * b); } };
struct OpMix { const float* x; float* z;
    __device__ __forceinline__ void operator()(int zi, int row, int col, f32x4 a, f32x4 b) const { const size_t i = (size_t)row * 2048 + col; const f32x4 x0 = *(const f32x4*)(x + i), x1 = *(const f32x4*)(x + i + 4);
        *(f32x4*)(z + i) = ALPHA * x0 + a; *(f32x4*)(z + i + 4) = ALPHA * x1 + b; } };
struct OpRes { float* z;
    __device__ __forceinline__ void operator()(int zi, int row, int col, f32x4 a, f32x4 b) const { const size_t i = (size_t)row * 2048 + col; const f32x4 x0 = *(const f32x4*)(z + i), x1 = *(const f32x4*)(z + i + 4);
        *(f32x4*)(z + i) = ALPHA * x0 + a; *(f32x4*)(z + i + 4) = ALPHA * x1 + b; } };

template <class Op>
__device__ __forceinline__ void gemm(const Frame& F, const bf16* A, int lda, const bf16* Bt, int ldb, int M, int N, int K, const Op& op) {
    pg8::Gemm g{lda, ldb, K}; pg8::MultiOrder<1> S; S.s[0] = pg8::Sub{A, Bt, M / 256, N / 256}; S.lda = lda; S.ldb = ldb; S.G = F.G; S.c = F.bid;
    pg8::Epi8<Op> E{op};
    pg8::gemm_phase<pg8::Epi8<Op>, pg8::MultiOrder<1>, true>((PG8_LAS unsigned char*)F.lds, g, S, E, F.wave, F.lane());
}
template <int NS, class Op>
__device__ __forceinline__ void gemm_multi(const Frame& F, const pg8::MultiOrder<NS>& S, int K, const Op& op) {
    pg8::Gemm g{S.lda, S.ldb, K}; pg8::Epi8<Op> E{op};
    pg8::gemm_phase<pg8::Epi8<Op>, pg8::MultiOrder<NS>, true>((PG8_LAS unsigned char*)F.lds, g, S, E, F.wave, F.lane());
}
template <class Off, class Op>
__device__ __forceinline__ void gemm_batch(const Frame& F, const pg8::BatchOrder<Off>& S, int K, const Op& op) {
    pg8::Gemm g{S.lda, S.ldb, K}; pg8::Epi8<Op> E{op};
    pg8::gemm_phase<pg8::Epi8<Op>, pg8::BatchOrder<Off>, true>((PG8_LAS unsigned char*)F.lds, g, S, E, F.wave, F.lane());
}
struct OffS { __device__ __forceinline__ size_t a(int z) const { return (size_t)(z >> 2) * 2048 * 2048 + (z & 3) * 512; } __device__ __forceinline__ size_t b(int z) const { return (size_t)(z >> 2) * 256 * 2048 + (z & 3) * 512; } };
struct OffPV { __device__ __forceinline__ size_t a(int z) const { return (size_t)(z >> 2) * 2048 * 1024 + (z & 3) * 256; } __device__ __forceinline__ size_t b(int z) const { return (size_t)(z & 3) * 512 * 2048 + (z >> 2) * 256; } };
struct OpLogit { float* lg;
    __device__ __forceinline__ void operator()(int z, int row, int col, f32x4 a, f32x4 b) const { float* p = lg + ((size_t)(z >> 2) * 2048 + row) * 1024 + (z & 3) * 256 + col; *(f32x4*)p = a * 0.04419417382415922f; *(f32x4*)(p + 4) = b * 0.04419417382415922f; } };
struct OpCO { bf16* co;
    __device__ __forceinline__ void operator()(int z, int row, int col, f32x4 a, f32x4 b) const { *(u32x4*)(co + ((size_t)(z >> 2) * 2048 + row) * 2048 + (z & 3) * 512 + col) = pack8(a, b); } };
struct OpCQKV { bf16* cq; bf16* ck; bf16* vt;
    __device__ __forceinline__ void operator()(int z, int row, int col, f32x4 a, f32x4 b) const { bf16* o = z == 0 ? cq : (z == 1 ? ck : vt); *(u32x4*)(o + (size_t)row * 2048 + col) = pack8(a, b); } };
__device__ __forceinline__ void ph_xsoftmax(const Frame& F, const float* lg, bf16* P) {
    const int gw = F.bid * 8 + F.wave, NGW = F.G * 8, lane = F.lane();
    for (int u = gw; u < T * 4; u += NGW) {
        const f32x4 v = *(const f32x4*)(lg + (size_t)u * 256 + 4 * lane);
        const float m = wave_max(fmaxf(fmaxf(v.x, v.y), fmaxf(v.z, v.w)));
        const float e0 = expf(v.x - m), e1 = expf(v.y - m), e2 = expf(v.z - m), e3 = expf(v.w - m);
        const float inv = 1.0f / wave_sum((e0 + e1) + (e2 + e3));
        u32x2 w; w.x = pk2(e0 * inv, e1 * inv); w.y = pk2(e2 * inv, e3 * inv);
        *(u32x2*)(P + (size_t)u * 256 + 4 * lane) = w;
    }
}

template <class CM>
__device__ __forceinline__ void transpose_item(const float* W, size_t ldw, bf16* WT, size_t ldwt, int row_off, int nblk, int item, float* scr, int lane, const CM& cm) {
    const int kb = item / nblk, nb = item % nblk, k0 = 64 * kb, n0 = 32 * nb;
    const int c = cm(n0 + (lane & 31));
#pragma unroll 8
    for (int i = 0; i < 32; ++i) { const int kk = 2 * i + (lane >> 5); scr[kk * 33 + (lane & 31)] = (c >= 0) ? W[(size_t)(k0 + kk) * ldw + c] : 0.f; }
    WAVE_SYNC();
    const int c8 = lane & 7;
#pragma unroll
    for (int j = 0; j < 4; ++j) { const int n = (lane >> 3) + 8 * j; const float* s = scr + (8 * c8) * 33 + n;
        u32x4 o; o.x = pk2(s[0 * 33], s[1 * 33]); o.y = pk2(s[2 * 33], s[3 * 33]); o.z = pk2(s[4 * 33], s[5 * 33]); o.w = pk2(s[6 * 33], s[7 * 33]);
        *(u32x4*)(WT + (size_t)(row_off + n0 + n) * ldwt + k0 + 8 * c8) = o; }
    WAVE_SYNC();
}
struct CmIdent { __device__ __forceinline__ int operator()(int n) const { return n; } };
struct CmWin { __device__ __forceinline__ int operator()(int n) const {
    if (n < 10240) return n;
    if (n < 12288) return 10496 + (n - 10240);
    if (n < 14336) return 12688 + (n - 12288);
    if (n < 16384) return 14736 + (n - 14336);
    if (n < 16640) return 10240 + (n - 16384);
    if (n < 16768) return 12544 + (n - 16640);
    if (n < 16784) return 12672 + (n - 16768);
    return -1; } };

__device__ __forceinline__ void cvt_bf16_stream(const Frame& F, const float* src, bf16* dst, size_t n8) {
    const size_t gt = (size_t)F.bid * 512 + F.wave * 64 + F.lane(), NT = (size_t)F.G * 512;
    for (size_t i = gt; i < n8; i += NT) { const f32x4 a = ((const f32x4*)src)[2 * i], b = ((const f32x4*)src)[2 * i + 1];
        u32x4 o; o.x = pk2(a.x, a.y); o.y = pk2(a.z, a.w); o.z = pk2(b.x, b.y); o.w = pk2(b.z, b.w); ((u32x4*)dst)[i] = o; }
}

__device__ __forceinline__ void ph0_prologue(const Frame& F) {
    const Args& a = *F.a;
    cvt_bf16_stream(F, a.in[0], (bf16*)a.out, (size_t)T * D / 8);
    cvt_bf16_stream(F, a.in[1], (bf16*)(F.ws + WS_MEMB), (size_t)2048 * 2048 / 8);
    float* scr = (float*)(F.lds + F.wave * 16384);
    const int gw = F.bid * 8 + F.wave, NGW = F.G * 8, lane = F.lane();
    {
        const int nblk = NCOLS / 32, nitems = (2048 / 64) * nblk;
        for (int it = gw; it < nitems; it += NGW) transpose_item(a.in[2], 16784, (bf16*)(F.ws + WS_WIN), 2048, 0, nblk, it, scr, lane, CmWin());
    }
    {
        for (int it = gw; it < 32 * 16; it += NGW) { const int mat = it >> 4, which = mat >> 4, h = mat & 15;
            transpose_item(a.in[which ? 9 : 8] + (size_t)h * 256 * 128, 128, (bf16*)(F.ws + WS_WKV), 256, which * 2048 + h * 128, 4, it & 15, scr, lane, CmIdent()); }
    }
    {
        const int gt = F.bid * 512 + F.wave * 64 + lane;
        if (gt < 2048) { const float l0 = a.in[3][gt], l1 = a.in[3][2048 + gt]; ((float*)(F.ws + WS_LB))[gt] = 1.0f / (1.0f + expf(l1 - l0)); }
    }
}

namespace hg {
constexpr int QP = 272, TP = 144, AP = 144;
constexpr int OFF_QD = 0, OFF_KD = OFF_QD + 64 * QP, OFF_QG = OFF_KD + 64 * QP, OFF_KET = OFF_QG + 64 * QP, OFF_VT = OFF_KET + 128 * TP, OFF_A = OFF_VT + 128 * TP,
              OFF_TOT = OFF_A + 64 * AP, OFF_DEC = OFF_TOT + 4 * 128 * 4, OFF_PART = OFF_DEC + 128 * 4, OFF_RSTD = OFF_PART + 8 * 64 * 4, END = OFF_RSTD + 64 * 4;
static_assert(END <= 131072, "hgrn LDS map");
}
typedef short bf16x4 __attribute__((ext_vector_type(4)));
__device__ __forceinline__ void hgrn_chunked(const Frame& F, int unit) {
    using namespace hg;
    const Args& a = *F.a;
    const int b = unit >> 4, h = unit & 15, lane = F.lane(), w = F.wave, tid = w * 64 + lane, c = tid & 127, rq = tid >> 7, l15 = lane & 15, q4 = lane >> 4;
    unsigned char* L = F.lds;
    const size_t base = (size_t)b * 2048 * 2048 + h * 128;
    const bf16* HQ = F.slot(0) + base; const bf16* HF = F.slot(1) + base; const bf16* HI = F.slot(2) + base; const bf16* HG = F.slot(3) + base; bf16* HO = F.slot(0) + base;
    const float lb = ((const float*)(F.ws + WS_LB))[h * 128 + c];
    const float ng = a.in[4][h * 128 + 16 * w + l15];
    f32x4 S[8];
#pragma unroll
    for (int d = 0; d < 8; ++d) S[d] = (f32x4){0.f, 0.f, 0.f, 0.f};
    unsigned short rq_[16], rf_[16], rv_[16];
#pragma unroll
    for (int k = 0; k < 16; ++k) { const size_t o = (size_t)(16 * rq + k) * 2048 + c; rq_[k] = HQ[o]; rf_[k] = HF[o]; rv_[k] = HI[o]; }
    float* tot = (float*)(L + OFF_TOT); float* dec = (float*)(L + OFF_DEC); float* part = (float*)(L + OFF_PART); float* rstd = (float*)(L + OFF_RSTD);
#pragma unroll 1
    for (int ch = 0; ch < 32; ++ch) {
        const int r0 = ch * 64;
        unsigned short gq[16];
#pragma unroll
        for (int mt = 0; mt < 4; ++mt)
#pragma unroll
            for (int r = 0; r < 4; ++r) gq[4 * mt + r] = HG[(size_t)(r0 + 16 * mt + 4 * q4 + r) * 2048 + 16 * w + l15];
        float G[16], qf[16], kk[16];
        { float run = 0.f;
#pragma unroll
          for (int k = 0; k < 16; ++k) { const float f = lb + (1.0f - lb) / (1.0f + __expf(-bf2f(rf_[k]))); run += __logf(f); G[k] = run; kk[k] = 1.0f - f; qf[k] = bf2f(rq_[k]); } }
        tot[rq * 128 + c] = G[15];
        __syncthreads();
        const float t0 = tot[c], t1 = tot[128 + c], t2 = tot[256 + c], t3 = tot[384 + c];
        const float offs = (rq > 0 ? t0 : 0.f) + (rq > 1 ? t1 : 0.f) + (rq > 2 ? t2 : 0.f);
        const float Gref = t0 + t1, Glast = Gref + t2 + t3, eref = __expf(Gref), elr = __expf(Glast - Gref);
        if (rq == 0) dec[c] = __expf(Glast);
        unsigned kew[8], vw[8];
#pragma unroll
        for (int k = 0; k < 16; ++k) {
            const float e1 = __expf(G[k] + offs - Gref), qd = qf[k] * e1, kd = kk[k] * __builtin_amdgcn_rcpf(e1);
            const int row = 16 * rq + k;
            *(bf16*)(L + OFF_QD + row * QP + 2 * c) = (bf16)f2bf(qd);
            *(bf16*)(L + OFF_KD + row * QP + 2 * c) = (bf16)f2bf(kd);
            *(bf16*)(L + OFF_QG + row * QP + 2 * c) = (bf16)f2bf(qd * eref);
            const unsigned ke = f2bf(kd * elr);
            if (k & 1) { kew[k >> 1] |= ke << 16; vw[k >> 1] |= (unsigned)rv_[k] << 16; } else { kew[k >> 1] = ke; vw[k >> 1] = rv_[k]; }
        }
        *(u32x4*)(L + OFF_KET + c * TP + 32 * rq) = (u32x4){kew[0], kew[1], kew[2], kew[3]}; *(u32x4*)(L + OFF_KET + c * TP + 32 * rq + 16) = (u32x4){kew[4], kew[5], kew[6], kew[7]};
        *(u32x4*)(L + OFF_VT + c * TP + 32 * rq) = (u32x4){vw[0], vw[1], vw[2], vw[3]}; *(u32x4*)(L + OFF_VT + c * TP + 32 * rq + 16) = (u32x4){vw[4], vw[5], vw[6], vw[7]};
        if (ch + 1 < 32) {
#pragma unroll
            for (int k = 0; k < 16; ++k) { const size_t o = (size_t)(r0 + 64 + 16 * rq + k) * 2048 + c; rq_[k] = HQ[o]; rf_[k] = HF[o]; rv_[k] = HI[o]; } }
        __syncthreads();
        { const int mi = w >> 1;
#pragma unroll
          for (int tt = 0; tt < 2; ++tt) { const int nj = 2 * (w & 1) + tt; f32x4 acc = (f32x4){0.f, 0.f, 0.f, 0.f};
              if (nj <= mi) {
#pragma unroll
                  for (int ks = 0; ks < 4; ++ks) { const bf16x8 aF = *(const bf16x8*)(L + OFF_KD + (16 * nj + l15) * QP + 64 * ks + 16 * q4), bF = *(const bf16x8*)(L + OFF_QD + (16 * mi + l15) * QP + 64 * ks + 16 * q4);
                      acc = __builtin_amdgcn_mfma_f32_16x16x32_bf16(aF, bF, acc, 0, 0, 0); } }
              const int i = 16 * mi + l15, j0 = 16 * nj + 4 * q4;
              const float v0 = (j0 <= i) ? acc.x : 0.f, v1 = (j0 + 1 <= i) ? acc.y : 0.f, v2 = (j0 + 2 <= i) ? acc.z : 0.f, v3 = (j0 + 3 <= i) ? acc.w : 0.f;
              *(u32x2*)(L + OFF_A + i * AP + 2 * j0) = (u32x2){pk2(v0, v1), pk2(v2, v3)}; } }
        __syncthreads();
        bf16x8 bV[2];
#pragma unroll
        for (int ks = 0; ks < 2; ++ks) bV[ks] = *(const bf16x8*)(L + OFF_VT + (16 * w + l15) * TP + 64 * ks + 16 * q4);
        f32x4 O[4];
#pragma unroll
        for (int mt = 0; mt < 4; ++mt) { O[mt] = (f32x4){0.f, 0.f, 0.f, 0.f};
#pragma unroll
            for (int ks = 0; ks < 2; ++ks) { const bf16x8 aF = *(const bf16x8*)(L + OFF_A + (16 * mt + l15) * AP + 64 * ks + 16 * q4); O[mt] = __builtin_amdgcn_mfma_f32_16x16x32_bf16(aF, bV[ks], O[mt], 0, 0, 0); } }
#pragma unroll
        for (int kq = 0; kq < 4; ++kq) {
            u32x4 sw; sw.x = pk2(S[2 * kq].x, S[2 * kq].y); sw.y = pk2(S[2 * kq].z, S[2 * kq].w); sw.z = pk2(S[2 * kq + 1].x, S[2 * kq + 1].y); sw.w = pk2(S[2 * kq + 1].z, S[2 * kq + 1].w);
            const bf16x8 bS = __builtin_bit_cast(bf16x8, sw);
#pragma unroll
            for (int mt = 0; mt < 4; ++mt) { const unsigned char* qp = L + OFF_QG + (16 * mt + l15) * QP + 64 * kq + 8 * q4;
                const u32x2 lo = *(const u32x2*)qp, hi = *(const u32x2*)(qp + 32);
                const bf16x8 aF = __builtin_bit_cast(bf16x8, (u32x4){lo.x, lo.y, hi.x, hi.y});
                O[mt] = __builtin_amdgcn_mfma_f32_16x16x32_bf16(aF, bS, O[mt], 0, 0, 0); } }
#pragma unroll
        for (int dt = 0; dt < 8; ++dt) { const f32x4 dc = *(const f32x4*)(dec + 16 * dt + 4 * q4); S[dt] = S[dt] * dc;
#pragma unroll
            for (int ks = 0; ks < 2; ++ks) { const bf16x8 aF = *(const bf16x8*)(L + OFF_KET + (16 * dt + l15) * TP + 64 * ks + 16 * q4); S[dt] = __builtin_amdgcn_mfma_f32_16x16x32_bf16(aF, bV[ks], S[dt], 0, 0, 0); } }
#pragma unroll
        for (int mt = 0; mt < 4; ++mt)
#pragma unroll
            for (int r = 0; r < 4; ++r) { float p = O[mt][r] * O[mt][r]; p += __shfl_xor(p, 1); p += __shfl_xor(p, 2); p += __shfl_xor(p, 4); p += __shfl_xor(p, 8);
                if (l15 == 0) part[w * 64 + 16 * mt + 4 * q4 + r] = p; }
        __syncthreads();
        if (tid < 64) { float s = 0.f;
#pragma unroll
            for (int ww = 0; ww < 8; ++ww) s += part[ww * 64 + tid];
            rstd[tid] = rsqrtf(s * (1.0f / 128.0f) + 1e-6f); }
        __syncthreads();
#pragma unroll
        for (int mt = 0; mt < 4; ++mt) { const f32x4 rs = *(const f32x4*)(rstd + 16 * mt + 4 * q4);
#pragma unroll
            for (int r = 0; r < 4; ++r) { const float g = bf2f(gq[4 * mt + r]); const float o = O[mt][r] * rs[r] * ng * (g / (1.0f + __expf(-g)));
                HO[(size_t)(r0 + 16 * mt + 4 * q4 + r) * 2048 + 16 * w + l15] = (bf16)f2bf(o); } }
    }
    __syncthreads();
}

__device__ __forceinline__ void ph2_side(const Frame& F, int sid, int nside) {
    const Args& a = *F.a;
    const int gw = sid * 8 + F.wave, NGW = nside * 8, lane = F.lane();
    bf16* CKV = (bf16*)(F.ws + WS_CKV); bf16* IKW = (bf16*)(F.ws + WS_IKW);
    for (int row = gw; row < T; row += NGW) {
        {   u32x2 w = *(u32x2*)(CKV + (size_t)row * 256 + 4 * lane);
            float x0 = bflo(w.x), x1 = bfhi(w.x), x2 = bflo(w.y), x3 = bfhi(w.y);
            const float ss = wave_sum(x0 * x0 + x1 * x1 + x2 * x2 + x3 * x3);
            const float r = rsqrtf(ss * (1.0f / 256.0f) + 1e-6f);
            const f32x4 g = *(const f32x4*)(a.in[5] + 4 * lane);
            w.x = pk2(x0 * r * g.x, x1 * r * g.y); w.y = pk2(x2 * r * g.z, x3 * r * g.w);
            *(u32x2*)(CKV + (size_t)row * 256 + 4 * lane) = w; }
        {   unsigned w = *(unsigned*)(IKW + (size_t)row * 256 + 2 * lane);
            float x0 = bflo(w), x1 = bfhi(w);
            const float mu = wave_sum(x0 + x1) * (1.0f / 128.0f);
            x0 -= mu; x1 -= mu;
            const float var = wave_sum(x0 * x0 + x1 * x1) * (1.0f / 128.0f);
            const float r = rsqrtf(var + 1e-5f);
            const float g0 = a.in[6][2 * lane], g1 = a.in[6][2 * lane + 1], b0 = a.in[7][2 * lane], b1 = a.in[7][2 * lane + 1];
            *(unsigned*)(IKW + (size_t)row * 256 + 2 * lane) = pk2(x0 * r * g0 + b0, x1 * r * g1 + b1); }
    }
    float* scr = (float*)(F.lds + F.wave * 16384);
    for (int it = gw; it < 8 * 2048; it += NGW) { const int m = it >> 11;
        const float* wsrc = m == 0 ? a.in[11] : m == 1 ? a.in[12] : m == 2 ? a.in[13] : m == 3 ? a.in[16] : m == 4 ? a.in[17] : m == 5 ? a.in[18] : m == 6 ? a.in[19] : a.in[22];
        transpose_item(wsrc, 2048, (bf16*)(F.ws + WS_WIN + (size_t)m * 8 * MiB), 2048, 0, 64, it & 2047, scr, lane, CmIdent()); }
}

__device__ __forceinline__ void ph3_hgnorm(const Frame& F) {
    const Args& a = *F.a;
    const int gw = F.bid * 8 + F.wave, NGW = F.G * 8, lane = F.lane();
    const float* oraw = a.out; const bf16* HG = F.slot(3); bf16* HO = F.slot(0);
    for (int u = gw; u < T * 16; u += NGW) {
        const size_t off = (size_t)(u >> 4) * 2048 + (u & 15) * 128 + 2 * lane;
        const float o0 = oraw[off], o1 = oraw[off + 1];
        const float r = rsqrtf(wave_sum(o0 * o0 + o1 * o1) * (1.0f / 128.0f) + 1e-6f);
        const unsigned gw2 = *(const unsigned*)(HG + off);
        const float g0 = bflo(gw2), g1 = bfhi(gw2);
        const int c = (u & 15) * 128 + 2 * lane;
        *(unsigned*)(HO + off) = pk2(o0 * r * a.in[4][c] * (g0 * sigm(g0)), o1 * r * a.in[4][c + 1] * (g1 * sigm(g1)));
    }
}

__device__ __forceinline__ unsigned fkey(float f) { const unsigned u = __float_as_uint(f); return (u & 0x80000000u) ? ~u : (u | 0x80000000u); }
__device__ __forceinline__ void ph5_select(const Frame& F) {
    const int lane = F.lane(), l31 = lane & 31, half = lane >> 5, w = F.wave;
    float* scl = (float*)F.lds;
    const bf16* AIQ = F.slot(5); const bf16* IKW = (const bf16*)(F.ws + WS_IKW);
    unsigned* MASK = (unsigned*)(F.ws + WS_MASK);
    for (int i = F.bid; i < 1024; i += F.G) {
        const int r4 = i >> 8, c = i & 255, j = c & 127, b = 2 * r4 + (c >> 7), qt = (r4 & 1) ? 127 - j : j, t0 = qt * 16;
        bf16x8 Af[8];
        { const size_t rowA = (size_t)b * 2048 + t0 + 2 * w + ((l31 >> 2) & 1); const int headA = (l31 & 3) + 4 * (l31 >> 3);
#pragma unroll
          for (int ks = 0; ks < 8; ++ks) Af[ks] = *(const bf16x8*)(AIQ + rowA * 2048 + headA * 128 + 16 * ks + 8 * half); }
        float wr[16];
        { const bf16* wp = IKW + ((size_t)b * 2048 + t0 + 2 * w + half) * 256 + 128;
#pragma unroll
          for (int r = 0; r < 16; ++r) wr[r] = bf2f(wp[(r & 3) + 4 * (r >> 2)]) * (0.25f * 0.08838834764831845f); }
        const int nkt = (t0 + 15) / 32 + 1;
        const bf16* kbase = IKW + ((size_t)b * 2048 + l31) * 256 + 8 * half;
        bf16x8 Bf[8];
#pragma unroll
        for (int ks = 0; ks < 8; ++ks) Bf[ks] = *(const bf16x8*)(kbase + 16 * ks);
        for (int kt = 0; kt < nkt; ++kt) {
            f32x16 acc;
#pragma unroll
            for (int r = 0; r < 16; ++r) acc[r] = 0.f;
#pragma unroll
            for (int ks = 0; ks < 8; ++ks) acc = __builtin_amdgcn_mfma_f32_32x32x16_bf16(Af[ks], Bf[ks], acc, 0, 0, 0);
            if (kt + 1 < nkt) {
#pragma unroll
                for (int ks = 0; ks < 8; ++ks) Bf[ks] = *(const bf16x8*)(kbase + (size_t)(kt + 1) * 32 * 256 + 16 * ks); }
            float sc = 0.f;
#pragma unroll
            for (int r = 0; r < 16; ++r) sc += fmaxf(acc[r], 0.f) * wr[r];
            scl[(2 * w + half) * 2048 + kt * 32 + l31] = sc;
        }
        WAVE_SYNC();
#pragma unroll 1
        for (int qi = 0; qi < 2; ++qi) {
            const int t = t0 + 2 * w + qi; const float* row = scl + (2 * w + qi) * 2048;
            unsigned key[32];
#pragma unroll
            for (int jj = 0; jj < 32; ++jj) { const int s2 = lane + 64 * jj; key[jj] = (s2 <= t) ? fkey(row[s2]) : 0u; }
            unsigned thr = 0u;
            if (t + 1 > 256) {
                for (int bit = 31; bit >= 0; --bit) {
                    const unsigned cand = thr | (1u << bit);
                    int cnt = 0;
#pragma unroll
                    for (int jj = 0; jj < 32; ++jj) cnt += __popcll(__ballot(key[jj] >= cand));
                    if (cnt >= 256) { thr = cand; if (cnt == 256) break; }
                }
            }
            unsigned wd = 0u;
#pragma unroll
            for (int jj = 0; jj < 32; ++jj) { const int s2 = lane + 64 * jj; const unsigned long long m = __ballot(s2 <= t && key[jj] >= thr);
                if (lane == 2 * jj) wd = (unsigned)m; if (lane == 2 * jj + 1) wd = (unsigned)(m >> 32); }
            MASK[((size_t)b * 2048 + t) * 64 + lane] = wd;
        }
        WAVE_SYNC();
    }
}

__device__ __forceinline__ int t5_bucket(int d) {
    if (d < 16) return d;
    return 16 + (d >= 19) + (d >= 21) + (d >= 24) + (d >= 27) + (d >= 31) + (d >= 35) + (d >= 40) + (d >= 46) + (d >= 52) + (d >= 59) + (d >= 67) + (d >= 77) + (d >= 87) + (d >= 99) + (d >= 113);
}
namespace dsa {
constexpr float SCALE = 0.08838834764831845f;
constexpr int NW = 8, QBLK = 32, KVBLK = 64, QB = NW * QBLK, DH = 128, LD = 2048;
constexpr int SHM_V = KVBLK * DH * 2, SHM_K = KVBLK * DH * 2;
constexpr int OFF_WS = 2 * SHM_V + 2 * SHM_K, OFF_BIAS = OFF_WS + NW * 64 * 4, LDS_TOTAL = OFF_BIAS + 16 * 128 * 4;
constexpr float THR = 8.f;
typedef short s16x4 __attribute__((ext_vector_type(4)));
#define KSWZ(row, colB) ((row) * 256 + ((colB) ^ (((row) & 7) << 4)))
#define SBAR() __builtin_amdgcn_sched_barrier(0)
__device__ __forceinline__ int v_st(int k, int c) { const int kk = (k & ~0xC) | ((k & 4) << 1) | ((k & 8) >> 1); return ((kk >> 3) * 4 + (c >> 5)) * 512 + ((kk & 7) * 32 + (c & 31)) * 2; }
__device__ __forceinline__ int v_rd_base(int lane) { return ((lane & 3) << 3) | (((lane >> 2) & 3) << 6) | (((lane >> 4) & 1) << 5) | (((lane >> 5) & 1) << 8); }
constexpr int v_rd_off(int d0, int ks, int half) { return d0 * 512 + ks * 4096 + half * 2048; }
__device__ __forceinline__ int crow(int r, int hi) { return (r & 3) + 8 * (r >> 2) + 4 * hi; }
__device__ __forceinline__ unsigned cvtpk(float lo, float hi) { unsigned r; asm volatile("v_cvt_pk_bf16_f32 %0, %1, %2" : "=v"(r) : "v"(lo), "v"(hi)); return r; }
__device__ __forceinline__ bf16x8 load8(const bf16* p) { return *reinterpret_cast<const bf16x8*>(p); }
template <bool NEAR>
__device__ __forceinline__ void init_scores(f32x16& p0, f32x16& p1, unsigned w0, unsigned w1, int hi, int dq, const float* bl) {
    w0 >>= 4 * hi; w1 >>= 4 * hi;
#pragma unroll
    for (int r = 0; r < 16; ++r) { const int c = (r & 3) + 8 * (r >> 2);
        const int x0 = __builtin_amdgcn_sbfe(w0, c, 1), x1 = __builtin_amdgcn_sbfe(w1, c, 1);
        unsigned b0 = 0u, b1 = 0u;
        if (NEAR) { int d0 = dq - c, d1 = dq - c - 32; d0 = d0 < 0 ? 0 : (d0 > 127 ? 127 : d0); d1 = d1 < 0 ? 0 : (d1 > 127 ? 127 : d1);
            b0 = __float_as_uint(bl[d0]); b1 = __float_as_uint(bl[d1]); }
        p0[r] = __uint_as_float((b0 & (unsigned)x0) | (0xFF800000u & ~(unsigned)x0));
        p1[r] = __uint_as_float((b1 & (unsigned)x1) | (0xFF800000u & ~(unsigned)x1)); }
}
__device__ __forceinline__ void partialSM(f32x16& p0, f32x16& p1, float& m_reg, float& mn, float& alpha) {
    float pmax = p0[0];
#pragma unroll
    for (int r = 1; r < 16; ++r) pmax = fmaxf(pmax, p0[r]);
#pragma unroll
    for (int r = 0; r < 16; ++r) pmax = fmaxf(pmax, p1[r]);
    { auto rr = __builtin_amdgcn_permlane32_swap(__float_as_uint(pmax), __float_as_uint(pmax), false, false);
      pmax = fmaxf(__uint_as_float(rr[0]), __uint_as_float(rr[1])); }
    constexpr float C2 = 1.4426950408889634f * SCALE;
    if (__builtin_expect(__all((pmax - m_reg) * SCALE <= THR), 1)) { mn = m_reg; alpha = 1.f; }
    else { mn = fmaxf(m_reg, pmax); alpha = __builtin_amdgcn_exp2f((m_reg - mn) * C2); m_reg = mn; }
    const float mnL = -mn * C2;
#pragma unroll
    for (int r = 0; r < 16; ++r) p0[r] = fmaf(p0[r], C2, mnL);
#pragma unroll
    for (int r = 0; r < 16; ++r) p1[r] = fmaf(p1[r], C2, mnL);
#pragma unroll
    for (int r = 0; r < 16; ++r) p0[r] = __builtin_amdgcn_exp2f(p0[r]);
}
__device__ __forceinline__ void finishSM(f32x16& p0, f32x16& p1, float alpha, float& l_reg, bf16x8& pa0, bf16x8& pa1, bf16x8& pa2, bf16x8& pa3) {
#pragma unroll
    for (int r = 0; r < 16; ++r) p1[r] = __builtin_amdgcn_exp2f(p1[r]);
    float ps = 0;
#pragma unroll
    for (int r = 0; r < 16; ++r) ps += p0[r];
#pragma unroll
    for (int r = 0; r < 16; ++r) ps += p1[r];
    { auto rr = __builtin_amdgcn_permlane32_swap(__float_as_uint(ps), __float_as_uint(ps), false, false);
      ps = __uint_as_float(rr[0]) + __uint_as_float(rr[1]); }
    l_reg = l_reg * alpha + ps;
#define PK4(P, B_, OUT) do { unsigned a0 = cvtpk(P[B_+0], P[B_+1]), a1 = cvtpk(P[B_+2], P[B_+3]);                          \
        unsigned b0 = cvtpk(P[B_+4], P[B_+5]), b1 = cvtpk(P[B_+6], P[B_+7]);                                             \
        auto r0 = __builtin_amdgcn_permlane32_swap(a0, b0, false, false); auto r1 = __builtin_amdgcn_permlane32_swap(a1, b1, false, false); \
        u32x4 w = {r0[0], r1[0], r0[1], r1[1]}; OUT = *reinterpret_cast<bf16x8*>(&w); } while (0)
    PK4(p0, 0, pa0); PK4(p0, 8, pa1); PK4(p1, 0, pa2); PK4(p1, 8, pa3);
#undef PK4
}
template <int KB>
__device__ __forceinline__ void qkt(f32x16& p0, f32x16& p1, const char* K_lds, int r32, int hi, const bf16x8* qr) {
    const char* kb[4];
#pragma unroll
    for (int dd = 0; dd < 4; ++dd) kb[dd] = K_lds + KB * SHM_K + KSWZ(r32, (dd * 16 + hi * 8) * 2);
#pragma unroll
    for (int d0 = 0; d0 < 8; ++d0) { const char* a = kb[d0 & 3] + (d0 >> 2) * 128;
        bf16x8 b0 = *reinterpret_cast<const bf16x8*>(a);
        bf16x8 b1 = *reinterpret_cast<const bf16x8*>(a + 32 * 256);
        p0 = __builtin_amdgcn_mfma_f32_32x32x16_bf16(b0, qr[d0], p0, 0, 0, 0);
        p1 = __builtin_amdgcn_mfma_f32_32x32x16_bf16(b1, qr[d0], p1, 0, 0, 0); }
}
template <int VB>
__device__ __forceinline__ void pv_tile(f32x16* o, int vb0, bf16x8 pa0, bf16x8 pa1, bf16x8 pa2, bf16x8 pa3) {
#define TRRD(dst, off) asm volatile("ds_read_b64_tr_b16 %0, %1 offset:%2" : "=&v"(dst) : "v"(vb0), "i"(off) : "memory")
#define PV_D0(d0) do { s16x4 l0, l1, l2, l3, h0, h1, h2, h3; constexpr int b_ = VB * SHM_V + v_rd_off(d0, 0, 0); \
        TRRD(l0, b_); TRRD(h0, b_ + 2048); TRRD(l1, b_ + 4096); TRRD(h1, b_ + 6144); TRRD(l2, b_ + 8192); TRRD(h2, b_ + 10240); TRRD(l3, b_ + 12288); TRRD(h3, b_ + 14336); \
        asm volatile("s_waitcnt lgkmcnt(0)" ::: "memory"); SBAR();   \
        o[d0] = __builtin_amdgcn_mfma_f32_32x32x16_bf16(pa0, (bf16x8){l0[0], l0[1], l0[2], l0[3], h0[0], h0[1], h0[2], h0[3]}, o[d0], 0, 0, 0);   \
        o[d0] = __builtin_amdgcn_mfma_f32_32x32x16_bf16(pa1, (bf16x8){l1[0], l1[1], l1[2], l1[3], h1[0], h1[1], h1[2], h1[3]}, o[d0], 0, 0, 0);   \
        o[d0] = __builtin_amdgcn_mfma_f32_32x32x16_bf16(pa2, (bf16x8){l2[0], l2[1], l2[2], l2[3], h2[0], h2[1], h2[2], h2[3]}, o[d0], 0, 0, 0);   \
        o[d0] = __builtin_amdgcn_mfma_f32_32x32x16_bf16(pa3, (bf16x8){l3[0], l3[1], l3[2], l3[3], h3[0], h3[1], h3[2], h3[3]}, o[d0], 0, 0, 0); } while (0)
    PV_D0(0); PV_D0(1); PV_D0(2); PV_D0(3);
#undef PV_D0
#undef TRRD
}
struct BlockRef { const bf16* Q; const bf16* K; const bf16* V; bf16* O; const unsigned* M; int P0; int h; };
struct Seam { bf16x8 qr[8]; bf16x8 st_v0, st_v1, st_k0, st_k1; };
#define ROWU(p, k0) ((p) + (size_t)(k0) * LD)
#define VMW() asm volatile("s_waitcnt vmcnt(0)" ::: "memory")
#define VMWN(n) asm volatile("s_waitcnt vmcnt(%0)" :: "i"(n) : "memory")
#define SLOAD_H(Kp, Vp, k0) do { S.st_v0 = load8(ROWU(Vp, k0) + sofs); S.st_v1 = load8(ROWU(Vp, (k0) + 32) + sofs);              \
                         S.st_k0 = load8(ROWU(Kp, k0) + sofs); S.st_k1 = load8(ROWU(Kp, (k0) + 32) + sofs); } while (0)
#define SWRITE_HK(bf) do { *(bf16x8*)(K_lds + (bf) * SHM_K + kws) = S.st_k0; *(bf16x8*)(K_lds + (bf) * SHM_K + kws + 32 * 256) = S.st_k1; } while (0)
#define SWRITE_HV(bf) do { *(bf16x8*)(V_lds + (bf) * SHM_V + vst0) = S.st_v0; *(bf16x8*)(V_lds + (bf) * SHM_V + vst1) = S.st_v1; } while (0)
#define SWRITE_H(bf) do { SWRITE_HV(bf); SWRITE_HK(bf); } while (0)
__device__ __forceinline__ void prime(const BlockRef& cur, char* lds, Seam& S, int wid) {
    const int lane = fresh_lane(), tid = wid * 64 + lane, r32 = lane & 31, hi = lane >> 5;
    const int sr = tid >> 4, sc = (tid & 15) * 8, kws = KSWZ(sr, sc * 2); char* K_lds = lds + 2 * SHM_V; const unsigned sofs = (unsigned)(sr * LD + sc);
    const unsigned qofs = (unsigned)((wid * QBLK + r32) * LD + hi * 8);
#pragma unroll
    for (int d0 = 0; d0 < 8; ++d0) S.qr[d0] = load8(cur.Q + qofs + d0 * 16);
    SLOAD_H(cur.K, cur.V, 0); VMW(); SWRITE_HK(0);
    __syncthreads();
}
__device__ __forceinline__ void block(const BlockRef& cur, const BlockRef& nxt, char* lds, Seam& S, int wid) {
    const int lane = fresh_lane(), tid = wid * 64 + lane,
               r32 = lane & 31, hi = lane >> 5;
    const int NT = (cur.P0 + QB - 1) / KVBLK + 1;
    const int qlo = cur.P0 + wid * QBLK, qm = qlo + r32 - 4 * hi;
    char* V_lds = lds; char* K_lds = lds + 2 * SHM_V;
    float* ws = (float*)(lds + OFF_WS) + wid * 64; float* li_l = ws, * al_l = ws + 32;
    const float* bl = (const float*)(lds + OFF_BIAS) + cur.h * 128;
    const unsigned mofs = (unsigned)((wid * QBLK + r32) * 64);
    float m_reg = -1e30f, l_reg = 0; f32x16 o[4] = {};
    const int sr = tid >> 4, sc = (tid & 15) * 8, vst0 = v_st(sr, sc), vst1 = v_st(32 + sr, sc), kws = KSWZ(sr, sc * 2); const unsigned sofs = (unsigned)(sr * LD + sc);
    const int vb0 = (int)(uintptr_t)V_lds + v_rd_base(lane);
    const bf16* Kh = cur.K; const bf16* Vh = cur.V;
#define RESC(a) do { if (__any((a) < 1.f)) { if (hi == 0) al_l[r32] = (a); asm volatile("s_waitcnt lgkmcnt(0)" ::: "memory");              \
                     for (int d_ = 0; d_ < 4; ++d_) for (int r = 0; r < 16; ++r) o[d_][r] *= al_l[crow(r, hi)]; } } while (0)
#define KBASE(t) ((t) * KVBLK)
#define LDMASK(t) (*(const u32x2*)(cur.M + 2 * ((t) < 31 ? (t) : 31) + mofs))
#define INIT(P0_, P1_, t) do { const int kb_ = KBASE(t); if (qlo - kb_ - 63 < 113) init_scores<true>(P0_, P1_, mw.x, mw.y, hi, qm - kb_, bl); else init_scores<false>(P0_, P1_, mw.x, mw.y, hi, 0, bl); } while (0)
#define SEAM_K0() do { VMWN(8); SWRITE_HK(0); SBAR(); } while (0)
    f32x16 pA0, pA1, pB0, pB1; float mnA, mnB, alA, alB; bf16x8 pa0, pa1, pa2, pa3; u32x2 mw;
    SWRITE_HV(0); SBAR();
    if (NT > 1) { SLOAD_H(Kh, Vh, KBASE(1)); }
    mw = LDMASK(0); INIT(pA0, pA1, 0); mw = LDMASK(1);
    SBAR(); qkt<0>(pA0, pA1, K_lds, r32, hi, S.qr);
    partialSM(pA0, pA1, m_reg, mnA, alA);
    if (NT > 1) { VMW(); SWRITE_H(1); }
    __syncthreads();
#define HALF_STEP(PX0, PX1, mnX, alX, PY0, PY1, alY, t, KB, VB, SB) do {                                                      \
        INIT(PX0, PX1, (t)); mw = LDMASK((t) + 1);                                                                           \
        SBAR(); qkt<KB>(PX0, PX1, K_lds, r32, hi, S.qr);                                                                      \
        finishSM(PY0, PY1, alY, l_reg, pa0, pa1, pa2, pa3); SBAR();                                                           \
        if ((t) + 1 < NT) { SLOAD_H(Kh, Vh, KBASE((t) + 1)); SBAR(); }                                                        \
        pv_tile<VB>(o, vb0, pa0, pa1, pa2, pa3); partialSM(PX0, PX1, m_reg, mnX, alX);              \
        __syncthreads();                                                                                                      \
        if ((t) + 1 < NT) { VMW(); SWRITE_H(SB); }                                                                            \
        RESC(alX); __syncthreads(); } while (0)
    for (int t = 1; t + 1 < NT; t += 2) {
        HALF_STEP(pB0, pB1, mnB, alB, pA0, pA1, alA, t, 1, 0, 0);
        HALF_STEP(pA0, pA1, mnA, alA, pB0, pB1, alB, t + 1, 0, 1, 1);
    }
    const bool even = (NT & 1) == 0;
    if (even) { INIT(pB0, pB1, NT - 1); SBAR(); qkt<1>(pB0, pB1, K_lds, r32, hi, S.qr); SBAR(); }
    SLOAD_H(nxt.K, nxt.V, 0); SBAR();
#pragma unroll
    for (int d0 = 0; d0 < 8; ++d0) S.qr[d0] = load8(nxt.Q + (unsigned)((wid * QBLK + r32) * LD + hi * 8) + d0 * 16);
    SBAR();
    finishSM(pA0, pA1, alA, l_reg, pa0, pa1, pa2, pa3); SBAR();
    pv_tile<0>(o, vb0, pa0, pa1, pa2, pa3);
    if (even) { partialSM(pB0, pB1, m_reg, mnB, alB); __syncthreads(); RESC(alB);
        finishSM(pB0, pB1, alB, l_reg, pa0, pa1, pa2, pa3); SBAR(); pv_tile<1>(o, vb0, pa0, pa1, pa2, pa3); }
    SBAR(); SEAM_K0();
    if (hi == 0) li_l[r32] = l_reg; asm volatile("s_waitcnt lgkmcnt(0)" ::: "memory");
    float rli[16];
#pragma unroll
    for (int r = 0; r < 16; ++r) rli[r] = __builtin_amdgcn_rcpf(li_l[crow(r, hi)]);
    int lofs = 4 * hi * LD + r32; asm volatile("" : "+v"(lofs));
    bf16* Ow = cur.O + (size_t)(wid * QBLK) * LD + lofs;
#pragma unroll
    for (int r = 0; r < 16; ++r) { const int orow = (r & 3) + 8 * (r >> 2);
#pragma unroll
        for (int d0 = 0; d0 < 4; ++d0) { const float v = o[d0][r] * rli[r];
            const float vn = __shfl_xor(v, 1);
            if ((r32 & 1) == 0) *(unsigned*)(Ow + orow * LD + d0 * 32) = cvtpk(v, vn); } }
    __syncthreads();
#undef RESC
#undef KBASE
#undef LDMASK
#undef INIT
#undef SEAM_K0
#undef HALF_STEP
}
#undef ROWU
#undef VMW
#undef VMWN
#undef SLOAD_H
#undef SWRITE_HK
#undef SWRITE_HV
#undef SWRITE_H
#undef KSWZ
#undef SBAR
}

__device__ __forceinline__ dsa::BlockRef dsa_ref(const Frame& F, int bh, int qb) {
    const int b = bh >> 4, h = bh & 15;
    dsa::BlockRef r;
    r.Q = F.slot(4) + ((size_t)b * 2048 + (size_t)qb * 256) * 2048 + h * 128;
    r.O = F.slot(3) + ((size_t)b * 2048 + (size_t)qb * 256) * 2048 + h * 128;
    r.K = F.slot(1) + (size_t)b * 2048 * 2048 + h * 128; r.V = F.slot(2) + (size_t)b * 2048 * 2048 + h * 128;
    r.M = (const unsigned*)(F.ws + WS_MASK) + ((size_t)b * 2048 + (size_t)qb * 256) * 64;
    r.P0 = qb * 256; r.h = h;
    return r;
}
__device__ __forceinline__ void ph6_attn(const Frame& F) {
    const Args& a = *F.a;
    char* lds = (char*)F.lds;
    {
        float* bt = (float*)(lds + dsa::OFF_BIAS);
        for (int i = F.wave * 64 + F.lane(); i < 16 * 128; i += 512) { const int h = i >> 7, d = i & 127; bt[i] = (a.in[10][t5_bucket(d) * 16 + h] - a.in[10][31 * 16 + h]) * (1.0f / dsa::SCALE); }
    }
    __syncthreads();
    const int total = 4 * 128;
    int L = F.bid; if (L >= total) return;
    int pass = 0;
    dsa::BlockRef cur = dsa_ref(F, L >> 2, L & 3);
    dsa::Seam S;
    dsa::prime(cur, lds, S, F.wave);
    for (;;) {
        const bool more_pass = pass == 0, more_item = L + F.G < total, last = !more_pass && !more_item;
        int passn = pass + 1, Ln = L;
        if (!more_pass) { passn = 0; Ln = more_item ? L + F.G : L; }
        const dsa::BlockRef nxt = last ? cur : dsa_ref(F, Ln >> 2, passn ? 7 - (Ln & 3) : (Ln & 3));
        dsa::block(cur, nxt, lds, S, F.wave);
        if (last) break;
        cur = nxt; pass = passn; L = Ln;
    }
}

__device__ __forceinline__ void ln_row(float* zrow, const float* g, const float* bta, bf16* brow, int lane) {
    f32x4 v[8]; float s = 0.f;
#pragma unroll
    for (int i = 0; i < 8; ++i) { v[i] = *(const f32x4*)(zrow + 256 * i + 4 * lane); s += (v[i].x + v[i].y) + (v[i].z + v[i].w); }
    const float mu = wave_sum(s) * (1.0f / 2048.0f); float s2 = 0.f;
#pragma unroll
    for (int i = 0; i < 8; ++i) { v[i] = v[i] - mu; s2 += (v[i].x * v[i].x + v[i].y * v[i].y) + (v[i].z * v[i].z + v[i].w * v[i].w); }
    const float r = rsqrtf(wave_sum(s2) * (1.0f / 2048.0f) + 1e-5f);
#pragma unroll
    for (int i = 0; i < 8; ++i) { const f32x4 gg = *(const f32x4*)(g + 256 * i + 4 * lane), bb = *(const f32x4*)(bta + 256 * i + 4 * lane);
        const f32x4 o = v[i] * r * gg + bb; *(f32x4*)(zrow + 256 * i + 4 * lane) = o;
        if (brow) { u32x2 w; w.x = pk2(o.x, o.y); w.y = pk2(o.z, o.w); *(u32x2*)(brow + 256 * i + 4 * lane) = w; } }
}
__device__ __forceinline__ void ph_ln(const Frame& F, const float* g, const float* bta, bf16* bout) {
    const int gw = F.bid * 8 + F.wave, NGW = F.G * 8, lane = F.lane();
    for (int row = gw; row < T; row += NGW) ln_row(F.a->out + (size_t)row * 2048, g, bta, bout + (size_t)row * 2048, lane);
}

__device__ __forceinline__ float pk_idx(float v, unsigned code, unsigned mask) { return __uint_as_float((__float_as_uint(v) & ~mask) | code); }
__device__ __forceinline__ void ph_peer_select(const Frame& F) {
    const Args& a = *F.a;
    const int lane = F.lane(), l31 = lane & 31, half = lane >> 5;
    const float* PQ = (const float*)F.slot(1); const float* keys = a.in[23];
    int* EIDX = (int*)(F.ws + WS_CKV); float* EG = (float*)(F.ws + WS_IKW);
    const float NEG = -__builtin_inff();
    for (int tile = F.bid; tile < T / 32; tile += F.G) {
        const int h = F.wave, t = tile * 32 + l31;
        float tv[2][16];
#pragma unroll
        for (int p = 0; p < 2; ++p) {
            const int g = 2 * h + p;
            float qv[64];
            { const float* qp = PQ + (size_t)t * 2048 + g * 128 + 64 * half;
#pragma unroll
              for (int j = 0; j < 16; ++j) { const f32x4 v = *(const f32x4*)(qp + 4 * j); qv[4 * j] = v.x; qv[4 * j + 1] = v.y; qv[4 * j + 2] = v.z; qv[4 * j + 3] = v.w; } }
            f32x16 acc[4];
#pragma unroll
            for (int mt = 0; mt < 4; ++mt) {
#pragma unroll
                for (int r = 0; r < 16; ++r) acc[mt][r] = 0.f;
                const float* kp = keys + ((size_t)(g * 128 + mt * 32 + l31) * 128 + 64 * half);
#pragma unroll
                for (int j = 0; j < 16; ++j) { const f32x4 kv = *(const f32x4*)(kp + 4 * j);
                    acc[mt] = __builtin_amdgcn_mfma_f32_32x32x2f32(kv.x, qv[4 * j], acc[mt], 0, 0, 0); acc[mt] = __builtin_amdgcn_mfma_f32_32x32x2f32(kv.y, qv[4 * j + 1], acc[mt], 0, 0, 0);
                    acc[mt] = __builtin_amdgcn_mfma_f32_32x32x2f32(kv.z, qv[4 * j + 2], acc[mt], 0, 0, 0); acc[mt] = __builtin_amdgcn_mfma_f32_32x32x2f32(kv.w, qv[4 * j + 3], acc[mt], 0, 0, 0);
                    if ((j & 3) == 3) __builtin_amdgcn_sched_barrier(0); }
            }
            unsigned hmask = ~(4u * (unsigned)half); asm volatile("" : "+v"(hmask));
#pragma unroll
            for (int mt = 0; mt < 4; ++mt)
#pragma unroll
                for (int r = 0; r < 16; ++r) acc[mt][r] = __uint_as_float(((__float_as_uint(acc[mt][r]) & ~127u) | (unsigned)(127 - (32 * mt + (r & 3) + 8 * (r >> 2)))) & hmask);
#pragma unroll
            for (int k = 0; k < 16; ++k) {
                float m = acc[0][0];
#pragma unroll
                for (int mt = 0; mt < 4; ++mt)
#pragma unroll
                    for (int r = 0; r < 16; ++r) m = fmaxf(m, acc[mt][r]);
                m = fmaxf(m, __shfl_xor(m, 32));
                tv[p][k] = m;
#pragma unroll
                for (int mt = 0; mt < 4; ++mt)
#pragma unroll
                    for (int r = 0; r < 16; ++r) acc[mt][r] = (acc[mt][r] == m) ? NEG : acc[mt][r];
            }
        }
        float cand[25]; int cid[25];
        unsigned hc = 25u * (unsigned)half; asm volatile("" : "+v"(hc));
        { const float ai = half ? tv[0][2] : tv[0][0], bj = half ? tv[1][1] : tv[1][0];
          cand[0] = pk_idx(ai + bj, (unsigned)(63 - 0) - hc, 63u); cid[0] = (int)((127u - (__float_as_uint(ai) & 127u)) * 128u + (127u - (__float_as_uint(bj) & 127u))); }
        { const float ai = half ? tv[0][2] : tv[0][0], bj = half ? tv[1][2] : tv[1][1];
          cand[1] = pk_idx(ai + bj, (unsigned)(63 - 1) - hc, 63u); cid[1] = (int)((127u - (__float_as_uint(ai) & 127u)) * 128u + (127u - (__float_as_uint(bj) & 127u))); }
        { const float ai = half ? tv[0][2] : tv[0][0], bj = half ? tv[1][3] : tv[1][2];
          cand[2] = pk_idx(ai + bj, (unsigned)(63 - 2) - hc, 63u); cid[2] = (int)((127u - (__float_as_uint(ai) & 127u)) * 128u + (127u - (__float_as_uint(bj) & 127u))); }
        { const float ai = half ? tv[0][2] : tv[0][0], bj = half ? tv[1][4] : tv[1][3];
          cand[3] = pk_idx(ai + bj, (unsigned)(63 - 3) - hc, 63u); cid[3] = (int)((127u - (__float_as_uint(ai) & 127u)) * 128u + (127u - (__float_as_uint(bj) & 127u))); }
        { const float ai = half ? tv[0][3] : tv[0][0], bj = half ? tv[1][0] : tv[1][4];
          cand[4] = pk_idx(ai + bj, (unsigned)(63 - 4) - hc, 63u); cid[4] = (int)((127u - (__float_as_uint(ai) & 127u)) * 128u + (127u - (__float_as_uint(bj) & 127u))); }
        { const float ai = half ? tv[0][3] : tv[0][0], bj = half ? tv[1][1] : tv[1][5];
          cand[5] = pk_idx(ai + bj, (unsigned)(63 - 5) - hc, 63u); cid[5] = (int)((127u - (__float_as_uint(ai) & 127u)) * 128u + (127u - (__float_as_uint(bj) & 127u))); }
        { const float ai = half ? tv[0][3] : tv[0][0], bj = half ? tv[1][2] : tv[1][6];
          cand[6] = pk_idx(ai + bj, (unsigned)(63 - 6) - hc, 63u); cid[6] = (int)((127u - (__float_as_uint(ai) & 127u)) * 128u + (127u - (__float_as_uint(bj) & 127u))); }
        { const float ai = half ? tv[0][3] : tv[0][0], bj = half ? tv[1][3] : tv[1][7];
          cand[7] = pk_idx(ai + bj, (unsigned)(63 - 7) - hc, 63u); cid[7] = (int)((127u - (__float_as_uint(ai) & 127u)) * 128u + (127u - (__float_as_uint(bj) & 127u))); }
        { const float ai = half ? tv[0][4] : tv[0][0], bj = half ? tv[1][0] : tv[1][8];
          cand[8] = pk_idx(ai + bj, (unsigned)(63 - 8) - hc, 63u); cid[8] = (int)((127u - (__float_as_uint(ai) & 127u)) * 128u + (127u - (__float_as_uint(bj) & 127u))); }
        { const float ai = half ? tv[0][4] : tv[0][0], bj = half ? tv[1][1] : tv[1][9];
          cand[9] = pk_idx(ai + bj, (unsigned)(63 - 9) - hc, 63u); cid[9] = (int)((127u - (__float_as_uint(ai) & 127u)) * 128u + (127u - (__float_as_uint(bj) & 127u))); }
        { const float ai = half ? tv[0][4] : tv[0][0], bj = half ? tv[1][2] : tv[1][10];
          cand[10] = pk_idx(ai + bj, (unsigned)(63 - 10) - hc, 63u); cid[10] = (int)((127u - (__float_as_uint(ai) & 127u)) * 128u + (127u - (__float_as_uint(bj) & 127u))); }
        { const float ai = half ? tv[0][5] : tv[0][0], bj = half ? tv[1][0] : tv[1][11];
          cand[11] = pk_idx(ai + bj, (unsigned)(63 - 11) - hc, 63u); cid[11] = (int)((127u - (__float_as_uint(ai) & 127u)) * 128u + (127u - (__float_as_uint(bj) & 127u))); }
        { const float ai = half ? tv[0][5] : tv[0][0], bj = half ? tv[1][1] : tv[1][12];
          cand[12] = pk_idx(ai + bj, (unsigned)(63 - 12) - hc, 63u); cid[12] = (int)((127u - (__float_as_uint(ai) & 127u)) * 128u + (127u - (__float_as_uint(bj) & 127u))); }
        { const float ai = half ? tv[0][6] : tv[0][0], bj = half ? tv[1][0] : tv[1][13];
          cand[13] = pk_idx(ai + bj, (unsigned)(63 - 13) - hc, 63u); cid[13] = (int)((127u - (__float_as_uint(ai) & 127u)) * 128u + (127u - (__float_as_uint(bj) & 127u))); }
        { const float ai = half ? tv[0][6] : tv[0][0], bj = half ? tv[1][1] : tv[1][14];
          cand[14] = pk_idx(ai + bj, (unsigned)(63 - 14) - hc, 63u); cid[14] = (int)((127u - (__float_as_uint(ai) & 127u)) * 128u + (127u - (__float_as_uint(bj) & 127u))); }
        { const float ai = half ? tv[0][7] : tv[0][0], bj = half ? tv[1][0] : tv[1][15];
          cand[15] = pk_idx(ai + bj, (unsigned)(63 - 15) - hc, 63u); cid[15] = (int)((127u - (__float_as_uint(ai) & 127u)) * 128u + (127u - (__float_as_uint(bj) & 127u))); }
        { const float ai = half ? tv[0][7] : tv[0][1], bj = half ? tv[1][1] : tv[1][0];
          cand[16] = pk_idx(ai + bj, (unsigned)(63 - 16) - hc, 63u); cid[16] = (int)((127u - (__float_as_uint(ai) & 127u)) * 128u + (127u - (__float_as_uint(bj) & 127u))); }
        { const float ai = half ? tv[0][8] : tv[0][1], bj = half ? tv[1][0] : tv[1][1];
          cand[17] = pk_idx(ai + bj, (unsigned)(63 - 17) - hc, 63u); cid[17] = (int)((127u - (__float_as_uint(ai) & 127u)) * 128u + (127u - (__float_as_uint(bj) & 127u))); }
        { const float ai = half ? tv[0][9] : tv[0][1], bj = half ? tv[1][0] : tv[1][2];
          cand[18] = pk_idx(ai + bj, (unsigned)(63 - 18) - hc, 63u); cid[18] = (int)((127u - (__float_as_uint(ai) & 127u)) * 128u + (127u - (__float_as_uint(bj) & 127u))); }
        { const float ai = half ? tv[0][10] : tv[0][1], bj = half ? tv[1][0] : tv[1][3];
          cand[19] = pk_idx(ai + bj, (unsigned)(63 - 19) - hc, 63u); cid[19] = (int)((127u - (__float_as_uint(ai) & 127u)) * 128u + (127u - (__float_as_uint(bj) & 127u))); }
        { const float ai = half ? tv[0][11] : tv[0][1], bj = half ? tv[1][0] : tv[1][4];
          cand[20] = pk_idx(ai + bj, (unsigned)(63 - 20) - hc, 63u); cid[20] = (int)((127u - (__float_as_uint(ai) & 127u)) * 128u + (127u - (__float_as_uint(bj) & 127u))); }
        { const float ai = half ? tv[0][12] : tv[0][1], bj = half ? tv[1][0] : tv[1][5];
          cand[21] = pk_idx(ai + bj, (unsigned)(63 - 21) - hc, 63u); cid[21] = (int)((127u - (__float_as_uint(ai) & 127u)) * 128u + (127u - (__float_as_uint(bj) & 127u))); }
        { const float ai = half ? tv[0][13] : tv[0][1], bj = half ? tv[1][0] : tv[1][6];
          cand[22] = pk_idx(ai + bj, (unsigned)(63 - 22) - hc, 63u); cid[22] = (int)((127u - (__float_as_uint(ai) & 127u)) * 128u + (127u - (__float_as_uint(bj) & 127u))); }
        { const float ai = half ? tv[0][14] : tv[0][1], bj = half ? tv[1][0] : tv[1][7];
          cand[23] = pk_idx(ai + bj, (unsigned)(63 - 23) - hc, 63u); cid[23] = (int)((127u - (__float_as_uint(ai) & 127u)) * 128u + (127u - (__float_as_uint(bj) & 127u))); }
        { const float ai = half ? tv[0][15] : tv[0][2], bj = half ? tv[1][0] : tv[1][0];
          cand[24] = pk_idx(ai + bj, (unsigned)(63 - 24) - hc, 63u); cid[24] = (int)((127u - (__float_as_uint(ai) & 127u)) * 128u + (127u - (__float_as_uint(bj) & 127u))); }
        float sv[16]; int sid[16];
#pragma unroll
        for (int k = 0; k < 16; ++k) {
            float m = cand[0];
#pragma unroll
            for (int c = 1; c < 25; ++c) m = fmaxf(m, cand[c]);
            const float mo = __shfl_xor(m, 32);
            const bool mine = (m > mo) || (m == mo && half == 0);
            const float mm = fmaxf(m, mo);
            int id = -1;
#pragma unroll
            for (int c = 0; c < 25; ++c) { const bool hit = mine && (cand[c] == mm); id = hit ? cid[c] : id; cand[c] = hit ? NEG : cand[c]; }
            const int ido = __shfl_xor(id, 32);
            sv[k] = mm; sid[k] = id > ido ? id : ido;
        }
        float den = 0.f; float ev[16];
#pragma unroll
        for (int k = 0; k < 16; ++k) { ev[k] = expf(sv[k] - sv[0]); den += ev[k]; }
        const float inv = 1.0f / den;
        if (half == 0) { int* ep = EIDX + (size_t)t * 128 + h * 16;
#pragma unroll
            for (int k = 0; k < 16; k += 4) *(u32x4*)(ep + k) = (u32x4){(unsigned)sid[k], (unsigned)sid[k + 1], (unsigned)sid[k + 2], (unsigned)sid[k + 3]}; }
        else { float* gp = EG + (size_t)t * 128 + h * 16;
#pragma unroll
            for (int k = 0; k < 16; k += 4) *(f32x4*)(gp + k) = (f32x4){ev[k] * inv, ev[k + 1] * inv, ev[k + 2] * inv, ev[k + 3] * inv}; }
    }
}

typedef __bf16 bf16x2_t __attribute__((ext_vector_type(2)));
__device__ __forceinline__ float dot2bf(unsigned a, unsigned b, float c) { return __builtin_amdgcn_fdot2_f32_bf16(__builtin_bit_cast(bf16x2_t, a), __builtin_bit_cast(bf16x2_t, b), c, false); }
#define RL(v, l) __builtin_amdgcn_readlane((v), (l))
#define EXR 2
#define EX_LOAD(buf, tab, idv, e) do { _Pragma("unroll") for (int r_ = 0; r_ < EXR; ++r_) { const bf16* rp_ = (tab) + (size_t)RL(idv, ((e) & 63) + r_) * 2048 + 8 * lane; \
        _Pragma("unroll") for (int c_ = 0; c_ < 4; ++c_) buf[r_][c_] = *(const u32x4*)(rp_ + 512 * c_); } } while (0)
#define EX_DOT(buf, e) do { float d_[EXR]; _Pragma("unroll") for (int r_ = 0; r_ < EXR; ++r_) { float a_ = 0.f, b_ = 0.f; \
        _Pragma("unroll") for (int c_ = 0; c_ < 4; ++c_) { a_ = dot2bf(buf[r_][c_].x, xb[c_].x, a_); b_ = dot2bf(buf[r_][c_].y, xb[c_].y, b_); a_ = dot2bf(buf[r_][c_].z, xb[c_].z, a_); b_ = dot2bf(buf[r_][c_].w, xb[c_].w, b_); } d_[r_] = a_ + b_; } \
        _Pragma("unroll") for (int o_ = 32; o_ >= 1; o_ >>= 1) { _Pragma("unroll") for (int r_ = 0; r_ < EXR; ++r_) d_[r_] += __shfl_xor(d_[r_], o_); } \
        _Pragma("unroll") for (int r_ = 0; r_ < EXR; ++r_) { const float hv_ = 0.5f * d_[r_] * (1.0f + erff(d_[r_] * 0.7071067811865476f)); if (lane == (((e) & 63) + r_)) { if ((e) < 64) c0 = g0 * hv_; else c1 = g1 * hv_; } } } while (0)
#define EX_AXPY(buf, e) do { const float cv_ = (e) < 64 ? c0 : c1; _Pragma("unroll") for (int r_ = 0; r_ < EXR; ++r_) { const float cf_ = __int_as_float(RL(__float_as_int(cv_), ((e) & 63) + r_)); \
        _Pragma("unroll") for (int c_ = 0; c_ < 4; ++c_) { y[c_][0] += cf_ * bflo(buf[r_][c_].x); y[c_][1] += cf_ * bfhi(buf[r_][c_].x); y[c_][2] += cf_ * bflo(buf[r_][c_].y); y[c_][3] += cf_ * bfhi(buf[r_][c_].y); \
            y[c_][4] += cf_ * bflo(buf[r_][c_].z); y[c_][5] += cf_ * bfhi(buf[r_][c_].z); y[c_][6] += cf_ * bflo(buf[r_][c_].w); y[c_][7] += cf_ * bfhi(buf[r_][c_].w); } } } while (0)
__device__ __forceinline__ void ph16_experts(const Frame& F) {
    const Args& a = *F.a;
    const int gw = F.bid * 8 + F.wave, NGW = F.G * 8, lane = F.lane();
    const int* EIDX = (const int*)(F.ws + WS_CKV); const float* EG = (const float*)(F.ws + WS_IKW);
    const bf16* PU = F.slot(5); const bf16* PV = F.slot(6); const bf16* XB = F.slot(0);
    for (int t = gw; t < T; t += NGW) {
        u32x4 xb[4];
#pragma unroll
        for (int c = 0; c < 4; ++c) xb[c] = *(const u32x4*)(XB + (size_t)t * 2048 + 512 * c + 8 * lane);
        const int id0 = EIDX[(size_t)t * 128 + lane], id1 = EIDX[(size_t)t * 128 + 64 + lane];
        const float g0 = EG[(size_t)t * 128 + lane], g1 = EG[(size_t)t * 128 + 64 + lane];
        float c0 = 0.f, c1 = 0.f;
        u32x4 bA[EXR][4], bB[EXR][4];
        EX_LOAD(bA, PU, id0, 0);
        for (int e = 0; e < 128; e += 2 * EXR) {
            const int idv = e < 64 ? id0 : id1;
            EX_LOAD(bB, PU, idv, e + EXR);
            EX_DOT(bA, e);
            if (e + 2 * EXR < 128) { const int idn = (e + 2 * EXR) < 64 ? id0 : id1; EX_LOAD(bA, PU, idn, e + 2 * EXR); }
            EX_DOT(bB, e + EXR);
        }
        float y[4][8];
#pragma unroll
        for (int c = 0; c < 4; ++c)
#pragma unroll
            for (int j = 0; j < 8; ++j) y[c][j] = 0.f;
        EX_LOAD(bA, PV, id0, 0);
        for (int e = 0; e < 128; e += 2 * EXR) {
            const int idv = e < 64 ? id0 : id1;
            EX_LOAD(bB, PV, idv, e + EXR);
            EX_AXPY(bA, e);
            if (e + 2 * EXR < 128) { const int idn = (e + 2 * EXR) < 64 ? id0 : id1; EX_LOAD(bA, PV, idn, e + 2 * EXR); }
            EX_AXPY(bB, e + EXR);
        }
        float* xrow = a.out + (size_t)t * 2048;
        float s = 0.f;
#pragma unroll
        for (int c = 0; c < 4; ++c) { const f32x4 x0 = *(const f32x4*)(xrow + 512 * c + 8 * lane), x1 = *(const f32x4*)(xrow + 512 * c + 8 * lane + 4);
            y[c][0] += ALPHA * x0.x; y[c][1] += ALPHA * x0.y; y[c][2] += ALPHA * x0.z; y[c][3] += ALPHA * x0.w; y[c][4] += ALPHA * x1.x; y[c][5] += ALPHA * x1.y; y[c][6] += ALPHA * x1.z; y[c][7] += ALPHA * x1.w;
#pragma unroll
            for (int j = 0; j < 8; ++j) s += y[c][j]; }
        const float mu = wave_sum(s) * (1.0f / 2048.0f); float s2 = 0.f;
#pragma unroll
        for (int c = 0; c < 4; ++c)
#pragma unroll
            for (int j = 0; j < 8; ++j) { y[c][j] -= mu; s2 += y[c][j] * y[c][j]; }
        const float rs = rsqrtf(wave_sum(s2) * (1.0f / 2048.0f) + 1e-5f);
#pragma unroll
        for (int c = 0; c < 4; ++c) { const int col = 512 * c + 8 * lane;
            const f32x4 ga = *(const f32x4*)(a.in[26] + col), gb = *(const f32x4*)(a.in[26] + col + 4), ba = *(const f32x4*)(a.in[27] + col), bb = *(const f32x4*)(a.in[27] + col + 4);
            f32x4 o0, o1; o0.x = y[c][0] * rs * ga.x + ba.x; o0.y = y[c][1] * rs * ga.y + ba.y; o0.z = y[c][2] * rs * ga.z + ba.z; o0.w = y[c][3] * rs * ga.w + ba.w;
            o1.x = y[c][4] * rs * gb.x + bb.x; o1.y = y[c][5] * rs * gb.y + bb.y; o1.z = y[c][6] * rs * gb.z + bb.z; o1.w = y[c][7] * rs * gb.w + bb.w;
            *(f32x4*)(xrow + col) = o0; *(f32x4*)(xrow + col + 4) = o1; }
    }
}

#define XB_TMO      128
#define XB_XCNT(j)  (256  + 64 * (j))
#define XB_XSUB(j)  (1280 + 64 * (j))
#define XB_XGEN(j)  (2304 + 64 * (j))
#define XB_TOP      3328
#define XB_TOPGEN   3392
#define XCD_BAR_WORDS 3456
#define XB_SPIN_CAP (1u << 22)
__device__ __forceinline__ unsigned xb_ld(unsigned* p)              { return __hip_atomic_load(p, __ATOMIC_RELAXED, __HIP_MEMORY_SCOPE_AGENT); }
__device__ __forceinline__ unsigned xb_add(unsigned* p, unsigned v) { return __hip_atomic_fetch_add(p, v, __ATOMIC_RELAXED, __HIP_MEMORY_SCOPE_AGENT); }
__device__ __forceinline__ unsigned xb_xcc_id() { return (unsigned)__builtin_amdgcn_s_getreg((3 << 11) | 20) & 0xFu; }
#define XB_SPIN(cond, bar) do { unsigned _sp = 0; while (cond) { __builtin_amdgcn_s_sleep(1); \
    if ((++_sp & 255u) == 0u) { if (xb_ld(&(bar)[XB_TMO])) break; if (_sp > XB_SPIN_CAP) { atomicAdd(&(bar)[XB_TMO], 1u); break; } } } } while (0)
struct XcdBarrier { unsigned* bar; unsigned x; volatile unsigned* st; };
__device__ __forceinline__ void xcd_barrier_complete(unsigned* bar, unsigned x, unsigned G, unsigned& nloc, unsigned& nx) {
    unsigned sum, cnt, mine, sp = 0u;
    for (;;) {
        sum = 0u; cnt = 0u; mine = 0u;
#pragma unroll
        for (unsigned j = 0; j < 16; ++j) { const unsigned c = xb_ld(&bar[XB_XCNT(j)]); sum += c; cnt += (c > 0u) ? 1u : 0u; mine = (j == x) ? c : mine; }
        if (sum == G) break;
        __builtin_amdgcn_s_sleep(1);
        if ((++sp & 255u) == 0u) { if (xb_ld(&bar[XB_TMO])) break; if (sp > XB_SPIN_CAP) { atomicAdd(&bar[XB_TMO], 1u); break; } }
    }
    nloc = mine > 0u ? mine : 1u; nx = cnt > 0u ? cnt : 1u;
}
__device__ __forceinline__ void xcd_barrier(const XcdBarrier& b, bool leader, unsigned G) {
    asm volatile("s_waitcnt vmcnt(0)" ::: "memory");
    __syncthreads();
    if (leader) {
        unsigned* bar = b.bar;
        __builtin_amdgcn_s_waitcnt(0);
        unsigned nloc = b.st[0], nx = b.st[1];
        if (nloc == 0u) { xcd_barrier_complete(bar, b.x, G, nloc, nx); b.st[0] = nloc; b.st[1] = nx; }
        const unsigned old = xb_add(&bar[XB_XSUB(b.x)], 1u);
        const unsigned gen = old / nloc;
        if (old + 1u == (gen + 1u) * nloc) {
            __builtin_amdgcn_fence(__ATOMIC_RELEASE, "agent");
            asm volatile("s_waitcnt vmcnt(0)" ::: "memory");
            const unsigned og = xb_add(&bar[XB_TOP], 1u);
            const unsigned tg = og / nx;
            if (og + 1u == (tg + 1u) * nx) xb_add(&bar[XB_TOPGEN], 1u);
            else XB_SPIN(xb_ld(&bar[XB_TOPGEN]) == tg, bar);
            __builtin_amdgcn_fence(__ATOMIC_ACQUIRE, "agent");
            xb_add(&bar[XB_XGEN(b.x)], 1u);
            asm volatile("s_waitcnt vmcnt(0)" ::: "memory");
        } else {
            XB_SPIN(xb_ld(&bar[XB_XGEN(b.x)]) == gen, bar);
            __builtin_amdgcn_fence(__ATOMIC_ACQUIRE, "agent");
            asm volatile("s_waitcnt vmcnt(0)" ::: "memory");
        }
    }
    __syncthreads();
}

__global__ void __launch_bounds__(512, 2) mega(Args args) {
    extern __shared__ __attribute__((aligned(16))) unsigned char lds[];
    cg::grid_group grid = cg::this_grid();
    Frame F;
    F.lds = lds; F.wave = __builtin_amdgcn_readfirstlane(threadIdx.x >> 6); F.bid = blockIdx.x; F.G = gridDim.x;
    F.a = &args; F.ws = args.ws;
    const int lo = args.ph_lo, hi = args.ph_hi;
    volatile unsigned* xst = (volatile unsigned*)(lds + LDS_BYTES - 64);
    const bool leader = (F.wave == 0) && (fresh_lane() == 0);
    if (leader) { xst[0] = 0u; xst[1] = 0u; }
    XcdBarrier xbar; xbar.bar = (unsigned*)(F.ws + WS_CTL) + 4096; xbar.x = xb_xcc_id(); xbar.st = xst;
    if (leader) (void)xb_add(&xbar.bar[XB_XCNT(xbar.x)], 1u);
    __syncthreads();
    bf16* W8 = (bf16*)(F.ws + WS_WIN);
#define IN(k) (lo <= (k) && (k) < hi)
#if PROBE_MASK
    unsigned long long pr_acc = 0ull, pr_t0 = __builtin_amdgcn_s_memrealtime();
#define SEAM(k) do { if (IN(k) && IN((k) + 1)) { if ((k) == 0) grid.sync(); else xcd_barrier(xbar, (F.wave == 0) && (fresh_lane() == 0), (unsigned)F.G); } { const unsigned long long t1_ = __builtin_amdgcn_s_memrealtime(); if ((PROBE_MASK >> (k)) & 1u) pr_acc += t1_ - pr_t0; pr_t0 = t1_; } } while (0)
#else
#define SEAM(k) do { if (IN(k) && IN((k) + 1)) { if ((k) == 0) grid.sync(); else xcd_barrier(xbar, (F.wave == 0) && (fresh_lane() == 0), (unsigned)F.G); } } while (0)
#endif
    if (IN(0)) { ph0_prologue(F); } SEAM(0);
    if (IN(1)) { gemm(F, (const bf16*)args.out, 2048, (const bf16*)(F.ws + WS_WIN), 2048, T, NCOLS, 2048, OpProj{F.ws}); } SEAM(1);
    if (IN(2)) {
        for (int u = F.bid; u < 128; u += F.G) hgrn_chunked(F, u);
        if (F.G > 128) { if (F.bid >= 128) ph2_side(F, F.bid - 128, F.G - 128); } else ph2_side(F, F.bid, F.G);
    } SEAM(2);
    if (IN(4)) {
        gemm(F, F.slot(0), 2048, W8, 2048, T, 2048, 2048, OpYA{F.slot(6)});
        gemm(F, (const bf16*)(F.ws + WS_CKV), 256, (const bf16*)(F.ws + WS_WKV), 256, T, 4096, 256, OpSplit2{F.slot(1), F.slot(2)});
    } SEAM(4);
    if (IN(5)) { ph5_select(F); } SEAM(5);
    if (IN(6)) { ph6_attn(F); } SEAM(6);
    if (IN(7)) { gemm(F, F.slot(3), 2048, W8 + (size_t)1 * 2048 * 2048, 2048, T, 2048, 2048, OpYB{F.slot(6), F.slot(7)}); } SEAM(7);
    if (IN(8)) { gemm(F, F.slot(6), 2048, W8 + (size_t)2 * 2048 * 2048, 2048, T, 2048, 2048, OpMix{args.in[0], args.out}); } SEAM(8);
    if (IN(9)) { ph_ln(F, args.in[14], args.in[15], F.slot(0)); } SEAM(9);
    if (IN(10)) {
        pg8::MultiOrder<3> S; S.lda = 2048; S.ldb = 2048; S.G = F.G; S.c = F.bid;
        S.s[0] = pg8::Sub{F.slot(0), W8 + (size_t)3 * 2048 * 2048, 64, 8};
        S.s[1] = pg8::Sub{(const bf16*)(F.ws + WS_MEMB), W8 + (size_t)4 * 2048 * 2048, 8, 8};
        S.s[2] = pg8::Sub{W8 + (size_t)5 * 2048 * 2048, (const bf16*)(F.ws + WS_MEMB), 8, 8};
        gemm_multi<3>(F, S, 2048, OpCQKV{F.slot(1), (bf16*)(F.ws + WS_CKV), (bf16*)(F.ws + WS_IKW)});
    } SEAM(10);
    if (IN(11)) {
        pg8::BatchOrder<OffS> S{F.slot(1), (const bf16*)(F.ws + WS_CKV), 8, 1, 32, 2048, 2048, F.G, F.bid, OffS()};
        gemm_batch(F, S, 512, OpLogit{(float*)F.slot(2)});
    } SEAM(11);
    if (IN(12)) { ph_xsoftmax(F, (const float*)F.slot(2), F.slot(3)); } SEAM(12);
    if (IN(13)) {
        pg8::BatchOrder<OffPV> S{F.slot(3), (const bf16*)(F.ws + WS_IKW), 8, 2, 32, 1024, 2048, F.G, F.bid, OffPV()};
        gemm_batch(F, S, 256, OpCO{F.slot(4)});
    } SEAM(13);
    if (IN(14)) { gemm(F, F.slot(4), 2048, W8 + (size_t)6 * 2048 * 2048, 2048, T, 2048, 2048, OpRes{args.out}); } SEAM(14);
    if (IN(15)) { ph_ln(F, args.in[20], args.in[21], F.slot(0));
        cvt_bf16_stream(F, args.in[24], F.slot(5), (size_t)16384 * 2048 / 8); cvt_bf16_stream(F, args.in[25], F.slot(6), (size_t)16384 * 2048 / 8); } SEAM(15);
    if (IN(16)) { gemm(F, F.slot(0), 2048, W8 + (size_t)7 * 2048 * 2048, 2048, T, 2048, 2048, OpF32{(float*)F.slot(1), 2048}); } SEAM(16);
    if (IN(17)) { ph_peer_select(F); } SEAM(17);
    if (IN(18)) { ph16_experts(F); }
#if PROBE_MASK
    { const unsigned long long t1_ = __builtin_amdgcn_s_memrealtime(); if ((PROBE_MASK >> 18) & 1u) pr_acc += t1_ - pr_t0;
      if (F.bid == 0 && threadIdx.x == 0) { const unsigned long long ts_ = __builtin_amdgcn_s_memrealtime(); while (__builtin_amdgcn_s_memrealtime() - ts_ < pr_acc) __builtin_amdgcn_s_sleep(8); } }
#endif
#undef IN
#undef SEAM
}

extern "C" void kernel_launch(void* const* d_in, const int* in_sizes, int n_in, void* d_out, int out_size, void* d_ws, size_t ws_size, hipStream_t stream) {
    static int grid = 0;
    if (grid == 0) {
        if (n_in != 28 || out_size != T * D || ws_size < WS_END) { fprintf(stderr, "kernel_launch: unexpected shapes (n_in %d out %d ws %zu)\n", n_in, out_size, ws_size); grid = -1; return; }
        int dev = 0, cus = 0, per_cu = 0;
        hipGetDevice(&dev); hipDeviceGetAttribute(&cus, hipDeviceAttributeMultiprocessorCount, dev);
        hipFuncSetAttribute((const void*)mega, hipFuncAttributeMaxDynamicSharedMemorySize, LDS_BYTES);
        hipOccupancyMaxActiveBlocksPerMultiprocessor(&per_cu, (const void*)mega, 512, LDS_BYTES);
        if (per_cu < 1) { fprintf(stderr, "kernel_launch: occupancy query says %d blocks per CU\n", per_cu); per_cu = 1; }
        (void)hipGetLastError();
        grid = cus;
    }
    if (grid < 0) return;
    (void)hipMemsetAsync((char*)d_ws + WS_CTL, 0, 65536, stream);
    Args a{};
    for (int i = 0; i < 28; ++i) a.in[i] = (const float*)d_in[i];
    a.out = (float*)d_out; a.ws = (unsigned char*)d_ws;
#if ONE_LAUNCH
    a.ph_lo = 0; a.ph_hi = NPH;
    void* params[] = {&a};
    hipError_t e = hipLaunchCooperativeKernel((const void*)mega, dim3(grid), dim3(512), params, LDS_BYTES, stream);
    if (e != hipSuccess) fprintf(stderr, "cooperative launch failed: %s\n", hipGetErrorString(e));
#else
    for (int ph = 0; ph < NPH; ++ph) {
        a.ph_lo = ph; a.ph_hi = ph + 1;
        void* params[] = {&a};
        hipError_t e = hipLaunchCooperativeKernel((const void*)mega, dim3(grid), dim3(512), params, LDS_BYTES, stream);
        if (e != hipSuccess) { fprintf(stderr, "launch %d failed: %s\n", ph, hipGetErrorString(e)); break; }
    }
#endif
}
```

```cpp
#include <hip/hip_runtime.h>
#include <hip/hip_cooperative_groups.h>
#include <cstdint>
#include <cmath>
#include <cstdio>
namespace cg = cooperative_groups;

#ifndef ONE_LAUNCH
#define ONE_LAUNCH 1
#endif
#ifndef PROBE_MASK
#define PROBE_MASK 0u
#endif

typedef unsigned short bf16;
typedef short bf16x8 __attribute__((ext_vector_type(8)));
typedef float f32x4 __attribute__((ext_vector_type(4)));
typedef float f32x16 __attribute__((ext_vector_type(16)));
typedef unsigned u32x4 __attribute__((ext_vector_type(4)));
typedef unsigned u32x2 __attribute__((ext_vector_type(2)));

constexpr int T = 16384, D = 2048, SEQ = 2048, NB = 8;
constexpr int NCOLS = 16896;
constexpr float ALPHA = 1.189207115002721f;
constexpr int NPH = 19;

constexpr size_t MiB = 1u << 20;
constexpr size_t WS_CTL = 0, WS_MEMB = 1 * MiB, WS_WKV = 9 * MiB, WS_LB = 11 * MiB, WS_MASK = 12 * MiB, WS_WIN = 17 * MiB,
                 WS_SLOT = 83 * MiB, SLOT_BYTES = 64 * MiB, WS_CKV = 595 * MiB, WS_IKW = 603 * MiB, WS_END = 611 * MiB;
constexpr int LDS_BYTES = 147456;

struct Args {
    const float* in[28];
    float* out;
    unsigned char* ws;
    int ph_lo, ph_hi;
};

#define WAVE_SYNC() asm volatile("s_waitcnt lgkmcnt(0)" ::: "memory")

__device__ __forceinline__ unsigned f2bf(float f) { unsigned u = __float_as_uint(f); return (u + 0x7fffu + ((u >> 16) & 1u)) >> 16; }
__device__ __forceinline__ unsigned pk2(float lo, float hi) { return f2bf(lo) | (f2bf(hi) << 16); }
__device__ __forceinline__ float bf2f(unsigned h) { return __uint_as_float(h << 16); }
__device__ __forceinline__ float bflo(unsigned w) { return __uint_as_float(w << 16); }
__device__ __forceinline__ float bfhi(unsigned w) { return __uint_as_float(w & 0xffff0000u); }
__device__ __forceinline__ float wave_sum(float v) {
#pragma unroll
    for (int o = 32; o >= 1; o >>= 1) v += __shfl_xor(v, o);
    return v;
}
__device__ __forceinline__ float wave_max(float v) {
#pragma unroll
    for (int o = 32; o >= 1; o >>= 1) v = fmaxf(v, __shfl_xor(v, o));
    return v;
}
__device__ __forceinline__ float sigm(float x) { return 1.0f / (1.0f + expf(-x)); }
__device__ __forceinline__ void unpack8(u32x4 w, float* f) {
    f[0] = bflo(w.x); f[1] = bfhi(w.x); f[2] = bflo(w.y); f[3] = bfhi(w.y); f[4] = bflo(w.z); f[5] = bfhi(w.z); f[6] = bflo(w.w); f[7] = bfhi(w.w);
}

__device__ __forceinline__ int fresh_lane() { int l; asm volatile("v_mbcnt_lo_u32_b32 %0, -1, 0\n\tv_mbcnt_hi_u32_b32 %0, -1, %0" : "=v"(l)); return l; }
struct Frame {
    unsigned char* lds;
    int wave, bid, G;
    __device__ __forceinline__ int lane() const { return fresh_lane(); }
    const Args* a;
    unsigned char* ws;
    __device__ __forceinline__ bf16* slot(int i) const { return (bf16*)(ws + WS_SLOT + (size_t)i * SLOT_BYTES); }
};

namespace pg8 {
#define PG8_LAS __attribute__((address_space(3)))
constexpr int BM = 256, BK = 64, HALF = 128, HTB = HALF * BK * 2, STAGE_BYTES = 8 * HTB, NXCD = 8, WGM = 8;
__host__ __device__ __forceinline__ int lds_byte(int r, int c) { const int st = (r >> 4) * 2 + (c >> 5), rr = r & 15, cc = c & 31, ob = rr * 64 + cc * 2; return st * 1024 + (ob ^ (((ob >> 9) & 1) << 5)); }
__host__ __device__ __forceinline__ void stage_rc(int b, int& R, int& C) { const int st = b / 1024, sb = b % 1024, swz = sb ^ (((sb >> 9) & 1) << 5); R = (st >> 1) * 16 + swz / 64; C = (st & 1) * 32 + (swz % 64) / 2; }
__host__ __device__ __forceinline__ int perm32(int rho) { const int n = rho >> 4, i = rho & 15; return 8 * (i >> 2) + 4 * n + (i & 3); }
struct Unit { int pm, pn, z; const char* a; const char* b; };
struct Gemm { int lda, ldb, K; };
__device__ __forceinline__ void tile_of(int wgid, int nM, int nN, int& pm, int& pn) {
    const int nwg = nM * nN; { const int q = nwg / NXCD, r = nwg % NXCD, xcd = wgid % NXCD, off = wgid / NXCD; wgid = (xcd < r ? xcd * (q + 1) : r * (q + 1) + (xcd - r) * q) + off; }
    const int nig = WGM * nN, gid = wgid / nig, fm = gid * WGM, gsz = (nM - fm) < WGM ? (nM - fm) : WGM;
    pm = fm + ((wgid % nig) % gsz); pn = (wgid % nig) / gsz;
}
struct Sub { const bf16* A; const bf16* Bt; int nM, nN; };
template <int NS> struct MultiOrder {
    Sub s[NS]; int lda, ldb, G, c;
    __device__ __forceinline__ bool next(int i, Unit& u) const {
        int L = i * G + c;
#pragma unroll
        for (int k = 0; k < NS; ++k) { const int n = s[k].nM * s[k].nN;
            if (L < n) { tile_of(L, s[k].nM, s[k].nN, u.pm, u.pn); u.z = k; u.a = (const char*)(s[k].A + (size_t)u.pm * BM * lda); u.b = (const char*)(s[k].Bt + (size_t)u.pn * BM * ldb); return true; }
            L -= n; }
        return false;
    }
};
template <class Off> struct BatchOrder {
    const bf16* A; const bf16* Bt; int nM, nN, nz, lda, ldb, G, c; Off off;
    __device__ __forceinline__ bool next(int i, Unit& u) const {
        const int L = i * G + c, per = nM * nN; if (L >= per * nz) return false;
        u.z = L / per; const int r = L % per; u.pn = r / nM; u.pm = r % nM;
        u.a = (const char*)(A + off.a(u.z) + (size_t)u.pm * BM * lda); u.b = (const char*)(Bt + off.b(u.z) + (size_t)u.pn * BM * ldb); return true;
    }
};
__device__ __forceinline__ unsigned cvt_pk_bf16(float lo, float hi) { unsigned r; asm volatile("v_cvt_pk_bf16_f32 %0, %1, %2" : "=v"(r) : "v"(lo), "v"(hi)); return r; }

template <class Op> struct Epi8 {
    static constexpr bool PERM = true;
    Op op;
    __device__ __forceinline__ void operator()(const f32x4 (&acc)[2][2][4][2], const Unit& u, int wr, int wc, int fr, int fq) const {
        const int row0 = u.pm * BM + wr * 64 + fr, col0 = u.pn * BM + wc * 32 + 8 * fq;
#pragma unroll
        for (int ai = 0; ai < 2; ++ai)
#pragma unroll
            for (int m = 0; m < 4; ++m)
#pragma unroll
                for (int bj = 0; bj < 2; ++bj) op(u.z, row0 + ai * HALF + m * 16, col0 + bj * HALF, acc[ai][bj][m][0], acc[ai][bj][m][1]);
    }
};

template <class Epi, class Sched, bool ALIGN_EPI>
__device__ __forceinline__ void gemm_phase(PG8_LAS unsigned char* lds, const Gemm g, const Sched& S, const Epi& E, int wid, int lane) {
    const int tid = wid * 64 + lane, wr = wid >> 2, wc = wid & 3, fr = lane & 15, fq = lane >> 4;
    const int K = g.K, nt = K / BK;
    unsigned voffA[2], voffB[2];
#pragma unroll
    for (int i = 0; i < 2; ++i) { int R, C; stage_rc(tid * 16 + i * 8192, R, C); const int Rb = Epi::PERM ? ((R & ~31) + perm32(R & 31)) : R;
        voffA[i] = (unsigned)(R * g.lda + C) * 2u; voffB[i] = (unsigned)(Rb * g.ldb + C) * 2u; }
    const size_t kstep = (size_t)(BK * 2);
    const size_t hstepA = (size_t)HALF * g.lda * 2, hstepB = (size_t)HALF * g.ldb * 2;
    const unsigned ldsw = (unsigned)wid * 1024u;
    const int aoff = lds_byte(wr * 64 + fr, fq * 8), boff = lds_byte(wc * 32 + fr, fq * 8);
#define PG8_SA(b, h) (((b) * 2 + (h)) * HTB)
#define PG8_SB(b, h) ((4 + (b) * 2 + (h)) * HTB)
#define PG8_STAGE(bufoff, gbase, voff) do { _Pragma("unroll") for (int _i = 0; _i < 2; ++_i) \
        __builtin_amdgcn_global_load_lds((const unsigned*)((const char*)(gbase) + (voff)[_i]), (PG8_LAS unsigned*)(lds + (bufoff) + ldsw + _i * 8192), 16, 0, 0); } while (0)
#define PG8_LDA(dst, b, h) do { _Pragma("unroll") for (int m = 0; m < 4; ++m) _Pragma("unroll") for (int k = 0; k < 2; ++k) dst[m][k] = *(const PG8_LAS bf16x8*)(lds + PG8_SA(b, h) + aoff + m * 2048 + k * 1024); } while (0)
#define PG8_LDB(dst, b, h) do { _Pragma("unroll") for (int n = 0; n < 2; ++n) _Pragma("unroll") for (int k = 0; k < 2; ++k) dst[n][k] = *(const PG8_LAS bf16x8*)(lds + PG8_SB(b, h) + boff + n * 2048 + k * 1024); } while (0)
#define PG8_MMA(ai, bj, At, Bt) do { __builtin_amdgcn_s_setprio(1); _Pragma("unroll") for (int m = 0; m < 4; ++m) _Pragma("unroll") for (int n = 0; n < 2; ++n) _Pragma("unroll") for (int k = 0; k < 2; ++k) \
        acc[ai][bj][m][n] = __builtin_amdgcn_mfma_f32_16x16x32_bf16(Bt[n][k], At[m][k], acc[ai][bj][m][n], 0, 0, 0); __builtin_amdgcn_s_setprio(0); } while (0)
#define PG8_WAIT_V(n) asm volatile("s_waitcnt vmcnt(" #n ")" ::: "memory")
#define PG8_WAIT_L(n) asm volatile("s_waitcnt lgkmcnt(" #n ")" ::: "memory")
#define PG8_BAR __builtin_amdgcn_s_barrier()
#define PG8_SCHED __builtin_amdgcn_sched_barrier(0)
    Unit cur, nxt; int ui = 0;
    if (!S.next(0, cur)) return;
    f32x4 acc[2][2][4][2];
#pragma unroll
    for (int a = 0; a < 2; ++a)
#pragma unroll
        for (int b = 0; b < 2; ++b)
#pragma unroll
            for (int m = 0; m < 4; ++m)
#pragma unroll
                for (int n = 0; n < 2; ++n) acc[a][b][m][n] = (f32x4){0.f, 0.f, 0.f, 0.f};
    bf16x8 At[4][2], B0[2][2], B1[2][2];
    const char* cA = cur.a; const char* cB = cur.b;
    PG8_STAGE(PG8_SB(0, 0), cB, voffB); PG8_STAGE(PG8_SB(0, 1), cB + hstepB, voffB); PG8_STAGE(PG8_SA(0, 0), cA, voffA); PG8_STAGE(PG8_SA(0, 1), cA + hstepA, voffA);
    if (wr == 1) PG8_BAR;
    PG8_WAIT_V(2); PG8_BAR;
    PG8_STAGE(PG8_SB(1, 0), cB + kstep, voffB); PG8_STAGE(PG8_SA(1, 0), cA + kstep, voffA); PG8_STAGE(PG8_SB(1, 1), cB + hstepB + kstep, voffB);
    PG8_WAIT_V(6); PG8_BAR;
    for (;;) {
        const bool has_next = S.next(ui + 1, nxt);
        const char* nA = has_next ? nxt.a : cA; const char* nB = has_next ? nxt.b : cB;
#pragma unroll 1
        for (int t = 0; t < nt; t += 2) {
            const bool last = (t == nt - 2);
            const char* a1 = cA + (size_t)(t + 1) * kstep;
            const char* a2 = last ? nA : cA + (size_t)(t + 2) * kstep; const char* b2 = last ? nB : cB + (size_t)(t + 2) * kstep;
            const char* a3 = a2 + kstep; const char* b3 = b2 + kstep;
            PG8_LDB(B0, 0, 0); PG8_LDB(B1, 0, 1); PG8_SCHED; PG8_LDA(At, 0, 0); PG8_STAGE(PG8_SA(1, 1), a1 + hstepA, voffA);
            PG8_WAIT_V(8); PG8_WAIT_L(0); PG8_BAR; PG8_MMA(0, 0, At, B0); PG8_MMA(0, 1, At, B1); PG8_BAR; PG8_SCHED;
            PG8_LDA(At, 0, 1); PG8_STAGE(PG8_SB(0, 0), b2, voffB); PG8_STAGE(PG8_SB(0, 1), b2 + hstepB, voffB); PG8_STAGE(PG8_SA(0, 0), a2, voffA);
            PG8_WAIT_V(8); PG8_WAIT_L(0); PG8_BAR; PG8_MMA(1, 0, At, B0); PG8_MMA(1, 1, At, B1); PG8_BAR; PG8_SCHED;
            PG8_LDB(B0, 1, 0); PG8_LDB(B1, 1, 1); PG8_SCHED; PG8_LDA(At, 1, 0); PG8_STAGE(PG8_SA(0, 1), a2 + hstepA, voffA);
            PG8_WAIT_V(8); PG8_WAIT_L(0); PG8_BAR; PG8_MMA(0, 0, At, B0); PG8_MMA(0, 1, At, B1); PG8_BAR; PG8_SCHED;
            PG8_LDA(At, 1, 1); PG8_STAGE(PG8_SB(1, 0), b3, voffB); PG8_STAGE(PG8_SB(1, 1), b3 + hstepB, voffB); PG8_STAGE(PG8_SA(1, 0), a3, voffA);
            PG8_WAIT_V(8); PG8_WAIT_L(0); PG8_BAR; PG8_MMA(1, 0, At, B0); PG8_MMA(1, 1, At, B1); PG8_BAR; PG8_SCHED;
        }
        if constexpr (ALIGN_EPI) { if (wr == 0) PG8_BAR; }
        E(acc, cur, wr, wc, fr, fq);
        if (!has_next) break;
#pragma unroll
        for (int a = 0; a < 2; ++a)
#pragma unroll
            for (int b = 0; b < 2; ++b)
#pragma unroll
                for (int m = 0; m < 4; ++m)
#pragma unroll
                    for (int n = 0; n < 2; ++n) acc[a][b][m][n] = (f32x4){0.f, 0.f, 0.f, 0.f};
        cur = nxt; cA = nA; cB = nB; ++ui;
        if constexpr (ALIGN_EPI) { if (wr == 1) PG8_BAR; }
    }
    PG8_WAIT_V(0);
    if constexpr (!ALIGN_EPI) { if (wr == 0) PG8_BAR; }
    PG8_BAR;
#undef PG8_SA
#undef PG8_SB
#undef PG8_STAGE
#undef PG8_LDA
#undef PG8_LDB
#undef PG8_MMA
#undef PG8_WAIT_V
#undef PG8_WAIT_L
#undef PG8_BAR
#undef PG8_SCHED
}
}

__device__ __forceinline__ u32x4 pack8(f32x4 a, f32x4 b) { u32x4 w; w.x = pg8::cvt_pk_bf16(a.x, a.y); w.y = pg8::cvt_pk_bf16(a.z, a.w); w.z = pg8::cvt_pk_bf16(b.x, b.y); w.w = pg8::cvt_pk_bf16(b.z, b.w); return w; }
__device__ __forceinline__ void unpack8v(u32x4 w, f32x4& a, f32x4& b) { a.x = bflo(w.x); a.y = bfhi(w.x); a.z = bflo(w.y); a.w = bfhi(w.y); b.x = bflo(w.z); b.y = bfhi(w.z); b.z = bflo(w.w); b.w = bfhi(w.w); }
__device__ __forceinline__ f32x4 sigm4(f32x4 v) { f32x4 r; r.x = sigm(v.x); r.y = sigm(v.y); r.z = sigm(v.z); r.w = sigm(v.w); return r; }

struct OpProj { unsigned char* ws;
    __device__ __forceinline__ void operator()(int z, int row, int col, f32x4 a, f32x4 b) const {
        bf16* p;
        if (col < 16384) p = (bf16*)(ws + WS_SLOT + (size_t)(col >> 11) * SLOT_BYTES) + (size_t)row * 2048 + (col & 2047);
        else if (col < 16640) p = (bf16*)(ws + WS_CKV) + (size_t)row * 256 + (col - 16384);
        else p = (bf16*)(ws + WS_IKW) + (size_t)row * 256 + (col - 16640);
        *(u32x4*)p = pack8(a, b);
    } };
struct OpBf16 { bf16* o; int ld;
    __device__ __forceinline__ void operator()(int z, int row, int col, f32x4 a, f32x4 b) const { *(u32x4*)(o + (size_t)row * ld + col) = pack8(a, b); } };
struct OpSplit2 { bf16* o0; bf16* o1;
    __device__ __forceinline__ void operator()(int z, int row, int col, f32x4 a, f32x4 b) const { bf16* p = (col < 2048 ? o0 : o1) + (size_t)row * 2048 + (col & 2047); *(u32x4*)p = pack8(a, b); } };
struct OpF32 { float* o; int ld;
    __device__ __forceinline__ void operator()(int z, int row, int col, f32x4 a, f32x4 b) const { float* p = o + (size_t)row * ld + col; *(f32x4*)p = a; *(f32x4*)(p + 4) = b; } };
struct OpYA { bf16* ga;
    __device__ __forceinline__ void operator()(int z, int row, int col, f32x4 a, f32x4 b) const { bf16* p = ga + (size_t)row * 2048 + col; f32x4 g0, g1; unpack8v(*(const u32x4*)p, g0, g1);
        *(u32x4*)p = pack8(sigm4(g0) * a, sigm4(g1) * b); } };
struct OpYB { bf16* ga; const bf16* gb;
    __device__ __forceinline__ void operator()(int z, int row, int col, f32x4 a, f32x4 b) const { const size_t i = (size_t)row * 2048 + col; f32x4 m0, m1, g0, g1; unpack8v(*(const u32x4*)(ga + i), m0, m1); unpack8v(*(const u32x4*)(gb + i), g0, g1);
        *(u32x4*)(ga + i) = pack8(m0 + sigm4(g0) * a, m1 + sigm4(g1) * b); } };
struct OpMix { const float* x; float* z;
    __device__ __forceinline__ void operator()(int zi, int row, int col, f32x4 a, f32x4 b) const { const size_t i = (size_t)row * 2048 + col; const f32x4 x0 = *(const f32x4*)(x + i), x1 = *(const f32x4*)(x + i + 4);
        *(f32x4*)(z + i) = ALPHA * x0 + a; *(f32x4*)(z + i + 4) = ALPHA * x1 + b; } };
struct OpRes { float* z;
    __device__ __forceinline__ void operator()(int zi, int row, int col, f32x4 a, f32x4 b) const { const size_t i = (size_t)row * 2048 + col; const f32x4 x0 = *(const f32x4*)(z + i), x1 = *(const f32x4*)(z + i + 4);
        *(f32x4*)(z + i) = ALPHA * x0 + a; *(f32x4*)(z + i + 4) = ALPHA * x1 + b; } };

template <class Op>
__device__ __forceinline__ void gemm(const Frame& F, const bf16* A, int lda, const bf16* Bt, int ldb, int M, int N, int K, const Op& op) {
    pg8::Gemm g{lda, ldb, K}; pg8::MultiOrder<1> S; S.s[0] = pg8::Sub{A, Bt, M / 256, N / 256}; S.lda = lda; S.ldb = ldb; S.G = F.G; S.c = F.bid;
    pg8::Epi8<Op> E{op};
    pg8::gemm_phase<pg8::Epi8<Op>, pg8::MultiOrder<1>, true>((PG8_LAS unsigned char*)F.lds, g, S, E, F.wave, F.lane());
}
template <int NS, class Op>
__device__ __forceinline__ void gemm_multi(const Frame& F, const pg8::MultiOrder<NS>& S, int K, const Op& op) {
    pg8::Gemm g{S.lda, S.ldb, K}; pg8::Epi8<Op> E{op};
    pg8::gemm_phase<pg8::Epi8<Op>, pg8::MultiOrder<NS>, true>((PG8_LAS unsigned char*)F.lds, g, S, E, F.wave, F.lane());
}
template <class Off, class Op>
__device__ __forceinline__ void gemm_batch(const Frame& F, const pg8::BatchOrder<Off>& S, int K, const Op& op) {
    pg8::Gemm g{S.lda, S.ldb, K}; pg8::Epi8<Op> E{op};
    pg8::gemm_phase<pg8::Epi8<Op>, pg8::BatchOrder<Off>, true>((PG8_LAS unsigned char*)F.lds, g, S, E, F.wave, F.lane());
}
struct OffS { __device__ __forceinline__ size_t a(int z) const { return (size_t)(z >> 2) * 2048 * 2048 + (z & 3) * 512; } __device__ __forceinline__ size_t b(int z) const { return (size_t)(z >> 2) * 256 * 2048 + (z & 3) * 512; } };
struct OffPV { __device__ __forceinline__ size_t a(int z) const { return (size_t)(z >> 2) * 2048 * 1024 + (z & 3) * 256; } __device__ __forceinline__ size_t b(int z) const { return (size_t)(z & 3) * 512 * 2048 + (z >> 2) * 256; } };
struct OpLogit { float* lg;
    __device__ __forceinline__ void operator()(int z, int row, int col, f32x4 a, f32x4 b) const { float* p = lg + ((size_t)(z >> 2) * 2048 + row) * 1024 + (z & 3) * 256 + col; *(f32x4*)p = a * 0.04419417382415922f; *(f32x4*)(p + 4) = b * 0.04419417382415922f; } };
struct OpCO { bf16* co;
    __device__ __forceinline__ void operator()(int z, int row, int col, f32x4 a, f32x4 b) const { *(u32x4*)(co + ((size_t)(z >> 2) * 2048 + row) * 2048 + (z & 3) * 512 + col) = pack8(a, b); } };
struct OpCQKV { bf16* cq; bf16* ck; bf16* vt;
    __device__ __forceinline__ void operator()(int z, int row, int col, f32x4 a, f32x4 b) const { bf16* o = z == 0 ? cq : (z == 1 ? ck : vt); *(u32x4*)(o + (size_t)row * 2048 + col) = pack8(a, b); } };
__device__ __forceinline__ void ph_xsoftmax(const Frame& F, const float* lg, bf16* P) {
    const int gw = F.bid * 8 + F.wave, NGW = F.G * 8, lane = F.lane();
    for (int u = gw; u < T * 4; u += NGW) {
        const f32x4 v = *(const f32x4*)(lg + (size_t)u * 256 + 4 * lane);
        const float m = wave_max(fmaxf(fmaxf(v.x, v.y), fmaxf(v.z, v.w)));
        const float e0 = expf(v.x - m), e1 = expf(v.y - m), e2 = expf(v.z - m), e3 = expf(v.w - m);
        const float inv = 1.0f / wave_sum((e0 + e1) + (e2 + e3));
        u32x2 w; w.x = pk2(e0 * inv, e1 * inv); w.y = pk2(e2 * inv, e3 * inv);
        *(u32x2*)(P + (size_t)u * 256 + 4 * lane) = w;
    }
}

template <class CM>
__device__ __forceinline__ void transpose_item(const float* W, size_t ldw, bf16* WT, size_t ldwt, int row_off, int nblk, int item, float* scr, int lane, const CM& cm) {
    const int kb = item / nblk, nb = item % nblk, k0 = 64 * kb, n0 = 32 * nb;
    const int c = cm(n0 + (lane & 31));
#pragma unroll 8
    for (int i = 0; i < 32; ++i) { const int kk = 2 * i + (lane >> 5); scr[kk * 33 + (lane & 31)] = (c >= 0) ? W[(size_t)(k0 + kk) * ldw + c] : 0.f; }
    WAVE_SYNC();
    const int c8 = lane & 7;
#pragma unroll
    for (int j = 0; j < 4; ++j) { const int n = (lane >> 3) + 8 * j; const float* s = scr + (8 * c8) * 33 + n;
        u32x4 o; o.x = pk2(s[0 * 33], s[1 * 33]); o.y = pk2(s[2 * 33], s[3 * 33]); o.z = pk2(s[4 * 33], s[5 * 33]); o.w = pk2(s[6 * 33], s[7 * 33]);
        *(u32x4*)(WT + (size_t)(row_off + n0 + n) * ldwt + k0 + 8 * c8) = o; }
    WAVE_SYNC();
}
struct CmIdent { __device__ __forceinline__ int operator()(int n) const { return n; } };
struct CmWin { __device__ __forceinline__ int operator()(int n) const {
    if (n < 10240) return n;
    if (n < 12288) return 10496 + (n - 10240);
    if (n < 14336) return 12688 + (n - 12288);
    if (n < 16384) return 14736 + (n - 14336);
    if (n < 16640) return 10240 + (n - 16384);
    if (n < 16768) return 12544 + (n - 16640);
    if (n < 16784) return 12672 + (n - 16768);
    return -1; } };

__device__ __forceinline__ void cvt_bf16_stream(const Frame& F, const float* src, bf16* dst, size_t n8) {
    const size_t gt = (size_t)F.bid * 512 + F.wave * 64 + F.lane(), NT = (size_t)F.G * 512;
    for (size_t i = gt; i < n8; i += NT) { const f32x4 a = ((const f32x4*)src)[2 * i], b = ((const f32x4*)src)[2 * i + 1];
        u32x4 o; o.x = pk2(a.x, a.y); o.y = pk2(a.z, a.w); o.z = pk2(b.x, b.y); o.w = pk2(b.z, b.w); ((u32x4*)dst)[i] = o; }
}

__device__ __forceinline__ void ph0_prologue(const Frame& F) {
    const Args& a = *F.a;
    cvt_bf16_stream(F, a.in[0], (bf16*)a.out, (size_t)T * D / 8);
    cvt_bf16_stream(F, a.in[1], (bf16*)(F.ws + WS_MEMB), (size_t)2048 * 2048 / 8);
    float* scr = (float*)(F.lds + F.wave * 16384);
    const int gw = F.bid * 8 + F.wave, NGW = F.G * 8, lane = F.lane();
    {
        const int nblk = NCOLS / 32, nitems = (2048 / 64) * nblk;
        for (int it = gw; it < nitems; it += NGW) transpose_item(a.in[2], 16784, (bf16*)(F.ws + WS_WIN), 2048, 0, nblk, it, scr, lane, CmWin());
    }
    {
        for (int it = gw; it < 32 * 16; it += NGW) { const int mat = it >> 4, which = mat >> 4, h = mat & 15;
            transpose_item(a.in[which ? 9 : 8] + (size_t)h * 256 * 128, 128, (bf16*)(F.ws + WS_WKV), 256, which * 2048 + h * 128, 4, it & 15, scr, lane, CmIdent()); }
    }
    {
        const int gt = F.bid * 512 + F.wave * 64 + lane;
        if (gt < 2048) { const float l0 = a.in[3][gt], l1 = a.in[3][2048 + gt]; ((float*)(F.ws + WS_LB))[gt] = 1.0f / (1.0f + expf(l1 - l0)); }
    }
}

namespace hg {
constexpr int QP = 272, TP = 144, AP = 144;
constexpr int OFF_QD = 0, OFF_KD = OFF_QD + 64 * QP, OFF_QG = OFF_KD + 64 * QP, OFF_KET = OFF_QG + 64 * QP, OFF_VT = OFF_KET + 128 * TP, OFF_A = OFF_VT + 128 * TP,
              OFF_TOT = OFF_A + 64 * AP, OFF_DEC = OFF_TOT + 4 * 128 * 4, OFF_PART = OFF_DEC + 128 * 4, OFF_RSTD = OFF_PART + 8 * 64 * 4, END = OFF_RSTD + 64 * 4;
static_assert(END <= 131072, "hgrn LDS map");
}
typedef short bf16x4 __attribute__((ext_vector_type(4)));
__device__ __forceinline__ void hgrn_chunked(const Frame& F, int unit) {
    using namespace hg;
    const Args& a = *F.a;
    const int b = unit >> 4, h = unit & 15, lane = F.lane(), w = F.wave, tid = w * 64 + lane, c = tid & 127, rq = tid >> 7, l15 = lane & 15, q4 = lane >> 4;
    unsigned char* L = F.lds;
    const size_t base = (size_t)b * 2048 * 2048 + h * 128;
    const bf16* HQ = F.slot(0) + base; const bf16* HF = F.slot(1) + base; const bf16* HI = F.slot(2) + base; const bf16* HG = F.slot(3) + base; bf16* HO = F.slot(0) + base;
    const float lb = ((const float*)(F.ws + WS_LB))[h * 128 + c];
    const float ng = a.in[4][h * 128 + 16 * w + l15];
    f32x4 S[8];
#pragma unroll
    for (int d = 0; d < 8; ++d) S[d] = (f32x4){0.f, 0.f, 0.f, 0.f};
    unsigned short rq_[16], rf_[16], rv_[16];
#pragma unroll
    for (int k = 0; k < 16; ++k) { const size_t o = (size_t)(16 * rq + k) * 2048 + c; rq_[k] = HQ[o]; rf_[k] = HF[o]; rv_[k] = HI[o]; }
    float* tot = (float*)(L + OFF_TOT); float* dec = (float*)(L + OFF_DEC); float* part = (float*)(L + OFF_PART); float* rstd = (float*)(L + OFF_RSTD);
#pragma unroll 1
    for (int ch = 0; ch < 32; ++ch) {
        const int r0 = ch * 64;
        unsigned short gq[16];
#pragma unroll
        for (int mt = 0; mt < 4; ++mt)
#pragma unroll
            for (int r = 0; r < 4; ++r) gq[4 * mt + r] = HG[(size_t)(r0 + 16 * mt + 4 * q4 + r) * 2048 + 16 * w + l15];
        float G[16], qf[16], kk[16];
        { float run = 0.f;
#pragma unroll
          for (int k = 0; k < 16; ++k) { const float f = lb + (1.0f - lb) / (1.0f + __expf(-bf2f(rf_[k]))); run += __logf(f); G[k] = run; kk[k] = 1.0f - f; qf[k] = bf2f(rq_[k]); } }
        tot[rq * 128 + c] = G[15];
        __syncthreads();
        const float t0 = tot[c], t1 = tot[128 + c], t2 = tot[256 + c], t3 = tot[384 + c];
        const float offs = (rq > 0 ? t0 : 0.f) + (rq > 1 ? t1 : 0.f) + (rq > 2 ? t2 : 0.f);
        const float Gref = t0 + t1, Glast = Gref + t2 + t3, eref = __expf(Gref), elr = __expf(Glast - Gref);
        if (rq == 0) dec[c] = __expf(Glast);
        unsigned kew[8], vw[8];
#pragma unroll
        for (int k = 0; k < 16; ++k) {
            const float e1 = __expf(G[k] + offs - Gref), qd = qf[k] * e1, kd = kk[k] * __builtin_amdgcn_rcpf(e1);
            const int row = 16 * rq + k;
            *(bf16*)(L + OFF_QD + row * QP + 2 * c) = (bf16)f2bf(qd);
            *(bf16*)(L + OFF_KD + row * QP + 2 * c) = (bf16)f2bf(kd);
            *(bf16*)(L + OFF_QG + row * QP + 2 * c) = (bf16)f2bf(qd * eref);
            const unsigned ke = f2bf(kd * elr);
            if (k & 1) { kew[k >> 1] |= ke << 16; vw[k >> 1] |= (unsigned)rv_[k] << 16; } else { kew[k >> 1] = ke; vw[k >> 1] = rv_[k]; }
        }
        *(u32x4*)(L + OFF_KET + c * TP + 32 * rq) = (u32x4){kew[0], kew[1], kew[2], kew[3]}; *(u32x4*)(L + OFF_KET + c * TP + 32 * rq + 16) = (u32x4){kew[4], kew[5], kew[6], kew[7]};
        *(u32x4*)(L + OFF_VT + c * TP + 32 * rq) = (u32x4){vw[0], vw[1], vw[2], vw[3]}; *(u32x4*)(L + OFF_VT + c * TP + 32 * rq + 16) = (u32x4){vw[4], vw[5], vw[6], vw[7]};
        if (ch + 1 < 32) {
#pragma unroll
            for (int k = 0; k < 16; ++k) { const size_t o = (size_t)(r0 + 64 + 16 * rq + k) * 2048 + c; rq_[k] = HQ[o]; rf_[k] = HF[o]; rv_[k] = HI[o]; } }
        __syncthreads();
        { const int mi = w >> 1;
#pragma unroll
          for (int tt = 0; tt < 2; ++tt) { const int nj = 2 * (w & 1) + tt; f32x4 acc = (f32x4){0.f, 0.f, 0.f, 0.f};
              if (nj <= mi) {
#pragma unroll
                  for (int ks = 0; ks < 4; ++ks) { const bf16x8 aF = *(const bf16x8*)(L + OFF_KD + (16 * nj + l15) * QP + 64 * ks + 16 * q4), bF = *(const bf16x8*)(L + OFF_QD + (16 * mi + l15) * QP + 64 * ks + 16 * q4);
                      acc = __builtin_amdgcn_mfma_f32_16x16x32_bf16(aF, bF, acc, 0, 0, 0); } }
              const int i = 16 * mi + l15, j0 = 16 * nj + 4 * q4;
              const float v0 = (j0 <= i) ? acc.x : 0.f, v1 = (j0 + 1 <= i) ? acc.y : 0.f, v2 = (j0 + 2 <= i) ? acc.z : 0.f, v3 = (j0 + 3 <= i) ? acc.w : 0.f;
              *(u32x2*)(L + OFF_A + i * AP + 2 * j0) = (u32x2){pk2(v0, v1), pk2(v2, v3)}; } }
        __syncthreads();
        bf16x8 bV[2];
#pragma unroll
        for (int ks = 0; ks < 2; ++ks) bV[ks] = *(const bf16x8*)(L + OFF_VT + (16 * w + l15) * TP + 64 * ks + 16 * q4);
        f32x4 O[4];
#pragma unroll
        for (int mt = 0; mt < 4; ++mt) { O[mt] = (f32x4){0.f, 0.f, 0.f, 0.f};
#pragma unroll
            for (int ks = 0; ks < 2; ++ks) { const bf16x8 aF = *(const bf16x8*)(L + OFF_A + (16 * mt + l15) * AP + 64 * ks + 16 * q4); O[mt] = __builtin_amdgcn_mfma_f32_16x16x32_bf16(aF, bV[ks], O[mt], 0, 0, 0); } }
#pragma unroll
        for (int kq = 0; kq < 4; ++kq) {
            u32x4 sw; sw.x = pk2(S[2 * kq].x, S[2 * kq].y); sw.y = pk2(S[2 * kq].z, S[2 * kq].w); sw.z = pk2(S[2 * kq + 1].x, S[2 * kq + 1].y); sw.w = pk2(S[2 * kq + 1].z, S[2 * kq + 1].w);
            const bf16x8 bS = __builtin_bit_cast(bf16x8, sw);
#pragma unroll
            for (int mt = 0; mt < 4; ++mt) { const unsigned char* qp = L + OFF_QG + (16 * mt + l15) * QP + 64 * kq + 8 * q4;
                const u32x2 lo = *(const u32x2*)qp, hi = *(const u32x2*)(qp + 32);
                const bf16x8 aF = __builtin_bit_cast(bf16x8, (u32x4){lo.x, lo.y, hi.x, hi.y});
                O[mt] = __builtin_amdgcn_mfma_f32_16x16x32_bf16(aF, bS, O[mt], 0, 0, 0); } }
#pragma unroll
        for (int dt = 0; dt < 8; ++dt) { const f32x4 dc = *(const f32x4*)(dec + 16 * dt + 4 * q4); S[dt] = S[dt] * dc;
#pragma unroll
            for (int ks = 0; ks < 2; ++ks) { const bf16x8 aF = *(const bf16x8*)(L + OFF_KET + (16 * dt + l15) * TP + 64 * ks + 16 * q4); S[dt] = __builtin_amdgcn_mfma_f32_16x16x32_bf16(aF, bV[ks], S[dt], 0, 0, 0); } }
#pragma unroll
        for (int mt = 0; mt < 4; ++mt)
#pragma unroll
            for (int r = 0; r < 4; ++r) { float p = O[mt][r] * O[mt][r]; p += __shfl_xor(p, 1); p += __shfl_xor(p, 2); p += __shfl_xor(p, 4); p += __shfl_xor(p, 8);
                if (l15 == 0) part[w * 64 + 16 * mt + 4 * q4 + r] = p; }
        __syncthreads();
        if (tid < 64) { float s = 0.f;
#pragma unroll
            for (int ww = 0; ww < 8; ++ww) s += part[ww * 64 + tid];
            rstd[tid] = rsqrtf(s * (1.0f / 128.0f) + 1e-6f); }
        __syncthreads();
#pragma unroll
        for (int mt = 0; mt < 4; ++mt) { const f32x4 rs = *(const f32x4*)(rstd + 16 * mt + 4 * q4);
#pragma unroll
            for (int r = 0; r < 4; ++r) { const float g = bf2f(gq[4 * mt + r]); const float o = O[mt][r] * rs[r] * ng * (g / (1.0f + __expf(-g)));
                HO[(size_t)(r0 + 16 * mt + 4 * q4 + r) * 2048 + 16 * w + l15] = (bf16)f2bf(o); } }
    }
    __syncthreads();
}

__device__ __forceinline__ void ph2_side(const Frame& F, int sid, int nside) {
    const Args& a = *F.a;
    const int gw = sid * 8 + F.wave, NGW = nside * 8, lane = F.lane();
    bf16* CKV = (bf16*)(F.ws + WS_CKV); bf16* IKW = (bf16*)(F.ws + WS_IKW);
    for (int row = gw; row < T; row += NGW) {
        {   u32x2 w = *(u32x2*)(CKV + (size_t)row * 256 + 4 * lane);
            float x0 = bflo(w.x), x1 = bfhi(w.x), x2 = bflo(w.y), x3 = bfhi(w.y);
            const float ss = wave_sum(x0 * x0 + x1 * x1 + x2 * x2 + x3 * x3);
            const float r = rsqrtf(ss * (1.0f / 256.0f) + 1e-6f);
            const f32x4 g = *(const f32x4*)(a.in[5] + 4 * lane);
            w.x = pk2(x0 * r * g.x, x1 * r * g.y); w.y = pk2(x2 * r * g.z, x3 * r * g.w);
            *(u32x2*)(CKV + (size_t)row * 256 + 4 * lane) = w; }
        {   unsigned w = *(unsigned*)(IKW + (size_t)row * 256 + 2 * lane);
            float x0 = bflo(w), x1 = bfhi(w);
            const float mu = wave_sum(x0 + x1) * (1.0f / 128.0f);
            x0 -= mu; x1 -= mu;
            const float var = wave_sum(x0 * x0 + x1 * x1) * (1.0f / 128.0f);
            const float r = rsqrtf(var + 1e-5f);
            const float g0 = a.in[6][2 * lane], g1 = a.in[6][2 * lane + 1], b0 = a.in[7][2 * lane], b1 = a.in[7][2 * lane + 1];
            *(unsigned*)(IKW + (size_t)row * 256 + 2 * lane) = pk2(x0 * r * g0 + b0, x1 * r * g1 + b1); }
    }
    float* scr = (float*)(F.lds + F.wave * 16384);
    for (int it = gw; it < 8 * 2048; it += NGW) { const int m = it >> 11;
        const float* wsrc = m == 0 ? a.in[11] : m == 1 ? a.in[12] : m == 2 ? a.in[13] : m == 3 ? a.in[16] : m == 4 ? a.in[17] : m == 5 ? a.in[18] : m == 6 ? a.in[19] : a.in[22];
        transpose_item(wsrc, 2048, (bf16*)(F.ws + WS_WIN + (size_t)m * 8 * MiB), 2048, 0, 64, it & 2047, scr, lane, CmIdent()); }
}

__device__ __forceinline__ void ph3_hgnorm(const Frame& F) {
    const Args& a = *F.a;
    const int gw = F.bid * 8 + F.wave, NGW = F.G * 8, lane = F.lane();
    const float* oraw = a.out; const bf16* HG = F.slot(3); bf16* HO = F.slot(0);
    for (int u = gw; u < T * 16; u += NGW) {
        const size_t off = (size_t)(u >> 4) * 2048 + (u & 15) * 128 + 2 * lane;
        const float o0 = oraw[off], o1 = oraw[off + 1];
        const float r = rsqrtf(wave_sum(o0 * o0 + o1 * o1) * (1.0f / 128.0f) + 1e-6f);
        const unsigned gw2 = *(const unsigned*)(HG + off);
        const float g0 = bflo(gw2), g1 = bfhi(gw2);
        const int c = (u & 15) * 128 + 2 * lane;
        *(unsigned*)(HO + off) = pk2(o0 * r * a.in[4][c] * (g0 * sigm(g0)), o1 * r * a.in[4][c + 1] * (g1 * sigm(g1)));
    }
}

__device__ __forceinline__ unsigned fkey(float f) { const unsigned u = __float_as_uint(f); return (u & 0x80000000u) ? ~u : (u | 0x80000000u); }
__device__ __forceinline__ void ph5_select(const Frame& F) {
    const int lane = F.lane(), l31 = lane & 31, half = lane >> 5, w = F.wave;
    float* scl = (float*)F.lds;
    const bf16* AIQ = F.slot(5); const bf16* IKW = (const bf16*)(F.ws + WS_IKW);
    unsigned* MASK = (unsigned*)(F.ws + WS_MASK);
    for (int i = F.bid; i < 1024; i += F.G) {
        const int r4 = i >> 8, c = i & 255, j = c & 127, b = 2 * r4 + (c >> 7), qt = (r4 & 1) ? 127 - j : j, t0 = qt * 16;
        bf16x8 Af[8];
        { const size_t rowA = (size_t)b * 2048 + t0 + 2 * w + ((l31 >> 2) & 1); const int headA = (l31 & 3) + 4 * (l31 >> 3);
#pragma unroll
          for (int ks = 0; ks < 8; ++ks) Af[ks] = *(const bf16x8*)(AIQ + rowA * 2048 + headA * 128 + 16 * ks + 8 * half); }
        float wr[16];
        { const bf16* wp = IKW + ((size_t)b * 2048 + t0 + 2 * w + half) * 256 + 128;
#pragma unroll
          for (int r = 0; r < 16; ++r) wr[r] = bf2f(wp[(r & 3) + 4 * (r >> 2)]) * (0.25f * 0.08838834764831845f); }
        const int nkt = (t0 + 15) / 32 + 1;
        const bf16* kbase = IKW + ((size_t)b * 2048 + l31) * 256 + 8 * half;
        bf16x8 Bf[8];
#pragma unroll
        for (int ks = 0; ks < 8; ++ks) Bf[ks] = *(const bf16x8*)(kbase + 16 * ks);
        for (int kt = 0; kt < nkt; ++kt) {
            f32x16 acc;
#pragma unroll
            for (int r = 0; r < 16; ++r) acc[r] = 0.f;
#pragma unroll
            for (int ks = 0; ks < 8; ++ks) acc = __builtin_amdgcn_mfma_f32_32x32x16_bf16(Af[ks], Bf[ks], acc, 0, 0, 0);
            if (kt + 1 < nkt) {
#pragma unroll
                for (int ks = 0; ks < 8; ++ks) Bf[ks] = *(const bf16x8*)(kbase + (size_t)(kt + 1) * 32 * 256 + 16 * ks); }
            float sc = 0.f;
#pragma unroll
            for (int r = 0; r < 16; ++r) sc += fmaxf(acc[r], 0.f) * wr[r];
            scl[(2 * w + half) * 2048 + kt * 32 + l31] = sc;
        }
        WAVE_SYNC();
#pragma unroll 1
        for (int qi = 0; qi < 2; ++qi) {
            const int t = t0 + 2 * w + qi; const float* row = scl + (2 * w + qi) * 2048;
            unsigned key[32];
#pragma unroll
            for (int jj = 0; jj < 32; ++jj) { const int s2 = lane + 64 * jj; key[jj] = (s2 <= t) ? fkey(row[s2]) : 0u; }
            unsigned thr = 0u;
            if (t + 1 > 256) {
                for (int bit = 31; bit >= 0; --bit) {
                    const unsigned cand = thr | (1u << bit);
                    int cnt = 0;
#pragma unroll
                    for (int jj = 0; jj < 32; ++jj) cnt += __popcll(__ballot(key[jj] >= cand));
                    if (cnt >= 256) { thr = cand; if (cnt == 256) break; }
                }
            }
            unsigned wd = 0u;
#pragma unroll
            for (int jj = 0; jj < 32; ++jj) { const int s2 = lane + 64 * jj; const unsigned long long m = __ballot(s2 <= t && key[jj] >= thr);
                if (lane == 2 * jj) wd = (unsigned)m; if (lane == 2 * jj + 1) wd = (unsigned)(m >> 32); }
            MASK[((size_t)b * 2048 + t) * 64 + lane] = wd;
        }
        WAVE_SYNC();
    }
}

__device__ __forceinline__ int t5_bucket(int d) {
    if (d < 16) return d;
    return 16 + (d >= 19) + (d >= 21) + (d >= 24) + (d >= 27) + (d >= 31) + (d >= 35) + (d >= 40) + (d >= 46) + (d >= 52) + (d >= 59) + (d >= 67) + (d >= 77) + (d >= 87) + (d >= 99) + (d >= 113);
}
namespace dsa {
constexpr float SCALE = 0.08838834764831845f;
constexpr int NW = 8, QBLK = 32, KVBLK = 64, QB = NW * QBLK, DH = 128, LD = 2048;
constexpr int SHM_V = KVBLK * DH * 2, SHM_K = KVBLK * DH * 2;
constexpr int OFF_WS = 2 * SHM_V + 2 * SHM_K, OFF_BIAS = OFF_WS + NW * 64 * 4, LDS_TOTAL = OFF_BIAS + 16 * 128 * 4;
constexpr float THR = 8.f;
typedef short s16x4 __attribute__((ext_vector_type(4)));
#define KSWZ(row, colB) ((row) * 256 + ((colB) ^ (((row) & 7) << 4)))
#define SBAR() __builtin_amdgcn_sched_barrier(0)
__device__ __forceinline__ int v_st(int k, int c) { const int kk = (k & ~0xC) | ((k & 4) << 1) | ((k & 8) >> 1); return ((kk >> 3) * 4 + (c >> 5)) * 512 + ((kk & 7) * 32 + (c & 31)) * 2; }
__device__ __forceinline__ int v_rd_base(int lane) { return ((lane & 3) << 3) | (((lane >> 2) & 3) << 6) | (((lane >> 4) & 1) << 5) | (((lane >> 5) & 1) << 8); }
constexpr int v_rd_off(int d0, int ks, int half) { return d0 * 512 + ks * 4096 + half * 2048; }
__device__ __forceinline__ int crow(int r, int hi) { return (r & 3) + 8 * (r >> 2) + 4 * hi; }
__device__ __forceinline__ unsigned cvtpk(float lo, float hi) { unsigned r; asm volatile("v_cvt_pk_bf16_f32 %0, %1, %2" : "=v"(r) : "v"(lo), "v"(hi)); return r; }
__device__ __forceinline__ bf16x8 load8(const bf16* p) { return *reinterpret_cast<const bf16x8*>(p); }
template <bool NEAR>
__device__ __forceinline__ void init_scores(f32x16& p0, f32x16& p1, unsigned w0, unsigned w1, int hi, int dq, const float* bl) {
    w0 >>= 4 * hi; w1 >>= 4 * hi;
#pragma unroll
    for (int r = 0; r < 16; ++r) { const int c = (r & 3) + 8 * (r >> 2);
        const int x0 = __builtin_amdgcn_sbfe(w0, c, 1), x1 = __builtin_amdgcn_sbfe(w1, c, 1);
        unsigned b0 = 0u, b1 = 0u;
        if (NEAR) { int d0 = dq - c, d1 = dq - c - 32; d0 = d0 < 0 ? 0 : (d0 > 127 ? 127 : d0); d1 = d1 < 0 ? 0 : (d1 > 127 ? 127 : d1);
            b0 = __float_as_uint(bl[d0]); b1 = __float_as_uint(bl[d1]); }
        p0[r] = __uint_as_float((b0 & (unsigned)x0) | (0xFF800000u & ~(unsigned)x0));
        p1[r] = __uint_as_float((b1 & (unsigned)x1) | (0xFF800000u & ~(unsigned)x1)); }
}
__device__ __forceinline__ void partialSM(f32x16& p0, f32x16& p1, float& m_reg, float& mn, float& alpha) {
    float pmax = p0[0];
#pragma unroll
    for (int r = 1; r < 16; ++r) pmax = fmaxf(pmax, p0[r]);
#pragma unroll
    for (int r = 0; r < 16; ++r) pmax = fmaxf(pmax, p1[r]);
    { auto rr = __builtin_amdgcn_permlane32_swap(__float_as_uint(pmax), __float_as_uint(pmax), false, false);
      pmax = fmaxf(__uint_as_float(rr[0]), __uint_as_float(rr[1])); }
    constexpr float C2 = 1.4426950408889634f * SCALE;
    if (__builtin_expect(__all((pmax - m_reg) * SCALE <= THR), 1)) { mn = m_reg; alpha = 1.f; }
    else { mn = fmaxf(m_reg, pmax); alpha = __builtin_amdgcn_exp2f((m_reg - mn) * C2); m_reg = mn; }
    const float mnL = -mn * C2;
#pragma unroll
    for (int r = 0; r < 16; ++r) p0[r] = fmaf(p0[r], C2, mnL);
#pragma unroll
    for (int r = 0; r < 16; ++r) p1[r] = fmaf(p1[r], C2, mnL);
#pragma unroll
    for (int r = 0; r < 16; ++r) p0[r] = __builtin_amdgcn_exp2f(p0[r]);
}
__device__ __forceinline__ void finishSM(f32x16& p0, f32x16& p1, float alpha, float& l_reg, bf16x8& pa0, bf16x8& pa1, bf16x8& pa2, bf16x8& pa3) {
#pragma unroll
    for (int r = 0; r < 16; ++r) p1[r] = __builtin_amdgcn_exp2f(p1[r]);
    float ps = 0;
#pragma unroll
    for (int r = 0; r < 16; ++r) ps += p0[r];
#pragma unroll
    for (int r = 0; r < 16; ++r) ps += p1[r];
    { auto rr = __builtin_amdgcn_permlane32_swap(__float_as_uint(ps), __float_as_uint(ps), false, false);
      ps = __uint_as_float(rr[0]) + __uint_as_float(rr[1]); }
    l_reg = l_reg * alpha + ps;
#define PK4(P, B_, OUT) do { unsigned a0 = cvtpk(P[B_+0], P[B_+1]), a1 = cvtpk(P[B_+2], P[B_+3]);                          \
        unsigned b0 = cvtpk(P[B_+4], P[B_+5]), b1 = cvtpk(P[B_+6], P[B_+7]);                                             \
        auto r0 = __builtin_amdgcn_permlane32_swap(a0, b0, false, false); auto r1 = __builtin_amdgcn_permlane32_swap(a1, b1, false, false); \
        u32x4 w = {r0[0], r1[0], r0[1], r1[1]}; OUT = *reinterpret_cast<bf16x8*>(&w); } while (0)
    PK4(p0, 0, pa0); PK4(p0, 8, pa1); PK4(p1, 0, pa2); PK4(p1, 8, pa3);
#undef PK4
}
template <int KB>
__device__ __forceinline__ void qkt(f32x16& p0, f32x16& p1, const char* K_lds, int r32, int hi, const bf16x8* qr) {
    const char* kb[4];
#pragma unroll
    for (int dd = 0; dd < 4; ++dd) kb[dd] = K_lds + KB * SHM_K + KSWZ(r32, (dd * 16 + hi * 8) * 2);
#pragma unroll
    for (int d0 = 0; d0 < 8; ++d0) { const char* a = kb[d0 & 3] + (d0 >> 2) * 128;
        bf16x8 b0 = *reinterpret_cast<const bf16x8*>(a);
        bf16x8 b1 = *reinterpret_cast<const bf16x8*>(a + 32 * 256);
        p0 = __builtin_amdgcn_mfma_f32_32x32x16_bf16(b0, qr[d0], p0, 0, 0, 0);
        p1 = __builtin_amdgcn_mfma_f32_32x32x16_bf16(b1, qr[d0], p1, 0, 0, 0); }
}
template <int VB>
__device__ __forceinline__ void pv_tile(f32x16* o, int vb0, bf16x8 pa0, bf16x8 pa1, bf16x8 pa2, bf16x8 pa3) {
#define TRRD(dst, off) asm volatile("ds_read_b64_tr_b16 %0, %1 offset:%2" : "=&v"(dst) : "v"(vb0), "i"(off) : "memory")
#define PV_D0(d0) do { s16x4 l0, l1, l2, l3, h0, h1, h2, h3; constexpr int b_ = VB * SHM_V + v_rd_off(d0, 0, 0); \
        TRRD(l0, b_); TRRD(h0, b_ + 2048); TRRD(l1, b_ + 4096); TRRD(h1, b_ + 6144); TRRD(l2, b_ + 8192); TRRD(h2, b_ + 10240); TRRD(l3, b_ + 12288); TRRD(h3, b_ + 14336); \
        asm volatile("s_waitcnt lgkmcnt(0)" ::: "memory"); SBAR();   \
        o[d0] = __builtin_amdgcn_mfma_f32_32x32x16_bf16(pa0, (bf16x8){l0[0], l0[1], l0[2], l0[3], h0[0], h0[1], h0[2], h0[3]}, o[d0], 0, 0, 0);   \
        o[d0] = __builtin_amdgcn_mfma_f32_32x32x16_bf16(pa1, (bf16x8){l1[0], l1[1], l1[2], l1[3], h1[0], h1[1], h1[2], h1[3]}, o[d0], 0, 0, 0);   \
        o[d0] = __builtin_amdgcn_mfma_f32_32x32x16_bf16(pa2, (bf16x8){l2[0], l2[1], l2[2], l2[3], h2[0], h2[1], h2[2], h2[3]}, o[d0], 0, 0, 0);   \
        o[d0] = __builtin_amdgcn_mfma_f32_32x32x16_bf16(pa3, (bf16x8){l3[0], l3[1], l3[2], l3[3], h3[0], h3[1], h3[2], h3[3]}, o[d0], 0, 0, 0); } while (0)
    PV_D0(0); PV_D0(1); PV_D0(2); PV_D0(3);
#undef PV_D0
#undef TRRD
}
struct BlockRef { const bf16* Q; const bf16* K; const bf16* V; bf16* O; const unsigned* M; int P0; int h; };
struct Seam { bf16x8 qr[8]; bf16x8 st_v0, st_v1, st_k0, st_k1; };
#define ROWU(p, k0) ((p) + (size_t)(k0) * LD)
#define VMW() asm volatile("s_waitcnt vmcnt(0)" ::: "memory")
#define VMWN(n) asm volatile("s_waitcnt vmcnt(%0)" :: "i"(n) : "memory")
#define SLOAD_H(Kp, Vp, k0) do { S.st_v0 = load8(ROWU(Vp, k0) + sofs); S.st_v1 = load8(ROWU(Vp, (k0) + 32) + sofs);              \
                         S.st_k0 = load8(ROWU(Kp, k0) + sofs); S.st_k1 = load8(ROWU(Kp, (k0) + 32) + sofs); } while (0)
#define SWRITE_HK(bf) do { *(bf16x8*)(K_lds + (bf) * SHM_K + kws) = S.st_k0; *(bf16x8*)(K_lds + (bf) * SHM_K + kws + 32 * 256) = S.st_k1; } while (0)
#define SWRITE_HV(bf) do { *(bf16x8*)(V_lds + (bf) * SHM_V + vst0) = S.st_v0; *(bf16x8*)(V_lds + (bf) * SHM_V + vst1) = S.st_v1; } while (0)
#define SWRITE_H(bf) do { SWRITE_HV(bf); SWRITE_HK(bf); } while (0)
__device__ __forceinline__ void prime(const BlockRef& cur, char* lds, Seam& S, int wid) {
    const int lane = fresh_lane(), tid = wid * 64 + lane, r32 = lane & 31, hi = lane >> 5;
    const int sr = tid >> 4, sc = (tid & 15) * 8, kws = KSWZ(sr, sc * 2); char* K_lds = lds + 2 * SHM_V; const unsigned sofs = (unsigned)(sr * LD + sc);
    const unsigned qofs = (unsigned)((wid * QBLK + r32) * LD + hi * 8);
#pragma unroll
    for (int d0 = 0; d0 < 8; ++d0) S.qr[d0] = load8(cur.Q + qofs + d0 * 16);
    SLOAD_H(cur.K, cur.V, 0); VMW(); SWRITE_HK(0);
    __syncthreads();
}
__device__ __forceinline__ void block(const BlockRef& cur, const BlockRef& nxt, char* lds, Seam& S, int wid) {
    const int lane = fresh_lane(), tid = wid * 64 + lane,
               r32 = lane & 31, hi = lane >> 5;
    const int NT = (cur.P0 + QB - 1) / KVBLK + 1;
    const int qlo = cur.P0 + wid * QBLK, qm = qlo + r32 - 4 * hi;
    char* V_lds = lds; char* K_lds = lds + 2 * SHM_V;
    float* ws = (float*)(lds + OFF_WS) + wid * 64; float* li_l = ws, * al_l = ws + 32;
    const float* bl = (const float*)(lds + OFF_BIAS) + cur.h * 128;
    const unsigned mofs = (unsigned)((wid * QBLK + r32) * 64);
    float m_reg = -1e30f, l_reg = 0; f32x16 o[4] = {};
    const int sr = tid >> 4, sc = (tid & 15) * 8, vst0 = v_st(sr, sc), vst1 = v_st(32 + sr, sc), kws = KSWZ(sr, sc * 2); const unsigned sofs = (unsigned)(sr * LD + sc);
    const int vb0 = (int)(uintptr_t)V_lds + v_rd_base(lane);
    const bf16* Kh = cur.K; const bf16* Vh = cur.V;
#define RESC(a) do { if (__any((a) < 1.f)) { if (hi == 0) al_l[r32] = (a); asm volatile("s_waitcnt lgkmcnt(0)" ::: "memory");              \
                     for (int d_ = 0; d_ < 4; ++d_) for (int r = 0; r < 16; ++r) o[d_][r] *= al_l[crow(r, hi)]; } } while (0)
#define KBASE(t) ((t) * KVBLK)
#define LDMASK(t) (*(const u32x2*)(cur.M + 2 * ((t) < 31 ? (t) : 31) + mofs))
#define INIT(P0_, P1_, t) do { const int kb_ = KBASE(t); if (qlo - kb_ - 63 < 113) init_scores<true>(P0_, P1_, mw.x, mw.y, hi, qm - kb_, bl); else init_scores<false>(P0_, P1_, mw.x, mw.y, hi, 0, bl); } while (0)
#define SEAM_K0() do { VMWN(8); SWRITE_HK(0); SBAR(); } while (0)
    f32x16 pA0, pA1, pB0, pB1; float mnA, mnB, alA, alB; bf16x8 pa0, pa1, pa2, pa3; u32x2 mw;
    SWRITE_HV(0); SBAR();
    if (NT > 1) { SLOAD_H(Kh, Vh, KBASE(1)); }
    mw = LDMASK(0); INIT(pA0, pA1, 0); mw = LDMASK(1);
    SBAR(); qkt<0>(pA0, pA1, K_lds, r32, hi, S.qr);
    partialSM(pA0, pA1, m_reg, mnA, alA);
    if (NT > 1) { VMW(); SWRITE_H(1); }
    __syncthreads();
#define HALF_STEP(PX0, PX1, mnX, alX, PY0, PY1, alY, t, KB, VB, SB) do {                                                      \
        INIT(PX0, PX1, (t)); mw = LDMASK((t) + 1);                                                                           \
        SBAR(); qkt<KB>(PX0, PX1, K_lds, r32, hi, S.qr);                                                                      \
        finishSM(PY0, PY1, alY, l_reg, pa0, pa1, pa2, pa3); SBAR();                                                           \
        if ((t) + 1 < NT) { SLOAD_H(Kh, Vh, KBASE((t) + 1)); SBAR(); }                                                        \
        pv_tile<VB>(o, vb0, pa0, pa1, pa2, pa3); partialSM(PX0, PX1, m_reg, mnX, alX);              \
        __syncthreads();                                                                                                      \
        if ((t) + 1 < NT) { VMW(); SWRITE_H(SB); }                                                                            \
        RESC(alX); __syncthreads(); } while (0)
    for (int t = 1; t + 1 < NT; t += 2) {
        HALF_STEP(pB0, pB1, mnB, alB, pA0, pA1, alA, t, 1, 0, 0);
        HALF_STEP(pA0, pA1, mnA, alA, pB0, pB1, alB, t + 1, 0, 1, 1);
    }
    const bool even = (NT & 1) == 0;
    if (even) { INIT(pB0, pB1, NT - 1); SBAR(); qkt<1>(pB0, pB1, K_lds, r32, hi, S.qr); SBAR(); }
    SLOAD_H(nxt.K, nxt.V, 0); SBAR();
#pragma unroll
    for (int d0 = 0; d0 < 8; ++d0) S.qr[d0] = load8(nxt.Q + (unsigned)((wid * QBLK + r32) * LD + hi * 8) + d0 * 16);
    SBAR();
    finishSM(pA0, pA1, alA, l_reg, pa0, pa1, pa2, pa3); SBAR();
    pv_tile<0>(o, vb0, pa0, pa1, pa2, pa3);
    if (even) { partialSM(pB0, pB1, m_reg, mnB, alB); __syncthreads(); RESC(alB);
        finishSM(pB0, pB1, alB, l_reg, pa0, pa1, pa2, pa3); SBAR(); pv_tile<1>(o, vb0, pa0, pa1, pa2, pa3); }
    SBAR(); SEAM_K0();
    if (hi == 0) li_l[r32] = l_reg; asm volatile("s_waitcnt lgkmcnt(0)" ::: "memory");
    float rli[16];
#pragma unroll
    for (int r = 0; r < 16; ++r) rli[r] = __builtin_amdgcn_rcpf(li_l[crow(r, hi)]);
    int lofs = 4 * hi * LD + r32; asm volatile("" : "+v"(lofs));
    bf16* Ow = cur.O + (size_t)(wid * QBLK) * LD + lofs;
#pragma unroll
    for (int r = 0; r < 16; ++r) { const int orow = (r & 3) + 8 * (r >> 2);
#pragma unroll
        for (int d0 = 0; d0 < 4; ++d0) { const float v = o[d0][r] * rli[r];
            const float vn = __shfl_xor(v, 1);
            if ((r32 & 1) == 0) *(unsigned*)(Ow + orow * LD + d0 * 32) = cvtpk(v, vn); } }
    __syncthreads();
#undef RESC
#undef KBASE
#undef LDMASK
#undef INIT
#undef SEAM_K0
#undef HALF_STEP
}
#undef ROWU
#undef VMW
#undef VMWN
#undef SLOAD_H
#undef SWRITE_HK
#undef SWRITE_HV
#undef SWRITE_H
#undef KSWZ
#undef SBAR
}

__device__ __forceinline__ dsa::BlockRef dsa_ref(const Frame& F, int bh, int qb) {
    const int b = bh >> 4, h = bh & 15;
    dsa::BlockRef r;
    r.Q = F.slot(4) + ((size_t)b * 2048 + (size_t)qb * 256) * 2048 + h * 128;
    r.O = F.slot(3) + ((size_t)b * 2048 + (size_t)qb * 256) * 2048 + h * 128;
    r.K = F.slot(1) + (size_t)b * 2048 * 2048 + h * 128; r.V = F.slot(2) + (size_t)b * 2048 * 2048 + h * 128;
    r.M = (const unsigned*)(F.ws + WS_MASK) + ((size_t)b * 2048 + (size_t)qb * 256) * 64;
    r.P0 = qb * 256; r.h = h;
    return r;
}
__device__ __forceinline__ void ph6_attn(const Frame& F) {
    const Args& a = *F.a;
    char* lds = (char*)F.lds;
    {
        float* bt = (float*)(lds + dsa::OFF_BIAS);
        for (int i = F.wave * 64 + F.lane(); i < 16 * 128; i += 512) { const int h = i >> 7, d = i & 127; bt[i] = (a.in[10][t5_bucket(d) * 16 + h] - a.in[10][31 * 16 + h]) * (1.0f / dsa::SCALE); }
    }
    __syncthreads();
    const int total = 4 * 128;
    int L = F.bid; if (L >= total) return;
    int pass = 0;
    dsa::BlockRef cur = dsa_ref(F, L >> 2, L & 3);
    dsa::Seam S;
    dsa::prime(cur, lds, S, F.wave);
    for (;;) {
        const bool more_pass = pass == 0, more_item = L + F.G < total, last = !more_pass && !more_item;
        int passn = pass + 1, Ln = L;
        if (!more_pass) { passn = 0; Ln = more_item ? L + F.G : L; }
        const dsa::BlockRef nxt = last ? cur : dsa_ref(F, Ln >> 2, passn ? 7 - (Ln & 3) : (Ln & 3));
        dsa::block(cur, nxt, lds, S, F.wave);
        if (last) break;
        cur = nxt; pass = passn; L = Ln;
    }
}

__device__ __forceinline__ void ln_row(float* zrow, const float* g, const float* bta, bf16* brow, int lane) {
    f32x4 v[8]; float s = 0.f;
#pragma unroll
    for (int i = 0; i < 8; ++i) { v[i] = *(const f32x4*)(zrow + 256 * i + 4 * lane); s += (v[i].x + v[i].y) + (v[i].z + v[i].w); }
    const float mu = wave_sum(s) * (1.0f / 2048.0f); float s2 = 0.f;
#pragma unroll
    for (int i = 0; i < 8; ++i) { v[i] = v[i] - mu; s2 += (v[i].x * v[i].x + v[i].y * v[i].y) + (v[i].z * v[i].z + v[i].w * v[i].w); }
    const float r = rsqrtf(wave_sum(s2) * (1.0f / 2048.0f) + 1e-5f);
#pragma unroll
    for (int i = 0; i < 8; ++i) { const f32x4 gg = *(const f32x4*)(g + 256 * i + 4 * lane), bb = *(const f32x4*)(bta + 256 * i + 4 * lane);
        const f32x4 o = v[i] * r * gg + bb; *(f32x4*)(zrow + 256 * i + 4 * lane) = o;
        if (brow) { u32x2 w; w.x = pk2(o.x, o.y); w.y = pk2(o.z, o.w); *(u32x2*)(brow + 256 * i + 4 * lane) = w; } }
}
__device__ __forceinline__ void ph_ln(const Frame& F, const float* g, const float* bta, bf16* bout) {
    const int gw = F.bid * 8 + F.wave, NGW = F.G * 8, lane = F.lane();
    for (int row = gw; row < T; row += NGW) ln_row(F.a->out + (size_t)row * 2048, g, bta, bout + (size_t)row * 2048, lane);
}

__device__ __forceinline__ float pk_idx(float v, unsigned code, unsigned mask) { return __uint_as_float((__float_as_uint(v) & ~mask) | code); }
__device__ __forceinline__ void ph_peer_select(const Frame& F) {
    const Args& a = *F.a;
    const int lane = F.lane(), l31 = lane & 31, half = lane >> 5;
    const float* PQ = (const float*)F.slot(1); const float* keys = a.in[23];
    int* EIDX = (int*)(F.ws + WS_CKV); float* EG = (float*)(F.ws + WS_IKW);
    const float NEG = -__builtin_inff();
    for (int tile = F.bid; tile < T / 32; tile += F.G) {
        const int h = F.wave, t = tile * 32 + l31;
        float tv[2][16];
#pragma unroll
        for (int p = 0; p < 2; ++p) {
            const int g = 2 * h + p;
            float qv[64];
            { const float* qp = PQ + (size_t)t * 2048 + g * 128 + 64 * half;
#pragma unroll
              for (int j = 0; j < 16; ++j) { const f32x4 v = *(const f32x4*)(qp + 4 * j); qv[4 * j] = v.x; qv[4 * j + 1] = v.y; qv[4 * j + 2] = v.z; qv[4 * j + 3] = v.w; } }
            f32x16 acc[4];
#pragma unroll
            for (int mt = 0; mt < 4; ++mt) {
#pragma unroll
                for (int r = 0; r < 16; ++r) acc[mt][r] = 0.f;
                const float* kp = keys + ((size_t)(g * 128 + mt * 32 + l31) * 128 + 64 * half);
#pragma unroll
                for (int j = 0; j < 16; ++j) { const f32x4 kv = *(const f32x4*)(kp + 4 * j);
                    acc[mt] = __builtin_amdgcn_mfma_f32_32x32x2f32(kv.x, qv[4 * j], acc[mt], 0, 0, 0); acc[mt] = __builtin_amdgcn_mfma_f32_32x32x2f32(kv.y, qv[4 * j + 1], acc[mt], 0, 0, 0);
                    acc[mt] = __builtin_amdgcn_mfma_f32_32x32x2f32(kv.z, qv[4 * j + 2], acc[mt], 0, 0, 0); acc[mt] = __builtin_amdgcn_mfma_f32_32x32x2f32(kv.w, qv[4 * j + 3], acc[mt], 0, 0, 0);
                    if ((j & 3) == 3) __builtin_amdgcn_sched_barrier(0); }
            }
            unsigned hmask = ~(4u * (unsigned)half); asm volatile("" : "+v"(hmask));
#pragma unroll
            for (int mt = 0; mt < 4; ++mt)
#pragma unroll
                for (int r = 0; r < 16; ++r) acc[mt][r] = __uint_as_float(((__float_as_uint(acc[mt][r]) & ~127u) | (unsigned)(127 - (32 * mt + (r & 3) + 8 * (r >> 2)))) & hmask);
#pragma unroll
            for (int k = 0; k < 16; ++k) {
                float m = acc[0][0];
#pragma unroll
                for (int mt = 0; mt < 4; ++mt)
#pragma unroll
                    for (int r = 0; r < 16; ++r) m = fmaxf(m, acc[mt][r]);
                m = fmaxf(m, __shfl_xor(m, 32));
                tv[p][k] = m;
#pragma unroll
                for (int mt = 0; mt < 4; ++mt)
#pragma unroll
                    for (int r = 0; r < 16; ++r) acc[mt][r] = (acc[mt][r] == m) ? NEG : acc[mt][r];
            }
        }
        float cand[25]; int cid[25];
        unsigned hc = 25u * (unsigned)half; asm volatile("" : "+v"(hc));
        { const float ai = half ? tv[0][2] : tv[0][0], bj = half ? tv[1][1] : tv[1][0];
          cand[0] = pk_idx(ai + bj, (unsigned)(63 - 0) - hc, 63u); cid[0] = (int)((127u - (__float_as_uint(ai) & 127u)) * 128u + (127u - (__float_as_uint(bj) & 127u))); }
        { const float ai = half ? tv[0][2] : tv[0][0], bj = half ? tv[1][2] : tv[1][1];
          cand[1] = pk_idx(ai + bj, (unsigned)(63 - 1) - hc, 63u); cid[1] = (int)((127u - (__float_as_uint(ai) & 127u)) * 128u + (127u - (__float_as_uint(bj) & 127u))); }
        { const float ai = half ? tv[0][2] : tv[0][0], bj = half ? tv[1][3] : tv[1][2];
          cand[2] = pk_idx(ai + bj, (unsigned)(63 - 2) - hc, 63u); cid[2] = (int)((127u - (__float_as_uint(ai) & 127u)) * 128u + (127u - (__float_as_uint(bj) & 127u))); }
        { const float ai = half ? tv[0][2] : tv[0][0], bj = half ? tv[1][4] : tv[1][3];
          cand[3] = pk_idx(ai + bj, (unsigned)(63 - 3) - hc, 63u); cid[3] = (int)((127u - (__float_as_uint(ai) & 127u)) * 128u + (127u - (__float_as_uint(bj) & 127u))); }
        { const float ai = half ? tv[0][3] : tv[0][0], bj = half ? tv[1][0] : tv[1][4];
          cand[4] = pk_idx(ai + bj, (unsigned)(63 - 4) - hc, 63u); cid[4] = (int)((127u - (__float_as_uint(ai) & 127u)) * 128u + (127u - (__float_as_uint(bj) & 127u))); }
        { const float ai = half ? tv[0][3] : tv[0][0], bj = half ? tv[1][1] : tv[1][5];
          cand[5] = pk_idx(ai + bj, (unsigned)(63 - 5) - hc, 63u); cid[5] = (int)((127u - (__float_as_uint(ai) & 127u)) * 128u + (127u - (__float_as_uint(bj) & 127u))); }
        { const float ai = half ? tv[0][3] : tv[0][0], bj = half ? tv[1][2] : tv[1][6];
          cand[6] = pk_idx(ai + bj, (unsigned)(63 - 6) - hc, 63u); cid[6] = (int)((127u - (__float_as_uint(ai) & 127u)) * 128u + (127u - (__float_as_uint(bj) & 127u))); }
        { const float ai = half ? tv[0][3] : tv[0][0], bj = half ? tv[1][3] : tv[1][7];
          cand[7] = pk_idx(ai + bj, (unsigned)(63 - 7) - hc, 63u); cid[7] = (int)((127u - (__float_as_uint(ai) & 127u)) * 128u + (127u - (__float_as_uint(bj) & 127u))); }
        { const float ai = half ? tv[0][4] : tv[0][0], bj = half ? tv[1][0] : tv[1][8];
          cand[8] = pk_idx(ai + bj, (unsigned)(63 - 8) - hc, 63u); cid[8] = (int)((127u - (__float_as_uint(ai) & 127u)) * 128u + (127u - (__float_as_uint(bj) & 127u))); }
        { const float ai = half ? tv[0][4] : tv[0][0], bj = half ? tv[1][1] : tv[1][9];
          cand[9] = pk_idx(ai + bj, (unsigned)(63 - 9) - hc, 63u); cid[9] = (int)((127u - (__float_as_uint(ai) & 127u)) * 128u + (127u - (__float_as_uint(bj) & 127u))); }
        { const float ai = half ? tv[0][4] : tv[0][0], bj = half ? tv[1][2] : tv[1][10];
          cand[10] = pk_idx(ai + bj, (unsigned)(63 - 10) - hc, 63u); cid[10] = (int)((127u - (__float_as_uint(ai) & 127u)) * 128u + (127u - (__float_as_uint(bj) & 127u))); }
        { const float ai = half ? tv[0][5] : tv[0][0], bj = half ? tv[1][0] : tv[1][11];
          cand[11] = pk_idx(ai + bj, (unsigned)(63 - 11) - hc, 63u); cid[11] = (int)((127u - (__float_as_uint(ai) & 127u)) * 128u + (127u - (__float_as_uint(bj) & 127u))); }
        { const float ai = half ? tv[0][5] : tv[0][0], bj = half ? tv[1][1] : tv[1][12];
          cand[12] = pk_idx(ai + bj, (unsigned)(63 - 12) - hc, 63u); cid[12] = (int)((127u - (__float_as_uint(ai) & 127u)) * 128u + (127u - (__float_as_uint(bj) & 127u))); }
        { const float ai = half ? tv[0][6] : tv[0][0], bj = half ? tv[1][0] : tv[1][13];
          cand[13] = pk_idx(ai + bj, (unsigned)(63 - 13) - hc, 63u); cid[13] = (int)((127u - (__float_as_uint(ai) & 127u)) * 128u + (127u - (__float_as_uint(bj) & 127u))); }
        { const float ai = half ? tv[0][6] : tv[0][0], bj = half ? tv[1][1] : tv[1][14];
          cand[14] = pk_idx(ai + bj, (unsigned)(63 - 14) - hc, 63u); cid[14] = (int)((127u - (__float_as_uint(ai) & 127u)) * 128u + (127u - (__float_as_uint(bj) & 127u))); }
        { const float ai = half ? tv[0][7] : tv[0][0], bj = half ? tv[1][0] : tv[1][15];
          cand[15] = pk_idx(ai + bj, (unsigned)(63 - 15) - hc, 63u); cid[15] = (int)((127u - (__float_as_uint(ai) & 127u)) * 128u + (127u - (__float_as_uint(bj) & 127u))); }
        { const float ai = half ? tv[0][7] : tv[0][1], bj = half ? tv[1][1] : tv[1][0];
          cand[16] = pk_idx(ai + bj, (unsigned)(63 - 16) - hc, 63u); cid[16] = (int)((127u - (__float_as_uint(ai) & 127u)) * 128u + (127u - (__float_as_uint(bj) & 127u))); }
        { const float ai = half ? tv[0][8] : tv[0][1], bj = half ? tv[1][0] : tv[1][1];
          cand[17] = pk_idx(ai + bj, (unsigned)(63 - 17) - hc, 63u); cid[17] = (int)((127u - (__float_as_uint(ai) & 127u)) * 128u + (127u - (__float_as_uint(bj) & 127u))); }
        { const float ai = half ? tv[0][9] : tv[0][1], bj = half ? tv[1][0] : tv[1][2];
          cand[18] = pk_idx(ai + bj, (unsigned)(63 - 18) - hc, 63u); cid[18] = (int)((127u - (__float_as_uint(ai) & 127u)) * 128u + (127u - (__float_as_uint(bj) & 127u))); }
        { const float ai = half ? tv[0][10] : tv[0][1], bj = half ? tv[1][0] : tv[1][3];
          cand[19] = pk_idx(ai + bj, (unsigned)(63 - 19) - hc, 63u); cid[19] = (int)((127u - (__float_as_uint(ai) & 127u)) * 128u + (127u - (__float_as_uint(bj) & 127u))); }
        { const float ai = half ? tv[0][11] : tv[0][1], bj = half ? tv[1][0] : tv[1][4];
          cand[20] = pk_idx(ai + bj, (unsigned)(63 - 20) - hc, 63u); cid[20] = (int)((127u - (__float_as_uint(ai) & 127u)) * 128u + (127u - (__float_as_uint(bj) & 127u))); }
        { const float ai = half ? tv[0][12] : tv[0][1], bj = half ? tv[1][0] : tv[1][5];
          cand[21] = pk_idx(ai + bj, (unsigned)(63 - 21) - hc, 63u); cid[21] = (int)((127u - (__float_as_uint(ai) & 127u)) * 128u + (127u - (__float_as_uint(bj) & 127u))); }
        { const float ai = half ? tv[0][13] : tv[0][1], bj = half ? tv[1][0] : tv[1][6];
          cand[22] = pk_idx(ai + bj, (unsigned)(63 - 22) - hc, 63u); cid[22] = (int)((127u - (__float_as_uint(ai) & 127u)) * 128u + (127u - (__float_as_uint(bj) & 127u))); }
        { const float ai = half ? tv[0][14] : tv[0][1], bj = half ? tv[1][0] : tv[1][7];
          cand[23] = pk_idx(ai + bj, (unsigned)(63 - 23) - hc, 63u); cid[23] = (int)((127u - (__float_as_uint(ai) & 127u)) * 128u + (127u - (__float_as_uint(bj) & 127u))); }
        { const float ai = half ? tv[0][15] : tv[0][2], bj = half ? tv[1][0] : tv[1][0];
          cand[24] = pk_idx(ai + bj, (unsigned)(63 - 24) - hc, 63u); cid[24] = (int)((127u - (__float_as_uint(ai) & 127u)) * 128u + (127u - (__float_as_uint(bj) & 127u))); }
        float sv[16]; int sid[16];
#pragma unroll
        for (int k = 0; k < 16; ++k) {
            float m = cand[0];
#pragma unroll
            for (int c = 1; c < 25; ++c) m = fmaxf(m, cand[c]);
            const float mo = __shfl_xor(m, 32);
            const bool mine = (m > mo) || (m == mo && half == 0);
            const float mm = fmaxf(m, mo);
            int id = -1;
#pragma unroll
            for (int c = 0; c < 25; ++c) { const bool hit = mine && (cand[c] == mm); id = hit ? cid[c] : id; cand[c] = hit ? NEG : cand[c]; }
            const int ido = __shfl_xor(id, 32);
            sv[k] = mm; sid[k] = id > ido ? id : ido;
        }
        float den = 0.f; float ev[16];
#pragma unroll
        for (int k = 0; k < 16; ++k) { ev[k] = expf(sv[k] - sv[0]); den += ev[k]; }
        const float inv = 1.0f / den;
        if (half == 0) { int* ep = EIDX + (size_t)t * 128 + h * 16;
#pragma unroll
            for (int k = 0; k < 16; k += 4) *(u32x4*)(ep + k) = (u32x4){(unsigned)sid[k], (unsigned)sid[k + 1], (unsigned)sid[k + 2], (unsigned)sid[k + 3]}; }
        else { float* gp = EG + (size_t)t * 128 + h * 16;
#pragma unroll
            for (int k = 0; k < 16; k += 4) *(f32x4*)(gp + k) = (f32x4){ev[k] * inv, ev[k + 1] * inv, ev[k + 2] * inv, ev[k + 3] * inv}; }
    }
}

typedef float f32x2 __attribute__((ext_vector_type(2)));
constexpr float PU_SCALE = 1024.0f, PV_SCALE = 32.0f;
#define RL(v, l) __builtin_amdgcn_readlane((v), (l))
#define EXR 4
#define EX_LOAD(buf, tab, idv, e) do { _Pragma("unroll") for (int r_ = 0; r_ < EXR; ++r_) { const unsigned char* rp_ = (tab) + (size_t)RL(idv, ((e) & 63) + r_) * 2048 + 16 * lane; \
        buf[r_][0] = *(const u32x4*)rp_; buf[r_][1] = *(const u32x4*)(rp_ + 1024); } } while (0)
#define EX_W4(acc_, w_, xp_) do { const f32x2 l_ = __builtin_amdgcn_cvt_pk_f32_fp8((int)(w_), false), h_ = __builtin_amdgcn_cvt_pk_f32_fp8((int)(w_), true); \
        acc_ += l_.x * (xp_)[0] + l_.y * (xp_)[1]; acc_ += h_.x * (xp_)[2] + h_.y * (xp_)[3]; } while (0)
#define EX_DOT(buf, e) do { float d_[EXR]; _Pragma("unroll") for (int r_ = 0; r_ < EXR; ++r_) { float a_ = 0.f, b_ = 0.f; \
        _Pragma("unroll") for (int c_ = 0; c_ < 2; ++c_) { EX_W4(a_, buf[r_][c_].x, &xf[c_][0]); EX_W4(b_, buf[r_][c_].y, &xf[c_][4]); EX_W4(a_, buf[r_][c_].z, &xf[c_][8]); EX_W4(b_, buf[r_][c_].w, &xf[c_][12]); } d_[r_] = a_ + b_; } \
        _Pragma("unroll") for (int o_ = 32; o_ >= 1; o_ >>= 1) { _Pragma("unroll") for (int r_ = 0; r_ < EXR; ++r_) d_[r_] += __shfl_xor(d_[r_], o_); } \
        _Pragma("unroll") for (int r_ = 0; r_ < EXR; ++r_) { const float pre_ = d_[r_] * (1.0f / PU_SCALE); const float hv_ = 0.5f * pre_ * (1.0f + erff(pre_ * 0.7071067811865476f)); \
            if (lane == (((e) & 63) + r_)) { if ((e) < 64) c0 = g0 * hv_; else c1 = g1 * hv_; } } } while (0)
#define EX_A4(w_, yp_, cf_) do { const f32x2 l_ = __builtin_amdgcn_cvt_pk_f32_fp8((int)(w_), false), h_ = __builtin_amdgcn_cvt_pk_f32_fp8((int)(w_), true); \
        (yp_)[0] += (cf_) * l_.x; (yp_)[1] += (cf_) * l_.y; (yp_)[2] += (cf_) * h_.x; (yp_)[3] += (cf_) * h_.y; } while (0)
#define EX_AXPY(buf, e) do { const float cv_ = (e) < 64 ? c0 : c1; _Pragma("unroll") for (int r_ = 0; r_ < EXR; ++r_) { const float cf_ = __int_as_float(RL(__float_as_int(cv_), ((e) & 63) + r_)) * (1.0f / PV_SCALE); \
        _Pragma("unroll") for (int c_ = 0; c_ < 2; ++c_) { EX_A4(buf[r_][c_].x, &y[c_][0], cf_); EX_A4(buf[r_][c_].y, &y[c_][4], cf_); EX_A4(buf[r_][c_].z, &y[c_][8], cf_); EX_A4(buf[r_][c_].w, &y[c_][12], cf_); } } } while (0)
__device__ __forceinline__ void cvt_fp8_stream(const Frame& F, const float* src, unsigned char* dst, size_t n16, float scale) {
    const size_t gt = (size_t)F.bid * 512 + F.wave * 64 + F.lane(), NT = (size_t)F.G * 512;
    for (size_t i = gt; i < n16; i += NT) { const f32x4 a = ((const f32x4*)src)[4 * i] * scale, b = ((const f32x4*)src)[4 * i + 1] * scale, c = ((const f32x4*)src)[4 * i + 2] * scale, d = ((const f32x4*)src)[4 * i + 3] * scale;
        int w0 = 0, w1 = 0, w2 = 0, w3 = 0;
        w0 = __builtin_amdgcn_cvt_pk_fp8_f32(a.x, a.y, w0, false); w0 = __builtin_amdgcn_cvt_pk_fp8_f32(a.z, a.w, w0, true);
        w1 = __builtin_amdgcn_cvt_pk_fp8_f32(b.x, b.y, w1, false); w1 = __builtin_amdgcn_cvt_pk_fp8_f32(b.z, b.w, w1, true);
        w2 = __builtin_amdgcn_cvt_pk_fp8_f32(c.x, c.y, w2, false); w2 = __builtin_amdgcn_cvt_pk_fp8_f32(c.z, c.w, w2, true);
        w3 = __builtin_amdgcn_cvt_pk_fp8_f32(d.x, d.y, w3, false); w3 = __builtin_amdgcn_cvt_pk_fp8_f32(d.z, d.w, w3, true);
        ((u32x4*)dst)[i] = (u32x4){(unsigned)w0, (unsigned)w1, (unsigned)w2, (unsigned)w3}; }
}
__device__ __forceinline__ void ph16_experts(const Frame& F) {
    const Args& a = *F.a;
    const int gw = F.bid * 8 + F.wave, NGW = F.G * 8, lane = F.lane();
    const int* EIDX = (const int*)(F.ws + WS_CKV); const float* EG = (const float*)(F.ws + WS_IKW);
    const unsigned char* PU = (const unsigned char*)F.slot(5); const unsigned char* PV = PU + (size_t)32 * MiB;
    for (int t = gw; t < T; t += NGW) {
        float* xrow = a.out + (size_t)t * 2048;
        float xf[2][16];
#pragma unroll
        for (int c = 0; c < 2; ++c)
#pragma unroll
            for (int q = 0; q < 4; ++q) { const f32x4 v = *(const f32x4*)(xrow + 1024 * c + 16 * lane + 4 * q); xf[c][4 * q] = v.x; xf[c][4 * q + 1] = v.y; xf[c][4 * q + 2] = v.z; xf[c][4 * q + 3] = v.w; }
        const int id0 = EIDX[(size_t)t * 128 + lane], id1 = EIDX[(size_t)t * 128 + 64 + lane];
        const float g0 = EG[(size_t)t * 128 + lane], g1 = EG[(size_t)t * 128 + 64 + lane];
        float c0 = 0.f, c1 = 0.f;
        u32x4 bA[EXR][2], bB[EXR][2];
        EX_LOAD(bA, PU, id0, 0);
        for (int e = 0; e < 128; e += 2 * EXR) {
            const int idv = e < 64 ? id0 : id1;
            EX_LOAD(bB, PU, idv, e + EXR);
            EX_DOT(bA, e);
            if (e + 2 * EXR < 128) { const int idn = (e + 2 * EXR) < 64 ? id0 : id1; EX_LOAD(bA, PU, idn, e + 2 * EXR); }
            EX_DOT(bB, e + EXR);
        }
        float y[2][16];
#pragma unroll
        for (int c = 0; c < 2; ++c)
#pragma unroll
            for (int j = 0; j < 16; ++j) y[c][j] = 0.f;
        EX_LOAD(bA, PV, id0, 0);
        for (int e = 0; e < 128; e += 2 * EXR) {
            const int idv = e < 64 ? id0 : id1;
            EX_LOAD(bB, PV, idv, e + EXR);
            EX_AXPY(bA, e);
            if (e + 2 * EXR < 128) { const int idn = (e + 2 * EXR) < 64 ? id0 : id1; EX_LOAD(bA, PV, idn, e + 2 * EXR); }
            EX_AXPY(bB, e + EXR);
        }
        float s = 0.f;
#pragma unroll
        for (int c = 0; c < 2; ++c)
#pragma unroll
            for (int j = 0; j < 16; ++j) { y[c][j] += ALPHA * xf[c][j]; s += y[c][j]; }
        const float mu = wave_sum(s) * (1.0f / 2048.0f); float s2 = 0.f;
#pragma unroll
        for (int c = 0; c < 2; ++c)
#pragma unroll
            for (int j = 0; j < 16; ++j) { y[c][j] -= mu; s2 += y[c][j] * y[c][j]; }
        const float rs = rsqrtf(wave_sum(s2) * (1.0f / 2048.0f) + 1e-5f);
        int lofs = 16 * lane; asm volatile("" : "+v"(lofs));
#pragma unroll
        for (int c = 0; c < 2; ++c)
#pragma unroll
            for (int q = 0; q < 4; ++q) { const int col = 1024 * c + lofs + 4 * q;
                const f32x4 ga = *(const f32x4*)(a.in[26] + col), ba = *(const f32x4*)(a.in[27] + col);
                f32x4 o; o.x = y[c][4 * q] * rs * ga.x + ba.x; o.y = y[c][4 * q + 1] * rs * ga.y + ba.y; o.z = y[c][4 * q + 2] * rs * ga.z + ba.z; o.w = y[c][4 * q + 3] * rs * ga.w + ba.w;
                *(f32x4*)(xrow + col) = o; }
    }
}

#define XB_TMO      128
#define XB_XCNT(j)  (256  + 64 * (j))
#define XB_XSUB(j)  (1280 + 64 * (j))
#define XB_XGEN(j)  (2304 + 64 * (j))
#define XB_TOP      3328
#define XB_TOPGEN   3392
#define XCD_BAR_WORDS 3456
#define XB_SPIN_CAP (1u << 22)
__device__ __forceinline__ unsigned xb_ld(unsigned* p)              { return __hip_atomic_load(p, __ATOMIC_RELAXED, __HIP_MEMORY_SCOPE_AGENT); }
__device__ __forceinline__ unsigned xb_add(unsigned* p, unsigned v) { return __hip_atomic_fetch_add(p, v, __ATOMIC_RELAXED, __HIP_MEMORY_SCOPE_AGENT); }
__device__ __forceinline__ unsigned xb_xcc_id() { return (unsigned)__builtin_amdgcn_s_getreg((3 << 11) | 20) & 0xFu; }
#define XB_SPIN(cond, bar) do { unsigned _sp = 0; while (cond) { __builtin_amdgcn_s_sleep(1); \
    if ((++_sp & 255u) == 0u) { if (xb_ld(&(bar)[XB_TMO])) break; if (_sp > XB_SPIN_CAP) { atomicAdd(&(bar)[XB_TMO], 1u); break; } } } } while (0)
__device__ __forceinline__ unsigned long long rt_now() { unsigned long long t; asm volatile("s_memrealtime %0\n\ts_waitcnt lgkmcnt(0)" : "=s"(t) :: "memory"); return t; }
struct XcdBarrier { unsigned* bar; unsigned x; volatile unsigned* st; };
__device__ __forceinline__ void xcd_barrier_complete(unsigned* bar, unsigned x, unsigned G, unsigned& nloc, unsigned& nx) {
    unsigned sum, cnt, mine, sp = 0u;
    for (;;) {
        sum = 0u; cnt = 0u; mine = 0u;
#pragma unroll
        for (unsigned j = 0; j < 16; ++j) { const unsigned c = xb_ld(&bar[XB_XCNT(j)]); sum += c; cnt += (c > 0u) ? 1u : 0u; mine = (j == x) ? c : mine; }
        if (sum == G) break;
        __builtin_amdgcn_s_sleep(1);
        if ((++sp & 255u) == 0u) { if (xb_ld(&bar[XB_TMO])) break; if (sp > XB_SPIN_CAP) { atomicAdd(&bar[XB_TMO], 1u); break; } }
    }
    nloc = mine > 0u ? mine : 1u; nx = cnt > 0u ? cnt : 1u;
}
__device__ __forceinline__ void xcd_barrier(const XcdBarrier& b, bool leader, unsigned G) {
    asm volatile("s_waitcnt vmcnt(0)" ::: "memory");
    __syncthreads();
    if (leader) {
        unsigned* bar = b.bar;
        __builtin_amdgcn_s_waitcnt(0);
        unsigned nloc = b.st[0], nx = b.st[1];
        if (nloc == 0u) { xcd_barrier_complete(bar, b.x, G, nloc, nx); b.st[0] = nloc; b.st[1] = nx; }
        const unsigned old = xb_add(&bar[XB_XSUB(b.x)], 1u);
        const unsigned gen = old / nloc;
        if (old + 1u == (gen + 1u) * nloc) {
            __builtin_amdgcn_fence(__ATOMIC_RELEASE, "agent");
            asm volatile("s_waitcnt vmcnt(0)" ::: "memory");
            const unsigned og = xb_add(&bar[XB_TOP], 1u);
            const unsigned tg = og / nx;
            if (og + 1u == (tg + 1u) * nx) xb_add(&bar[XB_TOPGEN], 1u);
            else XB_SPIN(xb_ld(&bar[XB_TOPGEN]) == tg, bar);
            __builtin_amdgcn_fence(__ATOMIC_ACQUIRE, "agent");
            xb_add(&bar[XB_XGEN(b.x)], 1u);
            asm volatile("s_waitcnt vmcnt(0)" ::: "memory");
        } else {
            XB_SPIN(xb_ld(&bar[XB_XGEN(b.x)]) == gen, bar);
            __builtin_amdgcn_fence(__ATOMIC_ACQUIRE, "agent");
            asm volatile("s_waitcnt vmcnt(0)" ::: "memory");
        }
    }
    __syncthreads();
}

__global__ void __launch_bounds__(512, 2) mega(Args args) {
    extern __shared__ __attribute__((aligned(16))) unsigned char lds[];
    cg::grid_group grid = cg::this_grid();
    Frame F;
    F.lds = lds; F.wave = __builtin_amdgcn_readfirstlane(threadIdx.x >> 6); F.bid = blockIdx.x; F.G = gridDim.x;
    F.a = &args; F.ws = args.ws;
    const int lo = args.ph_lo, hi = args.ph_hi;
    volatile unsigned* xst = (volatile unsigned*)(lds + LDS_BYTES - 64);
    const bool leader = (F.wave == 0) && (fresh_lane() == 0);
    if (leader) { xst[0] = 0u; xst[1] = 0u; }
    XcdBarrier xbar; xbar.bar = (unsigned*)(F.ws + WS_CTL) + 4096; xbar.x = xb_xcc_id(); xbar.st = xst;
    if (leader) (void)xb_add(&xbar.bar[XB_XCNT(xbar.x)], 1u);
    __syncthreads();
    bf16* W8 = (bf16*)(F.ws + WS_WIN);
#define IN(k) (lo <= (k) && (k) < hi)
#if PROBE_MASK
    unsigned long long pr_acc = 0ull, pr_t0 = rt_now();
#define SEAM(k) do { if (IN(k) && IN((k) + 1)) { if ((k) == 0) grid.sync(); else xcd_barrier(xbar, (F.wave == 0) && (fresh_lane() == 0), (unsigned)F.G); } { const unsigned long long t1_ = rt_now(); if ((PROBE_MASK >> (k)) & 1u) pr_acc += t1_ - pr_t0; pr_t0 = t1_; } } while (0)
#else
#define SEAM(k) do { if (IN(k) && IN((k) + 1)) { if ((k) == 0) grid.sync(); else xcd_barrier(xbar, (F.wave == 0) && (fresh_lane() == 0), (unsigned)F.G); } } while (0)
#endif
    if (IN(0)) { ph0_prologue(F); } SEAM(0);
    if (IN(1)) { gemm(F, (const bf16*)args.out, 2048, (const bf16*)(F.ws + WS_WIN), 2048, T, NCOLS, 2048, OpProj{F.ws}); } SEAM(1);
    if (IN(2)) {
        for (int u = F.bid; u < 128; u += F.G) hgrn_chunked(F, u);
        if (F.G > 128) { if (F.bid >= 128) ph2_side(F, F.bid - 128, F.G - 128); } else ph2_side(F, F.bid, F.G);
    } SEAM(2);
    if (IN(4)) {
        gemm(F, F.slot(0), 2048, W8, 2048, T, 2048, 2048, OpYA{F.slot(6)});
        gemm(F, (const bf16*)(F.ws + WS_CKV), 256, (const bf16*)(F.ws + WS_WKV), 256, T, 4096, 256, OpSplit2{F.slot(1), F.slot(2)});
    } SEAM(4);
    if (IN(5)) { ph5_select(F); } SEAM(5);
    if (IN(6)) { ph6_attn(F); } SEAM(6);
    if (IN(7)) { gemm(F, F.slot(3), 2048, W8 + (size_t)1 * 2048 * 2048, 2048, T, 2048, 2048, OpYB{F.slot(6), F.slot(7)}); } SEAM(7);
    if (IN(8)) { gemm(F, F.slot(6), 2048, W8 + (size_t)2 * 2048 * 2048, 2048, T, 2048, 2048, OpMix{args.in[0], args.out}); } SEAM(8);
    if (IN(9)) { ph_ln(F, args.in[14], args.in[15], F.slot(0)); } SEAM(9);
    if (IN(10)) {
        pg8::MultiOrder<3> S; S.lda = 2048; S.ldb = 2048; S.G = F.G; S.c = F.bid;
        S.s[0] = pg8::Sub{F.slot(0), W8 + (size_t)3 * 2048 * 2048, 64, 8};
        S.s[1] = pg8::Sub{(const bf16*)(F.ws + WS_MEMB), W8 + (size_t)4 * 2048 * 2048, 8, 8};
        S.s[2] = pg8::Sub{W8 + (size_t)5 * 2048 * 2048, (const bf16*)(F.ws + WS_MEMB), 8, 8};
        gemm_multi<3>(F, S, 2048, OpCQKV{F.slot(1), (bf16*)(F.ws + WS_CKV), (bf16*)(F.ws + WS_IKW)});
    } SEAM(10);
    if (IN(11)) {
        pg8::BatchOrder<OffS> S{F.slot(1), (const bf16*)(F.ws + WS_CKV), 8, 1, 32, 2048, 2048, F.G, F.bid, OffS()};
        gemm_batch(F, S, 512, OpLogit{(float*)F.slot(2)});
    } SEAM(11);
    if (IN(12)) { ph_xsoftmax(F, (const float*)F.slot(2), F.slot(3)); } SEAM(12);
    if (IN(13)) {
        pg8::BatchOrder<OffPV> S{F.slot(3), (const bf16*)(F.ws + WS_IKW), 8, 2, 32, 1024, 2048, F.G, F.bid, OffPV()};
        gemm_batch(F, S, 256, OpCO{F.slot(4)});
    } SEAM(13);
    if (IN(14)) { gemm(F, F.slot(4), 2048, W8 + (size_t)6 * 2048 * 2048, 2048, T, 2048, 2048, OpRes{args.out}); } SEAM(14);
    if (IN(15)) { ph_ln(F, args.in[20], args.in[21], F.slot(0));
        cvt_fp8_stream(F, args.in[24], (unsigned char*)F.slot(5), (size_t)16384 * 2048 / 16, PU_SCALE); cvt_fp8_stream(F, args.in[25], (unsigned char*)F.slot(5) + (size_t)32 * MiB, (size_t)16384 * 2048 / 16, PV_SCALE); } SEAM(15);
    if (IN(16)) { gemm(F, F.slot(0), 2048, W8 + (size_t)7 * 2048 * 2048, 2048, T, 2048, 2048, OpF32{(float*)F.slot(1), 2048}); } SEAM(16);
    if (IN(17)) { ph_peer_select(F); } SEAM(17);
    if (IN(18)) { ph16_experts(F); }
#if PROBE_MASK
    xcd_barrier(xbar, (F.wave == 0) && (fresh_lane() == 0), (unsigned)F.G);
    { const unsigned long long t1_ = rt_now(); if ((PROBE_MASK >> 18) & 1u) pr_acc += t1_ - pr_t0;
      if (F.bid == 0 && threadIdx.x == 0) { const unsigned long long ts_ = rt_now(); while (rt_now() - ts_ < pr_acc) __builtin_amdgcn_s_sleep(8); } }
#endif
#undef IN
#undef SEAM
}

extern "C" void kernel_launch(void* const* d_in, const int* in_sizes, int n_in, void* d_out, int out_size, void* d_ws, size_t ws_size, hipStream_t stream) {
    static int grid = 0;
    if (grid == 0) {
        if (n_in != 28 || out_size != T * D || ws_size < WS_END) { fprintf(stderr, "kernel_launch: unexpected shapes (n_in %d out %d ws %zu)\n", n_in, out_size, ws_size); grid = -1; return; }
        int dev = 0, cus = 0, per_cu = 0;
        hipGetDevice(&dev); hipDeviceGetAttribute(&cus, hipDeviceAttributeMultiprocessorCount, dev);
        hipFuncSetAttribute((const void*)mega, hipFuncAttributeMaxDynamicSharedMemorySize, LDS_BYTES);
        hipOccupancyMaxActiveBlocksPerMultiprocessor(&per_cu, (const void*)mega, 512, LDS_BYTES);
        if (per_cu < 1) { fprintf(stderr, "kernel_launch: occupancy query says %d blocks per CU\n", per_cu); per_cu = 1; }
        (void)hipGetLastError();
        grid = cus;
    }
    if (grid < 0) return;
    (void)hipMemsetAsync((char*)d_ws + WS_CTL, 0, 65536, stream);
    Args a{};
    for (int i = 0; i < 28; ++i) a.in[i] = (const float*)d_in[i];
    a.out = (float*)d_out; a.ws = (unsigned char*)d_ws;
#if ONE_LAUNCH
    a.ph_lo = 0; a.ph_hi = NPH;
    void* params[] = {&a};
    hipError_t e = hipLaunchCooperativeKernel((const void*)mega, dim3(grid), dim3(512), params, LDS_BYTES, stream);
    if (e != hipSuccess) fprintf(stderr, "cooperative launch failed: %s\n", hipGetErrorString(e));
#else
    for (int ph = 0; ph < NPH; ++ph) {
        a.ph_lo = ph; a.ph_hi = ph + 1;
        void* params[] = {&a};
        hipError_t e = hipLaunchCooperativeKernel((const void*)mega, dim3(grid), dim3(512), params, LDS_BYTES, stream);
        if (e != hipSuccess) { fprintf(stderr, "launch %d failed: %s\n", ph, hipGetErrorString(e)); break; }
    }
#endif
}
```

```cpp
#include <hip/hip_runtime.h>
#include <hip/hip_cooperative_groups.h>
#include <cstdint>
#include <cmath>
#include <cstdio>
namespace cg = cooperative_groups;

#ifndef ONE_LAUNCH
#define ONE_LAUNCH 1
#endif
#ifndef PROBE_MASK
#define PROBE_MASK 0u
#endif
#ifndef PROBE_SEC
#define PROBE_SEC 0
#endif

typedef unsigned short bf16;
typedef short bf16x8 __attribute__((ext_vector_type(8)));
typedef float f32x4 __attribute__((ext_vector_type(4)));
typedef float f32x16 __attribute__((ext_vector_type(16)));
typedef unsigned u32x4 __attribute__((ext_vector_type(4)));
typedef unsigned u32x2 __attribute__((ext_vector_type(2)));
typedef float f32x2v __attribute__((ext_vector_type(2)));

constexpr int T = 16384, D = 2048, SEQ = 2048, NB = 8;
constexpr int NCOLS = 16896;
constexpr float ALPHA = 1.189207115002721f;
constexpr int NPH = 19;

constexpr size_t MiB = 1u << 20;
constexpr size_t WS_CTL = 0, WS_MEMB = 1 * MiB, WS_WKV = 9 * MiB, WS_LB = 11 * MiB, WS_MASK = 12 * MiB, WS_WIN = 17 * MiB,
                 WS_SLOT = 83 * MiB, SLOT_BYTES = 64 * MiB, WS_CKV = 595 * MiB, WS_IKW = 603 * MiB, WS_END = 611 * MiB;
constexpr int LDS_BYTES = 157696;
constexpr size_t CTL_BAR = 16384, CTL_CVEC = 65536, CTL_ST1 = 262144, CTL_ST2 = 393216, CTL_ZERO = 524288;

struct Args {
    const float* in[28];
    float* out;
    unsigned char* ws;
    int ph_lo, ph_hi;
};

#define WAVE_SYNC() asm volatile("s_waitcnt lgkmcnt(0)" ::: "memory")

__device__ __forceinline__ unsigned f2bf(float f) { unsigned u = __float_as_uint(f); return (u + 0x7fffu + ((u >> 16) & 1u)) >> 16; }
__device__ __forceinline__ unsigned pk2(float lo, float hi) { return f2bf(lo) | (f2bf(hi) << 16); }
__device__ __forceinline__ float bf2f(unsigned h) { return __uint_as_float(h << 16); }
__device__ __forceinline__ float bflo(unsigned w) { return __uint_as_float(w << 16); }
__device__ __forceinline__ float bfhi(unsigned w) { return __uint_as_float(w & 0xffff0000u); }
__device__ __forceinline__ float wave_sum(float v) {
#pragma unroll
    for (int o = 32; o >= 1; o >>= 1) v += __shfl_xor(v, o);
    return v;
}
__device__ __forceinline__ float wave_max(float v) {
#pragma unroll
    for (int o = 32; o >= 1; o >>= 1) v = fmaxf(v, __shfl_xor(v, o));
    return v;
}
__device__ __forceinline__ float sigm(float x) { return 1.0f / (1.0f + expf(-x)); }
__device__ __forceinline__ void unpack8(u32x4 w, float* f) {
    f[0] = bflo(w.x); f[1] = bfhi(w.x); f[2] = bflo(w.y); f[3] = bfhi(w.y); f[4] = bflo(w.z); f[5] = bfhi(w.z); f[6] = bflo(w.w); f[7] = bfhi(w.w);
}

__device__ __forceinline__ int fresh_lane() { int l; asm volatile("v_mbcnt_lo_u32_b32 %0, -1, 0\n\tv_mbcnt_hi_u32_b32 %0, -1, %0" : "=v"(l)); return l; }
__device__ __forceinline__ unsigned long long rt_now() { unsigned long long t; asm volatile("s_memrealtime %0\n\ts_waitcnt lgkmcnt(0)" : "=s"(t) :: "memory"); return t; }
struct Frame {
    unsigned char* lds;
    int wave, bid, G;
    __device__ __forceinline__ int lane() const { return fresh_lane(); }
    const Args* a;
    unsigned char* ws;
    __device__ __forceinline__ bf16* slot(int i) const { return (bf16*)(ws + WS_SLOT + (size_t)i * SLOT_BYTES); }
};

namespace pg8 {
#define PG8_LAS __attribute__((address_space(3)))
constexpr int BM = 256, BK = 64, HALF = 128, HTB = HALF * BK * 2, STAGE_BYTES = 8 * HTB, NXCD = 8, WGM = 8;
__host__ __device__ __forceinline__ int lds_byte(int r, int c) { const int st = (r >> 4) * 2 + (c >> 5), rr = r & 15, cc = c & 31, ob = rr * 64 + cc * 2; return st * 1024 + (ob ^ (((ob >> 9) & 1) << 5)); }
__host__ __device__ __forceinline__ void stage_rc(int b, int& R, int& C) { const int st = b / 1024, sb = b % 1024, swz = sb ^ (((sb >> 9) & 1) << 5); R = (st >> 1) * 16 + swz / 64; C = (st & 1) * 32 + (swz % 64) / 2; }
__host__ __device__ __forceinline__ int perm32(int rho) { const int n = rho >> 4, i = rho & 15; return 8 * (i >> 2) + 4 * n + (i & 3); }
struct Unit { int pm, pn, z; const char* a; const char* b; };
struct Gemm { int lda, ldb, K; };
__device__ __forceinline__ void tile_of(int wgid, int nM, int nN, int& pm, int& pn) {
    const int nwg = nM * nN; { const int q = nwg / NXCD, r = nwg % NXCD, xcd = wgid % NXCD, off = wgid / NXCD; wgid = (xcd < r ? xcd * (q + 1) : r * (q + 1) + (xcd - r) * q) + off; }
    const int nig = WGM * nN, gid = wgid / nig, fm = gid * WGM, gsz = (nM - fm) < WGM ? (nM - fm) : WGM;
    pm = fm + ((wgid % nig) % gsz); pn = (wgid % nig) / gsz;
}
struct Sub { const bf16* A; const bf16* Bt; int nM, nN; };
template <int NS> struct MultiOrder {
    Sub s[NS]; int lda, ldb, G, c;
    __device__ __forceinline__ bool next(int i, Unit& u) const {
        int L = i * G + c;
#pragma unroll
        for (int k = 0; k < NS; ++k) { const int n = s[k].nM * s[k].nN;
            if (L < n) { tile_of(L, s[k].nM, s[k].nN, u.pm, u.pn); u.z = k; u.a = (const char*)(s[k].A + (size_t)u.pm * BM * lda); u.b = (const char*)(s[k].Bt + (size_t)u.pn * BM * ldb); return true; }
            L -= n; }
        return false;
    }
};
template <class Off> struct BatchOrder {
    const bf16* A; const bf16* Bt; int nM, nN, nz, lda, ldb, G, c; Off off;
    __device__ __forceinline__ bool next(int i, Unit& u) const {
        const int L = i * G + c, per = nM * nN; if (L >= per * nz) return false;
        u.z = L / per; const int r = L % per; u.pn = r / nM; u.pm = r % nM;
        u.a = (const char*)(A + off.a(u.z) + (size_t)u.pm * BM * lda); u.b = (const char*)(Bt + off.b(u.z) + (size_t)u.pn * BM * ldb); return true;
    }
};
__device__ __forceinline__ unsigned cvt_pk_bf16(float lo, float hi) { unsigned r; asm volatile("v_cvt_pk_bf16_f32 %0, %1, %2" : "=v"(r) : "v"(lo), "v"(hi)); return r; }

template <class Op> struct Epi8 {
    static constexpr bool PERM = true;
    Op op;
    __device__ __forceinline__ void operator()(const f32x4 (&acc)[2][2][4][2], const Unit& u, int wr, int wc, int fr, int fq) const {
        const int row0 = u.pm * BM + wr * 64 + fr, col0 = u.pn * BM + wc * 32 + 8 * fq;
        if constexpr (Op::NLD == 0) {
#pragma unroll
            for (int ai = 0; ai < 2; ++ai)
#pragma unroll
                for (int m = 0; m < 4; ++m)
#pragma unroll
                    for (int bj = 0; bj < 2; ++bj) op(u.z, row0 + ai * HALF + m * 16, col0 + bj * HALF, acc[ai][bj][m][0], acc[ai][bj][m][1]);
        } else {
#pragma unroll
            for (int ai = 0; ai < 2; ++ai) {
                u32x4 tmp[4][2][Op::NLD];
#pragma unroll
                for (int m = 0; m < 4; ++m)
#pragma unroll
                    for (int bj = 0; bj < 2; ++bj) op.ld(u.z, row0 + ai * HALF + m * 16, col0 + bj * HALF, tmp[m][bj]);
#pragma unroll
                for (int m = 0; m < 4; ++m)
#pragma unroll
                    for (int bj = 0; bj < 2; ++bj) op.ap(u.z, row0 + ai * HALF + m * 16, col0 + bj * HALF, acc[ai][bj][m][0], acc[ai][bj][m][1], tmp[m][bj]);
            }
        }
    }
};

template <class Epi, class Sched, bool ALIGN_EPI>
__device__ __forceinline__ void gemm_phase(PG8_LAS unsigned char* lds, const Gemm g, const Sched& S, const Epi& E, int wid, int lane) {
    const int tid = wid * 64 + lane, wr = wid >> 2, wc = wid & 3, fr = lane & 15, fq = lane >> 4;
    const int K = g.K, nt = K / BK;
    unsigned voffA[2], voffB[2];
#pragma unroll
    for (int i = 0; i < 2; ++i) { int R, C; stage_rc(tid * 16 + i * 8192, R, C); const int Rb = Epi::PERM ? ((R & ~31) + perm32(R & 31)) : R;
        voffA[i] = (unsigned)(R * g.lda + C) * 2u; voffB[i] = (unsigned)(Rb * g.ldb + C) * 2u; }
    const size_t kstep = (size_t)(BK * 2);
    const size_t hstepA = (size_t)HALF * g.lda * 2, hstepB = (size_t)HALF * g.ldb * 2;
    const unsigned ldsw = (unsigned)wid * 1024u;
    const int aoff = lds_byte(wr * 64 + fr, fq * 8), boff = lds_byte(wc * 32 + fr, fq * 8);
#define PG8_SA(b, h) (((b) * 2 + (h)) * HTB)
#define PG8_SB(b, h) ((4 + (b) * 2 + (h)) * HTB)
#define PG8_STAGE(bufoff, gbase, voff) do { _Pragma("unroll") for (int _i = 0; _i < 2; ++_i) \
        __builtin_amdgcn_global_load_lds((const unsigned*)((const char*)(gbase) + (voff)[_i]), (PG8_LAS unsigned*)(lds + (bufoff) + ldsw + _i * 8192), 16, 0, 0); } while (0)
#define PG8_LDA(dst, b, h) do { _Pragma("unroll") for (int m = 0; m < 4; ++m) _Pragma("unroll") for (int k = 0; k < 2; ++k) dst[m][k] = *(const PG8_LAS bf16x8*)(lds + PG8_SA(b, h) + aoff + m * 2048 + k * 1024); } while (0)
#define PG8_LDB(dst, b, h) do { _Pragma("unroll") for (int n = 0; n < 2; ++n) _Pragma("unroll") for (int k = 0; k < 2; ++k) dst[n][k] = *(const PG8_LAS bf16x8*)(lds + PG8_SB(b, h) + boff + n * 2048 + k * 1024); } while (0)
#define PG8_MMA(ai, bj, At, Bt) do { __builtin_amdgcn_s_setprio(1); _Pragma("unroll") for (int m = 0; m < 4; ++m) _Pragma("unroll") for (int n = 0; n < 2; ++n) _Pragma("unroll") for (int k = 0; k < 2; ++k) \
        acc[ai][bj][m][n] = __builtin_amdgcn_mfma_f32_16x16x32_bf16(Bt[n][k], At[m][k], acc[ai][bj][m][n], 0, 0, 0); __builtin_amdgcn_s_setprio(0); } while (0)
#define PG8_WAIT_V(n) asm volatile("s_waitcnt vmcnt(" #n ")" ::: "memory")
#define PG8_WAIT_L(n) asm volatile("s_waitcnt lgkmcnt(" #n ")" ::: "memory")
#define PG8_BAR __builtin_amdgcn_s_barrier()
#define PG8_SCHED __builtin_amdgcn_sched_barrier(0)
    Unit cur, nxt; int ui = 0;
    if (!S.next(0, cur)) return;
    f32x4 acc[2][2][4][2];
#pragma unroll
    for (int a = 0; a < 2; ++a)
#pragma unroll
        for (int b = 0; b < 2; ++b)
#pragma unroll
            for (int m = 0; m < 4; ++m)
#pragma unroll
                for (int n = 0; n < 2; ++n) acc[a][b][m][n] = (f32x4){0.f, 0.f, 0.f, 0.f};
    bf16x8 At[4][2], B0[2][2], B1[2][2];
    const char* cA = cur.a; const char* cB = cur.b;
    PG8_STAGE(PG8_SB(0, 0), cB, voffB); PG8_STAGE(PG8_SB(0, 1), cB + hstepB, voffB); PG8_STAGE(PG8_SA(0, 0), cA, voffA); PG8_STAGE(PG8_SA(0, 1), cA + hstepA, voffA);
    if (wr == 1) PG8_BAR;
    PG8_WAIT_V(2); PG8_BAR;
    PG8_STAGE(PG8_SB(1, 0), cB + kstep, voffB); PG8_STAGE(PG8_SA(1, 0), cA + kstep, voffA); PG8_STAGE(PG8_SB(1, 1), cB + hstepB + kstep, voffB);
    PG8_WAIT_V(6); PG8_BAR;
    for (;;) {
        const bool has_next = S.next(ui + 1, nxt);
        const char* nA = has_next ? nxt.a : cA; const char* nB = has_next ? nxt.b : cB;
#pragma unroll 1
        for (int t = 0; t < nt; t += 2) {
            const bool last = (t == nt - 2);
            const char* a1 = cA + (size_t)(t + 1) * kstep;
            const char* a2 = last ? nA : cA + (size_t)(t + 2) * kstep; const char* b2 = last ? nB : cB + (size_t)(t + 2) * kstep;
            const char* a3 = a2 + kstep; const char* b3 = b2 + kstep;
            PG8_LDB(B0, 0, 0); PG8_LDB(B1, 0, 1); PG8_SCHED; PG8_LDA(At, 0, 0); PG8_STAGE(PG8_SA(1, 1), a1 + hstepA, voffA);
            PG8_WAIT_V(8); PG8_WAIT_L(0); PG8_BAR; PG8_MMA(0, 0, At, B0); PG8_MMA(0, 1, At, B1); PG8_BAR; PG8_SCHED;
            PG8_LDA(At, 0, 1); PG8_STAGE(PG8_SB(0, 0), b2, voffB); PG8_STAGE(PG8_SB(0, 1), b2 + hstepB, voffB); PG8_STAGE(PG8_SA(0, 0), a2, voffA);
            PG8_WAIT_V(8); PG8_WAIT_L(0); PG8_BAR; PG8_MMA(1, 0, At, B0); PG8_MMA(1, 1, At, B1); PG8_BAR; PG8_SCHED;
            PG8_LDB(B0, 1, 0); PG8_LDB(B1, 1, 1); PG8_SCHED; PG8_LDA(At, 1, 0); PG8_STAGE(PG8_SA(0, 1), a2 + hstepA, voffA);
            PG8_WAIT_V(8); PG8_WAIT_L(0); PG8_BAR; PG8_MMA(0, 0, At, B0); PG8_MMA(0, 1, At, B1); PG8_BAR; PG8_SCHED;
            PG8_LDA(At, 1, 1); PG8_STAGE(PG8_SB(1, 0), b3, voffB); PG8_STAGE(PG8_SB(1, 1), b3 + hstepB, voffB); PG8_STAGE(PG8_SA(1, 0), a3, voffA);
            PG8_WAIT_V(8); PG8_WAIT_L(0); PG8_BAR; PG8_MMA(1, 0, At, B0); PG8_MMA(1, 1, At, B1); PG8_BAR; PG8_SCHED;
        }
        if constexpr (ALIGN_EPI) { if (wr == 0) PG8_BAR; }
        E(acc, cur, wr, wc, fr, fq);
        if (!has_next) break;
#pragma unroll
        for (int a = 0; a < 2; ++a)
#pragma unroll
            for (int b = 0; b < 2; ++b)
#pragma unroll
                for (int m = 0; m < 4; ++m)
#pragma unroll
                    for (int n = 0; n < 2; ++n) acc[a][b][m][n] = (f32x4){0.f, 0.f, 0.f, 0.f};
        cur = nxt; cA = nA; cB = nB; ++ui;
        if constexpr (ALIGN_EPI) { if (wr == 1) PG8_BAR; }
    }
    PG8_WAIT_V(0);
    if constexpr (!ALIGN_EPI) { if (wr == 0) PG8_BAR; }
    PG8_BAR;
#undef PG8_SA
#undef PG8_SB
#undef PG8_STAGE
#undef PG8_LDA
#undef PG8_LDB
#undef PG8_MMA
#undef PG8_WAIT_V
#undef PG8_WAIT_L
#undef PG8_BAR
#undef PG8_SCHED
}
}

__device__ __forceinline__ u32x4 pack8(f32x4 a, f32x4 b) { u32x4 w; w.x = pg8::cvt_pk_bf16(a.x, a.y); w.y = pg8::cvt_pk_bf16(a.z, a.w); w.z = pg8::cvt_pk_bf16(b.x, b.y); w.w = pg8::cvt_pk_bf16(b.z, b.w); return w; }
__device__ __forceinline__ void unpack8v(u32x4 w, f32x4& a, f32x4& b) { a.x = bflo(w.x); a.y = bfhi(w.x); a.z = bflo(w.y); a.w = bfhi(w.y); b.x = bflo(w.z); b.y = bfhi(w.z); b.z = bflo(w.w); b.w = bfhi(w.w); }
__device__ __forceinline__ f32x4 sigm4(f32x4 v) { f32x4 r; r.x = sigm(v.x); r.y = sigm(v.y); r.z = sigm(v.z); r.w = sigm(v.w); return r; }

struct OpProj { static constexpr int NLD = 0; unsigned char* ws;
    __device__ __forceinline__ void operator()(int z, int row, int col, f32x4 a, f32x4 b) const {
        bf16* p;
        if (col < 16384) p = (bf16*)(ws + WS_SLOT + (size_t)(col >> 11) * SLOT_BYTES) + (size_t)row * 2048 + (col & 2047);
        else if (col < 16640) p = (bf16*)(ws + WS_CKV) + (size_t)row * 256 + (col - 16384);
        else p = (bf16*)(ws + WS_IKW) + (size_t)row * 256 + (col - 16640);
        *(u32x4*)p = pack8(a, b);
    } };
struct OpBf16 { static constexpr int NLD = 0; bf16* o; int ld;
    __device__ __forceinline__ void operator()(int z, int row, int col, f32x4 a, f32x4 b) const { *(u32x4*)(o + (size_t)row * ld + col) = pack8(a, b); } };
struct OpSplit2 { static constexpr int NLD = 0; bf16* o0; bf16* o1;
    __device__ __forceinline__ void operator()(int z, int row, int col, f32x4 a, f32x4 b) const { bf16* p = (col < 2048 ? o0 : o1) + (size_t)row * 2048 + (col & 2047); *(u32x4*)p = pack8(a, b); } };
struct OpF32 { static constexpr int NLD = 0; float* o; int ld;
    __device__ __forceinline__ void operator()(int z, int row, int col, f32x4 a, f32x4 b) const { float* p = o + (size_t)row * ld + col; *(f32x4*)p = a; *(f32x4*)(p + 4) = b; } };
struct OpYA { static constexpr int NLD = 1; bf16* ga;
    __device__ __forceinline__ void ld(int zi, int row, int col, u32x4* t) const { t[0] = *(const u32x4*)(ga + (size_t)row * 2048 + col); }
    __device__ __forceinline__ void ap(int zi, int row, int col, f32x4 a, f32x4 b, const u32x4* t) const { f32x4 g0, g1; unpack8v(t[0], g0, g1); *(u32x4*)(ga + (size_t)row * 2048 + col) = pack8(sigm4(g0) * a, sigm4(g1) * b); } };
struct OpYB { static constexpr int NLD = 2; bf16* ga; const bf16* gb;
    __device__ __forceinline__ void ld(int zi, int row, int col, u32x4* t) const { const size_t i = (size_t)row * 2048 + col; t[0] = *(const u32x4*)(ga + i); t[1] = *(const u32x4*)(gb + i); }
    __device__ __forceinline__ void ap(int zi, int row, int col, f32x4 a, f32x4 b, const u32x4* t) const { f32x4 m0, m1, g0, g1; unpack8v(t[0], m0, m1); unpack8v(t[1], g0, g1);
        *(u32x4*)(ga + (size_t)row * 2048 + col) = pack8(m0 + sigm4(g0) * a, m1 + sigm4(g1) * b); } };
struct OpMix { static constexpr int NLD = 2; const float* x; float* zo;
    __device__ __forceinline__ void ld(int zi, int row, int col, u32x4* t) const { const size_t i = (size_t)row * 2048 + col; t[0] = *(const u32x4*)(x + i); t[1] = *(const u32x4*)(x + i + 4); }
    __device__ __forceinline__ void ap(int zi, int row, int col, f32x4 a, f32x4 b, const u32x4* t) const { const size_t i = (size_t)row * 2048 + col;
        *(f32x4*)(zo + i) = ALPHA * __builtin_bit_cast(f32x4, t[0]) + a; *(f32x4*)(zo + i + 4) = ALPHA * __builtin_bit_cast(f32x4, t[1]) + b; } };
struct OpRes { static constexpr int NLD = 2; float* zo;
    __device__ __forceinline__ void ld(int zi, int row, int col, u32x4* t) const { const size_t i = (size_t)row * 2048 + col; t[0] = *(const u32x4*)(zo + i); t[1] = *(const u32x4*)(zo + i + 4); }
    __device__ __forceinline__ void ap(int zi, int row, int col, f32x4 a, f32x4 b, const u32x4* t) const { const size_t i = (size_t)row * 2048 + col;
        *(f32x4*)(zo + i) = ALPHA * __builtin_bit_cast(f32x4, t[0]) + a; *(f32x4*)(zo + i + 4) = ALPHA * __builtin_bit_cast(f32x4, t[1]) + b; } };

__device__ __forceinline__ void row_stats_add(float* st, int row, float s1, float s2, int fq) {
    s1 += __shfl_xor(s1, 16); s1 += __shfl_xor(s1, 32); s2 += __shfl_xor(s2, 16); s2 += __shfl_xor(s2, 32);
    if (fq == 0) { atomicAdd(st + 2 * (size_t)row, s1); atomicAdd(st + 2 * (size_t)row + 1, s2); }
}
__device__ __forceinline__ void row_mu_rstd(const float* st, int row, float& mu, float& rstd) {
    const f32x2v p = *(const f32x2v*)(st + 2 * (size_t)row); mu = p.x * (1.0f / 2048.0f); rstd = rsqrtf(fmaxf(p.y * (1.0f / 2048.0f) - mu * mu, 0.f) + 1e-5f);
}
__device__ __forceinline__ float sum8(f32x4 a, f32x4 b) { return ((a.x + a.y) + (a.z + a.w)) + ((b.x + b.y) + (b.z + b.w)); }
__device__ __forceinline__ float sq8(f32x4 a, f32x4 b) { return ((a.x * a.x + a.y * a.y) + (a.z * a.z + a.w * a.w)) + ((b.x * b.x + b.y * b.y) + (b.z * b.z + b.w * b.w)); }
struct EpiMixStats { static constexpr bool PERM = true; const float* x; bf16* zb; float* st;
    __device__ __forceinline__ void operator()(const f32x4 (&acc)[2][2][4][2], const pg8::Unit& u, int wr, int wc, int fr, int fq) const {
        const int row0 = u.pm * 256 + wr * 64 + fr, col0 = u.pn * 256 + wc * 32 + 8 * fq;
#pragma unroll
        for (int ai = 0; ai < 2; ++ai) {
            f32x4 xv[4][2][2];
#pragma unroll
            for (int m = 0; m < 4; ++m)
#pragma unroll
                for (int bj = 0; bj < 2; ++bj) { const float* p = x + (size_t)(row0 + ai * 128 + m * 16) * 2048 + col0 + bj * 128; xv[m][bj][0] = *(const f32x4*)p; xv[m][bj][1] = *(const f32x4*)(p + 4); }
#pragma unroll
            for (int m = 0; m < 4; ++m) { const int row = row0 + ai * 128 + m * 16; float s1 = 0.f, s2 = 0.f;
#pragma unroll
                for (int bj = 0; bj < 2; ++bj) { const f32x4 z0 = ALPHA * xv[m][bj][0] + acc[ai][bj][m][0], z1 = ALPHA * xv[m][bj][1] + acc[ai][bj][m][1];
                    *(u32x4*)(zb + (size_t)row * 2048 + col0 + bj * 128) = pack8(z0, z1); s1 += sum8(z0, z1); s2 += sq8(z0, z1); }
                row_stats_add(st, row, s1, s2, fq); }
        }
    }
};
struct EpiCOStats { static constexpr bool PERM = true; bf16* zb; const float* st1; float* st2; const float* g; const float* bta;
    __device__ __forceinline__ void operator()(const f32x4 (&acc)[2][2][4][2], const pg8::Unit& u, int wr, int wc, int fr, int fq) const {
        const int row0 = u.pm * 256 + wr * 64 + fr, col0 = u.pn * 256 + wc * 32 + 8 * fq;
        f32x4 gv[2][2], bv[2][2];
#pragma unroll
        for (int bj = 0; bj < 2; ++bj) { gv[bj][0] = *(const f32x4*)(g + col0 + bj * 128); gv[bj][1] = *(const f32x4*)(g + col0 + bj * 128 + 4); bv[bj][0] = *(const f32x4*)(bta + col0 + bj * 128); bv[bj][1] = *(const f32x4*)(bta + col0 + bj * 128 + 4); }
#pragma unroll
        for (int ai = 0; ai < 2; ++ai) {
            u32x4 zv[4][2]; float mu[4], rs[4];
#pragma unroll
            for (int m = 0; m < 4; ++m) { const int row = row0 + ai * 128 + m * 16; row_mu_rstd(st1, row, mu[m], rs[m]);
#pragma unroll
                for (int bj = 0; bj < 2; ++bj) zv[m][bj] = *(const u32x4*)(zb + (size_t)row * 2048 + col0 + bj * 128); }
#pragma unroll
            for (int m = 0; m < 4; ++m) { const int row = row0 + ai * 128 + m * 16; float s1 = 0.f, s2 = 0.f;
#pragma unroll
                for (int bj = 0; bj < 2; ++bj) { f32x4 a0, a1; unpack8v(zv[m][bj], a0, a1);
                    const f32x4 z0 = ALPHA * ((a0 - mu[m]) * rs[m] * gv[bj][0] + bv[bj][0]) + acc[ai][bj][m][0], z1 = ALPHA * ((a1 - mu[m]) * rs[m] * gv[bj][1] + bv[bj][1]) + acc[ai][bj][m][1];
                    *(u32x4*)(zb + (size_t)row * 2048 + col0 + bj * 128) = pack8(z0, z1); s1 += sum8(z0, z1); s2 += sq8(z0, z1); }
                row_stats_add(st2, row, s1, s2, fq); }
        }
    }
};
__device__ __forceinline__ void ln_fold8(const float* st, const float* c1, const float* c0, int row, int col, f32x4& a, f32x4& b) {
    float mu, rs; row_mu_rstd(st, row, mu, rs);
    const f32x4 p0 = *(const f32x4*)(c1 + col), p1 = *(const f32x4*)(c1 + col + 4), q0 = *(const f32x4*)(c0 + col), q1 = *(const f32x4*)(c0 + col + 4);
    a = (a - mu * p0) * rs + q0; b = (b - mu * p1) * rs + q1;
}
struct OpPQFold { static constexpr int NLD = 0; float* o; const float* st; const float* c1; const float* c0;
    __device__ __forceinline__ void operator()(int zi, int row, int col, f32x4 a, f32x4 b) const { ln_fold8(st, c1, c0, row, col, a, b); float* p = o + (size_t)row * 2048 + col; *(f32x4*)p = a; *(f32x4*)(p + 4) = b; } };

template <class Op>
__device__ __forceinline__ void gemm(const Frame& F, const bf16* A, int lda, const bf16* Bt, int ldb, int M, int N, int K, const Op& op) {
    pg8::Gemm g{lda, ldb, K}; pg8::MultiOrder<1> S; S.s[0] = pg8::Sub{A, Bt, M / 256, N / 256}; S.lda = lda; S.ldb = ldb; S.G = F.G; S.c = F.bid;
    pg8::Epi8<Op> E{op};
    pg8::gemm_phase<pg8::Epi8<Op>, pg8::MultiOrder<1>, true>((PG8_LAS unsigned char*)F.lds, g, S, E, F.wave, F.lane());
}
template <class Epi>
__device__ __forceinline__ void gemm_epi(const Frame& F, const bf16* A, int lda, const bf16* Bt, int ldb, int M, int N, int K, const Epi& E) {
    pg8::Gemm g{lda, ldb, K}; pg8::MultiOrder<1> S; S.s[0] = pg8::Sub{A, Bt, M / 256, N / 256}; S.lda = lda; S.ldb = ldb; S.G = F.G; S.c = F.bid;
    pg8::gemm_phase<Epi, pg8::MultiOrder<1>, true>((PG8_LAS unsigned char*)F.lds, g, S, E, F.wave, F.lane());
}
template <int NS, class Op>
__device__ __forceinline__ void gemm_multi(const Frame& F, const pg8::MultiOrder<NS>& S, int K, const Op& op) {
    pg8::Gemm g{S.lda, S.ldb, K}; pg8::Epi8<Op> E{op};
    pg8::gemm_phase<pg8::Epi8<Op>, pg8::MultiOrder<NS>, true>((PG8_LAS unsigned char*)F.lds, g, S, E, F.wave, F.lane());
}
template <class Off, class Op>
__device__ __forceinline__ void gemm_batch(const Frame& F, const pg8::BatchOrder<Off>& S, int K, const Op& op) {
    pg8::Gemm g{S.lda, S.ldb, K}; pg8::Epi8<Op> E{op};
    pg8::gemm_phase<pg8::Epi8<Op>, pg8::BatchOrder<Off>, true>((PG8_LAS unsigned char*)F.lds, g, S, E, F.wave, F.lane());
}
struct OffS { __device__ __forceinline__ size_t a(int z) const { return (size_t)(z >> 2) * 2048 * 2048 + (z & 3) * 512; } __device__ __forceinline__ size_t b(int z) const { return (size_t)(z >> 2) * 256 * 2048 + (z & 3) * 512; } };
struct OffPV { __device__ __forceinline__ size_t a(int z) const { return (size_t)(z >> 2) * 2048 * 1024 + (z & 3) * 256; } __device__ __forceinline__ size_t b(int z) const { return (size_t)(z & 3) * 512 * 2048 + (z >> 2) * 256; } };
struct OpLogit { static constexpr int NLD = 0; float* lg;
    __device__ __forceinline__ void operator()(int z, int row, int col, f32x4 a, f32x4 b) const { float* p = lg + ((size_t)(z >> 2) * 2048 + row) * 1024 + (z & 3) * 256 + col; *(f32x4*)p = a * 0.04419417382415922f; *(f32x4*)(p + 4) = b * 0.04419417382415922f; } };
struct OpCO { static constexpr int NLD = 0; bf16* co;
    __device__ __forceinline__ void operator()(int z, int row, int col, f32x4 a, f32x4 b) const { *(u32x4*)(co + ((size_t)(z >> 2) * 2048 + row) * 2048 + (z & 3) * 512 + col) = pack8(a, b); } };
struct OpCQKV { static constexpr int NLD = 0; bf16* cq; bf16* ck; bf16* vt; const float* st; const float* c1; const float* c0;
    __device__ __forceinline__ void operator()(int z, int row, int col, f32x4 a, f32x4 b) const { if (z == 0) ln_fold8(st, c1, c0, row, col, a, b);
        bf16* o = z == 0 ? cq : (z == 1 ? ck : vt); *(u32x4*)(o + (size_t)row * 2048 + col) = pack8(a, b); } };
__device__ __forceinline__ void ph_xsoftmax(const Frame& F, const float* lg, bf16* P) {
    const int gw = F.bid * 8 + F.wave, NGW = F.G * 8, lane = F.lane();
    for (int u = gw; u < T * 4; u += NGW) {
        const f32x4 v = *(const f32x4*)(lg + (size_t)u * 256 + 4 * lane);
        const float m = wave_max(fmaxf(fmaxf(v.x, v.y), fmaxf(v.z, v.w)));
        const float e0 = expf(v.x - m), e1 = expf(v.y - m), e2 = expf(v.z - m), e3 = expf(v.w - m);
        const float inv = 1.0f / wave_sum((e0 + e1) + (e2 + e3));
        u32x2 w; w.x = pk2(e0 * inv, e1 * inv); w.y = pk2(e2 * inv, e3 * inv);
        *(u32x2*)(P + (size_t)u * 256 + 4 * lane) = w;
    }
}

template <class CM>
__device__ __forceinline__ void transpose_item(const float* W, size_t ldw, bf16* WT, size_t ldwt, int row_off, int nblk, int item, float* scr, int lane, const CM& cm) {
    const int kb = item / nblk, nb = item % nblk, k0 = 64 * kb, n0 = 32 * nb;
    const int c = cm(n0 + (lane & 31));
#pragma unroll 8
    for (int i = 0; i < 32; ++i) { const int kk = 2 * i + (lane >> 5); scr[kk * 33 + (lane & 31)] = (c >= 0) ? W[(size_t)(k0 + kk) * ldw + c] : 0.f; }
    WAVE_SYNC();
    const int c8 = lane & 7;
#pragma unroll
    for (int j = 0; j < 4; ++j) { const int n = (lane >> 3) + 8 * j; const float* s = scr + (8 * c8) * 33 + n;
        u32x4 o; o.x = pk2(s[0 * 33], s[1 * 33]); o.y = pk2(s[2 * 33], s[3 * 33]); o.z = pk2(s[4 * 33], s[5 * 33]); o.w = pk2(s[6 * 33], s[7 * 33]);
        *(u32x4*)(WT + (size_t)(row_off + n0 + n) * ldwt + k0 + 8 * c8) = o; }
    WAVE_SYNC();
}
__device__ __forceinline__ void transpose_item_ln(const float* W, bf16* WT, int item, float* scr, int lane, const float* g, const float* bta, float* c1, float* c0) {
    const int kb = item / 64, nb = item % 64, k0 = 64 * kb, n0 = 32 * nb;
#pragma unroll 8
    for (int i = 0; i < 32; ++i) { const int kk = 2 * i + (lane >> 5); scr[kk * 33 + (lane & 31)] = W[(size_t)(k0 + kk) * 2048 + n0 + (lane & 31)]; }
    WAVE_SYNC();
    const int c8 = lane & 7;
    float gk[8], bk[8];
#pragma unroll
    for (int i = 0; i < 8; ++i) { gk[i] = g[k0 + 8 * c8 + i]; bk[i] = bta[k0 + 8 * c8 + i]; }
#pragma unroll
    for (int j = 0; j < 4; ++j) { const int n = (lane >> 3) + 8 * j; const float* sp = scr + (8 * c8) * 33 + n;
        float wv[8]; float p1 = 0.f, p0 = 0.f;
#pragma unroll
        for (int i = 0; i < 8; ++i) { const float v = sp[i * 33]; wv[i] = v * gk[i]; p1 += wv[i]; p0 += v * bk[i]; }
        u32x4 o; o.x = pk2(wv[0], wv[1]); o.y = pk2(wv[2], wv[3]); o.z = pk2(wv[4], wv[5]); o.w = pk2(wv[6], wv[7]);
        *(u32x4*)(WT + (size_t)(n0 + n) * 2048 + k0 + 8 * c8) = o;
        p1 += __shfl_xor(p1, 1); p1 += __shfl_xor(p1, 2); p1 += __shfl_xor(p1, 4); p0 += __shfl_xor(p0, 1); p0 += __shfl_xor(p0, 2); p0 += __shfl_xor(p0, 4);
        if (c8 == 0) { atomicAdd(c1 + n0 + n, p1); atomicAdd(c0 + n0 + n, p0); } }
    WAVE_SYNC();
}
struct CmIdent { __device__ __forceinline__ int operator()(int n) const { return n; } };
struct CmWin { __device__ __forceinline__ int operator()(int n) const {
    if (n < 10240) return n;
    if (n < 12288) return 10496 + (n - 10240);
    if (n < 14336) return 12688 + (n - 12288);
    if (n < 16384) return 14736 + (n - 14336);
    if (n < 16640) return 10240 + (n - 16384);
    if (n < 16768) return 12544 + (n - 16640);
    if (n < 16784) return 12672 + (n - 16768);
    return -1; } };

__device__ __forceinline__ void cvt_bf16_stream(const Frame& F, const float* src, bf16* dst, size_t n8) {
    const size_t gt = (size_t)F.bid * 512 + F.wave * 64 + F.lane(), NT = (size_t)F.G * 512;
#pragma unroll 4
    for (size_t i = gt; i < n8; i += NT) { const f32x4 a = ((const f32x4*)src)[2 * i], b = ((const f32x4*)src)[2 * i + 1];
        u32x4 o; o.x = pk2(a.x, a.y); o.y = pk2(a.z, a.w); o.z = pk2(b.x, b.y); o.w = pk2(b.z, b.w); ((u32x4*)dst)[i] = o; }
}

__device__ __forceinline__ void ph0_prologue(const Frame& F) {
    const Args& a = *F.a;
    cvt_bf16_stream(F, a.in[0], (bf16*)a.out, (size_t)T * D / 8);
    cvt_bf16_stream(F, a.in[1], (bf16*)(F.ws + WS_MEMB), (size_t)2048 * 2048 / 8);
    float* scr = (float*)(F.lds + F.wave * 16384);
    const int gw = F.bid * 8 + F.wave, NGW = F.G * 8, lane = F.lane();
    {
        const int nblk = NCOLS / 32, nitems = (2048 / 64) * nblk;
        for (int it = gw; it < nitems; it += NGW) transpose_item(a.in[2], 16784, (bf16*)(F.ws + WS_WIN), 2048, 0, nblk, it, scr, lane, CmWin());
    }
    {
        for (int it = gw; it < 32 * 16; it += NGW) { const int mat = it >> 4, which = mat >> 4, h = mat & 15;
            transpose_item(a.in[which ? 9 : 8] + (size_t)h * 256 * 128, 128, (bf16*)(F.ws + WS_WKV), 256, which * 2048 + h * 128, 4, it & 15, scr, lane, CmIdent()); }
    }
    {
        const int gt = F.bid * 512 + F.wave * 64 + lane;
        if (gt < 2048) { const float l0 = a.in[3][gt], l1 = a.in[3][2048 + gt]; ((float*)(F.ws + WS_LB))[gt] = 1.0f / (1.0f + expf(l1 - l0)); }
    }
}

namespace hg {
constexpr int QP = 272, TP = 144, AP = 144;
constexpr int OFF_QD = 0, OFF_KD = OFF_QD + 64 * QP, OFF_QG = OFF_KD + 64 * QP, OFF_KET = OFF_QG + 64 * QP, OFF_VT = OFF_KET + 128 * TP, OFF_A = OFF_VT + 128 * TP,
              OFF_TOT = OFF_A + 64 * AP, OFF_DEC = OFF_TOT + 4 * 128 * 4, OFF_PART = OFF_DEC + 128 * 4, OFF_RSTD = OFF_PART + 8 * 64 * 4, END = OFF_RSTD + 64 * 4;
static_assert(END <= 131072, "hgrn LDS map");
}
typedef short bf16x4 __attribute__((ext_vector_type(4)));
#define HSEC_B() do { if (PROBE_SEC) hs_t0 = rt_now(); } while (0)
#define HSEC_E(n) do { if (PROBE_SEC == (n)) sacc += rt_now() - hs_t0; } while (0)
__device__ __forceinline__ void hgrn_chunked(const Frame& F, int unit, unsigned long long& sacc) {
    unsigned long long hs_t0 = 0ull;
    using namespace hg;
    const Args& a = *F.a;
    const int b = unit >> 4, h = unit & 15, lane = F.lane(), w = F.wave, tid = w * 64 + lane, c = tid & 127, rq = tid >> 7, l15 = lane & 15, q4 = lane >> 4;
    unsigned char* L = F.lds;
    const size_t base = (size_t)b * 2048 * 2048 + h * 128;
    const bf16* HQ = F.slot(0) + base; const bf16* HF = F.slot(1) + base; const bf16* HI = F.slot(2) + base; const bf16* HG = F.slot(3) + base; bf16* HO = F.slot(0) + base;
    const float lb = ((const float*)(F.ws + WS_LB))[h * 128 + c];
    const float ng = a.in[4][h * 128 + 16 * w + l15];
    f32x4 S[8];
#pragma unroll
    for (int d = 0; d < 8; ++d) S[d] = (f32x4){0.f, 0.f, 0.f, 0.f};
    unsigned short rq_[16], rf_[16], rv_[16];
#pragma unroll
    for (int k = 0; k < 16; ++k) { const size_t o = (size_t)(16 * rq + k) * 2048 + c; rq_[k] = HQ[o]; rf_[k] = HF[o]; rv_[k] = HI[o]; }
    float* tot = (float*)(L + OFF_TOT); float* dec = (float*)(L + OFF_DEC); float* part = (float*)(L + OFF_PART); float* rstd = (float*)(L + OFF_RSTD);
#pragma unroll 1
    for (int ch = 0; ch < 32; ++ch) {
        const int r0 = ch * 64;
        HSEC_B();
        unsigned short gq[16];
#pragma unroll
        for (int mt = 0; mt < 4; ++mt)
#pragma unroll
            for (int r = 0; r < 4; ++r) gq[4 * mt + r] = HG[(size_t)(r0 + 16 * mt + 4 * q4 + r) * 2048 + 16 * w + l15];
        unsigned short rv2_[16];
        if (ch + 1 < 32) {
#pragma unroll
            for (int k = 0; k < 16; ++k) rv2_[k] = HI[(size_t)(r0 + 64 + 16 * rq + k) * 2048 + c]; }
        float G[16], qf[16], kk[16];
        { float run = 0.f;
#pragma unroll
          for (int k = 0; k < 16; ++k) { const float f = lb + (1.0f - lb) * __builtin_amdgcn_rcpf(1.0f + __expf(-bf2f(rf_[k]))); run += __logf(f); G[k] = run; kk[k] = 1.0f - f; qf[k] = bf2f(rq_[k]); } }
        tot[rq * 128 + c] = G[15];
        if (ch + 1 < 32) {
#pragma unroll
            for (int k = 0; k < 16; ++k) { const size_t o = (size_t)(r0 + 64 + 16 * rq + k) * 2048 + c; rq_[k] = HQ[o]; rf_[k] = HF[o]; } }
        HSEC_E(1); HSEC_B();
        __syncthreads();
        HSEC_E(2); HSEC_B();
        const float t0 = tot[c], t1 = tot[128 + c], t2 = tot[256 + c], t3 = tot[384 + c];
        const float offs = (rq > 0 ? t0 : 0.f) + (rq > 1 ? t1 : 0.f) + (rq > 2 ? t2 : 0.f);
        const float Gref = t0 + t1, Glast = Gref + t2 + t3, eref = __expf(Gref), elr = __expf(Glast - Gref);
        if (rq == 0) dec[c] = __expf(Glast);
        unsigned kew[8], vw[8];
#pragma unroll
        for (int k = 0; k < 16; ++k) {
            const float e1 = __expf(G[k] + offs - Gref), qd = qf[k] * e1, kd = kk[k] * __builtin_amdgcn_rcpf(e1);
            const int row = 16 * rq + k;
            *(bf16*)(L + OFF_QD + row * QP + 2 * c) = (bf16)f2bf(qd);
            *(bf16*)(L + OFF_KD + row * QP + 2 * c) = (bf16)f2bf(kd);
            *(bf16*)(L + OFF_QG + row * QP + 2 * c) = (bf16)f2bf(qd * eref);
            const unsigned ke = f2bf(kd * elr);
            if (k & 1) { kew[k >> 1] |= ke << 16; vw[k >> 1] |= (unsigned)rv_[k] << 16; } else { kew[k >> 1] = ke; vw[k >> 1] = rv_[k]; }
        }
        *(u32x4*)(L + OFF_KET + c * TP + 32 * rq) = (u32x4){kew[0], kew[1], kew[2], kew[3]}; *(u32x4*)(L + OFF_KET + c * TP + 32 * rq + 16) = (u32x4){kew[4], kew[5], kew[6], kew[7]};
        *(u32x4*)(L + OFF_VT + c * TP + 32 * rq) = (u32x4){vw[0], vw[1], vw[2], vw[3]}; *(u32x4*)(L + OFF_VT + c * TP + 32 * rq + 16) = (u32x4){vw[4], vw[5], vw[6], vw[7]};
        if (ch + 1 < 32) {
#pragma unroll
            for (int k = 0; k < 16; ++k) rv_[k] = rv2_[k]; }
        HSEC_E(3); HSEC_B();
        __syncthreads();
        HSEC_E(4); HSEC_B();
        { const int mi = w >> 1;
#pragma unroll
          for (int tt = 0; tt < 2; ++tt) { const int nj = 2 * (w & 1) + tt; f32x4 acc = (f32x4){0.f, 0.f, 0.f, 0.f};
              if (nj <= mi) {
#pragma unroll
                  for (int ks = 0; ks < 4; ++ks) { const bf16x8 aF = *(const bf16x8*)(L + OFF_KD + (16 * nj + l15) * QP + 64 * ks + 16 * q4), bF = *(const bf16x8*)(L + OFF_QD + (16 * mi + l15) * QP + 64 * ks + 16 * q4);
                      acc = __builtin_amdgcn_mfma_f32_16x16x32_bf16(aF, bF, acc, 0, 0, 0); } }
              const int i = 16 * mi + l15, j0 = 16 * nj + 4 * q4;
              const float v0 = (j0 <= i) ? acc.x : 0.f, v1 = (j0 + 1 <= i) ? acc.y : 0.f, v2 = (j0 + 2 <= i) ? acc.z : 0.f, v3 = (j0 + 3 <= i) ? acc.w : 0.f;
              *(u32x2*)(L + OFF_A + i * AP + 2 * j0) = (u32x2){pk2(v0, v1), pk2(v2, v3)}; } }
        __syncthreads();
        HSEC_E(5); HSEC_B();
        bf16x8 bV[2];
#pragma unroll
        for (int ks = 0; ks < 2; ++ks) bV[ks] = *(const bf16x8*)(L + OFF_VT + (16 * w + l15) * TP + 64 * ks + 16 * q4);
        f32x4 O[4];
#pragma unroll
        for (int mt = 0; mt < 4; ++mt) { O[mt] = (f32x4){0.f, 0.f, 0.f, 0.f};
#pragma unroll
            for (int ks = 0; ks < 2; ++ks) { const bf16x8 aF = *(const bf16x8*)(L + OFF_A + (16 * mt + l15) * AP + 64 * ks + 16 * q4); O[mt] = __builtin_amdgcn_mfma_f32_16x16x32_bf16(aF, bV[ks], O[mt], 0, 0, 0); } }
#pragma unroll
        for (int kq = 0; kq < 4; ++kq) {
            u32x4 sw; sw.x = pk2(S[2 * kq].x, S[2 * kq].y); sw.y = pk2(S[2 * kq].z, S[2 * kq].w); sw.z = pk2(S[2 * kq + 1].x, S[2 * kq + 1].y); sw.w = pk2(S[2 * kq + 1].z, S[2 * kq + 1].w);
            const bf16x8 bS = __builtin_bit_cast(bf16x8, sw);
#pragma unroll
            for (int mt = 0; mt < 4; ++mt) { const unsigned char* qp = L + OFF_QG + (16 * mt + l15) * QP + 64 * kq + 8 * q4;
                const u32x2 lo = *(const u32x2*)qp, hi = *(const u32x2*)(qp + 32);
                const bf16x8 aF = __builtin_bit_cast(bf16x8, (u32x4){lo.x, lo.y, hi.x, hi.y});
                O[mt] = __builtin_amdgcn_mfma_f32_16x16x32_bf16(aF, bS, O[mt], 0, 0, 0); } }
#pragma unroll
        for (int dt = 0; dt < 8; ++dt) { const f32x4 dc = *(const f32x4*)(dec + 16 * dt + 4 * q4); S[dt] = S[dt] * dc;
#pragma unroll
            for (int ks = 0; ks < 2; ++ks) { const bf16x8 aF = *(const bf16x8*)(L + OFF_KET + (16 * dt + l15) * TP + 64 * ks + 16 * q4); S[dt] = __builtin_amdgcn_mfma_f32_16x16x32_bf16(aF, bV[ks], S[dt], 0, 0, 0); } }
        HSEC_E(6); HSEC_B();
#pragma unroll
        for (int mt = 0; mt < 4; ++mt)
#pragma unroll
            for (int r = 0; r < 4; ++r) { float p = O[mt][r] * O[mt][r]; p += __shfl_xor(p, 1); p += __shfl_xor(p, 2); p += __shfl_xor(p, 4); p += __shfl_xor(p, 8);
                if (l15 == 0) part[w * 64 + 16 * mt + 4 * q4 + r] = p; }
        __syncthreads();
        if (tid < 64) { float s = 0.f;
#pragma unroll
            for (int ww = 0; ww < 8; ++ww) s += part[ww * 64 + tid];
            rstd[tid] = rsqrtf(s * (1.0f / 128.0f) + 1e-6f); }
        __syncthreads();
        HSEC_E(7); HSEC_B();
#pragma unroll
        for (int mt = 0; mt < 4; ++mt) { const f32x4 rs = *(const f32x4*)(rstd + 16 * mt + 4 * q4);
#pragma unroll
            for (int r = 0; r < 4; ++r) { const float g = bf2f(gq[4 * mt + r]); const float o = O[mt][r] * rs[r] * ng * (g * __builtin_amdgcn_rcpf(1.0f + __expf(-g)));
                HO[(size_t)(r0 + 16 * mt + 4 * q4 + r) * 2048 + 16 * w + l15] = (bf16)f2bf(o); } }
        HSEC_E(8);
    }
    __syncthreads();
}

__device__ __forceinline__ void ph2_side(const Frame& F, int sid, int nside) {
    const Args& a = *F.a;
    const int gw = sid * 8 + F.wave, NGW = nside * 8, lane = F.lane();
    bf16* CKV = (bf16*)(F.ws + WS_CKV); bf16* IKW = (bf16*)(F.ws + WS_IKW);
    for (int row = gw; row < T; row += NGW) {
        {   u32x2 w = *(u32x2*)(CKV + (size_t)row * 256 + 4 * lane);
            float x0 = bflo(w.x), x1 = bfhi(w.x), x2 = bflo(w.y), x3 = bfhi(w.y);
            const float ss = wave_sum(x0 * x0 + x1 * x1 + x2 * x2 + x3 * x3);
            const float r = rsqrtf(ss * (1.0f / 256.0f) + 1e-6f);
            const f32x4 g = *(const f32x4*)(a.in[5] + 4 * lane);
            w.x = pk2(x0 * r * g.x, x1 * r * g.y); w.y = pk2(x2 * r * g.z, x3 * r * g.w);
            *(u32x2*)(CKV + (size_t)row * 256 + 4 * lane) = w; }
        {   unsigned w = *(unsigned*)(IKW + (size_t)row * 256 + 2 * lane);
            float x0 = bflo(w), x1 = bfhi(w);
            const float mu = wave_sum(x0 + x1) * (1.0f / 128.0f);
            x0 -= mu; x1 -= mu;
            const float var = wave_sum(x0 * x0 + x1 * x1) * (1.0f / 128.0f);
            const float r = rsqrtf(var + 1e-5f);
            const float g0 = a.in[6][2 * lane], g1 = a.in[6][2 * lane + 1], b0 = a.in[7][2 * lane], b1 = a.in[7][2 * lane + 1];
            *(unsigned*)(IKW + (size_t)row * 256 + 2 * lane) = pk2(x0 * r * g0 + b0, x1 * r * g1 + b1); }
    }
    float* scr = (float*)(F.lds + F.wave * 16384);
    for (int it = gw; it < 8 * 2048; it += NGW) { const int m = it >> 11;
        const float* wsrc = m == 0 ? a.in[11] : m == 1 ? a.in[12] : m == 2 ? a.in[13] : m == 3 ? a.in[16] : m == 4 ? a.in[17] : m == 5 ? a.in[18] : m == 6 ? a.in[19] : a.in[22];
        float* cv = (float*)(F.ws + WS_CTL + CTL_CVEC);
        if (m == 3) transpose_item_ln(wsrc, (bf16*)(F.ws + WS_WIN + (size_t)m * 8 * MiB), it & 2047, scr, lane, a.in[14], a.in[15], cv, cv + 2048);
        else if (m == 7) transpose_item_ln(wsrc, (bf16*)(F.ws + WS_WIN + (size_t)m * 8 * MiB), it & 2047, scr, lane, a.in[20], a.in[21], cv + 4096, cv + 6144);
        else transpose_item(wsrc, 2048, (bf16*)(F.ws + WS_WIN + (size_t)m * 8 * MiB), 2048, 0, 64, it & 2047, scr, lane, CmIdent()); }
}

__device__ __forceinline__ void ph3_hgnorm(const Frame& F) {
    const Args& a = *F.a;
    const int gw = F.bid * 8 + F.wave, NGW = F.G * 8, lane = F.lane();
    const float* oraw = a.out; const bf16* HG = F.slot(3); bf16* HO = F.slot(0);
    for (int u = gw; u < T * 16; u += NGW) {
        const size_t off = (size_t)(u >> 4) * 2048 + (u & 15) * 128 + 2 * lane;
        const float o0 = oraw[off], o1 = oraw[off + 1];
        const float r = rsqrtf(wave_sum(o0 * o0 + o1 * o1) * (1.0f / 128.0f) + 1e-6f);
        const unsigned gw2 = *(const unsigned*)(HG + off);
        const float g0 = bflo(gw2), g1 = bfhi(gw2);
        const int c = (u & 15) * 128 + 2 * lane;
        *(unsigned*)(HO + off) = pk2(o0 * r * a.in[4][c] * (g0 * sigm(g0)), o1 * r * a.in[4][c + 1] * (g1 * sigm(g1)));
    }
}

__device__ __forceinline__ unsigned fkey(float f) { const unsigned u = __float_as_uint(f); return (u & 0x80000000u) ? ~u : (u | 0x80000000u); }
__device__ __forceinline__ void ph5_select(const Frame& F) {
    const int lane = F.lane(), l31 = lane & 31, half = lane >> 5, w = F.wave;
    float* scl = (float*)F.lds;
    const bf16* AIQ = F.slot(5); const bf16* IKW = (const bf16*)(F.ws + WS_IKW);
    unsigned* MASK = (unsigned*)(F.ws + WS_MASK);
    for (int i = F.bid; i < 1024; i += F.G) {
        const int r4 = i >> 8, c = i & 255, j = c & 127, b = 2 * r4 + (c >> 7), qt = (r4 & 1) ? 127 - j : j, t0 = qt * 16;
        bf16x8 Af[8];
        { const size_t rowA = (size_t)b * 2048 + t0 + 2 * w + ((l31 >> 2) & 1); const int headA = (l31 & 3) + 4 * (l31 >> 3);
#pragma unroll
          for (int ks = 0; ks < 8; ++ks) Af[ks] = *(const bf16x8*)(AIQ + rowA * 2048 + headA * 128 + 16 * ks + 8 * half); }
        float wr[16];
        { const bf16* wp = IKW + ((size_t)b * 2048 + t0 + 2 * w + half) * 256 + 128;
#pragma unroll
          for (int r = 0; r < 16; ++r) wr[r] = bf2f(wp[(r & 3) + 4 * (r >> 2)]) * (0.25f * 0.08838834764831845f); }
        const int nkt = (t0 + 15) / 32 + 1;
        unsigned char* ring = F.lds + 131072;
        const int srow = (w * 64 + lane) >> 4, sch = lane & 15;
        const bf16* kg = IKW + ((size_t)b * 2048 + srow) * 256 + 8 * sch;
        const int swr = srow * 256 + ((sch ^ (srow & 15)) << 4);
        const int frd = l31 * 256;
        u32x4 st0, st1;
        st0 = *(const u32x4*)kg; *(u32x4*)(ring + swr) = st0;
        if (nkt > 1) { st1 = *(const u32x4*)(kg + (size_t)32 * 256); *(u32x4*)(ring + 8192 + swr) = st1; }
        if (nkt > 2) st0 = *(const u32x4*)(kg + (size_t)2 * 32 * 256);
        __syncthreads();
#define IDX_TILE(kt_, STW, STL) do { \
            if ((kt_) + 3 < nkt) STL = *(const u32x4*)(kg + (size_t)((kt_) + 3) * 32 * 256); \
            { const unsigned char* sl_ = ring + ((kt_) % 3) * 8192 + frd; f32x16 acc; _Pragma("unroll") for (int r = 0; r < 16; ++r) acc[r] = 0.f; \
              _Pragma("unroll") for (int ks = 0; ks < 8; ++ks) { const bf16x8 bfr = *(const bf16x8*)(sl_ + (((2 * ks + half) ^ (l31 & 15)) << 4)); acc = __builtin_amdgcn_mfma_f32_32x32x16_bf16(Af[ks], bfr, acc, 0, 0, 0); } \
              float sc = 0.f; _Pragma("unroll") for (int r = 0; r < 16; ++r) sc += fmaxf(acc[r], 0.f) * wr[r]; \
              scl[(2 * w + half) * 2048 + (kt_) * 32 + l31] = sc; } \
            if ((kt_) + 2 < nkt) *(u32x4*)(ring + (((kt_) + 2) % 3) * 8192 + swr) = STW; \
            __syncthreads(); } while (0)
        for (int kt = 0; kt < nkt; kt += 2) { IDX_TILE(kt, st0, st1); if (kt + 1 < nkt) IDX_TILE(kt + 1, st1, st0); }
#undef IDX_TILE
        WAVE_SYNC();
#pragma unroll 1
        for (int qi = 0; qi < 2; ++qi) {
            const int t = t0 + 2 * w + qi; const float* row = scl + (2 * w + qi) * 2048;
            unsigned key[32];
#pragma unroll
            for (int jj = 0; jj < 32; ++jj) { const int s2 = lane + 64 * jj; key[jj] = (s2 <= t) ? fkey(row[s2]) : 0u; }
            unsigned thr = 0u;
            if (t + 1 > 256) {
                for (int bit = 31; bit >= 0; --bit) {
                    const unsigned cand = thr | (1u << bit);
                    int cnt = 0;
#pragma unroll
                    for (int jj = 0; jj < 32; ++jj) cnt += (key[jj] >= cand) ? 1 : 0;
#pragma unroll
                    for (int o = 32; o >= 1; o >>= 1) cnt += __shfl_xor(cnt, o);
                    if (cnt >= 256) { thr = cand; if (cnt == 256) break; }
                }
            }
            unsigned wd = 0u;
#pragma unroll
            for (int jj = 0; jj < 32; ++jj) { const int s2 = lane + 64 * jj; const unsigned long long m = __ballot(s2 <= t && key[jj] >= thr);
                if (lane == 2 * jj) wd = (unsigned)m; if (lane == 2 * jj + 1) wd = (unsigned)(m >> 32); }
            MASK[((size_t)b * 2048 + t) * 64 + lane] = wd;
        }
        WAVE_SYNC();
    }
}

__device__ __forceinline__ int t5_bucket(int d) {
    if (d < 16) return d;
    return 16 + (d >= 19) + (d >= 21) + (d >= 24) + (d >= 27) + (d >= 31) + (d >= 35) + (d >= 40) + (d >= 46) + (d >= 52) + (d >= 59) + (d >= 67) + (d >= 77) + (d >= 87) + (d >= 99) + (d >= 113);
}
namespace dsa {
constexpr float SCALE = 0.08838834764831845f;
constexpr int NW = 8, QBLK = 32, KVBLK = 64, QB = NW * QBLK, DH = 128, LD = 2048;
constexpr int SHM_V = KVBLK * DH * 2, SHM_K = KVBLK * DH * 2;
constexpr int OFF_WS = 2 * SHM_V + 2 * SHM_K, OFF_BIAS = OFF_WS + NW * 64 * 4, LDS_TOTAL = OFF_BIAS + 16 * 128 * 4;
constexpr float THR = 8.f;
typedef short s16x4 __attribute__((ext_vector_type(4)));
#define KSWZ(row, colB) ((row) * 256 + ((colB) ^ (((row) & 7) << 4)))
#define SBAR() __builtin_amdgcn_sched_barrier(0)
__device__ __forceinline__ int v_st(int k, int c) { const int kk = (k & ~0xC) | ((k & 4) << 1) | ((k & 8) >> 1); return ((kk >> 3) * 4 + (c >> 5)) * 512 + ((kk & 7) * 32 + (c & 31)) * 2; }
__device__ __forceinline__ int v_rd_base(int lane) { return ((lane & 3) << 3) | (((lane >> 2) & 3) << 6) | (((lane >> 4) & 1) << 5) | (((lane >> 5) & 1) << 8); }
constexpr int v_rd_off(int d0, int ks, int half) { return d0 * 512 + ks * 4096 + half * 2048; }
__device__ __forceinline__ int crow(int r, int hi) { return (r & 3) + 8 * (r >> 2) + 4 * hi; }
__device__ __forceinline__ unsigned cvtpk(float lo, float hi) { unsigned r; asm volatile("v_cvt_pk_bf16_f32 %0, %1, %2" : "=v"(r) : "v"(lo), "v"(hi)); return r; }
__device__ __forceinline__ bf16x8 load8(const bf16* p) { return *reinterpret_cast<const bf16x8*>(p); }
template <bool NEAR>
__device__ __forceinline__ void init_scores(f32x16& p0, f32x16& p1, unsigned w0, unsigned w1, int hi, int dq, const float* bl) {
    w0 >>= 4 * hi; w1 >>= 4 * hi;
#pragma unroll
    for (int r = 0; r < 16; ++r) { const int c = (r & 3) + 8 * (r >> 2);
        const int x0 = __builtin_amdgcn_sbfe(w0, c, 1), x1 = __builtin_amdgcn_sbfe(w1, c, 1);
        unsigned b0 = 0u, b1 = 0u;
        if (NEAR) { int d0 = dq - c, d1 = dq - c - 32; d0 = d0 < 0 ? 0 : (d0 > 127 ? 127 : d0); d1 = d1 < 0 ? 0 : (d1 > 127 ? 127 : d1);
            b0 = __float_as_uint(bl[d0]); b1 = __float_as_uint(bl[d1]); }
        p0[r] = __uint_as_float((b0 & (unsigned)x0) | (0xFF800000u & ~(unsigned)x0));
        p1[r] = __uint_as_float((b1 & (unsigned)x1) | (0xFF800000u & ~(unsigned)x1)); }
}
__device__ __forceinline__ void partialSM(f32x16& p0, f32x16& p1, float& m_reg, float& mn, float& alpha) {
    float pmax = p0[0];
#pragma unroll
    for (int r = 1; r < 16; ++r) pmax = fmaxf(pmax, p0[r]);
#pragma unroll
    for (int r = 0; r < 16; ++r) pmax = fmaxf(pmax, p1[r]);
    { auto rr = __builtin_amdgcn_permlane32_swap(__float_as_uint(pmax), __float_as_uint(pmax), false, false);
      pmax = fmaxf(__uint_as_float(rr[0]), __uint_as_float(rr[1])); }
    constexpr float C2 = 1.4426950408889634f * SCALE;
    if (__builtin_expect(__all((pmax - m_reg) * SCALE <= THR), 1)) { mn = m_reg; alpha = 1.f; }
    else { mn = fmaxf(m_reg, pmax); alpha = __builtin_amdgcn_exp2f((m_reg - mn) * C2); m_reg = mn; }
    const float mnL = -mn * C2;
#pragma unroll
    for (int r = 0; r < 16; ++r) p0[r] = fmaf(p0[r], C2, mnL);
#pragma unroll
    for (int r = 0; r < 16; ++r) p1[r] = fmaf(p1[r], C2, mnL);
#pragma unroll
    for (int r = 0; r < 16; ++r) p0[r] = __builtin_amdgcn_exp2f(p0[r]);
}
__device__ __forceinline__ void finishSM(f32x16& p0, f32x16& p1, float alpha, float& l_reg, bf16x8& pa0, bf16x8& pa1, bf16x8& pa2, bf16x8& pa3) {
#pragma unroll
    for (int r = 0; r < 16; ++r) p1[r] = __builtin_amdgcn_exp2f(p1[r]);
    float ps = 0;
#pragma unroll
    for (int r = 0; r < 16; ++r) ps += p0[r];
#pragma unroll
    for (int r = 0; r < 16; ++r) ps += p1[r];
    { auto rr = __builtin_amdgcn_permlane32_swap(__float_as_uint(ps), __float_as_uint(ps), false, false);
      ps = __uint_as_float(rr[0]) + __uint_as_float(rr[1]); }
    l_reg = l_reg * alpha + ps;
#define PK4(P, B_, OUT) do { unsigned a0 = cvtpk(P[B_+0], P[B_+1]), a1 = cvtpk(P[B_+2], P[B_+3]);                          \
        unsigned b0 = cvtpk(P[B_+4], P[B_+5]), b1 = cvtpk(P[B_+6], P[B_+7]);                                             \
        auto r0 = __builtin_amdgcn_permlane32_swap(a0, b0, false, false); auto r1 = __builtin_amdgcn_permlane32_swap(a1, b1, false, false); \
        u32x4 w = {r0[0], r1[0], r0[1], r1[1]}; OUT = *reinterpret_cast<bf16x8*>(&w); } while (0)
    PK4(p0, 0, pa0); PK4(p0, 8, pa1); PK4(p1, 0, pa2); PK4(p1, 8, pa3);
#undef PK4
}
template <int KB>
__device__ __forceinline__ void qkt(f32x16& p0, f32x16& p1, const char* K_lds, int r32, int hi, const bf16x8* qr) {
    const char* kb[4];
#pragma unroll
    for (int dd = 0; dd < 4; ++dd) kb[dd] = K_lds + KB * SHM_K + KSWZ(r32, (dd * 16 + hi * 8) * 2);
#pragma unroll
    for (int d0 = 0; d0 < 8; ++d0) { const char* a = kb[d0 & 3] + (d0 >> 2) * 128;
        bf16x8 b0 = *reinterpret_cast<const bf16x8*>(a);
        bf16x8 b1 = *reinterpret_cast<const bf16x8*>(a + 32 * 256);
        p0 = __builtin_amdgcn_mfma_f32_32x32x16_bf16(b0, qr[d0], p0, 0, 0, 0);
        p1 = __builtin_amdgcn_mfma_f32_32x32x16_bf16(b1, qr[d0], p1, 0, 0, 0); }
}
template <int VB>
__device__ __forceinline__ void pv_tile(f32x16* o, int vb0, bf16x8 pa0, bf16x8 pa1, bf16x8 pa2, bf16x8 pa3) {
#define TRRD(dst, off) asm volatile("ds_read_b64_tr_b16 %0, %1 offset:%2" : "=&v"(dst) : "v"(vb0), "i"(off) : "memory")
#define PV_D0(d0) do { s16x4 l0, l1, l2, l3, h0, h1, h2, h3; constexpr int b_ = VB * SHM_V + v_rd_off(d0, 0, 0); \
        TRRD(l0, b_); TRRD(h0, b_ + 2048); TRRD(l1, b_ + 4096); TRRD(h1, b_ + 6144); TRRD(l2, b_ + 8192); TRRD(h2, b_ + 10240); TRRD(l3, b_ + 12288); TRRD(h3, b_ + 14336); \
        asm volatile("s_waitcnt lgkmcnt(0)" ::: "memory"); SBAR();   \
        o[d0] = __builtin_amdgcn_mfma_f32_32x32x16_bf16(pa0, (bf16x8){l0[0], l0[1], l0[2], l0[3], h0[0], h0[1], h0[2], h0[3]}, o[d0], 0, 0, 0);   \
        o[d0] = __builtin_amdgcn_mfma_f32_32x32x16_bf16(pa1, (bf16x8){l1[0], l1[1], l1[2], l1[3], h1[0], h1[1], h1[2], h1[3]}, o[d0], 0, 0, 0);   \
        o[d0] = __builtin_amdgcn_mfma_f32_32x32x16_bf16(pa2, (bf16x8){l2[0], l2[1], l2[2], l2[3], h2[0], h2[1], h2[2], h2[3]}, o[d0], 0, 0, 0);   \
        o[d0] = __builtin_amdgcn_mfma_f32_32x32x16_bf16(pa3, (bf16x8){l3[0], l3[1], l3[2], l3[3], h3[0], h3[1], h3[2], h3[3]}, o[d0], 0, 0, 0); } while (0)
    PV_D0(0); PV_D0(1); PV_D0(2); PV_D0(3);
#undef PV_D0
#undef TRRD
}
struct BlockRef { const bf16* Q; const bf16* K; const bf16* V; bf16* O; const unsigned* M; int P0; int h; };
struct Seam { bf16x8 qr[8]; bf16x8 st_v0, st_v1, st_k0, st_k1; };
#define ROWU(p, k0) ((p) + (size_t)(k0) * LD)
#define VMW() asm volatile("s_waitcnt vmcnt(0)" ::: "memory")
#define VMWN(n) asm volatile("s_waitcnt vmcnt(%0)" :: "i"(n) : "memory")
#define SLOAD_H(Kp, Vp, k0) do { S.st_v0 = load8(ROWU(Vp, k0) + sofs); S.st_v1 = load8(ROWU(Vp, (k0) + 32) + sofs);              \
                         S.st_k0 = load8(ROWU(Kp, k0) + sofs); S.st_k1 = load8(ROWU(Kp, (k0) + 32) + sofs); } while (0)
#define SWRITE_HK(bf) do { *(bf16x8*)(K_lds + (bf) * SHM_K + kws) = S.st_k0; *(bf16x8*)(K_lds + (bf) * SHM_K + kws + 32 * 256) = S.st_k1; } while (0)
#define SWRITE_HV(bf) do { *(bf16x8*)(V_lds + (bf) * SHM_V + vst0) = S.st_v0; *(bf16x8*)(V_lds + (bf) * SHM_V + vst1) = S.st_v1; } while (0)
#define SWRITE_H(bf) do { SWRITE_HV(bf); SWRITE_HK(bf); } while (0)
__device__ __forceinline__ void prime(const BlockRef& cur, char* lds, Seam& S, int wid) {
    const int lane = fresh_lane(), tid = wid * 64 + lane, r32 = lane & 31, hi = lane >> 5;
    const int sr = tid >> 4, sc = (tid & 15) * 8, kws = KSWZ(sr, sc * 2); char* K_lds = lds + 2 * SHM_V; const unsigned sofs = (unsigned)(sr * LD + sc);
    const unsigned qofs = (unsigned)((wid * QBLK + r32) * LD + hi * 8);
#pragma unroll
    for (int d0 = 0; d0 < 8; ++d0) S.qr[d0] = load8(cur.Q + qofs + d0 * 16);
    SLOAD_H(cur.K, cur.V, 0); VMW(); SWRITE_HK(0);
    __syncthreads();
}
__device__ __forceinline__ void block(const BlockRef& cur, const BlockRef& nxt, char* lds, Seam& S, int wid) {
    const int lane = fresh_lane(), tid = wid * 64 + lane,
               r32 = lane & 31, hi = lane >> 5;
    const int NT = (cur.P0 + QB - 1) / KVBLK + 1;
    const int qlo = cur.P0 + wid * QBLK, qm = qlo + r32 - 4 * hi;
    char* V_lds = lds; char* K_lds = lds + 2 * SHM_V;
    float* ws = (float*)(lds + OFF_WS) + wid * 64; float* li_l = ws, * al_l = ws + 32;
    const float* bl = (const float*)(lds + OFF_BIAS) + cur.h * 128;
    const unsigned mofs = (unsigned)((wid * QBLK + r32) * 64);
    float m_reg = -1e30f, l_reg = 0; f32x16 o[4] = {};
    const int sr = tid >> 4, sc = (tid & 15) * 8, vst0 = v_st(sr, sc), vst1 = v_st(32 + sr, sc), kws = KSWZ(sr, sc * 2); const unsigned sofs = (unsigned)(sr * LD + sc);
    const int vb0 = (int)(uintptr_t)V_lds + v_rd_base(lane);
    const bf16* Kh = cur.K; const bf16* Vh = cur.V;
#define RESC(a) do { if (__any((a) < 1.f)) { if (hi == 0) al_l[r32] = (a); asm volatile("s_waitcnt lgkmcnt(0)" ::: "memory");              \
                     for (int d_ = 0; d_ < 4; ++d_) for (int r = 0; r < 16; ++r) o[d_][r] *= al_l[crow(r, hi)]; } } while (0)
#define KBASE(t) ((t) * KVBLK)
#define LDMASK(t) (*(const u32x2*)(cur.M + 2 * ((t) < 31 ? (t) : 31) + mofs))
#define INIT(P0_, P1_, t) do { const int kb_ = KBASE(t); if (qlo - kb_ - 63 < 113) init_scores<true>(P0_, P1_, mw.x, mw.y, hi, qm - kb_, bl); else init_scores<false>(P0_, P1_, mw.x, mw.y, hi, 0, bl); } while (0)
#define SEAM_K0() do { VMWN(8); SWRITE_HK(0); SBAR(); } while (0)
    f32x16 pA0, pA1, pB0, pB1; float mnA, mnB, alA, alB; bf16x8 pa0, pa1, pa2, pa3; u32x2 mw;
    SWRITE_HV(0); SBAR();
    if (NT > 1) { SLOAD_H(Kh, Vh, KBASE(1)); }
    mw = LDMASK(0); INIT(pA0, pA1, 0); mw = LDMASK(1);
    SBAR(); qkt<0>(pA0, pA1, K_lds, r32, hi, S.qr);
    partialSM(pA0, pA1, m_reg, mnA, alA);
    if (NT > 1) { VMW(); SWRITE_H(1); }
    __syncthreads();
#define HALF_STEP(PX0, PX1, mnX, alX, PY0, PY1, alY, t, KB, VB, SB) do {                                                      \
        INIT(PX0, PX1, (t)); mw = LDMASK((t) + 1);                                                                           \
        SBAR(); qkt<KB>(PX0, PX1, K_lds, r32, hi, S.qr);                                                                      \
        finishSM(PY0, PY1, alY, l_reg, pa0, pa1, pa2, pa3); SBAR();                                                           \
        if ((t) + 1 < NT) { SLOAD_H(Kh, Vh, KBASE((t) + 1)); SBAR(); }                                                        \
        pv_tile<VB>(o, vb0, pa0, pa1, pa2, pa3); partialSM(PX0, PX1, m_reg, mnX, alX);              \
        __syncthreads();                                                                                                      \
        if ((t) + 1 < NT) { VMW(); SWRITE_H(SB); }                                                                            \
        RESC(alX); __syncthreads(); } while (0)
    for (int t = 1; t + 1 < NT; t += 2) {
        HALF_STEP(pB0, pB1, mnB, alB, pA0, pA1, alA, t, 1, 0, 0);
        HALF_STEP(pA0, pA1, mnA, alA, pB0, pB1, alB, t + 1, 0, 1, 1);
    }
    const bool even = (NT & 1) == 0;
    if (even) { INIT(pB0, pB1, NT - 1); SBAR(); qkt<1>(pB0, pB1, K_lds, r32, hi, S.qr); SBAR(); }
    SLOAD_H(nxt.K, nxt.V, 0); SBAR();
#pragma unroll
    for (int d0 = 0; d0 < 8; ++d0) S.qr[d0] = load8(nxt.Q + (unsigned)((wid * QBLK + r32) * LD + hi * 8) + d0 * 16);
    SBAR();
    finishSM(pA0, pA1, alA, l_reg, pa0, pa1, pa2, pa3); SBAR();
    pv_tile<0>(o, vb0, pa0, pa1, pa2, pa3);
    if (even) { partialSM(pB0, pB1, m_reg, mnB, alB); __syncthreads(); RESC(alB);
        finishSM(pB0, pB1, alB, l_reg, pa0, pa1, pa2, pa3); SBAR(); pv_tile<1>(o, vb0, pa0, pa1, pa2, pa3); }
    SBAR(); SEAM_K0();
    if (hi == 0) li_l[r32] = l_reg; asm volatile("s_waitcnt lgkmcnt(0)" ::: "memory");
    float rli[16];
#pragma unroll
    for (int r = 0; r < 16; ++r) rli[r] = __builtin_amdgcn_rcpf(li_l[crow(r, hi)]);
    int lofs = 4 * hi * LD + r32; asm volatile("" : "+v"(lofs));
    bf16* Ow = cur.O + (size_t)(wid * QBLK) * LD + lofs;
#pragma unroll
    for (int r = 0; r < 16; ++r) { const int orow = (r & 3) + 8 * (r >> 2);
#pragma unroll
        for (int d0 = 0; d0 < 4; ++d0) { const float v = o[d0][r] * rli[r];
            const float vn = __shfl_xor(v, 1);
            if ((r32 & 1) == 0) *(unsigned*)(Ow + orow * LD + d0 * 32) = cvtpk(v, vn); } }
    __syncthreads();
#undef RESC
#undef KBASE
#undef LDMASK
#undef INIT
#undef SEAM_K0
#undef HALF_STEP
}
#undef ROWU
#undef VMW
#undef VMWN
#undef SLOAD_H
#undef SWRITE_HK
#undef SWRITE_HV
#undef SWRITE_H
#undef KSWZ
#undef SBAR
}

__device__ __forceinline__ dsa::BlockRef dsa_ref(const Frame& F, int bh, int qb) {
    const int b = bh >> 4, h = bh & 15;
    dsa::BlockRef r;
    r.Q = F.slot(4) + ((size_t)b * 2048 + (size_t)qb * 256) * 2048 + h * 128;
    r.O = F.slot(3) + ((size_t)b * 2048 + (size_t)qb * 256) * 2048 + h * 128;
    r.K = F.slot(1) + (size_t)b * 2048 * 2048 + h * 128; r.V = F.slot(2) + (size_t)b * 2048 * 2048 + h * 128;
    r.M = (const unsigned*)(F.ws + WS_MASK) + ((size_t)b * 2048 + (size_t)qb * 256) * 64;
    r.P0 = qb * 256; r.h = h;
    return r;
}
__device__ __forceinline__ void ph6_attn(const Frame& F) {
    const Args& a = *F.a;
    char* lds = (char*)F.lds;
    {
        float* bt = (float*)(lds + dsa::OFF_BIAS);
        for (int i = F.wave * 64 + F.lane(); i < 16 * 128; i += 512) { const int h = i >> 7, d = i & 127; bt[i] = (a.in[10][t5_bucket(d) * 16 + h] - a.in[10][31 * 16 + h]) * (1.0f / dsa::SCALE); }
    }
    __syncthreads();
    const int total = 4 * 128;
    int L = F.bid; if (L >= total) return;
    int pass = 0;
    dsa::BlockRef cur = dsa_ref(F, L >> 2, L & 3);
    dsa::Seam S;
    dsa::prime(cur, lds, S, F.wave);
    for (;;) {
        const bool more_pass = pass == 0, more_item = L + F.G < total, last = !more_pass && !more_item;
        int passn = pass + 1, Ln = L;
        if (!more_pass) { passn = 0; Ln = more_item ? L + F.G : L; }
        const dsa::BlockRef nxt = last ? cur : dsa_ref(F, Ln >> 2, passn ? 7 - (Ln & 3) : (Ln & 3));
        dsa::block(cur, nxt, lds, S, F.wave);
        if (last) break;
        cur = nxt; pass = passn; L = Ln;
    }
}

__device__ __forceinline__ void ln_row(float* zrow, const float* g, const float* bta, bf16* brow, int lane) {
    f32x4 v[8]; float s = 0.f;
#pragma unroll
    for (int i = 0; i < 8; ++i) { v[i] = *(const f32x4*)(zrow + 256 * i + 4 * lane); s += (v[i].x + v[i].y) + (v[i].z + v[i].w); }
    const float mu = wave_sum(s) * (1.0f / 2048.0f); float s2 = 0.f;
#pragma unroll
    for (int i = 0; i < 8; ++i) { v[i] = v[i] - mu; s2 += (v[i].x * v[i].x + v[i].y * v[i].y) + (v[i].z * v[i].z + v[i].w * v[i].w); }
    const float r = rsqrtf(wave_sum(s2) * (1.0f / 2048.0f) + 1e-5f);
#pragma unroll
    for (int i = 0; i < 8; ++i) { const f32x4 gg = *(const f32x4*)(g + 256 * i + 4 * lane), bb = *(const f32x4*)(bta + 256 * i + 4 * lane);
        const f32x4 o = v[i] * r * gg + bb; *(f32x4*)(zrow + 256 * i + 4 * lane) = o;
        if (brow) { u32x2 w; w.x = pk2(o.x, o.y); w.y = pk2(o.z, o.w); *(u32x2*)(brow + 256 * i + 4 * lane) = w; } }
}
__device__ __forceinline__ void ph_ln(const Frame& F, const float* g, const float* bta, bf16* bout) {
    const int gw = F.bid * 8 + F.wave, NGW = F.G * 8, lane = F.lane();
    for (int row = gw; row < T; row += NGW) ln_row(F.a->out + (size_t)row * 2048, g, bta, bout + (size_t)row * 2048, lane);
}

__device__ __forceinline__ float pk_idx(float v, unsigned code, unsigned mask) { return __uint_as_float((__float_as_uint(v) & ~mask) | code); }
__device__ __forceinline__ void ph_peer_select(const Frame& F) {
    const Args& a = *F.a;
    const int lane = F.lane(), l31 = lane & 31, half = lane >> 5;
    const float* PQ = (const float*)F.slot(1); const float* keys = a.in[23];
    int* EIDX = (int*)(F.ws + WS_CKV); float* EG = (float*)(F.ws + WS_IKW);
    const float NEG = -__builtin_inff();
    for (int tile = F.bid; tile < T / 32; tile += F.G) {
        const int h = F.wave, t = tile * 32 + l31;
        float tv[2][16];
#pragma unroll
        for (int p = 0; p < 2; ++p) {
            const int g = 2 * h + p;
            float qv[64];
            { const float* qp = PQ + (size_t)t * 2048 + g * 128 + 64 * half;
#pragma unroll
              for (int j = 0; j < 16; ++j) { const f32x4 v = *(const f32x4*)(qp + 4 * j); qv[4 * j] = v.x; qv[4 * j + 1] = v.y; qv[4 * j + 2] = v.z; qv[4 * j + 3] = v.w; } }
            f32x16 acc[4];
#pragma unroll
            for (int mt = 0; mt < 4; ++mt)
#pragma unroll
                for (int r = 0; r < 16; ++r) acc[mt][r] = 0.f;
            const float* kp0 = keys + ((size_t)(g * 128 + l31) * 128 + 64 * half);
            f32x4 kb[3][4];
#define PK_LOADC(cc) do { _Pragma("unroll") for (int u_ = 0; u_ < 4; ++u_) kb[(cc) % 3][u_] = *(const f32x4*)(kp0 + (size_t)((cc) >> 2) * 32 * 128 + 16 * ((cc) & 3) + 4 * u_); } while (0)
#define PK_MMAC(cc) do { _Pragma("unroll") for (int u_ = 0; u_ < 4; ++u_) { const f32x4 kv_ = kb[(cc) % 3][u_]; const int j_ = 4 * ((cc) & 3) + u_; \
                acc[(cc) >> 2] = __builtin_amdgcn_mfma_f32_32x32x2f32(kv_.x, qv[4 * j_], acc[(cc) >> 2], 0, 0, 0); acc[(cc) >> 2] = __builtin_amdgcn_mfma_f32_32x32x2f32(kv_.y, qv[4 * j_ + 1], acc[(cc) >> 2], 0, 0, 0); \
                acc[(cc) >> 2] = __builtin_amdgcn_mfma_f32_32x32x2f32(kv_.z, qv[4 * j_ + 2], acc[(cc) >> 2], 0, 0, 0); acc[(cc) >> 2] = __builtin_amdgcn_mfma_f32_32x32x2f32(kv_.w, qv[4 * j_ + 3], acc[(cc) >> 2], 0, 0, 0); } } while (0)
            PK_LOADC(0); PK_LOADC(1);
            PK_LOADC(2); PK_MMAC(0); __builtin_amdgcn_sched_barrier(0);
            PK_LOADC(3); PK_MMAC(1); __builtin_amdgcn_sched_barrier(0);
            PK_LOADC(4); PK_MMAC(2); __builtin_amdgcn_sched_barrier(0);
            PK_LOADC(5); PK_MMAC(3); __builtin_amdgcn_sched_barrier(0);
            PK_LOADC(6); PK_MMAC(4); __builtin_amdgcn_sched_barrier(0);
            PK_LOADC(7); PK_MMAC(5); __builtin_amdgcn_sched_barrier(0);
            PK_LOADC(8); PK_MMAC(6); __builtin_amdgcn_sched_barrier(0);
            PK_LOADC(9); PK_MMAC(7); __builtin_amdgcn_sched_barrier(0);
            PK_LOADC(10); PK_MMAC(8); __builtin_amdgcn_sched_barrier(0);
            PK_LOADC(11); PK_MMAC(9); __builtin_amdgcn_sched_barrier(0);
            PK_LOADC(12); PK_MMAC(10); __builtin_amdgcn_sched_barrier(0);
            PK_LOADC(13); PK_MMAC(11); __builtin_amdgcn_sched_barrier(0);
            PK_LOADC(14); PK_MMAC(12); __builtin_amdgcn_sched_barrier(0);
            PK_LOADC(15); PK_MMAC(13); __builtin_amdgcn_sched_barrier(0);
            PK_MMAC(14); __builtin_amdgcn_sched_barrier(0);
            PK_MMAC(15); __builtin_amdgcn_sched_barrier(0);
#undef PK_LOADC
#undef PK_MMAC
            unsigned hmask = ~(4u * (unsigned)half); asm volatile("" : "+v"(hmask));
#pragma unroll
            for (int mt = 0; mt < 4; ++mt)
#pragma unroll
                for (int r = 0; r < 16; ++r) acc[mt][r] = __uint_as_float(((__float_as_uint(acc[mt][r]) & ~127u) | (unsigned)(127 - (32 * mt + (r & 3) + 8 * (r >> 2)))) & hmask);
#pragma unroll
            for (int k = 0; k < 16; ++k) {
                float m = acc[0][0];
#pragma unroll
                for (int mt = 0; mt < 4; ++mt)
#pragma unroll
                    for (int r = 0; r < 16; ++r) m = fmaxf(m, acc[mt][r]);
                m = fmaxf(m, __shfl_xor(m, 32));
                tv[p][k] = m;
#pragma unroll
                for (int mt = 0; mt < 4; ++mt)
#pragma unroll
                    for (int r = 0; r < 16; ++r) acc[mt][r] = (acc[mt][r] == m) ? NEG : acc[mt][r];
            }
        }
        float cand[25]; int cid[25];
        unsigned hc = 25u * (unsigned)half; asm volatile("" : "+v"(hc));
        { const float ai = half ? tv[0][2] : tv[0][0], bj = half ? tv[1][1] : tv[1][0];
          cand[0] = pk_idx(ai + bj, (unsigned)(63 - 0) - hc, 63u); cid[0] = (int)((127u - (__float_as_uint(ai) & 127u)) * 128u + (127u - (__float_as_uint(bj) & 127u))); }
        { const float ai = half ? tv[0][2] : tv[0][0], bj = half ? tv[1][2] : tv[1][1];
          cand[1] = pk_idx(ai + bj, (unsigned)(63 - 1) - hc, 63u); cid[1] = (int)((127u - (__float_as_uint(ai) & 127u)) * 128u + (127u - (__float_as_uint(bj) & 127u))); }
        { const float ai = half ? tv[0][2] : tv[0][0], bj = half ? tv[1][3] : tv[1][2];
          cand[2] = pk_idx(ai + bj, (unsigned)(63 - 2) - hc, 63u); cid[2] = (int)((127u - (__float_as_uint(ai) & 127u)) * 128u + (127u - (__float_as_uint(bj) & 127u))); }
        { const float ai = half ? tv[0][2] : tv[0][0], bj = half ? tv[1][4] : tv[1][3];
          cand[3] = pk_idx(ai + bj, (unsigned)(63 - 3) - hc, 63u); cid[3] = (int)((127u - (__float_as_uint(ai) & 127u)) * 128u + (127u - (__float_as_uint(bj) & 127u))); }
        { const float ai = half ? tv[0][3] : tv[0][0], bj = half ? tv[1][0] : tv[1][4];
          cand[4] = pk_idx(ai + bj, (unsigned)(63 - 4) - hc, 63u); cid[4] = (int)((127u - (__float_as_uint(ai) & 127u)) * 128u + (127u - (__float_as_uint(bj) & 127u))); }
        { const float ai = half ? tv[0][3] : tv[0][0], bj = half ? tv[1][1] : tv[1][5];
          cand[5] = pk_idx(ai + bj, (unsigned)(63 - 5) - hc, 63u); cid[5] = (int)((127u - (__float_as_uint(ai) & 127u)) * 128u + (127u - (__float_as_uint(bj) & 127u))); }
        { const float ai = half ? tv[0][3] : tv[0][0], bj = half ? tv[1][2] : tv[1][6];
          cand[6] = pk_idx(ai + bj, (unsigned)(63 - 6) - hc, 63u); cid[6] = (int)((127u - (__float_as_uint(ai) & 127u)) * 128u + (127u - (__float_as_uint(bj) & 127u))); }
        { const float ai = half ? tv[0][3] : tv[0][0], bj = half ? tv[1][3] : tv[1][7];
          cand[7] = pk_idx(ai + bj, (unsigned)(63 - 7) - hc, 63u); cid[7] = (int)((127u - (__float_as_uint(ai) & 127u)) * 128u + (127u - (__float_as_uint(bj) & 127u))); }
        { const float ai = half ? tv[0][4] : tv[0][0], bj = half ? tv[1][0] : tv[1][8];
          cand[8] = pk_idx(ai + bj, (unsigned)(63 - 8) - hc, 63u); cid[8] = (int)((127u - (__float_as_uint(ai) & 127u)) * 128u + (127u - (__float_as_uint(bj) & 127u))); }
        { const float ai = half ? tv[0][4] : tv[0][0], bj = half ? tv[1][1] : tv[1][9];
          cand[9] = pk_idx(ai + bj, (unsigned)(63 - 9) - hc, 63u); cid[9] = (int)((127u - (__float_as_uint(ai) & 127u)) * 128u + (127u - (__float_as_uint(bj) & 127u))); }
        { const float ai = half ? tv[0][4] : tv[0][0], bj = half ? tv[1][2] : tv[1][10];
          cand[10] = pk_idx(ai + bj, (unsigned)(63 - 10) - hc, 63u); cid[10] = (int)((127u - (__float_as_uint(ai) & 127u)) * 128u + (127u - (__float_as_uint(bj) & 127u))); }
        { const float ai = half ? tv[0][5] : tv[0][0], bj = half ? tv[1][0] : tv[1][11];
          cand[11] = pk_idx(ai + bj, (unsigned)(63 - 11) - hc, 63u); cid[11] = (int)((127u - (__float_as_uint(ai) & 127u)) * 128u + (127u - (__float_as_uint(bj) & 127u))); }
        { const float ai = half ? tv[0][5] : tv[0][0], bj = half ? tv[1][1] : tv[1][12];
          cand[12] = pk_idx(ai + bj, (unsigned)(63 - 12) - hc, 63u); cid[12] = (int)((127u - (__float_as_uint(ai) & 127u)) * 128u + (127u - (__float_as_uint(bj) & 127u))); }
        { const float ai = half ? tv[0][6] : tv[0][0], bj = half ? tv[1][0] : tv[1][13];
          cand[13] = pk_idx(ai + bj, (unsigned)(63 - 13) - hc, 63u); cid[13] = (int)((127u - (__float_as_uint(ai) & 127u)) * 128u + (127u - (__float_as_uint(bj) & 127u))); }
        { const float ai = half ? tv[0][6] : tv[0][0], bj = half ? tv[1][1] : tv[1][14];
          cand[14] = pk_idx(ai + bj, (unsigned)(63 - 14) - hc, 63u); cid[14] = (int)((127u - (__float_as_uint(ai) & 127u)) * 128u + (127u - (__float_as_uint(bj) & 127u))); }
        { const float ai = half ? tv[0][7] : tv[0][0], bj = half ? tv[1][0] : tv[1][15];
          cand[15] = pk_idx(ai + bj, (unsigned)(63 - 15) - hc, 63u); cid[15] = (int)((127u - (__float_as_uint(ai) & 127u)) * 128u + (127u - (__float_as_uint(bj) & 127u))); }
        { const float ai = half ? tv[0][7] : tv[0][1], bj = half ? tv[1][1] : tv[1][0];
          cand[16] = pk_idx(ai + bj, (unsigned)(63 - 16) - hc, 63u); cid[16] = (int)((127u - (__float_as_uint(ai) & 127u)) * 128u + (127u - (__float_as_uint(bj) & 127u))); }
        { const float ai = half ? tv[0][8] : tv[0][1], bj = half ? tv[1][0] : tv[1][1];
          cand[17] = pk_idx(ai + bj, (unsigned)(63 - 17) - hc, 63u); cid[17] = (int)((127u - (__float_as_uint(ai) & 127u)) * 128u + (127u - (__float_as_uint(bj) & 127u))); }
        { const float ai = half ? tv[0][9] : tv[0][1], bj = half ? tv[1][0] : tv[1][2];
          cand[18] = pk_idx(ai + bj, (unsigned)(63 - 18) - hc, 63u); cid[18] = (int)((127u - (__float_as_uint(ai) & 127u)) * 128u + (127u - (__float_as_uint(bj) & 127u))); }
        { const float ai = half ? tv[0][10] : tv[0][1], bj = half ? tv[1][0] : tv[1][3];
          cand[19] = pk_idx(ai + bj, (unsigned)(63 - 19) - hc, 63u); cid[19] = (int)((127u - (__float_as_uint(ai) & 127u)) * 128u + (127u - (__float_as_uint(bj) & 127u))); }
        { const float ai = half ? tv[0][11] : tv[0][1], bj = half ? tv[1][0] : tv[1][4];
          cand[20] = pk_idx(ai + bj, (unsigned)(63 - 20) - hc, 63u); cid[20] = (int)((127u - (__float_as_uint(ai) & 127u)) * 128u + (127u - (__float_as_uint(bj) & 127u))); }
        { const float ai = half ? tv[0][12] : tv[0][1], bj = half ? tv[1][0] : tv[1][5];
          cand[21] = pk_idx(ai + bj, (unsigned)(63 - 21) - hc, 63u); cid[21] = (int)((127u - (__float_as_uint(ai) & 127u)) * 128u + (127u - (__float_as_uint(bj) & 127u))); }
        { const float ai = half ? tv[0][13] : tv[0][1], bj = half ? tv[1][0] : tv[1][6];
          cand[22] = pk_idx(ai + bj, (unsigned)(63 - 22) - hc, 63u); cid[22] = (int)((127u - (__float_as_uint(ai) & 127u)) * 128u + (127u - (__float_as_uint(bj) & 127u))); }
        { const float ai = half ? tv[0][14] : tv[0][1], bj = half ? tv[1][0] : tv[1][7];
          cand[23] = pk_idx(ai + bj, (unsigned)(63 - 23) - hc, 63u); cid[23] = (int)((127u - (__float_as_uint(ai) & 127u)) * 128u + (127u - (__float_as_uint(bj) & 127u))); }
        { const float ai = half ? tv[0][15] : tv[0][2], bj = half ? tv[1][0] : tv[1][0];
          cand[24] = pk_idx(ai + bj, (unsigned)(63 - 24) - hc, 63u); cid[24] = (int)((127u - (__float_as_uint(ai) & 127u)) * 128u + (127u - (__float_as_uint(bj) & 127u))); }
        float sv[16]; int sid[16];
#pragma unroll
        for (int k = 0; k < 16; ++k) {
            float m = cand[0];
#pragma unroll
            for (int c = 1; c < 25; ++c) m = fmaxf(m, cand[c]);
            const float mo = __shfl_xor(m, 32);
            const bool mine = (m > mo) || (m == mo && half == 0);
            const float mm = fmaxf(m, mo);
            int id = -1;
#pragma unroll
            for (int c = 0; c < 25; ++c) { const bool hit = mine && (cand[c] == mm); id = hit ? cid[c] : id; cand[c] = hit ? NEG : cand[c]; }
            const int ido = __shfl_xor(id, 32);
            sv[k] = mm; sid[k] = id > ido ? id : ido;
        }
        float den = 0.f; float ev[16];
#pragma unroll
        for (int k = 0; k < 16; ++k) { ev[k] = expf(sv[k] - sv[0]); den += ev[k]; }
        const float inv = 1.0f / den;
        if (half == 0) { int* ep = EIDX + (size_t)t * 128 + h * 16;
#pragma unroll
            for (int k = 0; k < 16; k += 4) *(u32x4*)(ep + k) = (u32x4){(unsigned)sid[k], (unsigned)sid[k + 1], (unsigned)sid[k + 2], (unsigned)sid[k + 3]}; }
        else { float* gp = EG + (size_t)t * 128 + h * 16;
#pragma unroll
            for (int k = 0; k < 16; k += 4) *(f32x4*)(gp + k) = (f32x4){ev[k] * inv, ev[k + 1] * inv, ev[k + 2] * inv, ev[k + 3] * inv}; }
    }
}

typedef float f32x2 __attribute__((ext_vector_type(2)));
constexpr float PU_SCALE = 1024.0f, PV_SCALE = 32.0f;
#define RL(v, l) __builtin_amdgcn_readlane((v), (l))
#define EXR 4
#define EX_LOAD(buf, tab, idv, e) do { _Pragma("unroll") for (int r_ = 0; r_ < EXR; ++r_) { const unsigned char* rp_ = (tab) + (size_t)RL(idv, ((e) & 63) + r_) * 2048 + 16 * lane; \
        buf[r_][0] = *(const u32x4*)rp_; buf[r_][1] = *(const u32x4*)(rp_ + 1024); } } while (0)
#define EX_W4(acc_, w_, xp_) do { const f32x2 l_ = __builtin_amdgcn_cvt_pk_f32_fp8((int)(w_), false), h_ = __builtin_amdgcn_cvt_pk_f32_fp8((int)(w_), true); \
        acc_ += l_.x * (xp_)[0] + l_.y * (xp_)[1]; acc_ += h_.x * (xp_)[2] + h_.y * (xp_)[3]; } while (0)
#define EX_DOT(buf, e) do { float d_[EXR]; _Pragma("unroll") for (int r_ = 0; r_ < EXR; ++r_) { float a_ = 0.f, b_ = 0.f; \
        _Pragma("unroll") for (int c_ = 0; c_ < 2; ++c_) { EX_W4(a_, buf[r_][c_].x, &xf[c_][0]); EX_W4(b_, buf[r_][c_].y, &xf[c_][4]); EX_W4(a_, buf[r_][c_].z, &xf[c_][8]); EX_W4(b_, buf[r_][c_].w, &xf[c_][12]); } d_[r_] = a_ + b_; } \
        _Pragma("unroll") for (int o_ = 32; o_ >= 1; o_ >>= 1) { _Pragma("unroll") for (int r_ = 0; r_ < EXR; ++r_) d_[r_] += __shfl_xor(d_[r_], o_); } \
        _Pragma("unroll") for (int r_ = 0; r_ < EXR; ++r_) { const float pre_ = d_[r_] * (1.0f / PU_SCALE); const float hv_ = 0.5f * pre_ * (1.0f + erff(pre_ * 0.7071067811865476f)); \
            if (lane == (((e) & 63) + r_)) { if ((e) < 64) c0 = g0 * hv_; else c1 = g1 * hv_; } } } while (0)
#define EX_A4(w_, yp_, cf_) do { const f32x2 l_ = __builtin_amdgcn_cvt_pk_f32_fp8((int)(w_), false), h_ = __builtin_amdgcn_cvt_pk_f32_fp8((int)(w_), true); \
        (yp_)[0] += (cf_) * l_.x; (yp_)[1] += (cf_) * l_.y; (yp_)[2] += (cf_) * h_.x; (yp_)[3] += (cf_) * h_.y; } while (0)
#define EX_AXPY(buf, e) do { const float cv_ = (e) < 64 ? c0 : c1; _Pragma("unroll") for (int r_ = 0; r_ < EXR; ++r_) { const float cf_ = __int_as_float(RL(__float_as_int(cv_), ((e) & 63) + r_)) * (1.0f / PV_SCALE); \
        _Pragma("unroll") for (int c_ = 0; c_ < 2; ++c_) { EX_A4(buf[r_][c_].x, &y[c_][0], cf_); EX_A4(buf[r_][c_].y, &y[c_][4], cf_); EX_A4(buf[r_][c_].z, &y[c_][8], cf_); EX_A4(buf[r_][c_].w, &y[c_][12], cf_); } } } while (0)
__device__ __forceinline__ void cvt_fp8_stream(const Frame& F, const float* src, unsigned char* dst, size_t n16, float scale) {
    const size_t gt = (size_t)F.bid * 512 + F.wave * 64 + F.lane(), NT = (size_t)F.G * 512;
#pragma unroll 2
    for (size_t i = gt; i < n16; i += NT) { const f32x4 a = ((const f32x4*)src)[4 * i] * scale, b = ((const f32x4*)src)[4 * i + 1] * scale, c = ((const f32x4*)src)[4 * i + 2] * scale, d = ((const f32x4*)src)[4 * i + 3] * scale;
        int w0 = 0, w1 = 0, w2 = 0, w3 = 0;
        w0 = __builtin_amdgcn_cvt_pk_fp8_f32(a.x, a.y, w0, false); w0 = __builtin_amdgcn_cvt_pk_fp8_f32(a.z, a.w, w0, true);
        w1 = __builtin_amdgcn_cvt_pk_fp8_f32(b.x, b.y, w1, false); w1 = __builtin_amdgcn_cvt_pk_fp8_f32(b.z, b.w, w1, true);
        w2 = __builtin_amdgcn_cvt_pk_fp8_f32(c.x, c.y, w2, false); w2 = __builtin_amdgcn_cvt_pk_fp8_f32(c.z, c.w, w2, true);
        w3 = __builtin_amdgcn_cvt_pk_fp8_f32(d.x, d.y, w3, false); w3 = __builtin_amdgcn_cvt_pk_fp8_f32(d.z, d.w, w3, true);
        ((u32x4*)dst)[i] = (u32x4){(unsigned)w0, (unsigned)w1, (unsigned)w2, (unsigned)w3}; }
}
__device__ __forceinline__ void ph16_experts(const Frame& F) {
    const Args& a = *F.a;
    const int gw = F.bid * 8 + F.wave, NGW = F.G * 8, lane = F.lane();
    const int* EIDX = (const int*)(F.ws + WS_CKV); const float* EG = (const float*)(F.ws + WS_IKW);
    const unsigned char* PU = (const unsigned char*)F.slot(5); const unsigned char* PV = PU + (size_t)32 * MiB;
    for (int t = gw; t < T; t += NGW) {
        float* xrow = a.out + (size_t)t * 2048;
        float xf[2][16];
        { float mu, rs; row_mu_rstd((const float*)(F.ws + WS_CTL + CTL_ST2), t, mu, rs);
          const bf16* zr = F.slot(0) + (size_t)t * 2048;
#pragma unroll
          for (int c = 0; c < 2; ++c)
#pragma unroll
              for (int q = 0; q < 2; ++q) { const int col = 1024 * c + 16 * lane + 8 * q; f32x4 z0, z1; unpack8v(*(const u32x4*)(zr + col), z0, z1);
                  const f32x4 g0 = *(const f32x4*)(a.in[20] + col), g1 = *(const f32x4*)(a.in[20] + col + 4), b0 = *(const f32x4*)(a.in[21] + col), b1 = *(const f32x4*)(a.in[21] + col + 4);
                  const f32x4 h0 = (z0 - mu) * rs * g0 + b0, h1 = (z1 - mu) * rs * g1 + b1;
                  xf[c][8 * q] = h0.x; xf[c][8 * q + 1] = h0.y; xf[c][8 * q + 2] = h0.z; xf[c][8 * q + 3] = h0.w; xf[c][8 * q + 4] = h1.x; xf[c][8 * q + 5] = h1.y; xf[c][8 * q + 6] = h1.z; xf[c][8 * q + 7] = h1.w; } }
        const int id0 = EIDX[(size_t)t * 128 + lane], id1 = EIDX[(size_t)t * 128 + 64 + lane];
        const float g0 = EG[(size_t)t * 128 + lane], g1 = EG[(size_t)t * 128 + 64 + lane];
        float c0 = 0.f, c1 = 0.f;
        u32x4 bA[EXR][2], bB[EXR][2];
        EX_LOAD(bA, PU, id0, 0);
        for (int e = 0; e < 128; e += 2 * EXR) {
            const int idv = e < 64 ? id0 : id1;
            EX_LOAD(bB, PU, idv, e + EXR);
            EX_DOT(bA, e);
            if (e + 2 * EXR < 128) { const int idn = (e + 2 * EXR) < 64 ? id0 : id1; EX_LOAD(bA, PU, idn, e + 2 * EXR); }
            EX_DOT(bB, e + EXR);
        }
        float y[2][16];
#pragma unroll
        for (int c = 0; c < 2; ++c)
#pragma unroll
            for (int j = 0; j < 16; ++j) y[c][j] = 0.f;
        EX_LOAD(bA, PV, id0, 0);
        for (int e = 0; e < 128; e += 2 * EXR) {
            const int idv = e < 64 ? id0 : id1;
            EX_LOAD(bB, PV, idv, e + EXR);
            EX_AXPY(bA, e);
            if (e + 2 * EXR < 128) { const int idn = (e + 2 * EXR) < 64 ? id0 : id1; EX_LOAD(bA, PV, idn, e + 2 * EXR); }
            EX_AXPY(bB, e + EXR);
        }
        float s = 0.f;
#pragma unroll
        for (int c = 0; c < 2; ++c)
#pragma unroll
            for (int j = 0; j < 16; ++j) { y[c][j] += ALPHA * xf[c][j]; s += y[c][j]; }
        const float mu = wave_sum(s) * (1.0f / 2048.0f); float s2 = 0.f;
#pragma unroll
        for (int c = 0; c < 2; ++c)
#pragma unroll
            for (int j = 0; j < 16; ++j) { y[c][j] -= mu; s2 += y[c][j] * y[c][j]; }
        const float rs = rsqrtf(wave_sum(s2) * (1.0f / 2048.0f) + 1e-5f);
        int lofs = 16 * lane; asm volatile("" : "+v"(lofs));
#pragma unroll
        for (int c = 0; c < 2; ++c)
#pragma unroll
            for (int q = 0; q < 4; ++q) { const int col = 1024 * c + lofs + 4 * q;
                const f32x4 ga = *(const f32x4*)(a.in[26] + col), ba = *(const f32x4*)(a.in[27] + col);
                f32x4 o; o.x = y[c][4 * q] * rs * ga.x + ba.x; o.y = y[c][4 * q + 1] * rs * ga.y + ba.y; o.z = y[c][4 * q + 2] * rs * ga.z + ba.z; o.w = y[c][4 * q + 3] * rs * ga.w + ba.w;
                *(f32x4*)(xrow + col) = o; }
    }
}

#define XB_TMO      128
#define XB_XCNT(j)  (256  + 64 * (j))
#define XB_XSUB(j)  (1280 + 64 * (j))
#define XB_XGEN(j)  (2304 + 64 * (j))
#define XB_TOP      3328
#define XB_TOPGEN   3392
#define XCD_BAR_WORDS 3456
#define XB_SPIN_CAP (1u << 22)
__device__ __forceinline__ unsigned xb_ld(unsigned* p)              { return __hip_atomic_load(p, __ATOMIC_RELAXED, __HIP_MEMORY_SCOPE_AGENT); }
__device__ __forceinline__ unsigned xb_add(unsigned* p, unsigned v) { return __hip_atomic_fetch_add(p, v, __ATOMIC_RELAXED, __HIP_MEMORY_SCOPE_AGENT); }
__device__ __forceinline__ unsigned xb_xcc_id() { return (unsigned)__builtin_amdgcn_s_getreg((3 << 11) | 20) & 0xFu; }
#define XB_SPIN(cond, bar) do { unsigned _sp = 0; while (cond) { __builtin_amdgcn_s_sleep(1); \
    if ((++_sp & 255u) == 0u) { if (xb_ld(&(bar)[XB_TMO])) break; if (_sp > XB_SPIN_CAP) { atomicAdd(&(bar)[XB_TMO], 1u); break; } } } } while (0)
struct XcdBarrier { unsigned* bar; unsigned x; volatile unsigned* st; };
__device__ __forceinline__ void xcd_barrier_complete(unsigned* bar, unsigned x, unsigned G, unsigned& nloc, unsigned& nx) {
    unsigned sum, cnt, mine, sp = 0u;
    for (;;) {
        sum = 0u; cnt = 0u; mine = 0u;
#pragma unroll
        for (unsigned j = 0; j < 16; ++j) { const unsigned c = xb_ld(&bar[XB_XCNT(j)]); sum += c; cnt += (c > 0u) ? 1u : 0u; mine = (j == x) ? c : mine; }
        if (sum == G) break;
        __builtin_amdgcn_s_sleep(1);
        if ((++sp & 255u) == 0u) { if (xb_ld(&bar[XB_TMO])) break; if (sp > XB_SPIN_CAP) { atomicAdd(&bar[XB_TMO], 1u); break; } }
    }
    nloc = mine > 0u ? mine : 1u; nx = cnt > 0u ? cnt : 1u;
}
__device__ __forceinline__ void xcd_barrier(const XcdBarrier& b, bool leader, unsigned G) {
    asm volatile("s_waitcnt vmcnt(0)" ::: "memory");
    __syncthreads();
    if (leader) {
        unsigned* bar = b.bar;
        __builtin_amdgcn_s_waitcnt(0);
        unsigned nloc = b.st[0], nx = b.st[1];
        if (nloc == 0u) { xcd_barrier_complete(bar, b.x, G, nloc, nx); b.st[0] = nloc; b.st[1] = nx; }
        const unsigned old = xb_add(&bar[XB_XSUB(b.x)], 1u);
        const unsigned gen = old / nloc;
        if (old + 1u == (gen + 1u) * nloc) {
            __builtin_amdgcn_fence(__ATOMIC_RELEASE, "agent");
            asm volatile("s_waitcnt vmcnt(0)" ::: "memory");
            const unsigned og = xb_add(&bar[XB_TOP], 1u);
            const unsigned tg = og / nx;
            if (og + 1u == (tg + 1u) * nx) xb_add(&bar[XB_TOPGEN], 1u);
            else XB_SPIN(xb_ld(&bar[XB_TOPGEN]) == tg, bar);
            __builtin_amdgcn_fence(__ATOMIC_ACQUIRE, "agent");
            xb_add(&bar[XB_XGEN(b.x)], 1u);
            asm volatile("s_waitcnt vmcnt(0)" ::: "memory");
        } else {
            XB_SPIN(xb_ld(&bar[XB_XGEN(b.x)]) == gen, bar);
            __builtin_amdgcn_fence(__ATOMIC_ACQUIRE, "agent");
            asm volatile("s_waitcnt vmcnt(0)" ::: "memory");
        }
    }
    __syncthreads();
}

__global__ void __launch_bounds__(512, 2) mega(Args args) {
    extern __shared__ __attribute__((aligned(16))) unsigned char lds[];
    cg::grid_group grid = cg::this_grid();
    Frame F;
    F.lds = lds; F.wave = __builtin_amdgcn_readfirstlane(threadIdx.x >> 6); F.bid = blockIdx.x; F.G = gridDim.x;
    F.a = &args; F.ws = args.ws;
    const int lo = args.ph_lo, hi = args.ph_hi;
    unsigned long long sec_acc = 0ull;
    if (lo < 0) grid.sync();
    volatile unsigned* xst = (volatile unsigned*)(lds + LDS_BYTES - 64);
    const bool leader = (F.wave == 0) && (fresh_lane() == 0);
    if (leader) { xst[0] = 0u; xst[1] = 0u; }
    XcdBarrier xbar; xbar.bar = (unsigned*)(F.ws + WS_CTL + CTL_BAR); xbar.x = xb_xcc_id(); xbar.st = xst;
    if (leader) (void)xb_add(&xbar.bar[XB_XCNT(xbar.x)], 1u);
    __syncthreads();
    bf16* W8 = (bf16*)(F.ws + WS_WIN);
#define IN(k) (lo <= (k) && (k) < hi)
#if PROBE_MASK
    unsigned long long pr_acc = 0ull, pr_t0 = rt_now();
#define SEAM(k) do { if (IN(k) && IN((k) + 1)) { xcd_barrier(xbar, (F.wave == 0) && (fresh_lane() == 0), (unsigned)F.G); } { const unsigned long long t1_ = rt_now(); if ((PROBE_MASK >> (k)) & 1u) pr_acc += t1_ - pr_t0; pr_t0 = t1_; } } while (0)
#else
#define SEAM(k) do { if (IN(k) && IN((k) + 1)) { xcd_barrier(xbar, (F.wave == 0) && (fresh_lane() == 0), (unsigned)F.G); } } while (0)
#endif
    if (IN(0)) { ph0_prologue(F); } SEAM(0);
    if (IN(1)) { gemm(F, (const bf16*)args.out, 2048, (const bf16*)(F.ws + WS_WIN), 2048, T, NCOLS, 2048, OpProj{F.ws}); } SEAM(1);
    if (IN(2)) {
        for (int u = F.bid; u < 128; u += F.G) hgrn_chunked(F, u, sec_acc);
        if (F.G > 128) { if (F.bid >= 128) ph2_side(F, F.bid - 128, F.G - 128); } else ph2_side(F, F.bid, F.G);
    } SEAM(2);
    if (IN(4)) {
        gemm(F, F.slot(0), 2048, W8, 2048, T, 2048, 2048, OpYA{F.slot(6)});
        gemm(F, (const bf16*)(F.ws + WS_CKV), 256, (const bf16*)(F.ws + WS_WKV), 256, T, 4096, 256, OpSplit2{F.slot(1), F.slot(2)});
    } SEAM(4);
    if (IN(5)) { ph5_select(F); } SEAM(5);
    if (IN(6)) { ph6_attn(F); } SEAM(6);
    if (IN(7)) { gemm(F, F.slot(3), 2048, W8 + (size_t)1 * 2048 * 2048, 2048, T, 2048, 2048, OpYB{F.slot(6), F.slot(7)}); } SEAM(7);
    if (IN(8)) { gemm_epi(F, F.slot(6), 2048, W8 + (size_t)2 * 2048 * 2048, 2048, T, 2048, 2048, EpiMixStats{args.in[0], F.slot(0), (float*)(F.ws + WS_CTL + CTL_ST1)}); } SEAM(8);
    if (IN(10)) {
        pg8::MultiOrder<3> S; S.lda = 2048; S.ldb = 2048; S.G = F.G; S.c = F.bid;
        S.s[0] = pg8::Sub{F.slot(0), W8 + (size_t)3 * 2048 * 2048, 64, 8};
        S.s[1] = pg8::Sub{(const bf16*)(F.ws + WS_MEMB), W8 + (size_t)4 * 2048 * 2048, 8, 8};
        S.s[2] = pg8::Sub{W8 + (size_t)5 * 2048 * 2048, (const bf16*)(F.ws + WS_MEMB), 8, 8};
        gemm_multi<3>(F, S, 2048, OpCQKV{F.slot(1), (bf16*)(F.ws + WS_CKV), (bf16*)(F.ws + WS_IKW), (float*)(F.ws + WS_CTL + CTL_ST1), (float*)(F.ws + WS_CTL + CTL_CVEC), (float*)(F.ws + WS_CTL + CTL_CVEC) + 2048});
    } SEAM(10);
    if (IN(11)) {
        pg8::BatchOrder<OffS> S{F.slot(1), (const bf16*)(F.ws + WS_CKV), 8, 1, 32, 2048, 2048, F.G, F.bid, OffS()};
        gemm_batch(F, S, 512, OpLogit{(float*)F.slot(2)});
    } SEAM(11);
    if (IN(12)) { ph_xsoftmax(F, (const float*)F.slot(2), F.slot(3));
        cvt_fp8_stream(F, args.in[24], (unsigned char*)F.slot(5), (size_t)16384 * 2048 / 16, PU_SCALE); cvt_fp8_stream(F, args.in[25], (unsigned char*)F.slot(5) + (size_t)32 * MiB, (size_t)16384 * 2048 / 16, PV_SCALE); } SEAM(12);
    if (IN(13)) {
        pg8::BatchOrder<OffPV> S{F.slot(3), (const bf16*)(F.ws + WS_IKW), 8, 2, 32, 1024, 2048, F.G, F.bid, OffPV()};
        gemm_batch(F, S, 256, OpCO{F.slot(4)});
    } SEAM(13);
    if (IN(14)) { gemm_epi(F, F.slot(4), 2048, W8 + (size_t)6 * 2048 * 2048, 2048, T, 2048, 2048, EpiCOStats{F.slot(0), (float*)(F.ws + WS_CTL + CTL_ST1), (float*)(F.ws + WS_CTL + CTL_ST2), args.in[14], args.in[15]}); } SEAM(14);
    if (IN(16)) { gemm(F, F.slot(0), 2048, W8 + (size_t)7 * 2048 * 2048, 2048, T, 2048, 2048, OpPQFold{(float*)F.slot(1), (float*)(F.ws + WS_CTL + CTL_ST2), (float*)(F.ws + WS_CTL + CTL_CVEC) + 4096, (float*)(F.ws + WS_CTL + CTL_CVEC) + 6144}); } SEAM(16);
    if (IN(17)) { ph_peer_select(F); } SEAM(17);
    if (IN(18)) { ph16_experts(F); }
#if PROBE_MASK
    xcd_barrier(xbar, (F.wave == 0) && (fresh_lane() == 0), (unsigned)F.G);
    { const unsigned long long t1_ = rt_now(); if ((PROBE_MASK >> 18) & 1u) pr_acc += t1_ - pr_t0; pr_acc += sec_acc;
      if (F.bid == 0 && threadIdx.x == 0) { const unsigned long long ts_ = rt_now(); while (rt_now() - ts_ < pr_acc) __builtin_amdgcn_s_sleep(8); } }
#endif
#undef IN
#undef SEAM
}

extern "C" void kernel_launch(void* const* d_in, const int* in_sizes, int n_in, void* d_out, int out_size, void* d_ws, size_t ws_size, hipStream_t stream) {
    static int grid = 0;
    if (grid == 0) {
        if (n_in != 28 || out_size != T * D || ws_size < WS_END) { fprintf(stderr, "kernel_launch: unexpected shapes (n_in %d out %d ws %zu)\n", n_in, out_size, ws_size); grid = -1; return; }
        int dev = 0, cus = 0, per_cu = 0;
        hipGetDevice(&dev); hipDeviceGetAttribute(&cus, hipDeviceAttributeMultiprocessorCount, dev);
        hipFuncSetAttribute((const void*)mega, hipFuncAttributeMaxDynamicSharedMemorySize, LDS_BYTES);
        hipOccupancyMaxActiveBlocksPerMultiprocessor(&per_cu, (const void*)mega, 512, LDS_BYTES);
        if (per_cu < 1) { fprintf(stderr, "kernel_launch: occupancy query says %d blocks per CU\n", per_cu); per_cu = 1; }
        (void)hipGetLastError();
        grid = cus;
    }
    if (grid < 0) return;
    (void)hipMemsetAsync((char*)d_ws + WS_CTL, 0, CTL_ZERO, stream);
    Args a{};
    for (int i = 0; i < 28; ++i) a.in[i] = (const float*)d_in[i];
    a.out = (float*)d_out; a.ws = (unsigned char*)d_ws;
#if ONE_LAUNCH
    a.ph_lo = 0; a.ph_hi = NPH;
    void* params[] = {&a};
    hipError_t e = hipLaunchCooperativeKernel((const void*)mega, dim3(grid), dim3(512), params, LDS_BYTES, stream);
    if (e != hipSuccess) fprintf(stderr, "cooperative launch failed: %s\n", hipGetErrorString(e));
#else
    for (int ph = 0; ph < NPH; ++ph) {
        a.ph_lo = ph; a.ph_hi = ph + 1;
        void* params[] = {&a};
        hipError_t e = hipLaunchCooperativeKernel((const void*)mega, dim3(grid), dim3(512), params, LDS_BYTES, stream);
        if (e != hipSuccess) { fprintf(stderr, "launch %d failed: %s\n", ph, hipGetErrorString(e)); break; }
    }
#endif
}
```

```cpp
#include <hip/hip_runtime.h>
#include <hip/hip_cooperative_groups.h>
#include <cstdint>
#include <cmath>
#include <cstdio>
namespace cg = cooperative_groups;

#ifndef ONE_LAUNCH
#define ONE_LAUNCH 1
#endif
#ifndef PROBE_MASK
#define PROBE_MASK 0u
#endif
#ifndef PROBE_SEC
#define PROBE_SEC 0
#endif

typedef unsigned short bf16;
typedef short bf16x8 __attribute__((ext_vector_type(8)));
typedef float f32x4 __attribute__((ext_vector_type(4)));
typedef float f32x16 __attribute__((ext_vector_type(16)));
typedef unsigned u32x4 __attribute__((ext_vector_type(4)));
typedef unsigned u32x2 __attribute__((ext_vector_type(2)));
typedef float f32x2v __attribute__((ext_vector_type(2)));

constexpr int T = 16384, D = 2048, SEQ = 2048, NB = 8;
constexpr int NCOLS = 16896;
constexpr float ALPHA = 1.189207115002721f;
constexpr int NPH = 19;

constexpr size_t MiB = 1u << 20;
constexpr size_t WS_CTL = 0, WS_MEMB = 1 * MiB, WS_WKV = 9 * MiB, WS_LB = 11 * MiB, WS_MASK = 12 * MiB, WS_WIN = 17 * MiB,
                 WS_SLOT = 83 * MiB, SLOT_BYTES = 64 * MiB, WS_CKV = 595 * MiB, WS_IKW = 603 * MiB, WS_END = 611 * MiB;
constexpr int LDS_BYTES = 157696;
constexpr size_t CTL_BAR = 16384, CTL_CVEC = 65536, CTL_ST1 = 262144, CTL_ST2 = 393216, CTL_ZERO = 524288;

struct Args {
    const float* in[28];
    float* out;
    unsigned char* ws;
    int ph_lo, ph_hi;
};

#define WAVE_SYNC() asm volatile("s_waitcnt lgkmcnt(0)" ::: "memory")

__device__ __forceinline__ unsigned f2bf(float f) { unsigned u = __float_as_uint(f); return (u + 0x7fffu + ((u >> 16) & 1u)) >> 16; }
__device__ __forceinline__ unsigned pk2(float lo, float hi) { return f2bf(lo) | (f2bf(hi) << 16); }
__device__ __forceinline__ float bf2f(unsigned h) { return __uint_as_float(h << 16); }
__device__ __forceinline__ float bflo(unsigned w) { return __uint_as_float(w << 16); }
__device__ __forceinline__ float bfhi(unsigned w) { return __uint_as_float(w & 0xffff0000u); }
__device__ __forceinline__ float wave_sum(float v) {
#pragma unroll
    for (int o = 32; o >= 1; o >>= 1) v += __shfl_xor(v, o);
    return v;
}
__device__ __forceinline__ float wave_max(float v) {
#pragma unroll
    for (int o = 32; o >= 1; o >>= 1) v = fmaxf(v, __shfl_xor(v, o));
    return v;
}
__device__ __forceinline__ float sigm(float x) { return 1.0f / (1.0f + expf(-x)); }
__device__ __forceinline__ void unpack8(u32x4 w, float* f) {
    f[0] = bflo(w.x); f[1] = bfhi(w.x); f[2] = bflo(w.y); f[3] = bfhi(w.y); f[4] = bflo(w.z); f[5] = bfhi(w.z); f[6] = bflo(w.w); f[7] = bfhi(w.w);
}

__device__ __forceinline__ int fresh_lane() { int l; asm volatile("v_mbcnt_lo_u32_b32 %0, -1, 0\n\tv_mbcnt_hi_u32_b32 %0, -1, %0" : "=v"(l)); return l; }
__device__ __forceinline__ unsigned long long rt_now() { unsigned long long t; asm volatile("s_memrealtime %0\n\ts_waitcnt lgkmcnt(0)" : "=s"(t) :: "memory"); return t; }
struct Frame {
    unsigned char* lds;
    int wave, bid, G;
    __device__ __forceinline__ int lane() const { return fresh_lane(); }
    const Args* a;
    unsigned char* ws;
    __device__ __forceinline__ bf16* slot(int i) const { return (bf16*)(ws + WS_SLOT + (size_t)i * SLOT_BYTES); }
};

namespace pg8 {
#define PG8_LAS __attribute__((address_space(3)))
constexpr int BM = 256, BK = 64, HALF = 128, HTB = HALF * BK * 2, STAGE_BYTES = 8 * HTB, NXCD = 8, WGM = 8;
__host__ __device__ __forceinline__ int lds_byte(int r, int c) { const int st = (r >> 4) * 2 + (c >> 5), rr = r & 15, cc = c & 31, ob = rr * 64 + cc * 2; return st * 1024 + (ob ^ (((ob >> 9) & 1) << 5)); }
__host__ __device__ __forceinline__ void stage_rc(int b, int& R, int& C) { const int st = b / 1024, sb = b % 1024, swz = sb ^ (((sb >> 9) & 1) << 5); R = (st >> 1) * 16 + swz / 64; C = (st & 1) * 32 + (swz % 64) / 2; }
__host__ __device__ __forceinline__ int perm32(int rho) { const int n = rho >> 4, i = rho & 15; return 8 * (i >> 2) + 4 * n + (i & 3); }
struct Unit { int pm, pn, z; const char* a; const char* b; };
struct Gemm { int lda, ldb, K; };
__device__ __forceinline__ void tile_of(int wgid, int nM, int nN, int& pm, int& pn) {
    const int nwg = nM * nN; { const int q = nwg / NXCD, r = nwg % NXCD, xcd = wgid % NXCD, off = wgid / NXCD; wgid = (xcd < r ? xcd * (q + 1) : r * (q + 1) + (xcd - r) * q) + off; }
    const int nig = WGM * nN, gid = wgid / nig, fm = gid * WGM, gsz = (nM - fm) < WGM ? (nM - fm) : WGM;
    pm = fm + ((wgid % nig) % gsz); pn = (wgid % nig) / gsz;
}
struct Sub { const bf16* A; const bf16* Bt; int nM, nN; };
template <int NS> struct MultiOrder {
    Sub s[NS]; int lda, ldb, G, c;
    __device__ __forceinline__ bool next(int i, Unit& u) const {
        int L = i * G + c;
#pragma unroll
        for (int k = 0; k < NS; ++k) { const int n = s[k].nM * s[k].nN;
            if (L < n) { tile_of(L, s[k].nM, s[k].nN, u.pm, u.pn); u.z = k; u.a = (const char*)(s[k].A + (size_t)u.pm * BM * lda); u.b = (const char*)(s[k].Bt + (size_t)u.pn * BM * ldb); return true; }
            L -= n; }
        return false;
    }
};
template <class Off> struct BatchOrder {
    const bf16* A; const bf16* Bt; int nM, nN, nz, lda, ldb, G, c; Off off;
    __device__ __forceinline__ bool next(int i, Unit& u) const {
        const int L = i * G + c, per = nM * nN; if (L >= per * nz) return false;
        u.z = L / per; const int r = L % per; u.pn = r / nM; u.pm = r % nM;
        u.a = (const char*)(A + off.a(u.z) + (size_t)u.pm * BM * lda); u.b = (const char*)(Bt + off.b(u.z) + (size_t)u.pn * BM * ldb); return true;
    }
};
__device__ __forceinline__ unsigned cvt_pk_bf16(float lo, float hi) { unsigned r; asm volatile("v_cvt_pk_bf16_f32 %0, %1, %2" : "=v"(r) : "v"(lo), "v"(hi)); return r; }

template <class Op> struct Epi8 {
    static constexpr bool PERM = true;
    Op op;
    __device__ __forceinline__ void operator()(const f32x4 (&acc)[2][2][4][2], const Unit& u, int wr, int wc, int fr, int fq) const {
        const int row0 = u.pm * BM + wr * 64 + fr, col0 = u.pn * BM + wc * 32 + 8 * fq;
        if constexpr (Op::NLD == 0) {
#pragma unroll
            for (int ai = 0; ai < 2; ++ai)
#pragma unroll
                for (int m = 0; m < 4; ++m)
#pragma unroll
                    for (int bj = 0; bj < 2; ++bj) op(u.z, row0 + ai * HALF + m * 16, col0 + bj * HALF, acc[ai][bj][m][0], acc[ai][bj][m][1]);
        } else {
#pragma unroll
            for (int ai = 0; ai < 2; ++ai) {
                u32x4 tmp[4][2][Op::NLD];
#pragma unroll
                for (int m = 0; m < 4; ++m)
#pragma unroll
                    for (int bj = 0; bj < 2; ++bj) op.ld(u.z, row0 + ai * HALF + m * 16, col0 + bj * HALF, tmp[m][bj]);
#pragma unroll
                for (int m = 0; m < 4; ++m)
#pragma unroll
                    for (int bj = 0; bj < 2; ++bj) op.ap(u.z, row0 + ai * HALF + m * 16, col0 + bj * HALF, acc[ai][bj][m][0], acc[ai][bj][m][1], tmp[m][bj]);
            }
        }
    }
};

template <class Epi, class Sched, bool ALIGN_EPI>
__device__ __forceinline__ void gemm_phase(PG8_LAS unsigned char* lds, const Gemm g, const Sched& S, const Epi& E, int wid, int lane) {
    const int tid = wid * 64 + lane, wr = wid >> 2, wc = wid & 3, fr = lane & 15, fq = lane >> 4;
    const int K = g.K, nt = K / BK;
    unsigned voffA[2], voffB[2];
#pragma unroll
    for (int i = 0; i < 2; ++i) { int R, C; stage_rc(tid * 16 + i * 8192, R, C); const int Rb = Epi::PERM ? ((R & ~31) + perm32(R & 31)) : R;
        voffA[i] = (unsigned)(R * g.lda + C) * 2u; voffB[i] = (unsigned)(Rb * g.ldb + C) * 2u; }
    const size_t kstep = (size_t)(BK * 2);
    const size_t hstepA = (size_t)HALF * g.lda * 2, hstepB = (size_t)HALF * g.ldb * 2;
    const unsigned ldsw = (unsigned)wid * 1024u;
    const int aoff = lds_byte(wr * 64 + fr, fq * 8), boff = lds_byte(wc * 32 + fr, fq * 8);
#define PG8_SA(b, h) (((b) * 2 + (h)) * HTB)
#define PG8_SB(b, h) ((4 + (b) * 2 + (h)) * HTB)
#define PG8_STAGE(bufoff, gbase, voff) do { _Pragma("unroll") for (int _i = 0; _i < 2; ++_i) \
        __builtin_amdgcn_global_load_lds((const unsigned*)((const char*)(gbase) + (voff)[_i]), (PG8_LAS unsigned*)(lds + (bufoff) + ldsw + _i * 8192), 16, 0, 0); } while (0)
#define PG8_LDA(dst, b, h) do { _Pragma("unroll") for (int m = 0; m < 4; ++m) _Pragma("unroll") for (int k = 0; k < 2; ++k) dst[m][k] = *(const PG8_LAS bf16x8*)(lds + PG8_SA(b, h) + aoff + m * 2048 + k * 1024); } while (0)
#define PG8_LDB(dst, b, h) do { _Pragma("unroll") for (int n = 0; n < 2; ++n) _Pragma("unroll") for (int k = 0; k < 2; ++k) dst[n][k] = *(const PG8_LAS bf16x8*)(lds + PG8_SB(b, h) + boff + n * 2048 + k * 1024); } while (0)
#define PG8_MMA(ai, bj, At, Bt) do { __builtin_amdgcn_s_setprio(1); _Pragma("unroll") for (int m = 0; m < 4; ++m) _Pragma("unroll") for (int n = 0; n < 2; ++n) _Pragma("unroll") for (int k = 0; k < 2; ++k) \
        acc[ai][bj][m][n] = __builtin_amdgcn_mfma_f32_16x16x32_bf16(Bt[n][k], At[m][k], acc[ai][bj][m][n], 0, 0, 0); __builtin_amdgcn_s_setprio(0); } while (0)
#define PG8_WAIT_V(n) asm volatile("s_waitcnt vmcnt(" #n ")" ::: "memory")
#define PG8_WAIT_L(n) asm volatile("s_waitcnt lgkmcnt(" #n ")" ::: "memory")
#define PG8_BAR __builtin_amdgcn_s_barrier()
#define PG8_SCHED __builtin_amdgcn_sched_barrier(0)
    Unit cur, nxt; int ui = 0;
    if (!S.next(0, cur)) return;
    f32x4 acc[2][2][4][2];
#pragma unroll
    for (int a = 0; a < 2; ++a)
#pragma unroll
        for (int b = 0; b < 2; ++b)
#pragma unroll
            for (int m = 0; m < 4; ++m)
#pragma unroll
                for (int n = 0; n < 2; ++n) acc[a][b][m][n] = (f32x4){0.f, 0.f, 0.f, 0.f};
    bf16x8 At[4][2], B0[2][2], B1[2][2];
    const char* cA = cur.a; const char* cB = cur.b;
    PG8_STAGE(PG8_SB(0, 0), cB, voffB); PG8_STAGE(PG8_SB(0, 1), cB + hstepB, voffB); PG8_STAGE(PG8_SA(0, 0), cA, voffA); PG8_STAGE(PG8_SA(0, 1), cA + hstepA, voffA);
    if (wr == 1) PG8_BAR;
    PG8_WAIT_V(2); PG8_BAR;
    PG8_STAGE(PG8_SB(1, 0), cB + kstep, voffB); PG8_STAGE(PG8_SA(1, 0), cA + kstep, voffA); PG8_STAGE(PG8_SB(1, 1), cB + hstepB + kstep, voffB);
    PG8_WAIT_V(6); PG8_BAR;
    for (;;) {
        const bool has_next = S.next(ui + 1, nxt);
        const char* nA = has_next ? nxt.a : cA; const char* nB = has_next ? nxt.b : cB;
#pragma unroll 1
        for (int t = 0; t < nt; t += 2) {
            const bool last = (t == nt - 2);
            const char* a1 = cA + (size_t)(t + 1) * kstep;
            const char* a2 = last ? nA : cA + (size_t)(t + 2) * kstep; const char* b2 = last ? nB : cB + (size_t)(t + 2) * kstep;
            const char* a3 = a2 + kstep; const char* b3 = b2 + kstep;
            PG8_LDB(B0, 0, 0); PG8_LDB(B1, 0, 1); PG8_SCHED; PG8_LDA(At, 0, 0); PG8_STAGE(PG8_SA(1, 1), a1 + hstepA, voffA);
            PG8_WAIT_V(8); PG8_WAIT_L(0); PG8_BAR; PG8_MMA(0, 0, At, B0); PG8_MMA(0, 1, At, B1); PG8_BAR; PG8_SCHED;
            PG8_LDA(At, 0, 1); PG8_STAGE(PG8_SB(0, 0), b2, voffB); PG8_STAGE(PG8_SB(0, 1), b2 + hstepB, voffB); PG8_STAGE(PG8_SA(0, 0), a2, voffA);
            PG8_WAIT_V(8); PG8_WAIT_L(0); PG8_BAR; PG8_MMA(1, 0, At, B0); PG8_MMA(1, 1, At, B1); PG8_BAR; PG8_SCHED;
            PG8_LDB(B0, 1, 0); PG8_LDB(B1, 1, 1); PG8_SCHED; PG8_LDA(At, 1, 0); PG8_STAGE(PG8_SA(0, 1), a2 + hstepA, voffA);
            PG8_WAIT_V(8); PG8_WAIT_L(0); PG8_BAR; PG8_MMA(0, 0, At, B0); PG8_MMA(0, 1, At, B1); PG8_BAR; PG8_SCHED;
            PG8_LDA(At, 1, 1); PG8_STAGE(PG8_SB(1, 0), b3, voffB); PG8_STAGE(PG8_SB(1, 1), b3 + hstepB, voffB); PG8_STAGE(PG8_SA(1, 0), a3, voffA);
            PG8_WAIT_V(8); PG8_WAIT_L(0); PG8_BAR; PG8_MMA(1, 0, At, B0); PG8_MMA(1, 1, At, B1); PG8_BAR; PG8_SCHED;
        }
        if constexpr (ALIGN_EPI) { if (wr == 0) PG8_BAR; }
        E(acc, cur, wr, wc, fr, fq);
        if (!has_next) break;
#pragma unroll
        for (int a = 0; a < 2; ++a)
#pragma unroll
            for (int b = 0; b < 2; ++b)
#pragma unroll
                for (int m = 0; m < 4; ++m)
#pragma unroll
                    for (int n = 0; n < 2; ++n) acc[a][b][m][n] = (f32x4){0.f, 0.f, 0.f, 0.f};
        cur = nxt; cA = nA; cB = nB; ++ui;
        if constexpr (ALIGN_EPI) { if (wr == 1) PG8_BAR; }
    }
    PG8_WAIT_V(0);
    if constexpr (!ALIGN_EPI) { if (wr == 0) PG8_BAR; }
    PG8_BAR;
#undef PG8_SA
#undef PG8_SB
#undef PG8_STAGE
#undef PG8_LDA
#undef PG8_LDB
#undef PG8_MMA
#undef PG8_WAIT_V
#undef PG8_WAIT_L
#undef PG8_BAR
#undef PG8_SCHED
}
}

__device__ __forceinline__ u32x4 pack8(f32x4 a, f32x4 b) { u32x4 w; w.x = pg8::cvt_pk_bf16(a.x, a.y); w.y = pg8::cvt_pk_bf16(a.z, a.w); w.z = pg8::cvt_pk_bf16(b.x, b.y); w.w = pg8::cvt_pk_bf16(b.z, b.w); return w; }
__device__ __forceinline__ void unpack8v(u32x4 w, f32x4& a, f32x4& b) { a.x = bflo(w.x); a.y = bfhi(w.x); a.z = bflo(w.y); a.w = bfhi(w.y); b.x = bflo(w.z); b.y = bfhi(w.z); b.z = bflo(w.w); b.w = bfhi(w.w); }
__device__ __forceinline__ f32x4 sigm4(f32x4 v) { f32x4 r; r.x = sigm(v.x); r.y = sigm(v.y); r.z = sigm(v.z); r.w = sigm(v.w); return r; }

struct OpProj { static constexpr int NLD = 0; unsigned char* ws;
    __device__ __forceinline__ void operator()(int z, int row, int col, f32x4 a, f32x4 b) const {
        bf16* p;
        if (col < 16384) p = (bf16*)(ws + WS_SLOT + (size_t)(col >> 11) * SLOT_BYTES) + (size_t)row * 2048 + (col & 2047);
        else if (col < 16640) p = (bf16*)(ws + WS_CKV) + (size_t)row * 256 + (col - 16384);
        else p = (bf16*)(ws + WS_IKW) + (size_t)row * 256 + (col - 16640);
        *(u32x4*)p = pack8(a, b);
    } };
struct OpBf16 { static constexpr int NLD = 0; bf16* o; int ld;
    __device__ __forceinline__ void operator()(int z, int row, int col, f32x4 a, f32x4 b) const { *(u32x4*)(o + (size_t)row * ld + col) = pack8(a, b); } };
struct OpSplit2 { static constexpr int NLD = 0; bf16* o0; bf16* o1;
    __device__ __forceinline__ void operator()(int z, int row, int col, f32x4 a, f32x4 b) const { bf16* p = (col < 2048 ? o0 : o1) + (size_t)row * 2048 + (col & 2047); *(u32x4*)p = pack8(a, b); } };
struct OpF32 { static constexpr int NLD = 0; float* o; int ld;
    __device__ __forceinline__ void operator()(int z, int row, int col, f32x4 a, f32x4 b) const { float* p = o + (size_t)row * ld + col; *(f32x4*)p = a; *(f32x4*)(p + 4) = b; } };
struct OpYA { static constexpr int NLD = 1; bf16* ga;
    __device__ __forceinline__ void ld(int zi, int row, int col, u32x4* t) const { t[0] = *(const u32x4*)(ga + (size_t)row * 2048 + col); }
    __device__ __forceinline__ void ap(int zi, int row, int col, f32x4 a, f32x4 b, const u32x4* t) const { f32x4 g0, g1; unpack8v(t[0], g0, g1); *(u32x4*)(ga + (size_t)row * 2048 + col) = pack8(sigm4(g0) * a, sigm4(g1) * b); } };
struct OpYB { static constexpr int NLD = 2; bf16* ga; const bf16* gb;
    __device__ __forceinline__ void ld(int zi, int row, int col, u32x4* t) const { const size_t i = (size_t)row * 2048 + col; t[0] = *(const u32x4*)(ga + i); t[1] = *(const u32x4*)(gb + i); }
    __device__ __forceinline__ void ap(int zi, int row, int col, f32x4 a, f32x4 b, const u32x4* t) const { f32x4 m0, m1, g0, g1; unpack8v(t[0], m0, m1); unpack8v(t[1], g0, g1);
        *(u32x4*)(ga + (size_t)row * 2048 + col) = pack8(m0 + sigm4(g0) * a, m1 + sigm4(g1) * b); } };
struct OpMix { static constexpr int NLD = 2; const float* x; float* zo;
    __device__ __forceinline__ void ld(int zi, int row, int col, u32x4* t) const { const size_t i = (size_t)row * 2048 + col; t[0] = *(const u32x4*)(x + i); t[1] = *(const u32x4*)(x + i + 4); }
    __device__ __forceinline__ void ap(int zi, int row, int col, f32x4 a, f32x4 b, const u32x4* t) const { const size_t i = (size_t)row * 2048 + col;
        *(f32x4*)(zo + i) = ALPHA * __builtin_bit_cast(f32x4, t[0]) + a; *(f32x4*)(zo + i + 4) = ALPHA * __builtin_bit_cast(f32x4, t[1]) + b; } };
struct OpRes { static constexpr int NLD = 2; float* zo;
    __device__ __forceinline__ void ld(int zi, int row, int col, u32x4* t) const { const size_t i = (size_t)row * 2048 + col; t[0] = *(const u32x4*)(zo + i); t[1] = *(const u32x4*)(zo + i + 4); }
    __device__ __forceinline__ void ap(int zi, int row, int col, f32x4 a, f32x4 b, const u32x4* t) const { const size_t i = (size_t)row * 2048 + col;
        *(f32x4*)(zo + i) = ALPHA * __builtin_bit_cast(f32x4, t[0]) + a; *(f32x4*)(zo + i + 4) = ALPHA * __builtin_bit_cast(f32x4, t[1]) + b; } };

__device__ __forceinline__ void row_stats_add(float* st, int row, float s1, float s2, int fq) {
    s1 += __shfl_xor(s1, 16); s1 += __shfl_xor(s1, 32); s2 += __shfl_xor(s2, 16); s2 += __shfl_xor(s2, 32);
    if (fq == 0) { atomicAdd(st + 2 * (size_t)row, s1); atomicAdd(st + 2 * (size_t)row + 1, s2); }
}
__device__ __forceinline__ void row_mu_rstd(const float* st, int row, float& mu, float& rstd) {
    const f32x2v p = *(const f32x2v*)(st + 2 * (size_t)row); mu = p.x * (1.0f / 2048.0f); rstd = rsqrtf(fmaxf(p.y * (1.0f / 2048.0f) - mu * mu, 0.f) + 1e-5f);
}
__device__ __forceinline__ float sum8(f32x4 a, f32x4 b) { return ((a.x + a.y) + (a.z + a.w)) + ((b.x + b.y) + (b.z + b.w)); }
__device__ __forceinline__ float sq8(f32x4 a, f32x4 b) { return ((a.x * a.x + a.y * a.y) + (a.z * a.z + a.w * a.w)) + ((b.x * b.x + b.y * b.y) + (b.z * b.z + b.w * b.w)); }
struct EpiMixStats { static constexpr bool PERM = true; const float* x; bf16* zb; float* st;
    __device__ __forceinline__ void operator()(const f32x4 (&acc)[2][2][4][2], const pg8::Unit& u, int wr, int wc, int fr, int fq) const {
        const int row0 = u.pm * 256 + wr * 64 + fr, col0 = u.pn * 256 + wc * 32 + 8 * fq;
#pragma unroll
        for (int ai = 0; ai < 2; ++ai) {
            f32x4 xv[4][2][2];
#pragma unroll
            for (int m = 0; m < 4; ++m)
#pragma unroll
                for (int bj = 0; bj < 2; ++bj) { const float* p = x + (size_t)(row0 + ai * 128 + m * 16) * 2048 + col0 + bj * 128; xv[m][bj][0] = *(const f32x4*)p; xv[m][bj][1] = *(const f32x4*)(p + 4); }
#pragma unroll
            for (int m = 0; m < 4; ++m) { const int row = row0 + ai * 128 + m * 16; float s1 = 0.f, s2 = 0.f;
#pragma unroll
                for (int bj = 0; bj < 2; ++bj) { const f32x4 z0 = ALPHA * xv[m][bj][0] + acc[ai][bj][m][0], z1 = ALPHA * xv[m][bj][1] + acc[ai][bj][m][1];
                    *(u32x4*)(zb + (size_t)row * 2048 + col0 + bj * 128) = pack8(z0, z1); s1 += sum8(z0, z1); s2 += sq8(z0, z1); }
                row_stats_add(st, row, s1, s2, fq); }
        }
    }
};
struct EpiCOStats { static constexpr bool PERM = true; bf16* zb; const float* st1; float* st2; const float* g; const float* bta;
    __device__ __forceinline__ void operator()(const f32x4 (&acc)[2][2][4][2], const pg8::Unit& u, int wr, int wc, int fr, int fq) const {
        const int row0 = u.pm * 256 + wr * 64 + fr, col0 = u.pn * 256 + wc * 32 + 8 * fq;
        f32x4 gv[2][2], bv[2][2];
#pragma unroll
        for (int bj = 0; bj < 2; ++bj) { gv[bj][0] = *(const f32x4*)(g + col0 + bj * 128); gv[bj][1] = *(const f32x4*)(g + col0 + bj * 128 + 4); bv[bj][0] = *(const f32x4*)(bta + col0 + bj * 128); bv[bj][1] = *(const f32x4*)(bta + col0 + bj * 128 + 4); }
#pragma unroll
        for (int ai = 0; ai < 2; ++ai) {
            u32x4 zv[4][2]; float mu[4], rs[4];
#pragma unroll
            for (int m = 0; m < 4; ++m) { const int row = row0 + ai * 128 + m * 16; row_mu_rstd(st1, row, mu[m], rs[m]);
#pragma unroll
                for (int bj = 0; bj < 2; ++bj) zv[m][bj] = *(const u32x4*)(zb + (size_t)row * 2048 + col0 + bj * 128); }
#pragma unroll
            for (int m = 0; m < 4; ++m) { const int row = row0 + ai * 128 + m * 16; float s1 = 0.f, s2 = 0.f;
#pragma unroll
                for (int bj = 0; bj < 2; ++bj) { f32x4 a0, a1; unpack8v(zv[m][bj], a0, a1);
                    const f32x4 z0 = ALPHA * ((a0 - mu[m]) * rs[m] * gv[bj][0] + bv[bj][0]) + acc[ai][bj][m][0], z1 = ALPHA * ((a1 - mu[m]) * rs[m] * gv[bj][1] + bv[bj][1]) + acc[ai][bj][m][1];
                    *(u32x4*)(zb + (size_t)row * 2048 + col0 + bj * 128) = pack8(z0, z1); s1 += sum8(z0, z1); s2 += sq8(z0, z1); }
                row_stats_add(st2, row, s1, s2, fq); }
        }
    }
};
__device__ __forceinline__ void ln_fold8(const float* st, const float* c1, const float* c0, int row, int col, f32x4& a, f32x4& b) {
    float mu, rs; row_mu_rstd(st, row, mu, rs);
    const f32x4 p0 = *(const f32x4*)(c1 + col), p1 = *(const f32x4*)(c1 + col + 4), q0 = *(const f32x4*)(c0 + col), q1 = *(const f32x4*)(c0 + col + 4);
    a = (a - mu * p0) * rs + q0; b = (b - mu * p1) * rs + q1;
}
struct OpPQFold { static constexpr int NLD = 0; float* o; const float* st; const float* c1; const float* c0;
    __device__ __forceinline__ void operator()(int zi, int row, int col, f32x4 a, f32x4 b) const { ln_fold8(st, c1, c0, row, col, a, b); float* p = o + (size_t)row * 2048 + col; *(f32x4*)p = a; *(f32x4*)(p + 4) = b; } };

template <class Op>
__device__ __forceinline__ void gemm(const Frame& F, const bf16* A, int lda, const bf16* Bt, int ldb, int M, int N, int K, const Op& op) {
    pg8::Gemm g{lda, ldb, K}; pg8::MultiOrder<1> S; S.s[0] = pg8::Sub{A, Bt, M / 256, N / 256}; S.lda = lda; S.ldb = ldb; S.G = F.G; S.c = F.bid;
    pg8::Epi8<Op> E{op};
    pg8::gemm_phase<pg8::Epi8<Op>, pg8::MultiOrder<1>, true>((PG8_LAS unsigned char*)F.lds, g, S, E, F.wave, F.lane());
}
template <class Epi>
__device__ __forceinline__ void gemm_epi(const Frame& F, const bf16* A, int lda, const bf16* Bt, int ldb, int M, int N, int K, const Epi& E) {
    pg8::Gemm g{lda, ldb, K}; pg8::MultiOrder<1> S; S.s[0] = pg8::Sub{A, Bt, M / 256, N / 256}; S.lda = lda; S.ldb = ldb; S.G = F.G; S.c = F.bid;
    pg8::gemm_phase<Epi, pg8::MultiOrder<1>, true>((PG8_LAS unsigned char*)F.lds, g, S, E, F.wave, F.lane());
}
template <int NS, class Op>
__device__ __forceinline__ void gemm_multi(const Frame& F, const pg8::MultiOrder<NS>& S, int K, const Op& op) {
    pg8::Gemm g{S.lda, S.ldb, K}; pg8::Epi8<Op> E{op};
    pg8::gemm_phase<pg8::Epi8<Op>, pg8::MultiOrder<NS>, true>((PG8_LAS unsigned char*)F.lds, g, S, E, F.wave, F.lane());
}
template <class Off, class Op>
__device__ __forceinline__ void gemm_batch(const Frame& F, const pg8::BatchOrder<Off>& S, int K, const Op& op) {
    pg8::Gemm g{S.lda, S.ldb, K}; pg8::Epi8<Op> E{op};
    pg8::gemm_phase<pg8::Epi8<Op>, pg8::BatchOrder<Off>, true>((PG8_LAS unsigned char*)F.lds, g, S, E, F.wave, F.lane());
}
struct OffS { __device__ __forceinline__ size_t a(int z) const { return (size_t)(z >> 2) * 2048 * 2048 + (z & 3) * 512; } __device__ __forceinline__ size_t b(int z) const { return (size_t)(z >> 2) * 256 * 2048 + (z & 3) * 512; } };
struct OffPV { __device__ __forceinline__ size_t a(int z) const { return (size_t)(z >> 2) * 2048 * 1024 + (z & 3) * 256; } __device__ __forceinline__ size_t b(int z) const { return (size_t)(z & 3) * 512 * 2048 + (z >> 2) * 256; } };
struct OpLogit { static constexpr int NLD = 0; float* lg;
    __device__ __forceinline__ void operator()(int z, int row, int col, f32x4 a, f32x4 b) const { float* p = lg + ((size_t)(z >> 2) * 2048 + row) * 1024 + (z & 3) * 256 + col; *(f32x4*)p = a * 0.04419417382415922f; *(f32x4*)(p + 4) = b * 0.04419417382415922f; } };
struct OpCO { static constexpr int NLD = 0; bf16* co;
    __device__ __forceinline__ void operator()(int z, int row, int col, f32x4 a, f32x4 b) const { *(u32x4*)(co + ((size_t)(z >> 2) * 2048 + row) * 2048 + (z & 3) * 512 + col) = pack8(a, b); } };
struct OpCQKV { static constexpr int NLD = 0; bf16* cq; bf16* ck; bf16* vt; const float* st; const float* c1; const float* c0;
    __device__ __forceinline__ void operator()(int z, int row, int col, f32x4 a, f32x4 b) const { if (z == 0) ln_fold8(st, c1, c0, row, col, a, b);
        bf16* o = z == 0 ? cq : (z == 1 ? ck : vt); *(u32x4*)(o + (size_t)row * 2048 + col) = pack8(a, b); } };
__device__ __forceinline__ void ph_xsoftmax(const Frame& F, const float* lg, bf16* P) {
    const int gw = F.bid * 8 + F.wave, NGW = F.G * 8, lane = F.lane();
    for (int u = gw; u < T * 4; u += NGW) {
        const f32x4 v = *(const f32x4*)(lg + (size_t)u * 256 + 4 * lane);
        const float m = wave_max(fmaxf(fmaxf(v.x, v.y), fmaxf(v.z, v.w)));
        const float e0 = expf(v.x - m), e1 = expf(v.y - m), e2 = expf(v.z - m), e3 = expf(v.w - m);
        const float inv = 1.0f / wave_sum((e0 + e1) + (e2 + e3));
        u32x2 w; w.x = pk2(e0 * inv, e1 * inv); w.y = pk2(e2 * inv, e3 * inv);
        *(u32x2*)(P + (size_t)u * 256 + 4 * lane) = w;
    }
}

template <class CM>
__device__ __forceinline__ void transpose_item(const float* W, size_t ldw, bf16* WT, size_t ldwt, int row_off, int nblk, int item, float* scr, int lane, const CM& cm) {
    const int kb = item / nblk, nb = item % nblk, k0 = 64 * kb, n0 = 32 * nb;
    const int c = cm(n0 + (lane & 31));
#pragma unroll 8
    for (int i = 0; i < 32; ++i) { const int kk = 2 * i + (lane >> 5); scr[kk * 33 + (lane & 31)] = (c >= 0) ? W[(size_t)(k0 + kk) * ldw + c] : 0.f; }
    WAVE_SYNC();
    const int c8 = lane & 7;
#pragma unroll
    for (int j = 0; j < 4; ++j) { const int n = (lane >> 3) + 8 * j; const float* s = scr + (8 * c8) * 33 + n;
        u32x4 o; o.x = pk2(s[0 * 33], s[1 * 33]); o.y = pk2(s[2 * 33], s[3 * 33]); o.z = pk2(s[4 * 33], s[5 * 33]); o.w = pk2(s[6 * 33], s[7 * 33]);
        *(u32x4*)(WT + (size_t)(row_off + n0 + n) * ldwt + k0 + 8 * c8) = o; }
    WAVE_SYNC();
}
__device__ __forceinline__ void transpose_item_ln(const float* W, bf16* WT, int item, float* scr, int lane, const float* g, const float* bta, float* c1, float* c0) {
    const int kb = item / 64, nb = item % 64, k0 = 64 * kb, n0 = 32 * nb;
#pragma unroll 8
    for (int i = 0; i < 32; ++i) { const int kk = 2 * i + (lane >> 5); scr[kk * 33 + (lane & 31)] = W[(size_t)(k0 + kk) * 2048 + n0 + (lane & 31)]; }
    WAVE_SYNC();
    const int c8 = lane & 7;
    float gk[8], bk[8];
#pragma unroll
    for (int i = 0; i < 8; ++i) { gk[i] = g[k0 + 8 * c8 + i]; bk[i] = bta[k0 + 8 * c8 + i]; }
#pragma unroll
    for (int j = 0; j < 4; ++j) { const int n = (lane >> 3) + 8 * j; const float* sp = scr + (8 * c8) * 33 + n;
        float wv[8]; float p1 = 0.f, p0 = 0.f;
#pragma unroll
        for (int i = 0; i < 8; ++i) { const float v = sp[i * 33]; wv[i] = v * gk[i]; p1 += wv[i]; p0 += v * bk[i]; }
        u32x4 o; o.x = pk2(wv[0], wv[1]); o.y = pk2(wv[2], wv[3]); o.z = pk2(wv[4], wv[5]); o.w = pk2(wv[6], wv[7]);
        *(u32x4*)(WT + (size_t)(n0 + n) * 2048 + k0 + 8 * c8) = o;
        p1 += __shfl_xor(p1, 1); p1 += __shfl_xor(p1, 2); p1 += __shfl_xor(p1, 4); p0 += __shfl_xor(p0, 1); p0 += __shfl_xor(p0, 2); p0 += __shfl_xor(p0, 4);
        if (c8 == 0) { atomicAdd(c1 + n0 + n, p1); atomicAdd(c0 + n0 + n, p0); } }
    WAVE_SYNC();
}
struct CmIdent { __device__ __forceinline__ int operator()(int n) const { return n; } };
struct CmWin { __device__ __forceinline__ int operator()(int n) const {
    if (n < 10240) return n;
    if (n < 12288) return 10496 + (n - 10240);
    if (n < 14336) return 12688 + (n - 12288);
    if (n < 16384) return 14736 + (n - 14336);
    if (n < 16640) return 10240 + (n - 16384);
    if (n < 16768) return 12544 + (n - 16640);
    if (n < 16784) return 12672 + (n - 16768);
    return -1; } };

__device__ __forceinline__ void cvt_bf16_stream(const Frame& F, const float* src, bf16* dst, size_t n8) {
    const size_t gt = (size_t)F.bid * 512 + F.wave * 64 + F.lane(), NT = (size_t)F.G * 512;
#pragma unroll 4
    for (size_t i = gt; i < n8; i += NT) { const f32x4 a = ((const f32x4*)src)[2 * i], b = ((const f32x4*)src)[2 * i + 1];
        u32x4 o; o.x = pk2(a.x, a.y); o.y = pk2(a.z, a.w); o.z = pk2(b.x, b.y); o.w = pk2(b.z, b.w); ((u32x4*)dst)[i] = o; }
}

__device__ __forceinline__ void ph0_prologue(const Frame& F) {
    const Args& a = *F.a;
    cvt_bf16_stream(F, a.in[0], (bf16*)a.out, (size_t)T * D / 8);
    cvt_bf16_stream(F, a.in[1], (bf16*)(F.ws + WS_MEMB), (size_t)2048 * 2048 / 8);
    float* scr = (float*)(F.lds + F.wave * 16384);
    const int gw = F.bid * 8 + F.wave, NGW = F.G * 8, lane = F.lane();
    {
        const int nblk = NCOLS / 32, nitems = (2048 / 64) * nblk;
        for (int it = gw; it < nitems; it += NGW) transpose_item(a.in[2], 16784, (bf16*)(F.ws + WS_WIN), 2048, 0, nblk, it, scr, lane, CmWin());
    }
    {
        for (int it = gw; it < 32 * 16; it += NGW) { const int mat = it >> 4, which = mat >> 4, h = mat & 15;
            transpose_item(a.in[which ? 9 : 8] + (size_t)h * 256 * 128, 128, (bf16*)(F.ws + WS_WKV), 256, which * 2048 + h * 128, 4, it & 15, scr, lane, CmIdent()); }
    }
    {
        const int gt = F.bid * 512 + F.wave * 64 + lane;
        if (gt < 2048) { const float l0 = a.in[3][gt], l1 = a.in[3][2048 + gt]; ((float*)(F.ws + WS_LB))[gt] = 1.0f / (1.0f + expf(l1 - l0)); }
    }
}

namespace hg {
constexpr int QP = 272, TP = 144, AP = 144;
constexpr int OFF_QD = 0, OFF_KD = OFF_QD + 64 * QP, OFF_QG = OFF_KD + 64 * QP, OFF_KET = OFF_QG + 64 * QP, OFF_VT = OFF_KET + 128 * TP, OFF_A = OFF_VT + 128 * TP,
              OFF_TOT = OFF_A + 64 * AP, OFF_DEC = OFF_TOT + 4 * 128 * 4, OFF_PART = OFF_DEC + 128 * 4, OFF_RSTD = OFF_PART + 8 * 64 * 4, END = OFF_RSTD + 64 * 4;
static_assert(END <= 131072, "hgrn LDS map");
}
typedef short bf16x4 __attribute__((ext_vector_type(4)));
#define HSEC_B() do { if (PROBE_SEC) hs_t0 = rt_now(); } while (0)
#define HSEC_E(n) do { if (PROBE_SEC == (n)) sacc += rt_now() - hs_t0; } while (0)
__device__ __forceinline__ void hgrn_chunked(const Frame& F, int unit, unsigned long long& sacc) {
    unsigned long long hs_t0 = 0ull;
    using namespace hg;
    const Args& a = *F.a;
    const int b = unit >> 4, h = unit & 15, lane = F.lane(), w = F.wave, tid = w * 64 + lane, c = tid & 127, rq = tid >> 7, l15 = lane & 15, q4 = lane >> 4;
    unsigned char* L = F.lds;
    const size_t base = (size_t)b * 2048 * 2048 + h * 128;
    const bf16* HQ = F.slot(0) + base; const bf16* HF = F.slot(1) + base; const bf16* HI = F.slot(2) + base; const bf16* HG = F.slot(3) + base; bf16* HO = F.slot(0) + base;
    const float lb = ((const float*)(F.ws + WS_LB))[h * 128 + c];
    const float ng = a.in[4][h * 128 + 16 * w + l15];
    f32x4 S[8];
#pragma unroll
    for (int d = 0; d < 8; ++d) S[d] = (f32x4){0.f, 0.f, 0.f, 0.f};
    unsigned short rq_[16], rf_[16], rv_[16];
#pragma unroll
    for (int k = 0; k < 16; ++k) { const size_t o = (size_t)(16 * rq + k) * 2048 + c; rq_[k] = HQ[o]; rf_[k] = HF[o]; rv_[k] = HI[o]; }
    float* tot = (float*)(L + OFF_TOT); float* dec = (float*)(L + OFF_DEC); float* part = (float*)(L + OFF_PART); float* rstd = (float*)(L + OFF_RSTD);
#pragma unroll 1
    for (int ch = 0; ch < 32; ++ch) {
        const int r0 = ch * 64;
        HSEC_B();
        unsigned short gq[16];
#pragma unroll
        for (int mt = 0; mt < 4; ++mt)
#pragma unroll
            for (int r = 0; r < 4; ++r) gq[4 * mt + r] = HG[(size_t)(r0 + 16 * mt + 4 * q4 + r) * 2048 + 16 * w + l15];
        unsigned short rv2_[16];
        if (ch + 1 < 32) {
#pragma unroll
            for (int k = 0; k < 16; ++k) rv2_[k] = HI[(size_t)(r0 + 64 + 16 * rq + k) * 2048 + c]; }
        float G[16], qf[16], kk[16];
        { float run = 0.f;
#pragma unroll
          for (int k = 0; k < 16; ++k) { const float f = lb + (1.0f - lb) * __builtin_amdgcn_rcpf(1.0f + __expf(-bf2f(rf_[k]))); run += __logf(f); G[k] = run; kk[k] = 1.0f - f; qf[k] = bf2f(rq_[k]); } }
        tot[rq * 128 + c] = G[15];
        if (ch + 1 < 32) {
#pragma unroll
            for (int k = 0; k < 16; ++k) { const size_t o = (size_t)(r0 + 64 + 16 * rq + k) * 2048 + c; rq_[k] = HQ[o]; rf_[k] = HF[o]; } }
        HSEC_E(1); HSEC_B();
        __syncthreads();
        HSEC_E(2); HSEC_B();
        const float t0 = tot[c], t1 = tot[128 + c], t2 = tot[256 + c], t3 = tot[384 + c];
        const float offs = (rq > 0 ? t0 : 0.f) + (rq > 1 ? t1 : 0.f) + (rq > 2 ? t2 : 0.f);
        const float Gref = t0 + t1, Glast = Gref + t2 + t3, eref = __expf(Gref), elr = __expf(Glast - Gref);
        if (rq == 0) dec[c] = __expf(Glast);
        unsigned kew[8], vw[8];
#pragma unroll
        for (int k = 0; k < 16; ++k) {
            const float e1 = __expf(G[k] + offs - Gref), qd = qf[k] * e1, kd = kk[k] * __builtin_amdgcn_rcpf(e1);
            const int row = 16 * rq + k;
            *(bf16*)(L + OFF_QD + row * QP + 2 * c) = (bf16)f2bf(qd);
            *(bf16*)(L + OFF_KD + row * QP + 2 * c) = (bf16)f2bf(kd);
            *(bf16*)(L + OFF_QG + row * QP + 2 * c) = (bf16)f2bf(qd * eref);
            const unsigned ke = f2bf(kd * elr);
            if (k & 1) { kew[k >> 1] |= ke << 16; vw[k >> 1] |= (unsigned)rv_[k] << 16; } else { kew[k >> 1] = ke; vw[k >> 1] = rv_[k]; }
        }
        *(u32x4*)(L + OFF_KET + c * TP + 32 * rq) = (u32x4){kew[0], kew[1], kew[2], kew[3]}; *(u32x4*)(L + OFF_KET + c * TP + 32 * rq + 16) = (u32x4){kew[4], kew[5], kew[6], kew[7]};
        *(u32x4*)(L + OFF_VT + c * TP + 32 * rq) = (u32x4){vw[0], vw[1], vw[2], vw[3]}; *(u32x4*)(L + OFF_VT + c * TP + 32 * rq + 16) = (u32x4){vw[4], vw[5], vw[6], vw[7]};
        if (ch + 1 < 32) {
#pragma unroll
            for (int k = 0; k < 16; ++k) rv_[k] = rv2_[k]; }
        HSEC_E(3); HSEC_B();
        __syncthreads();
        HSEC_E(4); HSEC_B();
        { const int mi = w >> 1;
#pragma unroll
          for (int tt = 0; tt < 2; ++tt) { const int nj = 2 * (w & 1) + tt; f32x4 acc = (f32x4){0.f, 0.f, 0.f, 0.f};
              if (nj <= mi) {
#pragma unroll
                  for (int ks = 0; ks < 4; ++ks) { const bf16x8 aF = *(const bf16x8*)(L + OFF_KD + (16 * nj + l15) * QP + 64 * ks + 16 * q4), bF = *(const bf16x8*)(L + OFF_QD + (16 * mi + l15) * QP + 64 * ks + 16 * q4);
                      acc = __builtin_amdgcn_mfma_f32_16x16x32_bf16(aF, bF, acc, 0, 0, 0); } }
              const int i = 16 * mi + l15, j0 = 16 * nj + 4 * q4;
              const float v0 = (j0 <= i) ? acc.x : 0.f, v1 = (j0 + 1 <= i) ? acc.y : 0.f, v2 = (j0 + 2 <= i) ? acc.z : 0.f, v3 = (j0 + 3 <= i) ? acc.w : 0.f;
              *(u32x2*)(L + OFF_A + i * AP + 2 * j0) = (u32x2){pk2(v0, v1), pk2(v2, v3)}; } }
        __syncthreads();
        HSEC_E(5); HSEC_B();
        bf16x8 bV[2];
#pragma unroll
        for (int ks = 0; ks < 2; ++ks) bV[ks] = *(const bf16x8*)(L + OFF_VT + (16 * w + l15) * TP + 64 * ks + 16 * q4);
        f32x4 O[4];
#pragma unroll
        for (int mt = 0; mt < 4; ++mt) { O[mt] = (f32x4){0.f, 0.f, 0.f, 0.f};
#pragma unroll
            for (int ks = 0; ks < 2; ++ks) { const bf16x8 aF = *(const bf16x8*)(L + OFF_A + (16 * mt + l15) * AP + 64 * ks + 16 * q4); O[mt] = __builtin_amdgcn_mfma_f32_16x16x32_bf16(aF, bV[ks], O[mt], 0, 0, 0); } }
#pragma unroll
        for (int kq = 0; kq < 4; ++kq) {
            u32x4 sw; sw.x = pk2(S[2 * kq].x, S[2 * kq].y); sw.y = pk2(S[2 * kq].z, S[2 * kq].w); sw.z = pk2(S[2 * kq + 1].x, S[2 * kq + 1].y); sw.w = pk2(S[2 * kq + 1].z, S[2 * kq + 1].w);
            const bf16x8 bS = __builtin_bit_cast(bf16x8, sw);
#pragma unroll
            for (int mt = 0; mt < 4; ++mt) { const unsigned char* qp = L + OFF_QG + (16 * mt + l15) * QP + 64 * kq + 8 * q4;
                const u32x2 lo = *(const u32x2*)qp, hi = *(const u32x2*)(qp + 32);
                const bf16x8 aF = __builtin_bit_cast(bf16x8, (u32x4){lo.x, lo.y, hi.x, hi.y});
                O[mt] = __builtin_amdgcn_mfma_f32_16x16x32_bf16(aF, bS, O[mt], 0, 0, 0); } }
#pragma unroll
        for (int dt = 0; dt < 8; ++dt) { const f32x4 dc = *(const f32x4*)(dec + 16 * dt + 4 * q4); S[dt] = S[dt] * dc;
#pragma unroll
            for (int ks = 0; ks < 2; ++ks) { const bf16x8 aF = *(const bf16x8*)(L + OFF_KET + (16 * dt + l15) * TP + 64 * ks + 16 * q4); S[dt] = __builtin_amdgcn_mfma_f32_16x16x32_bf16(aF, bV[ks], S[dt], 0, 0, 0); } }
        HSEC_E(6); HSEC_B();
#pragma unroll
        for (int mt = 0; mt < 4; ++mt)
#pragma unroll
            for (int r = 0; r < 4; ++r) { float p = O[mt][r] * O[mt][r]; p += __shfl_xor(p, 1); p += __shfl_xor(p, 2); p += __shfl_xor(p, 4); p += __shfl_xor(p, 8);
                if (l15 == 0) part[w * 64 + 16 * mt + 4 * q4 + r] = p; }
        __syncthreads();
        if (tid < 64) { float s = 0.f;
#pragma unroll
            for (int ww = 0; ww < 8; ++ww) s += part[ww * 64 + tid];
            rstd[tid] = rsqrtf(s * (1.0f / 128.0f) + 1e-6f); }
        __syncthreads();
        HSEC_E(7); HSEC_B();
#pragma unroll
        for (int mt = 0; mt < 4; ++mt) { const f32x4 rs = *(const f32x4*)(rstd + 16 * mt + 4 * q4);
#pragma unroll
            for (int r = 0; r < 4; ++r) { const float g = bf2f(gq[4 * mt + r]); const float o = O[mt][r] * rs[r] * ng * (g * __builtin_amdgcn_rcpf(1.0f + __expf(-g)));
                HO[(size_t)(r0 + 16 * mt + 4 * q4 + r) * 2048 + 16 * w + l15] = (bf16)f2bf(o); } }
        HSEC_E(8);
    }
    __syncthreads();
}

__device__ __forceinline__ void ph2_side(const Frame& F, int sid, int nside) {
    const Args& a = *F.a;
    const int gw = sid * 8 + F.wave, NGW = nside * 8, lane = F.lane();
    bf16* CKV = (bf16*)(F.ws + WS_CKV); bf16* IKW = (bf16*)(F.ws + WS_IKW);
    for (int row = gw; row < T; row += NGW) {
        {   u32x2 w = *(u32x2*)(CKV + (size_t)row * 256 + 4 * lane);
            float x0 = bflo(w.x), x1 = bfhi(w.x), x2 = bflo(w.y), x3 = bfhi(w.y);
            const float ss = wave_sum(x0 * x0 + x1 * x1 + x2 * x2 + x3 * x3);
            const float r = rsqrtf(ss * (1.0f / 256.0f) + 1e-6f);
            const f32x4 g = *(const f32x4*)(a.in[5] + 4 * lane);
            w.x = pk2(x0 * r * g.x, x1 * r * g.y); w.y = pk2(x2 * r * g.z, x3 * r * g.w);
            *(u32x2*)(CKV + (size_t)row * 256 + 4 * lane) = w; }
        {   unsigned w = *(unsigned*)(IKW + (size_t)row * 256 + 2 * lane);
            float x0 = bflo(w), x1 = bfhi(w);
            const float mu = wave_sum(x0 + x1) * (1.0f / 128.0f);
            x0 -= mu; x1 -= mu;
            const float var = wave_sum(x0 * x0 + x1 * x1) * (1.0f / 128.0f);
            const float r = rsqrtf(var + 1e-5f);
            const float g0 = a.in[6][2 * lane], g1 = a.in[6][2 * lane + 1], b0 = a.in[7][2 * lane], b1 = a.in[7][2 * lane + 1];
            *(unsigned*)(IKW + (size_t)row * 256 + 2 * lane) = pk2(x0 * r * g0 + b0, x1 * r * g1 + b1); }
    }
}
__device__ __forceinline__ void w8_transposes(const Frame& F, bf16* W8) {
    const Args& a = *F.a;
    const int gw = F.bid * 8 + F.wave, NGW = F.G * 8, lane = F.lane();
    float* scr = (float*)(F.lds + F.wave * 16384);
    for (int it = gw; it < 8 * 2048; it += NGW) { const int m = it >> 11;
        const float* wsrc = m == 0 ? a.in[11] : m == 1 ? a.in[12] : m == 2 ? a.in[13] : m == 3 ? a.in[16] : m == 4 ? a.in[17] : m == 5 ? a.in[18] : m == 6 ? a.in[19] : a.in[22];
        float* cv = (float*)(F.ws + WS_CTL + CTL_CVEC);
        bf16* dst = W8 + (size_t)m * 2048 * 2048;
        if (m == 3) transpose_item_ln(wsrc, dst, it & 2047, scr, lane, a.in[14], a.in[15], cv, cv + 2048);
        else if (m == 7) transpose_item_ln(wsrc, dst, it & 2047, scr, lane, a.in[20], a.in[21], cv + 4096, cv + 6144);
        else transpose_item(wsrc, 2048, dst, 2048, 0, 64, it & 2047, scr, lane, CmIdent()); }
}

__device__ __forceinline__ void ph3_hgnorm(const Frame& F) {
    const Args& a = *F.a;
    const int gw = F.bid * 8 + F.wave, NGW = F.G * 8, lane = F.lane();
    const float* oraw = a.out; const bf16* HG = F.slot(3); bf16* HO = F.slot(0);
    for (int u = gw; u < T * 16; u += NGW) {
        const size_t off = (size_t)(u >> 4) * 2048 + (u & 15) * 128 + 2 * lane;
        const float o0 = oraw[off], o1 = oraw[off + 1];
        const float r = rsqrtf(wave_sum(o0 * o0 + o1 * o1) * (1.0f / 128.0f) + 1e-6f);
        const unsigned gw2 = *(const unsigned*)(HG + off);
        const float g0 = bflo(gw2), g1 = bfhi(gw2);
        const int c = (u & 15) * 128 + 2 * lane;
        *(unsigned*)(HO + off) = pk2(o0 * r * a.in[4][c] * (g0 * sigm(g0)), o1 * r * a.in[4][c + 1] * (g1 * sigm(g1)));
    }
}

__device__ __forceinline__ unsigned fkey(float f) { const unsigned u = __float_as_uint(f); return (u & 0x80000000u) ? ~u : (u | 0x80000000u); }
__device__ __forceinline__ void ph5_select(const Frame& F, int first, int stride) {
    const int lane = F.lane(), l31 = lane & 31, half = lane >> 5, w = F.wave;
    float* scl = (float*)F.lds;
    const bf16* AIQ = F.slot(5); const bf16* IKW = (const bf16*)(F.ws + WS_IKW);
    unsigned* MASK = (unsigned*)(F.ws + WS_MASK);
    for (int i = first; i < 1024; i += stride) {
        const int r4 = i >> 8, c = i & 255, j = c & 127, b = 2 * r4 + (c >> 7), qt = (r4 & 1) ? 127 - j : j, t0 = qt * 16;
        bf16x8 Af[8];
        { const size_t rowA = (size_t)b * 2048 + t0 + 2 * w + ((l31 >> 2) & 1); const int headA = (l31 & 3) + 4 * (l31 >> 3);
#pragma unroll
          for (int ks = 0; ks < 8; ++ks) Af[ks] = *(const bf16x8*)(AIQ + rowA * 2048 + headA * 128 + 16 * ks + 8 * half); }
        float wr[16];
        { const bf16* wp = IKW + ((size_t)b * 2048 + t0 + 2 * w + half) * 256 + 128;
#pragma unroll
          for (int r = 0; r < 16; ++r) wr[r] = bf2f(wp[(r & 3) + 4 * (r >> 2)]) * (0.25f * 0.08838834764831845f); }
        const int nkt = (t0 + 15) / 32 + 1;
        unsigned char* ring = F.lds + 131072;
        const int srow = (w * 64 + lane) >> 4, sch = lane & 15;
        const bf16* kg = IKW + ((size_t)b * 2048 + srow) * 256 + 8 * sch;
        const int swr = srow * 256 + ((sch ^ (srow & 15)) << 4);
        const int frd = l31 * 256;
        u32x4 st0, st1;
        st0 = *(const u32x4*)kg; *(u32x4*)(ring + swr) = st0;
        if (nkt > 1) { st1 = *(const u32x4*)(kg + (size_t)32 * 256); *(u32x4*)(ring + 8192 + swr) = st1; }
        if (nkt > 2) st0 = *(const u32x4*)(kg + (size_t)2 * 32 * 256);
        __syncthreads();
#define IDX_TILE(kt_, STW, STL) do { \
            if ((kt_) + 3 < nkt) STL = *(const u32x4*)(kg + (size_t)((kt_) + 3) * 32 * 256); \
            { const unsigned char* sl_ = ring + ((kt_) % 3) * 8192 + frd; f32x16 acc; _Pragma("unroll") for (int r = 0; r < 16; ++r) acc[r] = 0.f; \
              _Pragma("unroll") for (int ks = 0; ks < 8; ++ks) { const bf16x8 bfr = *(const bf16x8*)(sl_ + (((2 * ks + half) ^ (l31 & 15)) << 4)); acc = __builtin_amdgcn_mfma_f32_32x32x16_bf16(Af[ks], bfr, acc, 0, 0, 0); } \
              float sc = 0.f; _Pragma("unroll") for (int r = 0; r < 16; ++r) sc += fmaxf(acc[r], 0.f) * wr[r]; \
              scl[(2 * w + half) * 2048 + (kt_) * 32 + l31] = sc; } \
            if ((kt_) + 2 < nkt) *(u32x4*)(ring + (((kt_) + 2) % 3) * 8192 + swr) = STW; \
            __syncthreads(); } while (0)
        for (int kt = 0; kt < nkt; kt += 2) { IDX_TILE(kt, st0, st1); if (kt + 1 < nkt) IDX_TILE(kt + 1, st1, st0); }
#undef IDX_TILE
        WAVE_SYNC();
#pragma unroll 1
        for (int qi = 0; qi < 2; ++qi) {
            const int t = t0 + 2 * w + qi; const float* row = scl + (2 * w + qi) * 2048;
            unsigned key[32];
#pragma unroll
            for (int jj = 0; jj < 32; ++jj) { const int s2 = lane + 64 * jj; key[jj] = (s2 <= t) ? fkey(row[s2]) : 0u; }
            unsigned thr = 0u;
            if (t + 1 > 256) {
                for (int bit = 31; bit >= 0; --bit) {
                    const unsigned cand = thr | (1u << bit);
                    int cnt = 0;
#pragma unroll
                    for (int jj = 0; jj < 32; ++jj) cnt += (key[jj] >= cand) ? 1 : 0;
#pragma unroll
                    for (int o = 32; o >= 1; o >>= 1) cnt += __shfl_xor(cnt, o);
                    if (cnt >= 256) { thr = cand; if (cnt == 256) break; }
                }
            }
            unsigned wd = 0u;
#pragma unroll
            for (int jj = 0; jj < 32; ++jj) { const int s2 = lane + 64 * jj; const unsigned long long m = __ballot(s2 <= t && key[jj] >= thr);
                if (lane == 2 * jj) wd = (unsigned)m; if (lane == 2 * jj + 1) wd = (unsigned)(m >> 32); }
            MASK[((size_t)b * 2048 + t) * 64 + lane] = wd;
        }
        WAVE_SYNC();
    }
}

__device__ __forceinline__ int t5_bucket(int d) {
    if (d < 16) return d;
    return 16 + (d >= 19) + (d >= 21) + (d >= 24) + (d >= 27) + (d >= 31) + (d >= 35) + (d >= 40) + (d >= 46) + (d >= 52) + (d >= 59) + (d >= 67) + (d >= 77) + (d >= 87) + (d >= 99) + (d >= 113);
}
namespace dsa {
constexpr float SCALE = 0.08838834764831845f;
constexpr int NW = 8, QBLK = 32, KVBLK = 64, QB = NW * QBLK, DH = 128, LD = 2048;
constexpr int SHM_V = KVBLK * DH * 2, SHM_K = KVBLK * DH * 2;
constexpr int OFF_WS = 2 * SHM_V + 2 * SHM_K, OFF_BIAS = OFF_WS + NW * 64 * 4, LDS_TOTAL = OFF_BIAS + 16 * 128 * 4;
constexpr float THR = 8.f;
typedef short s16x4 __attribute__((ext_vector_type(4)));
#define KSWZ(row, colB) ((row) * 256 + ((colB) ^ (((row) & 7) << 4)))
#define SBAR() __builtin_amdgcn_sched_barrier(0)
__device__ __forceinline__ int v_st(int k, int c) { const int kk = (k & ~0xC) | ((k & 4) << 1) | ((k & 8) >> 1); return ((kk >> 3) * 4 + (c >> 5)) * 512 + ((kk & 7) * 32 + (c & 31)) * 2; }
__device__ __forceinline__ int v_rd_base(int lane) { return ((lane & 3) << 3) | (((lane >> 2) & 3) << 6) | (((lane >> 4) & 1) << 5) | (((lane >> 5) & 1) << 8); }
constexpr int v_rd_off(int d0, int ks, int half) { return d0 * 512 + ks * 4096 + half * 2048; }
__device__ __forceinline__ int crow(int r, int hi) { return (r & 3) + 8 * (r >> 2) + 4 * hi; }
__device__ __forceinline__ unsigned cvtpk(float lo, float hi) { unsigned r; asm volatile("v_cvt_pk_bf16_f32 %0, %1, %2" : "=v"(r) : "v"(lo), "v"(hi)); return r; }
__device__ __forceinline__ bf16x8 load8(const bf16* p) { return *reinterpret_cast<const bf16x8*>(p); }
template <bool NEAR>
__device__ __forceinline__ void init_scores(f32x16& p0, f32x16& p1, unsigned w0, unsigned w1, int hi, int dq, const float* bl) {
    w0 >>= 4 * hi; w1 >>= 4 * hi;
#pragma unroll
    for (int r = 0; r < 16; ++r) { const int c = (r & 3) + 8 * (r >> 2);
        const int x0 = __builtin_amdgcn_sbfe(w0, c, 1), x1 = __builtin_amdgcn_sbfe(w1, c, 1);
        unsigned b0 = 0u, b1 = 0u;
        if (NEAR) { int d0 = dq - c, d1 = dq - c - 32; d0 = d0 < 0 ? 0 : (d0 > 127 ? 127 : d0); d1 = d1 < 0 ? 0 : (d1 > 127 ? 127 : d1);
            b0 = __float_as_uint(bl[d0]); b1 = __float_as_uint(bl[d1]); }
        p0[r] = __uint_as_float((b0 & (unsigned)x0) | (0xFF800000u & ~(unsigned)x0));
        p1[r] = __uint_as_float((b1 & (unsigned)x1) | (0xFF800000u & ~(unsigned)x1)); }
}
__device__ __forceinline__ void partialSM(f32x16& p0, f32x16& p1, float& m_reg, float& mn, float& alpha) {
    float pmax = p0[0];
#pragma unroll
    for (int r = 1; r < 16; ++r) pmax = fmaxf(pmax, p0[r]);
#pragma unroll
    for (int r = 0; r < 16; ++r) pmax = fmaxf(pmax, p1[r]);
    { auto rr = __builtin_amdgcn_permlane32_swap(__float_as_uint(pmax), __float_as_uint(pmax), false, false);
      pmax = fmaxf(__uint_as_float(rr[0]), __uint_as_float(rr[1])); }
    constexpr float C2 = 1.4426950408889634f * SCALE;
    if (__builtin_expect(__all((pmax - m_reg) * SCALE <= THR), 1)) { mn = m_reg; alpha = 1.f; }
    else { mn = fmaxf(m_reg, pmax); alpha = __builtin_amdgcn_exp2f((m_reg - mn) * C2); m_reg = mn; }
    const float mnL = -mn * C2;
#pragma unroll
    for (int r = 0; r < 16; ++r) p0[r] = fmaf(p0[r], C2, mnL);
#pragma unroll
    for (int r = 0; r < 16; ++r) p1[r] = fmaf(p1[r], C2, mnL);
#pragma unroll
    for (int r = 0; r < 16; ++r) p0[r] = __builtin_amdgcn_exp2f(p0[r]);
}
__device__ __forceinline__ void finishSM(f32x16& p0, f32x16& p1, float alpha, float& l_reg, bf16x8& pa0, bf16x8& pa1, bf16x8& pa2, bf16x8& pa3) {
#pragma unroll
    for (int r = 0; r < 16; ++r) p1[r] = __builtin_amdgcn_exp2f(p1[r]);
    float ps = 0;
#pragma unroll
    for (int r = 0; r < 16; ++r) ps += p0[r];
#pragma unroll
    for (int r = 0; r < 16; ++r) ps += p1[r];
    { auto rr = __builtin_amdgcn_permlane32_swap(__float_as_uint(ps), __float_as_uint(ps), false, false);
      ps = __uint_as_float(rr[0]) + __uint_as_float(rr[1]); }
    l_reg = l_reg * alpha + ps;
#define PK4(P, B_, OUT) do { unsigned a0 = cvtpk(P[B_+0], P[B_+1]), a1 = cvtpk(P[B_+2], P[B_+3]);                          \
        unsigned b0 = cvtpk(P[B_+4], P[B_+5]), b1 = cvtpk(P[B_+6], P[B_+7]);                                             \
        auto r0 = __builtin_amdgcn_permlane32_swap(a0, b0, false, false); auto r1 = __builtin_amdgcn_permlane32_swap(a1, b1, false, false); \
        u32x4 w = {r0[0], r1[0], r0[1], r1[1]}; OUT = *reinterpret_cast<bf16x8*>(&w); } while (0)
    PK4(p0, 0, pa0); PK4(p0, 8, pa1); PK4(p1, 0, pa2); PK4(p1, 8, pa3);
#undef PK4
}
template <int KB>
__device__ __forceinline__ void qkt(f32x16& p0, f32x16& p1, const char* K_lds, int r32, int hi, const bf16x8* qr) {
    const char* kb[4];
#pragma unroll
    for (int dd = 0; dd < 4; ++dd) kb[dd] = K_lds + KB * SHM_K + KSWZ(r32, (dd * 16 + hi * 8) * 2);
#pragma unroll
    for (int d0 = 0; d0 < 8; ++d0) { const char* a = kb[d0 & 3] + (d0 >> 2) * 128;
        bf16x8 b0 = *reinterpret_cast<const bf16x8*>(a);
        bf16x8 b1 = *reinterpret_cast<const bf16x8*>(a + 32 * 256);
        p0 = __builtin_amdgcn_mfma_f32_32x32x16_bf16(b0, qr[d0], p0, 0, 0, 0);
        p1 = __builtin_amdgcn_mfma_f32_32x32x16_bf16(b1, qr[d0], p1, 0, 0, 0); }
}
template <int VB>
__device__ __forceinline__ void pv_tile(f32x16* o, int vb0, bf16x8 pa0, bf16x8 pa1, bf16x8 pa2, bf16x8 pa3) {
#define TRRD(dst, off) asm volatile("ds_read_b64_tr_b16 %0, %1 offset:%2" : "=&v"(dst) : "v"(vb0), "i"(off) : "memory")
#define PV_D0(d0) do { s16x4 l0, l1, l2, l3, h0, h1, h2, h3; constexpr int b_ = VB * SHM_V + v_rd_off(d0, 0, 0); \
        TRRD(l0, b_); TRRD(h0, b_ + 2048); TRRD(l1, b_ + 4096); TRRD(h1, b_ + 6144); TRRD(l2, b_ + 8192); TRRD(h2, b_ + 10240); TRRD(l3, b_ + 12288); TRRD(h3, b_ + 14336); \
        asm volatile("s_waitcnt lgkmcnt(0)" ::: "memory"); SBAR();   \
        o[d0] = __builtin_amdgcn_mfma_f32_32x32x16_bf16(pa0, (bf16x8){l0[0], l0[1], l0[2], l0[3], h0[0], h0[1], h0[2], h0[3]}, o[d0], 0, 0, 0);   \
        o[d0] = __builtin_amdgcn_mfma_f32_32x32x16_bf16(pa1, (bf16x8){l1[0], l1[1], l1[2], l1[3], h1[0], h1[1], h1[2], h1[3]}, o[d0], 0, 0, 0);   \
        o[d0] = __builtin_amdgcn_mfma_f32_32x32x16_bf16(pa2, (bf16x8){l2[0], l2[1], l2[2], l2[3], h2[0], h2[1], h2[2], h2[3]}, o[d0], 0, 0, 0);   \
        o[d0] = __builtin_amdgcn_mfma_f32_32x32x16_bf16(pa3, (bf16x8){l3[0], l3[1], l3[2], l3[3], h3[0], h3[1], h3[2], h3[3]}, o[d0], 0, 0, 0); } while (0)
    PV_D0(0); PV_D0(1); PV_D0(2); PV_D0(3);
#undef PV_D0
#undef TRRD
}
struct BlockRef { const bf16* Q; const bf16* K; const bf16* V; bf16* O; const unsigned* M; int P0; int h; };
struct Seam { bf16x8 qr[8]; bf16x8 st_v0, st_v1, st_k0, st_k1; };
#define ROWU(p, k0) ((p) + (size_t)(k0) * LD)
#define VMW() asm volatile("s_waitcnt vmcnt(0)" ::: "memory")
#define VMWN(n) asm volatile("s_waitcnt vmcnt(%0)" :: "i"(n) : "memory")
#define SLOAD_H(Kp, Vp, k0) do { S.st_v0 = load8(ROWU(Vp, k0) + sofs); S.st_v1 = load8(ROWU(Vp, (k0) + 32) + sofs);              \
                         S.st_k0 = load8(ROWU(Kp, k0) + sofs); S.st_k1 = load8(ROWU(Kp, (k0) + 32) + sofs); } while (0)
#define SWRITE_HK(bf) do { *(bf16x8*)(K_lds + (bf) * SHM_K + kws) = S.st_k0; *(bf16x8*)(K_lds + (bf) * SHM_K + kws + 32 * 256) = S.st_k1; } while (0)
#define SWRITE_HV(bf) do { *(bf16x8*)(V_lds + (bf) * SHM_V + vst0) = S.st_v0; *(bf16x8*)(V_lds + (bf) * SHM_V + vst1) = S.st_v1; } while (0)
#define SWRITE_H(bf) do { SWRITE_HV(bf); SWRITE_HK(bf); } while (0)
__device__ __forceinline__ void prime(const BlockRef& cur, char* lds, Seam& S, int wid) {
    const int lane = fresh_lane(), tid = wid * 64 + lane, r32 = lane & 31, hi = lane >> 5;
    const int sr = tid >> 4, sc = (tid & 15) * 8, kws = KSWZ(sr, sc * 2); char* K_lds = lds + 2 * SHM_V; const unsigned sofs = (unsigned)(sr * LD + sc);
    const unsigned qofs = (unsigned)((wid * QBLK + r32) * LD + hi * 8);
#pragma unroll
    for (int d0 = 0; d0 < 8; ++d0) S.qr[d0] = load8(cur.Q + qofs + d0 * 16);
    SLOAD_H(cur.K, cur.V, 0); VMW(); SWRITE_HK(0);
    __syncthreads();
}
__device__ __forceinline__ void block(const BlockRef& cur, const BlockRef& nxt, char* lds, Seam& S, int wid) {
    const int lane = fresh_lane(), tid = wid * 64 + lane,
               r32 = lane & 31, hi = lane >> 5;
    const int NT = (cur.P0 + QB - 1) / KVBLK + 1;
    const int qlo = cur.P0 + wid * QBLK, qm = qlo + r32 - 4 * hi;
    char* V_lds = lds; char* K_lds = lds + 2 * SHM_V;
    float* ws = (float*)(lds + OFF_WS) + wid * 64; float* li_l = ws, * al_l = ws + 32;
    const float* bl = (const float*)(lds + OFF_BIAS) + cur.h * 128;
    const unsigned mofs = (unsigned)((wid * QBLK + r32) * 64);
    float m_reg = -1e30f, l_reg = 0; f32x16 o[4] = {};
    const int sr = tid >> 4, sc = (tid & 15) * 8, vst0 = v_st(sr, sc), vst1 = v_st(32 + sr, sc), kws = KSWZ(sr, sc * 2); const unsigned sofs = (unsigned)(sr * LD + sc);
    const int vb0 = (int)(uintptr_t)V_lds + v_rd_base(lane);
    const bf16* Kh = cur.K; const bf16* Vh = cur.V;
#define RESC(a) do { if (__any((a) < 1.f)) { if (hi == 0) al_l[r32] = (a); asm volatile("s_waitcnt lgkmcnt(0)" ::: "memory");              \
                     for (int d_ = 0; d_ < 4; ++d_) for (int r = 0; r < 16; ++r) o[d_][r] *= al_l[crow(r, hi)]; } } while (0)
#define KBASE(t) ((t) * KVBLK)
#define LDMASK(t) (*(const u32x2*)(cur.M + 2 * ((t) < 31 ? (t) : 31) + mofs))
#define INIT(P0_, P1_, t) do { const int kb_ = KBASE(t); if (qlo - kb_ - 63 < 113) init_scores<true>(P0_, P1_, mw.x, mw.y, hi, qm - kb_, bl); else init_scores<false>(P0_, P1_, mw.x, mw.y, hi, 0, bl); } while (0)
#define SEAM_K0() do { VMWN(8); SWRITE_HK(0); SBAR(); } while (0)
    f32x16 pA0, pA1, pB0, pB1; float mnA, mnB, alA, alB; bf16x8 pa0, pa1, pa2, pa3; u32x2 mw;
    SWRITE_HV(0); SBAR();
    if (NT > 1) { SLOAD_H(Kh, Vh, KBASE(1)); }
    mw = LDMASK(0); INIT(pA0, pA1, 0); mw = LDMASK(1);
    SBAR(); qkt<0>(pA0, pA1, K_lds, r32, hi, S.qr);
    partialSM(pA0, pA1, m_reg, mnA, alA);
    if (NT > 1) { VMW(); SWRITE_H(1); }
    __syncthreads();
#define HALF_STEP(PX0, PX1, mnX, alX, PY0, PY1, alY, t, KB, VB, SB) do {                                                      \
        INIT(PX0, PX1, (t)); mw = LDMASK((t) + 1);                                                                           \
        SBAR(); qkt<KB>(PX0, PX1, K_lds, r32, hi, S.qr);                                                                      \
        finishSM(PY0, PY1, alY, l_reg, pa0, pa1, pa2, pa3); SBAR();                                                           \
        if ((t) + 1 < NT) { SLOAD_H(Kh, Vh, KBASE((t) + 1)); SBAR(); }                                                        \
        pv_tile<VB>(o, vb0, pa0, pa1, pa2, pa3); partialSM(PX0, PX1, m_reg, mnX, alX);              \
        __syncthreads();                                                                                                      \
        if ((t) + 1 < NT) { VMW(); SWRITE_H(SB); }                                                                            \
        RESC(alX); __syncthreads(); } while (0)
    for (int t = 1; t + 1 < NT; t += 2) {
        HALF_STEP(pB0, pB1, mnB, alB, pA0, pA1, alA, t, 1, 0, 0);
        HALF_STEP(pA0, pA1, mnA, alA, pB0, pB1, alB, t + 1, 0, 1, 1);
    }
    const bool even = (NT & 1) == 0;
    if (even) { INIT(pB0, pB1, NT - 1); SBAR(); qkt<1>(pB0, pB1, K_lds, r32, hi, S.qr); SBAR(); }
    SLOAD_H(nxt.K, nxt.V, 0); SBAR();
#pragma unroll
    for (int d0 = 0; d0 < 8; ++d0) S.qr[d0] = load8(nxt.Q + (unsigned)((wid * QBLK + r32) * LD + hi * 8) + d0 * 16);
    SBAR();
    finishSM(pA0, pA1, alA, l_reg, pa0, pa1, pa2, pa3); SBAR();
    pv_tile<0>(o, vb0, pa0, pa1, pa2, pa3);
    if (even) { partialSM(pB0, pB1, m_reg, mnB, alB); __syncthreads(); RESC(alB);
        finishSM(pB0, pB1, alB, l_reg, pa0, pa1, pa2, pa3); SBAR(); pv_tile<1>(o, vb0, pa0, pa1, pa2, pa3); }
    SBAR(); SEAM_K0();
    if (hi == 0) li_l[r32] = l_reg; asm volatile("s_waitcnt lgkmcnt(0)" ::: "memory");
    float rli[16];
#pragma unroll
    for (int r = 0; r < 16; ++r) rli[r] = __builtin_amdgcn_rcpf(li_l[crow(r, hi)]);
    int lofs = 4 * hi * LD + r32; asm volatile("" : "+v"(lofs));
    bf16* Ow = cur.O + (size_t)(wid * QBLK) * LD + lofs;
#pragma unroll
    for (int r = 0; r < 16; ++r) { const int orow = (r & 3) + 8 * (r >> 2);
#pragma unroll
        for (int d0 = 0; d0 < 4; ++d0) { const float v = o[d0][r] * rli[r];
            const float vn = __shfl_xor(v, 1);
            if ((r32 & 1) == 0) *(unsigned*)(Ow + orow * LD + d0 * 32) = cvtpk(v, vn); } }
    __syncthreads();
#undef RESC
#undef KBASE
#undef LDMASK
#undef INIT
#undef SEAM_K0
#undef HALF_STEP
}
#undef ROWU
#undef VMW
#undef VMWN
#undef SLOAD_H
#undef SWRITE_HK
#undef SWRITE_HV
#undef SWRITE_H
#undef KSWZ
#undef SBAR
}

__device__ __forceinline__ dsa::BlockRef dsa_ref(const Frame& F, int bh, int qb) {
    const int b = bh >> 4, h = bh & 15;
    dsa::BlockRef r;
    r.Q = F.slot(4) + ((size_t)b * 2048 + (size_t)qb * 256) * 2048 + h * 128;
    r.O = F.slot(3) + ((size_t)b * 2048 + (size_t)qb * 256) * 2048 + h * 128;
    r.K = F.slot(1) + (size_t)b * 2048 * 2048 + h * 128; r.V = F.slot(2) + (size_t)b * 2048 * 2048 + h * 128;
    r.M = (const unsigned*)(F.ws + WS_MASK) + ((size_t)b * 2048 + (size_t)qb * 256) * 64;
    r.P0 = qb * 256; r.h = h;
    return r;
}
__device__ __forceinline__ void ph6_attn(const Frame& F) {
    const Args& a = *F.a;
    char* lds = (char*)F.lds;
    {
        float* bt = (float*)(lds + dsa::OFF_BIAS);
        for (int i = F.wave * 64 + F.lane(); i < 16 * 128; i += 512) { const int h = i >> 7, d = i & 127; bt[i] = (a.in[10][t5_bucket(d) * 16 + h] - a.in[10][31 * 16 + h]) * (1.0f / dsa::SCALE); }
    }
    __syncthreads();
    const int total = 4 * 128;
    int L = F.bid; if (L >= total) return;
#define ATT_BH(L_) (((L_) >> 8) * 64 + ((L_) & 7) * 8 + ((((L_) & 255) >> 3) >> 2))
#define ATT_PR(L_) ((((L_) & 255) >> 3) & 3)
    int pass = 0;
    const bool xmap = (F.G == 256);
    dsa::BlockRef cur = dsa_ref(F, xmap ? ATT_BH(L) : (L >> 2), xmap ? ATT_PR(L) : (L & 3));
    dsa::Seam S;
    dsa::prime(cur, lds, S, F.wave);
    for (;;) {
        const bool more_pass = pass == 0, more_item = L + F.G < total, last = !more_pass && !more_item;
        int passn = pass + 1, Ln = L;
        if (!more_pass) { passn = 0; Ln = more_item ? L + F.G : L; }
        const int bhn = xmap ? ATT_BH(Ln) : (Ln >> 2), prn = xmap ? ATT_PR(Ln) : (Ln & 3);
        const dsa::BlockRef nxt = last ? cur : dsa_ref(F, bhn, passn ? 7 - prn : prn);
        dsa::block(cur, nxt, lds, S, F.wave);
        if (last) break;
        cur = nxt; pass = passn; L = Ln;
    }
}

__device__ __forceinline__ void ln_row(float* zrow, const float* g, const float* bta, bf16* brow, int lane) {
    f32x4 v[8]; float s = 0.f;
#pragma unroll
    for (int i = 0; i < 8; ++i) { v[i] = *(const f32x4*)(zrow + 256 * i + 4 * lane); s += (v[i].x + v[i].y) + (v[i].z + v[i].w); }
    const float mu = wave_sum(s) * (1.0f / 2048.0f); float s2 = 0.f;
#pragma unroll
    for (int i = 0; i < 8; ++i) { v[i] = v[i] - mu; s2 += (v[i].x * v[i].x + v[i].y * v[i].y) + (v[i].z * v[i].z + v[i].w * v[i].w); }
    const float r = rsqrtf(wave_sum(s2) * (1.0f / 2048.0f) + 1e-5f);
#pragma unroll
    for (int i = 0; i < 8; ++i) { const f32x4 gg = *(const f32x4*)(g + 256 * i + 4 * lane), bb = *(const f32x4*)(bta + 256 * i + 4 * lane);
        const f32x4 o = v[i] * r * gg + bb; *(f32x4*)(zrow + 256 * i + 4 * lane) = o;
        if (brow) { u32x2 w; w.x = pk2(o.x, o.y); w.y = pk2(o.z, o.w); *(u32x2*)(brow + 256 * i + 4 * lane) = w; } }
}
__device__ __forceinline__ void ph_ln(const Frame& F, const float* g, const float* bta, bf16* bout) {
    const int gw = F.bid * 8 + F.wave, NGW = F.G * 8, lane = F.lane();
    for (int row = gw; row < T; row += NGW) ln_row(F.a->out + (size_t)row * 2048, g, bta, bout + (size_t)row * 2048, lane);
}

__device__ __forceinline__ float pk_idx(float v, unsigned code, unsigned mask) { return __uint_as_float((__float_as_uint(v) & ~mask) | code); }
__device__ __forceinline__ void ph_peer_select(const Frame& F) {
    const Args& a = *F.a;
    const int lane = F.lane(), l31 = lane & 31, half = lane >> 5;
    const float* PQ = (const float*)F.slot(1); const float* keys = a.in[23];
    int* EIDX = (int*)(F.ws + WS_CKV); float* EG = (float*)(F.ws + WS_IKW);
    const float NEG = -__builtin_inff();
    for (int tile = F.bid; tile < T / 32; tile += F.G) {
        const int h = F.wave, t = tile * 32 + l31;
        float tv[2][16];
#pragma unroll
        for (int p = 0; p < 2; ++p) {
            const int g = 2 * h + p;
            float qv[64];
            { const float* qp = PQ + (size_t)t * 2048 + g * 128 + 64 * half;
#pragma unroll
              for (int j = 0; j < 16; ++j) { const f32x4 v = *(const f32x4*)(qp + 4 * j); qv[4 * j] = v.x; qv[4 * j + 1] = v.y; qv[4 * j + 2] = v.z; qv[4 * j + 3] = v.w; } }
            f32x16 acc[4];
#pragma unroll
            for (int mt = 0; mt < 4; ++mt)
#pragma unroll
                for (int r = 0; r < 16; ++r) acc[mt][r] = 0.f;
            const float* kp0 = keys + ((size_t)(g * 128 + l31) * 128 + 64 * half);
            f32x4 kb[3][4];
#define PK_LOADC(cc) do { _Pragma("unroll") for (int u_ = 0; u_ < 4; ++u_) kb[(cc) % 3][u_] = *(const f32x4*)(kp0 + (size_t)((cc) >> 2) * 32 * 128 + 16 * ((cc) & 3) + 4 * u_); } while (0)
#define PK_MMAC(cc) do { _Pragma("unroll") for (int u_ = 0; u_ < 4; ++u_) { const f32x4 kv_ = kb[(cc) % 3][u_]; const int j_ = 4 * ((cc) & 3) + u_; \
                acc[(cc) >> 2] = __builtin_amdgcn_mfma_f32_32x32x2f32(kv_.x, qv[4 * j_], acc[(cc) >> 2], 0, 0, 0); acc[(cc) >> 2] = __builtin_amdgcn_mfma_f32_32x32x2f32(kv_.y, qv[4 * j_ + 1], acc[(cc) >> 2], 0, 0, 0); \
                acc[(cc) >> 2] = __builtin_amdgcn_mfma_f32_32x32x2f32(kv_.z, qv[4 * j_ + 2], acc[(cc) >> 2], 0, 0, 0); acc[(cc) >> 2] = __builtin_amdgcn_mfma_f32_32x32x2f32(kv_.w, qv[4 * j_ + 3], acc[(cc) >> 2], 0, 0, 0); } } while (0)
            PK_LOADC(0); PK_LOADC(1);
            PK_LOADC(2); PK_MMAC(0); __builtin_amdgcn_sched_barrier(0);
            PK_LOADC(3); PK_MMAC(1); __builtin_amdgcn_sched_barrier(0);
            PK_LOADC(4); PK_MMAC(2); __builtin_amdgcn_sched_barrier(0);
            PK_LOADC(5); PK_MMAC(3); __builtin_amdgcn_sched_barrier(0);
            PK_LOADC(6); PK_MMAC(4); __builtin_amdgcn_sched_barrier(0);
            PK_LOADC(7); PK_MMAC(5); __builtin_amdgcn_sched_barrier(0);
            PK_LOADC(8); PK_MMAC(6); __builtin_amdgcn_sched_barrier(0);
            PK_LOADC(9); PK_MMAC(7); __builtin_amdgcn_sched_barrier(0);
            PK_LOADC(10); PK_MMAC(8); __builtin_amdgcn_sched_barrier(0);
            PK_LOADC(11); PK_MMAC(9); __builtin_amdgcn_sched_barrier(0);
            PK_LOADC(12); PK_MMAC(10); __builtin_amdgcn_sched_barrier(0);
            PK_LOADC(13); PK_MMAC(11); __builtin_amdgcn_sched_barrier(0);
            PK_LOADC(14); PK_MMAC(12); __builtin_amdgcn_sched_barrier(0);
            PK_LOADC(15); PK_MMAC(13); __builtin_amdgcn_sched_barrier(0);
            PK_MMAC(14); __builtin_amdgcn_sched_barrier(0);
            PK_MMAC(15); __builtin_amdgcn_sched_barrier(0);
#undef PK_LOADC
#undef PK_MMAC
            unsigned hmask = ~(4u * (unsigned)half); asm volatile("" : "+v"(hmask));
#pragma unroll
            for (int mt = 0; mt < 4; ++mt)
#pragma unroll
                for (int r = 0; r < 16; ++r) acc[mt][r] = __uint_as_float(((__float_as_uint(acc[mt][r]) & ~127u) | (unsigned)(127 - (32 * mt + (r & 3) + 8 * (r >> 2)))) & hmask);
#pragma unroll
            for (int k = 0; k < 16; ++k) {
                float m = acc[0][0];
#pragma unroll
                for (int mt = 0; mt < 4; ++mt)
#pragma unroll
                    for (int r = 0; r < 16; ++r) m = fmaxf(m, acc[mt][r]);
                m = fmaxf(m, __shfl_xor(m, 32));
                tv[p][k] = m;
#pragma unroll
                for (int mt = 0; mt < 4; ++mt)
#pragma unroll
                    for (int r = 0; r < 16; ++r) acc[mt][r] = (acc[mt][r] == m) ? NEG : acc[mt][r];
            }
        }
        float cand[25]; int cid[25];
        unsigned hc = 25u * (unsigned)half; asm volatile("" : "+v"(hc));
        { const float ai = half ? tv[0][2] : tv[0][0], bj = half ? tv[1][1] : tv[1][0];
          cand[0] = pk_idx(ai + bj, (unsigned)(63 - 0) - hc, 63u); cid[0] = (int)((127u - (__float_as_uint(ai) & 127u)) * 128u + (127u - (__float_as_uint(bj) & 127u))); }
        { const float ai = half ? tv[0][2] : tv[0][0], bj = half ? tv[1][2] : tv[1][1];
          cand[1] = pk_idx(ai + bj, (unsigned)(63 - 1) - hc, 63u); cid[1] = (int)((127u - (__float_as_uint(ai) & 127u)) * 128u + (127u - (__float_as_uint(bj) & 127u))); }
        { const float ai = half ? tv[0][2] : tv[0][0], bj = half ? tv[1][3] : tv[1][2];
          cand[2] = pk_idx(ai + bj, (unsigned)(63 - 2) - hc, 63u); cid[2] = (int)((127u - (__float_as_uint(ai) & 127u)) * 128u + (127u - (__float_as_uint(bj) & 127u))); }
        { const float ai = half ? tv[0][2] : tv[0][0], bj = half ? tv[1][4] : tv[1][3];
          cand[3] = pk_idx(ai + bj, (unsigned)(63 - 3) - hc, 63u); cid[3] = (int)((127u - (__float_as_uint(ai) & 127u)) * 128u + (127u - (__float_as_uint(bj) & 127u))); }
        { const float ai = half ? tv[0][3] : tv[0][0], bj = half ? tv[1][0] : tv[1][4];
          cand[4] = pk_idx(ai + bj, (unsigned)(63 - 4) - hc, 63u); cid[4] = (int)((127u - (__float_as_uint(ai) & 127u)) * 128u + (127u - (__float_as_uint(bj) & 127u))); }
        { const float ai = half ? tv[0][3] : tv[0][0], bj = half ? tv[1][1] : tv[1][5];
          cand[5] = pk_idx(ai + bj, (unsigned)(63 - 5) - hc, 63u); cid[5] = (int)((127u - (__float_as_uint(ai) & 127u)) * 128u + (127u - (__float_as_uint(bj) & 127u))); }
        { const float ai = half ? tv[0][3] : tv[0][0], bj = half ? tv[1][2] : tv[1][6];
          cand[6] = pk_idx(ai + bj, (unsigned)(63 - 6) - hc, 63u); cid[6] = (int)((127u - (__float_as_uint(ai) & 127u)) * 128u + (127u - (__float_as_uint(bj) & 127u))); }
        { const float ai = half ? tv[0][3] : tv[0][0], bj = half ? tv[1][3] : tv[1][7];
          cand[7] = pk_idx(ai + bj, (unsigned)(63 - 7) - hc, 63u); cid[7] = (int)((127u - (__float_as_uint(ai) & 127u)) * 128u + (127u - (__float_as_uint(bj) & 127u))); }
        { const float ai = half ? tv[0][4] : tv[0][0], bj = half ? tv[1][0] : tv[1][8];
          cand[8] = pk_idx(ai + bj, (unsigned)(63 - 8) - hc, 63u); cid[8] = (int)((127u - (__float_as_uint(ai) & 127u)) * 128u + (127u - (__float_as_uint(bj) & 127u))); }
        { const float ai = half ? tv[0][4] : tv[0][0], bj = half ? tv[1][1] : tv[1][9];
          cand[9] = pk_idx(ai + bj, (unsigned)(63 - 9) - hc, 63u); cid[9] = (int)((127u - (__float_as_uint(ai) & 127u)) * 128u + (127u - (__float_as_uint(bj) & 127u))); }
        { const float ai = half ? tv[0][4] : tv[0][0], bj = half ? tv[1][2] : tv[1][10];
          cand[10] = pk_idx(ai + bj, (unsigned)(63 - 10) - hc, 63u); cid[10] = (int)((127u - (__float_as_uint(ai) & 127u)) * 128u + (127u - (__float_as_uint(bj) & 127u))); }
        { const float ai = half ? tv[0][5] : tv[0][0], bj = half ? tv[1][0] : tv[1][11];
          cand[11] = pk_idx(ai + bj, (unsigned)(63 - 11) - hc, 63u); cid[11] = (int)((127u - (__float_as_uint(ai) & 127u)) * 128u + (127u - (__float_as_uint(bj) & 127u))); }
        { const float ai = half ? tv[0][5] : tv[0][0], bj = half ? tv[1][1] : tv[1][12];
          cand[12] = pk_idx(ai + bj, (unsigned)(63 - 12) - hc, 63u); cid[12] = (int)((127u - (__float_as_uint(ai) & 127u)) * 128u + (127u - (__float_as_uint(bj) & 127u))); }
        { const float ai = half ? tv[0][6] : tv[0][0], bj = half ? tv[1][0] : tv[1][13];
          cand[13] = pk_idx(ai + bj, (unsigned)(63 - 13) - hc, 63u); cid[13] = (int)((127u - (__float_as_uint(ai) & 127u)) * 128u + (127u - (__float_as_uint(bj) & 127u))); }
        { const float ai = half ? tv[0][6] : tv[0][0], bj = half ? tv[1][1] : tv[1][14];
          cand[14] = pk_idx(ai + bj, (unsigned)(63 - 14) - hc, 63u); cid[14] = (int)((127u - (__float_as_uint(ai) & 127u)) * 128u + (127u - (__float_as_uint(bj) & 127u))); }
        { const float ai = half ? tv[0][7] : tv[0][0], bj = half ? tv[1][0] : tv[1][15];
          cand[15] = pk_idx(ai + bj, (unsigned)(63 - 15) - hc, 63u); cid[15] = (int)((127u - (__float_as_uint(ai) & 127u)) * 128u + (127u - (__float_as_uint(bj) & 127u))); }
        { const float ai = half ? tv[0][7] : tv[0][1], bj = half ? tv[1][1] : tv[1][0];
          cand[16] = pk_idx(ai + bj, (unsigned)(63 - 16) - hc, 63u); cid[16] = (int)((127u - (__float_as_uint(ai) & 127u)) * 128u + (127u - (__float_as_uint(bj) & 127u))); }
        { const float ai = half ? tv[0][8] : tv[0][1], bj = half ? tv[1][0] : tv[1][1];
          cand[17] = pk_idx(ai + bj, (unsigned)(63 - 17) - hc, 63u); cid[17] = (int)((127u - (__float_as_uint(ai) & 127u)) * 128u + (127u - (__float_as_uint(bj) & 127u))); }
        { const float ai = half ? tv[0][9] : tv[0][1], bj = half ? tv[1][0] : tv[1][2];
          cand[18] = pk_idx(ai + bj, (unsigned)(63 - 18) - hc, 63u); cid[18] = (int)((127u - (__float_as_uint(ai) & 127u)) * 128u + (127u - (__float_as_uint(bj) & 127u))); }
        { const float ai = half ? tv[0][10] : tv[0][1], bj = half ? tv[1][0] : tv[1][3];
          cand[19] = pk_idx(ai + bj, (unsigned)(63 - 19) - hc, 63u); cid[19] = (int)((127u - (__float_as_uint(ai) & 127u)) * 128u + (127u - (__float_as_uint(bj) & 127u))); }
        { const float ai = half ? tv[0][11] : tv[0][1], bj = half ? tv[1][0] : tv[1][4];
          cand[20] = pk_idx(ai + bj, (unsigned)(63 - 20) - hc, 63u); cid[20] = (int)((127u - (__float_as_uint(ai) & 127u)) * 128u + (127u - (__float_as_uint(bj) & 127u))); }
        { const float ai = half ? tv[0][12] : tv[0][1], bj = half ? tv[1][0] : tv[1][5];
          cand[21] = pk_idx(ai + bj, (unsigned)(63 - 21) - hc, 63u); cid[21] = (int)((127u - (__float_as_uint(ai) & 127u)) * 128u + (127u - (__float_as_uint(bj) & 127u))); }
        { const float ai = half ? tv[0][13] : tv[0][1], bj = half ? tv[1][0] : tv[1][6];
          cand[22] = pk_idx(ai + bj, (unsigned)(63 - 22) - hc, 63u); cid[22] = (int)((127u - (__float_as_uint(ai) & 127u)) * 128u + (127u - (__float_as_uint(bj) & 127u))); }
        { const float ai = half ? tv[0][14] : tv[0][1], bj = half ? tv[1][0] : tv[1][7];
          cand[23] = pk_idx(ai + bj, (unsigned)(63 - 23) - hc, 63u); cid[23] = (int)((127u - (__float_as_uint(ai) & 127u)) * 128u + (127u - (__float_as_uint(bj) & 127u))); }
        { const float ai = half ? tv[0][15] : tv[0][2], bj = half ? tv[1][0] : tv[1][0];
          cand[24] = pk_idx(ai + bj, (unsigned)(63 - 24) - hc, 63u); cid[24] = (int)((127u - (__float_as_uint(ai) & 127u)) * 128u + (127u - (__float_as_uint(bj) & 127u))); }
        float sv[16]; int sid[16];
#pragma unroll
        for (int k = 0; k < 16; ++k) {
            float m = cand[0];
#pragma unroll
            for (int c = 1; c < 25; ++c) m = fmaxf(m, cand[c]);
            const float mo = __shfl_xor(m, 32);
            const bool mine = (m > mo) || (m == mo && half == 0);
            const float mm = fmaxf(m, mo);
            int id = -1;
#pragma unroll
            for (int c = 0; c < 25; ++c) { const bool hit = mine && (cand[c] == mm); id = hit ? cid[c] : id; cand[c] = hit ? NEG : cand[c]; }
            const int ido = __shfl_xor(id, 32);
            sv[k] = mm; sid[k] = id > ido ? id : ido;
        }
        float den = 0.f; float ev[16];
#pragma unroll
        for (int k = 0; k < 16; ++k) { ev[k] = expf(sv[k] - sv[0]); den += ev[k]; }
        const float inv = 1.0f / den;
        if (half == 0) { int* ep = EIDX + (size_t)t * 128 + h * 16;
#pragma unroll
            for (int k = 0; k < 16; k += 4) *(u32x4*)(ep + k) = (u32x4){(unsigned)sid[k], (unsigned)sid[k + 1], (unsigned)sid[k + 2], (unsigned)sid[k + 3]}; }
        else { float* gp = EG + (size_t)t * 128 + h * 16;
#pragma unroll
            for (int k = 0; k < 16; k += 4) *(f32x4*)(gp + k) = (f32x4){ev[k] * inv, ev[k + 1] * inv, ev[k + 2] * inv, ev[k + 3] * inv}; }
    }
}

typedef float f32x2 __attribute__((ext_vector_type(2)));
constexpr float PU_SCALE = 1024.0f, PV_SCALE = 32.0f;
#define RL(v, l) __builtin_amdgcn_readlane((v), (l))
#define EXR 4
#define EX_LOAD(buf, tab, idv, e) do { _Pragma("unroll") for (int r_ = 0; r_ < EXR; ++r_) { const unsigned char* rp_ = (tab) + (size_t)RL(idv, ((e) & 63) + r_) * 2048 + 16 * lane; \
        buf[r_][0] = *(const u32x4*)rp_; buf[r_][1] = *(const u32x4*)(rp_ + 1024); } } while (0)
#define EX_W4(acc_, w_, xp_) do { const f32x2 l_ = __builtin_amdgcn_cvt_pk_f32_fp8((int)(w_), false), h_ = __builtin_amdgcn_cvt_pk_f32_fp8((int)(w_), true); \
        acc_ += l_.x * (xp_)[0] + l_.y * (xp_)[1]; acc_ += h_.x * (xp_)[2] + h_.y * (xp_)[3]; } while (0)
#define EX_DOT(buf, e) do { float d_[EXR]; _Pragma("unroll") for (int r_ = 0; r_ < EXR; ++r_) { float a_ = 0.f, b_ = 0.f; \
        _Pragma("unroll") for (int c_ = 0; c_ < 2; ++c_) { EX_W4(a_, buf[r_][c_].x, &xf[c_][0]); EX_W4(b_, buf[r_][c_].y, &xf[c_][4]); EX_W4(a_, buf[r_][c_].z, &xf[c_][8]); EX_W4(b_, buf[r_][c_].w, &xf[c_][12]); } d_[r_] = a_ + b_; } \
        _Pragma("unroll") for (int o_ = 32; o_ >= 1; o_ >>= 1) { _Pragma("unroll") for (int r_ = 0; r_ < EXR; ++r_) d_[r_] += __shfl_xor(d_[r_], o_); } \
        _Pragma("unroll") for (int r_ = 0; r_ < EXR; ++r_) { const float pre_ = d_[r_] * (1.0f / PU_SCALE); const float hv_ = 0.5f * pre_ * (1.0f + erff(pre_ * 0.7071067811865476f)); \
            if (lane == (((e) & 63) + r_)) { if ((e) < 64) c0 = g0 * hv_; else c1 = g1 * hv_; } } } while (0)
#define EX_A4(w_, yp_, cf_) do { const f32x2 l_ = __builtin_amdgcn_cvt_pk_f32_fp8((int)(w_), false), h_ = __builtin_amdgcn_cvt_pk_f32_fp8((int)(w_), true); \
        (yp_)[0] += (cf_) * l_.x; (yp_)[1] += (cf_) * l_.y; (yp_)[2] += (cf_) * h_.x; (yp_)[3] += (cf_) * h_.y; } while (0)
#define EX_AXPY(buf, e) do { const float cv_ = (e) < 64 ? c0 : c1; _Pragma("unroll") for (int r_ = 0; r_ < EXR; ++r_) { const float cf_ = __int_as_float(RL(__float_as_int(cv_), ((e) & 63) + r_)) * (1.0f / PV_SCALE); \
        _Pragma("unroll") for (int c_ = 0; c_ < 2; ++c_) { EX_A4(buf[r_][c_].x, &y[c_][0], cf_); EX_A4(buf[r_][c_].y, &y[c_][4], cf_); EX_A4(buf[r_][c_].z, &y[c_][8], cf_); EX_A4(buf[r_][c_].w, &y[c_][12], cf_); } } } while (0)
__device__ __forceinline__ void cvt_fp8_stream(const Frame& F, const float* src, unsigned char* dst, size_t n16, float scale) {
    const size_t gt = (size_t)F.bid * 512 + F.wave * 64 + F.lane(), NT = (size_t)F.G * 512;
#pragma unroll 2
    for (size_t i = gt; i < n16; i += NT) { const f32x4 a = ((const f32x4*)src)[4 * i] * scale, b = ((const f32x4*)src)[4 * i + 1] * scale, c = ((const f32x4*)src)[4 * i + 2] * scale, d = ((const f32x4*)src)[4 * i + 3] * scale;
        int w0 = 0, w1 = 0, w2 = 0, w3 = 0;
        w0 = __builtin_amdgcn_cvt_pk_fp8_f32(a.x, a.y, w0, false); w0 = __builtin_amdgcn_cvt_pk_fp8_f32(a.z, a.w, w0, true);
        w1 = __builtin_amdgcn_cvt_pk_fp8_f32(b.x, b.y, w1, false); w1 = __builtin_amdgcn_cvt_pk_fp8_f32(b.z, b.w, w1, true);
        w2 = __builtin_amdgcn_cvt_pk_fp8_f32(c.x, c.y, w2, false); w2 = __builtin_amdgcn_cvt_pk_fp8_f32(c.z, c.w, w2, true);
        w3 = __builtin_amdgcn_cvt_pk_fp8_f32(d.x, d.y, w3, false); w3 = __builtin_amdgcn_cvt_pk_fp8_f32(d.z, d.w, w3, true);
        ((u32x4*)dst)[i] = (u32x4){(unsigned)w0, (unsigned)w1, (unsigned)w2, (unsigned)w3}; }
}
__device__ __forceinline__ void ph16_experts(const Frame& F) {
    const Args& a = *F.a;
    const int gw = F.bid * 8 + F.wave, NGW = F.G * 8, lane = F.lane();
    const int* EIDX = (const int*)(F.ws + WS_CKV); const float* EG = (const float*)(F.ws + WS_IKW);
    const unsigned char* PU = (const unsigned char*)F.slot(5); const unsigned char* PV = PU + (size_t)32 * MiB;
    for (int t = gw; t < T; t += NGW) {
        float* xrow = a.out + (size_t)t * 2048;
        float xf[2][16];
        { float mu, rs; row_mu_rstd((const float*)(F.ws + WS_CTL + CTL_ST2), t, mu, rs);
          const bf16* zr = F.slot(0) + (size_t)t * 2048;
#pragma unroll
          for (int c = 0; c < 2; ++c)
#pragma unroll
              for (int q = 0; q < 2; ++q) { const int col = 1024 * c + 16 * lane + 8 * q; f32x4 z0, z1; unpack8v(*(const u32x4*)(zr + col), z0, z1);
                  const f32x4 g0 = *(const f32x4*)(a.in[20] + col), g1 = *(const f32x4*)(a.in[20] + col + 4), b0 = *(const f32x4*)(a.in[21] + col), b1 = *(const f32x4*)(a.in[21] + col + 4);
                  const f32x4 h0 = (z0 - mu) * rs * g0 + b0, h1 = (z1 - mu) * rs * g1 + b1;
                  xf[c][8 * q] = h0.x; xf[c][8 * q + 1] = h0.y; xf[c][8 * q + 2] = h0.z; xf[c][8 * q + 3] = h0.w; xf[c][8 * q + 4] = h1.x; xf[c][8 * q + 5] = h1.y; xf[c][8 * q + 6] = h1.z; xf[c][8 * q + 7] = h1.w; } }
        const int id0 = EIDX[(size_t)t * 128 + lane], id1 = EIDX[(size_t)t * 128 + 64 + lane];
        const float g0 = EG[(size_t)t * 128 + lane], g1 = EG[(size_t)t * 128 + 64 + lane];
        float c0 = 0.f, c1 = 0.f;
        u32x4 bA[EXR][2], bB[EXR][2];
        EX_LOAD(bA, PU, id0, 0);
        for (int e = 0; e < 128; e += 2 * EXR) {
            const int idv = e < 64 ? id0 : id1;
            EX_LOAD(bB, PU, idv, e + EXR);
            EX_DOT(bA, e);
            if (e + 2 * EXR < 128) { const int idn = (e + 2 * EXR) < 64 ? id0 : id1; EX_LOAD(bA, PU, idn, e + 2 * EXR); }
            EX_DOT(bB, e + EXR);
        }
        float y[2][16];
#pragma unroll
        for (int c = 0; c < 2; ++c)
#pragma unroll
            for (int j = 0; j < 16; ++j) y[c][j] = 0.f;
        EX_LOAD(bA, PV, id0, 0);
        for (int e = 0; e < 128; e += 2 * EXR) {
            const int idv = e < 64 ? id0 : id1;
            EX_LOAD(bB, PV, idv, e + EXR);
            EX_AXPY(bA, e);
            if (e + 2 * EXR < 128) { const int idn = (e + 2 * EXR) < 64 ? id0 : id1; EX_LOAD(bA, PV, idn, e + 2 * EXR); }
            EX_AXPY(bB, e + EXR);
        }
        float s = 0.f;
#pragma unroll
        for (int c = 0; c < 2; ++c)
#pragma unroll
            for (int j = 0; j < 16; ++j) { y[c][j] += ALPHA * xf[c][j]; s += y[c][j]; }
        const float mu = wave_sum(s) * (1.0f / 2048.0f); float s2 = 0.f;
#pragma unroll
        for (int c = 0; c < 2; ++c)
#pragma unroll
            for (int j = 0; j < 16; ++j) { y[c][j] -= mu; s2 += y[c][j] * y[c][j]; }
        const float rs = rsqrtf(wave_sum(s2) * (1.0f / 2048.0f) + 1e-5f);
        int lofs = 16 * lane; asm volatile("" : "+v"(lofs));
#pragma unroll
        for (int c = 0; c < 2; ++c)
#pragma unroll
            for (int q = 0; q < 4; ++q) { const int col = 1024 * c + lofs + 4 * q;
                const f32x4 ga = *(const f32x4*)(a.in[26] + col), ba = *(const f32x4*)(a.in[27] + col);
                f32x4 o; o.x = y[c][4 * q] * rs * ga.x + ba.x; o.y = y[c][4 * q + 1] * rs * ga.y + ba.y; o.z = y[c][4 * q + 2] * rs * ga.z + ba.z; o.w = y[c][4 * q + 3] * rs * ga.w + ba.w;
                *(f32x4*)(xrow + col) = o; }
    }
}

#define XB_TMO      128
#define XB_XCNT(j)  (256  + 64 * (j))
#define XB_XSUB(j)  (1280 + 64 * (j))
#define XB_XGEN(j)  (2304 + 64 * (j))
#define XB_TOP      3328
#define XB_TOPGEN   3392
#define XCD_BAR_WORDS 3456
#define XB_SPIN_CAP (1u << 22)
__device__ __forceinline__ unsigned xb_ld(unsigned* p)              { return __hip_atomic_load(p, __ATOMIC_RELAXED, __HIP_MEMORY_SCOPE_AGENT); }
__device__ __forceinline__ unsigned xb_add(unsigned* p, unsigned v) { return __hip_atomic_fetch_add(p, v, __ATOMIC_RELAXED, __HIP_MEMORY_SCOPE_AGENT); }
__device__ __forceinline__ unsigned xb_xcc_id() { return (unsigned)__builtin_amdgcn_s_getreg((3 << 11) | 20) & 0xFu; }
#define XB_SPIN(cond, bar) do { unsigned _sp = 0; while (cond) { __builtin_amdgcn_s_sleep(1); \
    if ((++_sp & 255u) == 0u) { if (xb_ld(&(bar)[XB_TMO])) break; if (_sp > XB_SPIN_CAP) { atomicAdd(&(bar)[XB_TMO], 1u); break; } } } } while (0)
struct XcdBarrier { unsigned* bar; unsigned x; volatile unsigned* st; };
__device__ __forceinline__ void xcd_barrier_complete(unsigned* bar, unsigned x, unsigned G, unsigned& nloc, unsigned& nx) {
    unsigned sum, cnt, mine, sp = 0u;
    for (;;) {
        sum = 0u; cnt = 0u; mine = 0u;
#pragma unroll
        for (unsigned j = 0; j < 16; ++j) { const unsigned c = xb_ld(&bar[XB_XCNT(j)]); sum += c; cnt += (c > 0u) ? 1u : 0u; mine = (j == x) ? c : mine; }
        if (sum == G) break;
        __builtin_amdgcn_s_sleep(1);
        if ((++sp & 255u) == 0u) { if (xb_ld(&bar[XB_TMO])) break; if (sp > XB_SPIN_CAP) { atomicAdd(&bar[XB_TMO], 1u); break; } }
    }
    nloc = mine > 0u ? mine : 1u; nx = cnt > 0u ? cnt : 1u;
}
__device__ __forceinline__ void xcd_barrier(const XcdBarrier& b, bool leader, unsigned G) {
    asm volatile("s_waitcnt vmcnt(0)" ::: "memory");
    __syncthreads();
    if (leader) {
        unsigned* bar = b.bar;
        __builtin_amdgcn_s_waitcnt(0);
        unsigned nloc = b.st[0], nx = b.st[1];
        if (nloc == 0u) { xcd_barrier_complete(bar, b.x, G, nloc, nx); b.st[0] = nloc; b.st[1] = nx; }
        const unsigned old = xb_add(&bar[XB_XSUB(b.x)], 1u);
        const unsigned gen = old / nloc;
        if (old + 1u == (gen + 1u) * nloc) {
            __builtin_amdgcn_fence(__ATOMIC_RELEASE, "agent");
            asm volatile("s_waitcnt vmcnt(0)" ::: "memory");
            const unsigned og = xb_add(&bar[XB_TOP], 1u);
            const unsigned tg = og / nx;
            if (og + 1u == (tg + 1u) * nx) xb_add(&bar[XB_TOPGEN], 1u);
            else XB_SPIN(xb_ld(&bar[XB_TOPGEN]) == tg, bar);
            __builtin_amdgcn_fence(__ATOMIC_ACQUIRE, "agent");
            xb_add(&bar[XB_XGEN(b.x)], 1u);
            asm volatile("s_waitcnt vmcnt(0)" ::: "memory");
        } else {
            XB_SPIN(xb_ld(&bar[XB_XGEN(b.x)]) == gen, bar);
            __builtin_amdgcn_fence(__ATOMIC_ACQUIRE, "agent");
            asm volatile("s_waitcnt vmcnt(0)" ::: "memory");
        }
    }
    __syncthreads();
}

__device__ __forceinline__ void sub_barrier(unsigned* ctr, unsigned n, bool leader) {
    asm volatile("s_waitcnt vmcnt(0)" ::: "memory");
    __syncthreads();
    if (leader) {
        __builtin_amdgcn_fence(__ATOMIC_RELEASE, "agent");
        asm volatile("s_waitcnt vmcnt(0)" ::: "memory");
        (void)xb_add(ctr, 1u);
        unsigned sp = 0u; while (xb_ld(ctr) < n) { __builtin_amdgcn_s_sleep(1); if (++sp > XB_SPIN_CAP) break; }
        __builtin_amdgcn_fence(__ATOMIC_ACQUIRE, "agent");
        asm volatile("s_waitcnt vmcnt(0)" ::: "memory");
    }
    __syncthreads();
}

__global__ void __launch_bounds__(512, 2) mega(Args args) {
    extern __shared__ __attribute__((aligned(16))) unsigned char lds[];
    cg::grid_group grid = cg::this_grid();
    Frame F;
    F.lds = lds; F.wave = __builtin_amdgcn_readfirstlane(threadIdx.x >> 6); F.bid = blockIdx.x; F.G = gridDim.x;
    F.a = &args; F.ws = args.ws;
    const int lo = args.ph_lo, hi = args.ph_hi;
    unsigned long long sec_acc = 0ull;
    if (lo < 0) grid.sync();
    volatile unsigned* xst = (volatile unsigned*)(lds + LDS_BYTES - 64);
    const bool leader = (F.wave == 0) && (fresh_lane() == 0);
    if (leader) { xst[0] = 0u; xst[1] = 0u; }
    XcdBarrier xbar; xbar.bar = (unsigned*)(F.ws + WS_CTL + CTL_BAR); xbar.x = xb_xcc_id(); xbar.st = xst;
    if (leader) (void)xb_add(&xbar.bar[XB_XCNT(xbar.x)], 1u);
    __syncthreads();
    bf16* W8 = (bf16*)((unsigned char*)args.out + (size_t)64 * MiB);
#define IN(k) (lo <= (k) && (k) < hi)
#if PROBE_MASK
    unsigned long long pr_acc = 0ull, pr_t0 = rt_now();
#define SEAM(k) do { if (IN(k) && IN((k) + 1)) { xcd_barrier(xbar, (F.wave == 0) && (fresh_lane() == 0), (unsigned)F.G); } { const unsigned long long t1_ = rt_now(); if ((PROBE_MASK >> (k)) & 1u) pr_acc += t1_ - pr_t0; pr_t0 = t1_; } } while (0)
#else
#define SEAM(k) do { if (IN(k) && IN((k) + 1)) { xcd_barrier(xbar, (F.wave == 0) && (fresh_lane() == 0), (unsigned)F.G); } } while (0)
#endif
    if (IN(0)) { ph0_prologue(F); } SEAM(0);
    if (IN(1)) { gemm(F, (const bf16*)args.out, 2048, (const bf16*)(F.ws + WS_WIN), 2048, T, NCOLS, 2048, OpProj{F.ws}); w8_transposes(F, W8); } SEAM(1);
    if (IN(2)) {
        if (F.G == 256) {
            if (F.bid < 128) hgrn_chunked(F, F.bid, sec_acc);
            else { ph2_side(F, F.bid - 128, 128); sub_barrier((unsigned*)(F.ws + WS_CTL + CTL_BAR) + 3520, 128u, (F.wave == 0) && (fresh_lane() == 0)); ph5_select(F, F.bid - 128, 128); }
        } else {
            for (int u = F.bid; u < 128; u += F.G) hgrn_chunked(F, u, sec_acc);
            ph2_side(F, F.bid, F.G);
            xcd_barrier(xbar, (F.wave == 0) && (fresh_lane() == 0), (unsigned)F.G);
            ph5_select(F, F.bid, F.G);
        }
    } SEAM(2);
    if (IN(4)) {
        gemm(F, F.slot(0), 2048, W8, 2048, T, 2048, 2048, OpYA{F.slot(6)});
        gemm(F, (const bf16*)(F.ws + WS_CKV), 256, (const bf16*)(F.ws + WS_WKV), 256, T, 4096, 256, OpSplit2{F.slot(1), F.slot(2)});
    } SEAM(4);
    if (IN(6)) { ph6_attn(F); } SEAM(6);
    if (IN(7)) { gemm(F, F.slot(3), 2048, W8 + (size_t)1 * 2048 * 2048, 2048, T, 2048, 2048, OpYB{F.slot(6), F.slot(7)}); } SEAM(7);
    if (IN(8)) { gemm_epi(F, F.slot(6), 2048, W8 + (size_t)2 * 2048 * 2048, 2048, T, 2048, 2048, EpiMixStats{args.in[0], F.slot(0), (float*)(F.ws + WS_CTL + CTL_ST1)}); } SEAM(8);
    if (IN(10)) {
        pg8::MultiOrder<3> S; S.lda = 2048; S.ldb = 2048; S.G = F.G; S.c = F.bid;
        S.s[0] = pg8::Sub{F.slot(0), W8 + (size_t)3 * 2048 * 2048, 64, 8};
        S.s[1] = pg8::Sub{(const bf16*)(F.ws + WS_MEMB), W8 + (size_t)4 * 2048 * 2048, 8, 8};
        S.s[2] = pg8::Sub{W8 + (size_t)5 * 2048 * 2048, (const bf16*)(F.ws + WS_MEMB), 8, 8};
        gemm_multi<3>(F, S, 2048, OpCQKV{F.slot(1), (bf16*)(F.ws + WS_CKV), (bf16*)(F.ws + WS_IKW), (float*)(F.ws + WS_CTL + CTL_ST1), (float*)(F.ws + WS_CTL + CTL_CVEC), (float*)(F.ws + WS_CTL + CTL_CVEC) + 2048});
    } SEAM(10);
    if (IN(11)) {
        pg8::BatchOrder<OffS> S{F.slot(1), (const bf16*)(F.ws + WS_CKV), 8, 1, 32, 2048, 2048, F.G, F.bid, OffS()};
        gemm_batch(F, S, 512, OpLogit{(float*)F.slot(2)});
    } SEAM(11);
    if (IN(12)) { ph_xsoftmax(F, (const float*)F.slot(2), F.slot(3));
        cvt_fp8_stream(F, args.in[24], (unsigned char*)F.slot(5), (size_t)16384 * 2048 / 16, PU_SCALE); cvt_fp8_stream(F, args.in[25], (unsigned char*)F.slot(5) + (size_t)32 * MiB, (size_t)16384 * 2048 / 16, PV_SCALE); } SEAM(12);
    if (IN(13)) {
        pg8::BatchOrder<OffPV> S{F.slot(3), (const bf16*)(F.ws + WS_IKW), 8, 2, 32, 1024, 2048, F.G, F.bid, OffPV()};
        gemm_batch(F, S, 256, OpCO{F.slot(4)});
    } SEAM(13);
    if (IN(14)) { gemm_epi(F, F.slot(4), 2048, W8 + (size_t)6 * 2048 * 2048, 2048, T, 2048, 2048, EpiCOStats{F.slot(0), (float*)(F.ws + WS_CTL + CTL_ST1), (float*)(F.ws + WS_CTL + CTL_ST2), args.in[14], args.in[15]}); } SEAM(14);
    if (IN(16)) { gemm(F, F.slot(0), 2048, W8 + (size_t)7 * 2048 * 2048, 2048, T, 2048, 2048, OpPQFold{(float*)F.slot(1), (float*)(F.ws + WS_CTL + CTL_ST2), (float*)(F.ws + WS_CTL + CTL_CVEC) + 4096, (float*)(F.ws + WS_CTL + CTL_CVEC) + 6144}); } SEAM(16);
    if (IN(17)) { ph_peer_select(F); } SEAM(17);
    if (IN(18)) { ph16_experts(F); }
#if PROBE_MASK
    xcd_barrier(xbar, (F.wave == 0) && (fresh_lane() == 0), (unsigned)F.G);
    { const unsigned long long t1_ = rt_now(); if ((PROBE_MASK >> 18) & 1u) pr_acc += t1_ - pr_t0; pr_acc += sec_acc;
      if (F.bid == 0 && threadIdx.x == 0) { const unsigned long long ts_ = rt_now(); while (rt_now() - ts_ < pr_acc) __builtin_amdgcn_s_sleep(8); } }
#endif
#undef IN
#undef SEAM
}

extern "C" void kernel_launch(void* const* d_in, const int* in_sizes, int n_in, void* d_out, int out_size, void* d_ws, size_t ws_size, hipStream_t stream) {
    static int grid = 0;
    if (grid == 0) {
        if (n_in != 28 || out_size != T * D || ws_size < WS_END) { fprintf(stderr, "kernel_launch: unexpected shapes (n_in %d out %d ws %zu)\n", n_in, out_size, ws_size); grid = -1; return; }
        int dev = 0, cus = 0, per_cu = 0;
        hipGetDevice(&dev); hipDeviceGetAttribute(&cus, hipDeviceAttributeMultiprocessorCount, dev);
        hipFuncSetAttribute((const void*)mega, hipFuncAttributeMaxDynamicSharedMemorySize, LDS_BYTES);
        hipOccupancyMaxActiveBlocksPerMultiprocessor(&per_cu, (const void*)mega, 512, LDS_BYTES);
        if (per_cu < 1) { fprintf(stderr, "kernel_launch: occupancy query says %d blocks per CU\n", per_cu); per_cu = 1; }
        (void)hipGetLastError();
        grid = cus;
    }
    if (grid < 0) return;
    (void)hipMemsetAsync((char*)d_ws + WS_CTL, 0, CTL_ZERO, stream);
    Args a{};
    for (int i = 0; i < 28; ++i) a.in[i] = (const float*)d_in[i];
    a.out = (float*)d_out; a.ws = (unsigned char*)d_ws;
#if ONE_LAUNCH
    a.ph_lo = 0; a.ph_hi = NPH;
    void* params[] = {&a};
    hipError_t e = hipLaunchCooperativeKernel((const void*)mega, dim3(grid), dim3(512), params, LDS_BYTES, stream);
    if (e != hipSuccess) fprintf(stderr, "cooperative launch failed: %s\n", hipGetErrorString(e));
#else
    for (int ph = 0; ph < NPH; ++ph) {
        a.ph_lo = ph; a.ph_hi = ph + 1;
        void* params[] = {&a};
        hipError_t e = hipLaunchCooperativeKernel((const void*)mega, dim3(grid), dim3(512), params, LDS_BYTES, stream);
        if (e != hipSuccess) { fprintf(stderr, "launch %d failed: %s\n", ph, hipGetErrorString(e)); break; }
    }
#endif
}
```

```cpp
#include <hip/hip_runtime.h>
#include <hip/hip_cooperative_groups.h>
#include <cstdint>
#include <cmath>
#include <cstdio>
namespace cg = cooperative_groups;

#ifndef ONE_LAUNCH
#define ONE_LAUNCH 1
#endif
#ifndef PROBE_MASK
#define PROBE_MASK 0u
#endif
#ifndef PROBE_SEC
#define PROBE_SEC 0
#endif

typedef unsigned short bf16;
typedef short bf16x8 __attribute__((ext_vector_type(8)));
typedef float f32x4 __attribute__((ext_vector_type(4)));
typedef float f32x16 __attribute__((ext_vector_type(16)));
typedef unsigned u32x4 __attribute__((ext_vector_type(4)));
typedef unsigned u32x2 __attribute__((ext_vector_type(2)));
typedef float f32x2v __attribute__((ext_vector_type(2)));

constexpr int T = 16384, D = 2048, SEQ = 2048, NB = 8;
constexpr int NCOLS = 16896;
constexpr float ALPHA = 1.189207115002721f;
constexpr int NPH = 19;

constexpr size_t MiB = 1u << 20;
constexpr size_t WS_CTL = 0, WS_MEMB = 1 * MiB, WS_WKV = 9 * MiB, WS_LB = 11 * MiB, WS_MASK = 12 * MiB, WS_WIN = 17 * MiB,
                 WS_SLOT = 83 * MiB, SLOT_BYTES = 64 * MiB, WS_CKV = 595 * MiB, WS_IKW = 603 * MiB, WS_END = 611 * MiB;
constexpr int LDS_BYTES = 157696;
constexpr size_t CTL_BAR = 16384, CTL_CVEC = 65536, CTL_ST1 = 262144, CTL_ST2 = 393216, CTL_ZERO = 524288;

struct Args {
    const float* in[28];
    float* out;
    unsigned char* ws;
    int ph_lo, ph_hi;
};

#define WAVE_SYNC() asm volatile("s_waitcnt lgkmcnt(0)" ::: "memory")

__device__ __forceinline__ unsigned f2bf(float f) { unsigned u = __float_as_uint(f); return (u + 0x7fffu + ((u >> 16) & 1u)) >> 16; }
__device__ __forceinline__ unsigned pk2(float lo, float hi) { return f2bf(lo) | (f2bf(hi) << 16); }
__device__ __forceinline__ float bf2f(unsigned h) { return __uint_as_float(h << 16); }
__device__ __forceinline__ float bflo(unsigned w) { return __uint_as_float(w << 16); }
__device__ __forceinline__ float bfhi(unsigned w) { return __uint_as_float(w & 0xffff0000u); }
__device__ __forceinline__ float wave_sum(float v) {
#pragma unroll
    for (int o = 32; o >= 1; o >>= 1) v += __shfl_xor(v, o);
    return v;
}
__device__ __forceinline__ float wave_max(float v) {
#pragma unroll
    for (int o = 32; o >= 1; o >>= 1) v = fmaxf(v, __shfl_xor(v, o));
    return v;
}
__device__ __forceinline__ float sigm(float x) { return 1.0f / (1.0f + expf(-x)); }
__device__ __forceinline__ void unpack8(u32x4 w, float* f) {
    f[0] = bflo(w.x); f[1] = bfhi(w.x); f[2] = bflo(w.y); f[3] = bfhi(w.y); f[4] = bflo(w.z); f[5] = bfhi(w.z); f[6] = bflo(w.w); f[7] = bfhi(w.w);
}

__device__ __forceinline__ int fresh_lane() { int l; asm volatile("v_mbcnt_lo_u32_b32 %0, -1, 0\n\tv_mbcnt_hi_u32_b32 %0, -1, %0" : "=v"(l)); return l; }
__device__ __forceinline__ unsigned long long rt_now() { unsigned long long t; asm volatile("s_memrealtime %0\n\ts_waitcnt lgkmcnt(0)" : "=s"(t) :: "memory"); return t; }
struct Frame {
    unsigned char* lds;
    int wave, bid, G;
    __device__ __forceinline__ int lane() const { return fresh_lane(); }
    const Args* a;
    unsigned char* ws;
    __device__ __forceinline__ bf16* slot(int i) const { return (bf16*)(ws + WS_SLOT + (size_t)i * SLOT_BYTES); }
};

namespace pg8 {
#define PG8_LAS __attribute__((address_space(3)))
constexpr int BM = 256, BK = 64, HALF = 128, HTB = HALF * BK * 2, STAGE_BYTES = 8 * HTB, NXCD = 8, WGM = 8;
__host__ __device__ __forceinline__ int lds_byte(int r, int c) { const int st = (r >> 4) * 2 + (c >> 5), rr = r & 15, cc = c & 31, ob = rr * 64 + cc * 2; return st * 1024 + (ob ^ (((ob >> 9) & 1) << 5)); }
__host__ __device__ __forceinline__ void stage_rc(int b, int& R, int& C) { const int st = b / 1024, sb = b % 1024, swz = sb ^ (((sb >> 9) & 1) << 5); R = (st >> 1) * 16 + swz / 64; C = (st & 1) * 32 + (swz % 64) / 2; }
__host__ __device__ __forceinline__ int perm32(int rho) { const int n = rho >> 4, i = rho & 15; return 8 * (i >> 2) + 4 * n + (i & 3); }
struct Unit { int pm, pn, z; const char* a; const char* b; const char* a2; };
struct Gemm { int lda, ldb, K; };
__device__ __forceinline__ void tile_of(int wgid, int nM, int nN, int& pm, int& pn) {
    const int nwg = nM * nN; { const int q = nwg / NXCD, r = nwg % NXCD, xcd = wgid % NXCD, off = wgid / NXCD; wgid = (xcd < r ? xcd * (q + 1) : r * (q + 1) + (xcd - r) * q) + off; }
    const int nig = WGM * nN, gid = wgid / nig, fm = gid * WGM, gsz = (nM - fm) < WGM ? (nM - fm) : WGM;
    pm = fm + ((wgid % nig) % gsz); pn = (wgid % nig) / gsz;
}
struct Sub { const bf16* A; const bf16* Bt; int nM, nN; };
template <int NS> struct MultiOrder {
    Sub s[NS]; int lda, ldb, G, c; const bf16* A2 = nullptr;
    __device__ __forceinline__ bool next(int i, Unit& u) const {
        int L = i * G + c;
#pragma unroll
        for (int k = 0; k < NS; ++k) { const int n = s[k].nM * s[k].nN;
            if (L < n) { tile_of(L, s[k].nM, s[k].nN, u.pm, u.pn); u.z = k; u.a = (const char*)(s[k].A + (size_t)u.pm * BM * lda); u.b = (const char*)(s[k].Bt + (size_t)u.pn * BM * ldb); u.a2 = A2 ? (const char*)(A2 + (size_t)u.pm * BM * lda) : nullptr; return true; }
            L -= n; }
        return false;
    }
};
template <class Off> struct BatchOrder {
    const bf16* A; const bf16* Bt; int nM, nN, nz, lda, ldb, G, c; Off off;
    __device__ __forceinline__ bool next(int i, Unit& u) const {
        const int L = i * G + c, per = nM * nN; if (L >= per * nz) return false;
        u.z = L / per; const int r = L % per; u.pn = r / nM; u.pm = r % nM;
        u.a = (const char*)(A + off.a(u.z) + (size_t)u.pm * BM * lda); u.b = (const char*)(Bt + off.b(u.z) + (size_t)u.pn * BM * ldb); u.a2 = nullptr; return true;
    }
};
__device__ __forceinline__ unsigned cvt_pk_bf16(float lo, float hi) { unsigned r; asm volatile("v_cvt_pk_bf16_f32 %0, %1, %2" : "=v"(r) : "v"(lo), "v"(hi)); return r; }

template <class Op> struct Epi8 {
    static constexpr bool PERM = true;
    Op op;
    __device__ __forceinline__ void operator()(const f32x4 (&acc)[2][2][4][2], const Unit& u, int wr, int wc, int fr, int fq) const {
        const int row0 = u.pm * BM + wr * 64 + fr, col0 = u.pn * BM + wc * 32 + 8 * fq;
        if constexpr (Op::NLD == 0) {
#pragma unroll
            for (int ai = 0; ai < 2; ++ai)
#pragma unroll
                for (int m = 0; m < 4; ++m)
#pragma unroll
                    for (int bj = 0; bj < 2; ++bj) op(u.z, row0 + ai * HALF + m * 16, col0 + bj * HALF, acc[ai][bj][m][0], acc[ai][bj][m][1]);
        } else {
#pragma unroll
            for (int ai = 0; ai < 2; ++ai) {
                u32x4 tmp[4][2][Op::NLD];
#pragma unroll
                for (int m = 0; m < 4; ++m)
#pragma unroll
                    for (int bj = 0; bj < 2; ++bj) op.ld(u.z, row0 + ai * HALF + m * 16, col0 + bj * HALF, tmp[m][bj]);
#pragma unroll
                for (int m = 0; m < 4; ++m)
#pragma unroll
                    for (int bj = 0; bj < 2; ++bj) op.ap(u.z, row0 + ai * HALF + m * 16, col0 + bj * HALF, acc[ai][bj][m][0], acc[ai][bj][m][1], tmp[m][bj]);
            }
        }
    }
};

template <class Epi, class Sched, bool ALIGN_EPI, bool SPLIT = false>
__device__ __forceinline__ void gemm_phase(PG8_LAS unsigned char* lds, const Gemm g, const Sched& S, const Epi& E, int wid, int lane) {
    const int tid = wid * 64 + lane, wr = wid >> 2, wc = wid & 3, fr = lane & 15, fq = lane >> 4;
    const int K = g.K, nt = K / BK;
    unsigned voffA[2], voffB[2];
#pragma unroll
    for (int i = 0; i < 2; ++i) { int R, C; stage_rc(tid * 16 + i * 8192, R, C); const int Rb = Epi::PERM ? ((R & ~31) + perm32(R & 31)) : R;
        voffA[i] = (unsigned)(R * g.lda + C) * 2u; voffB[i] = (unsigned)(Rb * g.ldb + C) * 2u; }
    const size_t kstep = (size_t)(BK * 2);
    const size_t hstepA = (size_t)HALF * g.lda * 2, hstepB = (size_t)HALF * g.ldb * 2;
    const unsigned ldsw = (unsigned)wid * 1024u;
    const int aoff = lds_byte(wr * 64 + fr, fq * 8), boff = lds_byte(wc * 32 + fr, fq * 8);
#define PG8_SA(b, h) (((b) * 2 + (h)) * HTB)
#define PG8_SB(b, h) ((4 + (b) * 2 + (h)) * HTB)
#define PG8_STAGE(bufoff, gbase, voff) do { _Pragma("unroll") for (int _i = 0; _i < 2; ++_i) \
        __builtin_amdgcn_global_load_lds((const unsigned*)((const char*)(gbase) + (voff)[_i]), (PG8_LAS unsigned*)(lds + (bufoff) + ldsw + _i * 8192), 16, 0, 0); } while (0)
#define PG8_LDA(dst, b, h) do { _Pragma("unroll") for (int m = 0; m < 4; ++m) _Pragma("unroll") for (int k = 0; k < 2; ++k) dst[m][k] = *(const PG8_LAS bf16x8*)(lds + PG8_SA(b, h) + aoff + m * 2048 + k * 1024); } while (0)
#define PG8_LDB(dst, b, h) do { _Pragma("unroll") for (int n = 0; n < 2; ++n) _Pragma("unroll") for (int k = 0; k < 2; ++k) dst[n][k] = *(const PG8_LAS bf16x8*)(lds + PG8_SB(b, h) + boff + n * 2048 + k * 1024); } while (0)
#define PG8_MMA(ai, bj, At, Bt) do { __builtin_amdgcn_s_setprio(1); _Pragma("unroll") for (int m = 0; m < 4; ++m) _Pragma("unroll") for (int n = 0; n < 2; ++n) _Pragma("unroll") for (int k = 0; k < 2; ++k) \
        acc[ai][bj][m][n] = __builtin_amdgcn_mfma_f32_16x16x32_bf16(Bt[n][k], At[m][k], acc[ai][bj][m][n], 0, 0, 0); __builtin_amdgcn_s_setprio(0); } while (0)
#define PG8_WAIT_V(n) asm volatile("s_waitcnt vmcnt(" #n ")" ::: "memory")
#define PG8_WAIT_L(n) asm volatile("s_waitcnt lgkmcnt(" #n ")" ::: "memory")
#define PG8_BAR __builtin_amdgcn_s_barrier()
#define PG8_SCHED __builtin_amdgcn_sched_barrier(0)
    Unit cur, nxt; int ui = 0;
    if (!S.next(0, cur)) return;
    f32x4 acc[2][2][4][2];
#pragma unroll
    for (int a = 0; a < 2; ++a)
#pragma unroll
        for (int b = 0; b < 2; ++b)
#pragma unroll
            for (int m = 0; m < 4; ++m)
#pragma unroll
                for (int n = 0; n < 2; ++n) acc[a][b][m][n] = (f32x4){0.f, 0.f, 0.f, 0.f};
    bf16x8 At[4][2], B0[2][2], B1[2][2];
    const char* cA = cur.a; const char* cB = cur.b;
    const int nth = nt / 2;
    const char* cA2 = SPLIT ? cur.a2 - (size_t)nth * kstep : cA;
    PG8_STAGE(PG8_SB(0, 0), cB, voffB); PG8_STAGE(PG8_SB(0, 1), cB + hstepB, voffB); PG8_STAGE(PG8_SA(0, 0), cA, voffA); PG8_STAGE(PG8_SA(0, 1), cA + hstepA, voffA);
    if (wr == 1) PG8_BAR;
    PG8_WAIT_V(2); PG8_BAR;
    PG8_STAGE(PG8_SB(1, 0), cB + kstep, voffB); PG8_STAGE(PG8_SA(1, 0), cA + kstep, voffA); PG8_STAGE(PG8_SB(1, 1), cB + hstepB + kstep, voffB);
    PG8_WAIT_V(6); PG8_BAR;
    for (;;) {
        const bool has_next = S.next(ui + 1, nxt);
        const char* nA = has_next ? nxt.a : cA; const char* nB = has_next ? nxt.b : cB;
        const char* nA2 = SPLIT ? (has_next ? nxt.a2 - (size_t)nth * kstep : cA2) : nA;
#pragma unroll 1
        for (int half_ = 0; half_ < (SPLIT ? 2 : 1); ++half_) {
        if constexpr (SPLIT) { if (half_ == 1) { __builtin_amdgcn_sched_barrier(0); E.mid(acc, cur, wr, wc, fr, fq); __builtin_amdgcn_sched_barrier(0); } }
        const int t_lo = SPLIT ? half_ * nth : 0, t_hi = SPLIT ? (half_ + 1) * nth : nt;
#pragma unroll 1
        for (int t = t_lo; t < t_hi; t += 2) {
            const bool last = (t == nt - 2);
            const char* bA1 = (!SPLIT || t < nth) ? cA : cA2; const char* bA2 = (!SPLIT || t + 2 < nth) ? cA : cA2;
            const char* a1 = bA1 + (size_t)(t + 1) * kstep;
            const char* a2 = last ? nA : bA2 + (size_t)(t + 2) * kstep; const char* b2 = last ? nB : cB + (size_t)(t + 2) * kstep;
            const char* a3 = a2 + kstep; const char* b3 = b2 + kstep;
            PG8_LDB(B0, 0, 0); PG8_LDB(B1, 0, 1); PG8_SCHED; PG8_LDA(At, 0, 0); PG8_STAGE(PG8_SA(1, 1), a1 + hstepA, voffA);
            PG8_WAIT_V(8); PG8_WAIT_L(0); PG8_BAR; PG8_MMA(0, 0, At, B0); PG8_MMA(0, 1, At, B1); PG8_BAR; PG8_SCHED;
            PG8_LDA(At, 0, 1); PG8_STAGE(PG8_SB(0, 0), b2, voffB); PG8_STAGE(PG8_SB(0, 1), b2 + hstepB, voffB); PG8_STAGE(PG8_SA(0, 0), a2, voffA);
            PG8_WAIT_V(8); PG8_WAIT_L(0); PG8_BAR; PG8_MMA(1, 0, At, B0); PG8_MMA(1, 1, At, B1); PG8_BAR; PG8_SCHED;
            PG8_LDB(B0, 1, 0); PG8_LDB(B1, 1, 1); PG8_SCHED; PG8_LDA(At, 1, 0); PG8_STAGE(PG8_SA(0, 1), a2 + hstepA, voffA);
            PG8_WAIT_V(8); PG8_WAIT_L(0); PG8_BAR; PG8_MMA(0, 0, At, B0); PG8_MMA(0, 1, At, B1); PG8_BAR; PG8_SCHED;
            PG8_LDA(At, 1, 1); PG8_STAGE(PG8_SB(1, 0), b3, voffB); PG8_STAGE(PG8_SB(1, 1), b3 + hstepB, voffB); PG8_STAGE(PG8_SA(1, 0), a3, voffA);
            PG8_WAIT_V(8); PG8_WAIT_L(0); PG8_BAR; PG8_MMA(1, 0, At, B0); PG8_MMA(1, 1, At, B1); PG8_BAR; PG8_SCHED;
        }
        }
        if constexpr (ALIGN_EPI) { if (wr == 0) PG8_BAR; }
        E(acc, cur, wr, wc, fr, fq);
        if (!has_next) break;
#pragma unroll
        for (int a = 0; a < 2; ++a)
#pragma unroll
            for (int b = 0; b < 2; ++b)
#pragma unroll
                for (int m = 0; m < 4; ++m)
#pragma unroll
                    for (int n = 0; n < 2; ++n) acc[a][b][m][n] = (f32x4){0.f, 0.f, 0.f, 0.f};
        cur = nxt; cA = nA; cB = nB; cA2 = nA2; ++ui;
        if constexpr (ALIGN_EPI) { if (wr == 1) PG8_BAR; }
    }
    PG8_WAIT_V(0);
    if constexpr (!ALIGN_EPI) { if (wr == 0) PG8_BAR; }
    PG8_BAR;
#undef PG8_SA
#undef PG8_SB
#undef PG8_STAGE
#undef PG8_LDA
#undef PG8_LDB
#undef PG8_MMA
#undef PG8_WAIT_V
#undef PG8_WAIT_L
#undef PG8_BAR
#undef PG8_SCHED
}
}

__device__ __forceinline__ u32x4 pack8(f32x4 a, f32x4 b) { u32x4 w; w.x = pg8::cvt_pk_bf16(a.x, a.y); w.y = pg8::cvt_pk_bf16(a.z, a.w); w.z = pg8::cvt_pk_bf16(b.x, b.y); w.w = pg8::cvt_pk_bf16(b.z, b.w); return w; }
__device__ __forceinline__ void unpack8v(u32x4 w, f32x4& a, f32x4& b) { a.x = bflo(w.x); a.y = bfhi(w.x); a.z = bflo(w.y); a.w = bfhi(w.y); b.x = bflo(w.z); b.y = bfhi(w.z); b.z = bflo(w.w); b.w = bfhi(w.w); }
__device__ __forceinline__ f32x4 sigm4(f32x4 v) { f32x4 r; r.x = sigm(v.x); r.y = sigm(v.y); r.z = sigm(v.z); r.w = sigm(v.w); return r; }

struct OpProj { static constexpr int NLD = 0; unsigned char* ws;
    __device__ __forceinline__ void operator()(int z, int row, int col, f32x4 a, f32x4 b) const {
        bf16* p;
        if (col < 16384) p = (bf16*)(ws + WS_SLOT + (size_t)(col >> 11) * SLOT_BYTES) + (size_t)row * 2048 + (col & 2047);
        else if (col < 16640) p = (bf16*)(ws + WS_CKV) + (size_t)row * 256 + (col - 16384);
        else p = (bf16*)(ws + WS_IKW) + (size_t)row * 256 + (col - 16640);
        *(u32x4*)p = pack8(a, b);
    } };
struct OpBf16 { static constexpr int NLD = 0; bf16* o; int ld;
    __device__ __forceinline__ void operator()(int z, int row, int col, f32x4 a, f32x4 b) const { *(u32x4*)(o + (size_t)row * ld + col) = pack8(a, b); } };
struct OpSplit2 { static constexpr int NLD = 0; bf16* o0; bf16* o1;
    __device__ __forceinline__ void operator()(int z, int row, int col, f32x4 a, f32x4 b) const { bf16* p = (col < 2048 ? o0 : o1) + (size_t)row * 2048 + (col & 2047); *(u32x4*)p = pack8(a, b); } };
struct OpF32 { static constexpr int NLD = 0; float* o; int ld;
    __device__ __forceinline__ void operator()(int z, int row, int col, f32x4 a, f32x4 b) const { float* p = o + (size_t)row * ld + col; *(f32x4*)p = a; *(f32x4*)(p + 4) = b; } };
struct OpYA { static constexpr int NLD = 1; bf16* ga;
    __device__ __forceinline__ void ld(int zi, int row, int col, u32x4* t) const { t[0] = *(const u32x4*)(ga + (size_t)row * 2048 + col); }
    __device__ __forceinline__ void ap(int zi, int row, int col, f32x4 a, f32x4 b, const u32x4* t) const { f32x4 g0, g1; unpack8v(t[0], g0, g1); *(u32x4*)(ga + (size_t)row * 2048 + col) = pack8(sigm4(g0) * a, sigm4(g1) * b); } };
struct OpYB { static constexpr int NLD = 2; bf16* ga; const bf16* gb;
    __device__ __forceinline__ void ld(int zi, int row, int col, u32x4* t) const { const size_t i = (size_t)row * 2048 + col; t[0] = *(const u32x4*)(ga + i); t[1] = *(const u32x4*)(gb + i); }
    __device__ __forceinline__ void ap(int zi, int row, int col, f32x4 a, f32x4 b, const u32x4* t) const { f32x4 m0, m1, g0, g1; unpack8v(t[0], m0, m1); unpack8v(t[1], g0, g1);
        *(u32x4*)(ga + (size_t)row * 2048 + col) = pack8(m0 + sigm4(g0) * a, m1 + sigm4(g1) * b); } };
struct OpMix { static constexpr int NLD = 2; const float* x; float* zo;
    __device__ __forceinline__ void ld(int zi, int row, int col, u32x4* t) const { const size_t i = (size_t)row * 2048 + col; t[0] = *(const u32x4*)(x + i); t[1] = *(const u32x4*)(x + i + 4); }
    __device__ __forceinline__ void ap(int zi, int row, int col, f32x4 a, f32x4 b, const u32x4* t) const { const size_t i = (size_t)row * 2048 + col;
        *(f32x4*)(zo + i) = ALPHA * __builtin_bit_cast(f32x4, t[0]) + a; *(f32x4*)(zo + i + 4) = ALPHA * __builtin_bit_cast(f32x4, t[1]) + b; } };
struct OpRes { static constexpr int NLD = 2; float* zo;
    __device__ __forceinline__ void ld(int zi, int row, int col, u32x4* t) const { const size_t i = (size_t)row * 2048 + col; t[0] = *(const u32x4*)(zo + i); t[1] = *(const u32x4*)(zo + i + 4); }
    __device__ __forceinline__ void ap(int zi, int row, int col, f32x4 a, f32x4 b, const u32x4* t) const { const size_t i = (size_t)row * 2048 + col;
        *(f32x4*)(zo + i) = ALPHA * __builtin_bit_cast(f32x4, t[0]) + a; *(f32x4*)(zo + i + 4) = ALPHA * __builtin_bit_cast(f32x4, t[1]) + b; } };

__device__ __forceinline__ void row_stats_add(float* st, int row, float s1, float s2, int fq) {
    s1 += __shfl_xor(s1, 16); s1 += __shfl_xor(s1, 32); s2 += __shfl_xor(s2, 16); s2 += __shfl_xor(s2, 32);
    if (fq == 0) { atomicAdd(st + 2 * (size_t)row, s1); atomicAdd(st + 2 * (size_t)row + 1, s2); }
}
__device__ __forceinline__ void row_mu_rstd(const float* st, int row, float& mu, float& rstd) {
    const f32x2v p = *(const f32x2v*)(st + 2 * (size_t)row); mu = p.x * (1.0f / 2048.0f); rstd = rsqrtf(fmaxf(p.y * (1.0f / 2048.0f) - mu * mu, 0.f) + 1e-5f);
}
__device__ __forceinline__ float sum8(f32x4 a, f32x4 b) { return ((a.x + a.y) + (a.z + a.w)) + ((b.x + b.y) + (b.z + b.w)); }
__device__ __forceinline__ float sq8(f32x4 a, f32x4 b) { return ((a.x * a.x + a.y * a.y) + (a.z * a.z + a.w * a.w)) + ((b.x * b.x + b.y * b.y) + (b.z * b.z + b.w * b.w)); }
struct EpiMixStats { static constexpr bool PERM = true; const float* x; bf16* zb; float* st;
    __device__ __forceinline__ void operator()(const f32x4 (&acc)[2][2][4][2], const pg8::Unit& u, int wr, int wc, int fr, int fq) const {
        const int row0 = u.pm * 256 + wr * 64 + fr, col0 = u.pn * 256 + wc * 32 + 8 * fq;
#pragma unroll
        for (int ai = 0; ai < 2; ++ai) {
            f32x4 xv[4][2][2];
#pragma unroll
            for (int m = 0; m < 4; ++m)
#pragma unroll
                for (int bj = 0; bj < 2; ++bj) { const float* p = x + (size_t)(row0 + ai * 128 + m * 16) * 2048 + col0 + bj * 128; xv[m][bj][0] = *(const f32x4*)p; xv[m][bj][1] = *(const f32x4*)(p + 4); }
#pragma unroll
            for (int m = 0; m < 4; ++m) { const int row = row0 + ai * 128 + m * 16; float s1 = 0.f, s2 = 0.f;
#pragma unroll
                for (int bj = 0; bj < 2; ++bj) { const f32x4 z0 = ALPHA * xv[m][bj][0] + acc[ai][bj][m][0], z1 = ALPHA * xv[m][bj][1] + acc[ai][bj][m][1];
                    *(u32x4*)(zb + (size_t)row * 2048 + col0 + bj * 128) = pack8(z0, z1); s1 += sum8(z0, z1); s2 += sq8(z0, z1); }
                row_stats_add(st, row, s1, s2, fq); }
        }
    }
};
struct EpiCOStats { static constexpr bool PERM = true; bf16* zb; const float* st1; float* st2; const float* g; const float* bta;
    __device__ __forceinline__ void operator()(const f32x4 (&acc)[2][2][4][2], const pg8::Unit& u, int wr, int wc, int fr, int fq) const {
        const int row0 = u.pm * 256 + wr * 64 + fr, col0 = u.pn * 256 + wc * 32 + 8 * fq;
        f32x4 gv[2][2], bv[2][2];
#pragma unroll
        for (int bj = 0; bj < 2; ++bj) { gv[bj][0] = *(const f32x4*)(g + col0 + bj * 128); gv[bj][1] = *(const f32x4*)(g + col0 + bj * 128 + 4); bv[bj][0] = *(const f32x4*)(bta + col0 + bj * 128); bv[bj][1] = *(const f32x4*)(bta + col0 + bj * 128 + 4); }
#pragma unroll
        for (int ai = 0; ai < 2; ++ai) {
            u32x4 zv[4][2]; float mu[4], rs[4];
#pragma unroll
            for (int m = 0; m < 4; ++m) { const int row = row0 + ai * 128 + m * 16; row_mu_rstd(st1, row, mu[m], rs[m]);
#pragma unroll
                for (int bj = 0; bj < 2; ++bj) zv[m][bj] = *(const u32x4*)(zb + (size_t)row * 2048 + col0 + bj * 128); }
#pragma unroll
            for (int m = 0; m < 4; ++m) { const int row = row0 + ai * 128 + m * 16; float s1 = 0.f, s2 = 0.f;
#pragma unroll
                for (int bj = 0; bj < 2; ++bj) { f32x4 a0, a1; unpack8v(zv[m][bj], a0, a1);
                    const f32x4 z0 = ALPHA * ((a0 - mu[m]) * rs[m] * gv[bj][0] + bv[bj][0]) + acc[ai][bj][m][0], z1 = ALPHA * ((a1 - mu[m]) * rs[m] * gv[bj][1] + bv[bj][1]) + acc[ai][bj][m][1];
                    *(u32x4*)(zb + (size_t)row * 2048 + col0 + bj * 128) = pack8(z0, z1); s1 += sum8(z0, z1); s2 += sq8(z0, z1); }
                row_stats_add(st2, row, s1, s2, fq); }
        }
    }
};
struct EpiYAB { static constexpr bool PERM = true; bf16* ga; const bf16* gb;
    __device__ __forceinline__ void mid(f32x4 (&acc)[2][2][4][2], const pg8::Unit& u, int wr, int wc, int fr, int fq) const {
        int lofs = (wr * 64 + fr) * 2048 + wc * 32 + 8 * fq; asm volatile("" : "+v"(lofs));
        const size_t ub = ((size_t)u.pm * 256) * 2048 + u.pn * 256;
#pragma unroll
        for (int ai = 0; ai < 2; ++ai)
#pragma unroll
            for (int m = 0; m < 4; ++m) { u32x4 av[2], bv[2];
#pragma unroll
                for (int bj = 0; bj < 2; ++bj) { const size_t i = ub + (size_t)(lofs + (ai * 128 + m * 16) * 2048 + bj * 128); av[bj] = *(const u32x4*)(ga + i); bv[bj] = *(const u32x4*)(gb + i); }
#pragma unroll
                for (int bj = 0; bj < 2; ++bj) { f32x4 a0, a1, b0, b1; unpack8v(av[bj], a0, a1); unpack8v(bv[bj], b0, b1);
#pragma unroll
                    for (int e = 0; e < 4; ++e) { acc[ai][bj][m][0][e] *= (1.0f + __expf(-b0[e])) * __builtin_amdgcn_rcpf(1.0f + __expf(-a0[e])); acc[ai][bj][m][1][e] *= (1.0f + __expf(-b1[e])) * __builtin_amdgcn_rcpf(1.0f + __expf(-a1[e])); } } }
    }
    __device__ __forceinline__ void operator()(const f32x4 (&acc)[2][2][4][2], const pg8::Unit& u, int wr, int wc, int fr, int fq) const {
        int lofs = (wr * 64 + fr) * 2048 + wc * 32 + 8 * fq; asm volatile("" : "+v"(lofs));
        const size_t ub = ((size_t)u.pm * 256) * 2048 + u.pn * 256;
#pragma unroll
        for (int ai = 0; ai < 2; ++ai) { u32x4 bv[4][2];
#pragma unroll
            for (int m = 0; m < 4; ++m)
#pragma unroll
                for (int bj = 0; bj < 2; ++bj) bv[m][bj] = *(const u32x4*)(gb + ub + (size_t)(lofs + (ai * 128 + m * 16) * 2048 + bj * 128));
#pragma unroll
            for (int m = 0; m < 4; ++m)
#pragma unroll
                for (int bj = 0; bj < 2; ++bj) { f32x4 b0, b1; unpack8v(bv[m][bj], b0, b1); f32x4 s0, s1;
#pragma unroll
                    for (int e = 0; e < 4; ++e) { s0[e] = __builtin_amdgcn_rcpf(1.0f + __expf(-b0[e])); s1[e] = __builtin_amdgcn_rcpf(1.0f + __expf(-b1[e])); }
                    *(u32x4*)(ga + ub + (size_t)(lofs + (ai * 128 + m * 16) * 2048 + bj * 128)) = pack8(acc[ai][bj][m][0] * s0, acc[ai][bj][m][1] * s1); } }
    }
};
__device__ __forceinline__ void ln_fold8(const float* st, const float* c1, const float* c0, int row, int col, f32x4& a, f32x4& b) {
    float mu, rs; row_mu_rstd(st, row, mu, rs);
    const f32x4 p0 = *(const f32x4*)(c1 + col), p1 = *(const f32x4*)(c1 + col + 4), q0 = *(const f32x4*)(c0 + col), q1 = *(const f32x4*)(c0 + col + 4);
    a = (a - mu * p0) * rs + q0; b = (b - mu * p1) * rs + q1;
}
struct OpPQFold { static constexpr int NLD = 0; float* o; const float* st; const float* c1; const float* c0;
    __device__ __forceinline__ void operator()(int zi, int row, int col, f32x4 a, f32x4 b) const { ln_fold8(st, c1, c0, row, col, a, b); float* p = o + (size_t)row * 2048 + col; *(f32x4*)p = a; *(f32x4*)(p + 4) = b; } };

template <class Op>
__device__ __forceinline__ void gemm(const Frame& F, const bf16* A, int lda, const bf16* Bt, int ldb, int M, int N, int K, const Op& op) {
    pg8::Gemm g{lda, ldb, K}; pg8::MultiOrder<1> S; S.s[0] = pg8::Sub{A, Bt, M / 256, N / 256}; S.lda = lda; S.ldb = ldb; S.G = F.G; S.c = F.bid;
    pg8::Epi8<Op> E{op};
    pg8::gemm_phase<pg8::Epi8<Op>, pg8::MultiOrder<1>, true>((PG8_LAS unsigned char*)F.lds, g, S, E, F.wave, F.lane());
}
template <class Epi>
__device__ __forceinline__ void gemm_epi(const Frame& F, const bf16* A, int lda, const bf16* Bt, int ldb, int M, int N, int K, const Epi& E) {
    pg8::Gemm g{lda, ldb, K}; pg8::MultiOrder<1> S; S.s[0] = pg8::Sub{A, Bt, M / 256, N / 256}; S.lda = lda; S.ldb = ldb; S.G = F.G; S.c = F.bid;
    pg8::gemm_phase<Epi, pg8::MultiOrder<1>, true>((PG8_LAS unsigned char*)F.lds, g, S, E, F.wave, F.lane());
}
template <int NS, class Op>
__device__ __forceinline__ void gemm_multi(const Frame& F, const pg8::MultiOrder<NS>& S, int K, const Op& op) {
    pg8::Gemm g{S.lda, S.ldb, K}; pg8::Epi8<Op> E{op};
    pg8::gemm_phase<pg8::Epi8<Op>, pg8::MultiOrder<NS>, true>((PG8_LAS unsigned char*)F.lds, g, S, E, F.wave, F.lane());
}
template <class Off, class Op>
__device__ __forceinline__ void gemm_batch(const Frame& F, const pg8::BatchOrder<Off>& S, int K, const Op& op) {
    pg8::Gemm g{S.lda, S.ldb, K}; pg8::Epi8<Op> E{op};
    pg8::gemm_phase<pg8::Epi8<Op>, pg8::BatchOrder<Off>, true>((PG8_LAS unsigned char*)F.lds, g, S, E, F.wave, F.lane());
}
struct OffS { __device__ __forceinline__ size_t a(int z) const { return (size_t)(z >> 2) * 2048 * 2048 + (z & 3) * 512; } __device__ __forceinline__ size_t b(int z) const { return (size_t)(z >> 2) * 256 * 2048 + (z & 3) * 512; } };
struct OffPV { __device__ __forceinline__ size_t a(int z) const { return (size_t)(z >> 2) * 2048 * 1024 + (z & 3) * 256; } __device__ __forceinline__ size_t b(int z) const { return (size_t)(z & 3) * 512 * 2048 + (z >> 2) * 256; } };
struct OpLogit { static constexpr int NLD = 0; float* lg;
    __device__ __forceinline__ void operator()(int z, int row, int col, f32x4 a, f32x4 b) const { float* p = lg + ((size_t)(z >> 2) * 2048 + row) * 1024 + (z & 3) * 256 + col; *(f32x4*)p = a * 0.04419417382415922f; *(f32x4*)(p + 4) = b * 0.04419417382415922f; } };
struct OpCO { static constexpr int NLD = 0; bf16* co;
    __device__ __forceinline__ void operator()(int z, int row, int col, f32x4 a, f32x4 b) const { *(u32x4*)(co + ((size_t)(z >> 2) * 2048 + row) * 2048 + (z & 3) * 512 + col) = pack8(a, b); } };
struct OpCQKV { static constexpr int NLD = 0; bf16* cq; bf16* ck; bf16* vt; const float* st; const float* c1; const float* c0;
    __device__ __forceinline__ void operator()(int z, int row, int col, f32x4 a, f32x4 b) const { if (z == 0) ln_fold8(st, c1, c0, row, col, a, b);
        bf16* o = z == 0 ? cq : (z == 1 ? ck : vt); *(u32x4*)(o + (size_t)row * 2048 + col) = pack8(a, b); } };
__device__ __forceinline__ void ph_xsoftmax(const Frame& F, const float* lg, bf16* P) {
    const int gw = F.bid * 8 + F.wave, NGW = F.G * 8, lane = F.lane();
    for (int u = gw; u < T * 4; u += NGW) {
        const f32x4 v = *(const f32x4*)(lg + (size_t)u * 256 + 4 * lane);
        const float m = wave_max(fmaxf(fmaxf(v.x, v.y), fmaxf(v.z, v.w)));
        const float e0 = expf(v.x - m), e1 = expf(v.y - m), e2 = expf(v.z - m), e3 = expf(v.w - m);
        const float inv = 1.0f / wave_sum((e0 + e1) + (e2 + e3));
        u32x2 w; w.x = pk2(e0 * inv, e1 * inv); w.y = pk2(e2 * inv, e3 * inv);
        *(u32x2*)(P + (size_t)u * 256 + 4 * lane) = w;
    }
}

template <class CM>
__device__ __forceinline__ void transpose_item(const float* W, size_t ldw, bf16* WT, size_t ldwt, int row_off, int nblk, int item, float* scr, int lane, const CM& cm) {
    const int kb = item / nblk, nb = item % nblk, k0 = 64 * kb, n0 = 32 * nb;
    const int c = cm(n0 + (lane & 31));
#pragma unroll 8
    for (int i = 0; i < 32; ++i) { const int kk = 2 * i + (lane >> 5); scr[kk * 33 + (lane & 31)] = (c >= 0) ? W[(size_t)(k0 + kk) * ldw + c] : 0.f; }
    WAVE_SYNC();
    const int c8 = lane & 7;
#pragma unroll
    for (int j = 0; j < 4; ++j) { const int n = (lane >> 3) + 8 * j; const float* s = scr + (8 * c8) * 33 + n;
        u32x4 o; o.x = pk2(s[0 * 33], s[1 * 33]); o.y = pk2(s[2 * 33], s[3 * 33]); o.z = pk2(s[4 * 33], s[5 * 33]); o.w = pk2(s[6 * 33], s[7 * 33]);
        *(u32x4*)(WT + (size_t)(row_off + n0 + n) * ldwt + k0 + 8 * c8) = o; }
    WAVE_SYNC();
}
__device__ __forceinline__ void transpose_item_ln(const float* W, bf16* WT, int item, float* scr, int lane, const float* g, const float* bta, float* c1, float* c0) {
    const int kb = item / 64, nb = item % 64, k0 = 64 * kb, n0 = 32 * nb;
#pragma unroll 8
    for (int i = 0; i < 32; ++i) { const int kk = 2 * i + (lane >> 5); scr[kk * 33 + (lane & 31)] = W[(size_t)(k0 + kk) * 2048 + n0 + (lane & 31)]; }
    WAVE_SYNC();
    const int c8 = lane & 7;
    float gk[8], bk[8];
#pragma unroll
    for (int i = 0; i < 8; ++i) { gk[i] = g[k0 + 8 * c8 + i]; bk[i] = bta[k0 + 8 * c8 + i]; }
#pragma unroll
    for (int j = 0; j < 4; ++j) { const int n = (lane >> 3) + 8 * j; const float* sp = scr + (8 * c8) * 33 + n;
        float wv[8]; float p1 = 0.f, p0 = 0.f;
#pragma unroll
        for (int i = 0; i < 8; ++i) { const float v = sp[i * 33]; wv[i] = v * gk[i]; p1 += wv[i]; p0 += v * bk[i]; }
        u32x4 o; o.x = pk2(wv[0], wv[1]); o.y = pk2(wv[2], wv[3]); o.z = pk2(wv[4], wv[5]); o.w = pk2(wv[6], wv[7]);
        *(u32x4*)(WT + (size_t)(n0 + n) * 2048 + k0 + 8 * c8) = o;
        p1 += __shfl_xor(p1, 1); p1 += __shfl_xor(p1, 2); p1 += __shfl_xor(p1, 4); p0 += __shfl_xor(p0, 1); p0 += __shfl_xor(p0, 2); p0 += __shfl_xor(p0, 4);
        if (c8 == 0) { atomicAdd(c1 + n0 + n, p1); atomicAdd(c0 + n0 + n, p0); } }
    WAVE_SYNC();
}
template <class CM>
__device__ __forceinline__ void transpose_item64(const float* W, size_t ldw, bf16* WT, size_t ldwt, int row_off, int nblk, int item, float* scr, int lane, const CM& cm) {
    const int kb = item / nblk, nb = item % nblk, k0 = 64 * kb, n0 = 64 * nb, r = lane >> 4, c4 = lane & 15;
    const int c = cm(n0 + 4 * c4);
    f32x4 v[16];
#pragma unroll
    for (int i = 0; i < 16; ++i) v[i] = (c >= 0) ? *(const f32x4*)(W + (size_t)(k0 + 4 * i + r) * ldw + c) : (f32x4){0.f, 0.f, 0.f, 0.f};
#pragma unroll
    for (int i = 0; i < 16; ++i) *(f32x4*)(scr + (4 * i + r) * 68 + 4 * c4) = v[i];
    WAVE_SYNC();
    bf16* orow = WT + (size_t)(row_off + n0 + lane) * ldwt + k0;
#pragma unroll
    for (int j = 0; j < 8; ++j) { const float* sp = scr + (8 * j) * 68 + lane;
        u32x4 o; o.x = pk2(sp[0], sp[68]); o.y = pk2(sp[2 * 68], sp[3 * 68]); o.z = pk2(sp[4 * 68], sp[5 * 68]); o.w = pk2(sp[6 * 68], sp[7 * 68]);
        *(u32x4*)(orow + 8 * j) = o; }
    WAVE_SYNC();
}
struct CmIdent { __device__ __forceinline__ int operator()(int n) const { return n; } };
struct CmWin { __device__ __forceinline__ int operator()(int n) const {
    if (n < 10240) return n;
    if (n < 12288) return 10496 + (n - 10240);
    if (n < 14336) return 12688 + (n - 12288);
    if (n < 16384) return 14736 + (n - 14336);
    if (n < 16640) return 10240 + (n - 16384);
    if (n < 16768) return 12544 + (n - 16640);
    if (n < 16784) return 12672 + (n - 16768);
    return -1; } };

__device__ __forceinline__ void cvt_bf16_stream(const Frame& F, const float* src, bf16* dst, size_t n8) {
    const size_t gt = (size_t)F.bid * 512 + F.wave * 64 + F.lane(), NT = (size_t)F.G * 512;
#pragma unroll 4
    for (size_t i = gt; i < n8; i += NT) { const f32x4 a = ((const f32x4*)src)[2 * i], b = ((const f32x4*)src)[2 * i + 1];
        u32x4 o; o.x = pk2(a.x, a.y); o.y = pk2(a.z, a.w); o.z = pk2(b.x, b.y); o.w = pk2(b.z, b.w); ((u32x4*)dst)[i] = o; }
}

__device__ __forceinline__ void ph0_prologue(const Frame& F) {
    const Args& a = *F.a;
    cvt_bf16_stream(F, a.in[0], (bf16*)a.out, (size_t)T * D / 8);
    cvt_bf16_stream(F, a.in[1], (bf16*)(F.ws + WS_MEMB), (size_t)2048 * 2048 / 8);
    float* scr = (float*)(F.lds + F.wave * 17408);
    const int gw = F.bid * 8 + F.wave, NGW = F.G * 8, lane = F.lane();
    {
        const int nblk = NCOLS / 64, nitems = (2048 / 64) * nblk;
        float* scr64 = (float*)(F.lds + F.wave * 17408);
        for (int it = gw; it < nitems; it += NGW) transpose_item64(a.in[2], 16784, (bf16*)(F.ws + WS_WIN), 2048, 0, nblk, it, scr64, lane, CmWin());
    }
    {
        for (int it = gw; it < 32 * 16; it += NGW) { const int mat = it >> 4, which = mat >> 4, h = mat & 15;
            transpose_item(a.in[which ? 9 : 8] + (size_t)h * 256 * 128, 128, (bf16*)(F.ws + WS_WKV), 256, which * 2048 + h * 128, 4, it & 15, scr, lane, CmIdent()); }
    }
    {
        const int gt = F.bid * 512 + F.wave * 64 + lane;
        if (gt < 2048) { const float l0 = a.in[3][gt], l1 = a.in[3][2048 + gt]; ((float*)(F.ws + WS_LB))[gt] = 1.0f / (1.0f + expf(l1 - l0)); }
    }
}

namespace hg {
constexpr int QP = 272, TP = 144, AP = 144;
constexpr int OFF_QD = 0, OFF_KD = OFF_QD + 64 * QP, OFF_QG = OFF_KD + 64 * QP, OFF_KET = OFF_QG + 64 * QP, OFF_VT = OFF_KET + 128 * TP, OFF_A = OFF_VT + 128 * TP,
              OFF_TOT = OFF_A + 64 * AP, OFF_DEC = OFF_TOT + 4 * 128 * 4, OFF_PART = OFF_DEC + 128 * 4, OFF_RSTD = OFF_PART + 8 * 64 * 4, END = OFF_RSTD + 64 * 4;
static_assert(END <= 131072, "hgrn LDS map");
}
typedef short bf16x4 __attribute__((ext_vector_type(4)));
#define HSEC_B() do { if (PROBE_SEC) hs_t0 = rt_now(); } while (0)
#define HSEC_E(n) do { if (PROBE_SEC == (n)) sacc += rt_now() - hs_t0; } while (0)
__device__ __forceinline__ void hgrn_chunked(const Frame& F, int unit, unsigned long long& sacc) {
    unsigned long long hs_t0 = 0ull;
    using namespace hg;
    const Args& a = *F.a;
    const int b = unit >> 4, h = unit & 15, lane = F.lane(), w = F.wave, tid = w * 64 + lane, c = tid & 127, rq = tid >> 7, l15 = lane & 15, q4 = lane >> 4;
    unsigned char* L = F.lds;
    const size_t base = (size_t)b * 2048 * 2048 + h * 128;
    const bf16* HQ = F.slot(0) + base; const bf16* HF = F.slot(1) + base; const bf16* HI = F.slot(2) + base; const bf16* HG = F.slot(3) + base; bf16* HO = F.slot(0) + base;
    const float lb = ((const float*)(F.ws + WS_LB))[h * 128 + c];
    const float ng = a.in[4][h * 128 + 16 * w + l15];
    f32x4 S[8];
#pragma unroll
    for (int d = 0; d < 8; ++d) S[d] = (f32x4){0.f, 0.f, 0.f, 0.f};
    unsigned short rq_[16], rf_[16], rv_[16];
#pragma unroll
    for (int k = 0; k < 16; ++k) { const size_t o = (size_t)(16 * rq + k) * 2048 + c; rq_[k] = HQ[o]; rf_[k] = HF[o]; rv_[k] = HI[o]; }
    float* tot = (float*)(L + OFF_TOT); float* dec = (float*)(L + OFF_DEC); float* part = (float*)(L + OFF_PART); float* rstd = (float*)(L + OFF_RSTD);
#pragma unroll 1
    for (int ch = 0; ch < 32; ++ch) {
        const int r0 = ch * 64;
        HSEC_B();
        unsigned short gq[16];
#pragma unroll
        for (int mt = 0; mt < 4; ++mt)
#pragma unroll
            for (int r = 0; r < 4; ++r) gq[4 * mt + r] = HG[(size_t)(r0 + 16 * mt + 4 * q4 + r) * 2048 + 16 * w + l15];
        unsigned short rv2_[16];
        if (ch + 1 < 32) {
#pragma unroll
            for (int k = 0; k < 16; ++k) rv2_[k] = HI[(size_t)(r0 + 64 + 16 * rq + k) * 2048 + c]; }
        float G[16], qf[16], kk[16];
        { float run = 0.f;
#pragma unroll
          for (int k = 0; k < 16; ++k) { const float f = lb + (1.0f - lb) * __builtin_amdgcn_rcpf(1.0f + __expf(-bf2f(rf_[k]))); run += __logf(f); G[k] = run; kk[k] = 1.0f - f; qf[k] = bf2f(rq_[k]); } }
        tot[rq * 128 + c] = G[15];
        if (ch + 1 < 32) {
#pragma unroll
            for (int k = 0; k < 16; ++k) { const size_t o = (size_t)(r0 + 64 + 16 * rq + k) * 2048 + c; rq_[k] = HQ[o]; rf_[k] = HF[o]; } }
        HSEC_E(1); HSEC_B();
        __syncthreads();
        HSEC_E(2); HSEC_B();
        const float t0 = tot[c], t1 = tot[128 + c], t2 = tot[256 + c], t3 = tot[384 + c];
        const float offs = (rq > 0 ? t0 : 0.f) + (rq > 1 ? t1 : 0.f) + (rq > 2 ? t2 : 0.f);
        const float Gref = t0 + t1, Glast = Gref + t2 + t3, eref = __expf(Gref), elr = __expf(Glast - Gref);
        if (rq == 0) dec[c] = __expf(Glast);
        unsigned kew[8], vw[8];
#pragma unroll
        for (int k = 0; k < 16; ++k) {
            const float e1 = __expf(G[k] + offs - Gref), qd = qf[k] * e1, kd = kk[k] * __builtin_amdgcn_rcpf(e1);
            const int row = 16 * rq + k;
            *(bf16*)(L + OFF_QD + row * QP + 2 * c) = (bf16)f2bf(qd);
            *(bf16*)(L + OFF_KD + row * QP + 2 * c) = (bf16)f2bf(kd);
            *(bf16*)(L + OFF_QG + row * QP + 2 * c) = (bf16)f2bf(qd * eref);
            const unsigned ke = f2bf(kd * elr);
            if (k & 1) { kew[k >> 1] |= ke << 16; vw[k >> 1] |= (unsigned)rv_[k] << 16; } else { kew[k >> 1] = ke; vw[k >> 1] = rv_[k]; }
        }
        *(u32x4*)(L + OFF_KET + c * TP + 32 * rq) = (u32x4){kew[0], kew[1], kew[2], kew[3]}; *(u32x4*)(L + OFF_KET + c * TP + 32 * rq + 16) = (u32x4){kew[4], kew[5], kew[6], kew[7]};
        *(u32x4*)(L + OFF_VT + c * TP + 32 * rq) = (u32x4){vw[0], vw[1], vw[2], vw[3]}; *(u32x4*)(L + OFF_VT + c * TP + 32 * rq + 16) = (u32x4){vw[4], vw[5], vw[6], vw[7]};
        if (ch + 1 < 32) {
#pragma unroll
            for (int k = 0; k < 16; ++k) rv_[k] = rv2_[k]; }
        HSEC_E(3); HSEC_B();
        __syncthreads();
        HSEC_E(4); HSEC_B();
        { const int mi = w >> 1;
#pragma unroll
          for (int tt = 0; tt < 2; ++tt) { const int nj = 2 * (w & 1) + tt; f32x4 acc = (f32x4){0.f, 0.f, 0.f, 0.f};
              if (nj <= mi) {
#pragma unroll
                  for (int ks = 0; ks < 4; ++ks) { const bf16x8 aF = *(const bf16x8*)(L + OFF_KD + (16 * nj + l15) * QP + 64 * ks + 16 * q4), bF = *(const bf16x8*)(L + OFF_QD + (16 * mi + l15) * QP + 64 * ks + 16 * q4);
                      acc = __builtin_amdgcn_mfma_f32_16x16x32_bf16(aF, bF, acc, 0, 0, 0); } }
              const int i = 16 * mi + l15, j0 = 16 * nj + 4 * q4;
              const float v0 = (j0 <= i) ? acc.x : 0.f, v1 = (j0 + 1 <= i) ? acc.y : 0.f, v2 = (j0 + 2 <= i) ? acc.z : 0.f, v3 = (j0 + 3 <= i) ? acc.w : 0.f;
              *(u32x2*)(L + OFF_A + i * AP + 2 * j0) = (u32x2){pk2(v0, v1), pk2(v2, v3)}; } }
        __syncthreads();
        HSEC_E(5); HSEC_B();
        bf16x8 bV[2];
#pragma unroll
        for (int ks = 0; ks < 2; ++ks) bV[ks] = *(const bf16x8*)(L + OFF_VT + (16 * w + l15) * TP + 64 * ks + 16 * q4);
        f32x4 O[4];
#pragma unroll
        for (int mt = 0; mt < 4; ++mt) { O[mt] = (f32x4){0.f, 0.f, 0.f, 0.f};
#pragma unroll
            for (int ks = 0; ks < 2; ++ks) { const bf16x8 aF = *(const bf16x8*)(L + OFF_A + (16 * mt + l15) * AP + 64 * ks + 16 * q4); O[mt] = __builtin_amdgcn_mfma_f32_16x16x32_bf16(aF, bV[ks], O[mt], 0, 0, 0); } }
#pragma unroll
        for (int kq = 0; kq < 4; ++kq) {
            u32x4 sw; sw.x = pk2(S[2 * kq].x, S[2 * kq].y); sw.y = pk2(S[2 * kq].z, S[2 * kq].w); sw.z = pk2(S[2 * kq + 1].x, S[2 * kq + 1].y); sw.w = pk2(S[2 * kq + 1].z, S[2 * kq + 1].w);
            const bf16x8 bS = __builtin_bit_cast(bf16x8, sw);
#pragma unroll
            for (int mt = 0; mt < 4; ++mt) { const unsigned char* qp = L + OFF_QG + (16 * mt + l15) * QP + 64 * kq + 8 * q4;
                const u32x2 lo = *(const u32x2*)qp, hi = *(const u32x2*)(qp + 32);
                const bf16x8 aF = __builtin_bit_cast(bf16x8, (u32x4){lo.x, lo.y, hi.x, hi.y});
                O[mt] = __builtin_amdgcn_mfma_f32_16x16x32_bf16(aF, bS, O[mt], 0, 0, 0); } }
#pragma unroll
        for (int dt = 0; dt < 8; ++dt) { const f32x4 dc = *(const f32x4*)(dec + 16 * dt + 4 * q4); S[dt] = S[dt] * dc;
#pragma unroll
            for (int ks = 0; ks < 2; ++ks) { const bf16x8 aF = *(const bf16x8*)(L + OFF_KET + (16 * dt + l15) * TP + 64 * ks + 16 * q4); S[dt] = __builtin_amdgcn_mfma_f32_16x16x32_bf16(aF, bV[ks], S[dt], 0, 0, 0); } }
        HSEC_E(6); HSEC_B();
#pragma unroll
        for (int mt = 0; mt < 4; ++mt)
#pragma unroll
            for (int r = 0; r < 4; ++r) { float p = O[mt][r] * O[mt][r]; p += __shfl_xor(p, 1); p += __shfl_xor(p, 2); p += __shfl_xor(p, 4); p += __shfl_xor(p, 8);
                if (l15 == 0) part[w * 64 + 16 * mt + 4 * q4 + r] = p; }
        __syncthreads();
        if (tid < 64) { float s = 0.f;
#pragma unroll
            for (int ww = 0; ww < 8; ++ww) s += part[ww * 64 + tid];
            rstd[tid] = rsqrtf(s * (1.0f / 128.0f) + 1e-6f); }
        __syncthreads();
        HSEC_E(7); HSEC_B();
#pragma unroll
        for (int mt = 0; mt < 4; ++mt) { const f32x4 rs = *(const f32x4*)(rstd + 16 * mt + 4 * q4);
#pragma unroll
            for (int r = 0; r < 4; ++r) { const float g = bf2f(gq[4 * mt + r]); const float o = O[mt][r] * rs[r] * ng * (g * __builtin_amdgcn_rcpf(1.0f + __expf(-g)));
                HO[(size_t)(r0 + 16 * mt + 4 * q4 + r) * 2048 + 16 * w + l15] = (bf16)f2bf(o); } }
        HSEC_E(8);
    }
    __syncthreads();
}

__device__ __forceinline__ void ph2_side(const Frame& F, int sid, int nside) {
    const Args& a = *F.a;
    const int gw = sid * 8 + F.wave, NGW = nside * 8, lane = F.lane();
    bf16* CKV = (bf16*)(F.ws + WS_CKV); bf16* IKW = (bf16*)(F.ws + WS_IKW);
    for (int row = gw; row < T; row += NGW) {
        {   u32x2 w = *(u32x2*)(CKV + (size_t)row * 256 + 4 * lane);
            float x0 = bflo(w.x), x1 = bfhi(w.x), x2 = bflo(w.y), x3 = bfhi(w.y);
            const float ss = wave_sum(x0 * x0 + x1 * x1 + x2 * x2 + x3 * x3);
            const float r = rsqrtf(ss * (1.0f / 256.0f) + 1e-6f);
            const f32x4 g = *(const f32x4*)(a.in[5] + 4 * lane);
            w.x = pk2(x0 * r * g.x, x1 * r * g.y); w.y = pk2(x2 * r * g.z, x3 * r * g.w);
            *(u32x2*)(CKV + (size_t)row * 256 + 4 * lane) = w; }
        {   unsigned w = *(unsigned*)(IKW + (size_t)row * 256 + 2 * lane);
            float x0 = bflo(w), x1 = bfhi(w);
            const float mu = wave_sum(x0 + x1) * (1.0f / 128.0f);
            x0 -= mu; x1 -= mu;
            const float var = wave_sum(x0 * x0 + x1 * x1) * (1.0f / 128.0f);
            const float r = rsqrtf(var + 1e-5f);
            const float g0 = a.in[6][2 * lane], g1 = a.in[6][2 * lane + 1], b0 = a.in[7][2 * lane], b1 = a.in[7][2 * lane + 1];
            *(unsigned*)(IKW + (size_t)row * 256 + 2 * lane) = pk2(x0 * r * g0 + b0, x1 * r * g1 + b1); }
    }
}
__device__ __forceinline__ void w8_transposes(const Frame& F, bf16* W8) {
    const Args& a = *F.a;
    const int gw = F.bid * 8 + F.wave, NGW = F.G * 8, lane = F.lane();
    float* scr = (float*)(F.lds + F.wave * 17408);
    float* cv = (float*)(F.ws + WS_CTL + CTL_CVEC);
    for (int it = gw; it < 2 * 2048; it += NGW) {
        const int which = it >> 11, m = which ? 7 : 3;
        transpose_item_ln(which ? a.in[22] : a.in[16], W8 + (size_t)m * 2048 * 2048, it & 2047, scr, lane, which ? a.in[20] : a.in[14], which ? a.in[21] : a.in[15], cv + which * 4096, cv + which * 4096 + 2048); }
    for (int it = gw; it < 6 * 1024; it += NGW) {
        const int q = it >> 10, m = q < 3 ? q : (q + 1);
        const float* wsrc = m == 0 ? a.in[11] : m == 1 ? a.in[12] : m == 2 ? a.in[13] : m == 4 ? a.in[17] : m == 5 ? a.in[18] : a.in[19];
        if (m < 2) transpose_item64(wsrc, 2048, W8 + (size_t)m * 2048, 4096, 0, 32, it & 1023, scr, lane, CmIdent());
        else transpose_item64(wsrc, 2048, W8 + (size_t)m * 2048 * 2048, 2048, 0, 32, it & 1023, scr, lane, CmIdent()); }
}

__device__ __forceinline__ void ph3_hgnorm(const Frame& F) {
    const Args& a = *F.a;
    const int gw = F.bid * 8 + F.wave, NGW = F.G * 8, lane = F.lane();
    const float* oraw = a.out; const bf16* HG = F.slot(3); bf16* HO = F.slot(0);
    for (int u = gw; u < T * 16; u += NGW) {
        const size_t off = (size_t)(u >> 4) * 2048 + (u & 15) * 128 + 2 * lane;
        const float o0 = oraw[off], o1 = oraw[off + 1];
        const float r = rsqrtf(wave_sum(o0 * o0 + o1 * o1) * (1.0f / 128.0f) + 1e-6f);
        const unsigned gw2 = *(const unsigned*)(HG + off);
        const float g0 = bflo(gw2), g1 = bfhi(gw2);
        const int c = (u & 15) * 128 + 2 * lane;
        *(unsigned*)(HO + off) = pk2(o0 * r * a.in[4][c] * (g0 * sigm(g0)), o1 * r * a.in[4][c + 1] * (g1 * sigm(g1)));
    }
}

__device__ __forceinline__ unsigned fkey(float f) { const unsigned u = __float_as_uint(f); return (u & 0x80000000u) ? ~u : (u | 0x80000000u); }
__device__ __forceinline__ void ph5_select(const Frame& F, int first, int stride) {
    const int lane = F.lane(), l31 = lane & 31, half = lane >> 5, w = F.wave;
    float* scl = (float*)F.lds;
    const bf16* AIQ = F.slot(5); const bf16* IKW = (const bf16*)(F.ws + WS_IKW);
    unsigned* MASK = (unsigned*)(F.ws + WS_MASK);
    for (int i = first; i < 1024; i += stride) {
        const int r4 = i >> 8, c = i & 255, j = c & 127, b = 2 * r4 + (c >> 7), qt = (r4 & 1) ? 127 - j : j, t0 = qt * 16;
        bf16x8 Af[8];
        { const size_t rowA = (size_t)b * 2048 + t0 + 2 * w + ((l31 >> 2) & 1); const int headA = (l31 & 3) + 4 * (l31 >> 3);
#pragma unroll
          for (int ks = 0; ks < 8; ++ks) Af[ks] = *(const bf16x8*)(AIQ + rowA * 2048 + headA * 128 + 16 * ks + 8 * half); }
        float wr[16];
        { const bf16* wp = IKW + ((size_t)b * 2048 + t0 + 2 * w + half) * 256 + 128;
#pragma unroll
          for (int r = 0; r < 16; ++r) wr[r] = bf2f(wp[(r & 3) + 4 * (r >> 2)]) * (0.25f * 0.08838834764831845f); }
        const int nkt = (t0 + 15) / 32 + 1;
        unsigned char* ring = F.lds + 131072;
        const int srow = (w * 64 + lane) >> 4, sch = lane & 15;
        const bf16* kg = IKW + ((size_t)b * 2048 + srow) * 256 + 8 * sch;
        const int swr = srow * 256 + ((sch ^ (srow & 15)) << 4);
        const int frd = l31 * 256;
        u32x4 st0, st1;
        st0 = *(const u32x4*)kg; *(u32x4*)(ring + swr) = st0;
        if (nkt > 1) { st1 = *(const u32x4*)(kg + (size_t)32 * 256); *(u32x4*)(ring + 8192 + swr) = st1; }
        if (nkt > 2) st0 = *(const u32x4*)(kg + (size_t)2 * 32 * 256);
        __syncthreads();
#define IDX_TILE(kt_, STW, STL) do { \
            if ((kt_) + 3 < nkt) STL = *(const u32x4*)(kg + (size_t)((kt_) + 3) * 32 * 256); \
            { const unsigned char* sl_ = ring + ((kt_) % 3) * 8192 + frd; f32x16 acc; _Pragma("unroll") for (int r = 0; r < 16; ++r) acc[r] = 0.f; \
              _Pragma("unroll") for (int ks = 0; ks < 8; ++ks) { const bf16x8 bfr = *(const bf16x8*)(sl_ + (((2 * ks + half) ^ (l31 & 15)) << 4)); acc = __builtin_amdgcn_mfma_f32_32x32x16_bf16(Af[ks], bfr, acc, 0, 0, 0); } \
              float sc = 0.f; _Pragma("unroll") for (int r = 0; r < 16; ++r) sc += fmaxf(acc[r], 0.f) * wr[r]; \
              scl[(2 * w + half) * 2048 + (kt_) * 32 + l31] = sc; } \
            if ((kt_) + 2 < nkt) *(u32x4*)(ring + (((kt_) + 2) % 3) * 8192 + swr) = STW; \
            __syncthreads(); } while (0)
        for (int kt = 0; kt < nkt; kt += 2) { IDX_TILE(kt, st0, st1); if (kt + 1 < nkt) IDX_TILE(kt + 1, st1, st0); }
#undef IDX_TILE
        WAVE_SYNC();
#pragma unroll 1
        for (int qi = 0; qi < 2; ++qi) {
            const int t = t0 + 2 * w + qi; const float* row = scl + (2 * w + qi) * 2048;
            unsigned key[32];
#pragma unroll
            for (int jj = 0; jj < 32; ++jj) { const int s2 = lane + 64 * jj; key[jj] = (s2 <= t) ? fkey(row[s2]) : 0u; }
            unsigned thr = 0u;
            if (t + 1 > 256) {
                for (int bit = 31; bit >= 0; --bit) {
                    const unsigned cand = thr | (1u << bit);
                    int cnt = 0;
#pragma unroll
                    for (int jj = 0; jj < 32; ++jj) cnt += (key[jj] >= cand) ? 1 : 0;
#pragma unroll
                    for (int o = 32; o >= 1; o >>= 1) cnt += __shfl_xor(cnt, o);
                    if (cnt >= 256) { thr = cand; if (cnt == 256) break; }
                }
            }
            unsigned wd = 0u;
#pragma unroll
            for (int jj = 0; jj < 32; ++jj) { const int s2 = lane + 64 * jj; const unsigned long long m = __ballot(s2 <= t && key[jj] >= thr);
                if (lane == 2 * jj) wd = (unsigned)m; if (lane == 2 * jj + 1) wd = (unsigned)(m >> 32); }
            MASK[((size_t)b * 2048 + t) * 64 + lane] = wd;
        }
        WAVE_SYNC();
    }
}

__device__ __forceinline__ int t5_bucket(int d) {
    if (d < 16) return d;
    return 16 + (d >= 19) + (d >= 21) + (d >= 24) + (d >= 27) + (d >= 31) + (d >= 35) + (d >= 40) + (d >= 46) + (d >= 52) + (d >= 59) + (d >= 67) + (d >= 77) + (d >= 87) + (d >= 99) + (d >= 113);
}
namespace dsa {
constexpr float SCALE = 0.08838834764831845f;
constexpr int NW = 8, QBLK = 32, KVBLK = 64, QB = NW * QBLK, DH = 128, LD = 2048;
constexpr int SHM_V = KVBLK * DH * 2, SHM_K = KVBLK * DH * 2;
constexpr int OFF_WS = 2 * SHM_V + 2 * SHM_K, OFF_BIAS = OFF_WS + NW * 64 * 4, LDS_TOTAL = OFF_BIAS + 16 * 128 * 4;
constexpr float THR = 8.f;
typedef short s16x4 __attribute__((ext_vector_type(4)));
#define KSWZ(row, colB) ((row) * 256 + ((colB) ^ (((row) & 7) << 4)))
#define SBAR() __builtin_amdgcn_sched_barrier(0)
__device__ __forceinline__ int v_st(int k, int c) { const int kk = (k & ~0xC) | ((k & 4) << 1) | ((k & 8) >> 1); return ((kk >> 3) * 4 + (c >> 5)) * 512 + ((kk & 7) * 32 + (c & 31)) * 2; }
__device__ __forceinline__ int v_rd_base(int lane) { return ((lane & 3) << 3) | (((lane >> 2) & 3) << 6) | (((lane >> 4) & 1) << 5) | (((lane >> 5) & 1) << 8); }
constexpr int v_rd_off(int d0, int ks, int half) { return d0 * 512 + ks * 4096 + half * 2048; }
__device__ __forceinline__ int crow(int r, int hi) { return (r & 3) + 8 * (r >> 2) + 4 * hi; }
__device__ __forceinline__ unsigned cvtpk(float lo, float hi) { unsigned r; asm volatile("v_cvt_pk_bf16_f32 %0, %1, %2" : "=v"(r) : "v"(lo), "v"(hi)); return r; }
__device__ __forceinline__ bf16x8 load8(const bf16* p) { return *reinterpret_cast<const bf16x8*>(p); }
template <bool NEAR>
__device__ __forceinline__ void init_scores(f32x16& p0, f32x16& p1, unsigned w0, unsigned w1, int hi, int dq, const float* bl) {
    w0 >>= 4 * hi; w1 >>= 4 * hi;
#pragma unroll
    for (int r = 0; r < 16; ++r) { const int c = (r & 3) + 8 * (r >> 2);
        const int x0 = __builtin_amdgcn_sbfe(w0, c, 1), x1 = __builtin_amdgcn_sbfe(w1, c, 1);
        unsigned b0 = 0u, b1 = 0u;
        if (NEAR) { int d0 = dq - c, d1 = dq - c - 32; d0 = d0 < 0 ? 0 : (d0 > 127 ? 127 : d0); d1 = d1 < 0 ? 0 : (d1 > 127 ? 127 : d1);
            b0 = __float_as_uint(bl[d0]); b1 = __float_as_uint(bl[d1]); }
        p0[r] = __uint_as_float((b0 & (unsigned)x0) | (0xFF800000u & ~(unsigned)x0));
        p1[r] = __uint_as_float((b1 & (unsigned)x1) | (0xFF800000u & ~(unsigned)x1)); }
}
__device__ __forceinline__ void partialSM(f32x16& p0, f32x16& p1, float& m_reg, float& mn, float& alpha) {
    float pmax = p0[0];
#pragma unroll
    for (int r = 1; r < 16; ++r) pmax = fmaxf(pmax, p0[r]);
#pragma unroll
    for (int r = 0; r < 16; ++r) pmax = fmaxf(pmax, p1[r]);
    { auto rr = __builtin_amdgcn_permlane32_swap(__float_as_uint(pmax), __float_as_uint(pmax), false, false);
      pmax = fmaxf(__uint_as_float(rr[0]), __uint_as_float(rr[1])); }
    constexpr float C2 = 1.4426950408889634f * SCALE;
    if (__builtin_expect(__all((pmax - m_reg) * SCALE <= THR), 1)) { mn = m_reg; alpha = 1.f; }
    else { mn = fmaxf(m_reg, pmax); alpha = __builtin_amdgcn_exp2f((m_reg - mn) * C2); m_reg = mn; }
    const float mnL = -mn * C2;
#pragma unroll
    for (int r = 0; r < 16; ++r) p0[r] = fmaf(p0[r], C2, mnL);
#pragma unroll
    for (int r = 0; r < 16; ++r) p1[r] = fmaf(p1[r], C2, mnL);
#pragma unroll
    for (int r = 0; r < 16; ++r) p0[r] = __builtin_amdgcn_exp2f(p0[r]);
}
__device__ __forceinline__ void finishSM(f32x16& p0, f32x16& p1, float alpha, float& l_reg, bf16x8& pa0, bf16x8& pa1, bf16x8& pa2, bf16x8& pa3) {
#pragma unroll
    for (int r = 0; r < 16; ++r) p1[r] = __builtin_amdgcn_exp2f(p1[r]);
    float ps = 0;
#pragma unroll
    for (int r = 0; r < 16; ++r) ps += p0[r];
#pragma unroll
    for (int r = 0; r < 16; ++r) ps += p1[r];
    { auto rr = __builtin_amdgcn_permlane32_swap(__float_as_uint(ps), __float_as_uint(ps), false, false);
      ps = __uint_as_float(rr[0]) + __uint_as_float(rr[1]); }
    l_reg = l_reg * alpha + ps;
#define PK4(P, B_, OUT) do { unsigned a0 = cvtpk(P[B_+0], P[B_+1]), a1 = cvtpk(P[B_+2], P[B_+3]);                          \
        unsigned b0 = cvtpk(P[B_+4], P[B_+5]), b1 = cvtpk(P[B_+6], P[B_+7]);                                             \
        auto r0 = __builtin_amdgcn_permlane32_swap(a0, b0, false, false); auto r1 = __builtin_amdgcn_permlane32_swap(a1, b1, false, false); \
        u32x4 w = {r0[0], r1[0], r0[1], r1[1]}; OUT = *reinterpret_cast<bf16x8*>(&w); } while (0)
    PK4(p0, 0, pa0); PK4(p0, 8, pa1); PK4(p1, 0, pa2); PK4(p1, 8, pa3);
#undef PK4
}
template <int KB>
__device__ __forceinline__ void qkt(f32x16& p0, f32x16& p1, const char* K_lds, int r32, int hi, const bf16x8* qr) {
    const char* kb[4];
#pragma unroll
    for (int dd = 0; dd < 4; ++dd) kb[dd] = K_lds + KB * SHM_K + KSWZ(r32, (dd * 16 + hi * 8) * 2);
#pragma unroll
    for (int d0 = 0; d0 < 8; ++d0) { const char* a = kb[d0 & 3] + (d0 >> 2) * 128;
        bf16x8 b0 = *reinterpret_cast<const bf16x8*>(a);
        bf16x8 b1 = *reinterpret_cast<const bf16x8*>(a + 32 * 256);
        p0 = __builtin_amdgcn_mfma_f32_32x32x16_bf16(b0, qr[d0], p0, 0, 0, 0);
        p1 = __builtin_amdgcn_mfma_f32_32x32x16_bf16(b1, qr[d0], p1, 0, 0, 0); }
}
template <int VB>
__device__ __forceinline__ void pv_tile(f32x16* o, int vb0, bf16x8 pa0, bf16x8 pa1, bf16x8 pa2, bf16x8 pa3) {
#define TRRD(dst, off) asm volatile("ds_read_b64_tr_b16 %0, %1 offset:%2" : "=&v"(dst) : "v"(vb0), "i"(off) : "memory")
#define PV_D0(d0) do { s16x4 l0, l1, l2, l3, h0, h1, h2, h3; constexpr int b_ = VB * SHM_V + v_rd_off(d0, 0, 0); \
        TRRD(l0, b_); TRRD(h0, b_ + 2048); TRRD(l1, b_ + 4096); TRRD(h1, b_ + 6144); TRRD(l2, b_ + 8192); TRRD(h2, b_ + 10240); TRRD(l3, b_ + 12288); TRRD(h3, b_ + 14336); \
        asm volatile("s_waitcnt lgkmcnt(0)" ::: "memory"); SBAR();   \
        o[d0] = __builtin_amdgcn_mfma_f32_32x32x16_bf16(pa0, (bf16x8){l0[0], l0[1], l0[2], l0[3], h0[0], h0[1], h0[2], h0[3]}, o[d0], 0, 0, 0);   \
        o[d0] = __builtin_amdgcn_mfma_f32_32x32x16_bf16(pa1, (bf16x8){l1[0], l1[1], l1[2], l1[3], h1[0], h1[1], h1[2], h1[3]}, o[d0], 0, 0, 0);   \
        o[d0] = __builtin_amdgcn_mfma_f32_32x32x16_bf16(pa2, (bf16x8){l2[0], l2[1], l2[2], l2[3], h2[0], h2[1], h2[2], h2[3]}, o[d0], 0, 0, 0);   \
        o[d0] = __builtin_amdgcn_mfma_f32_32x32x16_bf16(pa3, (bf16x8){l3[0], l3[1], l3[2], l3[3], h3[0], h3[1], h3[2], h3[3]}, o[d0], 0, 0, 0); } while (0)
    PV_D0(0); PV_D0(1); PV_D0(2); PV_D0(3);
#undef PV_D0
#undef TRRD
}
struct BlockRef { const bf16* Q; const bf16* K; const bf16* V; bf16* O; const unsigned* M; int P0; int h; };
struct Seam { bf16x8 qr[8]; bf16x8 st_v0, st_v1, st_k0, st_k1; };
#define ROWU(p, k0) ((p) + (size_t)(k0) * LD)
#define VMW() asm volatile("s_waitcnt vmcnt(0)" ::: "memory")
#define VMWN(n) asm volatile("s_waitcnt vmcnt(%0)" :: "i"(n) : "memory")
#define SLOAD_H(Kp, Vp, k0) do { S.st_v0 = load8(ROWU(Vp, k0) + sofs); S.st_v1 = load8(ROWU(Vp, (k0) + 32) + sofs);              \
                         S.st_k0 = load8(ROWU(Kp, k0) + sofs); S.st_k1 = load8(ROWU(Kp, (k0) + 32) + sofs); } while (0)
#define SWRITE_HK(bf) do { *(bf16x8*)(K_lds + (bf) * SHM_K + kws) = S.st_k0; *(bf16x8*)(K_lds + (bf) * SHM_K + kws + 32 * 256) = S.st_k1; } while (0)
#define SWRITE_HV(bf) do { *(bf16x8*)(V_lds + (bf) * SHM_V + vst0) = S.st_v0; *(bf16x8*)(V_lds + (bf) * SHM_V + vst1) = S.st_v1; } while (0)
#define SWRITE_H(bf) do { SWRITE_HV(bf); SWRITE_HK(bf); } while (0)
__device__ __forceinline__ void prime(const BlockRef& cur, char* lds, Seam& S, int wid) {
    const int lane = fresh_lane(), tid = wid * 64 + lane, r32 = lane & 31, hi = lane >> 5;
    const int sr = tid >> 4, sc = (tid & 15) * 8, kws = KSWZ(sr, sc * 2); char* K_lds = lds + 2 * SHM_V; const unsigned sofs = (unsigned)(sr * LD + sc);
    const unsigned qofs = (unsigned)((wid * QBLK + r32) * LD + hi * 8);
#pragma unroll
    for (int d0 = 0; d0 < 8; ++d0) S.qr[d0] = load8(cur.Q + qofs + d0 * 16);
    SLOAD_H(cur.K, cur.V, 0); VMW(); SWRITE_HK(0);
    __syncthreads();
}
__device__ __forceinline__ void block(const BlockRef& cur, const BlockRef& nxt, char* lds, Seam& S, int wid) {
    const int lane = fresh_lane(), tid = wid * 64 + lane,
               r32 = lane & 31, hi = lane >> 5;
    const int NT = (cur.P0 + QB - 1) / KVBLK + 1;
    const int qlo = cur.P0 + wid * QBLK, qm = qlo + r32 - 4 * hi;
    char* V_lds = lds; char* K_lds = lds + 2 * SHM_V;
    float* ws = (float*)(lds + OFF_WS) + wid * 64; float* li_l = ws, * al_l = ws + 32;
    const float* bl = (const float*)(lds + OFF_BIAS) + cur.h * 128;
    const unsigned mofs = (unsigned)((wid * QBLK + r32) * 64);
    float m_reg = -1e30f, l_reg = 0; f32x16 o[4] = {};
    const int sr = tid >> 4, sc = (tid & 15) * 8, vst0 = v_st(sr, sc), vst1 = v_st(32 + sr, sc), kws = KSWZ(sr, sc * 2); const unsigned sofs = (unsigned)(sr * LD + sc);
    const int vb0 = (int)(uintptr_t)V_lds + v_rd_base(lane);
    const bf16* Kh = cur.K; const bf16* Vh = cur.V;
#define RESC(a) do { if (__any((a) < 1.f)) { if (hi == 0) al_l[r32] = (a); asm volatile("s_waitcnt lgkmcnt(0)" ::: "memory");              \
                     for (int d_ = 0; d_ < 4; ++d_) for (int r = 0; r < 16; ++r) o[d_][r] *= al_l[crow(r, hi)]; } } while (0)
#define KBASE(t) ((t) * KVBLK)
#define LDMASK(t) (*(const u32x2*)(cur.M + 2 * ((t) < 31 ? (t) : 31) + mofs))
#define INIT(P0_, P1_, t) do { const int kb_ = KBASE(t); if (qlo - kb_ - 63 < 113) init_scores<true>(P0_, P1_, mw.x, mw.y, hi, qm - kb_, bl); else init_scores<false>(P0_, P1_, mw.x, mw.y, hi, 0, bl); } while (0)
#define SEAM_K0() do { VMWN(8); SWRITE_HK(0); SBAR(); } while (0)
    f32x16 pA0, pA1, pB0, pB1; float mnA, mnB, alA, alB; bf16x8 pa0, pa1, pa2, pa3; u32x2 mw;
    SWRITE_HV(0); SBAR();
    if (NT > 1) { SLOAD_H(Kh, Vh, KBASE(1)); }
    mw = LDMASK(0); INIT(pA0, pA1, 0); mw = LDMASK(1);
    SBAR(); qkt<0>(pA0, pA1, K_lds, r32, hi, S.qr);
    partialSM(pA0, pA1, m_reg, mnA, alA);
    if (NT > 1) { VMW(); SWRITE_H(1); }
    __syncthreads();
#define HALF_STEP(PX0, PX1, mnX, alX, PY0, PY1, alY, t, KB, VB, SB) do {                                                      \
        INIT(PX0, PX1, (t)); mw = LDMASK((t) + 1);                                                                           \
        SBAR(); qkt<KB>(PX0, PX1, K_lds, r32, hi, S.qr);                                                                      \
        finishSM(PY0, PY1, alY, l_reg, pa0, pa1, pa2, pa3); SBAR();                                                           \
        if ((t) + 1 < NT) { SLOAD_H(Kh, Vh, KBASE((t) + 1)); SBAR(); }                                                        \
        pv_tile<VB>(o, vb0, pa0, pa1, pa2, pa3); partialSM(PX0, PX1, m_reg, mnX, alX);              \
        __syncthreads();                                                                                                      \
        if ((t) + 1 < NT) { VMW(); SWRITE_H(SB); }                                                                            \
        RESC(alX); __syncthreads(); } while (0)
    for (int t = 1; t + 1 < NT; t += 2) {
        HALF_STEP(pB0, pB1, mnB, alB, pA0, pA1, alA, t, 1, 0, 0);
        HALF_STEP(pA0, pA1, mnA, alA, pB0, pB1, alB, t + 1, 0, 1, 1);
    }
    const bool even = (NT & 1) == 0;
    if (even) { INIT(pB0, pB1, NT - 1); SBAR(); qkt<1>(pB0, pB1, K_lds, r32, hi, S.qr); SBAR(); }
    SLOAD_H(nxt.K, nxt.V, 0); SBAR();
#pragma unroll
    for (int d0 = 0; d0 < 8; ++d0) S.qr[d0] = load8(nxt.Q + (unsigned)((wid * QBLK + r32) * LD + hi * 8) + d0 * 16);
    SBAR();
    finishSM(pA0, pA1, alA, l_reg, pa0, pa1, pa2, pa3); SBAR();
    pv_tile<0>(o, vb0, pa0, pa1, pa2, pa3);
    if (even) { partialSM(pB0, pB1, m_reg, mnB, alB); __syncthreads(); RESC(alB);
        finishSM(pB0, pB1, alB, l_reg, pa0, pa1, pa2, pa3); SBAR(); pv_tile<1>(o, vb0, pa0, pa1, pa2, pa3); }
    SBAR(); SEAM_K0();
    if (hi == 0) li_l[r32] = l_reg; asm volatile("s_waitcnt lgkmcnt(0)" ::: "memory");
    float rli[16];
#pragma unroll
    for (int r = 0; r < 16; ++r) rli[r] = __builtin_amdgcn_rcpf(li_l[crow(r, hi)]);
    int lofs = 4 * hi * LD + r32; asm volatile("" : "+v"(lofs));
    bf16* Ow = cur.O + (size_t)(wid * QBLK) * LD + lofs;
#pragma unroll
    for (int r = 0; r < 16; ++r) { const int orow = (r & 3) + 8 * (r >> 2);
#pragma unroll
        for (int d0 = 0; d0 < 4; ++d0) { const float v = o[d0][r] * rli[r];
            const float vn = __shfl_xor(v, 1);
            if ((r32 & 1) == 0) *(unsigned*)(Ow + orow * LD + d0 * 32) = cvtpk(v, vn); } }
    __syncthreads();
#undef RESC
#undef KBASE
#undef LDMASK
#undef INIT
#undef SEAM_K0
#undef HALF_STEP
}
#undef ROWU
#undef VMW
#undef VMWN
#undef SLOAD_H
#undef SWRITE_HK
#undef SWRITE_HV
#undef SWRITE_H
#undef KSWZ
#undef SBAR
}

__device__ __forceinline__ dsa::BlockRef dsa_ref(const Frame& F, int bh, int qb) {
    const int b = bh >> 4, h = bh & 15;
    dsa::BlockRef r;
    r.Q = F.slot(4) + ((size_t)b * 2048 + (size_t)qb * 256) * 2048 + h * 128;
    r.O = F.slot(3) + ((size_t)b * 2048 + (size_t)qb * 256) * 2048 + h * 128;
    r.K = F.slot(1) + (size_t)b * 2048 * 2048 + h * 128; r.V = F.slot(2) + (size_t)b * 2048 * 2048 + h * 128;
    r.M = (const unsigned*)(F.ws + WS_MASK) + ((size_t)b * 2048 + (size_t)qb * 256) * 64;
    r.P0 = qb * 256; r.h = h;
    return r;
}
__device__ __forceinline__ void ph6_attn(const Frame& F) {
    const Args& a = *F.a;
    char* lds = (char*)F.lds;
    {
        float* bt = (float*)(lds + dsa::OFF_BIAS);
        for (int i = F.wave * 64 + F.lane(); i < 16 * 128; i += 512) { const int h = i >> 7, d = i & 127; bt[i] = (a.in[10][t5_bucket(d) * 16 + h] - a.in[10][31 * 16 + h]) * (1.0f / dsa::SCALE); }
    }
    __syncthreads();
    const int total = 4 * 128;
    int L = F.bid; if (L >= total) return;
#define ATT_BH(L_) (((L_) >> 8) * 64 + ((L_) & 7) * 8 + ((((L_) & 255) >> 3) >> 2))
#define ATT_PR(L_) ((((L_) & 255) >> 3) & 3)
    int pass = 0;
    const bool xmap = (F.G == 256);
    dsa::BlockRef cur = dsa_ref(F, xmap ? ATT_BH(L) : (L >> 2), xmap ? ATT_PR(L) : (L & 3));
    dsa::Seam S;
    dsa::prime(cur, lds, S, F.wave);
    for (;;) {
        const bool more_pass = pass == 0, more_item = L + F.G < total, last = !more_pass && !more_item;
        int passn = pass + 1, Ln = L;
        if (!more_pass) { passn = 0; Ln = more_item ? L + F.G : L; }
        const int bhn = xmap ? ATT_BH(Ln) : (Ln >> 2), prn = xmap ? ATT_PR(Ln) : (Ln & 3);
        const dsa::BlockRef nxt = last ? cur : dsa_ref(F, bhn, passn ? 7 - prn : prn);
        dsa::block(cur, nxt, lds, S, F.wave);
        if (last) break;
        cur = nxt; pass = passn; L = Ln;
    }
}

__device__ __forceinline__ void ln_row(float* zrow, const float* g, const float* bta, bf16* brow, int lane) {
    f32x4 v[8]; float s = 0.f;
#pragma unroll
    for (int i = 0; i < 8; ++i) { v[i] = *(const f32x4*)(zrow + 256 * i + 4 * lane); s += (v[i].x + v[i].y) + (v[i].z + v[i].w); }
    const float mu = wave_sum(s) * (1.0f / 2048.0f); float s2 = 0.f;
#pragma unroll
    for (int i = 0; i < 8; ++i) { v[i] = v[i] - mu; s2 += (v[i].x * v[i].x + v[i].y * v[i].y) + (v[i].z * v[i].z + v[i].w * v[i].w); }
    const float r = rsqrtf(wave_sum(s2) * (1.0f / 2048.0f) + 1e-5f);
#pragma unroll
    for (int i = 0; i < 8; ++i) { const f32x4 gg = *(const f32x4*)(g + 256 * i + 4 * lane), bb = *(const f32x4*)(bta + 256 * i + 4 * lane);
        const f32x4 o = v[i] * r * gg + bb; *(f32x4*)(zrow + 256 * i + 4 * lane) = o;
        if (brow) { u32x2 w; w.x = pk2(o.x, o.y); w.y = pk2(o.z, o.w); *(u32x2*)(brow + 256 * i + 4 * lane) = w; } }
}
__device__ __forceinline__ void ph_ln(const Frame& F, const float* g, const float* bta, bf16* bout) {
    const int gw = F.bid * 8 + F.wave, NGW = F.G * 8, lane = F.lane();
    for (int row = gw; row < T; row += NGW) ln_row(F.a->out + (size_t)row * 2048, g, bta, bout + (size_t)row * 2048, lane);
}

__device__ __forceinline__ float pk_idx(float v, unsigned code, unsigned mask) { return __uint_as_float((__float_as_uint(v) & ~mask) | code); }
__device__ __forceinline__ void ph_peer_select(const Frame& F) {
    const Args& a = *F.a;
    const int lane = F.lane(), l31 = lane & 31, half = lane >> 5;
    const float* PQ = (const float*)F.slot(1); const float* keys = a.in[23];
    int* EIDX = (int*)(F.ws + WS_CKV); float* EG = (float*)(F.ws + WS_IKW);
    const float NEG = -__builtin_inff();
    const int h = F.bid & 7, ntw = F.G >> 3;
    { const int tid = F.wave * 64 + lane;
#pragma unroll
      for (int p = 0; p < 2; ++p)
#pragma unroll
          for (int i = 0; i < 8; ++i) { const int idx = tid + 512 * i, row = idx >> 5, c4 = idx & 31;
              *(f32x4*)(F.lds + (size_t)p * 67584 + ((size_t)row * 132 + 4 * c4) * 4) = *(const f32x4*)(keys + ((size_t)(2 * h + p) * 128 + row) * 128 + 4 * c4); }
      __syncthreads(); }
    for (int tile = (F.bid >> 3) + ntw * F.wave; tile < T / 32; tile += ntw * 8) {
        const int t = tile * 32 + l31;
        float tv[2][16];
#pragma unroll
        for (int p = 0; p < 2; ++p) {
            const int g = 2 * h + p;
            float qv[64];
            { const float* qp = PQ + (size_t)t * 2048 + g * 128 + 64 * half;
#pragma unroll
              for (int j = 0; j < 16; ++j) { const f32x4 v = *(const f32x4*)(qp + 4 * j); qv[4 * j] = v.x; qv[4 * j + 1] = v.y; qv[4 * j + 2] = v.z; qv[4 * j + 3] = v.w; } }
            f32x16 acc[4];
#pragma unroll
            for (int mt = 0; mt < 4; ++mt)
#pragma unroll
                for (int r = 0; r < 16; ++r) acc[mt][r] = 0.f;
            const float* kp0 = (const float*)(F.lds + (size_t)p * 67584) + ((size_t)l31 * 132 + 64 * half);
            f32x4 kb[3][4];
#define PK_LOADC(cc) do { _Pragma("unroll") for (int u_ = 0; u_ < 4; ++u_) kb[(cc) % 3][u_] = *(const f32x4*)(kp0 + (size_t)((cc) >> 2) * 32 * 132 + 16 * ((cc) & 3) + 4 * u_); } while (0)
#define PK_MMAC(cc) do { _Pragma("unroll") for (int u_ = 0; u_ < 4; ++u_) { const f32x4 kv_ = kb[(cc) % 3][u_]; const int j_ = 4 * ((cc) & 3) + u_; \
                acc[(cc) >> 2] = __builtin_amdgcn_mfma_f32_32x32x2f32(kv_.x, qv[4 * j_], acc[(cc) >> 2], 0, 0, 0); acc[(cc) >> 2] = __builtin_amdgcn_mfma_f32_32x32x2f32(kv_.y, qv[4 * j_ + 1], acc[(cc) >> 2], 0, 0, 0); \
                acc[(cc) >> 2] = __builtin_amdgcn_mfma_f32_32x32x2f32(kv_.z, qv[4 * j_ + 2], acc[(cc) >> 2], 0, 0, 0); acc[(cc) >> 2] = __builtin_amdgcn_mfma_f32_32x32x2f32(kv_.w, qv[4 * j_ + 3], acc[(cc) >> 2], 0, 0, 0); } } while (0)
            PK_LOADC(0); PK_LOADC(1);
            PK_LOADC(2); PK_MMAC(0); __builtin_amdgcn_sched_barrier(0);
            PK_LOADC(3); PK_MMAC(1); __builtin_amdgcn_sched_barrier(0);
            PK_LOADC(4); PK_MMAC(2); __builtin_amdgcn_sched_barrier(0);
            PK_LOADC(5); PK_MMAC(3); __builtin_amdgcn_sched_barrier(0);
            PK_LOADC(6); PK_MMAC(4); __builtin_amdgcn_sched_barrier(0);
            PK_LOADC(7); PK_MMAC(5); __builtin_amdgcn_sched_barrier(0);
            PK_LOADC(8); PK_MMAC(6); __builtin_amdgcn_sched_barrier(0);
            PK_LOADC(9); PK_MMAC(7); __builtin_amdgcn_sched_barrier(0);
            PK_LOADC(10); PK_MMAC(8); __builtin_amdgcn_sched_barrier(0);
            PK_LOADC(11); PK_MMAC(9); __builtin_amdgcn_sched_barrier(0);
            PK_LOADC(12); PK_MMAC(10); __builtin_amdgcn_sched_barrier(0);
            PK_LOADC(13); PK_MMAC(11); __builtin_amdgcn_sched_barrier(0);
            PK_LOADC(14); PK_MMAC(12); __builtin_amdgcn_sched_barrier(0);
            PK_LOADC(15); PK_MMAC(13); __builtin_amdgcn_sched_barrier(0);
            PK_MMAC(14); __builtin_amdgcn_sched_barrier(0);
            PK_MMAC(15); __builtin_amdgcn_sched_barrier(0);
#undef PK_LOADC
#undef PK_MMAC
            unsigned hmask = ~(4u * (unsigned)half); asm volatile("" : "+v"(hmask));
#pragma unroll
            for (int mt = 0; mt < 4; ++mt)
#pragma unroll
                for (int r = 0; r < 16; ++r) acc[mt][r] = __uint_as_float(((__float_as_uint(acc[mt][r]) & ~127u) | (unsigned)(127 - (32 * mt + (r & 3) + 8 * (r >> 2)))) & hmask);
#pragma unroll
            for (int k = 0; k < 16; ++k) {
                float m = acc[0][0];
#pragma unroll
                for (int mt = 0; mt < 4; ++mt)
#pragma unroll
                    for (int r = 0; r < 16; ++r) m = fmaxf(m, acc[mt][r]);
                m = fmaxf(m, __shfl_xor(m, 32));
                tv[p][k] = m;
#pragma unroll
                for (int mt = 0; mt < 4; ++mt)
#pragma unroll
                    for (int r = 0; r < 16; ++r) acc[mt][r] = (acc[mt][r] == m) ? NEG : acc[mt][r];
            }
        }
        float cand[25]; int cid[25];
        unsigned hc = 25u * (unsigned)half; asm volatile("" : "+v"(hc));
        { const float ai = half ? tv[0][2] : tv[0][0], bj = half ? tv[1][1] : tv[1][0];
          cand[0] = pk_idx(ai + bj, (unsigned)(63 - 0) - hc, 63u); cid[0] = (int)((127u - (__float_as_uint(ai) & 127u)) * 128u + (127u - (__float_as_uint(bj) & 127u))); }
        { const float ai = half ? tv[0][2] : tv[0][0], bj = half ? tv[1][2] : tv[1][1];
          cand[1] = pk_idx(ai + bj, (unsigned)(63 - 1) - hc, 63u); cid[1] = (int)((127u - (__float_as_uint(ai) & 127u)) * 128u + (127u - (__float_as_uint(bj) & 127u))); }
        { const float ai = half ? tv[0][2] : tv[0][0], bj = half ? tv[1][3] : tv[1][2];
          cand[2] = pk_idx(ai + bj, (unsigned)(63 - 2) - hc, 63u); cid[2] = (int)((127u - (__float_as_uint(ai) & 127u)) * 128u + (127u - (__float_as_uint(bj) & 127u))); }
        { const float ai = half ? tv[0][2] : tv[0][0], bj = half ? tv[1][4] : tv[1][3];
          cand[3] = pk_idx(ai + bj, (unsigned)(63 - 3) - hc, 63u); cid[3] = (int)((127u - (__float_as_uint(ai) & 127u)) * 128u + (127u - (__float_as_uint(bj) & 127u))); }
        { const float ai = half ? tv[0][3] : tv[0][0], bj = half ? tv[1][0] : tv[1][4];
          cand[4] = pk_idx(ai + bj, (unsigned)(63 - 4) - hc, 63u); cid[4] = (int)((127u - (__float_as_uint(ai) & 127u)) * 128u + (127u - (__float_as_uint(bj) & 127u))); }
        { const float ai = half ? tv[0][3] : tv[0][0], bj = half ? tv[1][1] : tv[1][5];
          cand[5] = pk_idx(ai + bj, (unsigned)(63 - 5) - hc, 63u); cid[5] = (int)((127u - (__float_as_uint(ai) & 127u)) * 128u + (127u - (__float_as_uint(bj) & 127u))); }
        { const float ai = half ? tv[0][3] : tv[0][0], bj = half ? tv[1][2] : tv[1][6];
          cand[6] = pk_idx(ai + bj, (unsigned)(63 - 6) - hc, 63u); cid[6] = (int)((127u - (__float_as_uint(ai) & 127u)) * 128u + (127u - (__float_as_uint(bj) & 127u))); }
        { const float ai = half ? tv[0][3] : tv[0][0], bj = half ? tv[1][3] : tv[1][7];
          cand[7] = pk_idx(ai + bj, (unsigned)(63 - 7) - hc, 63u); cid[7] = (int)((127u - (__float_as_uint(ai) & 127u)) * 128u + (127u - (__float_as_uint(bj) & 127u))); }
        { const float ai = half ? tv[0][4] : tv[0][0], bj = half ? tv[1][0] : tv[1][8];
          cand[8] = pk_idx(ai + bj, (unsigned)(63 - 8) - hc, 63u); cid[8] = (int)((127u - (__float_as_uint(ai) & 127u)) * 128u + (127u - (__float_as_uint(bj) & 127u))); }
        { const float ai = half ? tv[0][4] : tv[0][0], bj = half ? tv[1][1] : tv[1][9];
          cand[9] = pk_idx(ai + bj, (unsigned)(63 - 9) - hc, 63u); cid[9] = (int)((127u - (__float_as_uint(ai) & 127u)) * 128u + (127u - (__float_as_uint(bj) & 127u))); }
        { const float ai = half ? tv[0][4] : tv[0][0], bj = half ? tv[1][2] : tv[1][10];
          cand[10] = pk_idx(ai + bj, (unsigned)(63 - 10) - hc, 63u); cid[10] = (int)((127u - (__float_as_uint(ai) & 127u)) * 128u + (127u - (__float_as_uint(bj) & 127u))); }
        { const float ai = half ? tv[0][5] : tv[0][0], bj = half ? tv[1][0] : tv[1][11];
          cand[11] = pk_idx(ai + bj, (unsigned)(63 - 11) - hc, 63u); cid[11] = (int)((127u - (__float_as_uint(ai) & 127u)) * 128u + (127u - (__float_as_uint(bj) & 127u))); }
        { const float ai = half ? tv[0][5] : tv[0][0], bj = half ? tv[1][1] : tv[1][12];
          cand[12] = pk_idx(ai + bj, (unsigned)(63 - 12) - hc, 63u); cid[12] = (int)((127u - (__float_as_uint(ai) & 127u)) * 128u + (127u - (__float_as_uint(bj) & 127u))); }
        { const float ai = half ? tv[0][6] : tv[0][0], bj = half ? tv[1][0] : tv[1][13];
          cand[13] = pk_idx(ai + bj, (unsigned)(63 - 13) - hc, 63u); cid[13] = (int)((127u - (__float_as_uint(ai) & 127u)) * 128u + (127u - (__float_as_uint(bj) & 127u))); }
        { const float ai = half ? tv[0][6] : tv[0][0], bj = half ? tv[1][1] : tv[1][14];
          cand[14] = pk_idx(ai + bj, (unsigned)(63 - 14) - hc, 63u); cid[14] = (int)((127u - (__float_as_uint(ai) & 127u)) * 128u + (127u - (__float_as_uint(bj) & 127u))); }
        { const float ai = half ? tv[0][7] : tv[0][0], bj = half ? tv[1][0] : tv[1][15];
          cand[15] = pk_idx(ai + bj, (unsigned)(63 - 15) - hc, 63u); cid[15] = (int)((127u - (__float_as_uint(ai) & 127u)) * 128u + (127u - (__float_as_uint(bj) & 127u))); }
        { const float ai = half ? tv[0][7] : tv[0][1], bj = half ? tv[1][1] : tv[1][0];
          cand[16] = pk_idx(ai + bj, (unsigned)(63 - 16) - hc, 63u); cid[16] = (int)((127u - (__float_as_uint(ai) & 127u)) * 128u + (127u - (__float_as_uint(bj) & 127u))); }
        { const float ai = half ? tv[0][8] : tv[0][1], bj = half ? tv[1][0] : tv[1][1];
          cand[17] = pk_idx(ai + bj, (unsigned)(63 - 17) - hc, 63u); cid[17] = (int)((127u - (__float_as_uint(ai) & 127u)) * 128u + (127u - (__float_as_uint(bj) & 127u))); }
        { const float ai = half ? tv[0][9] : tv[0][1], bj = half ? tv[1][0] : tv[1][2];
          cand[18] = pk_idx(ai + bj, (unsigned)(63 - 18) - hc, 63u); cid[18] = (int)((127u - (__float_as_uint(ai) & 127u)) * 128u + (127u - (__float_as_uint(bj) & 127u))); }
        { const float ai = half ? tv[0][10] : tv[0][1], bj = half ? tv[1][0] : tv[1][3];
          cand[19] = pk_idx(ai + bj, (unsigned)(63 - 19) - hc, 63u); cid[19] = (int)((127u - (__float_as_uint(ai) & 127u)) * 128u + (127u - (__float_as_uint(bj) & 127u))); }
        { const float ai = half ? tv[0][11] : tv[0][1], bj = half ? tv[1][0] : tv[1][4];
          cand[20] = pk_idx(ai + bj, (unsigned)(63 - 20) - hc, 63u); cid[20] = (int)((127u - (__float_as_uint(ai) & 127u)) * 128u + (127u - (__float_as_uint(bj) & 127u))); }
        { const float ai = half ? tv[0][12] : tv[0][1], bj = half ? tv[1][0] : tv[1][5];
          cand[21] = pk_idx(ai + bj, (unsigned)(63 - 21) - hc, 63u); cid[21] = (int)((127u - (__float_as_uint(ai) & 127u)) * 128u + (127u - (__float_as_uint(bj) & 127u))); }
        { const float ai = half ? tv[0][13] : tv[0][1], bj = half ? tv[1][0] : tv[1][6];
          cand[22] = pk_idx(ai + bj, (unsigned)(63 - 22) - hc, 63u); cid[22] = (int)((127u - (__float_as_uint(ai) & 127u)) * 128u + (127u - (__float_as_uint(bj) & 127u))); }
        { const float ai = half ? tv[0][14] : tv[0][1], bj = half ? tv[1][0] : tv[1][7];
          cand[23] = pk_idx(ai + bj, (unsigned)(63 - 23) - hc, 63u); cid[23] = (int)((127u - (__float_as_uint(ai) & 127u)) * 128u + (127u - (__float_as_uint(bj) & 127u))); }
        { const float ai = half ? tv[0][15] : tv[0][2], bj = half ? tv[1][0] : tv[1][0];
          cand[24] = pk_idx(ai + bj, (unsigned)(63 - 24) - hc, 63u); cid[24] = (int)((127u - (__float_as_uint(ai) & 127u)) * 128u + (127u - (__float_as_uint(bj) & 127u))); }
        float sv[16]; int sid[16];
#pragma unroll
        for (int k = 0; k < 16; ++k) {
            float m = cand[0];
#pragma unroll
            for (int c = 1; c < 25; ++c) m = fmaxf(m, cand[c]);
            const float mo = __shfl_xor(m, 32);
            const bool mine = (m > mo) || (m == mo && half == 0);
            const float mm = fmaxf(m, mo);
            int id = -1;
#pragma unroll
            for (int c = 0; c < 25; ++c) { const bool hit = mine && (cand[c] == mm); id = hit ? cid[c] : id; cand[c] = hit ? NEG : cand[c]; }
            const int ido = __shfl_xor(id, 32);
            sv[k] = mm; sid[k] = id > ido ? id : ido;
        }
        float den = 0.f; float ev[16];
#pragma unroll
        for (int k = 0; k < 16; ++k) { ev[k] = expf(sv[k] - sv[0]); den += ev[k]; }
        const float inv = 1.0f / den;
        if (half == 0) { int* ep = EIDX + (size_t)t * 128 + h * 16;
#pragma unroll
            for (int k = 0; k < 16; k += 4) *(u32x4*)(ep + k) = (u32x4){(unsigned)sid[k], (unsigned)sid[k + 1], (unsigned)sid[k + 2], (unsigned)sid[k + 3]}; }
        else { float* gp = EG + (size_t)t * 128 + h * 16;
#pragma unroll
            for (int k = 0; k < 16; k += 4) *(f32x4*)(gp + k) = (f32x4){ev[k] * inv, ev[k + 1] * inv, ev[k + 2] * inv, ev[k + 3] * inv}; }
    }
}

typedef float f32x2 __attribute__((ext_vector_type(2)));
constexpr float PU_SCALE = 1024.0f, PV_SCALE = 32.0f;
#define RL(v, l) __builtin_amdgcn_readlane((v), (l))
#define EXR 4
#define EX_LOAD(buf, tab, idv, e) do { _Pragma("unroll") for (int r_ = 0; r_ < EXR; ++r_) { const unsigned char* rp_ = (tab) + (size_t)RL(idv, ((e) & 63) + r_) * 2048 + 16 * lane; \
        buf[r_][0] = *(const u32x4*)rp_; buf[r_][1] = *(const u32x4*)(rp_ + 1024); } } while (0)
#define EX_W4(acc_, w_, xp_) do { const f32x2 l_ = __builtin_amdgcn_cvt_pk_f32_fp8((int)(w_), false), h_ = __builtin_amdgcn_cvt_pk_f32_fp8((int)(w_), true); \
        acc_ += l_.x * (xp_)[0] + l_.y * (xp_)[1]; acc_ += h_.x * (xp_)[2] + h_.y * (xp_)[3]; } while (0)
#define EX_DOT(buf, e) do { float d_[EXR]; _Pragma("unroll") for (int r_ = 0; r_ < EXR; ++r_) { float a_ = 0.f, b_ = 0.f; \
        _Pragma("unroll") for (int c_ = 0; c_ < 2; ++c_) { EX_W4(a_, buf[r_][c_].x, &xf[c_][0]); EX_W4(b_, buf[r_][c_].y, &xf[c_][4]); EX_W4(a_, buf[r_][c_].z, &xf[c_][8]); EX_W4(b_, buf[r_][c_].w, &xf[c_][12]); } d_[r_] = a_ + b_; } \
        _Pragma("unroll") for (int o_ = 32; o_ >= 1; o_ >>= 1) { _Pragma("unroll") for (int r_ = 0; r_ < EXR; ++r_) d_[r_] += __shfl_xor(d_[r_], o_); } \
        _Pragma("unroll") for (int r_ = 0; r_ < EXR; ++r_) { const float pre_ = d_[r_] * (1.0f / PU_SCALE); const float hv_ = 0.5f * pre_ * (1.0f + erff(pre_ * 0.7071067811865476f)); \
            if (lane == (((e) & 63) + r_)) { if ((e) < 64) c0 = g0 * hv_; else c1 = g1 * hv_; } } } while (0)
#define EX_A4(w_, yp_, cf_) do { const f32x2 l_ = __builtin_amdgcn_cvt_pk_f32_fp8((int)(w_), false), h_ = __builtin_amdgcn_cvt_pk_f32_fp8((int)(w_), true); \
        (yp_)[0] += (cf_) * l_.x; (yp_)[1] += (cf_) * l_.y; (yp_)[2] += (cf_) * h_.x; (yp_)[3] += (cf_) * h_.y; } while (0)
#define EX_AXPY(buf, e) do { const float cv_ = (e) < 64 ? c0 : c1; _Pragma("unroll") for (int r_ = 0; r_ < EXR; ++r_) { const float cf_ = __int_as_float(RL(__float_as_int(cv_), ((e) & 63) + r_)) * (1.0f / PV_SCALE); \
        _Pragma("unroll") for (int c_ = 0; c_ < 2; ++c_) { EX_A4(buf[r_][c_].x, &y[c_][0], cf_); EX_A4(buf[r_][c_].y, &y[c_][4], cf_); EX_A4(buf[r_][c_].z, &y[c_][8], cf_); EX_A4(buf[r_][c_].w, &y[c_][12], cf_); } } } while (0)
__device__ __forceinline__ void cvt_fp8_stream(const Frame& F, const float* src, unsigned char* dst, size_t n16, float scale) {
    const size_t gt = (size_t)F.bid * 512 + F.wave * 64 + F.lane(), NT = (size_t)F.G * 512;
#pragma unroll 2
    for (size_t i = gt; i < n16; i += NT) { const f32x4 a = ((const f32x4*)src)[4 * i] * scale, b = ((const f32x4*)src)[4 * i + 1] * scale, c = ((const f32x4*)src)[4 * i + 2] * scale, d = ((const f32x4*)src)[4 * i + 3] * scale;
        int w0 = 0, w1 = 0, w2 = 0, w3 = 0;
        w0 = __builtin_amdgcn_cvt_pk_fp8_f32(a.x, a.y, w0, false); w0 = __builtin_amdgcn_cvt_pk_fp8_f32(a.z, a.w, w0, true);
        w1 = __builtin_amdgcn_cvt_pk_fp8_f32(b.x, b.y, w1, false); w1 = __builtin_amdgcn_cvt_pk_fp8_f32(b.z, b.w, w1, true);
        w2 = __builtin_amdgcn_cvt_pk_fp8_f32(c.x, c.y, w2, false); w2 = __builtin_amdgcn_cvt_pk_fp8_f32(c.z, c.w, w2, true);
        w3 = __builtin_amdgcn_cvt_pk_fp8_f32(d.x, d.y, w3, false); w3 = __builtin_amdgcn_cvt_pk_fp8_f32(d.z, d.w, w3, true);
        ((u32x4*)dst)[i] = (u32x4){(unsigned)w0, (unsigned)w1, (unsigned)w2, (unsigned)w3}; }
}
__device__ __forceinline__ void ph16_experts(const Frame& F) {
    const Args& a = *F.a;
    const int gw = F.bid * 8 + F.wave, NGW = F.G * 8, lane = F.lane();
    const int* EIDX = (const int*)(F.ws + WS_CKV); const float* EG = (const float*)(F.ws + WS_IKW);
    const unsigned char* PU = (const unsigned char*)F.slot(5); const unsigned char* PV = PU + (size_t)32 * MiB;
    for (int t = gw; t < T; t += NGW) {
        float* xrow = a.out + (size_t)t * 2048;
        float xf[2][16];
        { float mu, rs; row_mu_rstd((const float*)(F.ws + WS_CTL + CTL_ST2), t, mu, rs);
          const bf16* zr = F.slot(0) + (size_t)t * 2048;
#pragma unroll
          for (int c = 0; c < 2; ++c)
#pragma unroll
              for (int q = 0; q < 2; ++q) { const int col = 1024 * c + 16 * lane + 8 * q; f32x4 z0, z1; unpack8v(*(const u32x4*)(zr + col), z0, z1);
                  const f32x4 g0 = *(const f32x4*)(a.in[20] + col), g1 = *(const f32x4*)(a.in[20] + col + 4), b0 = *(const f32x4*)(a.in[21] + col), b1 = *(const f32x4*)(a.in[21] + col + 4);
                  const f32x4 h0 = (z0 - mu) * rs * g0 + b0, h1 = (z1 - mu) * rs * g1 + b1;
                  xf[c][8 * q] = h0.x; xf[c][8 * q + 1] = h0.y; xf[c][8 * q + 2] = h0.z; xf[c][8 * q + 3] = h0.w; xf[c][8 * q + 4] = h1.x; xf[c][8 * q + 5] = h1.y; xf[c][8 * q + 6] = h1.z; xf[c][8 * q + 7] = h1.w; } }
        const int id0 = EIDX[(size_t)t * 128 + lane], id1 = EIDX[(size_t)t * 128 + 64 + lane];
        const float g0 = EG[(size_t)t * 128 + lane], g1 = EG[(size_t)t * 128 + 64 + lane];
        float c0 = 0.f, c1 = 0.f;
        u32x4 bA[EXR][2], bB[EXR][2];
        EX_LOAD(bA, PU, id0, 0);
        for (int e = 0; e < 128; e += 2 * EXR) {
            const int idv = e < 64 ? id0 : id1;
            EX_LOAD(bB, PU, idv, e + EXR);
            EX_DOT(bA, e);
            if (e + 2 * EXR < 128) { const int idn = (e + 2 * EXR) < 64 ? id0 : id1; EX_LOAD(bA, PU, idn, e + 2 * EXR); }
            EX_DOT(bB, e + EXR);
        }
        float y[2][16];
#pragma unroll
        for (int c = 0; c < 2; ++c)
#pragma unroll
            for (int j = 0; j < 16; ++j) y[c][j] = 0.f;
        EX_LOAD(bA, PV, id0, 0);
        for (int e = 0; e < 128; e += 2 * EXR) {
            const int idv = e < 64 ? id0 : id1;
            EX_LOAD(bB, PV, idv, e + EXR);
            EX_AXPY(bA, e);
            if (e + 2 * EXR < 128) { const int idn = (e + 2 * EXR) < 64 ? id0 : id1; EX_LOAD(bA, PV, idn, e + 2 * EXR); }
            EX_AXPY(bB, e + EXR);
        }
        float s = 0.f;
#pragma unroll
        for (int c = 0; c < 2; ++c)
#pragma unroll
            for (int j = 0; j < 16; ++j) { y[c][j] += ALPHA * xf[c][j]; s += y[c][j]; }
        const float mu = wave_sum(s) * (1.0f / 2048.0f); float s2 = 0.f;
#pragma unroll
        for (int c = 0; c < 2; ++c)
#pragma unroll
            for (int j = 0; j < 16; ++j) { y[c][j] -= mu; s2 += y[c][j] * y[c][j]; }
        const float rs = rsqrtf(wave_sum(s2) * (1.0f / 2048.0f) + 1e-5f);
        int lofs = 16 * lane; asm volatile("" : "+v"(lofs));
#pragma unroll
        for (int c = 0; c < 2; ++c)
#pragma unroll
            for (int q = 0; q < 4; ++q) { const int col = 1024 * c + lofs + 4 * q;
                const f32x4 ga = *(const f32x4*)(a.in[26] + col), ba = *(const f32x4*)(a.in[27] + col);
                f32x4 o; o.x = y[c][4 * q] * rs * ga.x + ba.x; o.y = y[c][4 * q + 1] * rs * ga.y + ba.y; o.z = y[c][4 * q + 2] * rs * ga.z + ba.z; o.w = y[c][4 * q + 3] * rs * ga.w + ba.w;
                *(f32x4*)(xrow + col) = o; }
    }
}

#define XB_TMO      128
#define XB_XCNT(j)  (256  + 64 * (j))
#define XB_XSUB(j)  (1280 + 64 * (j))
#define XB_XGEN(j)  (2304 + 64 * (j))
#define XB_TOP      3328
#define XB_TOPGEN   3392
#define XCD_BAR_WORDS 3456
#define XB_SPIN_CAP (1u << 22)
__device__ __forceinline__ unsigned xb_ld(unsigned* p)              { return __hip_atomic_load(p, __ATOMIC_RELAXED, __HIP_MEMORY_SCOPE_AGENT); }
__device__ __forceinline__ unsigned xb_add(unsigned* p, unsigned v) { return __hip_atomic_fetch_add(p, v, __ATOMIC_RELAXED, __HIP_MEMORY_SCOPE_AGENT); }
__device__ __forceinline__ unsigned xb_xcc_id() { return (unsigned)__builtin_amdgcn_s_getreg((3 << 11) | 20) & 0xFu; }
#define XB_SPIN(cond, bar) do { unsigned _sp = 0; while (cond) { __builtin_amdgcn_s_sleep(1); \
    if ((++_sp & 255u) == 0u) { if (xb_ld(&(bar)[XB_TMO])) break; if (_sp > XB_SPIN_CAP) { atomicAdd(&(bar)[XB_TMO], 1u); break; } } } } while (0)
struct XcdBarrier { unsigned* bar; unsigned x; volatile unsigned* st; };
__device__ __forceinline__ void xcd_barrier_complete(unsigned* bar, unsigned x, unsigned G, unsigned& nloc, unsigned& nx) {
    unsigned sum, cnt, mine, sp = 0u;
    for (;;) {
        sum = 0u; cnt = 0u; mine = 0u;
#pragma unroll
        for (unsigned j = 0; j < 16; ++j) { const unsigned c = xb_ld(&bar[XB_XCNT(j)]); sum += c; cnt += (c > 0u) ? 1u : 0u; mine = (j == x) ? c : mine; }
        if (sum == G) break;
        __builtin_amdgcn_s_sleep(1);
        if ((++sp & 255u) == 0u) { if (xb_ld(&bar[XB_TMO])) break; if (sp > XB_SPIN_CAP) { atomicAdd(&bar[XB_TMO], 1u); break; } }
    }
    nloc = mine > 0u ? mine : 1u; nx = cnt > 0u ? cnt : 1u;
}
__device__ __forceinline__ void xcd_barrier(const XcdBarrier& b, bool leader, unsigned G) {
    asm volatile("s_waitcnt vmcnt(0)" ::: "memory");
    __syncthreads();
    if (leader) {
        unsigned* bar = b.bar;
        __builtin_amdgcn_s_waitcnt(0);
        unsigned nloc = b.st[0], nx = b.st[1];
        if (nloc == 0u) { xcd_barrier_complete(bar, b.x, G, nloc, nx); b.st[0] = nloc; b.st[1] = nx; }
        const unsigned old = xb_add(&bar[XB_XSUB(b.x)], 1u);
        const unsigned gen = old / nloc;
        if (old + 1u == (gen + 1u) * nloc) {
            __builtin_amdgcn_fence(__ATOMIC_RELEASE, "agent");
            asm volatile("s_waitcnt vmcnt(0)" ::: "memory");
            const unsigned og = xb_add(&bar[XB_TOP], 1u);
            const unsigned tg = og / nx;
            if (og + 1u == (tg + 1u) * nx) xb_add(&bar[XB_TOPGEN], 1u);
            else XB_SPIN(xb_ld(&bar[XB_TOPGEN]) == tg, bar);
            __builtin_amdgcn_fence(__ATOMIC_ACQUIRE, "agent");
            xb_add(&bar[XB_XGEN(b.x)], 1u);
            asm volatile("s_waitcnt vmcnt(0)" ::: "memory");
        } else {
            XB_SPIN(xb_ld(&bar[XB_XGEN(b.x)]) == gen, bar);
            __builtin_amdgcn_fence(__ATOMIC_ACQUIRE, "agent");
            asm volatile("s_waitcnt vmcnt(0)" ::: "memory");
        }
    }
    __syncthreads();
}

__device__ __forceinline__ void sub_barrier(unsigned* ctr, unsigned n, bool leader) {
    asm volatile("s_waitcnt vmcnt(0)" ::: "memory");
    __syncthreads();
    if (leader) {
        __builtin_amdgcn_fence(__ATOMIC_RELEASE, "agent");
        asm volatile("s_waitcnt vmcnt(0)" ::: "memory");
        (void)xb_add(ctr, 1u);
        unsigned sp = 0u; while (xb_ld(ctr) < n) { __builtin_amdgcn_s_sleep(1); if (++sp > XB_SPIN_CAP) break; }
        __builtin_amdgcn_fence(__ATOMIC_ACQUIRE, "agent");
        asm volatile("s_waitcnt vmcnt(0)" ::: "memory");
    }
    __syncthreads();
}

__global__ void __launch_bounds__(512, 2) mega(Args args) {
    extern __shared__ __attribute__((aligned(16))) unsigned char lds[];
    cg::grid_group grid = cg::this_grid();
    Frame F;
    F.lds = lds; F.wave = __builtin_amdgcn_readfirstlane(threadIdx.x >> 6); F.bid = blockIdx.x; F.G = gridDim.x;
    F.a = &args; F.ws = args.ws;
    const int lo = args.ph_lo, hi = args.ph_hi;
    unsigned long long sec_acc = 0ull;
    if (lo < 0) grid.sync();
    volatile unsigned* xst = (volatile unsigned*)(lds + LDS_BYTES - 64);
    const bool leader = (F.wave == 0) && (fresh_lane() == 0);
    if (leader) { xst[0] = 0u; xst[1] = 0u; }
    XcdBarrier xbar; xbar.bar = (unsigned*)(F.ws + WS_CTL + CTL_BAR); xbar.x = xb_xcc_id(); xbar.st = xst;
    if (leader) (void)xb_add(&xbar.bar[XB_XCNT(xbar.x)], 1u);
    __syncthreads();
    bf16* W8 = (bf16*)((unsigned char*)args.out + (size_t)64 * MiB);
#define IN(k) (lo <= (k) && (k) < hi)
#if PROBE_MASK
    unsigned long long pr_acc = 0ull, pr_t0 = rt_now();
#define SEAM(k) do { if (IN(k) && IN((k) + 1)) { xcd_barrier(xbar, (F.wave == 0) && (fresh_lane() == 0), (unsigned)F.G); } { const unsigned long long t1_ = rt_now(); if ((PROBE_MASK >> (k)) & 1u) pr_acc += t1_ - pr_t0; pr_t0 = t1_; } } while (0)
#else
#define SEAM(k) do { if (IN(k) && IN((k) + 1)) { xcd_barrier(xbar, (F.wave == 0) && (fresh_lane() == 0), (unsigned)F.G); } } while (0)
#endif
    if (IN(0)) { ph0_prologue(F); } SEAM(0);
    if (IN(1)) { gemm(F, (const bf16*)args.out, 2048, (const bf16*)(F.ws + WS_WIN), 2048, T, NCOLS, 2048, OpProj{F.ws}); w8_transposes(F, W8); } SEAM(1);
    if (IN(2)) {
        if (F.G == 256) {
            if (F.bid < 128) hgrn_chunked(F, F.bid, sec_acc);
            else { ph2_side(F, F.bid - 128, 128); sub_barrier((unsigned*)(F.ws + WS_CTL + CTL_BAR) + 3520, 128u, (F.wave == 0) && (fresh_lane() == 0)); ph5_select(F, F.bid - 128, 128); }
        } else {
            for (int u = F.bid; u < 128; u += F.G) hgrn_chunked(F, u, sec_acc);
            ph2_side(F, F.bid, F.G);
            xcd_barrier(xbar, (F.wave == 0) && (fresh_lane() == 0), (unsigned)F.G);
            ph5_select(F, F.bid, F.G);
        }
    } SEAM(2);
    if (IN(4)) {
        gemm(F, (const bf16*)(F.ws + WS_CKV), 256, (const bf16*)(F.ws + WS_WKV), 256, T, 4096, 256, OpSplit2{F.slot(1), F.slot(2)});
    } SEAM(4);
    if (IN(6)) { ph6_attn(F); } SEAM(6);
    if (IN(7)) {
        pg8::Gemm g{2048, 4096, 4096}; pg8::MultiOrder<1> S; S.s[0] = pg8::Sub{F.slot(0), W8, 64, 8}; S.lda = 2048; S.ldb = 4096; S.G = F.G; S.c = F.bid; S.A2 = F.slot(3);
        EpiYAB E{F.slot(6), F.slot(7)};
        pg8::gemm_phase<EpiYAB, pg8::MultiOrder<1>, true, true>((PG8_LAS unsigned char*)F.lds, g, S, E, F.wave, F.lane());
    } SEAM(7);
    if (IN(8)) { gemm_epi(F, F.slot(6), 2048, W8 + (size_t)2 * 2048 * 2048, 2048, T, 2048, 2048, EpiMixStats{args.in[0], F.slot(0), (float*)(F.ws + WS_CTL + CTL_ST1)}); } SEAM(8);
    if (IN(10)) {
        pg8::MultiOrder<3> S; S.lda = 2048; S.ldb = 2048; S.G = F.G; S.c = F.bid;
        S.s[0] = pg8::Sub{F.slot(0), W8 + (size_t)3 * 2048 * 2048, 64, 8};
        S.s[1] = pg8::Sub{(const bf16*)(F.ws + WS_MEMB), W8 + (size_t)4 * 2048 * 2048, 8, 8};
        S.s[2] = pg8::Sub{W8 + (size_t)5 * 2048 * 2048, (const bf16*)(F.ws + WS_MEMB), 8, 8};
        gemm_multi<3>(F, S, 2048, OpCQKV{F.slot(1), (bf16*)(F.ws + WS_CKV), (bf16*)(F.ws + WS_IKW), (float*)(F.ws + WS_CTL + CTL_ST1), (float*)(F.ws + WS_CTL + CTL_CVEC), (float*)(F.ws + WS_CTL + CTL_CVEC) + 2048});
    } SEAM(10);
    if (IN(11)) {
        pg8::BatchOrder<OffS> S{F.slot(1), (const bf16*)(F.ws + WS_CKV), 8, 1, 32, 2048, 2048, F.G, F.bid, OffS()};
        gemm_batch(F, S, 512, OpLogit{(float*)F.slot(2)});
    } SEAM(11);
    if (IN(12)) { ph_xsoftmax(F, (const float*)F.slot(2), F.slot(3));
        cvt_fp8_stream(F, args.in[24], (unsigned char*)F.slot(5), (size_t)16384 * 2048 / 16, PU_SCALE); cvt_fp8_stream(F, args.in[25], (unsigned char*)F.slot(5) + (size_t)32 * MiB, (size_t)16384 * 2048 / 16, PV_SCALE); } SEAM(12);
    if (IN(13)) {
        pg8::BatchOrder<OffPV> S{F.slot(3), (const bf16*)(F.ws + WS_IKW), 8, 2, 32, 1024, 2048, F.G, F.bid, OffPV()};
        gemm_batch(F, S, 256, OpCO{F.slot(4)});
    } SEAM(13);
    if (IN(14)) { gemm_epi(F, F.slot(4), 2048, W8 + (size_t)6 * 2048 * 2048, 2048, T, 2048, 2048, EpiCOStats{F.slot(0), (float*)(F.ws + WS_CTL + CTL_ST1), (float*)(F.ws + WS_CTL + CTL_ST2), args.in[14], args.in[15]}); } SEAM(14);
    if (IN(16)) { gemm(F, F.slot(0), 2048, W8 + (size_t)7 * 2048 * 2048, 2048, T, 2048, 2048, OpPQFold{(float*)F.slot(1), (float*)(F.ws + WS_CTL + CTL_ST2), (float*)(F.ws + WS_CTL + CTL_CVEC) + 4096, (float*)(F.ws + WS_CTL + CTL_CVEC) + 6144}); } SEAM(16);
    if (IN(17)) { ph_peer_select(F); } SEAM(17);
    if (IN(18)) { ph16_experts(F); }
#if PROBE_MASK
    xcd_barrier(xbar, (F.wave == 0) && (fresh_lane() == 0), (unsigned)F.G);
    { const unsigned long long t1_ = rt_now(); if ((PROBE_MASK >> 18) & 1u) pr_acc += t1_ - pr_t0; pr_acc += sec_acc;
      if (F.bid == 0 && threadIdx.x == 0) { const unsigned long long ts_ = rt_now(); while (rt_now() - ts_ < pr_acc) __builtin_amdgcn_s_sleep(8); } }
#endif
#undef IN
#undef SEAM
}

extern "C" void kernel_launch(void* const* d_in, const int* in_sizes, int n_in, void* d_out, int out_size, void* d_ws, size_t ws_size, hipStream_t stream) {
    static int grid = 0;
    if (grid == 0) {
        if (n_in != 28 || out_size != T * D || ws_size < WS_END) { fprintf(stderr, "kernel_launch: unexpected shapes (n_in %d out %d ws %zu)\n", n_in, out_size, ws_size); grid = -1; return; }
        int dev = 0, cus = 0, per_cu = 0;
        hipGetDevice(&dev); hipDeviceGetAttribute(&cus, hipDeviceAttributeMultiprocessorCount, dev);
        hipFuncSetAttribute((const void*)mega, hipFuncAttributeMaxDynamicSharedMemorySize, LDS_BYTES);
        hipOccupancyMaxActiveBlocksPerMultiprocessor(&per_cu, (const void*)mega, 512, LDS_BYTES);
        if (per_cu < 1) { fprintf(stderr, "kernel_launch: occupancy query says %d blocks per CU\n", per_cu); per_cu = 1; }
        (void)hipGetLastError();
        grid = cus;
    }
    if (grid < 0) return;
    (void)hipMemsetAsync((char*)d_ws + WS_CTL, 0, CTL_ZERO, stream);
    Args a{};
    for (int i = 0; i < 28; ++i) a.in[i] = (const float*)d_in[i];
    a.out = (float*)d_out; a.ws = (unsigned char*)d_ws;
#if ONE_LAUNCH
    a.ph_lo = 0; a.ph_hi = NPH;
    void* params[] = {&a};
    hipError_t e = hipLaunchCooperativeKernel((const void*)mega, dim3(grid), dim3(512), params, LDS_BYTES, stream);
    if (e != hipSuccess) fprintf(stderr, "cooperative launch failed: %s\n", hipGetErrorString(e));
#else
    for (int ph = 0; ph < NPH; ++ph) {
        a.ph_lo = ph; a.ph_hi = ph + 1;
        void* params[] = {&a};
        hipError_t e = hipLaunchCooperativeKernel((const void*)mega, dim3(grid), dim3(512), params, LDS_BYTES, stream);
        if (e != hipSuccess) { fprintf(stderr, "launch %d failed: %s\n", ph, hipGetErrorString(e)); break; }
    }
#endif
}
```

```cpp
#include <hip/hip_runtime.h>
#include <hip/hip_cooperative_groups.h>
#include <cstdint>
#include <cmath>
#include <cstdio>
namespace cg = cooperative_groups;

#ifndef ONE_LAUNCH
#define ONE_LAUNCH 1
#endif
#ifndef PROBE_MASK
#define PROBE_MASK 0u
#endif
#ifndef PROBE_SEC
#define PROBE_SEC 0
#endif

typedef unsigned short bf16;
typedef short bf16x8 __attribute__((ext_vector_type(8)));
typedef float f32x4 __attribute__((ext_vector_type(4)));
typedef float f32x16 __attribute__((ext_vector_type(16)));
typedef unsigned u32x4 __attribute__((ext_vector_type(4)));
typedef unsigned u32x2 __attribute__((ext_vector_type(2)));
typedef float f32x2v __attribute__((ext_vector_type(2)));

constexpr int T = 16384, D = 2048, SEQ = 2048, NB = 8;
constexpr int NCOLS = 16896;
constexpr float ALPHA = 1.189207115002721f;
constexpr int NPH = 19;

constexpr size_t MiB = 1u << 20;
constexpr size_t WS_CTL = 0, WS_MEMB = 1 * MiB, WS_WKV = 9 * MiB, WS_LB = 11 * MiB, WS_MASK = 12 * MiB, WS_WIN = 17 * MiB,
                 WS_SLOT = 83 * MiB, SLOT_BYTES = 64 * MiB, WS_CKV = 595 * MiB, WS_IKW = 603 * MiB, WS_END = 611 * MiB;
constexpr int LDS_BYTES = 157696;
constexpr size_t CTL_BAR = 16384, CTL_CVEC = 65536, CTL_ST1 = 262144, CTL_ST2 = 393216, CTL_ZERO = 524288;

struct Args {
    const float* in[28];
    float* out;
    unsigned char* ws;
    int ph_lo, ph_hi;
};

#define WAVE_SYNC() asm volatile("s_waitcnt lgkmcnt(0)" ::: "memory")

__device__ __forceinline__ unsigned f2bf(float f) { unsigned u = __float_as_uint(f); return (u + 0x7fffu + ((u >> 16) & 1u)) >> 16; }
__device__ __forceinline__ unsigned pk2(float lo, float hi) { return f2bf(lo) | (f2bf(hi) << 16); }
__device__ __forceinline__ float bf2f(unsigned h) { return __uint_as_float(h << 16); }
__device__ __forceinline__ float bflo(unsigned w) { return __uint_as_float(w << 16); }
__device__ __forceinline__ float bfhi(unsigned w) { return __uint_as_float(w & 0xffff0000u); }
__device__ __forceinline__ float wave_sum(float v) {
#pragma unroll
    for (int o = 32; o >= 1; o >>= 1) v += __shfl_xor(v, o);
    return v;
}
__device__ __forceinline__ float wave_max(float v) {
#pragma unroll
    for (int o = 32; o >= 1; o >>= 1) v = fmaxf(v, __shfl_xor(v, o));
    return v;
}
__device__ __forceinline__ float row16_sum(float v) {
    v += __int_as_float(__builtin_amdgcn_mov_dpp(__float_as_int(v), 0xB1, 0xF, 0xF, false));
    v += __int_as_float(__builtin_amdgcn_mov_dpp(__float_as_int(v), 0x4E, 0xF, 0xF, false));
    v += __int_as_float(__builtin_amdgcn_mov_dpp(__float_as_int(v), 0x124, 0xF, 0xF, false));
    v += __int_as_float(__builtin_amdgcn_mov_dpp(__float_as_int(v), 0x128, 0xF, 0xF, false));
    return v;
}
__device__ __forceinline__ float wave_sum_dpp(float v) {
    v = row16_sum(v);
    return (__int_as_float(__builtin_amdgcn_readlane(__float_as_int(v), 0)) + __int_as_float(__builtin_amdgcn_readlane(__float_as_int(v), 16)))
         + (__int_as_float(__builtin_amdgcn_readlane(__float_as_int(v), 32)) + __int_as_float(__builtin_amdgcn_readlane(__float_as_int(v), 48)));
}
__device__ __forceinline__ float sigm(float x) { return 1.0f / (1.0f + expf(-x)); }
__device__ __forceinline__ void unpack8(u32x4 w, float* f) {
    f[0] = bflo(w.x); f[1] = bfhi(w.x); f[2] = bflo(w.y); f[3] = bfhi(w.y); f[4] = bflo(w.z); f[5] = bfhi(w.z); f[6] = bflo(w.w); f[7] = bfhi(w.w);
}

__device__ __forceinline__ int fresh_lane() { int l; asm volatile("v_mbcnt_lo_u32_b32 %0, -1, 0\n\tv_mbcnt_hi_u32_b32 %0, -1, %0" : "=v"(l)); return l; }
__device__ __forceinline__ unsigned long long rt_now() { unsigned long long t; asm volatile("s_memrealtime %0\n\ts_waitcnt lgkmcnt(0)" : "=s"(t) :: "memory"); return t; }
struct Frame {
    unsigned char* lds;
    int wave, bid, G;
    __device__ __forceinline__ int lane() const { return fresh_lane(); }
    const Args* a;
    unsigned char* ws;
    __device__ __forceinline__ bf16* slot(int i) const { return (bf16*)(ws + WS_SLOT + (size_t)i * SLOT_BYTES); }
};

namespace pg8 {
#define PG8_LAS __attribute__((address_space(3)))
constexpr int BM = 256, BK = 64, HALF = 128, HTB = HALF * BK * 2, STAGE_BYTES = 8 * HTB, NXCD = 8, WGM = 8;
__host__ __device__ __forceinline__ int lds_byte(int r, int c) { const int st = (r >> 4) * 2 + (c >> 5), rr = r & 15, cc = c & 31, ob = rr * 64 + cc * 2; return st * 1024 + (ob ^ (((ob >> 9) & 1) << 5)); }
__host__ __device__ __forceinline__ void stage_rc(int b, int& R, int& C) { const int st = b / 1024, sb = b % 1024, swz = sb ^ (((sb >> 9) & 1) << 5); R = (st >> 1) * 16 + swz / 64; C = (st & 1) * 32 + (swz % 64) / 2; }
__host__ __device__ __forceinline__ int perm32(int rho) { const int n = rho >> 4, i = rho & 15; return 8 * (i >> 2) + 4 * n + (i & 3); }
struct Unit { int pm, pn, z; const char* a; const char* b; const char* a2; };
struct Gemm { int lda, ldb, K; };
__device__ __forceinline__ void tile_of(int wgid, int nM, int nN, int& pm, int& pn) {
    const int nwg = nM * nN; { const int q = nwg / NXCD, r = nwg % NXCD, xcd = wgid % NXCD, off = wgid / NXCD; wgid = (xcd < r ? xcd * (q + 1) : r * (q + 1) + (xcd - r) * q) + off; }
    const int nig = WGM * nN, gid = wgid / nig, fm = gid * WGM, gsz = (nM - fm) < WGM ? (nM - fm) : WGM;
    pm = fm + ((wgid % nig) % gsz); pn = (wgid % nig) / gsz;
}
struct Sub { const bf16* A; const bf16* Bt; int nM, nN; };
template <int NS> struct MultiOrder {
    Sub s[NS]; int lda, ldb, G, c; const bf16* A2 = nullptr;
    __device__ __forceinline__ bool next(int i, Unit& u) const {
        int L = i * G + c;
#pragma unroll
        for (int k = 0; k < NS; ++k) { const int n = s[k].nM * s[k].nN;
            if (L < n) { tile_of(L, s[k].nM, s[k].nN, u.pm, u.pn); u.z = k; u.a = (const char*)(s[k].A + (size_t)u.pm * BM * lda); u.b = (const char*)(s[k].Bt + (size_t)u.pn * BM * ldb); u.a2 = A2 ? (const char*)(A2 + (size_t)u.pm * BM * lda) : nullptr; return true; }
            L -= n; }
        return false;
    }
};
template <class Off> struct BatchOrder {
    const bf16* A; const bf16* Bt; int nM, nN, nz, lda, ldb, G, c; Off off;
    __device__ __forceinline__ bool next(int i, Unit& u) const {
        const int L = i * G + c, per = nM * nN; if (L >= per * nz) return false;
        u.z = L / per; const int r = L % per; u.pn = r / nM; u.pm = r % nM;
        u.a = (const char*)(A + off.a(u.z) + (size_t)u.pm * BM * lda); u.b = (const char*)(Bt + off.b(u.z) + (size_t)u.pn * BM * ldb); u.a2 = nullptr; return true;
    }
};
__device__ __forceinline__ unsigned cvt_pk_bf16(float lo, float hi) { unsigned r; asm volatile("v_cvt_pk_bf16_f32 %0, %1, %2" : "=v"(r) : "v"(lo), "v"(hi)); return r; }

template <class Op> struct Epi8 {
    static constexpr bool PERM = true;
    Op op;
    __device__ __forceinline__ void operator()(const f32x4 (&acc)[2][2][4][2], const Unit& u, int wr, int wc, int fr, int fq) const {
        const int row0 = u.pm * BM + wr * 64 + fr, col0 = u.pn * BM + wc * 32 + 8 * fq;
        if constexpr (Op::NLD == 0) {
#pragma unroll
            for (int ai = 0; ai < 2; ++ai)
#pragma unroll
                for (int m = 0; m < 4; ++m)
#pragma unroll
                    for (int bj = 0; bj < 2; ++bj) op(u.z, row0 + ai * HALF + m * 16, col0 + bj * HALF, acc[ai][bj][m][0], acc[ai][bj][m][1]);
        } else {
#pragma unroll
            for (int ai = 0; ai < 2; ++ai) {
                u32x4 tmp[4][2][Op::NLD];
#pragma unroll
                for (int m = 0; m < 4; ++m)
#pragma unroll
                    for (int bj = 0; bj < 2; ++bj) op.ld(u.z, row0 + ai * HALF + m * 16, col0 + bj * HALF, tmp[m][bj]);
#pragma unroll
                for (int m = 0; m < 4; ++m)
#pragma unroll
                    for (int bj = 0; bj < 2; ++bj) op.ap(u.z, row0 + ai * HALF + m * 16, col0 + bj * HALF, acc[ai][bj][m][0], acc[ai][bj][m][1], tmp[m][bj]);
            }
        }
    }
};

template <class Epi, class Sched, bool ALIGN_EPI, bool SPLIT = false>
__device__ __forceinline__ void gemm_phase(PG8_LAS unsigned char* lds, const Gemm g, const Sched& S, const Epi& E, int wid, int lane) {
    const int tid = wid * 64 + lane, wr = wid >> 2, wc = wid & 3, fr = lane & 15, fq = lane >> 4;
    const int K = g.K, nt = K / BK;
    unsigned voffA[2], voffB[2];
#pragma unroll
    for (int i = 0; i < 2; ++i) { int R, C; stage_rc(tid * 16 + i * 8192, R, C); const int Rb = Epi::PERM ? ((R & ~31) + perm32(R & 31)) : R;
        voffA[i] = (unsigned)(R * g.lda + C) * 2u; voffB[i] = (unsigned)(Rb * g.ldb + C) * 2u; }
    const size_t kstep = (size_t)(BK * 2);
    const size_t hstepA = (size_t)HALF * g.lda * 2, hstepB = (size_t)HALF * g.ldb * 2;
    const unsigned ldsw = (unsigned)wid * 1024u;
    const int aoff = lds_byte(wr * 64 + fr, fq * 8), boff = lds_byte(wc * 32 + fr, fq * 8);
#define PG8_SA(b, h) (((b) * 2 + (h)) * HTB)
#define PG8_SB(b, h) ((4 + (b) * 2 + (h)) * HTB)
#define PG8_STAGE(bufoff, gbase, voff) do { _Pragma("unroll") for (int _i = 0; _i < 2; ++_i) \
        __builtin_amdgcn_global_load_lds((const unsigned*)((const char*)(gbase) + (voff)[_i]), (PG8_LAS unsigned*)(lds + (bufoff) + ldsw + _i * 8192), 16, 0, 0); } while (0)
#define PG8_LDA(dst, b, h) do { _Pragma("unroll") for (int m = 0; m < 4; ++m) _Pragma("unroll") for (int k = 0; k < 2; ++k) dst[m][k] = *(const PG8_LAS bf16x8*)(lds + PG8_SA(b, h) + aoff + m * 2048 + k * 1024); } while (0)
#define PG8_LDB(dst, b, h) do { _Pragma("unroll") for (int n = 0; n < 2; ++n) _Pragma("unroll") for (int k = 0; k < 2; ++k) dst[n][k] = *(const PG8_LAS bf16x8*)(lds + PG8_SB(b, h) + boff + n * 2048 + k * 1024); } while (0)
#define PG8_MMA(ai, bj, At, Bt) do { __builtin_amdgcn_s_setprio(1); _Pragma("unroll") for (int m = 0; m < 4; ++m) _Pragma("unroll") for (int n = 0; n < 2; ++n) _Pragma("unroll") for (int k = 0; k < 2; ++k) \
        acc[ai][bj][m][n] = __builtin_amdgcn_mfma_f32_16x16x32_bf16(Bt[n][k], At[m][k], acc[ai][bj][m][n], 0, 0, 0); __builtin_amdgcn_s_setprio(0); } while (0)
#define PG8_WAIT_V(n) asm volatile("s_waitcnt vmcnt(" #n ")" ::: "memory")
#define PG8_WAIT_L(n) asm volatile("s_waitcnt lgkmcnt(" #n ")" ::: "memory")
#define PG8_BAR __builtin_amdgcn_s_barrier()
#define PG8_SCHED __builtin_amdgcn_sched_barrier(0)
    Unit cur, nxt; int ui = 0;
    if (!S.next(0, cur)) return;
    f32x4 acc[2][2][4][2];
#pragma unroll
    for (int a = 0; a < 2; ++a)
#pragma unroll
        for (int b = 0; b < 2; ++b)
#pragma unroll
            for (int m = 0; m < 4; ++m)
#pragma unroll
                for (int n = 0; n < 2; ++n) acc[a][b][m][n] = (f32x4){0.f, 0.f, 0.f, 0.f};
    bf16x8 At[4][2], B0[2][2], B1[2][2];
    const char* cA = cur.a; const char* cB = cur.b;
    const int nth = nt / 2;
    const char* cA2 = SPLIT ? cur.a2 - (size_t)nth * kstep : cA;
    PG8_STAGE(PG8_SB(0, 0), cB, voffB); PG8_STAGE(PG8_SB(0, 1), cB + hstepB, voffB); PG8_STAGE(PG8_SA(0, 0), cA, voffA); PG8_STAGE(PG8_SA(0, 1), cA + hstepA, voffA);
    if (wr == 1) PG8_BAR;
    PG8_WAIT_V(2); PG8_BAR;
    PG8_STAGE(PG8_SB(1, 0), cB + kstep, voffB); PG8_STAGE(PG8_SA(1, 0), cA + kstep, voffA); PG8_STAGE(PG8_SB(1, 1), cB + hstepB + kstep, voffB);
    PG8_WAIT_V(6); PG8_BAR;
    for (;;) {
        const bool has_next = S.next(ui + 1, nxt);
        const char* nA = has_next ? nxt.a : cA; const char* nB = has_next ? nxt.b : cB;
        const char* nA2 = SPLIT ? (has_next ? nxt.a2 - (size_t)nth * kstep : cA2) : nA;
#pragma unroll 1
        for (int half_ = 0; half_ < (SPLIT ? 2 : 1); ++half_) {
        if constexpr (SPLIT) { if (half_ == 1) { __builtin_amdgcn_sched_barrier(0); E.mid(acc, cur, wr, wc, fr, fq); __builtin_amdgcn_sched_barrier(0); } }
        const int t_lo = SPLIT ? half_ * nth : 0, t_hi = SPLIT ? (half_ + 1) * nth : nt;
#pragma unroll 1
        for (int t = t_lo; t < t_hi; t += 2) {
            const bool last = (t == nt - 2);
            const char* bA1 = (!SPLIT || t < nth) ? cA : cA2; const char* bA2 = (!SPLIT || t + 2 < nth) ? cA : cA2;
            const char* a1 = bA1 + (size_t)(t + 1) * kstep;
            const char* a2 = last ? nA : bA2 + (size_t)(t + 2) * kstep; const char* b2 = last ? nB : cB + (size_t)(t + 2) * kstep;
            const char* a3 = a2 + kstep; const char* b3 = b2 + kstep;
            PG8_LDB(B0, 0, 0); PG8_LDB(B1, 0, 1); PG8_SCHED; PG8_LDA(At, 0, 0); PG8_STAGE(PG8_SA(1, 1), a1 + hstepA, voffA);
            PG8_WAIT_V(8); PG8_WAIT_L(0); PG8_BAR; PG8_MMA(0, 0, At, B0); PG8_MMA(0, 1, At, B1); PG8_BAR; PG8_SCHED;
            PG8_LDA(At, 0, 1); PG8_STAGE(PG8_SB(0, 0), b2, voffB); PG8_STAGE(PG8_SB(0, 1), b2 + hstepB, voffB); PG8_STAGE(PG8_SA(0, 0), a2, voffA);
            PG8_WAIT_V(8); PG8_WAIT_L(0); PG8_BAR; PG8_MMA(1, 0, At, B0); PG8_MMA(1, 1, At, B1); PG8_BAR; PG8_SCHED;
            PG8_LDB(B0, 1, 0); PG8_LDB(B1, 1, 1); PG8_SCHED; PG8_LDA(At, 1, 0); PG8_STAGE(PG8_SA(0, 1), a2 + hstepA, voffA);
            PG8_WAIT_V(8); PG8_WAIT_L(0); PG8_BAR; PG8_MMA(0, 0, At, B0); PG8_MMA(0, 1, At, B1); PG8_BAR; PG8_SCHED;
            PG8_LDA(At, 1, 1); PG8_STAGE(PG8_SB(1, 0), b3, voffB); PG8_STAGE(PG8_SB(1, 1), b3 + hstepB, voffB); PG8_STAGE(PG8_SA(1, 0), a3, voffA);
            PG8_WAIT_V(8); PG8_WAIT_L(0); PG8_BAR; PG8_MMA(1, 0, At, B0); PG8_MMA(1, 1, At, B1); PG8_BAR; PG8_SCHED;
        }
        }
        if constexpr (ALIGN_EPI) { if (wr == 0) PG8_BAR; }
        E(acc, cur, wr, wc, fr, fq);
        if (!has_next) break;
#pragma unroll
        for (int a = 0; a < 2; ++a)
#pragma unroll
            for (int b = 0; b < 2; ++b)
#pragma unroll
                for (int m = 0; m < 4; ++m)
#pragma unroll
                    for (int n = 0; n < 2; ++n) acc[a][b][m][n] = (f32x4){0.f, 0.f, 0.f, 0.f};
        cur = nxt; cA = nA; cB = nB; cA2 = nA2; ++ui;
        if constexpr (ALIGN_EPI) { if (wr == 1) PG8_BAR; }
    }
    PG8_WAIT_V(0);
    if constexpr (!ALIGN_EPI) { if (wr == 0) PG8_BAR; }
    PG8_BAR;
#undef PG8_SA
#undef PG8_SB
#undef PG8_STAGE
#undef PG8_LDA
#undef PG8_LDB
#undef PG8_MMA
#undef PG8_WAIT_V
#undef PG8_WAIT_L
#undef PG8_BAR
#undef PG8_SCHED
}
}

__device__ __forceinline__ u32x4 pack8(f32x4 a, f32x4 b) { u32x4 w; w.x = pg8::cvt_pk_bf16(a.x, a.y); w.y = pg8::cvt_pk_bf16(a.z, a.w); w.z = pg8::cvt_pk_bf16(b.x, b.y); w.w = pg8::cvt_pk_bf16(b.z, b.w); return w; }
__device__ __forceinline__ void unpack8v(u32x4 w, f32x4& a, f32x4& b) { a.x = bflo(w.x); a.y = bfhi(w.x); a.z = bflo(w.y); a.w = bfhi(w.y); b.x = bflo(w.z); b.y = bfhi(w.z); b.z = bflo(w.w); b.w = bfhi(w.w); }
__device__ __forceinline__ f32x4 sigm4(f32x4 v) { f32x4 r; r.x = sigm(v.x); r.y = sigm(v.y); r.z = sigm(v.z); r.w = sigm(v.w); return r; }

struct OpProj { static constexpr int NLD = 0; unsigned char* ws;
    __device__ __forceinline__ void operator()(int z, int row, int col, f32x4 a, f32x4 b) const {
        bf16* p;
        if (col < 16384) p = (bf16*)(ws + WS_SLOT + (size_t)(col >> 11) * SLOT_BYTES) + (size_t)row * 2048 + (col & 2047);
        else if (col < 16640) p = (bf16*)(ws + WS_CKV) + (size_t)row * 256 + (col - 16384);
        else p = (bf16*)(ws + WS_IKW) + (size_t)row * 256 + (col - 16640);
        *(u32x4*)p = pack8(a, b);
    } };
struct OpBf16 { static constexpr int NLD = 0; bf16* o; int ld;
    __device__ __forceinline__ void operator()(int z, int row, int col, f32x4 a, f32x4 b) const { *(u32x4*)(o + (size_t)row * ld + col) = pack8(a, b); } };
struct OpSplit2 { static constexpr int NLD = 0; bf16* o0; bf16* o1;
    __device__ __forceinline__ void operator()(int z, int row, int col, f32x4 a, f32x4 b) const { bf16* p = (col < 2048 ? o0 : o1) + (size_t)row * 2048 + (col & 2047); *(u32x4*)p = pack8(a, b); } };
struct OpF32 { static constexpr int NLD = 0; float* o; int ld;
    __device__ __forceinline__ void operator()(int z, int row, int col, f32x4 a, f32x4 b) const { float* p = o + (size_t)row * ld + col; *(f32x4*)p = a; *(f32x4*)(p + 4) = b; } };
struct OpYA { static constexpr int NLD = 1; bf16* ga;
    __device__ __forceinline__ void ld(int zi, int row, int col, u32x4* t) const { t[0] = *(const u32x4*)(ga + (size_t)row * 2048 + col); }
    __device__ __forceinline__ void ap(int zi, int row, int col, f32x4 a, f32x4 b, const u32x4* t) const { f32x4 g0, g1; unpack8v(t[0], g0, g1); *(u32x4*)(ga + (size_t)row * 2048 + col) = pack8(sigm4(g0) * a, sigm4(g1) * b); } };
struct OpYB { static constexpr int NLD = 2; bf16* ga; const bf16* gb;
    __device__ __forceinline__ void ld(int zi, int row, int col, u32x4* t) const { const size_t i = (size_t)row * 2048 + col; t[0] = *(const u32x4*)(ga + i); t[1] = *(const u32x4*)(gb + i); }
    __device__ __forceinline__ void ap(int zi, int row, int col, f32x4 a, f32x4 b, const u32x4* t) const { f32x4 m0, m1, g0, g1; unpack8v(t[0], m0, m1); unpack8v(t[1], g0, g1);
        *(u32x4*)(ga + (size_t)row * 2048 + col) = pack8(m0 + sigm4(g0) * a, m1 + sigm4(g1) * b); } };
struct OpMix { static constexpr int NLD = 2; const float* x; float* zo;
    __device__ __forceinline__ void ld(int zi, int row, int col, u32x4* t) const { const size_t i = (size_t)row * 2048 + col; t[0] = *(const u32x4*)(x + i); t[1] = *(const u32x4*)(x + i + 4); }
    __device__ __forceinline__ void ap(int zi, int row, int col, f32x4 a, f32x4 b, const u32x4* t) const { const size_t i = (size_t)row * 2048 + col;
        *(f32x4*)(zo + i) = ALPHA * __builtin_bit_cast(f32x4, t[0]) + a; *(f32x4*)(zo + i + 4) = ALPHA * __builtin_bit_cast(f32x4, t[1]) + b; } };
struct OpRes { static constexpr int NLD = 2; float* zo;
    __device__ __forceinline__ void ld(int zi, int row, int col, u32x4* t) const { const size_t i = (size_t)row * 2048 + col; t[0] = *(const u32x4*)(zo + i); t[1] = *(const u32x4*)(zo + i + 4); }
    __device__ __forceinline__ void ap(int zi, int row, int col, f32x4 a, f32x4 b, const u32x4* t) const { const size_t i = (size_t)row * 2048 + col;
        *(f32x4*)(zo + i) = ALPHA * __builtin_bit_cast(f32x4, t[0]) + a; *(f32x4*)(zo + i + 4) = ALPHA * __builtin_bit_cast(f32x4, t[1]) + b; } };

__device__ __forceinline__ void row_stats_add(float* st, int row, float s1, float s2, int fq) {
    s1 += __shfl_xor(s1, 16); s1 += __shfl_xor(s1, 32); s2 += __shfl_xor(s2, 16); s2 += __shfl_xor(s2, 32);
    if (fq == 0) { atomicAdd(st + 2 * (size_t)row, s1); atomicAdd(st + 2 * (size_t)row + 1, s2); }
}
__device__ __forceinline__ void row_mu_rstd(const float* st, int row, float& mu, float& rstd) {
    const f32x2v p = *(const f32x2v*)(st + 2 * (size_t)row); mu = p.x * (1.0f / 2048.0f); rstd = rsqrtf(fmaxf(p.y * (1.0f / 2048.0f) - mu * mu, 0.f) + 1e-5f);
}
__device__ __forceinline__ float sum8(f32x4 a, f32x4 b) { return ((a.x + a.y) + (a.z + a.w)) + ((b.x + b.y) + (b.z + b.w)); }
__device__ __forceinline__ float sq8(f32x4 a, f32x4 b) { return ((a.x * a.x + a.y * a.y) + (a.z * a.z + a.w * a.w)) + ((b.x * b.x + b.y * b.y) + (b.z * b.z + b.w * b.w)); }
struct EpiMixStats { static constexpr bool PERM = true; const float* x; bf16* zb; float* st;
    __device__ __forceinline__ void operator()(const f32x4 (&acc)[2][2][4][2], const pg8::Unit& u, int wr, int wc, int fr, int fq) const {
        const int row0 = u.pm * 256 + wr * 64 + fr, col0 = u.pn * 256 + wc * 32 + 8 * fq;
#pragma unroll
        for (int ai = 0; ai < 2; ++ai) {
            f32x4 xv[4][2][2];
#pragma unroll
            for (int m = 0; m < 4; ++m)
#pragma unroll
                for (int bj = 0; bj < 2; ++bj) { const float* p = x + (size_t)(row0 + ai * 128 + m * 16) * 2048 + col0 + bj * 128; xv[m][bj][0] = *(const f32x4*)p; xv[m][bj][1] = *(const f32x4*)(p + 4); }
#pragma unroll
            for (int m = 0; m < 4; ++m) { const int row = row0 + ai * 128 + m * 16; float s1 = 0.f, s2 = 0.f;
#pragma unroll
                for (int bj = 0; bj < 2; ++bj) { const f32x4 z0 = ALPHA * xv[m][bj][0] + acc[ai][bj][m][0], z1 = ALPHA * xv[m][bj][1] + acc[ai][bj][m][1];
                    *(u32x4*)(zb + (size_t)row * 2048 + col0 + bj * 128) = pack8(z0, z1); s1 += sum8(z0, z1); s2 += sq8(z0, z1); }
                row_stats_add(st, row, s1, s2, fq); }
        }
    }
};
struct EpiCOStats { static constexpr bool PERM = true; bf16* zb; const float* st1; float* st2; const float* g; const float* bta;
    __device__ __forceinline__ void operator()(const f32x4 (&acc)[2][2][4][2], const pg8::Unit& u, int wr, int wc, int fr, int fq) const {
        const int row0 = u.pm * 256 + wr * 64 + fr, col0 = u.pn * 256 + wc * 32 + 8 * fq;
        f32x4 gv[2][2], bv[2][2];
#pragma unroll
        for (int bj = 0; bj < 2; ++bj) { gv[bj][0] = *(const f32x4*)(g + col0 + bj * 128); gv[bj][1] = *(const f32x4*)(g + col0 + bj * 128 + 4); bv[bj][0] = *(const f32x4*)(bta + col0 + bj * 128); bv[bj][1] = *(const f32x4*)(bta + col0 + bj * 128 + 4); }
#pragma unroll
        for (int ai = 0; ai < 2; ++ai) {
            u32x4 zv[4][2]; float mu[4], rs[4];
#pragma unroll
            for (int m = 0; m < 4; ++m) { const int row = row0 + ai * 128 + m * 16; row_mu_rstd(st1, row, mu[m], rs[m]);
#pragma unroll
                for (int bj = 0; bj < 2; ++bj) zv[m][bj] = *(const u32x4*)(zb + (size_t)row * 2048 + col0 + bj * 128); }
#pragma unroll
            for (int m = 0; m < 4; ++m) { const int row = row0 + ai * 128 + m * 16; float s1 = 0.f, s2 = 0.f;
#pragma unroll
                for (int bj = 0; bj < 2; ++bj) { f32x4 a0, a1; unpack8v(zv[m][bj], a0, a1);
                    const f32x4 z0 = ALPHA * ((a0 - mu[m]) * rs[m] * gv[bj][0] + bv[bj][0]) + acc[ai][bj][m][0], z1 = ALPHA * ((a1 - mu[m]) * rs[m] * gv[bj][1] + bv[bj][1]) + acc[ai][bj][m][1];
                    *(u32x4*)(zb + (size_t)row * 2048 + col0 + bj * 128) = pack8(z0, z1); s1 += sum8(z0, z1); s2 += sq8(z0, z1); }
                row_stats_add(st2, row, s1, s2, fq); }
        }
    }
};
struct EpiYAB { static constexpr bool PERM = true; bf16* ga; const bf16* gb;
    __device__ __forceinline__ void mid(f32x4 (&acc)[2][2][4][2], const pg8::Unit& u, int wr, int wc, int fr, int fq) const {
        int lofs = (wr * 64 + fr) * 2048 + wc * 32 + 8 * fq; asm volatile("" : "+v"(lofs));
        const size_t ub = ((size_t)u.pm * 256) * 2048 + u.pn * 256;
#pragma unroll
        for (int ai = 0; ai < 2; ++ai)
#pragma unroll
            for (int m = 0; m < 4; ++m) { u32x4 av[2], bv[2];
#pragma unroll
                for (int bj = 0; bj < 2; ++bj) { const size_t i = ub + (size_t)(lofs + (ai * 128 + m * 16) * 2048 + bj * 128); av[bj] = *(const u32x4*)(ga + i); bv[bj] = *(const u32x4*)(gb + i); }
#pragma unroll
                for (int bj = 0; bj < 2; ++bj) { f32x4 a0, a1, b0, b1; unpack8v(av[bj], a0, a1); unpack8v(bv[bj], b0, b1);
#pragma unroll
                    for (int e = 0; e < 4; ++e) { acc[ai][bj][m][0][e] *= (1.0f + __expf(-b0[e])) * __builtin_amdgcn_rcpf(1.0f + __expf(-a0[e])); acc[ai][bj][m][1][e] *= (1.0f + __expf(-b1[e])) * __builtin_amdgcn_rcpf(1.0f + __expf(-a1[e])); } } }
    }
    __device__ __forceinline__ void operator()(const f32x4 (&acc)[2][2][4][2], const pg8::Unit& u, int wr, int wc, int fr, int fq) const {
        int lofs = (wr * 64 + fr) * 2048 + wc * 32 + 8 * fq; asm volatile("" : "+v"(lofs));
        const size_t ub = ((size_t)u.pm * 256) * 2048 + u.pn * 256;
#pragma unroll
        for (int ai = 0; ai < 2; ++ai) { u32x4 bv[4][2];
#pragma unroll
            for (int m = 0; m < 4; ++m)
#pragma unroll
                for (int bj = 0; bj < 2; ++bj) bv[m][bj] = *(const u32x4*)(gb + ub + (size_t)(lofs + (ai * 128 + m * 16) * 2048 + bj * 128));
#pragma unroll
            for (int m = 0; m < 4; ++m)
#pragma unroll
                for (int bj = 0; bj < 2; ++bj) { f32x4 b0, b1; unpack8v(bv[m][bj], b0, b1); f32x4 s0, s1;
#pragma unroll
                    for (int e = 0; e < 4; ++e) { s0[e] = __builtin_amdgcn_rcpf(1.0f + __expf(-b0[e])); s1[e] = __builtin_amdgcn_rcpf(1.0f + __expf(-b1[e])); }
                    *(u32x4*)(ga + ub + (size_t)(lofs + (ai * 128 + m * 16) * 2048 + bj * 128)) = pack8(acc[ai][bj][m][0] * s0, acc[ai][bj][m][1] * s1); } }
    }
};
__device__ __forceinline__ void ln_fold8(const float* st, const float* c1, const float* c0, int row, int col, f32x4& a, f32x4& b) {
    float mu, rs; row_mu_rstd(st, row, mu, rs);
    const f32x4 p0 = *(const f32x4*)(c1 + col), p1 = *(const f32x4*)(c1 + col + 4), q0 = *(const f32x4*)(c0 + col), q1 = *(const f32x4*)(c0 + col + 4);
    a = (a - mu * p0) * rs + q0; b = (b - mu * p1) * rs + q1;
}
struct OpPQFold { static constexpr int NLD = 0; float* o; const float* st; const float* c1; const float* c0;
    __device__ __forceinline__ void operator()(int zi, int row, int col, f32x4 a, f32x4 b) const { ln_fold8(st, c1, c0, row, col, a, b); float* p = o + (size_t)row * 2048 + col; *(f32x4*)p = a; *(f32x4*)(p + 4) = b; } };

template <class Op>
__device__ __forceinline__ void gemm(const Frame& F, const bf16* A, int lda, const bf16* Bt, int ldb, int M, int N, int K, const Op& op) {
    pg8::Gemm g{lda, ldb, K}; pg8::MultiOrder<1> S; S.s[0] = pg8::Sub{A, Bt, M / 256, N / 256}; S.lda = lda; S.ldb = ldb; S.G = F.G; S.c = F.bid;
    pg8::Epi8<Op> E{op};
    pg8::gemm_phase<pg8::Epi8<Op>, pg8::MultiOrder<1>, true>((PG8_LAS unsigned char*)F.lds, g, S, E, F.wave, F.lane());
}
template <class Epi>
__device__ __forceinline__ void gemm_epi(const Frame& F, const bf16* A, int lda, const bf16* Bt, int ldb, int M, int N, int K, const Epi& E) {
    pg8::Gemm g{lda, ldb, K}; pg8::MultiOrder<1> S; S.s[0] = pg8::Sub{A, Bt, M / 256, N / 256}; S.lda = lda; S.ldb = ldb; S.G = F.G; S.c = F.bid;
    pg8::gemm_phase<Epi, pg8::MultiOrder<1>, true>((PG8_LAS unsigned char*)F.lds, g, S, E, F.wave, F.lane());
}
template <int NS, class Op>
__device__ __forceinline__ void gemm_multi(const Frame& F, const pg8::MultiOrder<NS>& S, int K, const Op& op) {
    pg8::Gemm g{S.lda, S.ldb, K}; pg8::Epi8<Op> E{op};
    pg8::gemm_phase<pg8::Epi8<Op>, pg8::MultiOrder<NS>, true>((PG8_LAS unsigned char*)F.lds, g, S, E, F.wave, F.lane());
}
template <class Off, class Op>
__device__ __forceinline__ void gemm_batch(const Frame& F, const pg8::BatchOrder<Off>& S, int K, const Op& op) {
    pg8::Gemm g{S.lda, S.ldb, K}; pg8::Epi8<Op> E{op};
    pg8::gemm_phase<pg8::Epi8<Op>, pg8::BatchOrder<Off>, true>((PG8_LAS unsigned char*)F.lds, g, S, E, F.wave, F.lane());
}
struct OffS { __device__ __forceinline__ size_t a(int z) const { return (size_t)(z >> 2) * 2048 * 2048 + (z & 3) * 512; } __device__ __forceinline__ size_t b(int z) const { return (size_t)(z >> 2) * 256 * 2048 + (z & 3) * 512; } };
struct OffPV { __device__ __forceinline__ size_t a(int z) const { return (size_t)(z >> 2) * 2048 * 1024 + (z & 3) * 256; } __device__ __forceinline__ size_t b(int z) const { return (size_t)(z & 3) * 512 * 2048 + (z >> 2) * 256; } };
struct OpLogit { static constexpr int NLD = 0; float* lg;
    __device__ __forceinline__ void operator()(int z, int row, int col, f32x4 a, f32x4 b) const { float* p = lg + ((size_t)(z >> 2) * 2048 + row) * 1024 + (z & 3) * 256 + col; *(f32x4*)p = a * 0.04419417382415922f; *(f32x4*)(p + 4) = b * 0.04419417382415922f; } };
struct OpCO { static constexpr int NLD = 0; bf16* co;
    __device__ __forceinline__ void operator()(int z, int row, int col, f32x4 a, f32x4 b) const { *(u32x4*)(co + ((size_t)(z >> 2) * 2048 + row) * 2048 + (z & 3) * 512 + col) = pack8(a, b); } };
struct OpCQKV { static constexpr int NLD = 0; bf16* cq; bf16* ck; bf16* vt; const float* st; const float* c1; const float* c0;
    __device__ __forceinline__ void operator()(int z, int row, int col, f32x4 a, f32x4 b) const { if (z == 0) ln_fold8(st, c1, c0, row, col, a, b);
        bf16* o = z == 0 ? cq : (z == 1 ? ck : vt); *(u32x4*)(o + (size_t)row * 2048 + col) = pack8(a, b); } };
__device__ __forceinline__ void ph_xsoftmax(const Frame& F, const float* lg, bf16* P) {
    const int gw = F.bid * 8 + F.wave, NGW = F.G * 8, lane = F.lane();
    for (int u = gw; u < T * 4; u += NGW) {
        const f32x4 v = *(const f32x4*)(lg + (size_t)u * 256 + 4 * lane);
        const float m = wave_max(fmaxf(fmaxf(v.x, v.y), fmaxf(v.z, v.w)));
        const float e0 = expf(v.x - m), e1 = expf(v.y - m), e2 = expf(v.z - m), e3 = expf(v.w - m);
        const float inv = 1.0f / wave_sum((e0 + e1) + (e2 + e3));
        u32x2 w; w.x = pk2(e0 * inv, e1 * inv); w.y = pk2(e2 * inv, e3 * inv);
        *(u32x2*)(P + (size_t)u * 256 + 4 * lane) = w;
    }
}

template <class CM>
__device__ __forceinline__ void transpose_item(const float* W, size_t ldw, bf16* WT, size_t ldwt, int row_off, int nblk, int item, float* scr, int lane, const CM& cm) {
    const int kb = item / nblk, nb = item % nblk, k0 = 64 * kb, n0 = 32 * nb;
    const int c = cm(n0 + (lane & 31));
#pragma unroll 8
    for (int i = 0; i < 32; ++i) { const int kk = 2 * i + (lane >> 5); scr[kk * 33 + (lane & 31)] = (c >= 0) ? W[(size_t)(k0 + kk) * ldw + c] : 0.f; }
    WAVE_SYNC();
    const int c8 = lane & 7;
#pragma unroll
    for (int j = 0; j < 4; ++j) { const int n = (lane >> 3) + 8 * j; const float* s = scr + (8 * c8) * 33 + n;
        u32x4 o; o.x = pk2(s[0 * 33], s[1 * 33]); o.y = pk2(s[2 * 33], s[3 * 33]); o.z = pk2(s[4 * 33], s[5 * 33]); o.w = pk2(s[6 * 33], s[7 * 33]);
        *(u32x4*)(WT + (size_t)(row_off + n0 + n) * ldwt + k0 + 8 * c8) = o; }
    WAVE_SYNC();
}
__device__ __forceinline__ void transpose_item_ln(const float* W, bf16* WT, int item, float* scr, int lane, const float* g, const float* bta, float* c1, float* c0) {
    const int kb = item / 64, nb = item % 64, k0 = 64 * kb, n0 = 32 * nb;
#pragma unroll 8
    for (int i = 0; i < 32; ++i) { const int kk = 2 * i + (lane >> 5); scr[kk * 33 + (lane & 31)] = W[(size_t)(k0 + kk) * 2048 + n0 + (lane & 31)]; }
    WAVE_SYNC();
    const int c8 = lane & 7;
    float gk[8], bk[8];
#pragma unroll
    for (int i = 0; i < 8; ++i) { gk[i] = g[k0 + 8 * c8 + i]; bk[i] = bta[k0 + 8 * c8 + i]; }
#pragma unroll
    for (int j = 0; j < 4; ++j) { const int n = (lane >> 3) + 8 * j; const float* sp = scr + (8 * c8) * 33 + n;
        float wv[8]; float p1 = 0.f, p0 = 0.f;
#pragma unroll
        for (int i = 0; i < 8; ++i) { const float v = sp[i * 33]; wv[i] = v * gk[i]; p1 += wv[i]; p0 += v * bk[i]; }
        u32x4 o; o.x = pk2(wv[0], wv[1]); o.y = pk2(wv[2], wv[3]); o.z = pk2(wv[4], wv[5]); o.w = pk2(wv[6], wv[7]);
        *(u32x4*)(WT + (size_t)(n0 + n) * 2048 + k0 + 8 * c8) = o;
        p1 += __shfl_xor(p1, 1); p1 += __shfl_xor(p1, 2); p1 += __shfl_xor(p1, 4); p0 += __shfl_xor(p0, 1); p0 += __shfl_xor(p0, 2); p0 += __shfl_xor(p0, 4);
        if (c8 == 0) { atomicAdd(c1 + n0 + n, p1); atomicAdd(c0 + n0 + n, p0); } }
    WAVE_SYNC();
}
template <class CM>
__device__ __forceinline__ void transpose_item64(const float* W, size_t ldw, bf16* WT, size_t ldwt, int row_off, int nblk, int item, float* scr, int lane, const CM& cm) {
    const int kb = item / nblk, nb = item % nblk, k0 = 64 * kb, n0 = 64 * nb, r = lane >> 4, c4 = lane & 15;
    const int c = cm(n0 + 4 * c4);
    f32x4 v[16];
#pragma unroll
    for (int i = 0; i < 16; ++i) v[i] = (c >= 0) ? *(const f32x4*)(W + (size_t)(k0 + 4 * i + r) * ldw + c) : (f32x4){0.f, 0.f, 0.f, 0.f};
#pragma unroll
    for (int i = 0; i < 16; ++i) *(f32x4*)(scr + (4 * i + r) * 68 + 4 * c4) = v[i];
    WAVE_SYNC();
    bf16* orow = WT + (size_t)(row_off + n0 + lane) * ldwt + k0;
#pragma unroll
    for (int j = 0; j < 8; ++j) { const float* sp = scr + (8 * j) * 68 + lane;
        u32x4 o; o.x = pk2(sp[0], sp[68]); o.y = pk2(sp[2 * 68], sp[3 * 68]); o.z = pk2(sp[4 * 68], sp[5 * 68]); o.w = pk2(sp[6 * 68], sp[7 * 68]);
        *(u32x4*)(orow + 8 * j) = o; }
    WAVE_SYNC();
}
struct CmIdent { __device__ __forceinline__ int operator()(int n) const { return n; } };
struct CmWin { __device__ __forceinline__ int operator()(int n) const {
    if (n < 10240) return n;
    if (n < 12288) return 10496 + (n - 10240);
    if (n < 14336) return 12688 + (n - 12288);
    if (n < 16384) return 14736 + (n - 14336);
    if (n < 16640) return 10240 + (n - 16384);
    if (n < 16768) return 12544 + (n - 16640);
    if (n < 16784) return 12672 + (n - 16768);
    return -1; } };

__device__ __forceinline__ void cvt_bf16_stream(const Frame& F, const float* src, bf16* dst, size_t n8) {
    const size_t gt = (size_t)F.bid * 512 + F.wave * 64 + F.lane(), NT = (size_t)F.G * 512;
#pragma unroll 4
    for (size_t i = gt; i < n8; i += NT) { const f32x4 a = ((const f32x4*)src)[2 * i], b = ((const f32x4*)src)[2 * i + 1];
        u32x4 o; o.x = pk2(a.x, a.y); o.y = pk2(a.z, a.w); o.z = pk2(b.x, b.y); o.w = pk2(b.z, b.w); ((u32x4*)dst)[i] = o; }
}

__device__ __forceinline__ void ph0_prologue(const Frame& F) {
    const Args& a = *F.a;
    cvt_bf16_stream(F, a.in[0], (bf16*)a.out, (size_t)T * D / 8);
    cvt_bf16_stream(F, a.in[1], (bf16*)(F.ws + WS_MEMB), (size_t)2048 * 2048 / 8);
    float* scr = (float*)(F.lds + F.wave * 17408);
    const int gw = F.bid * 8 + F.wave, NGW = F.G * 8, lane = F.lane();
    {
        const int nblk = NCOLS / 64, nitems = (2048 / 64) * nblk;
        float* scr64 = (float*)(F.lds + F.wave * 17408);
        for (int it = gw; it < nitems; it += NGW) transpose_item64(a.in[2], 16784, (bf16*)(F.ws + WS_WIN), 2048, 0, nblk, it, scr64, lane, CmWin());
    }
    {
        for (int it = gw; it < 32 * 16; it += NGW) { const int mat = it >> 4, which = mat >> 4, h = mat & 15;
            transpose_item(a.in[which ? 9 : 8] + (size_t)h * 256 * 128, 128, (bf16*)(F.ws + WS_WKV), 256, which * 2048 + h * 128, 4, it & 15, scr, lane, CmIdent()); }
    }
    {
        const int gt = F.bid * 512 + F.wave * 64 + lane;
        if (gt < 2048) { const float l0 = a.in[3][gt], l1 = a.in[3][2048 + gt]; ((float*)(F.ws + WS_LB))[gt] = 1.0f / (1.0f + expf(l1 - l0)); }
    }
}

namespace hg {
constexpr int QP = 272, TP = 144, AP = 144;
constexpr int OFF_QD = 0, OFF_KD = OFF_QD + 64 * QP, OFF_QG = OFF_KD + 64 * QP, OFF_KET = OFF_QG + 64 * QP, OFF_VT = OFF_KET + 128 * TP, OFF_A = OFF_VT + 128 * TP,
              OFF_TOT = OFF_A + 64 * AP, OFF_DEC = OFF_TOT + 4 * 128 * 4, OFF_PART = OFF_DEC + 128 * 4, OFF_RSTD = OFF_PART + 8 * 64 * 4, END = OFF_RSTD + 64 * 4;
static_assert(END <= 131072, "hgrn LDS map");
}
typedef short bf16x4 __attribute__((ext_vector_type(4)));
#define HSEC_B() do { if (PROBE_SEC) hs_t0 = rt_now(); } while (0)
#define HSEC_E(n) do { if (PROBE_SEC == (n)) sacc += rt_now() - hs_t0; } while (0)
__device__ __forceinline__ void hgrn_chunked(const Frame& F, int unit, unsigned long long& sacc) {
    unsigned long long hs_t0 = 0ull;
    using namespace hg;
    const Args& a = *F.a;
    const int b = unit >> 4, h = unit & 15, lane = F.lane(), w = F.wave, tid = w * 64 + lane, c = tid & 127, rq = tid >> 7, l15 = lane & 15, q4 = lane >> 4;
    unsigned char* L = F.lds;
    const size_t base = (size_t)b * 2048 * 2048 + h * 128;
    const bf16* HQ = F.slot(0) + base; const bf16* HF = F.slot(1) + base; const bf16* HI = F.slot(2) + base; const bf16* HG = F.slot(3) + base; bf16* HO = F.slot(0) + base;
    const float lb = ((const float*)(F.ws + WS_LB))[h * 128 + c];
    const float ng = a.in[4][h * 128 + 16 * w + l15];
    f32x4 S[8];
#pragma unroll
    for (int d = 0; d < 8; ++d) S[d] = (f32x4){0.f, 0.f, 0.f, 0.f};
    unsigned short rq_[16], rf_[16], rv_[16];
#pragma unroll
    for (int k = 0; k < 16; ++k) { const size_t o = (size_t)(16 * rq + k) * 2048 + c; rq_[k] = HQ[o]; rf_[k] = HF[o]; rv_[k] = HI[o]; }
    float* tot = (float*)(L + OFF_TOT); float* dec = (float*)(L + OFF_DEC); float* part = (float*)(L + OFF_PART); float* rstd = (float*)(L + OFF_RSTD);
#pragma unroll 1
    for (int ch = 0; ch < 32; ++ch) {
        const int r0 = ch * 64;
        HSEC_B();
        unsigned short gq[16];
#pragma unroll
        for (int mt = 0; mt < 4; ++mt)
#pragma unroll
            for (int r = 0; r < 4; ++r) gq[4 * mt + r] = HG[(size_t)(r0 + 16 * mt + 4 * q4 + r) * 2048 + 16 * w + l15];
        unsigned short rv2_[16];
        if (ch + 1 < 32) {
#pragma unroll
            for (int k = 0; k < 16; ++k) rv2_[k] = HI[(size_t)(r0 + 64 + 16 * rq + k) * 2048 + c]; }
        float G[16], qf[16], kk[16];
        { float run = 0.f;
#pragma unroll
          for (int k = 0; k < 16; ++k) { const float f = lb + (1.0f - lb) * __builtin_amdgcn_rcpf(1.0f + __expf(-bf2f(rf_[k]))); run += __logf(f); G[k] = run; kk[k] = 1.0f - f; qf[k] = bf2f(rq_[k]); } }
        tot[rq * 128 + c] = G[15];
        if (ch + 1 < 32) {
#pragma unroll
            for (int k = 0; k < 16; ++k) { const size_t o = (size_t)(r0 + 64 + 16 * rq + k) * 2048 + c; rq_[k] = HQ[o]; rf_[k] = HF[o]; } }
        HSEC_E(1); HSEC_B();
        __syncthreads();
        HSEC_E(2); HSEC_B();
        const float t0 = tot[c], t1 = tot[128 + c], t2 = tot[256 + c], t3 = tot[384 + c];
        const float offs = (rq > 0 ? t0 : 0.f) + (rq > 1 ? t1 : 0.f) + (rq > 2 ? t2 : 0.f);
        const float Gref = t0 + t1, Glast = Gref + t2 + t3, eref = __expf(Gref), elr = __expf(Glast - Gref);
        if (rq == 0) dec[c] = __expf(Glast);
        unsigned kew[8], vw[8];
#pragma unroll
        for (int k = 0; k < 16; ++k) {
            const float e1 = __expf(G[k] + offs - Gref), qd = qf[k] * e1, kd = kk[k] * __builtin_amdgcn_rcpf(e1);
            const int row = 16 * rq + k;
            *(bf16*)(L + OFF_QD + row * QP + 2 * c) = (bf16)f2bf(qd);
            *(bf16*)(L + OFF_KD + row * QP + 2 * c) = (bf16)f2bf(kd);
            *(bf16*)(L + OFF_QG + row * QP + 2 * c) = (bf16)f2bf(qd * eref);
            const unsigned ke = f2bf(kd * elr);
            if (k & 1) { kew[k >> 1] |= ke << 16; vw[k >> 1] |= (unsigned)rv_[k] << 16; } else { kew[k >> 1] = ke; vw[k >> 1] = rv_[k]; }
        }
        *(u32x4*)(L + OFF_KET + c * TP + 32 * rq) = (u32x4){kew[0], kew[1], kew[2], kew[3]}; *(u32x4*)(L + OFF_KET + c * TP + 32 * rq + 16) = (u32x4){kew[4], kew[5], kew[6], kew[7]};
        *(u32x4*)(L + OFF_VT + c * TP + 32 * rq) = (u32x4){vw[0], vw[1], vw[2], vw[3]}; *(u32x4*)(L + OFF_VT + c * TP + 32 * rq + 16) = (u32x4){vw[4], vw[5], vw[6], vw[7]};
        if (ch + 1 < 32) {
#pragma unroll
            for (int k = 0; k < 16; ++k) rv_[k] = rv2_[k]; }
        HSEC_E(3); HSEC_B();
        __syncthreads();
        HSEC_E(4); HSEC_B();
        { const int mi = w >> 1;
#pragma unroll
          for (int tt = 0; tt < 2; ++tt) { const int nj = 2 * (w & 1) + tt; f32x4 acc = (f32x4){0.f, 0.f, 0.f, 0.f};
              if (nj <= mi) {
#pragma unroll
                  for (int ks = 0; ks < 4; ++ks) { const bf16x8 aF = *(const bf16x8*)(L + OFF_KD + (16 * nj + l15) * QP + 64 * ks + 16 * q4), bF = *(const bf16x8*)(L + OFF_QD + (16 * mi + l15) * QP + 64 * ks + 16 * q4);
                      acc = __builtin_amdgcn_mfma_f32_16x16x32_bf16(aF, bF, acc, 0, 0, 0); } }
              const int i = 16 * mi + l15, j0 = 16 * nj + 4 * q4;
              const float v0 = (j0 <= i) ? acc.x : 0.f, v1 = (j0 + 1 <= i) ? acc.y : 0.f, v2 = (j0 + 2 <= i) ? acc.z : 0.f, v3 = (j0 + 3 <= i) ? acc.w : 0.f;
              *(u32x2*)(L + OFF_A + i * AP + 2 * j0) = (u32x2){pk2(v0, v1), pk2(v2, v3)}; } }
        __syncthreads();
        HSEC_E(5); HSEC_B();
        bf16x8 bV[2];
#pragma unroll
        for (int ks = 0; ks < 2; ++ks) bV[ks] = *(const bf16x8*)(L + OFF_VT + (16 * w + l15) * TP + 64 * ks + 16 * q4);
        f32x4 O[4];
#pragma unroll
        for (int mt = 0; mt < 4; ++mt) { O[mt] = (f32x4){0.f, 0.f, 0.f, 0.f};
#pragma unroll
            for (int ks = 0; ks < 2; ++ks) { const bf16x8 aF = *(const bf16x8*)(L + OFF_A + (16 * mt + l15) * AP + 64 * ks + 16 * q4); O[mt] = __builtin_amdgcn_mfma_f32_16x16x32_bf16(aF, bV[ks], O[mt], 0, 0, 0); } }
#pragma unroll
        for (int kq = 0; kq < 4; ++kq) {
            u32x4 sw; sw.x = pk2(S[2 * kq].x, S[2 * kq].y); sw.y = pk2(S[2 * kq].z, S[2 * kq].w); sw.z = pk2(S[2 * kq + 1].x, S[2 * kq + 1].y); sw.w = pk2(S[2 * kq + 1].z, S[2 * kq + 1].w);
            const bf16x8 bS = __builtin_bit_cast(bf16x8, sw);
#pragma unroll
            for (int mt = 0; mt < 4; ++mt) { const unsigned char* qp = L + OFF_QG + (16 * mt + l15) * QP + 64 * kq + 8 * q4;
                const u32x2 lo = *(const u32x2*)qp, hi = *(const u32x2*)(qp + 32);
                const bf16x8 aF = __builtin_bit_cast(bf16x8, (u32x4){lo.x, lo.y, hi.x, hi.y});
                O[mt] = __builtin_amdgcn_mfma_f32_16x16x32_bf16(aF, bS, O[mt], 0, 0, 0); } }
#pragma unroll
        for (int dt = 0; dt < 8; ++dt) { const f32x4 dc = *(const f32x4*)(dec + 16 * dt + 4 * q4); S[dt] = S[dt] * dc;
#pragma unroll
            for (int ks = 0; ks < 2; ++ks) { const bf16x8 aF = *(const bf16x8*)(L + OFF_KET + (16 * dt + l15) * TP + 64 * ks + 16 * q4); S[dt] = __builtin_amdgcn_mfma_f32_16x16x32_bf16(aF, bV[ks], S[dt], 0, 0, 0); } }
        HSEC_E(6); HSEC_B();
#pragma unroll
        for (int mt = 0; mt < 4; ++mt)
#pragma unroll
            for (int r = 0; r < 4; ++r) { const float p = row16_sum(O[mt][r] * O[mt][r]);
                if (l15 == 0) part[w * 64 + 16 * mt + 4 * q4 + r] = p; }
        __syncthreads();
        if (tid < 64) { float s = 0.f;
#pragma unroll
            for (int ww = 0; ww < 8; ++ww) s += part[ww * 64 + tid];
            rstd[tid] = rsqrtf(s * (1.0f / 128.0f) + 1e-6f); }
        __syncthreads();
        HSEC_E(7); HSEC_B();
#pragma unroll
        for (int mt = 0; mt < 4; ++mt) { const f32x4 rs = *(const f32x4*)(rstd + 16 * mt + 4 * q4);
#pragma unroll
            for (int r = 0; r < 4; ++r) { const float g = bf2f(gq[4 * mt + r]); const float o = O[mt][r] * rs[r] * ng * (g * __builtin_amdgcn_rcpf(1.0f + __expf(-g)));
                HO[(size_t)(r0 + 16 * mt + 4 * q4 + r) * 2048 + 16 * w + l15] = (bf16)f2bf(o); } }
        HSEC_E(8);
    }
    __syncthreads();
}

__device__ __forceinline__ void ph2_side(const Frame& F, int sid, int nside) {
    const Args& a = *F.a;
    const int gw = sid * 8 + F.wave, NGW = nside * 8, lane = F.lane();
    bf16* CKV = (bf16*)(F.ws + WS_CKV); bf16* IKW = (bf16*)(F.ws + WS_IKW);
    for (int row = gw; row < T; row += NGW) {
        {   u32x2 w = *(u32x2*)(CKV + (size_t)row * 256 + 4 * lane);
            float x0 = bflo(w.x), x1 = bfhi(w.x), x2 = bflo(w.y), x3 = bfhi(w.y);
            const float ss = wave_sum(x0 * x0 + x1 * x1 + x2 * x2 + x3 * x3);
            const float r = rsqrtf(ss * (1.0f / 256.0f) + 1e-6f);
            const f32x4 g = *(const f32x4*)(a.in[5] + 4 * lane);
            w.x = pk2(x0 * r * g.x, x1 * r * g.y); w.y = pk2(x2 * r * g.z, x3 * r * g.w);
            *(u32x2*)(CKV + (size_t)row * 256 + 4 * lane) = w; }
        {   unsigned w = *(unsigned*)(IKW + (size_t)row * 256 + 2 * lane);
            float x0 = bflo(w), x1 = bfhi(w);
            const float mu = wave_sum(x0 + x1) * (1.0f / 128.0f);
            x0 -= mu; x1 -= mu;
            const float var = wave_sum(x0 * x0 + x1 * x1) * (1.0f / 128.0f);
            const float r = rsqrtf(var + 1e-5f);
            const float g0 = a.in[6][2 * lane], g1 = a.in[6][2 * lane + 1], b0 = a.in[7][2 * lane], b1 = a.in[7][2 * lane + 1];
            *(unsigned*)(IKW + (size_t)row * 256 + 2 * lane) = pk2(x0 * r * g0 + b0, x1 * r * g1 + b1); }
    }
}
__device__ __forceinline__ void w8_transposes(const Frame& F, bf16* W8) {
    const Args& a = *F.a;
    const int gw = F.bid * 8 + F.wave, NGW = F.G * 8, lane = F.lane();
    float* scr = (float*)(F.lds + F.wave * 17408);
    float* cv = (float*)(F.ws + WS_CTL + CTL_CVEC);
    for (int it = gw; it < 2 * 2048; it += NGW) {
        const int which = it >> 11, m = which ? 7 : 3;
        transpose_item_ln(which ? a.in[22] : a.in[16], W8 + (size_t)m * 2048 * 2048, it & 2047, scr, lane, which ? a.in[20] : a.in[14], which ? a.in[21] : a.in[15], cv + which * 4096, cv + which * 4096 + 2048); }
    for (int it = gw; it < 6 * 1024; it += NGW) {
        const int q = it >> 10, m = q < 3 ? q : (q + 1);
        const float* wsrc = m == 0 ? a.in[11] : m == 1 ? a.in[12] : m == 2 ? a.in[13] : m == 4 ? a.in[17] : m == 5 ? a.in[18] : a.in[19];
        if (m < 2) transpose_item64(wsrc, 2048, W8 + (size_t)m * 2048, 4096, 0, 32, it & 1023, scr, lane, CmIdent());
        else transpose_item64(wsrc, 2048, W8 + (size_t)m * 2048 * 2048, 2048, 0, 32, it & 1023, scr, lane, CmIdent()); }
}

__device__ __forceinline__ void ph3_hgnorm(const Frame& F) {
    const Args& a = *F.a;
    const int gw = F.bid * 8 + F.wave, NGW = F.G * 8, lane = F.lane();
    const float* oraw = a.out; const bf16* HG = F.slot(3); bf16* HO = F.slot(0);
    for (int u = gw; u < T * 16; u += NGW) {
        const size_t off = (size_t)(u >> 4) * 2048 + (u & 15) * 128 + 2 * lane;
        const float o0 = oraw[off], o1 = oraw[off + 1];
        const float r = rsqrtf(wave_sum(o0 * o0 + o1 * o1) * (1.0f / 128.0f) + 1e-6f);
        const unsigned gw2 = *(const unsigned*)(HG + off);
        const float g0 = bflo(gw2), g1 = bfhi(gw2);
        const int c = (u & 15) * 128 + 2 * lane;
        *(unsigned*)(HO + off) = pk2(o0 * r * a.in[4][c] * (g0 * sigm(g0)), o1 * r * a.in[4][c + 1] * (g1 * sigm(g1)));
    }
}

__device__ __forceinline__ unsigned fkey(float f) { const unsigned u = __float_as_uint(f); return (u & 0x80000000u) ? ~u : (u | 0x80000000u); }
__device__ __forceinline__ void ph5_select(const Frame& F, int first, int stride) {
    const int lane = F.lane(), l31 = lane & 31, half = lane >> 5, w = F.wave;
    float* scl = (float*)F.lds;
    const bf16* AIQ = F.slot(5); const bf16* IKW = (const bf16*)(F.ws + WS_IKW);
    unsigned* MASK = (unsigned*)(F.ws + WS_MASK);
    for (int i = first; i < 1024; i += stride) {
        const int r4 = i >> 8, c = i & 255, j = c & 127, b = 2 * r4 + (c >> 7), qt = (r4 & 1) ? 127 - j : j, t0 = qt * 16;
        bf16x8 Af[8];
        { const size_t rowA = (size_t)b * 2048 + t0 + 2 * w + ((l31 >> 2) & 1); const int headA = (l31 & 3) + 4 * (l31 >> 3);
#pragma unroll
          for (int ks = 0; ks < 8; ++ks) Af[ks] = *(const bf16x8*)(AIQ + rowA * 2048 + headA * 128 + 16 * ks + 8 * half); }
        float wr[16];
        { const bf16* wp = IKW + ((size_t)b * 2048 + t0 + 2 * w + half) * 256 + 128;
#pragma unroll
          for (int r = 0; r < 16; ++r) wr[r] = bf2f(wp[(r & 3) + 4 * (r >> 2)]) * (0.25f * 0.08838834764831845f); }
        const int nkt = (t0 + 15) / 32 + 1;
        unsigned char* ring = F.lds + 131072;
        const int srow = (w * 64 + lane) >> 4, sch = lane & 15;
        const bf16* kg = IKW + ((size_t)b * 2048 + srow) * 256 + 8 * sch;
        const int swr = srow * 256 + ((sch ^ (srow & 15)) << 4);
        const int frd = l31 * 256;
        u32x4 st0, st1;
        st0 = *(const u32x4*)kg; *(u32x4*)(ring + swr) = st0;
        if (nkt > 1) { st1 = *(const u32x4*)(kg + (size_t)32 * 256); *(u32x4*)(ring + 8192 + swr) = st1; }
        if (nkt > 2) st0 = *(const u32x4*)(kg + (size_t)2 * 32 * 256);
        __syncthreads();
#define IDX_TILE(kt_, STW, STL) do { \
            if ((kt_) + 3 < nkt) STL = *(const u32x4*)(kg + (size_t)((kt_) + 3) * 32 * 256); \
            { const unsigned char* sl_ = ring + ((kt_) % 3) * 8192 + frd; f32x16 acc; _Pragma("unroll") for (int r = 0; r < 16; ++r) acc[r] = 0.f; \
              _Pragma("unroll") for (int ks = 0; ks < 8; ++ks) { const bf16x8 bfr = *(const bf16x8*)(sl_ + (((2 * ks + half) ^ (l31 & 15)) << 4)); acc = __builtin_amdgcn_mfma_f32_32x32x16_bf16(Af[ks], bfr, acc, 0, 0, 0); } \
              float sc = 0.f; _Pragma("unroll") for (int r = 0; r < 16; ++r) sc += fmaxf(acc[r], 0.f) * wr[r]; \
              scl[(2 * w + half) * 2048 + (kt_) * 32 + l31] = sc; } \
            if ((kt_) + 2 < nkt) *(u32x4*)(ring + (((kt_) + 2) % 3) * 8192 + swr) = STW; \
            __syncthreads(); } while (0)
        for (int kt = 0; kt < nkt; kt += 2) { IDX_TILE(kt, st0, st1); if (kt + 1 < nkt) IDX_TILE(kt + 1, st1, st0); }
#undef IDX_TILE
        WAVE_SYNC();
#pragma unroll 1
        for (int qi = 0; qi < 2; ++qi) {
            const int t = t0 + 2 * w + qi; const float* row = scl + (2 * w + qi) * 2048;
            unsigned key[32];
#pragma unroll
            for (int jj = 0; jj < 32; ++jj) { const int s2 = lane + 64 * jj; key[jj] = (s2 <= t) ? fkey(row[s2]) : 0u; }
            unsigned thr = 0u;
            if (t + 1 > 256) {
                for (int bit = 31; bit >= 0; --bit) {
                    const unsigned cand = thr | (1u << bit);
                    int cnt = 0;
#pragma unroll
                    for (int jj = 0; jj < 32; ++jj) cnt += (key[jj] >= cand) ? 1 : 0;
                    { int tot = 0;
#pragma unroll
                      for (int bb = 0; bb < 6; ++bb) tot += __popcll(__ballot((cnt >> bb) & 1)) << bb;
                      cnt = tot; }
                    if (cnt >= 256) { thr = cand; if (cnt == 256) break; }
                }
            }
            unsigned wd = 0u;
#pragma unroll
            for (int jj = 0; jj < 32; ++jj) { const int s2 = lane + 64 * jj; const unsigned long long m = __ballot(s2 <= t && key[jj] >= thr);
                if (lane == 2 * jj) wd = (unsigned)m; if (lane == 2 * jj + 1) wd = (unsigned)(m >> 32); }
            MASK[((size_t)b * 2048 + t) * 64 + lane] = wd;
        }
        WAVE_SYNC();
    }
}

__device__ __forceinline__ int t5_bucket(int d) {
    if (d < 16) return d;
    return 16 + (d >= 19) + (d >= 21) + (d >= 24) + (d >= 27) + (d >= 31) + (d >= 35) + (d >= 40) + (d >= 46) + (d >= 52) + (d >= 59) + (d >= 67) + (d >= 77) + (d >= 87) + (d >= 99) + (d >= 113);
}
namespace dsa {
constexpr float SCALE = 0.08838834764831845f;
constexpr int NW = 8, QBLK = 32, KVBLK = 64, QB = NW * QBLK, DH = 128, LD = 2048;
constexpr int SHM_V = KVBLK * DH * 2, SHM_K = KVBLK * DH * 2;
constexpr int OFF_WS = 2 * SHM_V + 2 * SHM_K, OFF_BIAS = OFF_WS + NW * 64 * 4, LDS_TOTAL = OFF_BIAS + 16 * 128 * 4;
constexpr float THR = 8.f;
typedef short s16x4 __attribute__((ext_vector_type(4)));
#define KSWZ(row, colB) ((row) * 256 + ((colB) ^ (((row) & 7) << 4)))
#define SBAR() __builtin_amdgcn_sched_barrier(0)
__device__ __forceinline__ int v_st(int k, int c) { const int kk = (k & ~0xC) | ((k & 4) << 1) | ((k & 8) >> 1); return ((kk >> 3) * 4 + (c >> 5)) * 512 + ((kk & 7) * 32 + (c & 31)) * 2; }
__device__ __forceinline__ int v_rd_base(int lane) { return ((lane & 3) << 3) | (((lane >> 2) & 3) << 6) | (((lane >> 4) & 1) << 5) | (((lane >> 5) & 1) << 8); }
constexpr int v_rd_off(int d0, int ks, int half) { return d0 * 512 + ks * 4096 + half * 2048; }
__device__ __forceinline__ int crow(int r, int hi) { return (r & 3) + 8 * (r >> 2) + 4 * hi; }
__device__ __forceinline__ unsigned cvtpk(float lo, float hi) { unsigned r; asm volatile("v_cvt_pk_bf16_f32 %0, %1, %2" : "=v"(r) : "v"(lo), "v"(hi)); return r; }
__device__ __forceinline__ bf16x8 load8(const bf16* p) { return *reinterpret_cast<const bf16x8*>(p); }
template <bool NEAR>
__device__ __forceinline__ void init_scores(f32x16& p0, f32x16& p1, unsigned w0, unsigned w1, int hi, int dq, const float* bl) {
    w0 >>= 4 * hi; w1 >>= 4 * hi;
#pragma unroll
    for (int r = 0; r < 16; ++r) { const int c = (r & 3) + 8 * (r >> 2);
        const int x0 = __builtin_amdgcn_sbfe(w0, c, 1), x1 = __builtin_amdgcn_sbfe(w1, c, 1);
        unsigned b0 = 0u, b1 = 0u;
        if (NEAR) { int d0 = dq - c, d1 = dq - c - 32; d0 = d0 < 0 ? 0 : (d0 > 127 ? 127 : d0); d1 = d1 < 0 ? 0 : (d1 > 127 ? 127 : d1);
            b0 = __float_as_uint(bl[d0]); b1 = __float_as_uint(bl[d1]); }
        p0[r] = __uint_as_float((b0 & (unsigned)x0) | (0xFF800000u & ~(unsigned)x0));
        p1[r] = __uint_as_float((b1 & (unsigned)x1) | (0xFF800000u & ~(unsigned)x1)); }
}
__device__ __forceinline__ void partialSM(f32x16& p0, f32x16& p1, float& m_reg, float& mn, float& alpha) {
    float pmax = p0[0];
#pragma unroll
    for (int r = 1; r < 16; ++r) pmax = fmaxf(pmax, p0[r]);
#pragma unroll
    for (int r = 0; r < 16; ++r) pmax = fmaxf(pmax, p1[r]);
    { auto rr = __builtin_amdgcn_permlane32_swap(__float_as_uint(pmax), __float_as_uint(pmax), false, false);
      pmax = fmaxf(__uint_as_float(rr[0]), __uint_as_float(rr[1])); }
    constexpr float C2 = 1.4426950408889634f * SCALE;
    if (__builtin_expect(__all((pmax - m_reg) * SCALE <= THR), 1)) { mn = m_reg; alpha = 1.f; }
    else { mn = fmaxf(m_reg, pmax); alpha = __builtin_amdgcn_exp2f((m_reg - mn) * C2); m_reg = mn; }
    const float mnL = -mn * C2;
#pragma unroll
    for (int r = 0; r < 16; ++r) p0[r] = fmaf(p0[r], C2, mnL);
#pragma unroll
    for (int r = 0; r < 16; ++r) p1[r] = fmaf(p1[r], C2, mnL);
#pragma unroll
    for (int r = 0; r < 16; ++r) p0[r] = __builtin_amdgcn_exp2f(p0[r]);
}
__device__ __forceinline__ void finishSM(f32x16& p0, f32x16& p1, float alpha, float& l_reg, bf16x8& pa0, bf16x8& pa1, bf16x8& pa2, bf16x8& pa3) {
#pragma unroll
    for (int r = 0; r < 16; ++r) p1[r] = __builtin_amdgcn_exp2f(p1[r]);
    float ps = 0;
#pragma unroll
    for (int r = 0; r < 16; ++r) ps += p0[r];
#pragma unroll
    for (int r = 0; r < 16; ++r) ps += p1[r];
    { auto rr = __builtin_amdgcn_permlane32_swap(__float_as_uint(ps), __float_as_uint(ps), false, false);
      ps = __uint_as_float(rr[0]) + __uint_as_float(rr[1]); }
    l_reg = l_reg * alpha + ps;
#define PK4(P, B_, OUT) do { unsigned a0 = cvtpk(P[B_+0], P[B_+1]), a1 = cvtpk(P[B_+2], P[B_+3]);                          \
        unsigned b0 = cvtpk(P[B_+4], P[B_+5]), b1 = cvtpk(P[B_+6], P[B_+7]);                                             \
        auto r0 = __builtin_amdgcn_permlane32_swap(a0, b0, false, false); auto r1 = __builtin_amdgcn_permlane32_swap(a1, b1, false, false); \
        u32x4 w = {r0[0], r1[0], r0[1], r1[1]}; OUT = *reinterpret_cast<bf16x8*>(&w); } while (0)
    PK4(p0, 0, pa0); PK4(p0, 8, pa1); PK4(p1, 0, pa2); PK4(p1, 8, pa3);
#undef PK4
}
template <int KB>
__device__ __forceinline__ void qkt(f32x16& p0, f32x16& p1, const char* K_lds, int r32, int hi, const bf16x8* qr) {
    const char* kb[4];
#pragma unroll
    for (int dd = 0; dd < 4; ++dd) kb[dd] = K_lds + KB * SHM_K + KSWZ(r32, (dd * 16 + hi * 8) * 2);
#pragma unroll
    for (int d0 = 0; d0 < 8; ++d0) { const char* a = kb[d0 & 3] + (d0 >> 2) * 128;
        bf16x8 b0 = *reinterpret_cast<const bf16x8*>(a);
        bf16x8 b1 = *reinterpret_cast<const bf16x8*>(a + 32 * 256);
        p0 = __builtin_amdgcn_mfma_f32_32x32x16_bf16(b0, qr[d0], p0, 0, 0, 0);
        p1 = __builtin_amdgcn_mfma_f32_32x32x16_bf16(b1, qr[d0], p1, 0, 0, 0); }
}
template <int VB>
__device__ __forceinline__ void pv_tile(f32x16* o, int vb0, bf16x8 pa0, bf16x8 pa1, bf16x8 pa2, bf16x8 pa3) {
#define TRRD(dst, off) asm volatile("ds_read_b64_tr_b16 %0, %1 offset:%2" : "=&v"(dst) : "v"(vb0), "i"(off) : "memory")
#define PV_D0(d0) do { s16x4 l0, l1, l2, l3, h0, h1, h2, h3; constexpr int b_ = VB * SHM_V + v_rd_off(d0, 0, 0); \
        TRRD(l0, b_); TRRD(h0, b_ + 2048); TRRD(l1, b_ + 4096); TRRD(h1, b_ + 6144); TRRD(l2, b_ + 8192); TRRD(h2, b_ + 10240); TRRD(l3, b_ + 12288); TRRD(h3, b_ + 14336); \
        asm volatile("s_waitcnt lgkmcnt(0)" ::: "memory"); SBAR();   \
        o[d0] = __builtin_amdgcn_mfma_f32_32x32x16_bf16(pa0, (bf16x8){l0[0], l0[1], l0[2], l0[3], h0[0], h0[1], h0[2], h0[3]}, o[d0], 0, 0, 0);   \
        o[d0] = __builtin_amdgcn_mfma_f32_32x32x16_bf16(pa1, (bf16x8){l1[0], l1[1], l1[2], l1[3], h1[0], h1[1], h1[2], h1[3]}, o[d0], 0, 0, 0);   \
        o[d0] = __builtin_amdgcn_mfma_f32_32x32x16_bf16(pa2, (bf16x8){l2[0], l2[1], l2[2], l2[3], h2[0], h2[1], h2[2], h2[3]}, o[d0], 0, 0, 0);   \
        o[d0] = __builtin_amdgcn_mfma_f32_32x32x16_bf16(pa3, (bf16x8){l3[0], l3[1], l3[2], l3[3], h3[0], h3[1], h3[2], h3[3]}, o[d0], 0, 0, 0); } while (0)
    PV_D0(0); PV_D0(1); PV_D0(2); PV_D0(3);
#undef PV_D0
#undef TRRD
}
struct BlockRef { const bf16* Q; const bf16* K; const bf16* V; bf16* O; const unsigned* M; int P0; int h; };
struct Seam { bf16x8 qr[8]; bf16x8 st_v0, st_v1, st_k0, st_k1; };
#define ROWU(p, k0) ((p) + (size_t)(k0) * LD)
#define VMW() asm volatile("s_waitcnt vmcnt(0)" ::: "memory")
#define VMWN(n) asm volatile("s_waitcnt vmcnt(%0)" :: "i"(n) : "memory")
#define SLOAD_H(Kp, Vp, k0) do { S.st_v0 = load8(ROWU(Vp, k0) + sofs); S.st_v1 = load8(ROWU(Vp, (k0) + 32) + sofs);              \
                         S.st_k0 = load8(ROWU(Kp, k0) + sofs); S.st_k1 = load8(ROWU(Kp, (k0) + 32) + sofs); } while (0)
#define SWRITE_HK(bf) do { *(bf16x8*)(K_lds + (bf) * SHM_K + kws) = S.st_k0; *(bf16x8*)(K_lds + (bf) * SHM_K + kws + 32 * 256) = S.st_k1; } while (0)
#define SWRITE_HV(bf) do { *(bf16x8*)(V_lds + (bf) * SHM_V + vst0) = S.st_v0; *(bf16x8*)(V_lds + (bf) * SHM_V + vst1) = S.st_v1; } while (0)
#define SWRITE_H(bf) do { SWRITE_HV(bf); SWRITE_HK(bf); } while (0)
__device__ __forceinline__ void prime(const BlockRef& cur, char* lds, Seam& S, int wid) {
    const int lane = fresh_lane(), tid = wid * 64 + lane, r32 = lane & 31, hi = lane >> 5;
    const int sr = tid >> 4, sc = (tid & 15) * 8, kws = KSWZ(sr, sc * 2); char* K_lds = lds + 2 * SHM_V; const unsigned sofs = (unsigned)(sr * LD + sc);
    const unsigned qofs = (unsigned)((wid * QBLK + r32) * LD + hi * 8);
#pragma unroll
    for (int d0 = 0; d0 < 8; ++d0) S.qr[d0] = load8(cur.Q + qofs + d0 * 16);
    SLOAD_H(cur.K, cur.V, 0); VMW(); SWRITE_HK(0);
    __syncthreads();
}
__device__ __forceinline__ void block(const BlockRef& cur, const BlockRef& nxt, char* lds, Seam& S, int wid) {
    const int lane = fresh_lane(), tid = wid * 64 + lane,
               r32 = lane & 31, hi = lane >> 5;
    const int NT = (cur.P0 + QB - 1) / KVBLK + 1;
    const int qlo = cur.P0 + wid * QBLK, qm = qlo + r32 - 4 * hi;
    char* V_lds = lds; char* K_lds = lds + 2 * SHM_V;
    float* ws = (float*)(lds + OFF_WS) + wid * 64; float* li_l = ws, * al_l = ws + 32;
    const float* bl = (const float*)(lds + OFF_BIAS) + cur.h * 128;
    const unsigned mofs = (unsigned)((wid * QBLK + r32) * 64);
    float m_reg = -1e30f, l_reg = 0; f32x16 o[4] = {};
    const int sr = tid >> 4, sc = (tid & 15) * 8, vst0 = v_st(sr, sc), vst1 = v_st(32 + sr, sc), kws = KSWZ(sr, sc * 2); const unsigned sofs = (unsigned)(sr * LD + sc);
    const int vb0 = (int)(uintptr_t)V_lds + v_rd_base(lane);
    const bf16* Kh = cur.K; const bf16* Vh = cur.V;
#define RESC(a) do { if (__any((a) < 1.f)) { if (hi == 0) al_l[r32] = (a); asm volatile("s_waitcnt lgkmcnt(0)" ::: "memory");              \
                     for (int d_ = 0; d_ < 4; ++d_) for (int r = 0; r < 16; ++r) o[d_][r] *= al_l[crow(r, hi)]; } } while (0)
#define KBASE(t) ((t) * KVBLK)
#define LDMASK(t) (*(const u32x2*)(cur.M + 2 * ((t) < 31 ? (t) : 31) + mofs))
#define INIT(P0_, P1_, t) do { const int kb_ = KBASE(t); if (qlo - kb_ - 63 < 113) init_scores<true>(P0_, P1_, mw.x, mw.y, hi, qm - kb_, bl); else init_scores<false>(P0_, P1_, mw.x, mw.y, hi, 0, bl); } while (0)
#define SEAM_K0() do { VMWN(8); SWRITE_HK(0); SBAR(); } while (0)
    f32x16 pA0, pA1, pB0, pB1; float mnA, mnB, alA, alB; bf16x8 pa0, pa1, pa2, pa3; u32x2 mw;
    SWRITE_HV(0); SBAR();
    if (NT > 1) { SLOAD_H(Kh, Vh, KBASE(1)); }
    mw = LDMASK(0); INIT(pA0, pA1, 0); mw = LDMASK(1);
    SBAR(); qkt<0>(pA0, pA1, K_lds, r32, hi, S.qr);
    partialSM(pA0, pA1, m_reg, mnA, alA);
    if (NT > 1) { VMW(); SWRITE_H(1); }
    __syncthreads();
#define HALF_STEP(PX0, PX1, mnX, alX, PY0, PY1, alY, t, KB, VB, SB) do {                                                      \
        INIT(PX0, PX1, (t)); mw = LDMASK((t) + 1);                                                                           \
        SBAR(); qkt<KB>(PX0, PX1, K_lds, r32, hi, S.qr);                                                                      \
        finishSM(PY0, PY1, alY, l_reg, pa0, pa1, pa2, pa3); SBAR();                                                           \
        if ((t) + 1 < NT) { SLOAD_H(Kh, Vh, KBASE((t) + 1)); SBAR(); }                                                        \
        pv_tile<VB>(o, vb0, pa0, pa1, pa2, pa3); partialSM(PX0, PX1, m_reg, mnX, alX);              \
        __syncthreads();                                                                                                      \
        if ((t) + 1 < NT) { VMW(); SWRITE_H(SB); }                                                                            \
        RESC(alX); __syncthreads(); } while (0)
    for (int t = 1; t + 1 < NT; t += 2) {
        HALF_STEP(pB0, pB1, mnB, alB, pA0, pA1, alA, t, 1, 0, 0);
        HALF_STEP(pA0, pA1, mnA, alA, pB0, pB1, alB, t + 1, 0, 1, 1);
    }
    const bool even = (NT & 1) == 0;
    if (even) { INIT(pB0, pB1, NT - 1); SBAR(); qkt<1>(pB0, pB1, K_lds, r32, hi, S.qr); SBAR(); }
    SLOAD_H(nxt.K, nxt.V, 0); SBAR();
#pragma unroll
    for (int d0 = 0; d0 < 8; ++d0) S.qr[d0] = load8(nxt.Q + (unsigned)((wid * QBLK + r32) * LD + hi * 8) + d0 * 16);
    SBAR();
    finishSM(pA0, pA1, alA, l_reg, pa0, pa1, pa2, pa3); SBAR();
    pv_tile<0>(o, vb0, pa0, pa1, pa2, pa3);
    if (even) { partialSM(pB0, pB1, m_reg, mnB, alB); __syncthreads(); RESC(alB);
        finishSM(pB0, pB1, alB, l_reg, pa0, pa1, pa2, pa3); SBAR(); pv_tile<1>(o, vb0, pa0, pa1, pa2, pa3); }
    SBAR(); SEAM_K0();
    if (hi == 0) li_l[r32] = l_reg; asm volatile("s_waitcnt lgkmcnt(0)" ::: "memory");
    float rli[16];
#pragma unroll
    for (int r = 0; r < 16; ++r) rli[r] = __builtin_amdgcn_rcpf(li_l[crow(r, hi)]);
    int lofs = 4 * hi * LD + r32; asm volatile("" : "+v"(lofs));
    bf16* Ow = cur.O + (size_t)(wid * QBLK) * LD + lofs;
#pragma unroll
    for (int r = 0; r < 16; ++r) { const int orow = (r & 3) + 8 * (r >> 2);
#pragma unroll
        for (int d0 = 0; d0 < 4; ++d0) { const float v = o[d0][r] * rli[r];
            const float vn = __shfl_xor(v, 1);
            if ((r32 & 1) == 0) *(unsigned*)(Ow + orow * LD + d0 * 32) = cvtpk(v, vn); } }
    __syncthreads();
#undef RESC
#undef KBASE
#undef LDMASK
#undef INIT
#undef SEAM_K0
#undef HALF_STEP
}
#undef ROWU
#undef VMW
#undef VMWN
#undef SLOAD_H
#undef SWRITE_HK
#undef SWRITE_HV
#undef SWRITE_H
#undef KSWZ
#undef SBAR
}

__device__ __forceinline__ dsa::BlockRef dsa_ref(const Frame& F, int bh, int qb) {
    const int b = bh >> 4, h = bh & 15;
    dsa::BlockRef r;
    r.Q = F.slot(4) + ((size_t)b * 2048 + (size_t)qb * 256) * 2048 + h * 128;
    r.O = F.slot(3) + ((size_t)b * 2048 + (size_t)qb * 256) * 2048 + h * 128;
    r.K = F.slot(1) + (size_t)b * 2048 * 2048 + h * 128; r.V = F.slot(2) + (size_t)b * 2048 * 2048 + h * 128;
    r.M = (const unsigned*)(F.ws + WS_MASK) + ((size_t)b * 2048 + (size_t)qb * 256) * 64;
    r.P0 = qb * 256; r.h = h;
    return r;
}
__device__ __forceinline__ void ph6_attn(const Frame& F) {
    const Args& a = *F.a;
    char* lds = (char*)F.lds;
    {
        float* bt = (float*)(lds + dsa::OFF_BIAS);
        for (int i = F.wave * 64 + F.lane(); i < 16 * 128; i += 512) { const int h = i >> 7, d = i & 127; bt[i] = (a.in[10][t5_bucket(d) * 16 + h] - a.in[10][31 * 16 + h]) * (1.0f / dsa::SCALE); }
    }
    __syncthreads();
    const int total = 4 * 128;
    int L = F.bid; if (L >= total) return;
#define ATT_BH(L_) (((L_) >> 8) * 64 + ((L_) & 7) * 8 + ((((L_) & 255) >> 3) >> 2))
#define ATT_PR(L_) ((((L_) & 255) >> 3) & 3)
    int pass = 0;
    const bool xmap = (F.G == 256);
    dsa::BlockRef cur = dsa_ref(F, xmap ? ATT_BH(L) : (L >> 2), xmap ? ATT_PR(L) : (L & 3));
    dsa::Seam S;
    dsa::prime(cur, lds, S, F.wave);
    for (;;) {
        const bool more_pass = pass == 0, more_item = L + F.G < total, last = !more_pass && !more_item;
        int passn = pass + 1, Ln = L;
        if (!more_pass) { passn = 0; Ln = more_item ? L + F.G : L; }
        const int bhn = xmap ? ATT_BH(Ln) : (Ln >> 2), prn = xmap ? ATT_PR(Ln) : (Ln & 3);
        const dsa::BlockRef nxt = last ? cur : dsa_ref(F, bhn, passn ? 7 - prn : prn);
        dsa::block(cur, nxt, lds, S, F.wave);
        if (last) break;
        cur = nxt; pass = passn; L = Ln;
    }
}

__device__ __forceinline__ void ln_row(float* zrow, const float* g, const float* bta, bf16* brow, int lane) {
    f32x4 v[8]; float s = 0.f;
#pragma unroll
    for (int i = 0; i < 8; ++i) { v[i] = *(const f32x4*)(zrow + 256 * i + 4 * lane); s += (v[i].x + v[i].y) + (v[i].z + v[i].w); }
    const float mu = wave_sum(s) * (1.0f / 2048.0f); float s2 = 0.f;
#pragma unroll
    for (int i = 0; i < 8; ++i) { v[i] = v[i] - mu; s2 += (v[i].x * v[i].x + v[i].y * v[i].y) + (v[i].z * v[i].z + v[i].w * v[i].w); }
    const float r = rsqrtf(wave_sum(s2) * (1.0f / 2048.0f) + 1e-5f);
#pragma unroll
    for (int i = 0; i < 8; ++i) { const f32x4 gg = *(const f32x4*)(g + 256 * i + 4 * lane), bb = *(const f32x4*)(bta + 256 * i + 4 * lane);
        const f32x4 o = v[i] * r * gg + bb; *(f32x4*)(zrow + 256 * i + 4 * lane) = o;
        if (brow) { u32x2 w; w.x = pk2(o.x, o.y); w.y = pk2(o.z, o.w); *(u32x2*)(brow + 256 * i + 4 * lane) = w; } }
}
__device__ __forceinline__ void ph_ln(const Frame& F, const float* g, const float* bta, bf16* bout) {
    const int gw = F.bid * 8 + F.wave, NGW = F.G * 8, lane = F.lane();
    for (int row = gw; row < T; row += NGW) ln_row(F.a->out + (size_t)row * 2048, g, bta, bout + (size_t)row * 2048, lane);
}

__device__ __forceinline__ float pk_idx(float v, unsigned code, unsigned mask) { return __uint_as_float((__float_as_uint(v) & ~mask) | code); }
__device__ __forceinline__ void ph_peer_select(const Frame& F) {
    const Args& a = *F.a;
    const int lane = F.lane(), l31 = lane & 31, half = lane >> 5;
    const float* PQ = (const float*)F.slot(1); const float* keys = a.in[23];
    int* EIDX = (int*)(F.ws + WS_CKV); float* EG = (float*)(F.ws + WS_IKW);
    const float NEG = -__builtin_inff();
    const int h = F.bid & 7, ntw = F.G >> 3;
    { const int tid = F.wave * 64 + lane;
#pragma unroll
      for (int p = 0; p < 2; ++p)
#pragma unroll
          for (int i = 0; i < 8; ++i) { const int idx = tid + 512 * i, row = idx >> 5, c4 = idx & 31;
              *(f32x4*)(F.lds + (size_t)p * 67584 + ((size_t)row * 132 + 4 * c4) * 4) = *(const f32x4*)(keys + ((size_t)(2 * h + p) * 128 + row) * 128 + 4 * c4); }
      __syncthreads(); }
    for (int tile = (F.bid >> 3) + ntw * F.wave; tile < T / 32; tile += ntw * 8) {
        const int t = tile * 32 + l31;
        float tv[2][16];
#pragma unroll
        for (int p = 0; p < 2; ++p) {
            const int g = 2 * h + p;
            float qv[64];
            { const float* qp = PQ + (size_t)t * 2048 + g * 128 + 64 * half;
#pragma unroll
              for (int j = 0; j < 16; ++j) { const f32x4 v = *(const f32x4*)(qp + 4 * j); qv[4 * j] = v.x; qv[4 * j + 1] = v.y; qv[4 * j + 2] = v.z; qv[4 * j + 3] = v.w; } }
            f32x16 acc[4];
#pragma unroll
            for (int mt = 0; mt < 4; ++mt)
#pragma unroll
                for (int r = 0; r < 16; ++r) acc[mt][r] = 0.f;
            const float* kp0 = (const float*)(F.lds + (size_t)p * 67584) + ((size_t)l31 * 132 + 64 * half);
            f32x4 kb[3][4];
#define PK_LOADC(cc) do { _Pragma("unroll") for (int u_ = 0; u_ < 4; ++u_) kb[(cc) % 3][u_] = *(const f32x4*)(kp0 + (size_t)((cc) >> 2) * 32 * 132 + 16 * ((cc) & 3) + 4 * u_); } while (0)
#define PK_MMAC(cc) do { _Pragma("unroll") for (int u_ = 0; u_ < 4; ++u_) { const f32x4 kv_ = kb[(cc) % 3][u_]; const int j_ = 4 * ((cc) & 3) + u_; \
                acc[(cc) >> 2] = __builtin_amdgcn_mfma_f32_32x32x2f32(kv_.x, qv[4 * j_], acc[(cc) >> 2], 0, 0, 0); acc[(cc) >> 2] = __builtin_amdgcn_mfma_f32_32x32x2f32(kv_.y, qv[4 * j_ + 1], acc[(cc) >> 2], 0, 0, 0); \
                acc[(cc) >> 2] = __builtin_amdgcn_mfma_f32_32x32x2f32(kv_.z, qv[4 * j_ + 2], acc[(cc) >> 2], 0, 0, 0); acc[(cc) >> 2] = __builtin_amdgcn_mfma_f32_32x32x2f32(kv_.w, qv[4 * j_ + 3], acc[(cc) >> 2], 0, 0, 0); } } while (0)
            PK_LOADC(0); PK_LOADC(1);
            PK_LOADC(2); PK_MMAC(0); __builtin_amdgcn_sched_barrier(0);
            PK_LOADC(3); PK_MMAC(1); __builtin_amdgcn_sched_barrier(0);
            PK_LOADC(4); PK_MMAC(2); __builtin_amdgcn_sched_barrier(0);
            PK_LOADC(5); PK_MMAC(3); __builtin_amdgcn_sched_barrier(0);
            PK_LOADC(6); PK_MMAC(4); __builtin_amdgcn_sched_barrier(0);
            PK_LOADC(7); PK_MMAC(5); __builtin_amdgcn_sched_barrier(0);
            PK_LOADC(8); PK_MMAC(6); __builtin_amdgcn_sched_barrier(0);
            PK_LOADC(9); PK_MMAC(7); __builtin_amdgcn_sched_barrier(0);
            PK_LOADC(10); PK_MMAC(8); __builtin_amdgcn_sched_barrier(0);
            PK_LOADC(11); PK_MMAC(9); __builtin_amdgcn_sched_barrier(0);
            PK_LOADC(12); PK_MMAC(10); __builtin_amdgcn_sched_barrier(0);
            PK_LOADC(13); PK_MMAC(11); __builtin_amdgcn_sched_barrier(0);
            PK_LOADC(14); PK_MMAC(12); __builtin_amdgcn_sched_barrier(0);
            PK_LOADC(15); PK_MMAC(13); __builtin_amdgcn_sched_barrier(0);
            PK_MMAC(14); __builtin_amdgcn_sched_barrier(0);
            PK_MMAC(15); __builtin_amdgcn_sched_barrier(0);
#undef PK_LOADC
#undef PK_MMAC
            unsigned hmask = ~(4u * (unsigned)half); asm volatile("" : "+v"(hmask));
#pragma unroll
            for (int mt = 0; mt < 4; ++mt)
#pragma unroll
                for (int r = 0; r < 16; ++r) acc[mt][r] = __uint_as_float(((__float_as_uint(acc[mt][r]) & ~127u) | (unsigned)(127 - (32 * mt + (r & 3) + 8 * (r >> 2)))) & hmask);
#pragma unroll
            for (int k = 0; k < 16; ++k) {
                float m = acc[0][0];
#pragma unroll
                for (int mt = 0; mt < 4; ++mt)
#pragma unroll
                    for (int r = 0; r < 16; ++r) m = fmaxf(m, acc[mt][r]);
                m = fmaxf(m, __shfl_xor(m, 32));
                tv[p][k] = m;
#pragma unroll
                for (int mt = 0; mt < 4; ++mt)
#pragma unroll
                    for (int r = 0; r < 16; ++r) acc[mt][r] = (acc[mt][r] == m) ? NEG : acc[mt][r];
            }
        }
        float cand[25]; int cid[25];
        unsigned hc = 25u * (unsigned)half; asm volatile("" : "+v"(hc));
        { const float ai = half ? tv[0][2] : tv[0][0], bj = half ? tv[1][1] : tv[1][0];
          cand[0] = pk_idx(ai + bj, (unsigned)(63 - 0) - hc, 63u); cid[0] = (int)((127u - (__float_as_uint(ai) & 127u)) * 128u + (127u - (__float_as_uint(bj) & 127u))); }
        { const float ai = half ? tv[0][2] : tv[0][0], bj = half ? tv[1][2] : tv[1][1];
          cand[1] = pk_idx(ai + bj, (unsigned)(63 - 1) - hc, 63u); cid[1] = (int)((127u - (__float_as_uint(ai) & 127u)) * 128u + (127u - (__float_as_uint(bj) & 127u))); }
        { const float ai = half ? tv[0][2] : tv[0][0], bj = half ? tv[1][3] : tv[1][2];
          cand[2] = pk_idx(ai + bj, (unsigned)(63 - 2) - hc, 63u); cid[2] = (int)((127u - (__float_as_uint(ai) & 127u)) * 128u + (127u - (__float_as_uint(bj) & 127u))); }
        { const float ai = half ? tv[0][2] : tv[0][0], bj = half ? tv[1][4] : tv[1][3];
          cand[3] = pk_idx(ai + bj, (unsigned)(63 - 3) - hc, 63u); cid[3] = (int)((127u - (__float_as_uint(ai) & 127u)) * 128u + (127u - (__float_as_uint(bj) & 127u))); }
        { const float ai = half ? tv[0][3] : tv[0][0], bj = half ? tv[1][0] : tv[1][4];
          cand[4] = pk_idx(ai + bj, (unsigned)(63 - 4) - hc, 63u); cid[4] = (int)((127u - (__float_as_uint(ai) & 127u)) * 128u + (127u - (__float_as_uint(bj) & 127u))); }
        { const float ai = half ? tv[0][3] : tv[0][0], bj = half ? tv[1][1] : tv[1][5];
          cand[5] = pk_idx(ai + bj, (unsigned)(63 - 5) - hc, 63u); cid[5] = (int)((127u - (__float_as_uint(ai) & 127u)) * 128u + (127u - (__float_as_uint(bj) & 127u))); }
        { const float ai = half ? tv[0][3] : tv[0][0], bj = half ? tv[1][2] : tv[1][6];
          cand[6] = pk_idx(ai + bj, (unsigned)(63 - 6) - hc, 63u); cid[6] = (int)((127u - (__float_as_uint(ai) & 127u)) * 128u + (127u - (__float_as_uint(bj) & 127u))); }
        { const float ai = half ? tv[0][3] : tv[0][0], bj = half ? tv[1][3] : tv[1][7];
          cand[7] = pk_idx(ai + bj, (unsigned)(63 - 7) - hc, 63u); cid[7] = (int)((127u - (__float_as_uint(ai) & 127u)) * 128u + (127u - (__float_as_uint(bj) & 127u))); }
        { const float ai = half ? tv[0][4] : tv[0][0], bj = half ? tv[1][0] : tv[1][8];
          cand[8] = pk_idx(ai + bj, (unsigned)(63 - 8) - hc, 63u); cid[8] = (int)((127u - (__float_as_uint(ai) & 127u)) * 128u + (127u - (__float_as_uint(bj) & 127u))); }
        { const float ai = half ? tv[0][4] : tv[0][0], bj = half ? tv[1][1] : tv[1][9];
          cand[9] = pk_idx(ai + bj, (unsigned)(63 - 9) - hc, 63u); cid[9] = (int)((127u - (__float_as_uint(ai) & 127u)) * 128u + (127u - (__float_as_uint(bj) & 127u))); }
        { const float ai = half ? tv[0][4] : tv[0][0], bj = half ? tv[1][2] : tv[1][10];
          cand[10] = pk_idx(ai + bj, (unsigned)(63 - 10) - hc, 63u); cid[10] = (int)((127u - (__float_as_uint(ai) & 127u)) * 128u + (127u - (__float_as_uint(bj) & 127u))); }
        { const float ai = half ? tv[0][5] : tv[0][0], bj = half ? tv[1][0] : tv[1][11];
          cand[11] = pk_idx(ai + bj, (unsigned)(63 - 11) - hc, 63u); cid[11] = (int)((127u - (__float_as_uint(ai) & 127u)) * 128u + (127u - (__float_as_uint(bj) & 127u))); }
        { const float ai = half ? tv[0][5] : tv[0][0], bj = half ? tv[1][1] : tv[1][12];
          cand[12] = pk_idx(ai + bj, (unsigned)(63 - 12) - hc, 63u); cid[12] = (int)((127u - (__float_as_uint(ai) & 127u)) * 128u + (127u - (__float_as_uint(bj) & 127u))); }
        { const float ai = half ? tv[0][6] : tv[0][0], bj = half ? tv[1][0] : tv[1][13];
          cand[13] = pk_idx(ai + bj, (unsigned)(63 - 13) - hc, 63u); cid[13] = (int)((127u - (__float_as_uint(ai) & 127u)) * 128u + (127u - (__float_as_uint(bj) & 127u))); }
        { const float ai = half ? tv[0][6] : tv[0][0], bj = half ? tv[1][1] : tv[1][14];
          cand[14] = pk_idx(ai + bj, (unsigned)(63 - 14) - hc, 63u); cid[14] = (int)((127u - (__float_as_uint(ai) & 127u)) * 128u + (127u - (__float_as_uint(bj) & 127u))); }
        { const float ai = half ? tv[0][7] : tv[0][0], bj = half ? tv[1][0] : tv[1][15];
          cand[15] = pk_idx(ai + bj, (unsigned)(63 - 15) - hc, 63u); cid[15] = (int)((127u - (__float_as_uint(ai) & 127u)) * 128u + (127u - (__float_as_uint(bj) & 127u))); }
        { const float ai = half ? tv[0][7] : tv[0][1], bj = half ? tv[1][1] : tv[1][0];
          cand[16] = pk_idx(ai + bj, (unsigned)(63 - 16) - hc, 63u); cid[16] = (int)((127u - (__float_as_uint(ai) & 127u)) * 128u + (127u - (__float_as_uint(bj) & 127u))); }
        { const float ai = half ? tv[0][8] : tv[0][1], bj = half ? tv[1][0] : tv[1][1];
          cand[17] = pk_idx(ai + bj, (unsigned)(63 - 17) - hc, 63u); cid[17] = (int)((127u - (__float_as_uint(ai) & 127u)) * 128u + (127u - (__float_as_uint(bj) & 127u))); }
        { const float ai = half ? tv[0][9] : tv[0][1], bj = half ? tv[1][0] : tv[1][2];
          cand[18] = pk_idx(ai + bj, (unsigned)(63 - 18) - hc, 63u); cid[18] = (int)((127u - (__float_as_uint(ai) & 127u)) * 128u + (127u - (__float_as_uint(bj) & 127u))); }
        { const float ai = half ? tv[0][10] : tv[0][1], bj = half ? tv[1][0] : tv[1][3];
          cand[19] = pk_idx(ai + bj, (unsigned)(63 - 19) - hc, 63u); cid[19] = (int)((127u - (__float_as_uint(ai) & 127u)) * 128u + (127u - (__float_as_uint(bj) & 127u))); }
        { const float ai = half ? tv[0][11] : tv[0][1], bj = half ? tv[1][0] : tv[1][4];
          cand[20] = pk_idx(ai + bj, (unsigned)(63 - 20) - hc, 63u); cid[20] = (int)((127u - (__float_as_uint(ai) & 127u)) * 128u + (127u - (__float_as_uint(bj) & 127u))); }
        { const float ai = half ? tv[0][12] : tv[0][1], bj = half ? tv[1][0] : tv[1][5];
          cand[21] = pk_idx(ai + bj, (unsigned)(63 - 21) - hc, 63u); cid[21] = (int)((127u - (__float_as_uint(ai) & 127u)) * 128u + (127u - (__float_as_uint(bj) & 127u))); }
        { const float ai = half ? tv[0][13] : tv[0][1], bj = half ? tv[1][0] : tv[1][6];
          cand[22] = pk_idx(ai + bj, (unsigned)(63 - 22) - hc, 63u); cid[22] = (int)((127u - (__float_as_uint(ai) & 127u)) * 128u + (127u - (__float_as_uint(bj) & 127u))); }
        { const float ai = half ? tv[0][14] : tv[0][1], bj = half ? tv[1][0] : tv[1][7];
          cand[23] = pk_idx(ai + bj, (unsigned)(63 - 23) - hc, 63u); cid[23] = (int)((127u - (__float_as_uint(ai) & 127u)) * 128u + (127u - (__float_as_uint(bj) & 127u))); }
        { const float ai = half ? tv[0][15] : tv[0][2], bj = half ? tv[1][0] : tv[1][0];
          cand[24] = pk_idx(ai + bj, (unsigned)(63 - 24) - hc, 63u); cid[24] = (int)((127u - (__float_as_uint(ai) & 127u)) * 128u + (127u - (__float_as_uint(bj) & 127u))); }
        float sv[16]; int sid[16];
#pragma unroll
        for (int k = 0; k < 16; ++k) {
            float m = cand[0];
#pragma unroll
            for (int c = 1; c < 25; ++c) m = fmaxf(m, cand[c]);
            const float mo = __shfl_xor(m, 32);
            const bool mine = (m > mo) || (m == mo && half == 0);
            const float mm = fmaxf(m, mo);
            int id = -1;
#pragma unroll
            for (int c = 0; c < 25; ++c) { const bool hit = mine && (cand[c] == mm); id = hit ? cid[c] : id; cand[c] = hit ? NEG : cand[c]; }
            const int ido = __shfl_xor(id, 32);
            sv[k] = mm; sid[k] = id > ido ? id : ido;
        }
        float den = 0.f; float ev[16];
#pragma unroll
        for (int k = 0; k < 16; ++k) { ev[k] = expf(sv[k] - sv[0]); den += ev[k]; }
        const float inv = 1.0f / den;
        if (half == 0) { int* ep = EIDX + (size_t)t * 128 + h * 16;
#pragma unroll
            for (int k = 0; k < 16; k += 4) *(u32x4*)(ep + k) = (u32x4){(unsigned)sid[k], (unsigned)sid[k + 1], (unsigned)sid[k + 2], (unsigned)sid[k + 3]}; }
        else { float* gp = EG + (size_t)t * 128 + h * 16;
#pragma unroll
            for (int k = 0; k < 16; k += 4) *(f32x4*)(gp + k) = (f32x4){ev[k] * inv, ev[k + 1] * inv, ev[k + 2] * inv, ev[k + 3] * inv}; }
    }
}

typedef unsigned v6u __attribute__((ext_vector_type(6)));
typedef float v32f __attribute__((ext_vector_type(32)));
typedef float v16f __attribute__((ext_vector_type(16)));
constexpr float PU_SCALE = 64.0f, PV_SCALE = 2.0f;
#ifndef FP6_INTERLEAVED
#define FP6_INTERLEAVED 1
#endif
#define RL(v, l) __builtin_amdgcn_readlane((v), (l))
#define EXR 4
#define EX_LOAD(buf, tab, idv, e) do { _Pragma("unroll") for (int r_ = 0; r_ < EXR; ++r_) { const unsigned* rp_ = (const unsigned*)((tab) + (size_t)RL(idv, ((e) & 63) + r_) * 1536) + 6 * lane; \
        const u32x2 p0_ = *(const u32x2*)rp_, p1_ = *(const u32x2*)(rp_ + 2), p2_ = *(const u32x2*)(rp_ + 4); buf[r_] = (v6u){p0_.x, p0_.y, p1_.x, p1_.y, p2_.x, p2_.y}; } } while (0)
#define EX_DOT(buf, e) do { float d_[EXR]; _Pragma("unroll") for (int r_ = 0; r_ < EXR; ++r_) { const v32f w_ = __builtin_amdgcn_cvt_scalef32_pk32_f32_fp6(buf[r_], 1.0f); float a_ = 0.f, b_ = 0.f; \
        _Pragma("unroll") for (int j_ = 0; j_ < 32; j_ += 2) { a_ += w_[j_] * xf[j_]; b_ += w_[j_ + 1] * xf[j_ + 1]; } d_[r_] = a_ + b_; __builtin_amdgcn_sched_barrier(0); } \
        _Pragma("unroll") for (int r_ = 0; r_ < EXR; ++r_) d_[r_] = wave_sum_dpp(d_[r_]); \
        _Pragma("unroll") for (int r_ = 0; r_ < EXR; ++r_) { const float pre_ = d_[r_] * (1.0f / PU_SCALE); const float hv_ = 0.5f * pre_ * (1.0f + erff(pre_ * 0.7071067811865476f)); \
            if (lane == (((e) & 63) + r_)) { if ((e) < 64) c0 = g0 * hv_; else c1 = g1 * hv_; } } } while (0)
#define EX_AXPY(buf, e) do { const float cv_ = (e) < 64 ? c0 : c1; _Pragma("unroll") for (int r_ = 0; r_ < EXR; ++r_) { const float cf_ = __int_as_float(RL(__float_as_int(cv_), ((e) & 63) + r_)) * (1.0f / PV_SCALE); \
        const v32f w_ = __builtin_amdgcn_cvt_scalef32_pk32_f32_fp6(buf[r_], 1.0f); _Pragma("unroll") for (int j_ = 0; j_ < 32; ++j_) y[j_] += cf_ * w_[j_]; __builtin_amdgcn_sched_barrier(0); } } while (0)
__device__ __forceinline__ void cvt_fp6_stream(const Frame& F, const float* src, unsigned char* dst, size_t nblk, float scale) {
    const size_t gt = (size_t)F.bid * 512 + F.wave * 64 + F.lane(), NT = (size_t)F.G * 512;
    for (size_t i = gt; i < nblk; i += NT) {
        f32x4 q[8];
#pragma unroll
        for (int j = 0; j < 8; ++j) q[j] = ((const f32x4*)src)[8 * i + j] * scale;
        v16f x, y;
#pragma unroll
        for (int j = 0; j < 4; ++j) {
#if FP6_INTERLEAVED
            x[4 * j] = q[2 * j].x; y[4 * j] = q[2 * j].y; x[4 * j + 1] = q[2 * j].z; y[4 * j + 1] = q[2 * j].w; x[4 * j + 2] = q[2 * j + 1].x; y[4 * j + 2] = q[2 * j + 1].y; x[4 * j + 3] = q[2 * j + 1].z; y[4 * j + 3] = q[2 * j + 1].w;
#else
            x[4 * j] = q[j].x; x[4 * j + 1] = q[j].y; x[4 * j + 2] = q[j].z; x[4 * j + 3] = q[j].w; y[4 * j] = q[4 + j].x; y[4 * j + 1] = q[4 + j].y; y[4 * j + 2] = q[4 + j].z; y[4 * j + 3] = q[4 + j].w;
#endif
        }
        const v6u p = __builtin_amdgcn_cvt_scalef32_2xpk16_fp6_f32(x, y, 1.0f);
        unsigned* o = (unsigned*)dst + 6 * i;
        *(u32x2*)o = (u32x2){p[0], p[1]}; *(u32x2*)(o + 2) = (u32x2){p[2], p[3]}; *(u32x2*)(o + 4) = (u32x2){p[4], p[5]};
    }
}
#define EX_LOAD_XF() do { float mu_, rs_; row_mu_rstd((const float*)(F.ws + WS_CTL + CTL_ST2), t, mu_, rs_); \
          const bf16* zr = F.slot(0) + (size_t)t * 2048 + lq; \
          _Pragma("unroll") for (int q = 0; q < 4; ++q) { const int col = lq + 8 * q; f32x4 z0, z1; unpack8v(*(const u32x4*)(zr + 8 * q), z0, z1); \
              const f32x4 g0v = *(const f32x4*)(a.in[20] + col), g1v = *(const f32x4*)(a.in[20] + col + 4), b0v = *(const f32x4*)(a.in[21] + col), b1v = *(const f32x4*)(a.in[21] + col + 4); \
              const f32x4 h0 = (z0 - mu_) * rs_ * g0v + b0v, h1 = (z1 - mu_) * rs_ * g1v + b1v; \
              xf[8 * q] = h0.x; xf[8 * q + 1] = h0.y; xf[8 * q + 2] = h0.z; xf[8 * q + 3] = h0.w; xf[8 * q + 4] = h1.x; xf[8 * q + 5] = h1.y; xf[8 * q + 6] = h1.z; xf[8 * q + 7] = h1.w; } } while (0)
__device__ __forceinline__ void ph16_experts(const Frame& F) {
    const Args& a = *F.a;
    const int gw = F.bid * 8 + F.wave, NGW = F.G * 8, lane0 = F.lane();
    const int* EIDX = (const int*)(F.ws + WS_CKV); const float* EG = (const float*)(F.ws + WS_IKW);
    const unsigned char* PU = (const unsigned char*)F.slot(5); const unsigned char* PV = PU + (size_t)32 * MiB;
    for (int t = gw; t < T; t += NGW) {
        int lane_l = lane0; asm volatile("" : "+v"(lane_l)); const int lane = lane_l;
        float* xrow = a.out + (size_t)t * 2048;
        float xf[32];
        const int lq = 32 * lane;
        EX_LOAD_XF();
        const int id0 = EIDX[(size_t)t * 128 + lane], id1 = EIDX[(size_t)t * 128 + 64 + lane];
        const float g0 = EG[(size_t)t * 128 + lane], g1 = EG[(size_t)t * 128 + 64 + lane];
        float c0 = 0.f, c1 = 0.f;
        v6u bA[EXR], bB[EXR];
        EX_LOAD(bA, PU, id0, 0);
        for (int e = 0; e < 128; e += 2 * EXR) {
            const int idv = e < 64 ? id0 : id1;
            EX_LOAD(bB, PU, idv, e + EXR);
            EX_DOT(bA, e);
            if (e + 2 * EXR < 128) { const int idn = (e + 2 * EXR) < 64 ? id0 : id1; EX_LOAD(bA, PU, idn, e + 2 * EXR); }
            EX_DOT(bB, e + EXR);
        }
        float y[32];
#pragma unroll
        for (int j = 0; j < 32; ++j) y[j] = 0.f;
        EX_LOAD(bA, PV, id0, 0);
        for (int e = 0; e < 128; e += 2 * EXR) {
            const int idv = e < 64 ? id0 : id1;
            EX_LOAD(bB, PV, idv, e + EXR);
            EX_AXPY(bA, e);
            if (e + 2 * EXR < 128) { const int idn = (e + 2 * EXR) < 64 ? id0 : id1; EX_LOAD(bA, PV, idn, e + 2 * EXR); }
            EX_AXPY(bB, e + EXR);
        }
        EX_LOAD_XF();
        float s = 0.f;
#pragma unroll
        for (int j = 0; j < 32; ++j) { y[j] += ALPHA * xf[j]; s += y[j]; }
        const float mu = wave_sum_dpp(s) * (1.0f / 2048.0f); float s2 = 0.f;
#pragma unroll
        for (int j = 0; j < 32; ++j) { y[j] -= mu; s2 += y[j] * y[j]; }
        const float rs = rsqrtf(wave_sum_dpp(s2) * (1.0f / 2048.0f) + 1e-5f);
        const int lofs = lq;
#pragma unroll
        for (int q = 0; q < 8; ++q) { const int col = lofs + 4 * q;
            const f32x4 ga = *(const f32x4*)(a.in[26] + col), ba = *(const f32x4*)(a.in[27] + col);
            f32x4 o; o.x = y[4 * q] * rs * ga.x + ba.x; o.y = y[4 * q + 1] * rs * ga.y + ba.y; o.z = y[4 * q + 2] * rs * ga.z + ba.z; o.w = y[4 * q + 3] * rs * ga.w + ba.w;
            *(f32x4*)(xrow + col) = o; }
    }
}

#define XB_TMO      128
#define XB_XCNT(j)  (256  + 64 * (j))
#define XB_XSUB(j)  (1280 + 64 * (j))
#define XB_XGEN(j)  (2304 + 64 * (j))
#define XB_TOP      3328
#define XB_TOPGEN   3392
#define XCD_BAR_WORDS 3456
#define XB_SPIN_CAP (1u << 22)
__device__ __forceinline__ unsigned xb_ld(unsigned* p)              { return __hip_atomic_load(p, __ATOMIC_RELAXED, __HIP_MEMORY_SCOPE_AGENT); }
__device__ __forceinline__ unsigned xb_add(unsigned* p, unsigned v) { return __hip_atomic_fetch_add(p, v, __ATOMIC_RELAXED, __HIP_MEMORY_SCOPE_AGENT); }
__device__ __forceinline__ unsigned xb_xcc_id() { return (unsigned)__builtin_amdgcn_s_getreg((3 << 11) | 20) & 0xFu; }
#define XB_SPIN(cond, bar) do { unsigned _sp = 0; while (cond) { __builtin_amdgcn_s_sleep(1); \
    if ((++_sp & 255u) == 0u) { if (xb_ld(&(bar)[XB_TMO])) break; if (_sp > XB_SPIN_CAP) { atomicAdd(&(bar)[XB_TMO], 1u); break; } } } } while (0)
struct XcdBarrier { unsigned* bar; unsigned x; volatile unsigned* st; };
__device__ __forceinline__ void xcd_barrier_complete(unsigned* bar, unsigned x, unsigned G, unsigned& nloc, unsigned& nx) {
    unsigned sum, cnt, mine, sp = 0u;
    for (;;) {
        sum = 0u; cnt = 0u; mine = 0u;
#pragma unroll
        for (unsigned j = 0; j < 16; ++j) { const unsigned c = xb_ld(&bar[XB_XCNT(j)]); sum += c; cnt += (c > 0u) ? 1u : 0u; mine = (j == x) ? c : mine; }
        if (sum == G) break;
        __builtin_amdgcn_s_sleep(1);
        if ((++sp & 255u) == 0u) { if (xb_ld(&bar[XB_TMO])) break; if (sp > XB_SPIN_CAP) { atomicAdd(&bar[XB_TMO], 1u); break; } }
    }
    nloc = mine > 0u ? mine : 1u; nx = cnt > 0u ? cnt : 1u;
}
__device__ __forceinline__ void xcd_barrier(const XcdBarrier& b, bool leader, unsigned G) {
    asm volatile("s_waitcnt vmcnt(0)" ::: "memory");
    __syncthreads();
    if (leader) {
        unsigned* bar = b.bar;
        __builtin_amdgcn_s_waitcnt(0);
        unsigned nloc = b.st[0], nx = b.st[1];
        if (nloc == 0u) { xcd_barrier_complete(bar, b.x, G, nloc, nx); b.st[0] = nloc; b.st[1] = nx; }
        const unsigned old = xb_add(&bar[XB_XSUB(b.x)], 1u);
        const unsigned gen = old / nloc;
        if (old + 1u == (gen + 1u) * nloc) {
            __builtin_amdgcn_fence(__ATOMIC_RELEASE, "agent");
            asm volatile("s_waitcnt vmcnt(0)" ::: "memory");
            const unsigned og = xb_add(&bar[XB_TOP], 1u);
            const unsigned tg = og / nx;
            if (og + 1u == (tg + 1u) * nx) xb_add(&bar[XB_TOPGEN], 1u);
            else XB_SPIN(xb_ld(&bar[XB_TOPGEN]) == tg, bar);
            __builtin_amdgcn_fence(__ATOMIC_ACQUIRE, "agent");
            xb_add(&bar[XB_XGEN(b.x)], 1u);
            asm volatile("s_waitcnt vmcnt(0)" ::: "memory");
        } else {
            XB_SPIN(xb_ld(&bar[XB_XGEN(b.x)]) == gen, bar);
            __builtin_amdgcn_fence(__ATOMIC_ACQUIRE, "agent");
            asm volatile("s_waitcnt vmcnt(0)" ::: "memory");
        }
    }
    __syncthreads();
}

__device__ __forceinline__ void sub_barrier(unsigned* ctr, unsigned n, bool leader) {
    asm volatile("s_waitcnt vmcnt(0)" ::: "memory");
    __syncthreads();
    if (leader) {
        __builtin_amdgcn_fence(__ATOMIC_RELEASE, "agent");
        asm volatile("s_waitcnt vmcnt(0)" ::: "memory");
        (void)xb_add(ctr, 1u);
        unsigned sp = 0u; while (xb_ld(ctr) < n) { __builtin_amdgcn_s_sleep(1); if (++sp > XB_SPIN_CAP) break; }
        __builtin_amdgcn_fence(__ATOMIC_ACQUIRE, "agent");
        asm volatile("s_waitcnt vmcnt(0)" ::: "memory");
    }
    __syncthreads();
}

__global__ void __launch_bounds__(512, 2) mega(Args args) {
    extern __shared__ __attribute__((aligned(16))) unsigned char lds[];
    cg::grid_group grid = cg::this_grid();
    Frame F;
    F.lds = lds; F.wave = __builtin_amdgcn_readfirstlane(threadIdx.x >> 6); F.bid = blockIdx.x; F.G = gridDim.x;
    F.a = &args; F.ws = args.ws;
    const int lo = args.ph_lo, hi = args.ph_hi;
    unsigned long long sec_acc = 0ull;
    if (lo < 0) grid.sync();
    volatile unsigned* xst = (volatile unsigned*)(lds + LDS_BYTES - 64);
    const bool leader = (F.wave == 0) && (fresh_lane() == 0);
    if (leader) { xst[0] = 0u; xst[1] = 0u; }
    XcdBarrier xbar; xbar.bar = (unsigned*)(F.ws + WS_CTL + CTL_BAR); xbar.x = xb_xcc_id(); xbar.st = xst;
    if (leader) (void)xb_add(&xbar.bar[XB_XCNT(xbar.x)], 1u);
    __syncthreads();
    bf16* W8 = (bf16*)((unsigned char*)args.out + (size_t)64 * MiB);
#define IN(k) (lo <= (k) && (k) < hi)
#if PROBE_MASK
    unsigned long long pr_acc = 0ull, pr_t0 = rt_now();
#define SEAM(k) do { if (IN(k) && IN((k) + 1)) { xcd_barrier(xbar, (F.wave == 0) && (fresh_lane() == 0), (unsigned)F.G); } { const unsigned long long t1_ = rt_now(); if ((PROBE_MASK >> (k)) & 1u) pr_acc += t1_ - pr_t0; pr_t0 = t1_; } } while (0)
#else
#define SEAM(k) do { if (IN(k) && IN((k) + 1)) { xcd_barrier(xbar, (F.wave == 0) && (fresh_lane() == 0), (unsigned)F.G); } } while (0)
#endif
    if (IN(0)) { ph0_prologue(F); } SEAM(0);
    if (IN(1)) { gemm(F, (const bf16*)args.out, 2048, (const bf16*)(F.ws + WS_WIN), 2048, T, NCOLS, 2048, OpProj{F.ws}); w8_transposes(F, W8); } SEAM(1);
    if (IN(2)) {
        if (F.G == 256) {
            if (F.bid < 128) hgrn_chunked(F, F.bid, sec_acc);
            else { ph2_side(F, F.bid - 128, 128); sub_barrier((unsigned*)(F.ws + WS_CTL + CTL_BAR) + 3520, 128u, (F.wave == 0) && (fresh_lane() == 0)); ph5_select(F, F.bid - 128, 128); }
        } else {
            for (int u = F.bid; u < 128; u += F.G) hgrn_chunked(F, u, sec_acc);
            ph2_side(F, F.bid, F.G);
            xcd_barrier(xbar, (F.wave == 0) && (fresh_lane() == 0), (unsigned)F.G);
            ph5_select(F, F.bid, F.G);
        }
    } SEAM(2);
    if (IN(4)) {
        gemm(F, (const bf16*)(F.ws + WS_CKV), 256, (const bf16*)(F.ws + WS_WKV), 256, T, 4096, 256, OpSplit2{F.slot(1), F.slot(2)});
    } SEAM(4);
    if (IN(6)) { ph6_attn(F); } SEAM(6);
    if (IN(7)) {
        pg8::Gemm g{2048, 4096, 4096}; pg8::MultiOrder<1> S; S.s[0] = pg8::Sub{F.slot(0), W8, 64, 8}; S.lda = 2048; S.ldb = 4096; S.G = F.G; S.c = F.bid; S.A2 = F.slot(3);
        EpiYAB E{F.slot(6), F.slot(7)};
        pg8::gemm_phase<EpiYAB, pg8::MultiOrder<1>, true, true>((PG8_LAS unsigned char*)F.lds, g, S, E, F.wave, F.lane());
    } SEAM(7);
    if (IN(8)) { gemm_epi(F, F.slot(6), 2048, W8 + (size_t)2 * 2048 * 2048, 2048, T, 2048, 2048, EpiMixStats{args.in[0], F.slot(0), (float*)(F.ws + WS_CTL + CTL_ST1)}); } SEAM(8);
    if (IN(10)) {
        pg8::MultiOrder<3> S; S.lda = 2048; S.ldb = 2048; S.G = F.G; S.c = F.bid;
        S.s[0] = pg8::Sub{F.slot(0), W8 + (size_t)3 * 2048 * 2048, 64, 8};
        S.s[1] = pg8::Sub{(const bf16*)(F.ws + WS_MEMB), W8 + (size_t)4 * 2048 * 2048, 8, 8};
        S.s[2] = pg8::Sub{W8 + (size_t)5 * 2048 * 2048, (const bf16*)(F.ws + WS_MEMB), 8, 8};
        gemm_multi<3>(F, S, 2048, OpCQKV{F.slot(1), (bf16*)(F.ws + WS_CKV), (bf16*)(F.ws + WS_IKW), (float*)(F.ws + WS_CTL + CTL_ST1), (float*)(F.ws + WS_CTL + CTL_CVEC), (float*)(F.ws + WS_CTL + CTL_CVEC) + 2048});
    } SEAM(10);
    if (IN(11)) {
        pg8::BatchOrder<OffS> S{F.slot(1), (const bf16*)(F.ws + WS_CKV), 8, 1, 32, 2048, 2048, F.G, F.bid, OffS()};
        gemm_batch(F, S, 512, OpLogit{(float*)F.slot(2)});
    } SEAM(11);
    if (IN(12)) { ph_xsoftmax(F, (const float*)F.slot(2), F.slot(3));
        cvt_fp6_stream(F, args.in[24], (unsigned char*)F.slot(5), (size_t)16384 * 64, PU_SCALE); cvt_fp6_stream(F, args.in[25], (unsigned char*)F.slot(5) + (size_t)32 * MiB, (size_t)16384 * 64, PV_SCALE); } SEAM(12);
    if (IN(13)) {
        pg8::BatchOrder<OffPV> S{F.slot(3), (const bf16*)(F.ws + WS_IKW), 8, 2, 32, 1024, 2048, F.G, F.bid, OffPV()};
        gemm_batch(F, S, 256, OpCO{F.slot(4)});
    } SEAM(13);
    if (IN(14)) { gemm_epi(F, F.slot(4), 2048, W8 + (size_t)6 * 2048 * 2048, 2048, T, 2048, 2048, EpiCOStats{F.slot(0), (float*)(F.ws + WS_CTL + CTL_ST1), (float*)(F.ws + WS_CTL + CTL_ST2), args.in[14], args.in[15]}); } SEAM(14);
    if (IN(16)) { gemm(F, F.slot(0), 2048, W8 + (size_t)7 * 2048 * 2048, 2048, T, 2048, 2048, OpPQFold{(float*)F.slot(1), (float*)(F.ws + WS_CTL + CTL_ST2), (float*)(F.ws + WS_CTL + CTL_CVEC) + 4096, (float*)(F.ws + WS_CTL + CTL_CVEC) + 6144}); } SEAM(16);
    if (IN(17)) { ph_peer_select(F); } SEAM(17);
    if (IN(18)) { ph16_experts(F); }
#if PROBE_MASK
    xcd_barrier(xbar, (F.wave == 0) && (fresh_lane() == 0), (unsigned)F.G);
    { const unsigned long long t1_ = rt_now(); if ((PROBE_MASK >> 18) & 1u) pr_acc += t1_ - pr_t0; pr_acc += sec_acc;
      if (F.bid == 0 && threadIdx.x == 0) { const unsigned long long ts_ = rt_now(); while (rt_now() - ts_ < pr_acc) __builtin_amdgcn_s_sleep(8); } }
#endif
#undef IN
#undef SEAM
}

extern "C" void kernel_launch(void* const* d_in, const int* in_sizes, int n_in, void* d_out, int out_size, void* d_ws, size_t ws_size, hipStream_t stream) {
    static int grid = 0;
    if (grid == 0) {
        if (n_in != 28 || out_size != T * D || ws_size < WS_END) { fprintf(stderr, "kernel_launch: unexpected shapes (n_in %d out %d ws %zu)\n", n_in, out_size, ws_size); grid = -1; return; }
        int dev = 0, cus = 0, per_cu = 0;
        hipGetDevice(&dev); hipDeviceGetAttribute(&cus, hipDeviceAttributeMultiprocessorCount, dev);
        hipFuncSetAttribute((const void*)mega, hipFuncAttributeMaxDynamicSharedMemorySize, LDS_BYTES);
        hipOccupancyMaxActiveBlocksPerMultiprocessor(&per_cu, (const void*)mega, 512, LDS_BYTES);
        if (per_cu < 1) { fprintf(stderr, "kernel_launch: occupancy query says %d blocks per CU\n", per_cu); per_cu = 1; }
        (void)hipGetLastError();
        grid = cus;
    }
    if (grid < 0) return;
    (void)hipMemsetAsync((char*)d_ws + WS_CTL, 0, CTL_ZERO, stream);
    Args a{};
    for (int i = 0; i < 28; ++i) a.in[i] = (const float*)d_in[i];
    a.out = (float*)d_out; a.ws = (unsigned char*)d_ws;
#if ONE_LAUNCH
    a.ph_lo = 0; a.ph_hi = NPH;
    void* params[] = {&a};
    hipError_t e = hipLaunchCooperativeKernel((const void*)mega, dim3(grid), dim3(512), params, LDS_BYTES, stream);
    if (e != hipSuccess) fprintf(stderr, "cooperative launch failed: %s\n", hipGetErrorString(e));
#else
    for (int ph = 0; ph < NPH; ++ph) {
        a.ph_lo = ph; a.ph_hi = ph + 1;
        void* params[] = {&a};
        hipError_t e = hipLaunchCooperativeKernel((const void*)mega, dim3(grid), dim3(512), params, LDS_BYTES, stream);
        if (e != hipSuccess) { fprintf(stderr, "launch %d failed: %s\n", ph, hipGetErrorString(e)); break; }
    }
#endif
}
```

```cpp
#include <hip/hip_runtime.h>
#include <hip/hip_cooperative_groups.h>
#include <cstdint>
#include <cmath>
#include <cstdio>
namespace cg = cooperative_groups;

#ifndef ONE_LAUNCH
#define ONE_LAUNCH 1
#endif
#ifndef PROBE_MASK
#define PROBE_MASK 0u
#endif
#ifndef PROBE_SEC
#define PROBE_SEC 0
#endif

typedef unsigned short bf16;
typedef short bf16x8 __attribute__((ext_vector_type(8)));
typedef float f32x4 __attribute__((ext_vector_type(4)));
typedef float f32x16 __attribute__((ext_vector_type(16)));
typedef unsigned u32x4 __attribute__((ext_vector_type(4)));
typedef unsigned u32x2 __attribute__((ext_vector_type(2)));
typedef float f32x2v __attribute__((ext_vector_type(2)));

constexpr int T = 16384, D = 2048, SEQ = 2048, NB = 8;
constexpr int NCOLS = 16896;
constexpr float ALPHA = 1.189207115002721f;
constexpr int NPH = 19;

constexpr size_t MiB = 1u << 20;
constexpr size_t WS_CTL = 0, WS_MEMB = 1 * MiB, WS_WKV = 9 * MiB, WS_LB = 11 * MiB, WS_MASK = 12 * MiB, WS_WIN = 17 * MiB,
                 WS_SLOT = 83 * MiB, SLOT_BYTES = 64 * MiB, WS_CKV = 595 * MiB, WS_IKW = 603 * MiB, WS_CK = 611 * MiB, WS_VT = 619 * MiB, WS_END = 627 * MiB;
constexpr int LDS_BYTES = 157696;
constexpr size_t CTL_BAR = 16384, CTL_CVEC = 65536, CTL_ST1 = 262144, CTL_ST2 = 393216, CTL_ZERO = 524288;

struct Args {
    const float* in[28];
    float* out;
    unsigned char* ws;
    int ph_lo, ph_hi;
};

#define WAVE_SYNC() asm volatile("s_waitcnt lgkmcnt(0)" ::: "memory")

__device__ __forceinline__ unsigned f2bf(float f) { unsigned u = __float_as_uint(f); return (u + 0x7fffu + ((u >> 16) & 1u)) >> 16; }
__device__ __forceinline__ unsigned pk2(float lo, float hi) { return f2bf(lo) | (f2bf(hi) << 16); }
__device__ __forceinline__ float bf2f(unsigned h) { return __uint_as_float(h << 16); }
__device__ __forceinline__ float bflo(unsigned w) { return __uint_as_float(w << 16); }
__device__ __forceinline__ float bfhi(unsigned w) { return __uint_as_float(w & 0xffff0000u); }
__device__ __forceinline__ float wave_sum(float v) {
#pragma unroll
    for (int o = 32; o >= 1; o >>= 1) v += __shfl_xor(v, o);
    return v;
}
__device__ __forceinline__ float wave_max(float v) {
#pragma unroll
    for (int o = 32; o >= 1; o >>= 1) v = fmaxf(v, __shfl_xor(v, o));
    return v;
}
__device__ __forceinline__ float row16_sum(float v) {
    v += __int_as_float(__builtin_amdgcn_mov_dpp(__float_as_int(v), 0xB1, 0xF, 0xF, false));
    v += __int_as_float(__builtin_amdgcn_mov_dpp(__float_as_int(v), 0x4E, 0xF, 0xF, false));
    v += __int_as_float(__builtin_amdgcn_mov_dpp(__float_as_int(v), 0x124, 0xF, 0xF, false));
    v += __int_as_float(__builtin_amdgcn_mov_dpp(__float_as_int(v), 0x128, 0xF, 0xF, false));
    return v;
}
__device__ __forceinline__ float wave_sum_dpp(float v) {
    v = row16_sum(v);
    return (__int_as_float(__builtin_amdgcn_readlane(__float_as_int(v), 0)) + __int_as_float(__builtin_amdgcn_readlane(__float_as_int(v), 16)))
         + (__int_as_float(__builtin_amdgcn_readlane(__float_as_int(v), 32)) + __int_as_float(__builtin_amdgcn_readlane(__float_as_int(v), 48)));
}
__device__ __forceinline__ float sigm(float x) { return 1.0f / (1.0f + expf(-x)); }
__device__ __forceinline__ void unpack8(u32x4 w, float* f) {
    f[0] = bflo(w.x); f[1] = bfhi(w.x); f[2] = bflo(w.y); f[3] = bfhi(w.y); f[4] = bflo(w.z); f[5] = bfhi(w.z); f[6] = bflo(w.w); f[7] = bfhi(w.w);
}

__device__ __forceinline__ int fresh_lane() { int l; asm volatile("v_mbcnt_lo_u32_b32 %0, -1, 0\n\tv_mbcnt_hi_u32_b32 %0, -1, %0" : "=v"(l)); return l; }
__device__ __forceinline__ unsigned long long rt_now() { unsigned long long t; asm volatile("s_memrealtime %0\n\ts_waitcnt lgkmcnt(0)" : "=s"(t) :: "memory"); return t; }
struct Frame {
    unsigned char* lds;
    int wave, bid, G;
    __device__ __forceinline__ int lane() const { return fresh_lane(); }
    const Args* a;
    unsigned char* ws;
    __device__ __forceinline__ bf16* slot(int i) const { return (bf16*)(ws + WS_SLOT + (size_t)i * SLOT_BYTES); }
};

namespace pg8 {
#define PG8_LAS __attribute__((address_space(3)))
constexpr int BM = 256, BK = 64, HALF = 128, HTB = HALF * BK * 2, STAGE_BYTES = 8 * HTB, NXCD = 8, WGM = 8;
__host__ __device__ __forceinline__ int lds_byte(int r, int c) { const int st = (r >> 4) * 2 + (c >> 5), rr = r & 15, cc = c & 31, ob = rr * 64 + cc * 2; return st * 1024 + (ob ^ (((ob >> 9) & 1) << 5)); }
__host__ __device__ __forceinline__ void stage_rc(int b, int& R, int& C) { const int st = b / 1024, sb = b % 1024, swz = sb ^ (((sb >> 9) & 1) << 5); R = (st >> 1) * 16 + swz / 64; C = (st & 1) * 32 + (swz % 64) / 2; }
__host__ __device__ __forceinline__ int perm32(int rho) { const int n = rho >> 4, i = rho & 15; return 8 * (i >> 2) + 4 * n + (i & 3); }
struct Unit { int pm, pn, z; const char* a; const char* b; const char* a2; };
struct Gemm { int lda, ldb, K; };
__device__ __forceinline__ void tile_of(int wgid, int nM, int nN, int& pm, int& pn) {
    const int nwg = nM * nN; { const int q = nwg / NXCD, r = nwg % NXCD, xcd = wgid % NXCD, off = wgid / NXCD; wgid = (xcd < r ? xcd * (q + 1) : r * (q + 1) + (xcd - r) * q) + off; }
    const int nig = WGM * nN, gid = wgid / nig, fm = gid * WGM, gsz = (nM - fm) < WGM ? (nM - fm) : WGM;
    pm = fm + ((wgid % nig) % gsz); pn = (wgid % nig) / gsz;
}
struct Sub { const bf16* A; const bf16* Bt; int nM, nN; };
template <int NS> struct MultiOrder {
    Sub s[NS]; int lda, ldb, G, c; const bf16* A2 = nullptr;
    __device__ __forceinline__ bool next(int i, Unit& u) const {
        int L = i * G + c;
#pragma unroll
        for (int k = 0; k < NS; ++k) { const int n = s[k].nM * s[k].nN;
            if (L < n) { tile_of(L, s[k].nM, s[k].nN, u.pm, u.pn); u.z = k; u.a = (const char*)(s[k].A + (size_t)u.pm * BM * lda); u.b = (const char*)(s[k].Bt + (size_t)u.pn * BM * ldb); u.a2 = A2 ? (const char*)(A2 + (size_t)u.pm * BM * lda) : nullptr; return true; }
            L -= n; }
        return false;
    }
};
template <class Off> struct BatchOrder {
    const bf16* A; const bf16* Bt; int nM, nN, nz, lda, ldb, G, c; Off off;
    __device__ __forceinline__ bool next(int i, Unit& u) const {
        const int L = i * G + c, per = nM * nN; if (L >= per * nz) return false;
        u.z = L / per; const int r = L % per; u.pn = r / nM; u.pm = r % nM;
        u.a = (const char*)(A + off.a(u.z) + (size_t)u.pm * BM * lda); u.b = (const char*)(Bt + off.b(u.z) + (size_t)u.pn * BM * ldb); u.a2 = nullptr; return true;
    }
};
__device__ __forceinline__ unsigned cvt_pk_bf16(float lo, float hi) { unsigned r; asm volatile("v_cvt_pk_bf16_f32 %0, %1, %2" : "=v"(r) : "v"(lo), "v"(hi)); return r; }

template <class Op> struct Epi8 {
    static constexpr bool PERM = true;
    Op op;
    __device__ __forceinline__ void operator()(const f32x4 (&acc)[2][2][4][2], const Unit& u, int wr, int wc, int fr, int fq) const {
        const int row0 = u.pm * BM + wr * 64 + fr, col0 = u.pn * BM + wc * 32 + 8 * fq;
        if constexpr (Op::NLD == 0) {
#pragma unroll
            for (int ai = 0; ai < 2; ++ai)
#pragma unroll
                for (int m = 0; m < 4; ++m)
#pragma unroll
                    for (int bj = 0; bj < 2; ++bj) op(u.z, row0 + ai * HALF + m * 16, col0 + bj * HALF, acc[ai][bj][m][0], acc[ai][bj][m][1]);
        } else {
#pragma unroll
            for (int ai = 0; ai < 2; ++ai) {
                u32x4 tmp[4][2][Op::NLD];
#pragma unroll
                for (int m = 0; m < 4; ++m)
#pragma unroll
                    for (int bj = 0; bj < 2; ++bj) op.ld(u.z, row0 + ai * HALF + m * 16, col0 + bj * HALF, tmp[m][bj]);
#pragma unroll
                for (int m = 0; m < 4; ++m)
#pragma unroll
                    for (int bj = 0; bj < 2; ++bj) op.ap(u.z, row0 + ai * HALF + m * 16, col0 + bj * HALF, acc[ai][bj][m][0], acc[ai][bj][m][1], tmp[m][bj]);
            }
        }
    }
};

template <class Epi, class Sched, bool ALIGN_EPI, bool SPLIT = false>
__device__ __forceinline__ void gemm_phase(PG8_LAS unsigned char* lds, const Gemm g, const Sched& S, const Epi& E, int wid, int lane) {
    const int tid = wid * 64 + lane, wr = wid >> 2, wc = wid & 3, fr = lane & 15, fq = lane >> 4;
    const int K = g.K, nt = K / BK;
    unsigned voffA[2], voffB[2];
#pragma unroll
    for (int i = 0; i < 2; ++i) { int R, C; stage_rc(tid * 16 + i * 8192, R, C); const int Rb = Epi::PERM ? ((R & ~31) + perm32(R & 31)) : R;
        voffA[i] = (unsigned)(R * g.lda + C) * 2u; voffB[i] = (unsigned)(Rb * g.ldb + C) * 2u; }
    const size_t kstep = (size_t)(BK * 2);
    const size_t hstepA = (size_t)HALF * g.lda * 2, hstepB = (size_t)HALF * g.ldb * 2;
    const unsigned ldsw = (unsigned)wid * 1024u;
    const int aoff = lds_byte(wr * 64 + fr, fq * 8), boff = lds_byte(wc * 32 + fr, fq * 8);
#define PG8_SA(b, h) (((b) * 2 + (h)) * HTB)
#define PG8_SB(b, h) ((4 + (b) * 2 + (h)) * HTB)
#define PG8_STAGE(bufoff, gbase, voff) do { _Pragma("unroll") for (int _i = 0; _i < 2; ++_i) \
        __builtin_amdgcn_global_load_lds((const unsigned*)((const char*)(gbase) + (voff)[_i]), (PG8_LAS unsigned*)(lds + (bufoff) + ldsw + _i * 8192), 16, 0, 0); } while (0)
#define PG8_LDA(dst, b, h) do { _Pragma("unroll") for (int m = 0; m < 4; ++m) _Pragma("unroll") for (int k = 0; k < 2; ++k) dst[m][k] = *(const PG8_LAS bf16x8*)(lds + PG8_SA(b, h) + aoff + m * 2048 + k * 1024); } while (0)
#define PG8_LDB(dst, b, h) do { _Pragma("unroll") for (int n = 0; n < 2; ++n) _Pragma("unroll") for (int k = 0; k < 2; ++k) dst[n][k] = *(const PG8_LAS bf16x8*)(lds + PG8_SB(b, h) + boff + n * 2048 + k * 1024); } while (0)
#define PG8_MMA(ai, bj, At, Bt) do { __builtin_amdgcn_s_setprio(1); _Pragma("unroll") for (int m = 0; m < 4; ++m) _Pragma("unroll") for (int n = 0; n < 2; ++n) _Pragma("unroll") for (int k = 0; k < 2; ++k) \
        acc[ai][bj][m][n] = __builtin_amdgcn_mfma_f32_16x16x32_bf16(Bt[n][k], At[m][k], acc[ai][bj][m][n], 0, 0, 0); __builtin_amdgcn_s_setprio(0); } while (0)
#define PG8_WAIT_V(n) asm volatile("s_waitcnt vmcnt(" #n ")" ::: "memory")
#define PG8_WAIT_L(n) asm volatile("s_waitcnt lgkmcnt(" #n ")" ::: "memory")
#define PG8_BAR __builtin_amdgcn_s_barrier()
#define PG8_SCHED __builtin_amdgcn_sched_barrier(0)
    Unit cur, nxt; int ui = 0;
    if (!S.next(0, cur)) return;
    f32x4 acc[2][2][4][2];
#pragma unroll
    for (int a = 0; a < 2; ++a)
#pragma unroll
        for (int b = 0; b < 2; ++b)
#pragma unroll
            for (int m = 0; m < 4; ++m)
#pragma unroll
                for (int n = 0; n < 2; ++n) acc[a][b][m][n] = (f32x4){0.f, 0.f, 0.f, 0.f};
    bf16x8 At[4][2], B0[2][2], B1[2][2];
    const char* cA = cur.a; const char* cB = cur.b;
    const int nth = nt / 2;
    const char* cA2 = SPLIT ? cur.a2 - (size_t)nth * kstep : cA;
    PG8_STAGE(PG8_SB(0, 0), cB, voffB); PG8_STAGE(PG8_SB(0, 1), cB + hstepB, voffB); PG8_STAGE(PG8_SA(0, 0), cA, voffA); PG8_STAGE(PG8_SA(0, 1), cA + hstepA, voffA);
    if (wr == 1) PG8_BAR;
    PG8_WAIT_V(2); PG8_BAR;
    PG8_STAGE(PG8_SB(1, 0), cB + kstep, voffB); PG8_STAGE(PG8_SA(1, 0), cA + kstep, voffA); PG8_STAGE(PG8_SB(1, 1), cB + hstepB + kstep, voffB);
    PG8_WAIT_V(6); PG8_BAR;
    for (;;) {
        const bool has_next = S.next(ui + 1, nxt);
        const char* nA = has_next ? nxt.a : cA; const char* nB = has_next ? nxt.b : cB;
        const char* nA2 = SPLIT ? (has_next ? nxt.a2 - (size_t)nth * kstep : cA2) : nA;
#pragma unroll 1
        for (int half_ = 0; half_ < (SPLIT ? 2 : 1); ++half_) {
        if constexpr (SPLIT) { if (half_ == 1) { __builtin_amdgcn_sched_barrier(0); E.mid(acc, cur, wr, wc, fr, fq); __builtin_amdgcn_sched_barrier(0); } }
        const int t_lo = SPLIT ? half_ * nth : 0, t_hi = SPLIT ? (half_ + 1) * nth : nt;
#pragma unroll 1
        for (int t = t_lo; t < t_hi; t += 2) {
            const bool last = (t == nt - 2);
            const char* bA1 = (!SPLIT || t < nth) ? cA : cA2; const char* bA2 = (!SPLIT || t + 2 < nth) ? cA : cA2;
            const char* a1 = bA1 + (size_t)(t + 1) * kstep;
            const char* a2 = last ? nA : bA2 + (size_t)(t + 2) * kstep; const char* b2 = last ? nB : cB + (size_t)(t + 2) * kstep;
            const char* a3 = a2 + kstep; const char* b3 = b2 + kstep;
            PG8_LDB(B0, 0, 0); PG8_LDB(B1, 0, 1); PG8_SCHED; PG8_LDA(At, 0, 0); PG8_STAGE(PG8_SA(1, 1), a1 + hstepA, voffA);
            PG8_WAIT_V(8); PG8_WAIT_L(0); PG8_BAR; PG8_MMA(0, 0, At, B0); PG8_MMA(0, 1, At, B1); PG8_BAR; PG8_SCHED;
            PG8_LDA(At, 0, 1); PG8_STAGE(PG8_SB(0, 0), b2, voffB); PG8_STAGE(PG8_SB(0, 1), b2 + hstepB, voffB); PG8_STAGE(PG8_SA(0, 0), a2, voffA);
            PG8_WAIT_V(8); PG8_WAIT_L(0); PG8_BAR; PG8_MMA(1, 0, At, B0); PG8_MMA(1, 1, At, B1); PG8_BAR; PG8_SCHED;
            PG8_LDB(B0, 1, 0); PG8_LDB(B1, 1, 1); PG8_SCHED; PG8_LDA(At, 1, 0); PG8_STAGE(PG8_SA(0, 1), a2 + hstepA, voffA);
            PG8_WAIT_V(8); PG8_WAIT_L(0); PG8_BAR; PG8_MMA(0, 0, At, B0); PG8_MMA(0, 1, At, B1); PG8_BAR; PG8_SCHED;
            PG8_LDA(At, 1, 1); PG8_STAGE(PG8_SB(1, 0), b3, voffB); PG8_STAGE(PG8_SB(1, 1), b3 + hstepB, voffB); PG8_STAGE(PG8_SA(1, 0), a3, voffA);
            PG8_WAIT_V(8); PG8_WAIT_L(0); PG8_BAR; PG8_MMA(1, 0, At, B0); PG8_MMA(1, 1, At, B1); PG8_BAR; PG8_SCHED;
        }
        }
        if constexpr (ALIGN_EPI) { if (wr == 0) PG8_BAR; }
        E(acc, cur, wr, wc, fr, fq);
        if (!has_next) break;
#pragma unroll
        for (int a = 0; a < 2; ++a)
#pragma unroll
            for (int b = 0; b < 2; ++b)
#pragma unroll
                for (int m = 0; m < 4; ++m)
#pragma unroll
                    for (int n = 0; n < 2; ++n) acc[a][b][m][n] = (f32x4){0.f, 0.f, 0.f, 0.f};
        cur = nxt; cA = nA; cB = nB; cA2 = nA2; ++ui;
        if constexpr (ALIGN_EPI) { if (wr == 1) PG8_BAR; }
    }
    PG8_WAIT_V(0);
    if constexpr (!ALIGN_EPI) { if (wr == 0) PG8_BAR; }
    PG8_BAR;
#undef PG8_SA
#undef PG8_SB
#undef PG8_STAGE
#undef PG8_LDA
#undef PG8_LDB
#undef PG8_MMA
#undef PG8_WAIT_V
#undef PG8_WAIT_L
#undef PG8_BAR
#undef PG8_SCHED
}
}

__device__ __forceinline__ u32x4 pack8(f32x4 a, f32x4 b) { u32x4 w; w.x = pg8::cvt_pk_bf16(a.x, a.y); w.y = pg8::cvt_pk_bf16(a.z, a.w); w.z = pg8::cvt_pk_bf16(b.x, b.y); w.w = pg8::cvt_pk_bf16(b.z, b.w); return w; }
__device__ __forceinline__ void unpack8v(u32x4 w, f32x4& a, f32x4& b) { a.x = bflo(w.x); a.y = bfhi(w.x); a.z = bflo(w.y); a.w = bfhi(w.y); b.x = bflo(w.z); b.y = bfhi(w.z); b.z = bflo(w.w); b.w = bfhi(w.w); }
__device__ __forceinline__ f32x4 sigm4(f32x4 v) { f32x4 r; r.x = sigm(v.x); r.y = sigm(v.y); r.z = sigm(v.z); r.w = sigm(v.w); return r; }

struct OpProj { static constexpr int NLD = 0; unsigned char* ws;
    __device__ __forceinline__ void operator()(int z, int row, int col, f32x4 a, f32x4 b) const {
        bf16* p;
        if (col < 16384) p = (bf16*)(ws + WS_SLOT + (size_t)(col >> 11) * SLOT_BYTES) + (size_t)row * 2048 + (col & 2047);
        else if (col < 16640) p = (bf16*)(ws + WS_CKV) + (size_t)row * 256 + (col - 16384);
        else p = (bf16*)(ws + WS_IKW) + (size_t)row * 256 + (col - 16640);
        *(u32x4*)p = pack8(a, b);
    } };
struct OpProjCKV { static constexpr int NLD = 0; unsigned char* ws;
    __device__ __forceinline__ void operator()(int z, int row, int col, f32x4 a, f32x4 b) const {
        bf16* p;
        if (z == 0) { if (col < 16384) p = (bf16*)(ws + WS_SLOT + (size_t)(col >> 11) * SLOT_BYTES) + (size_t)row * 2048 + (col & 2047);
                      else if (col < 16640) p = (bf16*)(ws + WS_CKV) + (size_t)row * 256 + (col - 16384);
                      else p = (bf16*)(ws + WS_IKW) + (size_t)row * 256 + (col - 16640); }
        else p = (bf16*)(ws + (z == 1 ? WS_CK : WS_VT)) + (size_t)row * 2048 + col;
        *(u32x4*)p = pack8(a, b);
    } };
struct OpBf16 { static constexpr int NLD = 0; bf16* o; int ld;
    __device__ __forceinline__ void operator()(int z, int row, int col, f32x4 a, f32x4 b) const { *(u32x4*)(o + (size_t)row * ld + col) = pack8(a, b); } };
struct OpSplit2 { static constexpr int NLD = 0; bf16* o0; bf16* o1;
    __device__ __forceinline__ void operator()(int z, int row, int col, f32x4 a, f32x4 b) const { bf16* p = (col < 2048 ? o0 : o1) + (size_t)row * 2048 + (col & 2047); *(u32x4*)p = pack8(a, b); } };
struct OpF32 { static constexpr int NLD = 0; float* o; int ld;
    __device__ __forceinline__ void operator()(int z, int row, int col, f32x4 a, f32x4 b) const { float* p = o + (size_t)row * ld + col; *(f32x4*)p = a; *(f32x4*)(p + 4) = b; } };
struct OpYA { static constexpr int NLD = 1; bf16* ga;
    __device__ __forceinline__ void ld(int zi, int row, int col, u32x4* t) const { t[0] = *(const u32x4*)(ga + (size_t)row * 2048 + col); }
    __device__ __forceinline__ void ap(int zi, int row, int col, f32x4 a, f32x4 b, const u32x4* t) const { f32x4 g0, g1; unpack8v(t[0], g0, g1); *(u32x4*)(ga + (size_t)row * 2048 + col) = pack8(sigm4(g0) * a, sigm4(g1) * b); } };
struct OpYB { static constexpr int NLD = 2; bf16* ga; const bf16* gb;
    __device__ __forceinline__ void ld(int zi, int row, int col, u32x4* t) const { const size_t i = (size_t)row * 2048 + col; t[0] = *(const u32x4*)(ga + i); t[1] = *(const u32x4*)(gb + i); }
    __device__ __forceinline__ void ap(int zi, int row, int col, f32x4 a, f32x4 b, const u32x4* t) const { f32x4 m0, m1, g0, g1; unpack8v(t[0], m0, m1); unpack8v(t[1], g0, g1);
        *(u32x4*)(ga + (size_t)row * 2048 + col) = pack8(m0 + sigm4(g0) * a, m1 + sigm4(g1) * b); } };
struct OpMix { static constexpr int NLD = 2; const float* x; float* zo;
    __device__ __forceinline__ void ld(int zi, int row, int col, u32x4* t) const { const size_t i = (size_t)row * 2048 + col; t[0] = *(const u32x4*)(x + i); t[1] = *(const u32x4*)(x + i + 4); }
    __device__ __forceinline__ void ap(int zi, int row, int col, f32x4 a, f32x4 b, const u32x4* t) const { const size_t i = (size_t)row * 2048 + col;
        *(f32x4*)(zo + i) = ALPHA * __builtin_bit_cast(f32x4, t[0]) + a; *(f32x4*)(zo + i + 4) = ALPHA * __builtin_bit_cast(f32x4, t[1]) + b; } };
struct OpRes { static constexpr int NLD = 2; float* zo;
    __device__ __forceinline__ void ld(int zi, int row, int col, u32x4* t) const { const size_t i = (size_t)row * 2048 + col; t[0] = *(const u32x4*)(zo + i); t[1] = *(const u32x4*)(zo + i + 4); }
    __device__ __forceinline__ void ap(int zi, int row, int col, f32x4 a, f32x4 b, const u32x4* t) const { const size_t i = (size_t)row * 2048 + col;
        *(f32x4*)(zo + i) = ALPHA * __builtin_bit_cast(f32x4, t[0]) + a; *(f32x4*)(zo + i + 4) = ALPHA * __builtin_bit_cast(f32x4, t[1]) + b; } };

__device__ __forceinline__ void row_stats_add(float* st, int row, float s1, float s2, int fq) {
    s1 += __shfl_xor(s1, 16); s1 += __shfl_xor(s1, 32); s2 += __shfl_xor(s2, 16); s2 += __shfl_xor(s2, 32);
    if (fq == 0) { atomicAdd(st + 2 * (size_t)row, s1); atomicAdd(st + 2 * (size_t)row + 1, s2); }
}
__device__ __forceinline__ void row_mu_rstd(const float* st, int row, float& mu, float& rstd) {
    const f32x2v p = *(const f32x2v*)(st + 2 * (size_t)row); mu = p.x * (1.0f / 2048.0f); rstd = rsqrtf(fmaxf(p.y * (1.0f / 2048.0f) - mu * mu, 0.f) + 1e-5f);
}
__device__ __forceinline__ float sum8(f32x4 a, f32x4 b) { return ((a.x + a.y) + (a.z + a.w)) + ((b.x + b.y) + (b.z + b.w)); }
__device__ __forceinline__ float sq8(f32x4 a, f32x4 b) { return ((a.x * a.x + a.y * a.y) + (a.z * a.z + a.w * a.w)) + ((b.x * b.x + b.y * b.y) + (b.z * b.z + b.w * b.w)); }
struct EpiMixStats { static constexpr bool PERM = true; const float* x; bf16* zb; float* st;
    __device__ __forceinline__ void operator()(const f32x4 (&acc)[2][2][4][2], const pg8::Unit& u, int wr, int wc, int fr, int fq) const {
        const int row0 = u.pm * 256 + wr * 64 + fr, col0 = u.pn * 256 + wc * 32 + 8 * fq;
#pragma unroll
        for (int ai = 0; ai < 2; ++ai) {
            f32x4 xv[4][2][2];
#pragma unroll
            for (int m = 0; m < 4; ++m)
#pragma unroll
                for (int bj = 0; bj < 2; ++bj) { const float* p = x + (size_t)(row0 + ai * 128 + m * 16) * 2048 + col0 + bj * 128; xv[m][bj][0] = *(const f32x4*)p; xv[m][bj][1] = *(const f32x4*)(p + 4); }
#pragma unroll
            for (int m = 0; m < 4; ++m) { const int row = row0 + ai * 128 + m * 16; float s1 = 0.f, s2 = 0.f;
#pragma unroll
                for (int bj = 0; bj < 2; ++bj) { const f32x4 z0 = ALPHA * xv[m][bj][0] + acc[ai][bj][m][0], z1 = ALPHA * xv[m][bj][1] + acc[ai][bj][m][1];
                    *(u32x4*)(zb + (size_t)row * 2048 + col0 + bj * 128) = pack8(z0, z1); s1 += sum8(z0, z1); s2 += sq8(z0, z1); }
                row_stats_add(st, row, s1, s2, fq); }
        }
    }
};
struct EpiCOStats { static constexpr bool PERM = true; bf16* zb; const float* st1; float* st2; const float* g; const float* bta;
    __device__ __forceinline__ void operator()(const f32x4 (&acc)[2][2][4][2], const pg8::Unit& u, int wr, int wc, int fr, int fq) const {
        const int row0 = u.pm * 256 + wr * 64 + fr, col0 = u.pn * 256 + wc * 32 + 8 * fq;
        f32x4 gv[2][2], bv[2][2];
#pragma unroll
        for (int bj = 0; bj < 2; ++bj) { gv[bj][0] = *(const f32x4*)(g + col0 + bj * 128); gv[bj][1] = *(const f32x4*)(g + col0 + bj * 128 + 4); bv[bj][0] = *(const f32x4*)(bta + col0 + bj * 128); bv[bj][1] = *(const f32x4*)(bta + col0 + bj * 128 + 4); }
#pragma unroll
        for (int ai = 0; ai < 2; ++ai) {
            u32x4 zv[4][2]; float mu[4], rs[4];
#pragma unroll
            for (int m = 0; m < 4; ++m) { const int row = row0 + ai * 128 + m * 16; row_mu_rstd(st1, row, mu[m], rs[m]);
#pragma unroll
                for (int bj = 0; bj < 2; ++bj) zv[m][bj] = *(const u32x4*)(zb + (size_t)row * 2048 + col0 + bj * 128); }
#pragma unroll
            for (int m = 0; m < 4; ++m) { const int row = row0 + ai * 128 + m * 16; float s1 = 0.f, s2 = 0.f;
#pragma unroll
                for (int bj = 0; bj < 2; ++bj) { f32x4 a0, a1; unpack8v(zv[m][bj], a0, a1);
                    const f32x4 z0 = ALPHA * ((a0 - mu[m]) * rs[m] * gv[bj][0] + bv[bj][0]) + acc[ai][bj][m][0], z1 = ALPHA * ((a1 - mu[m]) * rs[m] * gv[bj][1] + bv[bj][1]) + acc[ai][bj][m][1];
                    *(u32x4*)(zb + (size_t)row * 2048 + col0 + bj * 128) = pack8(z0, z1); s1 += sum8(z0, z1); s2 += sq8(z0, z1); }
                row_stats_add(st2, row, s1, s2, fq); }
        }
    }
};
struct EpiYAB { static constexpr bool PERM = true; bf16* ga; const bf16* gb;
    __device__ __forceinline__ void mid(f32x4 (&acc)[2][2][4][2], const pg8::Unit& u, int wr, int wc, int fr, int fq) const {
        int lofs = (wr * 64 + fr) * 2048 + wc * 32 + 8 * fq; asm volatile("" : "+v"(lofs));
        const size_t ub = ((size_t)u.pm * 256) * 2048 + u.pn * 256;
#pragma unroll
        for (int ai = 0; ai < 2; ++ai)
#pragma unroll
            for (int m = 0; m < 4; ++m) { u32x4 av[2], bv[2];
#pragma unroll
                for (int bj = 0; bj < 2; ++bj) { const size_t i = ub + (size_t)(lofs + (ai * 128 + m * 16) * 2048 + bj * 128); av[bj] = *(const u32x4*)(ga + i); bv[bj] = *(const u32x4*)(gb + i); }
#pragma unroll
                for (int bj = 0; bj < 2; ++bj) { f32x4 a0, a1, b0, b1; unpack8v(av[bj], a0, a1); unpack8v(bv[bj], b0, b1);
#pragma unroll
                    for (int e = 0; e < 4; ++e) { acc[ai][bj][m][0][e] *= (1.0f + __expf(-b0[e])) * __builtin_amdgcn_rcpf(1.0f + __expf(-a0[e])); acc[ai][bj][m][1][e] *= (1.0f + __expf(-b1[e])) * __builtin_amdgcn_rcpf(1.0f + __expf(-a1[e])); } } }
    }
    __device__ __forceinline__ void operator()(const f32x4 (&acc)[2][2][4][2], const pg8::Unit& u, int wr, int wc, int fr, int fq) const {
        int lofs = (wr * 64 + fr) * 2048 + wc * 32 + 8 * fq; asm volatile("" : "+v"(lofs));
        const size_t ub = ((size_t)u.pm * 256) * 2048 + u.pn * 256;
#pragma unroll
        for (int ai = 0; ai < 2; ++ai) { u32x4 bv[4][2];
#pragma unroll
            for (int m = 0; m < 4; ++m)
#pragma unroll
                for (int bj = 0; bj < 2; ++bj) bv[m][bj] = *(const u32x4*)(gb + ub + (size_t)(lofs + (ai * 128 + m * 16) * 2048 + bj * 128));
#pragma unroll
            for (int m = 0; m < 4; ++m)
#pragma unroll
                for (int bj = 0; bj < 2; ++bj) { f32x4 b0, b1; unpack8v(bv[m][bj], b0, b1); f32x4 s0, s1;
#pragma unroll
                    for (int e = 0; e < 4; ++e) { s0[e] = __builtin_amdgcn_rcpf(1.0f + __expf(-b0[e])); s1[e] = __builtin_amdgcn_rcpf(1.0f + __expf(-b1[e])); }
                    *(u32x4*)(ga + ub + (size_t)(lofs + (ai * 128 + m * 16) * 2048 + bj * 128)) = pack8(acc[ai][bj][m][0] * s0, acc[ai][bj][m][1] * s1); } }
    }
};
__device__ __forceinline__ void ln_fold8(const float* st, const float* c1, const float* c0, int row, int col, f32x4& a, f32x4& b) {
    float mu, rs; row_mu_rstd(st, row, mu, rs);
    const f32x4 p0 = *(const f32x4*)(c1 + col), p1 = *(const f32x4*)(c1 + col + 4), q0 = *(const f32x4*)(c0 + col), q1 = *(const f32x4*)(c0 + col + 4);
    a = (a - mu * p0) * rs + q0; b = (b - mu * p1) * rs + q1;
}
struct OpPQFold { static constexpr int NLD = 0; float* o; const float* st; const float* c1; const float* c0;
    __device__ __forceinline__ void operator()(int zi, int row, int col, f32x4 a, f32x4 b) const { ln_fold8(st, c1, c0, row, col, a, b); float* p = o + (size_t)row * 2048 + col; *(f32x4*)p = a; *(f32x4*)(p + 4) = b; } };

template <class Op>
__device__ __forceinline__ void gemm(const Frame& F, const bf16* A, int lda, const bf16* Bt, int ldb, int M, int N, int K, const Op& op) {
    pg8::Gemm g{lda, ldb, K}; pg8::MultiOrder<1> S; S.s[0] = pg8::Sub{A, Bt, M / 256, N / 256}; S.lda = lda; S.ldb = ldb; S.G = F.G; S.c = F.bid;
    pg8::Epi8<Op> E{op};
    pg8::gemm_phase<pg8::Epi8<Op>, pg8::MultiOrder<1>, true>((PG8_LAS unsigned char*)F.lds, g, S, E, F.wave, F.lane());
}
template <class Epi>
__device__ __forceinline__ void gemm_epi(const Frame& F, const bf16* A, int lda, const bf16* Bt, int ldb, int M, int N, int K, const Epi& E) {
    pg8::Gemm g{lda, ldb, K}; pg8::MultiOrder<1> S; S.s[0] = pg8::Sub{A, Bt, M / 256, N / 256}; S.lda = lda; S.ldb = ldb; S.G = F.G; S.c = F.bid;
    pg8::gemm_phase<Epi, pg8::MultiOrder<1>, true>((PG8_LAS unsigned char*)F.lds, g, S, E, F.wave, F.lane());
}
template <int NS, class Op>
__device__ __forceinline__ void gemm_multi(const Frame& F, const pg8::MultiOrder<NS>& S, int K, const Op& op) {
    pg8::Gemm g{S.lda, S.ldb, K}; pg8::Epi8<Op> E{op};
    pg8::gemm_phase<pg8::Epi8<Op>, pg8::MultiOrder<NS>, true>((PG8_LAS unsigned char*)F.lds, g, S, E, F.wave, F.lane());
}
template <class Off, class Op>
__device__ __forceinline__ void gemm_batch(const Frame& F, const pg8::BatchOrder<Off>& S, int K, const Op& op) {
    pg8::Gemm g{S.lda, S.ldb, K}; pg8::Epi8<Op> E{op};
    pg8::gemm_phase<pg8::Epi8<Op>, pg8::BatchOrder<Off>, true>((PG8_LAS unsigned char*)F.lds, g, S, E, F.wave, F.lane());
}
struct OffS { __device__ __forceinline__ size_t a(int z) const { return (size_t)(z >> 2) * 2048 * 2048 + (z & 3) * 512; } __device__ __forceinline__ size_t b(int z) const { return (size_t)(z >> 2) * 256 * 2048 + (z & 3) * 512; } };
struct OffPV { __device__ __forceinline__ size_t a(int z) const { return (size_t)(z >> 2) * 2048 * 1024 + (z & 3) * 256; } __device__ __forceinline__ size_t b(int z) const { return (size_t)(z & 3) * 512 * 2048 + (z >> 2) * 256; } };
struct OpLogit { static constexpr int NLD = 0; float* lg;
    __device__ __forceinline__ void operator()(int z, int row, int col, f32x4 a, f32x4 b) const { float* p = lg + ((size_t)(z >> 2) * 2048 + row) * 1024 + (z & 3) * 256 + col; *(f32x4*)p = a * 0.04419417382415922f; *(f32x4*)(p + 4) = b * 0.04419417382415922f; } };
struct OpCO { static constexpr int NLD = 0; bf16* co;
    __device__ __forceinline__ void operator()(int z, int row, int col, f32x4 a, f32x4 b) const { *(u32x4*)(co + ((size_t)(z >> 2) * 2048 + row) * 2048 + (z & 3) * 512 + col) = pack8(a, b); } };
struct OpCQKV { static constexpr int NLD = 0; bf16* cq; bf16* ck; bf16* vt; const float* st; const float* c1; const float* c0;
    __device__ __forceinline__ void operator()(int z, int row, int col, f32x4 a, f32x4 b) const { if (z == 0) ln_fold8(st, c1, c0, row, col, a, b);
        bf16* o = z == 0 ? cq : (z == 1 ? ck : vt); *(u32x4*)(o + (size_t)row * 2048 + col) = pack8(a, b); } };
__device__ __forceinline__ void ph_xsoftmax(const Frame& F, const float* lg, bf16* P) {
    const int gw = F.bid * 8 + F.wave, NGW = F.G * 8, lane = F.lane();
    for (int u = gw; u < T * 4; u += NGW) {
        const f32x4 v = *(const f32x4*)(lg + (size_t)u * 256 + 4 * lane);
        const float m = wave_max(fmaxf(fmaxf(v.x, v.y), fmaxf(v.z, v.w)));
        const float e0 = expf(v.x - m), e1 = expf(v.y - m), e2 = expf(v.z - m), e3 = expf(v.w - m);
        const float inv = 1.0f / wave_sum((e0 + e1) + (e2 + e3));
        u32x2 w; w.x = pk2(e0 * inv, e1 * inv); w.y = pk2(e2 * inv, e3 * inv);
        *(u32x2*)(P + (size_t)u * 256 + 4 * lane) = w;
    }
}

template <class CM>
__device__ __forceinline__ void transpose_item(const float* W, size_t ldw, bf16* WT, size_t ldwt, int row_off, int nblk, int item, float* scr, int lane, const CM& cm) {
    const int kb = item / nblk, nb = item % nblk, k0 = 64 * kb, n0 = 32 * nb;
    const int c = cm(n0 + (lane & 31));
#pragma unroll 8
    for (int i = 0; i < 32; ++i) { const int kk = 2 * i + (lane >> 5); scr[kk * 33 + (lane & 31)] = (c >= 0) ? W[(size_t)(k0 + kk) * ldw + c] : 0.f; }
    WAVE_SYNC();
    const int c8 = lane & 7;
#pragma unroll
    for (int j = 0; j < 4; ++j) { const int n = (lane >> 3) + 8 * j; const float* s = scr + (8 * c8) * 33 + n;
        u32x4 o; o.x = pk2(s[0 * 33], s[1 * 33]); o.y = pk2(s[2 * 33], s[3 * 33]); o.z = pk2(s[4 * 33], s[5 * 33]); o.w = pk2(s[6 * 33], s[7 * 33]);
        *(u32x4*)(WT + (size_t)(row_off + n0 + n) * ldwt + k0 + 8 * c8) = o; }
    WAVE_SYNC();
}
__device__ __forceinline__ void transpose_item_ln(const float* W, bf16* WT, int item, float* scr, int lane, const float* g, const float* bta, float* c1, float* c0) {
    const int kb = item / 64, nb = item % 64, k0 = 64 * kb, n0 = 32 * nb;
#pragma unroll 8
    for (int i = 0; i < 32; ++i) { const int kk = 2 * i + (lane >> 5); scr[kk * 33 + (lane & 31)] = W[(size_t)(k0 + kk) * 2048 + n0 + (lane & 31)]; }
    WAVE_SYNC();
    const int c8 = lane & 7;
    float gk[8], bk[8];
#pragma unroll
    for (int i = 0; i < 8; ++i) { gk[i] = g[k0 + 8 * c8 + i]; bk[i] = bta[k0 + 8 * c8 + i]; }
#pragma unroll
    for (int j = 0; j < 4; ++j) { const int n = (lane >> 3) + 8 * j; const float* sp = scr + (8 * c8) * 33 + n;
        float wv[8]; float p1 = 0.f, p0 = 0.f;
#pragma unroll
        for (int i = 0; i < 8; ++i) { const float v = sp[i * 33]; wv[i] = v * gk[i]; p1 += wv[i]; p0 += v * bk[i]; }
        u32x4 o; o.x = pk2(wv[0], wv[1]); o.y = pk2(wv[2], wv[3]); o.z = pk2(wv[4], wv[5]); o.w = pk2(wv[6], wv[7]);
        *(u32x4*)(WT + (size_t)(n0 + n) * 2048 + k0 + 8 * c8) = o;
        p1 += __shfl_xor(p1, 1); p1 += __shfl_xor(p1, 2); p1 += __shfl_xor(p1, 4); p0 += __shfl_xor(p0, 1); p0 += __shfl_xor(p0, 2); p0 += __shfl_xor(p0, 4);
        if (c8 == 0) { atomicAdd(c1 + n0 + n, p1); atomicAdd(c0 + n0 + n, p0); } }
    WAVE_SYNC();
}
template <class CM>
__device__ __forceinline__ void transpose_item64(const float* W, size_t ldw, bf16* WT, size_t ldwt, int row_off, int nblk, int item, float* scr, int lane, const CM& cm) {
    const int kb = item / nblk, nb = item % nblk, k0 = 64 * kb, n0 = 64 * nb, r = lane >> 4, c4 = lane & 15;
    const int c = cm(n0 + 4 * c4);
    f32x4 v[16];
#pragma unroll
    for (int i = 0; i < 16; ++i) v[i] = (c >= 0) ? *(const f32x4*)(W + (size_t)(k0 + 4 * i + r) * ldw + c) : (f32x4){0.f, 0.f, 0.f, 0.f};
#pragma unroll
    for (int i = 0; i < 16; ++i) *(f32x4*)(scr + (4 * i + r) * 68 + 4 * c4) = v[i];
    WAVE_SYNC();
    bf16* orow = WT + (size_t)(row_off + n0 + lane) * ldwt + k0;
#pragma unroll
    for (int j = 0; j < 8; ++j) { const float* sp = scr + (8 * j) * 68 + lane;
        u32x4 o; o.x = pk2(sp[0], sp[68]); o.y = pk2(sp[2 * 68], sp[3 * 68]); o.z = pk2(sp[4 * 68], sp[5 * 68]); o.w = pk2(sp[6 * 68], sp[7 * 68]);
        *(u32x4*)(orow + 8 * j) = o; }
    WAVE_SYNC();
}
struct CmIdent { __device__ __forceinline__ int operator()(int n) const { return n; } };
struct CmWin { __device__ __forceinline__ int operator()(int n) const {
    if (n < 10240) return n;
    if (n < 12288) return 10496 + (n - 10240);
    if (n < 14336) return 12688 + (n - 12288);
    if (n < 16384) return 14736 + (n - 14336);
    if (n < 16640) return 10240 + (n - 16384);
    if (n < 16768) return 12544 + (n - 16640);
    if (n < 16784) return 12672 + (n - 16768);
    return -1; } };

__device__ __forceinline__ void cvt_bf16_stream(const Frame& F, const float* src, bf16* dst, size_t n8) {
    const size_t gt = (size_t)F.bid * 512 + F.wave * 64 + F.lane(), NT = (size_t)F.G * 512;
#pragma unroll 4
    for (size_t i = gt; i < n8; i += NT) { const f32x4 a = ((const f32x4*)src)[2 * i], b = ((const f32x4*)src)[2 * i + 1];
        u32x4 o; o.x = pk2(a.x, a.y); o.y = pk2(a.z, a.w); o.z = pk2(b.x, b.y); o.w = pk2(b.z, b.w); ((u32x4*)dst)[i] = o; }
}

__device__ __forceinline__ void ph0_prologue(const Frame& F) {
    const Args& a = *F.a;
    cvt_bf16_stream(F, a.in[0], (bf16*)a.out, (size_t)T * D / 8);
    cvt_bf16_stream(F, a.in[1], (bf16*)(F.ws + WS_MEMB), (size_t)2048 * 2048 / 8);
    float* scr = (float*)(F.lds + F.wave * 17408);
    const int gw = F.bid * 8 + F.wave, NGW = F.G * 8, lane = F.lane();
    {
        const int nblk = NCOLS / 64, nitems = (2048 / 64) * nblk;
        float* scr64 = (float*)(F.lds + F.wave * 17408);
        for (int it = gw; it < nitems; it += NGW) transpose_item64(a.in[2], 16784, (bf16*)(F.ws + WS_WIN), 2048, 0, nblk, it, scr64, lane, CmWin());
    }
    {
        for (int it = gw; it < 32 * 16; it += NGW) { const int mat = it >> 4, which = mat >> 4, h = mat & 15;
            transpose_item(a.in[which ? 9 : 8] + (size_t)h * 256 * 128, 128, (bf16*)(F.ws + WS_WKV), 256, which * 2048 + h * 128, 4, it & 15, scr, lane, CmIdent()); }
    }
    {
        bf16* W8p = (bf16*)((unsigned char*)a.out + (size_t)64 * MiB);
        for (int it = gw; it < 2 * 1024; it += NGW) { const int m = 4 + (it >> 10);
            transpose_item64(m == 4 ? a.in[17] : a.in[18], 2048, W8p + (size_t)m * 2048 * 2048, 2048, 0, 32, it & 1023, scr, lane, CmIdent()); }
    }
    {
        const int gt = F.bid * 512 + F.wave * 64 + lane;
        if (gt < 2048) { const float l0 = a.in[3][gt], l1 = a.in[3][2048 + gt]; ((float*)(F.ws + WS_LB))[gt] = 1.0f / (1.0f + expf(l1 - l0)); }
    }
}

namespace hg {
constexpr int QP = 272, TP = 144, AP = 144;
constexpr int OFF_QD = 0, OFF_KD = OFF_QD + 64 * QP, OFF_QG = OFF_KD + 64 * QP, OFF_KET = OFF_QG + 64 * QP, OFF_VT = OFF_KET + 128 * TP, OFF_A = OFF_VT + 128 * TP,
              OFF_TOT = OFF_A + 64 * AP, OFF_DEC = OFF_TOT + 4 * 128 * 4, OFF_PART = OFF_DEC + 128 * 4, OFF_RSTD = OFF_PART + 8 * 64 * 4, END = OFF_RSTD + 64 * 4;
static_assert(END <= 131072, "hgrn LDS map");
}
typedef short bf16x4 __attribute__((ext_vector_type(4)));
#define HSEC_B() do { if (PROBE_SEC) hs_t0 = rt_now(); } while (0)
#define HSEC_E(n) do { if (PROBE_SEC == (n)) sacc += rt_now() - hs_t0; } while (0)
__device__ __forceinline__ void hgrn_chunked(const Frame& F, int unit, unsigned long long& sacc) {
    unsigned long long hs_t0 = 0ull;
    using namespace hg;
    const Args& a = *F.a;
    const int b = unit >> 4, h = unit & 15, lane = F.lane(), w = F.wave, tid = w * 64 + lane, c = tid & 127, rq = tid >> 7, l15 = lane & 15, q4 = lane >> 4;
    unsigned char* L = F.lds;
    const size_t base = (size_t)b * 2048 * 2048 + h * 128;
    const bf16* HQ = F.slot(0) + base; const bf16* HF = F.slot(1) + base; const bf16* HI = F.slot(2) + base; const bf16* HG = F.slot(3) + base; bf16* HO = F.slot(0) + base;
    const float lb = ((const float*)(F.ws + WS_LB))[h * 128 + c];
    const float ng = a.in[4][h * 128 + 16 * w + l15];
    f32x4 S[8];
#pragma unroll
    for (int d = 0; d < 8; ++d) S[d] = (f32x4){0.f, 0.f, 0.f, 0.f};
    unsigned short rq_[16], rf_[16], rv_[16];
#pragma unroll
    for (int k = 0; k < 16; ++k) { const size_t o = (size_t)(16 * rq + k) * 2048 + c; rq_[k] = HQ[o]; rf_[k] = HF[o]; rv_[k] = HI[o]; }
    float* tot = (float*)(L + OFF_TOT); float* dec = (float*)(L + OFF_DEC); float* part = (float*)(L + OFF_PART); float* rstd = (float*)(L + OFF_RSTD);
#pragma unroll 1
    for (int ch = 0; ch < 32; ++ch) {
        const int r0 = ch * 64;
        HSEC_B();
        unsigned short gq[16];
#pragma unroll
        for (int mt = 0; mt < 4; ++mt)
#pragma unroll
            for (int r = 0; r < 4; ++r) gq[4 * mt + r] = HG[(size_t)(r0 + 16 * mt + 4 * q4 + r) * 2048 + 16 * w + l15];
        unsigned short rv2_[16];
        if (ch + 1 < 32) {
#pragma unroll
            for (int k = 0; k < 16; ++k) rv2_[k] = HI[(size_t)(r0 + 64 + 16 * rq + k) * 2048 + c]; }
        float G[16], qf[16], kk[16];
        { float run = 0.f;
#pragma unroll
          for (int k = 0; k < 16; ++k) { const float f = lb + (1.0f - lb) * __builtin_amdgcn_rcpf(1.0f + __expf(-bf2f(rf_[k]))); run += __logf(f); G[k] = run; kk[k] = 1.0f - f; qf[k] = bf2f(rq_[k]); } }
        tot[rq * 128 + c] = G[15];
        if (ch + 1 < 32) {
#pragma unroll
            for (int k = 0; k < 16; ++k) { const size_t o = (size_t)(r0 + 64 + 16 * rq + k) * 2048 + c; rq_[k] = HQ[o]; rf_[k] = HF[o]; } }
        HSEC_E(1); HSEC_B();
        __syncthreads();
        HSEC_E(2); HSEC_B();
        const float t0 = tot[c], t1 = tot[128 + c], t2 = tot[256 + c], t3 = tot[384 + c];
        const float offs = (rq > 0 ? t0 : 0.f) + (rq > 1 ? t1 : 0.f) + (rq > 2 ? t2 : 0.f);
        const float Gref = t0 + t1, Glast = Gref + t2 + t3, eref = __expf(Gref), elr = __expf(Glast - Gref);
        if (rq == 0) dec[c] = __expf(Glast);
        unsigned kew[8], vw[8];
#pragma unroll
        for (int k = 0; k < 16; ++k) {
            const float e1 = __expf(G[k] + offs - Gref), qd = qf[k] * e1, kd = kk[k] * __builtin_amdgcn_rcpf(e1);
            const int row = 16 * rq + k;
            *(bf16*)(L + OFF_QD + row * QP + 2 * c) = (bf16)f2bf(qd);
            *(bf16*)(L + OFF_KD + row * QP + 2 * c) = (bf16)f2bf(kd);
            *(bf16*)(L + OFF_QG + row * QP + 2 * c) = (bf16)f2bf(qd * eref);
            const unsigned ke = f2bf(kd * elr);
            if (k & 1) { kew[k >> 1] |= ke << 16; vw[k >> 1] |= (unsigned)rv_[k] << 16; } else { kew[k >> 1] = ke; vw[k >> 1] = rv_[k]; }
        }
        *(u32x4*)(L + OFF_KET + c * TP + 32 * rq) = (u32x4){kew[0], kew[1], kew[2], kew[3]}; *(u32x4*)(L + OFF_KET + c * TP + 32 * rq + 16) = (u32x4){kew[4], kew[5], kew[6], kew[7]};
        *(u32x4*)(L + OFF_VT + c * TP + 32 * rq) = (u32x4){vw[0], vw[1], vw[2], vw[3]}; *(u32x4*)(L + OFF_VT + c * TP + 32 * rq + 16) = (u32x4){vw[4], vw[5], vw[6], vw[7]};
        if (ch + 1 < 32) {
#pragma unroll
            for (int k = 0; k < 16; ++k) rv_[k] = rv2_[k]; }
        HSEC_E(3); HSEC_B();
        __syncthreads();
        HSEC_E(4); HSEC_B();
        { const int mi = w >> 1;
#pragma unroll
          for (int tt = 0; tt < 2; ++tt) { const int nj = 2 * (w & 1) + tt; f32x4 acc = (f32x4){0.f, 0.f, 0.f, 0.f};
              if (nj <= mi) {
#pragma unroll
                  for (int ks = 0; ks < 4; ++ks) { const bf16x8 aF = *(const bf16x8*)(L + OFF_KD + (16 * nj + l15) * QP + 64 * ks + 16 * q4), bF = *(const bf16x8*)(L + OFF_QD + (16 * mi + l15) * QP + 64 * ks + 16 * q4);
                      acc = __builtin_amdgcn_mfma_f32_16x16x32_bf16(aF, bF, acc, 0, 0, 0); } }
              const int i = 16 * mi + l15, j0 = 16 * nj + 4 * q4;
              const float v0 = (j0 <= i) ? acc.x : 0.f, v1 = (j0 + 1 <= i) ? acc.y : 0.f, v2 = (j0 + 2 <= i) ? acc.z : 0.f, v3 = (j0 + 3 <= i) ? acc.w : 0.f;
              *(u32x2*)(L + OFF_A + i * AP + 2 * j0) = (u32x2){pk2(v0, v1), pk2(v2, v3)}; } }
        __syncthreads();
        HSEC_E(5); HSEC_B();
        bf16x8 bV[2];
#pragma unroll
        for (int ks = 0; ks < 2; ++ks) bV[ks] = *(const bf16x8*)(L + OFF_VT + (16 * w + l15) * TP + 64 * ks + 16 * q4);
        f32x4 O[4];
#pragma unroll
        for (int mt = 0; mt < 4; ++mt) { O[mt] = (f32x4){0.f, 0.f, 0.f, 0.f};
#pragma unroll
            for (int ks = 0; ks < 2; ++ks) { const bf16x8 aF = *(const bf16x8*)(L + OFF_A + (16 * mt + l15) * AP + 64 * ks + 16 * q4); O[mt] = __builtin_amdgcn_mfma_f32_16x16x32_bf16(aF, bV[ks], O[mt], 0, 0, 0); } }
#pragma unroll
        for (int kq = 0; kq < 4; ++kq) {
            u32x4 sw; sw.x = pk2(S[2 * kq].x, S[2 * kq].y); sw.y = pk2(S[2 * kq].z, S[2 * kq].w); sw.z = pk2(S[2 * kq + 1].x, S[2 * kq + 1].y); sw.w = pk2(S[2 * kq + 1].z, S[2 * kq + 1].w);
            const bf16x8 bS = __builtin_bit_cast(bf16x8, sw);
#pragma unroll
            for (int mt = 0; mt < 4; ++mt) { const unsigned char* qp = L + OFF_QG + (16 * mt + l15) * QP + 64 * kq + 8 * q4;
                const u32x2 lo = *(const u32x2*)qp, hi = *(const u32x2*)(qp + 32);
                const bf16x8 aF = __builtin_bit_cast(bf16x8, (u32x4){lo.x, lo.y, hi.x, hi.y});
                O[mt] = __builtin_amdgcn_mfma_f32_16x16x32_bf16(aF, bS, O[mt], 0, 0, 0); } }
#pragma unroll
        for (int dt = 0; dt < 8; ++dt) { const f32x4 dc = *(const f32x4*)(dec + 16 * dt + 4 * q4); S[dt] = S[dt] * dc;
#pragma unroll
            for (int ks = 0; ks < 2; ++ks) { const bf16x8 aF = *(const bf16x8*)(L + OFF_KET + (16 * dt + l15) * TP + 64 * ks + 16 * q4); S[dt] = __builtin_amdgcn_mfma_f32_16x16x32_bf16(aF, bV[ks], S[dt], 0, 0, 0); } }
        HSEC_E(6); HSEC_B();
#pragma unroll
        for (int mt = 0; mt < 4; ++mt)
#pragma unroll
            for (int r = 0; r < 4; ++r) { const float p = row16_sum(O[mt][r] * O[mt][r]);
                if (l15 == 0) part[w * 64 + 16 * mt + 4 * q4 + r] = p; }
        __syncthreads();
        if (tid < 64) { float s = 0.f;
#pragma unroll
            for (int ww = 0; ww < 8; ++ww) s += part[ww * 64 + tid];
            rstd[tid] = rsqrtf(s * (1.0f / 128.0f) + 1e-6f); }
        __syncthreads();
        HSEC_E(7); HSEC_B();
#pragma unroll
        for (int mt = 0; mt < 4; ++mt) { const f32x4 rs = *(const f32x4*)(rstd + 16 * mt + 4 * q4);
#pragma unroll
            for (int r = 0; r < 4; ++r) { const float g = bf2f(gq[4 * mt + r]); const float o = O[mt][r] * rs[r] * ng * (g * __builtin_amdgcn_rcpf(1.0f + __expf(-g)));
                HO[(size_t)(r0 + 16 * mt + 4 * q4 + r) * 2048 + 16 * w + l15] = (bf16)f2bf(o); } }
        HSEC_E(8);
    }
    __syncthreads();
}

__device__ __forceinline__ void ph2_side(const Frame& F, int sid, int nside) {
    const Args& a = *F.a;
    const int gw = sid * 8 + F.wave, NGW = nside * 8, lane = F.lane();
    bf16* CKV = (bf16*)(F.ws + WS_CKV); bf16* IKW = (bf16*)(F.ws + WS_IKW);
    for (int row = gw; row < T; row += NGW) {
        {   u32x2 w = *(u32x2*)(CKV + (size_t)row * 256 + 4 * lane);
            float x0 = bflo(w.x), x1 = bfhi(w.x), x2 = bflo(w.y), x3 = bfhi(w.y);
            const float ss = wave_sum(x0 * x0 + x1 * x1 + x2 * x2 + x3 * x3);
            const float r = rsqrtf(ss * (1.0f / 256.0f) + 1e-6f);
            const f32x4 g = *(const f32x4*)(a.in[5] + 4 * lane);
            w.x = pk2(x0 * r * g.x, x1 * r * g.y); w.y = pk2(x2 * r * g.z, x3 * r * g.w);
            *(u32x2*)(CKV + (size_t)row * 256 + 4 * lane) = w; }
        {   unsigned w = *(unsigned*)(IKW + (size_t)row * 256 + 2 * lane);
            float x0 = bflo(w), x1 = bfhi(w);
            const float mu = wave_sum(x0 + x1) * (1.0f / 128.0f);
            x0 -= mu; x1 -= mu;
            const float var = wave_sum(x0 * x0 + x1 * x1) * (1.0f / 128.0f);
            const float r = rsqrtf(var + 1e-5f);
            const float g0 = a.in[6][2 * lane], g1 = a.in[6][2 * lane + 1], b0 = a.in[7][2 * lane], b1 = a.in[7][2 * lane + 1];
            *(unsigned*)(IKW + (size_t)row * 256 + 2 * lane) = pk2(x0 * r * g0 + b0, x1 * r * g1 + b1); }
    }
}
__device__ __forceinline__ void w8_transposes(const Frame& F, bf16* W8) {
    const Args& a = *F.a;
    const int gw = F.bid * 8 + F.wave, NGW = F.G * 8, lane = F.lane();
    float* scr = (float*)(F.lds + F.wave * 17408);
    float* cv = (float*)(F.ws + WS_CTL + CTL_CVEC);
    for (int it = gw; it < 2 * 2048; it += NGW) {
        const int which = it >> 11, m = which ? 7 : 3;
        transpose_item_ln(which ? a.in[22] : a.in[16], W8 + (size_t)m * 2048 * 2048, it & 2047, scr, lane, which ? a.in[20] : a.in[14], which ? a.in[21] : a.in[15], cv + which * 4096, cv + which * 4096 + 2048); }
    for (int it = gw; it < 4 * 1024; it += NGW) {
        const int q = it >> 10, m = q < 3 ? q : 6;
        const float* wsrc = m == 0 ? a.in[11] : m == 1 ? a.in[12] : m == 2 ? a.in[13] : a.in[19];
        if (m < 2) transpose_item64(wsrc, 2048, W8 + (size_t)m * 2048, 4096, 0, 32, it & 1023, scr, lane, CmIdent());
        else transpose_item64(wsrc, 2048, W8 + (size_t)m * 2048 * 2048, 2048, 0, 32, it & 1023, scr, lane, CmIdent()); }
}

__device__ __forceinline__ void ph3_hgnorm(const Frame& F) {
    const Args& a = *F.a;
    const int gw = F.bid * 8 + F.wave, NGW = F.G * 8, lane = F.lane();
    const float* oraw = a.out; const bf16* HG = F.slot(3); bf16* HO = F.slot(0);
    for (int u = gw; u < T * 16; u += NGW) {
        const size_t off = (size_t)(u >> 4) * 2048 + (u & 15) * 128 + 2 * lane;
        const float o0 = oraw[off], o1 = oraw[off + 1];
        const float r = rsqrtf(wave_sum(o0 * o0 + o1 * o1) * (1.0f / 128.0f) + 1e-6f);
        const unsigned gw2 = *(const unsigned*)(HG + off);
        const float g0 = bflo(gw2), g1 = bfhi(gw2);
        const int c = (u & 15) * 128 + 2 * lane;
        *(unsigned*)(HO + off) = pk2(o0 * r * a.in[4][c] * (g0 * sigm(g0)), o1 * r * a.in[4][c + 1] * (g1 * sigm(g1)));
    }
}

__device__ __forceinline__ unsigned fkey(float f) { const unsigned u = __float_as_uint(f); return (u & 0x80000000u) ? ~u : (u | 0x80000000u); }
__device__ __forceinline__ void ph5_select(const Frame& F, int first, int stride) {
    const int lane = F.lane(), l31 = lane & 31, half = lane >> 5, w = F.wave;
    float* scl = (float*)F.lds;
    const bf16* AIQ = F.slot(5); const bf16* IKW = (const bf16*)(F.ws + WS_IKW);
    unsigned* MASK = (unsigned*)(F.ws + WS_MASK);
    for (int i = first; i < 1024; i += stride) {
        const int r4 = i >> 8, c = i & 255, j = c & 127, b = 2 * r4 + (c >> 7), qt = (r4 & 1) ? 127 - j : j, t0 = qt * 16;
        bf16x8 Af[8];
        { const size_t rowA = (size_t)b * 2048 + t0 + 2 * w + ((l31 >> 2) & 1); const int headA = (l31 & 3) + 4 * (l31 >> 3);
#pragma unroll
          for (int ks = 0; ks < 8; ++ks) Af[ks] = *(const bf16x8*)(AIQ + rowA * 2048 + headA * 128 + 16 * ks + 8 * half); }
        float wr[16];
        { const bf16* wp = IKW + ((size_t)b * 2048 + t0 + 2 * w + half) * 256 + 128;
#pragma unroll
          for (int r = 0; r < 16; ++r) wr[r] = bf2f(wp[(r & 3) + 4 * (r >> 2)]) * (0.25f * 0.08838834764831845f); }
        const int nkt = (t0 + 15) / 32 + 1;
        unsigned char* ring = F.lds + 131072;
        const int srow = (w * 64 + lane) >> 4, sch = lane & 15;
        const bf16* kg = IKW + ((size_t)b * 2048 + srow) * 256 + 8 * sch;
        const int swr = srow * 256 + ((sch ^ (srow & 15)) << 4);
        const int frd = l31 * 256;
        u32x4 st0, st1;
        st0 = *(const u32x4*)kg; *(u32x4*)(ring + swr) = st0;
        if (nkt > 1) { st1 = *(const u32x4*)(kg + (size_t)32 * 256); *(u32x4*)(ring + 8192 + swr) = st1; }
        if (nkt > 2) st0 = *(const u32x4*)(kg + (size_t)2 * 32 * 256);
        __syncthreads();
#define IDX_TILE(kt_, STW, STL) do { \
            if ((kt_) + 3 < nkt) STL = *(const u32x4*)(kg + (size_t)((kt_) + 3) * 32 * 256); \
            { const unsigned char* sl_ = ring + ((kt_) % 3) * 8192 + frd; f32x16 acc; _Pragma("unroll") for (int r = 0; r < 16; ++r) acc[r] = 0.f; \
              _Pragma("unroll") for (int ks = 0; ks < 8; ++ks) { const bf16x8 bfr = *(const bf16x8*)(sl_ + (((2 * ks + half) ^ (l31 & 15)) << 4)); acc = __builtin_amdgcn_mfma_f32_32x32x16_bf16(Af[ks], bfr, acc, 0, 0, 0); } \
              float sc = 0.f; _Pragma("unroll") for (int r = 0; r < 16; ++r) sc += fmaxf(acc[r], 0.f) * wr[r]; \
              scl[(2 * w + half) * 2048 + (kt_) * 32 + l31] = sc; } \
            if ((kt_) + 2 < nkt) *(u32x4*)(ring + (((kt_) + 2) % 3) * 8192 + swr) = STW; \
            __syncthreads(); } while (0)
        for (int kt = 0; kt < nkt; kt += 2) { IDX_TILE(kt, st0, st1); if (kt + 1 < nkt) IDX_TILE(kt + 1, st1, st0); }
#undef IDX_TILE
        WAVE_SYNC();
#pragma unroll 1
        for (int qi = 0; qi < 2; ++qi) {
            const int t = t0 + 2 * w + qi; const float* row = scl + (2 * w + qi) * 2048;
            unsigned key[32];
#pragma unroll
            for (int jj = 0; jj < 32; ++jj) { const int s2 = lane + 64 * jj; key[jj] = (s2 <= t) ? fkey(row[s2]) : 0u; }
            unsigned thr = 0u;
            if (t + 1 > 256) {
                for (int bit = 31; bit >= 0; --bit) {
                    const unsigned cand = thr | (1u << bit);
                    int cnt = 0;
#pragma unroll
                    for (int jj = 0; jj < 32; ++jj) cnt += (key[jj] >= cand) ? 1 : 0;
                    { int tot = 0;
#pragma unroll
                      for (int bb = 0; bb < 6; ++bb) tot += __popcll(__ballot((cnt >> bb) & 1)) << bb;
                      cnt = tot; }
                    if (cnt >= 256) { thr = cand; if (cnt == 256) break; }
                }
            }
            unsigned wd = 0u;
#pragma unroll
            for (int jj = 0; jj < 32; ++jj) { const int s2 = lane + 64 * jj; const unsigned long long m = __ballot(s2 <= t && key[jj] >= thr);
                if (lane == 2 * jj) wd = (unsigned)m; if (lane == 2 * jj + 1) wd = (unsigned)(m >> 32); }
            MASK[((size_t)b * 2048 + t) * 64 + lane] = wd;
        }
        WAVE_SYNC();
    }
}

__device__ __forceinline__ int t5_bucket(int d) {
    if (d < 16) return d;
    return 16 + (d >= 19) + (d >= 21) + (d >= 24) + (d >= 27) + (d >= 31) + (d >= 35) + (d >= 40) + (d >= 46) + (d >= 52) + (d >= 59) + (d >= 67) + (d >= 77) + (d >= 87) + (d >= 99) + (d >= 113);
}
namespace dsa {
constexpr float SCALE = 0.08838834764831845f;
constexpr int NW = 8, QBLK = 32, KVBLK = 64, QB = NW * QBLK, DH = 128, LD = 2048;
constexpr int SHM_V = KVBLK * DH * 2, SHM_K = KVBLK * DH * 2;
constexpr int OFF_WS = 2 * SHM_V + 2 * SHM_K, OFF_BIAS = OFF_WS + NW * 64 * 4, LDS_TOTAL = OFF_BIAS + 16 * 128 * 4;
constexpr float THR = 8.f;
typedef short s16x4 __attribute__((ext_vector_type(4)));
#define KSWZ(row, colB) ((row) * 256 + ((colB) ^ (((row) & 7) << 4)))
#define SBAR() __builtin_amdgcn_sched_barrier(0)
__device__ __forceinline__ int v_st(int k, int c) { const int kk = (k & ~0xC) | ((k & 4) << 1) | ((k & 8) >> 1); return ((kk >> 3) * 4 + (c >> 5)) * 512 + ((kk & 7) * 32 + (c & 31)) * 2; }
__device__ __forceinline__ int v_rd_base(int lane) { return ((lane & 3) << 3) | (((lane >> 2) & 3) << 6) | (((lane >> 4) & 1) << 5) | (((lane >> 5) & 1) << 8); }
constexpr int v_rd_off(int d0, int ks, int half) { return d0 * 512 + ks * 4096 + half * 2048; }
__device__ __forceinline__ int crow(int r, int hi) { return (r & 3) + 8 * (r >> 2) + 4 * hi; }
__device__ __forceinline__ unsigned cvtpk(float lo, float hi) { unsigned r; asm volatile("v_cvt_pk_bf16_f32 %0, %1, %2" : "=v"(r) : "v"(lo), "v"(hi)); return r; }
__device__ __forceinline__ bf16x8 load8(const bf16* p) { return *reinterpret_cast<const bf16x8*>(p); }
template <bool NEAR>
__device__ __forceinline__ void init_scores(f32x16& p0, f32x16& p1, unsigned w0, unsigned w1, int hi, int dq, const float* bl) {
    w0 >>= 4 * hi; w1 >>= 4 * hi;
#pragma unroll
    for (int r = 0; r < 16; ++r) { const int c = (r & 3) + 8 * (r >> 2);
        const int x0 = __builtin_amdgcn_sbfe(w0, c, 1), x1 = __builtin_amdgcn_sbfe(w1, c, 1);
        unsigned b0 = 0u, b1 = 0u;
        if (NEAR) { int d0 = dq - c, d1 = dq - c - 32; d0 = d0 < 0 ? 0 : (d0 > 127 ? 127 : d0); d1 = d1 < 0 ? 0 : (d1 > 127 ? 127 : d1);
            b0 = __float_as_uint(bl[d0]); b1 = __float_as_uint(bl[d1]); }
        p0[r] = __uint_as_float((b0 & (unsigned)x0) | (0xFF800000u & ~(unsigned)x0));
        p1[r] = __uint_as_float((b1 & (unsigned)x1) | (0xFF800000u & ~(unsigned)x1)); }
}
__device__ __forceinline__ void partialSM(f32x16& p0, f32x16& p1, float& m_reg, float& mn, float& alpha) {
    float pmax = p0[0];
#pragma unroll
    for (int r = 1; r < 16; ++r) pmax = fmaxf(pmax, p0[r]);
#pragma unroll
    for (int r = 0; r < 16; ++r) pmax = fmaxf(pmax, p1[r]);
    { auto rr = __builtin_amdgcn_permlane32_swap(__float_as_uint(pmax), __float_as_uint(pmax), false, false);
      pmax = fmaxf(__uint_as_float(rr[0]), __uint_as_float(rr[1])); }
    constexpr float C2 = 1.4426950408889634f * SCALE;
    if (__builtin_expect(__all((pmax - m_reg) * SCALE <= THR), 1)) { mn = m_reg; alpha = 1.f; }
    else { mn = fmaxf(m_reg, pmax); alpha = __builtin_amdgcn_exp2f((m_reg - mn) * C2); m_reg = mn; }
    const float mnL = -mn * C2;
#pragma unroll
    for (int r = 0; r < 16; ++r) p0[r] = fmaf(p0[r], C2, mnL);
#pragma unroll
    for (int r = 0; r < 16; ++r) p1[r] = fmaf(p1[r], C2, mnL);
#pragma unroll
    for (int r = 0; r < 16; ++r) p0[r] = __builtin_amdgcn_exp2f(p0[r]);
}
__device__ __forceinline__ void finishSM(f32x16& p0, f32x16& p1, float alpha, float& l_reg, bf16x8& pa0, bf16x8& pa1, bf16x8& pa2, bf16x8& pa3) {
#pragma unroll
    for (int r = 0; r < 16; ++r) p1[r] = __builtin_amdgcn_exp2f(p1[r]);
    float ps = 0;
#pragma unroll
    for (int r = 0; r < 16; ++r) ps += p0[r];
#pragma unroll
    for (int r = 0; r < 16; ++r) ps += p1[r];
    { auto rr = __builtin_amdgcn_permlane32_swap(__float_as_uint(ps), __float_as_uint(ps), false, false);
      ps = __uint_as_float(rr[0]) + __uint_as_float(rr[1]); }
    l_reg = l_reg * alpha + ps;
#define PK4(P, B_, OUT) do { unsigned a0 = cvtpk(P[B_+0], P[B_+1]), a1 = cvtpk(P[B_+2], P[B_+3]);                          \
        unsigned b0 = cvtpk(P[B_+4], P[B_+5]), b1 = cvtpk(P[B_+6], P[B_+7]);                                             \
        auto r0 = __builtin_amdgcn_permlane32_swap(a0, b0, false, false); auto r1 = __builtin_amdgcn_permlane32_swap(a1, b1, false, false); \
        u32x4 w = {r0[0], r1[0], r0[1], r1[1]}; OUT = *reinterpret_cast<bf16x8*>(&w); } while (0)
    PK4(p0, 0, pa0); PK4(p0, 8, pa1); PK4(p1, 0, pa2); PK4(p1, 8, pa3);
#undef PK4
}
template <int KB>
__device__ __forceinline__ void qkt(f32x16& p0, f32x16& p1, const char* K_lds, int r32, int hi, const bf16x8* qr) {
    const char* kb[4];
#pragma unroll
    for (int dd = 0; dd < 4; ++dd) kb[dd] = K_lds + KB * SHM_K + KSWZ(r32, (dd * 16 + hi * 8) * 2);
#pragma unroll
    for (int d0 = 0; d0 < 8; ++d0) { const char* a = kb[d0 & 3] + (d0 >> 2) * 128;
        bf16x8 b0 = *reinterpret_cast<const bf16x8*>(a);
        bf16x8 b1 = *reinterpret_cast<const bf16x8*>(a + 32 * 256);
        p0 = __builtin_amdgcn_mfma_f32_32x32x16_bf16(b0, qr[d0], p0, 0, 0, 0);
        p1 = __builtin_amdgcn_mfma_f32_32x32x16_bf16(b1, qr[d0], p1, 0, 0, 0); }
}
template <int VB>
__device__ __forceinline__ void pv_tile(f32x16* o, int vb0, bf16x8 pa0, bf16x8 pa1, bf16x8 pa2, bf16x8 pa3) {
#define TRRD(dst, off) asm volatile("ds_read_b64_tr_b16 %0, %1 offset:%2" : "=&v"(dst) : "v"(vb0), "i"(off) : "memory")
#define PV_D0(d0) do { s16x4 l0, l1, l2, l3, h0, h1, h2, h3; constexpr int b_ = VB * SHM_V + v_rd_off(d0, 0, 0); \
        TRRD(l0, b_); TRRD(h0, b_ + 2048); TRRD(l1, b_ + 4096); TRRD(h1, b_ + 6144); TRRD(l2, b_ + 8192); TRRD(h2, b_ + 10240); TRRD(l3, b_ + 12288); TRRD(h3, b_ + 14336); \
        asm volatile("s_waitcnt lgkmcnt(0)" ::: "memory"); SBAR();   \
        o[d0] = __builtin_amdgcn_mfma_f32_32x32x16_bf16(pa0, (bf16x8){l0[0], l0[1], l0[2], l0[3], h0[0], h0[1], h0[2], h0[3]}, o[d0], 0, 0, 0);   \
        o[d0] = __builtin_amdgcn_mfma_f32_32x32x16_bf16(pa1, (bf16x8){l1[0], l1[1], l1[2], l1[3], h1[0], h1[1], h1[2], h1[3]}, o[d0], 0, 0, 0);   \
        o[d0] = __builtin_amdgcn_mfma_f32_32x32x16_bf16(pa2, (bf16x8){l2[0], l2[1], l2[2], l2[3], h2[0], h2[1], h2[2], h2[3]}, o[d0], 0, 0, 0);   \
        o[d0] = __builtin_amdgcn_mfma_f32_32x32x16_bf16(pa3, (bf16x8){l3[0], l3[1], l3[2], l3[3], h3[0], h3[1], h3[2], h3[3]}, o[d0], 0, 0, 0); } while (0)
    PV_D0(0); PV_D0(1); PV_D0(2); PV_D0(3);
#undef PV_D0
#undef TRRD
}
struct BlockRef { const bf16* Q; const bf16* K; const bf16* V; bf16* O; const unsigned* M; int P0; int h; };
struct Seam { bf16x8 qr[8]; bf16x8 st_v0, st_v1, st_k0, st_k1; };
#define ROWU(p, k0) ((p) + (size_t)(k0) * LD)
#define VMW() asm volatile("s_waitcnt vmcnt(0)" ::: "memory")
#define VMWN(n) asm volatile("s_waitcnt vmcnt(%0)" :: "i"(n) : "memory")
#define SLOAD_H(Kp, Vp, k0) do { S.st_v0 = load8(ROWU(Vp, k0) + sofs); S.st_v1 = load8(ROWU(Vp, (k0) + 32) + sofs);              \
                         S.st_k0 = load8(ROWU(Kp, k0) + sofs); S.st_k1 = load8(ROWU(Kp, (k0) + 32) + sofs); } while (0)
#define SWRITE_HK(bf) do { *(bf16x8*)(K_lds + (bf) * SHM_K + kws) = S.st_k0; *(bf16x8*)(K_lds + (bf) * SHM_K + kws + 32 * 256) = S.st_k1; } while (0)
#define SWRITE_HV(bf) do { *(bf16x8*)(V_lds + (bf) * SHM_V + vst0) = S.st_v0; *(bf16x8*)(V_lds + (bf) * SHM_V + vst1) = S.st_v1; } while (0)
#define SWRITE_H(bf) do { SWRITE_HV(bf); SWRITE_HK(bf); } while (0)
__device__ __forceinline__ void prime(const BlockRef& cur, char* lds, Seam& S, int wid) {
    const int lane = fresh_lane(), tid = wid * 64 + lane, r32 = lane & 31, hi = lane >> 5;
    const int sr = tid >> 4, sc = (tid & 15) * 8, kws = KSWZ(sr, sc * 2); char* K_lds = lds + 2 * SHM_V; const unsigned sofs = (unsigned)(sr * LD + sc);
    const unsigned qofs = (unsigned)((wid * QBLK + r32) * LD + hi * 8);
#pragma unroll
    for (int d0 = 0; d0 < 8; ++d0) S.qr[d0] = load8(cur.Q + qofs + d0 * 16);
    SLOAD_H(cur.K, cur.V, 0); VMW(); SWRITE_HK(0);
    __syncthreads();
}
__device__ __forceinline__ void block(const BlockRef& cur, const BlockRef& nxt, char* lds, Seam& S, int wid) {
    const int lane = fresh_lane(), tid = wid * 64 + lane,
               r32 = lane & 31, hi = lane >> 5;
    const int NT = (cur.P0 + QB - 1) / KVBLK + 1;
    const int qlo = cur.P0 + wid * QBLK, qm = qlo + r32 - 4 * hi;
    char* V_lds = lds; char* K_lds = lds + 2 * SHM_V;
    float* ws = (float*)(lds + OFF_WS) + wid * 64; float* li_l = ws, * al_l = ws + 32;
    const float* bl = (const float*)(lds + OFF_BIAS) + cur.h * 128;
    const unsigned mofs = (unsigned)((wid * QBLK + r32) * 64);
    float m_reg = -1e30f, l_reg = 0; f32x16 o[4] = {};
    const int sr = tid >> 4, sc = (tid & 15) * 8, vst0 = v_st(sr, sc), vst1 = v_st(32 + sr, sc), kws = KSWZ(sr, sc * 2); const unsigned sofs = (unsigned)(sr * LD + sc);
    const int vb0 = (int)(uintptr_t)V_lds + v_rd_base(lane);
    const bf16* Kh = cur.K; const bf16* Vh = cur.V;
#define RESC(a) do { if (__any((a) < 1.f)) { if (hi == 0) al_l[r32] = (a); asm volatile("s_waitcnt lgkmcnt(0)" ::: "memory");              \
                     for (int d_ = 0; d_ < 4; ++d_) for (int r = 0; r < 16; ++r) o[d_][r] *= al_l[crow(r, hi)]; } } while (0)
#define KBASE(t) ((t) * KVBLK)
#define LDMASK(t) (*(const u32x2*)(cur.M + 2 * ((t) < 31 ? (t) : 31) + mofs))
#define INIT(P0_, P1_, t) do { const int kb_ = KBASE(t); if (qlo - kb_ - 63 < 113) init_scores<true>(P0_, P1_, mw.x, mw.y, hi, qm - kb_, bl); else init_scores<false>(P0_, P1_, mw.x, mw.y, hi, 0, bl); } while (0)
#define SEAM_K0() do { VMWN(8); SWRITE_HK(0); SBAR(); } while (0)
    f32x16 pA0, pA1, pB0, pB1; float mnA, mnB, alA, alB; bf16x8 pa0, pa1, pa2, pa3; u32x2 mw;
    SWRITE_HV(0); SBAR();
    if (NT > 1) { SLOAD_H(Kh, Vh, KBASE(1)); }
    mw = LDMASK(0); INIT(pA0, pA1, 0); mw = LDMASK(1);
    SBAR(); qkt<0>(pA0, pA1, K_lds, r32, hi, S.qr);
    partialSM(pA0, pA1, m_reg, mnA, alA);
    if (NT > 1) { VMW(); SWRITE_H(1); }
    __syncthreads();
#define HALF_STEP(PX0, PX1, mnX, alX, PY0, PY1, alY, t, KB, VB, SB) do {                                                      \
        INIT(PX0, PX1, (t)); mw = LDMASK((t) + 1);                                                                           \
        SBAR(); qkt<KB>(PX0, PX1, K_lds, r32, hi, S.qr);                                                                      \
        finishSM(PY0, PY1, alY, l_reg, pa0, pa1, pa2, pa3); SBAR();                                                           \
        if ((t) + 1 < NT) { SLOAD_H(Kh, Vh, KBASE((t) + 1)); SBAR(); }                                                        \
        pv_tile<VB>(o, vb0, pa0, pa1, pa2, pa3); partialSM(PX0, PX1, m_reg, mnX, alX);              \
        __syncthreads();                                                                                                      \
        if ((t) + 1 < NT) { VMW(); SWRITE_H(SB); }                                                                            \
        RESC(alX); __syncthreads(); } while (0)
    for (int t = 1; t + 1 < NT; t += 2) {
        HALF_STEP(pB0, pB1, mnB, alB, pA0, pA1, alA, t, 1, 0, 0);
        HALF_STEP(pA0, pA1, mnA, alA, pB0, pB1, alB, t + 1, 0, 1, 1);
    }
    const bool even = (NT & 1) == 0;
    if (even) { INIT(pB0, pB1, NT - 1); SBAR(); qkt<1>(pB0, pB1, K_lds, r32, hi, S.qr); SBAR(); }
    SLOAD_H(nxt.K, nxt.V, 0); SBAR();
#pragma unroll
    for (int d0 = 0; d0 < 8; ++d0) S.qr[d0] = load8(nxt.Q + (unsigned)((wid * QBLK + r32) * LD + hi * 8) + d0 * 16);
    SBAR();
    finishSM(pA0, pA1, alA, l_reg, pa0, pa1, pa2, pa3); SBAR();
    pv_tile<0>(o, vb0, pa0, pa1, pa2, pa3);
    if (even) { partialSM(pB0, pB1, m_reg, mnB, alB); __syncthreads(); RESC(alB);
        finishSM(pB0, pB1, alB, l_reg, pa0, pa1, pa2, pa3); SBAR(); pv_tile<1>(o, vb0, pa0, pa1, pa2, pa3); }
    SBAR(); SEAM_K0();
    if (hi == 0) li_l[r32] = l_reg; asm volatile("s_waitcnt lgkmcnt(0)" ::: "memory");
    float rli[16];
#pragma unroll
    for (int r = 0; r < 16; ++r) rli[r] = __builtin_amdgcn_rcpf(li_l[crow(r, hi)]);
    int lofs = 4 * hi * LD + r32; asm volatile("" : "+v"(lofs));
    bf16* Ow = cur.O + (size_t)(wid * QBLK) * LD + lofs;
#pragma unroll
    for (int r = 0; r < 16; ++r) { const int orow = (r & 3) + 8 * (r >> 2);
#pragma unroll
        for (int d0 = 0; d0 < 4; ++d0) { const float v = o[d0][r] * rli[r];
            const float vn = __shfl_xor(v, 1);
            if ((r32 & 1) == 0) *(unsigned*)(Ow + orow * LD + d0 * 32) = cvtpk(v, vn); } }
    __syncthreads();
#undef RESC
#undef KBASE
#undef LDMASK
#undef INIT
#undef SEAM_K0
#undef HALF_STEP
}
#undef ROWU
#undef VMW
#undef VMWN
#undef SLOAD_H
#undef SWRITE_HK
#undef SWRITE_HV
#undef SWRITE_H
#undef KSWZ
#undef SBAR
}

__device__ __forceinline__ dsa::BlockRef dsa_ref(const Frame& F, int bh, int qb) {
    const int b = bh >> 4, h = bh & 15;
    dsa::BlockRef r;
    r.Q = F.slot(4) + ((size_t)b * 2048 + (size_t)qb * 256) * 2048 + h * 128;
    r.O = F.slot(3) + ((size_t)b * 2048 + (size_t)qb * 256) * 2048 + h * 128;
    r.K = F.slot(1) + (size_t)b * 2048 * 2048 + h * 128; r.V = F.slot(2) + (size_t)b * 2048 * 2048 + h * 128;
    r.M = (const unsigned*)(F.ws + WS_MASK) + ((size_t)b * 2048 + (size_t)qb * 256) * 64;
    r.P0 = qb * 256; r.h = h;
    return r;
}
__device__ __forceinline__ void ph6_attn(const Frame& F) {
    const Args& a = *F.a;
    char* lds = (char*)F.lds;
    {
        float* bt = (float*)(lds + dsa::OFF_BIAS);
        for (int i = F.wave * 64 + F.lane(); i < 16 * 128; i += 512) { const int h = i >> 7, d = i & 127; bt[i] = (a.in[10][t5_bucket(d) * 16 + h] - a.in[10][31 * 16 + h]) * (1.0f / dsa::SCALE); }
    }
    __syncthreads();
    const int total = 4 * 128;
    int L = F.bid; if (L >= total) return;
#define ATT_BH(L_) (((L_) >> 8) * 64 + ((L_) & 7) * 8 + ((((L_) & 255) >> 3) >> 2))
#define ATT_PR(L_) ((((L_) & 255) >> 3) & 3)
    int pass = 0;
    const bool xmap = (F.G == 256);
    dsa::BlockRef cur = dsa_ref(F, xmap ? ATT_BH(L) : (L >> 2), xmap ? ATT_PR(L) : (L & 3));
    dsa::Seam S;
    dsa::prime(cur, lds, S, F.wave);
    for (;;) {
        const bool more_pass = pass == 0, more_item = L + F.G < total, last = !more_pass && !more_item;
        int passn = pass + 1, Ln = L;
        if (!more_pass) { passn = 0; Ln = more_item ? L + F.G : L; }
        const int bhn = xmap ? ATT_BH(Ln) : (Ln >> 2), prn = xmap ? ATT_PR(Ln) : (Ln & 3);
        const dsa::BlockRef nxt = last ? cur : dsa_ref(F, bhn, passn ? 7 - prn : prn);
        dsa::block(cur, nxt, lds, S, F.wave);
        if (last) break;
        cur = nxt; pass = passn; L = Ln;
    }
}

__device__ __forceinline__ void ln_row(float* zrow, const float* g, const float* bta, bf16* brow, int lane) {
    f32x4 v[8]; float s = 0.f;
#pragma unroll
    for (int i = 0; i < 8; ++i) { v[i] = *(const f32x4*)(zrow + 256 * i + 4 * lane); s += (v[i].x + v[i].y) + (v[i].z + v[i].w); }
    const float mu = wave_sum(s) * (1.0f / 2048.0f); float s2 = 0.f;
#pragma unroll
    for (int i = 0; i < 8; ++i) { v[i] = v[i] - mu; s2 += (v[i].x * v[i].x + v[i].y * v[i].y) + (v[i].z * v[i].z + v[i].w * v[i].w); }
    const float r = rsqrtf(wave_sum(s2) * (1.0f / 2048.0f) + 1e-5f);
#pragma unroll
    for (int i = 0; i < 8; ++i) { const f32x4 gg = *(const f32x4*)(g + 256 * i + 4 * lane), bb = *(const f32x4*)(bta + 256 * i + 4 * lane);
        const f32x4 o = v[i] * r * gg + bb; *(f32x4*)(zrow + 256 * i + 4 * lane) = o;
        if (brow) { u32x2 w; w.x = pk2(o.x, o.y); w.y = pk2(o.z, o.w); *(u32x2*)(brow + 256 * i + 4 * lane) = w; } }
}
__device__ __forceinline__ void ph_ln(const Frame& F, const float* g, const float* bta, bf16* bout) {
    const int gw = F.bid * 8 + F.wave, NGW = F.G * 8, lane = F.lane();
    for (int row = gw; row < T; row += NGW) ln_row(F.a->out + (size_t)row * 2048, g, bta, bout + (size_t)row * 2048, lane);
}

__device__ __forceinline__ float pk_idx(float v, unsigned code, unsigned mask) { return __uint_as_float((__float_as_uint(v) & ~mask) | code); }
__device__ __forceinline__ void ph_peer_select(const Frame& F) {
    const Args& a = *F.a;
    const int lane = F.lane(), l31 = lane & 31, half = lane >> 5;
    const float* PQ = (const float*)F.slot(1); const float* keys = a.in[23];
    int* EIDX = (int*)(F.ws + WS_CKV); float* EG = (float*)(F.ws + WS_IKW);
    const float NEG = -__builtin_inff();
    const int h = F.bid & 7, ntw = F.G >> 3;
    { const int tid = F.wave * 64 + lane;
#pragma unroll
      for (int p = 0; p < 2; ++p)
#pragma unroll
          for (int i = 0; i < 8; ++i) { const int idx = tid + 512 * i, row = idx >> 5, c4 = idx & 31;
              *(f32x4*)(F.lds + (size_t)p * 67584 + ((size_t)row * 132 + 4 * c4) * 4) = *(const f32x4*)(keys + ((size_t)(2 * h + p) * 128 + row) * 128 + 4 * c4); }
      __syncthreads(); }
    for (int tile = (F.bid >> 3) + ntw * F.wave; tile < T / 32; tile += ntw * 8) {
        const int t = tile * 32 + l31;
        float tv[2][16];
#pragma unroll
        for (int p = 0; p < 2; ++p) {
            const int g = 2 * h + p;
            float qv[64];
            { const float* qp = PQ + (size_t)t * 2048 + g * 128 + 64 * half;
#pragma unroll
              for (int j = 0; j < 16; ++j) { const f32x4 v = *(const f32x4*)(qp + 4 * j); qv[4 * j] = v.x; qv[4 * j + 1] = v.y; qv[4 * j + 2] = v.z; qv[4 * j + 3] = v.w; } }
            f32x16 acc[4];
#pragma unroll
            for (int mt = 0; mt < 4; ++mt)
#pragma unroll
                for (int r = 0; r < 16; ++r) acc[mt][r] = 0.f;
            const float* kp0 = (const float*)(F.lds + (size_t)p * 67584) + ((size_t)l31 * 132 + 64 * half);
            f32x4 kb[3][4];
#define PK_LOADC(cc) do { _Pragma("unroll") for (int u_ = 0; u_ < 4; ++u_) kb[(cc) % 3][u_] = *(const f32x4*)(kp0 + (size_t)((cc) >> 2) * 32 * 132 + 16 * ((cc) & 3) + 4 * u_); } while (0)
#define PK_MMAC(cc) do { _Pragma("unroll") for (int u_ = 0; u_ < 4; ++u_) { const f32x4 kv_ = kb[(cc) % 3][u_]; const int j_ = 4 * ((cc) & 3) + u_; \
                acc[(cc) >> 2] = __builtin_amdgcn_mfma_f32_32x32x2f32(kv_.x, qv[4 * j_], acc[(cc) >> 2], 0, 0, 0); acc[(cc) >> 2] = __builtin_amdgcn_mfma_f32_32x32x2f32(kv_.y, qv[4 * j_ + 1], acc[(cc) >> 2], 0, 0, 0); \
                acc[(cc) >> 2] = __builtin_amdgcn_mfma_f32_32x32x2f32(kv_.z, qv[4 * j_ + 2], acc[(cc) >> 2], 0, 0, 0); acc[(cc) >> 2] = __builtin_amdgcn_mfma_f32_32x32x2f32(kv_.w, qv[4 * j_ + 3], acc[(cc) >> 2], 0, 0, 0); } } while (0)
            PK_LOADC(0); PK_LOADC(1);
            PK_LOADC(2); PK_MMAC(0); __builtin_amdgcn_sched_barrier(0);
            PK_LOADC(3); PK_MMAC(1); __builtin_amdgcn_sched_barrier(0);
            PK_LOADC(4); PK_MMAC(2); __builtin_amdgcn_sched_barrier(0);
            PK_LOADC(5); PK_MMAC(3); __builtin_amdgcn_sched_barrier(0);
            PK_LOADC(6); PK_MMAC(4); __builtin_amdgcn_sched_barrier(0);
            PK_LOADC(7); PK_MMAC(5); __builtin_amdgcn_sched_barrier(0);
            PK_LOADC(8); PK_MMAC(6); __builtin_amdgcn_sched_barrier(0);
            PK_LOADC(9); PK_MMAC(7); __builtin_amdgcn_sched_barrier(0);
            PK_LOADC(10); PK_MMAC(8); __builtin_amdgcn_sched_barrier(0);
            PK_LOADC(11); PK_MMAC(9); __builtin_amdgcn_sched_barrier(0);
            PK_LOADC(12); PK_MMAC(10); __builtin_amdgcn_sched_barrier(0);
            PK_LOADC(13); PK_MMAC(11); __builtin_amdgcn_sched_barrier(0);
            PK_LOADC(14); PK_MMAC(12); __builtin_amdgcn_sched_barrier(0);
            PK_LOADC(15); PK_MMAC(13); __builtin_amdgcn_sched_barrier(0);
            PK_MMAC(14); __builtin_amdgcn_sched_barrier(0);
            PK_MMAC(15); __builtin_amdgcn_sched_barrier(0);
#undef PK_LOADC
#undef PK_MMAC
            unsigned hmask = ~(4u * (unsigned)half); asm volatile("" : "+v"(hmask));
#pragma unroll
            for (int mt = 0; mt < 4; ++mt)
#pragma unroll
                for (int r = 0; r < 16; ++r) acc[mt][r] = __uint_as_float(((__float_as_uint(acc[mt][r]) & ~127u) | (unsigned)(127 - (32 * mt + (r & 3) + 8 * (r >> 2)))) & hmask);
#pragma unroll
            for (int k = 0; k < 16; ++k) {
                float m = acc[0][0];
#pragma unroll
                for (int mt = 0; mt < 4; ++mt)
#pragma unroll
                    for (int r = 0; r < 16; ++r) m = fmaxf(m, acc[mt][r]);
                m = fmaxf(m, __shfl_xor(m, 32));
                tv[p][k] = m;
#pragma unroll
                for (int mt = 0; mt < 4; ++mt)
#pragma unroll
                    for (int r = 0; r < 16; ++r) acc[mt][r] = (acc[mt][r] == m) ? NEG : acc[mt][r];
            }
        }
        float cand[25]; int cid[25];
        unsigned hc = 25u * (unsigned)half; asm volatile("" : "+v"(hc));
        { const float ai = half ? tv[0][2] : tv[0][0], bj = half ? tv[1][1] : tv[1][0];
          cand[0] = pk_idx(ai + bj, (unsigned)(63 - 0) - hc, 63u); cid[0] = (int)((127u - (__float_as_uint(ai) & 127u)) * 128u + (127u - (__float_as_uint(bj) & 127u))); }
        { const float ai = half ? tv[0][2] : tv[0][0], bj = half ? tv[1][2] : tv[1][1];
          cand[1] = pk_idx(ai + bj, (unsigned)(63 - 1) - hc, 63u); cid[1] = (int)((127u - (__float_as_uint(ai) & 127u)) * 128u + (127u - (__float_as_uint(bj) & 127u))); }
        { const float ai = half ? tv[0][2] : tv[0][0], bj = half ? tv[1][3] : tv[1][2];
          cand[2] = pk_idx(ai + bj, (unsigned)(63 - 2) - hc, 63u); cid[2] = (int)((127u - (__float_as_uint(ai) & 127u)) * 128u + (127u - (__float_as_uint(bj) & 127u))); }
        { const float ai = half ? tv[0][2] : tv[0][0], bj = half ? tv[1][4] : tv[1][3];
          cand[3] = pk_idx(ai + bj, (unsigned)(63 - 3) - hc, 63u); cid[3] = (int)((127u - (__float_as_uint(ai) & 127u)) * 128u + (127u - (__float_as_uint(bj) & 127u))); }
        { const float ai = half ? tv[0][3] : tv[0][0], bj = half ? tv[1][0] : tv[1][4];
          cand[4] = pk_idx(ai + bj, (unsigned)(63 - 4) - hc, 63u); cid[4] = (int)((127u - (__float_as_uint(ai) & 127u)) * 128u + (127u - (__float_as_uint(bj) & 127u))); }
        { const float ai = half ? tv[0][3] : tv[0][0], bj = half ? tv[1][1] : tv[1][5];
          cand[5] = pk_idx(ai + bj, (unsigned)(63 - 5) - hc, 63u); cid[5] = (int)((127u - (__float_as_uint(ai) & 127u)) * 128u + (127u - (__float_as_uint(bj) & 127u))); }
        { const float ai = half ? tv[0][3] : tv[0][0], bj = half ? tv[1][2] : tv[1][6];
          cand[6] = pk_idx(ai + bj, (unsigned)(63 - 6) - hc, 63u); cid[6] = (int)((127u - (__float_as_uint(ai) & 127u)) * 128u + (127u - (__float_as_uint(bj) & 127u))); }
        { const float ai = half ? tv[0][3] : tv[0][0], bj = half ? tv[1][3] : tv[1][7];
          cand[7] = pk_idx(ai + bj, (unsigned)(63 - 7) - hc, 63u); cid[7] = (int)((127u - (__float_as_uint(ai) & 127u)) * 128u + (127u - (__float_as_uint(bj) & 127u))); }
        { const float ai = half ? tv[0][4] : tv[0][0], bj = half ? tv[1][0] : tv[1][8];
          cand[8] = pk_idx(ai + bj, (unsigned)(63 - 8) - hc, 63u); cid[8] = (int)((127u - (__float_as_uint(ai) & 127u)) * 128u + (127u - (__float_as_uint(bj) & 127u))); }
        { const float ai = half ? tv[0][4] : tv[0][0], bj = half ? tv[1][1] : tv[1][9];
          cand[9] = pk_idx(ai + bj, (unsigned)(63 - 9) - hc, 63u); cid[9] = (int)((127u - (__float_as_uint(ai) & 127u)) * 128u + (127u - (__float_as_uint(bj) & 127u))); }
        { const float ai = half ? tv[0][4] : tv[0][0], bj = half ? tv[1][2] : tv[1][10];
          cand[10] = pk_idx(ai + bj, (unsigned)(63 - 10) - hc, 63u); cid[10] = (int)((127u - (__float_as_uint(ai) & 127u)) * 128u + (127u - (__float_as_uint(bj) & 127u))); }
        { const float ai = half ? tv[0][5] : tv[0][0], bj = half ? tv[1][0] : tv[1][11];
          cand[11] = pk_idx(ai + bj, (unsigned)(63 - 11) - hc, 63u); cid[11] = (int)((127u - (__float_as_uint(ai) & 127u)) * 128u + (127u - (__float_as_uint(bj) & 127u))); }
        { const float ai = half ? tv[0][5] : tv[0][0], bj = half ? tv[1][1] : tv[1][12];
          cand[12] = pk_idx(ai + bj, (unsigned)(63 - 12) - hc, 63u); cid[12] = (int)((127u - (__float_as_uint(ai) & 127u)) * 128u + (127u - (__float_as_uint(bj) & 127u))); }
        { const float ai = half ? tv[0][6] : tv[0][0], bj = half ? tv[1][0] : tv[1][13];
          cand[13] = pk_idx(ai + bj, (unsigned)(63 - 13) - hc, 63u); cid[13] = (int)((127u - (__float_as_uint(ai) & 127u)) * 128u + (127u - (__float_as_uint(bj) & 127u))); }
        { const float ai = half ? tv[0][6] : tv[0][0], bj = half ? tv[1][1] : tv[1][14];
          cand[14] = pk_idx(ai + bj, (unsigned)(63 - 14) - hc, 63u); cid[14] = (int)((127u - (__float_as_uint(ai) & 127u)) * 128u + (127u - (__float_as_uint(bj) & 127u))); }
        { const float ai = half ? tv[0][7] : tv[0][0], bj = half ? tv[1][0] : tv[1][15];
          cand[15] = pk_idx(ai + bj, (unsigned)(63 - 15) - hc, 63u); cid[15] = (int)((127u - (__float_as_uint(ai) & 127u)) * 128u + (127u - (__float_as_uint(bj) & 127u))); }
        { const float ai = half ? tv[0][7] : tv[0][1], bj = half ? tv[1][1] : tv[1][0];
          cand[16] = pk_idx(ai + bj, (unsigned)(63 - 16) - hc, 63u); cid[16] = (int)((127u - (__float_as_uint(ai) & 127u)) * 128u + (127u - (__float_as_uint(bj) & 127u))); }
        { const float ai = half ? tv[0][8] : tv[0][1], bj = half ? tv[1][0] : tv[1][1];
          cand[17] = pk_idx(ai + bj, (unsigned)(63 - 17) - hc, 63u); cid[17] = (int)((127u - (__float_as_uint(ai) & 127u)) * 128u + (127u - (__float_as_uint(bj) & 127u))); }
        { const float ai = half ? tv[0][9] : tv[0][1], bj = half ? tv[1][0] : tv[1][2];
          cand[18] = pk_idx(ai + bj, (unsigned)(63 - 18) - hc, 63u); cid[18] = (int)((127u - (__float_as_uint(ai) & 127u)) * 128u + (127u - (__float_as_uint(bj) & 127u))); }
        { const float ai = half ? tv[0][10] : tv[0][1], bj = half ? tv[1][0] : tv[1][3];
          cand[19] = pk_idx(ai + bj, (unsigned)(63 - 19) - hc, 63u); cid[19] = (int)((127u - (__float_as_uint(ai) & 127u)) * 128u + (127u - (__float_as_uint(bj) & 127u))); }
        { const float ai = half ? tv[0][11] : tv[0][1], bj = half ? tv[1][0] : tv[1][4];
          cand[20] = pk_idx(ai + bj, (unsigned)(63 - 20) - hc, 63u); cid[20] = (int)((127u - (__float_as_uint(ai) & 127u)) * 128u + (127u - (__float_as_uint(bj) & 127u))); }
        { const float ai = half ? tv[0][12] : tv[0][1], bj = half ? tv[1][0] : tv[1][5];
          cand[21] = pk_idx(ai + bj, (unsigned)(63 - 21) - hc, 63u); cid[21] = (int)((127u - (__float_as_uint(ai) & 127u)) * 128u + (127u - (__float_as_uint(bj) & 127u))); }
        { const float ai = half ? tv[0][13] : tv[0][1], bj = half ? tv[1][0] : tv[1][6];
          cand[22] = pk_idx(ai + bj, (unsigned)(63 - 22) - hc, 63u); cid[22] = (int)((127u - (__float_as_uint(ai) & 127u)) * 128u + (127u - (__float_as_uint(bj) & 127u))); }
        { const float ai = half ? tv[0][14] : tv[0][1], bj = half ? tv[1][0] : tv[1][7];
          cand[23] = pk_idx(ai + bj, (unsigned)(63 - 23) - hc, 63u); cid[23] = (int)((127u - (__float_as_uint(ai) & 127u)) * 128u + (127u - (__float_as_uint(bj) & 127u))); }
        { const float ai = half ? tv[0][15] : tv[0][2], bj = half ? tv[1][0] : tv[1][0];
          cand[24] = pk_idx(ai + bj, (unsigned)(63 - 24) - hc, 63u); cid[24] = (int)((127u - (__float_as_uint(ai) & 127u)) * 128u + (127u - (__float_as_uint(bj) & 127u))); }
        float sv[16]; int sid[16];
#pragma unroll
        for (int k = 0; k < 16; ++k) {
            float m = cand[0];
#pragma unroll
            for (int c = 1; c < 25; ++c) m = fmaxf(m, cand[c]);
            const float mo = __shfl_xor(m, 32);
            const bool mine = (m > mo) || (m == mo && half == 0);
            const float mm = fmaxf(m, mo);
            int id = -1;
#pragma unroll
            for (int c = 0; c < 25; ++c) { const bool hit = mine && (cand[c] == mm); id = hit ? cid[c] : id; cand[c] = hit ? NEG : cand[c]; }
            const int ido = __shfl_xor(id, 32);
            sv[k] = mm; sid[k] = id > ido ? id : ido;
        }
        float den = 0.f; float ev[16];
#pragma unroll
        for (int k = 0; k < 16; ++k) { ev[k] = expf(sv[k] - sv[0]); den += ev[k]; }
        const float inv = 1.0f / den;
        if (half == 0) { int* ep = EIDX + (size_t)t * 128 + h * 16;
#pragma unroll
            for (int k = 0; k < 16; k += 4) *(u32x4*)(ep + k) = (u32x4){(unsigned)sid[k], (unsigned)sid[k + 1], (unsigned)sid[k + 2], (unsigned)sid[k + 3]}; }
        else { float* gp = EG + (size_t)t * 128 + h * 16;
#pragma unroll
            for (int k = 0; k < 16; k += 4) *(f32x4*)(gp + k) = (f32x4){ev[k] * inv, ev[k + 1] * inv, ev[k + 2] * inv, ev[k + 3] * inv}; }
    }
}

typedef unsigned v6u __attribute__((ext_vector_type(6)));
typedef float v32f __attribute__((ext_vector_type(32)));
typedef float v16f __attribute__((ext_vector_type(16)));
constexpr float PU_SCALE = 64.0f, PV_SCALE = 2.0f;
#ifndef FP6_INTERLEAVED
#define FP6_INTERLEAVED 1
#endif
#define RL(v, l) __builtin_amdgcn_readlane((v), (l))
#define EXR 4
#define EX_LOAD(buf, tab, idv, e) do { _Pragma("unroll") for (int r_ = 0; r_ < EXR; ++r_) { const unsigned* rp_ = (const unsigned*)((tab) + (size_t)RL(idv, ((e) & 63) + r_) * 1536) + 6 * lane; \
        const u32x2 p0_ = *(const u32x2*)rp_, p1_ = *(const u32x2*)(rp_ + 2), p2_ = *(const u32x2*)(rp_ + 4); buf[r_] = (v6u){p0_.x, p0_.y, p1_.x, p1_.y, p2_.x, p2_.y}; } } while (0)
#define EX_DOT(buf, e) do { float d_[EXR]; _Pragma("unroll") for (int r_ = 0; r_ < EXR; ++r_) { const v32f w_ = __builtin_amdgcn_cvt_scalef32_pk32_f32_fp6(buf[r_], 1.0f); float a_ = 0.f, b_ = 0.f; \
        _Pragma("unroll") for (int j_ = 0; j_ < 32; j_ += 2) { a_ += w_[j_] * xf[j_]; b_ += w_[j_ + 1] * xf[j_ + 1]; } d_[r_] = a_ + b_; __builtin_amdgcn_sched_barrier(0); } \
        _Pragma("unroll") for (int r_ = 0; r_ < EXR; ++r_) d_[r_] = wave_sum_dpp(d_[r_]); \
        _Pragma("unroll") for (int r_ = 0; r_ < EXR; ++r_) { const float pre_ = d_[r_] * (1.0f / PU_SCALE); const float hv_ = 0.5f * pre_ * (1.0f + erff(pre_ * 0.7071067811865476f)); \
            if (lane == (((e) & 63) + r_)) { if ((e) < 64) c0 = g0 * hv_; else c1 = g1 * hv_; } } } while (0)
#define EX_AXPY(buf, e) do { const float cv_ = (e) < 64 ? c0 : c1; _Pragma("unroll") for (int r_ = 0; r_ < EXR; ++r_) { const float cf_ = __int_as_float(RL(__float_as_int(cv_), ((e) & 63) + r_)) * (1.0f / PV_SCALE); \
        const v32f w_ = __builtin_amdgcn_cvt_scalef32_pk32_f32_fp6(buf[r_], 1.0f); _Pragma("unroll") for (int j_ = 0; j_ < 32; ++j_) y[j_] += cf_ * w_[j_]; __builtin_amdgcn_sched_barrier(0); } } while (0)
__device__ __forceinline__ void cvt_fp6_stream(const Frame& F, const float* src, unsigned char* dst, size_t nrows, float scale, int wg, int nwg) {
    const int lane = F.lane();
    float* tile = (float*)(F.lds + F.wave * 8192);
    for (size_t r = (size_t)wg * 8 + F.wave; r < nrows; r += (size_t)nwg * 8) {
#pragma unroll
        for (int j = 0; j < 8; ++j) *(f32x4*)(tile + 256 * j + 4 * lane) = *(const f32x4*)(src + r * 2048 + 256 * j + 4 * lane) * scale;
        WAVE_SYNC();
        f32x4 q[8];
#pragma unroll
        for (int j = 0; j < 8; ++j) q[j] = *(const f32x4*)(tile + 32 * lane + 4 * j);
        WAVE_SYNC();
        v16f x, y;
#pragma unroll
        for (int j = 0; j < 8; ++j) { x[2 * j] = q[j].x; y[2 * j] = q[j].y; x[2 * j + 1] = q[j].z; y[2 * j + 1] = q[j].w; }
        const v6u p = __builtin_amdgcn_cvt_scalef32_2xpk16_fp6_f32(x, y, 1.0f);
        unsigned* o = (unsigned*)(dst + r * 1536) + 6 * lane;
        *(u32x2*)o = (u32x2){p[0], p[1]}; *(u32x2*)(o + 2) = (u32x2){p[2], p[3]}; *(u32x2*)(o + 4) = (u32x2){p[4], p[5]};
    }
}
#define EX_LOAD_XF() do { float mu_, rs_; row_mu_rstd((const float*)(F.ws + WS_CTL + CTL_ST2), t, mu_, rs_); \
          const bf16* zr = F.slot(0) + (size_t)t * 2048 + lq; \
          _Pragma("unroll") for (int q = 0; q < 4; ++q) { const int col = lq + 8 * q; f32x4 z0, z1; unpack8v(*(const u32x4*)(zr + 8 * q), z0, z1); \
              const f32x4 g0v = *(const f32x4*)(a.in[20] + col), g1v = *(const f32x4*)(a.in[20] + col + 4), b0v = *(const f32x4*)(a.in[21] + col), b1v = *(const f32x4*)(a.in[21] + col + 4); \
              const f32x4 h0 = (z0 - mu_) * rs_ * g0v + b0v, h1 = (z1 - mu_) * rs_ * g1v + b1v; \
              xf[8 * q] = h0.x; xf[8 * q + 1] = h0.y; xf[8 * q + 2] = h0.z; xf[8 * q + 3] = h0.w; xf[8 * q + 4] = h1.x; xf[8 * q + 5] = h1.y; xf[8 * q + 6] = h1.z; xf[8 * q + 7] = h1.w; } } while (0)
__device__ __forceinline__ void ph16_experts(const Frame& F) {
    const Args& a = *F.a;
    const int gw = F.bid * 8 + F.wave, NGW = F.G * 8, lane0 = F.lane();
    const int* EIDX = (const int*)(F.ws + WS_CKV); const float* EG = (const float*)(F.ws + WS_IKW);
    const unsigned char* PU = (const unsigned char*)(F.ws + WS_WIN); const unsigned char* PV = PU + (size_t)32 * MiB;
    for (int t = gw; t < T; t += NGW) {
        int lane_l = lane0; asm volatile("" : "+v"(lane_l)); const int lane = lane_l;
        float* xrow = a.out + (size_t)t * 2048;
        float xf[32];
        const int lq = 32 * lane;
        EX_LOAD_XF();
        const int id0 = EIDX[(size_t)t * 128 + lane], id1 = EIDX[(size_t)t * 128 + 64 + lane];
        const float g0 = EG[(size_t)t * 128 + lane], g1 = EG[(size_t)t * 128 + 64 + lane];
        float c0 = 0.f, c1 = 0.f;
        v6u bA[EXR], bB[EXR];
        EX_LOAD(bA, PU, id0, 0);
        for (int e = 0; e < 128; e += 2 * EXR) {
            const int idv = e < 64 ? id0 : id1;
            EX_LOAD(bB, PU, idv, e + EXR);
            EX_DOT(bA, e);
            if (e + 2 * EXR < 128) { const int idn = (e + 2 * EXR) < 64 ? id0 : id1; EX_LOAD(bA, PU, idn, e + 2 * EXR); }
            EX_DOT(bB, e + EXR);
        }
        float y[32];
#pragma unroll
        for (int j = 0; j < 32; ++j) y[j] = 0.f;
        EX_LOAD(bA, PV, id0, 0);
        for (int e = 0; e < 128; e += 2 * EXR) {
            const int idv = e < 64 ? id0 : id1;
            EX_LOAD(bB, PV, idv, e + EXR);
            EX_AXPY(bA, e);
            if (e + 2 * EXR < 128) { const int idn = (e + 2 * EXR) < 64 ? id0 : id1; EX_LOAD(bA, PV, idn, e + 2 * EXR); }
            EX_AXPY(bB, e + EXR);
        }
        EX_LOAD_XF();
        float s = 0.f;
#pragma unroll
        for (int j = 0; j < 32; ++j) { y[j] += ALPHA * xf[j]; s += y[j]; }
        const float mu = wave_sum_dpp(s) * (1.0f / 2048.0f); float s2 = 0.f;
#pragma unroll
        for (int j = 0; j < 32; ++j) { y[j] -= mu; s2 += y[j] * y[j]; }
        const float rs = rsqrtf(wave_sum_dpp(s2) * (1.0f / 2048.0f) + 1e-5f);
        const int lofs = lq;
#pragma unroll
        for (int q = 0; q < 8; ++q) { const int col = lofs + 4 * q;
            const f32x4 ga = *(const f32x4*)(a.in[26] + col), ba = *(const f32x4*)(a.in[27] + col);
            f32x4 o; o.x = y[4 * q] * rs * ga.x + ba.x; o.y = y[4 * q + 1] * rs * ga.y + ba.y; o.z = y[4 * q + 2] * rs * ga.z + ba.z; o.w = y[4 * q + 3] * rs * ga.w + ba.w;
            *(f32x4*)(xrow + col) = o; }
    }
}

#define XB_TMO      128
#define XB_XCNT(j)  (256  + 64 * (j))
#define XB_XSUB(j)  (1280 + 64 * (j))
#define XB_XGEN(j)  (2304 + 64 * (j))
#define XB_TOP      3328
#define XB_TOPGEN   3392
#define XCD_BAR_WORDS 3456
#define XB_SPIN_CAP (1u << 22)
__device__ __forceinline__ unsigned xb_ld(unsigned* p)              { return __hip_atomic_load(p, __ATOMIC_RELAXED, __HIP_MEMORY_SCOPE_AGENT); }
__device__ __forceinline__ unsigned xb_add(unsigned* p, unsigned v) { return __hip_atomic_fetch_add(p, v, __ATOMIC_RELAXED, __HIP_MEMORY_SCOPE_AGENT); }
__device__ __forceinline__ unsigned xb_xcc_id() { return (unsigned)__builtin_amdgcn_s_getreg((3 << 11) | 20) & 0xFu; }
#define XB_SPIN(cond, bar) do { unsigned _sp = 0; while (cond) { __builtin_amdgcn_s_sleep(1); \
    if ((++_sp & 255u) == 0u) { if (xb_ld(&(bar)[XB_TMO])) break; if (_sp > XB_SPIN_CAP) { atomicAdd(&(bar)[XB_TMO], 1u); break; } } } } while (0)
struct XcdBarrier { unsigned* bar; unsigned x; volatile unsigned* st; };
__device__ __forceinline__ void xcd_barrier_complete(unsigned* bar, unsigned x, unsigned G, unsigned& nloc, unsigned& nx) {
    unsigned sum, cnt, mine, sp = 0u;
    for (;;) {
        sum = 0u; cnt = 0u; mine = 0u;
#pragma unroll
        for (unsigned j = 0; j < 16; ++j) { const unsigned c = xb_ld(&bar[XB_XCNT(j)]); sum += c; cnt += (c > 0u) ? 1u : 0u; mine = (j == x) ? c : mine; }
        if (sum == G) break;
        __builtin_amdgcn_s_sleep(1);
        if ((++sp & 255u) == 0u) { if (xb_ld(&bar[XB_TMO])) break; if (sp > XB_SPIN_CAP) { atomicAdd(&bar[XB_TMO], 1u); break; } }
    }
    nloc = mine > 0u ? mine : 1u; nx = cnt > 0u ? cnt : 1u;
}
__device__ __forceinline__ void xcd_barrier(const XcdBarrier& b, bool leader, unsigned G) {
    asm volatile("s_waitcnt vmcnt(0)" ::: "memory");
    __syncthreads();
    if (leader) {
        unsigned* bar = b.bar;
        __builtin_amdgcn_s_waitcnt(0);
        unsigned nloc = b.st[0], nx = b.st[1];
        if (nloc == 0u) { xcd_barrier_complete(bar, b.x, G, nloc, nx); b.st[0] = nloc; b.st[1] = nx; }
        const unsigned old = xb_add(&bar[XB_XSUB(b.x)], 1u);
        const unsigned gen = old / nloc;
        if (old + 1u == (gen + 1u) * nloc) {
            __builtin_amdgcn_fence(__ATOMIC_RELEASE, "agent");
            asm volatile("s_waitcnt vmcnt(0)" ::: "memory");
            const unsigned og = xb_add(&bar[XB_TOP], 1u);
            const unsigned tg = og / nx;
            if (og + 1u == (tg + 1u) * nx) xb_add(&bar[XB_TOPGEN], 1u);
            else XB_SPIN(xb_ld(&bar[XB_TOPGEN]) == tg, bar);
            __builtin_amdgcn_fence(__ATOMIC_ACQUIRE, "agent");
            xb_add(&bar[XB_XGEN(b.x)], 1u);
            asm volatile("s_waitcnt vmcnt(0)" ::: "memory");
        } else {
            XB_SPIN(xb_ld(&bar[XB_XGEN(b.x)]) == gen, bar);
            __builtin_amdgcn_fence(__ATOMIC_ACQUIRE, "agent");
            asm volatile("s_waitcnt vmcnt(0)" ::: "memory");
        }
    }
    __syncthreads();
}

__device__ __forceinline__ void sub_barrier(unsigned* ctr, unsigned n, bool leader) {
    asm volatile("s_waitcnt vmcnt(0)" ::: "memory");
    __syncthreads();
    if (leader) {
        __builtin_amdgcn_fence(__ATOMIC_RELEASE, "agent");
        asm volatile("s_waitcnt vmcnt(0)" ::: "memory");
        (void)xb_add(ctr, 1u);
        unsigned sp = 0u; while (xb_ld(ctr) < n) { __builtin_amdgcn_s_sleep(1); if (++sp > XB_SPIN_CAP) break; }
        __builtin_amdgcn_fence(__ATOMIC_ACQUIRE, "agent");
        asm volatile("s_waitcnt vmcnt(0)" ::: "memory");
    }
    __syncthreads();
}

__global__ void __launch_bounds__(512, 2) mega(Args args) {
    extern __shared__ __attribute__((aligned(16))) unsigned char lds[];
    cg::grid_group grid = cg::this_grid();
    Frame F;
    F.lds = lds; F.wave = __builtin_amdgcn_readfirstlane(threadIdx.x >> 6); F.bid = blockIdx.x; F.G = gridDim.x;
    F.a = &args; F.ws = args.ws;
    const int lo = args.ph_lo, hi = args.ph_hi;
    unsigned long long sec_acc = 0ull;
    if (lo < 0) grid.sync();
    volatile unsigned* xst = (volatile unsigned*)(lds + LDS_BYTES - 64);
    const bool leader = (F.wave == 0) && (fresh_lane() == 0);
    if (leader) { xst[0] = 0u; xst[1] = 0u; }
    XcdBarrier xbar; xbar.bar = (unsigned*)(F.ws + WS_CTL + CTL_BAR); xbar.x = xb_xcc_id(); xbar.st = xst;
    if (leader) (void)xb_add(&xbar.bar[XB_XCNT(xbar.x)], 1u);
    __syncthreads();
    bf16* W8 = (bf16*)((unsigned char*)args.out + (size_t)64 * MiB);
#define IN(k) (lo <= (k) && (k) < hi)
#if PROBE_MASK
    unsigned long long pr_acc = 0ull, pr_t0 = rt_now();
#define SEAM(k) do { if (IN(k) && IN((k) + 1)) { xcd_barrier(xbar, (F.wave == 0) && (fresh_lane() == 0), (unsigned)F.G); } { const unsigned long long t1_ = rt_now(); if ((PROBE_MASK >> (k)) & 1u) pr_acc += t1_ - pr_t0; pr_t0 = t1_; } } while (0)
#else
#define SEAM(k) do { if (IN(k) && IN((k) + 1)) { xcd_barrier(xbar, (F.wave == 0) && (fresh_lane() == 0), (unsigned)F.G); } } while (0)
#endif
    if (IN(0)) { ph0_prologue(F); } SEAM(0);
    if (IN(1)) {
        pg8::MultiOrder<3> S; S.lda = 2048; S.ldb = 2048; S.G = F.G; S.c = F.bid;
        S.s[0] = pg8::Sub{(const bf16*)args.out, (const bf16*)(F.ws + WS_WIN), 64, NCOLS / 256};
        S.s[1] = pg8::Sub{(const bf16*)(F.ws + WS_MEMB), W8 + (size_t)4 * 2048 * 2048, 8, 8};
        S.s[2] = pg8::Sub{W8 + (size_t)5 * 2048 * 2048, (const bf16*)(F.ws + WS_MEMB), 8, 8};
        gemm_multi<3>(F, S, 2048, OpProjCKV{F.ws});
        w8_transposes(F, W8);
    } SEAM(1);
    if (IN(2)) {
        if (F.G == 256) {
            if (F.bid < 128) { hgrn_chunked(F, F.bid, sec_acc);
                cvt_fp6_stream(F, args.in[24], F.ws + WS_WIN, (size_t)16384, PU_SCALE, F.bid, 128); cvt_fp6_stream(F, args.in[25], F.ws + WS_WIN + (size_t)32 * MiB, (size_t)16384, PV_SCALE, F.bid, 128); }
            else { ph2_side(F, F.bid - 128, 128); sub_barrier((unsigned*)(F.ws + WS_CTL + CTL_BAR) + 3520, 128u, (F.wave == 0) && (fresh_lane() == 0)); ph5_select(F, F.bid - 128, 128); }
        } else {
            for (int u = F.bid; u < 128; u += F.G) hgrn_chunked(F, u, sec_acc);
            ph2_side(F, F.bid, F.G);
            xcd_barrier(xbar, (F.wave == 0) && (fresh_lane() == 0), (unsigned)F.G);
            ph5_select(F, F.bid, F.G);
            cvt_fp6_stream(F, args.in[24], F.ws + WS_WIN, (size_t)16384, PU_SCALE, F.bid, F.G); cvt_fp6_stream(F, args.in[25], F.ws + WS_WIN + (size_t)32 * MiB, (size_t)16384, PV_SCALE, F.bid, F.G);
        }
    } SEAM(2);
    if (IN(4)) {
        gemm(F, (const bf16*)(F.ws + WS_CKV), 256, (const bf16*)(F.ws + WS_WKV), 256, T, 4096, 256, OpSplit2{F.slot(1), F.slot(2)});
    } SEAM(4);
    if (IN(6)) { ph6_attn(F); } SEAM(6);
    if (IN(7)) {
        pg8::Gemm g{2048, 4096, 4096}; pg8::MultiOrder<1> S; S.s[0] = pg8::Sub{F.slot(0), W8, 64, 8}; S.lda = 2048; S.ldb = 4096; S.G = F.G; S.c = F.bid; S.A2 = F.slot(3);
        EpiYAB E{F.slot(6), F.slot(7)};
        pg8::gemm_phase<EpiYAB, pg8::MultiOrder<1>, true, true>((PG8_LAS unsigned char*)F.lds, g, S, E, F.wave, F.lane());
    } SEAM(7);
    if (IN(8)) { gemm_epi(F, F.slot(6), 2048, W8 + (size_t)2 * 2048 * 2048, 2048, T, 2048, 2048, EpiMixStats{args.in[0], F.slot(0), (float*)(F.ws + WS_CTL + CTL_ST1)}); } SEAM(8);
    if (IN(10)) { gemm(F, F.slot(0), 2048, W8 + (size_t)3 * 2048 * 2048, 2048, T, 2048, 2048, OpCQKV{F.slot(1), nullptr, nullptr, (float*)(F.ws + WS_CTL + CTL_ST1), (float*)(F.ws + WS_CTL + CTL_CVEC), (float*)(F.ws + WS_CTL + CTL_CVEC) + 2048}); } SEAM(10);
    if (IN(11)) {
        pg8::BatchOrder<OffS> S{F.slot(1), (const bf16*)(F.ws + WS_CK), 8, 1, 32, 2048, 2048, F.G, F.bid, OffS()};
        gemm_batch(F, S, 512, OpLogit{(float*)F.slot(2)});
    } SEAM(11);
    if (IN(12)) { ph_xsoftmax(F, (const float*)F.slot(2), F.slot(3)); } SEAM(12);
    if (IN(13)) {
        pg8::BatchOrder<OffPV> S{F.slot(3), (const bf16*)(F.ws + WS_VT), 8, 2, 32, 1024, 2048, F.G, F.bid, OffPV()};
        gemm_batch(F, S, 256, OpCO{F.slot(4)});
    } SEAM(13);
    if (IN(14)) { gemm_epi(F, F.slot(4), 2048, W8 + (size_t)6 * 2048 * 2048, 2048, T, 2048, 2048, EpiCOStats{F.slot(0), (float*)(F.ws + WS_CTL + CTL_ST1), (float*)(F.ws + WS_CTL + CTL_ST2), args.in[14], args.in[15]}); } SEAM(14);
    if (IN(16)) { gemm(F, F.slot(0), 2048, W8 + (size_t)7 * 2048 * 2048, 2048, T, 2048, 2048, OpPQFold{(float*)F.slot(1), (float*)(F.ws + WS_CTL + CTL_ST2), (float*)(F.ws + WS_CTL + CTL_CVEC) + 4096, (float*)(F.ws + WS_CTL + CTL_CVEC) + 6144}); } SEAM(16);
    if (IN(17)) { ph_peer_select(F); } SEAM(17);
    if (IN(18)) { ph16_experts(F); }
#if PROBE_MASK
    xcd_barrier(xbar, (F.wave == 0) && (fresh_lane() == 0), (unsigned)F.G);
    { const unsigned long long t1_ = rt_now(); if ((PROBE_MASK >> 18) & 1u) pr_acc += t1_ - pr_t0; pr_acc += sec_acc;
      if (F.bid == 0 && threadIdx.x == 0) { const unsigned long long ts_ = rt_now(); while (rt_now() - ts_ < pr_acc) __builtin_amdgcn_s_sleep(8); } }
#endif
#undef IN
#undef SEAM
}

extern "C" void kernel_launch(void* const* d_in, const int* in_sizes, int n_in, void* d_out, int out_size, void* d_ws, size_t ws_size, hipStream_t stream) {
    static int grid = 0;
    if (grid == 0) {
        if (n_in != 28 || out_size != T * D || ws_size < WS_END) { fprintf(stderr, "kernel_launch: unexpected shapes (n_in %d out %d ws %zu)\n", n_in, out_size, ws_size); grid = -1; return; }
        int dev = 0, cus = 0, per_cu = 0;
        hipGetDevice(&dev); hipDeviceGetAttribute(&cus, hipDeviceAttributeMultiprocessorCount, dev);
        hipFuncSetAttribute((const void*)mega, hipFuncAttributeMaxDynamicSharedMemorySize, LDS_BYTES);
        hipOccupancyMaxActiveBlocksPerMultiprocessor(&per_cu, (const void*)mega, 512, LDS_BYTES);
        if (per_cu < 1) { fprintf(stderr, "kernel_launch: occupancy query says %d blocks per CU\n", per_cu); per_cu = 1; }
        (void)hipGetLastError();
        grid = cus;
    }
    if (grid < 0) return;
    (void)hipMemsetAsync((char*)d_ws + WS_CTL, 0, CTL_ZERO, stream);
    Args a{};
    for (int i = 0; i < 28; ++i) a.in[i] = (const float*)d_in[i];
    a.out = (float*)d_out; a.ws = (unsigned char*)d_ws;
#if ONE_LAUNCH
    a.ph_lo = 0; a.ph_hi = NPH;
    void* params[] = {&a};
    hipError_t e = hipLaunchCooperativeKernel((const void*)mega, dim3(grid), dim3(512), params, LDS_BYTES, stream);
    if (e != hipSuccess) fprintf(stderr, "cooperative launch failed: %s\n", hipGetErrorString(e));
#else
    for (int ph = 0; ph < NPH; ++ph) {
        a.ph_lo = ph; a.ph_hi = ph + 1;
        void* params[] = {&a};
        hipError_t e = hipLaunchCooperativeKernel((const void*)mega, dim3(grid), dim3(512), params, LDS_BYTES, stream);
        if (e != hipSuccess) { fprintf(stderr, "launch %d failed: %s\n", ph, hipGetErrorString(e)); break; }
    }
#endif
}
```

```cpp
#include <hip/hip_runtime.h>
#include <hip/hip_cooperative_groups.h>
#include <cstdint>
#include <cmath>
#include <cstdio>
namespace cg = cooperative_groups;

#ifndef ONE_LAUNCH
#define ONE_LAUNCH 1
#endif
#ifndef PROBE_MASK
#define PROBE_MASK 0u
#endif
#ifndef PROBE_SEC
#define PROBE_SEC 0
#endif

typedef unsigned short bf16;
typedef short bf16x8 __attribute__((ext_vector_type(8)));
typedef float f32x4 __attribute__((ext_vector_type(4)));
typedef float f32x16 __attribute__((ext_vector_type(16)));
typedef unsigned u32x4 __attribute__((ext_vector_type(4)));
typedef unsigned u32x2 __attribute__((ext_vector_type(2)));
typedef float f32x2v __attribute__((ext_vector_type(2)));

constexpr int T = 16384, D = 2048, SEQ = 2048, NB = 8;
constexpr int NCOLS = 16896;
constexpr float ALPHA = 1.189207115002721f;
constexpr int NPH = 19;

constexpr size_t MiB = 1u << 20;
constexpr size_t WS_CTL = 0, WS_MEMB = 1 * MiB, WS_WKV = 9 * MiB, WS_LB = 11 * MiB, WS_MASK = 12 * MiB, WS_WIN = 17 * MiB,
                 WS_SLOT = 83 * MiB, SLOT_BYTES = 64 * MiB, WS_CKV = 595 * MiB, WS_IKW = 603 * MiB, WS_CK = 611 * MiB, WS_VT = 619 * MiB, WS_END = 627 * MiB;
constexpr int LDS_BYTES = 157696;
constexpr size_t CTL_BAR = 16384, CTL_CVEC = 65536, CTL_ST1 = 262144, CTL_ST2 = 393216, CTL_ZERO = 524288;

struct Args {
    const float* in[28];
    float* out;
    unsigned char* ws;
    int ph_lo, ph_hi;
};

#define WAVE_SYNC() asm volatile("s_waitcnt lgkmcnt(0)" ::: "memory")

__device__ __forceinline__ unsigned f2bf(float f) { unsigned u = __float_as_uint(f); return (u + 0x7fffu + ((u >> 16) & 1u)) >> 16; }
__device__ __forceinline__ unsigned pk2(float lo, float hi) { return f2bf(lo) | (f2bf(hi) << 16); }
__device__ __forceinline__ float bf2f(unsigned h) { return __uint_as_float(h << 16); }
__device__ __forceinline__ float bflo(unsigned w) { return __uint_as_float(w << 16); }
__device__ __forceinline__ float bfhi(unsigned w) { return __uint_as_float(w & 0xffff0000u); }
__device__ __forceinline__ float wave_sum(float v) {
#pragma unroll
    for (int o = 32; o >= 1; o >>= 1) v += __shfl_xor(v, o);
    return v;
}
__device__ __forceinline__ float wave_max(float v) {
#pragma unroll
    for (int o = 32; o >= 1; o >>= 1) v = fmaxf(v, __shfl_xor(v, o));
    return v;
}
__device__ __forceinline__ float row16_sum(float v) {
    v += __int_as_float(__builtin_amdgcn_mov_dpp(__float_as_int(v), 0xB1, 0xF, 0xF, false));
    v += __int_as_float(__builtin_amdgcn_mov_dpp(__float_as_int(v), 0x4E, 0xF, 0xF, false));
    v += __int_as_float(__builtin_amdgcn_mov_dpp(__float_as_int(v), 0x124, 0xF, 0xF, false));
    v += __int_as_float(__builtin_amdgcn_mov_dpp(__float_as_int(v), 0x128, 0xF, 0xF, false));
    return v;
}
__device__ __forceinline__ float wave_sum_dpp(float v) {
    v = row16_sum(v);
    return (__int_as_float(__builtin_amdgcn_readlane(__float_as_int(v), 0)) + __int_as_float(__builtin_amdgcn_readlane(__float_as_int(v), 16)))
         + (__int_as_float(__builtin_amdgcn_readlane(__float_as_int(v), 32)) + __int_as_float(__builtin_amdgcn_readlane(__float_as_int(v), 48)));
}
__device__ __forceinline__ float sigm(float x) { return 1.0f / (1.0f + expf(-x)); }
__device__ __forceinline__ void unpack8(u32x4 w, float* f) {
    f[0] = bflo(w.x); f[1] = bfhi(w.x); f[2] = bflo(w.y); f[3] = bfhi(w.y); f[4] = bflo(w.z); f[5] = bfhi(w.z); f[6] = bflo(w.w); f[7] = bfhi(w.w);
}

__device__ __forceinline__ int fresh_lane() { int l; asm volatile("v_mbcnt_lo_u32_b32 %0, -1, 0\n\tv_mbcnt_hi_u32_b32 %0, -1, %0" : "=v"(l)); return l; }
__device__ __forceinline__ unsigned long long rt_now() { unsigned long long t; asm volatile("s_memrealtime %0\n\ts_waitcnt lgkmcnt(0)" : "=s"(t) :: "memory"); return t; }
struct Frame {
    unsigned char* lds;
    int wave, bid, G;
    __device__ __forceinline__ int lane() const { return fresh_lane(); }
    const Args* a;
    unsigned char* ws;
    __device__ __forceinline__ bf16* slot(int i) const { return (bf16*)(ws + WS_SLOT + (size_t)i * SLOT_BYTES); }
};

namespace pg8 {
#define PG8_LAS __attribute__((address_space(3)))
constexpr int BM = 256, BK = 64, HALF = 128, HTB = HALF * BK * 2, STAGE_BYTES = 8 * HTB, NXCD = 8, WGM = 8;
__host__ __device__ __forceinline__ int lds_byte(int r, int c) { const int st = (r >> 4) * 2 + (c >> 5), rr = r & 15, cc = c & 31, ob = rr * 64 + cc * 2; return st * 1024 + (ob ^ (((ob >> 9) & 1) << 5)); }
__host__ __device__ __forceinline__ void stage_rc(int b, int& R, int& C) { const int st = b / 1024, sb = b % 1024, swz = sb ^ (((sb >> 9) & 1) << 5); R = (st >> 1) * 16 + swz / 64; C = (st & 1) * 32 + (swz % 64) / 2; }
__host__ __device__ __forceinline__ int perm32(int rho) { const int n = rho >> 4, i = rho & 15; return 8 * (i >> 2) + 4 * n + (i & 3); }
struct Unit { int pm, pn, z; const char* a; const char* b; const char* a2; };
struct Gemm { int lda, ldb, K; };
__device__ __forceinline__ void tile_of(int wgid, int nM, int nN, int& pm, int& pn) {
    const int nwg = nM * nN; { const int q = nwg / NXCD, r = nwg % NXCD, xcd = wgid % NXCD, off = wgid / NXCD; wgid = (xcd < r ? xcd * (q + 1) : r * (q + 1) + (xcd - r) * q) + off; }
    const int nig = WGM * nN, gid = wgid / nig, fm = gid * WGM, gsz = (nM - fm) < WGM ? (nM - fm) : WGM;
    pm = fm + ((wgid % nig) % gsz); pn = (wgid % nig) / gsz;
}
struct Sub { const bf16* A; const bf16* Bt; int nM, nN; };
template <int NS> struct MultiOrder {
    Sub s[NS]; int lda, ldb, G, c; const bf16* A2 = nullptr;
    __device__ __forceinline__ bool next(int i, Unit& u) const {
        int L = i * G + c;
#pragma unroll
        for (int k = 0; k < NS; ++k) { const int n = s[k].nM * s[k].nN;
            if (L < n) { tile_of(L, s[k].nM, s[k].nN, u.pm, u.pn); u.z = k; u.a = (const char*)(s[k].A + (size_t)u.pm * BM * lda); u.b = (const char*)(s[k].Bt + (size_t)u.pn * BM * ldb); u.a2 = A2 ? (const char*)(A2 + (size_t)u.pm * BM * lda) : nullptr; return true; }
            L -= n; }
        return false;
    }
};
template <class Off> struct BatchOrder {
    const bf16* A; const bf16* Bt; int nM, nN, nz, lda, ldb, G, c; Off off;
    __device__ __forceinline__ bool next(int i, Unit& u) const {
        const int L = i * G + c, per = nM * nN; if (L >= per * nz) return false;
        u.z = L / per; const int r = L % per; u.pn = r / nM; u.pm = r % nM;
        u.a = (const char*)(A + off.a(u.z) + (size_t)u.pm * BM * lda); u.b = (const char*)(Bt + off.b(u.z) + (size_t)u.pn * BM * ldb); u.a2 = nullptr; return true;
    }
};
__device__ __forceinline__ unsigned cvt_pk_bf16(float lo, float hi) { unsigned r; asm volatile("v_cvt_pk_bf16_f32 %0, %1, %2" : "=v"(r) : "v"(lo), "v"(hi)); return r; }

template <class Op> struct Epi8 {
    static constexpr bool PERM = true;
    Op op;
    __device__ __forceinline__ void operator()(const f32x4 (&acc)[2][2][4][2], const Unit& u, int wr, int wc, int fr, int fq) const {
        const int row0 = u.pm * BM + wr * 64 + fr, col0 = u.pn * BM + wc * 32 + 8 * fq;
        if constexpr (Op::NLD == 0) {
#pragma unroll
            for (int ai = 0; ai < 2; ++ai)
#pragma unroll
                for (int m = 0; m < 4; ++m)
#pragma unroll
                    for (int bj = 0; bj < 2; ++bj) op(u.z, row0 + ai * HALF + m * 16, col0 + bj * HALF, acc[ai][bj][m][0], acc[ai][bj][m][1]);
        } else {
#pragma unroll
            for (int ai = 0; ai < 2; ++ai) {
                u32x4 tmp[4][2][Op::NLD];
#pragma unroll
                for (int m = 0; m < 4; ++m)
#pragma unroll
                    for (int bj = 0; bj < 2; ++bj) op.ld(u.z, row0 + ai * HALF + m * 16, col0 + bj * HALF, tmp[m][bj]);
#pragma unroll
                for (int m = 0; m < 4; ++m)
#pragma unroll
                    for (int bj = 0; bj < 2; ++bj) op.ap(u.z, row0 + ai * HALF + m * 16, col0 + bj * HALF, acc[ai][bj][m][0], acc[ai][bj][m][1], tmp[m][bj]);
            }
        }
    }
};

template <class Epi, class Sched, bool ALIGN_EPI, bool SPLIT = false>
__device__ __forceinline__ void gemm_phase(PG8_LAS unsigned char* lds, const Gemm g, const Sched& S, const Epi& E, int wid, int lane) {
    const int tid = wid * 64 + lane, wr = wid >> 2, wc = wid & 3, fr = lane & 15, fq = lane >> 4;
    const int K = g.K, nt = K / BK;
    unsigned voffA[2], voffB[2];
#pragma unroll
    for (int i = 0; i < 2; ++i) { int R, C; stage_rc(tid * 16 + i * 8192, R, C); const int Rb = Epi::PERM ? ((R & ~31) + perm32(R & 31)) : R;
        voffA[i] = (unsigned)(R * g.lda + C) * 2u; voffB[i] = (unsigned)(Rb * g.ldb + C) * 2u; }
    const size_t kstep = (size_t)(BK * 2);
    const size_t hstepA = (size_t)HALF * g.lda * 2, hstepB = (size_t)HALF * g.ldb * 2;
    const unsigned ldsw = (unsigned)wid * 1024u;
    const int aoff = lds_byte(wr * 64 + fr, fq * 8), boff = lds_byte(wc * 32 + fr, fq * 8);
#define PG8_SA(b, h) (((b) * 2 + (h)) * HTB)
#define PG8_SB(b, h) ((4 + (b) * 2 + (h)) * HTB)
#define PG8_STAGE(bufoff, gbase, voff) do { _Pragma("unroll") for (int _i = 0; _i < 2; ++_i) \
        __builtin_amdgcn_global_load_lds((const unsigned*)((const char*)(gbase) + (voff)[_i]), (PG8_LAS unsigned*)(lds + (bufoff) + ldsw + _i * 8192), 16, 0, 0); } while (0)
#define PG8_LDA(dst, b, h) do { _Pragma("unroll") for (int m = 0; m < 4; ++m) _Pragma("unroll") for (int k = 0; k < 2; ++k) dst[m][k] = *(const PG8_LAS bf16x8*)(lds + PG8_SA(b, h) + aoff + m * 2048 + k * 1024); } while (0)
#define PG8_LDB(dst, b, h) do { _Pragma("unroll") for (int n = 0; n < 2; ++n) _Pragma("unroll") for (int k = 0; k < 2; ++k) dst[n][k] = *(const PG8_LAS bf16x8*)(lds + PG8_SB(b, h) + boff + n * 2048 + k * 1024); } while (0)
#define PG8_MMA(ai, bj, At, Bt) do { __builtin_amdgcn_s_setprio(1); _Pragma("unroll") for (int m = 0; m < 4; ++m) _Pragma("unroll") for (int n = 0; n < 2; ++n) _Pragma("unroll") for (int k = 0; k < 2; ++k) \
        acc[ai][bj][m][n] = __builtin_amdgcn_mfma_f32_16x16x32_bf16(Bt[n][k], At[m][k], acc[ai][bj][m][n], 0, 0, 0); __builtin_amdgcn_s_setprio(0); } while (0)
#define PG8_WAIT_V(n) asm volatile("s_waitcnt vmcnt(" #n ")" ::: "memory")
#define PG8_WAIT_L(n) asm volatile("s_waitcnt lgkmcnt(" #n ")" ::: "memory")
#define PG8_BAR __builtin_amdgcn_s_barrier()
#define PG8_SCHED __builtin_amdgcn_sched_barrier(0)
    Unit cur, nxt; int ui = 0;
    if (!S.next(0, cur)) return;
    f32x4 acc[2][2][4][2];
#pragma unroll
    for (int a = 0; a < 2; ++a)
#pragma unroll
        for (int b = 0; b < 2; ++b)
#pragma unroll
            for (int m = 0; m < 4; ++m)
#pragma unroll
                for (int n = 0; n < 2; ++n) acc[a][b][m][n] = (f32x4){0.f, 0.f, 0.f, 0.f};
    bf16x8 At[4][2], B0[2][2], B1[2][2];
    const char* cA = cur.a; const char* cB = cur.b;
    const int nth = nt / 2;
    const char* cA2 = SPLIT ? cur.a2 - (size_t)nth * kstep : cA;
    PG8_STAGE(PG8_SB(0, 0), cB, voffB); PG8_STAGE(PG8_SB(0, 1), cB + hstepB, voffB); PG8_STAGE(PG8_SA(0, 0), cA, voffA); PG8_STAGE(PG8_SA(0, 1), cA + hstepA, voffA);
    if (wr == 1) PG8_BAR;
    PG8_WAIT_V(2); PG8_BAR;
    PG8_STAGE(PG8_SB(1, 0), cB + kstep, voffB); PG8_STAGE(PG8_SA(1, 0), cA + kstep, voffA); PG8_STAGE(PG8_SB(1, 1), cB + hstepB + kstep, voffB);
    PG8_WAIT_V(6); PG8_BAR;
    for (;;) {
        const bool has_next = S.next(ui + 1, nxt);
        const char* nA = has_next ? nxt.a : cA; const char* nB = has_next ? nxt.b : cB;
        const char* nA2 = SPLIT ? (has_next ? nxt.a2 - (size_t)nth * kstep : cA2) : nA;
#pragma unroll 1
        for (int half_ = 0; half_ < (SPLIT ? 2 : 1); ++half_) {
        if constexpr (SPLIT) { if (half_ == 1) { __builtin_amdgcn_sched_barrier(0); E.mid(acc, cur, wr, wc, fr, fq); __builtin_amdgcn_sched_barrier(0); } }
        const int t_lo = SPLIT ? half_ * nth : 0, t_hi = SPLIT ? (half_ + 1) * nth : nt;
#pragma unroll 1
        for (int t = t_lo; t < t_hi; t += 2) {
            const bool last = (t == nt - 2);
            const char* bA1 = (!SPLIT || t < nth) ? cA : cA2; const char* bA2 = (!SPLIT || t + 2 < nth) ? cA : cA2;
            const char* a1 = bA1 + (size_t)(t + 1) * kstep;
            const char* a2 = last ? nA : bA2 + (size_t)(t + 2) * kstep; const char* b2 = last ? nB : cB + (size_t)(t + 2) * kstep;
            const char* a3 = a2 + kstep; const char* b3 = b2 + kstep;
            PG8_LDB(B0, 0, 0); PG8_LDB(B1, 0, 1); PG8_SCHED; PG8_LDA(At, 0, 0); PG8_STAGE(PG8_SA(1, 1), a1 + hstepA, voffA);
            PG8_WAIT_V(8); PG8_WAIT_L(0); PG8_BAR; PG8_MMA(0, 0, At, B0); PG8_MMA(0, 1, At, B1); PG8_BAR; PG8_SCHED;
            PG8_LDA(At, 0, 1); PG8_STAGE(PG8_SB(0, 0), b2, voffB); PG8_STAGE(PG8_SB(0, 1), b2 + hstepB, voffB); PG8_STAGE(PG8_SA(0, 0), a2, voffA);
            PG8_WAIT_V(8); PG8_WAIT_L(0); PG8_BAR; PG8_MMA(1, 0, At, B0); PG8_MMA(1, 1, At, B1); PG8_BAR; PG8_SCHED;
            PG8_LDB(B0, 1, 0); PG8_LDB(B1, 1, 1); PG8_SCHED; PG8_LDA(At, 1, 0); PG8_STAGE(PG8_SA(0, 1), a2 + hstepA, voffA);
            PG8_WAIT_V(8); PG8_WAIT_L(0); PG8_BAR; PG8_MMA(0, 0, At, B0); PG8_MMA(0, 1, At, B1); PG8_BAR; PG8_SCHED;
            PG8_LDA(At, 1, 1); PG8_STAGE(PG8_SB(1, 0), b3, voffB); PG8_STAGE(PG8_SB(1, 1), b3 + hstepB, voffB); PG8_STAGE(PG8_SA(1, 0), a3, voffA);
            PG8_WAIT_V(8); PG8_WAIT_L(0); PG8_BAR; PG8_MMA(1, 0, At, B0); PG8_MMA(1, 1, At, B1); PG8_BAR; PG8_SCHED;
        }
        }
        if constexpr (ALIGN_EPI) { if (wr == 0) PG8_BAR; }
        E(acc, cur, wr, wc, fr, fq);
        if (!has_next) break;
#pragma unroll
        for (int a = 0; a < 2; ++a)
#pragma unroll
            for (int b = 0; b < 2; ++b)
#pragma unroll
                for (int m = 0; m < 4; ++m)
#pragma unroll
                    for (int n = 0; n < 2; ++n) acc[a][b][m][n] = (f32x4){0.f, 0.f, 0.f, 0.f};
        cur = nxt; cA = nA; cB = nB; cA2 = nA2; ++ui;
        if constexpr (ALIGN_EPI) { if (wr == 1) PG8_BAR; }
    }
    PG8_WAIT_V(0);
    if constexpr (!ALIGN_EPI) { if (wr == 0) PG8_BAR; }
    PG8_BAR;
#undef PG8_SA
#undef PG8_SB
#undef PG8_STAGE
#undef PG8_LDA
#undef PG8_LDB
#undef PG8_MMA
#undef PG8_WAIT_V
#undef PG8_WAIT_L
#undef PG8_BAR
#undef PG8_SCHED
}
}

__device__ __forceinline__ u32x4 pack8(f32x4 a, f32x4 b) { u32x4 w; w.x = pg8::cvt_pk_bf16(a.x, a.y); w.y = pg8::cvt_pk_bf16(a.z, a.w); w.z = pg8::cvt_pk_bf16(b.x, b.y); w.w = pg8::cvt_pk_bf16(b.z, b.w); return w; }
__device__ __forceinline__ void unpack8v(u32x4 w, f32x4& a, f32x4& b) { a.x = bflo(w.x); a.y = bfhi(w.x); a.z = bflo(w.y); a.w = bfhi(w.y); b.x = bflo(w.z); b.y = bfhi(w.z); b.z = bflo(w.w); b.w = bfhi(w.w); }
__device__ __forceinline__ f32x4 sigm4(f32x4 v) { f32x4 r; r.x = sigm(v.x); r.y = sigm(v.y); r.z = sigm(v.z); r.w = sigm(v.w); return r; }

struct OpProj { static constexpr int NLD = 0; unsigned char* ws;
    __device__ __forceinline__ void operator()(int z, int row, int col, f32x4 a, f32x4 b) const {
        bf16* p;
        if (col < 16384) p = (bf16*)(ws + WS_SLOT + (size_t)(col >> 11) * SLOT_BYTES) + (size_t)row * 2048 + (col & 2047);
        else if (col < 16640) p = (bf16*)(ws + WS_CKV) + (size_t)row * 256 + (col - 16384);
        else p = (bf16*)(ws + WS_IKW) + (size_t)row * 256 + (col - 16640);
        *(u32x4*)p = pack8(a, b);
    } };
struct OpProjCKV { static constexpr int NLD = 0; unsigned char* ws;
    __device__ __forceinline__ void operator()(int z, int row, int col, f32x4 a, f32x4 b) const {
        bf16* p;
        if (z == 0) { if (col < 16384) p = (bf16*)(ws + WS_SLOT + (size_t)(col >> 11) * SLOT_BYTES) + (size_t)row * 2048 + (col & 2047);
                      else if (col < 16640) p = (bf16*)(ws + WS_CKV) + (size_t)row * 256 + (col - 16384);
                      else p = (bf16*)(ws + WS_IKW) + (size_t)row * 256 + (col - 16640); }
        else p = (bf16*)(ws + (z == 1 ? WS_CK : WS_VT)) + (size_t)row * 2048 + col;
        *(u32x4*)p = pack8(a, b);
    } };
struct OpBf16 { static constexpr int NLD = 0; bf16* o; int ld;
    __device__ __forceinline__ void operator()(int z, int row, int col, f32x4 a, f32x4 b) const { *(u32x4*)(o + (size_t)row * ld + col) = pack8(a, b); } };
struct OpSplit2 { static constexpr int NLD = 0; bf16* o0; bf16* o1;
    __device__ __forceinline__ void operator()(int z, int row, int col, f32x4 a, f32x4 b) const { bf16* p = (col < 2048 ? o0 : o1) + (size_t)row * 2048 + (col & 2047); *(u32x4*)p = pack8(a, b); } };
struct OpF32 { static constexpr int NLD = 0; float* o; int ld;
    __device__ __forceinline__ void operator()(int z, int row, int col, f32x4 a, f32x4 b) const { float* p = o + (size_t)row * ld + col; *(f32x4*)p = a; *(f32x4*)(p + 4) = b; } };
struct OpYA { static constexpr int NLD = 1; bf16* ga;
    __device__ __forceinline__ void ld(int zi, int row, int col, u32x4* t) const { t[0] = *(const u32x4*)(ga + (size_t)row * 2048 + col); }
    __device__ __forceinline__ void ap(int zi, int row, int col, f32x4 a, f32x4 b, const u32x4* t) const { f32x4 g0, g1; unpack8v(t[0], g0, g1); *(u32x4*)(ga + (size_t)row * 2048 + col) = pack8(sigm4(g0) * a, sigm4(g1) * b); } };
struct OpYB { static constexpr int NLD = 2; bf16* ga; const bf16* gb;
    __device__ __forceinline__ void ld(int zi, int row, int col, u32x4* t) const { const size_t i = (size_t)row * 2048 + col; t[0] = *(const u32x4*)(ga + i); t[1] = *(const u32x4*)(gb + i); }
    __device__ __forceinline__ void ap(int zi, int row, int col, f32x4 a, f32x4 b, const u32x4* t) const { f32x4 m0, m1, g0, g1; unpack8v(t[0], m0, m1); unpack8v(t[1], g0, g1);
        *(u32x4*)(ga + (size_t)row * 2048 + col) = pack8(m0 + sigm4(g0) * a, m1 + sigm4(g1) * b); } };
struct OpMix { static constexpr int NLD = 2; const float* x; float* zo;
    __device__ __forceinline__ void ld(int zi, int row, int col, u32x4* t) const { const size_t i = (size_t)row * 2048 + col; t[0] = *(const u32x4*)(x + i); t[1] = *(const u32x4*)(x + i + 4); }
    __device__ __forceinline__ void ap(int zi, int row, int col, f32x4 a, f32x4 b, const u32x4* t) const { const size_t i = (size_t)row * 2048 + col;
        *(f32x4*)(zo + i) = ALPHA * __builtin_bit_cast(f32x4, t[0]) + a; *(f32x4*)(zo + i + 4) = ALPHA * __builtin_bit_cast(f32x4, t[1]) + b; } };
struct OpRes { static constexpr int NLD = 2; float* zo;
    __device__ __forceinline__ void ld(int zi, int row, int col, u32x4* t) const { const size_t i = (size_t)row * 2048 + col; t[0] = *(const u32x4*)(zo + i); t[1] = *(const u32x4*)(zo + i + 4); }
    __device__ __forceinline__ void ap(int zi, int row, int col, f32x4 a, f32x4 b, const u32x4* t) const { const size_t i = (size_t)row * 2048 + col;
        *(f32x4*)(zo + i) = ALPHA * __builtin_bit_cast(f32x4, t[0]) + a; *(f32x4*)(zo + i + 4) = ALPHA * __builtin_bit_cast(f32x4, t[1]) + b; } };

__device__ __forceinline__ void row_stats_add(float* st, int row, float s1, float s2, int fq) {
    s1 += __shfl_xor(s1, 16); s1 += __shfl_xor(s1, 32); s2 += __shfl_xor(s2, 16); s2 += __shfl_xor(s2, 32);
    if (fq == 0) { atomicAdd(st + 2 * (size_t)row, s1); atomicAdd(st + 2 * (size_t)row + 1, s2); }
}
__device__ __forceinline__ void row_mu_rstd(const float* st, int row, float& mu, float& rstd) {
    const f32x2v p = *(const f32x2v*)(st + 2 * (size_t)row); mu = p.x * (1.0f / 2048.0f); rstd = rsqrtf(fmaxf(p.y * (1.0f / 2048.0f) - mu * mu, 0.f) + 1e-5f);
}
__device__ __forceinline__ float sum8(f32x4 a, f32x4 b) { return ((a.x + a.y) + (a.z + a.w)) + ((b.x + b.y) + (b.z + b.w)); }
__device__ __forceinline__ float sq8(f32x4 a, f32x4 b) { return ((a.x * a.x + a.y * a.y) + (a.z * a.z + a.w * a.w)) + ((b.x * b.x + b.y * b.y) + (b.z * b.z + b.w * b.w)); }
struct EpiMixStats { static constexpr bool PERM = true; const float* x; bf16* zb; float* st;
    __device__ __forceinline__ void operator()(const f32x4 (&acc)[2][2][4][2], const pg8::Unit& u, int wr, int wc, int fr, int fq) const {
        const int row0 = u.pm * 256 + wr * 64 + fr, col0 = u.pn * 256 + wc * 32 + 8 * fq;
#pragma unroll
        for (int ai = 0; ai < 2; ++ai) {
            f32x4 xv[4][2][2];
#pragma unroll
            for (int m = 0; m < 4; ++m)
#pragma unroll
                for (int bj = 0; bj < 2; ++bj) { const float* p = x + (size_t)(row0 + ai * 128 + m * 16) * 2048 + col0 + bj * 128; xv[m][bj][0] = *(const f32x4*)p; xv[m][bj][1] = *(const f32x4*)(p + 4); }
#pragma unroll
            for (int m = 0; m < 4; ++m) { const int row = row0 + ai * 128 + m * 16; float s1 = 0.f, s2 = 0.f;
#pragma unroll
                for (int bj = 0; bj < 2; ++bj) { const f32x4 z0 = ALPHA * xv[m][bj][0] + acc[ai][bj][m][0], z1 = ALPHA * xv[m][bj][1] + acc[ai][bj][m][1];
                    *(u32x4*)(zb + (size_t)row * 2048 + col0 + bj * 128) = pack8(z0, z1); s1 += sum8(z0, z1); s2 += sq8(z0, z1); }
                row_stats_add(st, row, s1, s2, fq); }
        }
    }
};
struct EpiCOStats { static constexpr bool PERM = true; bf16* zb; const float* st1; float* st2; const float* g; const float* bta;
    __device__ __forceinline__ void operator()(const f32x4 (&acc)[2][2][4][2], const pg8::Unit& u, int wr, int wc, int fr, int fq) const {
        const int row0 = u.pm * 256 + wr * 64 + fr, col0 = u.pn * 256 + wc * 32 + 8 * fq;
        f32x4 gv[2][2], bv[2][2];
#pragma unroll
        for (int bj = 0; bj < 2; ++bj) { gv[bj][0] = *(const f32x4*)(g + col0 + bj * 128); gv[bj][1] = *(const f32x4*)(g + col0 + bj * 128 + 4); bv[bj][0] = *(const f32x4*)(bta + col0 + bj * 128); bv[bj][1] = *(const f32x4*)(bta + col0 + bj * 128 + 4); }
#pragma unroll
        for (int ai = 0; ai < 2; ++ai) {
            u32x4 zv[4][2]; float mu[4], rs[4];
#pragma unroll
            for (int m = 0; m < 4; ++m) { const int row = row0 + ai * 128 + m * 16; row_mu_rstd(st1, row, mu[m], rs[m]);
#pragma unroll
                for (int bj = 0; bj < 2; ++bj) zv[m][bj] = *(const u32x4*)(zb + (size_t)row * 2048 + col0 + bj * 128); }
#pragma unroll
            for (int m = 0; m < 4; ++m) { const int row = row0 + ai * 128 + m * 16; float s1 = 0.f, s2 = 0.f;
#pragma unroll
                for (int bj = 0; bj < 2; ++bj) { f32x4 a0, a1; unpack8v(zv[m][bj], a0, a1);
                    const f32x4 z0 = ALPHA * ((a0 - mu[m]) * rs[m] * gv[bj][0] + bv[bj][0]) + acc[ai][bj][m][0], z1 = ALPHA * ((a1 - mu[m]) * rs[m] * gv[bj][1] + bv[bj][1]) + acc[ai][bj][m][1];
                    *(u32x4*)(zb + (size_t)row * 2048 + col0 + bj * 128) = pack8(z0, z1); s1 += sum8(z0, z1); s2 += sq8(z0, z1); }
                row_stats_add(st2, row, s1, s2, fq); }
        }
    }
};
struct EpiYAB { static constexpr bool PERM = true; bf16* ga; const bf16* gb;
    __device__ __forceinline__ void mid(f32x4 (&acc)[2][2][4][2], const pg8::Unit& u, int wr, int wc, int fr, int fq) const {
        int lofs = (wr * 64 + fr) * 2048 + wc * 32 + 8 * fq; asm volatile("" : "+v"(lofs));
        const size_t ub = ((size_t)u.pm * 256) * 2048 + u.pn * 256;
#pragma unroll
        for (int ai = 0; ai < 2; ++ai)
#pragma unroll
            for (int m = 0; m < 4; ++m) { u32x4 av[2], bv[2];
#pragma unroll
                for (int bj = 0; bj < 2; ++bj) { const size_t i = ub + (size_t)(lofs + (ai * 128 + m * 16) * 2048 + bj * 128); av[bj] = *(const u32x4*)(ga + i); bv[bj] = *(const u32x4*)(gb + i); }
#pragma unroll
                for (int bj = 0; bj < 2; ++bj) { f32x4 a0, a1, b0, b1; unpack8v(av[bj], a0, a1); unpack8v(bv[bj], b0, b1);
#pragma unroll
                    for (int e = 0; e < 4; ++e) { acc[ai][bj][m][0][e] *= (1.0f + __expf(-b0[e])) * __builtin_amdgcn_rcpf(1.0f + __expf(-a0[e])); acc[ai][bj][m][1][e] *= (1.0f + __expf(-b1[e])) * __builtin_amdgcn_rcpf(1.0f + __expf(-a1[e])); } } }
    }
    __device__ __forceinline__ void operator()(const f32x4 (&acc)[2][2][4][2], const pg8::Unit& u, int wr, int wc, int fr, int fq) const {
        int lofs = (wr * 64 + fr) * 2048 + wc * 32 + 8 * fq; asm volatile("" : "+v"(lofs));
        const size_t ub = ((size_t)u.pm * 256) * 2048 + u.pn * 256;
#pragma unroll
        for (int ai = 0; ai < 2; ++ai) { u32x4 bv[4][2];
#pragma unroll
            for (int m = 0; m < 4; ++m)
#pragma unroll
                for (int bj = 0; bj < 2; ++bj) bv[m][bj] = *(const u32x4*)(gb + ub + (size_t)(lofs + (ai * 128 + m * 16) * 2048 + bj * 128));
#pragma unroll
            for (int m = 0; m < 4; ++m)
#pragma unroll
                for (int bj = 0; bj < 2; ++bj) { f32x4 b0, b1; unpack8v(bv[m][bj], b0, b1); f32x4 s0, s1;
#pragma unroll
                    for (int e = 0; e < 4; ++e) { s0[e] = __builtin_amdgcn_rcpf(1.0f + __expf(-b0[e])); s1[e] = __builtin_amdgcn_rcpf(1.0f + __expf(-b1[e])); }
                    *(u32x4*)(ga + ub + (size_t)(lofs + (ai * 128 + m * 16) * 2048 + bj * 128)) = pack8(acc[ai][bj][m][0] * s0, acc[ai][bj][m][1] * s1); } }
    }
};
__device__ __forceinline__ void ln_fold8(const float* st, const float* c1, const float* c0, int row, int col, f32x4& a, f32x4& b) {
    float mu, rs; row_mu_rstd(st, row, mu, rs);
    const f32x4 p0 = *(const f32x4*)(c1 + col), p1 = *(const f32x4*)(c1 + col + 4), q0 = *(const f32x4*)(c0 + col), q1 = *(const f32x4*)(c0 + col + 4);
    a = (a - mu * p0) * rs + q0; b = (b - mu * p1) * rs + q1;
}
struct OpPQFold { static constexpr int NLD = 0; float* o; const float* st; const float* c1; const float* c0;
    __device__ __forceinline__ void operator()(int zi, int row, int col, f32x4 a, f32x4 b) const { ln_fold8(st, c1, c0, row, col, a, b); float* p = o + (size_t)row * 2048 + col; *(f32x4*)p = a; *(f32x4*)(p + 4) = b; } };

template <class Op>
__device__ __forceinline__ void gemm(const Frame& F, const bf16* A, int lda, const bf16* Bt, int ldb, int M, int N, int K, const Op& op) {
    pg8::Gemm g{lda, ldb, K}; pg8::MultiOrder<1> S; S.s[0] = pg8::Sub{A, Bt, M / 256, N / 256}; S.lda = lda; S.ldb = ldb; S.G = F.G; S.c = F.bid;
    pg8::Epi8<Op> E{op};
    pg8::gemm_phase<pg8::Epi8<Op>, pg8::MultiOrder<1>, true>((PG8_LAS unsigned char*)F.lds, g, S, E, F.wave, F.lane());
}
template <class Epi>
__device__ __forceinline__ void gemm_epi(const Frame& F, const bf16* A, int lda, const bf16* Bt, int ldb, int M, int N, int K, const Epi& E) {
    pg8::Gemm g{lda, ldb, K}; pg8::MultiOrder<1> S; S.s[0] = pg8::Sub{A, Bt, M / 256, N / 256}; S.lda = lda; S.ldb = ldb; S.G = F.G; S.c = F.bid;
    pg8::gemm_phase<Epi, pg8::MultiOrder<1>, true>((PG8_LAS unsigned char*)F.lds, g, S, E, F.wave, F.lane());
}
template <int NS, class Op>
__device__ __forceinline__ void gemm_multi(const Frame& F, const pg8::MultiOrder<NS>& S, int K, const Op& op) {
    pg8::Gemm g{S.lda, S.ldb, K}; pg8::Epi8<Op> E{op};
    pg8::gemm_phase<pg8::Epi8<Op>, pg8::MultiOrder<NS>, true>((PG8_LAS unsigned char*)F.lds, g, S, E, F.wave, F.lane());
}
template <class Off, class Op>
__device__ __forceinline__ void gemm_batch(const Frame& F, const pg8::BatchOrder<Off>& S, int K, const Op& op) {
    pg8::Gemm g{S.lda, S.ldb, K}; pg8::Epi8<Op> E{op};
    pg8::gemm_phase<pg8::Epi8<Op>, pg8::BatchOrder<Off>, true>((PG8_LAS unsigned char*)F.lds, g, S, E, F.wave, F.lane());
}
struct OffS { __device__ __forceinline__ size_t a(int z) const { return (size_t)(z >> 2) * 2048 * 2048 + (z & 3) * 512; } __device__ __forceinline__ size_t b(int z) const { return (size_t)(z >> 2) * 256 * 2048 + (z & 3) * 512; } };
struct OffPV { __device__ __forceinline__ size_t a(int z) const { return (size_t)(z >> 2) * 2048 * 1024 + (z & 3) * 256; } __device__ __forceinline__ size_t b(int z) const { return (size_t)(z & 3) * 512 * 2048 + (z >> 2) * 256; } };
struct OpLogit { static constexpr int NLD = 0; float* lg;
    __device__ __forceinline__ void operator()(int z, int row, int col, f32x4 a, f32x4 b) const { float* p = lg + ((size_t)(z >> 2) * 2048 + row) * 1024 + (z & 3) * 256 + col; *(f32x4*)p = a * 0.04419417382415922f; *(f32x4*)(p + 4) = b * 0.04419417382415922f; } };
struct OpCO { static constexpr int NLD = 0; bf16* co;
    __device__ __forceinline__ void operator()(int z, int row, int col, f32x4 a, f32x4 b) const { *(u32x4*)(co + ((size_t)(z >> 2) * 2048 + row) * 2048 + (z & 3) * 512 + col) = pack8(a, b); } };
struct OpCQKV { static constexpr int NLD = 0; bf16* cq; bf16* ck; bf16* vt; const float* st; const float* c1; const float* c0;
    __device__ __forceinline__ void operator()(int z, int row, int col, f32x4 a, f32x4 b) const { if (z == 0) ln_fold8(st, c1, c0, row, col, a, b);
        bf16* o = z == 0 ? cq : (z == 1 ? ck : vt); *(u32x4*)(o + (size_t)row * 2048 + col) = pack8(a, b); } };
__device__ __forceinline__ void ph_xsoftmax(const Frame& F, const float* lg, bf16* P) {
    const int gw = F.bid * 8 + F.wave, NGW = F.G * 8, lane = F.lane();
    for (int u = gw; u < T * 4; u += NGW) {
        const f32x4 v = *(const f32x4*)(lg + (size_t)u * 256 + 4 * lane);
        const float m = wave_max(fmaxf(fmaxf(v.x, v.y), fmaxf(v.z, v.w)));
        const float e0 = expf(v.x - m), e1 = expf(v.y - m), e2 = expf(v.z - m), e3 = expf(v.w - m);
        const float inv = 1.0f / wave_sum((e0 + e1) + (e2 + e3));
        u32x2 w; w.x = pk2(e0 * inv, e1 * inv); w.y = pk2(e2 * inv, e3 * inv);
        *(u32x2*)(P + (size_t)u * 256 + 4 * lane) = w;
    }
}

template <class CM>
__device__ __forceinline__ void transpose_item(const float* W, size_t ldw, bf16* WT, size_t ldwt, int row_off, int nblk, int item, float* scr, int lane, const CM& cm) {
    const int kb = item / nblk, nb = item % nblk, k0 = 64 * kb, n0 = 32 * nb;
    const int c = cm(n0 + (lane & 31));
#pragma unroll 8
    for (int i = 0; i < 32; ++i) { const int kk = 2 * i + (lane >> 5); scr[kk * 33 + (lane & 31)] = (c >= 0) ? W[(size_t)(k0 + kk) * ldw + c] : 0.f; }
    WAVE_SYNC();
    const int c8 = lane & 7;
#pragma unroll
    for (int j = 0; j < 4; ++j) { const int n = (lane >> 3) + 8 * j; const float* s = scr + (8 * c8) * 33 + n;
        u32x4 o; o.x = pk2(s[0 * 33], s[1 * 33]); o.y = pk2(s[2 * 33], s[3 * 33]); o.z = pk2(s[4 * 33], s[5 * 33]); o.w = pk2(s[6 * 33], s[7 * 33]);
        *(u32x4*)(WT + (size_t)(row_off + n0 + n) * ldwt + k0 + 8 * c8) = o; }
    WAVE_SYNC();
}
__device__ __forceinline__ void transpose_item_ln(const float* W, bf16* WT, int item, float* scr, int lane, const float* g, const float* bta, float* c1, float* c0) {
    const int kb = item / 64, nb = item % 64, k0 = 64 * kb, n0 = 32 * nb;
#pragma unroll 8
    for (int i = 0; i < 32; ++i) { const int kk = 2 * i + (lane >> 5); scr[kk * 33 + (lane & 31)] = W[(size_t)(k0 + kk) * 2048 + n0 + (lane & 31)]; }
    WAVE_SYNC();
    const int c8 = lane & 7;
    float gk[8], bk[8];
#pragma unroll
    for (int i = 0; i < 8; ++i) { gk[i] = g[k0 + 8 * c8 + i]; bk[i] = bta[k0 + 8 * c8 + i]; }
#pragma unroll
    for (int j = 0; j < 4; ++j) { const int n = (lane >> 3) + 8 * j; const float* sp = scr + (8 * c8) * 33 + n;
        float wv[8]; float p1 = 0.f, p0 = 0.f;
#pragma unroll
        for (int i = 0; i < 8; ++i) { const float v = sp[i * 33]; wv[i] = v * gk[i]; p1 += wv[i]; p0 += v * bk[i]; }
        u32x4 o; o.x = pk2(wv[0], wv[1]); o.y = pk2(wv[2], wv[3]); o.z = pk2(wv[4], wv[5]); o.w = pk2(wv[6], wv[7]);
        *(u32x4*)(WT + (size_t)(n0 + n) * 2048 + k0 + 8 * c8) = o;
        p1 += __shfl_xor(p1, 1); p1 += __shfl_xor(p1, 2); p1 += __shfl_xor(p1, 4); p0 += __shfl_xor(p0, 1); p0 += __shfl_xor(p0, 2); p0 += __shfl_xor(p0, 4);
        if (c8 == 0) { atomicAdd(c1 + n0 + n, p1); atomicAdd(c0 + n0 + n, p0); } }
    WAVE_SYNC();
}
template <class CM>
__device__ __forceinline__ void transpose_item64(const float* W, size_t ldw, bf16* WT, size_t ldwt, int row_off, int nblk, int item, float* scr, int lane, const CM& cm) {
    const int kb = item / nblk, nb = item % nblk, k0 = 64 * kb, n0 = 64 * nb, r = lane >> 4, c4 = lane & 15;
    const int c = cm(n0 + 4 * c4);
    f32x4 v[16];
#pragma unroll
    for (int i = 0; i < 16; ++i) v[i] = (c >= 0) ? *(const f32x4*)(W + (size_t)(k0 + 4 * i + r) * ldw + c) : (f32x4){0.f, 0.f, 0.f, 0.f};
#pragma unroll
    for (int i = 0; i < 16; ++i) *(f32x4*)(scr + (4 * i + r) * 68 + 4 * c4) = v[i];
    WAVE_SYNC();
    bf16* orow = WT + (size_t)(row_off + n0 + lane) * ldwt + k0;
#pragma unroll
    for (int j = 0; j < 8; ++j) { const float* sp = scr + (8 * j) * 68 + lane;
        u32x4 o; o.x = pk2(sp[0], sp[68]); o.y = pk2(sp[2 * 68], sp[3 * 68]); o.z = pk2(sp[4 * 68], sp[5 * 68]); o.w = pk2(sp[6 * 68], sp[7 * 68]);
        *(u32x4*)(orow + 8 * j) = o; }
    WAVE_SYNC();
}
struct CmIdent { __device__ __forceinline__ int operator()(int n) const { return n; } };
struct CmWin { __device__ __forceinline__ int operator()(int n) const {
    if (n < 10240) return n;
    if (n < 12288) return 10496 + (n - 10240);
    if (n < 14336) return 12688 + (n - 12288);
    if (n < 16384) return 14736 + (n - 14336);
    if (n < 16640) return 10240 + (n - 16384);
    if (n < 16768) return 12544 + (n - 16640);
    if (n < 16784) return 12672 + (n - 16768);
    return -1; } };

__device__ __forceinline__ void cvt_bf16_stream(const Frame& F, const float* src, bf16* dst, size_t n8) {
    const size_t gt = (size_t)F.bid * 512 + F.wave * 64 + F.lane(), NT = (size_t)F.G * 512;
#pragma unroll 4
    for (size_t i = gt; i < n8; i += NT) { const f32x4 a = ((const f32x4*)src)[2 * i], b = ((const f32x4*)src)[2 * i + 1];
        u32x4 o; o.x = pk2(a.x, a.y); o.y = pk2(a.z, a.w); o.z = pk2(b.x, b.y); o.w = pk2(b.z, b.w); ((u32x4*)dst)[i] = o; }
}

__device__ __forceinline__ void ph0_prologue(const Frame& F) {
    const Args& a = *F.a;
    cvt_bf16_stream(F, a.in[0], (bf16*)a.out, (size_t)T * D / 8);
    cvt_bf16_stream(F, a.in[1], (bf16*)(F.ws + WS_MEMB), (size_t)2048 * 2048 / 8);
    float* scr = (float*)(F.lds + F.wave * 17408);
    const int gw = F.bid * 8 + F.wave, NGW = F.G * 8, lane = F.lane();
    {
        const int nblk = NCOLS / 64, nitems = (2048 / 64) * nblk;
        float* scr64 = (float*)(F.lds + F.wave * 17408);
        for (int it = gw; it < nitems; it += NGW) transpose_item64(a.in[2], 16784, (bf16*)(F.ws + WS_WIN), 2048, 0, nblk, it, scr64, lane, CmWin());
    }
    {
        for (int it = gw; it < 32 * 16; it += NGW) { const int mat = it >> 4, which = mat >> 4, h = mat & 15;
            transpose_item(a.in[which ? 9 : 8] + (size_t)h * 256 * 128, 128, (bf16*)(F.ws + WS_WKV), 256, which * 2048 + h * 128, 4, it & 15, scr, lane, CmIdent()); }
    }
    {
        bf16* W8p = (bf16*)((unsigned char*)a.out + (size_t)64 * MiB);
        for (int it = gw; it < 2 * 1024; it += NGW) { const int m = 4 + (it >> 10);
            transpose_item64(m == 4 ? a.in[17] : a.in[18], 2048, W8p + (size_t)m * 2048 * 2048, 2048, 0, 32, it & 1023, scr, lane, CmIdent()); }
    }
    {
        const int gt = F.bid * 512 + F.wave * 64 + lane;
        if (gt < 2048) { const float l0 = a.in[3][gt], l1 = a.in[3][2048 + gt]; ((float*)(F.ws + WS_LB))[gt] = 1.0f / (1.0f + expf(l1 - l0)); }
    }
}

namespace hg {
constexpr int QP = 272, TP = 144, AP = 144;
constexpr int OFF_QD = 0, OFF_KD = OFF_QD + 64 * QP, OFF_QG = OFF_KD + 64 * QP, OFF_KET = OFF_QG + 64 * QP, OFF_VT = OFF_KET + 128 * TP, OFF_A = OFF_VT + 128 * TP,
              OFF_TOT = OFF_A + 64 * AP, OFF_DEC = OFF_TOT + 4 * 128 * 4, OFF_PART = OFF_DEC + 128 * 4, OFF_RSTD = OFF_PART + 8 * 64 * 4, END = OFF_RSTD + 64 * 4;
static_assert(END <= 131072, "hgrn LDS map");
}
typedef short bf16x4 __attribute__((ext_vector_type(4)));
#define HSEC_B() do { if (PROBE_SEC) hs_t0 = rt_now(); } while (0)
#define HSEC_E(n) do { if (PROBE_SEC == (n)) sacc += rt_now() - hs_t0; } while (0)
__device__ __forceinline__ void hgrn_chunked(const Frame& F, int unit, unsigned long long& sacc) {
    unsigned long long hs_t0 = 0ull;
    using namespace hg;
    const Args& a = *F.a;
    const int b = unit >> 4, h = unit & 15, lane = F.lane(), w = F.wave, tid = w * 64 + lane, c = tid & 127, rq = tid >> 7, l15 = lane & 15, q4 = lane >> 4;
    unsigned char* L = F.lds;
    const size_t base = (size_t)b * 2048 * 2048 + h * 128;
    const bf16* HQ = F.slot(0) + base; const bf16* HF = F.slot(1) + base; const bf16* HI = F.slot(2) + base; const bf16* HG = F.slot(3) + base; bf16* HO = F.slot(0) + base;
    const float lb = ((const float*)(F.ws + WS_LB))[h * 128 + c];
    const float ng = a.in[4][h * 128 + 16 * w + l15];
    f32x4 S[8];
#pragma unroll
    for (int d = 0; d < 8; ++d) S[d] = (f32x4){0.f, 0.f, 0.f, 0.f};
    unsigned short rq_[16], rf_[16], rv_[16];
#pragma unroll
    for (int k = 0; k < 16; ++k) { const size_t o = (size_t)(16 * rq + k) * 2048 + c; rq_[k] = HQ[o]; rf_[k] = HF[o]; rv_[k] = HI[o]; }
    float* tot = (float*)(L + OFF_TOT); float* dec = (float*)(L + OFF_DEC); float* part = (float*)(L + OFF_PART); float* rstd = (float*)(L + OFF_RSTD);
#pragma unroll 1
    for (int ch = 0; ch < 32; ++ch) {
        const int r0 = ch * 64;
        HSEC_B();
        unsigned short gq[16];
#pragma unroll
        for (int mt = 0; mt < 4; ++mt)
#pragma unroll
            for (int r = 0; r < 4; ++r) gq[4 * mt + r] = HG[(size_t)(r0 + 16 * mt + 4 * q4 + r) * 2048 + 16 * w + l15];
        unsigned short rv2_[16];
        if (ch + 1 < 32) {
#pragma unroll
            for (int k = 0; k < 16; ++k) rv2_[k] = HI[(size_t)(r0 + 64 + 16 * rq + k) * 2048 + c]; }
        float G[16], qf[16], kk[16];
        { float run = 0.f;
#pragma unroll
          for (int k = 0; k < 16; ++k) { const float f = lb + (1.0f - lb) * __builtin_amdgcn_rcpf(1.0f + __expf(-bf2f(rf_[k]))); run += __logf(f); G[k] = run; kk[k] = 1.0f - f; qf[k] = bf2f(rq_[k]); } }
        tot[rq * 128 + c] = G[15];
        if (ch + 1 < 32) {
#pragma unroll
            for (int k = 0; k < 16; ++k) { const size_t o = (size_t)(r0 + 64 + 16 * rq + k) * 2048 + c; rq_[k] = HQ[o]; rf_[k] = HF[o]; } }
        HSEC_E(1); HSEC_B();
        __syncthreads();
        HSEC_E(2); HSEC_B();
        const float t0 = tot[c], t1 = tot[128 + c], t2 = tot[256 + c], t3 = tot[384 + c];
        const float offs = (rq > 0 ? t0 : 0.f) + (rq > 1 ? t1 : 0.f) + (rq > 2 ? t2 : 0.f);
        const float Gref = t0 + t1, Glast = Gref + t2 + t3, eref = __expf(Gref), elr = __expf(Glast - Gref);
        if (rq == 0) dec[c] = __expf(Glast);
        unsigned kew[8], vw[8];
#pragma unroll
        for (int k = 0; k < 16; ++k) {
            const float e1 = __expf(G[k] + offs - Gref), qd = qf[k] * e1, kd = kk[k] * __builtin_amdgcn_rcpf(e1);
            const int row = 16 * rq + k;
            *(bf16*)(L + OFF_QD + row * QP + 2 * c) = (bf16)f2bf(qd);
            *(bf16*)(L + OFF_KD + row * QP + 2 * c) = (bf16)f2bf(kd);
            *(bf16*)(L + OFF_QG + row * QP + 2 * c) = (bf16)f2bf(qd * eref);
            const unsigned ke = f2bf(kd * elr);
            if (k & 1) { kew[k >> 1] |= ke << 16; vw[k >> 1] |= (unsigned)rv_[k] << 16; } else { kew[k >> 1] = ke; vw[k >> 1] = rv_[k]; }
        }
        *(u32x4*)(L + OFF_KET + c * TP + 32 * rq) = (u32x4){kew[0], kew[1], kew[2], kew[3]}; *(u32x4*)(L + OFF_KET + c * TP + 32 * rq + 16) = (u32x4){kew[4], kew[5], kew[6], kew[7]};
        *(u32x4*)(L + OFF_VT + c * TP + 32 * rq) = (u32x4){vw[0], vw[1], vw[2], vw[3]}; *(u32x4*)(L + OFF_VT + c * TP + 32 * rq + 16) = (u32x4){vw[4], vw[5], vw[6], vw[7]};
        if (ch + 1 < 32) {
#pragma unroll
            for (int k = 0; k < 16; ++k) rv_[k] = rv2_[k]; }
        HSEC_E(3); HSEC_B();
        __syncthreads();
        HSEC_E(4); HSEC_B();
        { const int mi = w >> 1;
#pragma unroll
          for (int tt = 0; tt < 2; ++tt) { const int nj = 2 * (w & 1) + tt; f32x4 acc = (f32x4){0.f, 0.f, 0.f, 0.f};
              if (nj <= mi) {
#pragma unroll
                  for (int ks = 0; ks < 4; ++ks) { const bf16x8 aF = *(const bf16x8*)(L + OFF_KD + (16 * nj + l15) * QP + 64 * ks + 16 * q4), bF = *(const bf16x8*)(L + OFF_QD + (16 * mi + l15) * QP + 64 * ks + 16 * q4);
                      acc = __builtin_amdgcn_mfma_f32_16x16x32_bf16(aF, bF, acc, 0, 0, 0); } }
              const int i = 16 * mi + l15, j0 = 16 * nj + 4 * q4;
              const float v0 = (j0 <= i) ? acc.x : 0.f, v1 = (j0 + 1 <= i) ? acc.y : 0.f, v2 = (j0 + 2 <= i) ? acc.z : 0.f, v3 = (j0 + 3 <= i) ? acc.w : 0.f;
              *(u32x2*)(L + OFF_A + i * AP + 2 * j0) = (u32x2){pk2(v0, v1), pk2(v2, v3)}; } }
        __syncthreads();
        HSEC_E(5); HSEC_B();
        bf16x8 bV[2];
#pragma unroll
        for (int ks = 0; ks < 2; ++ks) bV[ks] = *(const bf16x8*)(L + OFF_VT + (16 * w + l15) * TP + 64 * ks + 16 * q4);
        f32x4 O[4];
#pragma unroll
        for (int mt = 0; mt < 4; ++mt) { O[mt] = (f32x4){0.f, 0.f, 0.f, 0.f};
#pragma unroll
            for (int ks = 0; ks < 2; ++ks) { const bf16x8 aF = *(const bf16x8*)(L + OFF_A + (16 * mt + l15) * AP + 64 * ks + 16 * q4); O[mt] = __builtin_amdgcn_mfma_f32_16x16x32_bf16(aF, bV[ks], O[mt], 0, 0, 0); } }
#pragma unroll
        for (int kq = 0; kq < 4; ++kq) {
            u32x4 sw; sw.x = pk2(S[2 * kq].x, S[2 * kq].y); sw.y = pk2(S[2 * kq].z, S[2 * kq].w); sw.z = pk2(S[2 * kq + 1].x, S[2 * kq + 1].y); sw.w = pk2(S[2 * kq + 1].z, S[2 * kq + 1].w);
            const bf16x8 bS = __builtin_bit_cast(bf16x8, sw);
#pragma unroll
            for (int mt = 0; mt < 4; ++mt) { const unsigned char* qp = L + OFF_QG + (16 * mt + l15) * QP + 64 * kq + 8 * q4;
                const u32x2 lo = *(const u32x2*)qp, hi = *(const u32x2*)(qp + 32);
                const bf16x8 aF = __builtin_bit_cast(bf16x8, (u32x4){lo.x, lo.y, hi.x, hi.y});
                O[mt] = __builtin_amdgcn_mfma_f32_16x16x32_bf16(aF, bS, O[mt], 0, 0, 0); } }
#pragma unroll
        for (int dt = 0; dt < 8; ++dt) { const f32x4 dc = *(const f32x4*)(dec + 16 * dt + 4 * q4); S[dt] = S[dt] * dc;
#pragma unroll
            for (int ks = 0; ks < 2; ++ks) { const bf16x8 aF = *(const bf16x8*)(L + OFF_KET + (16 * dt + l15) * TP + 64 * ks + 16 * q4); S[dt] = __builtin_amdgcn_mfma_f32_16x16x32_bf16(aF, bV[ks], S[dt], 0, 0, 0); } }
        HSEC_E(6); HSEC_B();
#pragma unroll
        for (int mt = 0; mt < 4; ++mt)
#pragma unroll
            for (int r = 0; r < 4; ++r) { const float p = row16_sum(O[mt][r] * O[mt][r]);
                if (l15 == 0) part[w * 64 + 16 * mt + 4 * q4 + r] = p; }
        __syncthreads();
        if (tid < 64) { float s = 0.f;
#pragma unroll
            for (int ww = 0; ww < 8; ++ww) s += part[ww * 64 + tid];
            rstd[tid] = rsqrtf(s * (1.0f / 128.0f) + 1e-6f); }
        __syncthreads();
        HSEC_E(7); HSEC_B();
#pragma unroll
        for (int mt = 0; mt < 4; ++mt) { const f32x4 rs = *(const f32x4*)(rstd + 16 * mt + 4 * q4);
#pragma unroll
            for (int r = 0; r < 4; ++r) { const float g = bf2f(gq[4 * mt + r]); const float o = O[mt][r] * rs[r] * ng * (g * __builtin_amdgcn_rcpf(1.0f + __expf(-g)));
                HO[(size_t)(r0 + 16 * mt + 4 * q4 + r) * 2048 + 16 * w + l15] = (bf16)f2bf(o); } }
        HSEC_E(8);
    }
    __syncthreads();
}

__device__ __forceinline__ void ph2_side(const Frame& F, int sid, int nside) {
    const Args& a = *F.a;
    const int gw = sid * 8 + F.wave, NGW = nside * 8, lane = F.lane();
    bf16* CKV = (bf16*)(F.ws + WS_CKV); bf16* IKW = (bf16*)(F.ws + WS_IKW);
    for (int row = gw; row < T; row += NGW) {
        {   u32x2 w = *(u32x2*)(CKV + (size_t)row * 256 + 4 * lane);
            float x0 = bflo(w.x), x1 = bfhi(w.x), x2 = bflo(w.y), x3 = bfhi(w.y);
            const float ss = wave_sum(x0 * x0 + x1 * x1 + x2 * x2 + x3 * x3);
            const float r = rsqrtf(ss * (1.0f / 256.0f) + 1e-6f);
            const f32x4 g = *(const f32x4*)(a.in[5] + 4 * lane);
            w.x = pk2(x0 * r * g.x, x1 * r * g.y); w.y = pk2(x2 * r * g.z, x3 * r * g.w);
            *(u32x2*)(CKV + (size_t)row * 256 + 4 * lane) = w; }
        {   unsigned w = *(unsigned*)(IKW + (size_t)row * 256 + 2 * lane);
            float x0 = bflo(w), x1 = bfhi(w);
            const float mu = wave_sum(x0 + x1) * (1.0f / 128.0f);
            x0 -= mu; x1 -= mu;
            const float var = wave_sum(x0 * x0 + x1 * x1) * (1.0f / 128.0f);
            const float r = rsqrtf(var + 1e-5f);
            const float g0 = a.in[6][2 * lane], g1 = a.in[6][2 * lane + 1], b0 = a.in[7][2 * lane], b1 = a.in[7][2 * lane + 1];
            *(unsigned*)(IKW + (size_t)row * 256 + 2 * lane) = pk2(x0 * r * g0 + b0, x1 * r * g1 + b1); }
    }
}
__device__ __forceinline__ void w8_transposes(const Frame& F, bf16* W8) {
    const Args& a = *F.a;
    const int gw = F.bid * 8 + F.wave, NGW = F.G * 8, lane = F.lane();
    float* scr = (float*)(F.lds + F.wave * 17408);
    float* cv = (float*)(F.ws + WS_CTL + CTL_CVEC);
    for (int it = gw; it < 2 * 2048; it += NGW) {
        const int which = it >> 11, m = which ? 7 : 3;
        transpose_item_ln(which ? a.in[22] : a.in[16], W8 + (size_t)m * 2048 * 2048, it & 2047, scr, lane, which ? a.in[20] : a.in[14], which ? a.in[21] : a.in[15], cv + which * 4096, cv + which * 4096 + 2048); }
    for (int it = gw; it < 4 * 1024; it += NGW) {
        const int q = it >> 10, m = q < 3 ? q : 6;
        const float* wsrc = m == 0 ? a.in[11] : m == 1 ? a.in[12] : m == 2 ? a.in[13] : a.in[19];
        if (m < 2) transpose_item64(wsrc, 2048, W8 + (size_t)m * 2048, 4096, 0, 32, it & 1023, scr, lane, CmIdent());
        else transpose_item64(wsrc, 2048, W8 + (size_t)m * 2048 * 2048, 2048, 0, 32, it & 1023, scr, lane, CmIdent()); }
}

__device__ __forceinline__ void ph3_hgnorm(const Frame& F) {
    const Args& a = *F.a;
    const int gw = F.bid * 8 + F.wave, NGW = F.G * 8, lane = F.lane();
    const float* oraw = a.out; const bf16* HG = F.slot(3); bf16* HO = F.slot(0);
    for (int u = gw; u < T * 16; u += NGW) {
        const size_t off = (size_t)(u >> 4) * 2048 + (u & 15) * 128 + 2 * lane;
        const float o0 = oraw[off], o1 = oraw[off + 1];
        const float r = rsqrtf(wave_sum(o0 * o0 + o1 * o1) * (1.0f / 128.0f) + 1e-6f);
        const unsigned gw2 = *(const unsigned*)(HG + off);
        const float g0 = bflo(gw2), g1 = bfhi(gw2);
        const int c = (u & 15) * 128 + 2 * lane;
        *(unsigned*)(HO + off) = pk2(o0 * r * a.in[4][c] * (g0 * sigm(g0)), o1 * r * a.in[4][c + 1] * (g1 * sigm(g1)));
    }
}

__device__ __forceinline__ unsigned fkey(float f) { const unsigned u = __float_as_uint(f); return (u & 0x80000000u) ? ~u : (u | 0x80000000u); }
__device__ __forceinline__ void ph5_select(const Frame& F, int first, int stride) {
    const int lane = F.lane(), l31 = lane & 31, half = lane >> 5, w = F.wave;
    float* scl = (float*)F.lds;
    const bf16* AIQ = F.slot(5); const bf16* IKW = (const bf16*)(F.ws + WS_IKW);
    unsigned* MASK = (unsigned*)(F.ws + WS_MASK);
    for (int i = first; i < 1024; i += stride) {
        const int r4 = i >> 8, c = i & 255, j = c & 127, b = 2 * r4 + (c >> 7), qt = (r4 & 1) ? 127 - j : j, t0 = qt * 16;
        bf16x8 Af[8];
        { const size_t rowA = (size_t)b * 2048 + t0 + 2 * w + ((l31 >> 2) & 1); const int headA = (l31 & 3) + 4 * (l31 >> 3);
#pragma unroll
          for (int ks = 0; ks < 8; ++ks) Af[ks] = *(const bf16x8*)(AIQ + rowA * 2048 + headA * 128 + 16 * ks + 8 * half); }
        float wr[16];
        { const bf16* wp = IKW + ((size_t)b * 2048 + t0 + 2 * w + half) * 256 + 128;
#pragma unroll
          for (int r = 0; r < 16; ++r) wr[r] = bf2f(wp[(r & 3) + 4 * (r >> 2)]) * (0.25f * 0.08838834764831845f); }
        const int nkt = (t0 + 15) / 32 + 1;
        unsigned char* ring = F.lds + 131072;
        const int srow = (w * 64 + lane) >> 4, sch = lane & 15;
        const bf16* kg = IKW + ((size_t)b * 2048 + srow) * 256 + 8 * sch;
        const int swr = srow * 256 + ((sch ^ (srow & 15)) << 4);
        const int frd = l31 * 256;
        u32x4 st0, st1;
        st0 = *(const u32x4*)kg; *(u32x4*)(ring + swr) = st0;
        if (nkt > 1) { st1 = *(const u32x4*)(kg + (size_t)32 * 256); *(u32x4*)(ring + 8192 + swr) = st1; }
        if (nkt > 2) st0 = *(const u32x4*)(kg + (size_t)2 * 32 * 256);
        __syncthreads();
#define IDX_TILE(kt_, STW, STL) do { \
            if ((kt_) + 3 < nkt) STL = *(const u32x4*)(kg + (size_t)((kt_) + 3) * 32 * 256); \
            { const unsigned char* sl_ = ring + ((kt_) % 3) * 8192 + frd; f32x16 acc; _Pragma("unroll") for (int r = 0; r < 16; ++r) acc[r] = 0.f; \
              _Pragma("unroll") for (int ks = 0; ks < 8; ++ks) { const bf16x8 bfr = *(const bf16x8*)(sl_ + (((2 * ks + half) ^ (l31 & 15)) << 4)); acc = __builtin_amdgcn_mfma_f32_32x32x16_bf16(Af[ks], bfr, acc, 0, 0, 0); } \
              float sc = 0.f; _Pragma("unroll") for (int r = 0; r < 16; ++r) sc += fmaxf(acc[r], 0.f) * wr[r]; \
              scl[(2 * w + half) * 2048 + (kt_) * 32 + l31] = sc; } \
            if ((kt_) + 2 < nkt) *(u32x4*)(ring + (((kt_) + 2) % 3) * 8192 + swr) = STW; \
            __syncthreads(); } while (0)
        for (int kt = 0; kt < nkt; kt += 2) { IDX_TILE(kt, st0, st1); if (kt + 1 < nkt) IDX_TILE(kt + 1, st1, st0); }
#undef IDX_TILE
        WAVE_SYNC();
#pragma unroll 1
        for (int qi = 0; qi < 2; ++qi) {
            const int t = t0 + 2 * w + qi; const float* row = scl + (2 * w + qi) * 2048;
            unsigned key[32];
#pragma unroll
            for (int jj = 0; jj < 32; ++jj) { const int s2 = lane + 64 * jj; key[jj] = (s2 <= t) ? fkey(row[s2]) : 0u; }
            unsigned thr = 0u;
            if (t + 1 > 256) {
                for (int bit = 31; bit >= 0; --bit) {
                    const unsigned cand = thr | (1u << bit);
                    int cnt = 0;
#pragma unroll
                    for (int jj = 0; jj < 32; ++jj) cnt += (key[jj] >= cand) ? 1 : 0;
                    { int tot = 0;
#pragma unroll
                      for (int bb = 0; bb < 6; ++bb) tot += __popcll(__ballot((cnt >> bb) & 1)) << bb;
                      cnt = tot; }
                    if (cnt >= 256) { thr = cand; if (cnt == 256) break; }
                }
            }
            unsigned wd = 0u;
#pragma unroll
            for (int jj = 0; jj < 32; ++jj) { const int s2 = lane + 64 * jj; const unsigned long long m = __ballot(s2 <= t && key[jj] >= thr);
                if (lane == 2 * jj) wd = (unsigned)m; if (lane == 2 * jj + 1) wd = (unsigned)(m >> 32); }
            MASK[((size_t)b * 2048 + t) * 64 + lane] = wd;
        }
        WAVE_SYNC();
    }
}

__device__ __forceinline__ int t5_bucket(int d) {
    if (d < 16) return d;
    return 16 + (d >= 19) + (d >= 21) + (d >= 24) + (d >= 27) + (d >= 31) + (d >= 35) + (d >= 40) + (d >= 46) + (d >= 52) + (d >= 59) + (d >= 67) + (d >= 77) + (d >= 87) + (d >= 99) + (d >= 113);
}
namespace dsa {
constexpr float SCALE = 0.08838834764831845f;
constexpr int NW = 8, QBLK = 32, KVBLK = 64, QB = NW * QBLK, DH = 128, LD = 2048;
constexpr int SHM_V = KVBLK * DH * 2, SHM_K = KVBLK * DH * 2;
constexpr int OFF_WS = 2 * SHM_V + 2 * SHM_K, OFF_BIAS = OFF_WS + NW * 64 * 4, LDS_TOTAL = OFF_BIAS + 16 * 128 * 4;
constexpr float THR = 8.f;
typedef short s16x4 __attribute__((ext_vector_type(4)));
#define KSWZ(row, colB) ((row) * 256 + ((colB) ^ (((row) & 7) << 4)))
#define SBAR() __builtin_amdgcn_sched_barrier(0)
__device__ __forceinline__ int v_st(int k, int c) { const int kk = (k & ~0xC) | ((k & 4) << 1) | ((k & 8) >> 1); return ((kk >> 3) * 4 + (c >> 5)) * 512 + ((kk & 7) * 32 + (c & 31)) * 2; }
__device__ __forceinline__ int v_rd_base(int lane) { return ((lane & 3) << 3) | (((lane >> 2) & 3) << 6) | (((lane >> 4) & 1) << 5) | (((lane >> 5) & 1) << 8); }
constexpr int v_rd_off(int d0, int ks, int half) { return d0 * 512 + ks * 4096 + half * 2048; }
__device__ __forceinline__ int crow(int r, int hi) { return (r & 3) + 8 * (r >> 2) + 4 * hi; }
__device__ __forceinline__ unsigned cvtpk(float lo, float hi) { unsigned r; asm volatile("v_cvt_pk_bf16_f32 %0, %1, %2" : "=v"(r) : "v"(lo), "v"(hi)); return r; }
__device__ __forceinline__ bf16x8 load8(const bf16* p) { return *reinterpret_cast<const bf16x8*>(p); }
template <bool NEAR>
__device__ __forceinline__ void init_scores(f32x16& p0, f32x16& p1, unsigned w0, unsigned w1, int hi, int dq, const float* bl) {
    w0 >>= 4 * hi; w1 >>= 4 * hi;
#pragma unroll
    for (int r = 0; r < 16; ++r) { const int c = (r & 3) + 8 * (r >> 2);
        const int x0 = __builtin_amdgcn_sbfe(w0, c, 1), x1 = __builtin_amdgcn_sbfe(w1, c, 1);
        unsigned b0 = 0u, b1 = 0u;
        if (NEAR) { int d0 = dq - c, d1 = dq - c - 32; d0 = d0 < 0 ? 0 : (d0 > 127 ? 127 : d0); d1 = d1 < 0 ? 0 : (d1 > 127 ? 127 : d1);
            b0 = __float_as_uint(bl[d0]); b1 = __float_as_uint(bl[d1]); }
        p0[r] = __uint_as_float((b0 & (unsigned)x0) | (0xFF800000u & ~(unsigned)x0));
        p1[r] = __uint_as_float((b1 & (unsigned)x1) | (0xFF800000u & ~(unsigned)x1)); }
}
__device__ __forceinline__ void partialSM(f32x16& p0, f32x16& p1, float& m_reg, float& mn, float& alpha) {
    float pmax = p0[0];
#pragma unroll
    for (int r = 1; r < 16; ++r) pmax = fmaxf(pmax, p0[r]);
#pragma unroll
    for (int r = 0; r < 16; ++r) pmax = fmaxf(pmax, p1[r]);
    { auto rr = __builtin_amdgcn_permlane32_swap(__float_as_uint(pmax), __float_as_uint(pmax), false, false);
      pmax = fmaxf(__uint_as_float(rr[0]), __uint_as_float(rr[1])); }
    constexpr float C2 = 1.4426950408889634f * SCALE;
    if (__builtin_expect(__all((pmax - m_reg) * SCALE <= THR), 1)) { mn = m_reg; alpha = 1.f; }
    else { mn = fmaxf(m_reg, pmax); alpha = __builtin_amdgcn_exp2f((m_reg - mn) * C2); m_reg = mn; }
    const float mnL = -mn * C2;
#pragma unroll
    for (int r = 0; r < 16; ++r) p0[r] = fmaf(p0[r], C2, mnL);
#pragma unroll
    for (int r = 0; r < 16; ++r) p1[r] = fmaf(p1[r], C2, mnL);
#pragma unroll
    for (int r = 0; r < 16; ++r) p0[r] = __builtin_amdgcn_exp2f(p0[r]);
}
__device__ __forceinline__ void finishSM(f32x16& p0, f32x16& p1, float alpha, float& l_reg, bf16x8& pa0, bf16x8& pa1, bf16x8& pa2, bf16x8& pa3) {
#pragma unroll
    for (int r = 0; r < 16; ++r) p1[r] = __builtin_amdgcn_exp2f(p1[r]);
    float ps = 0;
#pragma unroll
    for (int r = 0; r < 16; ++r) ps += p0[r];
#pragma unroll
    for (int r = 0; r < 16; ++r) ps += p1[r];
    { auto rr = __builtin_amdgcn_permlane32_swap(__float_as_uint(ps), __float_as_uint(ps), false, false);
      ps = __uint_as_float(rr[0]) + __uint_as_float(rr[1]); }
    l_reg = l_reg * alpha + ps;
#define PK4(P, B_, OUT) do { unsigned a0 = cvtpk(P[B_+0], P[B_+1]), a1 = cvtpk(P[B_+2], P[B_+3]);                          \
        unsigned b0 = cvtpk(P[B_+4], P[B_+5]), b1 = cvtpk(P[B_+6], P[B_+7]);                                             \
        auto r0 = __builtin_amdgcn_permlane32_swap(a0, b0, false, false); auto r1 = __builtin_amdgcn_permlane32_swap(a1, b1, false, false); \
        u32x4 w = {r0[0], r1[0], r0[1], r1[1]}; OUT = *reinterpret_cast<bf16x8*>(&w); } while (0)
    PK4(p0, 0, pa0); PK4(p0, 8, pa1); PK4(p1, 0, pa2); PK4(p1, 8, pa3);
#undef PK4
}
template <int KB>
__device__ __forceinline__ void qkt(f32x16& p0, f32x16& p1, const char* K_lds, int r32, int hi, const bf16x8* qr) {
    const char* kb[4];
#pragma unroll
    for (int dd = 0; dd < 4; ++dd) kb[dd] = K_lds + KB * SHM_K + KSWZ(r32, (dd * 16 + hi * 8) * 2);
#pragma unroll
    for (int d0 = 0; d0 < 8; ++d0) { const char* a = kb[d0 & 3] + (d0 >> 2) * 128;
        bf16x8 b0 = *reinterpret_cast<const bf16x8*>(a);
        bf16x8 b1 = *reinterpret_cast<const bf16x8*>(a + 32 * 256);
        p0 = __builtin_amdgcn_mfma_f32_32x32x16_bf16(b0, qr[d0], p0, 0, 0, 0);
        p1 = __builtin_amdgcn_mfma_f32_32x32x16_bf16(b1, qr[d0], p1, 0, 0, 0); }
}
template <int VB>
__device__ __forceinline__ void pv_tile(f32x16* o, int vb0, bf16x8 pa0, bf16x8 pa1, bf16x8 pa2, bf16x8 pa3) {
#define TRRD(dst, off) asm volatile("ds_read_b64_tr_b16 %0, %1 offset:%2" : "=&v"(dst) : "v"(vb0), "i"(off) : "memory")
#define PV_D0(d0) do { s16x4 l0, l1, l2, l3, h0, h1, h2, h3; constexpr int b_ = VB * SHM_V + v_rd_off(d0, 0, 0); \
        TRRD(l0, b_); TRRD(h0, b_ + 2048); TRRD(l1, b_ + 4096); TRRD(h1, b_ + 6144); TRRD(l2, b_ + 8192); TRRD(h2, b_ + 10240); TRRD(l3, b_ + 12288); TRRD(h3, b_ + 14336); \
        asm volatile("s_waitcnt lgkmcnt(0)" ::: "memory"); SBAR();   \
        o[d0] = __builtin_amdgcn_mfma_f32_32x32x16_bf16(pa0, (bf16x8){l0[0], l0[1], l0[2], l0[3], h0[0], h0[1], h0[2], h0[3]}, o[d0], 0, 0, 0);   \
        o[d0] = __builtin_amdgcn_mfma_f32_32x32x16_bf16(pa1, (bf16x8){l1[0], l1[1], l1[2], l1[3], h1[0], h1[1], h1[2], h1[3]}, o[d0], 0, 0, 0);   \
        o[d0] = __builtin_amdgcn_mfma_f32_32x32x16_bf16(pa2, (bf16x8){l2[0], l2[1], l2[2], l2[3], h2[0], h2[1], h2[2], h2[3]}, o[d0], 0, 0, 0);   \
        o[d0] = __builtin_amdgcn_mfma_f32_32x32x16_bf16(pa3, (bf16x8){l3[0], l3[1], l3[2], l3[3], h3[0], h3[1], h3[2], h3[3]}, o[d0], 0, 0, 0); } while (0)
    PV_D0(0); PV_D0(1); PV_D0(2); PV_D0(3);
#undef PV_D0
#undef TRRD
}
struct BlockRef { const bf16* Q; const bf16* K; const bf16* V; bf16* O; const unsigned* M; int P0; int h; };
struct Seam { bf16x8 qr[8]; bf16x8 st_v0, st_v1, st_k0, st_k1; };
#define ROWU(p, k0) ((p) + (size_t)(k0) * LD)
#define VMW() asm volatile("s_waitcnt vmcnt(0)" ::: "memory")
#define VMWN(n) asm volatile("s_waitcnt vmcnt(%0)" :: "i"(n) : "memory")
#define SLOAD_H(Kp, Vp, k0) do { S.st_v0 = load8(ROWU(Vp, k0) + sofs); S.st_v1 = load8(ROWU(Vp, (k0) + 32) + sofs);              \
                         S.st_k0 = load8(ROWU(Kp, k0) + sofs); S.st_k1 = load8(ROWU(Kp, (k0) + 32) + sofs); } while (0)
#define SWRITE_HK(bf) do { *(bf16x8*)(K_lds + (bf) * SHM_K + kws) = S.st_k0; *(bf16x8*)(K_lds + (bf) * SHM_K + kws + 32 * 256) = S.st_k1; } while (0)
#define SWRITE_HV(bf) do { *(bf16x8*)(V_lds + (bf) * SHM_V + vst0) = S.st_v0; *(bf16x8*)(V_lds + (bf) * SHM_V + vst1) = S.st_v1; } while (0)
#define SWRITE_H(bf) do { SWRITE_HV(bf); SWRITE_HK(bf); } while (0)
__device__ __forceinline__ void prime(const BlockRef& cur, char* lds, Seam& S, int wid) {
    const int lane = fresh_lane(), tid = wid * 64 + lane, r32 = lane & 31, hi = lane >> 5;
    const int sr = tid >> 4, sc = (tid & 15) * 8, kws = KSWZ(sr, sc * 2); char* K_lds = lds + 2 * SHM_V; const unsigned sofs = (unsigned)(sr * LD + sc);
    const unsigned qofs = (unsigned)((wid * QBLK + r32) * LD + hi * 8);
#pragma unroll
    for (int d0 = 0; d0 < 8; ++d0) S.qr[d0] = load8(cur.Q + qofs + d0 * 16);
    SLOAD_H(cur.K, cur.V, 0); VMW(); SWRITE_HK(0);
    __syncthreads();
}
__device__ __forceinline__ void block(const BlockRef& cur, const BlockRef& nxt, char* lds, Seam& S, int wid) {
    const int lane = fresh_lane(), tid = wid * 64 + lane,
               r32 = lane & 31, hi = lane >> 5;
    const int NT = (cur.P0 + QB - 1) / KVBLK + 1;
    const int qlo = cur.P0 + wid * QBLK, qm = qlo + r32 - 4 * hi;
    char* V_lds = lds; char* K_lds = lds + 2 * SHM_V;
    float* ws = (float*)(lds + OFF_WS) + wid * 64; float* li_l = ws, * al_l = ws + 32;
    const float* bl = (const float*)(lds + OFF_BIAS) + cur.h * 128;
    const unsigned mofs = (unsigned)((wid * QBLK + r32) * 64);
    float m_reg = -1e30f, l_reg = 0; f32x16 o[4] = {};
    const int sr = tid >> 4, sc = (tid & 15) * 8, vst0 = v_st(sr, sc), vst1 = v_st(32 + sr, sc), kws = KSWZ(sr, sc * 2); const unsigned sofs = (unsigned)(sr * LD + sc);
    const int vb0 = (int)(uintptr_t)V_lds + v_rd_base(lane);
    const bf16* Kh = cur.K; const bf16* Vh = cur.V;
#define RESC(a) do { if (__any((a) < 1.f)) { if (hi == 0) al_l[r32] = (a); asm volatile("s_waitcnt lgkmcnt(0)" ::: "memory");              \
                     for (int d_ = 0; d_ < 4; ++d_) for (int r = 0; r < 16; ++r) o[d_][r] *= al_l[crow(r, hi)]; } } while (0)
#define KBASE(t) ((t) * KVBLK)
#define LDMASK(t) (*(const u32x2*)(cur.M + 2 * ((t) < 31 ? (t) : 31) + mofs))
#define INIT(P0_, P1_, t) do { const int kb_ = KBASE(t); if (qlo - kb_ - 63 < 113) init_scores<true>(P0_, P1_, mw.x, mw.y, hi, qm - kb_, bl); else init_scores<false>(P0_, P1_, mw.x, mw.y, hi, 0, bl); } while (0)
#define SEAM_K0() do { VMWN(8); SWRITE_HK(0); SBAR(); } while (0)
    f32x16 pA0, pA1, pB0, pB1; float mnA, mnB, alA, alB; bf16x8 pa0, pa1, pa2, pa3; u32x2 mw;
    SWRITE_HV(0); SBAR();
    if (NT > 1) { SLOAD_H(Kh, Vh, KBASE(1)); }
    mw = LDMASK(0); INIT(pA0, pA1, 0); mw = LDMASK(1);
    SBAR(); qkt<0>(pA0, pA1, K_lds, r32, hi, S.qr);
    partialSM(pA0, pA1, m_reg, mnA, alA);
    if (NT > 1) { VMW(); SWRITE_H(1); }
    __syncthreads();
#define HALF_STEP(PX0, PX1, mnX, alX, PY0, PY1, alY, t, KB, VB, SB) do {                                                      \
        INIT(PX0, PX1, (t)); mw = LDMASK((t) + 1);                                                                           \
        SBAR(); qkt<KB>(PX0, PX1, K_lds, r32, hi, S.qr);                                                                      \
        finishSM(PY0, PY1, alY, l_reg, pa0, pa1, pa2, pa3); SBAR();                                                           \
        if ((t) + 1 < NT) { SLOAD_H(Kh, Vh, KBASE((t) + 1)); SBAR(); }                                                        \
        pv_tile<VB>(o, vb0, pa0, pa1, pa2, pa3); partialSM(PX0, PX1, m_reg, mnX, alX);              \
        __syncthreads();                                                                                                      \
        if ((t) + 1 < NT) { VMW(); SWRITE_H(SB); }                                                                            \
        RESC(alX); __syncthreads(); } while (0)
    for (int t = 1; t + 1 < NT; t += 2) {
        HALF_STEP(pB0, pB1, mnB, alB, pA0, pA1, alA, t, 1, 0, 0);
        HALF_STEP(pA0, pA1, mnA, alA, pB0, pB1, alB, t + 1, 0, 1, 1);
    }
    const bool even = (NT & 1) == 0;
    if (even) { INIT(pB0, pB1, NT - 1); SBAR(); qkt<1>(pB0, pB1, K_lds, r32, hi, S.qr); SBAR(); }
    SLOAD_H(nxt.K, nxt.V, 0); SBAR();
#pragma unroll
    for (int d0 = 0; d0 < 8; ++d0) S.qr[d0] = load8(nxt.Q + (unsigned)((wid * QBLK + r32) * LD + hi * 8) + d0 * 16);
    SBAR();
    finishSM(pA0, pA1, alA, l_reg, pa0, pa1, pa2, pa3); SBAR();
    pv_tile<0>(o, vb0, pa0, pa1, pa2, pa3);
    if (even) { partialSM(pB0, pB1, m_reg, mnB, alB); __syncthreads(); RESC(alB);
        finishSM(pB0, pB1, alB, l_reg, pa0, pa1, pa2, pa3); SBAR(); pv_tile<1>(o, vb0, pa0, pa1, pa2, pa3); }
    SBAR(); SEAM_K0();
    if (hi == 0) li_l[r32] = l_reg; asm volatile("s_waitcnt lgkmcnt(0)" ::: "memory");
    float rli[16];
#pragma unroll
    for (int r = 0; r < 16; ++r) rli[r] = __builtin_amdgcn_rcpf(li_l[crow(r, hi)]);
    int lofs = 4 * hi * LD + r32; asm volatile("" : "+v"(lofs));
    bf16* Ow = cur.O + (size_t)(wid * QBLK) * LD + lofs;
#pragma unroll
    for (int r = 0; r < 16; ++r) { const int orow = (r & 3) + 8 * (r >> 2);
#pragma unroll
        for (int d0 = 0; d0 < 4; ++d0) { const float v = o[d0][r] * rli[r];
            const float vn = __shfl_xor(v, 1);
            if ((r32 & 1) == 0) *(unsigned*)(Ow + orow * LD + d0 * 32) = cvtpk(v, vn); } }
    __syncthreads();
#undef RESC
#undef KBASE
#undef LDMASK
#undef INIT
#undef SEAM_K0
#undef HALF_STEP
}
#undef ROWU
#undef VMW
#undef VMWN
#undef SLOAD_H
#undef SWRITE_HK
#undef SWRITE_HV
#undef SWRITE_H
#undef KSWZ
#undef SBAR
}

__device__ __forceinline__ dsa::BlockRef dsa_ref(const Frame& F, int bh, int qb) {
    const int b = bh >> 4, h = bh & 15;
    dsa::BlockRef r;
    r.Q = F.slot(4) + ((size_t)b * 2048 + (size_t)qb * 256) * 2048 + h * 128;
    r.O = F.slot(3) + ((size_t)b * 2048 + (size_t)qb * 256) * 2048 + h * 128;
    r.K = F.slot(1) + (size_t)b * 2048 * 2048 + h * 128; r.V = F.slot(2) + (size_t)b * 2048 * 2048 + h * 128;
    r.M = (const unsigned*)(F.ws + WS_MASK) + ((size_t)b * 2048 + (size_t)qb * 256) * 64;
    r.P0 = qb * 256; r.h = h;
    return r;
}
__device__ __forceinline__ void ph6_attn(const Frame& F) {
    const Args& a = *F.a;
    char* lds = (char*)F.lds;
    {
        float* bt = (float*)(lds + dsa::OFF_BIAS);
        for (int i = F.wave * 64 + F.lane(); i < 16 * 128; i += 512) { const int h = i >> 7, d = i & 127; bt[i] = (a.in[10][t5_bucket(d) * 16 + h] - a.in[10][31 * 16 + h]) * (1.0f / dsa::SCALE); }
    }
    __syncthreads();
    const int total = 4 * 128;
    int L = F.bid; if (L >= total) return;
#define ATT_BH(L_) (((L_) >> 8) * 64 + ((L_) & 7) * 8 + ((((L_) & 255) >> 3) >> 2))
#define ATT_PR(L_) ((((L_) & 255) >> 3) & 3)
    int pass = 0;
    const bool xmap = (F.G == 256);
    dsa::BlockRef cur = dsa_ref(F, xmap ? ATT_BH(L) : (L >> 2), xmap ? ATT_PR(L) : (L & 3));
    dsa::Seam S;
    dsa::prime(cur, lds, S, F.wave);
    for (;;) {
        const bool more_pass = pass == 0, more_item = L + F.G < total, last = !more_pass && !more_item;
        int passn = pass + 1, Ln = L;
        if (!more_pass) { passn = 0; Ln = more_item ? L + F.G : L; }
        const int bhn = xmap ? ATT_BH(Ln) : (Ln >> 2), prn = xmap ? ATT_PR(Ln) : (Ln & 3);
        const dsa::BlockRef nxt = last ? cur : dsa_ref(F, bhn, passn ? 7 - prn : prn);
        dsa::block(cur, nxt, lds, S, F.wave);
        if (last) break;
        cur = nxt; pass = passn; L = Ln;
    }
}

__device__ __forceinline__ void ln_row(float* zrow, const float* g, const float* bta, bf16* brow, int lane) {
    f32x4 v[8]; float s = 0.f;
#pragma unroll
    for (int i = 0; i < 8; ++i) { v[i] = *(const f32x4*)(zrow + 256 * i + 4 * lane); s += (v[i].x + v[i].y) + (v[i].z + v[i].w); }
    const float mu = wave_sum(s) * (1.0f / 2048.0f); float s2 = 0.f;
#pragma unroll
    for (int i = 0; i < 8; ++i) { v[i] = v[i] - mu; s2 += (v[i].x * v[i].x + v[i].y * v[i].y) + (v[i].z * v[i].z + v[i].w * v[i].w); }
    const float r = rsqrtf(wave_sum(s2) * (1.0f / 2048.0f) + 1e-5f);
#pragma unroll
    for (int i = 0; i < 8; ++i) { const f32x4 gg = *(const f32x4*)(g + 256 * i + 4 * lane), bb = *(const f32x4*)(bta + 256 * i + 4 * lane);
        const f32x4 o = v[i] * r * gg + bb; *(f32x4*)(zrow + 256 * i + 4 * lane) = o;
        if (brow) { u32x2 w; w.x = pk2(o.x, o.y); w.y = pk2(o.z, o.w); *(u32x2*)(brow + 256 * i + 4 * lane) = w; } }
}
__device__ __forceinline__ void ph_ln(const Frame& F, const float* g, const float* bta, bf16* bout) {
    const int gw = F.bid * 8 + F.wave, NGW = F.G * 8, lane = F.lane();
    for (int row = gw; row < T; row += NGW) ln_row(F.a->out + (size_t)row * 2048, g, bta, bout + (size_t)row * 2048, lane);
}

__device__ __forceinline__ float pk_idx(float v, unsigned code, unsigned mask) { return __uint_as_float((__float_as_uint(v) & ~mask) | code); }
__device__ __forceinline__ void ph_peer_select(const Frame& F) {
    const Args& a = *F.a;
    const int lane = F.lane(), l31 = lane & 31, half = lane >> 5;
    const float* PQ = (const float*)F.slot(1); const float* keys = a.in[23];
    int* EIDX = (int*)(F.ws + WS_CKV); float* EG = (float*)(F.ws + WS_IKW);
    const float NEG = -__builtin_inff();
    const int h = F.bid & 7, ntw = F.G >> 3;
    { const int tid = F.wave * 64 + lane;
#pragma unroll
      for (int p = 0; p < 2; ++p)
#pragma unroll
          for (int i = 0; i < 8; ++i) { const int idx = tid + 512 * i, row = idx >> 5, c4 = idx & 31;
              *(f32x4*)(F.lds + (size_t)p * 67584 + ((size_t)row * 132 + 4 * c4) * 4) = *(const f32x4*)(keys + ((size_t)(2 * h + p) * 128 + row) * 128 + 4 * c4); }
      __syncthreads(); }
    for (int tile = (F.bid >> 3) + ntw * F.wave; tile < T / 32; tile += ntw * 8) {
        const int t = tile * 32 + l31;
        float tv[2][16];
#pragma unroll
        for (int p = 0; p < 2; ++p) {
            const int g = 2 * h + p;
            float qv[64];
            { const float* qp = PQ + (size_t)t * 2048 + g * 128 + 64 * half;
#pragma unroll
              for (int j = 0; j < 16; ++j) { const f32x4 v = *(const f32x4*)(qp + 4 * j); qv[4 * j] = v.x; qv[4 * j + 1] = v.y; qv[4 * j + 2] = v.z; qv[4 * j + 3] = v.w; } }
            f32x16 acc[4];
#pragma unroll
            for (int mt = 0; mt < 4; ++mt)
#pragma unroll
                for (int r = 0; r < 16; ++r) acc[mt][r] = 0.f;
            const float* kp0 = (const float*)(F.lds + (size_t)p * 67584) + ((size_t)l31 * 132 + 64 * half);
            f32x4 kb[3][4];
#define PK_LOADC(cc) do { _Pragma("unroll") for (int u_ = 0; u_ < 4; ++u_) kb[(cc) % 3][u_] = *(const f32x4*)(kp0 + (size_t)((cc) >> 2) * 32 * 132 + 16 * ((cc) & 3) + 4 * u_); } while (0)
#define PK_MMAC(cc) do { _Pragma("unroll") for (int u_ = 0; u_ < 4; ++u_) { const f32x4 kv_ = kb[(cc) % 3][u_]; const int j_ = 4 * ((cc) & 3) + u_; \
                acc[(cc) >> 2] = __builtin_amdgcn_mfma_f32_32x32x2f32(kv_.x, qv[4 * j_], acc[(cc) >> 2], 0, 0, 0); acc[(cc) >> 2] = __builtin_amdgcn_mfma_f32_32x32x2f32(kv_.y, qv[4 * j_ + 1], acc[(cc) >> 2], 0, 0, 0); \
                acc[(cc) >> 2] = __builtin_amdgcn_mfma_f32_32x32x2f32(kv_.z, qv[4 * j_ + 2], acc[(cc) >> 2], 0, 0, 0); acc[(cc) >> 2] = __builtin_amdgcn_mfma_f32_32x32x2f32(kv_.w, qv[4 * j_ + 3], acc[(cc) >> 2], 0, 0, 0); } } while (0)
            PK_LOADC(0); PK_LOADC(1);
            PK_LOADC(2); PK_MMAC(0); __builtin_amdgcn_sched_barrier(0);
            PK_LOADC(3); PK_MMAC(1); __builtin_amdgcn_sched_barrier(0);
            PK_LOADC(4); PK_MMAC(2); __builtin_amdgcn_sched_barrier(0);
            PK_LOADC(5); PK_MMAC(3); __builtin_amdgcn_sched_barrier(0);
            PK_LOADC(6); PK_MMAC(4); __builtin_amdgcn_sched_barrier(0);
            PK_LOADC(7); PK_MMAC(5); __builtin_amdgcn_sched_barrier(0);
            PK_LOADC(8); PK_MMAC(6); __builtin_amdgcn_sched_barrier(0);
            PK_LOADC(9); PK_MMAC(7); __builtin_amdgcn_sched_barrier(0);
            PK_LOADC(10); PK_MMAC(8); __builtin_amdgcn_sched_barrier(0);
            PK_LOADC(11); PK_MMAC(9); __builtin_amdgcn_sched_barrier(0);
            PK_LOADC(12); PK_MMAC(10); __builtin_amdgcn_sched_barrier(0);
            PK_LOADC(13); PK_MMAC(11); __builtin_amdgcn_sched_barrier(0);
            PK_LOADC(14); PK_MMAC(12); __builtin_amdgcn_sched_barrier(0);
            PK_LOADC(15); PK_MMAC(13); __builtin_amdgcn_sched_barrier(0);
            PK_MMAC(14); __builtin_amdgcn_sched_barrier(0);
            PK_MMAC(15); __builtin_amdgcn_sched_barrier(0);
#undef PK_LOADC
#undef PK_MMAC
            unsigned hmask = ~(4u * (unsigned)half); asm volatile("" : "+v"(hmask));
#pragma unroll
            for (int mt = 0; mt < 4; ++mt)
#pragma unroll
                for (int r = 0; r < 16; ++r) acc[mt][r] = __uint_as_float(((__float_as_uint(acc[mt][r]) & ~127u) | (unsigned)(127 - (32 * mt + (r & 3) + 8 * (r >> 2)))) & hmask);
#pragma unroll
            for (int k = 0; k < 16; ++k) {
                float m = acc[0][0];
#pragma unroll
                for (int mt = 0; mt < 4; ++mt)
#pragma unroll
                    for (int r = 0; r < 16; ++r) m = fmaxf(m, acc[mt][r]);
                m = fmaxf(m, __shfl_xor(m, 32));
                tv[p][k] = m;
#pragma unroll
                for (int mt = 0; mt < 4; ++mt)
#pragma unroll
                    for (int r = 0; r < 16; ++r) acc[mt][r] = (acc[mt][r] == m) ? NEG : acc[mt][r];
            }
        }
        float cand[25]; int cid[25];
        unsigned hc = 25u * (unsigned)half; asm volatile("" : "+v"(hc));
        { const float ai = half ? tv[0][2] : tv[0][0], bj = half ? tv[1][1] : tv[1][0];
          cand[0] = pk_idx(ai + bj, (unsigned)(63 - 0) - hc, 63u); cid[0] = (int)((127u - (__float_as_uint(ai) & 127u)) * 128u + (127u - (__float_as_uint(bj) & 127u))); }
        { const float ai = half ? tv[0][2] : tv[0][0], bj = half ? tv[1][2] : tv[1][1];
          cand[1] = pk_idx(ai + bj, (unsigned)(63 - 1) - hc, 63u); cid[1] = (int)((127u - (__float_as_uint(ai) & 127u)) * 128u + (127u - (__float_as_uint(bj) & 127u))); }
        { const float ai = half ? tv[0][2] : tv[0][0], bj = half ? tv[1][3] : tv[1][2];
          cand[2] = pk_idx(ai + bj, (unsigned)(63 - 2) - hc, 63u); cid[2] = (int)((127u - (__float_as_uint(ai) & 127u)) * 128u + (127u - (__float_as_uint(bj) & 127u))); }
        { const float ai = half ? tv[0][2] : tv[0][0], bj = half ? tv[1][4] : tv[1][3];
          cand[3] = pk_idx(ai + bj, (unsigned)(63 - 3) - hc, 63u); cid[3] = (int)((127u - (__float_as_uint(ai) & 127u)) * 128u + (127u - (__float_as_uint(bj) & 127u))); }
        { const float ai = half ? tv[0][3] : tv[0][0], bj = half ? tv[1][0] : tv[1][4];
          cand[4] = pk_idx(ai + bj, (unsigned)(63 - 4) - hc, 63u); cid[4] = (int)((127u - (__float_as_uint(ai) & 127u)) * 128u + (127u - (__float_as_uint(bj) & 127u))); }
        { const float ai = half ? tv[0][3] : tv[0][0], bj = half ? tv[1][1] : tv[1][5];
          cand[5] = pk_idx(ai + bj, (unsigned)(63 - 5) - hc, 63u); cid[5] = (int)((127u - (__float_as_uint(ai) & 127u)) * 128u + (127u - (__float_as_uint(bj) & 127u))); }
        { const float ai = half ? tv[0][3] : tv[0][0], bj = half ? tv[1][2] : tv[1][6];
          cand[6] = pk_idx(ai + bj, (unsigned)(63 - 6) - hc, 63u); cid[6] = (int)((127u - (__float_as_uint(ai) & 127u)) * 128u + (127u - (__float_as_uint(bj) & 127u))); }
        { const float ai = half ? tv[0][3] : tv[0][0], bj = half ? tv[1][3] : tv[1][7];
          cand[7] = pk_idx(ai + bj, (unsigned)(63 - 7) - hc, 63u); cid[7] = (int)((127u - (__float_as_uint(ai) & 127u)) * 128u + (127u - (__float_as_uint(bj) & 127u))); }
        { const float ai = half ? tv[0][4] : tv[0][0], bj = half ? tv[1][0] : tv[1][8];
          cand[8] = pk_idx(ai + bj, (unsigned)(63 - 8) - hc, 63u); cid[8] = (int)((127u - (__float_as_uint(ai) & 127u)) * 128u + (127u - (__float_as_uint(bj) & 127u))); }
        { const float ai = half ? tv[0][4] : tv[0][0], bj = half ? tv[1][1] : tv[1][9];
          cand[9] = pk_idx(ai + bj, (unsigned)(63 - 9) - hc, 63u); cid[9] = (int)((127u - (__float_as_uint(ai) & 127u)) * 128u + (127u - (__float_as_uint(bj) & 127u))); }
        { const float ai = half ? tv[0][4] : tv[0][0], bj = half ? tv[1][2] : tv[1][10];
          cand[10] = pk_idx(ai + bj, (unsigned)(63 - 10) - hc, 63u); cid[10] = (int)((127u - (__float_as_uint(ai) & 127u)) * 128u + (127u - (__float_as_uint(bj) & 127u))); }
        { const float ai = half ? tv[0][5] : tv[0][0], bj = half ? tv[1][0] : tv[1][11];
          cand[11] = pk_idx(ai + bj, (unsigned)(63 - 11) - hc, 63u); cid[11] = (int)((127u - (__float_as_uint(ai) & 127u)) * 128u + (127u - (__float_as_uint(bj) & 127u))); }
        { const float ai = half ? tv[0][5] : tv[0][0], bj = half ? tv[1][1] : tv[1][12];
          cand[12] = pk_idx(ai + bj, (unsigned)(63 - 12) - hc, 63u); cid[12] = (int)((127u - (__float_as_uint(ai) & 127u)) * 128u + (127u - (__float_as_uint(bj) & 127u))); }
        { const float ai = half ? tv[0][6] : tv[0][0], bj = half ? tv[1][0] : tv[1][13];
          cand[13] = pk_idx(ai + bj, (unsigned)(63 - 13) - hc, 63u); cid[13] = (int)((127u - (__float_as_uint(ai) & 127u)) * 128u + (127u - (__float_as_uint(bj) & 127u))); }
        { const float ai = half ? tv[0][6] : tv[0][0], bj = half ? tv[1][1] : tv[1][14];
          cand[14] = pk_idx(ai + bj, (unsigned)(63 - 14) - hc, 63u); cid[14] = (int)((127u - (__float_as_uint(ai) & 127u)) * 128u + (127u - (__float_as_uint(bj) & 127u))); }
        { const float ai = half ? tv[0][7] : tv[0][0], bj = half ? tv[1][0] : tv[1][15];
          cand[15] = pk_idx(ai + bj, (unsigned)(63 - 15) - hc, 63u); cid[15] = (int)((127u - (__float_as_uint(ai) & 127u)) * 128u + (127u - (__float_as_uint(bj) & 127u))); }
        { const float ai = half ? tv[0][7] : tv[0][1], bj = half ? tv[1][1] : tv[1][0];
          cand[16] = pk_idx(ai + bj, (unsigned)(63 - 16) - hc, 63u); cid[16] = (int)((127u - (__float_as_uint(ai) & 127u)) * 128u + (127u - (__float_as_uint(bj) & 127u))); }
        { const float ai = half ? tv[0][8] : tv[0][1], bj = half ? tv[1][0] : tv[1][1];
          cand[17] = pk_idx(ai + bj, (unsigned)(63 - 17) - hc, 63u); cid[17] = (int)((127u - (__float_as_uint(ai) & 127u)) * 128u + (127u - (__float_as_uint(bj) & 127u))); }
        { const float ai = half ? tv[0][9] : tv[0][1], bj = half ? tv[1][0] : tv[1][2];
          cand[18] = pk_idx(ai + bj, (unsigned)(63 - 18) - hc, 63u); cid[18] = (int)((127u - (__float_as_uint(ai) & 127u)) * 128u + (127u - (__float_as_uint(bj) & 127u))); }
        { const float ai = half ? tv[0][10] : tv[0][1], bj = half ? tv[1][0] : tv[1][3];
          cand[19] = pk_idx(ai + bj, (unsigned)(63 - 19) - hc, 63u); cid[19] = (int)((127u - (__float_as_uint(ai) & 127u)) * 128u + (127u - (__float_as_uint(bj) & 127u))); }
        { const float ai = half ? tv[0][11] : tv[0][1], bj = half ? tv[1][0] : tv[1][4];
          cand[20] = pk_idx(ai + bj, (unsigned)(63 - 20) - hc, 63u); cid[20] = (int)((127u - (__float_as_uint(ai) & 127u)) * 128u + (127u - (__float_as_uint(bj) & 127u))); }
        { const float ai = half ? tv[0][12] : tv[0][1], bj = half ? tv[1][0] : tv[1][5];
          cand[21] = pk_idx(ai + bj, (unsigned)(63 - 21) - hc, 63u); cid[21] = (int)((127u - (__float_as_uint(ai) & 127u)) * 128u + (127u - (__float_as_uint(bj) & 127u))); }
        { const float ai = half ? tv[0][13] : tv[0][1], bj = half ? tv[1][0] : tv[1][6];
          cand[22] = pk_idx(ai + bj, (unsigned)(63 - 22) - hc, 63u); cid[22] = (int)((127u - (__float_as_uint(ai) & 127u)) * 128u + (127u - (__float_as_uint(bj) & 127u))); }
        { const float ai = half ? tv[0][14] : tv[0][1], bj = half ? tv[1][0] : tv[1][7];
          cand[23] = pk_idx(ai + bj, (unsigned)(63 - 23) - hc, 63u); cid[23] = (int)((127u - (__float_as_uint(ai) & 127u)) * 128u + (127u - (__float_as_uint(bj) & 127u))); }
        { const float ai = half ? tv[0][15] : tv[0][2], bj = half ? tv[1][0] : tv[1][0];
          cand[24] = pk_idx(ai + bj, (unsigned)(63 - 24) - hc, 63u); cid[24] = (int)((127u - (__float_as_uint(ai) & 127u)) * 128u + (127u - (__float_as_uint(bj) & 127u))); }
        float sv[16]; int sid[16];
#pragma unroll
        for (int k = 0; k < 16; ++k) {
            float m = cand[0];
#pragma unroll
            for (int c = 1; c < 25; ++c) m = fmaxf(m, cand[c]);
            const float mo = __shfl_xor(m, 32);
            const bool mine = (m > mo) || (m == mo && half == 0);
            const float mm = fmaxf(m, mo);
            int id = -1;
#pragma unroll
            for (int c = 0; c < 25; ++c) { const bool hit = mine && (cand[c] == mm); id = hit ? cid[c] : id; cand[c] = hit ? NEG : cand[c]; }
            const int ido = __shfl_xor(id, 32);
            sv[k] = mm; sid[k] = id > ido ? id : ido;
        }
        float den = 0.f; float ev[16];
#pragma unroll
        for (int k = 0; k < 16; ++k) { ev[k] = expf(sv[k] - sv[0]); den += ev[k]; }
        const float inv = 1.0f / den;
        if (half == 0) { int* ep = EIDX + (size_t)t * 128 + h * 16;
#pragma unroll
            for (int k = 0; k < 16; k += 4) *(u32x4*)(ep + k) = (u32x4){(unsigned)sid[k], (unsigned)sid[k + 1], (unsigned)sid[k + 2], (unsigned)sid[k + 3]}; }
        else { float* gp = EG + (size_t)t * 128 + h * 16;
#pragma unroll
            for (int k = 0; k < 16; k += 4) *(f32x4*)(gp + k) = (f32x4){ev[k] * inv, ev[k + 1] * inv, ev[k + 2] * inv, ev[k + 3] * inv}; }
    }
}

typedef unsigned v6u __attribute__((ext_vector_type(6)));
typedef float v32f __attribute__((ext_vector_type(32)));
typedef float v16f __attribute__((ext_vector_type(16)));
constexpr float PU_SCALE = 64.0f, PV_SCALE = 2.0f;
#ifndef FP6_INTERLEAVED
#define FP6_INTERLEAVED 1
#endif
#define RL(v, l) __builtin_amdgcn_readlane((v), (l))
#define EXR 2
#define EX_LOAD(bu, bv, idv, e) do { _Pragma("unroll") for (int r_ = 0; r_ < EXR; ++r_) { const unsigned* rp_ = (const unsigned*)(PUV + (size_t)RL(idv, ((e) & 63) + r_) * 3072) + 6 * lane; \
        const u32x2 p0_ = *(const u32x2*)rp_, p1_ = *(const u32x2*)(rp_ + 2), p2_ = *(const u32x2*)(rp_ + 4), q0_ = *(const u32x2*)(rp_ + 384), q1_ = *(const u32x2*)(rp_ + 386), q2_ = *(const u32x2*)(rp_ + 388); \
        bu[r_] = (v6u){p0_.x, p0_.y, p1_.x, p1_.y, p2_.x, p2_.y}; bv[r_] = (v6u){q0_.x, q0_.y, q1_.x, q1_.y, q2_.x, q2_.y}; } } while (0)
#define EX_USE(bu, bv, e) do { float d_[EXR]; _Pragma("unroll") for (int r_ = 0; r_ < EXR; ++r_) { const v32f w_ = __builtin_amdgcn_cvt_scalef32_pk32_f32_fp6(bu[r_], 1.0f); float a_ = 0.f, b_ = 0.f; \
        _Pragma("unroll") for (int j_ = 0; j_ < 32; j_ += 2) { a_ += w_[j_] * xf[j_]; b_ += w_[j_ + 1] * xf[j_ + 1]; } d_[r_] = a_ + b_; __builtin_amdgcn_sched_barrier(0); } \
        _Pragma("unroll") for (int r_ = 0; r_ < EXR; ++r_) d_[r_] = wave_sum_dpp(d_[r_]); \
        const float gv_ = (e) < 64 ? g0 : g1; \
        _Pragma("unroll") for (int r_ = 0; r_ < EXR; ++r_) { const float pre_ = d_[r_] * (1.0f / PU_SCALE); const float hv_ = 0.5f * pre_ * (1.0f + erff(pre_ * 0.7071067811865476f)); \
            const float cf_ = __int_as_float(RL(__float_as_int(gv_), ((e) & 63) + r_)) * hv_ * (1.0f / PV_SCALE); \
            const v32f w_ = __builtin_amdgcn_cvt_scalef32_pk32_f32_fp6(bv[r_], 1.0f); _Pragma("unroll") for (int j_ = 0; j_ < 32; ++j_) y[j_] += cf_ * w_[j_]; __builtin_amdgcn_sched_barrier(0); } } while (0)
__device__ __forceinline__ void cvt_fp6_stream(const Frame& F, const float* src, unsigned char* dst, size_t nrows, float scale, int wg, int nwg) {
    const int lane = F.lane();
    float* tile = (float*)(F.lds + F.wave * 8192);
    for (size_t r = (size_t)wg * 8 + F.wave; r < nrows; r += (size_t)nwg * 8) {
#pragma unroll
        for (int j = 0; j < 8; ++j) *(f32x4*)(tile + 256 * j + 4 * lane) = *(const f32x4*)(src + r * 2048 + 256 * j + 4 * lane) * scale;
        WAVE_SYNC();
        f32x4 q[8];
#pragma unroll
        for (int j = 0; j < 8; ++j) q[j] = *(const f32x4*)(tile + 32 * lane + 4 * j);
        WAVE_SYNC();
        v16f x, y;
#pragma unroll
        for (int j = 0; j < 8; ++j) { x[2 * j] = q[j].x; y[2 * j] = q[j].y; x[2 * j + 1] = q[j].z; y[2 * j + 1] = q[j].w; }
        const v6u p = __builtin_amdgcn_cvt_scalef32_2xpk16_fp6_f32(x, y, 1.0f);
        unsigned* o = (unsigned*)(dst + r * 3072) + 6 * lane;
        *(u32x2*)o = (u32x2){p[0], p[1]}; *(u32x2*)(o + 2) = (u32x2){p[2], p[3]}; *(u32x2*)(o + 4) = (u32x2){p[4], p[5]};
    }
}
#define EX_LOAD_XF() do { float mu_, rs_; row_mu_rstd((const float*)(F.ws + WS_CTL + CTL_ST2), t, mu_, rs_); \
          const bf16* zr = F.slot(0) + (size_t)t * 2048 + lq; \
          _Pragma("unroll") for (int q = 0; q < 4; ++q) { const int col = lq + 8 * q; f32x4 z0, z1; unpack8v(*(const u32x4*)(zr + 8 * q), z0, z1); \
              const f32x4 g0v = *(const f32x4*)(a.in[20] + col), g1v = *(const f32x4*)(a.in[20] + col + 4), b0v = *(const f32x4*)(a.in[21] + col), b1v = *(const f32x4*)(a.in[21] + col + 4); \
              const f32x4 h0 = (z0 - mu_) * rs_ * g0v + b0v, h1 = (z1 - mu_) * rs_ * g1v + b1v; \
              xf[8 * q] = h0.x; xf[8 * q + 1] = h0.y; xf[8 * q + 2] = h0.z; xf[8 * q + 3] = h0.w; xf[8 * q + 4] = h1.x; xf[8 * q + 5] = h1.y; xf[8 * q + 6] = h1.z; xf[8 * q + 7] = h1.w; } } while (0)
__device__ __forceinline__ void ph16_experts(const Frame& F) {
    const Args& a = *F.a;
    const int gw = F.bid * 8 + F.wave, NGW = F.G * 8, lane0 = F.lane();
    const int* EIDX = (const int*)(F.ws + WS_CKV); const float* EG = (const float*)(F.ws + WS_IKW);
    const unsigned char* PUV = (const unsigned char*)(F.ws + WS_WIN);
    for (int t = gw; t < T; t += NGW) {
        int lane_l = lane0; asm volatile("" : "+v"(lane_l)); const int lane = lane_l;
        float* xrow = a.out + (size_t)t * 2048;
        float xf[32];
        const int lq = 32 * lane;
        EX_LOAD_XF();
        const int id0 = EIDX[(size_t)t * 128 + lane], id1 = EIDX[(size_t)t * 128 + 64 + lane];
        const float g0 = EG[(size_t)t * 128 + lane], g1 = EG[(size_t)t * 128 + 64 + lane];
        float y[32];
#pragma unroll
        for (int j = 0; j < 32; ++j) y[j] = 0.f;
        v6u uA[EXR], vA[EXR], uB[EXR], vB[EXR];
        EX_LOAD(uA, vA, id0, 0);
#pragma unroll 1
        for (int e = 0; e < 128; e += 2 * EXR) {
            const int idv = e < 64 ? id0 : id1;
            EX_LOAD(uB, vB, idv, e + EXR);
            EX_USE(uA, vA, e);
            if (e + 2 * EXR < 128) { const int idn = (e + 2 * EXR) < 64 ? id0 : id1; EX_LOAD(uA, vA, idn, e + 2 * EXR); }
            EX_USE(uB, vB, e + EXR);
        }
        float s = 0.f;
#pragma unroll
        for (int j = 0; j < 32; ++j) { y[j] += ALPHA * xf[j]; s += y[j]; }
        const float mu = wave_sum_dpp(s) * (1.0f / 2048.0f); float s2 = 0.f;
#pragma unroll
        for (int j = 0; j < 32; ++j) { y[j] -= mu; s2 += y[j] * y[j]; }
        const float rs = rsqrtf(wave_sum_dpp(s2) * (1.0f / 2048.0f) + 1e-5f);
        const int lofs = lq;
#pragma unroll
        for (int q = 0; q < 8; ++q) { const int col = lofs + 4 * q;
            const f32x4 ga = *(const f32x4*)(a.in[26] + col), ba = *(const f32x4*)(a.in[27] + col);
            f32x4 o; o.x = y[4 * q] * rs * ga.x + ba.x; o.y = y[4 * q + 1] * rs * ga.y + ba.y; o.z = y[4 * q + 2] * rs * ga.z + ba.z; o.w = y[4 * q + 3] * rs * ga.w + ba.w;
            *(f32x4*)(xrow + col) = o; }
    }
}

#define XB_TMO      128
#define XB_XCNT(j)  (256  + 64 * (j))
#define XB_XSUB(j)  (1280 + 64 * (j))
#define XB_XGEN(j)  (2304 + 64 * (j))
#define XB_TOP      3328
#define XB_TOPGEN   3392
#define XCD_BAR_WORDS 3456
#define XB_SPIN_CAP (1u << 22)
__device__ __forceinline__ unsigned xb_ld(unsigned* p)              { return __hip_atomic_load(p, __ATOMIC_RELAXED, __HIP_MEMORY_SCOPE_AGENT); }
__device__ __forceinline__ unsigned xb_add(unsigned* p, unsigned v) { return __hip_atomic_fetch_add(p, v, __ATOMIC_RELAXED, __HIP_MEMORY_SCOPE_AGENT); }
__device__ __forceinline__ unsigned xb_xcc_id() { return (unsigned)__builtin_amdgcn_s_getreg((3 << 11) | 20) & 0xFu; }
#define XB_SPIN(cond, bar) do { unsigned _sp = 0; while (cond) { __builtin_amdgcn_s_sleep(1); \
    if ((++_sp & 255u) == 0u) { if (xb_ld(&(bar)[XB_TMO])) break; if (_sp > XB_SPIN_CAP) { atomicAdd(&(bar)[XB_TMO], 1u); break; } } } } while (0)
struct XcdBarrier { unsigned* bar; unsigned x; volatile unsigned* st; };
__device__ __forceinline__ void xcd_barrier_complete(unsigned* bar, unsigned x, unsigned G, unsigned& nloc, unsigned& nx) {
    unsigned sum, cnt, mine, sp = 0u;
    for (;;) {
        sum = 0u; cnt = 0u; mine = 0u;
#pragma unroll
        for (unsigned j = 0; j < 16; ++j) { const unsigned c = xb_ld(&bar[XB_XCNT(j)]); sum += c; cnt += (c > 0u) ? 1u : 0u; mine = (j == x) ? c : mine; }
        if (sum == G) break;
        __builtin_amdgcn_s_sleep(1);
        if ((++sp & 255u) == 0u) { if (xb_ld(&bar[XB_TMO])) break; if (sp > XB_SPIN_CAP) { atomicAdd(&bar[XB_TMO], 1u); break; } }
    }
    nloc = mine > 0u ? mine : 1u; nx = cnt > 0u ? cnt : 1u;
}
__device__ __forceinline__ void xcd_barrier(const XcdBarrier& b, bool leader, unsigned G) {
    asm volatile("s_waitcnt vmcnt(0)" ::: "memory");
    __syncthreads();
    if (leader) {
        unsigned* bar = b.bar;
        __builtin_amdgcn_s_waitcnt(0);
        unsigned nloc = b.st[0], nx = b.st[1];
        if (nloc == 0u) { xcd_barrier_complete(bar, b.x, G, nloc, nx); b.st[0] = nloc; b.st[1] = nx; }
        const unsigned old = xb_add(&bar[XB_XSUB(b.x)], 1u);
        const unsigned gen = old / nloc;
        if (old + 1u == (gen + 1u) * nloc) {
            __builtin_amdgcn_fence(__ATOMIC_RELEASE, "agent");
            asm volatile("s_waitcnt vmcnt(0)" ::: "memory");
            const unsigned og = xb_add(&bar[XB_TOP], 1u);
            const unsigned tg = og / nx;
            if (og + 1u == (tg + 1u) * nx) xb_add(&bar[XB_TOPGEN], 1u);
            else XB_SPIN(xb_ld(&bar[XB_TOPGEN]) == tg, bar);
            __builtin_amdgcn_fence(__ATOMIC_ACQUIRE, "agent");
            xb_add(&bar[XB_XGEN(b.x)], 1u);
            asm volatile("s_waitcnt vmcnt(0)" ::: "memory");
        } else {
            XB_SPIN(xb_ld(&bar[XB_XGEN(b.x)]) == gen, bar);
            __builtin_amdgcn_fence(__ATOMIC_ACQUIRE, "agent");
            asm volatile("s_waitcnt vmcnt(0)" ::: "memory");
        }
    }
    __syncthreads();
}

__device__ __forceinline__ void sub_barrier(unsigned* ctr, unsigned n, bool leader) {
    asm volatile("s_waitcnt vmcnt(0)" ::: "memory");
    __syncthreads();
    if (leader) {
        __builtin_amdgcn_fence(__ATOMIC_RELEASE, "agent");
        asm volatile("s_waitcnt vmcnt(0)" ::: "memory");
        (void)xb_add(ctr, 1u);
        unsigned sp = 0u; while (xb_ld(ctr) < n) { __builtin_amdgcn_s_sleep(1); if (++sp > XB_SPIN_CAP) break; }
        __builtin_amdgcn_fence(__ATOMIC_ACQUIRE, "agent");
        asm volatile("s_waitcnt vmcnt(0)" ::: "memory");
    }
    __syncthreads();
}

__global__ void __launch_bounds__(512, 2) mega(Args args) {
    extern __shared__ __attribute__((aligned(16))) unsigned char lds[];
    cg::grid_group grid = cg::this_grid();
    Frame F;
    F.lds = lds; F.wave = __builtin_amdgcn_readfirstlane(threadIdx.x >> 6); F.bid = blockIdx.x; F.G = gridDim.x;
    F.a = &args; F.ws = args.ws;
    const int lo = args.ph_lo, hi = args.ph_hi;
    unsigned long long sec_acc = 0ull;
    if (lo < 0) grid.sync();
    volatile unsigned* xst = (volatile unsigned*)(lds + LDS_BYTES - 64);
    const bool leader = (F.wave == 0) && (fresh_lane() == 0);
    if (leader) { xst[0] = 0u; xst[1] = 0u; }
    XcdBarrier xbar; xbar.bar = (unsigned*)(F.ws + WS_CTL + CTL_BAR); xbar.x = xb_xcc_id(); xbar.st = xst;
    if (leader) (void)xb_add(&xbar.bar[XB_XCNT(xbar.x)], 1u);
    __syncthreads();
    bf16* W8 = (bf16*)((unsigned char*)args.out + (size_t)64 * MiB);
#define IN(k) (lo <= (k) && (k) < hi)
#if PROBE_MASK
    unsigned long long pr_acc = 0ull, pr_t0 = rt_now();
#define SEAM(k) do { if (IN(k) && IN((k) + 1)) { xcd_barrier(xbar, (F.wave == 0) && (fresh_lane() == 0), (unsigned)F.G); } { const unsigned long long t1_ = rt_now(); if ((PROBE_MASK >> (k)) & 1u) pr_acc += t1_ - pr_t0; pr_t0 = t1_; } } while (0)
#else
#define SEAM(k) do { if (IN(k) && IN((k) + 1)) { xcd_barrier(xbar, (F.wave == 0) && (fresh_lane() == 0), (unsigned)F.G); } } while (0)
#endif
    if (IN(0)) { ph0_prologue(F); } SEAM(0);
    if (IN(1)) {
        pg8::MultiOrder<3> S; S.lda = 2048; S.ldb = 2048; S.G = F.G; S.c = F.bid;
        S.s[0] = pg8::Sub{(const bf16*)args.out, (const bf16*)(F.ws + WS_WIN), 64, NCOLS / 256};
        S.s[1] = pg8::Sub{(const bf16*)(F.ws + WS_MEMB), W8 + (size_t)4 * 2048 * 2048, 8, 8};
        S.s[2] = pg8::Sub{W8 + (size_t)5 * 2048 * 2048, (const bf16*)(F.ws + WS_MEMB), 8, 8};
        gemm_multi<3>(F, S, 2048, OpProjCKV{F.ws});
        w8_transposes(F, W8);
    } SEAM(1);
    if (IN(2)) {
        if (F.G == 256) {
            if (F.bid < 128) { hgrn_chunked(F, F.bid, sec_acc);
                cvt_fp6_stream(F, args.in[24], F.ws + WS_WIN, (size_t)16384, PU_SCALE, F.bid, 128); cvt_fp6_stream(F, args.in[25], F.ws + WS_WIN + 1536, (size_t)16384, PV_SCALE, F.bid, 128); }
            else { ph2_side(F, F.bid - 128, 128); sub_barrier((unsigned*)(F.ws + WS_CTL + CTL_BAR) + 3520, 128u, (F.wave == 0) && (fresh_lane() == 0)); ph5_select(F, F.bid - 128, 128); }
        } else {
            for (int u = F.bid; u < 128; u += F.G) hgrn_chunked(F, u, sec_acc);
            ph2_side(F, F.bid, F.G);
            xcd_barrier(xbar, (F.wave == 0) && (fresh_lane() == 0), (unsigned)F.G);
            ph5_select(F, F.bid, F.G);
            cvt_fp6_stream(F, args.in[24], F.ws + WS_WIN, (size_t)16384, PU_SCALE, F.bid, F.G); cvt_fp6_stream(F, args.in[25], F.ws + WS_WIN + 1536, (size_t)16384, PV_SCALE, F.bid, F.G);
        }
    } SEAM(2);
    if (IN(4)) {
        gemm(F, (const bf16*)(F.ws + WS_CKV), 256, (const bf16*)(F.ws + WS_WKV), 256, T, 4096, 256, OpSplit2{F.slot(1), F.slot(2)});
    } SEAM(4);
    if (IN(6)) { ph6_attn(F); } SEAM(6);
    if (IN(7)) {
        pg8::Gemm g{2048, 4096, 4096}; pg8::MultiOrder<1> S; S.s[0] = pg8::Sub{F.slot(0), W8, 64, 8}; S.lda = 2048; S.ldb = 4096; S.G = F.G; S.c = F.bid; S.A2 = F.slot(3);
        EpiYAB E{F.slot(6), F.slot(7)};
        pg8::gemm_phase<EpiYAB, pg8::MultiOrder<1>, true, true>((PG8_LAS unsigned char*)F.lds, g, S, E, F.wave, F.lane());
    } SEAM(7);
    if (IN(8)) { gemm_epi(F, F.slot(6), 2048, W8 + (size_t)2 * 2048 * 2048, 2048, T, 2048, 2048, EpiMixStats{args.in[0], F.slot(0), (float*)(F.ws + WS_CTL + CTL_ST1)}); } SEAM(8);
    if (IN(10)) { gemm(F, F.slot(0), 2048, W8 + (size_t)3 * 2048 * 2048, 2048, T, 2048, 2048, OpCQKV{F.slot(1), nullptr, nullptr, (float*)(F.ws + WS_CTL + CTL_ST1), (float*)(F.ws + WS_CTL + CTL_CVEC), (float*)(F.ws + WS_CTL + CTL_CVEC) + 2048}); } SEAM(10);
    if (IN(11)) {
        pg8::BatchOrder<OffS> S{F.slot(1), (const bf16*)(F.ws + WS_CK), 8, 1, 32, 2048, 2048, F.G, F.bid, OffS()};
        gemm_batch(F, S, 512, OpLogit{(float*)F.slot(2)});
    } SEAM(11);
    if (IN(12)) { ph_xsoftmax(F, (const float*)F.slot(2), F.slot(3)); } SEAM(12);
    if (IN(13)) {
        pg8::BatchOrder<OffPV> S{F.slot(3), (const bf16*)(F.ws + WS_VT), 8, 2, 32, 1024, 2048, F.G, F.bid, OffPV()};
        gemm_batch(F, S, 256, OpCO{F.slot(4)});
    } SEAM(13);
    if (IN(14)) { gemm_epi(F, F.slot(4), 2048, W8 + (size_t)6 * 2048 * 2048, 2048, T, 2048, 2048, EpiCOStats{F.slot(0), (float*)(F.ws + WS_CTL + CTL_ST1), (float*)(F.ws + WS_CTL + CTL_ST2), args.in[14], args.in[15]}); } SEAM(14);
    if (IN(16)) { gemm(F, F.slot(0), 2048, W8 + (size_t)7 * 2048 * 2048, 2048, T, 2048, 2048, OpPQFold{(float*)F.slot(1), (float*)(F.ws + WS_CTL + CTL_ST2), (float*)(F.ws + WS_CTL + CTL_CVEC) + 4096, (float*)(F.ws + WS_CTL + CTL_CVEC) + 6144}); } SEAM(16);
    if (IN(17)) { ph_peer_select(F); } SEAM(17);
    if (IN(18)) { ph16_experts(F); }
#if PROBE_MASK
    xcd_barrier(xbar, (F.wave == 0) && (fresh_lane() == 0), (unsigned)F.G);
    { const unsigned long long t1_ = rt_now(); if ((PROBE_MASK >> 18) & 1u) pr_acc += t1_ - pr_t0; pr_acc += sec_acc;
      if (F.bid == 0 && threadIdx.x == 0) { const unsigned long long ts_ = rt_now(); while (rt_now() - ts_ < pr_acc) __builtin_amdgcn_s_sleep(8); } }
#endif
#undef IN
#undef SEAM
}

extern "C" void kernel_launch(void* const* d_in, const int* in_sizes, int n_in, void* d_out, int out_size, void* d_ws, size_t ws_size, hipStream_t stream) {
    static int grid = 0;
    if (grid == 0) {
        if (n_in != 28 || out_size != T * D || ws_size < WS_END) { fprintf(stderr, "kernel_launch: unexpected shapes (n_in %d out %d ws %zu)\n", n_in, out_size, ws_size); grid = -1; return; }
        int dev = 0, cus = 0, per_cu = 0;
        hipGetDevice(&dev); hipDeviceGetAttribute(&cus, hipDeviceAttributeMultiprocessorCount, dev);
        hipFuncSetAttribute((const void*)mega, hipFuncAttributeMaxDynamicSharedMemorySize, LDS_BYTES);
        hipOccupancyMaxActiveBlocksPerMultiprocessor(&per_cu, (const void*)mega, 512, LDS_BYTES);
        if (per_cu < 1) { fprintf(stderr, "kernel_launch: occupancy query says %d blocks per CU\n", per_cu); per_cu = 1; }
        (void)hipGetLastError();
        grid = cus;
    }
    if (grid < 0) return;
    (void)hipMemsetAsync((char*)d_ws + WS_CTL, 0, CTL_ZERO, stream);
    Args a{};
    for (int i = 0; i < 28; ++i) a.in[i] = (const float*)d_in[i];
    a.out = (float*)d_out; a.ws = (unsigned char*)d_ws;
#if ONE_LAUNCH
    a.ph_lo = 0; a.ph_hi = NPH;
    void* params[] = {&a};
    hipError_t e = hipLaunchCooperativeKernel((const void*)mega, dim3(grid), dim3(512), params, LDS_BYTES, stream);
    if (e != hipSuccess) fprintf(stderr, "cooperative launch failed: %s\n", hipGetErrorString(e));
#else
    for (int ph = 0; ph < NPH; ++ph) {
        a.ph_lo = ph; a.ph_hi = ph + 1;
        void* params[] = {&a};
        hipError_t e = hipLaunchCooperativeKernel((const void*)mega, dim3(grid), dim3(512), params, LDS_BYTES, stream);
        if (e != hipSuccess) { fprintf(stderr, "launch %d failed: %s\n", ph, hipGetErrorString(e)); break; }
    }
#endif
}
```

```cpp
#include <hip/hip_runtime.h>
#include <hip/hip_cooperative_groups.h>
#include <cstdint>
#include <cmath>
#include <cstdio>
namespace cg = cooperative_groups;

#ifndef ONE_LAUNCH
#define ONE_LAUNCH 1
#endif
#ifndef PROBE_MASK
#define PROBE_MASK 0u
#endif
#ifndef PROBE_SEC
#define PROBE_SEC 0
#endif

typedef unsigned short bf16;
typedef short bf16x8 __attribute__((ext_vector_type(8)));
typedef float f32x4 __attribute__((ext_vector_type(4)));
typedef float f32x16 __attribute__((ext_vector_type(16)));
typedef unsigned u32x4 __attribute__((ext_vector_type(4)));
typedef unsigned u32x2 __attribute__((ext_vector_type(2)));
typedef float f32x2v __attribute__((ext_vector_type(2)));

constexpr int T = 16384, D = 2048, SEQ = 2048, NB = 8;
constexpr int NCOLS = 16896;
constexpr float ALPHA = 1.189207115002721f;
constexpr int NPH = 19;

constexpr size_t MiB = 1u << 20;
constexpr size_t WS_CTL = 0, WS_MEMB = 1 * MiB, WS_WKV = 9 * MiB, WS_LB = 11 * MiB, WS_MASK = 12 * MiB, WS_WIN = 17 * MiB,
                 WS_SLOT = 83 * MiB, SLOT_BYTES = 64 * MiB, WS_CKV = 595 * MiB, WS_IKW = 603 * MiB, WS_CK = 611 * MiB, WS_VT = 619 * MiB, WS_END = 627 * MiB;
constexpr int LDS_BYTES = 157696;
constexpr size_t CTL_BAR = 16384, CTL_CVEC = 65536, CTL_ST1 = 262144, CTL_ST2 = 393216, CTL_ZERO = 524288;

struct Args {
    const float* in[28];
    float* out;
    unsigned char* ws;
    int ph_lo, ph_hi;
};

#define WAVE_SYNC() asm volatile("s_waitcnt lgkmcnt(0)" ::: "memory")

__device__ __forceinline__ unsigned f2bf(float f) { unsigned u = __float_as_uint(f); return (u + 0x7fffu + ((u >> 16) & 1u)) >> 16; }
__device__ __forceinline__ unsigned pk2(float lo, float hi) { return f2bf(lo) | (f2bf(hi) << 16); }
__device__ __forceinline__ float bf2f(unsigned h) { return __uint_as_float(h << 16); }
__device__ __forceinline__ float bflo(unsigned w) { return __uint_as_float(w << 16); }
__device__ __forceinline__ float bfhi(unsigned w) { return __uint_as_float(w & 0xffff0000u); }
__device__ __forceinline__ float wave_sum(float v) {
#pragma unroll
    for (int o = 32; o >= 1; o >>= 1) v += __shfl_xor(v, o);
    return v;
}
__device__ __forceinline__ float wave_max(float v) {
#pragma unroll
    for (int o = 32; o >= 1; o >>= 1) v = fmaxf(v, __shfl_xor(v, o));
    return v;
}
__device__ __forceinline__ float row16_sum(float v) {
    v += __int_as_float(__builtin_amdgcn_mov_dpp(__float_as_int(v), 0xB1, 0xF, 0xF, false));
    v += __int_as_float(__builtin_amdgcn_mov_dpp(__float_as_int(v), 0x4E, 0xF, 0xF, false));
    v += __int_as_float(__builtin_amdgcn_mov_dpp(__float_as_int(v), 0x124, 0xF, 0xF, false));
    v += __int_as_float(__builtin_amdgcn_mov_dpp(__float_as_int(v), 0x128, 0xF, 0xF, false));
    return v;
}
__device__ __forceinline__ float wave_sum_dpp(float v) {
    v = row16_sum(v);
    return (__int_as_float(__builtin_amdgcn_readlane(__float_as_int(v), 0)) + __int_as_float(__builtin_amdgcn_readlane(__float_as_int(v), 16)))
         + (__int_as_float(__builtin_amdgcn_readlane(__float_as_int(v), 32)) + __int_as_float(__builtin_amdgcn_readlane(__float_as_int(v), 48)));
}
__device__ __forceinline__ float sigm(float x) { return 1.0f / (1.0f + expf(-x)); }
__device__ __forceinline__ void unpack8(u32x4 w, float* f) {
    f[0] = bflo(w.x); f[1] = bfhi(w.x); f[2] = bflo(w.y); f[3] = bfhi(w.y); f[4] = bflo(w.z); f[5] = bfhi(w.z); f[6] = bflo(w.w); f[7] = bfhi(w.w);
}

__device__ __forceinline__ int fresh_lane() { int l; asm volatile("v_mbcnt_lo_u32_b32 %0, -1, 0\n\tv_mbcnt_hi_u32_b32 %0, -1, %0" : "=v"(l)); return l; }
__device__ __forceinline__ unsigned long long rt_now() { unsigned long long t; asm volatile("s_memrealtime %0\n\ts_waitcnt lgkmcnt(0)" : "=s"(t) :: "memory"); return t; }
struct Frame {
    unsigned char* lds;
    int wave, bid, G;
    __device__ __forceinline__ int lane() const { return fresh_lane(); }
    const Args* a;
    unsigned char* ws;
    __device__ __forceinline__ bf16* slot(int i) const { return (bf16*)(ws + WS_SLOT + (size_t)i * SLOT_BYTES); }
};

namespace pg8 {
#define PG8_LAS __attribute__((address_space(3)))
constexpr int BM = 256, BK = 64, HALF = 128, HTB = HALF * BK * 2, STAGE_BYTES = 8 * HTB, NXCD = 8, WGM = 8;
__host__ __device__ __forceinline__ int lds_byte(int r, int c) { const int st = (r >> 4) * 2 + (c >> 5), rr = r & 15, cc = c & 31, ob = rr * 64 + cc * 2; return st * 1024 + (ob ^ (((ob >> 9) & 1) << 5)); }
__host__ __device__ __forceinline__ void stage_rc(int b, int& R, int& C) { const int st = b / 1024, sb = b % 1024, swz = sb ^ (((sb >> 9) & 1) << 5); R = (st >> 1) * 16 + swz / 64; C = (st & 1) * 32 + (swz % 64) / 2; }
__host__ __device__ __forceinline__ int perm32(int rho) { const int n = rho >> 4, i = rho & 15; return 8 * (i >> 2) + 4 * n + (i & 3); }
struct Unit { int pm, pn, z; const char* a; const char* b; const char* a2; };
struct Gemm { int lda, ldb, K; };
__device__ __forceinline__ void tile_of(int wgid, int nM, int nN, int& pm, int& pn) {
    const int nwg = nM * nN; { const int q = nwg / NXCD, r = nwg % NXCD, xcd = wgid % NXCD, off = wgid / NXCD; wgid = (xcd < r ? xcd * (q + 1) : r * (q + 1) + (xcd - r) * q) + off; }
    const int nig = WGM * nN, gid = wgid / nig, fm = gid * WGM, gsz = (nM - fm) < WGM ? (nM - fm) : WGM;
    pm = fm + ((wgid % nig) % gsz); pn = (wgid % nig) / gsz;
}
struct Sub { const bf16* A; const bf16* Bt; int nM, nN; };
template <int NS> struct MultiOrder {
    Sub s[NS]; int lda, ldb, G, c; const bf16* A2 = nullptr;
    __device__ __forceinline__ bool next(int i, Unit& u) const {
        int L = i * G + c;
#pragma unroll
        for (int k = 0; k < NS; ++k) { const int n = s[k].nM * s[k].nN;
            if (L < n) { tile_of(L, s[k].nM, s[k].nN, u.pm, u.pn); u.z = k; u.a = (const char*)(s[k].A + (size_t)u.pm * BM * lda); u.b = (const char*)(s[k].Bt + (size_t)u.pn * BM * ldb); u.a2 = A2 ? (const char*)(A2 + (size_t)u.pm * BM * lda) : nullptr; return true; }
            L -= n; }
        return false;
    }
};
template <class Off> struct BatchOrder {
    const bf16* A; const bf16* Bt; int nM, nN, nz, lda, ldb, G, c; Off off;
    __device__ __forceinline__ bool next(int i, Unit& u) const {
        const int L = i * G + c, per = nM * nN; if (L >= per * nz) return false;
        u.z = L / per; const int r = L % per; u.pn = r / nM; u.pm = r % nM;
        u.a = (const char*)(A + off.a(u.z) + (size_t)u.pm * BM * lda); u.b = (const char*)(Bt + off.b(u.z) + (size_t)u.pn * BM * ldb); u.a2 = nullptr; return true;
    }
};
__device__ __forceinline__ unsigned cvt_pk_bf16(float lo, float hi) { unsigned r; asm volatile("v_cvt_pk_bf16_f32 %0, %1, %2" : "=v"(r) : "v"(lo), "v"(hi)); return r; }

template <class Op> struct Epi8 {
    static constexpr bool PERM = true;
    Op op;
    __device__ __forceinline__ void operator()(const f32x4 (&acc)[2][2][4][2], const Unit& u, int wr, int wc, int fr, int fq) const {
        const int row0 = u.pm * BM + wr * 64 + fr, col0 = u.pn * BM + wc * 32 + 8 * fq;
        if constexpr (Op::NLD == 0) {
#pragma unroll
            for (int ai = 0; ai < 2; ++ai)
#pragma unroll
                for (int m = 0; m < 4; ++m)
#pragma unroll
                    for (int bj = 0; bj < 2; ++bj) op(u.z, row0 + ai * HALF + m * 16, col0 + bj * HALF, acc[ai][bj][m][0], acc[ai][bj][m][1]);
        } else {
#pragma unroll
            for (int ai = 0; ai < 2; ++ai) {
                u32x4 tmp[4][2][Op::NLD];
#pragma unroll
                for (int m = 0; m < 4; ++m)
#pragma unroll
                    for (int bj = 0; bj < 2; ++bj) op.ld(u.z, row0 + ai * HALF + m * 16, col0 + bj * HALF, tmp[m][bj]);
#pragma unroll
                for (int m = 0; m < 4; ++m)
#pragma unroll
                    for (int bj = 0; bj < 2; ++bj) op.ap(u.z, row0 + ai * HALF + m * 16, col0 + bj * HALF, acc[ai][bj][m][0], acc[ai][bj][m][1], tmp[m][bj]);
            }
        }
    }
};

template <class Epi, class Sched, bool ALIGN_EPI, bool SPLIT = false, bool AFTER_DRAIN = false>
__device__ __forceinline__ void gemm_phase(PG8_LAS unsigned char* lds, const Gemm g, const Sched& S, const Epi& E, int wid, int lane) {
    const int tid = wid * 64 + lane, wr = wid >> 2, wc = wid & 3, fr = lane & 15, fq = lane >> 4;
    const int K = g.K, nt = K / BK;
    unsigned voffA[2], voffB[2];
#pragma unroll
    for (int i = 0; i < 2; ++i) { int R, C; stage_rc(tid * 16 + i * 8192, R, C); const int Rb = Epi::PERM ? ((R & ~31) + perm32(R & 31)) : R;
        voffA[i] = (unsigned)(R * g.lda + C) * 2u; voffB[i] = (unsigned)(Rb * g.ldb + C) * 2u; }
    const size_t kstep = (size_t)(BK * 2);
    const size_t hstepA = (size_t)HALF * g.lda * 2, hstepB = (size_t)HALF * g.ldb * 2;
    const unsigned ldsw = (unsigned)wid * 1024u;
    const int aoff = lds_byte(wr * 64 + fr, fq * 8), boff = lds_byte(wc * 32 + fr, fq * 8);
#define PG8_SA(b, h) (((b) * 2 + (h)) * HTB)
#define PG8_SB(b, h) ((4 + (b) * 2 + (h)) * HTB)
#define PG8_STAGE(bufoff, gbase, voff) do { _Pragma("unroll") for (int _i = 0; _i < 2; ++_i) \
        __builtin_amdgcn_global_load_lds((const unsigned*)((const char*)(gbase) + (voff)[_i]), (PG8_LAS unsigned*)(lds + (bufoff) + ldsw + _i * 8192), 16, 0, 0); } while (0)
#define PG8_LDA(dst, b, h) do { _Pragma("unroll") for (int m = 0; m < 4; ++m) _Pragma("unroll") for (int k = 0; k < 2; ++k) dst[m][k] = *(const PG8_LAS bf16x8*)(lds + PG8_SA(b, h) + aoff + m * 2048 + k * 1024); } while (0)
#define PG8_LDB(dst, b, h) do { _Pragma("unroll") for (int n = 0; n < 2; ++n) _Pragma("unroll") for (int k = 0; k < 2; ++k) dst[n][k] = *(const PG8_LAS bf16x8*)(lds + PG8_SB(b, h) + boff + n * 2048 + k * 1024); } while (0)
#define PG8_MMA(ai, bj, At, Bt) do { __builtin_amdgcn_s_setprio(1); _Pragma("unroll") for (int m = 0; m < 4; ++m) _Pragma("unroll") for (int n = 0; n < 2; ++n) _Pragma("unroll") for (int k = 0; k < 2; ++k) \
        acc[ai][bj][m][n] = __builtin_amdgcn_mfma_f32_16x16x32_bf16(Bt[n][k], At[m][k], acc[ai][bj][m][n], 0, 0, 0); __builtin_amdgcn_s_setprio(0); } while (0)
#define PG8_WAIT_V(n) asm volatile("s_waitcnt vmcnt(" #n ")" ::: "memory")
#define PG8_WAIT_L(n) asm volatile("s_waitcnt lgkmcnt(" #n ")" ::: "memory")
#define PG8_BAR __builtin_amdgcn_s_barrier()
#define PG8_SCHED __builtin_amdgcn_sched_barrier(0)
    Unit cur, nxt; int ui = 0;
    if (!S.next(0, cur)) return;
    f32x4 acc[2][2][4][2];
#pragma unroll
    for (int a = 0; a < 2; ++a)
#pragma unroll
        for (int b = 0; b < 2; ++b)
#pragma unroll
            for (int m = 0; m < 4; ++m)
#pragma unroll
                for (int n = 0; n < 2; ++n) acc[a][b][m][n] = (f32x4){0.f, 0.f, 0.f, 0.f};
    bf16x8 At[4][2], B0[2][2], B1[2][2];
    const char* cA = cur.a; const char* cB = cur.b;
    const int nth = nt / 2;
    const char* cA2 = SPLIT ? cur.a2 - (size_t)nth * kstep : cA;
    PG8_STAGE(PG8_SB(0, 0), cB, voffB); PG8_STAGE(PG8_SB(0, 1), cB + hstepB, voffB); PG8_STAGE(PG8_SA(0, 0), cA, voffA); PG8_STAGE(PG8_SA(0, 1), cA + hstepA, voffA);
    if (wr == 1) PG8_BAR;
    PG8_WAIT_V(2); PG8_BAR;
    PG8_STAGE(PG8_SB(1, 0), cB + kstep, voffB); PG8_STAGE(PG8_SA(1, 0), cA + kstep, voffA); PG8_STAGE(PG8_SB(1, 1), cB + hstepB + kstep, voffB);
    PG8_WAIT_V(6); PG8_BAR;
    for (;;) {
        const bool has_next = S.next(ui + 1, nxt);
        const char* nA = has_next ? nxt.a : cA; const char* nB = has_next ? nxt.b : cB;
        const char* nA2 = SPLIT ? (has_next ? nxt.a2 - (size_t)nth * kstep : cA2) : nA;
#pragma unroll 1
        for (int half_ = 0; half_ < (SPLIT ? 2 : 1); ++half_) {
        if constexpr (SPLIT) { if (half_ == 1) { __builtin_amdgcn_sched_barrier(0); E.mid(acc, cur, wr, wc, fr, fq); __builtin_amdgcn_sched_barrier(0); } }
        const int t_lo = SPLIT ? half_ * nth : 0, t_hi = SPLIT ? (half_ + 1) * nth : nt;
#pragma unroll 1
        for (int t = t_lo; t < t_hi; t += 2) {
            const bool last = (t == nt - 2);
            const char* bA1 = (!SPLIT || t < nth) ? cA : cA2; const char* bA2 = (!SPLIT || t + 2 < nth) ? cA : cA2;
            const char* a1 = bA1 + (size_t)(t + 1) * kstep;
            const char* a2 = last ? nA : bA2 + (size_t)(t + 2) * kstep; const char* b2 = last ? nB : cB + (size_t)(t + 2) * kstep;
            const char* a3 = a2 + kstep; const char* b3 = b2 + kstep;
            PG8_LDB(B0, 0, 0); PG8_LDB(B1, 0, 1); PG8_SCHED; PG8_LDA(At, 0, 0); PG8_STAGE(PG8_SA(1, 1), a1 + hstepA, voffA);
            PG8_WAIT_V(8); PG8_WAIT_L(0); PG8_BAR; PG8_MMA(0, 0, At, B0); PG8_MMA(0, 1, At, B1); PG8_BAR; PG8_SCHED;
            PG8_LDA(At, 0, 1); PG8_STAGE(PG8_SB(0, 0), b2, voffB); PG8_STAGE(PG8_SB(0, 1), b2 + hstepB, voffB); PG8_STAGE(PG8_SA(0, 0), a2, voffA);
            PG8_WAIT_V(8); PG8_WAIT_L(0); PG8_BAR; PG8_MMA(1, 0, At, B0); PG8_MMA(1, 1, At, B1); PG8_BAR; PG8_SCHED;
            PG8_LDB(B0, 1, 0); PG8_LDB(B1, 1, 1); PG8_SCHED; PG8_LDA(At, 1, 0); PG8_STAGE(PG8_SA(0, 1), a2 + hstepA, voffA);
            PG8_WAIT_V(8); PG8_WAIT_L(0); PG8_BAR; PG8_MMA(0, 0, At, B0); PG8_MMA(0, 1, At, B1); PG8_BAR; PG8_SCHED;
            PG8_LDA(At, 1, 1); PG8_STAGE(PG8_SB(1, 0), b3, voffB); PG8_STAGE(PG8_SB(1, 1), b3 + hstepB, voffB); PG8_STAGE(PG8_SA(1, 0), a3, voffA);
            PG8_WAIT_V(8); PG8_WAIT_L(0); PG8_BAR; PG8_MMA(1, 0, At, B0); PG8_MMA(1, 1, At, B1); PG8_BAR; PG8_SCHED;
        }
        }
        if constexpr (ALIGN_EPI) { if (wr == 0) PG8_BAR; }
        if constexpr (!AFTER_DRAIN) E(acc, cur, wr, wc, fr, fq);
        if (!has_next) break;
#pragma unroll
        for (int a = 0; a < 2; ++a)
#pragma unroll
            for (int b = 0; b < 2; ++b)
#pragma unroll
                for (int m = 0; m < 4; ++m)
#pragma unroll
                    for (int n = 0; n < 2; ++n) acc[a][b][m][n] = (f32x4){0.f, 0.f, 0.f, 0.f};
        cur = nxt; cA = nA; cB = nB; cA2 = nA2; ++ui;
        if constexpr (ALIGN_EPI) { if (wr == 1) PG8_BAR; }
    }
    PG8_WAIT_V(0);
    if constexpr (!ALIGN_EPI) { if (wr == 0) PG8_BAR; }
    PG8_BAR;
    if constexpr (AFTER_DRAIN) E.fused(acc, cur, wr, wc, fr, fq, (unsigned char*)lds);
#undef PG8_SA
#undef PG8_SB
#undef PG8_STAGE
#undef PG8_LDA
#undef PG8_LDB
#undef PG8_MMA
#undef PG8_WAIT_V
#undef PG8_WAIT_L
#undef PG8_BAR
#undef PG8_SCHED
}
}

__device__ __forceinline__ u32x4 pack8(f32x4 a, f32x4 b) { u32x4 w; w.x = pg8::cvt_pk_bf16(a.x, a.y); w.y = pg8::cvt_pk_bf16(a.z, a.w); w.z = pg8::cvt_pk_bf16(b.x, b.y); w.w = pg8::cvt_pk_bf16(b.z, b.w); return w; }
__device__ __forceinline__ void unpack8v(u32x4 w, f32x4& a, f32x4& b) { a.x = bflo(w.x); a.y = bfhi(w.x); a.z = bflo(w.y); a.w = bfhi(w.y); b.x = bflo(w.z); b.y = bfhi(w.z); b.z = bflo(w.w); b.w = bfhi(w.w); }
__device__ __forceinline__ f32x4 sigm4(f32x4 v) { f32x4 r; r.x = sigm(v.x); r.y = sigm(v.y); r.z = sigm(v.z); r.w = sigm(v.w); return r; }

struct OpProj { static constexpr int NLD = 0; unsigned char* ws;
    __device__ __forceinline__ void operator()(int z, int row, int col, f32x4 a, f32x4 b) const {
        bf16* p;
        if (col < 16384) p = (bf16*)(ws + WS_SLOT + (size_t)(col >> 11) * SLOT_BYTES) + (size_t)row * 2048 + (col & 2047);
        else if (col < 16640) p = (bf16*)(ws + WS_CKV) + (size_t)row * 256 + (col - 16384);
        else p = (bf16*)(ws + WS_IKW) + (size_t)row * 256 + (col - 16640);
        *(u32x4*)p = pack8(a, b);
    } };
struct OpProjCKV { static constexpr int NLD = 0; unsigned char* ws;
    __device__ __forceinline__ void operator()(int z, int row, int col, f32x4 a, f32x4 b) const {
        bf16* p;
        if (z == 0) { if (col < 16384) p = (bf16*)(ws + WS_SLOT + (size_t)(col >> 11) * SLOT_BYTES) + (size_t)row * 2048 + (col & 2047);
                      else if (col < 16640) p = (bf16*)(ws + WS_CKV) + (size_t)row * 256 + (col - 16384);
                      else p = (bf16*)(ws + WS_IKW) + (size_t)row * 256 + (col - 16640); }
        else p = (bf16*)(ws + (z == 1 ? WS_CK : WS_VT)) + (size_t)row * 2048 + col;
        *(u32x4*)p = pack8(a, b);
    } };
struct OpBf16 { static constexpr int NLD = 0; bf16* o; int ld;
    __device__ __forceinline__ void operator()(int z, int row, int col, f32x4 a, f32x4 b) const { *(u32x4*)(o + (size_t)row * ld + col) = pack8(a, b); } };
struct OpSplit2 { static constexpr int NLD = 0; bf16* o0; bf16* o1;
    __device__ __forceinline__ void operator()(int z, int row, int col, f32x4 a, f32x4 b) const { bf16* p = (col < 2048 ? o0 : o1) + (size_t)row * 2048 + (col & 2047); *(u32x4*)p = pack8(a, b); } };
struct OpF32 { static constexpr int NLD = 0; float* o; int ld;
    __device__ __forceinline__ void operator()(int z, int row, int col, f32x4 a, f32x4 b) const { float* p = o + (size_t)row * ld + col; *(f32x4*)p = a; *(f32x4*)(p + 4) = b; } };
struct OpYA { static constexpr int NLD = 1; bf16* ga;
    __device__ __forceinline__ void ld(int zi, int row, int col, u32x4* t) const { t[0] = *(const u32x4*)(ga + (size_t)row * 2048 + col); }
    __device__ __forceinline__ void ap(int zi, int row, int col, f32x4 a, f32x4 b, const u32x4* t) const { f32x4 g0, g1; unpack8v(t[0], g0, g1); *(u32x4*)(ga + (size_t)row * 2048 + col) = pack8(sigm4(g0) * a, sigm4(g1) * b); } };
struct OpYB { static constexpr int NLD = 2; bf16* ga; const bf16* gb;
    __device__ __forceinline__ void ld(int zi, int row, int col, u32x4* t) const { const size_t i = (size_t)row * 2048 + col; t[0] = *(const u32x4*)(ga + i); t[1] = *(const u32x4*)(gb + i); }
    __device__ __forceinline__ void ap(int zi, int row, int col, f32x4 a, f32x4 b, const u32x4* t) const { f32x4 m0, m1, g0, g1; unpack8v(t[0], m0, m1); unpack8v(t[1], g0, g1);
        *(u32x4*)(ga + (size_t)row * 2048 + col) = pack8(m0 + sigm4(g0) * a, m1 + sigm4(g1) * b); } };
struct OpMix { static constexpr int NLD = 2; const float* x; float* zo;
    __device__ __forceinline__ void ld(int zi, int row, int col, u32x4* t) const { const size_t i = (size_t)row * 2048 + col; t[0] = *(const u32x4*)(x + i); t[1] = *(const u32x4*)(x + i + 4); }
    __device__ __forceinline__ void ap(int zi, int row, int col, f32x4 a, f32x4 b, const u32x4* t) const { const size_t i = (size_t)row * 2048 + col;
        *(f32x4*)(zo + i) = ALPHA * __builtin_bit_cast(f32x4, t[0]) + a; *(f32x4*)(zo + i + 4) = ALPHA * __builtin_bit_cast(f32x4, t[1]) + b; } };
struct OpRes { static constexpr int NLD = 2; float* zo;
    __device__ __forceinline__ void ld(int zi, int row, int col, u32x4* t) const { const size_t i = (size_t)row * 2048 + col; t[0] = *(const u32x4*)(zo + i); t[1] = *(const u32x4*)(zo + i + 4); }
    __device__ __forceinline__ void ap(int zi, int row, int col, f32x4 a, f32x4 b, const u32x4* t) const { const size_t i = (size_t)row * 2048 + col;
        *(f32x4*)(zo + i) = ALPHA * __builtin_bit_cast(f32x4, t[0]) + a; *(f32x4*)(zo + i + 4) = ALPHA * __builtin_bit_cast(f32x4, t[1]) + b; } };

__device__ __forceinline__ void row_stats_add(float* st, int row, float s1, float s2, int fq) {
    s1 += __shfl_xor(s1, 16); s1 += __shfl_xor(s1, 32); s2 += __shfl_xor(s2, 16); s2 += __shfl_xor(s2, 32);
    if (fq == 0) { atomicAdd(st + 2 * (size_t)row, s1); atomicAdd(st + 2 * (size_t)row + 1, s2); }
}
__device__ __forceinline__ void row_mu_rstd(const float* st, int row, float& mu, float& rstd) {
    const f32x2v p = *(const f32x2v*)(st + 2 * (size_t)row); mu = p.x * (1.0f / 2048.0f); rstd = rsqrtf(fmaxf(p.y * (1.0f / 2048.0f) - mu * mu, 0.f) + 1e-5f);
}
__device__ __forceinline__ float sum8(f32x4 a, f32x4 b) { return ((a.x + a.y) + (a.z + a.w)) + ((b.x + b.y) + (b.z + b.w)); }
__device__ __forceinline__ float sq8(f32x4 a, f32x4 b) { return ((a.x * a.x + a.y * a.y) + (a.z * a.z + a.w * a.w)) + ((b.x * b.x + b.y * b.y) + (b.z * b.z + b.w * b.w)); }
struct EpiMixStats { static constexpr bool PERM = true; const float* x; bf16* zb; float* st;
    __device__ __forceinline__ void operator()(const f32x4 (&acc)[2][2][4][2], const pg8::Unit& u, int wr, int wc, int fr, int fq) const {
        const int row0 = u.pm * 256 + wr * 64 + fr, col0 = u.pn * 256 + wc * 32 + 8 * fq;
#pragma unroll
        for (int ai = 0; ai < 2; ++ai) {
            f32x4 xv[4][2][2];
#pragma unroll
            for (int m = 0; m < 4; ++m)
#pragma unroll
                for (int bj = 0; bj < 2; ++bj) { const float* p = x + (size_t)(row0 + ai * 128 + m * 16) * 2048 + col0 + bj * 128; xv[m][bj][0] = *(const f32x4*)p; xv[m][bj][1] = *(const f32x4*)(p + 4); }
#pragma unroll
            for (int m = 0; m < 4; ++m) { const int row = row0 + ai * 128 + m * 16; float s1 = 0.f, s2 = 0.f;
#pragma unroll
                for (int bj = 0; bj < 2; ++bj) { const f32x4 z0 = ALPHA * xv[m][bj][0] + acc[ai][bj][m][0], z1 = ALPHA * xv[m][bj][1] + acc[ai][bj][m][1];
                    *(u32x4*)(zb + (size_t)row * 2048 + col0 + bj * 128) = pack8(z0, z1); s1 += sum8(z0, z1); s2 += sq8(z0, z1); }
                row_stats_add(st, row, s1, s2, fq); }
        }
    }
};
struct EpiCOStats { static constexpr bool PERM = true; bf16* zb; const float* st1; float* st2; const float* g; const float* bta;
    __device__ __forceinline__ void operator()(const f32x4 (&acc)[2][2][4][2], const pg8::Unit& u, int wr, int wc, int fr, int fq) const {
        const int row0 = u.pm * 256 + wr * 64 + fr, col0 = u.pn * 256 + wc * 32 + 8 * fq;
        f32x4 gv[2][2], bv[2][2];
#pragma unroll
        for (int bj = 0; bj < 2; ++bj) { gv[bj][0] = *(const f32x4*)(g + col0 + bj * 128); gv[bj][1] = *(const f32x4*)(g + col0 + bj * 128 + 4); bv[bj][0] = *(const f32x4*)(bta + col0 + bj * 128); bv[bj][1] = *(const f32x4*)(bta + col0 + bj * 128 + 4); }
#pragma unroll
        for (int ai = 0; ai < 2; ++ai) {
            u32x4 zv[4][2]; float mu[4], rs[4];
#pragma unroll
            for (int m = 0; m < 4; ++m) { const int row = row0 + ai * 128 + m * 16; row_mu_rstd(st1, row, mu[m], rs[m]);
#pragma unroll
                for (int bj = 0; bj < 2; ++bj) zv[m][bj] = *(const u32x4*)(zb + (size_t)row * 2048 + col0 + bj * 128); }
#pragma unroll
            for (int m = 0; m < 4; ++m) { const int row = row0 + ai * 128 + m * 16; float s1 = 0.f, s2 = 0.f;
#pragma unroll
                for (int bj = 0; bj < 2; ++bj) { f32x4 a0, a1; unpack8v(zv[m][bj], a0, a1);
                    const f32x4 z0 = ALPHA * ((a0 - mu[m]) * rs[m] * gv[bj][0] + bv[bj][0]) + acc[ai][bj][m][0], z1 = ALPHA * ((a1 - mu[m]) * rs[m] * gv[bj][1] + bv[bj][1]) + acc[ai][bj][m][1];
                    *(u32x4*)(zb + (size_t)row * 2048 + col0 + bj * 128) = pack8(z0, z1); s1 += sum8(z0, z1); s2 += sq8(z0, z1); }
                row_stats_add(st2, row, s1, s2, fq); }
        }
    }
};
struct EpiYAB { static constexpr bool PERM = true; bf16* ga; const bf16* gb;
    __device__ __forceinline__ void mid(f32x4 (&acc)[2][2][4][2], const pg8::Unit& u, int wr, int wc, int fr, int fq) const {
        int lofs = (wr * 64 + fr) * 2048 + wc * 32 + 8 * fq; asm volatile("" : "+v"(lofs));
        const size_t ub = ((size_t)u.pm * 256) * 2048 + u.pn * 256;
#pragma unroll
        for (int ai = 0; ai < 2; ++ai)
#pragma unroll
            for (int m = 0; m < 4; ++m) { u32x4 av[2], bv[2];
#pragma unroll
                for (int bj = 0; bj < 2; ++bj) { const size_t i = ub + (size_t)(lofs + (ai * 128 + m * 16) * 2048 + bj * 128); av[bj] = *(const u32x4*)(ga + i); bv[bj] = *(const u32x4*)(gb + i); }
#pragma unroll
                for (int bj = 0; bj < 2; ++bj) { f32x4 a0, a1, b0, b1; unpack8v(av[bj], a0, a1); unpack8v(bv[bj], b0, b1);
#pragma unroll
                    for (int e = 0; e < 4; ++e) { acc[ai][bj][m][0][e] *= (1.0f + __expf(-b0[e])) * __builtin_amdgcn_rcpf(1.0f + __expf(-a0[e])); acc[ai][bj][m][1][e] *= (1.0f + __expf(-b1[e])) * __builtin_amdgcn_rcpf(1.0f + __expf(-a1[e])); } } }
    }
    __device__ __forceinline__ void operator()(const f32x4 (&acc)[2][2][4][2], const pg8::Unit& u, int wr, int wc, int fr, int fq) const {
        int lofs = (wr * 64 + fr) * 2048 + wc * 32 + 8 * fq; asm volatile("" : "+v"(lofs));
        const size_t ub = ((size_t)u.pm * 256) * 2048 + u.pn * 256;
#pragma unroll
        for (int ai = 0; ai < 2; ++ai) { u32x4 bv[4][2];
#pragma unroll
            for (int m = 0; m < 4; ++m)
#pragma unroll
                for (int bj = 0; bj < 2; ++bj) bv[m][bj] = *(const u32x4*)(gb + ub + (size_t)(lofs + (ai * 128 + m * 16) * 2048 + bj * 128));
#pragma unroll
            for (int m = 0; m < 4; ++m)
#pragma unroll
                for (int bj = 0; bj < 2; ++bj) { f32x4 b0, b1; unpack8v(bv[m][bj], b0, b1); f32x4 s0, s1;
#pragma unroll
                    for (int e = 0; e < 4; ++e) { s0[e] = __builtin_amdgcn_rcpf(1.0f + __expf(-b0[e])); s1[e] = __builtin_amdgcn_rcpf(1.0f + __expf(-b1[e])); }
                    *(u32x4*)(ga + ub + (size_t)(lofs + (ai * 128 + m * 16) * 2048 + bj * 128)) = pack8(acc[ai][bj][m][0] * s0, acc[ai][bj][m][1] * s1); } }
    }
};
__device__ __forceinline__ void ln_fold8(const float* st, const float* c1, const float* c0, int row, int col, f32x4& a, f32x4& b) {
    float mu, rs; row_mu_rstd(st, row, mu, rs);
    const f32x4 p0 = *(const f32x4*)(c1 + col), p1 = *(const f32x4*)(c1 + col + 4), q0 = *(const f32x4*)(c0 + col), q1 = *(const f32x4*)(c0 + col + 4);
    a = (a - mu * p0) * rs + q0; b = (b - mu * p1) * rs + q1;
}
struct OpPQFold { static constexpr int NLD = 0; float* o; const float* st; const float* c1; const float* c0;
    __device__ __forceinline__ void operator()(int zi, int row, int col, f32x4 a, f32x4 b) const { ln_fold8(st, c1, c0, row, col, a, b); float* p = o + (size_t)row * 2048 + col; *(f32x4*)p = a; *(f32x4*)(p + 4) = b; } };

template <class Op>
__device__ __forceinline__ void gemm(const Frame& F, const bf16* A, int lda, const bf16* Bt, int ldb, int M, int N, int K, const Op& op) {
    pg8::Gemm g{lda, ldb, K}; pg8::MultiOrder<1> S; S.s[0] = pg8::Sub{A, Bt, M / 256, N / 256}; S.lda = lda; S.ldb = ldb; S.G = F.G; S.c = F.bid;
    pg8::Epi8<Op> E{op};
    pg8::gemm_phase<pg8::Epi8<Op>, pg8::MultiOrder<1>, true>((PG8_LAS unsigned char*)F.lds, g, S, E, F.wave, F.lane());
}
template <class Epi>
__device__ __forceinline__ void gemm_epi(const Frame& F, const bf16* A, int lda, const bf16* Bt, int ldb, int M, int N, int K, const Epi& E) {
    pg8::Gemm g{lda, ldb, K}; pg8::MultiOrder<1> S; S.s[0] = pg8::Sub{A, Bt, M / 256, N / 256}; S.lda = lda; S.ldb = ldb; S.G = F.G; S.c = F.bid;
    pg8::gemm_phase<Epi, pg8::MultiOrder<1>, true>((PG8_LAS unsigned char*)F.lds, g, S, E, F.wave, F.lane());
}
template <int NS, class Op>
__device__ __forceinline__ void gemm_multi(const Frame& F, const pg8::MultiOrder<NS>& S, int K, const Op& op) {
    pg8::Gemm g{S.lda, S.ldb, K}; pg8::Epi8<Op> E{op};
    pg8::gemm_phase<pg8::Epi8<Op>, pg8::MultiOrder<NS>, true>((PG8_LAS unsigned char*)F.lds, g, S, E, F.wave, F.lane());
}
template <class Off, class Op>
__device__ __forceinline__ void gemm_batch(const Frame& F, const pg8::BatchOrder<Off>& S, int K, const Op& op) {
    pg8::Gemm g{S.lda, S.ldb, K}; pg8::Epi8<Op> E{op};
    pg8::gemm_phase<pg8::Epi8<Op>, pg8::BatchOrder<Off>, true>((PG8_LAS unsigned char*)F.lds, g, S, E, F.wave, F.lane());
}
struct OffS { __device__ __forceinline__ size_t a(int z) const { return (size_t)(z >> 2) * 2048 * 2048 + (z & 3) * 512; } __device__ __forceinline__ size_t b(int z) const { return (size_t)(z >> 2) * 256 * 2048 + (z & 3) * 512; } };
struct OffPV { __device__ __forceinline__ size_t a(int z) const { return (size_t)(z >> 2) * 2048 * 1024 + (z & 3) * 256; } __device__ __forceinline__ size_t b(int z) const { return (size_t)(z & 3) * 512 * 2048 + (z >> 2) * 256; } };
struct OpLogit { static constexpr int NLD = 0; float* lg;
    __device__ __forceinline__ void operator()(int z, int row, int col, f32x4 a, f32x4 b) const { float* p = lg + ((size_t)(z >> 2) * 2048 + row) * 1024 + (z & 3) * 256 + col; *(f32x4*)p = a * 0.04419417382415922f; *(f32x4*)(p + 4) = b * 0.04419417382415922f; } };
struct OpCO { static constexpr int NLD = 0; bf16* co;
    __device__ __forceinline__ void operator()(int z, int row, int col, f32x4 a, f32x4 b) const { *(u32x4*)(co + ((size_t)(z >> 2) * 2048 + row) * 2048 + (z & 3) * 512 + col) = pack8(a, b); } };
struct OpCQKV { static constexpr int NLD = 0; bf16* cq; bf16* ck; bf16* vt; const float* st; const float* c1; const float* c0;
    __device__ __forceinline__ void operator()(int z, int row, int col, f32x4 a, f32x4 b) const { if (z == 0) ln_fold8(st, c1, c0, row, col, a, b);
        bf16* o = z == 0 ? cq : (z == 1 ? ck : vt); *(u32x4*)(o + (size_t)row * 2048 + col) = pack8(a, b); } };
struct EpiXSoftmax { static constexpr bool PERM = true; bf16* P;
    __device__ __forceinline__ void operator()(const f32x4 (&)[2][2][4][2], const pg8::Unit&, int, int, int, int) const {}
    __device__ __forceinline__ void fused(f32x4 (&acc)[2][2][4][2], const pg8::Unit& u, int wr, int wc, int fr, int fq, unsigned char* lds) const {
        float* pm = (float*)lds;
        float* ps = pm + 1024;
        const float sc = 0.04419417382415922f * 1.4426950408889634f;
        float mx[2][4];
#pragma unroll
        for (int ai = 0; ai < 2; ++ai)
#pragma unroll
            for (int m = 0; m < 4; ++m) { float v = -INFINITY;
#pragma unroll
                for (int bj = 0; bj < 2; ++bj)
#pragma unroll
                    for (int n = 0; n < 2; ++n)
#pragma unroll
                        for (int e = 0; e < 4; ++e) v = fmaxf(v, acc[ai][bj][m][n][e]);
                v = fmaxf(v, __shfl_xor(v, 16)); v = fmaxf(v, __shfl_xor(v, 32));
                if (fq == 0) pm[(ai * 128 + wr * 64 + m * 16 + fr) * 4 + wc] = v; }
        __syncthreads();
#pragma unroll
        for (int ai = 0; ai < 2; ++ai)
#pragma unroll
            for (int m = 0; m < 4; ++m) { const f32x4 q = *(const f32x4*)(pm + (ai * 128 + wr * 64 + m * 16 + fr) * 4); const float rm = fmaxf(fmaxf(q.x, q.y), fmaxf(q.z, q.w)) * sc; mx[ai][m] = rm; float sm = 0.f;
#pragma unroll
                for (int bj = 0; bj < 2; ++bj)
#pragma unroll
                    for (int n = 0; n < 2; ++n)
#pragma unroll
                        for (int e = 0; e < 4; ++e) { const float p = __builtin_amdgcn_exp2f(acc[ai][bj][m][n][e] * sc - rm); acc[ai][bj][m][n][e] = p; sm += p; }
                sm += __shfl_xor(sm, 16); sm += __shfl_xor(sm, 32);
                if (fq == 0) ps[(ai * 128 + wr * 64 + m * 16 + fr) * 4 + wc] = sm; }
        __syncthreads();
        const int row0 = u.pm * 256 + wr * 64 + fr, col0 = wc * 32 + 8 * fq;
#pragma unroll
        for (int ai = 0; ai < 2; ++ai)
#pragma unroll
            for (int m = 0; m < 4; ++m) { const f32x4 q = *(const f32x4*)(ps + (ai * 128 + wr * 64 + m * 16 + fr) * 4); const float inv = 1.0f / ((q.x + q.y) + (q.z + q.w));
                bf16* prow = P + ((size_t)(u.z >> 2) * 2048 + row0 + ai * 128 + m * 16) * 1024 + (u.z & 3) * 256 + col0;
#pragma unroll
                for (int bj = 0; bj < 2; ++bj) *(u32x4*)(prow + bj * 128) = pack8(acc[ai][bj][m][0] * inv, acc[ai][bj][m][1] * inv); }
        (void)mx;
        __syncthreads();
    }
};
__device__ __forceinline__ void ph_xsoftmax(const Frame& F, const float* lg, bf16* P) {
    const int gw = F.bid * 8 + F.wave, NGW = F.G * 8, lane = F.lane();
    for (int u = gw; u < T * 4; u += NGW) {
        const f32x4 v = *(const f32x4*)(lg + (size_t)u * 256 + 4 * lane);
        const float m = wave_max(fmaxf(fmaxf(v.x, v.y), fmaxf(v.z, v.w)));
        const float e0 = expf(v.x - m), e1 = expf(v.y - m), e2 = expf(v.z - m), e3 = expf(v.w - m);
        const float inv = 1.0f / wave_sum((e0 + e1) + (e2 + e3));
        u32x2 w; w.x = pk2(e0 * inv, e1 * inv); w.y = pk2(e2 * inv, e3 * inv);
        *(u32x2*)(P + (size_t)u * 256 + 4 * lane) = w;
    }
}

template <class CM>
__device__ __forceinline__ void transpose_item(const float* W, size_t ldw, bf16* WT, size_t ldwt, int row_off, int nblk, int item, float* scr, int lane, const CM& cm) {
    const int kb = item / nblk, nb = item % nblk, k0 = 64 * kb, n0 = 32 * nb;
    const int c = cm(n0 + (lane & 31));
#pragma unroll 8
    for (int i = 0; i < 32; ++i) { const int kk = 2 * i + (lane >> 5); scr[kk * 33 + (lane & 31)] = (c >= 0) ? W[(size_t)(k0 + kk) * ldw + c] : 0.f; }
    WAVE_SYNC();
    const int c8 = lane & 7;
#pragma unroll
    for (int j = 0; j < 4; ++j) { const int n = (lane >> 3) + 8 * j; const float* s = scr + (8 * c8) * 33 + n;
        u32x4 o; o.x = pk2(s[0 * 33], s[1 * 33]); o.y = pk2(s[2 * 33], s[3 * 33]); o.z = pk2(s[4 * 33], s[5 * 33]); o.w = pk2(s[6 * 33], s[7 * 33]);
        *(u32x4*)(WT + (size_t)(row_off + n0 + n) * ldwt + k0 + 8 * c8) = o; }
    WAVE_SYNC();
}
__device__ __forceinline__ void transpose_item_ln(const float* W, bf16* WT, int item, float* scr, int lane, const float* g, const float* bta, float* c1, float* c0) {
    const int kb = item / 64, nb = item % 64, k0 = 64 * kb, n0 = 32 * nb;
#pragma unroll 8
    for (int i = 0; i < 32; ++i) { const int kk = 2 * i + (lane >> 5); scr[kk * 33 + (lane & 31)] = W[(size_t)(k0 + kk) * 2048 + n0 + (lane & 31)]; }
    WAVE_SYNC();
    const int c8 = lane & 7;
    float gk[8], bk[8];
#pragma unroll
    for (int i = 0; i < 8; ++i) { gk[i] = g[k0 + 8 * c8 + i]; bk[i] = bta[k0 + 8 * c8 + i]; }
#pragma unroll
    for (int j = 0; j < 4; ++j) { const int n = (lane >> 3) + 8 * j; const float* sp = scr + (8 * c8) * 33 + n;
        float wv[8]; float p1 = 0.f, p0 = 0.f;
#pragma unroll
        for (int i = 0; i < 8; ++i) { const float v = sp[i * 33]; wv[i] = v * gk[i]; p1 += wv[i]; p0 += v * bk[i]; }
        u32x4 o; o.x = pk2(wv[0], wv[1]); o.y = pk2(wv[2], wv[3]); o.z = pk2(wv[4], wv[5]); o.w = pk2(wv[6], wv[7]);
        *(u32x4*)(WT + (size_t)(n0 + n) * 2048 + k0 + 8 * c8) = o;
        p1 += __shfl_xor(p1, 1); p1 += __shfl_xor(p1, 2); p1 += __shfl_xor(p1, 4); p0 += __shfl_xor(p0, 1); p0 += __shfl_xor(p0, 2); p0 += __shfl_xor(p0, 4);
        if (c8 == 0) { atomicAdd(c1 + n0 + n, p1); atomicAdd(c0 + n0 + n, p0); } }
    WAVE_SYNC();
}
template <class CM>
__device__ __forceinline__ void transpose_item64(const float* W, size_t ldw, bf16* WT, size_t ldwt, int row_off, int nblk, int item, float* scr, int lane, const CM& cm) {
    const int kb = item / nblk, nb = item % nblk, k0 = 64 * kb, n0 = 64 * nb, r = lane >> 4, c4 = lane & 15;
    const int c = cm(n0 + 4 * c4);
    f32x4 v[16];
#pragma unroll
    for (int i = 0; i < 16; ++i) v[i] = (c >= 0) ? *(const f32x4*)(W + (size_t)(k0 + 4 * i + r) * ldw + c) : (f32x4){0.f, 0.f, 0.f, 0.f};
#pragma unroll
    for (int i = 0; i < 16; ++i) *(f32x4*)(scr + (4 * i + r) * 68 + 4 * c4) = v[i];
    WAVE_SYNC();
    bf16* orow = WT + (size_t)(row_off + n0 + lane) * ldwt + k0;
#pragma unroll
    for (int j = 0; j < 8; ++j) { const float* sp = scr + (8 * j) * 68 + lane;
        u32x4 o; o.x = pk2(sp[0], sp[68]); o.y = pk2(sp[2 * 68], sp[3 * 68]); o.z = pk2(sp[4 * 68], sp[5 * 68]); o.w = pk2(sp[6 * 68], sp[7 * 68]);
        *(u32x4*)(orow + 8 * j) = o; }
    WAVE_SYNC();
}
struct CmIdent { __device__ __forceinline__ int operator()(int n) const { return n; } };
struct CmWin { __device__ __forceinline__ int operator()(int n) const {
    if (n < 10240) return n;
    if (n < 12288) return 10496 + (n - 10240);
    if (n < 14336) return 12688 + (n - 12288);
    if (n < 16384) return 14736 + (n - 14336);
    if (n < 16640) return 10240 + (n - 16384);
    if (n < 16768) return 12544 + (n - 16640);
    if (n < 16784) return 12672 + (n - 16768);
    return -1; } };

__device__ __forceinline__ void cvt_bf16_stream(const Frame& F, const float* src, bf16* dst, size_t n8) {
    const size_t gt = (size_t)F.bid * 512 + F.wave * 64 + F.lane(), NT = (size_t)F.G * 512;
#pragma unroll 4
    for (size_t i = gt; i < n8; i += NT) { const f32x4 a = ((const f32x4*)src)[2 * i], b = ((const f32x4*)src)[2 * i + 1];
        u32x4 o; o.x = pk2(a.x, a.y); o.y = pk2(a.z, a.w); o.z = pk2(b.x, b.y); o.w = pk2(b.z, b.w); ((u32x4*)dst)[i] = o; }
}

__device__ __forceinline__ void ph0_prologue(const Frame& F) {
    const Args& a = *F.a;
    cvt_bf16_stream(F, a.in[0], (bf16*)a.out, (size_t)T * D / 8);
    cvt_bf16_stream(F, a.in[1], (bf16*)(F.ws + WS_MEMB), (size_t)2048 * 2048 / 8);
    float* scr = (float*)(F.lds + F.wave * 17408);
    const int gw = F.bid * 8 + F.wave, NGW = F.G * 8, lane = F.lane();
    {
        const int nblk = NCOLS / 64, nitems = (2048 / 64) * nblk;
        float* scr64 = (float*)(F.lds + F.wave * 17408);
        for (int it = gw; it < nitems; it += NGW) transpose_item64(a.in[2], 16784, (bf16*)(F.ws + WS_WIN), 2048, 0, nblk, it, scr64, lane, CmWin());
    }
    {
        for (int it = gw; it < 32 * 16; it += NGW) { const int mat = it >> 4, which = mat >> 4, h = mat & 15;
            transpose_item(a.in[which ? 9 : 8] + (size_t)h * 256 * 128, 128, (bf16*)(F.ws + WS_WKV), 256, which * 2048 + h * 128, 4, it & 15, scr, lane, CmIdent()); }
    }
    {
        bf16* W8p = (bf16*)((unsigned char*)a.out + (size_t)64 * MiB);
        for (int it = gw; it < 2 * 1024; it += NGW) { const int m = 4 + (it >> 10);
            transpose_item64(m == 4 ? a.in[17] : a.in[18], 2048, W8p + (size_t)m * 2048 * 2048, 2048, 0, 32, it & 1023, scr, lane, CmIdent()); }
    }
    {
        const int gt = F.bid * 512 + F.wave * 64 + lane;
        if (gt < 2048) { const float l0 = a.in[3][gt], l1 = a.in[3][2048 + gt]; ((float*)(F.ws + WS_LB))[gt] = 1.0f / (1.0f + expf(l1 - l0)); }
    }
}

namespace hg {
constexpr int QP = 272, TP = 144, AP = 144;
constexpr int OFF_QD = 0, OFF_KD = OFF_QD + 64 * QP, OFF_QG = OFF_KD + 64 * QP, OFF_KET = OFF_QG + 64 * QP, OFF_VT = OFF_KET + 128 * TP, OFF_A = OFF_VT + 128 * TP,
              OFF_TOT = OFF_A + 64 * AP, OFF_DEC = OFF_TOT + 4 * 128 * 4, OFF_PART = OFF_DEC + 128 * 4, OFF_RSTD = OFF_PART + 8 * 64 * 4, END = OFF_RSTD + 64 * 4;
static_assert(END <= 131072, "hgrn LDS map");
}
typedef short bf16x4 __attribute__((ext_vector_type(4)));
#define HSEC_B() do { if (PROBE_SEC) hs_t0 = rt_now(); } while (0)
#define HSEC_E(n) do { if (PROBE_SEC == (n)) sacc += rt_now() - hs_t0; } while (0)
__device__ __forceinline__ void hgrn_chunked(const Frame& F, int unit, unsigned long long& sacc) {
    unsigned long long hs_t0 = 0ull;
    using namespace hg;
    const Args& a = *F.a;
    const int b = unit >> 4, h = unit & 15, lane = F.lane(), w = F.wave, tid = w * 64 + lane, c = tid & 127, rq = tid >> 7, l15 = lane & 15, q4 = lane >> 4;
    unsigned char* L = F.lds;
    const size_t base = (size_t)b * 2048 * 2048 + h * 128;
    const bf16* HQ = F.slot(0) + base; const bf16* HF = F.slot(1) + base; const bf16* HI = F.slot(2) + base; const bf16* HG = F.slot(3) + base; bf16* HO = F.slot(0) + base;
    const float lb = ((const float*)(F.ws + WS_LB))[h * 128 + c];
    const float ng = a.in[4][h * 128 + 16 * w + l15];
    f32x4 S[8];
#pragma unroll
    for (int d = 0; d < 8; ++d) S[d] = (f32x4){0.f, 0.f, 0.f, 0.f};
    unsigned short rq_[16], rf_[16], rv_[16];
#pragma unroll
    for (int k = 0; k < 16; ++k) { const size_t o = (size_t)(16 * rq + k) * 2048 + c; rq_[k] = HQ[o]; rf_[k] = HF[o]; rv_[k] = HI[o]; }
    float* tot = (float*)(L + OFF_TOT); float* dec = (float*)(L + OFF_DEC); float* part = (float*)(L + OFF_PART); float* rstd = (float*)(L + OFF_RSTD);
#pragma unroll 1
    for (int ch = 0; ch < 32; ++ch) {
        const int r0 = ch * 64;
        HSEC_B();
        unsigned short gq[16];
#pragma unroll
        for (int mt = 0; mt < 4; ++mt)
#pragma unroll
            for (int r = 0; r < 4; ++r) gq[4 * mt + r] = HG[(size_t)(r0 + 16 * mt + 4 * q4 + r) * 2048 + 16 * w + l15];
        unsigned short rv2_[16];
        if (ch + 1 < 32) {
#pragma unroll
            for (int k = 0; k < 16; ++k) rv2_[k] = HI[(size_t)(r0 + 64 + 16 * rq + k) * 2048 + c]; }
        float G[16], qf[16], kk[16];
        { float run = 0.f;
#pragma unroll
          for (int k = 0; k < 16; ++k) { const float f = lb + (1.0f - lb) * __builtin_amdgcn_rcpf(1.0f + __expf(-bf2f(rf_[k]))); run += __logf(f); G[k] = run; kk[k] = 1.0f - f; qf[k] = bf2f(rq_[k]); } }
        tot[rq * 128 + c] = G[15];
        if (ch + 1 < 32) {
#pragma unroll
            for (int k = 0; k < 16; ++k) { const size_t o = (size_t)(r0 + 64 + 16 * rq + k) * 2048 + c; rq_[k] = HQ[o]; rf_[k] = HF[o]; } }
        HSEC_E(1); HSEC_B();
        __syncthreads();
        HSEC_E(2); HSEC_B();
        const float t0 = tot[c], t1 = tot[128 + c], t2 = tot[256 + c], t3 = tot[384 + c];
        const float offs = (rq > 0 ? t0 : 0.f) + (rq > 1 ? t1 : 0.f) + (rq > 2 ? t2 : 0.f);
        const float Gref = t0 + t1, Glast = Gref + t2 + t3, eref = __expf(Gref), elr = __expf(Glast - Gref);
        if (rq == 0) dec[c] = __expf(Glast);
        unsigned kew[8], vw[8];
#pragma unroll
        for (int k = 0; k < 16; ++k) {
            const float e1 = __expf(G[k] + offs - Gref), qd = qf[k] * e1, kd = kk[k] * __builtin_amdgcn_rcpf(e1);
            const int row = 16 * rq + k;
            *(bf16*)(L + OFF_QD + row * QP + 2 * c) = (bf16)f2bf(qd);
            *(bf16*)(L + OFF_KD + row * QP + 2 * c) = (bf16)f2bf(kd);
            *(bf16*)(L + OFF_QG + row * QP + 2 * c) = (bf16)f2bf(qd * eref);
            const unsigned ke = f2bf(kd * elr);
            if (k & 1) { kew[k >> 1] |= ke << 16; vw[k >> 1] |= (unsigned)rv_[k] << 16; } else { kew[k >> 1] = ke; vw[k >> 1] = rv_[k]; }
        }
        *(u32x4*)(L + OFF_KET + c * TP + 32 * rq) = (u32x4){kew[0], kew[1], kew[2], kew[3]}; *(u32x4*)(L + OFF_KET + c * TP + 32 * rq + 16) = (u32x4){kew[4], kew[5], kew[6], kew[7]};
        *(u32x4*)(L + OFF_VT + c * TP + 32 * rq) = (u32x4){vw[0], vw[1], vw[2], vw[3]}; *(u32x4*)(L + OFF_VT + c * TP + 32 * rq + 16) = (u32x4){vw[4], vw[5], vw[6], vw[7]};
        if (ch + 1 < 32) {
#pragma unroll
            for (int k = 0; k < 16; ++k) rv_[k] = rv2_[k]; }
        HSEC_E(3); HSEC_B();
        __syncthreads();
        HSEC_E(4); HSEC_B();
        { const int mi = w >> 1;
#pragma unroll
          for (int tt = 0; tt < 2; ++tt) { const int nj = 2 * (w & 1) + tt; f32x4 acc = (f32x4){0.f, 0.f, 0.f, 0.f};
              if (nj <= mi) {
#pragma unroll
                  for (int ks = 0; ks < 4; ++ks) { const bf16x8 aF = *(const bf16x8*)(L + OFF_KD + (16 * nj + l15) * QP + 64 * ks + 16 * q4), bF = *(const bf16x8*)(L + OFF_QD + (16 * mi + l15) * QP + 64 * ks + 16 * q4);
                      acc = __builtin_amdgcn_mfma_f32_16x16x32_bf16(aF, bF, acc, 0, 0, 0); } }
              const int i = 16 * mi + l15, j0 = 16 * nj + 4 * q4;
              const float v0 = (j0 <= i) ? acc.x : 0.f, v1 = (j0 + 1 <= i) ? acc.y : 0.f, v2 = (j0 + 2 <= i) ? acc.z : 0.f, v3 = (j0 + 3 <= i) ? acc.w : 0.f;
              *(u32x2*)(L + OFF_A + i * AP + 2 * j0) = (u32x2){pk2(v0, v1), pk2(v2, v3)}; } }
        __syncthreads();
        HSEC_E(5); HSEC_B();
        bf16x8 bV[2];
#pragma unroll
        for (int ks = 0; ks < 2; ++ks) bV[ks] = *(const bf16x8*)(L + OFF_VT + (16 * w + l15) * TP + 64 * ks + 16 * q4);
        f32x4 O[4];
#pragma unroll
        for (int mt = 0; mt < 4; ++mt) { O[mt] = (f32x4){0.f, 0.f, 0.f, 0.f};
#pragma unroll
            for (int ks = 0; ks < 2; ++ks) { const bf16x8 aF = *(const bf16x8*)(L + OFF_A + (16 * mt + l15) * AP + 64 * ks + 16 * q4); O[mt] = __builtin_amdgcn_mfma_f32_16x16x32_bf16(aF, bV[ks], O[mt], 0, 0, 0); } }
#pragma unroll
        for (int kq = 0; kq < 4; ++kq) {
            u32x4 sw; sw.x = pk2(S[2 * kq].x, S[2 * kq].y); sw.y = pk2(S[2 * kq].z, S[2 * kq].w); sw.z = pk2(S[2 * kq + 1].x, S[2 * kq + 1].y); sw.w = pk2(S[2 * kq + 1].z, S[2 * kq + 1].w);
            const bf16x8 bS = __builtin_bit_cast(bf16x8, sw);
#pragma unroll
            for (int mt = 0; mt < 4; ++mt) { const unsigned char* qp = L + OFF_QG + (16 * mt + l15) * QP + 64 * kq + 8 * q4;
                const u32x2 lo = *(const u32x2*)qp, hi = *(const u32x2*)(qp + 32);
                const bf16x8 aF = __builtin_bit_cast(bf16x8, (u32x4){lo.x, lo.y, hi.x, hi.y});
                O[mt] = __builtin_amdgcn_mfma_f32_16x16x32_bf16(aF, bS, O[mt], 0, 0, 0); } }
#pragma unroll
        for (int dt = 0; dt < 8; ++dt) { const f32x4 dc = *(const f32x4*)(dec + 16 * dt + 4 * q4); S[dt] = S[dt] * dc;
#pragma unroll
            for (int ks = 0; ks < 2; ++ks) { const bf16x8 aF = *(const bf16x8*)(L + OFF_KET + (16 * dt + l15) * TP + 64 * ks + 16 * q4); S[dt] = __builtin_amdgcn_mfma_f32_16x16x32_bf16(aF, bV[ks], S[dt], 0, 0, 0); } }
        HSEC_E(6); HSEC_B();
#pragma unroll
        for (int mt = 0; mt < 4; ++mt)
#pragma unroll
            for (int r = 0; r < 4; ++r) { const float p = row16_sum(O[mt][r] * O[mt][r]);
                if (l15 == 0) part[w * 64 + 16 * mt + 4 * q4 + r] = p; }
        __syncthreads();
        if (tid < 64) { float s = 0.f;
#pragma unroll
            for (int ww = 0; ww < 8; ++ww) s += part[ww * 64 + tid];
            rstd[tid] = rsqrtf(s * (1.0f / 128.0f) + 1e-6f); }
        __syncthreads();
        HSEC_E(7); HSEC_B();
#pragma unroll
        for (int mt = 0; mt < 4; ++mt) { const f32x4 rs = *(const f32x4*)(rstd + 16 * mt + 4 * q4);
#pragma unroll
            for (int r = 0; r < 4; ++r) { const float g = bf2f(gq[4 * mt + r]); const float o = O[mt][r] * rs[r] * ng * (g * __builtin_amdgcn_rcpf(1.0f + __expf(-g)));
                HO[(size_t)(r0 + 16 * mt + 4 * q4 + r) * 2048 + 16 * w + l15] = (bf16)f2bf(o); } }
        HSEC_E(8);
    }
    __syncthreads();
}

__device__ __forceinline__ void ph2_side(const Frame& F, int sid, int nside) {
    const Args& a = *F.a;
    const int gw = sid * 8 + F.wave, NGW = nside * 8, lane = F.lane();
    bf16* CKV = (bf16*)(F.ws + WS_CKV); bf16* IKW = (bf16*)(F.ws + WS_IKW);
    for (int row = gw; row < T; row += NGW) {
        {   u32x2 w = *(u32x2*)(CKV + (size_t)row * 256 + 4 * lane);
            float x0 = bflo(w.x), x1 = bfhi(w.x), x2 = bflo(w.y), x3 = bfhi(w.y);
            const float ss = wave_sum(x0 * x0 + x1 * x1 + x2 * x2 + x3 * x3);
            const float r = rsqrtf(ss * (1.0f / 256.0f) + 1e-6f);
            const f32x4 g = *(const f32x4*)(a.in[5] + 4 * lane);
            w.x = pk2(x0 * r * g.x, x1 * r * g.y); w.y = pk2(x2 * r * g.z, x3 * r * g.w);
            *(u32x2*)(CKV + (size_t)row * 256 + 4 * lane) = w; }
        {   unsigned w = *(unsigned*)(IKW + (size_t)row * 256 + 2 * lane);
            float x0 = bflo(w), x1 = bfhi(w);
            const float mu = wave_sum(x0 + x1) * (1.0f / 128.0f);
            x0 -= mu; x1 -= mu;
            const float var = wave_sum(x0 * x0 + x1 * x1) * (1.0f / 128.0f);
            const float r = rsqrtf(var + 1e-5f);
            const float g0 = a.in[6][2 * lane], g1 = a.in[6][2 * lane + 1], b0 = a.in[7][2 * lane], b1 = a.in[7][2 * lane + 1];
            *(unsigned*)(IKW + (size_t)row * 256 + 2 * lane) = pk2(x0 * r * g0 + b0, x1 * r * g1 + b1); }
    }
}
__device__ __forceinline__ void w8_transposes(const Frame& F, bf16* W8) {
    const Args& a = *F.a;
    const int gw = F.bid * 8 + F.wave, NGW = F.G * 8, lane = F.lane();
    float* scr = (float*)(F.lds + F.wave * 17408);
    float* cv = (float*)(F.ws + WS_CTL + CTL_CVEC);
    for (int it = gw; it < 2 * 2048; it += NGW) {
        const int which = it >> 11, m = which ? 7 : 3;
        transpose_item_ln(which ? a.in[22] : a.in[16], W8 + (size_t)m * 2048 * 2048, it & 2047, scr, lane, which ? a.in[20] : a.in[14], which ? a.in[21] : a.in[15], cv + which * 4096, cv + which * 4096 + 2048); }
    for (int it = gw; it < 4 * 1024; it += NGW) {
        const int q = it >> 10, m = q < 3 ? q : 6;
        const float* wsrc = m == 0 ? a.in[11] : m == 1 ? a.in[12] : m == 2 ? a.in[13] : a.in[19];
        if (m < 2) transpose_item64(wsrc, 2048, W8 + (size_t)m * 2048, 4096, 0, 32, it & 1023, scr, lane, CmIdent());
        else transpose_item64(wsrc, 2048, W8 + (size_t)m * 2048 * 2048, 2048, 0, 32, it & 1023, scr, lane, CmIdent()); }
}

__device__ __forceinline__ void ph3_hgnorm(const Frame& F) {
    const Args& a = *F.a;
    const int gw = F.bid * 8 + F.wave, NGW = F.G * 8, lane = F.lane();
    const float* oraw = a.out; const bf16* HG = F.slot(3); bf16* HO = F.slot(0);
    for (int u = gw; u < T * 16; u += NGW) {
        const size_t off = (size_t)(u >> 4) * 2048 + (u & 15) * 128 + 2 * lane;
        const float o0 = oraw[off], o1 = oraw[off + 1];
        const float r = rsqrtf(wave_sum(o0 * o0 + o1 * o1) * (1.0f / 128.0f) + 1e-6f);
        const unsigned gw2 = *(const unsigned*)(HG + off);
        const float g0 = bflo(gw2), g1 = bfhi(gw2);
        const int c = (u & 15) * 128 + 2 * lane;
        *(unsigned*)(HO + off) = pk2(o0 * r * a.in[4][c] * (g0 * sigm(g0)), o1 * r * a.in[4][c + 1] * (g1 * sigm(g1)));
    }
}

__device__ __forceinline__ unsigned fkey(float f) { const unsigned u = __float_as_uint(f); return (u & 0x80000000u) ? ~u : (u | 0x80000000u); }
__device__ __forceinline__ void ph5_select(const Frame& F, int first, int stride) {
    const int lane = F.lane(), l31 = lane & 31, half = lane >> 5, w = F.wave;
    float* scl = (float*)F.lds;
    const bf16* AIQ = F.slot(5); const bf16* IKW = (const bf16*)(F.ws + WS_IKW);
    unsigned* MASK = (unsigned*)(F.ws + WS_MASK);
    for (int i = first; i < 1024; i += stride) {
        const int r4 = i >> 8, c = i & 255, j = c & 127, b = 2 * r4 + (c >> 7), qt = (r4 & 1) ? 127 - j : j, t0 = qt * 16;
        bf16x8 Af[8];
        { const size_t rowA = (size_t)b * 2048 + t0 + 2 * w + ((l31 >> 2) & 1); const int headA = (l31 & 3) + 4 * (l31 >> 3);
#pragma unroll
          for (int ks = 0; ks < 8; ++ks) Af[ks] = *(const bf16x8*)(AIQ + rowA * 2048 + headA * 128 + 16 * ks + 8 * half); }
        float wr[16];
        { const bf16* wp = IKW + ((size_t)b * 2048 + t0 + 2 * w + half) * 256 + 128;
#pragma unroll
          for (int r = 0; r < 16; ++r) wr[r] = bf2f(wp[(r & 3) + 4 * (r >> 2)]) * (0.25f * 0.08838834764831845f); }
        const int nkt = (t0 + 15) / 32 + 1;
        unsigned char* ring = F.lds + 131072;
        const int srow = (w * 64 + lane) >> 4, sch = lane & 15;
        const bf16* kg = IKW + ((size_t)b * 2048 + srow) * 256 + 8 * sch;
        const int swr = srow * 256 + ((sch ^ (srow & 15)) << 4);
        const int frd = l31 * 256;
        u32x4 st0, st1;
        st0 = *(const u32x4*)kg; *(u32x4*)(ring + swr) = st0;
        if (nkt > 1) { st1 = *(const u32x4*)(kg + (size_t)32 * 256); *(u32x4*)(ring + 8192 + swr) = st1; }
        if (nkt > 2) st0 = *(const u32x4*)(kg + (size_t)2 * 32 * 256);
        __syncthreads();
#define IDX_TILE(kt_, STW, STL) do { \
            if ((kt_) + 3 < nkt) STL = *(const u32x4*)(kg + (size_t)((kt_) + 3) * 32 * 256); \
            { const unsigned char* sl_ = ring + ((kt_) % 3) * 8192 + frd; f32x16 acc; _Pragma("unroll") for (int r = 0; r < 16; ++r) acc[r] = 0.f; \
              _Pragma("unroll") for (int ks = 0; ks < 8; ++ks) { const bf16x8 bfr = *(const bf16x8*)(sl_ + (((2 * ks + half) ^ (l31 & 15)) << 4)); acc = __builtin_amdgcn_mfma_f32_32x32x16_bf16(Af[ks], bfr, acc, 0, 0, 0); } \
              float sc = 0.f; _Pragma("unroll") for (int r = 0; r < 16; ++r) sc += fmaxf(acc[r], 0.f) * wr[r]; \
              scl[(2 * w + half) * 2048 + (kt_) * 32 + l31] = sc; } \
            if ((kt_) + 2 < nkt) *(u32x4*)(ring + (((kt_) + 2) % 3) * 8192 + swr) = STW; \
            __syncthreads(); } while (0)
        for (int kt = 0; kt < nkt; kt += 2) { IDX_TILE(kt, st0, st1); if (kt + 1 < nkt) IDX_TILE(kt + 1, st1, st0); }
#undef IDX_TILE
        WAVE_SYNC();
#pragma unroll 1
        for (int qi = 0; qi < 2; ++qi) {
            const int t = t0 + 2 * w + qi; const float* row = scl + (2 * w + qi) * 2048;
            unsigned key[32];
#pragma unroll
            for (int jj = 0; jj < 32; ++jj) { const int s2 = lane + 64 * jj; key[jj] = (s2 <= t) ? fkey(row[s2]) : 0u; }
            unsigned thr = 0u;
            if (t + 1 > 256) {
                for (int bit = 31; bit >= 0; --bit) {
                    const unsigned cand = thr | (1u << bit);
                    int cnt = 0;
#pragma unroll
                    for (int jj = 0; jj < 32; ++jj) cnt += (key[jj] >= cand) ? 1 : 0;
                    { int tot = 0;
#pragma unroll
                      for (int bb = 0; bb < 6; ++bb) tot += __popcll(__ballot((cnt >> bb) & 1)) << bb;
                      cnt = tot; }
                    if (cnt >= 256) { thr = cand; if (cnt == 256) break; }
                }
            }
            unsigned wd = 0u;
#pragma unroll
            for (int jj = 0; jj < 32; ++jj) { const int s2 = lane + 64 * jj; const unsigned long long m = __ballot(s2 <= t && key[jj] >= thr);
                if (lane == 2 * jj) wd = (unsigned)m; if (lane == 2 * jj + 1) wd = (unsigned)(m >> 32); }
            MASK[((size_t)b * 2048 + t) * 64 + lane] = wd;
        }
        WAVE_SYNC();
    }
}

__device__ __forceinline__ int t5_bucket(int d) {
    if (d < 16) return d;
    return 16 + (d >= 19) + (d >= 21) + (d >= 24) + (d >= 27) + (d >= 31) + (d >= 35) + (d >= 40) + (d >= 46) + (d >= 52) + (d >= 59) + (d >= 67) + (d >= 77) + (d >= 87) + (d >= 99) + (d >= 113);
}
namespace dsa {
constexpr float SCALE = 0.08838834764831845f;
constexpr int NW = 8, QBLK = 32, KVBLK = 64, QB = NW * QBLK, DH = 128, LD = 2048;
constexpr int SHM_V = KVBLK * DH * 2, SHM_K = KVBLK * DH * 2;
constexpr int OFF_WS = 2 * SHM_V + 2 * SHM_K, OFF_BIAS = OFF_WS + NW * 64 * 4, LDS_TOTAL = OFF_BIAS + 16 * 128 * 4;
constexpr float THR = 8.f;
typedef short s16x4 __attribute__((ext_vector_type(4)));
#define KSWZ(row, colB) ((row) * 256 + ((colB) ^ (((row) & 7) << 4)))
#define SBAR() __builtin_amdgcn_sched_barrier(0)
__device__ __forceinline__ int v_st(int k, int c) { const int kk = (k & ~0xC) | ((k & 4) << 1) | ((k & 8) >> 1); return ((kk >> 3) * 4 + (c >> 5)) * 512 + ((kk & 7) * 32 + (c & 31)) * 2; }
__device__ __forceinline__ int v_rd_base(int lane) { return ((lane & 3) << 3) | (((lane >> 2) & 3) << 6) | (((lane >> 4) & 1) << 5) | (((lane >> 5) & 1) << 8); }
constexpr int v_rd_off(int d0, int ks, int half) { return d0 * 512 + ks * 4096 + half * 2048; }
__device__ __forceinline__ int crow(int r, int hi) { return (r & 3) + 8 * (r >> 2) + 4 * hi; }
__device__ __forceinline__ unsigned cvtpk(float lo, float hi) { unsigned r; asm volatile("v_cvt_pk_bf16_f32 %0, %1, %2" : "=v"(r) : "v"(lo), "v"(hi)); return r; }
__device__ __forceinline__ bf16x8 load8(const bf16* p) { return *reinterpret_cast<const bf16x8*>(p); }
template <bool NEAR>
__device__ __forceinline__ void init_scores(f32x16& p0, f32x16& p1, unsigned w0, unsigned w1, int hi, int dq, const float* bl) {
    w0 >>= 4 * hi; w1 >>= 4 * hi;
#pragma unroll
    for (int r = 0; r < 16; ++r) { const int c = (r & 3) + 8 * (r >> 2);
        const int x0 = __builtin_amdgcn_sbfe(w0, c, 1), x1 = __builtin_amdgcn_sbfe(w1, c, 1);
        unsigned b0 = 0u, b1 = 0u;
        if (NEAR) { int d0 = dq - c, d1 = dq - c - 32; d0 = d0 < 0 ? 0 : (d0 > 127 ? 127 : d0); d1 = d1 < 0 ? 0 : (d1 > 127 ? 127 : d1);
            b0 = __float_as_uint(bl[d0]); b1 = __float_as_uint(bl[d1]); }
        p0[r] = __uint_as_float((b0 & (unsigned)x0) | (0xFF800000u & ~(unsigned)x0));
        p1[r] = __uint_as_float((b1 & (unsigned)x1) | (0xFF800000u & ~(unsigned)x1)); }
}
__device__ __forceinline__ void partialSM(f32x16& p0, f32x16& p1, float& m_reg, float& mn, float& alpha) {
    float pmax = p0[0];
#pragma unroll
    for (int r = 1; r < 16; ++r) pmax = fmaxf(pmax, p0[r]);
#pragma unroll
    for (int r = 0; r < 16; ++r) pmax = fmaxf(pmax, p1[r]);
    { auto rr = __builtin_amdgcn_permlane32_swap(__float_as_uint(pmax), __float_as_uint(pmax), false, false);
      pmax = fmaxf(__uint_as_float(rr[0]), __uint_as_float(rr[1])); }
    constexpr float C2 = 1.4426950408889634f * SCALE;
    if (__builtin_expect(__all((pmax - m_reg) * SCALE <= THR), 1)) { mn = m_reg; alpha = 1.f; }
    else { mn = fmaxf(m_reg, pmax); alpha = __builtin_amdgcn_exp2f((m_reg - mn) * C2); m_reg = mn; }
    const float mnL = -mn * C2;
#pragma unroll
    for (int r = 0; r < 16; ++r) p0[r] = fmaf(p0[r], C2, mnL);
#pragma unroll
    for (int r = 0; r < 16; ++r) p1[r] = fmaf(p1[r], C2, mnL);
#pragma unroll
    for (int r = 0; r < 16; ++r) p0[r] = __builtin_amdgcn_exp2f(p0[r]);
}
__device__ __forceinline__ void finishSM(f32x16& p0, f32x16& p1, float alpha, float& l_reg, bf16x8& pa0, bf16x8& pa1, bf16x8& pa2, bf16x8& pa3) {
#pragma unroll
    for (int r = 0; r < 16; ++r) p1[r] = __builtin_amdgcn_exp2f(p1[r]);
    float ps = 0;
#pragma unroll
    for (int r = 0; r < 16; ++r) ps += p0[r];
#pragma unroll
    for (int r = 0; r < 16; ++r) ps += p1[r];
    { auto rr = __builtin_amdgcn_permlane32_swap(__float_as_uint(ps), __float_as_uint(ps), false, false);
      ps = __uint_as_float(rr[0]) + __uint_as_float(rr[1]); }
    l_reg = l_reg * alpha + ps;
#define PK4(P, B_, OUT) do { unsigned a0 = cvtpk(P[B_+0], P[B_+1]), a1 = cvtpk(P[B_+2], P[B_+3]);                          \
        unsigned b0 = cvtpk(P[B_+4], P[B_+5]), b1 = cvtpk(P[B_+6], P[B_+7]);                                             \
        auto r0 = __builtin_amdgcn_permlane32_swap(a0, b0, false, false); auto r1 = __builtin_amdgcn_permlane32_swap(a1, b1, false, false); \
        u32x4 w = {r0[0], r1[0], r0[1], r1[1]}; OUT = *reinterpret_cast<bf16x8*>(&w); } while (0)
    PK4(p0, 0, pa0); PK4(p0, 8, pa1); PK4(p1, 0, pa2); PK4(p1, 8, pa3);
#undef PK4
}
template <int KB>
__device__ __forceinline__ void qkt(f32x16& p0, f32x16& p1, const char* K_lds, int r32, int hi, const bf16x8* qr) {
    const char* kb[4];
#pragma unroll
    for (int dd = 0; dd < 4; ++dd) kb[dd] = K_lds + KB * SHM_K + KSWZ(r32, (dd * 16 + hi * 8) * 2);
#pragma unroll
    for (int d0 = 0; d0 < 8; ++d0) { const char* a = kb[d0 & 3] + (d0 >> 2) * 128;
        bf16x8 b0 = *reinterpret_cast<const bf16x8*>(a);
        bf16x8 b1 = *reinterpret_cast<const bf16x8*>(a + 32 * 256);
        p0 = __builtin_amdgcn_mfma_f32_32x32x16_bf16(b0, qr[d0], p0, 0, 0, 0);
        p1 = __builtin_amdgcn_mfma_f32_32x32x16_bf16(b1, qr[d0], p1, 0, 0, 0); }
}
template <int VB>
__device__ __forceinline__ void pv_tile(f32x16* o, int vb0, bf16x8 pa0, bf16x8 pa1, bf16x8 pa2, bf16x8 pa3) {
#define TRRD(dst, off) asm volatile("ds_read_b64_tr_b16 %0, %1 offset:%2" : "=&v"(dst) : "v"(vb0), "i"(off) : "memory")
#define PV_D0(d0) do { s16x4 l0, l1, l2, l3, h0, h1, h2, h3; constexpr int b_ = VB * SHM_V + v_rd_off(d0, 0, 0); \
        TRRD(l0, b_); TRRD(h0, b_ + 2048); TRRD(l1, b_ + 4096); TRRD(h1, b_ + 6144); TRRD(l2, b_ + 8192); TRRD(h2, b_ + 10240); TRRD(l3, b_ + 12288); TRRD(h3, b_ + 14336); \
        asm volatile("s_waitcnt lgkmcnt(0)" ::: "memory"); SBAR();   \
        o[d0] = __builtin_amdgcn_mfma_f32_32x32x16_bf16(pa0, (bf16x8){l0[0], l0[1], l0[2], l0[3], h0[0], h0[1], h0[2], h0[3]}, o[d0], 0, 0, 0);   \
        o[d0] = __builtin_amdgcn_mfma_f32_32x32x16_bf16(pa1, (bf16x8){l1[0], l1[1], l1[2], l1[3], h1[0], h1[1], h1[2], h1[3]}, o[d0], 0, 0, 0);   \
        o[d0] = __builtin_amdgcn_mfma_f32_32x32x16_bf16(pa2, (bf16x8){l2[0], l2[1], l2[2], l2[3], h2[0], h2[1], h2[2], h2[3]}, o[d0], 0, 0, 0);   \
        o[d0] = __builtin_amdgcn_mfma_f32_32x32x16_bf16(pa3, (bf16x8){l3[0], l3[1], l3[2], l3[3], h3[0], h3[1], h3[2], h3[3]}, o[d0], 0, 0, 0); } while (0)
    PV_D0(0); PV_D0(1); PV_D0(2); PV_D0(3);
#undef PV_D0
#undef TRRD
}
struct BlockRef { const bf16* Q; const bf16* K; const bf16* V; bf16* O; const unsigned* M; int P0; int h; };
struct Seam { bf16x8 qr[8]; bf16x8 st_v0, st_v1, st_k0, st_k1; };
#define ROWU(p, k0) ((p) + (size_t)(k0) * LD)
#define VMW() asm volatile("s_waitcnt vmcnt(0)" ::: "memory")
#define VMWN(n) asm volatile("s_waitcnt vmcnt(%0)" :: "i"(n) : "memory")
#define SLOAD_H(Kp, Vp, k0) do { S.st_v0 = load8(ROWU(Vp, k0) + sofs); S.st_v1 = load8(ROWU(Vp, (k0) + 32) + sofs);              \
                         S.st_k0 = load8(ROWU(Kp, k0) + sofs); S.st_k1 = load8(ROWU(Kp, (k0) + 32) + sofs); } while (0)
#define SWRITE_HK(bf) do { *(bf16x8*)(K_lds + (bf) * SHM_K + kws) = S.st_k0; *(bf16x8*)(K_lds + (bf) * SHM_K + kws + 32 * 256) = S.st_k1; } while (0)
#define SWRITE_HV(bf) do { *(bf16x8*)(V_lds + (bf) * SHM_V + vst0) = S.st_v0; *(bf16x8*)(V_lds + (bf) * SHM_V + vst1) = S.st_v1; } while (0)
#define SWRITE_H(bf) do { SWRITE_HV(bf); SWRITE_HK(bf); } while (0)
__device__ __forceinline__ void prime(const BlockRef& cur, char* lds, Seam& S, int wid) {
    const int lane = fresh_lane(), tid = wid * 64 + lane, r32 = lane & 31, hi = lane >> 5;
    const int sr = tid >> 4, sc = (tid & 15) * 8, kws = KSWZ(sr, sc * 2); char* K_lds = lds + 2 * SHM_V; const unsigned sofs = (unsigned)(sr * LD + sc);
    const unsigned qofs = (unsigned)((wid * QBLK + r32) * LD + hi * 8);
#pragma unroll
    for (int d0 = 0; d0 < 8; ++d0) S.qr[d0] = load8(cur.Q + qofs + d0 * 16);
    SLOAD_H(cur.K, cur.V, 0); VMW(); SWRITE_HK(0);
    __syncthreads();
}
__device__ __forceinline__ void block(const BlockRef& cur, const BlockRef& nxt, char* lds, Seam& S, int wid) {
    const int lane = fresh_lane(), tid = wid * 64 + lane,
               r32 = lane & 31, hi = lane >> 5;
    const int NT = (cur.P0 + QB - 1) / KVBLK + 1;
    const int qlo = cur.P0 + wid * QBLK, qm = qlo + r32 - 4 * hi;
    char* V_lds = lds; char* K_lds = lds + 2 * SHM_V;
    float* ws = (float*)(lds + OFF_WS) + wid * 64; float* li_l = ws, * al_l = ws + 32;
    const float* bl = (const float*)(lds + OFF_BIAS) + cur.h * 128;
    const unsigned mofs = (unsigned)((wid * QBLK + r32) * 64);
    float m_reg = -1e30f, l_reg = 0; f32x16 o[4] = {};
    const int sr = tid >> 4, sc = (tid & 15) * 8, vst0 = v_st(sr, sc), vst1 = v_st(32 + sr, sc), kws = KSWZ(sr, sc * 2); const unsigned sofs = (unsigned)(sr * LD + sc);
    const int vb0 = (int)(uintptr_t)V_lds + v_rd_base(lane);
    const bf16* Kh = cur.K; const bf16* Vh = cur.V;
#define RESC(a) do { if (__any((a) < 1.f)) { if (hi == 0) al_l[r32] = (a); asm volatile("s_waitcnt lgkmcnt(0)" ::: "memory");              \
                     for (int d_ = 0; d_ < 4; ++d_) for (int r = 0; r < 16; ++r) o[d_][r] *= al_l[crow(r, hi)]; } } while (0)
#define KBASE(t) ((t) * KVBLK)
#define LDMASK(t) (*(const u32x2*)(cur.M + 2 * ((t) < 31 ? (t) : 31) + mofs))
#define INIT(P0_, P1_, t) do { const int kb_ = KBASE(t); if (qlo - kb_ - 63 < 113) init_scores<true>(P0_, P1_, mw.x, mw.y, hi, qm - kb_, bl); else init_scores<false>(P0_, P1_, mw.x, mw.y, hi, 0, bl); } while (0)
#define SEAM_K0() do { VMWN(8); SWRITE_HK(0); SBAR(); } while (0)
    f32x16 pA0, pA1, pB0, pB1; float mnA, mnB, alA, alB; bf16x8 pa0, pa1, pa2, pa3; u32x2 mw;
    SWRITE_HV(0); SBAR();
    if (NT > 1) { SLOAD_H(Kh, Vh, KBASE(1)); }
    mw = LDMASK(0); INIT(pA0, pA1, 0); mw = LDMASK(1);
    SBAR(); qkt<0>(pA0, pA1, K_lds, r32, hi, S.qr);
    partialSM(pA0, pA1, m_reg, mnA, alA);
    if (NT > 1) { VMW(); SWRITE_H(1); }
    __syncthreads();
#define HALF_STEP(PX0, PX1, mnX, alX, PY0, PY1, alY, t, KB, VB, SB) do {                                                      \
        INIT(PX0, PX1, (t)); mw = LDMASK((t) + 1);                                                                           \
        SBAR(); qkt<KB>(PX0, PX1, K_lds, r32, hi, S.qr);                                                                      \
        finishSM(PY0, PY1, alY, l_reg, pa0, pa1, pa2, pa3); SBAR();                                                           \
        if ((t) + 1 < NT) { SLOAD_H(Kh, Vh, KBASE((t) + 1)); SBAR(); }                                                        \
        pv_tile<VB>(o, vb0, pa0, pa1, pa2, pa3); partialSM(PX0, PX1, m_reg, mnX, alX);              \
        __syncthreads();                                                                                                      \
        if ((t) + 1 < NT) { VMW(); SWRITE_H(SB); }                                                                            \
        RESC(alX); __syncthreads(); } while (0)
    for (int t = 1; t + 1 < NT; t += 2) {
        HALF_STEP(pB0, pB1, mnB, alB, pA0, pA1, alA, t, 1, 0, 0);
        HALF_STEP(pA0, pA1, mnA, alA, pB0, pB1, alB, t + 1, 0, 1, 1);
    }
    const bool even = (NT & 1) == 0;
    if (even) { INIT(pB0, pB1, NT - 1); SBAR(); qkt<1>(pB0, pB1, K_lds, r32, hi, S.qr); SBAR(); }
    SLOAD_H(nxt.K, nxt.V, 0); SBAR();
#pragma unroll
    for (int d0 = 0; d0 < 8; ++d0) S.qr[d0] = load8(nxt.Q + (unsigned)((wid * QBLK + r32) * LD + hi * 8) + d0 * 16);
    SBAR();
    finishSM(pA0, pA1, alA, l_reg, pa0, pa1, pa2, pa3); SBAR();
    pv_tile<0>(o, vb0, pa0, pa1, pa2, pa3);
    if (even) { partialSM(pB0, pB1, m_reg, mnB, alB); __syncthreads(); RESC(alB);
        finishSM(pB0, pB1, alB, l_reg, pa0, pa1, pa2, pa3); SBAR(); pv_tile<1>(o, vb0, pa0, pa1, pa2, pa3); }
    SBAR(); SEAM_K0();
    if (hi == 0) li_l[r32] = l_reg; asm volatile("s_waitcnt lgkmcnt(0)" ::: "memory");
    float rli[16];
#pragma unroll
    for (int r = 0; r < 16; ++r) rli[r] = __builtin_amdgcn_rcpf(li_l[crow(r, hi)]);
    int lofs = 4 * hi * LD + r32; asm volatile("" : "+v"(lofs));
    bf16* Ow = cur.O + (size_t)(wid * QBLK) * LD + lofs;
#pragma unroll
    for (int r = 0; r < 16; ++r) { const int orow = (r & 3) + 8 * (r >> 2);
#pragma unroll
        for (int d0 = 0; d0 < 4; ++d0) { const float v = o[d0][r] * rli[r];
            const float vn = __shfl_xor(v, 1);
            if ((r32 & 1) == 0) *(unsigned*)(Ow + orow * LD + d0 * 32) = cvtpk(v, vn); } }
    __syncthreads();
#undef RESC
#undef KBASE
#undef LDMASK
#undef INIT
#undef SEAM_K0
#undef HALF_STEP
}
#undef ROWU
#undef VMW
#undef VMWN
#undef SLOAD_H
#undef SWRITE_HK
#undef SWRITE_HV
#undef SWRITE_H
#undef KSWZ
#undef SBAR
}

__device__ __forceinline__ dsa::BlockRef dsa_ref(const Frame& F, int bh, int qb) {
    const int b = bh >> 4, h = bh & 15;
    dsa::BlockRef r;
    r.Q = F.slot(4) + ((size_t)b * 2048 + (size_t)qb * 256) * 2048 + h * 128;
    r.O = F.slot(3) + ((size_t)b * 2048 + (size_t)qb * 256) * 2048 + h * 128;
    r.K = F.slot(1) + (size_t)b * 2048 * 2048 + h * 128; r.V = F.slot(2) + (size_t)b * 2048 * 2048 + h * 128;
    r.M = (const unsigned*)(F.ws + WS_MASK) + ((size_t)b * 2048 + (size_t)qb * 256) * 64;
    r.P0 = qb * 256; r.h = h;
    return r;
}
__device__ __forceinline__ void ph6_attn(const Frame& F) {
    const Args& a = *F.a;
    char* lds = (char*)F.lds;
    {
        float* bt = (float*)(lds + dsa::OFF_BIAS);
        for (int i = F.wave * 64 + F.lane(); i < 16 * 128; i += 512) { const int h = i >> 7, d = i & 127; bt[i] = (a.in[10][t5_bucket(d) * 16 + h] - a.in[10][31 * 16 + h]) * (1.0f / dsa::SCALE); }
    }
    __syncthreads();
    const int total = 4 * 128;
    int L = F.bid; if (L >= total) return;
#define ATT_BH(L_) (((L_) >> 8) * 64 + ((L_) & 7) * 8 + ((((L_) & 255) >> 3) >> 2))
#define ATT_PR(L_) ((((L_) & 255) >> 3) & 3)
    int pass = 0;
    const bool xmap = (F.G == 256);
    dsa::BlockRef cur = dsa_ref(F, xmap ? ATT_BH(L) : (L >> 2), xmap ? ATT_PR(L) : (L & 3));
    dsa::Seam S;
    dsa::prime(cur, lds, S, F.wave);
    for (;;) {
        const bool more_pass = pass == 0, more_item = L + F.G < total, last = !more_pass && !more_item;
        int passn = pass + 1, Ln = L;
        if (!more_pass) { passn = 0; Ln = more_item ? L + F.G : L; }
        const int bhn = xmap ? ATT_BH(Ln) : (Ln >> 2), prn = xmap ? ATT_PR(Ln) : (Ln & 3);
        const dsa::BlockRef nxt = last ? cur : dsa_ref(F, bhn, passn ? 7 - prn : prn);
        dsa::block(cur, nxt, lds, S, F.wave);
        if (last) break;
        cur = nxt; pass = passn; L = Ln;
    }
}

__device__ __forceinline__ void ln_row(float* zrow, const float* g, const float* bta, bf16* brow, int lane) {
    f32x4 v[8]; float s = 0.f;
#pragma unroll
    for (int i = 0; i < 8; ++i) { v[i] = *(const f32x4*)(zrow + 256 * i + 4 * lane); s += (v[i].x + v[i].y) + (v[i].z + v[i].w); }
    const float mu = wave_sum(s) * (1.0f / 2048.0f); float s2 = 0.f;
#pragma unroll
    for (int i = 0; i < 8; ++i) { v[i] = v[i] - mu; s2 += (v[i].x * v[i].x + v[i].y * v[i].y) + (v[i].z * v[i].z + v[i].w * v[i].w); }
    const float r = rsqrtf(wave_sum(s2) * (1.0f / 2048.0f) + 1e-5f);
#pragma unroll
    for (int i = 0; i < 8; ++i) { const f32x4 gg = *(const f32x4*)(g + 256 * i + 4 * lane), bb = *(const f32x4*)(bta + 256 * i + 4 * lane);
        const f32x4 o = v[i] * r * gg + bb; *(f32x4*)(zrow + 256 * i + 4 * lane) = o;
        if (brow) { u32x2 w; w.x = pk2(o.x, o.y); w.y = pk2(o.z, o.w); *(u32x2*)(brow + 256 * i + 4 * lane) = w; } }
}
__device__ __forceinline__ void ph_ln(const Frame& F, const float* g, const float* bta, bf16* bout) {
    const int gw = F.bid * 8 + F.wave, NGW = F.G * 8, lane = F.lane();
    for (int row = gw; row < T; row += NGW) ln_row(F.a->out + (size_t)row * 2048, g, bta, bout + (size_t)row * 2048, lane);
}

__device__ __forceinline__ float pk_idx(float v, unsigned code, unsigned mask) { return __uint_as_float((__float_as_uint(v) & ~mask) | code); }
__device__ __forceinline__ void ph_peer_select(const Frame& F) {
    const Args& a = *F.a;
    const int lane = F.lane(), l31 = lane & 31, half = lane >> 5;
    const float* PQ = (const float*)F.slot(1); const float* keys = a.in[23];
    int* EIDX = (int*)(F.ws + WS_CKV); float* EG = (float*)(F.ws + WS_IKW);
    const float NEG = -__builtin_inff();
    const int h = F.bid & 7, ntw = F.G >> 3;
    { const int tid = F.wave * 64 + lane;
#pragma unroll
      for (int p = 0; p < 2; ++p)
#pragma unroll
          for (int i = 0; i < 8; ++i) { const int idx = tid + 512 * i, row = idx >> 5, c4 = idx & 31;
              *(f32x4*)(F.lds + (size_t)p * 67584 + ((size_t)row * 132 + 4 * c4) * 4) = *(const f32x4*)(keys + ((size_t)(2 * h + p) * 128 + row) * 128 + 4 * c4); }
      __syncthreads(); }
    for (int tile = (F.bid >> 3) + ntw * F.wave; tile < T / 32; tile += ntw * 8) {
        const int t = tile * 32 + l31;
        float tv[2][16];
#pragma unroll
        for (int p = 0; p < 2; ++p) {
            const int g = 2 * h + p;
            float qv[64];
            { const float* qp = PQ + (size_t)t * 2048 + g * 128 + 64 * half;
#pragma unroll
              for (int j = 0; j < 16; ++j) { const f32x4 v = *(const f32x4*)(qp + 4 * j); qv[4 * j] = v.x; qv[4 * j + 1] = v.y; qv[4 * j + 2] = v.z; qv[4 * j + 3] = v.w; } }
            f32x16 acc[4];
#pragma unroll
            for (int mt = 0; mt < 4; ++mt)
#pragma unroll
                for (int r = 0; r < 16; ++r) acc[mt][r] = 0.f;
            const float* kp0 = (const float*)(F.lds + (size_t)p * 67584) + ((size_t)l31 * 132 + 64 * half);
            f32x4 kb[3][4];
#define PK_LOADC(cc) do { _Pragma("unroll") for (int u_ = 0; u_ < 4; ++u_) kb[(cc) % 3][u_] = *(const f32x4*)(kp0 + (size_t)((cc) >> 2) * 32 * 132 + 16 * ((cc) & 3) + 4 * u_); } while (0)
#define PK_MMAC(cc) do { _Pragma("unroll") for (int u_ = 0; u_ < 4; ++u_) { const f32x4 kv_ = kb[(cc) % 3][u_]; const int j_ = 4 * ((cc) & 3) + u_; \
                acc[(cc) >> 2] = __builtin_amdgcn_mfma_f32_32x32x2f32(kv_.x, qv[4 * j_], acc[(cc) >> 2], 0, 0, 0); acc[(cc) >> 2] = __builtin_amdgcn_mfma_f32_32x32x2f32(kv_.y, qv[4 * j_ + 1], acc[(cc) >> 2], 0, 0, 0); \
                acc[(cc) >> 2] = __builtin_amdgcn_mfma_f32_32x32x2f32(kv_.z, qv[4 * j_ + 2], acc[(cc) >> 2], 0, 0, 0); acc[(cc) >> 2] = __builtin_amdgcn_mfma_f32_32x32x2f32(kv_.w, qv[4 * j_ + 3], acc[(cc) >> 2], 0, 0, 0); } } while (0)
            PK_LOADC(0); PK_LOADC(1);
            PK_LOADC(2); PK_MMAC(0); __builtin_amdgcn_sched_barrier(0);
            PK_LOADC(3); PK_MMAC(1); __builtin_amdgcn_sched_barrier(0);
            PK_LOADC(4); PK_MMAC(2); __builtin_amdgcn_sched_barrier(0);
            PK_LOADC(5); PK_MMAC(3); __builtin_amdgcn_sched_barrier(0);
            PK_LOADC(6); PK_MMAC(4); __builtin_amdgcn_sched_barrier(0);
            PK_LOADC(7); PK_MMAC(5); __builtin_amdgcn_sched_barrier(0);
            PK_LOADC(8); PK_MMAC(6); __builtin_amdgcn_sched_barrier(0);
            PK_LOADC(9); PK_MMAC(7); __builtin_amdgcn_sched_barrier(0);
            PK_LOADC(10); PK_MMAC(8); __builtin_amdgcn_sched_barrier(0);
            PK_LOADC(11); PK_MMAC(9); __builtin_amdgcn_sched_barrier(0);
            PK_LOADC(12); PK_MMAC(10); __builtin_amdgcn_sched_barrier(0);
            PK_LOADC(13); PK_MMAC(11); __builtin_amdgcn_sched_barrier(0);
            PK_LOADC(14); PK_MMAC(12); __builtin_amdgcn_sched_barrier(0);
            PK_LOADC(15); PK_MMAC(13); __builtin_amdgcn_sched_barrier(0);
            PK_MMAC(14); __builtin_amdgcn_sched_barrier(0);
            PK_MMAC(15); __builtin_amdgcn_sched_barrier(0);
#undef PK_LOADC
#undef PK_MMAC
            unsigned hmask = ~(4u * (unsigned)half); asm volatile("" : "+v"(hmask));
#pragma unroll
            for (int mt = 0; mt < 4; ++mt)
#pragma unroll
                for (int r = 0; r < 16; ++r) acc[mt][r] = __uint_as_float(((__float_as_uint(acc[mt][r]) & ~127u) | (unsigned)(127 - (32 * mt + (r & 3) + 8 * (r >> 2)))) & hmask);
#pragma unroll
            for (int k = 0; k < 16; ++k) {
                float m = acc[0][0];
#pragma unroll
                for (int mt = 0; mt < 4; ++mt)
#pragma unroll
                    for (int r = 0; r < 16; ++r) m = fmaxf(m, acc[mt][r]);
                m = fmaxf(m, __shfl_xor(m, 32));
                tv[p][k] = m;
#pragma unroll
                for (int mt = 0; mt < 4; ++mt)
#pragma unroll
                    for (int r = 0; r < 16; ++r) acc[mt][r] = (acc[mt][r] == m) ? NEG : acc[mt][r];
            }
        }
        float cand[25]; int cid[25];
        unsigned hc = 25u * (unsigned)half; asm volatile("" : "+v"(hc));
        { const float ai = half ? tv[0][2] : tv[0][0], bj = half ? tv[1][1] : tv[1][0];
          cand[0] = pk_idx(ai + bj, (unsigned)(63 - 0) - hc, 63u); cid[0] = (int)((127u - (__float_as_uint(ai) & 127u)) * 128u + (127u - (__float_as_uint(bj) & 127u))); }
        { const float ai = half ? tv[0][2] : tv[0][0], bj = half ? tv[1][2] : tv[1][1];
          cand[1] = pk_idx(ai + bj, (unsigned)(63 - 1) - hc, 63u); cid[1] = (int)((127u - (__float_as_uint(ai) & 127u)) * 128u + (127u - (__float_as_uint(bj) & 127u))); }
        { const float ai = half ? tv[0][2] : tv[0][0], bj = half ? tv[1][3] : tv[1][2];
          cand[2] = pk_idx(ai + bj, (unsigned)(63 - 2) - hc, 63u); cid[2] = (int)((127u - (__float_as_uint(ai) & 127u)) * 128u + (127u - (__float_as_uint(bj) & 127u))); }
        { const float ai = half ? tv[0][2] : tv[0][0], bj = half ? tv[1][4] : tv[1][3];
          cand[3] = pk_idx(ai + bj, (unsigned)(63 - 3) - hc, 63u); cid[3] = (int)((127u - (__float_as_uint(ai) & 127u)) * 128u + (127u - (__float_as_uint(bj) & 127u))); }
        { const float ai = half ? tv[0][3] : tv[0][0], bj = half ? tv[1][0] : tv[1][4];
          cand[4] = pk_idx(ai + bj, (unsigned)(63 - 4) - hc, 63u); cid[4] = (int)((127u - (__float_as_uint(ai) & 127u)) * 128u + (127u - (__float_as_uint(bj) & 127u))); }
        { const float ai = half ? tv[0][3] : tv[0][0], bj = half ? tv[1][1] : tv[1][5];
          cand[5] = pk_idx(ai + bj, (unsigned)(63 - 5) - hc, 63u); cid[5] = (int)((127u - (__float_as_uint(ai) & 127u)) * 128u + (127u - (__float_as_uint(bj) & 127u))); }
        { const float ai = half ? tv[0][3] : tv[0][0], bj = half ? tv[1][2] : tv[1][6];
          cand[6] = pk_idx(ai + bj, (unsigned)(63 - 6) - hc, 63u); cid[6] = (int)((127u - (__float_as_uint(ai) & 127u)) * 128u + (127u - (__float_as_uint(bj) & 127u))); }
        { const float ai = half ? tv[0][3] : tv[0][0], bj = half ? tv[1][3] : tv[1][7];
          cand[7] = pk_idx(ai + bj, (unsigned)(63 - 7) - hc, 63u); cid[7] = (int)((127u - (__float_as_uint(ai) & 127u)) * 128u + (127u - (__float_as_uint(bj) & 127u))); }
        { const float ai = half ? tv[0][4] : tv[0][0], bj = half ? tv[1][0] : tv[1][8];
          cand[8] = pk_idx(ai + bj, (unsigned)(63 - 8) - hc, 63u); cid[8] = (int)((127u - (__float_as_uint(ai) & 127u)) * 128u + (127u - (__float_as_uint(bj) & 127u))); }
        { const float ai = half ? tv[0][4] : tv[0][0], bj = half ? tv[1][1] : tv[1][9];
          cand[9] = pk_idx(ai + bj, (unsigned)(63 - 9) - hc, 63u); cid[9] = (int)((127u - (__float_as_uint(ai) & 127u)) * 128u + (127u - (__float_as_uint(bj) & 127u))); }
        { const float ai = half ? tv[0][4] : tv[0][0], bj = half ? tv[1][2] : tv[1][10];
          cand[10] = pk_idx(ai + bj, (unsigned)(63 - 10) - hc, 63u); cid[10] = (int)((127u - (__float_as_uint(ai) & 127u)) * 128u + (127u - (__float_as_uint(bj) & 127u))); }
        { const float ai = half ? tv[0][5] : tv[0][0], bj = half ? tv[1][0] : tv[1][11];
          cand[11] = pk_idx(ai + bj, (unsigned)(63 - 11) - hc, 63u); cid[11] = (int)((127u - (__float_as_uint(ai) & 127u)) * 128u + (127u - (__float_as_uint(bj) & 127u))); }
        { const float ai = half ? tv[0][5] : tv[0][0], bj = half ? tv[1][1] : tv[1][12];
          cand[12] = pk_idx(ai + bj, (unsigned)(63 - 12) - hc, 63u); cid[12] = (int)((127u - (__float_as_uint(ai) & 127u)) * 128u + (127u - (__float_as_uint(bj) & 127u))); }
        { const float ai = half ? tv[0][6] : tv[0][0], bj = half ? tv[1][0] : tv[1][13];
          cand[13] = pk_idx(ai + bj, (unsigned)(63 - 13) - hc, 63u); cid[13] = (int)((127u - (__float_as_uint(ai) & 127u)) * 128u + (127u - (__float_as_uint(bj) & 127u))); }
        { const float ai = half ? tv[0][6] : tv[0][0], bj = half ? tv[1][1] : tv[1][14];
          cand[14] = pk_idx(ai + bj, (unsigned)(63 - 14) - hc, 63u); cid[14] = (int)((127u - (__float_as_uint(ai) & 127u)) * 128u + (127u - (__float_as_uint(bj) & 127u))); }
        { const float ai = half ? tv[0][7] : tv[0][0], bj = half ? tv[1][0] : tv[1][15];
          cand[15] = pk_idx(ai + bj, (unsigned)(63 - 15) - hc, 63u); cid[15] = (int)((127u - (__float_as_uint(ai) & 127u)) * 128u + (127u - (__float_as_uint(bj) & 127u))); }
        { const float ai = half ? tv[0][7] : tv[0][1], bj = half ? tv[1][1] : tv[1][0];
          cand[16] = pk_idx(ai + bj, (unsigned)(63 - 16) - hc, 63u); cid[16] = (int)((127u - (__float_as_uint(ai) & 127u)) * 128u + (127u - (__float_as_uint(bj) & 127u))); }
        { const float ai = half ? tv[0][8] : tv[0][1], bj = half ? tv[1][0] : tv[1][1];
          cand[17] = pk_idx(ai + bj, (unsigned)(63 - 17) - hc, 63u); cid[17] = (int)((127u - (__float_as_uint(ai) & 127u)) * 128u + (127u - (__float_as_uint(bj) & 127u))); }
        { const float ai = half ? tv[0][9] : tv[0][1], bj = half ? tv[1][0] : tv[1][2];
          cand[18] = pk_idx(ai + bj, (unsigned)(63 - 18) - hc, 63u); cid[18] = (int)((127u - (__float_as_uint(ai) & 127u)) * 128u + (127u - (__float_as_uint(bj) & 127u))); }
        { const float ai = half ? tv[0][10] : tv[0][1], bj = half ? tv[1][0] : tv[1][3];
          cand[19] = pk_idx(ai + bj, (unsigned)(63 - 19) - hc, 63u); cid[19] = (int)((127u - (__float_as_uint(ai) & 127u)) * 128u + (127u - (__float_as_uint(bj) & 127u))); }
        { const float ai = half ? tv[0][11] : tv[0][1], bj = half ? tv[1][0] : tv[1][4];
          cand[20] = pk_idx(ai + bj, (unsigned)(63 - 20) - hc, 63u); cid[20] = (int)((127u - (__float_as_uint(ai) & 127u)) * 128u + (127u - (__float_as_uint(bj) & 127u))); }
        { const float ai = half ? tv[0][12] : tv[0][1], bj = half ? tv[1][0] : tv[1][5];
          cand[21] = pk_idx(ai + bj, (unsigned)(63 - 21) - hc, 63u); cid[21] = (int)((127u - (__float_as_uint(ai) & 127u)) * 128u + (127u - (__float_as_uint(bj) & 127u))); }
        { const float ai = half ? tv[0][13] : tv[0][1], bj = half ? tv[1][0] : tv[1][6];
          cand[22] = pk_idx(ai + bj, (unsigned)(63 - 22) - hc, 63u); cid[22] = (int)((127u - (__float_as_uint(ai) & 127u)) * 128u + (127u - (__float_as_uint(bj) & 127u))); }
        { const float ai = half ? tv[0][14] : tv[0][1], bj = half ? tv[1][0] : tv[1][7];
          cand[23] = pk_idx(ai + bj, (unsigned)(63 - 23) - hc, 63u); cid[23] = (int)((127u - (__float_as_uint(ai) & 127u)) * 128u + (127u - (__float_as_uint(bj) & 127u))); }
        { const float ai = half ? tv[0][15] : tv[0][2], bj = half ? tv[1][0] : tv[1][0];
          cand[24] = pk_idx(ai + bj, (unsigned)(63 - 24) - hc, 63u); cid[24] = (int)((127u - (__float_as_uint(ai) & 127u)) * 128u + (127u - (__float_as_uint(bj) & 127u))); }
        float sv[16]; int sid[16];
#pragma unroll
        for (int k = 0; k < 16; ++k) {
            float m = cand[0];
#pragma unroll
            for (int c = 1; c < 25; ++c) m = fmaxf(m, cand[c]);
            const float mo = __shfl_xor(m, 32);
            const bool mine = (m > mo) || (m == mo && half == 0);
            const float mm = fmaxf(m, mo);
            int id = -1;
#pragma unroll
            for (int c = 0; c < 25; ++c) { const bool hit = mine && (cand[c] == mm); id = hit ? cid[c] : id; cand[c] = hit ? NEG : cand[c]; }
            const int ido = __shfl_xor(id, 32);
            sv[k] = mm; sid[k] = id > ido ? id : ido;
        }
        float den = 0.f; float ev[16];
#pragma unroll
        for (int k = 0; k < 16; ++k) { ev[k] = expf(sv[k] - sv[0]); den += ev[k]; }
        const float inv = 1.0f / den;
        if (half == 0) { int* ep = EIDX + (size_t)t * 128 + h * 16;
#pragma unroll
            for (int k = 0; k < 16; k += 4) *(u32x4*)(ep + k) = (u32x4){(unsigned)sid[k], (unsigned)sid[k + 1], (unsigned)sid[k + 2], (unsigned)sid[k + 3]}; }
        else { float* gp = EG + (size_t)t * 128 + h * 16;
#pragma unroll
            for (int k = 0; k < 16; k += 4) *(f32x4*)(gp + k) = (f32x4){ev[k] * inv, ev[k + 1] * inv, ev[k + 2] * inv, ev[k + 3] * inv}; }
    }
}

typedef unsigned v6u __attribute__((ext_vector_type(6)));
typedef float v32f __attribute__((ext_vector_type(32)));
typedef float v16f __attribute__((ext_vector_type(16)));
constexpr float PU_SCALE = 64.0f, PV_SCALE = 2.0f;
#ifndef FP6_INTERLEAVED
#define FP6_INTERLEAVED 1
#endif
#define RL(v, l) __builtin_amdgcn_readlane((v), (l))
#define EXR 2
#define EX_LOAD(bu, bv, idv, e) do { _Pragma("unroll") for (int r_ = 0; r_ < EXR; ++r_) { const unsigned* rp_ = (const unsigned*)(PUV + (size_t)RL(idv, ((e) & 63) + r_) * 3072) + 6 * lane; \
        const u32x2 p0_ = *(const u32x2*)rp_, p1_ = *(const u32x2*)(rp_ + 2), p2_ = *(const u32x2*)(rp_ + 4), q0_ = *(const u32x2*)(rp_ + 384), q1_ = *(const u32x2*)(rp_ + 386), q2_ = *(const u32x2*)(rp_ + 388); \
        bu[r_] = (v6u){p0_.x, p0_.y, p1_.x, p1_.y, p2_.x, p2_.y}; bv[r_] = (v6u){q0_.x, q0_.y, q1_.x, q1_.y, q2_.x, q2_.y}; } } while (0)
#define EX_USE(bu, bv, e) do { float d_[EXR]; _Pragma("unroll") for (int r_ = 0; r_ < EXR; ++r_) { const v32f w_ = __builtin_amdgcn_cvt_scalef32_pk32_f32_fp6(bu[r_], 1.0f); float a_ = 0.f, b_ = 0.f; \
        _Pragma("unroll") for (int j_ = 0; j_ < 32; j_ += 2) { a_ += w_[j_] * xf[j_]; b_ += w_[j_ + 1] * xf[j_ + 1]; } d_[r_] = a_ + b_; __builtin_amdgcn_sched_barrier(0); } \
        _Pragma("unroll") for (int r_ = 0; r_ < EXR; ++r_) d_[r_] = wave_sum_dpp(d_[r_]); \
        const float gv_ = (e) < 64 ? g0 : g1; \
        _Pragma("unroll") for (int r_ = 0; r_ < EXR; ++r_) { const float pre_ = d_[r_] * (1.0f / PU_SCALE); const float hv_ = 0.5f * pre_ * (1.0f + erff(pre_ * 0.7071067811865476f)); \
            const float cf_ = __int_as_float(RL(__float_as_int(gv_), ((e) & 63) + r_)) * hv_ * (1.0f / PV_SCALE); \
            const v32f w_ = __builtin_amdgcn_cvt_scalef32_pk32_f32_fp6(bv[r_], 1.0f); _Pragma("unroll") for (int j_ = 0; j_ < 32; ++j_) y[j_] += cf_ * w_[j_]; __builtin_amdgcn_sched_barrier(0); } } while (0)
__device__ __forceinline__ void cvt_fp6_stream(const Frame& F, const float* src, unsigned char* dst, size_t nrows, float scale, int wg, int nwg) {
    const int lane = F.lane();
    float* tile = (float*)(F.lds + F.wave * 8192);
    for (size_t r = (size_t)wg * 8 + F.wave; r < nrows; r += (size_t)nwg * 8) {
#pragma unroll
        for (int j = 0; j < 8; ++j) *(f32x4*)(tile + 256 * j + 4 * lane) = *(const f32x4*)(src + r * 2048 + 256 * j + 4 * lane) * scale;
        WAVE_SYNC();
        f32x4 q[8];
#pragma unroll
        for (int j = 0; j < 8; ++j) q[j] = *(const f32x4*)(tile + 32 * lane + 4 * j);
        WAVE_SYNC();
        v16f x, y;
#pragma unroll
        for (int j = 0; j < 8; ++j) { x[2 * j] = q[j].x; y[2 * j] = q[j].y; x[2 * j + 1] = q[j].z; y[2 * j + 1] = q[j].w; }
        const v6u p = __builtin_amdgcn_cvt_scalef32_2xpk16_fp6_f32(x, y, 1.0f);
        unsigned* o = (unsigned*)(dst + r * 3072) + 6 * lane;
        *(u32x2*)o = (u32x2){p[0], p[1]}; *(u32x2*)(o + 2) = (u32x2){p[2], p[3]}; *(u32x2*)(o + 4) = (u32x2){p[4], p[5]};
    }
}
#define EX_LOAD_XF() do { float mu_, rs_; row_mu_rstd((const float*)(F.ws + WS_CTL + CTL_ST2), t, mu_, rs_); \
          const bf16* zr = F.slot(0) + (size_t)t * 2048 + lq; \
          _Pragma("unroll") for (int q = 0; q < 4; ++q) { const int col = lq + 8 * q; f32x4 z0, z1; unpack8v(*(const u32x4*)(zr + 8 * q), z0, z1); \
              const f32x4 g0v = *(const f32x4*)(a.in[20] + col), g1v = *(const f32x4*)(a.in[20] + col + 4), b0v = *(const f32x4*)(a.in[21] + col), b1v = *(const f32x4*)(a.in[21] + col + 4); \
              const f32x4 h0 = (z0 - mu_) * rs_ * g0v + b0v, h1 = (z1 - mu_) * rs_ * g1v + b1v; \
              xf[8 * q] = h0.x; xf[8 * q + 1] = h0.y; xf[8 * q + 2] = h0.z; xf[8 * q + 3] = h0.w; xf[8 * q + 4] = h1.x; xf[8 * q + 5] = h1.y; xf[8 * q + 6] = h1.z; xf[8 * q + 7] = h1.w; } } while (0)
__device__ __forceinline__ void ph16_experts(const Frame& F) {
    const Args& a = *F.a;
    const int gw = F.bid * 8 + F.wave, NGW = F.G * 8, lane0 = F.lane();
    const int* EIDX = (const int*)(F.ws + WS_CKV); const float* EG = (const float*)(F.ws + WS_IKW);
    const unsigned char* PUV = (const unsigned char*)(F.ws + WS_WIN);
    for (int t = gw; t < T; t += NGW) {
        int lane_l = lane0; asm volatile("" : "+v"(lane_l)); const int lane = lane_l;
        float* xrow = a.out + (size_t)t * 2048;
        float xf[32];
        const int lq = 32 * lane;
        EX_LOAD_XF();
        const int id0 = EIDX[(size_t)t * 128 + lane], id1 = EIDX[(size_t)t * 128 + 64 + lane];
        const float g0 = EG[(size_t)t * 128 + lane], g1 = EG[(size_t)t * 128 + 64 + lane];
        float y[32];
#pragma unroll
        for (int j = 0; j < 32; ++j) y[j] = 0.f;
        v6u uA[EXR], vA[EXR], uB[EXR], vB[EXR];
        EX_LOAD(uA, vA, id0, 0);
#pragma unroll 1
        for (int e = 0; e < 128; e += 2 * EXR) {
            const int idv = e < 64 ? id0 : id1;
            EX_LOAD(uB, vB, idv, e + EXR);
            EX_USE(uA, vA, e);
            if (e + 2 * EXR < 128) { const int idn = (e + 2 * EXR) < 64 ? id0 : id1; EX_LOAD(uA, vA, idn, e + 2 * EXR); }
            EX_USE(uB, vB, e + EXR);
        }
        float s = 0.f;
#pragma unroll
        for (int j = 0; j < 32; ++j) { y[j] += ALPHA * xf[j]; s += y[j]; }
        const float mu = wave_sum_dpp(s) * (1.0f / 2048.0f); float s2 = 0.f;
#pragma unroll
        for (int j = 0; j < 32; ++j) { y[j] -= mu; s2 += y[j] * y[j]; }
        const float rs = rsqrtf(wave_sum_dpp(s2) * (1.0f / 2048.0f) + 1e-5f);
        const int lofs = lq;
#pragma unroll
        for (int q = 0; q < 8; ++q) { const int col = lofs + 4 * q;
            const f32x4 ga = *(const f32x4*)(a.in[26] + col), ba = *(const f32x4*)(a.in[27] + col);
            f32x4 o; o.x = y[4 * q] * rs * ga.x + ba.x; o.y = y[4 * q + 1] * rs * ga.y + ba.y; o.z = y[4 * q + 2] * rs * ga.z + ba.z; o.w = y[4 * q + 3] * rs * ga.w + ba.w;
            *(f32x4*)(xrow + col) = o; }
    }
}

#define XB_TMO      128
#define XB_XCNT(j)  (256  + 64 * (j))
#define XB_XSUB(j)  (1280 + 64 * (j))
#define XB_XGEN(j)  (2304 + 64 * (j))
#define XB_TOP      3328
#define XB_TOPGEN   3392
#define XCD_BAR_WORDS 3456
#define XB_SPIN_CAP (1u << 22)
__device__ __forceinline__ unsigned xb_ld(unsigned* p)              { return __hip_atomic_load(p, __ATOMIC_RELAXED, __HIP_MEMORY_SCOPE_AGENT); }
__device__ __forceinline__ unsigned xb_add(unsigned* p, unsigned v) { return __hip_atomic_fetch_add(p, v, __ATOMIC_RELAXED, __HIP_MEMORY_SCOPE_AGENT); }
__device__ __forceinline__ unsigned xb_xcc_id() { return (unsigned)__builtin_amdgcn_s_getreg((3 << 11) | 20) & 0xFu; }
#define XB_SPIN(cond, bar) do { unsigned _sp = 0; while (cond) { __builtin_amdgcn_s_sleep(1); \
    if ((++_sp & 255u) == 0u) { if (xb_ld(&(bar)[XB_TMO])) break; if (_sp > XB_SPIN_CAP) { atomicAdd(&(bar)[XB_TMO], 1u); break; } } } } while (0)
struct XcdBarrier { unsigned* bar; unsigned x; volatile unsigned* st; };
__device__ __forceinline__ void xcd_barrier_complete(unsigned* bar, unsigned x, unsigned G, unsigned& nloc, unsigned& nx) {
    unsigned sum, cnt, mine, sp = 0u;
    for (;;) {
        sum = 0u; cnt = 0u; mine = 0u;
#pragma unroll
        for (unsigned j = 0; j < 16; ++j) { const unsigned c = xb_ld(&bar[XB_XCNT(j)]); sum += c; cnt += (c > 0u) ? 1u : 0u; mine = (j == x) ? c : mine; }
        if (sum == G) break;
        __builtin_amdgcn_s_sleep(1);
        if ((++sp & 255u) == 0u) { if (xb_ld(&bar[XB_TMO])) break; if (sp > XB_SPIN_CAP) { atomicAdd(&bar[XB_TMO], 1u); break; } }
    }
    nloc = mine > 0u ? mine : 1u; nx = cnt > 0u ? cnt : 1u;
}
__device__ __forceinline__ void xcd_barrier(const XcdBarrier& b, bool leader, unsigned G) {
    asm volatile("s_waitcnt vmcnt(0)" ::: "memory");
    __syncthreads();
    if (leader) {
        unsigned* bar = b.bar;
        __builtin_amdgcn_s_waitcnt(0);
        unsigned nloc = b.st[0], nx = b.st[1];
        if (nloc == 0u) { xcd_barrier_complete(bar, b.x, G, nloc, nx); b.st[0] = nloc; b.st[1] = nx; }
        const unsigned old = xb_add(&bar[XB_XSUB(b.x)], 1u);
        const unsigned gen = old / nloc;
        if (old + 1u == (gen + 1u) * nloc) {
            __builtin_amdgcn_fence(__ATOMIC_RELEASE, "agent");
            asm volatile("s_waitcnt vmcnt(0)" ::: "memory");
            const unsigned og = xb_add(&bar[XB_TOP], 1u);
            const unsigned tg = og / nx;
            if (og + 1u == (tg + 1u) * nx) xb_add(&bar[XB_TOPGEN], 1u);
            else XB_SPIN(xb_ld(&bar[XB_TOPGEN]) == tg, bar);
            __builtin_amdgcn_fence(__ATOMIC_ACQUIRE, "agent");
            xb_add(&bar[XB_XGEN(b.x)], 1u);
            asm volatile("s_waitcnt vmcnt(0)" ::: "memory");
        } else {
            XB_SPIN(xb_ld(&bar[XB_XGEN(b.x)]) == gen, bar);
            __builtin_amdgcn_fence(__ATOMIC_ACQUIRE, "agent");
            asm volatile("s_waitcnt vmcnt(0)" ::: "memory");
        }
    }
    __syncthreads();
}

__device__ __forceinline__ void sub_barrier(unsigned* ctr, unsigned n, bool leader) {
    asm volatile("s_waitcnt vmcnt(0)" ::: "memory");
    __syncthreads();
    if (leader) {
        __builtin_amdgcn_fence(__ATOMIC_RELEASE, "agent");
        asm volatile("s_waitcnt vmcnt(0)" ::: "memory");
        (void)xb_add(ctr, 1u);
        unsigned sp = 0u; while (xb_ld(ctr) < n) { __builtin_amdgcn_s_sleep(1); if (++sp > XB_SPIN_CAP) break; }
        __builtin_amdgcn_fence(__ATOMIC_ACQUIRE, "agent");
        asm volatile("s_waitcnt vmcnt(0)" ::: "memory");
    }
    __syncthreads();
}

__global__ void __launch_bounds__(512, 2) mega(Args args) {
    extern __shared__ __attribute__((aligned(16))) unsigned char lds[];
    cg::grid_group grid = cg::this_grid();
    Frame F;
    F.lds = lds; F.wave = __builtin_amdgcn_readfirstlane(threadIdx.x >> 6); F.bid = blockIdx.x; F.G = gridDim.x;
    F.a = &args; F.ws = args.ws;
    const int lo = args.ph_lo, hi = args.ph_hi;
    unsigned long long sec_acc = 0ull;
    if (lo < 0) grid.sync();
    volatile unsigned* xst = (volatile unsigned*)(lds + LDS_BYTES - 64);
    const bool leader = (F.wave == 0) && (fresh_lane() == 0);
    if (leader) { xst[0] = 0u; xst[1] = 0u; }
    XcdBarrier xbar; xbar.bar = (unsigned*)(F.ws + WS_CTL + CTL_BAR); xbar.x = xb_xcc_id(); xbar.st = xst;
    if (leader) (void)xb_add(&xbar.bar[XB_XCNT(xbar.x)], 1u);
    __syncthreads();
    bf16* W8 = (bf16*)((unsigned char*)args.out + (size_t)64 * MiB);
#define IN(k) (lo <= (k) && (k) < hi)
#if PROBE_MASK
    unsigned long long pr_acc = 0ull, pr_t0 = rt_now();
#define SEAM(k) do { if (IN(k) && IN((k) + 1)) { xcd_barrier(xbar, (F.wave == 0) && (fresh_lane() == 0), (unsigned)F.G); } { const unsigned long long t1_ = rt_now(); if ((PROBE_MASK >> (k)) & 1u) pr_acc += t1_ - pr_t0; pr_t0 = t1_; } } while (0)
#else
#define SEAM(k) do { if (IN(k) && IN((k) + 1)) { xcd_barrier(xbar, (F.wave == 0) && (fresh_lane() == 0), (unsigned)F.G); } } while (0)
#endif
    if (IN(0)) { ph0_prologue(F); } SEAM(0);
    if (IN(1)) {
        pg8::MultiOrder<3> S; S.lda = 2048; S.ldb = 2048; S.G = F.G; S.c = F.bid;
        S.s[0] = pg8::Sub{(const bf16*)args.out, (const bf16*)(F.ws + WS_WIN), 64, NCOLS / 256};
        S.s[1] = pg8::Sub{(const bf16*)(F.ws + WS_MEMB), W8 + (size_t)4 * 2048 * 2048, 8, 8};
        S.s[2] = pg8::Sub{W8 + (size_t)5 * 2048 * 2048, (const bf16*)(F.ws + WS_MEMB), 8, 8};
        gemm_multi<3>(F, S, 2048, OpProjCKV{F.ws});
        w8_transposes(F, W8);
    } SEAM(1);
    if (IN(2)) {
        if (F.G == 256) {
            if (F.bid < 128) { hgrn_chunked(F, F.bid, sec_acc);
                cvt_fp6_stream(F, args.in[24], F.ws + WS_WIN, (size_t)16384, PU_SCALE, F.bid, 128); cvt_fp6_stream(F, args.in[25], F.ws + WS_WIN + 1536, (size_t)16384, PV_SCALE, F.bid, 128); }
            else { ph2_side(F, F.bid - 128, 128); sub_barrier((unsigned*)(F.ws + WS_CTL + CTL_BAR) + 3520, 128u, (F.wave == 0) && (fresh_lane() == 0)); ph5_select(F, F.bid - 128, 128); }
        } else {
            for (int u = F.bid; u < 128; u += F.G) hgrn_chunked(F, u, sec_acc);
            ph2_side(F, F.bid, F.G);
            xcd_barrier(xbar, (F.wave == 0) && (fresh_lane() == 0), (unsigned)F.G);
            ph5_select(F, F.bid, F.G);
            cvt_fp6_stream(F, args.in[24], F.ws + WS_WIN, (size_t)16384, PU_SCALE, F.bid, F.G); cvt_fp6_stream(F, args.in[25], F.ws + WS_WIN + 1536, (size_t)16384, PV_SCALE, F.bid, F.G);
        }
    } SEAM(2);
    if (IN(4)) {
        gemm(F, (const bf16*)(F.ws + WS_CKV), 256, (const bf16*)(F.ws + WS_WKV), 256, T, 4096, 256, OpSplit2{F.slot(1), F.slot(2)});
    } SEAM(4);
    if (IN(6)) { ph6_attn(F); } SEAM(6);
    if (IN(7)) {
        pg8::Gemm g{2048, 4096, 4096}; pg8::MultiOrder<1> S; S.s[0] = pg8::Sub{F.slot(0), W8, 64, 8}; S.lda = 2048; S.ldb = 4096; S.G = F.G; S.c = F.bid; S.A2 = F.slot(3);
        EpiYAB E{F.slot(6), F.slot(7)};
        pg8::gemm_phase<EpiYAB, pg8::MultiOrder<1>, true, true>((PG8_LAS unsigned char*)F.lds, g, S, E, F.wave, F.lane());
    } SEAM(7);
    if (IN(8)) { gemm_epi(F, F.slot(6), 2048, W8 + (size_t)2 * 2048 * 2048, 2048, T, 2048, 2048, EpiMixStats{args.in[0], F.slot(0), (float*)(F.ws + WS_CTL + CTL_ST1)}); } SEAM(8);
    if (IN(10)) { gemm(F, F.slot(0), 2048, W8 + (size_t)3 * 2048 * 2048, 2048, T, 2048, 2048, OpCQKV{F.slot(1), nullptr, nullptr, (float*)(F.ws + WS_CTL + CTL_ST1), (float*)(F.ws + WS_CTL + CTL_CVEC), (float*)(F.ws + WS_CTL + CTL_CVEC) + 2048}); } SEAM(10);
    if (IN(11)) {
        pg8::BatchOrder<OffS> S{F.slot(1), (const bf16*)(F.ws + WS_CK), 8, 1, 32, 2048, 2048, F.G, F.bid, OffS()};
        if (F.G == 256) { pg8::Gemm g{2048, 2048, 512}; EpiXSoftmax E{F.slot(3)};
            pg8::gemm_phase<EpiXSoftmax, pg8::BatchOrder<OffS>, false, false, true>((PG8_LAS unsigned char*)F.lds, g, S, E, F.wave, F.lane()); }
        else gemm_batch(F, S, 512, OpLogit{(float*)F.slot(2)});
    } SEAM(11);
    if (IN(12)) { if (F.G != 256) ph_xsoftmax(F, (const float*)F.slot(2), F.slot(3)); } if (F.G != 256) SEAM(12);
    if (IN(13)) {
        pg8::BatchOrder<OffPV> S{F.slot(3), (const bf16*)(F.ws + WS_VT), 8, 2, 32, 1024, 2048, F.G, F.bid, OffPV()};
        gemm_batch(F, S, 256, OpCO{F.slot(4)});
    } SEAM(13);
    if (IN(14)) { gemm_epi(F, F.slot(4), 2048, W8 + (size_t)6 * 2048 * 2048, 2048, T, 2048, 2048, EpiCOStats{F.slot(0), (float*)(F.ws + WS_CTL + CTL_ST1), (float*)(F.ws + WS_CTL + CTL_ST2), args.in[14], args.in[15]}); } SEAM(14);
    if (IN(16)) { gemm(F, F.slot(0), 2048, W8 + (size_t)7 * 2048 * 2048, 2048, T, 2048, 2048, OpPQFold{(float*)F.slot(1), (float*)(F.ws + WS_CTL + CTL_ST2), (float*)(F.ws + WS_CTL + CTL_CVEC) + 4096, (float*)(F.ws + WS_CTL + CTL_CVEC) + 6144}); } SEAM(16);
    if (IN(17)) { ph_peer_select(F); } SEAM(17);
    if (IN(18)) { ph16_experts(F); }
#if PROBE_MASK
    xcd_barrier(xbar, (F.wave == 0) && (fresh_lane() == 0), (unsigned)F.G);
    { const unsigned long long t1_ = rt_now(); if ((PROBE_MASK >> 18) & 1u) pr_acc += t1_ - pr_t0; pr_acc += sec_acc;
      if (F.bid == 0 && threadIdx.x == 0) { const unsigned long long ts_ = rt_now(); while (rt_now() - ts_ < pr_acc) __builtin_amdgcn_s_sleep(8); } }
#endif
#undef IN
#undef SEAM
}

extern "C" void kernel_launch(void* const* d_in, const int* in_sizes, int n_in, void* d_out, int out_size, void* d_ws, size_t ws_size, hipStream_t stream) {
    static int grid = 0;
    if (grid == 0) {
        if (n_in != 28 || out_size != T * D || ws_size < WS_END) { fprintf(stderr, "kernel_launch: unexpected shapes (n_in %d out %d ws %zu)\n", n_in, out_size, ws_size); grid = -1; return; }
        int dev = 0, cus = 0, per_cu = 0;
        hipGetDevice(&dev); hipDeviceGetAttribute(&cus, hipDeviceAttributeMultiprocessorCount, dev);
        hipFuncSetAttribute((const void*)mega, hipFuncAttributeMaxDynamicSharedMemorySize, LDS_BYTES);
        hipOccupancyMaxActiveBlocksPerMultiprocessor(&per_cu, (const void*)mega, 512, LDS_BYTES);
        if (per_cu < 1) { fprintf(stderr, "kernel_launch: occupancy query says %d blocks per CU\n", per_cu); per_cu = 1; }
        (void)hipGetLastError();
        grid = cus;
    }
    if (grid < 0) return;
    (void)hipMemsetAsync((char*)d_ws + WS_CTL, 0, CTL_ZERO, stream);
    Args a{};
    for (int i = 0; i < 28; ++i) a.in[i] = (const float*)d_in[i];
    a.out = (float*)d_out; a.ws = (unsigned char*)d_ws;
#if ONE_LAUNCH
    a.ph_lo = 0; a.ph_hi = NPH;
    void* params[] = {&a};
    hipError_t e = hipLaunchCooperativeKernel((const void*)mega, dim3(grid), dim3(512), params, LDS_BYTES, stream);
    if (e != hipSuccess) fprintf(stderr, "cooperative launch failed: %s\n", hipGetErrorString(e));
#else
    for (int ph = 0; ph < NPH; ++ph) {
        a.ph_lo = ph; a.ph_hi = ph + 1;
        void* params[] = {&a};
        hipError_t e = hipLaunchCooperativeKernel((const void*)mega, dim3(grid), dim3(512), params, LDS_BYTES, stream);
        if (e != hipSuccess) { fprintf(stderr, "launch %d failed: %s\n", ph, hipGetErrorString(e)); break; }
    }
#endif
}
```

```cpp
#include <hip/hip_runtime.h>
#include <hip/hip_cooperative_groups.h>
#include <cstdint>
#include <cmath>
#include <cstdio>
namespace cg = cooperative_groups;

#ifndef ONE_LAUNCH
#define ONE_LAUNCH 1
#endif
#ifndef PROBE_MASK
#define PROBE_MASK 0u
#endif
#ifndef PROBE_SEC
#define PROBE_SEC 0
#endif

typedef unsigned short bf16;
typedef short bf16x8 __attribute__((ext_vector_type(8)));
typedef float f32x4 __attribute__((ext_vector_type(4)));
typedef float f32x16 __attribute__((ext_vector_type(16)));
typedef unsigned u32x4 __attribute__((ext_vector_type(4)));
typedef unsigned u32x2 __attribute__((ext_vector_type(2)));
typedef float f32x2v __attribute__((ext_vector_type(2)));

constexpr int T = 16384, D = 2048, SEQ = 2048, NB = 8;
constexpr int NCOLS = 16896;
constexpr float ALPHA = 1.189207115002721f;
constexpr int NPH = 19;

constexpr size_t MiB = 1u << 20;
constexpr size_t WS_CTL = 0, WS_MEMB = 1 * MiB, WS_WKV = 9 * MiB, WS_LB = 11 * MiB, WS_MASK = 12 * MiB, WS_WIN = 17 * MiB,
                 WS_SLOT = 83 * MiB, SLOT_BYTES = 64 * MiB, WS_CKV = 595 * MiB, WS_IKW = 603 * MiB, WS_CK = 611 * MiB, WS_VT = 619 * MiB, WS_END = 627 * MiB;
constexpr int LDS_BYTES = 157696;
constexpr size_t CTL_BAR = 16384, CTL_CVEC = 65536, CTL_ST1 = 262144, CTL_ST2 = 393216, CTL_ZERO = 524288;

struct Args {
    const float* in[28];
    float* out;
    unsigned char* ws;
    int ph_lo, ph_hi;
};

#define WAVE_SYNC() asm volatile("s_waitcnt lgkmcnt(0)" ::: "memory")

__device__ __forceinline__ unsigned f2bf(float f) { unsigned u = __float_as_uint(f); return (u + 0x7fffu + ((u >> 16) & 1u)) >> 16; }
__device__ __forceinline__ unsigned pk2(float lo, float hi) { return f2bf(lo) | (f2bf(hi) << 16); }
__device__ __forceinline__ float bf2f(unsigned h) { return __uint_as_float(h << 16); }
__device__ __forceinline__ float bflo(unsigned w) { return __uint_as_float(w << 16); }
__device__ __forceinline__ float bfhi(unsigned w) { return __uint_as_float(w & 0xffff0000u); }
__device__ __forceinline__ float wave_sum(float v) {
#pragma unroll
    for (int o = 32; o >= 1; o >>= 1) v += __shfl_xor(v, o);
    return v;
}
__device__ __forceinline__ float wave_max(float v) {
#pragma unroll
    for (int o = 32; o >= 1; o >>= 1) v = fmaxf(v, __shfl_xor(v, o));
    return v;
}
__device__ __forceinline__ float row16_sum(float v) {
    v += __int_as_float(__builtin_amdgcn_mov_dpp(__float_as_int(v), 0xB1, 0xF, 0xF, false));
    v += __int_as_float(__builtin_amdgcn_mov_dpp(__float_as_int(v), 0x4E, 0xF, 0xF, false));
    v += __int_as_float(__builtin_amdgcn_mov_dpp(__float_as_int(v), 0x124, 0xF, 0xF, false));
    v += __int_as_float(__builtin_amdgcn_mov_dpp(__float_as_int(v), 0x128, 0xF, 0xF, false));
    return v;
}
__device__ __forceinline__ float wave_sum_dpp(float v) {
    v = row16_sum(v);
    return (__int_as_float(__builtin_amdgcn_readlane(__float_as_int(v), 0)) + __int_as_float(__builtin_amdgcn_readlane(__float_as_int(v), 16)))
         + (__int_as_float(__builtin_amdgcn_readlane(__float_as_int(v), 32)) + __int_as_float(__builtin_amdgcn_readlane(__float_as_int(v), 48)));
}
__device__ __forceinline__ float sigm(float x) { return 1.0f / (1.0f + expf(-x)); }
__device__ __forceinline__ void unpack8(u32x4 w, float* f) {
    f[0] = bflo(w.x); f[1] = bfhi(w.x); f[2] = bflo(w.y); f[3] = bfhi(w.y); f[4] = bflo(w.z); f[5] = bfhi(w.z); f[6] = bflo(w.w); f[7] = bfhi(w.w);
}

__device__ __forceinline__ int fresh_lane() { int l; asm volatile("v_mbcnt_lo_u32_b32 %0, -1, 0\n\tv_mbcnt_hi_u32_b32 %0, -1, %0" : "=v"(l)); return l; }
__device__ __forceinline__ unsigned long long rt_now() { unsigned long long t; asm volatile("s_memrealtime %0\n\ts_waitcnt lgkmcnt(0)" : "=s"(t) :: "memory"); return t; }
struct Frame {
    unsigned char* lds;
    int wave, bid, G;
    __device__ __forceinline__ int lane() const { return fresh_lane(); }
    const Args* a;
    unsigned char* ws;
    __device__ __forceinline__ bf16* slot(int i) const { return (bf16*)(ws + WS_SLOT + (size_t)i * SLOT_BYTES); }
};

namespace pg8 {
#define PG8_LAS __attribute__((address_space(3)))
constexpr int BM = 256, BK = 64, HALF = 128, HTB = HALF * BK * 2, STAGE_BYTES = 8 * HTB, NXCD = 8, WGM = 8;
__host__ __device__ __forceinline__ int lds_byte(int r, int c) { const int st = (r >> 4) * 2 + (c >> 5), rr = r & 15, cc = c & 31, ob = rr * 64 + cc * 2; return st * 1024 + (ob ^ (((ob >> 9) & 1) << 5)); }
__host__ __device__ __forceinline__ void stage_rc(int b, int& R, int& C) { const int st = b / 1024, sb = b % 1024, swz = sb ^ (((sb >> 9) & 1) << 5); R = (st >> 1) * 16 + swz / 64; C = (st & 1) * 32 + (swz % 64) / 2; }
__host__ __device__ __forceinline__ int perm32(int rho) { const int n = rho >> 4, i = rho & 15; return 8 * (i >> 2) + 4 * n + (i & 3); }
struct Unit { int pm, pn, z; const char* a; const char* b; const char* a2; };
struct Gemm { int lda, ldb, K; };
__device__ __forceinline__ void tile_of(int wgid, int nM, int nN, int& pm, int& pn) {
    const int nwg = nM * nN; { const int q = nwg / NXCD, r = nwg % NXCD, xcd = wgid % NXCD, off = wgid / NXCD; wgid = (xcd < r ? xcd * (q + 1) : r * (q + 1) + (xcd - r) * q) + off; }
    const int nig = WGM * nN, gid = wgid / nig, fm = gid * WGM, gsz = (nM - fm) < WGM ? (nM - fm) : WGM;
    pm = fm + ((wgid % nig) % gsz); pn = (wgid % nig) / gsz;
}
struct Sub { const bf16* A; const bf16* Bt; int nM, nN; };
template <int NS> struct MultiOrder {
    Sub s[NS]; int lda, ldb, G, c; const bf16* A2 = nullptr;
    __device__ __forceinline__ bool next(int i, Unit& u) const {
        int L = i * G + c;
#pragma unroll
        for (int k = 0; k < NS; ++k) { const int n = s[k].nM * s[k].nN;
            if (L < n) { tile_of(L, s[k].nM, s[k].nN, u.pm, u.pn); u.z = k; u.a = (const char*)(s[k].A + (size_t)u.pm * BM * lda); u.b = (const char*)(s[k].Bt + (size_t)u.pn * BM * ldb); u.a2 = A2 ? (const char*)(A2 + (size_t)u.pm * BM * lda) : nullptr; return true; }
            L -= n; }
        return false;
    }
};
template <class Off> struct BatchOrder {
    const bf16* A; const bf16* Bt; int nM, nN, nz, lda, ldb, G, c; Off off;
    __device__ __forceinline__ bool next(int i, Unit& u) const {
        const int L = i * G + c, per = nM * nN; if (L >= per * nz) return false;
        u.z = L / per; const int r = L % per; u.pn = r / nM; u.pm = r % nM;
        u.a = (const char*)(A + off.a(u.z) + (size_t)u.pm * BM * lda); u.b = (const char*)(Bt + off.b(u.z) + (size_t)u.pn * BM * ldb); u.a2 = nullptr; return true;
    }
};
__device__ __forceinline__ unsigned cvt_pk_bf16(float lo, float hi) { unsigned r; asm volatile("v_cvt_pk_bf16_f32 %0, %1, %2" : "=v"(r) : "v"(lo), "v"(hi)); return r; }

template <class Op> struct Epi8 {
    static constexpr bool PERM = true;
    Op op;
    __device__ __forceinline__ void operator()(const f32x4 (&acc)[2][2][4][2], const Unit& u, int wr, int wc, int fr, int fq) const {
        const int row0 = u.pm * BM + wr * 64 + fr, col0 = u.pn * BM + wc * 32 + 8 * fq;
        if constexpr (Op::NLD == 0) {
#pragma unroll
            for (int ai = 0; ai < 2; ++ai)
#pragma unroll
                for (int m = 0; m < 4; ++m)
#pragma unroll
                    for (int bj = 0; bj < 2; ++bj) op(u.z, row0 + ai * HALF + m * 16, col0 + bj * HALF, acc[ai][bj][m][0], acc[ai][bj][m][1]);
        } else {
#pragma unroll
            for (int ai = 0; ai < 2; ++ai) {
                u32x4 tmp[4][2][Op::NLD];
#pragma unroll
                for (int m = 0; m < 4; ++m)
#pragma unroll
                    for (int bj = 0; bj < 2; ++bj) op.ld(u.z, row0 + ai * HALF + m * 16, col0 + bj * HALF, tmp[m][bj]);
#pragma unroll
                for (int m = 0; m < 4; ++m)
#pragma unroll
                    for (int bj = 0; bj < 2; ++bj) op.ap(u.z, row0 + ai * HALF + m * 16, col0 + bj * HALF, acc[ai][bj][m][0], acc[ai][bj][m][1], tmp[m][bj]);
            }
        }
    }
};

template <class Epi, class Sched, bool ALIGN_EPI, bool SPLIT = false, bool AFTER_DRAIN = false>
__device__ __forceinline__ void gemm_phase(PG8_LAS unsigned char* lds, const Gemm g, const Sched& S, const Epi& E, int wid, int lane) {
    const int tid = wid * 64 + lane, wr = wid >> 2, wc = wid & 3, fr = lane & 15, fq = lane >> 4;
    const int K = g.K, nt = K / BK;
    unsigned voffA[2], voffB[2];
#pragma unroll
    for (int i = 0; i < 2; ++i) { int R, C; stage_rc(tid * 16 + i * 8192, R, C); const int Rb = Epi::PERM ? ((R & ~31) + perm32(R & 31)) : R;
        voffA[i] = (unsigned)(R * g.lda + C) * 2u; voffB[i] = (unsigned)(Rb * g.ldb + C) * 2u; }
    const size_t kstep = (size_t)(BK * 2);
    const size_t hstepA = (size_t)HALF * g.lda * 2, hstepB = (size_t)HALF * g.ldb * 2;
    const unsigned ldsw = (unsigned)wid * 1024u;
    const int aoff = lds_byte(wr * 64 + fr, fq * 8), boff = lds_byte(wc * 32 + fr, fq * 8);
#define PG8_SA(b, h) (((b) * 2 + (h)) * HTB)
#define PG8_SB(b, h) ((4 + (b) * 2 + (h)) * HTB)
#define PG8_STAGE(bufoff, gbase, voff) do { _Pragma("unroll") for (int _i = 0; _i < 2; ++_i) \
        __builtin_amdgcn_global_load_lds((const unsigned*)((const char*)(gbase) + (voff)[_i]), (PG8_LAS unsigned*)(lds + (bufoff) + ldsw + _i * 8192), 16, 0, 0); } while (0)
#define PG8_LDA(dst, b, h) do { _Pragma("unroll") for (int m = 0; m < 4; ++m) _Pragma("unroll") for (int k = 0; k < 2; ++k) dst[m][k] = *(const PG8_LAS bf16x8*)(lds + PG8_SA(b, h) + aoff + m * 2048 + k * 1024); } while (0)
#define PG8_LDB(dst, b, h) do { _Pragma("unroll") for (int n = 0; n < 2; ++n) _Pragma("unroll") for (int k = 0; k < 2; ++k) dst[n][k] = *(const PG8_LAS bf16x8*)(lds + PG8_SB(b, h) + boff + n * 2048 + k * 1024); } while (0)
#define PG8_MMA(ai, bj, At, Bt) do { __builtin_amdgcn_s_setprio(1); _Pragma("unroll") for (int m = 0; m < 4; ++m) _Pragma("unroll") for (int n = 0; n < 2; ++n) _Pragma("unroll") for (int k = 0; k < 2; ++k) \
        acc[ai][bj][m][n] = __builtin_amdgcn_mfma_f32_16x16x32_bf16(Bt[n][k], At[m][k], acc[ai][bj][m][n], 0, 0, 0); __builtin_amdgcn_s_setprio(0); } while (0)
#define PG8_WAIT_V(n) asm volatile("s_waitcnt vmcnt(" #n ")" ::: "memory")
#define PG8_WAIT_L(n) asm volatile("s_waitcnt lgkmcnt(" #n ")" ::: "memory")
#define PG8_BAR __builtin_amdgcn_s_barrier()
#define PG8_SCHED __builtin_amdgcn_sched_barrier(0)
    Unit cur, nxt; int ui = 0;
    if (!S.next(0, cur)) return;
    f32x4 acc[2][2][4][2];
#pragma unroll
    for (int a = 0; a < 2; ++a)
#pragma unroll
        for (int b = 0; b < 2; ++b)
#pragma unroll
            for (int m = 0; m < 4; ++m)
#pragma unroll
                for (int n = 0; n < 2; ++n) acc[a][b][m][n] = (f32x4){0.f, 0.f, 0.f, 0.f};
    bf16x8 At[4][2], B0[2][2], B1[2][2];
    const char* cA = cur.a; const char* cB = cur.b;
    const int nth = nt / 2;
    const char* cA2 = SPLIT ? cur.a2 - (size_t)nth * kstep : cA;
    PG8_STAGE(PG8_SB(0, 0), cB, voffB); PG8_STAGE(PG8_SB(0, 1), cB + hstepB, voffB); PG8_STAGE(PG8_SA(0, 0), cA, voffA); PG8_STAGE(PG8_SA(0, 1), cA + hstepA, voffA);
    if (wr == 1) PG8_BAR;
    PG8_WAIT_V(2); PG8_BAR;
    PG8_STAGE(PG8_SB(1, 0), cB + kstep, voffB); PG8_STAGE(PG8_SA(1, 0), cA + kstep, voffA); PG8_STAGE(PG8_SB(1, 1), cB + hstepB + kstep, voffB);
    PG8_WAIT_V(6); PG8_BAR;
    for (;;) {
        const bool has_next = S.next(ui + 1, nxt);
        const char* nA = has_next ? nxt.a : cA; const char* nB = has_next ? nxt.b : cB;
        const char* nA2 = SPLIT ? (has_next ? nxt.a2 - (size_t)nth * kstep : cA2) : nA;
#pragma unroll 1
        for (int half_ = 0; half_ < (SPLIT ? 2 : 1); ++half_) {
        if constexpr (SPLIT) { if (half_ == 1) { __builtin_amdgcn_sched_barrier(0); E.mid(acc, cur, wr, wc, fr, fq); __builtin_amdgcn_sched_barrier(0); } }
        const int t_lo = SPLIT ? half_ * nth : 0, t_hi = SPLIT ? (half_ + 1) * nth : nt;
#pragma unroll 1
        for (int t = t_lo; t < t_hi; t += 2) {
            const bool last = (t == nt - 2);
            const char* bA1 = (!SPLIT || t < nth) ? cA : cA2; const char* bA2 = (!SPLIT || t + 2 < nth) ? cA : cA2;
            const char* a1 = bA1 + (size_t)(t + 1) * kstep;
            const char* a2 = last ? nA : bA2 + (size_t)(t + 2) * kstep; const char* b2 = last ? nB : cB + (size_t)(t + 2) * kstep;
            const char* a3 = a2 + kstep; const char* b3 = b2 + kstep;
            PG8_LDB(B0, 0, 0); PG8_LDB(B1, 0, 1); PG8_SCHED; PG8_LDA(At, 0, 0); PG8_STAGE(PG8_SA(1, 1), a1 + hstepA, voffA);
            PG8_WAIT_V(8); PG8_WAIT_L(0); PG8_BAR; PG8_MMA(0, 0, At, B0); PG8_MMA(0, 1, At, B1); PG8_BAR; PG8_SCHED;
            PG8_LDA(At, 0, 1); PG8_STAGE(PG8_SB(0, 0), b2, voffB); PG8_STAGE(PG8_SB(0, 1), b2 + hstepB, voffB); PG8_STAGE(PG8_SA(0, 0), a2, voffA);
            PG8_WAIT_V(8); PG8_WAIT_L(0); PG8_BAR; PG8_MMA(1, 0, At, B0); PG8_MMA(1, 1, At, B1); PG8_BAR; PG8_SCHED;
            PG8_LDB(B0, 1, 0); PG8_LDB(B1, 1, 1); PG8_SCHED; PG8_LDA(At, 1, 0); PG8_STAGE(PG8_SA(0, 1), a2 + hstepA, voffA);
            PG8_WAIT_V(8); PG8_WAIT_L(0); PG8_BAR; PG8_MMA(0, 0, At, B0); PG8_MMA(0, 1, At, B1); PG8_BAR; PG8_SCHED;
            PG8_LDA(At, 1, 1); PG8_STAGE(PG8_SB(1, 0), b3, voffB); PG8_STAGE(PG8_SB(1, 1), b3 + hstepB, voffB); PG8_STAGE(PG8_SA(1, 0), a3, voffA);
            PG8_WAIT_V(8); PG8_WAIT_L(0); PG8_BAR; PG8_MMA(1, 0, At, B0); PG8_MMA(1, 1, At, B1); PG8_BAR; PG8_SCHED;
        }
        }
        if constexpr (ALIGN_EPI) { if (wr == 0) PG8_BAR; }
        if constexpr (!AFTER_DRAIN) E(acc, cur, wr, wc, fr, fq);
        if (!has_next) break;
#pragma unroll
        for (int a = 0; a < 2; ++a)
#pragma unroll
            for (int b = 0; b < 2; ++b)
#pragma unroll
                for (int m = 0; m < 4; ++m)
#pragma unroll
                    for (int n = 0; n < 2; ++n) acc[a][b][m][n] = (f32x4){0.f, 0.f, 0.f, 0.f};
        cur = nxt; cA = nA; cB = nB; cA2 = nA2; ++ui;
        if constexpr (ALIGN_EPI) { if (wr == 1) PG8_BAR; }
    }
    PG8_WAIT_V(0);
    if constexpr (!ALIGN_EPI) { if (wr == 0) PG8_BAR; }
    PG8_BAR;
    if constexpr (AFTER_DRAIN) E.fused(acc, cur, wr, wc, fr, fq, (unsigned char*)lds);
#undef PG8_SA
#undef PG8_SB
#undef PG8_STAGE
#undef PG8_LDA
#undef PG8_LDB
#undef PG8_MMA
#undef PG8_WAIT_V
#undef PG8_WAIT_L
#undef PG8_BAR
#undef PG8_SCHED
}
}

__device__ __forceinline__ u32x4 pack8(f32x4 a, f32x4 b) { u32x4 w; w.x = pg8::cvt_pk_bf16(a.x, a.y); w.y = pg8::cvt_pk_bf16(a.z, a.w); w.z = pg8::cvt_pk_bf16(b.x, b.y); w.w = pg8::cvt_pk_bf16(b.z, b.w); return w; }
__device__ __forceinline__ void unpack8v(u32x4 w, f32x4& a, f32x4& b) { a.x = bflo(w.x); a.y = bfhi(w.x); a.z = bflo(w.y); a.w = bfhi(w.y); b.x = bflo(w.z); b.y = bfhi(w.z); b.z = bflo(w.w); b.w = bfhi(w.w); }
__device__ __forceinline__ f32x4 sigm4(f32x4 v) { f32x4 r; r.x = sigm(v.x); r.y = sigm(v.y); r.z = sigm(v.z); r.w = sigm(v.w); return r; }

struct OpProj { static constexpr int NLD = 0; unsigned char* ws;
    __device__ __forceinline__ void operator()(int z, int row, int col, f32x4 a, f32x4 b) const {
        bf16* p;
        if (col < 16384) p = (bf16*)(ws + WS_SLOT + (size_t)(col >> 11) * SLOT_BYTES) + (size_t)row * 2048 + (col & 2047);
        else if (col < 16640) p = (bf16*)(ws + WS_CKV) + (size_t)row * 256 + (col - 16384);
        else p = (bf16*)(ws + WS_IKW) + (size_t)row * 256 + (col - 16640);
        *(u32x4*)p = pack8(a, b);
    } };
struct OpProjCKV { static constexpr int NLD = 0; unsigned char* ws;
    __device__ __forceinline__ void operator()(int z, int row, int col, f32x4 a, f32x4 b) const {
        bf16* p;
        if (z == 0) { if (col < 16384) p = (bf16*)(ws + WS_SLOT + (size_t)(col >> 11) * SLOT_BYTES) + (size_t)row * 2048 + (col & 2047);
                      else if (col < 16640) p = (bf16*)(ws + WS_CKV) + (size_t)row * 256 + (col - 16384);
                      else p = (bf16*)(ws + WS_IKW) + (size_t)row * 256 + (col - 16640); }
        else p = (bf16*)(ws + (z == 1 ? WS_CK : WS_VT)) + (size_t)row * 2048 + col;
        *(u32x4*)p = pack8(a, b);
    } };
struct OpBf16 { static constexpr int NLD = 0; bf16* o; int ld;
    __device__ __forceinline__ void operator()(int z, int row, int col, f32x4 a, f32x4 b) const { *(u32x4*)(o + (size_t)row * ld + col) = pack8(a, b); } };
struct OpSplit2 { static constexpr int NLD = 0; bf16* o0; bf16* o1;
    __device__ __forceinline__ void operator()(int z, int row, int col, f32x4 a, f32x4 b) const { bf16* p = (col < 2048 ? o0 : o1) + (size_t)row * 2048 + (col & 2047); *(u32x4*)p = pack8(a, b); } };
struct OpF32 { static constexpr int NLD = 0; float* o; int ld;
    __device__ __forceinline__ void operator()(int z, int row, int col, f32x4 a, f32x4 b) const { float* p = o + (size_t)row * ld + col; *(f32x4*)p = a; *(f32x4*)(p + 4) = b; } };
struct OpYA { static constexpr int NLD = 1; bf16* ga;
    __device__ __forceinline__ void ld(int zi, int row, int col, u32x4* t) const { t[0] = *(const u32x4*)(ga + (size_t)row * 2048 + col); }
    __device__ __forceinline__ void ap(int zi, int row, int col, f32x4 a, f32x4 b, const u32x4* t) const { f32x4 g0, g1; unpack8v(t[0], g0, g1); *(u32x4*)(ga + (size_t)row * 2048 + col) = pack8(sigm4(g0) * a, sigm4(g1) * b); } };
struct OpYB { static constexpr int NLD = 2; bf16* ga; const bf16* gb;
    __device__ __forceinline__ void ld(int zi, int row, int col, u32x4* t) const { const size_t i = (size_t)row * 2048 + col; t[0] = *(const u32x4*)(ga + i); t[1] = *(const u32x4*)(gb + i); }
    __device__ __forceinline__ void ap(int zi, int row, int col, f32x4 a, f32x4 b, const u32x4* t) const { f32x4 m0, m1, g0, g1; unpack8v(t[0], m0, m1); unpack8v(t[1], g0, g1);
        *(u32x4*)(ga + (size_t)row * 2048 + col) = pack8(m0 + sigm4(g0) * a, m1 + sigm4(g1) * b); } };
struct OpMix { static constexpr int NLD = 2; const float* x; float* zo;
    __device__ __forceinline__ void ld(int zi, int row, int col, u32x4* t) const { const size_t i = (size_t)row * 2048 + col; t[0] = *(const u32x4*)(x + i); t[1] = *(const u32x4*)(x + i + 4); }
    __device__ __forceinline__ void ap(int zi, int row, int col, f32x4 a, f32x4 b, const u32x4* t) const { const size_t i = (size_t)row * 2048 + col;
        *(f32x4*)(zo + i) = ALPHA * __builtin_bit_cast(f32x4, t[0]) + a; *(f32x4*)(zo + i + 4) = ALPHA * __builtin_bit_cast(f32x4, t[1]) + b; } };
struct OpRes { static constexpr int NLD = 2; float* zo;
    __device__ __forceinline__ void ld(int zi, int row, int col, u32x4* t) const { const size_t i = (size_t)row * 2048 + col; t[0] = *(const u32x4*)(zo + i); t[1] = *(const u32x4*)(zo + i + 4); }
    __device__ __forceinline__ void ap(int zi, int row, int col, f32x4 a, f32x4 b, const u32x4* t) const { const size_t i = (size_t)row * 2048 + col;
        *(f32x4*)(zo + i) = ALPHA * __builtin_bit_cast(f32x4, t[0]) + a; *(f32x4*)(zo + i + 4) = ALPHA * __builtin_bit_cast(f32x4, t[1]) + b; } };

__device__ __forceinline__ void row_stats_add(float* st, int row, float s1, float s2, int fq) {
    s1 += __shfl_xor(s1, 16); s1 += __shfl_xor(s1, 32); s2 += __shfl_xor(s2, 16); s2 += __shfl_xor(s2, 32);
    if (fq == 0) { atomicAdd(st + 2 * (size_t)row, s1); atomicAdd(st + 2 * (size_t)row + 1, s2); }
}
__device__ __forceinline__ void row_mu_rstd(const float* st, int row, float& mu, float& rstd) {
    const f32x2v p = *(const f32x2v*)(st + 2 * (size_t)row); mu = p.x * (1.0f / 2048.0f); rstd = rsqrtf(fmaxf(p.y * (1.0f / 2048.0f) - mu * mu, 0.f) + 1e-5f);
}
__device__ __forceinline__ float sum8(f32x4 a, f32x4 b) { return ((a.x + a.y) + (a.z + a.w)) + ((b.x + b.y) + (b.z + b.w)); }
__device__ __forceinline__ float sq8(f32x4 a, f32x4 b) { return ((a.x * a.x + a.y * a.y) + (a.z * a.z + a.w * a.w)) + ((b.x * b.x + b.y * b.y) + (b.z * b.z + b.w * b.w)); }
struct EpiMixStats { static constexpr bool PERM = true; const float* x; bf16* zb; float* st;
    __device__ __forceinline__ void operator()(const f32x4 (&acc)[2][2][4][2], const pg8::Unit& u, int wr, int wc, int fr, int fq) const {
        const int row0 = u.pm * 256 + wr * 64 + fr, col0 = u.pn * 256 + wc * 32 + 8 * fq;
#pragma unroll
        for (int ai = 0; ai < 2; ++ai) {
            f32x4 xv[4][2][2];
#pragma unroll
            for (int m = 0; m < 4; ++m)
#pragma unroll
                for (int bj = 0; bj < 2; ++bj) { const float* p = x + (size_t)(row0 + ai * 128 + m * 16) * 2048 + col0 + bj * 128; xv[m][bj][0] = *(const f32x4*)p; xv[m][bj][1] = *(const f32x4*)(p + 4); }
#pragma unroll
            for (int m = 0; m < 4; ++m) { const int row = row0 + ai * 128 + m * 16; float s1 = 0.f, s2 = 0.f;
#pragma unroll
                for (int bj = 0; bj < 2; ++bj) { const f32x4 z0 = ALPHA * xv[m][bj][0] + acc[ai][bj][m][0], z1 = ALPHA * xv[m][bj][1] + acc[ai][bj][m][1];
                    *(u32x4*)(zb + (size_t)row * 2048 + col0 + bj * 128) = pack8(z0, z1); s1 += sum8(z0, z1); s2 += sq8(z0, z1); }
                row_stats_add(st, row, s1, s2, fq); }
        }
    }
};
struct EpiCOStats { static constexpr bool PERM = true; bf16* zb; const float* st1; float* st2; const float* g; const float* bta;
    __device__ __forceinline__ void operator()(const f32x4 (&acc)[2][2][4][2], const pg8::Unit& u, int wr, int wc, int fr, int fq) const {
        const int row0 = u.pm * 256 + wr * 64 + fr, col0 = u.pn * 256 + wc * 32 + 8 * fq;
        f32x4 gv[2][2], bv[2][2];
#pragma unroll
        for (int bj = 0; bj < 2; ++bj) { gv[bj][0] = *(const f32x4*)(g + col0 + bj * 128); gv[bj][1] = *(const f32x4*)(g + col0 + bj * 128 + 4); bv[bj][0] = *(const f32x4*)(bta + col0 + bj * 128); bv[bj][1] = *(const f32x4*)(bta + col0 + bj * 128 + 4); }
#pragma unroll
        for (int ai = 0; ai < 2; ++ai) {
            u32x4 zv[4][2]; float mu[4], rs[4];
#pragma unroll
            for (int m = 0; m < 4; ++m) { const int row = row0 + ai * 128 + m * 16; row_mu_rstd(st1, row, mu[m], rs[m]);
#pragma unroll
                for (int bj = 0; bj < 2; ++bj) zv[m][bj] = *(const u32x4*)(zb + (size_t)row * 2048 + col0 + bj * 128); }
#pragma unroll
            for (int m = 0; m < 4; ++m) { const int row = row0 + ai * 128 + m * 16; float s1 = 0.f, s2 = 0.f;
#pragma unroll
                for (int bj = 0; bj < 2; ++bj) { f32x4 a0, a1; unpack8v(zv[m][bj], a0, a1);
                    const f32x4 z0 = ALPHA * ((a0 - mu[m]) * rs[m] * gv[bj][0] + bv[bj][0]) + acc[ai][bj][m][0], z1 = ALPHA * ((a1 - mu[m]) * rs[m] * gv[bj][1] + bv[bj][1]) + acc[ai][bj][m][1];
                    *(u32x4*)(zb + (size_t)row * 2048 + col0 + bj * 128) = pack8(z0, z1); s1 += sum8(z0, z1); s2 += sq8(z0, z1); }
                row_stats_add(st2, row, s1, s2, fq); }
        }
    }
};
struct EpiYAB { static constexpr bool PERM = true; bf16* ga; const bf16* gb;
    __device__ __forceinline__ void mid(f32x4 (&acc)[2][2][4][2], const pg8::Unit& u, int wr, int wc, int fr, int fq) const {
        int lofs = (wr * 64 + fr) * 2048 + wc * 32 + 8 * fq; asm volatile("" : "+v"(lofs));
        const size_t ub = ((size_t)u.pm * 256) * 2048 + u.pn * 256;
#pragma unroll
        for (int ai = 0; ai < 2; ++ai)
#pragma unroll
            for (int m = 0; m < 4; ++m) { u32x4 av[2], bv[2];
#pragma unroll
                for (int bj = 0; bj < 2; ++bj) { const size_t i = ub + (size_t)(lofs + (ai * 128 + m * 16) * 2048 + bj * 128); av[bj] = *(const u32x4*)(ga + i); bv[bj] = *(const u32x4*)(gb + i); }
#pragma unroll
                for (int bj = 0; bj < 2; ++bj) { f32x4 a0, a1, b0, b1; unpack8v(av[bj], a0, a1); unpack8v(bv[bj], b0, b1);
#pragma unroll
                    for (int e = 0; e < 4; ++e) { acc[ai][bj][m][0][e] *= (1.0f + __expf(-b0[e])) * __builtin_amdgcn_rcpf(1.0f + __expf(-a0[e])); acc[ai][bj][m][1][e] *= (1.0f + __expf(-b1[e])) * __builtin_amdgcn_rcpf(1.0f + __expf(-a1[e])); } } }
    }
    __device__ __forceinline__ void operator()(const f32x4 (&acc)[2][2][4][2], const pg8::Unit& u, int wr, int wc, int fr, int fq) const {
        int lofs = (wr * 64 + fr) * 2048 + wc * 32 + 8 * fq; asm volatile("" : "+v"(lofs));
        const size_t ub = ((size_t)u.pm * 256) * 2048 + u.pn * 256;
#pragma unroll
        for (int ai = 0; ai < 2; ++ai) { u32x4 bv[4][2];
#pragma unroll
            for (int m = 0; m < 4; ++m)
#pragma unroll
                for (int bj = 0; bj < 2; ++bj) bv[m][bj] = *(const u32x4*)(gb + ub + (size_t)(lofs + (ai * 128 + m * 16) * 2048 + bj * 128));
#pragma unroll
            for (int m = 0; m < 4; ++m)
#pragma unroll
                for (int bj = 0; bj < 2; ++bj) { f32x4 b0, b1; unpack8v(bv[m][bj], b0, b1); f32x4 s0, s1;
#pragma unroll
                    for (int e = 0; e < 4; ++e) { s0[e] = __builtin_amdgcn_rcpf(1.0f + __expf(-b0[e])); s1[e] = __builtin_amdgcn_rcpf(1.0f + __expf(-b1[e])); }
                    *(u32x4*)(ga + ub + (size_t)(lofs + (ai * 128 + m * 16) * 2048 + bj * 128)) = pack8(acc[ai][bj][m][0] * s0, acc[ai][bj][m][1] * s1); } }
    }
};
__device__ __forceinline__ void ln_fold8(const float* st, const float* c1, const float* c0, int row, int col, f32x4& a, f32x4& b) {
    float mu, rs; row_mu_rstd(st, row, mu, rs);
    const f32x4 p0 = *(const f32x4*)(c1 + col), p1 = *(const f32x4*)(c1 + col + 4), q0 = *(const f32x4*)(c0 + col), q1 = *(const f32x4*)(c0 + col + 4);
    a = (a - mu * p0) * rs + q0; b = (b - mu * p1) * rs + q1;
}
struct OpPQFold { static constexpr int NLD = 0; float* o; const float* st; const float* c1; const float* c0;
    __device__ __forceinline__ void operator()(int zi, int row, int col, f32x4 a, f32x4 b) const { ln_fold8(st, c1, c0, row, col, a, b); float* p = o + (size_t)row * 2048 + col; *(f32x4*)p = a; *(f32x4*)(p + 4) = b; } };

template <class Op>
__device__ __forceinline__ void gemm(const Frame& F, const bf16* A, int lda, const bf16* Bt, int ldb, int M, int N, int K, const Op& op) {
    pg8::Gemm g{lda, ldb, K}; pg8::MultiOrder<1> S; S.s[0] = pg8::Sub{A, Bt, M / 256, N / 256}; S.lda = lda; S.ldb = ldb; S.G = F.G; S.c = F.bid;
    pg8::Epi8<Op> E{op};
    pg8::gemm_phase<pg8::Epi8<Op>, pg8::MultiOrder<1>, true>((PG8_LAS unsigned char*)F.lds, g, S, E, F.wave, F.lane());
}
template <class Epi>
__device__ __forceinline__ void gemm_epi(const Frame& F, const bf16* A, int lda, const bf16* Bt, int ldb, int M, int N, int K, const Epi& E) {
    pg8::Gemm g{lda, ldb, K}; pg8::MultiOrder<1> S; S.s[0] = pg8::Sub{A, Bt, M / 256, N / 256}; S.lda = lda; S.ldb = ldb; S.G = F.G; S.c = F.bid;
    pg8::gemm_phase<Epi, pg8::MultiOrder<1>, true>((PG8_LAS unsigned char*)F.lds, g, S, E, F.wave, F.lane());
}
template <int NS, class Op>
__device__ __forceinline__ void gemm_multi(const Frame& F, const pg8::MultiOrder<NS>& S, int K, const Op& op) {
    pg8::Gemm g{S.lda, S.ldb, K}; pg8::Epi8<Op> E{op};
    pg8::gemm_phase<pg8::Epi8<Op>, pg8::MultiOrder<NS>, true>((PG8_LAS unsigned char*)F.lds, g, S, E, F.wave, F.lane());
}
template <class Off, class Op>
__device__ __forceinline__ void gemm_batch(const Frame& F, const pg8::BatchOrder<Off>& S, int K, const Op& op) {
    pg8::Gemm g{S.lda, S.ldb, K}; pg8::Epi8<Op> E{op};
    pg8::gemm_phase<pg8::Epi8<Op>, pg8::BatchOrder<Off>, true>((PG8_LAS unsigned char*)F.lds, g, S, E, F.wave, F.lane());
}
struct OffS { __device__ __forceinline__ size_t a(int z) const { return (size_t)(z >> 2) * 2048 * 2048 + (z & 3) * 512; } __device__ __forceinline__ size_t b(int z) const { return (size_t)(z >> 2) * 256 * 2048 + (z & 3) * 512; } };
struct OffPV { __device__ __forceinline__ size_t a(int z) const { return (size_t)(z >> 2) * 2048 * 1024 + (z & 3) * 256; } __device__ __forceinline__ size_t b(int z) const { return (size_t)(z & 3) * 512 * 2048 + (z >> 2) * 256; } };
struct OpLogit { static constexpr int NLD = 0; float* lg;
    __device__ __forceinline__ void operator()(int z, int row, int col, f32x4 a, f32x4 b) const { float* p = lg + ((size_t)(z >> 2) * 2048 + row) * 1024 + (z & 3) * 256 + col; *(f32x4*)p = a * 0.04419417382415922f; *(f32x4*)(p + 4) = b * 0.04419417382415922f; } };
struct OpCO { static constexpr int NLD = 0; bf16* co;
    __device__ __forceinline__ void operator()(int z, int row, int col, f32x4 a, f32x4 b) const { *(u32x4*)(co + ((size_t)(z >> 2) * 2048 + row) * 2048 + (z & 3) * 512 + col) = pack8(a, b); } };
struct OpCQKV { static constexpr int NLD = 0; bf16* cq; bf16* ck; bf16* vt; const float* st; const float* c1; const float* c0;
    __device__ __forceinline__ void operator()(int z, int row, int col, f32x4 a, f32x4 b) const { if (z == 0) ln_fold8(st, c1, c0, row, col, a, b);
        bf16* o = z == 0 ? cq : (z == 1 ? ck : vt); *(u32x4*)(o + (size_t)row * 2048 + col) = pack8(a, b); } };
struct EpiXSoftmax { static constexpr bool PERM = true; bf16* P;
    __device__ __forceinline__ void operator()(const f32x4 (&)[2][2][4][2], const pg8::Unit&, int, int, int, int) const {}
    __device__ __forceinline__ void fused(f32x4 (&acc)[2][2][4][2], const pg8::Unit& u, int wr, int wc, int fr, int fq, unsigned char* lds) const {
        float* pm = (float*)lds;
        float* ps = pm + 1024;
        const float sc = 0.04419417382415922f * 1.4426950408889634f;
        float mx[2][4];
#pragma unroll
        for (int ai = 0; ai < 2; ++ai)
#pragma unroll
            for (int m = 0; m < 4; ++m) { float v = -INFINITY;
#pragma unroll
                for (int bj = 0; bj < 2; ++bj)
#pragma unroll
                    for (int n = 0; n < 2; ++n)
#pragma unroll
                        for (int e = 0; e < 4; ++e) v = fmaxf(v, acc[ai][bj][m][n][e]);
                v = fmaxf(v, __shfl_xor(v, 16)); v = fmaxf(v, __shfl_xor(v, 32));
                if (fq == 0) pm[(ai * 128 + wr * 64 + m * 16 + fr) * 4 + wc] = v; }
        __syncthreads();
#pragma unroll
        for (int ai = 0; ai < 2; ++ai)
#pragma unroll
            for (int m = 0; m < 4; ++m) { const f32x4 q = *(const f32x4*)(pm + (ai * 128 + wr * 64 + m * 16 + fr) * 4); const float rm = fmaxf(fmaxf(q.x, q.y), fmaxf(q.z, q.w)) * sc; mx[ai][m] = rm; float sm = 0.f;
#pragma unroll
                for (int bj = 0; bj < 2; ++bj)
#pragma unroll
                    for (int n = 0; n < 2; ++n)
#pragma unroll
                        for (int e = 0; e < 4; ++e) { const float p = __builtin_amdgcn_exp2f(acc[ai][bj][m][n][e] * sc - rm); acc[ai][bj][m][n][e] = p; sm += p; }
                sm += __shfl_xor(sm, 16); sm += __shfl_xor(sm, 32);
                if (fq == 0) ps[(ai * 128 + wr * 64 + m * 16 + fr) * 4 + wc] = sm; }
        __syncthreads();
        const int row0 = u.pm * 256 + wr * 64 + fr, col0 = wc * 32 + 8 * fq;
#pragma unroll
        for (int ai = 0; ai < 2; ++ai)
#pragma unroll
            for (int m = 0; m < 4; ++m) { const f32x4 q = *(const f32x4*)(ps + (ai * 128 + wr * 64 + m * 16 + fr) * 4); const float inv = 1.0f / ((q.x + q.y) + (q.z + q.w));
                bf16* prow = P + ((size_t)(u.z >> 2) * 2048 + row0 + ai * 128 + m * 16) * 1024 + (u.z & 3) * 256 + col0;
#pragma unroll
                for (int bj = 0; bj < 2; ++bj) *(u32x4*)(prow + bj * 128) = pack8(acc[ai][bj][m][0] * inv, acc[ai][bj][m][1] * inv); }
        (void)mx;
        __syncthreads();
    }
};
__device__ __forceinline__ void ph_xsoftmax(const Frame& F, const float* lg, bf16* P) {
    const int gw = F.bid * 8 + F.wave, NGW = F.G * 8, lane = F.lane();
    for (int u = gw; u < T * 4; u += NGW) {
        const f32x4 v = *(const f32x4*)(lg + (size_t)u * 256 + 4 * lane);
        const float m = wave_max(fmaxf(fmaxf(v.x, v.y), fmaxf(v.z, v.w)));
        const float e0 = expf(v.x - m), e1 = expf(v.y - m), e2 = expf(v.z - m), e3 = expf(v.w - m);
        const float inv = 1.0f / wave_sum((e0 + e1) + (e2 + e3));
        u32x2 w; w.x = pk2(e0 * inv, e1 * inv); w.y = pk2(e2 * inv, e3 * inv);
        *(u32x2*)(P + (size_t)u * 256 + 4 * lane) = w;
    }
}

template <class CM>
__device__ __forceinline__ void transpose_item(const float* W, size_t ldw, bf16* WT, size_t ldwt, int row_off, int nblk, int item, float* scr, int lane, const CM& cm) {
    const int kb = item / nblk, nb = item % nblk, k0 = 64 * kb, n0 = 32 * nb;
    const int c = cm(n0 + (lane & 31));
#pragma unroll 8
    for (int i = 0; i < 32; ++i) { const int kk = 2 * i + (lane >> 5); scr[kk * 33 + (lane & 31)] = (c >= 0) ? W[(size_t)(k0 + kk) * ldw + c] : 0.f; }
    WAVE_SYNC();
    const int c8 = lane & 7;
#pragma unroll
    for (int j = 0; j < 4; ++j) { const int n = (lane >> 3) + 8 * j; const float* s = scr + (8 * c8) * 33 + n;
        u32x4 o; o.x = pk2(s[0 * 33], s[1 * 33]); o.y = pk2(s[2 * 33], s[3 * 33]); o.z = pk2(s[4 * 33], s[5 * 33]); o.w = pk2(s[6 * 33], s[7 * 33]);
        *(u32x4*)(WT + (size_t)(row_off + n0 + n) * ldwt + k0 + 8 * c8) = o; }
    WAVE_SYNC();
}
__device__ __forceinline__ void transpose_item_ln(const float* W, bf16* WT, int item, float* scr, int lane, const float* g, const float* bta, float* c1, float* c0) {
    const int kb = item / 64, nb = item % 64, k0 = 64 * kb, n0 = 32 * nb;
#pragma unroll 8
    for (int i = 0; i < 32; ++i) { const int kk = 2 * i + (lane >> 5); scr[kk * 33 + (lane & 31)] = W[(size_t)(k0 + kk) * 2048 + n0 + (lane & 31)]; }
    WAVE_SYNC();
    const int c8 = lane & 7;
    float gk[8], bk[8];
#pragma unroll
    for (int i = 0; i < 8; ++i) { gk[i] = g[k0 + 8 * c8 + i]; bk[i] = bta[k0 + 8 * c8 + i]; }
#pragma unroll
    for (int j = 0; j < 4; ++j) { const int n = (lane >> 3) + 8 * j; const float* sp = scr + (8 * c8) * 33 + n;
        float wv[8]; float p1 = 0.f, p0 = 0.f;
#pragma unroll
        for (int i = 0; i < 8; ++i) { const float v = sp[i * 33]; wv[i] = v * gk[i]; p1 += wv[i]; p0 += v * bk[i]; }
        u32x4 o; o.x = pk2(wv[0], wv[1]); o.y = pk2(wv[2], wv[3]); o.z = pk2(wv[4], wv[5]); o.w = pk2(wv[6], wv[7]);
        *(u32x4*)(WT + (size_t)(n0 + n) * 2048 + k0 + 8 * c8) = o;
        p1 += __shfl_xor(p1, 1); p1 += __shfl_xor(p1, 2); p1 += __shfl_xor(p1, 4); p0 += __shfl_xor(p0, 1); p0 += __shfl_xor(p0, 2); p0 += __shfl_xor(p0, 4);
        if (c8 == 0) { atomicAdd(c1 + n0 + n, p1); atomicAdd(c0 + n0 + n, p0); } }
    WAVE_SYNC();
}
template <class CM>
__device__ __forceinline__ void transpose_item64(const float* W, size_t ldw, bf16* WT, size_t ldwt, int row_off, int nblk, int item, float* scr, int lane, const CM& cm) {
    const int kb = item / nblk, nb = item % nblk, k0 = 64 * kb, n0 = 64 * nb, r = lane >> 4, c4 = lane & 15;
    const int c = cm(n0 + 4 * c4);
    f32x4 v[16];
#pragma unroll
    for (int i = 0; i < 16; ++i) v[i] = (c >= 0) ? *(const f32x4*)(W + (size_t)(k0 + 4 * i + r) * ldw + c) : (f32x4){0.f, 0.f, 0.f, 0.f};
#pragma unroll
    for (int i = 0; i < 16; ++i) *(f32x4*)(scr + (4 * i + r) * 68 + 4 * c4) = v[i];
    WAVE_SYNC();
    bf16* orow = WT + (size_t)(row_off + n0 + lane) * ldwt + k0;
#pragma unroll
    for (int j = 0; j < 8; ++j) { const float* sp = scr + (8 * j) * 68 + lane;
        u32x4 o; o.x = pk2(sp[0], sp[68]); o.y = pk2(sp[2 * 68], sp[3 * 68]); o.z = pk2(sp[4 * 68], sp[5 * 68]); o.w = pk2(sp[6 * 68], sp[7 * 68]);
        *(u32x4*)(orow + 8 * j) = o; }
    WAVE_SYNC();
}
struct CmIdent { __device__ __forceinline__ int operator()(int n) const { return n; } };
struct CmWin { __device__ __forceinline__ int operator()(int n) const {
    if (n < 10240) return n;
    if (n < 12288) return 10496 + (n - 10240);
    if (n < 14336) return 12688 + (n - 12288);
    if (n < 16384) return 14736 + (n - 14336);
    if (n < 16640) return 10240 + (n - 16384);
    if (n < 16768) return 12544 + (n - 16640);
    if (n < 16784) return 12672 + (n - 16768);
    return -1; } };

__device__ __forceinline__ void cvt_bf16_stream(const Frame& F, const float* src, bf16* dst, size_t n8) {
    const size_t gt = (size_t)F.bid * 512 + F.wave * 64 + F.lane(), NT = (size_t)F.G * 512;
#pragma unroll 4
    for (size_t i = gt; i < n8; i += NT) { const f32x4 a = ((const f32x4*)src)[2 * i], b = ((const f32x4*)src)[2 * i + 1];
        u32x4 o; o.x = pk2(a.x, a.y); o.y = pk2(a.z, a.w); o.z = pk2(b.x, b.y); o.w = pk2(b.z, b.w); ((u32x4*)dst)[i] = o; }
}

__device__ __forceinline__ void ph0_prologue(const Frame& F) {
    const Args& a = *F.a;
    cvt_bf16_stream(F, a.in[0], (bf16*)a.out, (size_t)T * D / 8);
    cvt_bf16_stream(F, a.in[1], (bf16*)(F.ws + WS_MEMB), (size_t)2048 * 2048 / 8);
    float* scr = (float*)(F.lds + F.wave * 17408);
    const int gw = F.bid * 8 + F.wave, NGW = F.G * 8, lane = F.lane();
    {
        const int nblk = NCOLS / 64, nitems = (2048 / 64) * nblk;
        float* scr64 = (float*)(F.lds + F.wave * 17408);
        for (int it = gw; it < nitems; it += NGW) transpose_item64(a.in[2], 16784, (bf16*)(F.ws + WS_WIN), 2048, 0, nblk, it, scr64, lane, CmWin());
    }
    {
        for (int it = gw; it < 32 * 16; it += NGW) { const int mat = it >> 4, which = mat >> 4, h = mat & 15;
            transpose_item(a.in[which ? 9 : 8] + (size_t)h * 256 * 128, 128, (bf16*)(F.ws + WS_WKV), 256, which * 2048 + h * 128, 4, it & 15, scr, lane, CmIdent()); }
    }
    {
        bf16* W8p = (bf16*)((unsigned char*)a.out + (size_t)64 * MiB);
        for (int it = gw; it < 2 * 1024; it += NGW) { const int m = 4 + (it >> 10);
            transpose_item64(m == 4 ? a.in[17] : a.in[18], 2048, W8p + (size_t)m * 2048 * 2048, 2048, 0, 32, it & 1023, scr, lane, CmIdent()); }
    }
    {
        const int gt = F.bid * 512 + F.wave * 64 + lane;
        if (gt < 2048) { const float l0 = a.in[3][gt], l1 = a.in[3][2048 + gt]; ((float*)(F.ws + WS_LB))[gt] = 1.0f / (1.0f + expf(l1 - l0)); }
    }
}

namespace hg {
constexpr int QP = 272, TP = 144, AP = 144;
constexpr int OFF_QD = 0, OFF_KD = OFF_QD + 64 * QP, OFF_QG = OFF_KD + 64 * QP, OFF_KET = OFF_QG + 64 * QP, OFF_VT = OFF_KET + 128 * TP, OFF_A = OFF_VT + 128 * TP,
              OFF_TOT = OFF_A + 64 * AP, OFF_DEC = OFF_TOT + 4 * 128 * 4, OFF_PART = OFF_DEC + 128 * 4, OFF_RSTD = OFF_PART + 8 * 64 * 4, END = OFF_RSTD + 64 * 4;
static_assert(END <= 131072, "hgrn LDS map");
}
typedef short bf16x4 __attribute__((ext_vector_type(4)));
#define HSEC_B() do { if (PROBE_SEC) hs_t0 = rt_now(); } while (0)
#define HSEC_E(n) do { if (PROBE_SEC == (n)) sacc += rt_now() - hs_t0; } while (0)
__device__ __forceinline__ void hgrn_chunked(const Frame& F, int unit, unsigned long long& sacc) {
    unsigned long long hs_t0 = 0ull;
    using namespace hg;
    const Args& a = *F.a;
    const int b = unit >> 4, h = unit & 15, lane = F.lane(), w = F.wave, tid = w * 64 + lane, c = tid & 127, rq = tid >> 7, l15 = lane & 15, q4 = lane >> 4;
    unsigned char* L = F.lds;
    const size_t base = (size_t)b * 2048 * 2048 + h * 128;
    const bf16* HQ = F.slot(0) + base; const bf16* HF = F.slot(1) + base; const bf16* HI = F.slot(2) + base; const bf16* HG = F.slot(3) + base; bf16* HO = F.slot(0) + base;
    const float lb = ((const float*)(F.ws + WS_LB))[h * 128 + c];
    const float ng = a.in[4][h * 128 + 16 * w + l15];
    f32x4 S[8];
#pragma unroll
    for (int d = 0; d < 8; ++d) S[d] = (f32x4){0.f, 0.f, 0.f, 0.f};
    unsigned short rq_[16], rf_[16], rv_[16];
#pragma unroll
    for (int k = 0; k < 16; ++k) { const size_t o = (size_t)(16 * rq + k) * 2048 + c; rq_[k] = HQ[o]; rf_[k] = HF[o]; rv_[k] = HI[o]; }
    float* tot = (float*)(L + OFF_TOT); float* dec = (float*)(L + OFF_DEC); float* part = (float*)(L + OFF_PART); float* rstd = (float*)(L + OFF_RSTD);
#pragma unroll 1
    for (int ch = 0; ch < 32; ++ch) {
        const int r0 = ch * 64;
        HSEC_B();
        unsigned short gq[16];
#pragma unroll
        for (int mt = 0; mt < 4; ++mt)
#pragma unroll
            for (int r = 0; r < 4; ++r) gq[4 * mt + r] = HG[(size_t)(r0 + 16 * mt + 4 * q4 + r) * 2048 + 16 * w + l15];
        unsigned short rv2_[16];
        if (ch + 1 < 32) {
#pragma unroll
            for (int k = 0; k < 16; ++k) rv2_[k] = HI[(size_t)(r0 + 64 + 16 * rq + k) * 2048 + c]; }
        float G[16], qf[16], kk[16];
        { float run = 0.f;
#pragma unroll
          for (int k = 0; k < 16; ++k) { const float f = lb + (1.0f - lb) * __builtin_amdgcn_rcpf(1.0f + __expf(-bf2f(rf_[k]))); run += __logf(f); G[k] = run; kk[k] = 1.0f - f; qf[k] = bf2f(rq_[k]); } }
        tot[rq * 128 + c] = G[15];
        if (ch + 1 < 32) {
#pragma unroll
            for (int k = 0; k < 16; ++k) { const size_t o = (size_t)(r0 + 64 + 16 * rq + k) * 2048 + c; rq_[k] = HQ[o]; rf_[k] = HF[o]; } }
        HSEC_E(1); HSEC_B();
        __syncthreads();
        HSEC_E(2); HSEC_B();
        const float t0 = tot[c], t1 = tot[128 + c], t2 = tot[256 + c], t3 = tot[384 + c];
        const float offs = (rq > 0 ? t0 : 0.f) + (rq > 1 ? t1 : 0.f) + (rq > 2 ? t2 : 0.f);
        const float Gref = t0 + t1, Glast = Gref + t2 + t3, eref = __expf(Gref), elr = __expf(Glast - Gref);
        if (rq == 0) dec[c] = __expf(Glast);
        unsigned kew[8], vw[8];
#pragma unroll
        for (int k = 0; k < 16; ++k) {
            const float e1 = __expf(G[k] + offs - Gref), qd = qf[k] * e1, kd = kk[k] * __builtin_amdgcn_rcpf(e1);
            const int row = 16 * rq + k;
            *(bf16*)(L + OFF_QD + row * QP + 2 * c) = (bf16)f2bf(qd);
            *(bf16*)(L + OFF_KD + row * QP + 2 * c) = (bf16)f2bf(kd);
            *(bf16*)(L + OFF_QG + row * QP + 2 * c) = (bf16)f2bf(qd * eref);
            const unsigned ke = f2bf(kd * elr);
            if (k & 1) { kew[k >> 1] |= ke << 16; vw[k >> 1] |= (unsigned)rv_[k] << 16; } else { kew[k >> 1] = ke; vw[k >> 1] = rv_[k]; }
        }
        *(u32x4*)(L + OFF_KET + c * TP + 32 * rq) = (u32x4){kew[0], kew[1], kew[2], kew[3]}; *(u32x4*)(L + OFF_KET + c * TP + 32 * rq + 16) = (u32x4){kew[4], kew[5], kew[6], kew[7]};
        *(u32x4*)(L + OFF_VT + c * TP + 32 * rq) = (u32x4){vw[0], vw[1], vw[2], vw[3]}; *(u32x4*)(L + OFF_VT + c * TP + 32 * rq + 16) = (u32x4){vw[4], vw[5], vw[6], vw[7]};
        if (ch + 1 < 32) {
#pragma unroll
            for (int k = 0; k < 16; ++k) rv_[k] = rv2_[k]; }
        HSEC_E(3); HSEC_B();
        __syncthreads();
        HSEC_E(4); HSEC_B();
        { const int mi = w >> 1;
#pragma unroll
          for (int tt = 0; tt < 2; ++tt) { const int nj = 2 * (w & 1) + tt; f32x4 acc = (f32x4){0.f, 0.f, 0.f, 0.f};
              if (nj <= mi) {
#pragma unroll
                  for (int ks = 0; ks < 4; ++ks) { const bf16x8 aF = *(const bf16x8*)(L + OFF_KD + (16 * nj + l15) * QP + 64 * ks + 16 * q4), bF = *(const bf16x8*)(L + OFF_QD + (16 * mi + l15) * QP + 64 * ks + 16 * q4);
                      acc = __builtin_amdgcn_mfma_f32_16x16x32_bf16(aF, bF, acc, 0, 0, 0); } }
              const int i = 16 * mi + l15, j0 = 16 * nj + 4 * q4;
              const float v0 = (j0 <= i) ? acc.x : 0.f, v1 = (j0 + 1 <= i) ? acc.y : 0.f, v2 = (j0 + 2 <= i) ? acc.z : 0.f, v3 = (j0 + 3 <= i) ? acc.w : 0.f;
              *(u32x2*)(L + OFF_A + i * AP + 2 * j0) = (u32x2){pk2(v0, v1), pk2(v2, v3)}; } }
        __syncthreads();
        HSEC_E(5); HSEC_B();
        bf16x8 bV[2];
#pragma unroll
        for (int ks = 0; ks < 2; ++ks) bV[ks] = *(const bf16x8*)(L + OFF_VT + (16 * w + l15) * TP + 64 * ks + 16 * q4);
        f32x4 O[4];
#pragma unroll
        for (int mt = 0; mt < 4; ++mt) { O[mt] = (f32x4){0.f, 0.f, 0.f, 0.f};
#pragma unroll
            for (int ks = 0; ks < 2; ++ks) { const bf16x8 aF = *(const bf16x8*)(L + OFF_A + (16 * mt + l15) * AP + 64 * ks + 16 * q4); O[mt] = __builtin_amdgcn_mfma_f32_16x16x32_bf16(aF, bV[ks], O[mt], 0, 0, 0); } }
#pragma unroll
        for (int kq = 0; kq < 4; ++kq) {
            u32x4 sw; sw.x = pk2(S[2 * kq].x, S[2 * kq].y); sw.y = pk2(S[2 * kq].z, S[2 * kq].w); sw.z = pk2(S[2 * kq + 1].x, S[2 * kq + 1].y); sw.w = pk2(S[2 * kq + 1].z, S[2 * kq + 1].w);
            const bf16x8 bS = __builtin_bit_cast(bf16x8, sw);
#pragma unroll
            for (int mt = 0; mt < 4; ++mt) { const unsigned char* qp = L + OFF_QG + (16 * mt + l15) * QP + 64 * kq + 8 * q4;
                const u32x2 lo = *(const u32x2*)qp, hi = *(const u32x2*)(qp + 32);
                const bf16x8 aF = __builtin_bit_cast(bf16x8, (u32x4){lo.x, lo.y, hi.x, hi.y});
                O[mt] = __builtin_amdgcn_mfma_f32_16x16x32_bf16(aF, bS, O[mt], 0, 0, 0); } }
#pragma unroll
        for (int dt = 0; dt < 8; ++dt) { const f32x4 dc = *(const f32x4*)(dec + 16 * dt + 4 * q4); S[dt] = S[dt] * dc;
#pragma unroll
            for (int ks = 0; ks < 2; ++ks) { const bf16x8 aF = *(const bf16x8*)(L + OFF_KET + (16 * dt + l15) * TP + 64 * ks + 16 * q4); S[dt] = __builtin_amdgcn_mfma_f32_16x16x32_bf16(aF, bV[ks], S[dt], 0, 0, 0); } }
        HSEC_E(6); HSEC_B();
#pragma unroll
        for (int mt = 0; mt < 4; ++mt)
#pragma unroll
            for (int r = 0; r < 4; ++r) { const float p = row16_sum(O[mt][r] * O[mt][r]);
                if (l15 == 0) part[w * 64 + 16 * mt + 4 * q4 + r] = p; }
        __syncthreads();
        if (tid < 64) { float s = 0.f;
#pragma unroll
            for (int ww = 0; ww < 8; ++ww) s += part[ww * 64 + tid];
            rstd[tid] = rsqrtf(s * (1.0f / 128.0f) + 1e-6f); }
        __syncthreads();
        HSEC_E(7); HSEC_B();
#pragma unroll
        for (int mt = 0; mt < 4; ++mt) { const f32x4 rs = *(const f32x4*)(rstd + 16 * mt + 4 * q4);
#pragma unroll
            for (int r = 0; r < 4; ++r) { const float g = bf2f(gq[4 * mt + r]); const float o = O[mt][r] * rs[r] * ng * (g * __builtin_amdgcn_rcpf(1.0f + __expf(-g)));
                HO[(size_t)(r0 + 16 * mt + 4 * q4 + r) * 2048 + 16 * w + l15] = (bf16)f2bf(o); } }
        HSEC_E(8);
    }
    __syncthreads();
}

__device__ __forceinline__ void ph2_side(const Frame& F, int sid, int nside) {
    const Args& a = *F.a;
    const int gw = sid * 8 + F.wave, NGW = nside * 8, lane = F.lane();
    bf16* CKV = (bf16*)(F.ws + WS_CKV); bf16* IKW = (bf16*)(F.ws + WS_IKW);
    for (int row = gw; row < T; row += NGW) {
        {   u32x2 w = *(u32x2*)(CKV + (size_t)row * 256 + 4 * lane);
            float x0 = bflo(w.x), x1 = bfhi(w.x), x2 = bflo(w.y), x3 = bfhi(w.y);
            const float ss = wave_sum(x0 * x0 + x1 * x1 + x2 * x2 + x3 * x3);
            const float r = rsqrtf(ss * (1.0f / 256.0f) + 1e-6f);
            const f32x4 g = *(const f32x4*)(a.in[5] + 4 * lane);
            w.x = pk2(x0 * r * g.x, x1 * r * g.y); w.y = pk2(x2 * r * g.z, x3 * r * g.w);
            *(u32x2*)(CKV + (size_t)row * 256 + 4 * lane) = w; }
        {   unsigned w = *(unsigned*)(IKW + (size_t)row * 256 + 2 * lane);
            float x0 = bflo(w), x1 = bfhi(w);
            const float mu = wave_sum(x0 + x1) * (1.0f / 128.0f);
            x0 -= mu; x1 -= mu;
            const float var = wave_sum(x0 * x0 + x1 * x1) * (1.0f / 128.0f);
            const float r = rsqrtf(var + 1e-5f);
            const float g0 = a.in[6][2 * lane], g1 = a.in[6][2 * lane + 1], b0 = a.in[7][2 * lane], b1 = a.in[7][2 * lane + 1];
            *(unsigned*)(IKW + (size_t)row * 256 + 2 * lane) = pk2(x0 * r * g0 + b0, x1 * r * g1 + b1); }
    }
}
__device__ __forceinline__ void w8_transposes(const Frame& F, bf16* W8) {
    const Args& a = *F.a;
    const int gw = F.bid * 8 + F.wave, NGW = F.G * 8, lane = F.lane();
    float* scr = (float*)(F.lds + F.wave * 17408);
    float* cv = (float*)(F.ws + WS_CTL + CTL_CVEC);
    for (int it = gw; it < 2 * 2048; it += NGW) {
        const int which = it >> 11, m = which ? 7 : 3;
        transpose_item_ln(which ? a.in[22] : a.in[16], W8 + (size_t)m * 2048 * 2048, it & 2047, scr, lane, which ? a.in[20] : a.in[14], which ? a.in[21] : a.in[15], cv + which * 4096, cv + which * 4096 + 2048); }
    for (int it = gw; it < 4 * 1024; it += NGW) {
        const int q = it >> 10, m = q < 3 ? q : 6;
        const float* wsrc = m == 0 ? a.in[11] : m == 1 ? a.in[12] : m == 2 ? a.in[13] : a.in[19];
        if (m < 2) transpose_item64(wsrc, 2048, W8 + (size_t)m * 2048, 4096, 0, 32, it & 1023, scr, lane, CmIdent());
        else transpose_item64(wsrc, 2048, W8 + (size_t)m * 2048 * 2048, 2048, 0, 32, it & 1023, scr, lane, CmIdent()); }
}

__device__ __forceinline__ void ph3_hgnorm(const Frame& F) {
    const Args& a = *F.a;
    const int gw = F.bid * 8 + F.wave, NGW = F.G * 8, lane = F.lane();
    const float* oraw = a.out; const bf16* HG = F.slot(3); bf16* HO = F.slot(0);
    for (int u = gw; u < T * 16; u += NGW) {
        const size_t off = (size_t)(u >> 4) * 2048 + (u & 15) * 128 + 2 * lane;
        const float o0 = oraw[off], o1 = oraw[off + 1];
        const float r = rsqrtf(wave_sum(o0 * o0 + o1 * o1) * (1.0f / 128.0f) + 1e-6f);
        const unsigned gw2 = *(const unsigned*)(HG + off);
        const float g0 = bflo(gw2), g1 = bfhi(gw2);
        const int c = (u & 15) * 128 + 2 * lane;
        *(unsigned*)(HO + off) = pk2(o0 * r * a.in[4][c] * (g0 * sigm(g0)), o1 * r * a.in[4][c + 1] * (g1 * sigm(g1)));
    }
}

__device__ __forceinline__ unsigned fkey(float f) { const unsigned u = __float_as_uint(f); return (u & 0x80000000u) ? ~u : (u | 0x80000000u); }
__device__ __forceinline__ void ph5_select(const Frame& F, int first, int stride) {
    const int lane = F.lane(), l31 = lane & 31, half = lane >> 5, w = F.wave;
    float* scl = (float*)F.lds;
    const bf16* AIQ = F.slot(5); const bf16* IKW = (const bf16*)(F.ws + WS_IKW);
    unsigned* MASK = (unsigned*)(F.ws + WS_MASK);
    for (int i = first; i < 1024; i += stride) {
        const int r4 = i >> 8, c = i & 255, j = c & 127, b = 2 * r4 + (c >> 7), qt = (r4 & 1) ? 127 - j : j, t0 = qt * 16;
        bf16x8 Af[8];
        { const size_t rowA = (size_t)b * 2048 + t0 + 2 * w + ((l31 >> 2) & 1); const int headA = (l31 & 3) + 4 * (l31 >> 3);
#pragma unroll
          for (int ks = 0; ks < 8; ++ks) Af[ks] = *(const bf16x8*)(AIQ + rowA * 2048 + headA * 128 + 16 * ks + 8 * half); }
        float wr[16];
        { const bf16* wp = IKW + ((size_t)b * 2048 + t0 + 2 * w + half) * 256 + 128;
#pragma unroll
          for (int r = 0; r < 16; ++r) wr[r] = bf2f(wp[(r & 3) + 4 * (r >> 2)]) * (0.25f * 0.08838834764831845f); }
        const int nkt = (t0 + 15) / 32 + 1;
        unsigned char* ring = F.lds + 131072;
        const int srow = (w * 64 + lane) >> 4, sch = lane & 15;
        const bf16* kg = IKW + ((size_t)b * 2048 + srow) * 256 + 8 * sch;
        const int swr = srow * 256 + ((sch ^ (srow & 15)) << 4);
        const int frd = l31 * 256;
        u32x4 st0, st1;
        st0 = *(const u32x4*)kg; *(u32x4*)(ring + swr) = st0;
        if (nkt > 1) { st1 = *(const u32x4*)(kg + (size_t)32 * 256); *(u32x4*)(ring + 8192 + swr) = st1; }
        if (nkt > 2) st0 = *(const u32x4*)(kg + (size_t)2 * 32 * 256);
        __syncthreads();
#define IDX_TILE(kt_, STW, STL) do { \
            if ((kt_) + 3 < nkt) STL = *(const u32x4*)(kg + (size_t)((kt_) + 3) * 32 * 256); \
            { const unsigned char* sl_ = ring + ((kt_) % 3) * 8192 + frd; f32x16 acc; _Pragma("unroll") for (int r = 0; r < 16; ++r) acc[r] = 0.f; \
              _Pragma("unroll") for (int ks = 0; ks < 8; ++ks) { const bf16x8 bfr = *(const bf16x8*)(sl_ + (((2 * ks + half) ^ (l31 & 15)) << 4)); acc = __builtin_amdgcn_mfma_f32_32x32x16_bf16(Af[ks], bfr, acc, 0, 0, 0); } \
              float sc = 0.f; _Pragma("unroll") for (int r = 0; r < 16; ++r) sc += fmaxf(acc[r], 0.f) * wr[r]; \
              scl[(2 * w + half) * 2048 + (kt_) * 32 + l31] = sc; } \
            if ((kt_) + 2 < nkt) *(u32x4*)(ring + (((kt_) + 2) % 3) * 8192 + swr) = STW; \
            __syncthreads(); } while (0)
        for (int kt = 0; kt < nkt; kt += 2) { IDX_TILE(kt, st0, st1); if (kt + 1 < nkt) IDX_TILE(kt + 1, st1, st0); }
#undef IDX_TILE
        WAVE_SYNC();
#pragma unroll 1
        for (int qi = 0; qi < 2; ++qi) {
            const int t = t0 + 2 * w + qi; const float* row = scl + (2 * w + qi) * 2048;
            unsigned key[32];
#pragma unroll
            for (int jj = 0; jj < 32; ++jj) { const int s2 = lane + 64 * jj; key[jj] = (s2 <= t) ? fkey(row[s2]) : 0u; }
            unsigned thr = 0u;
            if (t + 1 > 256) {
                for (int bit = 31; bit >= 0; --bit) {
                    const unsigned cand = thr | (1u << bit);
                    int cnt = 0;
#pragma unroll
                    for (int jj = 0; jj < 32; ++jj) cnt += (key[jj] >= cand) ? 1 : 0;
                    { int tot = 0;
#pragma unroll
                      for (int bb = 0; bb < 6; ++bb) tot += __popcll(__ballot((cnt >> bb) & 1)) << bb;
                      cnt = tot; }
                    if (cnt >= 256) { thr = cand; if (cnt == 256) break; }
                }
            }
            unsigned wd = 0u;
#pragma unroll
            for (int jj = 0; jj < 32; ++jj) { const int s2 = lane + 64 * jj; const unsigned long long m = __ballot(s2 <= t && key[jj] >= thr);
                if (lane == 2 * jj) wd = (unsigned)m; if (lane == 2 * jj + 1) wd = (unsigned)(m >> 32); }
            MASK[((size_t)b * 2048 + t) * 64 + lane] = wd;
        }
        WAVE_SYNC();
    }
}

__device__ __forceinline__ int t5_bucket(int d) {
    if (d < 16) return d;
    return 16 + (d >= 19) + (d >= 21) + (d >= 24) + (d >= 27) + (d >= 31) + (d >= 35) + (d >= 40) + (d >= 46) + (d >= 52) + (d >= 59) + (d >= 67) + (d >= 77) + (d >= 87) + (d >= 99) + (d >= 113);
}
namespace dsa {
constexpr float SCALE = 0.08838834764831845f;
constexpr int NW = 8, QBLK = 32, KVBLK = 64, QB = NW * QBLK, DH = 128, LD = 2048;
constexpr int SHM_V = KVBLK * DH * 2, SHM_K = KVBLK * DH * 2;
constexpr int OFF_WS = 2 * SHM_V + 2 * SHM_K, OFF_BIAS = OFF_WS + NW * 64 * 4, LDS_TOTAL = OFF_BIAS + 16 * 128 * 4;
constexpr float THR = 8.f;
typedef short s16x4 __attribute__((ext_vector_type(4)));
#define KSWZ(row, colB) ((row) * 256 + ((colB) ^ (((row) & 7) << 4)))
#define SBAR() __builtin_amdgcn_sched_barrier(0)
__device__ __forceinline__ int v_st(int k, int c) { const int kk = (k & ~0xC) | ((k & 4) << 1) | ((k & 8) >> 1); return ((kk >> 3) * 4 + (c >> 5)) * 512 + ((kk & 7) * 32 + (c & 31)) * 2; }
__device__ __forceinline__ int v_rd_base(int lane) { return ((lane & 3) << 3) | (((lane >> 2) & 3) << 6) | (((lane >> 4) & 1) << 5) | (((lane >> 5) & 1) << 8); }
constexpr int v_rd_off(int d0, int ks, int half) { return d0 * 512 + ks * 4096 + half * 2048; }
__device__ __forceinline__ int crow(int r, int hi) { return (r & 3) + 8 * (r >> 2) + 4 * hi; }
__device__ __forceinline__ unsigned cvtpk(float lo, float hi) { unsigned r; asm volatile("v_cvt_pk_bf16_f32 %0, %1, %2" : "=v"(r) : "v"(lo), "v"(hi)); return r; }
__device__ __forceinline__ bf16x8 load8(const bf16* p) { return *reinterpret_cast<const bf16x8*>(p); }
template <bool NEAR>
__device__ __forceinline__ void init_scores(f32x16& p0, f32x16& p1, unsigned w0, unsigned w1, int hi, int dq, const float* bl) {
    w0 >>= 4 * hi; w1 >>= 4 * hi;
#pragma unroll
    for (int r = 0; r < 16; ++r) { const int c = (r & 3) + 8 * (r >> 2);
        const int x0 = __builtin_amdgcn_sbfe(w0, c, 1), x1 = __builtin_amdgcn_sbfe(w1, c, 1);
        unsigned b0 = 0u, b1 = 0u;
        if (NEAR) { int d0 = dq - c, d1 = dq - c - 32; d0 = d0 < 0 ? 0 : (d0 > 127 ? 127 : d0); d1 = d1 < 0 ? 0 : (d1 > 127 ? 127 : d1);
            b0 = __float_as_uint(bl[d0]); b1 = __float_as_uint(bl[d1]); }
        p0[r] = __uint_as_float((b0 & (unsigned)x0) | (0xFF800000u & ~(unsigned)x0));
        p1[r] = __uint_as_float((b1 & (unsigned)x1) | (0xFF800000u & ~(unsigned)x1)); }
}
__device__ __forceinline__ void partialSM(f32x16& p0, f32x16& p1, float& m_reg, float& mn, float& alpha) {
    float pmax = p0[0];
#pragma unroll
    for (int r = 1; r < 16; ++r) pmax = fmaxf(pmax, p0[r]);
#pragma unroll
    for (int r = 0; r < 16; ++r) pmax = fmaxf(pmax, p1[r]);
    { auto rr = __builtin_amdgcn_permlane32_swap(__float_as_uint(pmax), __float_as_uint(pmax), false, false);
      pmax = fmaxf(__uint_as_float(rr[0]), __uint_as_float(rr[1])); }
    constexpr float C2 = 1.4426950408889634f * SCALE;
    if (__builtin_expect(__all((pmax - m_reg) * SCALE <= THR), 1)) { mn = m_reg; alpha = 1.f; }
    else { mn = fmaxf(m_reg, pmax); alpha = __builtin_amdgcn_exp2f((m_reg - mn) * C2); m_reg = mn; }
    const float mnL = -mn * C2;
#pragma unroll
    for (int r = 0; r < 16; ++r) p0[r] = fmaf(p0[r], C2, mnL);
#pragma unroll
    for (int r = 0; r < 16; ++r) p1[r] = fmaf(p1[r], C2, mnL);
#pragma unroll
    for (int r = 0; r < 16; ++r) p0[r] = __builtin_amdgcn_exp2f(p0[r]);
}
__device__ __forceinline__ void finishSM(f32x16& p0, f32x16& p1, float alpha, float& l_reg, bf16x8& pa0, bf16x8& pa1, bf16x8& pa2, bf16x8& pa3) {
#pragma unroll
    for (int r = 0; r < 16; ++r) p1[r] = __builtin_amdgcn_exp2f(p1[r]);
    float ps = 0;
#pragma unroll
    for (int r = 0; r < 16; ++r) ps += p0[r];
#pragma unroll
    for (int r = 0; r < 16; ++r) ps += p1[r];
    { auto rr = __builtin_amdgcn_permlane32_swap(__float_as_uint(ps), __float_as_uint(ps), false, false);
      ps = __uint_as_float(rr[0]) + __uint_as_float(rr[1]); }
    l_reg = l_reg * alpha + ps;
#define PK4(P, B_, OUT) do { unsigned a0 = cvtpk(P[B_+0], P[B_+1]), a1 = cvtpk(P[B_+2], P[B_+3]);                          \
        unsigned b0 = cvtpk(P[B_+4], P[B_+5]), b1 = cvtpk(P[B_+6], P[B_+7]);                                             \
        auto r0 = __builtin_amdgcn_permlane32_swap(a0, b0, false, false); auto r1 = __builtin_amdgcn_permlane32_swap(a1, b1, false, false); \
        u32x4 w = {r0[0], r1[0], r0[1], r1[1]}; OUT = *reinterpret_cast<bf16x8*>(&w); } while (0)
    PK4(p0, 0, pa0); PK4(p0, 8, pa1); PK4(p1, 0, pa2); PK4(p1, 8, pa3);
#undef PK4
}
template <int KB>
__device__ __forceinline__ void qkt(f32x16& p0, f32x16& p1, const char* K_lds, int r32, int hi, const bf16x8* qr) {
    const char* kb[4];
#pragma unroll
    for (int dd = 0; dd < 4; ++dd) kb[dd] = K_lds + KB * SHM_K + KSWZ(r32, (dd * 16 + hi * 8) * 2);
#pragma unroll
    for (int d0 = 0; d0 < 8; ++d0) { const char* a = kb[d0 & 3] + (d0 >> 2) * 128;
        bf16x8 b0 = *reinterpret_cast<const bf16x8*>(a);
        bf16x8 b1 = *reinterpret_cast<const bf16x8*>(a + 32 * 256);
        p0 = __builtin_amdgcn_mfma_f32_32x32x16_bf16(b0, qr[d0], p0, 0, 0, 0);
        p1 = __builtin_amdgcn_mfma_f32_32x32x16_bf16(b1, qr[d0], p1, 0, 0, 0); }
}
template <int VB>
__device__ __forceinline__ void pv_tile(f32x16* o, int vb0, bf16x8 pa0, bf16x8 pa1, bf16x8 pa2, bf16x8 pa3) {
#define TRRD(dst, off) asm volatile("ds_read_b64_tr_b16 %0, %1 offset:%2" : "=&v"(dst) : "v"(vb0), "i"(off) : "memory")
#define PV_D0(d0) do { s16x4 l0, l1, l2, l3, h0, h1, h2, h3; constexpr int b_ = VB * SHM_V + v_rd_off(d0, 0, 0); \
        TRRD(l0, b_); TRRD(h0, b_ + 2048); TRRD(l1, b_ + 4096); TRRD(h1, b_ + 6144); TRRD(l2, b_ + 8192); TRRD(h2, b_ + 10240); TRRD(l3, b_ + 12288); TRRD(h3, b_ + 14336); \
        asm volatile("s_waitcnt lgkmcnt(0)" ::: "memory"); SBAR();   \
        o[d0] = __builtin_amdgcn_mfma_f32_32x32x16_bf16(pa0, (bf16x8){l0[0], l0[1], l0[2], l0[3], h0[0], h0[1], h0[2], h0[3]}, o[d0], 0, 0, 0);   \
        o[d0] = __builtin_amdgcn_mfma_f32_32x32x16_bf16(pa1, (bf16x8){l1[0], l1[1], l1[2], l1[3], h1[0], h1[1], h1[2], h1[3]}, o[d0], 0, 0, 0);   \
        o[d0] = __builtin_amdgcn_mfma_f32_32x32x16_bf16(pa2, (bf16x8){l2[0], l2[1], l2[2], l2[3], h2[0], h2[1], h2[2], h2[3]}, o[d0], 0, 0, 0);   \
        o[d0] = __builtin_amdgcn_mfma_f32_32x32x16_bf16(pa3, (bf16x8){l3[0], l3[1], l3[2], l3[3], h3[0], h3[1], h3[2], h3[3]}, o[d0], 0, 0, 0); } while (0)
    PV_D0(0); PV_D0(1); PV_D0(2); PV_D0(3);
#undef PV_D0
#undef TRRD
}
struct BlockRef { const bf16* Q; const bf16* K; const bf16* V; bf16* O; const unsigned* M; int P0; int h; };
struct Seam { bf16x8 qr[8]; bf16x8 st_v0, st_v1, st_k0, st_k1; };
#define ROWU(p, k0) ((p) + (size_t)(k0) * LD)
#define VMW() asm volatile("s_waitcnt vmcnt(0)" ::: "memory")
#define VMWN(n) asm volatile("s_waitcnt vmcnt(%0)" :: "i"(n) : "memory")
#define SLOAD_H(Kp, Vp, k0) do { S.st_v0 = load8(ROWU(Vp, k0) + sofs); S.st_v1 = load8(ROWU(Vp, (k0) + 32) + sofs);              \
                         S.st_k0 = load8(ROWU(Kp, k0) + sofs); S.st_k1 = load8(ROWU(Kp, (k0) + 32) + sofs); } while (0)
#define SWRITE_HK(bf) do { *(bf16x8*)(K_lds + (bf) * SHM_K + kws) = S.st_k0; *(bf16x8*)(K_lds + (bf) * SHM_K + kws + 32 * 256) = S.st_k1; } while (0)
#define SWRITE_HV(bf) do { *(bf16x8*)(V_lds + (bf) * SHM_V + vst0) = S.st_v0; *(bf16x8*)(V_lds + (bf) * SHM_V + vst1) = S.st_v1; } while (0)
#define SWRITE_H(bf) do { SWRITE_HV(bf); SWRITE_HK(bf); } while (0)
__device__ __forceinline__ void prime(const BlockRef& cur, char* lds, Seam& S, int wid) {
    const int lane = fresh_lane(), tid = wid * 64 + lane, r32 = lane & 31, hi = lane >> 5;
    const int sr = tid >> 4, sc = (tid & 15) * 8, kws = KSWZ(sr, sc * 2); char* K_lds = lds + 2 * SHM_V; const unsigned sofs = (unsigned)(sr * LD + sc);
    const unsigned qofs = (unsigned)((wid * QBLK + r32) * LD + hi * 8);
#pragma unroll
    for (int d0 = 0; d0 < 8; ++d0) S.qr[d0] = load8(cur.Q + qofs + d0 * 16);
    SLOAD_H(cur.K, cur.V, 0); VMW(); SWRITE_HK(0);
    __syncthreads();
}
__device__ __forceinline__ void block(const BlockRef& cur, const BlockRef& nxt, char* lds, Seam& S, int wid) {
    const int lane = fresh_lane(), tid = wid * 64 + lane,
               r32 = lane & 31, hi = lane >> 5;
    const int NT = (cur.P0 + QB - 1) / KVBLK + 1;
    const int qlo = cur.P0 + wid * QBLK, qm = qlo + r32 - 4 * hi;
    char* V_lds = lds; char* K_lds = lds + 2 * SHM_V;
    float* ws = (float*)(lds + OFF_WS) + wid * 64; float* li_l = ws, * al_l = ws + 32;
    const float* bl = (const float*)(lds + OFF_BIAS) + cur.h * 128;
    const unsigned mofs = (unsigned)((wid * QBLK + r32) * 64);
    float m_reg = -1e30f, l_reg = 0; f32x16 o[4] = {};
    const int sr = tid >> 4, sc = (tid & 15) * 8, vst0 = v_st(sr, sc), vst1 = v_st(32 + sr, sc), kws = KSWZ(sr, sc * 2); const unsigned sofs = (unsigned)(sr * LD + sc);
    const int vb0 = (int)(uintptr_t)V_lds + v_rd_base(lane);
    const bf16* Kh = cur.K; const bf16* Vh = cur.V;
#define RESC(a) do { if (__any((a) < 1.f)) { if (hi == 0) al_l[r32] = (a); asm volatile("s_waitcnt lgkmcnt(0)" ::: "memory");              \
                     for (int d_ = 0; d_ < 4; ++d_) for (int r = 0; r < 16; ++r) o[d_][r] *= al_l[crow(r, hi)]; } } while (0)
#define KBASE(t) ((t) * KVBLK)
#define LDMASK(t) (*(const u32x2*)(cur.M + 2 * ((t) < 31 ? (t) : 31) + mofs))
#define INIT(P0_, P1_, t) do { const int kb_ = KBASE(t); if (qlo - kb_ - 63 < 113) init_scores<true>(P0_, P1_, mw.x, mw.y, hi, qm - kb_, bl); else init_scores<false>(P0_, P1_, mw.x, mw.y, hi, 0, bl); } while (0)
#define SEAM_K0() do { VMWN(8); SWRITE_HK(0); SBAR(); } while (0)
    f32x16 pA0, pA1, pB0, pB1; float mnA, mnB, alA, alB; bf16x8 pa0, pa1, pa2, pa3; u32x2 mw;
    SWRITE_HV(0); SBAR();
    if (NT > 1) { SLOAD_H(Kh, Vh, KBASE(1)); }
    mw = LDMASK(0); INIT(pA0, pA1, 0); mw = LDMASK(1);
    SBAR(); qkt<0>(pA0, pA1, K_lds, r32, hi, S.qr);
    partialSM(pA0, pA1, m_reg, mnA, alA);
    if (NT > 1) { VMW(); SWRITE_H(1); }
    __syncthreads();
#define HALF_STEP(PX0, PX1, mnX, alX, PY0, PY1, alY, t, KB, VB, SB) do {                                                      \
        INIT(PX0, PX1, (t)); mw = LDMASK((t) + 1);                                                                           \
        SBAR(); qkt<KB>(PX0, PX1, K_lds, r32, hi, S.qr);                                                                      \
        finishSM(PY0, PY1, alY, l_reg, pa0, pa1, pa2, pa3); SBAR();                                                           \
        if ((t) + 1 < NT) { SLOAD_H(Kh, Vh, KBASE((t) + 1)); SBAR(); }                                                        \
        pv_tile<VB>(o, vb0, pa0, pa1, pa2, pa3); partialSM(PX0, PX1, m_reg, mnX, alX);              \
        __syncthreads();                                                                                                      \
        if ((t) + 1 < NT) { VMW(); SWRITE_H(SB); }                                                                            \
        RESC(alX); __syncthreads(); } while (0)
    for (int t = 1; t + 1 < NT; t += 2) {
        HALF_STEP(pB0, pB1, mnB, alB, pA0, pA1, alA, t, 1, 0, 0);
        HALF_STEP(pA0, pA1, mnA, alA, pB0, pB1, alB, t + 1, 0, 1, 1);
    }
    const bool even = (NT & 1) == 0;
    if (even) { INIT(pB0, pB1, NT - 1); SBAR(); qkt<1>(pB0, pB1, K_lds, r32, hi, S.qr); SBAR(); }
    SLOAD_H(nxt.K, nxt.V, 0); SBAR();
#pragma unroll
    for (int d0 = 0; d0 < 8; ++d0) S.qr[d0] = load8(nxt.Q + (unsigned)((wid * QBLK + r32) * LD + hi * 8) + d0 * 16);
    SBAR();
    finishSM(pA0, pA1, alA, l_reg, pa0, pa1, pa2, pa3); SBAR();
    pv_tile<0>(o, vb0, pa0, pa1, pa2, pa3);
    if (even) { partialSM(pB0, pB1, m_reg, mnB, alB); __syncthreads(); RESC(alB);
        finishSM(pB0, pB1, alB, l_reg, pa0, pa1, pa2, pa3); SBAR(); pv_tile<1>(o, vb0, pa0, pa1, pa2, pa3); }
    SBAR(); SEAM_K0();
    if (hi == 0) li_l[r32] = l_reg; asm volatile("s_waitcnt lgkmcnt(0)" ::: "memory");
    float rli[16];
#pragma unroll
    for (int r = 0; r < 16; ++r) rli[r] = __builtin_amdgcn_rcpf(li_l[crow(r, hi)]);
    int lofs = 4 * hi * LD + r32; asm volatile("" : "+v"(lofs));
    bf16* Ow = cur.O + (size_t)(wid * QBLK) * LD + lofs;
#pragma unroll
    for (int r = 0; r < 16; ++r) { const int orow = (r & 3) + 8 * (r >> 2);
#pragma unroll
        for (int d0 = 0; d0 < 4; ++d0) { const float v = o[d0][r] * rli[r];
            const float vn = __shfl_xor(v, 1);
            if ((r32 & 1) == 0) *(unsigned*)(Ow + orow * LD + d0 * 32) = cvtpk(v, vn); } }
    __syncthreads();
#undef RESC
#undef KBASE
#undef LDMASK
#undef INIT
#undef SEAM_K0
#undef HALF_STEP
}
#undef ROWU
#undef VMW
#undef VMWN
#undef SLOAD_H
#undef SWRITE_HK
#undef SWRITE_HV
#undef SWRITE_H
#undef KSWZ
#undef SBAR
}

__device__ __forceinline__ dsa::BlockRef dsa_ref(const Frame& F, int bh, int qb) {
    const int b = bh >> 4, h = bh & 15;
    dsa::BlockRef r;
    r.Q = F.slot(4) + ((size_t)b * 2048 + (size_t)qb * 256) * 2048 + h * 128;
    r.O = F.slot(3) + ((size_t)b * 2048 + (size_t)qb * 256) * 2048 + h * 128;
    r.K = F.slot(1) + (size_t)b * 2048 * 2048 + h * 128; r.V = F.slot(2) + (size_t)b * 2048 * 2048 + h * 128;
    r.M = (const unsigned*)(F.ws + WS_MASK) + ((size_t)b * 2048 + (size_t)qb * 256) * 64;
    r.P0 = qb * 256; r.h = h;
    return r;
}
__device__ __forceinline__ void ph6_attn(const Frame& F) {
    const Args& a = *F.a;
    char* lds = (char*)F.lds;
    {
        float* bt = (float*)(lds + dsa::OFF_BIAS);
        for (int i = F.wave * 64 + F.lane(); i < 16 * 128; i += 512) { const int h = i >> 7, d = i & 127; bt[i] = (a.in[10][t5_bucket(d) * 16 + h] - a.in[10][31 * 16 + h]) * (1.0f / dsa::SCALE); }
    }
    __syncthreads();
    const int total = 4 * 128;
    int L = F.bid; if (L >= total) return;
#define ATT_BH(L_) (((L_) >> 8) * 64 + ((L_) & 7) * 8 + ((((L_) & 255) >> 3) >> 2))
#define ATT_PR(L_) ((((L_) & 255) >> 3) & 3)
    int pass = 0;
    const bool xmap = (F.G == 256);
    dsa::BlockRef cur = dsa_ref(F, xmap ? ATT_BH(L) : (L >> 2), xmap ? ATT_PR(L) : (L & 3));
    dsa::Seam S;
    dsa::prime(cur, lds, S, F.wave);
    for (;;) {
        const bool more_pass = pass == 0, more_item = L + F.G < total, last = !more_pass && !more_item;
        int passn = pass + 1, Ln = L;
        if (!more_pass) { passn = 0; Ln = more_item ? L + F.G : L; }
        const int bhn = xmap ? ATT_BH(Ln) : (Ln >> 2), prn = xmap ? ATT_PR(Ln) : (Ln & 3);
        const dsa::BlockRef nxt = last ? cur : dsa_ref(F, bhn, passn ? 7 - prn : prn);
        dsa::block(cur, nxt, lds, S, F.wave);
        if (last) break;
        cur = nxt; pass = passn; L = Ln;
    }
}

__device__ __forceinline__ void ln_row(float* zrow, const float* g, const float* bta, bf16* brow, int lane) {
    f32x4 v[8]; float s = 0.f;
#pragma unroll
    for (int i = 0; i < 8; ++i) { v[i] = *(const f32x4*)(zrow + 256 * i + 4 * lane); s += (v[i].x + v[i].y) + (v[i].z + v[i].w); }
    const float mu = wave_sum(s) * (1.0f / 2048.0f); float s2 = 0.f;
#pragma unroll
    for (int i = 0; i < 8; ++i) { v[i] = v[i] - mu; s2 += (v[i].x * v[i].x + v[i].y * v[i].y) + (v[i].z * v[i].z + v[i].w * v[i].w); }
    const float r = rsqrtf(wave_sum(s2) * (1.0f / 2048.0f) + 1e-5f);
#pragma unroll
    for (int i = 0; i < 8; ++i) { const f32x4 gg = *(const f32x4*)(g + 256 * i + 4 * lane), bb = *(const f32x4*)(bta + 256 * i + 4 * lane);
        const f32x4 o = v[i] * r * gg + bb; *(f32x4*)(zrow + 256 * i + 4 * lane) = o;
        if (brow) { u32x2 w; w.x = pk2(o.x, o.y); w.y = pk2(o.z, o.w); *(u32x2*)(brow + 256 * i + 4 * lane) = w; } }
}
__device__ __forceinline__ void ph_ln(const Frame& F, const float* g, const float* bta, bf16* bout) {
    const int gw = F.bid * 8 + F.wave, NGW = F.G * 8, lane = F.lane();
    for (int row = gw; row < T; row += NGW) ln_row(F.a->out + (size_t)row * 2048, g, bta, bout + (size_t)row * 2048, lane);
}

__device__ __forceinline__ float pk_idx(float v, unsigned code, unsigned mask) { return __uint_as_float((__float_as_uint(v) & ~mask) | code); }
__device__ __forceinline__ void ph_peer_select(const Frame& F) {
    const Args& a = *F.a;
    const int lane = F.lane(), l31 = lane & 31, half = lane >> 5;
    const float* PQ = (const float*)F.slot(1); const float* keys = a.in[23];
    int* EIDX = (int*)(F.ws + WS_CKV); float* EG = (float*)(F.ws + WS_IKW);
    const float NEG = -__builtin_inff();
    const int h = F.bid & 7, ntw = F.G >> 3;
    { const int tid = F.wave * 64 + lane;
#pragma unroll
      for (int p = 0; p < 2; ++p)
#pragma unroll
          for (int i = 0; i < 8; ++i) { const int idx = tid + 512 * i, row = idx >> 5, c4 = idx & 31;
              *(f32x4*)(F.lds + (size_t)p * 67584 + ((size_t)row * 132 + 4 * c4) * 4) = *(const f32x4*)(keys + ((size_t)(2 * h + p) * 128 + row) * 128 + 4 * c4); }
      __syncthreads(); }
    for (int tile = (F.bid >> 3) + ntw * F.wave; tile < T / 32; tile += ntw * 8) {
        const int t = tile * 32 + l31;
        float tv[2][16];
#pragma unroll
        for (int p = 0; p < 2; ++p) {
            const int g = 2 * h + p;
            float qv[64];
            { const float* qp = PQ + (size_t)t * 2048 + g * 128 + 64 * half;
#pragma unroll
              for (int j = 0; j < 16; ++j) { const f32x4 v = *(const f32x4*)(qp + 4 * j); qv[4 * j] = v.x; qv[4 * j + 1] = v.y; qv[4 * j + 2] = v.z; qv[4 * j + 3] = v.w; } }
            f32x16 acc[4];
#pragma unroll
            for (int mt = 0; mt < 4; ++mt)
#pragma unroll
                for (int r = 0; r < 16; ++r) acc[mt][r] = 0.f;
            const float* kp0 = (const float*)(F.lds + (size_t)p * 67584) + ((size_t)l31 * 132 + 64 * half);
            f32x4 kb[3][4];
#define PK_LOADC(cc) do { _Pragma("unroll") for (int u_ = 0; u_ < 4; ++u_) kb[(cc) % 3][u_] = *(const f32x4*)(kp0 + (size_t)((cc) >> 2) * 32 * 132 + 16 * ((cc) & 3) + 4 * u_); } while (0)
#define PK_MMAC(cc) do { _Pragma("unroll") for (int u_ = 0; u_ < 4; ++u_) { const f32x4 kv_ = kb[(cc) % 3][u_]; const int j_ = 4 * ((cc) & 3) + u_; \
                acc[(cc) >> 2] = __builtin_amdgcn_mfma_f32_32x32x2f32(kv_.x, qv[4 * j_], acc[(cc) >> 2], 0, 0, 0); acc[(cc) >> 2] = __builtin_amdgcn_mfma_f32_32x32x2f32(kv_.y, qv[4 * j_ + 1], acc[(cc) >> 2], 0, 0, 0); \
                acc[(cc) >> 2] = __builtin_amdgcn_mfma_f32_32x32x2f32(kv_.z, qv[4 * j_ + 2], acc[(cc) >> 2], 0, 0, 0); acc[(cc) >> 2] = __builtin_amdgcn_mfma_f32_32x32x2f32(kv_.w, qv[4 * j_ + 3], acc[(cc) >> 2], 0, 0, 0); } } while (0)
            PK_LOADC(0); PK_LOADC(1);
            PK_LOADC(2); PK_MMAC(0); __builtin_amdgcn_sched_barrier(0);
            PK_LOADC(3); PK_MMAC(1); __builtin_amdgcn_sched_barrier(0);
            PK_LOADC(4); PK_MMAC(2); __builtin_amdgcn_sched_barrier(0);
            PK_LOADC(5); PK_MMAC(3); __builtin_amdgcn_sched_barrier(0);
            PK_LOADC(6); PK_MMAC(4); __builtin_amdgcn_sched_barrier(0);
            PK_LOADC(7); PK_MMAC(5); __builtin_amdgcn_sched_barrier(0);
            PK_LOADC(8); PK_MMAC(6); __builtin_amdgcn_sched_barrier(0);
            PK_LOADC(9); PK_MMAC(7); __builtin_amdgcn_sched_barrier(0);
            PK_LOADC(10); PK_MMAC(8); __builtin_amdgcn_sched_barrier(0);
            PK_LOADC(11); PK_MMAC(9); __builtin_amdgcn_sched_barrier(0);
            PK_LOADC(12); PK_MMAC(10); __builtin_amdgcn_sched_barrier(0);
            PK_LOADC(13); PK_MMAC(11); __builtin_amdgcn_sched_barrier(0);
            PK_LOADC(14); PK_MMAC(12); __builtin_amdgcn_sched_barrier(0);
            PK_LOADC(15); PK_MMAC(13); __builtin_amdgcn_sched_barrier(0);
            PK_MMAC(14); __builtin_amdgcn_sched_barrier(0);
            PK_MMAC(15); __builtin_amdgcn_sched_barrier(0);
#undef PK_LOADC
#undef PK_MMAC
            unsigned hmask = ~(4u * (unsigned)half); asm volatile("" : "+v"(hmask));
#pragma unroll
            for (int mt = 0; mt < 4; ++mt)
#pragma unroll
                for (int r = 0; r < 16; ++r) acc[mt][r] = __uint_as_float(((__float_as_uint(acc[mt][r]) & ~127u) | (unsigned)(127 - (32 * mt + (r & 3) + 8 * (r >> 2)))) & hmask);
#pragma unroll
            for (int k = 0; k < 16; ++k) {
                float m = acc[0][0];
#pragma unroll
                for (int mt = 0; mt < 4; ++mt)
#pragma unroll
                    for (int r = 0; r < 16; ++r) m = fmaxf(m, acc[mt][r]);
                m = fmaxf(m, __shfl_xor(m, 32));
                tv[p][k] = m;
#pragma unroll
                for (int mt = 0; mt < 4; ++mt)
#pragma unroll
                    for (int r = 0; r < 16; ++r) acc[mt][r] = (acc[mt][r] == m) ? NEG : acc[mt][r];
            }
        }
        float cand[25]; int cid[25];
        unsigned hc = 25u * (unsigned)half; asm volatile("" : "+v"(hc));
        { const float ai = half ? tv[0][2] : tv[0][0], bj = half ? tv[1][1] : tv[1][0];
          cand[0] = pk_idx(ai + bj, (unsigned)(63 - 0) - hc, 63u); cid[0] = (int)((127u - (__float_as_uint(ai) & 127u)) * 128u + (127u - (__float_as_uint(bj) & 127u))); }
        { const float ai = half ? tv[0][2] : tv[0][0], bj = half ? tv[1][2] : tv[1][1];
          cand[1] = pk_idx(ai + bj, (unsigned)(63 - 1) - hc, 63u); cid[1] = (int)((127u - (__float_as_uint(ai) & 127u)) * 128u + (127u - (__float_as_uint(bj) & 127u))); }
        { const float ai = half ? tv[0][2] : tv[0][0], bj = half ? tv[1][3] : tv[1][2];
          cand[2] = pk_idx(ai + bj, (unsigned)(63 - 2) - hc, 63u); cid[2] = (int)((127u - (__float_as_uint(ai) & 127u)) * 128u + (127u - (__float_as_uint(bj) & 127u))); }
        { const float ai = half ? tv[0][2] : tv[0][0], bj = half ? tv[1][4] : tv[1][3];
          cand[3] = pk_idx(ai + bj, (unsigned)(63 - 3) - hc, 63u); cid[3] = (int)((127u - (__float_as_uint(ai) & 127u)) * 128u + (127u - (__float_as_uint(bj) & 127u))); }
        { const float ai = half ? tv[0][3] : tv[0][0], bj = half ? tv[1][0] : tv[1][4];
          cand[4] = pk_idx(ai + bj, (unsigned)(63 - 4) - hc, 63u); cid[4] = (int)((127u - (__float_as_uint(ai) & 127u)) * 128u + (127u - (__float_as_uint(bj) & 127u))); }
        { const float ai = half ? tv[0][3] : tv[0][0], bj = half ? tv[1][1] : tv[1][5];
          cand[5] = pk_idx(ai + bj, (unsigned)(63 - 5) - hc, 63u); cid[5] = (int)((127u - (__float_as_uint(ai) & 127u)) * 128u + (127u - (__float_as_uint(bj) & 127u))); }
        { const float ai = half ? tv[0][3] : tv[0][0], bj = half ? tv[1][2] : tv[1][6];
          cand[6] = pk_idx(ai + bj, (unsigned)(63 - 6) - hc, 63u); cid[6] = (int)((127u - (__float_as_uint(ai) & 127u)) * 128u + (127u - (__float_as_uint(bj) & 127u))); }
        { const float ai = half ? tv[0][3] : tv[0][0], bj = half ? tv[1][3] : tv[1][7];
          cand[7] = pk_idx(ai + bj, (unsigned)(63 - 7) - hc, 63u); cid[7] = (int)((127u - (__float_as_uint(ai) & 127u)) * 128u + (127u - (__float_as_uint(bj) & 127u))); }
        { const float ai = half ? tv[0][4] : tv[0][0], bj = half ? tv[1][0] : tv[1][8];
          cand[8] = pk_idx(ai + bj, (unsigned)(63 - 8) - hc, 63u); cid[8] = (int)((127u - (__float_as_uint(ai) & 127u)) * 128u + (127u - (__float_as_uint(bj) & 127u))); }
        { const float ai = half ? tv[0][4] : tv[0][0], bj = half ? tv[1][1] : tv[1][9];
          cand[9] = pk_idx(ai + bj, (unsigned)(63 - 9) - hc, 63u); cid[9] = (int)((127u - (__float_as_uint(ai) & 127u)) * 128u + (127u - (__float_as_uint(bj) & 127u))); }
        { const float ai = half ? tv[0][4] : tv[0][0], bj = half ? tv[1][2] : tv[1][10];
          cand[10] = pk_idx(ai + bj, (unsigned)(63 - 10) - hc, 63u); cid[10] = (int)((127u - (__float_as_uint(ai) & 127u)) * 128u + (127u - (__float_as_uint(bj) & 127u))); }
        { const float ai = half ? tv[0][5] : tv[0][0], bj = half ? tv[1][0] : tv[1][11];
          cand[11] = pk_idx(ai + bj, (unsigned)(63 - 11) - hc, 63u); cid[11] = (int)((127u - (__float_as_uint(ai) & 127u)) * 128u + (127u - (__float_as_uint(bj) & 127u))); }
        { const float ai = half ? tv[0][5] : tv[0][0], bj = half ? tv[1][1] : tv[1][12];
          cand[12] = pk_idx(ai + bj, (unsigned)(63 - 12) - hc, 63u); cid[12] = (int)((127u - (__float_as_uint(ai) & 127u)) * 128u + (127u - (__float_as_uint(bj) & 127u))); }
        { const float ai = half ? tv[0][6] : tv[0][0], bj = half ? tv[1][0] : tv[1][13];
          cand[13] = pk_idx(ai + bj, (unsigned)(63 - 13) - hc, 63u); cid[13] = (int)((127u - (__float_as_uint(ai) & 127u)) * 128u + (127u - (__float_as_uint(bj) & 127u))); }
        { const float ai = half ? tv[0][6] : tv[0][0], bj = half ? tv[1][1] : tv[1][14];
          cand[14] = pk_idx(ai + bj, (unsigned)(63 - 14) - hc, 63u); cid[14] = (int)((127u - (__float_as_uint(ai) & 127u)) * 128u + (127u - (__float_as_uint(bj) & 127u))); }
        { const float ai = half ? tv[0][7] : tv[0][0], bj = half ? tv[1][0] : tv[1][15];
          cand[15] = pk_idx(ai + bj, (unsigned)(63 - 15) - hc, 63u); cid[15] = (int)((127u - (__float_as_uint(ai) & 127u)) * 128u + (127u - (__float_as_uint(bj) & 127u))); }
        { const float ai = half ? tv[0][7] : tv[0][1], bj = half ? tv[1][1] : tv[1][0];
          cand[16] = pk_idx(ai + bj, (unsigned)(63 - 16) - hc, 63u); cid[16] = (int)((127u - (__float_as_uint(ai) & 127u)) * 128u + (127u - (__float_as_uint(bj) & 127u))); }
        { const float ai = half ? tv[0][8] : tv[0][1], bj = half ? tv[1][0] : tv[1][1];
          cand[17] = pk_idx(ai + bj, (unsigned)(63 - 17) - hc, 63u); cid[17] = (int)((127u - (__float_as_uint(ai) & 127u)) * 128u + (127u - (__float_as_uint(bj) & 127u))); }
        { const float ai = half ? tv[0][9] : tv[0][1], bj = half ? tv[1][0] : tv[1][2];
          cand[18] = pk_idx(ai + bj, (unsigned)(63 - 18) - hc, 63u); cid[18] = (int)((127u - (__float_as_uint(ai) & 127u)) * 128u + (127u - (__float_as_uint(bj) & 127u))); }
        { const float ai = half ? tv[0][10] : tv[0][1], bj = half ? tv[1][0] : tv[1][3];
          cand[19] = pk_idx(ai + bj, (unsigned)(63 - 19) - hc, 63u); cid[19] = (int)((127u - (__float_as_uint(ai) & 127u)) * 128u + (127u - (__float_as_uint(bj) & 127u))); }
        { const float ai = half ? tv[0][11] : tv[0][1], bj = half ? tv[1][0] : tv[1][4];
          cand[20] = pk_idx(ai + bj, (unsigned)(63 - 20) - hc, 63u); cid[20] = (int)((127u - (__float_as_uint(ai) & 127u)) * 128u + (127u - (__float_as_uint(bj) & 127u))); }
        { const float ai = half ? tv[0][12] : tv[0][1], bj = half ? tv[1][0] : tv[1][5];
          cand[21] = pk_idx(ai + bj, (unsigned)(63 - 21) - hc, 63u); cid[21] = (int)((127u - (__float_as_uint(ai) & 127u)) * 128u + (127u - (__float_as_uint(bj) & 127u))); }
        { const float ai = half ? tv[0][13] : tv[0][1], bj = half ? tv[1][0] : tv[1][6];
          cand[22] = pk_idx(ai + bj, (unsigned)(63 - 22) - hc, 63u); cid[22] = (int)((127u - (__float_as_uint(ai) & 127u)) * 128u + (127u - (__float_as_uint(bj) & 127u))); }
        { const float ai = half ? tv[0][14] : tv[0][1], bj = half ? tv[1][0] : tv[1][7];
          cand[23] = pk_idx(ai + bj, (unsigned)(63 - 23) - hc, 63u); cid[23] = (int)((127u - (__float_as_uint(ai) & 127u)) * 128u + (127u - (__float_as_uint(bj) & 127u))); }
        { const float ai = half ? tv[0][15] : tv[0][2], bj = half ? tv[1][0] : tv[1][0];
          cand[24] = pk_idx(ai + bj, (unsigned)(63 - 24) - hc, 63u); cid[24] = (int)((127u - (__float_as_uint(ai) & 127u)) * 128u + (127u - (__float_as_uint(bj) & 127u))); }
        float sv[16]; int sid[16];
#pragma unroll
        for (int k = 0; k < 16; ++k) {
            float m = cand[0];
#pragma unroll
            for (int c = 1; c < 25; ++c) m = fmaxf(m, cand[c]);
            const float mo = __shfl_xor(m, 32);
            const bool mine = (m > mo) || (m == mo && half == 0);
            const float mm = fmaxf(m, mo);
            int id = -1;
#pragma unroll
            for (int c = 0; c < 25; ++c) { const bool hit = mine && (cand[c] == mm); id = hit ? cid[c] : id; cand[c] = hit ? NEG : cand[c]; }
            const int ido = __shfl_xor(id, 32);
            sv[k] = mm; sid[k] = id > ido ? id : ido;
        }
        float den = 0.f; float ev[16];
#pragma unroll
        for (int k = 0; k < 16; ++k) { ev[k] = expf(sv[k] - sv[0]); den += ev[k]; }
        const float inv = 1.0f / den;
        if (half == 0) { int* ep = EIDX + (size_t)t * 128 + h * 16;
#pragma unroll
            for (int k = 0; k < 16; k += 4) *(u32x4*)(ep + k) = (u32x4){(unsigned)sid[k], (unsigned)sid[k + 1], (unsigned)sid[k + 2], (unsigned)sid[k + 3]}; }
        else { float* gp = EG + (size_t)t * 128 + h * 16;
#pragma unroll
            for (int k = 0; k < 16; k += 4) *(f32x4*)(gp + k) = (f32x4){ev[k] * inv, ev[k + 1] * inv, ev[k + 2] * inv, ev[k + 3] * inv}; }
    }
}

typedef unsigned v6u __attribute__((ext_vector_type(6)));
typedef float v32f __attribute__((ext_vector_type(32)));
typedef float v16f __attribute__((ext_vector_type(16)));
constexpr float PU_SCALE = 64.0f, PV_SCALE = 2.0f;
#ifndef FP6_INTERLEAVED
#define FP6_INTERLEAVED 1
#endif
#define RL(v, l) __builtin_amdgcn_readlane((v), (l))
#define EXR 2
#define EX_LOAD(bu, bv, idv, e) do { _Pragma("unroll") for (int r_ = 0; r_ < EXR; ++r_) { const unsigned* rp_ = (const unsigned*)(PUV + (size_t)RL(idv, ((e) & 63) + r_) * 3072) + 6 * lane; \
        const u32x2 p0_ = *(const u32x2*)rp_, p1_ = *(const u32x2*)(rp_ + 2), p2_ = *(const u32x2*)(rp_ + 4), q0_ = *(const u32x2*)(rp_ + 384), q1_ = *(const u32x2*)(rp_ + 386), q2_ = *(const u32x2*)(rp_ + 388); \
        bu[r_] = (v6u){p0_.x, p0_.y, p1_.x, p1_.y, p2_.x, p2_.y}; bv[r_] = (v6u){q0_.x, q0_.y, q1_.x, q1_.y, q2_.x, q2_.y}; } } while (0)
#define EX_USE(bu, bv, e) do { float d_[EXR]; _Pragma("unroll") for (int r_ = 0; r_ < EXR; ++r_) { const v32f w_ = __builtin_amdgcn_cvt_scalef32_pk32_f32_fp6(bu[r_], 1.0f); float a_ = 0.f, b_ = 0.f; \
        _Pragma("unroll") for (int j_ = 0; j_ < 32; j_ += 2) { a_ += w_[j_] * xf[j_]; b_ += w_[j_ + 1] * xf[j_ + 1]; } d_[r_] = a_ + b_; __builtin_amdgcn_sched_barrier(0); } \
        _Pragma("unroll") for (int r_ = 0; r_ < EXR; ++r_) d_[r_] = wave_sum_dpp(d_[r_]); \
        const float gv_ = (e) < 64 ? g0 : g1; \
        _Pragma("unroll") for (int r_ = 0; r_ < EXR; ++r_) { const float pre_ = d_[r_] * (1.0f / PU_SCALE); const float hv_ = 0.5f * pre_ * (1.0f + erff(pre_ * 0.7071067811865476f)); \
            const float cf_ = __int_as_float(RL(__float_as_int(gv_), ((e) & 63) + r_)) * hv_ * (1.0f / PV_SCALE); \
            const v32f w_ = __builtin_amdgcn_cvt_scalef32_pk32_f32_fp6(bv[r_], 1.0f); _Pragma("unroll") for (int j_ = 0; j_ < 32; ++j_) y[j_] += cf_ * w_[j_]; __builtin_amdgcn_sched_barrier(0); } } while (0)
__device__ __forceinline__ void cvt_fp6_stream(const Frame& F, const float* src, unsigned char* dst, size_t nrows, float scale, int wg, int nwg) {
    const int lane = F.lane();
    float* tile = (float*)(F.lds + F.wave * 8192);
    for (size_t r = (size_t)wg * 8 + F.wave; r < nrows; r += (size_t)nwg * 8) {
#pragma unroll
        for (int j = 0; j < 8; ++j) *(f32x4*)(tile + 256 * j + 4 * lane) = *(const f32x4*)(src + r * 2048 + 256 * j + 4 * lane) * scale;
        WAVE_SYNC();
        f32x4 q[8];
#pragma unroll
        for (int j = 0; j < 8; ++j) q[j] = *(const f32x4*)(tile + 32 * lane + 4 * j);
        WAVE_SYNC();
        v16f x, y;
#pragma unroll
        for (int j = 0; j < 8; ++j) { x[2 * j] = q[j].x; y[2 * j] = q[j].y; x[2 * j + 1] = q[j].z; y[2 * j + 1] = q[j].w; }
        const v6u p = __builtin_amdgcn_cvt_scalef32_2xpk16_fp6_f32(x, y, 1.0f);
        unsigned* o = (unsigned*)(dst + r * 3072) + 6 * lane;
        *(u32x2*)o = (u32x2){p[0], p[1]}; *(u32x2*)(o + 2) = (u32x2){p[2], p[3]}; *(u32x2*)(o + 4) = (u32x2){p[4], p[5]};
    }
}
#define EX_LOAD_XF() do { float mu_, rs_; row_mu_rstd((const float*)(F.ws + WS_CTL + CTL_ST2), t, mu_, rs_); \
          const bf16* zr = F.slot(0) + (size_t)t * 2048 + lq; \
          _Pragma("unroll") for (int q = 0; q < 4; ++q) { const int col = lq + 8 * q; f32x4 z0, z1; unpack8v(*(const u32x4*)(zr + 8 * q), z0, z1); \
              const f32x4 g0v = *(const f32x4*)(a.in[20] + col), g1v = *(const f32x4*)(a.in[20] + col + 4), b0v = *(const f32x4*)(a.in[21] + col), b1v = *(const f32x4*)(a.in[21] + col + 4); \
              const f32x4 h0 = (z0 - mu_) * rs_ * g0v + b0v, h1 = (z1 - mu_) * rs_ * g1v + b1v; \
              xf[8 * q] = h0.x; xf[8 * q + 1] = h0.y; xf[8 * q + 2] = h0.z; xf[8 * q + 3] = h0.w; xf[8 * q + 4] = h1.x; xf[8 * q + 5] = h1.y; xf[8 * q + 6] = h1.z; xf[8 * q + 7] = h1.w; } } while (0)
__device__ __forceinline__ void ph16_experts(const Frame& F) {
    const Args& a = *F.a;
    const int gw = F.bid * 8 + F.wave, NGW = F.G * 8, lane0 = F.lane();
    const int* EIDX = (const int*)(F.ws + WS_CKV); const float* EG = (const float*)(F.ws + WS_IKW);
    const unsigned char* PUV = (const unsigned char*)(F.ws + WS_WIN);
    for (int t = gw; t < T; t += NGW) {
        int lane_l = lane0; asm volatile("" : "+v"(lane_l)); const int lane = lane_l;
        float* xrow = a.out + (size_t)t * 2048;
        float xf[32];
        const int lq = 32 * lane;
        EX_LOAD_XF();
        const int id0 = EIDX[(size_t)t * 128 + lane], id1 = EIDX[(size_t)t * 128 + 64 + lane];
        const float g0 = EG[(size_t)t * 128 + lane], g1 = EG[(size_t)t * 128 + 64 + lane];
        float y[32];
#pragma unroll
        for (int j = 0; j < 32; ++j) y[j] = 0.f;
        v6u uA[EXR], vA[EXR], uB[EXR], vB[EXR];
        EX_LOAD(uA, vA, id0, 0);
#pragma unroll 1
        for (int e = 0; e < 128; e += 2 * EXR) {
            const int idv = e < 64 ? id0 : id1;
            EX_LOAD(uB, vB, idv, e + EXR);
            EX_USE(uA, vA, e);
            if (e + 2 * EXR < 128) { const int idn = (e + 2 * EXR) < 64 ? id0 : id1; EX_LOAD(uA, vA, idn, e + 2 * EXR); }
            EX_USE(uB, vB, e + EXR);
        }
        float s = 0.f;
#pragma unroll
        for (int j = 0; j < 32; ++j) { y[j] += ALPHA * xf[j]; s += y[j]; }
        const float mu = wave_sum_dpp(s) * (1.0f / 2048.0f); float s2 = 0.f;
#pragma unroll
        for (int j = 0; j < 32; ++j) { y[j] -= mu; s2 += y[j] * y[j]; }
        const float rs = rsqrtf(wave_sum_dpp(s2) * (1.0f / 2048.0f) + 1e-5f);
        const int lofs = lq;
#pragma unroll
        for (int q = 0; q < 8; ++q) { const int col = lofs + 4 * q;
            const f32x4 ga = *(const f32x4*)(a.in[26] + col), ba = *(const f32x4*)(a.in[27] + col);
            f32x4 o; o.x = y[4 * q] * rs * ga.x + ba.x; o.y = y[4 * q + 1] * rs * ga.y + ba.y; o.z = y[4 * q + 2] * rs * ga.z + ba.z; o.w = y[4 * q + 3] * rs * ga.w + ba.w;
            *(f32x4*)(xrow + col) = o; }
    }
}

#define XB_TMO      128
#define XB_XCNT(j)  (256  + 64 * (j))
#define XB_XSUB(j)  (1280 + 64 * (j))
#define XB_XGEN(j)  (2304 + 64 * (j))
#define XB_TOP      3328
#define XB_TOPGEN   3392
#define XCD_BAR_WORDS 3456
#define XB_SPIN_CAP (1u << 22)
__device__ __forceinline__ unsigned xb_ld(unsigned* p)              { return __hip_atomic_load(p, __ATOMIC_RELAXED, __HIP_MEMORY_SCOPE_AGENT); }
__device__ __forceinline__ unsigned xb_add(unsigned* p, unsigned v) { return __hip_atomic_fetch_add(p, v, __ATOMIC_RELAXED, __HIP_MEMORY_SCOPE_AGENT); }
__device__ __forceinline__ unsigned xb_xcc_id() { return (unsigned)__builtin_amdgcn_s_getreg((3 << 11) | 20) & 0xFu; }
#define XB_SPIN(cond, bar) do { unsigned _sp = 0; while (cond) { __builtin_amdgcn_s_sleep(1); \
    if ((++_sp & 255u) == 0u) { if (xb_ld(&(bar)[XB_TMO])) break; if (_sp > XB_SPIN_CAP) { atomicAdd(&(bar)[XB_TMO], 1u); break; } } } } while (0)
struct XcdBarrier { unsigned* bar; unsigned x; volatile unsigned* st; };
__device__ __forceinline__ void xcd_barrier_complete(unsigned* bar, unsigned x, unsigned G, unsigned& nloc, unsigned& nx) {
    unsigned sum, cnt, mine, sp = 0u;
    for (;;) {
        sum = 0u; cnt = 0u; mine = 0u;
#pragma unroll
        for (unsigned j = 0; j < 16; ++j) { const unsigned c = xb_ld(&bar[XB_XCNT(j)]); sum += c; cnt += (c > 0u) ? 1u : 0u; mine = (j == x) ? c : mine; }
        if (sum == G) break;
        __builtin_amdgcn_s_sleep(1);
        if ((++sp & 255u) == 0u) { if (xb_ld(&bar[XB_TMO])) break; if (sp > XB_SPIN_CAP) { atomicAdd(&bar[XB_TMO], 1u); break; } }
    }
    nloc = mine > 0u ? mine : 1u; nx = cnt > 0u ? cnt : 1u;
}
__device__ __forceinline__ void xcd_barrier(const XcdBarrier& b, bool leader, unsigned G) {
    asm volatile("s_waitcnt vmcnt(0)" ::: "memory");
    __syncthreads();
    if (leader) {
        unsigned* bar = b.bar;
        __builtin_amdgcn_s_waitcnt(0);
        unsigned nloc = b.st[0], nx = b.st[1];
        if (nloc == 0u) { xcd_barrier_complete(bar, b.x, G, nloc, nx); b.st[0] = nloc; b.st[1] = nx; }
        const unsigned old = xb_add(&bar[XB_XSUB(b.x)], 1u);
        const unsigned gen = old / nloc;
        if (old + 1u == (gen + 1u) * nloc) {
            __builtin_amdgcn_fence(__ATOMIC_RELEASE, "agent");
            asm volatile("s_waitcnt vmcnt(0)" ::: "memory");
            const unsigned og = xb_add(&bar[XB_TOP], 1u);
            const unsigned tg = og / nx;
            if (og + 1u == (tg + 1u) * nx) xb_add(&bar[XB_TOPGEN], 1u);
            else XB_SPIN(xb_ld(&bar[XB_TOPGEN]) == tg, bar);
            __builtin_amdgcn_fence(__ATOMIC_ACQUIRE, "agent");
            xb_add(&bar[XB_XGEN(b.x)], 1u);
            asm volatile("s_waitcnt vmcnt(0)" ::: "memory");
        } else {
            XB_SPIN(xb_ld(&bar[XB_XGEN(b.x)]) == gen, bar);
            __builtin_amdgcn_fence(__ATOMIC_ACQUIRE, "agent");
            asm volatile("s_waitcnt vmcnt(0)" ::: "memory");
        }
    }
    __syncthreads();
}

__device__ __forceinline__ void group_barrier(unsigned* ctr, unsigned target, bool leader) {
    asm volatile("s_waitcnt vmcnt(0)" ::: "memory");
    __syncthreads();
    if (leader) {
        __builtin_amdgcn_fence(__ATOMIC_RELEASE, "agent");
        asm volatile("s_waitcnt vmcnt(0)" ::: "memory");
        (void)xb_add(ctr, 1u);
        unsigned sp = 0u; while (xb_ld(ctr) < target) { __builtin_amdgcn_s_sleep(1); if (++sp > XB_SPIN_CAP) break; }
        __builtin_amdgcn_fence(__ATOMIC_ACQUIRE, "agent");
        asm volatile("s_waitcnt vmcnt(0)" ::: "memory");
    }
    __syncthreads();
}
__device__ __forceinline__ void sub_barrier(unsigned* ctr, unsigned n, bool leader) {
    asm volatile("s_waitcnt vmcnt(0)" ::: "memory");
    __syncthreads();
    if (leader) {
        __builtin_amdgcn_fence(__ATOMIC_RELEASE, "agent");
        asm volatile("s_waitcnt vmcnt(0)" ::: "memory");
        (void)xb_add(ctr, 1u);
        unsigned sp = 0u; while (xb_ld(ctr) < n) { __builtin_amdgcn_s_sleep(1); if (++sp > XB_SPIN_CAP) break; }
        __builtin_amdgcn_fence(__ATOMIC_ACQUIRE, "agent");
        asm volatile("s_waitcnt vmcnt(0)" ::: "memory");
    }
    __syncthreads();
}

__global__ void __launch_bounds__(512, 2) mega(Args args) {
    extern __shared__ __attribute__((aligned(16))) unsigned char lds[];
    cg::grid_group grid = cg::this_grid();
    Frame F;
    F.lds = lds; F.wave = __builtin_amdgcn_readfirstlane(threadIdx.x >> 6); F.bid = blockIdx.x; F.G = gridDim.x;
    F.a = &args; F.ws = args.ws;
    const int lo = args.ph_lo, hi = args.ph_hi;
    unsigned long long sec_acc = 0ull;
    unsigned grp_gen = 0u;
    if (lo < 0) grid.sync();
    volatile unsigned* xst = (volatile unsigned*)(lds + LDS_BYTES - 64);
    const bool leader = (F.wave == 0) && (fresh_lane() == 0);
    if (leader) { xst[0] = 0u; xst[1] = 0u; }
    XcdBarrier xbar; xbar.bar = (unsigned*)(F.ws + WS_CTL + CTL_BAR); xbar.x = xb_xcc_id(); xbar.st = xst;
    if (leader) (void)xb_add(&xbar.bar[XB_XCNT(xbar.x)], 1u);
    __syncthreads();
    bf16* W8 = (bf16*)((unsigned char*)args.out + (size_t)64 * MiB);
#define IN(k) (lo <= (k) && (k) < hi)
#if PROBE_MASK
    unsigned long long pr_acc = 0ull, pr_t0 = rt_now();
#define SEAM(k) do { if (IN(k) && IN((k) + 1)) { xcd_barrier(xbar, (F.wave == 0) && (fresh_lane() == 0), (unsigned)F.G); } { const unsigned long long t1_ = rt_now(); if ((PROBE_MASK >> (k)) & 1u) pr_acc += t1_ - pr_t0; pr_t0 = t1_; } } while (0)
#define GSEAM(k) SEAM(k)
#else
#define SEAM(k) do { if (IN(k) && IN((k) + 1)) { xcd_barrier(xbar, (F.wave == 0) && (fresh_lane() == 0), (unsigned)F.G); } } while (0)
#define GSEAM(k) do { if (IN(k) && IN((k) + 1)) { if ((F.G & 7) == 0) { ++grp_gen; group_barrier((unsigned*)(F.ws + WS_CTL + CTL_BAR) + 3648 + 64 * (F.bid & 7), (unsigned)(F.G >> 3) * grp_gen, (F.wave == 0) && (fresh_lane() == 0)); } else xcd_barrier(xbar, (F.wave == 0) && (fresh_lane() == 0), (unsigned)F.G); } } while (0)
#endif
    if (IN(0)) { ph0_prologue(F); } SEAM(0);
    if (IN(1)) {
        pg8::MultiOrder<3> S; S.lda = 2048; S.ldb = 2048; S.G = F.G; S.c = F.bid;
        S.s[0] = pg8::Sub{(const bf16*)args.out, (const bf16*)(F.ws + WS_WIN), 64, NCOLS / 256};
        S.s[1] = pg8::Sub{(const bf16*)(F.ws + WS_MEMB), W8 + (size_t)4 * 2048 * 2048, 8, 8};
        S.s[2] = pg8::Sub{W8 + (size_t)5 * 2048 * 2048, (const bf16*)(F.ws + WS_MEMB), 8, 8};
        gemm_multi<3>(F, S, 2048, OpProjCKV{F.ws});
        w8_transposes(F, W8);
    } SEAM(1);
    if (IN(2)) {
        if (F.G == 256) {
            if (F.bid < 128) { hgrn_chunked(F, F.bid, sec_acc);
                cvt_fp6_stream(F, args.in[24], F.ws + WS_WIN, (size_t)16384, PU_SCALE, F.bid, 128); cvt_fp6_stream(F, args.in[25], F.ws + WS_WIN + 1536, (size_t)16384, PV_SCALE, F.bid, 128); }
            else { ph2_side(F, F.bid - 128, 128); sub_barrier((unsigned*)(F.ws + WS_CTL + CTL_BAR) + 3520, 128u, (F.wave == 0) && (fresh_lane() == 0)); ph5_select(F, F.bid - 128, 128); }
        } else {
            for (int u = F.bid; u < 128; u += F.G) hgrn_chunked(F, u, sec_acc);
            ph2_side(F, F.bid, F.G);
            xcd_barrier(xbar, (F.wave == 0) && (fresh_lane() == 0), (unsigned)F.G);
            ph5_select(F, F.bid, F.G);
            cvt_fp6_stream(F, args.in[24], F.ws + WS_WIN, (size_t)16384, PU_SCALE, F.bid, F.G); cvt_fp6_stream(F, args.in[25], F.ws + WS_WIN + 1536, (size_t)16384, PV_SCALE, F.bid, F.G);
        }
    } SEAM(2);
    if (IN(4)) {
        gemm(F, (const bf16*)(F.ws + WS_CKV), 256, (const bf16*)(F.ws + WS_WKV), 256, T, 4096, 256, OpSplit2{F.slot(1), F.slot(2)});
    } SEAM(4);
    if (IN(6)) { ph6_attn(F); } SEAM(6);
    if (IN(7)) {
        pg8::Gemm g{2048, 4096, 4096}; pg8::MultiOrder<1> S; S.s[0] = pg8::Sub{F.slot(0), W8, 64, 8}; S.lda = 2048; S.ldb = 4096; S.G = F.G; S.c = F.bid; S.A2 = F.slot(3);
        EpiYAB E{F.slot(6), F.slot(7)};
        pg8::gemm_phase<EpiYAB, pg8::MultiOrder<1>, true, true>((PG8_LAS unsigned char*)F.lds, g, S, E, F.wave, F.lane());
    } GSEAM(7);
    if (IN(8)) { gemm_epi(F, F.slot(6), 2048, W8 + (size_t)2 * 2048 * 2048, 2048, T, 2048, 2048, EpiMixStats{args.in[0], F.slot(0), (float*)(F.ws + WS_CTL + CTL_ST1)}); } GSEAM(8);
    if (IN(10)) { gemm(F, F.slot(0), 2048, W8 + (size_t)3 * 2048 * 2048, 2048, T, 2048, 2048, OpCQKV{F.slot(1), nullptr, nullptr, (float*)(F.ws + WS_CTL + CTL_ST1), (float*)(F.ws + WS_CTL + CTL_CVEC), (float*)(F.ws + WS_CTL + CTL_CVEC) + 2048}); } SEAM(10);
    if (IN(11)) {
        pg8::BatchOrder<OffS> S{F.slot(1), (const bf16*)(F.ws + WS_CK), 8, 1, 32, 2048, 2048, F.G, F.bid, OffS()};
        if (F.G == 256) { pg8::Gemm g{2048, 2048, 512}; EpiXSoftmax E{F.slot(3)};
            pg8::gemm_phase<EpiXSoftmax, pg8::BatchOrder<OffS>, false, false, true>((PG8_LAS unsigned char*)F.lds, g, S, E, F.wave, F.lane()); }
        else gemm_batch(F, S, 512, OpLogit{(float*)F.slot(2)});
    } SEAM(11);
    if (IN(12)) { if (F.G != 256) ph_xsoftmax(F, (const float*)F.slot(2), F.slot(3)); } if (F.G != 256) SEAM(12);
    if (IN(13)) {
        pg8::BatchOrder<OffPV> S{F.slot(3), (const bf16*)(F.ws + WS_VT), 8, 2, 32, 1024, 2048, F.G, F.bid, OffPV()};
        gemm_batch(F, S, 256, OpCO{F.slot(4)});
    } SEAM(13);
    if (IN(14)) { gemm_epi(F, F.slot(4), 2048, W8 + (size_t)6 * 2048 * 2048, 2048, T, 2048, 2048, EpiCOStats{F.slot(0), (float*)(F.ws + WS_CTL + CTL_ST1), (float*)(F.ws + WS_CTL + CTL_ST2), args.in[14], args.in[15]}); } GSEAM(14);
    if (IN(16)) { gemm(F, F.slot(0), 2048, W8 + (size_t)7 * 2048 * 2048, 2048, T, 2048, 2048, OpPQFold{(float*)F.slot(1), (float*)(F.ws + WS_CTL + CTL_ST2), (float*)(F.ws + WS_CTL + CTL_CVEC) + 4096, (float*)(F.ws + WS_CTL + CTL_CVEC) + 6144}); } SEAM(16);
    if (IN(17)) { ph_peer_select(F); } SEAM(17);
    if (IN(18)) { ph16_experts(F); }
#if PROBE_MASK
    xcd_barrier(xbar, (F.wave == 0) && (fresh_lane() == 0), (unsigned)F.G);
    { const unsigned long long t1_ = rt_now(); if ((PROBE_MASK >> 18) & 1u) pr_acc += t1_ - pr_t0; pr_acc += sec_acc;
      if (F.bid == 0 && threadIdx.x == 0) { const unsigned long long ts_ = rt_now(); while (rt_now() - ts_ < pr_acc) __builtin_amdgcn_s_sleep(8); } }
#endif
#undef IN
#undef SEAM
}

extern "C" void kernel_launch(void* const* d_in, const int* in_sizes, int n_in, void* d_out, int out_size, void* d_ws, size_t ws_size, hipStream_t stream) {
    static int grid = 0;
    if (grid == 0) {
        if (n_in != 28 || out_size != T * D || ws_size < WS_END) { fprintf(stderr, "kernel_launch: unexpected shapes (n_in %d out %d ws %zu)\n", n_in, out_size, ws_size); grid = -1; return; }
        int dev = 0, cus = 0, per_cu = 0;
        hipGetDevice(&dev); hipDeviceGetAttribute(&cus, hipDeviceAttributeMultiprocessorCount, dev);
        hipFuncSetAttribute((const void*)mega, hipFuncAttributeMaxDynamicSharedMemorySize, LDS_BYTES);
        hipOccupancyMaxActiveBlocksPerMultiprocessor(&per_cu, (const void*)mega, 512, LDS_BYTES);
        if (per_cu < 1) { fprintf(stderr, "kernel_launch: occupancy query says %d blocks per CU\n", per_cu); per_cu = 1; }
        (void)hipGetLastError();
        grid = cus;
    }
    if (grid < 0) return;
    (void)hipMemsetAsync((char*)d_ws + WS_CTL, 0, CTL_ZERO, stream);
    Args a{};
    for (int i = 0; i < 28; ++i) a.in[i] = (const float*)d_in[i];
    a.out = (float*)d_out; a.ws = (unsigned char*)d_ws;
#if ONE_LAUNCH
    a.ph_lo = 0; a.ph_hi = NPH;
    void* params[] = {&a};
    hipError_t e = hipLaunchCooperativeKernel((const void*)mega, dim3(grid), dim3(512), params, LDS_BYTES, stream);
    if (e != hipSuccess) fprintf(stderr, "cooperative launch failed: %s\n", hipGetErrorString(e));
#else
    for (int ph = 0; ph < NPH; ++ph) {
        a.ph_lo = ph; a.ph_hi = ph + 1;
        void* params[] = {&a};
        hipError_t e = hipLaunchCooperativeKernel((const void*)mega, dim3(grid), dim3(512), params, LDS_BYTES, stream);
        if (e != hipSuccess) { fprintf(stderr, "launch %d failed: %s\n", ph, hipGetErrorString(e)); break; }
    }
#endif
}
```

```cpp
#include <hip/hip_runtime.h>
#include <hip/hip_cooperative_groups.h>
#include <cstdint>
#include <cmath>
#include <cstdio>
namespace cg = cooperative_groups;

#ifndef ONE_LAUNCH
#define ONE_LAUNCH 1
#endif
#ifndef PROBE_MASK
#define PROBE_MASK 0u
#endif
#ifndef PROBE_SEC
#define PROBE_SEC 0
#endif

typedef unsigned short bf16;
typedef short bf16x8 __attribute__((ext_vector_type(8)));
typedef float f32x4 __attribute__((ext_vector_type(4)));
typedef float f32x16 __attribute__((ext_vector_type(16)));
typedef unsigned u32x4 __attribute__((ext_vector_type(4)));
typedef unsigned u32x2 __attribute__((ext_vector_type(2)));
typedef float f32x2v __attribute__((ext_vector_type(2)));

constexpr int T = 16384, D = 2048, SEQ = 2048, NB = 8;
constexpr int NCOLS = 16896;
constexpr float ALPHA = 1.189207115002721f;
constexpr int NPH = 19;

constexpr size_t MiB = 1u << 20;
constexpr size_t WS_CTL = 0, WS_MEMB = 1 * MiB, WS_WKV = 9 * MiB, WS_LB = 11 * MiB, WS_MASK = 12 * MiB, WS_WIN = 17 * MiB,
                 WS_SLOT = 83 * MiB, SLOT_BYTES = 64 * MiB, WS_CKV = 595 * MiB, WS_IKW = 603 * MiB, WS_CK = 611 * MiB, WS_VT = 619 * MiB, WS_END = 627 * MiB;
constexpr int LDS_BYTES = 157696;
constexpr size_t CTL_BAR = 16384, CTL_CVEC = 65536, CTL_ST1 = 262144, CTL_ST2 = 393216, CTL_ZERO = 524288;

struct Args {
    const float* in[28];
    float* out;
    unsigned char* ws;
    int ph_lo, ph_hi;
};

#define WAVE_SYNC() asm volatile("s_waitcnt lgkmcnt(0)" ::: "memory")

__device__ __forceinline__ unsigned f2bf(float f) { unsigned u = __float_as_uint(f); return (u + 0x7fffu + ((u >> 16) & 1u)) >> 16; }
__device__ __forceinline__ unsigned pk2(float lo, float hi) { return f2bf(lo) | (f2bf(hi) << 16); }
__device__ __forceinline__ float bf2f(unsigned h) { return __uint_as_float(h << 16); }
__device__ __forceinline__ float bflo(unsigned w) { return __uint_as_float(w << 16); }
__device__ __forceinline__ float bfhi(unsigned w) { return __uint_as_float(w & 0xffff0000u); }
__device__ __forceinline__ float wave_sum(float v) {
#pragma unroll
    for (int o = 32; o >= 1; o >>= 1) v += __shfl_xor(v, o);
    return v;
}
__device__ __forceinline__ float wave_max(float v) {
#pragma unroll
    for (int o = 32; o >= 1; o >>= 1) v = fmaxf(v, __shfl_xor(v, o));
    return v;
}
__device__ __forceinline__ float row16_sum(float v) {
    v += __int_as_float(__builtin_amdgcn_mov_dpp(__float_as_int(v), 0xB1, 0xF, 0xF, false));
    v += __int_as_float(__builtin_amdgcn_mov_dpp(__float_as_int(v), 0x4E, 0xF, 0xF, false));
    v += __int_as_float(__builtin_amdgcn_mov_dpp(__float_as_int(v), 0x124, 0xF, 0xF, false));
    v += __int_as_float(__builtin_amdgcn_mov_dpp(__float_as_int(v), 0x128, 0xF, 0xF, false));
    return v;
}
__device__ __forceinline__ float wave_sum_dpp(float v) {
    v = row16_sum(v);
    return (__int_as_float(__builtin_amdgcn_readlane(__float_as_int(v), 0)) + __int_as_float(__builtin_amdgcn_readlane(__float_as_int(v), 16)))
         + (__int_as_float(__builtin_amdgcn_readlane(__float_as_int(v), 32)) + __int_as_float(__builtin_amdgcn_readlane(__float_as_int(v), 48)));
}
__device__ __forceinline__ float sigm(float x) { return 1.0f / (1.0f + expf(-x)); }
__device__ __forceinline__ void unpack8(u32x4 w, float* f) {
    f[0] = bflo(w.x); f[1] = bfhi(w.x); f[2] = bflo(w.y); f[3] = bfhi(w.y); f[4] = bflo(w.z); f[5] = bfhi(w.z); f[6] = bflo(w.w); f[7] = bfhi(w.w);
}

__device__ __forceinline__ int fresh_lane() { int l; asm volatile("v_mbcnt_lo_u32_b32 %0, -1, 0\n\tv_mbcnt_hi_u32_b32 %0, -1, %0" : "=v"(l)); return l; }
__device__ __forceinline__ unsigned long long rt_now() { unsigned long long t; asm volatile("s_memrealtime %0\n\ts_waitcnt lgkmcnt(0)" : "=s"(t) :: "memory"); return t; }
struct Frame {
    unsigned char* lds;
    int wave, bid, G;
    __device__ __forceinline__ int lane() const { return fresh_lane(); }
    const Args* a;
    unsigned char* ws;
    __device__ __forceinline__ bf16* slot(int i) const { return (bf16*)(ws + WS_SLOT + (size_t)i * SLOT_BYTES); }
};

namespace pg8 {
#define PG8_LAS __attribute__((address_space(3)))
constexpr int BM = 256, BK = 64, HALF = 128, HTB = HALF * BK * 2, STAGE_BYTES = 8 * HTB, NXCD = 8, WGM = 8;
__host__ __device__ __forceinline__ int lds_byte(int r, int c) { const int st = (r >> 4) * 2 + (c >> 5), rr = r & 15, cc = c & 31, ob = rr * 64 + cc * 2; return st * 1024 + (ob ^ (((ob >> 9) & 1) << 5)); }
__host__ __device__ __forceinline__ void stage_rc(int b, int& R, int& C) { const int st = b / 1024, sb = b % 1024, swz = sb ^ (((sb >> 9) & 1) << 5); R = (st >> 1) * 16 + swz / 64; C = (st & 1) * 32 + (swz % 64) / 2; }
__host__ __device__ __forceinline__ int perm32(int rho) { const int n = rho >> 4, i = rho & 15; return 8 * (i >> 2) + 4 * n + (i & 3); }
struct Unit { int pm, pn, z; const char* a; const char* b; const char* a2; };
struct Gemm { int lda, ldb, K; };
__device__ __forceinline__ void tile_of(int wgid, int nM, int nN, int& pm, int& pn) {
    const int nwg = nM * nN; { const int q = nwg / NXCD, r = nwg % NXCD, xcd = wgid % NXCD, off = wgid / NXCD; wgid = (xcd < r ? xcd * (q + 1) : r * (q + 1) + (xcd - r) * q) + off; }
    const int nig = WGM * nN, gid = wgid / nig, fm = gid * WGM, gsz = (nM - fm) < WGM ? (nM - fm) : WGM;
    pm = fm + ((wgid % nig) % gsz); pn = (wgid % nig) / gsz;
}
struct Sub { const bf16* A; const bf16* Bt; int nM, nN; };
template <int NS> struct MultiOrder {
    Sub s[NS]; int lda, ldb, G, c; const bf16* A2 = nullptr;
    __device__ __forceinline__ bool next(int i, Unit& u) const {
        int L = i * G + c;
#pragma unroll
        for (int k = 0; k < NS; ++k) { const int n = s[k].nM * s[k].nN;
            if (L < n) { tile_of(L, s[k].nM, s[k].nN, u.pm, u.pn); u.z = k; u.a = (const char*)(s[k].A + (size_t)u.pm * BM * lda); u.b = (const char*)(s[k].Bt + (size_t)u.pn * BM * ldb); u.a2 = A2 ? (const char*)(A2 + (size_t)u.pm * BM * lda) : nullptr; return true; }
            L -= n; }
        return false;
    }
};
template <class Off> struct GroupBatchOrder {
    const bf16* A; const bf16* Bt; int nN, lda, ldb, c; Off off;
    __device__ __forceinline__ bool next(int i, Unit& u) const {
        if (i >= nN) return false;
        const int b = c & 7, j = (c >> 3) + 32 * i; u.z = b * 4 + ((j >> 3) & 3); u.pm = j & 7; u.pn = j >> 5;
        u.a = (const char*)(A + off.a(u.z) + (size_t)u.pm * BM * lda); u.b = (const char*)(Bt + off.b(u.z) + (size_t)u.pn * BM * ldb); u.a2 = nullptr; return true;
    }
};
template <class Off> struct BatchOrder {
    const bf16* A; const bf16* Bt; int nM, nN, nz, lda, ldb, G, c; Off off;
    __device__ __forceinline__ bool next(int i, Unit& u) const {
        const int L = i * G + c, per = nM * nN; if (L >= per * nz) return false;
        u.z = L / per; const int r = L % per; u.pn = r / nM; u.pm = r % nM;
        u.a = (const char*)(A + off.a(u.z) + (size_t)u.pm * BM * lda); u.b = (const char*)(Bt + off.b(u.z) + (size_t)u.pn * BM * ldb); u.a2 = nullptr; return true;
    }
};
__device__ __forceinline__ unsigned cvt_pk_bf16(float lo, float hi) { unsigned r; asm volatile("v_cvt_pk_bf16_f32 %0, %1, %2" : "=v"(r) : "v"(lo), "v"(hi)); return r; }

template <class Op> struct Epi8 {
    static constexpr bool PERM = true;
    Op op;
    __device__ __forceinline__ void operator()(const f32x4 (&acc)[2][2][4][2], const Unit& u, int wr, int wc, int fr, int fq) const {
        const int row0 = u.pm * BM + wr * 64 + fr, col0 = u.pn * BM + wc * 32 + 8 * fq;
        if constexpr (Op::NLD == 0) {
#pragma unroll
            for (int ai = 0; ai < 2; ++ai)
#pragma unroll
                for (int m = 0; m < 4; ++m)
#pragma unroll
                    for (int bj = 0; bj < 2; ++bj) op(u.z, row0 + ai * HALF + m * 16, col0 + bj * HALF, acc[ai][bj][m][0], acc[ai][bj][m][1]);
        } else {
#pragma unroll
            for (int ai = 0; ai < 2; ++ai) {
                u32x4 tmp[4][2][Op::NLD];
#pragma unroll
                for (int m = 0; m < 4; ++m)
#pragma unroll
                    for (int bj = 0; bj < 2; ++bj) op.ld(u.z, row0 + ai * HALF + m * 16, col0 + bj * HALF, tmp[m][bj]);
#pragma unroll
                for (int m = 0; m < 4; ++m)
#pragma unroll
                    for (int bj = 0; bj < 2; ++bj) op.ap(u.z, row0 + ai * HALF + m * 16, col0 + bj * HALF, acc[ai][bj][m][0], acc[ai][bj][m][1], tmp[m][bj]);
            }
        }
    }
};

typedef int v8i32 __attribute__((ext_vector_type(8)));
typedef int v4i32 __attribute__((ext_vector_type(4)));
template <class Epi, class Sched, bool ALIGN_EPI, bool SPLIT = false, bool AFTER_DRAIN = false, bool FP8 = false>
__device__ __forceinline__ void gemm_phase(PG8_LAS unsigned char* lds, const Gemm g, const Sched& S, const Epi& E, int wid, int lane) {
    const int tid = wid * 64 + lane, wr = wid >> 2, wc = wid & 3, fr = lane & 15, fq = lane >> 4;
    const int K = g.K, nt = K / BK;
    unsigned voffA, voffB;
    { int R, C; stage_rc(tid * 16, R, C); const int Rb = Epi::PERM ? ((R & ~31) + perm32(R & 31)) : R;
      voffA = (unsigned)(R * g.lda + C) * 2u; voffB = (unsigned)(Rb * g.ldb + C) * 2u; }
    const size_t rstepvoffA = (size_t)64 * g.lda * 2, rstepvoffB = (size_t)64 * g.ldb * 2; const unsigned voffAV = voffA, voffBV = voffB;
    const size_t kstep = (size_t)(BK * 2);
    const size_t hstepA = (size_t)HALF * g.lda * 2, hstepB = (size_t)HALF * g.ldb * 2;
    const unsigned ldsw = (unsigned)wid * 1024u;
    const int aoff = lds_byte(wr * 64 + fr, fq * 8), boff = lds_byte(wc * 32 + fr, fq * 8);
    PG8_LAS unsigned char* ldsA = lds + aoff; PG8_LAS unsigned char* ldsB = lds + 65536 + boff;
    if constexpr (FP8) { asm volatile("" : "+v"(ldsA)); asm volatile("" : "+v"(ldsB)); }
#define PG8_SA(b, h) (((b) * 2 + (h)) * HTB)
#define PG8_SB(b, h) ((4 + (b) * 2 + (h)) * HTB)
#define PG8_STAGE(bufoff, gbase, voff) do { _Pragma("unroll") for (int _i = 0; _i < 2; ++_i) \
        __builtin_amdgcn_global_load_lds((const unsigned*)((const char*)(gbase) + _i * (rstep##voff) + (voff##V)), (PG8_LAS unsigned*)(lds + (bufoff) + ldsw + _i * 8192), 16, 0, 0); } while (0)
#define PG8_LDA(dst, b, h) do { _Pragma("unroll") for (int m = 0; m < 4; ++m) _Pragma("unroll") for (int k = 0; k < 2; ++k) dst[m][k] = *(const PG8_LAS bf16x8*)(ldsA + PG8_SA(b, h) + m * 2048 + k * 1024); } while (0)
#define PG8_LDB(dst, b, h) do { _Pragma("unroll") for (int n = 0; n < 2; ++n) _Pragma("unroll") for (int k = 0; k < 2; ++k) dst[n][k] = *(const PG8_LAS bf16x8*)(ldsB + (PG8_SB(b, h) - 65536) + n * 2048 + k * 1024); } while (0)
#define PG8_MMA(ai, bj, At, Bt) do { __builtin_amdgcn_s_setprio(1); _Pragma("unroll") for (int m = 0; m < 4; ++m) _Pragma("unroll") for (int n = 0; n < 2; ++n) { \
        if constexpr (FP8) { const v4i32 b0_ = __builtin_bit_cast(v4i32, Bt[n][0]), b1_ = __builtin_bit_cast(v4i32, Bt[n][1]), a0_ = __builtin_bit_cast(v4i32, At[m][0]), a1_ = __builtin_bit_cast(v4i32, At[m][1]); \
            const v8i32 s0_ = (v8i32){b0_.x, b0_.y, b0_.z, b0_.w, b1_.x, b1_.y, b1_.z, b1_.w}, s1_ = (v8i32){a0_.x, a0_.y, a0_.z, a0_.w, a1_.x, a1_.y, a1_.z, a1_.w}; \
            asm volatile("v_mfma_f32_16x16x128_f8f6f4 %0, %1, %2, %0" : "+v"(acc[ai][bj][m][n]) : "v"(s0_), "v"(s1_)); } \
        else { _Pragma("unroll") for (int k = 0; k < 2; ++k) acc[ai][bj][m][n] = __builtin_amdgcn_mfma_f32_16x16x32_bf16(Bt[n][k], At[m][k], acc[ai][bj][m][n], 0, 0, 0); } } __builtin_amdgcn_s_setprio(0); } while (0)
#define PG8_WAIT_V(n) asm volatile("s_waitcnt vmcnt(" #n ")" ::: "memory")
#define PG8_WAIT_L(n) asm volatile("s_waitcnt lgkmcnt(" #n ")" ::: "memory")
#define PG8_BAR __builtin_amdgcn_s_barrier()
#define PG8_SCHED __builtin_amdgcn_sched_barrier(0)
    Unit cur, nxt; int ui = 0;
    if (!S.next(0, cur)) return;
    f32x4 acc[2][2][4][2];
#pragma unroll
    for (int a = 0; a < 2; ++a)
#pragma unroll
        for (int b = 0; b < 2; ++b)
#pragma unroll
            for (int m = 0; m < 4; ++m)
#pragma unroll
                for (int n = 0; n < 2; ++n) acc[a][b][m][n] = (f32x4){0.f, 0.f, 0.f, 0.f};
    bf16x8 At[4][2], B0[2][2], B1[2][2];
    const char* cA = cur.a; const char* cB = cur.b;
    const int nth = nt / 2;
    const char* cA2 = SPLIT ? cur.a2 - (size_t)nth * kstep : cA;
    PG8_STAGE(PG8_SB(0, 0), cB, voffB); PG8_STAGE(PG8_SB(0, 1), cB + hstepB, voffB); PG8_STAGE(PG8_SA(0, 0), cA, voffA); PG8_STAGE(PG8_SA(0, 1), cA + hstepA, voffA);
    if (wr == 1) PG8_BAR;
    PG8_WAIT_V(2); PG8_BAR;
    PG8_STAGE(PG8_SB(1, 0), cB + kstep, voffB); PG8_STAGE(PG8_SA(1, 0), cA + kstep, voffA); PG8_STAGE(PG8_SB(1, 1), cB + hstepB + kstep, voffB);
    PG8_WAIT_V(6); PG8_BAR;
    for (;;) {
        const bool has_next = S.next(ui + 1, nxt);
        const char* nA = has_next ? nxt.a : cA; const char* nB = has_next ? nxt.b : cB;
        const char* nA2 = SPLIT ? (has_next ? nxt.a2 - (size_t)nth * kstep : cA2) : nA;
#pragma unroll 1
        for (int half_ = 0; half_ < (SPLIT ? 2 : 1); ++half_) {
        if constexpr (SPLIT) { if (half_ == 1) { __builtin_amdgcn_sched_barrier(0); E.mid(acc, cur, wr, wc, fr, fq); __builtin_amdgcn_sched_barrier(0); } }
        const int t_lo = SPLIT ? half_ * nth : 0, t_hi = SPLIT ? (half_ + 1) * nth : nt;
#pragma unroll 1
        for (int t = t_lo; t < t_hi; t += 2) {
            const bool last = (t == nt - 2);
            const char* bA1 = (!SPLIT || t < nth) ? cA : cA2; const char* bA2 = (!SPLIT || t + 2 < nth) ? cA : cA2;
            const char* a1 = bA1 + (size_t)(t + 1) * kstep;
            const char* a2 = last ? nA : bA2 + (size_t)(t + 2) * kstep; const char* b2 = last ? nB : cB + (size_t)(t + 2) * kstep;
            const char* a3 = a2 + kstep; const char* b3 = b2 + kstep;
            PG8_LDB(B0, 0, 0); PG8_LDB(B1, 0, 1); PG8_SCHED; PG8_LDA(At, 0, 0); PG8_STAGE(PG8_SA(1, 1), a1 + hstepA, voffA);
            PG8_WAIT_V(8); PG8_WAIT_L(0); PG8_BAR; PG8_MMA(0, 0, At, B0); PG8_MMA(0, 1, At, B1); PG8_BAR; PG8_SCHED;
            PG8_LDA(At, 0, 1); PG8_STAGE(PG8_SB(0, 0), b2, voffB); PG8_STAGE(PG8_SB(0, 1), b2 + hstepB, voffB); PG8_STAGE(PG8_SA(0, 0), a2, voffA);
            PG8_WAIT_V(8); PG8_WAIT_L(0); PG8_BAR; PG8_MMA(1, 0, At, B0); PG8_MMA(1, 1, At, B1); PG8_BAR; PG8_SCHED;
            PG8_LDB(B0, 1, 0); PG8_LDB(B1, 1, 1); PG8_SCHED; PG8_LDA(At, 1, 0); PG8_STAGE(PG8_SA(0, 1), a2 + hstepA, voffA);
            PG8_WAIT_V(8); PG8_WAIT_L(0); PG8_BAR; PG8_MMA(0, 0, At, B0); PG8_MMA(0, 1, At, B1); PG8_BAR; PG8_SCHED;
            PG8_LDA(At, 1, 1); PG8_STAGE(PG8_SB(1, 0), b3, voffB); PG8_STAGE(PG8_SB(1, 1), b3 + hstepB, voffB); PG8_STAGE(PG8_SA(1, 0), a3, voffA);
            PG8_WAIT_V(8); PG8_WAIT_L(0); PG8_BAR; PG8_MMA(1, 0, At, B0); PG8_MMA(1, 1, At, B1); PG8_BAR; PG8_SCHED;
        }
        }
        if constexpr (ALIGN_EPI) { if (wr == 0) PG8_BAR; }
        if constexpr (FP8) asm volatile("s_nop 15\n\ts_nop 15" ::: "memory");
        if constexpr (!AFTER_DRAIN) { const int le_ = FP8 ? fresh_lane() : lane; E(acc, cur, wr, wc, le_ & 15, le_ >> 4); }
        if (!has_next) break;
#pragma unroll
        for (int a = 0; a < 2; ++a)
#pragma unroll
            for (int b = 0; b < 2; ++b)
#pragma unroll
                for (int m = 0; m < 4; ++m)
#pragma unroll
                    for (int n = 0; n < 2; ++n) acc[a][b][m][n] = (f32x4){0.f, 0.f, 0.f, 0.f};
        cur = nxt; cA = nA; cB = nB; cA2 = nA2; ++ui;
        if constexpr (ALIGN_EPI) { if (wr == 1) PG8_BAR; }
    }
    PG8_WAIT_V(0);
    if constexpr (!ALIGN_EPI) { if (wr == 0) PG8_BAR; }
    PG8_BAR;
    if constexpr (AFTER_DRAIN) E.fused(acc, cur, wr, wc, fr, fq, (unsigned char*)lds);
#undef PG8_SA
#undef PG8_SB
#undef PG8_STAGE
#undef PG8_LDA
#undef PG8_LDB
#undef PG8_MMA
#undef PG8_WAIT_V
#undef PG8_WAIT_L
#undef PG8_BAR
#undef PG8_SCHED
}
}

__device__ __forceinline__ u32x4 pack8(f32x4 a, f32x4 b) { u32x4 w; w.x = pg8::cvt_pk_bf16(a.x, a.y); w.y = pg8::cvt_pk_bf16(a.z, a.w); w.z = pg8::cvt_pk_bf16(b.x, b.y); w.w = pg8::cvt_pk_bf16(b.z, b.w); return w; }
__device__ __forceinline__ u32x2 pack8_fp8(f32x4 a, f32x4 b, float s) { int p = __builtin_amdgcn_cvt_pk_fp8_f32(a.x * s, a.y * s, 0, false); p = __builtin_amdgcn_cvt_pk_fp8_f32(a.z * s, a.w * s, p, true);
    int q = __builtin_amdgcn_cvt_pk_fp8_f32(b.x * s, b.y * s, 0, false); q = __builtin_amdgcn_cvt_pk_fp8_f32(b.z * s, b.w * s, q, true); return (u32x2){(unsigned)p, (unsigned)q}; }
__device__ __forceinline__ void unpack8_fp8(u32x2 w, f32x4& a, f32x4& b) { const f32x2v p0 = __builtin_amdgcn_cvt_pk_f32_fp8((int)w.x, false), p1 = __builtin_amdgcn_cvt_pk_f32_fp8((int)w.x, true),
        p2 = __builtin_amdgcn_cvt_pk_f32_fp8((int)w.y, false), p3 = __builtin_amdgcn_cvt_pk_f32_fp8((int)w.y, true); a = (f32x4){p0.x, p0.y, p1.x, p1.y}; b = (f32x4){p2.x, p2.y, p3.x, p3.y}; }
__device__ __forceinline__ void unpack8v(u32x4 w, f32x4& a, f32x4& b) { a.x = bflo(w.x); a.y = bfhi(w.x); a.z = bflo(w.y); a.w = bfhi(w.y); b.x = bflo(w.z); b.y = bfhi(w.z); b.z = bflo(w.w); b.w = bfhi(w.w); }
__device__ __forceinline__ f32x4 sigm4(f32x4 v) { f32x4 r; r.x = sigm(v.x); r.y = sigm(v.y); r.z = sigm(v.z); r.w = sigm(v.w); return r; }

constexpr size_t WS_HO8 = WS_WIN + 33 * MiB;
constexpr float Q8_X = 16.0f, Q8_W = 1024.0f, Q8_OUT = 1.0f / (Q8_X * Q8_W), Q8_G = 256.0f;
__device__ __forceinline__ float gate1(float x) { return fmaxf(__builtin_amdgcn_rcpf(1.0f + __expf(-x)), 2e-5f); }
__device__ __forceinline__ f32x4 gate4(f32x4 v) { f32x4 r; r.x = gate1(v.x); r.y = gate1(v.y); r.z = gate1(v.z); r.w = gate1(v.w); return r; }
struct OpProj { static constexpr int NLD = 0; unsigned char* ws;
    __device__ __forceinline__ void operator()(int z, int row, int col, f32x4 a, f32x4 b) const {
        bf16* p;
        if (col < 16384) p = (bf16*)(ws + WS_SLOT + (size_t)(col >> 11) * SLOT_BYTES) + (size_t)row * 2048 + (col & 2047);
        else if (col < 16640) p = (bf16*)(ws + WS_CKV) + (size_t)row * 256 + (col - 16384);
        else p = (bf16*)(ws + WS_IKW) + (size_t)row * 256 + (col - 16640);
        *(u32x4*)p = pack8(a, b);
    } };
struct OpProjCKV { static constexpr int NLD = 0; unsigned char* ws;
    __device__ __forceinline__ void operator()(int z, int row, int col, f32x4 a, f32x4 b) const {
        bf16* p;
        if (z == 0 && col >= 12288 && col < 16384) {
            *(u32x2*)(ws + WS_SLOT + (size_t)(col >> 11) * SLOT_BYTES + (size_t)row * 2048 + (col & 2047)) = pack8_fp8(gate4(a * Q8_OUT), gate4(b * Q8_OUT), Q8_G); return; }
        if (z == 0) { if (col < 16384) p = (bf16*)(ws + WS_SLOT + (size_t)(col >> 11) * SLOT_BYTES) + (size_t)row * 2048 + (col & 2047);
                      else if (col < 16640) p = (bf16*)(ws + WS_CKV) + (size_t)row * 256 + (col - 16384);
                      else p = (bf16*)(ws + WS_IKW) + (size_t)row * 256 + (col - 16640); }
        else p = (bf16*)(ws + (z == 1 ? WS_CK : WS_VT)) + (size_t)row * 2048 + col;
        *(u32x4*)p = pack8(a * Q8_OUT, b * Q8_OUT);
    } };
struct OpBf16 { static constexpr int NLD = 0; bf16* o; int ld;
    __device__ __forceinline__ void operator()(int z, int row, int col, f32x4 a, f32x4 b) const { *(u32x4*)(o + (size_t)row * ld + col) = pack8(a, b); } };
struct OpSplit2 { static constexpr int NLD = 0; bf16* o0; bf16* o1;
    __device__ __forceinline__ void operator()(int z, int row, int col, f32x4 a, f32x4 b) const { bf16* p = (col < 2048 ? o0 : o1) + (size_t)row * 2048 + (col & 2047); *(u32x4*)p = pack8(a, b); } };
struct OpF32 { static constexpr int NLD = 0; float* o; int ld;
    __device__ __forceinline__ void operator()(int z, int row, int col, f32x4 a, f32x4 b) const { float* p = o + (size_t)row * ld + col; *(f32x4*)p = a; *(f32x4*)(p + 4) = b; } };
struct OpYA { static constexpr int NLD = 1; bf16* ga;
    __device__ __forceinline__ void ld(int zi, int row, int col, u32x4* t) const { t[0] = *(const u32x4*)(ga + (size_t)row * 2048 + col); }
    __device__ __forceinline__ void ap(int zi, int row, int col, f32x4 a, f32x4 b, const u32x4* t) const { f32x4 g0, g1; unpack8v(t[0], g0, g1); *(u32x4*)(ga + (size_t)row * 2048 + col) = pack8(sigm4(g0) * a, sigm4(g1) * b); } };
struct OpYB { static constexpr int NLD = 2; bf16* ga; const bf16* gb;
    __device__ __forceinline__ void ld(int zi, int row, int col, u32x4* t) const { const size_t i = (size_t)row * 2048 + col; t[0] = *(const u32x4*)(ga + i); t[1] = *(const u32x4*)(gb + i); }
    __device__ __forceinline__ void ap(int zi, int row, int col, f32x4 a, f32x4 b, const u32x4* t) const { f32x4 m0, m1, g0, g1; unpack8v(t[0], m0, m1); unpack8v(t[1], g0, g1);
        *(u32x4*)(ga + (size_t)row * 2048 + col) = pack8(m0 + sigm4(g0) * a, m1 + sigm4(g1) * b); } };
struct OpMix { static constexpr int NLD = 2; const float* x; float* zo;
    __device__ __forceinline__ void ld(int zi, int row, int col, u32x4* t) const { const size_t i = (size_t)row * 2048 + col; t[0] = *(const u32x4*)(x + i); t[1] = *(const u32x4*)(x + i + 4); }
    __device__ __forceinline__ void ap(int zi, int row, int col, f32x4 a, f32x4 b, const u32x4* t) const { const size_t i = (size_t)row * 2048 + col;
        *(f32x4*)(zo + i) = ALPHA * __builtin_bit_cast(f32x4, t[0]) + a; *(f32x4*)(zo + i + 4) = ALPHA * __builtin_bit_cast(f32x4, t[1]) + b; } };
struct OpRes { static constexpr int NLD = 2; float* zo;
    __device__ __forceinline__ void ld(int zi, int row, int col, u32x4* t) const { const size_t i = (size_t)row * 2048 + col; t[0] = *(const u32x4*)(zo + i); t[1] = *(const u32x4*)(zo + i + 4); }
    __device__ __forceinline__ void ap(int zi, int row, int col, f32x4 a, f32x4 b, const u32x4* t) const { const size_t i = (size_t)row * 2048 + col;
        *(f32x4*)(zo + i) = ALPHA * __builtin_bit_cast(f32x4, t[0]) + a; *(f32x4*)(zo + i + 4) = ALPHA * __builtin_bit_cast(f32x4, t[1]) + b; } };

__device__ __forceinline__ void row_stats_add(float* st, int row, float s1, float s2, int fq) {
    s1 += __shfl_xor(s1, 16); s1 += __shfl_xor(s1, 32); s2 += __shfl_xor(s2, 16); s2 += __shfl_xor(s2, 32);
    if (fq == 0) { atomicAdd(st + 2 * (size_t)row, s1); atomicAdd(st + 2 * (size_t)row + 1, s2); }
}
__device__ __forceinline__ void row_mu_rstd(const float* st, int row, float& mu, float& rstd) {
    const f32x2v p = *(const f32x2v*)(st + 2 * (size_t)row); mu = p.x * (1.0f / 2048.0f); rstd = rsqrtf(fmaxf(p.y * (1.0f / 2048.0f) - mu * mu, 0.f) + 1e-5f);
}
__device__ __forceinline__ float sum8(f32x4 a, f32x4 b) { return ((a.x + a.y) + (a.z + a.w)) + ((b.x + b.y) + (b.z + b.w)); }
__device__ __forceinline__ float sq8(f32x4 a, f32x4 b) { return ((a.x * a.x + a.y * a.y) + (a.z * a.z + a.w * a.w)) + ((b.x * b.x + b.y * b.y) + (b.z * b.z + b.w * b.w)); }
struct EpiMixStats { static constexpr bool PERM = true; const float* x; bf16* zb; float* st; unsigned char* zq;
    __device__ __forceinline__ void operator()(const f32x4 (&acc)[2][2][4][2], const pg8::Unit& u, int wr, int wc, int fr, int fq) const {
        const int row0 = u.pm * 256 + wr * 64 + fr, col0 = u.pn * 256 + wc * 32 + 8 * fq;
#pragma unroll
        for (int ai = 0; ai < 2; ++ai) {
            f32x4 xv[4][2][2];
#pragma unroll
            for (int m = 0; m < 4; ++m)
#pragma unroll
                for (int bj = 0; bj < 2; ++bj) { const float* p = x + (size_t)(row0 + ai * 128 + m * 16) * 2048 + col0 + bj * 128; xv[m][bj][0] = *(const f32x4*)p; xv[m][bj][1] = *(const f32x4*)(p + 4); }
#pragma unroll
            for (int m = 0; m < 4; ++m) { const int row = row0 + ai * 128 + m * 16; float s1 = 0.f, s2 = 0.f;
#pragma unroll
                for (int bj = 0; bj < 2; ++bj) { const f32x4 z0 = ALPHA * xv[m][bj][0] + acc[ai][bj][m][0] * Q8_OUT, z1 = ALPHA * xv[m][bj][1] + acc[ai][bj][m][1] * Q8_OUT;
                    *(u32x4*)(zb + (size_t)row * 2048 + col0 + bj * 128) = pack8(z0, z1); *(u32x2*)(zq + (size_t)row * 2048 + col0 + bj * 128) = pack8_fp8(z0, z1, Q8_X); s1 += sum8(z0, z1); s2 += sq8(z0, z1); }
                row_stats_add(st, row, s1, s2, fq); }
        }
    }
};
struct EpiCOStats { static constexpr bool PERM = true; bf16* zb; const float* st1; float* st2; const float* g; const float* bta;
    __device__ __forceinline__ void operator()(const f32x4 (&acc)[2][2][4][2], const pg8::Unit& u, int wr, int wc, int fr, int fq) const {
        const int row0 = u.pm * 256 + wr * 64 + fr, col0 = u.pn * 256 + wc * 32 + 8 * fq;
        f32x4 gv[2][2], bv[2][2];
#pragma unroll
        for (int bj = 0; bj < 2; ++bj) { gv[bj][0] = *(const f32x4*)(g + col0 + bj * 128); gv[bj][1] = *(const f32x4*)(g + col0 + bj * 128 + 4); bv[bj][0] = *(const f32x4*)(bta + col0 + bj * 128); bv[bj][1] = *(const f32x4*)(bta + col0 + bj * 128 + 4); }
#pragma unroll
        for (int ai = 0; ai < 2; ++ai) {
            u32x4 zv[4][2]; float mu[4], rs[4];
#pragma unroll
            for (int m = 0; m < 4; ++m) { const int row = row0 + ai * 128 + m * 16; row_mu_rstd(st1, row, mu[m], rs[m]);
#pragma unroll
                for (int bj = 0; bj < 2; ++bj) zv[m][bj] = *(const u32x4*)(zb + (size_t)row * 2048 + col0 + bj * 128); }
#pragma unroll
            for (int m = 0; m < 4; ++m) { const int row = row0 + ai * 128 + m * 16; float s1 = 0.f, s2 = 0.f;
#pragma unroll
                for (int bj = 0; bj < 2; ++bj) { f32x4 a0, a1; unpack8v(zv[m][bj], a0, a1);
                    const f32x4 z0 = ALPHA * ((a0 - mu[m]) * rs[m] * gv[bj][0] + bv[bj][0]) + acc[ai][bj][m][0] * Q8_OUT, z1 = ALPHA * ((a1 - mu[m]) * rs[m] * gv[bj][1] + bv[bj][1]) + acc[ai][bj][m][1] * Q8_OUT;
                    *(u32x4*)(zb + (size_t)row * 2048 + col0 + bj * 128) = pack8(z0, z1); s1 += sum8(z0, z1); s2 += sq8(z0, z1); }
                row_stats_add(st2, row, s1, s2, fq); }
        }
    }
};
struct EpiYAB { static constexpr bool PERM = true; const unsigned char* ga; const unsigned char* gb; unsigned char* mx;
    __device__ __forceinline__ void mid(f32x4 (&acc)[2][2][4][2], const pg8::Unit& u, int wr, int wc, int fr, int fq) const {
        int lofs = (wr * 64 + fr) * 2048 + wc * 32 + 8 * fq; asm volatile("" : "+v"(lofs));
        const size_t ub = ((size_t)u.pm * 256) * 2048 + u.pn * 256;
#pragma unroll
        for (int ai = 0; ai < 2; ++ai) { u32x2 av[4][2], bv[4][2];
#pragma unroll
            for (int m = 0; m < 4; ++m)
#pragma unroll
                for (int bj = 0; bj < 2; ++bj) { const size_t i = ub + (size_t)(lofs + (ai * 128 + m * 16) * 2048 + bj * 128); av[m][bj] = *(const u32x2*)(ga + i); bv[m][bj] = *(const u32x2*)(gb + i); }
#pragma unroll
            for (int m = 0; m < 4; ++m)
#pragma unroll
                for (int bj = 0; bj < 2; ++bj) { f32x4 a0, a1, b0, b1; unpack8_fp8(av[m][bj], a0, a1); unpack8_fp8(bv[m][bj], b0, b1);
#pragma unroll
                    for (int e = 0; e < 4; ++e) { acc[ai][bj][m][0][e] *= a0[e] * __builtin_amdgcn_rcpf(b0[e]); acc[ai][bj][m][1][e] *= a1[e] * __builtin_amdgcn_rcpf(b1[e]); } } }
    }
    __device__ __forceinline__ void operator()(const f32x4 (&acc)[2][2][4][2], const pg8::Unit& u, int wr, int wc, int fr, int fq) const {
        int lofs = (wr * 64 + fr) * 2048 + wc * 32 + 8 * fq; asm volatile("" : "+v"(lofs));
        const size_t ub = ((size_t)u.pm * 256) * 2048 + u.pn * 256;
#pragma unroll
        for (int ai = 0; ai < 2; ++ai) { u32x2 bv[4][2];
#pragma unroll
            for (int m = 0; m < 4; ++m)
#pragma unroll
                for (int bj = 0; bj < 2; ++bj) bv[m][bj] = *(const u32x2*)(gb + ub + (size_t)(lofs + (ai * 128 + m * 16) * 2048 + bj * 128));
#pragma unroll
            for (int m = 0; m < 4; ++m)
#pragma unroll
                for (int bj = 0; bj < 2; ++bj) { f32x4 b0, b1; unpack8_fp8(bv[m][bj], b0, b1);
                    *(u32x2*)(mx + ub + (size_t)(lofs + (ai * 128 + m * 16) * 2048 + bj * 128)) = pack8_fp8(acc[ai][bj][m][0] * b0, acc[ai][bj][m][1] * b1, Q8_X * Q8_OUT / Q8_G); } }
    }
};
__device__ __forceinline__ void ln_fold8(const float* st, const float* c1, const float* c0, int row, int col, f32x4& a, f32x4& b) {
    float mu, rs; row_mu_rstd(st, row, mu, rs);
    const f32x4 p0 = *(const f32x4*)(c1 + col), p1 = *(const f32x4*)(c1 + col + 4), q0 = *(const f32x4*)(c0 + col), q1 = *(const f32x4*)(c0 + col + 4);
    a = (a - mu * p0) * rs + q0; b = (b - mu * p1) * rs + q1;
}
struct OpPQFold { static constexpr int NLD = 0; float* o1; float* o2; const float* st; const float* c1; const float* c0;
    __device__ __forceinline__ void operator()(int zi, int row, int col, f32x4 a, f32x4 b) const { ln_fold8(st, c1, c0, row, col, a, b); float* p = (col < 1024 ? o1 : o2) + (size_t)row * 1024 + (col & 1023); *(f32x4*)p = a; *(f32x4*)(p + 4) = b; } };

template <bool FP8 = false, class Op>
__device__ __forceinline__ void gemm(const Frame& F, const bf16* A, int lda, const bf16* Bt, int ldb, int M, int N, int K, const Op& op) {
    pg8::Gemm g{lda, ldb, K}; pg8::MultiOrder<1> S; S.s[0] = pg8::Sub{A, Bt, M / 256, N / 256}; S.lda = lda; S.ldb = ldb; S.G = F.G; S.c = F.bid;
    pg8::Epi8<Op> E{op};
    pg8::gemm_phase<pg8::Epi8<Op>, pg8::MultiOrder<1>, true, false, false, FP8>((PG8_LAS unsigned char*)F.lds, g, S, E, F.wave, F.lane());
}
template <bool FP8 = false, class Epi>
__device__ __forceinline__ void gemm_epi(const Frame& F, const bf16* A, int lda, const bf16* Bt, int ldb, int M, int N, int K, const Epi& E) {
    pg8::Gemm g{lda, ldb, K}; pg8::MultiOrder<1> S; S.s[0] = pg8::Sub{A, Bt, M / 256, N / 256}; S.lda = lda; S.ldb = ldb; S.G = F.G; S.c = F.bid;
    pg8::gemm_phase<Epi, pg8::MultiOrder<1>, true, false, false, FP8>((PG8_LAS unsigned char*)F.lds, g, S, E, F.wave, F.lane());
}
template <int NS, bool FP8 = false, class Op>
__device__ __forceinline__ void gemm_multi(const Frame& F, const pg8::MultiOrder<NS>& S, int K, const Op& op) {
    pg8::Gemm g{S.lda, S.ldb, K}; pg8::Epi8<Op> E{op};
    pg8::gemm_phase<pg8::Epi8<Op>, pg8::MultiOrder<NS>, true, false, false, FP8>((PG8_LAS unsigned char*)F.lds, g, S, E, F.wave, F.lane());
}
template <class Off, class Op>
__device__ __forceinline__ void gemm_batch(const Frame& F, const pg8::BatchOrder<Off>& S, int K, const Op& op) {
    pg8::Gemm g{S.lda, S.ldb, K}; pg8::Epi8<Op> E{op};
    pg8::gemm_phase<pg8::Epi8<Op>, pg8::BatchOrder<Off>, true>((PG8_LAS unsigned char*)F.lds, g, S, E, F.wave, F.lane());
}
struct OffS { __device__ __forceinline__ size_t a(int z) const { return (size_t)(z >> 2) * 2048 * 2048 + (z & 3) * 512; } __device__ __forceinline__ size_t b(int z) const { return (size_t)(z >> 2) * 256 * 2048 + (z & 3) * 512; } };
struct OffPV { __device__ __forceinline__ size_t a(int z) const { return (size_t)(z >> 2) * 2048 * 2048 + (z & 3) * 256; } __device__ __forceinline__ size_t b(int z) const { return (size_t)(z & 3) * 512 * 2048 + (z >> 2) * 256; } };
struct OpLogit { static constexpr int NLD = 0; float* lg;
    __device__ __forceinline__ void operator()(int z, int row, int col, f32x4 a, f32x4 b) const { float* p = lg + ((size_t)(z >> 2) * 2048 + row) * 1024 + (z & 3) * 256 + col; *(f32x4*)p = a * 0.04419417382415922f; *(f32x4*)(p + 4) = b * 0.04419417382415922f; } };
struct OpCO { static constexpr int NLD = 0; unsigned char* co;
    __device__ __forceinline__ void operator()(int z, int row, int col, f32x4 a, f32x4 b) const { *(u32x2*)(co + ((size_t)(z >> 2) * 2048 + row) * 4096 + (z & 3) * 512 + col) = pack8_fp8(a, b, Q8_X); } };
struct OpCQKV { static constexpr int NLD = 0; bf16* cq; bf16* ck; bf16* vt; const float* st; const float* c1; const float* c0;
    __device__ __forceinline__ void operator()(int z, int row, int col, f32x4 a, f32x4 b) const { a = a * Q8_OUT; b = b * Q8_OUT; if (z == 0) ln_fold8(st, c1, c0, row, col, a, b);
        bf16* o = z == 0 ? cq : (z == 1 ? ck : vt); *(u32x4*)(o + (size_t)row * 2048 + col) = pack8(a, b); } };
struct EpiXSoftmax { static constexpr bool PERM = true; bf16* P;
    __device__ __forceinline__ void operator()(const f32x4 (&)[2][2][4][2], const pg8::Unit&, int, int, int, int) const {}
    __device__ __forceinline__ void fused(f32x4 (&acc)[2][2][4][2], const pg8::Unit& u, int wr, int wc, int fr, int fq, unsigned char* lds) const {
        float* pm = (float*)lds;
        float* ps = pm + 1024;
        const float sc = 0.04419417382415922f * 1.4426950408889634f;
        float mx[2][4];
#pragma unroll
        for (int ai = 0; ai < 2; ++ai)
#pragma unroll
            for (int m = 0; m < 4; ++m) { float v = -INFINITY;
#pragma unroll
                for (int bj = 0; bj < 2; ++bj)
#pragma unroll
                    for (int n = 0; n < 2; ++n)
#pragma unroll
                        for (int e = 0; e < 4; ++e) v = fmaxf(v, acc[ai][bj][m][n][e]);
                v = fmaxf(v, __shfl_xor(v, 16)); v = fmaxf(v, __shfl_xor(v, 32));
                if (fq == 0) pm[(ai * 128 + wr * 64 + m * 16 + fr) * 4 + wc] = v; }
        __syncthreads();
#pragma unroll
        for (int ai = 0; ai < 2; ++ai)
#pragma unroll
            for (int m = 0; m < 4; ++m) { const f32x4 q = *(const f32x4*)(pm + (ai * 128 + wr * 64 + m * 16 + fr) * 4); const float rm = fmaxf(fmaxf(q.x, q.y), fmaxf(q.z, q.w)) * sc; mx[ai][m] = rm; float sm = 0.f;
#pragma unroll
                for (int bj = 0; bj < 2; ++bj)
#pragma unroll
                    for (int n = 0; n < 2; ++n)
#pragma unroll
                        for (int e = 0; e < 4; ++e) { const float p = __builtin_amdgcn_exp2f(acc[ai][bj][m][n][e] * sc - rm); acc[ai][bj][m][n][e] = p; sm += p; }
                sm += __shfl_xor(sm, 16); sm += __shfl_xor(sm, 32);
                if (fq == 0) ps[(ai * 128 + wr * 64 + m * 16 + fr) * 4 + wc] = sm; }
        __syncthreads();
        const int row0 = u.pm * 256 + wr * 64 + fr, col0 = wc * 32 + 8 * fq;
#pragma unroll
        for (int ai = 0; ai < 2; ++ai)
#pragma unroll
            for (int m = 0; m < 4; ++m) { const f32x4 q = *(const f32x4*)(ps + (ai * 128 + wr * 64 + m * 16 + fr) * 4); const float inv = 1.0f / ((q.x + q.y) + (q.z + q.w));
                bf16* prow = P + ((size_t)(u.z >> 2) * 2048 + row0 + ai * 128 + m * 16) * 2048 + (u.z & 3) * 256 + col0;
#pragma unroll
                for (int bj = 0; bj < 2; ++bj) *(u32x4*)(prow + bj * 128) = pack8(acc[ai][bj][m][0] * inv, acc[ai][bj][m][1] * inv); }
        (void)mx;
        __syncthreads();
    }
};
__device__ __forceinline__ void ph_xsoftmax(const Frame& F, const float* lg, bf16* P) {
    const int gw = F.bid * 8 + F.wave, NGW = F.G * 8, lane = F.lane();
    for (int u = gw; u < T * 4; u += NGW) {
        const f32x4 v = *(const f32x4*)(lg + (size_t)u * 256 + 4 * lane);
        const float m = wave_max(fmaxf(fmaxf(v.x, v.y), fmaxf(v.z, v.w)));
        const float e0 = expf(v.x - m), e1 = expf(v.y - m), e2 = expf(v.z - m), e3 = expf(v.w - m);
        const float inv = 1.0f / wave_sum((e0 + e1) + (e2 + e3));
        u32x2 w; w.x = pk2(e0 * inv, e1 * inv); w.y = pk2(e2 * inv, e3 * inv);
        *(u32x2*)(P + (size_t)(u >> 2) * 2048 + (u & 3) * 256 + 4 * lane) = w;
    }
}

template <class CM>
__device__ __forceinline__ void transpose_item(const float* W, size_t ldw, bf16* WT, size_t ldwt, int row_off, int nblk, int item, float* scr, int lane, const CM& cm) {
    const int kb = item / nblk, nb = item % nblk, k0 = 64 * kb, n0 = 32 * nb;
    const int c = cm(n0 + (lane & 31));
#pragma unroll 8
    for (int i = 0; i < 32; ++i) { const int kk = 2 * i + (lane >> 5); scr[kk * 33 + (lane & 31)] = (c >= 0) ? W[(size_t)(k0 + kk) * ldw + c] : 0.f; }
    WAVE_SYNC();
    const int c8 = lane & 7;
#pragma unroll
    for (int j = 0; j < 4; ++j) { const int n = (lane >> 3) + 8 * j; const float* s = scr + (8 * c8) * 33 + n;
        u32x4 o; o.x = pk2(s[0 * 33], s[1 * 33]); o.y = pk2(s[2 * 33], s[3 * 33]); o.z = pk2(s[4 * 33], s[5 * 33]); o.w = pk2(s[6 * 33], s[7 * 33]);
        *(u32x4*)(WT + (size_t)(row_off + n0 + n) * ldwt + k0 + 8 * c8) = o; }
    WAVE_SYNC();
}
template <bool FP8>
__device__ __forceinline__ void transpose_item_ln(const float* W, unsigned char* WT, int item, float* scr, int lane, const float* g, const float* bta, float* c1, float* c0) {
    const int kb = item / 64, nb = item % 64, k0 = 64 * kb, n0 = 32 * nb;
#pragma unroll 8
    for (int i = 0; i < 32; ++i) { const int kk = 2 * i + (lane >> 5); scr[kk * 33 + (lane & 31)] = W[(size_t)(k0 + kk) * 2048 + n0 + (lane & 31)]; }
    WAVE_SYNC();
    const int c8 = lane & 7;
    float gk[8], bk[8];
#pragma unroll
    for (int i = 0; i < 8; ++i) { gk[i] = g[k0 + 8 * c8 + i]; bk[i] = bta[k0 + 8 * c8 + i]; }
#pragma unroll
    for (int j = 0; j < 4; ++j) { const int n = (lane >> 3) + 8 * j; const float* sp = scr + (8 * c8) * 33 + n;
        float wv[8]; float p1 = 0.f, p0 = 0.f;
#pragma unroll
        for (int i = 0; i < 8; ++i) { const float v = sp[i * 33]; wv[i] = v * gk[i]; p1 += wv[i]; p0 += v * bk[i]; }
        if constexpr (FP8) *(u32x2*)(WT + (size_t)(n0 + n) * 2048 + k0 + 8 * c8) = pack8_fp8((f32x4){wv[0], wv[1], wv[2], wv[3]}, (f32x4){wv[4], wv[5], wv[6], wv[7]}, Q8_W);
        else { u32x4 o; o.x = pk2(wv[0], wv[1]); o.y = pk2(wv[2], wv[3]); o.z = pk2(wv[4], wv[5]); o.w = pk2(wv[6], wv[7]); *(u32x4*)((bf16*)WT + (size_t)(n0 + n) * 2048 + k0 + 8 * c8) = o; }
        p1 += __shfl_xor(p1, 1); p1 += __shfl_xor(p1, 2); p1 += __shfl_xor(p1, 4); p0 += __shfl_xor(p0, 1); p0 += __shfl_xor(p0, 2); p0 += __shfl_xor(p0, 4);
        if (c8 == 0) { atomicAdd(c1 + n0 + n, p1); atomicAdd(c0 + n0 + n, p0); } }
    WAVE_SYNC();
}
__device__ __forceinline__ unsigned pk4_fp8(float a, float b, float c, float d, float s) { int p = __builtin_amdgcn_cvt_pk_fp8_f32(a * s, b * s, 0, false); p = __builtin_amdgcn_cvt_pk_fp8_f32(c * s, d * s, p, true); return (unsigned)p; }
__device__ __forceinline__ void cvt_fp8_stream(const Frame& F, const float* src, unsigned char* dst, size_t n16, float s) {
    const size_t gt = (size_t)F.bid * 512 + F.wave * 64 + F.lane(), NT = (size_t)F.G * 512;
#pragma unroll 2
    for (size_t i = gt; i < n16; i += NT) { const f32x4 a = ((const f32x4*)src)[4 * i], b = ((const f32x4*)src)[4 * i + 1], c = ((const f32x4*)src)[4 * i + 2], d = ((const f32x4*)src)[4 * i + 3];
        u32x4 o; o.x = pk4_fp8(a.x, a.y, a.z, a.w, s); o.y = pk4_fp8(b.x, b.y, b.z, b.w, s); o.z = pk4_fp8(c.x, c.y, c.z, c.w, s); o.w = pk4_fp8(d.x, d.y, d.z, d.w, s); ((u32x4*)dst)[i] = o; }
}
template <class CM>
__device__ __forceinline__ void transpose_item64_fp8(const float* W, size_t ldw, unsigned char* WT, size_t ldwt, int row_off, int nblk, int item, float* scr, int lane, const CM& cm, float s) {
    const int kb = item / nblk, nb = item % nblk, k0 = 64 * kb, n0 = 64 * nb, r = lane >> 4, c4 = lane & 15;
    const int c = cm(n0 + 4 * c4);
    f32x4 v[16];
#pragma unroll
    for (int i = 0; i < 16; ++i) v[i] = (c >= 0) ? *(const f32x4*)(W + (size_t)(k0 + 4 * i + r) * ldw + c) : (f32x4){0.f, 0.f, 0.f, 0.f};
#pragma unroll
    for (int i = 0; i < 16; ++i) *(f32x4*)(scr + (4 * i + r) * 68 + 4 * c4) = v[i];
    WAVE_SYNC();
    unsigned char* orow = WT + (size_t)(row_off + n0 + lane) * ldwt + k0;
#pragma unroll
    for (int j = 0; j < 4; ++j) { const float* sp = scr + (16 * j) * 68 + lane;
        u32x4 o; o.x = pk4_fp8(sp[0], sp[68], sp[2 * 68], sp[3 * 68], s); o.y = pk4_fp8(sp[4 * 68], sp[5 * 68], sp[6 * 68], sp[7 * 68], s);
        o.z = pk4_fp8(sp[8 * 68], sp[9 * 68], sp[10 * 68], sp[11 * 68], s); o.w = pk4_fp8(sp[12 * 68], sp[13 * 68], sp[14 * 68], sp[15 * 68], s);
        *(u32x4*)(orow + 16 * j) = o; }
    WAVE_SYNC();
}
template <class CM>
__device__ __forceinline__ void t64_load(const float* W, size_t ldw, int nblk, int item, int lane, const CM& cm, f32x4 (&v)[16]) {
    const int kb = item / nblk, nb = item % nblk, k0 = 64 * kb, n0 = 64 * nb, r = lane >> 4, c4 = lane & 15;
    const int c = cm(n0 + 4 * c4);
#pragma unroll
    for (int i = 0; i < 16; ++i) v[i] = (c >= 0) ? *(const f32x4*)(W + (size_t)(k0 + 4 * i + r) * ldw + c) : (f32x4){0.f, 0.f, 0.f, 0.f};
}
__device__ __forceinline__ void t64_to_lds(const f32x4 (&v)[16], float* scr, int lane) {
    const int r = lane >> 4, c4 = lane & 15;
#pragma unroll
    for (int i = 0; i < 16; ++i) *(f32x4*)(scr + (4 * i + r) * 68 + 4 * c4) = v[i];
    WAVE_SYNC();
}
__device__ __forceinline__ void t64_out_fp8(unsigned char* WT, size_t ldwt, int nblk, int item, const float* scr, int lane, float s) {
    const int kb = item / nblk, nb = item % nblk, k0 = 64 * kb, n0 = 64 * nb;
    unsigned char* orow = WT + (size_t)(n0 + lane) * ldwt + k0;
#pragma unroll
    for (int j = 0; j < 4; ++j) { const float* sp = scr + (16 * j) * 68 + lane;
        u32x4 o; o.x = pk4_fp8(sp[0], sp[68], sp[2 * 68], sp[3 * 68], s); o.y = pk4_fp8(sp[4 * 68], sp[5 * 68], sp[6 * 68], sp[7 * 68], s);
        o.z = pk4_fp8(sp[8 * 68], sp[9 * 68], sp[10 * 68], sp[11 * 68], s); o.w = pk4_fp8(sp[12 * 68], sp[13 * 68], sp[14 * 68], sp[15 * 68], s);
        *(u32x4*)(orow + 16 * j) = o; }
    WAVE_SYNC();
}
template <class CM>
__device__ __forceinline__ void transpose_item64(const float* W, size_t ldw, bf16* WT, size_t ldwt, int row_off, int nblk, int item, float* scr, int lane, const CM& cm) {
    const int kb = item / nblk, nb = item % nblk, k0 = 64 * kb, n0 = 64 * nb, r = lane >> 4, c4 = lane & 15;
    const int c = cm(n0 + 4 * c4);
    f32x4 v[16];
#pragma unroll
    for (int i = 0; i < 16; ++i) v[i] = (c >= 0) ? *(const f32x4*)(W + (size_t)(k0 + 4 * i + r) * ldw + c) : (f32x4){0.f, 0.f, 0.f, 0.f};
#pragma unroll
    for (int i = 0; i < 16; ++i) *(f32x4*)(scr + (4 * i + r) * 68 + 4 * c4) = v[i];
    WAVE_SYNC();
    bf16* orow = WT + (size_t)(row_off + n0 + lane) * ldwt + k0;
#pragma unroll
    for (int j = 0; j < 8; ++j) { const float* sp = scr + (8 * j) * 68 + lane;
        u32x4 o; o.x = pk2(sp[0], sp[68]); o.y = pk2(sp[2 * 68], sp[3 * 68]); o.z = pk2(sp[4 * 68], sp[5 * 68]); o.w = pk2(sp[6 * 68], sp[7 * 68]);
        *(u32x4*)(orow + 8 * j) = o; }
    WAVE_SYNC();
}
struct CmIdent { __device__ __forceinline__ int operator()(int n) const { return n; } };
struct CmWin { __device__ __forceinline__ int operator()(int n) const {
    if (n < 10240) return n;
    if (n < 12288) return 10496 + (n - 10240);
    if (n < 14336) return 12688 + (n - 12288);
    if (n < 16384) return 14736 + (n - 14336);
    if (n < 16640) return 10240 + (n - 16384);
    if (n < 16768) return 12544 + (n - 16640);
    if (n < 16784) return 12672 + (n - 16768);
    return -1; } };

__device__ __forceinline__ void cvt_bf16_stream(const Frame& F, const float* src, bf16* dst, size_t n8) {
    const size_t gt = (size_t)F.bid * 512 + F.wave * 64 + F.lane(), NT = (size_t)F.G * 512;
#pragma unroll 4
    for (size_t i = gt; i < n8; i += NT) { const f32x4 a = ((const f32x4*)src)[2 * i], b = ((const f32x4*)src)[2 * i + 1];
        u32x4 o; o.x = pk2(a.x, a.y); o.y = pk2(a.z, a.w); o.z = pk2(b.x, b.y); o.w = pk2(b.z, b.w); ((u32x4*)dst)[i] = o; }
}

__device__ __forceinline__ void ph0_prologue(const Frame& F) {
    const Args& a = *F.a;
    cvt_fp8_stream(F, a.in[0], (unsigned char*)a.out, (size_t)T * D / 16, Q8_X);
    cvt_fp8_stream(F, a.in[1], F.ws + WS_MEMB, (size_t)2048 * 2048 / 16, Q8_X);
    float* scr = (float*)(F.lds + F.wave * 17408);
    const int gw = F.bid * 8 + F.wave, NGW = F.G * 8, lane = F.lane();
    {
        const int nblk = NCOLS / 64, nitems = (2048 / 64) * nblk;
        float* scr64 = (float*)(F.lds + F.wave * 17408);
        f32x4 v[16];
        if (gw < nitems) t64_load(a.in[2], 16784, nblk, gw, lane, CmWin(), v);
        for (int it = gw; it < nitems; it += NGW) {
            t64_to_lds(v, scr64, lane);
            if (it + NGW < nitems) t64_load(a.in[2], 16784, nblk, it + NGW, lane, CmWin(), v);
            t64_out_fp8(F.ws + WS_WIN, 2048, nblk, it, scr64, lane, Q8_W);
        }
    }
    {
        for (int it = gw; it < 32 * 16; it += NGW) { const int mat = it >> 4, which = mat >> 4, h = mat & 15;
            transpose_item(a.in[which ? 9 : 8] + (size_t)h * 256 * 128, 128, (bf16*)(F.ws + WS_WKV), 256, which * 2048 + h * 128, 4, it & 15, scr, lane, CmIdent()); }
    }
    {
        bf16* W8p = (bf16*)((unsigned char*)a.out + (size_t)64 * MiB);
        for (int it = gw; it < 2 * 1024; it += NGW) { const int m = 4 + (it >> 10);
            transpose_item64_fp8(m == 4 ? a.in[17] : a.in[18], 2048, (unsigned char*)(W8p + (size_t)m * 2048 * 2048), 2048, 0, 32, it & 1023, scr, lane, CmIdent(), Q8_W); }
    }
    {
        const int gt = F.bid * 512 + F.wave * 64 + lane;
        if (gt < 2048) { const float l0 = a.in[3][gt], l1 = a.in[3][2048 + gt]; ((float*)(F.ws + WS_LB))[gt] = 1.0f / (1.0f + expf(l1 - l0)); }
    }
}

namespace hg {
constexpr int QP = 272, TP = 144, AP = 144;
constexpr int OFF_QD = 0, OFF_KD = OFF_QD + 64 * QP, OFF_QG = OFF_KD + 64 * QP, OFF_KET = OFF_QG + 64 * QP, OFF_VT = OFF_KET + 128 * TP, OFF_A = OFF_VT + 128 * TP,
              OFF_TOT = OFF_A + 64 * AP, OFF_DEC = OFF_TOT + 4 * 128 * 4, OFF_PART = OFF_DEC + 128 * 4, OFF_RSTD = OFF_PART + 8 * 64 * 4, END = OFF_RSTD + 64 * 4;
static_assert(END <= 131072, "hgrn LDS map");
}
typedef short bf16x4 __attribute__((ext_vector_type(4)));
#define HSEC_B() do { if (PROBE_SEC) hs_t0 = rt_now(); } while (0)
#define HSEC_E(n) do { if (PROBE_SEC == (n)) sacc += rt_now() - hs_t0; } while (0)
__device__ __forceinline__ void hgrn_chunked(const Frame& F, int unit, unsigned long long& sacc) {
    unsigned long long hs_t0 = 0ull;
    using namespace hg;
    const Args& a = *F.a;
    const int b = unit >> 4, h = unit & 15, lane = F.lane(), w = F.wave, tid = w * 64 + lane, c = tid & 127, rq = tid >> 7, l15 = lane & 15, q4 = lane >> 4;
    unsigned char* L = F.lds;
    const size_t base = (size_t)b * 2048 * 2048 + h * 128;
    const bf16* HQ = F.slot(0) + base; const bf16* HF = F.slot(1) + base; const bf16* HI = F.slot(2) + base; const bf16* HG = F.slot(3) + base; unsigned char* HO8 = F.ws + WS_HO8 + base;
    const float lb = ((const float*)(F.ws + WS_LB))[h * 128 + c];
    const float ng = a.in[4][h * 128 + 16 * w + l15];
    f32x4 S[8];
#pragma unroll
    for (int d = 0; d < 8; ++d) S[d] = (f32x4){0.f, 0.f, 0.f, 0.f};
    unsigned short rq_[16], rf_[16], rv_[16];
#pragma unroll
    for (int k = 0; k < 16; ++k) { const size_t o = (size_t)(16 * rq + k) * 2048 + c; rq_[k] = HQ[o]; rf_[k] = HF[o]; rv_[k] = HI[o]; }
    float* tot = (float*)(L + OFF_TOT); float* dec = (float*)(L + OFF_DEC); float* part = (float*)(L + OFF_PART); float* rstd = (float*)(L + OFF_RSTD);
#pragma unroll 1
    for (int ch = 0; ch < 32; ++ch) {
        const int r0 = ch * 64;
        HSEC_B();
        unsigned short gq[16];
#pragma unroll
        for (int mt = 0; mt < 4; ++mt)
#pragma unroll
            for (int r = 0; r < 4; ++r) gq[4 * mt + r] = HG[(size_t)(r0 + 16 * mt + 4 * q4 + r) * 2048 + 16 * w + l15];
        unsigned short rv2_[16];
        if (ch + 1 < 32) {
#pragma unroll
            for (int k = 0; k < 16; ++k) rv2_[k] = HI[(size_t)(r0 + 64 + 16 * rq + k) * 2048 + c]; }
        float G[16], qf[16], kk[16];
        { float run = 0.f;
#pragma unroll
          for (int k = 0; k < 16; ++k) { const float f = lb + (1.0f - lb) * __builtin_amdgcn_rcpf(1.0f + __expf(-bf2f(rf_[k]))); run += __logf(f); G[k] = run; kk[k] = 1.0f - f; qf[k] = bf2f(rq_[k]); } }
        tot[rq * 128 + c] = G[15];
        if (ch + 1 < 32) {
#pragma unroll
            for (int k = 0; k < 16; ++k) { const size_t o = (size_t)(r0 + 64 + 16 * rq + k) * 2048 + c; rq_[k] = HQ[o]; rf_[k] = HF[o]; } }
        HSEC_E(1); HSEC_B();
        __syncthreads();
        HSEC_E(2); HSEC_B();
        const float t0 = tot[c], t1 = tot[128 + c], t2 = tot[256 + c], t3 = tot[384 + c];
        const float offs = (rq > 0 ? t0 : 0.f) + (rq > 1 ? t1 : 0.f) + (rq > 2 ? t2 : 0.f);
        const float Gref = t0 + t1, Glast = Gref + t2 + t3, eref = __expf(Gref), elr = __expf(Glast - Gref);
        if (rq == 0) dec[c] = __expf(Glast);
        unsigned kew[8], vw[8];
#pragma unroll
        for (int k = 0; k < 16; ++k) {
            const float e1 = __expf(G[k] + offs - Gref), qd = qf[k] * e1, kd = kk[k] * __builtin_amdgcn_rcpf(e1);
            const int row = 16 * rq + k;
            *(bf16*)(L + OFF_QD + row * QP + 2 * c) = (bf16)f2bf(qd);
            *(bf16*)(L + OFF_KD + row * QP + 2 * c) = (bf16)f2bf(kd);
            *(bf16*)(L + OFF_QG + row * QP + 2 * c) = (bf16)f2bf(qd * eref);
            const unsigned ke = f2bf(kd * elr);
            if (k & 1) { kew[k >> 1] |= ke << 16; vw[k >> 1] |= (unsigned)rv_[k] << 16; } else { kew[k >> 1] = ke; vw[k >> 1] = rv_[k]; }
        }
        *(u32x4*)(L + OFF_KET + c * TP + 32 * rq) = (u32x4){kew[0], kew[1], kew[2], kew[3]}; *(u32x4*)(L + OFF_KET + c * TP + 32 * rq + 16) = (u32x4){kew[4], kew[5], kew[6], kew[7]};
        *(u32x4*)(L + OFF_VT + c * TP + 32 * rq) = (u32x4){vw[0], vw[1], vw[2], vw[3]}; *(u32x4*)(L + OFF_VT + c * TP + 32 * rq + 16) = (u32x4){vw[4], vw[5], vw[6], vw[7]};
        if (ch + 1 < 32) {
#pragma unroll
            for (int k = 0; k < 16; ++k) rv_[k] = rv2_[k]; }
        HSEC_E(3); HSEC_B();
        __syncthreads();
        HSEC_E(4); HSEC_B();
        { const int mi = w >> 1;
#pragma unroll
          for (int tt = 0; tt < 2; ++tt) { const int nj = 2 * (w & 1) + tt; f32x4 acc = (f32x4){0.f, 0.f, 0.f, 0.f};
              if (nj <= mi) {
#pragma unroll
                  for (int ks = 0; ks < 4; ++ks) { const bf16x8 aF = *(const bf16x8*)(L + OFF_KD + (16 * nj + l15) * QP + 64 * ks + 16 * q4), bF = *(const bf16x8*)(L + OFF_QD + (16 * mi + l15) * QP + 64 * ks + 16 * q4);
                      acc = __builtin_amdgcn_mfma_f32_16x16x32_bf16(aF, bF, acc, 0, 0, 0); } }
              const int i = 16 * mi + l15, j0 = 16 * nj + 4 * q4;
              const float v0 = (j0 <= i) ? acc.x : 0.f, v1 = (j0 + 1 <= i) ? acc.y : 0.f, v2 = (j0 + 2 <= i) ? acc.z : 0.f, v3 = (j0 + 3 <= i) ? acc.w : 0.f;
              *(u32x2*)(L + OFF_A + i * AP + 2 * j0) = (u32x2){pk2(v0, v1), pk2(v2, v3)}; } }
        __syncthreads();
        HSEC_E(5); HSEC_B();
        bf16x8 bV[2];
#pragma unroll
        for (int ks = 0; ks < 2; ++ks) bV[ks] = *(const bf16x8*)(L + OFF_VT + (16 * w + l15) * TP + 64 * ks + 16 * q4);
        f32x4 O[4];
#pragma unroll
        for (int mt = 0; mt < 4; ++mt) { O[mt] = (f32x4){0.f, 0.f, 0.f, 0.f};
#pragma unroll
            for (int ks = 0; ks < 2; ++ks) { const bf16x8 aF = *(const bf16x8*)(L + OFF_A + (16 * mt + l15) * AP + 64 * ks + 16 * q4); O[mt] = __builtin_amdgcn_mfma_f32_16x16x32_bf16(aF, bV[ks], O[mt], 0, 0, 0); } }
#pragma unroll
        for (int kq = 0; kq < 4; ++kq) {
            u32x4 sw; sw.x = pk2(S[2 * kq].x, S[2 * kq].y); sw.y = pk2(S[2 * kq].z, S[2 * kq].w); sw.z = pk2(S[2 * kq + 1].x, S[2 * kq + 1].y); sw.w = pk2(S[2 * kq + 1].z, S[2 * kq + 1].w);
            const bf16x8 bS = __builtin_bit_cast(bf16x8, sw);
#pragma unroll
            for (int mt = 0; mt < 4; ++mt) { const unsigned char* qp = L + OFF_QG + (16 * mt + l15) * QP + 64 * kq + 8 * q4;
                const u32x2 lo = *(const u32x2*)qp, hi = *(const u32x2*)(qp + 32);
                const bf16x8 aF = __builtin_bit_cast(bf16x8, (u32x4){lo.x, lo.y, hi.x, hi.y});
                O[mt] = __builtin_amdgcn_mfma_f32_16x16x32_bf16(aF, bS, O[mt], 0, 0, 0); } }
#pragma unroll
        for (int dt = 0; dt < 8; ++dt) { const f32x4 dc = *(const f32x4*)(dec + 16 * dt + 4 * q4); S[dt] = S[dt] * dc;
#pragma unroll
            for (int ks = 0; ks < 2; ++ks) { const bf16x8 aF = *(const bf16x8*)(L + OFF_KET + (16 * dt + l15) * TP + 64 * ks + 16 * q4); S[dt] = __builtin_amdgcn_mfma_f32_16x16x32_bf16(aF, bV[ks], S[dt], 0, 0, 0); } }
        HSEC_E(6); HSEC_B();
#pragma unroll
        for (int mt = 0; mt < 4; ++mt)
#pragma unroll
            for (int r = 0; r < 4; ++r) { const float p = row16_sum(O[mt][r] * O[mt][r]);
                if (l15 == 0) part[w * 64 + 16 * mt + 4 * q4 + r] = p; }
        __syncthreads();
        if (tid < 64) { float s = 0.f;
#pragma unroll
            for (int ww = 0; ww < 8; ++ww) s += part[ww * 64 + tid];
            rstd[tid] = rsqrtf(s * (1.0f / 128.0f) + 1e-6f); }
        __syncthreads();
        HSEC_E(7); HSEC_B();
#pragma unroll
        for (int mt = 0; mt < 4; ++mt) { const f32x4 rs = *(const f32x4*)(rstd + 16 * mt + 4 * q4);
#pragma unroll
            for (int r = 0; r < 4; ++r) { const float g = bf2f(gq[4 * mt + r]); const float o = O[mt][r] * rs[r] * ng * (g * __builtin_amdgcn_rcpf(1.0f + __expf(-g)));
                HO8[(size_t)(r0 + 16 * mt + 4 * q4 + r) * 2048 + 16 * w + l15] = (unsigned char)__builtin_amdgcn_cvt_pk_fp8_f32(o * Q8_X, 0.f, 0, false); } }
        HSEC_E(8);
    }
    __syncthreads();
}

__device__ __forceinline__ void ph2_side(const Frame& F, int sid, int nside) {
    const Args& a = *F.a;
    const int gw = sid * 8 + F.wave, NGW = nside * 8, lane = F.lane();
    bf16* CKV = (bf16*)(F.ws + WS_CKV); bf16* IKW = (bf16*)(F.ws + WS_IKW);
    for (int row = gw; row < T; row += NGW) {
        {   u32x2 w = *(u32x2*)(CKV + (size_t)row * 256 + 4 * lane);
            float x0 = bflo(w.x), x1 = bfhi(w.x), x2 = bflo(w.y), x3 = bfhi(w.y);
            const float ss = wave_sum(x0 * x0 + x1 * x1 + x2 * x2 + x3 * x3);
            const float r = rsqrtf(ss * (1.0f / 256.0f) + 1e-6f);
            const f32x4 g = *(const f32x4*)(a.in[5] + 4 * lane);
            w.x = pk2(x0 * r * g.x, x1 * r * g.y); w.y = pk2(x2 * r * g.z, x3 * r * g.w);
            *(u32x2*)(CKV + (size_t)row * 256 + 4 * lane) = w; }
        {   unsigned w = *(unsigned*)(IKW + (size_t)row * 256 + 2 * lane);
            float x0 = bflo(w), x1 = bfhi(w);
            const float mu = wave_sum(x0 + x1) * (1.0f / 128.0f);
            x0 -= mu; x1 -= mu;
            const float var = wave_sum(x0 * x0 + x1 * x1) * (1.0f / 128.0f);
            const float r = rsqrtf(var + 1e-5f);
            const float g0 = a.in[6][2 * lane], g1 = a.in[6][2 * lane + 1], b0 = a.in[7][2 * lane], b1 = a.in[7][2 * lane + 1];
            *(unsigned*)(IKW + (size_t)row * 256 + 2 * lane) = pk2(x0 * r * g0 + b0, x1 * r * g1 + b1); }
    }
}
__device__ __forceinline__ void w8_transposes(const Frame& F, bf16* W8) {
    const Args& a = *F.a;
    const int gw = F.bid * 8 + F.wave, NGW = F.G * 8, lane = F.lane();
    float* scr = (float*)(F.lds + F.wave * 17408);
    float* cv = (float*)(F.ws + WS_CTL + CTL_CVEC);
    for (int it = gw; it < 2 * 2048; it += NGW) {
        const int which = it >> 11, m = which ? 7 : 3;
        if (which) transpose_item_ln<false>(a.in[22], (unsigned char*)(W8 + (size_t)m * 2048 * 2048), it & 2047, scr, lane, a.in[20], a.in[21], cv + 4096, cv + 4096 + 2048);
        else transpose_item_ln<true>(a.in[16], (unsigned char*)(W8 + (size_t)m * 2048 * 2048), it & 2047, scr, lane, a.in[14], a.in[15], cv, cv + 2048); }
    for (int it = gw; it < 4 * 1024; it += NGW) {
        const int q = it >> 10, m = q < 3 ? q : 6;
        const float* wsrc = m == 0 ? a.in[11] : m == 1 ? a.in[12] : m == 2 ? a.in[13] : a.in[19];
        if (m < 2) transpose_item64_fp8(wsrc, 2048, (unsigned char*)W8 + (size_t)m * 2048, 4096, 0, 32, it & 1023, scr, lane, CmIdent(), Q8_W);
        else transpose_item64_fp8(wsrc, 2048, (unsigned char*)(W8 + (size_t)m * 2048 * 2048), 2048, 0, 32, it & 1023, scr, lane, CmIdent(), Q8_W); }
}

__device__ __forceinline__ void ph3_hgnorm(const Frame& F) {
    const Args& a = *F.a;
    const int gw = F.bid * 8 + F.wave, NGW = F.G * 8, lane = F.lane();
    const float* oraw = a.out; const bf16* HG = F.slot(3); bf16* HO = F.slot(0);
    for (int u = gw; u < T * 16; u += NGW) {
        const size_t off = (size_t)(u >> 4) * 2048 + (u & 15) * 128 + 2 * lane;
        const float o0 = oraw[off], o1 = oraw[off + 1];
        const float r = rsqrtf(wave_sum(o0 * o0 + o1 * o1) * (1.0f / 128.0f) + 1e-6f);
        const unsigned gw2 = *(const unsigned*)(HG + off);
        const float g0 = bflo(gw2), g1 = bfhi(gw2);
        const int c = (u & 15) * 128 + 2 * lane;
        *(unsigned*)(HO + off) = pk2(o0 * r * a.in[4][c] * (g0 * sigm(g0)), o1 * r * a.in[4][c + 1] * (g1 * sigm(g1)));
    }
}

__device__ __forceinline__ unsigned fkey(float f) { const unsigned u = __float_as_uint(f); return (u & 0x80000000u) ? ~u : (u | 0x80000000u); }
__device__ __forceinline__ void ph5_select(const Frame& F, int first, int stride) {
    const int lane = F.lane(), l31 = lane & 31, half = lane >> 5, w = F.wave;
    float* scl = (float*)F.lds;
    const bf16* AIQ = F.slot(5); const bf16* IKW = (const bf16*)(F.ws + WS_IKW);
    unsigned* MASK = (unsigned*)(F.ws + WS_MASK);
    for (int i = first; i < 1024; i += stride) {
        const int r4 = i >> 8, c = i & 255, j = c & 127, b = 2 * r4 + (c >> 7), qt = (r4 & 1) ? 127 - j : j, t0 = qt * 16;
        bf16x8 Af[8];
        { const size_t rowA = (size_t)b * 2048 + t0 + 2 * w + ((l31 >> 2) & 1); const int headA = (l31 & 3) + 4 * (l31 >> 3);
#pragma unroll
          for (int ks = 0; ks < 8; ++ks) Af[ks] = *(const bf16x8*)(AIQ + rowA * 2048 + headA * 128 + 16 * ks + 8 * half); }
        float wr[16];
        { const bf16* wp = IKW + ((size_t)b * 2048 + t0 + 2 * w + half) * 256 + 128;
#pragma unroll
          for (int r = 0; r < 16; ++r) wr[r] = bf2f(wp[(r & 3) + 4 * (r >> 2)]) * (0.25f * 0.08838834764831845f); }
        const int nkt = (t0 + 15) / 32 + 1;
        unsigned char* ring = F.lds + 131072;
        const int srow = (w * 64 + lane) >> 4, sch = lane & 15;
        const bf16* kg = IKW + ((size_t)b * 2048 + srow) * 256 + 8 * sch;
        const int swr = srow * 256 + ((sch ^ (srow & 15)) << 4);
        const int frd = l31 * 256;
        u32x4 st0, st1;
        st0 = *(const u32x4*)kg; *(u32x4*)(ring + swr) = st0;
        if (nkt > 1) { st1 = *(const u32x4*)(kg + (size_t)32 * 256); *(u32x4*)(ring + 8192 + swr) = st1; }
        if (nkt > 2) st0 = *(const u32x4*)(kg + (size_t)2 * 32 * 256);
        __syncthreads();
#define IDX_TILE(kt_, STW, STL) do { \
            if ((kt_) + 3 < nkt) STL = *(const u32x4*)(kg + (size_t)((kt_) + 3) * 32 * 256); \
            { const unsigned char* sl_ = ring + ((kt_) % 3) * 8192 + frd; f32x16 acc; _Pragma("unroll") for (int r = 0; r < 16; ++r) acc[r] = 0.f; \
              _Pragma("unroll") for (int ks = 0; ks < 8; ++ks) { const bf16x8 bfr = *(const bf16x8*)(sl_ + (((2 * ks + half) ^ (l31 & 15)) << 4)); acc = __builtin_amdgcn_mfma_f32_32x32x16_bf16(Af[ks], bfr, acc, 0, 0, 0); } \
              float sc = 0.f; _Pragma("unroll") for (int r = 0; r < 16; ++r) sc += fmaxf(acc[r], 0.f) * wr[r]; \
              scl[(2 * w + half) * 2048 + (kt_) * 32 + l31] = sc; } \
            if ((kt_) + 2 < nkt) *(u32x4*)(ring + (((kt_) + 2) % 3) * 8192 + swr) = STW; \
            __syncthreads(); } while (0)
        for (int kt = 0; kt < nkt; kt += 2) { IDX_TILE(kt, st0, st1); if (kt + 1 < nkt) IDX_TILE(kt + 1, st1, st0); }
#undef IDX_TILE
        WAVE_SYNC();
#pragma unroll 1
        for (int qi = 0; qi < 2; ++qi) {
            const int t = t0 + 2 * w + qi; const float* row = scl + (2 * w + qi) * 2048;
            unsigned key[32];
#pragma unroll
            for (int jj = 0; jj < 32; ++jj) { const int s2 = lane + 64 * jj; key[jj] = (s2 <= t) ? fkey(row[s2]) : 0u; }
            unsigned thr = 0u;
            if (t + 1 > 256) {
                for (int bit = 31; bit >= 0; --bit) {
                    const unsigned cand = thr | (1u << bit);
                    int cnt = 0;
#pragma unroll
                    for (int jj = 0; jj < 32; ++jj) cnt += (key[jj] >= cand) ? 1 : 0;
                    { int tot = 0;
#pragma unroll
                      for (int bb = 0; bb < 6; ++bb) tot += __popcll(__ballot((cnt >> bb) & 1)) << bb;
                      cnt = tot; }
                    if (cnt >= 256) { thr = cand; if (cnt == 256) break; }
                }
            }
            unsigned wd = 0u;
#pragma unroll
            for (int jj = 0; jj < 32; ++jj) { const int s2 = lane + 64 * jj; const unsigned long long m = __ballot(s2 <= t && key[jj] >= thr);
                if (lane == 2 * jj) wd = (unsigned)m; if (lane == 2 * jj + 1) wd = (unsigned)(m >> 32); }
            MASK[((size_t)b * 2048 + t) * 64 + lane] = wd;
        }
        WAVE_SYNC();
    }
}

__device__ __forceinline__ int t5_bucket(int d) {
    if (d < 16) return d;
    return 16 + (d >= 19) + (d >= 21) + (d >= 24) + (d >= 27) + (d >= 31) + (d >= 35) + (d >= 40) + (d >= 46) + (d >= 52) + (d >= 59) + (d >= 67) + (d >= 77) + (d >= 87) + (d >= 99) + (d >= 113);
}
namespace dsa {
constexpr float SCALE = 0.08838834764831845f;
constexpr int NW = 8, QBLK = 32, KVBLK = 64, QB = NW * QBLK, DH = 128, LD = 2048;
constexpr int SHM_V = KVBLK * DH * 2, SHM_K = KVBLK * DH * 2;
constexpr int OFF_WS = 2 * SHM_V + 2 * SHM_K, OFF_BIAS = OFF_WS + NW * 64 * 4, LDS_TOTAL = OFF_BIAS + 16 * 128 * 4;
constexpr float THR = 8.f;
typedef short s16x4 __attribute__((ext_vector_type(4)));
#define KSWZ(row, colB) ((row) * 256 + ((colB) ^ (((row) & 7) << 4)))
#define SBAR() __builtin_amdgcn_sched_barrier(0)
__device__ __forceinline__ int v_st(int k, int c) { const int kk = (k & ~0xC) | ((k & 4) << 1) | ((k & 8) >> 1); return ((kk >> 3) * 4 + (c >> 5)) * 512 + ((kk & 7) * 32 + (c & 31)) * 2; }
__device__ __forceinline__ int v_rd_base(int lane) { return ((lane & 3) << 3) | (((lane >> 2) & 3) << 6) | (((lane >> 4) & 1) << 5) | (((lane >> 5) & 1) << 8); }
constexpr int v_rd_off(int d0, int ks, int half) { return d0 * 512 + ks * 4096 + half * 2048; }
__device__ __forceinline__ int crow(int r, int hi) { return (r & 3) + 8 * (r >> 2) + 4 * hi; }
__device__ __forceinline__ unsigned cvtpk(float lo, float hi) { unsigned r; asm volatile("v_cvt_pk_bf16_f32 %0, %1, %2" : "=v"(r) : "v"(lo), "v"(hi)); return r; }
__device__ __forceinline__ bf16x8 load8(const bf16* p) { return *reinterpret_cast<const bf16x8*>(p); }
template <bool NEAR>
__device__ __forceinline__ void init_scores(f32x16& p0, f32x16& p1, unsigned w0, unsigned w1, int hi, int dq, const float* bl) {
    w0 >>= 4 * hi; w1 >>= 4 * hi;
#pragma unroll
    for (int r = 0; r < 16; ++r) { const int c = (r & 3) + 8 * (r >> 2);
        const int x0 = __builtin_amdgcn_sbfe(w0, c, 1), x1 = __builtin_amdgcn_sbfe(w1, c, 1);
        unsigned b0 = 0u, b1 = 0u;
        if (NEAR) { int d0 = dq - c, d1 = dq - c - 32; d0 = d0 < 0 ? 0 : (d0 > 127 ? 127 : d0); d1 = d1 < 0 ? 0 : (d1 > 127 ? 127 : d1);
            b0 = __float_as_uint(bl[d0]); b1 = __float_as_uint(bl[d1]); }
        p0[r] = __uint_as_float((b0 & (unsigned)x0) | (0xFF800000u & ~(unsigned)x0));
        p1[r] = __uint_as_float((b1 & (unsigned)x1) | (0xFF800000u & ~(unsigned)x1)); }
}
__device__ __forceinline__ void partialSM(f32x16& p0, f32x16& p1, float& m_reg, float& mn, float& alpha) {
    float pmax = p0[0];
#pragma unroll
    for (int r = 1; r < 16; ++r) pmax = fmaxf(pmax, p0[r]);
#pragma unroll
    for (int r = 0; r < 16; ++r) pmax = fmaxf(pmax, p1[r]);
    { auto rr = __builtin_amdgcn_permlane32_swap(__float_as_uint(pmax), __float_as_uint(pmax), false, false);
      pmax = fmaxf(__uint_as_float(rr[0]), __uint_as_float(rr[1])); }
    constexpr float C2 = 1.4426950408889634f * SCALE;
    if (__builtin_expect(__all((pmax - m_reg) * SCALE <= THR), 1)) { mn = m_reg; alpha = 1.f; }
    else { mn = fmaxf(m_reg, pmax); alpha = __builtin_amdgcn_exp2f((m_reg - mn) * C2); m_reg = mn; }
    const float mnL = -mn * C2;
#pragma unroll
    for (int r = 0; r < 16; ++r) p0[r] = fmaf(p0[r], C2, mnL);
#pragma unroll
    for (int r = 0; r < 16; ++r) p1[r] = fmaf(p1[r], C2, mnL);
#pragma unroll
    for (int r = 0; r < 16; ++r) p0[r] = __builtin_amdgcn_exp2f(p0[r]);
}
__device__ __forceinline__ void finishSM(f32x16& p0, f32x16& p1, float alpha, float& l_reg, bf16x8& pa0, bf16x8& pa1, bf16x8& pa2, bf16x8& pa3) {
#pragma unroll
    for (int r = 0; r < 16; ++r) p1[r] = __builtin_amdgcn_exp2f(p1[r]);
    float ps = 0;
#pragma unroll
    for (int r = 0; r < 16; ++r) ps += p0[r];
#pragma unroll
    for (int r = 0; r < 16; ++r) ps += p1[r];
    { auto rr = __builtin_amdgcn_permlane32_swap(__float_as_uint(ps), __float_as_uint(ps), false, false);
      ps = __uint_as_float(rr[0]) + __uint_as_float(rr[1]); }
    l_reg = l_reg * alpha + ps;
#define PK4(P, B_, OUT) do { unsigned a0 = cvtpk(P[B_+0], P[B_+1]), a1 = cvtpk(P[B_+2], P[B_+3]);                          \
        unsigned b0 = cvtpk(P[B_+4], P[B_+5]), b1 = cvtpk(P[B_+6], P[B_+7]);                                             \
        auto r0 = __builtin_amdgcn_permlane32_swap(a0, b0, false, false); auto r1 = __builtin_amdgcn_permlane32_swap(a1, b1, false, false); \
        u32x4 w = {r0[0], r1[0], r0[1], r1[1]}; OUT = *reinterpret_cast<bf16x8*>(&w); } while (0)
    PK4(p0, 0, pa0); PK4(p0, 8, pa1); PK4(p1, 0, pa2); PK4(p1, 8, pa3);
#undef PK4
}
template <int KB>
__device__ __forceinline__ void qkt(f32x16& p0, f32x16& p1, const char* K_lds, int r32, int hi, const bf16x8* qr) {
    const char* kb[4];
#pragma unroll
    for (int dd = 0; dd < 4; ++dd) kb[dd] = K_lds + KB * SHM_K + KSWZ(r32, (dd * 16 + hi * 8) * 2);
#pragma unroll
    for (int d0 = 0; d0 < 8; ++d0) { const char* a = kb[d0 & 3] + (d0 >> 2) * 128;
        bf16x8 b0 = *reinterpret_cast<const bf16x8*>(a);
        bf16x8 b1 = *reinterpret_cast<const bf16x8*>(a + 32 * 256);
        p0 = __builtin_amdgcn_mfma_f32_32x32x16_bf16(b0, qr[d0], p0, 0, 0, 0);
        p1 = __builtin_amdgcn_mfma_f32_32x32x16_bf16(b1, qr[d0], p1, 0, 0, 0); }
}
template <int VB>
__device__ __forceinline__ void pv_tile(f32x16* o, int vb0, bf16x8 pa0, bf16x8 pa1, bf16x8 pa2, bf16x8 pa3) {
#define TRRD(dst, off) asm volatile("ds_read_b64_tr_b16 %0, %1 offset:%2" : "=&v"(dst) : "v"(vb0), "i"(off) : "memory")
#define PV_D0(d0) do { s16x4 l0, l1, l2, l3, h0, h1, h2, h3; constexpr int b_ = VB * SHM_V + v_rd_off(d0, 0, 0); \
        TRRD(l0, b_); TRRD(h0, b_ + 2048); TRRD(l1, b_ + 4096); TRRD(h1, b_ + 6144); TRRD(l2, b_ + 8192); TRRD(h2, b_ + 10240); TRRD(l3, b_ + 12288); TRRD(h3, b_ + 14336); \
        asm volatile("s_waitcnt lgkmcnt(0)" ::: "memory"); SBAR();   \
        o[d0] = __builtin_amdgcn_mfma_f32_32x32x16_bf16(pa0, (bf16x8){l0[0], l0[1], l0[2], l0[3], h0[0], h0[1], h0[2], h0[3]}, o[d0], 0, 0, 0);   \
        o[d0] = __builtin_amdgcn_mfma_f32_32x32x16_bf16(pa1, (bf16x8){l1[0], l1[1], l1[2], l1[3], h1[0], h1[1], h1[2], h1[3]}, o[d0], 0, 0, 0);   \
        o[d0] = __builtin_amdgcn_mfma_f32_32x32x16_bf16(pa2, (bf16x8){l2[0], l2[1], l2[2], l2[3], h2[0], h2[1], h2[2], h2[3]}, o[d0], 0, 0, 0);   \
        o[d0] = __builtin_amdgcn_mfma_f32_32x32x16_bf16(pa3, (bf16x8){l3[0], l3[1], l3[2], l3[3], h3[0], h3[1], h3[2], h3[3]}, o[d0], 0, 0, 0); } while (0)
    PV_D0(0); PV_D0(1); PV_D0(2); PV_D0(3);
#undef PV_D0
#undef TRRD
}
struct BlockRef { const bf16* Q; const bf16* K; const bf16* V; unsigned char* O; const unsigned* M; int P0; int h; };
struct Seam { bf16x8 qr[8]; bf16x8 st_v0, st_v1, st_k0, st_k1; };
#define ROWU(p, k0) ((p) + (size_t)(k0) * LD)
#define VMW() asm volatile("s_waitcnt vmcnt(0)" ::: "memory")
#define VMWN(n) asm volatile("s_waitcnt vmcnt(%0)" :: "i"(n) : "memory")
#define SLOAD_H(Kp, Vp, k0) do { S.st_v0 = load8(ROWU(Vp, k0) + sofs); S.st_v1 = load8(ROWU(Vp, (k0) + 32) + sofs);              \
                         S.st_k0 = load8(ROWU(Kp, k0) + sofs); S.st_k1 = load8(ROWU(Kp, (k0) + 32) + sofs); } while (0)
#define SWRITE_HK(bf) do { *(bf16x8*)(K_lds + (bf) * SHM_K + kws) = S.st_k0; *(bf16x8*)(K_lds + (bf) * SHM_K + kws + 32 * 256) = S.st_k1; } while (0)
#define SWRITE_HV(bf) do { *(bf16x8*)(V_lds + (bf) * SHM_V + vst0) = S.st_v0; *(bf16x8*)(V_lds + (bf) * SHM_V + vst1) = S.st_v1; } while (0)
#define SWRITE_H(bf) do { SWRITE_HV(bf); SWRITE_HK(bf); } while (0)
__device__ __forceinline__ void prime(const BlockRef& cur, char* lds, Seam& S, int wid) {
    const int lane = fresh_lane(), tid = wid * 64 + lane, r32 = lane & 31, hi = lane >> 5;
    const int sr = tid >> 4, sc = (tid & 15) * 8, kws = KSWZ(sr, sc * 2); char* K_lds = lds + 2 * SHM_V; const unsigned sofs = (unsigned)(sr * LD + sc);
    const unsigned qofs = (unsigned)((wid * QBLK + r32) * LD + hi * 8);
#pragma unroll
    for (int d0 = 0; d0 < 8; ++d0) S.qr[d0] = load8(cur.Q + qofs + d0 * 16);
    SLOAD_H(cur.K, cur.V, 0); VMW(); SWRITE_HK(0);
    __syncthreads();
}
__device__ __forceinline__ void block(const BlockRef& cur, const BlockRef& nxt, char* lds, Seam& S, int wid) {
    const int lane = fresh_lane(), tid = wid * 64 + lane,
               r32 = lane & 31, hi = lane >> 5;
    const int NT = (cur.P0 + QB - 1) / KVBLK + 1;
    const int qlo = cur.P0 + wid * QBLK, qm = qlo + r32 - 4 * hi;
    char* V_lds = lds; char* K_lds = lds + 2 * SHM_V;
    float* ws = (float*)(lds + OFF_WS) + wid * 64; float* li_l = ws, * al_l = ws + 32;
    const float* bl = (const float*)(lds + OFF_BIAS) + cur.h * 128;
    const unsigned mofs = (unsigned)((wid * QBLK + r32) * 64);
    float m_reg = -1e30f, l_reg = 0; f32x16 o[4] = {};
    const int sr = tid >> 4, sc = (tid & 15) * 8, vst0 = v_st(sr, sc), vst1 = v_st(32 + sr, sc), kws = KSWZ(sr, sc * 2); const unsigned sofs = (unsigned)(sr * LD + sc);
    const int vb0 = (int)(uintptr_t)V_lds + v_rd_base(lane);
    const bf16* Kh = cur.K; const bf16* Vh = cur.V;
#define RESC(a) do { if (__any((a) < 1.f)) { if (hi == 0) al_l[r32] = (a); asm volatile("s_waitcnt lgkmcnt(0)" ::: "memory");              \
                     for (int d_ = 0; d_ < 4; ++d_) for (int r = 0; r < 16; ++r) o[d_][r] *= al_l[crow(r, hi)]; } } while (0)
#define KBASE(t) ((t) * KVBLK)
#define LDMASK(t) (*(const u32x2*)(cur.M + 2 * ((t) < 31 ? (t) : 31) + mofs))
#define INIT(P0_, P1_, t) do { const int kb_ = KBASE(t); if (qlo - kb_ - 63 < 113) init_scores<true>(P0_, P1_, mw.x, mw.y, hi, qm - kb_, bl); else init_scores<false>(P0_, P1_, mw.x, mw.y, hi, 0, bl); } while (0)
#define SEAM_K0() do { VMWN(8); SWRITE_HK(0); SBAR(); } while (0)
    f32x16 pA0, pA1, pB0, pB1; float mnA, mnB, alA, alB; bf16x8 pa0, pa1, pa2, pa3; u32x2 mw;
    SWRITE_HV(0); SBAR();
    if (NT > 1) { SLOAD_H(Kh, Vh, KBASE(1)); }
    mw = LDMASK(0); INIT(pA0, pA1, 0); mw = LDMASK(1);
    SBAR(); qkt<0>(pA0, pA1, K_lds, r32, hi, S.qr);
    partialSM(pA0, pA1, m_reg, mnA, alA);
    if (NT > 1) { VMW(); SWRITE_H(1); }
    __syncthreads();
#define HALF_STEP(PX0, PX1, mnX, alX, PY0, PY1, alY, t, KB, VB, SB) do {                                                      \
        INIT(PX0, PX1, (t)); mw = LDMASK((t) + 1);                                                                           \
        SBAR(); qkt<KB>(PX0, PX1, K_lds, r32, hi, S.qr);                                                                      \
        finishSM(PY0, PY1, alY, l_reg, pa0, pa1, pa2, pa3); SBAR();                                                           \
        if ((t) + 1 < NT) { SLOAD_H(Kh, Vh, KBASE((t) + 1)); SBAR(); }                                                        \
        pv_tile<VB>(o, vb0, pa0, pa1, pa2, pa3); partialSM(PX0, PX1, m_reg, mnX, alX);              \
        __syncthreads();                                                                                                      \
        if ((t) + 1 < NT) { VMW(); SWRITE_H(SB); }                                                                            \
        RESC(alX); __syncthreads(); } while (0)
    for (int t = 1; t + 1 < NT; t += 2) {
        HALF_STEP(pB0, pB1, mnB, alB, pA0, pA1, alA, t, 1, 0, 0);
        HALF_STEP(pA0, pA1, mnA, alA, pB0, pB1, alB, t + 1, 0, 1, 1);
    }
    const bool even = (NT & 1) == 0;
    if (even) { INIT(pB0, pB1, NT - 1); SBAR(); qkt<1>(pB0, pB1, K_lds, r32, hi, S.qr); SBAR(); }
    SLOAD_H(nxt.K, nxt.V, 0); SBAR();
#pragma unroll
    for (int d0 = 0; d0 < 8; ++d0) S.qr[d0] = load8(nxt.Q + (unsigned)((wid * QBLK + r32) * LD + hi * 8) + d0 * 16);
    SBAR();
    finishSM(pA0, pA1, alA, l_reg, pa0, pa1, pa2, pa3); SBAR();
    pv_tile<0>(o, vb0, pa0, pa1, pa2, pa3);
    if (even) { partialSM(pB0, pB1, m_reg, mnB, alB); __syncthreads(); RESC(alB);
        finishSM(pB0, pB1, alB, l_reg, pa0, pa1, pa2, pa3); SBAR(); pv_tile<1>(o, vb0, pa0, pa1, pa2, pa3); }
    SBAR(); SEAM_K0();
    if (hi == 0) li_l[r32] = l_reg; asm volatile("s_waitcnt lgkmcnt(0)" ::: "memory");
    float rli[16];
#pragma unroll
    for (int r = 0; r < 16; ++r) rli[r] = __builtin_amdgcn_rcpf(li_l[crow(r, hi)]);
    int lofs = 4 * hi * LD + r32; asm volatile("" : "+v"(lofs));
    unsigned char* Ow = cur.O + (size_t)(wid * QBLK) * LD + lofs;
#pragma unroll
    for (int r = 0; r < 16; ++r) { const int orow = (r & 3) + 8 * (r >> 2);
#pragma unroll
        for (int d0 = 0; d0 < 4; ++d0) { const float v = o[d0][r] * rli[r] * 16.0f;
            const float v1 = __int_as_float(__builtin_amdgcn_mov_dpp(__float_as_int(v), 0x55, 0xF, 0xF, false)), v2 = __int_as_float(__builtin_amdgcn_mov_dpp(__float_as_int(v), 0xAA, 0xF, 0xF, false)),
                        v3 = __int_as_float(__builtin_amdgcn_mov_dpp(__float_as_int(v), 0xFF, 0xF, 0xF, false));
            int p = __builtin_amdgcn_cvt_pk_fp8_f32(v, v1, 0, false); p = __builtin_amdgcn_cvt_pk_fp8_f32(v2, v3, p, true);
            if ((r32 & 3) == 0) *(unsigned*)(Ow + orow * LD + d0 * 32) = (unsigned)p; } }
    __syncthreads();
#undef RESC
#undef KBASE
#undef LDMASK
#undef INIT
#undef SEAM_K0
#undef HALF_STEP
}
#undef ROWU
#undef VMW
#undef VMWN
#undef SLOAD_H
#undef SWRITE_HK
#undef SWRITE_HV
#undef SWRITE_H
#undef KSWZ
#undef SBAR
}

__device__ __forceinline__ dsa::BlockRef dsa_ref(const Frame& F, int bh, int qb) {
    const int b = bh >> 4, h = bh & 15;
    dsa::BlockRef r;
    r.Q = F.slot(4) + ((size_t)b * 2048 + (size_t)qb * 256) * 2048 + h * 128;
    r.O = (unsigned char*)F.slot(5) + ((size_t)b * 2048 + (size_t)qb * 256) * 2048 + h * 128;
    r.K = F.slot(1) + (size_t)b * 2048 * 2048 + h * 128; r.V = F.slot(2) + (size_t)b * 2048 * 2048 + h * 128;
    r.M = (const unsigned*)(F.ws + WS_MASK) + ((size_t)b * 2048 + (size_t)qb * 256) * 64;
    r.P0 = qb * 256; r.h = h;
    return r;
}
__device__ __forceinline__ void ph6_attn(const Frame& F) {
    const Args& a = *F.a;
    char* lds = (char*)F.lds;
    {
        float* bt = (float*)(lds + dsa::OFF_BIAS);
        for (int i = F.wave * 64 + F.lane(); i < 16 * 128; i += 512) { const int h = i >> 7, d = i & 127; bt[i] = (a.in[10][t5_bucket(d) * 16 + h] - a.in[10][31 * 16 + h]) * (1.0f / dsa::SCALE); }
    }
    __syncthreads();
    const int total = 4 * 128;
    int L = F.bid; if (L >= total) return;
#define ATT_BH(L_) (((L_) & 7) * 16 + (((((L_) & 255) >> 3) + 32 * ((L_) >> 8)) >> 2))
#define ATT_PR(L_) (((((L_) & 255) >> 3) + 32 * ((L_) >> 8)) & 3)
    int pass = 0;
    const bool xmap = (F.G == 256);
    dsa::BlockRef cur = dsa_ref(F, xmap ? ATT_BH(L) : (L >> 2), xmap ? ATT_PR(L) : (L & 3));
    dsa::Seam S;
    dsa::prime(cur, lds, S, F.wave);
    for (;;) {
        const bool more_pass = pass == 0, more_item = L + F.G < total, last = !more_pass && !more_item;
        int passn = pass + 1, Ln = L;
        if (!more_pass) { passn = 0; Ln = more_item ? L + F.G : L; }
        const int bhn = xmap ? ATT_BH(Ln) : (Ln >> 2), prn = xmap ? ATT_PR(Ln) : (Ln & 3);
        const dsa::BlockRef nxt = last ? cur : dsa_ref(F, bhn, passn ? 7 - prn : prn);
        dsa::block(cur, nxt, lds, S, F.wave);
        if (last) break;
        cur = nxt; pass = passn; L = Ln;
    }
}

__device__ __forceinline__ void ln_row(float* zrow, const float* g, const float* bta, bf16* brow, int lane) {
    f32x4 v[8]; float s = 0.f;
#pragma unroll
    for (int i = 0; i < 8; ++i) { v[i] = *(const f32x4*)(zrow + 256 * i + 4 * lane); s += (v[i].x + v[i].y) + (v[i].z + v[i].w); }
    const float mu = wave_sum(s) * (1.0f / 2048.0f); float s2 = 0.f;
#pragma unroll
    for (int i = 0; i < 8; ++i) { v[i] = v[i] - mu; s2 += (v[i].x * v[i].x + v[i].y * v[i].y) + (v[i].z * v[i].z + v[i].w * v[i].w); }
    const float r = rsqrtf(wave_sum(s2) * (1.0f / 2048.0f) + 1e-5f);
#pragma unroll
    for (int i = 0; i < 8; ++i) { const f32x4 gg = *(const f32x4*)(g + 256 * i + 4 * lane), bb = *(const f32x4*)(bta + 256 * i + 4 * lane);
        const f32x4 o = v[i] * r * gg + bb; *(f32x4*)(zrow + 256 * i + 4 * lane) = o;
        if (brow) { u32x2 w; w.x = pk2(o.x, o.y); w.y = pk2(o.z, o.w); *(u32x2*)(brow + 256 * i + 4 * lane) = w; } }
}
__device__ __forceinline__ void ph_ln(const Frame& F, const float* g, const float* bta, bf16* bout) {
    const int gw = F.bid * 8 + F.wave, NGW = F.G * 8, lane = F.lane();
    for (int row = gw; row < T; row += NGW) ln_row(F.a->out + (size_t)row * 2048, g, bta, bout + (size_t)row * 2048, lane);
}

__device__ __forceinline__ float pk_idx(float v, unsigned code, unsigned mask) { return __uint_as_float((__float_as_uint(v) & ~mask) | code); }
__device__ __forceinline__ void ph_peer_select(const Frame& F) {
    const Args& a = *F.a;
    const int lane = F.lane(), l31 = lane & 31, half = lane >> 5;
    const float* PQ1 = (const float*)F.slot(1); const float* PQ2 = (const float*)F.slot(2); const float* keys = a.in[23];
    int* EIDX = (int*)(F.ws + WS_CKV); float* EG = (float*)(F.ws + WS_IKW);
    const float NEG = -__builtin_inff();
    const bool gmap = false;
    const int h = gmap ? ((F.bid >> 3) & 7) : (F.bid & 7), ntw = F.G >> 3;
    { const int tid = F.wave * 64 + lane;
#pragma unroll
      for (int p = 0; p < 2; ++p)
#pragma unroll
          for (int i = 0; i < 8; ++i) { const int idx = tid + 512 * i, row = idx >> 5, c4 = idx & 31;
              *(f32x4*)(F.lds + (size_t)p * 67584 + ((size_t)row * 132 + 4 * c4) * 4) = *(const f32x4*)(keys + ((size_t)(2 * h + p) * 128 + row) * 128 + 4 * c4); }
      __syncthreads(); }
    for (int tile = gmap ? ((F.bid & 7) * 64 + (F.bid >> 6) * 16 + F.wave) : ((F.bid >> 3) + ntw * F.wave), tend = gmap ? ((F.bid & 7) * 64 + (F.bid >> 6) * 16 + 16) : (T / 32); tile < tend; tile += gmap ? 8 : ntw * 8) {
        const int t = tile * 32 + l31;
        float tv[2][16];
#pragma unroll
        for (int p = 0; p < 2; ++p) {
            const int g = 2 * h + p;
            float qv[64];
            { const float* qp = (g < 8 ? PQ1 : PQ2) + (size_t)t * 1024 + (g & 7) * 128 + 64 * half;
#pragma unroll
              for (int j = 0; j < 16; ++j) { const f32x4 v = *(const f32x4*)(qp + 4 * j); qv[4 * j] = v.x; qv[4 * j + 1] = v.y; qv[4 * j + 2] = v.z; qv[4 * j + 3] = v.w; } }
            f32x16 acc[4];
#pragma unroll
            for (int mt = 0; mt < 4; ++mt)
#pragma unroll
                for (int r = 0; r < 16; ++r) acc[mt][r] = 0.f;
            const float* kp0 = (const float*)(F.lds + (size_t)p * 67584) + ((size_t)l31 * 132 + 64 * half);
            f32x4 kb[3][4];
#define PK_LOADC(cc) do { _Pragma("unroll") for (int u_ = 0; u_ < 4; ++u_) kb[(cc) % 3][u_] = *(const f32x4*)(kp0 + (size_t)((cc) >> 2) * 32 * 132 + 16 * ((cc) & 3) + 4 * u_); } while (0)
#define PK_MMAC(cc) do { _Pragma("unroll") for (int u_ = 0; u_ < 4; ++u_) { const f32x4 kv_ = kb[(cc) % 3][u_]; const int j_ = 4 * ((cc) & 3) + u_; \
                acc[(cc) >> 2] = __builtin_amdgcn_mfma_f32_32x32x2f32(kv_.x, qv[4 * j_], acc[(cc) >> 2], 0, 0, 0); acc[(cc) >> 2] = __builtin_amdgcn_mfma_f32_32x32x2f32(kv_.y, qv[4 * j_ + 1], acc[(cc) >> 2], 0, 0, 0); \
                acc[(cc) >> 2] = __builtin_amdgcn_mfma_f32_32x32x2f32(kv_.z, qv[4 * j_ + 2], acc[(cc) >> 2], 0, 0, 0); acc[(cc) >> 2] = __builtin_amdgcn_mfma_f32_32x32x2f32(kv_.w, qv[4 * j_ + 3], acc[(cc) >> 2], 0, 0, 0); } } while (0)
            PK_LOADC(0); PK_LOADC(1);
            PK_LOADC(2); PK_MMAC(0); __builtin_amdgcn_sched_barrier(0);
            PK_LOADC(3); PK_MMAC(1); __builtin_amdgcn_sched_barrier(0);
            PK_LOADC(4); PK_MMAC(2); __builtin_amdgcn_sched_barrier(0);
            PK_LOADC(5); PK_MMAC(3); __builtin_amdgcn_sched_barrier(0);
            PK_LOADC(6); PK_MMAC(4); __builtin_amdgcn_sched_barrier(0);
            PK_LOADC(7); PK_MMAC(5); __builtin_amdgcn_sched_barrier(0);
            PK_LOADC(8); PK_MMAC(6); __builtin_amdgcn_sched_barrier(0);
            PK_LOADC(9); PK_MMAC(7); __builtin_amdgcn_sched_barrier(0);
            PK_LOADC(10); PK_MMAC(8); __builtin_amdgcn_sched_barrier(0);
            PK_LOADC(11); PK_MMAC(9); __builtin_amdgcn_sched_barrier(0);
            PK_LOADC(12); PK_MMAC(10); __builtin_amdgcn_sched_barrier(0);
            PK_LOADC(13); PK_MMAC(11); __builtin_amdgcn_sched_barrier(0);
            PK_LOADC(14); PK_MMAC(12); __builtin_amdgcn_sched_barrier(0);
            PK_LOADC(15); PK_MMAC(13); __builtin_amdgcn_sched_barrier(0);
            PK_MMAC(14); __builtin_amdgcn_sched_barrier(0);
            PK_MMAC(15); __builtin_amdgcn_sched_barrier(0);
#undef PK_LOADC
#undef PK_MMAC
            unsigned hmask = ~(4u * (unsigned)half); asm volatile("" : "+v"(hmask));
#pragma unroll
            for (int mt = 0; mt < 4; ++mt)
#pragma unroll
                for (int r = 0; r < 16; ++r) acc[mt][r] = __uint_as_float(((__float_as_uint(acc[mt][r]) & ~127u) | (unsigned)(127 - (32 * mt + (r & 3) + 8 * (r >> 2)))) & hmask);
#pragma unroll
            for (int k = 0; k < 16; ++k) {
                float m = acc[0][0];
#pragma unroll
                for (int mt = 0; mt < 4; ++mt)
#pragma unroll
                    for (int r = 0; r < 16; ++r) m = fmaxf(m, acc[mt][r]);
                m = fmaxf(m, __shfl_xor(m, 32));
                tv[p][k] = m;
#pragma unroll
                for (int mt = 0; mt < 4; ++mt)
#pragma unroll
                    for (int r = 0; r < 16; ++r) acc[mt][r] = (acc[mt][r] == m) ? NEG : acc[mt][r];
            }
        }
        float cand[25]; int cid[25];
        unsigned hc = 25u * (unsigned)half; asm volatile("" : "+v"(hc));
        { const float ai = half ? tv[0][2] : tv[0][0], bj = half ? tv[1][1] : tv[1][0];
          cand[0] = pk_idx(ai + bj, (unsigned)(63 - 0) - hc, 63u); cid[0] = (int)((127u - (__float_as_uint(ai) & 127u)) * 128u + (127u - (__float_as_uint(bj) & 127u))); }
        { const float ai = half ? tv[0][2] : tv[0][0], bj = half ? tv[1][2] : tv[1][1];
          cand[1] = pk_idx(ai + bj, (unsigned)(63 - 1) - hc, 63u); cid[1] = (int)((127u - (__float_as_uint(ai) & 127u)) * 128u + (127u - (__float_as_uint(bj) & 127u))); }
        { const float ai = half ? tv[0][2] : tv[0][0], bj = half ? tv[1][3] : tv[1][2];
          cand[2] = pk_idx(ai + bj, (unsigned)(63 - 2) - hc, 63u); cid[2] = (int)((127u - (__float_as_uint(ai) & 127u)) * 128u + (127u - (__float_as_uint(bj) & 127u))); }
        { const float ai = half ? tv[0][2] : tv[0][0], bj = half ? tv[1][4] : tv[1][3];
          cand[3] = pk_idx(ai + bj, (unsigned)(63 - 3) - hc, 63u); cid[3] = (int)((127u - (__float_as_uint(ai) & 127u)) * 128u + (127u - (__float_as_uint(bj) & 127u))); }
        { const float ai = half ? tv[0][3] : tv[0][0], bj = half ? tv[1][0] : tv[1][4];
          cand[4] = pk_idx(ai + bj, (unsigned)(63 - 4) - hc, 63u); cid[4] = (int)((127u - (__float_as_uint(ai) & 127u)) * 128u + (127u - (__float_as_uint(bj) & 127u))); }
        { const float ai = half ? tv[0][3] : tv[0][0], bj = half ? tv[1][1] : tv[1][5];
          cand[5] = pk_idx(ai + bj, (unsigned)(63 - 5) - hc, 63u); cid[5] = (int)((127u - (__float_as_uint(ai) & 127u)) * 128u + (127u - (__float_as_uint(bj) & 127u))); }
        { const float ai = half ? tv[0][3] : tv[0][0], bj = half ? tv[1][2] : tv[1][6];
          cand[6] = pk_idx(ai + bj, (unsigned)(63 - 6) - hc, 63u); cid[6] = (int)((127u - (__float_as_uint(ai) & 127u)) * 128u + (127u - (__float_as_uint(bj) & 127u))); }
        { const float ai = half ? tv[0][3] : tv[0][0], bj = half ? tv[1][3] : tv[1][7];
          cand[7] = pk_idx(ai + bj, (unsigned)(63 - 7) - hc, 63u); cid[7] = (int)((127u - (__float_as_uint(ai) & 127u)) * 128u + (127u - (__float_as_uint(bj) & 127u))); }
        { const float ai = half ? tv[0][4] : tv[0][0], bj = half ? tv[1][0] : tv[1][8];
          cand[8] = pk_idx(ai + bj, (unsigned)(63 - 8) - hc, 63u); cid[8] = (int)((127u - (__float_as_uint(ai) & 127u)) * 128u + (127u - (__float_as_uint(bj) & 127u))); }
        { const float ai = half ? tv[0][4] : tv[0][0], bj = half ? tv[1][1] : tv[1][9];
          cand[9] = pk_idx(ai + bj, (unsigned)(63 - 9) - hc, 63u); cid[9] = (int)((127u - (__float_as_uint(ai) & 127u)) * 128u + (127u - (__float_as_uint(bj) & 127u))); }
        { const float ai = half ? tv[0][4] : tv[0][0], bj = half ? tv[1][2] : tv[1][10];
          cand[10] = pk_idx(ai + bj, (unsigned)(63 - 10) - hc, 63u); cid[10] = (int)((127u - (__float_as_uint(ai) & 127u)) * 128u + (127u - (__float_as_uint(bj) & 127u))); }
        { const float ai = half ? tv[0][5] : tv[0][0], bj = half ? tv[1][0] : tv[1][11];
          cand[11] = pk_idx(ai + bj, (unsigned)(63 - 11) - hc, 63u); cid[11] = (int)((127u - (__float_as_uint(ai) & 127u)) * 128u + (127u - (__float_as_uint(bj) & 127u))); }
        { const float ai = half ? tv[0][5] : tv[0][0], bj = half ? tv[1][1] : tv[1][12];
          cand[12] = pk_idx(ai + bj, (unsigned)(63 - 12) - hc, 63u); cid[12] = (int)((127u - (__float_as_uint(ai) & 127u)) * 128u + (127u - (__float_as_uint(bj) & 127u))); }
        { const float ai = half ? tv[0][6] : tv[0][0], bj = half ? tv[1][0] : tv[1][13];
          cand[13] = pk_idx(ai + bj, (unsigned)(63 - 13) - hc, 63u); cid[13] = (int)((127u - (__float_as_uint(ai) & 127u)) * 128u + (127u - (__float_as_uint(bj) & 127u))); }
        { const float ai = half ? tv[0][6] : tv[0][0], bj = half ? tv[1][1] : tv[1][14];
          cand[14] = pk_idx(ai + bj, (unsigned)(63 - 14) - hc, 63u); cid[14] = (int)((127u - (__float_as_uint(ai) & 127u)) * 128u + (127u - (__float_as_uint(bj) & 127u))); }
        { const float ai = half ? tv[0][7] : tv[0][0], bj = half ? tv[1][0] : tv[1][15];
          cand[15] = pk_idx(ai + bj, (unsigned)(63 - 15) - hc, 63u); cid[15] = (int)((127u - (__float_as_uint(ai) & 127u)) * 128u + (127u - (__float_as_uint(bj) & 127u))); }
        { const float ai = half ? tv[0][7] : tv[0][1], bj = half ? tv[1][1] : tv[1][0];
          cand[16] = pk_idx(ai + bj, (unsigned)(63 - 16) - hc, 63u); cid[16] = (int)((127u - (__float_as_uint(ai) & 127u)) * 128u + (127u - (__float_as_uint(bj) & 127u))); }
        { const float ai = half ? tv[0][8] : tv[0][1], bj = half ? tv[1][0] : tv[1][1];
          cand[17] = pk_idx(ai + bj, (unsigned)(63 - 17) - hc, 63u); cid[17] = (int)((127u - (__float_as_uint(ai) & 127u)) * 128u + (127u - (__float_as_uint(bj) & 127u))); }
        { const float ai = half ? tv[0][9] : tv[0][1], bj = half ? tv[1][0] : tv[1][2];
          cand[18] = pk_idx(ai + bj, (unsigned)(63 - 18) - hc, 63u); cid[18] = (int)((127u - (__float_as_uint(ai) & 127u)) * 128u + (127u - (__float_as_uint(bj) & 127u))); }
        { const float ai = half ? tv[0][10] : tv[0][1], bj = half ? tv[1][0] : tv[1][3];
          cand[19] = pk_idx(ai + bj, (unsigned)(63 - 19) - hc, 63u); cid[19] = (int)((127u - (__float_as_uint(ai) & 127u)) * 128u + (127u - (__float_as_uint(bj) & 127u))); }
        { const float ai = half ? tv[0][11] : tv[0][1], bj = half ? tv[1][0] : tv[1][4];
          cand[20] = pk_idx(ai + bj, (unsigned)(63 - 20) - hc, 63u); cid[20] = (int)((127u - (__float_as_uint(ai) & 127u)) * 128u + (127u - (__float_as_uint(bj) & 127u))); }
        { const float ai = half ? tv[0][12] : tv[0][1], bj = half ? tv[1][0] : tv[1][5];
          cand[21] = pk_idx(ai + bj, (unsigned)(63 - 21) - hc, 63u); cid[21] = (int)((127u - (__float_as_uint(ai) & 127u)) * 128u + (127u - (__float_as_uint(bj) & 127u))); }
        { const float ai = half ? tv[0][13] : tv[0][1], bj = half ? tv[1][0] : tv[1][6];
          cand[22] = pk_idx(ai + bj, (unsigned)(63 - 22) - hc, 63u); cid[22] = (int)((127u - (__float_as_uint(ai) & 127u)) * 128u + (127u - (__float_as_uint(bj) & 127u))); }
        { const float ai = half ? tv[0][14] : tv[0][1], bj = half ? tv[1][0] : tv[1][7];
          cand[23] = pk_idx(ai + bj, (unsigned)(63 - 23) - hc, 63u); cid[23] = (int)((127u - (__float_as_uint(ai) & 127u)) * 128u + (127u - (__float_as_uint(bj) & 127u))); }
        { const float ai = half ? tv[0][15] : tv[0][2], bj = half ? tv[1][0] : tv[1][0];
          cand[24] = pk_idx(ai + bj, (unsigned)(63 - 24) - hc, 63u); cid[24] = (int)((127u - (__float_as_uint(ai) & 127u)) * 128u + (127u - (__float_as_uint(bj) & 127u))); }
        float sv[16]; int sid[16];
#pragma unroll
        for (int k = 0; k < 16; ++k) {
            float m = cand[0];
#pragma unroll
            for (int c = 1; c < 25; ++c) m = fmaxf(m, cand[c]);
            const float mo = __shfl_xor(m, 32);
            const bool mine = (m > mo) || (m == mo && half == 0);
            const float mm = fmaxf(m, mo);
            int id = -1;
#pragma unroll
            for (int c = 0; c < 25; ++c) { const bool hit = mine && (cand[c] == mm); id = hit ? cid[c] : id; cand[c] = hit ? NEG : cand[c]; }
            const int ido = __shfl_xor(id, 32);
            sv[k] = mm; sid[k] = id > ido ? id : ido;
        }
        float den = 0.f; float ev[16];
#pragma unroll
        for (int k = 0; k < 16; ++k) { ev[k] = expf(sv[k] - sv[0]); den += ev[k]; }
        const float inv = 1.0f / den;
        if (half == 0) { int* ep = EIDX + (size_t)t * 128 + h * 16;
#pragma unroll
            for (int k = 0; k < 16; k += 4) *(u32x4*)(ep + k) = (u32x4){(unsigned)sid[k], (unsigned)sid[k + 1], (unsigned)sid[k + 2], (unsigned)sid[k + 3]}; }
        else { float* gp = EG + (size_t)t * 128 + h * 16;
#pragma unroll
            for (int k = 0; k < 16; k += 4) *(f32x4*)(gp + k) = (f32x4){ev[k] * inv, ev[k + 1] * inv, ev[k + 2] * inv, ev[k + 3] * inv}; }
    }
}

typedef int v8i __attribute__((ext_vector_type(8)));
constexpr float HS = 8.0f;
constexpr size_t PEER_SC_OFF = 32 * MiB;
#define RL(v, l) __builtin_amdgcn_readlane((v), (l))
__device__ __forceinline__ float erf_as(float x) {
    const float ax = fabsf(x), tt = __builtin_amdgcn_rcpf(1.0f + 0.3275911f * ax);
    const float p = tt * (0.254829592f + tt * (-0.284496736f + tt * (1.421413741f + tt * (-1.453152027f + tt * 1.061405429f))));
    const float r = 1.0f - p * __expf(-ax * ax);
    return copysignf(r, x);
}
#define FP4_ENC(w, a, b, sel) w = __builtin_amdgcn_cvt_scalef32_pk_fp4_f32(w, (a), (b), 1.0f, sel)
__device__ __forceinline__ void cvt_fp4_stream(const Frame& F, const float* src, unsigned char* dst, float* sc, size_t nrows, int wg, int nwg) {
    const int lane = F.lane();
    float* tile = (float*)(F.lds + F.wave * 8192);
    const size_t r0 = (size_t)wg * 8 + F.wave, rstep = (size_t)nwg * 8;
    f32x4 nx[8];
    if (r0 < nrows) {
#pragma unroll
        for (int j = 0; j < 8; ++j) nx[j] = *(const f32x4*)(src + r0 * 2048 + 256 * j + 4 * lane);
    }
    for (size_t r = r0; r < nrows; r += rstep) {
#pragma unroll
        for (int j = 0; j < 8; ++j) *(f32x4*)(tile + 256 * j + 4 * lane) = nx[j];
        const size_t rn = (r + rstep < nrows) ? r + rstep : r;
#pragma unroll
        for (int j = 0; j < 8; ++j) nx[j] = *(const f32x4*)(src + rn * 2048 + 256 * j + 4 * lane);
        WAVE_SYNC();
        f32x4 q[8];
#pragma unroll
        for (int j = 0; j < 8; ++j) q[j] = *(const f32x4*)(tile + 32 * lane + 4 * j);
        WAVE_SYNC();
        float m = 0.f;
#pragma unroll
        for (int j = 0; j < 8; ++j) m = fmaxf(fmaxf(m, fmaxf(fabsf(q[j].x), fabsf(q[j].y))), fmaxf(fabsf(q[j].z), fabsf(q[j].w)));
        m = wave_max(m);
        const float inv = m > 0.f ? 6.0f / m : 0.f;
#pragma unroll
        for (int j = 0; j < 8; ++j) q[j] = q[j] * inv;
        unsigned w0 = 0u, w1 = 0u, w2 = 0u, w3 = 0u;
        FP4_ENC(w0, q[0].x, q[0].y, 0); FP4_ENC(w0, q[0].z, q[0].w, 1); FP4_ENC(w0, q[1].x, q[1].y, 2); FP4_ENC(w0, q[1].z, q[1].w, 3);
        FP4_ENC(w1, q[2].x, q[2].y, 0); FP4_ENC(w1, q[2].z, q[2].w, 1); FP4_ENC(w1, q[3].x, q[3].y, 2); FP4_ENC(w1, q[3].z, q[3].w, 3);
        FP4_ENC(w2, q[4].x, q[4].y, 0); FP4_ENC(w2, q[4].z, q[4].w, 1); FP4_ENC(w2, q[5].x, q[5].y, 2); FP4_ENC(w2, q[5].z, q[5].w, 3);
        FP4_ENC(w3, q[6].x, q[6].y, 0); FP4_ENC(w3, q[6].z, q[6].w, 1); FP4_ENC(w3, q[7].x, q[7].y, 2); FP4_ENC(w3, q[7].z, q[7].w, 3);
        *(u32x4*)(dst + r * 2048 + 16 * lane) = (u32x4){w0, w1, w2, w3};
        if (lane == 0) sc[2 * r] = m * (1.0f / 6.0f);
    }
}
#define EX_LOAD_XF() do { float mu_, rs_; row_mu_rstd((const float*)(F.ws + WS_CTL + CTL_ST2), t, mu_, rs_); \
          const bf16* zr = F.slot(0) + (size_t)t * 2048 + lq; \
          _Pragma("unroll") for (int q = 0; q < 4; ++q) { const int col = lq + 8 * q; f32x4 z0, z1; unpack8v(*(const u32x4*)(zr + 8 * q), z0, z1); \
              const f32x4 g0v = *(const f32x4*)(a.in[20] + col), g1v = *(const f32x4*)(a.in[20] + col + 4), b0v = *(const f32x4*)(a.in[21] + col), b1v = *(const f32x4*)(a.in[21] + col + 4); \
              const f32x4 h0 = (z0 - mu_) * rs_ * g0v + b0v, h1 = (z1 - mu_) * rs_ * g1v + b1v; \
              xf[8 * q] = h0.x; xf[8 * q + 1] = h0.y; xf[8 * q + 2] = h0.z; xf[8 * q + 3] = h0.w; xf[8 * q + 4] = h1.x; xf[8 * q + 5] = h1.y; xf[8 * q + 6] = h1.z; xf[8 * q + 7] = h1.w; } } while (0)
#define EX_A_PITCH 1040
#define EX_A_DMA(g) do { const int gg_ = (g); const int idv_ = gg_ < 4 ? id0 : (gg_ < 8 ? id1 : idn0); _Pragma("unroll") for (int j_ = 0; j_ < 16; ++j_) { const int rid_ = RL(idv_, 16 * (gg_ & 3) + j_); \
        __builtin_amdgcn_global_load_lds((const unsigned*)(PUV + (size_t)rid_ * 2048 + voff), (__attribute__((address_space(3))) unsigned*)(abuf + j_ * EX_A_PITCH), 16, 0, 0); } } while (0)
#define EX_V_LOAD(buf, g, j) do { const int gg_ = (g); const int idv_ = gg_ < 4 ? id0 : (gg_ < 8 ? id1 : idn0); const int rid_ = RL(idv_, 16 * (gg_ & 3) + (j)); const unsigned char* vp_ = PUV + (size_t)rid_ * 2048 + voff; \
        asm volatile("global_load_dwordx4 %0, %1, off offset:1024" : "=v"(buf) : "v"(vp_) : "memory"); } while (0)
#define EX_NV 4
#define EX_STR2(n) #n
#define EX_STR(n) EX_STR2(n)
#define EX_V_WAIT(buf, n) asm volatile("s_waitcnt vmcnt(%1)" : "+v"(buf) : "n"(n) : "memory")
#define EX_WAITN(n) asm volatile("s_waitcnt vmcnt(%0)" :: "n"(n) : "memory")
#define EX_V_B(wd, k, sel) do { const f32x2v d_ = __builtin_amdgcn_cvt_scalef32_pk_f32_fp4((wd), 1.0f, sel); y2[(k) >> 1] = __builtin_elementwise_fma(d_, cf2_, y2[(k) >> 1]); } while (0)
#define EX_V_W(wd, k) do { EX_V_B(wd, k, 0); EX_V_B(wd, (k) + 2, 1); EX_V_B(wd, (k) + 4, 2); EX_V_B(wd, (k) + 6, 3); } while (0)
#define EX_V_USE(buf, j) do { const float cf_ = __int_as_float(RL(__float_as_int(cfv[(j) & 3]), 16 * ((j) >> 2))); const f32x2v cf2_ = (f32x2v){cf_, cf_}; EX_V_W(buf.x, 0); EX_V_W(buf.y, 8); EX_V_W(buf.z, 16); EX_V_W(buf.w, 24); } while (0)
#define EX_PIN_Y() do { asm volatile("" : "+v"(y2[0]), "+v"(y2[1]), "+v"(y2[2]), "+v"(y2[3]), "+v"(y2[4]), "+v"(y2[5]), "+v"(y2[6]), "+v"(y2[7]), "+v"(y2[8]), "+v"(y2[9]), "+v"(y2[10]), "+v"(y2[11]), "+v"(y2[12]), "+v"(y2[13]), "+v"(y2[14]), "+v"(y2[15])); } while (0)
__device__ __forceinline__ void ph16_experts(const Frame& F) {
    const Args& a = *F.a;
    const int gw = F.bid * 8 + F.wave, NGW = F.G * 8, lane0 = F.lane();
    const int* EIDX = (const int*)(F.ws + WS_CKV); const float* EG = (const float*)(F.ws + WS_IKW);
    const unsigned char* PUV = (const unsigned char*)(F.ws + WS_WIN);
    const f32x2v* SC = (const f32x2v*)(F.ws + WS_WIN + PEER_SC_OFF);
    unsigned char* hb = F.lds + F.wave * 2048;
    unsigned char* abuf = F.lds + 16384 + F.wave * (16 * EX_A_PITCH);
    u32x4 vb[EX_NV];
    int nid0 = EIDX[(size_t)gw * 128 + lane0], nid1 = EIDX[(size_t)gw * 128 + 64 + lane0];
    { const int id0 = nid0, id1 = nid1, idn0 = nid0; const unsigned voff = 16u * (unsigned)lane0;
      EX_A_DMA(0);
#pragma unroll
      for (int j = 0; j < EX_NV; ++j) EX_V_LOAD(vb[j], 0, j); }
    for (int k8 = 0; k8 < T / NGW; ++k8) {
        const int t = gw + NGW * k8;
        int lane_l = lane0; asm volatile("" : "+v"(lane_l)); const int lane = lane_l;
        float* xrow = a.out + (size_t)t * 2048;
        const int lq = 32 * lane;
        const int i16 = lane & 15, q4 = lane >> 4; const unsigned aoff = 16u * (unsigned)q4, voff = 16u * (unsigned)lane;
        {
            float xf[32];
            EX_LOAD_XF();
            unsigned w[8];
#pragma unroll
            for (int i = 0; i < 8; ++i) { int p = __builtin_amdgcn_cvt_pk_fp8_f32(xf[4 * i] * HS, xf[4 * i + 1] * HS, 0, false); p = __builtin_amdgcn_cvt_pk_fp8_f32(xf[4 * i + 2] * HS, xf[4 * i + 3] * HS, p, true); w[i] = (unsigned)p; }
            *(u32x4*)(hb + 32 * lane) = (u32x4){w[0], w[1], w[2], w[3]}; *(u32x4*)(hb + 32 * lane + 16) = (u32x4){w[4], w[5], w[6], w[7]};
        }
        __builtin_amdgcn_sched_barrier(0);
        const int id0 = nid0, id1 = nid1;
        { const int tn = (k8 + 1 < T / NGW) ? t + NGW : t; nid0 = EIDX[(size_t)tn * 128 + lane]; nid1 = EIDX[(size_t)tn * 128 + 64 + lane]; }
        const int idn0 = nid0;
        const float g0 = EG[(size_t)t * 128 + lane], g1 = EG[(size_t)t * 128 + 64 + lane];
        const f32x2v s0 = SC[id0], s1 = SC[id1];
        const float su0 = s0.x * (1.0f / HS), su1 = s1.x * (1.0f / HS), gs0 = g0 * s0.y, gs1 = g1 * s1.y;
        f32x2v y2[16];
#pragma unroll
        for (int j = 0; j < 16; ++j) y2[j] = (f32x2v){0.f, 0.f};
        WAVE_SYNC();
#pragma unroll 1
        for (int g = 0; g < 8; ++g) {
            f32x4 acc0 = (f32x4){0.f, 0.f, 0.f, 0.f}, acc1 = (f32x4){0.f, 0.f, 0.f, 0.f};
            const unsigned char* hq = hb + 16 * q4;
            const unsigned char* aq = abuf + i16 * EX_A_PITCH + 16 * q4;
            EX_WAITN(EX_NV);
            u32x4 b0 = *(const u32x4*)(hq), b1 = *(const u32x4*)(hq + 64), b2 = *(const u32x4*)(hq + 128), b3 = *(const u32x4*)(hq + 192), a0 = *(const u32x4*)(aq), a1 = *(const u32x4*)(aq + 64);
#pragma unroll
            for (int s = 0; s < 16; s += 2) {
                u32x4 n0, n1, n2, n3, m0, m1;
                if (s + 2 < 16) { n0 = *(const u32x4*)(hq + 128 * (s + 2)); n1 = *(const u32x4*)(hq + 128 * (s + 2) + 64); n2 = *(const u32x4*)(hq + 128 * (s + 3)); n3 = *(const u32x4*)(hq + 128 * (s + 3) + 64);
                                  m0 = *(const u32x4*)(aq + 64 * (s + 2)); m1 = *(const u32x4*)(aq + 64 * (s + 3)); }
                acc0 = __builtin_amdgcn_mfma_scale_f32_16x16x128_f8f6f4((v8i){(int)a0.x, (int)a0.y, (int)a0.z, (int)a0.w, 0, 0, 0, 0}, (v8i){(int)b0.x, (int)b0.y, (int)b0.z, (int)b0.w, (int)b1.x, (int)b1.y, (int)b1.z, (int)b1.w}, acc0, 4, 0, 0, 127, 0, 127);
                acc1 = __builtin_amdgcn_mfma_scale_f32_16x16x128_f8f6f4((v8i){(int)a1.x, (int)a1.y, (int)a1.z, (int)a1.w, 0, 0, 0, 0}, (v8i){(int)b2.x, (int)b2.y, (int)b2.z, (int)b2.w, (int)b3.x, (int)b3.y, (int)b3.z, (int)b3.w}, acc1, 4, 0, 0, 127, 0, 127);
                __builtin_amdgcn_sched_barrier(0);
                if (s + 2 < 16) { b0 = n0; b1 = n1; b2 = n2; b3 = n3; a0 = m0; a1 = m1; }
            }
            __builtin_amdgcn_sched_barrier(0);
            const int gn = g + 1;
            EX_A_DMA(gn);
            float cfv[4];
            { const int sv = g < 4 ? __float_as_int(su0) : __float_as_int(su1), gv = g < 4 ? __float_as_int(gs0) : __float_as_int(gs1);
              const f32x4 acc = acc0 + acc1;
#pragma unroll
              for (int r = 0; r < 4; ++r) { const int sl = (16 * (g & 3) + 4 * q4 + r) << 2;
                  const float pre = acc[r] * __int_as_float(__builtin_amdgcn_ds_bpermute(sl, sv)); const float hv = 0.5f * pre * (1.0f + erf_as(pre * 0.7071067811865476f));
                  cfv[r] = __int_as_float(__builtin_amdgcn_ds_bpermute(sl, gv)) * hv; } }
            __builtin_amdgcn_sched_barrier(0);
#pragma unroll
            for (int j = 0; j < 16; ++j) {
                if (j < EX_NV) EX_V_WAIT(vb[j % EX_NV], EX_NV + 15); else EX_V_WAIT(vb[j % EX_NV], EX_NV - 1);
                EX_V_USE(vb[j % EX_NV], j);
                if (j + EX_NV < 16) EX_V_LOAD(vb[j % EX_NV], g, j + EX_NV); else EX_V_LOAD(vb[j % EX_NV], gn, j + EX_NV - 16);
                EX_PIN_Y();
                __builtin_amdgcn_sched_barrier(0);
            }
        }
        asm volatile("s_waitcnt vmcnt(0)" ::: "memory");
        __builtin_amdgcn_sched_barrier(0);
        float s = 0.f; float y[32];
        { float xf[32];
          EX_LOAD_XF();
#pragma unroll
          for (int j = 0; j < 32; ++j) { y[j] = y2[j >> 1][j & 1] + ALPHA * xf[j]; s += y[j]; } }
        const float mu = wave_sum_dpp(s) * (1.0f / 2048.0f); float s2 = 0.f;
#pragma unroll
        for (int j = 0; j < 32; ++j) { y[j] -= mu; s2 += y[j] * y[j]; }
        const float rs = rsqrtf(wave_sum_dpp(s2) * (1.0f / 2048.0f) + 1e-5f);
        const int lofs = lq;
#pragma unroll
        for (int q = 0; q < 8; ++q) { const int col = lofs + 4 * q;
            const f32x4 ga = *(const f32x4*)(a.in[26] + col), ba = *(const f32x4*)(a.in[27] + col);
            f32x4 o; o.x = y[4 * q] * rs * ga.x + ba.x; o.y = y[4 * q + 1] * rs * ga.y + ba.y; o.z = y[4 * q + 2] * rs * ga.z + ba.z; o.w = y[4 * q + 3] * rs * ga.w + ba.w;
            *(f32x4*)(xrow + col) = o; }
    }
}

#define XB_TMO      128
#define XB_XCNT(j)  (256  + 64 * (j))
#define XB_XSUB(j)  (1280 + 64 * (j))
#define XB_XGEN(j)  (2304 + 64 * (j))
#define XB_TOP      3328
#define XB_TOPGEN   3392
#define XCD_BAR_WORDS 3456
#define XB_SPIN_CAP (1u << 22)
__device__ __forceinline__ unsigned xb_ld(unsigned* p)              { return __hip_atomic_load(p, __ATOMIC_RELAXED, __HIP_MEMORY_SCOPE_AGENT); }
__device__ __forceinline__ unsigned xb_add(unsigned* p, unsigned v) { return __hip_atomic_fetch_add(p, v, __ATOMIC_RELAXED, __HIP_MEMORY_SCOPE_AGENT); }
__device__ __forceinline__ unsigned xb_xcc_id() { return (unsigned)__builtin_amdgcn_s_getreg((3 << 11) | 20) & 0xFu; }
#define XB_SPIN(cond, bar) do { unsigned _sp = 0; while (cond) { __builtin_amdgcn_s_sleep(1); \
    if ((++_sp & 255u) == 0u) { if (xb_ld(&(bar)[XB_TMO])) break; if (_sp > XB_SPIN_CAP) { atomicAdd(&(bar)[XB_TMO], 1u); break; } } } } while (0)
struct XcdBarrier { unsigned* bar; unsigned x; volatile unsigned* st; };
__device__ __forceinline__ void xcd_barrier_complete(unsigned* bar, unsigned x, unsigned G, unsigned& nloc, unsigned& nx) {
    unsigned sum, cnt, mine, sp = 0u;
    for (;;) {
        sum = 0u; cnt = 0u; mine = 0u;
#pragma unroll
        for (unsigned j = 0; j < 16; ++j) { const unsigned c = xb_ld(&bar[XB_XCNT(j)]); sum += c; cnt += (c > 0u) ? 1u : 0u; mine = (j == x) ? c : mine; }
        if (sum == G) break;
        __builtin_amdgcn_s_sleep(1);
        if ((++sp & 255u) == 0u) { if (xb_ld(&bar[XB_TMO])) break; if (sp > XB_SPIN_CAP) { atomicAdd(&bar[XB_TMO], 1u); break; } }
    }
    nloc = mine > 0u ? mine : 1u; nx = cnt > 0u ? cnt : 1u;
}
__device__ __forceinline__ void xcd_barrier(const XcdBarrier& b, bool leader, unsigned G) {
    asm volatile("s_waitcnt vmcnt(0)" ::: "memory");
    __syncthreads();
    if (leader) {
        unsigned* bar = b.bar;
        __builtin_amdgcn_s_waitcnt(0);
        unsigned nloc = b.st[0], nx = b.st[1];
        if (nloc == 0u) { xcd_barrier_complete(bar, b.x, G, nloc, nx); b.st[0] = nloc; b.st[1] = nx; }
        const unsigned old = xb_add(&bar[XB_XSUB(b.x)], 1u);
        const unsigned gen = old / nloc;
        if (old + 1u == (gen + 1u) * nloc) {
            __builtin_amdgcn_fence(__ATOMIC_RELEASE, "agent");
            asm volatile("s_waitcnt vmcnt(0)" ::: "memory");
            const unsigned og = xb_add(&bar[XB_TOP], 1u);
            const unsigned tg = og / nx;
            if (og + 1u == (tg + 1u) * nx) xb_add(&bar[XB_TOPGEN], 1u);
            else XB_SPIN(xb_ld(&bar[XB_TOPGEN]) == tg, bar);
            __builtin_amdgcn_fence(__ATOMIC_ACQUIRE, "agent");
            xb_add(&bar[XB_XGEN(b.x)], 1u);
            asm volatile("s_waitcnt vmcnt(0)" ::: "memory");
        } else {
            XB_SPIN(xb_ld(&bar[XB_XGEN(b.x)]) == gen, bar);
            __builtin_amdgcn_fence(__ATOMIC_ACQUIRE, "agent");
            asm volatile("s_waitcnt vmcnt(0)" ::: "memory");
        }
    }
    __syncthreads();
}

__device__ __forceinline__ void group_barrier(unsigned* ctr, unsigned target, bool leader) {
    asm volatile("s_waitcnt vmcnt(0)" ::: "memory");
    __syncthreads();
    if (leader) {
        (void)xb_add(ctr, 1u);
        unsigned sp = 0u; while (xb_ld(ctr) < target) { __builtin_amdgcn_s_sleep(1); if (++sp > XB_SPIN_CAP) break; }
        __builtin_amdgcn_fence(__ATOMIC_ACQUIRE, "agent");
        asm volatile("s_waitcnt vmcnt(0)" ::: "memory");
    }
    __syncthreads();
}
__device__ __forceinline__ void sub_barrier(unsigned* ctr, unsigned n, bool leader) {
    asm volatile("s_waitcnt vmcnt(0)" ::: "memory");
    __syncthreads();
    if (leader) {
        __builtin_amdgcn_fence(__ATOMIC_RELEASE, "agent");
        asm volatile("s_waitcnt vmcnt(0)" ::: "memory");
        (void)xb_add(ctr, 1u);
        unsigned sp = 0u; while (xb_ld(ctr) < n) { __builtin_amdgcn_s_sleep(1); if (++sp > XB_SPIN_CAP) break; }
        __builtin_amdgcn_fence(__ATOMIC_ACQUIRE, "agent");
        asm volatile("s_waitcnt vmcnt(0)" ::: "memory");
    }
    __syncthreads();
}

__global__ void __launch_bounds__(512, 2) mega(Args args) {
    extern __shared__ __attribute__((aligned(16))) unsigned char lds[];
    cg::grid_group grid = cg::this_grid();
    Frame F;
    F.lds = lds; F.wave = __builtin_amdgcn_readfirstlane(threadIdx.x >> 6); F.bid = blockIdx.x; F.G = gridDim.x;
    F.a = &args; F.ws = args.ws;
    const int lo = args.ph_lo, hi = args.ph_hi;
    unsigned long long sec_acc = 0ull;
    unsigned grp_gen = 0u;
    if (lo < 0) grid.sync();
    volatile unsigned* xst = (volatile unsigned*)(lds + LDS_BYTES - 64);
    const bool leader = (F.wave == 0) && (fresh_lane() == 0);
    if (leader) { xst[0] = 0u; xst[1] = 0u; }
    XcdBarrier xbar; xbar.bar = (unsigned*)(F.ws + WS_CTL + CTL_BAR); xbar.x = xb_xcc_id(); xbar.st = xst;
    if (leader) (void)xb_add(&xbar.bar[XB_XCNT(xbar.x)], 1u);
    unsigned* gcen = (unsigned*)(F.ws + WS_CTL + CTL_BAR) + 4352;
    if (leader) (void)xb_add(gcen + 64 * (F.bid & 7) + xbar.x, 1u);
    bool galign = false;
    __syncthreads();
    bf16* W8 = (bf16*)((unsigned char*)args.out + (size_t)64 * MiB);
#define IN(k) (lo <= (k) && (k) < hi)
#if PROBE_MASK
    unsigned long long pr_acc = 0ull, pr_t0 = rt_now();
#define SEAM(k) do { if (IN(k) && IN((k) + 1)) { xcd_barrier(xbar, (F.wave == 0) && (fresh_lane() == 0), (unsigned)F.G); } { const unsigned long long t1_ = rt_now(); if ((PROBE_MASK >> (k)) & 1u) pr_acc += t1_ - pr_t0; pr_t0 = t1_; } } while (0)
#define GSEAM(k) SEAM(k)
#else
#define SEAM(k) do { if (IN(k) && IN((k) + 1)) { xcd_barrier(xbar, (F.wave == 0) && (fresh_lane() == 0), (unsigned)F.G); } } while (0)
#define GSEAM(k) do { if (IN(k) && IN((k) + 1)) { if (galign) { ++grp_gen; group_barrier((unsigned*)(F.ws + WS_CTL + CTL_BAR) + 3648 + 64 * (F.bid & 7), (unsigned)(F.G >> 3) * grp_gen, (F.wave == 0) && (fresh_lane() == 0)); } else xcd_barrier(xbar, (F.wave == 0) && (fresh_lane() == 0), (unsigned)F.G); } } while (0)
#endif
    if (IN(0)) { ph0_prologue(F); } SEAM(0);
    if (IN(1)) {
        pg8::MultiOrder<3> S; S.lda = 1024; S.ldb = 1024; S.G = F.G; S.c = F.bid;
        S.s[0] = pg8::Sub{(const bf16*)args.out, (const bf16*)(F.ws + WS_WIN), 64, NCOLS / 256};
        S.s[1] = pg8::Sub{(const bf16*)(F.ws + WS_MEMB), W8 + (size_t)4 * 2048 * 2048, 8, 8};
        S.s[2] = pg8::Sub{W8 + (size_t)5 * 2048 * 2048, (const bf16*)(F.ws + WS_MEMB), 8, 8};
        gemm_multi<3, true>(F, S, 1024, OpProjCKV{F.ws});
        w8_transposes(F, W8);
    } SEAM(1);
    if (IN(2)) {
        if (F.G == 256) {
            if (F.bid < 128) { hgrn_chunked(F, F.bid, sec_acc);
                cvt_fp4_stream(F, args.in[24], F.ws + WS_WIN, (float*)(F.ws + WS_WIN + PEER_SC_OFF), (size_t)16384, F.bid, 128); cvt_fp4_stream(F, args.in[25], F.ws + WS_WIN + 1024, (float*)(F.ws + WS_WIN + PEER_SC_OFF) + 1, (size_t)16384, F.bid, 128); }
            else { ph2_side(F, F.bid - 128, 128); sub_barrier((unsigned*)(F.ws + WS_CTL + CTL_BAR) + 3520, 128u, (F.wave == 0) && (fresh_lane() == 0)); ph5_select(F, F.bid - 128, 128); }
        } else {
            for (int u = F.bid; u < 128; u += F.G) hgrn_chunked(F, u, sec_acc);
            ph2_side(F, F.bid, F.G);
            xcd_barrier(xbar, (F.wave == 0) && (fresh_lane() == 0), (unsigned)F.G);
            ph5_select(F, F.bid, F.G);
            cvt_fp4_stream(F, args.in[24], F.ws + WS_WIN, (float*)(F.ws + WS_WIN + PEER_SC_OFF), (size_t)16384, F.bid, F.G); cvt_fp4_stream(F, args.in[25], F.ws + WS_WIN + 1024, (float*)(F.ws + WS_WIN + PEER_SC_OFF) + 1, (size_t)16384, F.bid, F.G);
        }
    } SEAM(2);
    if (F.G == 256 && IN(2) && IN(4)) {
        if ((F.wave == 0) && (fresh_lane() == 0)) { unsigned ok = 1u;
            for (int gq = 0; gq < 8; ++gq) { unsigned best = 0u; for (int xq = 0; xq < 16; ++xq) { const unsigned cnt_ = xb_ld(gcen + 64 * gq + xq); best = cnt_ > best ? cnt_ : best; } ok &= (best == (unsigned)(F.G >> 3)) ? 1u : 0u; }
            xst[2] = ok; }
        __syncthreads();
        galign = xst[2] != 0u;
    }
    if (IN(4)) {
        gemm(F, (const bf16*)(F.ws + WS_CKV), 256, (const bf16*)(F.ws + WS_WKV), 256, T, 4096, 256, OpSplit2{F.slot(1), F.slot(2)});
    } GSEAM(4);
    if (IN(6)) { ph6_attn(F); } GSEAM(6);
    if (IN(7)) {
        pg8::Gemm g{1024, 2048, 2048}; pg8::MultiOrder<1> S; S.s[0] = pg8::Sub{(const bf16*)(F.ws + WS_HO8), W8, 64, 8}; S.lda = 1024; S.ldb = 2048; S.G = F.G; S.c = F.bid; S.A2 = F.slot(5);
        EpiYAB E{(const unsigned char*)F.slot(6), (const unsigned char*)F.slot(7), (unsigned char*)F.slot(5) + (size_t)32 * MiB};
        pg8::gemm_phase<EpiYAB, pg8::MultiOrder<1>, true, true, false, true>((PG8_LAS unsigned char*)F.lds, g, S, E, F.wave, F.lane());
    } GSEAM(7);
    if (IN(8)) { gemm_epi<true>(F, (const bf16*)((unsigned char*)F.slot(5) + (size_t)32 * MiB), 1024, W8 + (size_t)2 * 2048 * 2048, 1024, T, 2048, 1024, EpiMixStats{args.in[0], F.slot(0), (float*)(F.ws + WS_CTL + CTL_ST1), (unsigned char*)F.slot(5)}); } GSEAM(8);
    if (IN(10)) { gemm<true>(F, F.slot(5), 1024, W8 + (size_t)3 * 2048 * 2048, 1024, T, 2048, 1024, OpCQKV{F.slot(1), nullptr, nullptr, (float*)(F.ws + WS_CTL + CTL_ST1), (float*)(F.ws + WS_CTL + CTL_CVEC), (float*)(F.ws + WS_CTL + CTL_CVEC) + 2048}); } GSEAM(10);
    if (IN(11)) {
        if (F.G == 256) { pg8::GroupBatchOrder<OffS> S{F.slot(1), (const bf16*)(F.ws + WS_CK), 1, 2048, 2048, F.bid, OffS()}; pg8::Gemm g{2048, 2048, 512}; EpiXSoftmax E{F.slot(3)};
            pg8::gemm_phase<EpiXSoftmax, pg8::GroupBatchOrder<OffS>, false, false, true>((PG8_LAS unsigned char*)F.lds, g, S, E, F.wave, F.lane()); }
        else { pg8::BatchOrder<OffS> S{F.slot(1), (const bf16*)(F.ws + WS_CK), 8, 1, 32, 2048, 2048, F.G, F.bid, OffS()}; gemm_batch(F, S, 512, OpLogit{(float*)F.slot(2)}); }
    } GSEAM(11);
    if (IN(12)) { if (F.G != 256) ph_xsoftmax(F, (const float*)F.slot(2), F.slot(3)); } if (F.G != 256) SEAM(12);
    if (IN(13)) {
        if (F.G == 256) { pg8::GroupBatchOrder<OffPV> S{F.slot(3), (const bf16*)(F.ws + WS_VT), 2, 2048, 2048, F.bid, OffPV()}; pg8::Gemm g{2048, 2048, 256}; pg8::Epi8<OpCO> E{OpCO{(unsigned char*)F.slot(4)}};
            pg8::gemm_phase<pg8::Epi8<OpCO>, pg8::GroupBatchOrder<OffPV>, true>((PG8_LAS unsigned char*)F.lds, g, S, E, F.wave, F.lane()); }
        else { pg8::BatchOrder<OffPV> S{F.slot(3), (const bf16*)(F.ws + WS_VT), 8, 2, 32, 2048, 2048, F.G, F.bid, OffPV()}; gemm_batch(F, S, 256, OpCO{(unsigned char*)F.slot(4)}); }
    } GSEAM(13);
    if (IN(14)) { gemm_epi<true>(F, F.slot(4), 2048, W8 + (size_t)6 * 2048 * 2048, 1024, T, 2048, 1024, EpiCOStats{F.slot(0), (float*)(F.ws + WS_CTL + CTL_ST1), (float*)(F.ws + WS_CTL + CTL_ST2), args.in[14], args.in[15]}); } GSEAM(14);
    if (IN(16)) { gemm(F, F.slot(0), 2048, W8 + (size_t)7 * 2048 * 2048, 2048, T, 2048, 2048, OpPQFold{(float*)F.slot(1), (float*)F.slot(2), (float*)(F.ws + WS_CTL + CTL_ST2), (float*)(F.ws + WS_CTL + CTL_CVEC) + 4096, (float*)(F.ws + WS_CTL + CTL_CVEC) + 6144}); } SEAM(16);
    if (IN(17)) { ph_peer_select(F); } SEAM(17);
    if (IN(18)) { ph16_experts(F); }
#if PROBE_MASK
    xcd_barrier(xbar, (F.wave == 0) && (fresh_lane() == 0), (unsigned)F.G);
    { const unsigned long long t1_ = rt_now(); if ((PROBE_MASK >> 18) & 1u) pr_acc += t1_ - pr_t0; pr_acc += sec_acc;
      if (F.bid == 0 && threadIdx.x == 0) { const unsigned long long ts_ = rt_now(); while (rt_now() - ts_ < pr_acc) __builtin_amdgcn_s_sleep(8); } }
#endif
#undef IN
#undef SEAM
}

extern "C" void kernel_launch(void* const* d_in, const int* in_sizes, int n_in, void* d_out, int out_size, void* d_ws, size_t ws_size, hipStream_t stream) {
    static int grid = 0;
    if (grid == 0) {
        if (n_in != 28 || out_size != T * D || ws_size < WS_END) { fprintf(stderr, "kernel_launch: unexpected shapes (n_in %d out %d ws %zu)\n", n_in, out_size, ws_size); grid = -1; return; }
        int dev = 0, cus = 0, per_cu = 0;
        hipGetDevice(&dev); hipDeviceGetAttribute(&cus, hipDeviceAttributeMultiprocessorCount, dev);
        hipFuncSetAttribute((const void*)mega, hipFuncAttributeMaxDynamicSharedMemorySize, LDS_BYTES);
        hipOccupancyMaxActiveBlocksPerMultiprocessor(&per_cu, (const void*)mega, 512, LDS_BYTES);
        if (per_cu < 1) { fprintf(stderr, "kernel_launch: occupancy query says %d blocks per CU\n", per_cu); per_cu = 1; }
        (void)hipGetLastError();
        grid = cus;
    }
    if (grid < 0) return;
    (void)hipMemsetAsync((char*)d_ws + WS_CTL, 0, CTL_ZERO, stream);
    Args a{};
    for (int i = 0; i < 28; ++i) a.in[i] = (const float*)d_in[i];
    a.out = (float*)d_out; a.ws = (unsigned char*)d_ws;
#if ONE_LAUNCH
    a.ph_lo = 0; a.ph_hi = NPH;
    void* params[] = {&a};
    hipError_t e = hipLaunchCooperativeKernel((const void*)mega, dim3(grid), dim3(512), params, LDS_BYTES, stream);
    if (e != hipSuccess) fprintf(stderr, "cooperative launch failed: %s\n", hipGetErrorString(e));
#else
    for (int ph = 0; ph < NPH; ++ph) {
        a.ph_lo = ph; a.ph_hi = ph + 1;
        void* params[] = {&a};
        hipError_t e = hipLaunchCooperativeKernel((const void*)mega, dim3(grid), dim3(512), params, LDS_BYTES, stream);
        if (e != hipSuccess) { fprintf(stderr, "launch %d failed: %s\n", ph, hipGetErrorString(e)); break; }
    }
#endif
}
```
